# Optimizing an MI355X kernel written in HIP

```python
import jax
import jax.numpy as jnp
from jax import lax

D_MODEL = 1024
BATCH = 8
SEQ = 2048
DEPTH = 2

CHUNK = 64
N_META = 16
D_CONV = 512
CONV_WIDTH = 31
N_HEADS = 8
Q_LORA = 256
KV_LORA = 128
NOPE_DIM = 64
ROPE_DIM = 32
QK_DIM = NOPE_DIM + ROPE_DIM
V_DIM = 64
ROPE_THETA = 10000.0
Q_BLOCK = 128
N_IN = 2 * D_CONV + Q_LORA + KV_LORA + ROPE_DIM + 2 * D_MODEL
PEER_HEADS = 8
PEER_QDIM = 256
PEER_HALF = PEER_QDIM // 2
N_KEYS = 128
N_EXPERTS = N_KEYS * N_KEYS
PEER_TOPK = 16
PEER_BLOCK = 256

EPS = 1e-6
MASK_VALUE = -1e30
PAD_CHUNK = 2 ** 30

kernel_name = 'hybrid_conv_mla_peer_trunk'


def _rmsnorm(x, g):
    xf = x.astype(jnp.float32)
    y = xf * lax.rsqrt(jnp.mean(xf * xf, axis=-1, keepdims=True) + EPS)
    return (y * g.astype(jnp.float32)).astype(x.dtype)


def _layernorm(x, g, b):
    xf = x.astype(jnp.float32)
    mu = jnp.mean(xf, axis=-1, keepdims=True)
    xc = xf - mu
    y = xc * lax.rsqrt(jnp.mean(xc * xc, axis=-1, keepdims=True) + EPS)
    return (y * g.astype(jnp.float32) + b.astype(jnp.float32)).astype(x.dtype)


def _rope_tables(length):
    pos = jnp.arange(length, dtype=jnp.float32)
    inv = 1.0 / (ROPE_THETA ** (jnp.arange(0, ROPE_DIM, 2, dtype=jnp.float32) / ROPE_DIM))
    ang = pos[:, None] * inv[None, :]
    ang = jnp.concatenate([ang, ang], axis=-1)
    return jnp.cos(ang), jnp.sin(ang)


def _apply_rope(x, cos, sin):
    half = ROPE_DIM // 2
    x1, x2 = x[..., :half], x[..., half:]
    rot = jnp.concatenate([-x2, x1], axis=-1)
    c = cos[None, :, None, :].astype(x.dtype)
    s = sin[None, :, None, :].astype(x.dtype)
    return x * c + rot * s


def _chunk_ids(length):
    p = jnp.arange(length, dtype=jnp.int32)
    return jnp.where(p < N_META, 0, 1 + (p - N_META) // CHUNK).astype(jnp.int32)


def _chunk_causal_attention(q, k, v, chunk):
    B, L, H, dk = q.shape
    dv = v.shape[-1]
    l_pad = -(-L // Q_BLOCK) * Q_BLOCK
    pad = l_pad - L
    padw = ((0, 0), (0, pad), (0, 0), (0, 0))
    q = jnp.pad(q, padw)
    k = jnp.pad(k, padw).astype(jnp.float32)
    v = jnp.pad(v, padw)
    cid = jnp.pad(chunk, (0, pad), constant_values=PAD_CHUNK)
    scale = dk ** -0.5

    def block(i):
        qs = lax.dynamic_slice_in_dim(q, i * Q_BLOCK, Q_BLOCK, axis=1).astype(jnp.float32)
        qc = lax.dynamic_slice_in_dim(cid, i * Q_BLOCK, Q_BLOCK)
        s = jnp.einsum('bqhd,bkhd->bhqk', qs, k) * scale
        mask = cid[None, :] <= qc[:, None]
        s = jnp.where(mask[None, None], s, MASK_VALUE)
        p = jax.nn.softmax(s, axis=-1)
        return jnp.einsum('bhqk,bkhd->bqhd', p, v.astype(jnp.float32)).astype(v.dtype)

    out = lax.map(block, jnp.arange(l_pad // Q_BLOCK))
    out = jnp.transpose(out, (1, 0, 2, 3, 4)).reshape(B, l_pad, H, dv)
    return out[:, :L]


def _causal_depthwise_conv(x, w, b):
    C = x.shape[-1]
    xp = jnp.pad(x, ((0, 0), (CONV_WIDTH - 1, 0), (0, 0)))
    y = lax.conv_general_dilated(xp, w[:, None, :].astype(x.dtype), window_strides=(1,),
                                 padding='VALID', dimension_numbers=('NWC', 'WIO', 'NWC'),
                                 feature_group_count=C)
    return y + b.astype(x.dtype)


def _mixer_block(x, mix_g, w_in, conv_w, conv_b, conv_ln_g, conv_ln_b, w_conv_out,
                 q_a_g, w_uq, kv_a_g, w_ukv, q_norm_g, k_norm_g, w_mla_out, w_out,
                 cos, sin, chunk):
    B, L, _ = x.shape
    h = _rmsnorm(x, mix_g)
    z = h @ w_in
    o0 = 2 * D_CONV
    o1 = o0 + Q_LORA
    o2 = o1 + KV_LORA
    o3 = o2 + ROPE_DIM
    conv_in, c_q, c_kv, k_rope, gate_logits = (z[..., :o0], z[..., o0:o1], z[..., o1:o2],
                                              z[..., o2:o3], z[..., o3:])

    u = conv_in[..., :D_CONV] * jax.nn.sigmoid(conv_in[..., D_CONV:])
    u = _causal_depthwise_conv(u, conv_w, conv_b)
    u = jax.nn.silu(_layernorm(u, conv_ln_g, conv_ln_b))
    y_conv = u @ w_conv_out

    q = (_rmsnorm(c_q, q_a_g) @ w_uq).reshape(B, L, N_HEADS, QK_DIM)
    kv = (_rmsnorm(c_kv, kv_a_g) @ w_ukv).reshape(B, L, N_HEADS, NOPE_DIM + V_DIM)
    k_nope, v = kv[..., :NOPE_DIM], kv[..., NOPE_DIM:]
    k_r = jnp.broadcast_to(k_rope[:, :, None, :], (B, L, N_HEADS, ROPE_DIM))
    k = jnp.concatenate([k_nope, k_r], axis=-1)
    q = _rmsnorm(q, q_norm_g)
    k = _rmsnorm(k, k_norm_g)
    q = jnp.concatenate([q[..., :NOPE_DIM], _apply_rope(q[..., NOPE_DIM:], cos, sin)], axis=-1)
    k = jnp.concatenate([k[..., :NOPE_DIM], _apply_rope(k[..., NOPE_DIM:], cos, sin)], axis=-1)
    o = _chunk_causal_attention(q, k, v, chunk).reshape(B, L, N_HEADS * V_DIM)
    y_mla = o @ w_mla_out

    gates = jax.nn.sigmoid(gate_logits)
    merged = gates[..., :D_MODEL] * y_conv + gates[..., D_MODEL:] * y_mla
    return x + merged @ w_out


def _peer(h, wq, keys, u_table, v_table):
    B, L, D = h.shape
    T = B * L
    hf = h.reshape(T, D)
    q = (hf @ wq).reshape(T, PEER_HEADS, 2, PEER_HALF)
    s = jnp.einsum('thpd,hpnd->thpn', q, keys)
    sv, si = lax.top_k(s, PEER_TOPK)
    cand = (sv[:, :, 0, :, None] + sv[:, :, 1, None, :]).reshape(T, PEER_HEADS, PEER_TOPK * PEER_TOPK)
    cidx = (si[:, :, 0, :, None] * N_KEYS + si[:, :, 1, None, :]).reshape(T, PEER_HEADS, PEER_TOPK * PEER_TOPK)
    top_s, top_pos = lax.top_k(cand, PEER_TOPK)
    eidx = jnp.take_along_axis(cidx, top_pos, axis=-1)
    gw = jax.nn.softmax(top_s.astype(jnp.float32), axis=-1).astype(h.dtype)
    eidx = eidx.reshape(T, PEER_HEADS * PEER_TOPK)
    gw = gw.reshape(T, PEER_HEADS * PEER_TOPK)

    t_pad = -(-T // PEER_BLOCK) * PEER_BLOCK
    pad = t_pad - T
    nb = t_pad // PEER_BLOCK
    xs = jnp.pad(hf, ((0, pad), (0, 0))).reshape(nb, PEER_BLOCK, D)
    ids = jnp.pad(eidx, ((0, pad), (0, 0))).reshape(nb, PEER_BLOCK, PEER_HEADS * PEER_TOPK)
    ws = jnp.pad(gw, ((0, pad), (0, 0))).reshape(nb, PEER_BLOCK, PEER_HEADS * PEER_TOPK)

    def block(args):
        xb, ib, wb = args
        a = jnp.einsum('ted,td->te', u_table[ib], xb)
        act = jax.nn.gelu(a) * wb
        return jnp.einsum('te,ted->td', act, v_table[ib])

    out = lax.map(block, (xs, ids, ws)).reshape(t_pad, D)[:T]
    return out.reshape(B, L, D)


def setup_inputs(seed: int = 0) -> dict:
    key = jax.random.key(seed)
    ks = jax.random.split(key, 24)
    f32 = jnp.float32

    def w(k, shape, fan_in):
        return jax.random.normal(k, shape, f32) * (fan_in ** -0.5)

    def gain(k, shape):
        return 1.0 + 0.02 * jax.random.normal(k, shape, f32)

    def bias(k, shape):
        return 0.02 * jax.random.normal(k, shape, f32)

    return {
        'x': jax.random.normal(ks[0], (BATCH, SEQ, D_MODEL), f32),
        'meta_tokens': jax.random.normal(ks[1], (N_META, D_MODEL), f32),
        'mix_norm_g': gain(ks[2], (DEPTH, D_MODEL)),
        'w_in': w(ks[3], (DEPTH, D_MODEL, N_IN), D_MODEL),
        'conv_w': w(ks[4], (DEPTH, CONV_WIDTH, D_CONV), CONV_WIDTH),
        'conv_b': bias(ks[5], (DEPTH, D_CONV)),
        'conv_ln_g': gain(ks[6], (DEPTH, D_CONV)),
        'conv_ln_b': bias(ks[7], (DEPTH, D_CONV)),
        'w_conv_out': w(ks[8], (DEPTH, D_CONV, D_MODEL), D_CONV),
        'q_a_norm_g': gain(ks[9], (DEPTH, Q_LORA)),
        'w_uq': w(ks[10], (DEPTH, Q_LORA, N_HEADS * QK_DIM), Q_LORA),
        'kv_a_norm_g': gain(ks[11], (DEPTH, KV_LORA)),
        'w_ukv': w(ks[12], (DEPTH, KV_LORA, N_HEADS * (NOPE_DIM + V_DIM)), KV_LORA),
        'q_norm_g': gain(ks[13], (DEPTH, QK_DIM)),
        'k_norm_g': gain(ks[14], (DEPTH, QK_DIM)),
        'w_mla_out': w(ks[15], (DEPTH, N_HEADS * V_DIM, D_MODEL), N_HEADS * V_DIM),
        'w_out': w(ks[16], (DEPTH, D_MODEL, D_MODEL), D_MODEL),
        'ffn_norm_g': gain(ks[17], (DEPTH, D_MODEL)),
        'peer_wq': w(ks[18], (DEPTH, D_MODEL, PEER_HEADS * PEER_QDIM), D_MODEL),
        'peer_keys': w(ks[19], (DEPTH, PEER_HEADS, 2, N_KEYS, PEER_HALF), PEER_HALF),
        'peer_u': w(ks[20], (DEPTH, N_EXPERTS, D_MODEL), D_MODEL),
        'peer_v': w(ks[21], (DEPTH, N_EXPERTS, D_MODEL), D_MODEL),
    }


def reference(x, meta_tokens, mix_norm_g, w_in, conv_w, conv_b, conv_ln_g, conv_ln_b,
              w_conv_out, q_a_norm_g, w_uq, kv_a_norm_g, w_ukv, q_norm_g, k_norm_g,
              w_mla_out, w_out, ffn_norm_g, peer_wq, peer_keys, peer_u, peer_v):
    B = x.shape[0]
    meta = jnp.broadcast_to(meta_tokens[None].astype(x.dtype), (B, N_META, D_MODEL))
    h = jnp.concatenate([meta, x], axis=1)
    L = h.shape[1]
    cos, sin = _rope_tables(L)
    chunk = _chunk_ids(L)
    for l in range(DEPTH):
        h = _mixer_block(h, mix_norm_g[l], w_in[l], conv_w[l], conv_b[l], conv_ln_g[l],
                         conv_ln_b[l], w_conv_out[l], q_a_norm_g[l], w_uq[l], kv_a_norm_g[l],
                         w_ukv[l], q_norm_g[l], k_norm_g[l], w_mla_out[l], w_out[l],
                         cos, sin, chunk)
        h = h + _peer(_rmsnorm(h, ffn_norm_g[l]), peer_wq[l], peer_keys[l], peer_u[l], peer_v[l])
    return h[:, N_META:]
```

```cpp
#include <hip/hip_runtime.h>
#include <cstdio>
#include <cstdint>

#ifndef MK_PER_PHASE
#define MK_PER_PHASE 0
#endif

typedef unsigned short bf16;
typedef short bf16x8 __attribute__((ext_vector_type(8)));
typedef float f32x4 __attribute__((ext_vector_type(4)));
typedef unsigned u32x4 __attribute__((ext_vector_type(4)));
typedef unsigned u32x2 __attribute__((ext_vector_type(2)));
typedef __bf16 bf16x2 __attribute__((ext_vector_type(2)));

constexpr int NB = 8, SEQ = 2048, NMETA = 16, L = SEQ + NMETA, T = NB * L, D = 1024;
constexpr int DC = 512, CW = 31, NH = 8, QL = 256, KVL = 128, NOPE = 64, ROPE = 32, QK = 96, VD = 64;
constexpr int NIN = 3488, NINP = 3584;
constexpr int NEXP = 16384;
constexpr float EPS = 1e-6f;
constexpr int MT = T / 128;
static_assert(T % 128 == 0, "T tiles");

constexpr size_t al256(size_t x) { return (x + 255) & ~(size_t)255; }
constexpr size_t WS_CTL = 0;
constexpr size_t CTL_BYTES = 65536;
constexpr size_t WS_ROPE = WS_CTL + CTL_BYTES;
constexpr size_t WS_WIN = al256(WS_ROPE + (size_t)L * 16 * 8);
constexpr size_t SZ_WIN = (size_t)NINP * 1024 * 2, SZ_WCO = (size_t)1024 * 512 * 2, SZ_WUQ = (size_t)1024 * 256 * 2, SZ_WUKV = (size_t)1024 * 128 * 2,
                 SZ_WMLA = (size_t)1024 * 512 * 2, SZ_WOUT = (size_t)1024 * 1024 * 2, SZ_WPQ = (size_t)2048 * 1024 * 2, SZ_KEYS = (size_t)16 * 128 * 128 * 2;
constexpr size_t OFF_WCO = SZ_WIN, OFF_WUQ = OFF_WCO + SZ_WCO, OFF_WUKV = OFF_WUQ + SZ_WUQ, OFF_WMLA = OFF_WUKV + SZ_WUKV, OFF_WOUT = OFF_WMLA + SZ_WMLA,
                 OFF_WPQ = OFF_WOUT + SZ_WOUT, OFF_KEYS = OFF_WPQ + SZ_WPQ, SZ_WLAYER = OFF_KEYS + SZ_KEYS;
constexpr size_t WS_TAB = al256(WS_WIN + 2 * SZ_WLAYER);
constexpr size_t SZ_TAB = (size_t)NEXP * 1024 * 2;
constexpr size_t WS_H = al256(WS_TAB + 4 * SZ_TAB);
constexpr size_t WS_HB = al256(WS_H + (size_t)T * 1024 * 4);
constexpr size_t WS_SSQ = al256(WS_HB + (size_t)T * 1024 * 2);
constexpr size_t WS_UGLU = al256(WS_SSQ + (size_t)T * 8 * 4);
constexpr size_t WS_CQ = al256(WS_UGLU + (size_t)T * 512 * 2);
constexpr size_t WS_CKV = al256(WS_CQ + (size_t)T * 256 * 2);
constexpr size_t WS_KROPE = al256(WS_CKV + (size_t)T * 128 * 2);
constexpr size_t WS_SSQQ = al256(WS_KROPE + (size_t)T * 32 * 4);
constexpr size_t WS_SSQKV = al256(WS_SSQQ + (size_t)T * 2 * 4);
constexpr size_t WS_U2 = al256(WS_SSQKV + (size_t)T * 4);
constexpr size_t WS_Q = al256(WS_U2 + (size_t)T * 512 * 2);
constexpr size_t WS_K = al256(WS_Q + (size_t)T * NH * QK * 2);
constexpr size_t WS_VT = al256(WS_K + (size_t)T * NH * QK * 2);
constexpr size_t WS_O = al256(WS_VT + (size_t)T * NH * VD * 2 + 4096);
constexpr size_t WS_MERGED = al256(WS_O + (size_t)T * 512 * 2);
constexpr size_t WS_GATES = al256(WS_MERGED + (size_t)T * 1024 * 2);
constexpr size_t WS_SV = WS_GATES;
constexpr size_t WS_SI = al256(WS_SV + (size_t)T * 256 * 4);
constexpr size_t WS_EIDX = al256(WS_SI + (size_t)T * 256);
constexpr size_t WS_GW = al256(WS_EIDX + (size_t)T * 128 * 4);
constexpr size_t WS_PEER_END = WS_GW + (size_t)T * 128 * 4;
constexpr size_t WS_END = al256(WS_GATES + (size_t)T * 2048 * 2);
static_assert(WS_PEER_END <= WS_END, "peer scratch overlay");

constexpr int CW_BAR = 0;
constexpr int CW_QUEUE = 4096;

constexpr int LDS_MAIN = 128 * 132 * 4;
constexpr int LDS_MISC = LDS_MAIN;
constexpr int LDS_BYTES = LDS_MAIN + 64;

constexpr int NTHREADS = 256;

__device__ __forceinline__ unsigned pk2(float lo, float hi) { bf16x2 v; v.x = (__bf16)lo; v.y = (__bf16)hi; return __builtin_bit_cast(unsigned, v); }
__device__ __forceinline__ float bf_lo(unsigned p) { return __uint_as_float(p << 16); }
__device__ __forceinline__ float bf_hi(unsigned p) { return __uint_as_float(p & 0xffff0000u); }
__device__ __forceinline__ float fast_rcp(float x) { return __builtin_amdgcn_rcpf(x); }
__device__ __forceinline__ float fast_exp2(float x) { return __builtin_amdgcn_exp2f(x); }
__device__ __forceinline__ float sigmoidf_(float x) { return fast_rcp(1.0f + fast_exp2(-1.4426950409f * x)); }
__device__ __forceinline__ float gelu_tanh(float x) { const float u = 1.5957691216f * (x + 0.044715f * x * x * x); return x * fast_rcp(1.0f + fast_exp2(-1.4426950409f * u)); }
__device__ __forceinline__ float rsqrt_(float x) { return __builtin_amdgcn_rsqf(x); }
__device__ __forceinline__ float quad_sum(float v) { v += __shfl_xor(v, 16); v += __shfl_xor(v, 32); return v; }
__device__ __forceinline__ float quad_max(float v) { v = fmaxf(v, __shfl_xor(v, 16)); v = fmaxf(v, __shfl_xor(v, 32)); return v; }
__device__ __forceinline__ float wave_sum(float v) {
#pragma unroll
    for (int o = 1; o < 64; o <<= 1) v += __shfl_xor(v, o);
    return v;
}
__device__ __forceinline__ float dot2(unsigned a, unsigned b, float c) { return __builtin_amdgcn_fdot2_f32_bf16(__builtin_bit_cast(bf16x2, a), __builtin_bit_cast(bf16x2, b), c, false); }

#define XB_TMO      128
#define XB_XCNT(j)  (256  + 64 * (j))
#define XB_XSUB(j)  (1280 + 64 * (j))
#define XB_XGEN(j)  (2304 + 64 * (j))
#define XB_TOP      3328
#define XB_TOPGEN   3392
#define XCD_BAR_WORDS 3456
#define XB_SPIN_CAP (1u << 20)
__device__ __forceinline__ unsigned xb_ld(unsigned* p)              { return __hip_atomic_load(p, __ATOMIC_RELAXED, __HIP_MEMORY_SCOPE_AGENT); }
__device__ __forceinline__ unsigned xb_add(unsigned* p, unsigned v) { return __hip_atomic_fetch_add(p, v, __ATOMIC_RELAXED, __HIP_MEMORY_SCOPE_AGENT); }
__device__ __forceinline__ unsigned xb_xcc_id() { return (unsigned)__builtin_amdgcn_s_getreg((3 << 11) | 20) & 0xFu; }
#define XB_SPIN(cond, bar) do { unsigned _sp = 0; while (cond) { __builtin_amdgcn_s_sleep(1); \
    if ((++_sp & 255u) == 0u) { if (xb_ld(&(bar)[XB_TMO])) break; if (_sp > XB_SPIN_CAP) { atomicAdd(&(bar)[XB_TMO], 1u); break; } } } } while (0)
struct XcdBarrier { unsigned* bar; unsigned x; volatile unsigned* st; };
__device__ __forceinline__ XcdBarrier xcd_barrier_post(unsigned* bar, volatile unsigned* st) {
    XcdBarrier b; b.bar = bar; b.x = xb_xcc_id(); b.st = st;
    if (threadIdx.x == 0) (void)xb_add(&bar[XB_XCNT(b.x)], 1u);
    return b;
}
__device__ __forceinline__ void xcd_barrier_complete(unsigned* bar, unsigned x, unsigned& nloc, unsigned& nx) {
    const unsigned G = gridDim.x * gridDim.y * gridDim.z;
    unsigned sum, cnt, mine, sp = 0u;
    for (;;) {
        sum = 0u; cnt = 0u; mine = 0u;
#pragma unroll
        for (unsigned j = 0; j < 16; ++j) { const unsigned c = xb_ld(&bar[XB_XCNT(j)]); sum += c; cnt += (c > 0u) ? 1u : 0u; mine = (j == x) ? c : mine; }
        if (sum == G) break;
        __builtin_amdgcn_s_sleep(1);
        if ((++sp & 255u) == 0u) { if (xb_ld(&bar[XB_TMO])) break; if (sp > XB_SPIN_CAP) { atomicAdd(&bar[XB_TMO], 1u); break; } }
    }
    nloc = mine > 0u ? mine : 1u; nx = cnt > 0u ? cnt : 1u;
}
__device__ __forceinline__ void xcd_barrier(const XcdBarrier& b) {
    asm volatile("s_waitcnt vmcnt(0)" ::: "memory");
    __syncthreads();
    if (threadIdx.x == 0) {
        unsigned* bar = b.bar;
        __builtin_amdgcn_s_waitcnt(0);
        unsigned nloc = b.st[0], nx = b.st[1];
        if (nloc == 0u) { xcd_barrier_complete(bar, b.x, nloc, nx); b.st[0] = nloc; b.st[1] = nx; }
        const unsigned old = xb_add(&bar[XB_XSUB(b.x)], 1u);
        const unsigned gen = old / nloc;
        if (old + 1u == (gen + 1u) * nloc) {
            __builtin_amdgcn_fence(__ATOMIC_RELEASE, "agent");
            asm volatile("s_waitcnt vmcnt(0)" ::: "memory");
            const unsigned og = xb_add(&bar[XB_TOP], 1u);
            const unsigned tg = og / nx;
            if (og + 1u == (tg + 1u) * nx) xb_add(&bar[XB_TOPGEN], 1u);
            else XB_SPIN(xb_ld(&bar[XB_TOPGEN]) == tg, bar);
            __builtin_amdgcn_fence(__ATOMIC_ACQUIRE, "agent");
            xb_add(&bar[XB_XGEN(b.x)], 1u);
            asm volatile("s_waitcnt vmcnt(0)" ::: "memory");
        } else {
            XB_SPIN(xb_ld(&bar[XB_XGEN(b.x)]) == gen, bar);
            __builtin_amdgcn_fence(__ATOMIC_ACQUIRE, "agent");
            asm volatile("s_waitcnt vmcnt(0)" ::: "memory");
        }
    }
    __syncthreads();
}

struct Ctx {
    const float* in[22]; float* out; unsigned char* ws;
    unsigned char* lds; int tid, lane, wave, G, vb;
};
#define WSP(T_, off) ((T_*)(c.ws + (off)))
__device__ __forceinline__ Ctx reopaque(const Ctx& c0) {
    Ctx c = c0; int t = c0.tid; asm volatile("" : "+v"(t)); c.tid = t; c.lane = t & 63; c.wave = __builtin_amdgcn_readfirstlane(t >> 6);
    int vb = c0.vb; asm volatile("" : "+s"(vb)); c.vb = vb; return c;
}

__device__ __forceinline__ int lds_off(int row, int chunk) { return row * 128 + ((chunk ^ (row & 7)) << 4); }

__device__ __forceinline__ void gemm_compute_stage(f32x4 (&acc)[2][8], const unsigned char* sA, const unsigned char* sB, int wave, int lane) {
    const int r = lane & 15, q = lane >> 4;
#pragma unroll
    for (int ks = 0; ks < 2; ++ks) {
        bf16x8 af[2], bfr[8];
#pragma unroll
        for (int mi = 0; mi < 2; ++mi) af[mi] = *(const bf16x8*)(sA + lds_off(32 * wave + 16 * mi + r, 4 * ks + q));
#pragma unroll
        for (int ni = 0; ni < 8; ++ni) bfr[ni] = *(const bf16x8*)(sB + lds_off(16 * ni + r, 4 * ks + q));
#pragma unroll
        for (int mi = 0; mi < 2; ++mi)
#pragma unroll
            for (int ni = 0; ni < 8; ++ni) acc[mi][ni] = __builtin_amdgcn_mfma_f32_16x16x32_bf16(bfr[ni], af[mi], acc[mi][ni], 0, 0, 0);
    }
}

__device__ __forceinline__ void gemm_core(f32x4 (&acc)[2][8], const bf16* A, int lda, const bf16* Bt, int ldb, int K, unsigned char* lds, int tid) {
    const int wave = __builtin_amdgcn_readfirstlane(tid >> 6), lane = tid & 63;
    const int chunk = tid & 7, row0 = tid >> 3;
    const int nk = K >> 6;
    u32x4 ra[4], rb[4];
    const bf16* pa = A + (size_t)row0 * lda + chunk * 8;
    const bf16* pb = Bt + (size_t)row0 * ldb + chunk * 8;
#pragma unroll
    for (int i = 0; i < 4; ++i) { ra[i] = *(const u32x4*)(pa + (size_t)(32 * i) * lda); rb[i] = *(const u32x4*)(pb + (size_t)(32 * i) * ldb); }
#pragma unroll
    for (int i = 0; i < 4; ++i) { *(u32x4*)(lds + lds_off(row0 + 32 * i, chunk)) = ra[i]; *(u32x4*)(lds + 16384 + lds_off(row0 + 32 * i, chunk)) = rb[i]; }
    __syncthreads();
    for (int kt = 0; kt < nk; ++kt) {
        const int cur = kt & 1;
        if (kt + 1 < nk) {
#pragma unroll
            for (int i = 0; i < 4; ++i) { ra[i] = *(const u32x4*)(pa + (size_t)(32 * i) * lda + (kt + 1) * 64); rb[i] = *(const u32x4*)(pb + (size_t)(32 * i) * ldb + (kt + 1) * 64); }
        }
        gemm_compute_stage(acc, lds + cur * 32768, lds + cur * 32768 + 16384, wave, lane);
        if (kt + 1 < nk) {
            unsigned char* st = lds + (cur ^ 1) * 32768;
#pragma unroll
            for (int i = 0; i < 4; ++i) { *(u32x4*)(st + lds_off(row0 + 32 * i, chunk)) = ra[i]; *(u32x4*)(st + 16384 + lds_off(row0 + 32 * i, chunk)) = rb[i]; }
        }
        __syncthreads();
    }
}
__device__ __forceinline__ void acc_zero(f32x4 (&acc)[2][8]) {
#pragma unroll
    for (int mi = 0; mi < 2; ++mi)
#pragma unroll
        for (int ni = 0; ni < 8; ++ni) acc[mi][ni] = (f32x4){0.f, 0.f, 0.f, 0.f};
}
__device__ __forceinline__ float rstd_from_ssq8(const float* ssq, int tok) {
    const f32x4 a = *(const f32x4*)(ssq + (size_t)tok * 8), b = *(const f32x4*)(ssq + (size_t)tok * 8 + 4);
    const float s = ((a.x + a.y) + (a.z + a.w)) + ((b.x + b.y) + (b.z + b.w));
    return rsqrt_(s * (1.0f / 1024.0f) + EPS);
}

__device__ __forceinline__ int src_col(int mode, int np) {
    if (mode == 0) return np;
    if (mode == 2) { const int h = np >> 7, j = np & 127; return j < 96 ? h * 96 + j : -1; }
    if (np < 1024) { const int cblk = np >> 7, j = np & 127; return j < 64 ? 64 * cblk + j : 512 + 64 * cblk + (j - 64); }
    if (np < 1408) return np;
    if (np < 1536) { const int j = np - 1408; return j < 32 ? 1408 + j : -1; }
    return 1440 + (np - 1536);
}
__device__ __forceinline__ void p0_transpose_item(const float* W, int K, int N, bf16* Wt, int mode, const float* g, int item, float* scr, int lane) {
    const int nblk_k = K / 64, nb = item / nblk_k, kb = item % nblk_k, k0 = 64 * kb, n0 = 32 * nb;
    const int n = src_col(mode, n0 + (lane & 31));
#pragma unroll 8
    for (int i = 0; i < 32; ++i) { const int kk = 2 * i + (lane >> 5); float v = 0.f; if (n >= 0) { v = W[(size_t)(k0 + kk) * N + n]; if (g) v *= g[k0 + kk]; } scr[kk * 33 + (lane & 31)] = v; }
    __builtin_amdgcn_s_waitcnt(0xC07F); asm volatile("" ::: "memory");
    const int cch = lane & 7;
#pragma unroll
    for (int j = 0; j < 4; ++j) { const int nl = (lane >> 3) + 8 * j; const float* s = scr + (8 * cch) * 33 + nl;
        u32x4 o; o.x = pk2(s[0 * 33], s[1 * 33]); o.y = pk2(s[2 * 33], s[3 * 33]); o.z = pk2(s[4 * 33], s[5 * 33]); o.w = pk2(s[6 * 33], s[7 * 33]);
        *(u32x4*)(Wt + (size_t)(n0 + nl) * K + k0 + 8 * cch) = o; }
    __builtin_amdgcn_s_waitcnt(0xC07F); asm volatile("" ::: "memory");
}
struct WDesc { int in_idx, K, N, Np, mode, g_idx; size_t off; };
__device__ __forceinline__ void phase_prologue(const Ctx& c0) {
    Ctx c = reopaque(c0);
    const int gw = c.vb * 4 + c.wave, NGW = c.G * 4;
    float* scr = (float*)(c.lds + c.wave * 8704);
    const WDesc wd[7] = {
        {3, 1024, NIN, NINP, 1, 2, 0}, {8, 512, 1024, 1024, 0, -1, OFF_WCO}, {10, 256, 768, 1024, 2, 9, OFF_WUQ}, {12, 128, 1024, 1024, 0, 11, OFF_WUKV},
        {15, 512, 1024, 1024, 0, -1, OFF_WMLA}, {16, 1024, 1024, 1024, 0, -1, OFF_WOUT}, {18, 1024, 2048, 2048, 0, 17, OFF_WPQ}};
    for (int l = 0; l < 2; ++l)
#pragma unroll
        for (int m = 0; m < 7; ++m) {
            const int K = wd[m].K, N = wd[m].N, Np = wd[m].Np;
            const float* W = c.in[wd[m].in_idx] + (size_t)l * K * N;
            const float* g = wd[m].g_idx >= 0 ? c.in[wd[m].g_idx] + (size_t)l * K : nullptr;
            bf16* Wt = (bf16*)(c.ws + WS_WIN + l * SZ_WLAYER + wd[m].off);
            const int items = (K / 64) * (Np / 32);
            for (int it = gw; it < items; it += NGW) p0_transpose_item(W, K, N, Wt, wd[m].mode, g, it, scr, c.lane);
        }
    const int gt = c.vb * NTHREADS + c.tid, NGT = c.G * NTHREADS;
    for (int l = 0; l < 2; ++l) {
        const float* src = c.in[19] + (size_t)l * 262144; bf16* dst = (bf16*)(c.ws + WS_WIN + l * SZ_WLAYER + OFF_KEYS);
        for (int i = gt; i < 262144 / 8; i += NGT) { const f32x4 a = *(const f32x4*)(src + i * 8), b = *(const f32x4*)(src + i * 8 + 4);
            u32x4 o; o.x = pk2(a.x, a.y); o.y = pk2(a.z, a.w); o.z = pk2(b.x, b.y); o.w = pk2(b.z, b.w); *(u32x4*)(dst + i * 8) = o; }
    }
    for (int l = 0; l < 2; ++l)
        for (int uv = 0; uv < 2; ++uv) {
            const float* src = c.in[20 + uv] + (size_t)l * NEXP * 1024; bf16* dst = (bf16*)(c.ws + WS_TAB + (size_t)(l * 2 + uv) * SZ_TAB);
            const float* g = c.in[17] + l * 1024;
            for (int i = gt; i < NEXP * 1024 / 8; i += NGT) {
                f32x4 a = *(const f32x4*)(src + (size_t)i * 8), b = *(const f32x4*)(src + (size_t)i * 8 + 4);
                if (uv == 0) { const int col = (i & 127) * 8; const f32x4 ga = *(const f32x4*)(g + col), gb = *(const f32x4*)(g + col + 4); a = a * ga; b = b * gb; }
                u32x4 o; o.x = pk2(a.x, a.y); o.y = pk2(a.z, a.w); o.z = pk2(b.x, b.y); o.w = pk2(b.z, b.w); *(u32x4*)(dst + (size_t)i * 8) = o; }
        }
    { float* rope = WSP(float, WS_ROPE);
      for (int i = gt; i < L * 16; i += NGT) { const int pos = i >> 4, j = i & 15;
          const float inv = 1.0f / __builtin_exp2f((float)j * 0.8304820237218406f);
          const float angf = (float)pos * inv; const double ang = (double)angf;
          const double nq = __builtin_rint(ang * 0.63661977236758134308);
          double rr = __builtin_fma(-nq, 1.57079632679489655800e+00, ang); rr = __builtin_fma(-nq, 6.12323399573676603587e-17, rr);
          const double r2 = rr * rr;
          double sp = -1.0 / 1307674368000.0; sp = sp * r2 + 1.0 / 6227020800.0; sp = sp * r2 - 1.0 / 39916800.0; sp = sp * r2 + 1.0 / 362880.0; sp = sp * r2 - 1.0 / 5040.0; sp = sp * r2 + 1.0 / 120.0; sp = sp * r2 - 1.0 / 6.0; sp = sp * r2 * rr + rr;
          double cp = 1.0 / 87178291200.0; cp = cp * r2 - 1.0 / 479001600.0; cp = cp * r2 + 1.0 / 3628800.0; cp = cp * r2 - 1.0 / 40320.0; cp = cp * r2 + 1.0 / 720.0; cp = cp * r2 - 1.0 / 24.0; cp = cp * r2 + 0.5; cp = 1.0 - cp * r2;
          const int qd = ((int)nq) & 3;
          const double cv = qd == 0 ? cp : qd == 1 ? -sp : qd == 2 ? -cp : sp;
          const double sv_ = qd == 0 ? sp : qd == 1 ? cp : qd == 2 ? -sp : -cp;
          rope[2 * i] = (float)cv; rope[2 * i + 1] = (float)sv_; } }
    { float* h = WSP(float, WS_H); bf16* hb = WSP(bf16, WS_HB); float* ssq = WSP(float, WS_SSQ);
      for (int t = gw; t < T; t += NGW) { const int b = t / L, pos = t % L;
          const float* src = pos < NMETA ? c.in[1] + (size_t)pos * D : c.in[0] + ((size_t)b * SEQ + (pos - NMETA)) * D;
          float s = 0.f;
#pragma unroll
          for (int j = 0; j < 4; ++j) { const f32x4 v = *(const f32x4*)(src + j * 256 + c.lane * 4); *(f32x4*)(h + (size_t)t * D + j * 256 + c.lane * 4) = v;
              u32x2 o; o.x = pk2(v.x, v.y); o.y = pk2(v.z, v.w); *(u32x2*)(hb + (size_t)t * D + j * 256 + c.lane * 4) = o; s += (v.x * v.x + v.y * v.y) + (v.z * v.z + v.w * v.w); }
          s = wave_sum(s);
          if (c.lane < 8) ssq[(size_t)t * 8 + c.lane] = c.lane == 0 ? s : 0.f; } }
}

__device__ __forceinline__ void phase_A(const Ctx& c0, int l) {
    Ctx c = reopaque(c0);
    const bf16* hb = WSP(bf16, WS_HB); const bf16* Wt = (const bf16*)(c.ws + WS_WIN + l * SZ_WLAYER);
    const float* ssq = WSP(float, WS_SSQ);
    bf16* uglu = WSP(bf16, WS_UGLU); bf16* cq = WSP(bf16, WS_CQ); bf16* ckv = WSP(bf16, WS_CKV); float* krope = WSP(float, WS_KROPE);
    float* ssqq = WSP(float, WS_SSQQ); float* ssqkv = WSP(float, WS_SSQKV); bf16* gates = WSP(bf16, WS_GATES);
    constexpr int NT = NINP / 128;
    const int r = c.lane & 15, q = c.lane >> 4;
    for (int it = c.vb; it < MT * NT; it += c.G) {
        const int mt = it / NT, nt = it % NT;
        f32x4 acc[2][8]; acc_zero(acc);
        gemm_core(acc, hb + (size_t)mt * 128 * D, D, Wt + (size_t)nt * 128 * D, D, D, c.lds, c.tid);
#pragma unroll
        for (int mi = 0; mi < 2; ++mi) {
            const int tok = mt * 128 + 32 * c.wave + 16 * mi + r;
            const float rs = rstd_from_ssq8(ssq, tok);
            if (nt < 8) {
#pragma unroll
                for (int ni = 0; ni < 4; ++ni) { const f32x4 v = acc[mi][ni] * rs, g = acc[mi][ni + 4] * rs;
                    u32x2 o; o.x = pk2(v.x * sigmoidf_(g.x), v.y * sigmoidf_(g.y)); o.y = pk2(v.z * sigmoidf_(g.z), v.w * sigmoidf_(g.w));
                    *(u32x2*)(uglu + (size_t)tok * DC + nt * 64 + 16 * ni + 4 * q) = o; }
            } else if (nt < 11) {
                bf16* dst = nt < 10 ? cq + (size_t)tok * QL + (nt - 8) * 128 : ckv + (size_t)tok * KVL;
                float ss = 0.f;
#pragma unroll
                for (int ni = 0; ni < 8; ++ni) { const f32x4 v = acc[mi][ni] * rs; ss += (v.x * v.x + v.y * v.y) + (v.z * v.z + v.w * v.w);
                    u32x2 o; o.x = pk2(v.x, v.y); o.y = pk2(v.z, v.w); *(u32x2*)(dst + 16 * ni + 4 * q) = o; }
                ss = quad_sum(ss);
                if (q == 0) { if (nt < 10) ssqq[(size_t)tok * 2 + (nt - 8)] = ss; else ssqkv[tok] = ss; }
            } else if (nt == 11) {
#pragma unroll
                for (int ni = 0; ni < 2; ++ni) *(f32x4*)(krope + (size_t)tok * 32 + 16 * ni + 4 * q) = acc[mi][ni] * rs;
            } else {
#pragma unroll
                for (int ni = 0; ni < 8; ++ni) { const f32x4 v = acc[mi][ni] * rs;
                    u32x2 o; o.x = pk2(sigmoidf_(v.x), sigmoidf_(v.y)); o.y = pk2(sigmoidf_(v.z), sigmoidf_(v.w));
                    *(u32x2*)(gates + (size_t)tok * 2048 + (nt - 12) * 128 + 16 * ni + 4 * q) = o; }
            }
        }
    }
}

__device__ __forceinline__ void phaseB_q_item(Ctx& c, int l, int mt, int head) {
    const bf16* cq = WSP(bf16, WS_CQ); const bf16* Wt = (const bf16*)(c.ws + WS_WIN + l * SZ_WLAYER + OFF_WUQ);
    const float* ssqq = WSP(float, WS_SSQQ); const float* rope = WSP(float, WS_ROPE); const float* qg = c.in[13] + l * QK; bf16* Qb = WSP(bf16, WS_Q);
    const int r = c.lane & 15, q = c.lane >> 4;
    f32x4 acc[2][8]; acc_zero(acc);
    gemm_core(acc, cq + (size_t)mt * 128 * QL, QL, Wt + (size_t)head * 128 * QL, QL, QL, c.lds, c.tid);
    constexpr float QSCALE = 0.10206207261596575f * 1.4426950408889634f;
#pragma unroll
    for (int mi = 0; mi < 2; ++mi) {
        const int tok = mt * 128 + 32 * c.wave + 16 * mi + r, b = tok / L, pos = tok - b * L;
        const float rs = rsqrt_((ssqq[(size_t)tok * 2] + ssqq[(size_t)tok * 2 + 1]) * (1.0f / 256.0f) + EPS);
        float ss = 0.f;
#pragma unroll
        for (int ni = 0; ni < 6; ++ni) { acc[mi][ni] = acc[mi][ni] * rs; const f32x4 v = acc[mi][ni]; ss += (v.x * v.x + v.y * v.y) + (v.z * v.z + v.w * v.w); }
        ss = quad_sum(ss);
        const float rn = rsqrt_(ss * (1.0f / 96.0f) + EPS) * QSCALE;
#pragma unroll
        for (int ni = 0; ni < 6; ++ni) { const f32x4 g = *(const f32x4*)(qg + 16 * ni + 4 * q); acc[mi][ni] = acc[mi][ni] * g * rn; }
        const f32x4 cs0 = *(const f32x4*)(rope + ((size_t)pos * 16 + 4 * q) * 2), cs1 = *(const f32x4*)(rope + ((size_t)pos * 16 + 4 * q) * 2 + 4);
        const float co[4] = {cs0.x, cs0.z, cs1.x, cs1.z}, si[4] = {cs0.y, cs0.w, cs1.y, cs1.w};
        f32x4 x1 = acc[mi][4], x2 = acc[mi][5];
#pragma unroll
        for (int e = 0; e < 4; ++e) { const float a = x1[e], bb = x2[e]; x1[e] = a * co[e] - bb * si[e]; x2[e] = bb * co[e] + a * si[e]; }
        acc[mi][4] = x1; acc[mi][5] = x2;
        bf16* dst = Qb + (((size_t)b * NH + head) * L + pos) * QK;
#pragma unroll
        for (int ni = 0; ni < 6; ++ni) { const f32x4 v = acc[mi][ni]; u32x2 o; o.x = pk2(v.x, v.y); o.y = pk2(v.z, v.w); *(u32x2*)(dst + 16 * ni + 4 * q) = o; }
    }
}
__device__ __forceinline__ void phaseB_kv_item(Ctx& c, int l, int mt, int head) {
    const bf16* ckv = WSP(bf16, WS_CKV); const bf16* Wt = (const bf16*)(c.ws + WS_WIN + l * SZ_WLAYER + OFF_WUKV);
    const float* ssqkv = WSP(float, WS_SSQKV); const float* rope = WSP(float, WS_ROPE); const float* kg = c.in[14] + l * QK; const float* krope = WSP(float, WS_KROPE);
    bf16* Kb = WSP(bf16, WS_K); bf16* Vt = WSP(bf16, WS_VT);
    const int tid = c.tid, wave = c.wave, lane = c.lane, r = lane & 15, q = lane >> 4;
    unsigned char* lds = c.lds;
    f32x4 ak[2][4], av[2][4];
#pragma unroll
    for (int mi = 0; mi < 2; ++mi)
#pragma unroll
        for (int ni = 0; ni < 4; ++ni) { ak[mi][ni] = (f32x4){0.f, 0.f, 0.f, 0.f}; av[mi][ni] = (f32x4){0.f, 0.f, 0.f, 0.f}; }
    { const int chunk = tid & 7, row0 = tid >> 3;
      const bf16* pa = ckv + ((size_t)mt * 128 + row0) * KVL + chunk * 8; const bf16* pb = Wt + ((size_t)head * 128 + row0) * KVL + chunk * 8;
#pragma unroll
      for (int s = 0; s < 2; ++s)
#pragma unroll
          for (int i = 0; i < 4; ++i) { *(u32x4*)(lds + s * 32768 + lds_off(row0 + 32 * i, chunk)) = *(const u32x4*)(pa + (size_t)(32 * i) * KVL + s * 64);
              *(u32x4*)(lds + s * 32768 + 16384 + lds_off(row0 + 32 * i, chunk)) = *(const u32x4*)(pb + (size_t)(32 * i) * KVL + s * 64); }
    }
    __syncthreads();
#pragma unroll
    for (int s = 0; s < 2; ++s)
#pragma unroll
        for (int ks = 0; ks < 2; ++ks) {
            const unsigned char* sA = lds + s * 32768; const unsigned char* sB = sA + 16384;
            bf16x8 af[2], bfr[8];
#pragma unroll
            for (int mi = 0; mi < 2; ++mi) af[mi] = *(const bf16x8*)(sA + lds_off(32 * wave + 16 * mi + r, 4 * ks + q));
#pragma unroll
            for (int ni = 0; ni < 8; ++ni) bfr[ni] = *(const bf16x8*)(sB + lds_off(16 * ni + r, 4 * ks + q));
#pragma unroll
            for (int mi = 0; mi < 2; ++mi)
#pragma unroll
                for (int ni = 0; ni < 4; ++ni) { ak[mi][ni] = __builtin_amdgcn_mfma_f32_16x16x32_bf16(bfr[ni], af[mi], ak[mi][ni], 0, 0, 0);
                    av[mi][ni] = __builtin_amdgcn_mfma_f32_16x16x32_bf16(af[mi], bfr[ni + 4], av[mi][ni], 0, 0, 0); }
        }
    __syncthreads();
#pragma unroll
    for (int mi = 0; mi < 2; ++mi) {
        const int tok0 = mt * 128 + 32 * wave + 16 * mi, b = tok0 / L, pos0 = tok0 - b * L;
        { const int tok = tok0 + r, pos = pos0 + r;
          const float rs = rsqrt_(ssqkv[tok] * (1.0f / 128.0f) + EPS);
          const f32x4 kr1 = *(const f32x4*)(krope + (size_t)tok * 32 + 4 * q), kr2 = *(const f32x4*)(krope + (size_t)tok * 32 + 16 + 4 * q);
          float ss = (kr1.x * kr1.x + kr1.y * kr1.y) + (kr1.z * kr1.z + kr1.w * kr1.w) + (kr2.x * kr2.x + kr2.y * kr2.y) + (kr2.z * kr2.z + kr2.w * kr2.w);
#pragma unroll
          for (int ni = 0; ni < 4; ++ni) { ak[mi][ni] = ak[mi][ni] * rs; const f32x4 v = ak[mi][ni]; ss += (v.x * v.x + v.y * v.y) + (v.z * v.z + v.w * v.w); }
          ss = quad_sum(ss);
          const float rn = rsqrt_(ss * (1.0f / 96.0f) + EPS);
          bf16* dst = Kb + (((size_t)b * NH + head) * L + pos) * QK;
#pragma unroll
          for (int ni = 0; ni < 4; ++ni) { const f32x4 g = *(const f32x4*)(kg + 16 * ni + 4 * q); const f32x4 v = ak[mi][ni] * g * rn;
              u32x2 o; o.x = pk2(v.x, v.y); o.y = pk2(v.z, v.w); *(u32x2*)(dst + 16 * ni + 4 * q) = o; }
          const f32x4 g1 = *(const f32x4*)(kg + 64 + 4 * q), g2 = *(const f32x4*)(kg + 80 + 4 * q);
          f32x4 x1 = kr1 * g1 * rn, x2 = kr2 * g2 * rn;
          const f32x4 cs0 = *(const f32x4*)(rope + ((size_t)pos * 16 + 4 * q) * 2), cs1 = *(const f32x4*)(rope + ((size_t)pos * 16 + 4 * q) * 2 + 4);
          const float co[4] = {cs0.x, cs0.z, cs1.x, cs1.z}, si[4] = {cs0.y, cs0.w, cs1.y, cs1.w};
#pragma unroll
          for (int e = 0; e < 4; ++e) { const float a = x1[e], bb = x2[e]; x1[e] = a * co[e] - bb * si[e]; x2[e] = bb * co[e] + a * si[e]; }
          u32x2 o1, o2; o1.x = pk2(x1.x, x1.y); o1.y = pk2(x1.z, x1.w); o2.x = pk2(x2.x, x2.y); o2.y = pk2(x2.z, x2.w);
          *(u32x2*)(dst + 64 + 4 * q) = o1; *(u32x2*)(dst + 80 + 4 * q) = o2; }
        { const f32x4 sq = *(const f32x4*)(ssqkv + tok0 + 4 * q);
          f32x4 rs4; rs4.x = rsqrt_(sq.x * (1.0f / 128.0f) + EPS); rs4.y = rsqrt_(sq.y * (1.0f / 128.0f) + EPS); rs4.z = rsqrt_(sq.z * (1.0f / 128.0f) + EPS); rs4.w = rsqrt_(sq.w * (1.0f / 128.0f) + EPS);
#pragma unroll
          for (int ni = 0; ni < 4; ++ni) { const f32x4 v = av[mi][ni] * rs4; u32x2 o; o.x = pk2(v.x, v.y); o.y = pk2(v.z, v.w);
              *(u32x2*)(Vt + (((size_t)b * NH + head) * VD + 16 * ni + r) * L + pos0 + 4 * q) = o; } }
    }
}
__device__ __forceinline__ u32x4 conv_row(const bf16* uglu, int b, int pos, int ch) {
    u32x4 xv = (u32x4){0u, 0u, 0u, 0u};
    if (pos >= 0) xv = *(const u32x4*)(uglu + ((size_t)b * L + pos) * DC + ch);
    return xv;
}
__device__ __forceinline__ void conv_fma(float (&a)[8], const u32x4 xv, const f32x4 w0, const f32x4 w1) {
    a[0] += bf_lo(xv.x) * w0.x; a[1] += bf_hi(xv.x) * w0.y; a[2] += bf_lo(xv.y) * w0.z; a[3] += bf_hi(xv.y) * w0.w;
    a[4] += bf_lo(xv.z) * w1.x; a[5] += bf_hi(xv.z) * w1.y; a[6] += bf_lo(xv.w) * w1.z; a[7] += bf_hi(xv.w) * w1.w;
}
__device__ __forceinline__ void phaseB_conv_item(Ctx& c, int l, int grp) {
    const bf16* uglu = WSP(bf16, WS_UGLU); bf16* u2 = WSP(bf16, WS_U2);
    const float* cw = c.in[4] + (size_t)l * CW * DC; const float* cb = c.in[5] + l * DC; const float* lg = c.in[6] + l * DC; const float* lb = c.in[7] + l * DC;
    const int tok0 = grp * 4, b = tok0 / L, pos0 = tok0 - b * L, ch = c.lane * 8;
    float acc[4][8];
    { const f32x4 b0 = *(const f32x4*)(cb + ch), b1 = *(const f32x4*)(cb + ch + 4);
#pragma unroll
      for (int d = 0; d < 4; ++d) { acc[d][0] = b0.x; acc[d][1] = b0.y; acc[d][2] = b0.z; acc[d][3] = b0.w; acc[d][4] = b1.x; acc[d][5] = b1.y; acc[d][6] = b1.z; acc[d][7] = b1.w; } }
    const int base = pos0 - 30;
    u32x4 x0 = conv_row(uglu, b, base + 0, ch), x1 = conv_row(uglu, b, base + 1, ch), x2 = conv_row(uglu, b, base + 2, ch),
          x3 = conv_row(uglu, b, base + 3, ch), x4 = conv_row(uglu, b, base + 4, ch), x5;
    const float* wp = cw + ch;
#pragma unroll 1
    for (int w = 0; w < CW; ++w) {
        x5 = conv_row(uglu, b, (w + 5 <= 33) ? base + w + 5 : -1, ch);
        const f32x4 w0 = *(const f32x4*)wp, w1 = *(const f32x4*)(wp + 4); wp += DC;
        conv_fma(acc[0], x0, w0, w1); conv_fma(acc[1], x1, w0, w1); conv_fma(acc[2], x2, w0, w1); conv_fma(acc[3], x3, w0, w1);
        x0 = x1; x1 = x2; x2 = x3; x3 = x4; x4 = x5;
    }
    const f32x4 g0 = *(const f32x4*)(lg + ch), g1 = *(const f32x4*)(lg + ch + 4), e0 = *(const f32x4*)(lb + ch), e1 = *(const f32x4*)(lb + ch + 4);
    const float gg[8] = {g0.x, g0.y, g0.z, g0.w, g1.x, g1.y, g1.z, g1.w}, be[8] = {e0.x, e0.y, e0.z, e0.w, e1.x, e1.y, e1.z, e1.w};
#pragma unroll
    for (int d = 0; d < 4; ++d) {
        float s = 0.f;
#pragma unroll
        for (int j = 0; j < 8; ++j) s += acc[d][j];
        const float mu = wave_sum(s) * (1.0f / 512.0f);
        float vq = 0.f;
#pragma unroll
        for (int j = 0; j < 8; ++j) { acc[d][j] -= mu; vq += acc[d][j] * acc[d][j]; }
        const float rstd = rsqrt_(wave_sum(vq) * (1.0f / 512.0f) + EPS);
        float y[8];
#pragma unroll
        for (int j = 0; j < 8; ++j) { const float v = acc[d][j] * rstd * gg[j] + be[j]; y[j] = v * sigmoidf_(v); }
        u32x4 o; o.x = pk2(y[0], y[1]); o.y = pk2(y[2], y[3]); o.z = pk2(y[4], y[5]); o.w = pk2(y[6], y[7]);
        *(u32x4*)(u2 + (size_t)(tok0 + d) * DC + ch) = o;
    }
}
__device__ __forceinline__ void phase_B(const Ctx& c0, int l) {
    Ctx c = reopaque(c0);
    constexpr int NQ = MT * NH, NKV = MT * NH, NCV = T / 16;
    for (int it = c.vb; it < NQ + NKV + NCV; it += c.G) {
        if (it < NQ) phaseB_q_item(c, l, it / NH, it % NH);
        else if (it < NQ + NKV) phaseB_kv_item(c, l, (it - NQ) / NH, (it - NQ) % NH);
        else phaseB_conv_item(c, l, (it - NQ - NKV) * 4 + c.wave);
    }
}

constexpr int KROW = 208, VROW = 136, ATT_STAGE = 64 * KROW + 64 * VROW;
__device__ __forceinline__ void phase_C(const Ctx& c0, int l) {
    Ctx c = reopaque(c0);
    const bf16* Qb = WSP(bf16, WS_Q); const bf16* Kb = WSP(bf16, WS_K); const bf16* Vt = WSP(bf16, WS_VT); bf16* O = WSP(bf16, WS_O);
    unsigned* qctr = WSP(unsigned, WS_CTL) + CW_QUEUE + 64 * l;
    volatile unsigned* misc = (volatile unsigned*)(c.lds + LDS_MISC);
    const int tid = c.tid, wave = c.wave, lane = c.lane, r = lane & 15, q = lane >> 4;
    unsigned char* lds = c.lds;
    for (;;) {
        if (tid == 0) misc[4] = atomicAdd(qctr, 1u);
        __syncthreads();
        const int item = (int)misc[4];
        __syncthreads();
        if (item >= NB * NH * 33) break;
        const int ch = 32 - item / 64, bh = item % 64, b = bh / NH, h = bh % NH;
        const int r0 = ch == 0 ? 0 : 16 + 64 * (ch - 1);
        const bool active = ch > 0 || wave == 0;
        const int ntiles = ch + 1;
        const bf16* Kbase = Kb + (size_t)bh * L * QK; const bf16* Vbase = Vt + (size_t)bh * VD * L;
        bf16x8 qf[3];
#pragma unroll
        for (int ks = 0; ks < 3; ++ks) qf[ks] = *(const bf16x8*)(Qb + ((size_t)bh * L + r0 + 16 * wave + r) * QK + 32 * ks + 8 * q);
        float m = -1e30f, lsum = 0.f;
        f32x4 o[4];
#pragma unroll
        for (int dt = 0; dt < 4; ++dt) o[dt] = (f32x4){0.f, 0.f, 0.f, 0.f};
        u32x4 rk[3], rv[2];
        auto gload = [&](int kt) {
#pragma unroll
            for (int i = 0; i < 3; ++i) { const int id = tid + 256 * i, row = id / 12, cc = id % 12; rk[i] = *(const u32x4*)(Kbase + (size_t)(kt * 64 + row) * QK + cc * 8); }
#pragma unroll
            for (int i = 0; i < 2; ++i) { const int id = tid + 256 * i, row = id >> 3, cc = id & 7; rv[i] = *(const u32x4*)(Vbase + (size_t)row * L + kt * 64 + cc * 8); }
        };
        auto lstore = [&](int s) {
            unsigned char* st = lds + s * ATT_STAGE;
#pragma unroll
            for (int i = 0; i < 3; ++i) { const int id = tid + 256 * i, row = id / 12, cc = id % 12; *(u32x4*)(st + row * KROW + cc * 16) = rk[i]; }
#pragma unroll
            for (int i = 0; i < 2; ++i) { const int id = tid + 256 * i, row = id >> 3, cc = id & 7; u32x2* d = (u32x2*)(st + 64 * KROW + row * VROW + cc * 16); d[0] = (u32x2){rv[i].x, rv[i].y}; d[1] = (u32x2){rv[i].z, rv[i].w}; }
        };
        gload(0); lstore(0);
        __syncthreads();
        for (int kt = 0; kt < ntiles; ++kt) {
            const int cur = kt & 1;
            if (kt + 1 < ntiles) gload(kt + 1);
            const unsigned char* sK = lds + cur * ATT_STAGE; const unsigned char* sV = sK + 64 * KROW;
            const bool full = kt < ch;
            f32x4 s[4];
#pragma unroll
            for (int k4 = 0; k4 < 4; ++k4) {
                s[k4] = (f32x4){0.f, 0.f, 0.f, 0.f};
                if (k4 == 0 || full) {
#pragma unroll
                    for (int ks = 0; ks < 3; ++ks) { const bf16x8 kf = *(const bf16x8*)(sK + (16 * k4 + r) * KROW + 64 * ks + 16 * q);
                        s[k4] = __builtin_amdgcn_mfma_f32_16x16x32_bf16(kf, qf[ks], s[k4], 0, 0, 0); }
                }
            }
            float mx = fmaxf(fmaxf(s[0].x, s[0].y), fmaxf(s[0].z, s[0].w));
            if (full) {
#pragma unroll
                for (int k4 = 1; k4 < 4; ++k4) mx = fmaxf(mx, fmaxf(fmaxf(s[k4].x, s[k4].y), fmaxf(s[k4].z, s[k4].w)));
            }
            mx = quad_max(mx);
            const float mn = fmaxf(m, mx), alpha = fast_exp2(m - mn); m = mn;
            float ps = 0.f;
#pragma unroll
            for (int k4 = 0; k4 < 4; ++k4) {
                if (k4 == 0 || full) { f32x4 p; p.x = fast_exp2(s[k4].x - mn); p.y = fast_exp2(s[k4].y - mn); p.z = fast_exp2(s[k4].z - mn); p.w = fast_exp2(s[k4].w - mn);
                    ps += (p.x + p.y) + (p.z + p.w); s[k4] = p; }
            }
            lsum = lsum * alpha + ps;
#pragma unroll
            for (int dt = 0; dt < 4; ++dt) o[dt] = o[dt] * alpha;
#pragma unroll
            for (int st = 0; st < 2; ++st) {
                if (st == 0 || full) {
                    u32x4 pw; pw.x = pk2(s[2 * st].x, s[2 * st].y); pw.y = pk2(s[2 * st].z, s[2 * st].w); pw.z = pk2(s[2 * st + 1].x, s[2 * st + 1].y); pw.w = pk2(s[2 * st + 1].z, s[2 * st + 1].w);
                    if (!full) { pw.z = 0u; pw.w = 0u; }
                    const bf16x8 pf = __builtin_bit_cast(bf16x8, pw);
#pragma unroll
                    for (int dt = 0; dt < 4; ++dt) {
                        const unsigned char* vp = sV + (16 * dt + r) * VROW + (32 * st + 4 * q) * 2;
                        const u32x2 v0 = *(const u32x2*)vp; u32x2 v1 = (u32x2){0u, 0u};
                        if (full) v1 = *(const u32x2*)(vp + 32);
                        const u32x4 vw = (u32x4){v0.x, v0.y, v1.x, v1.y};
                        o[dt] = __builtin_amdgcn_mfma_f32_16x16x32_bf16(__builtin_bit_cast(bf16x8, vw), pf, o[dt], 0, 0, 0);
                    }
                }
            }
            if (kt + 1 < ntiles) lstore(cur ^ 1);
            __syncthreads();
        }
        lsum = quad_sum(lsum);
        if (active) {
            const float inv = 1.0f / lsum;
            bf16* dst = O + ((size_t)b * L + r0 + 16 * wave + r) * 512 + h * VD;
#pragma unroll
            for (int dt = 0; dt < 4; ++dt) { const f32x4 v = o[dt] * inv; u32x2 ov; ov.x = pk2(v.x, v.y); ov.y = pk2(v.z, v.w); *(u32x2*)(dst + 16 * dt + 4 * q) = ov; }
        }
    }
}

__device__ __forceinline__ void phase_D(const Ctx& c0, int l) {
    Ctx c = reopaque(c0);
    const bf16* u2 = WSP(bf16, WS_U2); const bf16* O = WSP(bf16, WS_O); const bf16* gates = WSP(bf16, WS_GATES); bf16* merged = WSP(bf16, WS_MERGED);
    const bf16* Wco = (const bf16*)(c.ws + WS_WIN + l * SZ_WLAYER + OFF_WCO); const bf16* Wmla = (const bf16*)(c.ws + WS_WIN + l * SZ_WLAYER + OFF_WMLA);
    const int r = c.lane & 15, q = c.lane >> 4;
    for (int it = c.vb; it < MT * 8; it += c.G) {
        const int mt = it / 8, nt = it % 8;
        f32x4 acc[2][8]; acc_zero(acc);
        gemm_core(acc, u2 + (size_t)mt * 128 * 512, 512, Wco + (size_t)nt * 128 * 512, 512, 512, c.lds, c.tid);
#pragma unroll
        for (int mi = 0; mi < 2; ++mi) { const int tok = mt * 128 + 32 * c.wave + 16 * mi + r;
            const bf16* gp = gates + (size_t)tok * 2048 + nt * 128 + 4 * q; bf16* mp = merged + (size_t)tok * D + nt * 128 + 4 * q;
#pragma unroll
            for (int ni = 0; ni < 8; ++ni) { const u32x2 g = *(const u32x2*)(gp + 16 * ni); const f32x4 v = acc[mi][ni];
                u32x2 o; o.x = pk2(v.x * bf_lo(g.x), v.y * bf_hi(g.x)); o.y = pk2(v.z * bf_lo(g.y), v.w * bf_hi(g.y)); *(u32x2*)(mp + 16 * ni) = o; } }
        acc_zero(acc);
        gemm_core(acc, O + (size_t)mt * 128 * 512, 512, Wmla + (size_t)nt * 128 * 512, 512, 512, c.lds, c.tid);
#pragma unroll
        for (int mi = 0; mi < 2; ++mi) { const int tok = mt * 128 + 32 * c.wave + 16 * mi + r;
            const bf16* gp = gates + (size_t)tok * 2048 + 1024 + nt * 128 + 4 * q; bf16* mp = merged + (size_t)tok * D + nt * 128 + 4 * q;
#pragma unroll
            for (int ni = 0; ni < 8; ++ni) { const u32x2 g = *(const u32x2*)(gp + 16 * ni); const u32x2 s = *(const u32x2*)(mp + 16 * ni); const f32x4 v = acc[mi][ni];
                u32x2 o; o.x = pk2(bf_lo(s.x) + v.x * bf_lo(g.x), bf_hi(s.x) + v.y * bf_hi(g.x)); o.y = pk2(bf_lo(s.y) + v.z * bf_lo(g.y), bf_hi(s.y) + v.w * bf_hi(g.y));
                *(u32x2*)(mp + 16 * ni) = o; } }
    }
}

__device__ __forceinline__ void phase_E(const Ctx& c0, int l) {
    Ctx c = reopaque(c0);
    const bf16* merged = WSP(bf16, WS_MERGED); const bf16* Wout = (const bf16*)(c.ws + WS_WIN + l * SZ_WLAYER + OFF_WOUT);
    float* h = WSP(float, WS_H); bf16* hb = WSP(bf16, WS_HB); float* ssq = WSP(float, WS_SSQ);
    const int r = c.lane & 15, q = c.lane >> 4;
    for (int it = c.vb; it < MT * 8; it += c.G) {
        const int mt = it / 8, nt = it % 8;
        f32x4 acc[2][8]; acc_zero(acc);
        gemm_core(acc, merged + (size_t)mt * 128 * D, D, Wout + (size_t)nt * 128 * D, D, D, c.lds, c.tid);
#pragma unroll
        for (int mi = 0; mi < 2; ++mi) { const int tok = mt * 128 + 32 * c.wave + 16 * mi + r; float ss = 0.f;
#pragma unroll
            for (int ni = 0; ni < 8; ++ni) { float* hp = h + (size_t)tok * D + nt * 128 + 16 * ni + 4 * q; const f32x4 v = *(const f32x4*)hp + acc[mi][ni]; *(f32x4*)hp = v;
                ss += (v.x * v.x + v.y * v.y) + (v.z * v.z + v.w * v.w);
                u32x2 o; o.x = pk2(v.x, v.y); o.y = pk2(v.z, v.w); *(u32x2*)(hb + (size_t)tok * D + nt * 128 + 16 * ni + 4 * q) = o; }
            ss = quad_sum(ss);
            if (q == 0) ssq[(size_t)tok * 8 + nt] = ss; }
    }
}

__device__ __forceinline__ unsigned f2key(float f) { const unsigned u = __float_as_uint(f); return u ^ ((u >> 31) ? 0xFFFFFFFFu : 0x80000000u); }
__device__ __forceinline__ float key2f(unsigned k) { const unsigned u = (k >> 31) ? (k ^ 0x80000000u) : ~k; return __uint_as_float(u); }
__device__ __forceinline__ void top16_insert(unsigned (&lst)[16], unsigned x) {
#pragma unroll
    for (int i = 0; i < 16; ++i) { const unsigned a = lst[i]; lst[i] = a > x ? a : x; x = a > x ? x : a; }
}
__device__ __forceinline__ void phase_F(const Ctx& c0, int l) {
    Ctx c = reopaque(c0);
    const bf16* hb = WSP(bf16, WS_HB); const bf16* Wpq = (const bf16*)(c.ws + WS_WIN + l * SZ_WLAYER + OFF_WPQ); const bf16* keys = (const bf16*)(c.ws + WS_WIN + l * SZ_WLAYER + OFF_KEYS);
    const float* ssq = WSP(float, WS_SSQ); float* sv = WSP(float, WS_SV); unsigned char* si = WSP(unsigned char, WS_SI);
    const int tid = c.tid, wave = c.wave, lane = c.lane, r = lane & 15, q = lane >> 4;
    unsigned char* lds = c.lds;
    for (int it = c.vb; it < MT * 16; it += c.G) {
        const int mt = it / 16, hp = it % 16;
        f32x4 acc[2][8]; acc_zero(acc);
        gemm_core(acc, hb + (size_t)mt * 128 * D, D, Wpq + (size_t)hp * 128 * D, D, D, lds, tid);
#pragma unroll
        for (int mi = 0; mi < 2; ++mi) { const int row = 32 * wave + 16 * mi + r; const float rs = rstd_from_ssq8(ssq, mt * 128 + row);
#pragma unroll
            for (int ni = 0; ni < 8; ++ni) { const f32x4 v = acc[mi][ni] * rs; u32x2 o; o.x = pk2(v.x, v.y); o.y = pk2(v.z, v.w);
                *(u32x2*)(lds + (ni >> 2) * 32768 + lds_off(row, 2 * (ni & 3) + (q >> 1)) + 8 * (q & 1)) = o; } }
        { const int chunk = tid & 7, row0 = tid >> 3; const bf16* pb = keys + ((size_t)hp * 128 + row0) * 128 + chunk * 8;
#pragma unroll
          for (int s = 0; s < 2; ++s)
#pragma unroll
              for (int i = 0; i < 4; ++i) *(u32x4*)(lds + s * 32768 + 16384 + lds_off(row0 + 32 * i, chunk)) = *(const u32x4*)(pb + (size_t)(32 * i) * 128 + s * 64); }
        __syncthreads();
        acc_zero(acc);
        gemm_compute_stage(acc, lds, lds + 16384, wave, lane);
        gemm_compute_stage(acc, lds + 32768, lds + 32768 + 16384, wave, lane);
        __syncthreads();
        float* S = (float*)lds;
#pragma unroll
        for (int mi = 0; mi < 2; ++mi) { const int row = 32 * wave + 16 * mi + r;
#pragma unroll
            for (int ni = 0; ni < 8; ++ni) *(f32x4*)(S + row * 132 + 16 * ni + 4 * q) = acc[mi][ni]; }
        __syncthreads();
        if (tid < 128) {
            unsigned lst[16];
#pragma unroll
            for (int i = 0; i < 16; ++i) lst[i] = 0u;
            const float* row = S + tid * 132;
#pragma unroll 4
            for (int j = 0; j < 32; ++j) { const f32x4 v = *(const f32x4*)(row + 4 * j);
                top16_insert(lst, (f2key(v.x) & ~127u) | (unsigned)(127 - (4 * j)));
                top16_insert(lst, (f2key(v.y) & ~127u) | (unsigned)(127 - (4 * j + 1)));
                top16_insert(lst, (f2key(v.z) & ~127u) | (unsigned)(127 - (4 * j + 2)));
                top16_insert(lst, (f2key(v.w) & ~127u) | (unsigned)(127 - (4 * j + 3))); }
            const int tok = mt * 128 + tid;
            unsigned idx[16]; float val[16];
#pragma unroll
            for (int i = 0; i < 16; ++i) { idx[i] = 127u - (lst[i] & 127u); val[i] = row[idx[i]]; }
            float* svp = sv + ((size_t)tok * 16 + hp) * 16;
#pragma unroll
            for (int i = 0; i < 4; ++i) *(f32x4*)(svp + 4 * i) = (f32x4){val[4 * i], val[4 * i + 1], val[4 * i + 2], val[4 * i + 3]};
            u32x4 pi;
            pi.x = idx[0] | (idx[1] << 8) | (idx[2] << 16) | (idx[3] << 24); pi.y = idx[4] | (idx[5] << 8) | (idx[6] << 16) | (idx[7] << 24);
            pi.z = idx[8] | (idx[9] << 8) | (idx[10] << 16) | (idx[11] << 24); pi.w = idx[12] | (idx[13] << 8) | (idx[14] << 16) | (idx[15] << 24);
            *(u32x4*)(si + ((size_t)tok * 16 + hp) * 16) = pi;
        }
        __syncthreads();
    }
}

__device__ __forceinline__ void phase_F3(const Ctx& c0, int l) {
    Ctx c = reopaque(c0);
    const float* sv = WSP(float, WS_SV); const unsigned char* si = WSP(unsigned char, WS_SI); int* eidx = WSP(int, WS_EIDX); float* gw = WSP(float, WS_GW);
    float* lsv = (float*)c.lds;
    unsigned char* lsi = c.lds + 256 * 33 * 4;
    const int tid = c.tid;
    for (int base = c.vb * NTHREADS; base < T * 8; base += c.G * NTHREADS) {
        const int th = base + tid;
        float a[16], b[16];
#pragma unroll
        for (int i = 0; i < 4; ++i) { const f32x4 x = *(const f32x4*)(sv + (size_t)th * 32 + 4 * i), y = *(const f32x4*)(sv + (size_t)th * 32 + 16 + 4 * i);
            a[4 * i] = x.x; a[4 * i + 1] = x.y; a[4 * i + 2] = x.z; a[4 * i + 3] = x.w; b[4 * i] = y.x; b[4 * i + 1] = y.y; b[4 * i + 2] = y.z; b[4 * i + 3] = y.w; }
        const u32x4 ia = *(const u32x4*)(si + (size_t)th * 32), ib = *(const u32x4*)(si + (size_t)th * 32 + 16);
#pragma unroll
        for (int i = 0; i < 16; ++i) { lsv[tid * 33 + i] = a[i]; lsv[tid * 33 + 16 + i] = b[i]; }
        *(u32x4*)(lsi + tid * 32) = ia; *(u32x4*)(lsi + tid * 32 + 16) = ib;
        unsigned lst[16];
#pragma unroll
        for (int i = 0; i < 16; ++i) lst[i] = 0u;
#pragma unroll
        for (int i = 0; i < 16; ++i)
#pragma unroll
            for (int j = 0; j < 16; ++j)
                if ((i + 1) * (j + 1) <= 16) top16_insert(lst, (f2key(a[i] + b[j]) & ~255u) | (unsigned)(255 - (i * 16 + j)));
        __builtin_amdgcn_s_waitcnt(0xC07F); asm volatile("" ::: "memory");
        float s[16]; int e[16];
#pragma unroll
        for (int k = 0; k < 16; ++k) { const unsigned code = 255u - (lst[k] & 255u); const int i = code >> 4, j = code & 15;
            s[k] = lsv[tid * 33 + i] + lsv[tid * 33 + 16 + j]; e[k] = (int)lsi[tid * 32 + i] * 128 + (int)lsi[tid * 32 + 16 + j]; }
        float mx = s[0];
#pragma unroll
        for (int k = 1; k < 16; ++k) mx = fmaxf(mx, s[k]);
        float sum = 0.f;
#pragma unroll
        for (int k = 0; k < 16; ++k) { s[k] = fast_exp2((s[k] - mx) * 1.4426950409f); sum += s[k]; }
        const float inv = 1.0f / sum;
#pragma unroll
        for (int k = 0; k < 4; ++k) { *(f32x4*)(gw + (size_t)th * 16 + 4 * k) = (f32x4){s[4 * k] * inv, s[4 * k + 1] * inv, s[4 * k + 2] * inv, s[4 * k + 3] * inv};
            typedef int i32x4 __attribute__((ext_vector_type(4)));
            *(i32x4*)(eidx + (size_t)th * 16 + 4 * k) = (i32x4){e[4 * k], e[4 * k + 1], e[4 * k + 2], e[4 * k + 3]}; }
        __builtin_amdgcn_s_waitcnt(0xC07F); asm volatile("" ::: "memory");
    }
}

__device__ __forceinline__ void phase_G(const Ctx& c0, int l) {
    Ctx c = reopaque(c0);
    const bf16* hb = WSP(bf16, WS_HB); const float* ssq = WSP(float, WS_SSQ); const int* eidx = WSP(int, WS_EIDX); const float* gw = WSP(float, WS_GW);
    const bf16* U = (const bf16*)(c.ws + WS_TAB + (size_t)(l * 2) * SZ_TAB); const bf16* V = (const bf16*)(c.ws + WS_TAB + (size_t)(l * 2 + 1) * SZ_TAB);
    float* h = WSP(float, WS_H); bf16* hbw = WSP(bf16, WS_HB); float* ssqw = WSP(float, WS_SSQ);
    unsigned* qctr = WSP(unsigned, WS_CTL) + CW_QUEUE + 64 * (2 + l);
    volatile unsigned* misc = (volatile unsigned*)(c.lds + LDS_MISC);
    const int lane = c.lane;
    for (;;) {
        if (c.tid == 0) misc[4] = atomicAdd(qctr, 1u);
        __syncthreads();
        const int blk = (int)misc[4];
        __syncthreads();
        if (blk * 4 >= T) break;
        const int tok = blk * 4 + c.wave;
        const u32x4 x0 = *(const u32x4*)(hb + (size_t)tok * D + lane * 8), x1 = *(const u32x4*)(hb + (size_t)tok * D + 512 + lane * 8);
        const float rs = rstd_from_ssq8(ssq, tok);
        const int e0 = eidx[(size_t)tok * 128 + lane], e1 = eidx[(size_t)tok * 128 + 64 + lane];
        const float w0 = gw[(size_t)tok * 128 + lane], w1 = gw[(size_t)tok * 128 + 64 + lane];
        float acc[16];
#pragma unroll
        for (int j = 0; j < 16; ++j) acc[j] = 0.f;
        for (int cc = 0; cc < 16; ++cc) {
            const int esel = cc < 8 ? e0 : e1; const float wsel = cc < 8 ? w0 : w1;
            int ex[8]; float wx[8];
#pragma unroll
            for (int k = 0; k < 8; ++k) { ex[k] = __shfl(esel, (cc & 7) * 8 + k); wx[k] = __shfl(wsel, (cc & 7) * 8 + k); }
            u32x4 ua[8], ub[8], va[8], vb[8];
#pragma unroll
            for (int k = 0; k < 8; ++k) { const bf16* up = U + (size_t)ex[k] * D + lane * 8; ua[k] = *(const u32x4*)up; ub[k] = *(const u32x4*)(up + 512); }
#pragma unroll
            for (int k = 0; k < 8; ++k) { const bf16* vp = V + (size_t)ex[k] * D + lane * 8; va[k] = *(const u32x4*)vp; vb[k] = *(const u32x4*)(vp + 512); }
            float a[8];
#pragma unroll
            for (int k = 0; k < 8; ++k) { float d0 = dot2(ua[k].x, x0.x, 0.f), d1 = dot2(ua[k].y, x0.y, 0.f); d0 = dot2(ua[k].z, x0.z, d0); d1 = dot2(ua[k].w, x0.w, d1);
                d0 = dot2(ub[k].x, x1.x, d0); d1 = dot2(ub[k].y, x1.y, d1); d0 = dot2(ub[k].z, x1.z, d0); d1 = dot2(ub[k].w, x1.w, d1); a[k] = d0 + d1; }
#pragma unroll
            for (int k = 0; k < 8; ++k) { a[k] = wave_sum(a[k]); a[k] = gelu_tanh(a[k] * rs) * wx[k]; }
#pragma unroll
            for (int k = 0; k < 8; ++k) {
                acc[0] += a[k] * bf_lo(va[k].x); acc[1] += a[k] * bf_hi(va[k].x); acc[2] += a[k] * bf_lo(va[k].y); acc[3] += a[k] * bf_hi(va[k].y);
                acc[4] += a[k] * bf_lo(va[k].z); acc[5] += a[k] * bf_hi(va[k].z); acc[6] += a[k] * bf_lo(va[k].w); acc[7] += a[k] * bf_hi(va[k].w);
                acc[8] += a[k] * bf_lo(vb[k].x); acc[9] += a[k] * bf_hi(vb[k].x); acc[10] += a[k] * bf_lo(vb[k].y); acc[11] += a[k] * bf_hi(vb[k].y);
                acc[12] += a[k] * bf_lo(vb[k].z); acc[13] += a[k] * bf_hi(vb[k].z); acc[14] += a[k] * bf_lo(vb[k].w); acc[15] += a[k] * bf_hi(vb[k].w); }
        }
        float* hp = h + (size_t)tok * D + lane * 8;
        f32x4 r0 = *(const f32x4*)hp, r1 = *(const f32x4*)(hp + 4), r2 = *(const f32x4*)(hp + 512), r3 = *(const f32x4*)(hp + 516);
        r0 += (f32x4){acc[0], acc[1], acc[2], acc[3]}; r1 += (f32x4){acc[4], acc[5], acc[6], acc[7]}; r2 += (f32x4){acc[8], acc[9], acc[10], acc[11]}; r3 += (f32x4){acc[12], acc[13], acc[14], acc[15]};
        if (l == 0) {
            *(f32x4*)hp = r0; *(f32x4*)(hp + 4) = r1; *(f32x4*)(hp + 512) = r2; *(f32x4*)(hp + 516) = r3;
            u32x4 o0, o1; o0.x = pk2(r0.x, r0.y); o0.y = pk2(r0.z, r0.w); o0.z = pk2(r1.x, r1.y); o0.w = pk2(r1.z, r1.w);
            o1.x = pk2(r2.x, r2.y); o1.y = pk2(r2.z, r2.w); o1.z = pk2(r3.x, r3.y); o1.w = pk2(r3.z, r3.w);
            *(u32x4*)(hbw + (size_t)tok * D + lane * 8) = o0; *(u32x4*)(hbw + (size_t)tok * D + 512 + lane * 8) = o1;
            float ss = (r0.x * r0.x + r0.y * r0.y) + (r0.z * r0.z + r0.w * r0.w) + (r1.x * r1.x + r1.y * r1.y) + (r1.z * r1.z + r1.w * r1.w)
                     + (r2.x * r2.x + r2.y * r2.y) + (r2.z * r2.z + r2.w * r2.w) + (r3.x * r3.x + r3.y * r3.y) + (r3.z * r3.z + r3.w * r3.w);
            ss = wave_sum(ss);
            if (lane < 8) ssqw[(size_t)tok * 8 + lane] = lane == 0 ? ss : 0.f;
        } else {
            const int b = tok / L, pos = tok - b * L;
            if (pos >= NMETA) { float* op = c.out + ((size_t)b * SEQ + (pos - NMETA)) * D + lane * 8;
                *(f32x4*)op = r0; *(f32x4*)(op + 4) = r1; *(f32x4*)(op + 512) = r2; *(f32x4*)(op + 516) = r3; }
        }
    }
}

struct Args { const float* in[22]; float* out; unsigned char* ws; int ph_lo, ph_hi; };
constexpr int N_PHASES = 17;

__global__ void __launch_bounds__(NTHREADS, 2) fwd_kernel(Args args) {
    extern __shared__ __attribute__((aligned(16))) unsigned char lds_raw[];
    Ctx c;
#pragma unroll
    for (int i = 0; i < 22; ++i) c.in[i] = args.in[i];
    c.out = args.out; c.ws = args.ws; c.lds = lds_raw;
    c.tid = threadIdx.x; c.lane = c.tid & 63; c.wave = __builtin_amdgcn_readfirstlane(c.tid >> 6);
    c.G = gridDim.x; { const int bx = blockIdx.x; c.vb = (c.G % 8 == 0) ? (bx % 8) * (c.G / 8) + bx / 8 : bx; }
    volatile unsigned* misc = (volatile unsigned*)(c.lds + LDS_MISC);
    if (c.tid < 16) misc[c.tid] = 0u;
    __syncthreads();
    const int lo = args.ph_lo, hi = args.ph_hi;
    const bool multi = (hi - lo) > 1;
    XcdBarrier bar; bar.bar = WSP(unsigned, WS_CTL) + CW_BAR; bar.x = 0; bar.st = misc;
    if (multi) bar = xcd_barrier_post(WSP(unsigned, WS_CTL) + CW_BAR, misc);
#define IN_(k) (lo <= (k) && (k) < hi)
#define SEAM_(k) do { if ((k) + 1 < hi) xcd_barrier(bar); } while (0)
    if (IN_(0)) { phase_prologue(c); SEAM_(0); }
#pragma unroll 1
    for (int l = 0; l < 2; ++l) {
        const int p0 = 1 + 8 * l;
        if (IN_(p0 + 0)) { phase_A(c, l); SEAM_(p0 + 0); }
        if (IN_(p0 + 1)) { phase_B(c, l); SEAM_(p0 + 1); }
        if (IN_(p0 + 2)) { phase_C(c, l); SEAM_(p0 + 2); }
        if (IN_(p0 + 3)) { phase_D(c, l); SEAM_(p0 + 3); }
        if (IN_(p0 + 4)) { phase_E(c, l); SEAM_(p0 + 4); }
        if (IN_(p0 + 5)) { phase_F(c, l); SEAM_(p0 + 5); }
        if (IN_(p0 + 6)) { phase_F3(c, l); SEAM_(p0 + 6); }
        if (IN_(p0 + 7)) { phase_G(c, l); SEAM_(p0 + 7); }
    }
}

extern "C" void kernel_launch(void* const* d_in, const int* in_sizes, int n_in, void* d_out, int out_size, void* d_ws, size_t ws_size, hipStream_t stream) {
    static int grid = 0;
    if (grid == 0) {
        if (n_in != 22 || out_size != NB * SEQ * D || ws_size < WS_END) { fprintf(stderr, "kernel_launch: unexpected shapes (n_in %d out %d ws %zu need %zu)\n", n_in, out_size, ws_size, (size_t)WS_END); grid = -1; return; }
        int dev = 0, cus = 0, per_cu = 0;
        hipGetDevice(&dev); hipDeviceGetAttribute(&cus, hipDeviceAttributeMultiprocessorCount, dev);
        if (hipFuncSetAttribute((const void*)fwd_kernel, hipFuncAttributeMaxDynamicSharedMemorySize, LDS_BYTES) != hipSuccess) { fprintf(stderr, "kernel_launch: hipFuncSetAttribute failed\n"); grid = -1; return; }
        if (hipOccupancyMaxActiveBlocksPerMultiprocessor(&per_cu, (const void*)fwd_kernel, NTHREADS, LDS_BYTES) != hipSuccess || per_cu < 1) { fprintf(stderr, "kernel_launch: occupancy query failed (%d)\n", per_cu); per_cu = 1; (void)hipGetLastError(); }
        if (per_cu > 2) per_cu = 2;
        grid = cus * per_cu;
        fprintf(stderr, "kernel_launch: grid %d (%d per CU), lds %d, ws need %zu have %zu\n", grid, per_cu, LDS_BYTES, (size_t)WS_END, ws_size);
    }
    if (grid < 0) return;
    hipMemsetAsync((char*)d_ws + WS_CTL, 0, CTL_BYTES, stream);
    Args a{};
    for (int i = 0; i < 22; ++i) a.in[i] = (const float*)d_in[i];
    a.out = (float*)d_out; a.ws = (unsigned char*)d_ws;
#if MK_PER_PHASE
    for (int ph = 0; ph < N_PHASES; ++ph) { a.ph_lo = ph; a.ph_hi = ph + 1; hipLaunchKernelGGL(fwd_kernel, dim3(grid), dim3(NTHREADS), LDS_BYTES, stream, a); }
#else
    a.ph_lo = 0; a.ph_hi = N_PHASES;
    void* kargs[] = {&a};
    hipError_t e = hipLaunchCooperativeKernel((const void*)fwd_kernel, dim3(grid), dim3(NTHREADS), kargs, LDS_BYTES, stream);
    if (e != hipSuccess) fprintf(stderr, "kernel_launch: cooperative launch failed: %s (grid %d)\n", hipGetErrorString(e), grid);
#endif
}
```

```cpp
#include <hip/hip_runtime.h>
#include <cstdio>
#include <cstdint>

#ifndef MK_PER_PHASE
#define MK_PER_PHASE 0
#endif

typedef unsigned short bf16;
typedef short bf16x8 __attribute__((ext_vector_type(8)));
typedef float f32x4 __attribute__((ext_vector_type(4)));
typedef unsigned u32x4 __attribute__((ext_vector_type(4)));
typedef unsigned u32x2 __attribute__((ext_vector_type(2)));
typedef __bf16 bf16x2 __attribute__((ext_vector_type(2)));

constexpr int NB = 8, SEQ = 2048, NMETA = 16, L = SEQ + NMETA, T = NB * L, D = 1024;
constexpr int DC = 512, CW = 31, NH = 8, QL = 256, KVL = 128, NOPE = 64, ROPE = 32, QK = 96, VD = 64;
constexpr int NIN = 3488, NINP = 3584;
constexpr int NEXP = 16384;
constexpr float EPS = 1e-6f;
constexpr int MT = T / 128;
static_assert(T % 128 == 0, "T tiles");

constexpr size_t al256(size_t x) { return (x + 255) & ~(size_t)255; }
constexpr size_t WS_CTL = 0;
constexpr size_t CTL_BYTES = 65536;
constexpr size_t WS_ROPE = WS_CTL + CTL_BYTES;
constexpr size_t WS_WIN = al256(WS_ROPE + (size_t)L * 16 * 8);
constexpr size_t SZ_WIN = (size_t)NINP * 1024 * 2, SZ_WCO = (size_t)1024 * 512 * 2, SZ_WUQ = (size_t)1024 * 256 * 2, SZ_WUKV = (size_t)1024 * 128 * 2,
                 SZ_WMLA = (size_t)1024 * 512 * 2, SZ_WOUT = (size_t)1024 * 1024 * 2, SZ_WPQ = (size_t)2048 * 1024 * 2, SZ_KEYS = (size_t)16 * 128 * 128 * 2;
constexpr size_t OFF_WCO = SZ_WIN, OFF_WUQ = OFF_WCO + SZ_WCO, OFF_WUKV = OFF_WUQ + SZ_WUQ, OFF_WMLA = OFF_WUKV + SZ_WUKV, OFF_WOUT = OFF_WMLA + SZ_WMLA,
                 OFF_WPQ = OFF_WOUT + SZ_WOUT, OFF_KEYS = OFF_WPQ + SZ_WPQ, SZ_WLAYER = OFF_KEYS + SZ_KEYS;
constexpr size_t WS_TAB = al256(WS_WIN + 2 * SZ_WLAYER);
constexpr size_t SZ_TAB = (size_t)NEXP * 1024 * 2;
constexpr size_t WS_H = al256(WS_TAB + 4 * SZ_TAB);
constexpr size_t WS_HB = al256(WS_H + (size_t)T * 1024 * 4);
constexpr size_t WS_SSQ = al256(WS_HB + (size_t)T * 1024 * 2);
constexpr size_t WS_UGLU = al256(WS_SSQ + (size_t)T * 8 * 4);
constexpr size_t WS_CQ = al256(WS_UGLU + (size_t)T * 512 * 2);
constexpr size_t WS_CKV = al256(WS_CQ + (size_t)T * 256 * 2);
constexpr size_t WS_KROPE = al256(WS_CKV + (size_t)T * 128 * 2);
constexpr size_t WS_SSQQ = al256(WS_KROPE + (size_t)T * 32 * 4);
constexpr size_t WS_SSQKV = al256(WS_SSQQ + (size_t)T * 2 * 4);
constexpr size_t WS_U2 = al256(WS_SSQKV + (size_t)T * 4);
constexpr size_t WS_Q = al256(WS_U2 + (size_t)T * 512 * 2);
constexpr size_t WS_K = al256(WS_Q + (size_t)T * NH * QK * 2);
constexpr size_t WS_VT = al256(WS_K + (size_t)T * NH * QK * 2);
constexpr size_t WS_O = al256(WS_VT + (size_t)T * NH * VD * 2 + 4096);
constexpr size_t WS_MERGED = al256(WS_O + (size_t)T * 512 * 2);
constexpr size_t WS_GATES = al256(WS_MERGED + (size_t)T * 1024 * 2);
constexpr size_t WS_SV = WS_GATES;
constexpr size_t WS_SI = al256(WS_SV + (size_t)T * 256 * 4);
constexpr size_t WS_EIDX = al256(WS_SI + (size_t)T * 256);
constexpr size_t WS_GW = al256(WS_EIDX + (size_t)T * 128 * 4);
constexpr size_t WS_STB = al256(WS_GW + (size_t)T * 128 * 4);
constexpr size_t WS_PEER_END = WS_STB + (size_t)T * 16;
constexpr size_t WS_END = al256(WS_GATES + (size_t)T * 2048 * 2);
static_assert(WS_PEER_END <= WS_END, "peer scratch overlay");

constexpr int CW_BAR = 0;
constexpr int CW_QUEUE = 4096;

constexpr int LDS_MAIN = 128 * 132 * 4;
constexpr int LDS_MISC = LDS_MAIN;
constexpr int LDS_BYTES = LDS_MAIN + 64;

constexpr int NTHREADS = 256;

__device__ __forceinline__ unsigned pk2(float lo, float hi) { bf16x2 v; v.x = (__bf16)lo; v.y = (__bf16)hi; return __builtin_bit_cast(unsigned, v); }
__device__ __forceinline__ float bf_lo(unsigned p) { return __uint_as_float(p << 16); }
__device__ __forceinline__ float bf_hi(unsigned p) { return __uint_as_float(p & 0xffff0000u); }
__device__ __forceinline__ float fast_rcp(float x) { return __builtin_amdgcn_rcpf(x); }
__device__ __forceinline__ float fast_exp2(float x) { return __builtin_amdgcn_exp2f(x); }
__device__ __forceinline__ float sigmoidf_(float x) { return fast_rcp(1.0f + fast_exp2(-1.4426950409f * x)); }
__device__ __forceinline__ float gelu_tanh(float x) { const float u = 1.5957691216f * (x + 0.044715f * x * x * x); return x * fast_rcp(1.0f + fast_exp2(-1.4426950409f * u)); }
__device__ __forceinline__ float rsqrt_(float x) { return __builtin_amdgcn_rsqf(x); }
__device__ __forceinline__ float quad_sum(float v) { v += __shfl_xor(v, 16); v += __shfl_xor(v, 32); return v; }
__device__ __forceinline__ float quad_max(float v) { v = fmaxf(v, __shfl_xor(v, 16)); v = fmaxf(v, __shfl_xor(v, 32)); return v; }
__device__ __forceinline__ float wave_sum(float v) {
#pragma unroll
    for (int o = 1; o < 64; o <<= 1) v += __shfl_xor(v, o);
    return v;
}
template <int CTRL> __device__ __forceinline__ float dpp(float x) { return __builtin_bit_cast(float, __builtin_amdgcn_mov_dpp(__builtin_bit_cast(int, x), CTRL, 0xf, 0xf, true)); }
__device__ __forceinline__ float xrow16_sum(float x) {
    auto s = __builtin_amdgcn_permlane16_swap(__float_as_uint(x), __float_as_uint(x), false, false);
    x = __uint_as_float(s[0]) + __uint_as_float(s[1]);
    auto t = __builtin_amdgcn_permlane32_swap(__float_as_uint(x), __float_as_uint(x), false, false);
    return __uint_as_float(t[0]) + __uint_as_float(t[1]);
}
__device__ __forceinline__ float wave_sum_dpp(float x) {
    x += dpp<0xB1>(x); x += dpp<0x4E>(x); x += dpp<0x141>(x); x += dpp<0x128>(x); return xrow16_sum(x);
}
__device__ __forceinline__ float dot2(unsigned a, unsigned b, float c) { return __builtin_amdgcn_fdot2_f32_bf16(__builtin_bit_cast(bf16x2, a), __builtin_bit_cast(bf16x2, b), c, false); }

#define XB_TMO      128
#define XB_XCNT(j)  (256  + 64 * (j))
#define XB_XSUB(j)  (1280 + 64 * (j))
#define XB_XGEN(j)  (2304 + 64 * (j))
#define XB_TOP      3328
#define XB_TOPGEN   3392
#define XCD_BAR_WORDS 3456
#define XB_SPIN_CAP (1u << 20)
__device__ __forceinline__ unsigned xb_ld(unsigned* p)              { return __hip_atomic_load(p, __ATOMIC_RELAXED, __HIP_MEMORY_SCOPE_AGENT); }
__device__ __forceinline__ unsigned xb_add(unsigned* p, unsigned v) { return __hip_atomic_fetch_add(p, v, __ATOMIC_RELAXED, __HIP_MEMORY_SCOPE_AGENT); }
__device__ __forceinline__ unsigned xb_xcc_id() { return (unsigned)__builtin_amdgcn_s_getreg((3 << 11) | 20) & 0xFu; }
#define XB_SPIN(cond, bar) do { unsigned _sp = 0; while (cond) { __builtin_amdgcn_s_sleep(1); \
    if ((++_sp & 255u) == 0u) { if (xb_ld(&(bar)[XB_TMO])) break; if (_sp > XB_SPIN_CAP) { atomicAdd(&(bar)[XB_TMO], 1u); break; } } } } while (0)
struct XcdBarrier { unsigned* bar; unsigned x; volatile unsigned* st; };
__device__ __forceinline__ XcdBarrier xcd_barrier_post(unsigned* bar, volatile unsigned* st) {
    XcdBarrier b; b.bar = bar; b.x = xb_xcc_id(); b.st = st;
    if (threadIdx.x == 0) (void)xb_add(&bar[XB_XCNT(b.x)], 1u);
    return b;
}
__device__ __forceinline__ void xcd_barrier_complete(unsigned* bar, unsigned x, unsigned& nloc, unsigned& nx) {
    const unsigned G = gridDim.x * gridDim.y * gridDim.z;
    unsigned sum, cnt, mine, sp = 0u;
    for (;;) {
        sum = 0u; cnt = 0u; mine = 0u;
#pragma unroll
        for (unsigned j = 0; j < 16; ++j) { const unsigned c = xb_ld(&bar[XB_XCNT(j)]); sum += c; cnt += (c > 0u) ? 1u : 0u; mine = (j == x) ? c : mine; }
        if (sum == G) break;
        __builtin_amdgcn_s_sleep(1);
        if ((++sp & 255u) == 0u) { if (xb_ld(&bar[XB_TMO])) break; if (sp > XB_SPIN_CAP) { atomicAdd(&bar[XB_TMO], 1u); break; } }
    }
    nloc = mine > 0u ? mine : 1u; nx = cnt > 0u ? cnt : 1u;
}
__device__ __forceinline__ void xcd_barrier(const XcdBarrier& b) {
    asm volatile("s_waitcnt vmcnt(0)" ::: "memory");
    __syncthreads();
    if (threadIdx.x == 0) {
        unsigned* bar = b.bar;
        __builtin_amdgcn_s_waitcnt(0);
        unsigned nloc = b.st[0], nx = b.st[1];
        if (nloc == 0u) { xcd_barrier_complete(bar, b.x, nloc, nx); b.st[0] = nloc; b.st[1] = nx; }
        const unsigned old = xb_add(&bar[XB_XSUB(b.x)], 1u);
        const unsigned gen = old / nloc;
        if (old + 1u == (gen + 1u) * nloc) {
            __builtin_amdgcn_fence(__ATOMIC_RELEASE, "agent");
            asm volatile("s_waitcnt vmcnt(0)" ::: "memory");
            const unsigned og = xb_add(&bar[XB_TOP], 1u);
            const unsigned tg = og / nx;
            if (og + 1u == (tg + 1u) * nx) xb_add(&bar[XB_TOPGEN], 1u);
            else XB_SPIN(xb_ld(&bar[XB_TOPGEN]) == tg, bar);
            __builtin_amdgcn_fence(__ATOMIC_ACQUIRE, "agent");
            xb_add(&bar[XB_XGEN(b.x)], 1u);
            asm volatile("s_waitcnt vmcnt(0)" ::: "memory");
        } else {
            XB_SPIN(xb_ld(&bar[XB_XGEN(b.x)]) == gen, bar);
            __builtin_amdgcn_fence(__ATOMIC_ACQUIRE, "agent");
            asm volatile("s_waitcnt vmcnt(0)" ::: "memory");
        }
    }
    __syncthreads();
}

struct Ctx {
    const float* in[22]; float* out; unsigned char* ws;
    unsigned char* lds; int tid, lane, wave, G, vb;
};
#define WSP(T_, off) ((T_*)(c.ws + (off)))
__device__ __forceinline__ Ctx reopaque(const Ctx& c0) {
    Ctx c = c0; int t = c0.tid; asm volatile("" : "+v"(t)); c.tid = t; c.lane = t & 63; c.wave = __builtin_amdgcn_readfirstlane(t >> 6);
    int vb = c0.vb; asm volatile("" : "+s"(vb)); c.vb = vb; return c;
}

__device__ __forceinline__ int lds_off(int row, int chunk) { return row * 128 + ((chunk ^ (row & 7)) << 4); }

__device__ __forceinline__ void gemm_compute_stage(f32x4 (&acc)[2][8], const unsigned char* sA, const unsigned char* sB, int wave, int lane) {
    const int r = lane & 15, q = lane >> 4;
#pragma unroll
    for (int ks = 0; ks < 2; ++ks) {
        bf16x8 af[2], bfr[8];
#pragma unroll
        for (int mi = 0; mi < 2; ++mi) af[mi] = *(const bf16x8*)(sA + lds_off(32 * wave + 16 * mi + r, 4 * ks + q));
#pragma unroll
        for (int ni = 0; ni < 8; ++ni) bfr[ni] = *(const bf16x8*)(sB + lds_off(16 * ni + r, 4 * ks + q));
#pragma unroll
        for (int mi = 0; mi < 2; ++mi)
#pragma unroll
            for (int ni = 0; ni < 8; ++ni) acc[mi][ni] = __builtin_amdgcn_mfma_f32_16x16x32_bf16(bfr[ni], af[mi], acc[mi][ni], 0, 0, 0);
    }
}

__device__ __forceinline__ void gemm_core(f32x4 (&acc)[2][8], const bf16* A, int lda, const bf16* Bt, int ldb, int K, unsigned char* lds, int tid) {
    const int wave = __builtin_amdgcn_readfirstlane(tid >> 6), lane = tid & 63;
    const int chunk = tid & 7, row0 = tid >> 3;
    const int nk = K >> 6;
    u32x4 ra[4], rb[4];
    const bf16* pa = A + (size_t)row0 * lda + chunk * 8;
    const bf16* pb = Bt + (size_t)row0 * ldb + chunk * 8;
#pragma unroll
    for (int i = 0; i < 4; ++i) { ra[i] = *(const u32x4*)(pa + (size_t)(32 * i) * lda); rb[i] = *(const u32x4*)(pb + (size_t)(32 * i) * ldb); }
#pragma unroll
    for (int i = 0; i < 4; ++i) { *(u32x4*)(lds + lds_off(row0 + 32 * i, chunk)) = ra[i]; *(u32x4*)(lds + 16384 + lds_off(row0 + 32 * i, chunk)) = rb[i]; }
    __syncthreads();
    for (int kt = 0; kt < nk; ++kt) {
        const int cur = kt & 1;
        if (kt + 1 < nk) {
#pragma unroll
            for (int i = 0; i < 4; ++i) { ra[i] = *(const u32x4*)(pa + (size_t)(32 * i) * lda + (kt + 1) * 64); rb[i] = *(const u32x4*)(pb + (size_t)(32 * i) * ldb + (kt + 1) * 64); }
        }
        gemm_compute_stage(acc, lds + cur * 32768, lds + cur * 32768 + 16384, wave, lane);
        if (kt + 1 < nk) {
            unsigned char* st = lds + (cur ^ 1) * 32768;
#pragma unroll
            for (int i = 0; i < 4; ++i) { *(u32x4*)(st + lds_off(row0 + 32 * i, chunk)) = ra[i]; *(u32x4*)(st + 16384 + lds_off(row0 + 32 * i, chunk)) = rb[i]; }
        }
        __syncthreads();
    }
}
__device__ __forceinline__ void acc_zero(f32x4 (&acc)[2][8]) {
#pragma unroll
    for (int mi = 0; mi < 2; ++mi)
#pragma unroll
        for (int ni = 0; ni < 8; ++ni) acc[mi][ni] = (f32x4){0.f, 0.f, 0.f, 0.f};
}
__device__ __forceinline__ float rstd_from_ssq8(const float* ssq, int tok) {
    const f32x4 a = *(const f32x4*)(ssq + (size_t)tok * 8), b = *(const f32x4*)(ssq + (size_t)tok * 8 + 4);
    const float s = ((a.x + a.y) + (a.z + a.w)) + ((b.x + b.y) + (b.z + b.w));
    return rsqrt_(s * (1.0f / 1024.0f) + EPS);
}

__device__ __forceinline__ int src_col(int mode, int np) {
    if (mode == 0) return np;
    if (mode == 2) { const int h = np >> 7, j = np & 127; return j < 96 ? h * 96 + j : -1; }
    if (np < 1024) { const int cblk = np >> 7, j = np & 127; return j < 64 ? 64 * cblk + j : 512 + 64 * cblk + (j - 64); }
    if (np < 1408) return np;
    if (np < 1536) { const int j = np - 1408; return j < 32 ? 1408 + j : -1; }
    return 1440 + (np - 1536);
}
__device__ __forceinline__ void p0_transpose_item(const float* W, int K, int N, bf16* Wt, int mode, const float* g, int item, float* scr, int lane) {
    const int nblk_k = K / 64, nb = item / nblk_k, kb = item % nblk_k, k0 = 64 * kb, n0 = 32 * nb;
    const int n = src_col(mode, n0 + (lane & 31));
#pragma unroll 8
    for (int i = 0; i < 32; ++i) { const int kk = 2 * i + (lane >> 5); float v = 0.f; if (n >= 0) { v = W[(size_t)(k0 + kk) * N + n]; if (g) v *= g[k0 + kk]; } scr[kk * 33 + (lane & 31)] = v; }
    __builtin_amdgcn_s_waitcnt(0xC07F); asm volatile("" ::: "memory");
    const int cch = lane & 7;
#pragma unroll
    for (int j = 0; j < 4; ++j) { const int nl = (lane >> 3) + 8 * j; const float* s = scr + (8 * cch) * 33 + nl;
        u32x4 o; o.x = pk2(s[0 * 33], s[1 * 33]); o.y = pk2(s[2 * 33], s[3 * 33]); o.z = pk2(s[4 * 33], s[5 * 33]); o.w = pk2(s[6 * 33], s[7 * 33]);
        *(u32x4*)(Wt + (size_t)(n0 + nl) * K + k0 + 8 * cch) = o; }
    __builtin_amdgcn_s_waitcnt(0xC07F); asm volatile("" ::: "memory");
}
struct WDesc { int in_idx, K, N, Np, mode, g_idx; size_t off; };
__device__ __forceinline__ void phase_prologue(const Ctx& c0) {
    Ctx c = reopaque(c0);
    const int gw = c.vb * 4 + c.wave, NGW = c.G * 4;
    float* scr = (float*)(c.lds + c.wave * 8704);
    const WDesc wd[7] = {
        {3, 1024, NIN, NINP, 1, 2, 0}, {8, 512, 1024, 1024, 0, -1, OFF_WCO}, {10, 256, 768, 1024, 2, 9, OFF_WUQ}, {12, 128, 1024, 1024, 0, 11, OFF_WUKV},
        {15, 512, 1024, 1024, 0, -1, OFF_WMLA}, {16, 1024, 1024, 1024, 0, -1, OFF_WOUT}, {18, 1024, 2048, 2048, 0, 17, OFF_WPQ}};
    for (int l = 0; l < 2; ++l)
#pragma unroll
        for (int m = 0; m < 7; ++m) {
            const int K = wd[m].K, N = wd[m].N, Np = wd[m].Np;
            const float* W = c.in[wd[m].in_idx] + (size_t)l * K * N;
            const float* g = wd[m].g_idx >= 0 ? c.in[wd[m].g_idx] + (size_t)l * K : nullptr;
            bf16* Wt = (bf16*)(c.ws + WS_WIN + l * SZ_WLAYER + wd[m].off);
            const int items = (K / 64) * (Np / 32);
            for (int it = gw; it < items; it += NGW) p0_transpose_item(W, K, N, Wt, wd[m].mode, g, it, scr, c.lane);
        }
    const int gt = c.vb * NTHREADS + c.tid, NGT = c.G * NTHREADS;
    for (int l = 0; l < 2; ++l) {
        const float* src = c.in[19] + (size_t)l * 262144; bf16* dst = (bf16*)(c.ws + WS_WIN + l * SZ_WLAYER + OFF_KEYS);
        for (int i = gt; i < 262144 / 8; i += NGT) { const f32x4 a = *(const f32x4*)(src + i * 8), b = *(const f32x4*)(src + i * 8 + 4);
            u32x4 o; o.x = pk2(a.x, a.y); o.y = pk2(a.z, a.w); o.z = pk2(b.x, b.y); o.w = pk2(b.z, b.w); *(u32x4*)(dst + i * 8) = o; }
    }
    for (int l = 0; l < 2; ++l)
        for (int uv = 0; uv < 2; ++uv) {
            const float* src = c.in[20 + uv] + (size_t)l * NEXP * 1024; bf16* dst = (bf16*)(c.ws + WS_TAB + (size_t)(l * 2 + uv) * SZ_TAB);
            const float* g = c.in[17] + l * 1024;
            for (int i = gt; i < NEXP * 1024 / 8; i += NGT) {
                f32x4 a = *(const f32x4*)(src + (size_t)i * 8), b = *(const f32x4*)(src + (size_t)i * 8 + 4);
                if (uv == 0) { const int col = (i & 127) * 8; const f32x4 ga = *(const f32x4*)(g + col), gb = *(const f32x4*)(g + col + 4); a = a * ga; b = b * gb; }
                u32x4 o; o.x = pk2(a.x, a.y); o.y = pk2(a.z, a.w); o.z = pk2(b.x, b.y); o.w = pk2(b.z, b.w); *(u32x4*)(dst + (size_t)i * 8) = o; }
        }
    { float* rope = WSP(float, WS_ROPE);
      for (int i = gt; i < L * 16; i += NGT) { const int pos = i >> 4, j = i & 15;
          const float inv = 1.0f / __builtin_exp2f((float)j * 0.8304820237218406f);
          const float angf = (float)pos * inv; const double ang = (double)angf;
          const double nq = __builtin_rint(ang * 0.63661977236758134308);
          double rr = __builtin_fma(-nq, 1.57079632679489655800e+00, ang); rr = __builtin_fma(-nq, 6.12323399573676603587e-17, rr);
          const double r2 = rr * rr;
          double sp = -1.0 / 1307674368000.0; sp = sp * r2 + 1.0 / 6227020800.0; sp = sp * r2 - 1.0 / 39916800.0; sp = sp * r2 + 1.0 / 362880.0; sp = sp * r2 - 1.0 / 5040.0; sp = sp * r2 + 1.0 / 120.0; sp = sp * r2 - 1.0 / 6.0; sp = sp * r2 * rr + rr;
          double cp = 1.0 / 87178291200.0; cp = cp * r2 - 1.0 / 479001600.0; cp = cp * r2 + 1.0 / 3628800.0; cp = cp * r2 - 1.0 / 40320.0; cp = cp * r2 + 1.0 / 720.0; cp = cp * r2 - 1.0 / 24.0; cp = cp * r2 + 0.5; cp = 1.0 - cp * r2;
          const int qd = ((int)nq) & 3;
          const double cv = qd == 0 ? cp : qd == 1 ? -sp : qd == 2 ? -cp : sp;
          const double sv_ = qd == 0 ? sp : qd == 1 ? cp : qd == 2 ? -sp : -cp;
          rope[2 * i] = (float)cv; rope[2 * i + 1] = (float)sv_; } }
    { float* h = WSP(float, WS_H); bf16* hb = WSP(bf16, WS_HB); float* ssq = WSP(float, WS_SSQ);
      for (int t = gw; t < T; t += NGW) { const int b = t / L, pos = t % L;
          const float* src = pos < NMETA ? c.in[1] + (size_t)pos * D : c.in[0] + ((size_t)b * SEQ + (pos - NMETA)) * D;
          float s = 0.f;
#pragma unroll
          for (int j = 0; j < 4; ++j) { const f32x4 v = *(const f32x4*)(src + j * 256 + c.lane * 4); *(f32x4*)(h + (size_t)t * D + j * 256 + c.lane * 4) = v;
              u32x2 o; o.x = pk2(v.x, v.y); o.y = pk2(v.z, v.w); *(u32x2*)(hb + (size_t)t * D + j * 256 + c.lane * 4) = o; s += (v.x * v.x + v.y * v.y) + (v.z * v.z + v.w * v.w); }
          s = wave_sum(s);
          if (c.lane < 8) ssq[(size_t)t * 8 + c.lane] = c.lane == 0 ? s : 0.f; } }
}

__device__ __forceinline__ void phase_A(const Ctx& c0, int l) {
    Ctx c = reopaque(c0);
    const bf16* hb = WSP(bf16, WS_HB); const bf16* Wt = (const bf16*)(c.ws + WS_WIN + l * SZ_WLAYER);
    const float* ssq = WSP(float, WS_SSQ);
    bf16* uglu = WSP(bf16, WS_UGLU); bf16* cq = WSP(bf16, WS_CQ); bf16* ckv = WSP(bf16, WS_CKV); float* krope = WSP(float, WS_KROPE);
    float* ssqq = WSP(float, WS_SSQQ); float* ssqkv = WSP(float, WS_SSQKV); bf16* gates = WSP(bf16, WS_GATES);
    constexpr int NT = NINP / 128;
    const int r = c.lane & 15, q = c.lane >> 4;
    for (int it = c.vb; it < MT * NT; it += c.G) {
        const int mt = it / NT, nt = it % NT;
        f32x4 acc[2][8]; acc_zero(acc);
        gemm_core(acc, hb + (size_t)mt * 128 * D, D, Wt + (size_t)nt * 128 * D, D, D, c.lds, c.tid);
#pragma unroll
        for (int mi = 0; mi < 2; ++mi) {
            const int tok = mt * 128 + 32 * c.wave + 16 * mi + r;
            const float rs = rstd_from_ssq8(ssq, tok);
            if (nt < 8) {
#pragma unroll
                for (int ni = 0; ni < 4; ++ni) { const f32x4 v = acc[mi][ni] * rs, g = acc[mi][ni + 4] * rs;
                    u32x2 o; o.x = pk2(v.x * sigmoidf_(g.x), v.y * sigmoidf_(g.y)); o.y = pk2(v.z * sigmoidf_(g.z), v.w * sigmoidf_(g.w));
                    *(u32x2*)(uglu + (size_t)tok * DC + nt * 64 + 16 * ni + 4 * q) = o; }
            } else if (nt < 11) {
                bf16* dst = nt < 10 ? cq + (size_t)tok * QL + (nt - 8) * 128 : ckv + (size_t)tok * KVL;
                float ss = 0.f;
#pragma unroll
                for (int ni = 0; ni < 8; ++ni) { const f32x4 v = acc[mi][ni] * rs; ss += (v.x * v.x + v.y * v.y) + (v.z * v.z + v.w * v.w);
                    u32x2 o; o.x = pk2(v.x, v.y); o.y = pk2(v.z, v.w); *(u32x2*)(dst + 16 * ni + 4 * q) = o; }
                ss = quad_sum(ss);
                if (q == 0) { if (nt < 10) ssqq[(size_t)tok * 2 + (nt - 8)] = ss; else ssqkv[tok] = ss; }
            } else if (nt == 11) {
#pragma unroll
                for (int ni = 0; ni < 2; ++ni) *(f32x4*)(krope + (size_t)tok * 32 + 16 * ni + 4 * q) = acc[mi][ni] * rs;
            } else {
#pragma unroll
                for (int ni = 0; ni < 8; ++ni) { const f32x4 v = acc[mi][ni] * rs;
                    u32x2 o; o.x = pk2(sigmoidf_(v.x), sigmoidf_(v.y)); o.y = pk2(sigmoidf_(v.z), sigmoidf_(v.w));
                    *(u32x2*)(gates + (size_t)tok * 2048 + (nt - 12) * 128 + 16 * ni + 4 * q) = o; }
            }
        }
    }
}

__device__ __forceinline__ void phaseB_q_item(Ctx& c, int l, int mt, int head) {
    const bf16* cq = WSP(bf16, WS_CQ); const bf16* Wt = (const bf16*)(c.ws + WS_WIN + l * SZ_WLAYER + OFF_WUQ);
    const float* ssqq = WSP(float, WS_SSQQ); const float* rope = WSP(float, WS_ROPE); const float* qg = c.in[13] + l * QK; bf16* Qb = WSP(bf16, WS_Q);
    const int r = c.lane & 15, q = c.lane >> 4;
    f32x4 acc[2][8]; acc_zero(acc);
    gemm_core(acc, cq + (size_t)mt * 128 * QL, QL, Wt + (size_t)head * 128 * QL, QL, QL, c.lds, c.tid);
    constexpr float QSCALE = 0.10206207261596575f * 1.4426950408889634f;
#pragma unroll
    for (int mi = 0; mi < 2; ++mi) {
        const int tok = mt * 128 + 32 * c.wave + 16 * mi + r, b = tok / L, pos = tok - b * L;
        const float rs = rsqrt_((ssqq[(size_t)tok * 2] + ssqq[(size_t)tok * 2 + 1]) * (1.0f / 256.0f) + EPS);
        float ss = 0.f;
#pragma unroll
        for (int ni = 0; ni < 6; ++ni) { acc[mi][ni] = acc[mi][ni] * rs; const f32x4 v = acc[mi][ni]; ss += (v.x * v.x + v.y * v.y) + (v.z * v.z + v.w * v.w); }
        ss = quad_sum(ss);
        const float rn = rsqrt_(ss * (1.0f / 96.0f) + EPS) * QSCALE;
#pragma unroll
        for (int ni = 0; ni < 6; ++ni) { const f32x4 g = *(const f32x4*)(qg + 16 * ni + 4 * q); acc[mi][ni] = acc[mi][ni] * g * rn; }
        const f32x4 cs0 = *(const f32x4*)(rope + ((size_t)pos * 16 + 4 * q) * 2), cs1 = *(const f32x4*)(rope + ((size_t)pos * 16 + 4 * q) * 2 + 4);
        const float co[4] = {cs0.x, cs0.z, cs1.x, cs1.z}, si[4] = {cs0.y, cs0.w, cs1.y, cs1.w};
        f32x4 x1 = acc[mi][4], x2 = acc[mi][5];
#pragma unroll
        for (int e = 0; e < 4; ++e) { const float a = x1[e], bb = x2[e]; x1[e] = a * co[e] - bb * si[e]; x2[e] = bb * co[e] + a * si[e]; }
        acc[mi][4] = x1; acc[mi][5] = x2;
        bf16* dst = Qb + (((size_t)b * NH + head) * L + pos) * QK;
#pragma unroll
        for (int ni = 0; ni < 6; ++ni) { const f32x4 v = acc[mi][ni]; u32x2 o; o.x = pk2(v.x, v.y); o.y = pk2(v.z, v.w); *(u32x2*)(dst + 16 * ni + 4 * q) = o; }
    }
}
__device__ __forceinline__ void phaseB_kv_item(Ctx& c, int l, int mt, int head) {
    const bf16* ckv = WSP(bf16, WS_CKV); const bf16* Wt = (const bf16*)(c.ws + WS_WIN + l * SZ_WLAYER + OFF_WUKV);
    const float* ssqkv = WSP(float, WS_SSQKV); const float* rope = WSP(float, WS_ROPE); const float* kg = c.in[14] + l * QK; const float* krope = WSP(float, WS_KROPE);
    bf16* Kb = WSP(bf16, WS_K); bf16* Vt = WSP(bf16, WS_VT);
    const int tid = c.tid, wave = c.wave, lane = c.lane, r = lane & 15, q = lane >> 4;
    unsigned char* lds = c.lds;
    f32x4 ak[2][4], av[2][4];
#pragma unroll
    for (int mi = 0; mi < 2; ++mi)
#pragma unroll
        for (int ni = 0; ni < 4; ++ni) { ak[mi][ni] = (f32x4){0.f, 0.f, 0.f, 0.f}; av[mi][ni] = (f32x4){0.f, 0.f, 0.f, 0.f}; }
    { const int chunk = tid & 7, row0 = tid >> 3;
      const bf16* pa = ckv + ((size_t)mt * 128 + row0) * KVL + chunk * 8; const bf16* pb = Wt + ((size_t)head * 128 + row0) * KVL + chunk * 8;
#pragma unroll
      for (int s = 0; s < 2; ++s)
#pragma unroll
          for (int i = 0; i < 4; ++i) { *(u32x4*)(lds + s * 32768 + lds_off(row0 + 32 * i, chunk)) = *(const u32x4*)(pa + (size_t)(32 * i) * KVL + s * 64);
              *(u32x4*)(lds + s * 32768 + 16384 + lds_off(row0 + 32 * i, chunk)) = *(const u32x4*)(pb + (size_t)(32 * i) * KVL + s * 64); }
    }
    __syncthreads();
#pragma unroll
    for (int s = 0; s < 2; ++s)
#pragma unroll
        for (int ks = 0; ks < 2; ++ks) {
            const unsigned char* sA = lds + s * 32768; const unsigned char* sB = sA + 16384;
            bf16x8 af[2], bfr[8];
#pragma unroll
            for (int mi = 0; mi < 2; ++mi) af[mi] = *(const bf16x8*)(sA + lds_off(32 * wave + 16 * mi + r, 4 * ks + q));
#pragma unroll
            for (int ni = 0; ni < 8; ++ni) bfr[ni] = *(const bf16x8*)(sB + lds_off(16 * ni + r, 4 * ks + q));
#pragma unroll
            for (int mi = 0; mi < 2; ++mi)
#pragma unroll
                for (int ni = 0; ni < 4; ++ni) { ak[mi][ni] = __builtin_amdgcn_mfma_f32_16x16x32_bf16(bfr[ni], af[mi], ak[mi][ni], 0, 0, 0);
                    av[mi][ni] = __builtin_amdgcn_mfma_f32_16x16x32_bf16(af[mi], bfr[ni + 4], av[mi][ni], 0, 0, 0); }
        }
    __syncthreads();
#pragma unroll
    for (int mi = 0; mi < 2; ++mi) {
        const int tok0 = mt * 128 + 32 * wave + 16 * mi, b = tok0 / L, pos0 = tok0 - b * L;
        { const int tok = tok0 + r, pos = pos0 + r;
          const float rs = rsqrt_(ssqkv[tok] * (1.0f / 128.0f) + EPS);
          const f32x4 kr1 = *(const f32x4*)(krope + (size_t)tok * 32 + 4 * q), kr2 = *(const f32x4*)(krope + (size_t)tok * 32 + 16 + 4 * q);
          float ss = (kr1.x * kr1.x + kr1.y * kr1.y) + (kr1.z * kr1.z + kr1.w * kr1.w) + (kr2.x * kr2.x + kr2.y * kr2.y) + (kr2.z * kr2.z + kr2.w * kr2.w);
#pragma unroll
          for (int ni = 0; ni < 4; ++ni) { ak[mi][ni] = ak[mi][ni] * rs; const f32x4 v = ak[mi][ni]; ss += (v.x * v.x + v.y * v.y) + (v.z * v.z + v.w * v.w); }
          ss = quad_sum(ss);
          const float rn = rsqrt_(ss * (1.0f / 96.0f) + EPS);
          bf16* dst = Kb + (((size_t)b * NH + head) * L + pos) * QK;
#pragma unroll
          for (int ni = 0; ni < 4; ++ni) { const f32x4 g = *(const f32x4*)(kg + 16 * ni + 4 * q); const f32x4 v = ak[mi][ni] * g * rn;
              u32x2 o; o.x = pk2(v.x, v.y); o.y = pk2(v.z, v.w); *(u32x2*)(dst + 16 * ni + 4 * q) = o; }
          const f32x4 g1 = *(const f32x4*)(kg + 64 + 4 * q), g2 = *(const f32x4*)(kg + 80 + 4 * q);
          f32x4 x1 = kr1 * g1 * rn, x2 = kr2 * g2 * rn;
          const f32x4 cs0 = *(const f32x4*)(rope + ((size_t)pos * 16 + 4 * q) * 2), cs1 = *(const f32x4*)(rope + ((size_t)pos * 16 + 4 * q) * 2 + 4);
          const float co[4] = {cs0.x, cs0.z, cs1.x, cs1.z}, si[4] = {cs0.y, cs0.w, cs1.y, cs1.w};
#pragma unroll
          for (int e = 0; e < 4; ++e) { const float a = x1[e], bb = x2[e]; x1[e] = a * co[e] - bb * si[e]; x2[e] = bb * co[e] + a * si[e]; }
          u32x2 o1, o2; o1.x = pk2(x1.x, x1.y); o1.y = pk2(x1.z, x1.w); o2.x = pk2(x2.x, x2.y); o2.y = pk2(x2.z, x2.w);
          *(u32x2*)(dst + 64 + 4 * q) = o1; *(u32x2*)(dst + 80 + 4 * q) = o2; }
        { const f32x4 sq = *(const f32x4*)(ssqkv + tok0 + 4 * q);
          f32x4 rs4; rs4.x = rsqrt_(sq.x * (1.0f / 128.0f) + EPS); rs4.y = rsqrt_(sq.y * (1.0f / 128.0f) + EPS); rs4.z = rsqrt_(sq.z * (1.0f / 128.0f) + EPS); rs4.w = rsqrt_(sq.w * (1.0f / 128.0f) + EPS);
#pragma unroll
          for (int ni = 0; ni < 4; ++ni) { const f32x4 v = av[mi][ni] * rs4; u32x2 o; o.x = pk2(v.x, v.y); o.y = pk2(v.z, v.w);
              *(u32x2*)(Vt + (((size_t)b * NH + head) * VD + 16 * ni + r) * L + pos0 + 4 * q) = o; } }
    }
}
__device__ __forceinline__ u32x4 conv_row(const bf16* uglu, int b, int pos, int ch) {
    u32x4 xv = (u32x4){0u, 0u, 0u, 0u};
    if (pos >= 0) xv = *(const u32x4*)(uglu + ((size_t)b * L + pos) * DC + ch);
    return xv;
}
__device__ __forceinline__ void conv_fma(float (&a)[8], const u32x4 xv, const f32x4 w0, const f32x4 w1) {
    a[0] += bf_lo(xv.x) * w0.x; a[1] += bf_hi(xv.x) * w0.y; a[2] += bf_lo(xv.y) * w0.z; a[3] += bf_hi(xv.y) * w0.w;
    a[4] += bf_lo(xv.z) * w1.x; a[5] += bf_hi(xv.z) * w1.y; a[6] += bf_lo(xv.w) * w1.z; a[7] += bf_hi(xv.w) * w1.w;
}
__device__ __forceinline__ void phaseB_conv_item(Ctx& c, int l, int grp) {
    const bf16* uglu = WSP(bf16, WS_UGLU); bf16* u2 = WSP(bf16, WS_U2);
    const float* cw = c.in[4] + (size_t)l * CW * DC; const float* cb = c.in[5] + l * DC; const float* lg = c.in[6] + l * DC; const float* lb = c.in[7] + l * DC;
    const int tok0 = grp * 4, b = tok0 / L, pos0 = tok0 - b * L, ch = c.lane * 8;
    float acc[4][8];
    { const f32x4 b0 = *(const f32x4*)(cb + ch), b1 = *(const f32x4*)(cb + ch + 4);
#pragma unroll
      for (int d = 0; d < 4; ++d) { acc[d][0] = b0.x; acc[d][1] = b0.y; acc[d][2] = b0.z; acc[d][3] = b0.w; acc[d][4] = b1.x; acc[d][5] = b1.y; acc[d][6] = b1.z; acc[d][7] = b1.w; } }
    const int base = pos0 - 30;
    u32x4 x0 = conv_row(uglu, b, base + 0, ch), x1 = conv_row(uglu, b, base + 1, ch), x2 = conv_row(uglu, b, base + 2, ch),
          x3 = conv_row(uglu, b, base + 3, ch), x4 = conv_row(uglu, b, base + 4, ch), x5;
    const float* wp = cw + ch;
#pragma unroll 1
    for (int w = 0; w < CW; ++w) {
        x5 = conv_row(uglu, b, (w + 5 <= 33) ? base + w + 5 : -1, ch);
        const f32x4 w0 = *(const f32x4*)wp, w1 = *(const f32x4*)(wp + 4); wp += DC;
        conv_fma(acc[0], x0, w0, w1); conv_fma(acc[1], x1, w0, w1); conv_fma(acc[2], x2, w0, w1); conv_fma(acc[3], x3, w0, w1);
        x0 = x1; x1 = x2; x2 = x3; x3 = x4; x4 = x5;
    }
    const f32x4 g0 = *(const f32x4*)(lg + ch), g1 = *(const f32x4*)(lg + ch + 4), e0 = *(const f32x4*)(lb + ch), e1 = *(const f32x4*)(lb + ch + 4);
    const float gg[8] = {g0.x, g0.y, g0.z, g0.w, g1.x, g1.y, g1.z, g1.w}, be[8] = {e0.x, e0.y, e0.z, e0.w, e1.x, e1.y, e1.z, e1.w};
#pragma unroll
    for (int d = 0; d < 4; ++d) {
        float s = 0.f;
#pragma unroll
        for (int j = 0; j < 8; ++j) s += acc[d][j];
        const float mu = wave_sum(s) * (1.0f / 512.0f);
        float vq = 0.f;
#pragma unroll
        for (int j = 0; j < 8; ++j) { acc[d][j] -= mu; vq += acc[d][j] * acc[d][j]; }
        const float rstd = rsqrt_(wave_sum(vq) * (1.0f / 512.0f) + EPS);
        float y[8];
#pragma unroll
        for (int j = 0; j < 8; ++j) { const float v = acc[d][j] * rstd * gg[j] + be[j]; y[j] = v * sigmoidf_(v); }
        u32x4 o; o.x = pk2(y[0], y[1]); o.y = pk2(y[2], y[3]); o.z = pk2(y[4], y[5]); o.w = pk2(y[6], y[7]);
        *(u32x4*)(u2 + (size_t)(tok0 + d) * DC + ch) = o;
    }
}
__device__ __forceinline__ void phase_B(const Ctx& c0, int l) {
    Ctx c = reopaque(c0);
    constexpr int NQ = MT * NH, NKV = MT * NH, NCV = T / 16;
    for (int it = c.vb; it < NQ + NKV + NCV; it += c.G) {
        if (it < NQ) phaseB_q_item(c, l, it / NH, it % NH);
        else if (it < NQ + NKV) phaseB_kv_item(c, l, (it - NQ) / NH, (it - NQ) % NH);
        else phaseB_conv_item(c, l, (it - NQ - NKV) * 4 + c.wave);
    }
}

constexpr int KROW = 208, VROW = 136, ATT_STAGE = 64 * KROW + 64 * VROW;
__device__ __forceinline__ void phase_C(const Ctx& c0, int l) {
    Ctx c = reopaque(c0);
    const bf16* Qb = WSP(bf16, WS_Q); const bf16* Kb = WSP(bf16, WS_K); const bf16* Vt = WSP(bf16, WS_VT); bf16* O = WSP(bf16, WS_O);
    unsigned* qctr = WSP(unsigned, WS_CTL) + CW_QUEUE + 64 * l;
    volatile unsigned* misc = (volatile unsigned*)(c.lds + LDS_MISC);
    const int tid = c.tid, wave = c.wave, lane = c.lane, r = lane & 15, q = lane >> 4;
    unsigned char* lds = c.lds;
    for (;;) {
        if (tid == 0) misc[4] = atomicAdd(qctr, 1u);
        __syncthreads();
        const int item = (int)misc[4];
        __syncthreads();
        if (item >= NB * NH * 33) break;
        const int ch = 32 - item / 64, bh = item % 64, b = bh / NH, h = bh % NH;
        const int r0 = ch == 0 ? 0 : 16 + 64 * (ch - 1);
        const bool active = ch > 0 || wave == 0;
        const int ntiles = ch + 1;
        const bf16* Kbase = Kb + (size_t)bh * L * QK; const bf16* Vbase = Vt + (size_t)bh * VD * L;
        bf16x8 qf[3];
#pragma unroll
        for (int ks = 0; ks < 3; ++ks) qf[ks] = *(const bf16x8*)(Qb + ((size_t)bh * L + r0 + 16 * wave + r) * QK + 32 * ks + 8 * q);
        float m = -1e30f, lsum = 0.f;
        f32x4 o[4];
#pragma unroll
        for (int dt = 0; dt < 4; ++dt) o[dt] = (f32x4){0.f, 0.f, 0.f, 0.f};
        u32x4 rk[3], rv[2];
        auto gload = [&](int kt) {
#pragma unroll
            for (int i = 0; i < 3; ++i) { const int id = tid + 256 * i, row = id / 12, cc = id % 12; rk[i] = *(const u32x4*)(Kbase + (size_t)(kt * 64 + row) * QK + cc * 8); }
#pragma unroll
            for (int i = 0; i < 2; ++i) { const int id = tid + 256 * i, row = id >> 3, cc = id & 7; rv[i] = *(const u32x4*)(Vbase + (size_t)row * L + kt * 64 + cc * 8); }
        };
        auto lstore = [&](int s) {
            unsigned char* st = lds + s * ATT_STAGE;
#pragma unroll
            for (int i = 0; i < 3; ++i) { const int id = tid + 256 * i, row = id / 12, cc = id % 12; *(u32x4*)(st + row * KROW + cc * 16) = rk[i]; }
#pragma unroll
            for (int i = 0; i < 2; ++i) { const int id = tid + 256 * i, row = id >> 3, cc = id & 7; u32x2* d = (u32x2*)(st + 64 * KROW + row * VROW + cc * 16); d[0] = (u32x2){rv[i].x, rv[i].y}; d[1] = (u32x2){rv[i].z, rv[i].w}; }
        };
        gload(0); lstore(0);
        __syncthreads();
        for (int kt = 0; kt < ntiles; ++kt) {
            const int cur = kt & 1;
            if (kt + 1 < ntiles) gload(kt + 1);
            const unsigned char* sK = lds + cur * ATT_STAGE; const unsigned char* sV = sK + 64 * KROW;
            const bool full = kt < ch;
            f32x4 s[4];
#pragma unroll
            for (int k4 = 0; k4 < 4; ++k4) {
                s[k4] = (f32x4){0.f, 0.f, 0.f, 0.f};
                if (k4 == 0 || full) {
#pragma unroll
                    for (int ks = 0; ks < 3; ++ks) { const bf16x8 kf = *(const bf16x8*)(sK + (16 * k4 + r) * KROW + 64 * ks + 16 * q);
                        s[k4] = __builtin_amdgcn_mfma_f32_16x16x32_bf16(kf, qf[ks], s[k4], 0, 0, 0); }
                }
            }
            float mx = fmaxf(fmaxf(s[0].x, s[0].y), fmaxf(s[0].z, s[0].w));
            if (full) {
#pragma unroll
                for (int k4 = 1; k4 < 4; ++k4) mx = fmaxf(mx, fmaxf(fmaxf(s[k4].x, s[k4].y), fmaxf(s[k4].z, s[k4].w)));
            }
            mx = quad_max(mx);
            const float mn = fmaxf(m, mx), alpha = fast_exp2(m - mn); m = mn;
            float ps = 0.f;
#pragma unroll
            for (int k4 = 0; k4 < 4; ++k4) {
                if (k4 == 0 || full) { f32x4 p; p.x = fast_exp2(s[k4].x - mn); p.y = fast_exp2(s[k4].y - mn); p.z = fast_exp2(s[k4].z - mn); p.w = fast_exp2(s[k4].w - mn);
                    ps += (p.x + p.y) + (p.z + p.w); s[k4] = p; }
            }
            lsum = lsum * alpha + ps;
#pragma unroll
            for (int dt = 0; dt < 4; ++dt) o[dt] = o[dt] * alpha;
#pragma unroll
            for (int st = 0; st < 2; ++st) {
                if (st == 0 || full) {
                    u32x4 pw; pw.x = pk2(s[2 * st].x, s[2 * st].y); pw.y = pk2(s[2 * st].z, s[2 * st].w); pw.z = pk2(s[2 * st + 1].x, s[2 * st + 1].y); pw.w = pk2(s[2 * st + 1].z, s[2 * st + 1].w);
                    if (!full) { pw.z = 0u; pw.w = 0u; }
                    const bf16x8 pf = __builtin_bit_cast(bf16x8, pw);
#pragma unroll
                    for (int dt = 0; dt < 4; ++dt) {
                        const unsigned char* vp = sV + (16 * dt + r) * VROW + (32 * st + 4 * q) * 2;
                        const u32x2 v0 = *(const u32x2*)vp; u32x2 v1 = (u32x2){0u, 0u};
                        if (full) v1 = *(const u32x2*)(vp + 32);
                        const u32x4 vw = (u32x4){v0.x, v0.y, v1.x, v1.y};
                        o[dt] = __builtin_amdgcn_mfma_f32_16x16x32_bf16(__builtin_bit_cast(bf16x8, vw), pf, o[dt], 0, 0, 0);
                    }
                }
            }
            if (kt + 1 < ntiles) lstore(cur ^ 1);
            __syncthreads();
        }
        lsum = quad_sum(lsum);
        if (active) {
            const float inv = 1.0f / lsum;
            bf16* dst = O + ((size_t)b * L + r0 + 16 * wave + r) * 512 + h * VD;
#pragma unroll
            for (int dt = 0; dt < 4; ++dt) { const f32x4 v = o[dt] * inv; u32x2 ov; ov.x = pk2(v.x, v.y); ov.y = pk2(v.z, v.w); *(u32x2*)(dst + 16 * dt + 4 * q) = ov; }
        }
    }
}

__device__ __forceinline__ void phase_D(const Ctx& c0, int l) {
    Ctx c = reopaque(c0);
    const bf16* u2 = WSP(bf16, WS_U2); const bf16* O = WSP(bf16, WS_O); const bf16* gates = WSP(bf16, WS_GATES); bf16* merged = WSP(bf16, WS_MERGED);
    const bf16* Wco = (const bf16*)(c.ws + WS_WIN + l * SZ_WLAYER + OFF_WCO); const bf16* Wmla = (const bf16*)(c.ws + WS_WIN + l * SZ_WLAYER + OFF_WMLA);
    const int r = c.lane & 15, q = c.lane >> 4;
    for (int it = c.vb; it < MT * 8; it += c.G) {
        const int mt = it / 8, nt = it % 8;
        f32x4 acc[2][8]; acc_zero(acc);
        gemm_core(acc, u2 + (size_t)mt * 128 * 512, 512, Wco + (size_t)nt * 128 * 512, 512, 512, c.lds, c.tid);
#pragma unroll
        for (int mi = 0; mi < 2; ++mi) { const int tok = mt * 128 + 32 * c.wave + 16 * mi + r;
            const bf16* gp = gates + (size_t)tok * 2048 + nt * 128 + 4 * q; bf16* mp = merged + (size_t)tok * D + nt * 128 + 4 * q;
#pragma unroll
            for (int ni = 0; ni < 8; ++ni) { const u32x2 g = *(const u32x2*)(gp + 16 * ni); const f32x4 v = acc[mi][ni];
                u32x2 o; o.x = pk2(v.x * bf_lo(g.x), v.y * bf_hi(g.x)); o.y = pk2(v.z * bf_lo(g.y), v.w * bf_hi(g.y)); *(u32x2*)(mp + 16 * ni) = o; } }
        acc_zero(acc);
        gemm_core(acc, O + (size_t)mt * 128 * 512, 512, Wmla + (size_t)nt * 128 * 512, 512, 512, c.lds, c.tid);
#pragma unroll
        for (int mi = 0; mi < 2; ++mi) { const int tok = mt * 128 + 32 * c.wave + 16 * mi + r;
            const bf16* gp = gates + (size_t)tok * 2048 + 1024 + nt * 128 + 4 * q; bf16* mp = merged + (size_t)tok * D + nt * 128 + 4 * q;
#pragma unroll
            for (int ni = 0; ni < 8; ++ni) { const u32x2 g = *(const u32x2*)(gp + 16 * ni); const u32x2 s = *(const u32x2*)(mp + 16 * ni); const f32x4 v = acc[mi][ni];
                u32x2 o; o.x = pk2(bf_lo(s.x) + v.x * bf_lo(g.x), bf_hi(s.x) + v.y * bf_hi(g.x)); o.y = pk2(bf_lo(s.y) + v.z * bf_lo(g.y), bf_hi(s.y) + v.w * bf_hi(g.y));
                *(u32x2*)(mp + 16 * ni) = o; } }
    }
}

__device__ __forceinline__ void phase_E(const Ctx& c0, int l) {
    Ctx c = reopaque(c0);
    const bf16* merged = WSP(bf16, WS_MERGED); const bf16* Wout = (const bf16*)(c.ws + WS_WIN + l * SZ_WLAYER + OFF_WOUT);
    float* h = WSP(float, WS_H); bf16* hb = WSP(bf16, WS_HB); float* ssq = WSP(float, WS_SSQ);
    const int r = c.lane & 15, q = c.lane >> 4;
    for (int it = c.vb; it < MT * 8; it += c.G) {
        const int mt = it / 8, nt = it % 8;
        f32x4 acc[2][8]; acc_zero(acc);
        gemm_core(acc, merged + (size_t)mt * 128 * D, D, Wout + (size_t)nt * 128 * D, D, D, c.lds, c.tid);
#pragma unroll
        for (int mi = 0; mi < 2; ++mi) { const int tok = mt * 128 + 32 * c.wave + 16 * mi + r; float ss = 0.f;
#pragma unroll
            for (int ni = 0; ni < 8; ++ni) { float* hp = h + (size_t)tok * D + nt * 128 + 16 * ni + 4 * q; const f32x4 v = *(const f32x4*)hp + acc[mi][ni]; *(f32x4*)hp = v;
                ss += (v.x * v.x + v.y * v.y) + (v.z * v.z + v.w * v.w);
                u32x2 o; o.x = pk2(v.x, v.y); o.y = pk2(v.z, v.w); *(u32x2*)(hb + (size_t)tok * D + nt * 128 + 16 * ni + 4 * q) = o; }
            ss = quad_sum(ss);
            if (q == 0) ssq[(size_t)tok * 8 + nt] = ss; }
    }
}

__device__ __forceinline__ unsigned f2key(float f) { const unsigned u = __float_as_uint(f); return u ^ ((u >> 31) ? 0xFFFFFFFFu : 0x80000000u); }
__device__ __forceinline__ float key2f(unsigned k) { const unsigned u = (k >> 31) ? (k ^ 0x80000000u) : ~k; return __uint_as_float(u); }
__device__ __forceinline__ void top16_insert(unsigned (&lst)[16], unsigned x) {
#pragma unroll
    for (int i = 0; i < 16; ++i) { const unsigned a = lst[i]; lst[i] = a > x ? a : x; x = a > x ? x : a; }
}
__device__ __forceinline__ void phase_F(const Ctx& c0, int l) {
    Ctx c = reopaque(c0);
    const bf16* hb = WSP(bf16, WS_HB); const bf16* Wpq = (const bf16*)(c.ws + WS_WIN + l * SZ_WLAYER + OFF_WPQ); const bf16* keys = (const bf16*)(c.ws + WS_WIN + l * SZ_WLAYER + OFF_KEYS);
    const float* ssq = WSP(float, WS_SSQ); float* sv = WSP(float, WS_SV); unsigned char* si = WSP(unsigned char, WS_SI);
    const int tid = c.tid, wave = c.wave, lane = c.lane, r = lane & 15, q = lane >> 4;
    unsigned char* lds = c.lds;
    for (int it = c.vb; it < MT * 16; it += c.G) {
        const int mt = it / 16, hp = it % 16;
        f32x4 acc[2][8]; acc_zero(acc);
        gemm_core(acc, hb + (size_t)mt * 128 * D, D, Wpq + (size_t)hp * 128 * D, D, D, lds, tid);
#pragma unroll
        for (int mi = 0; mi < 2; ++mi) { const int row = 32 * wave + 16 * mi + r; const float rs = rstd_from_ssq8(ssq, mt * 128 + row);
#pragma unroll
            for (int ni = 0; ni < 8; ++ni) { const f32x4 v = acc[mi][ni] * rs; u32x2 o; o.x = pk2(v.x, v.y); o.y = pk2(v.z, v.w);
                *(u32x2*)(lds + (ni >> 2) * 32768 + lds_off(row, 2 * (ni & 3) + (q >> 1)) + 8 * (q & 1)) = o; } }
        { const int chunk = tid & 7, row0 = tid >> 3; const bf16* pb = keys + ((size_t)hp * 128 + row0) * 128 + chunk * 8;
#pragma unroll
          for (int s = 0; s < 2; ++s)
#pragma unroll
              for (int i = 0; i < 4; ++i) *(u32x4*)(lds + s * 32768 + 16384 + lds_off(row0 + 32 * i, chunk)) = *(const u32x4*)(pb + (size_t)(32 * i) * 128 + s * 64); }
        __syncthreads();
        acc_zero(acc);
        gemm_compute_stage(acc, lds, lds + 16384, wave, lane);
        gemm_compute_stage(acc, lds + 32768, lds + 32768 + 16384, wave, lane);
        __syncthreads();
        float* S = (float*)lds;
#pragma unroll
        for (int mi = 0; mi < 2; ++mi) { const int row = 32 * wave + 16 * mi + r;
#pragma unroll
            for (int ni = 0; ni < 8; ++ni) *(f32x4*)(S + row * 132 + 16 * ni + 4 * q) = acc[mi][ni]; }
        __syncthreads();
        if (tid < 128) {
            unsigned lst[16];
#pragma unroll
            for (int i = 0; i < 16; ++i) lst[i] = 0u;
            const float* row = S + tid * 132;
#pragma unroll 4
            for (int j = 0; j < 32; ++j) { const f32x4 v = *(const f32x4*)(row + 4 * j);
                top16_insert(lst, (f2key(v.x) & ~127u) | (unsigned)(127 - (4 * j)));
                top16_insert(lst, (f2key(v.y) & ~127u) | (unsigned)(127 - (4 * j + 1)));
                top16_insert(lst, (f2key(v.z) & ~127u) | (unsigned)(127 - (4 * j + 2)));
                top16_insert(lst, (f2key(v.w) & ~127u) | (unsigned)(127 - (4 * j + 3))); }
            const int tok = mt * 128 + tid;
            unsigned idx[16]; float val[16];
#pragma unroll
            for (int i = 0; i < 16; ++i) { idx[i] = 127u - (lst[i] & 127u); val[i] = row[idx[i]]; }
            float* svp = sv + ((size_t)tok * 16 + hp) * 16;
#pragma unroll
            for (int i = 0; i < 4; ++i) *(f32x4*)(svp + 4 * i) = (f32x4){val[4 * i], val[4 * i + 1], val[4 * i + 2], val[4 * i + 3]};
            u32x4 pi;
            pi.x = idx[0] | (idx[1] << 8) | (idx[2] << 16) | (idx[3] << 24); pi.y = idx[4] | (idx[5] << 8) | (idx[6] << 16) | (idx[7] << 24);
            pi.z = idx[8] | (idx[9] << 8) | (idx[10] << 16) | (idx[11] << 24); pi.w = idx[12] | (idx[13] << 8) | (idx[14] << 16) | (idx[15] << 24);
            *(u32x4*)(si + ((size_t)tok * 16 + hp) * 16) = pi;
        }
        __syncthreads();
    }
}

__device__ __forceinline__ void phase_F3(const Ctx& c0, int l) {
    Ctx c = reopaque(c0);
    const float* sv = WSP(float, WS_SV); const unsigned char* si = WSP(unsigned char, WS_SI); int* eidx = WSP(int, WS_EIDX); float* gw = WSP(float, WS_GW); unsigned char* stb = WSP(unsigned char, WS_STB);
    float* lsv = (float*)c.lds;
    unsigned char* lsi = c.lds + 256 * 33 * 4;
    const int tid = c.tid;
    for (int base = c.vb * NTHREADS; base < T * 8; base += c.G * NTHREADS) {
        const int th = base + tid;
        float a[16], b[16];
#pragma unroll
        for (int i = 0; i < 4; ++i) { const f32x4 x = *(const f32x4*)(sv + (size_t)th * 32 + 4 * i), y = *(const f32x4*)(sv + (size_t)th * 32 + 16 + 4 * i);
            a[4 * i] = x.x; a[4 * i + 1] = x.y; a[4 * i + 2] = x.z; a[4 * i + 3] = x.w; b[4 * i] = y.x; b[4 * i + 1] = y.y; b[4 * i + 2] = y.z; b[4 * i + 3] = y.w; }
        const u32x4 ia = *(const u32x4*)(si + (size_t)th * 32), ib = *(const u32x4*)(si + (size_t)th * 32 + 16);
#pragma unroll
        for (int i = 0; i < 16; ++i) { lsv[tid * 33 + i] = a[i]; lsv[tid * 33 + 16 + i] = b[i]; }
        *(u32x4*)(lsi + tid * 32) = ia; *(u32x4*)(lsi + tid * 32 + 16) = ib;
        unsigned lst[16];
#pragma unroll
        for (int i = 0; i < 16; ++i) lst[i] = 0u;
#pragma unroll
        for (int i = 0; i < 16; ++i)
#pragma unroll
            for (int j = 0; j < 16; ++j)
                if ((i + 1) * (j + 1) <= 16) top16_insert(lst, (f2key(a[i] + b[j]) & ~255u) | (unsigned)(255 - (i * 16 + j)));
        __builtin_amdgcn_s_waitcnt(0xC07F); asm volatile("" ::: "memory");
        float s[16]; int e[16];
#pragma unroll
        for (int k = 0; k < 16; ++k) { const unsigned code = 255u - (lst[k] & 255u); const int i = code >> 4, j = code & 15;
            s[k] = lsv[tid * 33 + i] + lsv[tid * 33 + 16 + j]; e[k] = (int)lsi[tid * 32 + i] * 128 + (int)lsi[tid * 32 + 16 + j]; }
        float mx = s[0];
#pragma unroll
        for (int k = 1; k < 16; ++k) mx = fmaxf(mx, s[k]);
        float sum = 0.f;
#pragma unroll
        for (int k = 0; k < 16; ++k) { s[k] = fast_exp2((s[k] - mx) * 1.4426950409f); sum += s[k]; }
        const float inv = 1.0f / sum;
        typedef unsigned long long u64;
        u64 hlo = 0ull, hhi = 0ull;
#pragma unroll
        for (int k = 0; k < 16; ++k) { const int sl = e[k] >> 10; if (sl < 8) hlo += 1ull << (8 * sl); else hhi += 1ull << (8 * (sl - 8)); }
        u64 ilo = hlo, ihi = hhi;
#pragma unroll
        for (int d = 1; d < 8; d <<= 1) { const u64 a_ = __shfl_up(ilo, d, 8), b_ = __shfl_up(ihi, d, 8); if ((tid & 7) >= d) { ilo += a_; ihi += b_; } }
        const u64 tlo = __shfl(ilo, 7, 8), thi = __shfl(ihi, 7, 8);
        const u64 ones = 0x0101010101010101ull;
        const u64 inlo = tlo * ones, inhi = thi * ones + (inlo >> 56) * ones;
        const u64 stlo = inlo - tlo, sthi = inhi - thi;
        u64 rlo = stlo + (ilo - hlo), rhi = sthi + (ihi - hhi);
        const int tokn = th >> 3;
#pragma unroll
        for (int k = 0; k < 16; ++k) { const int sl = e[k] >> 10; int pos;
            if (sl < 8) { pos = (int)((rlo >> (8 * sl)) & 255ull); rlo += 1ull << (8 * sl); } else { pos = (int)((rhi >> (8 * (sl - 8))) & 255ull); rhi += 1ull << (8 * (sl - 8)); }
            eidx[(size_t)tokn * 128 + pos] = e[k]; gw[(size_t)tokn * 128 + pos] = s[k] * inv; }
        if ((tid & 7) == 0) { u64* sp = (u64*)(stb + (size_t)tokn * 16); sp[0] = stlo; sp[1] = sthi; }
        __builtin_amdgcn_s_waitcnt(0xC07F); asm volatile("" ::: "memory");
    }
}

__device__ __forceinline__ void phase_G(const Ctx& c0, int l) {
    Ctx c = reopaque(c0);
    const bf16* hb = WSP(bf16, WS_HB); const float* ssq = WSP(float, WS_SSQ); const int* eidx = WSP(int, WS_EIDX); const float* gw = WSP(float, WS_GW);
    const bf16* U = (const bf16*)(c.ws + WS_TAB + (size_t)(l * 2) * SZ_TAB); const bf16* V = (const bf16*)(c.ws + WS_TAB + (size_t)(l * 2 + 1) * SZ_TAB);
    float* h = WSP(float, WS_H); bf16* hbw = WSP(bf16, WS_HB); float* ssqw = WSP(float, WS_SSQ);
    unsigned* qctr = WSP(unsigned, WS_CTL) + CW_QUEUE + 64 * (2 + l);
    volatile unsigned* misc = (volatile unsigned*)(c.lds + LDS_MISC);
    const int lane = c.lane;
    for (;;) {
        if (c.tid == 0) misc[4] = atomicAdd(qctr, 1u);
        __syncthreads();
        const int blk = (int)misc[4];
        __syncthreads();
        if (blk * 4 >= T) break;
        const int tok = blk * 4 + c.wave;
        const u32x4 x0 = *(const u32x4*)(hb + (size_t)tok * D + lane * 8), x1 = *(const u32x4*)(hb + (size_t)tok * D + 512 + lane * 8);
        const float rs = rstd_from_ssq8(ssq, tok);
        const int e0 = eidx[(size_t)tok * 128 + lane], e1 = eidx[(size_t)tok * 128 + 64 + lane];
        const float w0 = gw[(size_t)tok * 128 + lane], w1 = gw[(size_t)tok * 128 + 64 + lane];
        float acc[16];
#pragma unroll
        for (int j = 0; j < 16; ++j) acc[j] = 0.f;
        for (int cc = 0; cc < 16; ++cc) {
            const int esel = cc < 8 ? e0 : e1; const float wsel = cc < 8 ? w0 : w1;
            int ex[8]; float wx[8];
#pragma unroll
            for (int k = 0; k < 8; ++k) { ex[k] = __shfl(esel, (cc & 7) * 8 + k); wx[k] = __shfl(wsel, (cc & 7) * 8 + k); }
            u32x4 ua[8], ub[8], va[8], vb[8];
#pragma unroll
            for (int k = 0; k < 8; ++k) { const bf16* up = U + (size_t)ex[k] * D + lane * 8; ua[k] = *(const u32x4*)up; ub[k] = *(const u32x4*)(up + 512); }
#pragma unroll
            for (int k = 0; k < 8; ++k) { const bf16* vp = V + (size_t)ex[k] * D + lane * 8; va[k] = *(const u32x4*)vp; vb[k] = *(const u32x4*)(vp + 512); }
            float a[8];
#pragma unroll
            for (int k = 0; k < 8; ++k) { float d0 = dot2(ua[k].x, x0.x, 0.f), d1 = dot2(ua[k].y, x0.y, 0.f); d0 = dot2(ua[k].z, x0.z, d0); d1 = dot2(ua[k].w, x0.w, d1);
                d0 = dot2(ub[k].x, x1.x, d0); d1 = dot2(ub[k].y, x1.y, d1); d0 = dot2(ub[k].z, x1.z, d0); d1 = dot2(ub[k].w, x1.w, d1); a[k] = d0 + d1; }
#pragma unroll
            for (int k = 0; k < 8; ++k) { a[k] = wave_sum(a[k]); a[k] = gelu_tanh(a[k] * rs) * wx[k]; }
#pragma unroll
            for (int k = 0; k < 8; ++k) {
                acc[0] += a[k] * bf_lo(va[k].x); acc[1] += a[k] * bf_hi(va[k].x); acc[2] += a[k] * bf_lo(va[k].y); acc[3] += a[k] * bf_hi(va[k].y);
                acc[4] += a[k] * bf_lo(va[k].z); acc[5] += a[k] * bf_hi(va[k].z); acc[6] += a[k] * bf_lo(va[k].w); acc[7] += a[k] * bf_hi(va[k].w);
                acc[8] += a[k] * bf_lo(vb[k].x); acc[9] += a[k] * bf_hi(vb[k].x); acc[10] += a[k] * bf_lo(vb[k].y); acc[11] += a[k] * bf_hi(vb[k].y);
                acc[12] += a[k] * bf_lo(vb[k].z); acc[13] += a[k] * bf_hi(vb[k].z); acc[14] += a[k] * bf_lo(vb[k].w); acc[15] += a[k] * bf_hi(vb[k].w); }
        }
        float* hp = h + (size_t)tok * D + lane * 8;
        f32x4 r0 = *(const f32x4*)hp, r1 = *(const f32x4*)(hp + 4), r2 = *(const f32x4*)(hp + 512), r3 = *(const f32x4*)(hp + 516);
        r0 += (f32x4){acc[0], acc[1], acc[2], acc[3]}; r1 += (f32x4){acc[4], acc[5], acc[6], acc[7]}; r2 += (f32x4){acc[8], acc[9], acc[10], acc[11]}; r3 += (f32x4){acc[12], acc[13], acc[14], acc[15]};
        if (l == 0) {
            *(f32x4*)hp = r0; *(f32x4*)(hp + 4) = r1; *(f32x4*)(hp + 512) = r2; *(f32x4*)(hp + 516) = r3;
            u32x4 o0, o1; o0.x = pk2(r0.x, r0.y); o0.y = pk2(r0.z, r0.w); o0.z = pk2(r1.x, r1.y); o0.w = pk2(r1.z, r1.w);
            o1.x = pk2(r2.x, r2.y); o1.y = pk2(r2.z, r2.w); o1.z = pk2(r3.x, r3.y); o1.w = pk2(r3.z, r3.w);
            *(u32x4*)(hbw + (size_t)tok * D + lane * 8) = o0; *(u32x4*)(hbw + (size_t)tok * D + 512 + lane * 8) = o1;
            float ss = (r0.x * r0.x + r0.y * r0.y) + (r0.z * r0.z + r0.w * r0.w) + (r1.x * r1.x + r1.y * r1.y) + (r1.z * r1.z + r1.w * r1.w)
                     + (r2.x * r2.x + r2.y * r2.y) + (r2.z * r2.z + r2.w * r2.w) + (r3.x * r3.x + r3.y * r3.y) + (r3.z * r3.z + r3.w * r3.w);
            ss = wave_sum(ss);
            if (lane < 8) ssqw[(size_t)tok * 8 + lane] = lane == 0 ? ss : 0.f;
        } else {
            const int b = tok / L, pos = tok - b * L;
            if (pos >= NMETA) { float* op = c.out + ((size_t)b * SEQ + (pos - NMETA)) * D + lane * 8;
                *(f32x4*)op = r0; *(f32x4*)(op + 4) = r1; *(f32x4*)(op + 512) = r2; *(f32x4*)(op + 516) = r3; }
        }
    }
}

constexpr int G2_WSTRIDE = 14336, G2_MAXTOK = 9;
__device__ __forceinline__ void g2_u_group(const bf16* U, const int* pe_l, const float* pw_l, float* act_l, int b0, int b1, const u32x4 xa, const u32x4 xb, float rs, int lane) {
    for (int i = b0; i < b1; i += 4) {
        u32x4 ua[4], ub[4];
#pragma unroll
        for (int k = 0; k < 4; ++k) { const int idx = (i + k < b1) ? i + k : b1 - 1; const int e = __builtin_amdgcn_readfirstlane(pe_l[idx]);
            const bf16* up = U + (size_t)e * D + lane * 8; ua[k] = *(const u32x4*)up; ub[k] = *(const u32x4*)(up + 512); }
#pragma unroll
        for (int k = 0; k < 4; ++k) { float d0 = dot2(ua[k].x, xa.x, 0.f), d1 = dot2(ua[k].y, xa.y, 0.f); d0 = dot2(ua[k].z, xa.z, d0); d1 = dot2(ua[k].w, xa.w, d1);
            d0 = dot2(ub[k].x, xb.x, d0); d1 = dot2(ub[k].y, xb.y, d1); d0 = dot2(ub[k].z, xb.z, d0); d1 = dot2(ub[k].w, xb.w, d1);
            const float a = wave_sum_dpp(d0 + d1);
            if (i + k < b1 && lane == 0) act_l[i + k] = gelu_tanh(a * rs) * pw_l[i + k]; }
    }
}
__device__ __forceinline__ void g2_v_group(const bf16* V, const int* pe_l, const float* act_l, int b0, int b1, float (&acc)[16], int lane) {
    for (int i = b0; i < b1; i += 4) {
        u32x4 va[4], vb[4]; float a[4];
#pragma unroll
        for (int k = 0; k < 4; ++k) { const int idx = (i + k < b1) ? i + k : b1 - 1; const int e = __builtin_amdgcn_readfirstlane(pe_l[idx]);
            a[k] = (i + k < b1) ? act_l[idx] : 0.f;
            const bf16* vp = V + (size_t)e * D + lane * 8; va[k] = *(const u32x4*)vp; vb[k] = *(const u32x4*)(vp + 512); }
#pragma unroll
        for (int k = 0; k < 4; ++k) {
            acc[0] += a[k] * bf_lo(va[k].x); acc[1] += a[k] * bf_hi(va[k].x); acc[2] += a[k] * bf_lo(va[k].y); acc[3] += a[k] * bf_hi(va[k].y);
            acc[4] += a[k] * bf_lo(va[k].z); acc[5] += a[k] * bf_hi(va[k].z); acc[6] += a[k] * bf_lo(va[k].w); acc[7] += a[k] * bf_hi(va[k].w);
            acc[8] += a[k] * bf_lo(vb[k].x); acc[9] += a[k] * bf_hi(vb[k].x); acc[10] += a[k] * bf_lo(vb[k].y); acc[11] += a[k] * bf_hi(vb[k].y);
            acc[12] += a[k] * bf_lo(vb[k].z); acc[13] += a[k] * bf_hi(vb[k].z); acc[14] += a[k] * bf_lo(vb[k].w); acc[15] += a[k] * bf_hi(vb[k].w); }
    }
}
__device__ __forceinline__ void phase_G2(const Ctx& c0, int l) {
    Ctx c = reopaque(c0);
    const bf16* hb = WSP(bf16, WS_HB); const float* ssq = WSP(float, WS_SSQ); const int* pe = WSP(int, WS_EIDX); const float* pw = WSP(float, WS_GW); const unsigned char* stb = WSP(unsigned char, WS_STB);
    const bf16* U = (const bf16*)(c.ws + WS_TAB + (size_t)(l * 2) * SZ_TAB); const bf16* V = (const bf16*)(c.ws + WS_TAB + (size_t)(l * 2 + 1) * SZ_TAB);
    float* h = WSP(float, WS_H); bf16* hbw = WSP(bf16, WS_HB); float* ssqw = WSP(float, WS_SSQ);
    const int lane = c.lane;
    const int NW = c.G * 4, gw = c.vb * 4 + c.wave, base_t = T / NW, rem = T % NW;
    const int t0 = gw * base_t + (gw < rem ? gw : rem), nt = base_t + (gw < rem ? 1 : 0);
    unsigned char* wl = c.lds + c.wave * G2_WSTRIDE;
    int* pe_l = (int*)wl; float* pw_l = (float*)(wl + 4608); float* act_l = (float*)(wl + 9216); unsigned char* stb_l = wl + 13824;
    {
        u32x4 xa[G2_MAXTOK], xb[G2_MAXTOK]; float rs[G2_MAXTOK];
#pragma unroll
        for (int j = 0; j < G2_MAXTOK; ++j) { const int tok = t0 + (j < nt ? j : 0);
            pe_l[j * 128 + lane] = pe[(size_t)tok * 128 + lane]; pe_l[j * 128 + 64 + lane] = pe[(size_t)tok * 128 + 64 + lane];
            pw_l[j * 128 + lane] = pw[(size_t)tok * 128 + lane]; pw_l[j * 128 + 64 + lane] = pw[(size_t)tok * 128 + 64 + lane];
            if (lane < 4) ((unsigned*)(stb_l + j * 32))[lane] = ((const unsigned*)(stb + (size_t)tok * 16))[lane];
            if (lane == 4) ((unsigned*)(stb_l + j * 32))[4] = 128u;
            xa[j] = *(const u32x4*)(hb + (size_t)tok * D + lane * 8); xb[j] = *(const u32x4*)(hb + (size_t)tok * D + 512 + lane * 8); rs[j] = rstd_from_ssq8(ssq, tok); }
#pragma unroll 1
        for (int s = 0; s < 16; ++s) {
#pragma unroll
            for (int j = 0; j < G2_MAXTOK; ++j) if (j < nt) {
                const int b0 = __builtin_amdgcn_readfirstlane((int)stb_l[j * 32 + s]), b1 = __builtin_amdgcn_readfirstlane((int)stb_l[j * 32 + s + 1]);
                g2_u_group(U, pe_l + j * 128, pw_l + j * 128, act_l + j * 128, b0, b1, xa[j], xb[j], rs[j], lane); }
        }
    }
    float acc[G2_MAXTOK][16];
#pragma unroll
    for (int j = 0; j < G2_MAXTOK; ++j)
#pragma unroll
        for (int i = 0; i < 16; ++i) acc[j][i] = 0.f;
#pragma unroll 1
    for (int s = 0; s < 16; ++s) {
#pragma unroll
        for (int j = 0; j < G2_MAXTOK; ++j) if (j < nt) {
            const int b0 = __builtin_amdgcn_readfirstlane((int)stb_l[j * 32 + s]), b1 = __builtin_amdgcn_readfirstlane((int)stb_l[j * 32 + s + 1]);
            g2_v_group(V, pe_l + j * 128, act_l + j * 128, b0, b1, acc[j], lane); }
    }
#pragma unroll
    for (int j = 0; j < G2_MAXTOK; ++j) if (j < nt) {
        const int tok = t0 + j;
        float* hp = h + (size_t)tok * D + lane * 8;
        f32x4 r0 = *(const f32x4*)hp, r1 = *(const f32x4*)(hp + 4), r2 = *(const f32x4*)(hp + 512), r3 = *(const f32x4*)(hp + 516);
        r0 += (f32x4){acc[j][0], acc[j][1], acc[j][2], acc[j][3]}; r1 += (f32x4){acc[j][4], acc[j][5], acc[j][6], acc[j][7]};
        r2 += (f32x4){acc[j][8], acc[j][9], acc[j][10], acc[j][11]}; r3 += (f32x4){acc[j][12], acc[j][13], acc[j][14], acc[j][15]};
        if (l == 0) {
            *(f32x4*)hp = r0; *(f32x4*)(hp + 4) = r1; *(f32x4*)(hp + 512) = r2; *(f32x4*)(hp + 516) = r3;
            u32x4 o0, o1; o0.x = pk2(r0.x, r0.y); o0.y = pk2(r0.z, r0.w); o0.z = pk2(r1.x, r1.y); o0.w = pk2(r1.z, r1.w);
            o1.x = pk2(r2.x, r2.y); o1.y = pk2(r2.z, r2.w); o1.z = pk2(r3.x, r3.y); o1.w = pk2(r3.z, r3.w);
            *(u32x4*)(hbw + (size_t)tok * D + lane * 8) = o0; *(u32x4*)(hbw + (size_t)tok * D + 512 + lane * 8) = o1;
            float ss = (r0.x * r0.x + r0.y * r0.y) + (r0.z * r0.z + r0.w * r0.w) + (r1.x * r1.x + r1.y * r1.y) + (r1.z * r1.z + r1.w * r1.w)
                     + (r2.x * r2.x + r2.y * r2.y) + (r2.z * r2.z + r2.w * r2.w) + (r3.x * r3.x + r3.y * r3.y) + (r3.z * r3.z + r3.w * r3.w);
            ss = wave_sum_dpp(ss);
            if (lane < 8) ssqw[(size_t)tok * 8 + lane] = lane == 0 ? ss : 0.f;
        } else {
            const int b = tok / L, pos = tok - b * L;
            if (pos >= NMETA) { float* op = c.out + ((size_t)b * SEQ + (pos - NMETA)) * D + lane * 8;
                *(f32x4*)op = r0; *(f32x4*)(op + 4) = r1; *(f32x4*)(op + 512) = r2; *(f32x4*)(op + 516) = r3; }
        }
    }
}

struct Args { const float* in[22]; float* out; unsigned char* ws; int ph_lo, ph_hi; };
constexpr int N_PHASES = 17;

__global__ void __launch_bounds__(NTHREADS, 2) fwd_kernel(Args args) {
    extern __shared__ __attribute__((aligned(16))) unsigned char lds_raw[];
    Ctx c;
#pragma unroll
    for (int i = 0; i < 22; ++i) c.in[i] = args.in[i];
    c.out = args.out; c.ws = args.ws; c.lds = lds_raw;
    c.tid = threadIdx.x; c.lane = c.tid & 63; c.wave = __builtin_amdgcn_readfirstlane(c.tid >> 6);
    c.G = gridDim.x; { const int bx = blockIdx.x; c.vb = (c.G % 8 == 0) ? (bx % 8) * (c.G / 8) + bx / 8 : bx; }
    volatile unsigned* misc = (volatile unsigned*)(c.lds + LDS_MISC);
    if (c.tid < 16) misc[c.tid] = 0u;
    __syncthreads();
    const int lo = args.ph_lo, hi = args.ph_hi;
    const bool multi = (hi - lo) > 1;
    XcdBarrier bar; bar.bar = WSP(unsigned, WS_CTL) + CW_BAR; bar.x = 0; bar.st = misc;
    if (multi) bar = xcd_barrier_post(WSP(unsigned, WS_CTL) + CW_BAR, misc);
#define IN_(k) (lo <= (k) && (k) < hi)
#define SEAM_(k) do { if ((k) + 1 < hi) xcd_barrier(bar); } while (0)
    if (IN_(0)) { phase_prologue(c); SEAM_(0); }
#pragma unroll 1
    for (int l = 0; l < 2; ++l) {
        const int p0 = 1 + 8 * l;
        if (IN_(p0 + 0)) { phase_A(c, l); SEAM_(p0 + 0); }
        if (IN_(p0 + 1)) { phase_B(c, l); SEAM_(p0 + 1); }
        if (IN_(p0 + 2)) { phase_C(c, l); SEAM_(p0 + 2); }
        if (IN_(p0 + 3)) { phase_D(c, l); SEAM_(p0 + 3); }
        if (IN_(p0 + 4)) { phase_E(c, l); SEAM_(p0 + 4); }
        if (IN_(p0 + 5)) { phase_F(c, l); SEAM_(p0 + 5); }
        if (IN_(p0 + 6)) { phase_F3(c, l); SEAM_(p0 + 6); }
        if (IN_(p0 + 7)) { if (c.G * 4 * G2_MAXTOK >= T && c.G * 4 * (G2_MAXTOK - 1) <= T) phase_G2(c, l); else phase_G(c, l); SEAM_(p0 + 7); }
    }
}

extern "C" void kernel_launch(void* const* d_in, const int* in_sizes, int n_in, void* d_out, int out_size, void* d_ws, size_t ws_size, hipStream_t stream) {
    static int grid = 0;
    if (grid == 0) {
        if (n_in != 22 || out_size != NB * SEQ * D || ws_size < WS_END) { fprintf(stderr, "kernel_launch: unexpected shapes (n_in %d out %d ws %zu need %zu)\n", n_in, out_size, ws_size, (size_t)WS_END); grid = -1; return; }
        int dev = 0, cus = 0, per_cu = 0;
        hipGetDevice(&dev); hipDeviceGetAttribute(&cus, hipDeviceAttributeMultiprocessorCount, dev);
        if (hipFuncSetAttribute((const void*)fwd_kernel, hipFuncAttributeMaxDynamicSharedMemorySize, LDS_BYTES) != hipSuccess) { fprintf(stderr, "kernel_launch: hipFuncSetAttribute failed\n"); grid = -1; return; }
        if (hipOccupancyMaxActiveBlocksPerMultiprocessor(&per_cu, (const void*)fwd_kernel, NTHREADS, LDS_BYTES) != hipSuccess || per_cu < 1) { fprintf(stderr, "kernel_launch: occupancy query failed (%d)\n", per_cu); per_cu = 1; (void)hipGetLastError(); }
        if (per_cu > 2) per_cu = 2;
        grid = cus * per_cu;
        fprintf(stderr, "kernel_launch: grid %d (%d per CU), lds %d, ws need %zu have %zu\n", grid, per_cu, LDS_BYTES, (size_t)WS_END, ws_size);
    }
    if (grid < 0) return;
    hipMemsetAsync((char*)d_ws + WS_CTL, 0, CTL_BYTES, stream);
    Args a{};
    for (int i = 0; i < 22; ++i) a.in[i] = (const float*)d_in[i];
    a.out = (float*)d_out; a.ws = (unsigned char*)d_ws;
#if MK_PER_PHASE
    for (int ph = 0; ph < N_PHASES; ++ph) { a.ph_lo = ph; a.ph_hi = ph + 1; hipLaunchKernelGGL(fwd_kernel, dim3(grid), dim3(NTHREADS), LDS_BYTES, stream, a); }
#else
    a.ph_lo = 0; a.ph_hi = N_PHASES;
    void* kargs[] = {&a};
    hipError_t e = hipLaunchCooperativeKernel((const void*)fwd_kernel, dim3(grid), dim3(NTHREADS), kargs, LDS_BYTES, stream);
    if (e != hipSuccess) fprintf(stderr, "kernel_launch: cooperative launch failed: %s (grid %d)\n", hipGetErrorString(e), grid);
#endif
}
```

```cpp
#include <hip/hip_runtime.h>
#include <cstdio>
#include <cstdint>

#ifndef MK_PER_PHASE
#define MK_PER_PHASE 0
#endif

typedef unsigned short bf16;
typedef short bf16x8 __attribute__((ext_vector_type(8)));
typedef float f32x4 __attribute__((ext_vector_type(4)));
typedef unsigned u32x4 __attribute__((ext_vector_type(4)));
typedef unsigned u32x2 __attribute__((ext_vector_type(2)));
typedef __bf16 bf16x2 __attribute__((ext_vector_type(2)));

constexpr int NB = 8, SEQ = 2048, NMETA = 16, L = SEQ + NMETA, T = NB * L, D = 1024;
constexpr int DC = 512, CW = 31, NH = 8, QL = 256, KVL = 128, NOPE = 64, ROPE = 32, QK = 96, VD = 64;
constexpr int NIN = 3488, NINP = 3584;
constexpr int NEXP = 16384;
constexpr float EPS = 1e-6f;
constexpr int MT = T / 128;
static_assert(T % 128 == 0, "T tiles");

constexpr size_t al256(size_t x) { return (x + 255) & ~(size_t)255; }
constexpr size_t WS_CTL = 0;
constexpr size_t CTL_BYTES = 65536;
constexpr size_t WS_ROPE = WS_CTL + CTL_BYTES;
constexpr size_t WS_WIN = al256(WS_ROPE + (size_t)L * 16 * 8);
constexpr size_t SZ_WIN = (size_t)NINP * 1024 * 2, SZ_WCO = (size_t)1024 * 512 * 2, SZ_WUQ = (size_t)1024 * 256 * 2, SZ_WUKV = (size_t)1024 * 128 * 2,
                 SZ_WMLA = (size_t)1024 * 512 * 2, SZ_WOUT = (size_t)1024 * 1024 * 2, SZ_WPQ = (size_t)2048 * 1024 * 2, SZ_KEYS = (size_t)16 * 128 * 128 * 2;
constexpr size_t OFF_WCO = SZ_WIN, OFF_WUQ = OFF_WCO + SZ_WCO, OFF_WUKV = OFF_WUQ + SZ_WUQ, OFF_WMLA = OFF_WUKV + SZ_WUKV, OFF_WOUT = OFF_WMLA + SZ_WMLA,
                 OFF_WPQ = OFF_WOUT + SZ_WOUT, OFF_KEYS = OFF_WPQ + SZ_WPQ, SZ_WLAYER = OFF_KEYS + SZ_KEYS;
constexpr size_t WS_TAB = al256(WS_WIN + 2 * SZ_WLAYER);
constexpr size_t SZ_TAB = (size_t)NEXP * 1024;
constexpr float TAB_SCALE = 256.0f, TAB_INV = 1.0f / 256.0f;
constexpr size_t WS_H = al256(WS_TAB + 4 * SZ_TAB);
constexpr size_t WS_HB = al256(WS_H + (size_t)T * 1024 * 4);
constexpr size_t WS_SSQ = al256(WS_HB + (size_t)T * 1024 * 2);
constexpr size_t WS_UGLU = al256(WS_SSQ + (size_t)T * 8 * 4);
constexpr size_t WS_CQ = al256(WS_UGLU + (size_t)T * 512 * 2);
constexpr size_t WS_CKV = al256(WS_CQ + (size_t)T * 256 * 2);
constexpr size_t WS_KROPE = al256(WS_CKV + (size_t)T * 128 * 2);
constexpr size_t WS_SSQQ = al256(WS_KROPE + (size_t)T * 32 * 4);
constexpr size_t WS_SSQKV = al256(WS_SSQQ + (size_t)T * 2 * 4);
constexpr size_t WS_U2 = al256(WS_SSQKV + (size_t)T * 4);
constexpr size_t WS_Q = al256(WS_U2 + (size_t)T * 512 * 2);
constexpr size_t WS_K = al256(WS_Q + (size_t)T * NH * QK * 2);
constexpr size_t WS_VT = al256(WS_K + (size_t)T * NH * QK * 2);
constexpr size_t WS_O = al256(WS_VT + (size_t)T * NH * VD * 2 + 4096);
constexpr size_t WS_MERGED = al256(WS_O + (size_t)T * 512 * 2);
constexpr size_t WS_GATES = al256(WS_MERGED + (size_t)T * 1024 * 2);
constexpr size_t WS_SV = WS_GATES;
constexpr size_t WS_SI = al256(WS_SV + (size_t)T * 256 * 4);
constexpr size_t WS_EIDX = al256(WS_SI + (size_t)T * 256);
constexpr size_t WS_GW = al256(WS_EIDX + (size_t)T * 128 * 4);
constexpr size_t WS_STB = al256(WS_GW + (size_t)T * 128 * 4);
constexpr size_t WS_PEER_END = WS_STB + (size_t)T * 16;
constexpr size_t WS_END = al256(WS_GATES + (size_t)T * 2048 * 2);
static_assert(WS_PEER_END <= WS_END, "peer scratch overlay");

constexpr int CW_BAR = 0;
constexpr int CW_QUEUE = 4096;

constexpr int LDS_MAIN = 128 * 132 * 4;
constexpr int LDS_MISC = LDS_MAIN;
constexpr int LDS_BYTES = LDS_MAIN + 64;

constexpr int NTHREADS = 256;

__device__ __forceinline__ unsigned pk2(float lo, float hi) { bf16x2 v; v.x = (__bf16)lo; v.y = (__bf16)hi; return __builtin_bit_cast(unsigned, v); }
__device__ __forceinline__ float bf_lo(unsigned p) { return __uint_as_float(p << 16); }
__device__ __forceinline__ float bf_hi(unsigned p) { return __uint_as_float(p & 0xffff0000u); }
__device__ __forceinline__ float fast_rcp(float x) { return __builtin_amdgcn_rcpf(x); }
__device__ __forceinline__ float fast_exp2(float x) { return __builtin_amdgcn_exp2f(x); }
__device__ __forceinline__ float sigmoidf_(float x) { return fast_rcp(1.0f + fast_exp2(-1.4426950409f * x)); }
__device__ __forceinline__ float gelu_tanh(float x) { const float u = 1.5957691216f * (x + 0.044715f * x * x * x); return x * fast_rcp(1.0f + fast_exp2(-1.4426950409f * u)); }
__device__ __forceinline__ float rsqrt_(float x) { return __builtin_amdgcn_rsqf(x); }
__device__ __forceinline__ float quad_sum(float v) { v += __shfl_xor(v, 16); v += __shfl_xor(v, 32); return v; }
__device__ __forceinline__ float quad_max(float v) { v = fmaxf(v, __shfl_xor(v, 16)); v = fmaxf(v, __shfl_xor(v, 32)); return v; }
__device__ __forceinline__ float wave_sum(float v) {
#pragma unroll
    for (int o = 1; o < 64; o <<= 1) v += __shfl_xor(v, o);
    return v;
}
template <int CTRL> __device__ __forceinline__ float dpp(float x) { return __builtin_bit_cast(float, __builtin_amdgcn_mov_dpp(__builtin_bit_cast(int, x), CTRL, 0xf, 0xf, true)); }
__device__ __forceinline__ float xrow16_sum(float x) {
    auto s = __builtin_amdgcn_permlane16_swap(__float_as_uint(x), __float_as_uint(x), false, false);
    x = __uint_as_float(s[0]) + __uint_as_float(s[1]);
    auto t = __builtin_amdgcn_permlane32_swap(__float_as_uint(x), __float_as_uint(x), false, false);
    return __uint_as_float(t[0]) + __uint_as_float(t[1]);
}
__device__ __forceinline__ float wave_sum_dpp(float x) {
    x += dpp<0xB1>(x); x += dpp<0x4E>(x); x += dpp<0x141>(x); x += dpp<0x128>(x); return xrow16_sum(x);
}
__device__ __forceinline__ float dot2(unsigned a, unsigned b, float c) { return __builtin_amdgcn_fdot2_f32_bf16(__builtin_bit_cast(bf16x2, a), __builtin_bit_cast(bf16x2, b), c, false); }

#define XB_TMO      128
#define XB_XCNT(j)  (256  + 64 * (j))
#define XB_XSUB(j)  (1280 + 64 * (j))
#define XB_XGEN(j)  (2304 + 64 * (j))
#define XB_TOP      3328
#define XB_TOPGEN   3392
#define XCD_BAR_WORDS 3456
#define XB_SPIN_CAP (1u << 20)
__device__ __forceinline__ unsigned xb_ld(unsigned* p)              { return __hip_atomic_load(p, __ATOMIC_RELAXED, __HIP_MEMORY_SCOPE_AGENT); }
__device__ __forceinline__ unsigned xb_add(unsigned* p, unsigned v) { return __hip_atomic_fetch_add(p, v, __ATOMIC_RELAXED, __HIP_MEMORY_SCOPE_AGENT); }
__device__ __forceinline__ unsigned xb_xcc_id() { return (unsigned)__builtin_amdgcn_s_getreg((3 << 11) | 20) & 0xFu; }
#define XB_SPIN(cond, bar) do { unsigned _sp = 0; while (cond) { __builtin_amdgcn_s_sleep(1); \
    if ((++_sp & 255u) == 0u) { if (xb_ld(&(bar)[XB_TMO])) break; if (_sp > XB_SPIN_CAP) { atomicAdd(&(bar)[XB_TMO], 1u); break; } } } } while (0)
struct XcdBarrier { unsigned* bar; unsigned x; volatile unsigned* st; };
__device__ __forceinline__ XcdBarrier xcd_barrier_post(unsigned* bar, volatile unsigned* st) {
    XcdBarrier b; b.bar = bar; b.x = xb_xcc_id(); b.st = st;
    if (threadIdx.x == 0) (void)xb_add(&bar[XB_XCNT(b.x)], 1u);
    return b;
}
__device__ __forceinline__ void xcd_barrier_complete(unsigned* bar, unsigned x, unsigned& nloc, unsigned& nx) {
    const unsigned G = gridDim.x * gridDim.y * gridDim.z;
    unsigned sum, cnt, mine, sp = 0u;
    for (;;) {
        sum = 0u; cnt = 0u; mine = 0u;
#pragma unroll
        for (unsigned j = 0; j < 16; ++j) { const unsigned c = xb_ld(&bar[XB_XCNT(j)]); sum += c; cnt += (c > 0u) ? 1u : 0u; mine = (j == x) ? c : mine; }
        if (sum == G) break;
        __builtin_amdgcn_s_sleep(1);
        if ((++sp & 255u) == 0u) { if (xb_ld(&bar[XB_TMO])) break; if (sp > XB_SPIN_CAP) { atomicAdd(&bar[XB_TMO], 1u); break; } }
    }
    nloc = mine > 0u ? mine : 1u; nx = cnt > 0u ? cnt : 1u;
}
__device__ __forceinline__ void xcd_barrier(const XcdBarrier& b) {
    asm volatile("s_waitcnt vmcnt(0)" ::: "memory");
    __syncthreads();
    if (threadIdx.x == 0) {
        unsigned* bar = b.bar;
        __builtin_amdgcn_s_waitcnt(0);
        unsigned nloc = b.st[0], nx = b.st[1];
        if (nloc == 0u) { xcd_barrier_complete(bar, b.x, nloc, nx); b.st[0] = nloc; b.st[1] = nx; }
        const unsigned old = xb_add(&bar[XB_XSUB(b.x)], 1u);
        const unsigned gen = old / nloc;
        if (old + 1u == (gen + 1u) * nloc) {
            __builtin_amdgcn_fence(__ATOMIC_RELEASE, "agent");
            asm volatile("s_waitcnt vmcnt(0)" ::: "memory");
            const unsigned og = xb_add(&bar[XB_TOP], 1u);
            const unsigned tg = og / nx;
            if (og + 1u == (tg + 1u) * nx) xb_add(&bar[XB_TOPGEN], 1u);
            else XB_SPIN(xb_ld(&bar[XB_TOPGEN]) == tg, bar);
            __builtin_amdgcn_fence(__ATOMIC_ACQUIRE, "agent");
            xb_add(&bar[XB_XGEN(b.x)], 1u);
            asm volatile("s_waitcnt vmcnt(0)" ::: "memory");
        } else {
            XB_SPIN(xb_ld(&bar[XB_XGEN(b.x)]) == gen, bar);
            __builtin_amdgcn_fence(__ATOMIC_ACQUIRE, "agent");
            asm volatile("s_waitcnt vmcnt(0)" ::: "memory");
        }
    }
    __syncthreads();
}

struct Ctx {
    const float* in[22]; float* out; unsigned char* ws;
    unsigned char* lds; int tid, lane, wave, G, vb;
};
#define WSP(T_, off) ((T_*)(c.ws + (off)))
__device__ __forceinline__ Ctx reopaque(const Ctx& c0) {
    Ctx c = c0; int t = c0.tid; asm volatile("" : "+v"(t)); c.tid = t; c.lane = t & 63; c.wave = __builtin_amdgcn_readfirstlane(t >> 6);
    int vb = c0.vb; asm volatile("" : "+s"(vb)); c.vb = vb; return c;
}

__device__ __forceinline__ int lds_off(int row, int chunk) { return row * 128 + ((chunk ^ (row & 7)) << 4); }

__device__ __forceinline__ void gemm_compute_stage(f32x4 (&acc)[2][8], const unsigned char* sA, const unsigned char* sB, int wave, int lane) {
    const int r = lane & 15, q = lane >> 4;
#pragma unroll
    for (int ks = 0; ks < 2; ++ks) {
        bf16x8 af[2], bfr[8];
#pragma unroll
        for (int mi = 0; mi < 2; ++mi) af[mi] = *(const bf16x8*)(sA + lds_off(32 * wave + 16 * mi + r, 4 * ks + q));
#pragma unroll
        for (int ni = 0; ni < 8; ++ni) bfr[ni] = *(const bf16x8*)(sB + lds_off(16 * ni + r, 4 * ks + q));
#pragma unroll
        for (int mi = 0; mi < 2; ++mi)
#pragma unroll
            for (int ni = 0; ni < 8; ++ni) acc[mi][ni] = __builtin_amdgcn_mfma_f32_16x16x32_bf16(bfr[ni], af[mi], acc[mi][ni], 0, 0, 0);
    }
}

__device__ __forceinline__ void gemm_core(f32x4 (&acc)[2][8], const bf16* A, int lda, const bf16* Bt, int ldb, int K, unsigned char* lds, int tid) {
    const int wave = __builtin_amdgcn_readfirstlane(tid >> 6), lane = tid & 63;
    const int chunk = tid & 7, row0 = tid >> 3;
    const int nk = K >> 6;
    u32x4 ra[4], rb[4];
    const bf16* pa = A + (size_t)row0 * lda + chunk * 8;
    const bf16* pb = Bt + (size_t)row0 * ldb + chunk * 8;
#pragma unroll
    for (int i = 0; i < 4; ++i) { ra[i] = *(const u32x4*)(pa + (size_t)(32 * i) * lda); rb[i] = *(const u32x4*)(pb + (size_t)(32 * i) * ldb); }
#pragma unroll
    for (int i = 0; i < 4; ++i) { *(u32x4*)(lds + lds_off(row0 + 32 * i, chunk)) = ra[i]; *(u32x4*)(lds + 16384 + lds_off(row0 + 32 * i, chunk)) = rb[i]; }
    __syncthreads();
    for (int kt = 0; kt < nk; ++kt) {
        const int cur = kt & 1;
        if (kt + 1 < nk) {
#pragma unroll
            for (int i = 0; i < 4; ++i) { ra[i] = *(const u32x4*)(pa + (size_t)(32 * i) * lda + (kt + 1) * 64); rb[i] = *(const u32x4*)(pb + (size_t)(32 * i) * ldb + (kt + 1) * 64); }
        }
        gemm_compute_stage(acc, lds + cur * 32768, lds + cur * 32768 + 16384, wave, lane);
        if (kt + 1 < nk) {
            unsigned char* st = lds + (cur ^ 1) * 32768;
#pragma unroll
            for (int i = 0; i < 4; ++i) { *(u32x4*)(st + lds_off(row0 + 32 * i, chunk)) = ra[i]; *(u32x4*)(st + 16384 + lds_off(row0 + 32 * i, chunk)) = rb[i]; }
        }
        __syncthreads();
    }
}
__device__ __forceinline__ void acc_zero(f32x4 (&acc)[2][8]) {
#pragma unroll
    for (int mi = 0; mi < 2; ++mi)
#pragma unroll
        for (int ni = 0; ni < 8; ++ni) acc[mi][ni] = (f32x4){0.f, 0.f, 0.f, 0.f};
}
__device__ __forceinline__ float rstd_from_ssq8(const float* ssq, int tok) {
    const f32x4 a = *(const f32x4*)(ssq + (size_t)tok * 8), b = *(const f32x4*)(ssq + (size_t)tok * 8 + 4);
    const float s = ((a.x + a.y) + (a.z + a.w)) + ((b.x + b.y) + (b.z + b.w));
    return rsqrt_(s * (1.0f / 1024.0f) + EPS);
}

__device__ __forceinline__ int src_col(int mode, int np) {
    if (mode == 0) return np;
    if (mode == 2) { const int h = np >> 7, j = np & 127; return j < 96 ? h * 96 + j : -1; }
    if (np < 1024) { const int cblk = np >> 7, j = np & 127; return j < 64 ? 64 * cblk + j : 512 + 64 * cblk + (j - 64); }
    if (np < 1408) return np;
    if (np < 1536) { const int j = np - 1408; return j < 32 ? 1408 + j : -1; }
    return 1440 + (np - 1536);
}
__device__ __forceinline__ void p0_transpose_item(const float* W, int K, int N, bf16* Wt, int mode, const float* g, int item, float* scr, int lane) {
    const int nblk_k = K / 64, nb = item / nblk_k, kb = item % nblk_k, k0 = 64 * kb, n0 = 32 * nb;
    const int n = src_col(mode, n0 + (lane & 31));
#pragma unroll 8
    for (int i = 0; i < 32; ++i) { const int kk = 2 * i + (lane >> 5); float v = 0.f; if (n >= 0) { v = W[(size_t)(k0 + kk) * N + n]; if (g) v *= g[k0 + kk]; } scr[kk * 33 + (lane & 31)] = v; }
    __builtin_amdgcn_s_waitcnt(0xC07F); asm volatile("" ::: "memory");
    const int cch = lane & 7;
#pragma unroll
    for (int j = 0; j < 4; ++j) { const int nl = (lane >> 3) + 8 * j; const float* s = scr + (8 * cch) * 33 + nl;
        u32x4 o; o.x = pk2(s[0 * 33], s[1 * 33]); o.y = pk2(s[2 * 33], s[3 * 33]); o.z = pk2(s[4 * 33], s[5 * 33]); o.w = pk2(s[6 * 33], s[7 * 33]);
        *(u32x4*)(Wt + (size_t)(n0 + nl) * K + k0 + 8 * cch) = o; }
    __builtin_amdgcn_s_waitcnt(0xC07F); asm volatile("" ::: "memory");
}
struct WDesc { int in_idx, K, N, Np, mode, g_idx; size_t off; };
__device__ __forceinline__ void phase_prologue(const Ctx& c0) {
    Ctx c = reopaque(c0);
    const int gw = c.vb * 4 + c.wave, NGW = c.G * 4;
    float* scr = (float*)(c.lds + c.wave * 8704);
    const WDesc wd[7] = {
        {3, 1024, NIN, NINP, 1, 2, 0}, {8, 512, 1024, 1024, 0, -1, OFF_WCO}, {10, 256, 768, 1024, 2, 9, OFF_WUQ}, {12, 128, 1024, 1024, 0, 11, OFF_WUKV},
        {15, 512, 1024, 1024, 0, -1, OFF_WMLA}, {16, 1024, 1024, 1024, 0, -1, OFF_WOUT}, {18, 1024, 2048, 2048, 0, 17, OFF_WPQ}};
    for (int l = 0; l < 2; ++l)
#pragma unroll
        for (int m = 0; m < 7; ++m) {
            const int K = wd[m].K, N = wd[m].N, Np = wd[m].Np;
            const float* W = c.in[wd[m].in_idx] + (size_t)l * K * N;
            const float* g = wd[m].g_idx >= 0 ? c.in[wd[m].g_idx] + (size_t)l * K : nullptr;
            bf16* Wt = (bf16*)(c.ws + WS_WIN + l * SZ_WLAYER + wd[m].off);
            const int items = (K / 64) * (Np / 32);
            for (int it = gw; it < items; it += NGW) p0_transpose_item(W, K, N, Wt, wd[m].mode, g, it, scr, c.lane);
        }
    const int gt = c.vb * NTHREADS + c.tid, NGT = c.G * NTHREADS;
    for (int l = 0; l < 2; ++l) {
        const float* src = c.in[19] + (size_t)l * 262144; bf16* dst = (bf16*)(c.ws + WS_WIN + l * SZ_WLAYER + OFF_KEYS);
        for (int i = gt; i < 262144 / 8; i += NGT) { const f32x4 a = *(const f32x4*)(src + i * 8), b = *(const f32x4*)(src + i * 8 + 4);
            u32x4 o; o.x = pk2(a.x, a.y); o.y = pk2(a.z, a.w); o.z = pk2(b.x, b.y); o.w = pk2(b.z, b.w); *(u32x4*)(dst + i * 8) = o; }
    }
    for (int l = 0; l < 2; ++l)
        for (int uv = 0; uv < 2; ++uv) {
            const float* src = c.in[20 + uv] + (size_t)l * NEXP * 1024; unsigned char* dst = c.ws + WS_TAB + (size_t)(l * 2 + uv) * SZ_TAB;
            const float* g = c.in[17] + l * 1024;
            for (int i = gt; i < NEXP * 1024 / 16; i += NGT) {
                const float* sp = src + (size_t)i * 16;
                f32x4 a0 = *(const f32x4*)sp, a1 = *(const f32x4*)(sp + 4), a2 = *(const f32x4*)(sp + 8), a3 = *(const f32x4*)(sp + 12);
                if (uv == 0) { const float* gp = g + (i & 63) * 16; a0 = a0 * *(const f32x4*)gp; a1 = a1 * *(const f32x4*)(gp + 4); a2 = a2 * *(const f32x4*)(gp + 8); a3 = a3 * *(const f32x4*)(gp + 12); }
                a0 = a0 * TAB_SCALE; a1 = a1 * TAB_SCALE; a2 = a2 * TAB_SCALE; a3 = a3 * TAB_SCALE;
                u32x4 o;
                o.x = (unsigned)__builtin_amdgcn_cvt_pk_fp8_f32(a0.z, a0.w, __builtin_amdgcn_cvt_pk_fp8_f32(a0.x, a0.y, 0, false), true);
                o.y = (unsigned)__builtin_amdgcn_cvt_pk_fp8_f32(a1.z, a1.w, __builtin_amdgcn_cvt_pk_fp8_f32(a1.x, a1.y, 0, false), true);
                o.z = (unsigned)__builtin_amdgcn_cvt_pk_fp8_f32(a2.z, a2.w, __builtin_amdgcn_cvt_pk_fp8_f32(a2.x, a2.y, 0, false), true);
                o.w = (unsigned)__builtin_amdgcn_cvt_pk_fp8_f32(a3.z, a3.w, __builtin_amdgcn_cvt_pk_fp8_f32(a3.x, a3.y, 0, false), true);
                *(u32x4*)(dst + (size_t)i * 16) = o; }
        }
    { float* rope = WSP(float, WS_ROPE);
      for (int i = gt; i < L * 16; i += NGT) { const int pos = i >> 4, j = i & 15;
          const float inv = 1.0f / __builtin_exp2f((float)j * 0.8304820237218406f);
          const float angf = (float)pos * inv; const double ang = (double)angf;
          const double nq = __builtin_rint(ang * 0.63661977236758134308);
          double rr = __builtin_fma(-nq, 1.57079632679489655800e+00, ang); rr = __builtin_fma(-nq, 6.12323399573676603587e-17, rr);
          const double r2 = rr * rr;
          double sp = -1.0 / 1307674368000.0; sp = sp * r2 + 1.0 / 6227020800.0; sp = sp * r2 - 1.0 / 39916800.0; sp = sp * r2 + 1.0 / 362880.0; sp = sp * r2 - 1.0 / 5040.0; sp = sp * r2 + 1.0 / 120.0; sp = sp * r2 - 1.0 / 6.0; sp = sp * r2 * rr + rr;
          double cp = 1.0 / 87178291200.0; cp = cp * r2 - 1.0 / 479001600.0; cp = cp * r2 + 1.0 / 3628800.0; cp = cp * r2 - 1.0 / 40320.0; cp = cp * r2 + 1.0 / 720.0; cp = cp * r2 - 1.0 / 24.0; cp = cp * r2 + 0.5; cp = 1.0 - cp * r2;
          const int qd = ((int)nq) & 3;
          const double cv = qd == 0 ? cp : qd == 1 ? -sp : qd == 2 ? -cp : sp;
          const double sv_ = qd == 0 ? sp : qd == 1 ? cp : qd == 2 ? -sp : -cp;
          rope[2 * i] = (float)cv; rope[2 * i + 1] = (float)sv_; } }
    { float* h = WSP(float, WS_H); bf16* hb = WSP(bf16, WS_HB); float* ssq = WSP(float, WS_SSQ);
      for (int t = gw; t < T; t += NGW) { const int b = t / L, pos = t % L;
          const float* src = pos < NMETA ? c.in[1] + (size_t)pos * D : c.in[0] + ((size_t)b * SEQ + (pos - NMETA)) * D;
          float s = 0.f;
#pragma unroll
          for (int j = 0; j < 4; ++j) { const f32x4 v = *(const f32x4*)(src + j * 256 + c.lane * 4); *(f32x4*)(h + (size_t)t * D + j * 256 + c.lane * 4) = v;
              u32x2 o; o.x = pk2(v.x, v.y); o.y = pk2(v.z, v.w); *(u32x2*)(hb + (size_t)t * D + j * 256 + c.lane * 4) = o; s += (v.x * v.x + v.y * v.y) + (v.z * v.z + v.w * v.w); }
          s = wave_sum(s);
          if (c.lane < 8) ssq[(size_t)t * 8 + c.lane] = c.lane == 0 ? s : 0.f; } }
}

__device__ __forceinline__ void phase_A(const Ctx& c0, int l) {
    Ctx c = reopaque(c0);
    const bf16* hb = WSP(bf16, WS_HB); const bf16* Wt = (const bf16*)(c.ws + WS_WIN + l * SZ_WLAYER);
    const float* ssq = WSP(float, WS_SSQ);
    bf16* uglu = WSP(bf16, WS_UGLU); bf16* cq = WSP(bf16, WS_CQ); bf16* ckv = WSP(bf16, WS_CKV); float* krope = WSP(float, WS_KROPE);
    float* ssqq = WSP(float, WS_SSQQ); float* ssqkv = WSP(float, WS_SSQKV); bf16* gates = WSP(bf16, WS_GATES);
    constexpr int NT = NINP / 128;
    const int r = c.lane & 15, q = c.lane >> 4;
    for (int it = c.vb; it < MT * NT; it += c.G) {
        const int mt = it / NT, nt = it % NT;
        f32x4 acc[2][8]; acc_zero(acc);
        gemm_core(acc, hb + (size_t)mt * 128 * D, D, Wt + (size_t)nt * 128 * D, D, D, c.lds, c.tid);
#pragma unroll
        for (int mi = 0; mi < 2; ++mi) {
            const int tok = mt * 128 + 32 * c.wave + 16 * mi + r;
            const float rs = rstd_from_ssq8(ssq, tok);
            if (nt < 8) {
#pragma unroll
                for (int ni = 0; ni < 4; ++ni) { const f32x4 v = acc[mi][ni] * rs, g = acc[mi][ni + 4] * rs;
                    u32x2 o; o.x = pk2(v.x * sigmoidf_(g.x), v.y * sigmoidf_(g.y)); o.y = pk2(v.z * sigmoidf_(g.z), v.w * sigmoidf_(g.w));
                    *(u32x2*)(uglu + (size_t)tok * DC + nt * 64 + 16 * ni + 4 * q) = o; }
            } else if (nt < 11) {
                bf16* dst = nt < 10 ? cq + (size_t)tok * QL + (nt - 8) * 128 : ckv + (size_t)tok * KVL;
                float ss = 0.f;
#pragma unroll
                for (int ni = 0; ni < 8; ++ni) { const f32x4 v = acc[mi][ni] * rs; ss += (v.x * v.x + v.y * v.y) + (v.z * v.z + v.w * v.w);
                    u32x2 o; o.x = pk2(v.x, v.y); o.y = pk2(v.z, v.w); *(u32x2*)(dst + 16 * ni + 4 * q) = o; }
                ss = quad_sum(ss);
                if (q == 0) { if (nt < 10) ssqq[(size_t)tok * 2 + (nt - 8)] = ss; else ssqkv[tok] = ss; }
            } else if (nt == 11) {
#pragma unroll
                for (int ni = 0; ni < 2; ++ni) *(f32x4*)(krope + (size_t)tok * 32 + 16 * ni + 4 * q) = acc[mi][ni] * rs;
            } else {
#pragma unroll
                for (int ni = 0; ni < 8; ++ni) { const f32x4 v = acc[mi][ni] * rs;
                    u32x2 o; o.x = pk2(sigmoidf_(v.x), sigmoidf_(v.y)); o.y = pk2(sigmoidf_(v.z), sigmoidf_(v.w));
                    *(u32x2*)(gates + (size_t)tok * 2048 + (nt - 12) * 128 + 16 * ni + 4 * q) = o; }
            }
        }
    }
}

__device__ __forceinline__ void phaseB_q_item(Ctx& c, int l, int mt, int head) {
    const bf16* cq = WSP(bf16, WS_CQ); const bf16* Wt = (const bf16*)(c.ws + WS_WIN + l * SZ_WLAYER + OFF_WUQ);
    const float* ssqq = WSP(float, WS_SSQQ); const float* rope = WSP(float, WS_ROPE); const float* qg = c.in[13] + l * QK; bf16* Qb = WSP(bf16, WS_Q);
    const int r = c.lane & 15, q = c.lane >> 4;
    f32x4 acc[2][8]; acc_zero(acc);
    gemm_core(acc, cq + (size_t)mt * 128 * QL, QL, Wt + (size_t)head * 128 * QL, QL, QL, c.lds, c.tid);
    constexpr float QSCALE = 0.10206207261596575f * 1.4426950408889634f;
#pragma unroll
    for (int mi = 0; mi < 2; ++mi) {
        const int tok = mt * 128 + 32 * c.wave + 16 * mi + r, b = tok / L, pos = tok - b * L;
        const float rs = rsqrt_((ssqq[(size_t)tok * 2] + ssqq[(size_t)tok * 2 + 1]) * (1.0f / 256.0f) + EPS);
        float ss = 0.f;
#pragma unroll
        for (int ni = 0; ni < 6; ++ni) { acc[mi][ni] = acc[mi][ni] * rs; const f32x4 v = acc[mi][ni]; ss += (v.x * v.x + v.y * v.y) + (v.z * v.z + v.w * v.w); }
        ss = quad_sum(ss);
        const float rn = rsqrt_(ss * (1.0f / 96.0f) + EPS) * QSCALE;
#pragma unroll
        for (int ni = 0; ni < 6; ++ni) { const f32x4 g = *(const f32x4*)(qg + 16 * ni + 4 * q); acc[mi][ni] = acc[mi][ni] * g * rn; }
        const f32x4 cs0 = *(const f32x4*)(rope + ((size_t)pos * 16 + 4 * q) * 2), cs1 = *(const f32x4*)(rope + ((size_t)pos * 16 + 4 * q) * 2 + 4);
        const float co[4] = {cs0.x, cs0.z, cs1.x, cs1.z}, si[4] = {cs0.y, cs0.w, cs1.y, cs1.w};
        f32x4 x1 = acc[mi][4], x2 = acc[mi][5];
#pragma unroll
        for (int e = 0; e < 4; ++e) { const float a = x1[e], bb = x2[e]; x1[e] = a * co[e] - bb * si[e]; x2[e] = bb * co[e] + a * si[e]; }
        acc[mi][4] = x1; acc[mi][5] = x2;
        bf16* dst = Qb + (((size_t)b * NH + head) * L + pos) * QK;
#pragma unroll
        for (int ni = 0; ni < 6; ++ni) { const f32x4 v = acc[mi][ni]; u32x2 o; o.x = pk2(v.x, v.y); o.y = pk2(v.z, v.w); *(u32x2*)(dst + 16 * ni + 4 * q) = o; }
    }
}
__device__ __forceinline__ void phaseB_kv_item(Ctx& c, int l, int mt, int head) {
    const bf16* ckv = WSP(bf16, WS_CKV); const bf16* Wt = (const bf16*)(c.ws + WS_WIN + l * SZ_WLAYER + OFF_WUKV);
    const float* ssqkv = WSP(float, WS_SSQKV); const float* rope = WSP(float, WS_ROPE); const float* kg = c.in[14] + l * QK; const float* krope = WSP(float, WS_KROPE);
    bf16* Kb = WSP(bf16, WS_K); bf16* Vt = WSP(bf16, WS_VT);
    const int tid = c.tid, wave = c.wave, lane = c.lane, r = lane & 15, q = lane >> 4;
    unsigned char* lds = c.lds;
    f32x4 ak[2][4], av[2][4];
#pragma unroll
    for (int mi = 0; mi < 2; ++mi)
#pragma unroll
        for (int ni = 0; ni < 4; ++ni) { ak[mi][ni] = (f32x4){0.f, 0.f, 0.f, 0.f}; av[mi][ni] = (f32x4){0.f, 0.f, 0.f, 0.f}; }
    { const int chunk = tid & 7, row0 = tid >> 3;
      const bf16* pa = ckv + ((size_t)mt * 128 + row0) * KVL + chunk * 8; const bf16* pb = Wt + ((size_t)head * 128 + row0) * KVL + chunk * 8;
#pragma unroll
      for (int s = 0; s < 2; ++s)
#pragma unroll
          for (int i = 0; i < 4; ++i) { *(u32x4*)(lds + s * 32768 + lds_off(row0 + 32 * i, chunk)) = *(const u32x4*)(pa + (size_t)(32 * i) * KVL + s * 64);
              *(u32x4*)(lds + s * 32768 + 16384 + lds_off(row0 + 32 * i, chunk)) = *(const u32x4*)(pb + (size_t)(32 * i) * KVL + s * 64); }
    }
    __syncthreads();
#pragma unroll
    for (int s = 0; s < 2; ++s)
#pragma unroll
        for (int ks = 0; ks < 2; ++ks) {
            const unsigned char* sA = lds + s * 32768; const unsigned char* sB = sA + 16384;
            bf16x8 af[2], bfr[8];
#pragma unroll
            for (int mi = 0; mi < 2; ++mi) af[mi] = *(const bf16x8*)(sA + lds_off(32 * wave + 16 * mi + r, 4 * ks + q));
#pragma unroll
            for (int ni = 0; ni < 8; ++ni) bfr[ni] = *(const bf16x8*)(sB + lds_off(16 * ni + r, 4 * ks + q));
#pragma unroll
            for (int mi = 0; mi < 2; ++mi)
#pragma unroll
                for (int ni = 0; ni < 4; ++ni) { ak[mi][ni] = __builtin_amdgcn_mfma_f32_16x16x32_bf16(bfr[ni], af[mi], ak[mi][ni], 0, 0, 0);
                    av[mi][ni] = __builtin_amdgcn_mfma_f32_16x16x32_bf16(af[mi], bfr[ni + 4], av[mi][ni], 0, 0, 0); }
        }
    __syncthreads();
#pragma unroll
    for (int mi = 0; mi < 2; ++mi) {
        const int tok0 = mt * 128 + 32 * wave + 16 * mi, b = tok0 / L, pos0 = tok0 - b * L;
        { const int tok = tok0 + r, pos = pos0 + r;
          const float rs = rsqrt_(ssqkv[tok] * (1.0f / 128.0f) + EPS);
          const f32x4 kr1 = *(const f32x4*)(krope + (size_t)tok * 32 + 4 * q), kr2 = *(const f32x4*)(krope + (size_t)tok * 32 + 16 + 4 * q);
          float ss = (kr1.x * kr1.x + kr1.y * kr1.y) + (kr1.z * kr1.z + kr1.w * kr1.w) + (kr2.x * kr2.x + kr2.y * kr2.y) + (kr2.z * kr2.z + kr2.w * kr2.w);
#pragma unroll
          for (int ni = 0; ni < 4; ++ni) { ak[mi][ni] = ak[mi][ni] * rs; const f32x4 v = ak[mi][ni]; ss += (v.x * v.x + v.y * v.y) + (v.z * v.z + v.w * v.w); }
          ss = quad_sum(ss);
          const float rn = rsqrt_(ss * (1.0f / 96.0f) + EPS);
          bf16* dst = Kb + (((size_t)b * NH + head) * L + pos) * QK;
#pragma unroll
          for (int ni = 0; ni < 4; ++ni) { const f32x4 g = *(const f32x4*)(kg + 16 * ni + 4 * q); const f32x4 v = ak[mi][ni] * g * rn;
              u32x2 o; o.x = pk2(v.x, v.y); o.y = pk2(v.z, v.w); *(u32x2*)(dst + 16 * ni + 4 * q) = o; }
          const f32x4 g1 = *(const f32x4*)(kg + 64 + 4 * q), g2 = *(const f32x4*)(kg + 80 + 4 * q);
          f32x4 x1 = kr1 * g1 * rn, x2 = kr2 * g2 * rn;
          const f32x4 cs0 = *(const f32x4*)(rope + ((size_t)pos * 16 + 4 * q) * 2), cs1 = *(const f32x4*)(rope + ((size_t)pos * 16 + 4 * q) * 2 + 4);
          const float co[4] = {cs0.x, cs0.z, cs1.x, cs1.z}, si[4] = {cs0.y, cs0.w, cs1.y, cs1.w};
#pragma unroll
          for (int e = 0; e < 4; ++e) { const float a = x1[e], bb = x2[e]; x1[e] = a * co[e] - bb * si[e]; x2[e] = bb * co[e] + a * si[e]; }
          u32x2 o1, o2; o1.x = pk2(x1.x, x1.y); o1.y = pk2(x1.z, x1.w); o2.x = pk2(x2.x, x2.y); o2.y = pk2(x2.z, x2.w);
          *(u32x2*)(dst + 64 + 4 * q) = o1; *(u32x2*)(dst + 80 + 4 * q) = o2; }
        { const f32x4 sq = *(const f32x4*)(ssqkv + tok0 + 4 * q);
          f32x4 rs4; rs4.x = rsqrt_(sq.x * (1.0f / 128.0f) + EPS); rs4.y = rsqrt_(sq.y * (1.0f / 128.0f) + EPS); rs4.z = rsqrt_(sq.z * (1.0f / 128.0f) + EPS); rs4.w = rsqrt_(sq.w * (1.0f / 128.0f) + EPS);
#pragma unroll
          for (int ni = 0; ni < 4; ++ni) { const f32x4 v = av[mi][ni] * rs4; u32x2 o; o.x = pk2(v.x, v.y); o.y = pk2(v.z, v.w);
              *(u32x2*)(Vt + (((size_t)b * NH + head) * VD + 16 * ni + r) * L + pos0 + 4 * q) = o; } }
    }
}
__device__ __forceinline__ u32x4 conv_row(const bf16* uglu, int b, int pos, int ch) {
    u32x4 xv = (u32x4){0u, 0u, 0u, 0u};
    if (pos >= 0) xv = *(const u32x4*)(uglu + ((size_t)b * L + pos) * DC + ch);
    return xv;
}
__device__ __forceinline__ void conv_fma(float (&a)[8], const u32x4 xv, const f32x4 w0, const f32x4 w1) {
    a[0] += bf_lo(xv.x) * w0.x; a[1] += bf_hi(xv.x) * w0.y; a[2] += bf_lo(xv.y) * w0.z; a[3] += bf_hi(xv.y) * w0.w;
    a[4] += bf_lo(xv.z) * w1.x; a[5] += bf_hi(xv.z) * w1.y; a[6] += bf_lo(xv.w) * w1.z; a[7] += bf_hi(xv.w) * w1.w;
}
__device__ __forceinline__ void phaseB_conv_item(Ctx& c, int l, int grp) {
    const bf16* uglu = WSP(bf16, WS_UGLU); bf16* u2 = WSP(bf16, WS_U2);
    const float* cw = c.in[4] + (size_t)l * CW * DC; const float* cb = c.in[5] + l * DC; const float* lg = c.in[6] + l * DC; const float* lb = c.in[7] + l * DC;
    const int tok0 = grp * 4, b = tok0 / L, pos0 = tok0 - b * L, ch = c.lane * 8;
    float acc[4][8];
    { const f32x4 b0 = *(const f32x4*)(cb + ch), b1 = *(const f32x4*)(cb + ch + 4);
#pragma unroll
      for (int d = 0; d < 4; ++d) { acc[d][0] = b0.x; acc[d][1] = b0.y; acc[d][2] = b0.z; acc[d][3] = b0.w; acc[d][4] = b1.x; acc[d][5] = b1.y; acc[d][6] = b1.z; acc[d][7] = b1.w; } }
    const int base = pos0 - 30;
    u32x4 x0 = conv_row(uglu, b, base + 0, ch), x1 = conv_row(uglu, b, base + 1, ch), x2 = conv_row(uglu, b, base + 2, ch),
          x3 = conv_row(uglu, b, base + 3, ch), x4 = conv_row(uglu, b, base + 4, ch), x5;
    const float* wp = cw + ch;
#pragma unroll 1
    for (int w = 0; w < CW; ++w) {
        x5 = conv_row(uglu, b, (w + 5 <= 33) ? base + w + 5 : -1, ch);
        const f32x4 w0 = *(const f32x4*)wp, w1 = *(const f32x4*)(wp + 4); wp += DC;
        conv_fma(acc[0], x0, w0, w1); conv_fma(acc[1], x1, w0, w1); conv_fma(acc[2], x2, w0, w1); conv_fma(acc[3], x3, w0, w1);
        x0 = x1; x1 = x2; x2 = x3; x3 = x4; x4 = x5;
    }
    const f32x4 g0 = *(const f32x4*)(lg + ch), g1 = *(const f32x4*)(lg + ch + 4), e0 = *(const f32x4*)(lb + ch), e1 = *(const f32x4*)(lb + ch + 4);
    const float gg[8] = {g0.x, g0.y, g0.z, g0.w, g1.x, g1.y, g1.z, g1.w}, be[8] = {e0.x, e0.y, e0.z, e0.w, e1.x, e1.y, e1.z, e1.w};
#pragma unroll
    for (int d = 0; d < 4; ++d) {
        float s = 0.f;
#pragma unroll
        for (int j = 0; j < 8; ++j) s += acc[d][j];
        const float mu = wave_sum(s) * (1.0f / 512.0f);
        float vq = 0.f;
#pragma unroll
        for (int j = 0; j < 8; ++j) { acc[d][j] -= mu; vq += acc[d][j] * acc[d][j]; }
        const float rstd = rsqrt_(wave_sum(vq) * (1.0f / 512.0f) + EPS);
        float y[8];
#pragma unroll
        for (int j = 0; j < 8; ++j) { const float v = acc[d][j] * rstd * gg[j] + be[j]; y[j] = v * sigmoidf_(v); }
        u32x4 o; o.x = pk2(y[0], y[1]); o.y = pk2(y[2], y[3]); o.z = pk2(y[4], y[5]); o.w = pk2(y[6], y[7]);
        *(u32x4*)(u2 + (size_t)(tok0 + d) * DC + ch) = o;
    }
}
__device__ __forceinline__ void phase_B(const Ctx& c0, int l) {
    Ctx c = reopaque(c0);
    constexpr int NQ = MT * NH, NKV = MT * NH, NCV = T / 16;
    for (int it = c.vb; it < NQ + NKV + NCV; it += c.G) {
        if (it < NQ) phaseB_q_item(c, l, it / NH, it % NH);
        else if (it < NQ + NKV) phaseB_kv_item(c, l, (it - NQ) / NH, (it - NQ) % NH);
        else phaseB_conv_item(c, l, (it - NQ - NKV) * 4 + c.wave);
    }
}

constexpr int KROW = 208, VROW = 136, ATT_STAGE = 64 * KROW + 64 * VROW;
__device__ __forceinline__ void phase_C(const Ctx& c0, int l) {
    Ctx c = reopaque(c0);
    const bf16* Qb = WSP(bf16, WS_Q); const bf16* Kb = WSP(bf16, WS_K); const bf16* Vt = WSP(bf16, WS_VT); bf16* O = WSP(bf16, WS_O);
    unsigned* qctr = WSP(unsigned, WS_CTL) + CW_QUEUE + 64 * l;
    volatile unsigned* misc = (volatile unsigned*)(c.lds + LDS_MISC);
    const int tid = c.tid, wave = c.wave, lane = c.lane, r = lane & 15, q = lane >> 4;
    unsigned char* lds = c.lds;
    for (;;) {
        if (tid == 0) misc[4] = atomicAdd(qctr, 1u);
        __syncthreads();
        const int item = (int)misc[4];
        __syncthreads();
        if (item >= NB * NH * 33) break;
        const int ch = 32 - item / 64, bh = item % 64, b = bh / NH, h = bh % NH;
        const int r0 = ch == 0 ? 0 : 16 + 64 * (ch - 1);
        const bool active = ch > 0 || wave == 0;
        const int ntiles = ch + 1;
        const bf16* Kbase = Kb + (size_t)bh * L * QK; const bf16* Vbase = Vt + (size_t)bh * VD * L;
        bf16x8 qf[3];
#pragma unroll
        for (int ks = 0; ks < 3; ++ks) qf[ks] = *(const bf16x8*)(Qb + ((size_t)bh * L + r0 + 16 * wave + r) * QK + 32 * ks + 8 * q);
        float m = -1e30f, lsum = 0.f;
        f32x4 o[4];
#pragma unroll
        for (int dt = 0; dt < 4; ++dt) o[dt] = (f32x4){0.f, 0.f, 0.f, 0.f};
        u32x4 rk[3], rv[2];
        auto gload = [&](int kt) {
#pragma unroll
            for (int i = 0; i < 3; ++i) { const int id = tid + 256 * i, row = id / 12, cc = id % 12; rk[i] = *(const u32x4*)(Kbase + (size_t)(kt * 64 + row) * QK + cc * 8); }
#pragma unroll
            for (int i = 0; i < 2; ++i) { const int id = tid + 256 * i, row = id >> 3, cc = id & 7; rv[i] = *(const u32x4*)(Vbase + (size_t)row * L + kt * 64 + cc * 8); }
        };
        auto lstore = [&](int s) {
            unsigned char* st = lds + s * ATT_STAGE;
#pragma unroll
            for (int i = 0; i < 3; ++i) { const int id = tid + 256 * i, row = id / 12, cc = id % 12; *(u32x4*)(st + row * KROW + cc * 16) = rk[i]; }
#pragma unroll
            for (int i = 0; i < 2; ++i) { const int id = tid + 256 * i, row = id >> 3, cc = id & 7; u32x2* d = (u32x2*)(st + 64 * KROW + row * VROW + cc * 16); d[0] = (u32x2){rv[i].x, rv[i].y}; d[1] = (u32x2){rv[i].z, rv[i].w}; }
        };
        gload(0); lstore(0);
        __syncthreads();
        for (int kt = 0; kt < ntiles; ++kt) {
            const int cur = kt & 1;
            if (kt + 1 < ntiles) gload(kt + 1);
            const unsigned char* sK = lds + cur * ATT_STAGE; const unsigned char* sV = sK + 64 * KROW;
            const bool full = kt < ch;
            f32x4 s[4];
#pragma unroll
            for (int k4 = 0; k4 < 4; ++k4) {
                s[k4] = (f32x4){0.f, 0.f, 0.f, 0.f};
                if (k4 == 0 || full) {
#pragma unroll
                    for (int ks = 0; ks < 3; ++ks) { const bf16x8 kf = *(const bf16x8*)(sK + (16 * k4 + r) * KROW + 64 * ks + 16 * q);
                        s[k4] = __builtin_amdgcn_mfma_f32_16x16x32_bf16(kf, qf[ks], s[k4], 0, 0, 0); }
                }
            }
            float mx = fmaxf(fmaxf(s[0].x, s[0].y), fmaxf(s[0].z, s[0].w));
            if (full) {
#pragma unroll
                for (int k4 = 1; k4 < 4; ++k4) mx = fmaxf(mx, fmaxf(fmaxf(s[k4].x, s[k4].y), fmaxf(s[k4].z, s[k4].w)));
            }
            mx = quad_max(mx);
            const float mn = fmaxf(m, mx), alpha = fast_exp2(m - mn); m = mn;
            float ps = 0.f;
#pragma unroll
            for (int k4 = 0; k4 < 4; ++k4) {
                if (k4 == 0 || full) { f32x4 p; p.x = fast_exp2(s[k4].x - mn); p.y = fast_exp2(s[k4].y - mn); p.z = fast_exp2(s[k4].z - mn); p.w = fast_exp2(s[k4].w - mn);
                    ps += (p.x + p.y) + (p.z + p.w); s[k4] = p; }
            }
            lsum = lsum * alpha + ps;
#pragma unroll
            for (int dt = 0; dt < 4; ++dt) o[dt] = o[dt] * alpha;
#pragma unroll
            for (int st = 0; st < 2; ++st) {
                if (st == 0 || full) {
                    u32x4 pw; pw.x = pk2(s[2 * st].x, s[2 * st].y); pw.y = pk2(s[2 * st].z, s[2 * st].w); pw.z = pk2(s[2 * st + 1].x, s[2 * st + 1].y); pw.w = pk2(s[2 * st + 1].z, s[2 * st + 1].w);
                    if (!full) { pw.z = 0u; pw.w = 0u; }
                    const bf16x8 pf = __builtin_bit_cast(bf16x8, pw);
#pragma unroll
                    for (int dt = 0; dt < 4; ++dt) {
                        const unsigned char* vp = sV + (16 * dt + r) * VROW + (32 * st + 4 * q) * 2;
                        const u32x2 v0 = *(const u32x2*)vp; u32x2 v1 = (u32x2){0u, 0u};
                        if (full) v1 = *(const u32x2*)(vp + 32);
                        const u32x4 vw = (u32x4){v0.x, v0.y, v1.x, v1.y};
                        o[dt] = __builtin_amdgcn_mfma_f32_16x16x32_bf16(__builtin_bit_cast(bf16x8, vw), pf, o[dt], 0, 0, 0);
                    }
                }
            }
            if (kt + 1 < ntiles) lstore(cur ^ 1);
            __syncthreads();
        }
        lsum = quad_sum(lsum);
        if (active) {
            const float inv = 1.0f / lsum;
            bf16* dst = O + ((size_t)b * L + r0 + 16 * wave + r) * 512 + h * VD;
#pragma unroll
            for (int dt = 0; dt < 4; ++dt) { const f32x4 v = o[dt] * inv; u32x2 ov; ov.x = pk2(v.x, v.y); ov.y = pk2(v.z, v.w); *(u32x2*)(dst + 16 * dt + 4 * q) = ov; }
        }
    }
}

__device__ __forceinline__ void phase_D(const Ctx& c0, int l) {
    Ctx c = reopaque(c0);
    const bf16* u2 = WSP(bf16, WS_U2); const bf16* O = WSP(bf16, WS_O); const bf16* gates = WSP(bf16, WS_GATES); bf16* merged = WSP(bf16, WS_MERGED);
    const bf16* Wco = (const bf16*)(c.ws + WS_WIN + l * SZ_WLAYER + OFF_WCO); const bf16* Wmla = (const bf16*)(c.ws + WS_WIN + l * SZ_WLAYER + OFF_WMLA);
    const int r = c.lane & 15, q = c.lane >> 4;
    for (int it = c.vb; it < MT * 8; it += c.G) {
        const int mt = it / 8, nt = it % 8;
        f32x4 acc[2][8]; acc_zero(acc);
        gemm_core(acc, u2 + (size_t)mt * 128 * 512, 512, Wco + (size_t)nt * 128 * 512, 512, 512, c.lds, c.tid);
#pragma unroll
        for (int mi = 0; mi < 2; ++mi) { const int tok = mt * 128 + 32 * c.wave + 16 * mi + r;
            const bf16* gp = gates + (size_t)tok * 2048 + nt * 128 + 4 * q; bf16* mp = merged + (size_t)tok * D + nt * 128 + 4 * q;
#pragma unroll
            for (int ni = 0; ni < 8; ++ni) { const u32x2 g = *(const u32x2*)(gp + 16 * ni); const f32x4 v = acc[mi][ni];
                u32x2 o; o.x = pk2(v.x * bf_lo(g.x), v.y * bf_hi(g.x)); o.y = pk2(v.z * bf_lo(g.y), v.w * bf_hi(g.y)); *(u32x2*)(mp + 16 * ni) = o; } }
        acc_zero(acc);
        gemm_core(acc, O + (size_t)mt * 128 * 512, 512, Wmla + (size_t)nt * 128 * 512, 512, 512, c.lds, c.tid);
#pragma unroll
        for (int mi = 0; mi < 2; ++mi) { const int tok = mt * 128 + 32 * c.wave + 16 * mi + r;
            const bf16* gp = gates + (size_t)tok * 2048 + 1024 + nt * 128 + 4 * q; bf16* mp = merged + (size_t)tok * D + nt * 128 + 4 * q;
#pragma unroll
            for (int ni = 0; ni < 8; ++ni) { const u32x2 g = *(const u32x2*)(gp + 16 * ni); const u32x2 s = *(const u32x2*)(mp + 16 * ni); const f32x4 v = acc[mi][ni];
                u32x2 o; o.x = pk2(bf_lo(s.x) + v.x * bf_lo(g.x), bf_hi(s.x) + v.y * bf_hi(g.x)); o.y = pk2(bf_lo(s.y) + v.z * bf_lo(g.y), bf_hi(s.y) + v.w * bf_hi(g.y));
                *(u32x2*)(mp + 16 * ni) = o; } }
    }
}

__device__ __forceinline__ void phase_E(const Ctx& c0, int l) {
    Ctx c = reopaque(c0);
    const bf16* merged = WSP(bf16, WS_MERGED); const bf16* Wout = (const bf16*)(c.ws + WS_WIN + l * SZ_WLAYER + OFF_WOUT);
    float* h = WSP(float, WS_H); bf16* hb = WSP(bf16, WS_HB); float* ssq = WSP(float, WS_SSQ);
    const int r = c.lane & 15, q = c.lane >> 4;
    for (int it = c.vb; it < MT * 8; it += c.G) {
        const int mt = it / 8, nt = it % 8;
        f32x4 acc[2][8]; acc_zero(acc);
        gemm_core(acc, merged + (size_t)mt * 128 * D, D, Wout + (size_t)nt * 128 * D, D, D, c.lds, c.tid);
#pragma unroll
        for (int mi = 0; mi < 2; ++mi) { const int tok = mt * 128 + 32 * c.wave + 16 * mi + r; float ss = 0.f;
#pragma unroll
            for (int ni = 0; ni < 8; ++ni) { float* hp = h + (size_t)tok * D + nt * 128 + 16 * ni + 4 * q; const f32x4 v = *(const f32x4*)hp + acc[mi][ni]; *(f32x4*)hp = v;
                ss += (v.x * v.x + v.y * v.y) + (v.z * v.z + v.w * v.w);
                u32x2 o; o.x = pk2(v.x, v.y); o.y = pk2(v.z, v.w); *(u32x2*)(hb + (size_t)tok * D + nt * 128 + 16 * ni + 4 * q) = o; }
            ss = quad_sum(ss);
            if (q == 0) ssq[(size_t)tok * 8 + nt] = ss; }
    }
}

__device__ __forceinline__ unsigned f2key(float f) { const unsigned u = __float_as_uint(f); return u ^ ((u >> 31) ? 0xFFFFFFFFu : 0x80000000u); }
__device__ __forceinline__ float key2f(unsigned k) { const unsigned u = (k >> 31) ? (k ^ 0x80000000u) : ~k; return __uint_as_float(u); }
__device__ __forceinline__ void top16_insert(unsigned (&lst)[16], unsigned x) {
#pragma unroll
    for (int i = 0; i < 16; ++i) { const unsigned a = lst[i]; lst[i] = a > x ? a : x; x = a > x ? x : a; }
}
__device__ __forceinline__ void phase_F(const Ctx& c0, int l) {
    Ctx c = reopaque(c0);
    const bf16* hb = WSP(bf16, WS_HB); const bf16* Wpq = (const bf16*)(c.ws + WS_WIN + l * SZ_WLAYER + OFF_WPQ); const bf16* keys = (const bf16*)(c.ws + WS_WIN + l * SZ_WLAYER + OFF_KEYS);
    const float* ssq = WSP(float, WS_SSQ); float* sv = WSP(float, WS_SV); unsigned char* si = WSP(unsigned char, WS_SI);
    const int tid = c.tid, wave = c.wave, lane = c.lane, r = lane & 15, q = lane >> 4;
    unsigned char* lds = c.lds;
    for (int it = c.vb; it < MT * 16; it += c.G) {
        const int mt = it / 16, hp = it % 16;
        f32x4 acc[2][8]; acc_zero(acc);
        gemm_core(acc, hb + (size_t)mt * 128 * D, D, Wpq + (size_t)hp * 128 * D, D, D, lds, tid);
#pragma unroll
        for (int mi = 0; mi < 2; ++mi) { const int row = 32 * wave + 16 * mi + r; const float rs = rstd_from_ssq8(ssq, mt * 128 + row);
#pragma unroll
            for (int ni = 0; ni < 8; ++ni) { const f32x4 v = acc[mi][ni] * rs; u32x2 o; o.x = pk2(v.x, v.y); o.y = pk2(v.z, v.w);
                *(u32x2*)(lds + (ni >> 2) * 32768 + lds_off(row, 2 * (ni & 3) + (q >> 1)) + 8 * (q & 1)) = o; } }
        { const int chunk = tid & 7, row0 = tid >> 3; const bf16* pb = keys + ((size_t)hp * 128 + row0) * 128 + chunk * 8;
#pragma unroll
          for (int s = 0; s < 2; ++s)
#pragma unroll
              for (int i = 0; i < 4; ++i) *(u32x4*)(lds + s * 32768 + 16384 + lds_off(row0 + 32 * i, chunk)) = *(const u32x4*)(pb + (size_t)(32 * i) * 128 + s * 64); }
        __syncthreads();
        acc_zero(acc);
        gemm_compute_stage(acc, lds, lds + 16384, wave, lane);
        gemm_compute_stage(acc, lds + 32768, lds + 32768 + 16384, wave, lane);
        __syncthreads();
        float* S = (float*)lds;
#pragma unroll
        for (int mi = 0; mi < 2; ++mi) { const int row = 32 * wave + 16 * mi + r;
#pragma unroll
            for (int ni = 0; ni < 8; ++ni) *(f32x4*)(S + row * 132 + 16 * ni + 4 * q) = acc[mi][ni]; }
        __syncthreads();
        if (tid < 128) {
            unsigned lst[16];
#pragma unroll
            for (int i = 0; i < 16; ++i) lst[i] = 0u;
            const float* row = S + tid * 132;
#pragma unroll 4
            for (int j = 0; j < 32; ++j) { const f32x4 v = *(const f32x4*)(row + 4 * j);
                top16_insert(lst, (f2key(v.x) & ~127u) | (unsigned)(127 - (4 * j)));
                top16_insert(lst, (f2key(v.y) & ~127u) | (unsigned)(127 - (4 * j + 1)));
                top16_insert(lst, (f2key(v.z) & ~127u) | (unsigned)(127 - (4 * j + 2)));
                top16_insert(lst, (f2key(v.w) & ~127u) | (unsigned)(127 - (4 * j + 3))); }
            const int tok = mt * 128 + tid;
            unsigned idx[16]; float val[16];
#pragma unroll
            for (int i = 0; i < 16; ++i) { idx[i] = 127u - (lst[i] & 127u); val[i] = row[idx[i]]; }
            float* svp = sv + ((size_t)tok * 16 + hp) * 16;
#pragma unroll
            for (int i = 0; i < 4; ++i) *(f32x4*)(svp + 4 * i) = (f32x4){val[4 * i], val[4 * i + 1], val[4 * i + 2], val[4 * i + 3]};
            u32x4 pi;
            pi.x = idx[0] | (idx[1] << 8) | (idx[2] << 16) | (idx[3] << 24); pi.y = idx[4] | (idx[5] << 8) | (idx[6] << 16) | (idx[7] << 24);
            pi.z = idx[8] | (idx[9] << 8) | (idx[10] << 16) | (idx[11] << 24); pi.w = idx[12] | (idx[13] << 8) | (idx[14] << 16) | (idx[15] << 24);
            *(u32x4*)(si + ((size_t)tok * 16 + hp) * 16) = pi;
        }
        __syncthreads();
    }
}

__device__ __forceinline__ void phase_F3(const Ctx& c0, int l) {
    Ctx c = reopaque(c0);
    const float* sv = WSP(float, WS_SV); const unsigned char* si = WSP(unsigned char, WS_SI); int* eidx = WSP(int, WS_EIDX); float* gw = WSP(float, WS_GW); unsigned char* stb = WSP(unsigned char, WS_STB);
    float* lsv = (float*)c.lds;
    unsigned char* lsi = c.lds + 256 * 33 * 4;
    const int tid = c.tid;
    for (int base = c.vb * NTHREADS; base < T * 8; base += c.G * NTHREADS) {
        const int th = base + tid;
        float a[16], b[16];
#pragma unroll
        for (int i = 0; i < 4; ++i) { const f32x4 x = *(const f32x4*)(sv + (size_t)th * 32 + 4 * i), y = *(const f32x4*)(sv + (size_t)th * 32 + 16 + 4 * i);
            a[4 * i] = x.x; a[4 * i + 1] = x.y; a[4 * i + 2] = x.z; a[4 * i + 3] = x.w; b[4 * i] = y.x; b[4 * i + 1] = y.y; b[4 * i + 2] = y.z; b[4 * i + 3] = y.w; }
        const u32x4 ia = *(const u32x4*)(si + (size_t)th * 32), ib = *(const u32x4*)(si + (size_t)th * 32 + 16);
#pragma unroll
        for (int i = 0; i < 16; ++i) { lsv[tid * 33 + i] = a[i]; lsv[tid * 33 + 16 + i] = b[i]; }
        *(u32x4*)(lsi + tid * 32) = ia; *(u32x4*)(lsi + tid * 32 + 16) = ib;
        unsigned lst[16];
#pragma unroll
        for (int i = 0; i < 16; ++i) lst[i] = 0u;
#pragma unroll
        for (int i = 0; i < 16; ++i)
#pragma unroll
            for (int j = 0; j < 16; ++j)
                if ((i + 1) * (j + 1) <= 16) top16_insert(lst, (f2key(a[i] + b[j]) & ~255u) | (unsigned)(255 - (i * 16 + j)));
        __builtin_amdgcn_s_waitcnt(0xC07F); asm volatile("" ::: "memory");
        float s[16]; int e[16];
#pragma unroll
        for (int k = 0; k < 16; ++k) { const unsigned code = 255u - (lst[k] & 255u); const int i = code >> 4, j = code & 15;
            s[k] = lsv[tid * 33 + i] + lsv[tid * 33 + 16 + j]; e[k] = (int)lsi[tid * 32 + i] * 128 + (int)lsi[tid * 32 + 16 + j]; }
        float mx = s[0];
#pragma unroll
        for (int k = 1; k < 16; ++k) mx = fmaxf(mx, s[k]);
        float sum = 0.f;
#pragma unroll
        for (int k = 0; k < 16; ++k) { s[k] = fast_exp2((s[k] - mx) * 1.4426950409f); sum += s[k]; }
        const float inv = 1.0f / sum;
        typedef unsigned long long u64;
        u64 hlo = 0ull, hhi = 0ull;
#pragma unroll
        for (int k = 0; k < 16; ++k) { const int sl = e[k] >> 10; if (sl < 8) hlo += 1ull << (8 * sl); else hhi += 1ull << (8 * (sl - 8)); }
        u64 ilo = hlo, ihi = hhi;
#pragma unroll
        for (int d = 1; d < 8; d <<= 1) { const u64 a_ = __shfl_up(ilo, d, 8), b_ = __shfl_up(ihi, d, 8); if ((tid & 7) >= d) { ilo += a_; ihi += b_; } }
        const u64 tlo = __shfl(ilo, 7, 8), thi = __shfl(ihi, 7, 8);
        const u64 ones = 0x0101010101010101ull;
        const u64 inlo = tlo * ones, inhi = thi * ones + (inlo >> 56) * ones;
        const u64 stlo = inlo - tlo, sthi = inhi - thi;
        u64 rlo = stlo + (ilo - hlo), rhi = sthi + (ihi - hhi);
        const int tokn = th >> 3;
#pragma unroll
        for (int k = 0; k < 16; ++k) { const int sl = e[k] >> 10; int pos;
            if (sl < 8) { pos = (int)((rlo >> (8 * sl)) & 255ull); rlo += 1ull << (8 * sl); } else { pos = (int)((rhi >> (8 * (sl - 8))) & 255ull); rhi += 1ull << (8 * (sl - 8)); }
            eidx[(size_t)tokn * 128 + pos] = e[k]; gw[(size_t)tokn * 128 + pos] = s[k] * inv; }
        if ((tid & 7) == 0) { u64* sp = (u64*)(stb + (size_t)tokn * 16); sp[0] = stlo; sp[1] = sthi; }
        __builtin_amdgcn_s_waitcnt(0xC07F); asm volatile("" ::: "memory");
    }
}

typedef float f32x2 __attribute__((ext_vector_type(2)));
constexpr int G2_WSTRIDE = 14336, G2_MAXTOK = 9;
__device__ __forceinline__ float fp8dot4(unsigned w, unsigned x01, unsigned x23, float acc) {
    const bf16x2 lo = __builtin_amdgcn_cvt_scalef32_pk_bf16_fp8(w, 1.0f, false), hi = __builtin_amdgcn_cvt_scalef32_pk_bf16_fp8(w, 1.0f, true);
    acc = __builtin_amdgcn_fdot2_f32_bf16(lo, __builtin_bit_cast(bf16x2, x01), acc, false);
    return __builtin_amdgcn_fdot2_f32_bf16(hi, __builtin_bit_cast(bf16x2, x23), acc, false);
}
__device__ __forceinline__ float reduce8_transposed(const float (&p)[8], int lane) {
    float s[4];
#pragma unroll
    for (int k = 0; k < 4; ++k) { auto r = __builtin_amdgcn_permlane32_swap(__float_as_uint(p[k]), __float_as_uint(p[k + 4]), false, false); s[k] = __uint_as_float(r[0]) + __uint_as_float(r[1]); }
    float t[2];
#pragma unroll
    for (int k = 0; k < 2; ++k) { auto r = __builtin_amdgcn_permlane16_swap(__float_as_uint(s[k]), __float_as_uint(s[k + 2]), false, false); t[k] = __uint_as_float(r[0]) + __uint_as_float(r[1]); }
    const float u0 = t[0] + dpp<0x128>(t[0]), u1 = t[1] + dpp<0x128>(t[1]);
    float r = (lane & 8) ? u1 : u0;
    r += dpp<0xB1>(r); r += dpp<0x4E>(r); r += dpp<0x141>(r);
    return r;
}
__device__ __forceinline__ void g2_u_group(const unsigned char* U, const int* pe_l, const float* pw_l, float* act_l, int b0, int b1, const u32x4 xa, const u32x4 xb, float rs, int lane) {
    for (int i = b0; i < b1; i += 8) {
        u32x4 u[8];
#pragma unroll
        for (int k = 0; k < 8; ++k) if (i + k < b1) { const int e = __builtin_amdgcn_readfirstlane(pe_l[i + k]); u[k] = *(const u32x4*)(U + (size_t)e * 1024 + lane * 16); }
        float p[8];
#pragma unroll
        for (int k = 0; k < 8; ++k) { p[k] = 0.f; if (i + k < b1) {
            float d0 = fp8dot4(u[k].x, xa.x, xa.y, 0.f), d1 = fp8dot4(u[k].y, xa.z, xa.w, 0.f); d0 = fp8dot4(u[k].z, xb.x, xb.y, d0); d1 = fp8dot4(u[k].w, xb.z, xb.w, d1); p[k] = d0 + d1; } }
        const float a = reduce8_transposed(p, lane);
        const int row = i + ((lane >> 3) & 7);
        if (row < b1 && (lane & 7) == 0) act_l[row] = gelu_tanh(a * rs) * pw_l[row];
    }
}
__device__ __forceinline__ void fp8fma4(f32x2 (&acc)[8], int o, unsigned w, f32x2 a2) {
    const f32x2 lo = __builtin_amdgcn_cvt_scalef32_pk_f32_fp8(w, 1.0f, false), hi = __builtin_amdgcn_cvt_scalef32_pk_f32_fp8(w, 1.0f, true);
    acc[o] = __builtin_elementwise_fma(a2, lo, acc[o]); acc[o + 1] = __builtin_elementwise_fma(a2, hi, acc[o + 1]);
}
__device__ __forceinline__ void g2_v_group(const unsigned char* V, const int* pe_l, const float* act_l, int b0, int b1, f32x2 (&acc)[8], int lane) {
    for (int i = b0; i < b1; i += 8) {
        u32x4 v[8]; float a[8];
#pragma unroll
        for (int k = 0; k < 8; ++k) if (i + k < b1) { const int e = __builtin_amdgcn_readfirstlane(pe_l[i + k]); a[k] = act_l[i + k]; v[k] = *(const u32x4*)(V + (size_t)e * 1024 + lane * 16); }
#pragma unroll
        for (int k = 0; k < 8; ++k) if (i + k < b1) { const f32x2 a2 = (f32x2){a[k], a[k]}; fp8fma4(acc, 0, v[k].x, a2); fp8fma4(acc, 2, v[k].y, a2); fp8fma4(acc, 4, v[k].z, a2); fp8fma4(acc, 6, v[k].w, a2); }
    }
}
__device__ __forceinline__ void phase_G2(const Ctx& c0, int l) {
    Ctx c = reopaque(c0);
    const bf16* hb = WSP(bf16, WS_HB); const float* ssq = WSP(float, WS_SSQ); const int* pe = WSP(int, WS_EIDX); const float* pw = WSP(float, WS_GW); const unsigned char* stb = WSP(unsigned char, WS_STB);
    const unsigned char* U = c.ws + WS_TAB + (size_t)(l * 2) * SZ_TAB; const unsigned char* V = c.ws + WS_TAB + (size_t)(l * 2 + 1) * SZ_TAB;
    float* h = WSP(float, WS_H); bf16* hbw = WSP(bf16, WS_HB); float* ssqw = WSP(float, WS_SSQ);
    const int lane = c.lane;
    const int NW = c.G * 4, gw = c.vb * 4 + c.wave, base_t = T / NW, rem = T % NW;
    const int t0 = gw * base_t + (gw < rem ? gw : rem), nt = base_t + (gw < rem ? 1 : 0);
    unsigned char* wl = c.lds + c.wave * G2_WSTRIDE;
    int* pe_l = (int*)wl; float* pw_l = (float*)(wl + 4608); float* act_l = (float*)(wl + 9216); unsigned char* stb_l = wl + 13824;
    {
        u32x4 xa[G2_MAXTOK], xb[G2_MAXTOK]; float rs[G2_MAXTOK];
#pragma unroll
        for (int j = 0; j < G2_MAXTOK; ++j) { const int tok = t0 + (j < nt ? j : 0);
            pe_l[j * 128 + lane] = pe[(size_t)tok * 128 + lane]; pe_l[j * 128 + 64 + lane] = pe[(size_t)tok * 128 + 64 + lane];
            pw_l[j * 128 + lane] = pw[(size_t)tok * 128 + lane] * TAB_INV; pw_l[j * 128 + 64 + lane] = pw[(size_t)tok * 128 + 64 + lane] * TAB_INV;
            if (lane < 4) ((unsigned*)(stb_l + j * 32))[lane] = ((const unsigned*)(stb + (size_t)tok * 16))[lane];
            if (lane == 4) ((unsigned*)(stb_l + j * 32))[4] = 128u;
            xa[j] = *(const u32x4*)(hb + (size_t)tok * D + lane * 16); xb[j] = *(const u32x4*)(hb + (size_t)tok * D + lane * 16 + 8); rs[j] = rstd_from_ssq8(ssq, tok) * TAB_INV; }
#pragma unroll 1
        for (int s = 0; s < 16; ++s) {
#pragma unroll
            for (int j = 0; j < G2_MAXTOK; ++j) if (j < nt) {
                const int b0 = __builtin_amdgcn_readfirstlane((int)stb_l[j * 32 + s]), b1 = __builtin_amdgcn_readfirstlane((int)stb_l[j * 32 + s + 1]);
                g2_u_group(U, pe_l + j * 128, pw_l + j * 128, act_l + j * 128, b0, b1, xa[j], xb[j], rs[j], lane); }
        }
    }
    f32x2 acc[G2_MAXTOK][8];
#pragma unroll
    for (int j = 0; j < G2_MAXTOK; ++j)
#pragma unroll
        for (int i = 0; i < 8; ++i) acc[j][i] = (f32x2){0.f, 0.f};
#pragma unroll 1
    for (int s = 0; s < 16; ++s) {
#pragma unroll
        for (int j = 0; j < G2_MAXTOK; ++j) if (j < nt) {
            const int b0 = __builtin_amdgcn_readfirstlane((int)stb_l[j * 32 + s]), b1 = __builtin_amdgcn_readfirstlane((int)stb_l[j * 32 + s + 1]);
            g2_v_group(V, pe_l + j * 128, act_l + j * 128, b0, b1, acc[j], lane); }
    }
#pragma unroll
    for (int j = 0; j < G2_MAXTOK; ++j) if (j < nt) {
        const int tok = t0 + j;
        float* hp = h + (size_t)tok * D + lane * 16;
        f32x4 r0 = *(const f32x4*)hp, r1 = *(const f32x4*)(hp + 4), r2 = *(const f32x4*)(hp + 8), r3 = *(const f32x4*)(hp + 12);
        r0 += (f32x4){acc[j][0].x, acc[j][0].y, acc[j][1].x, acc[j][1].y}; r1 += (f32x4){acc[j][2].x, acc[j][2].y, acc[j][3].x, acc[j][3].y};
        r2 += (f32x4){acc[j][4].x, acc[j][4].y, acc[j][5].x, acc[j][5].y}; r3 += (f32x4){acc[j][6].x, acc[j][6].y, acc[j][7].x, acc[j][7].y};
        if (l == 0) {
            *(f32x4*)hp = r0; *(f32x4*)(hp + 4) = r1; *(f32x4*)(hp + 8) = r2; *(f32x4*)(hp + 12) = r3;
            u32x4 o0, o1; o0.x = pk2(r0.x, r0.y); o0.y = pk2(r0.z, r0.w); o0.z = pk2(r1.x, r1.y); o0.w = pk2(r1.z, r1.w);
            o1.x = pk2(r2.x, r2.y); o1.y = pk2(r2.z, r2.w); o1.z = pk2(r3.x, r3.y); o1.w = pk2(r3.z, r3.w);
            *(u32x4*)(hbw + (size_t)tok * D + lane * 16) = o0; *(u32x4*)(hbw + (size_t)tok * D + lane * 16 + 8) = o1;
            float ss = (r0.x * r0.x + r0.y * r0.y) + (r0.z * r0.z + r0.w * r0.w) + (r1.x * r1.x + r1.y * r1.y) + (r1.z * r1.z + r1.w * r1.w)
                     + (r2.x * r2.x + r2.y * r2.y) + (r2.z * r2.z + r2.w * r2.w) + (r3.x * r3.x + r3.y * r3.y) + (r3.z * r3.z + r3.w * r3.w);
            ss = wave_sum_dpp(ss);
            if (lane < 8) ssqw[(size_t)tok * 8 + lane] = lane == 0 ? ss : 0.f;
        } else {
            const int b = tok / L, pos = tok - b * L;
            if (pos >= NMETA) { float* op = c.out + ((size_t)b * SEQ + (pos - NMETA)) * D + lane * 16;
                *(f32x4*)op = r0; *(f32x4*)(op + 4) = r1; *(f32x4*)(op + 8) = r2; *(f32x4*)(op + 12) = r3; }
        }
    }
}

struct Args { const float* in[22]; float* out; unsigned char* ws; int ph_lo, ph_hi; };
constexpr int N_PHASES = 17;

__global__ void __launch_bounds__(NTHREADS, 2) fwd_kernel(Args args) {
    extern __shared__ __attribute__((aligned(16))) unsigned char lds_raw[];
    Ctx c;
#pragma unroll
    for (int i = 0; i < 22; ++i) c.in[i] = args.in[i];
    c.out = args.out; c.ws = args.ws; c.lds = lds_raw;
    c.tid = threadIdx.x; c.lane = c.tid & 63; c.wave = __builtin_amdgcn_readfirstlane(c.tid >> 6);
    c.G = gridDim.x; { const int bx = blockIdx.x; c.vb = (c.G % 8 == 0) ? (bx % 8) * (c.G / 8) + bx / 8 : bx; }
    volatile unsigned* misc = (volatile unsigned*)(c.lds + LDS_MISC);
    if (c.tid < 16) misc[c.tid] = 0u;
    __syncthreads();
    const int lo = args.ph_lo, hi = args.ph_hi;
    const bool multi = (hi - lo) > 1;
    XcdBarrier bar; bar.bar = WSP(unsigned, WS_CTL) + CW_BAR; bar.x = 0; bar.st = misc;
    if (multi) bar = xcd_barrier_post(WSP(unsigned, WS_CTL) + CW_BAR, misc);
#define IN_(k) (lo <= (k) && (k) < hi)
#define SEAM_(k) do { if ((k) + 1 < hi) xcd_barrier(bar); } while (0)
    if (IN_(0)) { phase_prologue(c); SEAM_(0); }
#pragma unroll 1
    for (int l = 0; l < 2; ++l) {
        const int p0 = 1 + 8 * l;
        if (IN_(p0 + 0)) { phase_A(c, l); SEAM_(p0 + 0); }
        if (IN_(p0 + 1)) { phase_B(c, l); SEAM_(p0 + 1); }
        if (IN_(p0 + 2)) { phase_C(c, l); SEAM_(p0 + 2); }
        if (IN_(p0 + 3)) { phase_D(c, l); SEAM_(p0 + 3); }
        if (IN_(p0 + 4)) { phase_E(c, l); SEAM_(p0 + 4); }
        if (IN_(p0 + 5)) { phase_F(c, l); SEAM_(p0 + 5); }
        if (IN_(p0 + 6)) { phase_F3(c, l); SEAM_(p0 + 6); }
        if (IN_(p0 + 7)) { phase_G2(c, l); SEAM_(p0 + 7); }
    }
}

extern "C" void kernel_launch(void* const* d_in, const int* in_sizes, int n_in, void* d_out, int out_size, void* d_ws, size_t ws_size, hipStream_t stream) {
    static int grid = 0;
    if (grid == 0) {
        if (n_in != 22 || out_size != NB * SEQ * D || ws_size < WS_END) { fprintf(stderr, "kernel_launch: unexpected shapes (n_in %d out %d ws %zu need %zu)\n", n_in, out_size, ws_size, (size_t)WS_END); grid = -1; return; }
        int dev = 0, cus = 0, per_cu = 0;
        hipGetDevice(&dev); hipDeviceGetAttribute(&cus, hipDeviceAttributeMultiprocessorCount, dev);
        if (hipFuncSetAttribute((const void*)fwd_kernel, hipFuncAttributeMaxDynamicSharedMemorySize, LDS_BYTES) != hipSuccess) { fprintf(stderr, "kernel_launch: hipFuncSetAttribute failed\n"); grid = -1; return; }
        if (hipOccupancyMaxActiveBlocksPerMultiprocessor(&per_cu, (const void*)fwd_kernel, NTHREADS, LDS_BYTES) != hipSuccess || per_cu < 1) { fprintf(stderr, "kernel_launch: occupancy query failed (%d)\n", per_cu); per_cu = 1; (void)hipGetLastError(); }
        if (per_cu > 2) per_cu = 2;
        grid = cus * per_cu;
        if ((long)grid * 4 * G2_MAXTOK < T || (long)grid * 4 * (G2_MAXTOK - 1) > T) { fprintf(stderr, "kernel_launch: grid %d unsupported by phase G2 (needs 8..9 tokens per wave)\n", grid); grid = -1; return; }
        fprintf(stderr, "kernel_launch: grid %d (%d per CU), lds %d, ws need %zu have %zu\n", grid, per_cu, LDS_BYTES, (size_t)WS_END, ws_size);
    }
    if (grid < 0) return;
    hipMemsetAsync((char*)d_ws + WS_CTL, 0, CTL_BYTES, stream);
    Args a{};
    for (int i = 0; i < 22; ++i) a.in[i] = (const float*)d_in[i];
    a.out = (float*)d_out; a.ws = (unsigned char*)d_ws;
#if MK_PER_PHASE
    for (int ph = 0; ph < N_PHASES; ++ph) { a.ph_lo = ph; a.ph_hi = ph + 1; hipLaunchKernelGGL(fwd_kernel, dim3(grid), dim3(NTHREADS), LDS_BYTES, stream, a); }
#else
    a.ph_lo = 0; a.ph_hi = N_PHASES;
    void* kargs[] = {&a};
    hipError_t e = hipLaunchCooperativeKernel((const void*)fwd_kernel, dim3(grid), dim3(NTHREADS), kargs, LDS_BYTES, stream);
    if (e != hipSuccess) fprintf(stderr, "kernel_launch: cooperative launch failed: %s (grid %d)\n", hipGetErrorString(e), grid);
#endif
}
```

```cpp
#include <hip/hip_runtime.h>
#include <cstdio>
#include <cstdint>

#ifndef MK_PER_PHASE
#define MK_PER_PHASE 0
#endif

typedef unsigned short bf16;
typedef short bf16x8 __attribute__((ext_vector_type(8)));
typedef float f32x4 __attribute__((ext_vector_type(4)));
typedef unsigned u32x4 __attribute__((ext_vector_type(4)));
typedef unsigned u32x2 __attribute__((ext_vector_type(2)));
typedef __bf16 bf16x2 __attribute__((ext_vector_type(2)));

constexpr int NB = 8, SEQ = 2048, NMETA = 16, L = SEQ + NMETA, T = NB * L, D = 1024;
constexpr int DC = 512, CW = 31, NH = 8, QL = 256, KVL = 128, NOPE = 64, ROPE = 32, QK = 96, VD = 64;
constexpr int NIN = 3488, NINP = 3584;
constexpr int NEXP = 16384;
constexpr float EPS = 1e-6f;
constexpr int MT = T / 128;
static_assert(T % 128 == 0, "T tiles");

constexpr size_t al256(size_t x) { return (x + 255) & ~(size_t)255; }
constexpr size_t WS_CTL = 0;
constexpr size_t CTL_BYTES = 65536;
constexpr size_t WS_ROPE = WS_CTL + CTL_BYTES;
constexpr size_t WS_WIN = al256(WS_ROPE + (size_t)L * 16 * 8);
constexpr size_t SZ_WIN = (size_t)NINP * 1024 * 2, SZ_WCO = (size_t)1024 * 512 * 2, SZ_WUQ = (size_t)1024 * 256 * 2, SZ_WUKV = (size_t)1024 * 128 * 2,
                 SZ_WMLA = (size_t)1024 * 512 * 2, SZ_WOUT = (size_t)1024 * 1024 * 2, SZ_WPQ = (size_t)2048 * 1024 * 2, SZ_KEYS = (size_t)16 * 128 * 128 * 2;
constexpr size_t OFF_WCO = SZ_WIN, OFF_WUQ = OFF_WCO + SZ_WCO, OFF_WUKV = OFF_WUQ + SZ_WUQ, OFF_WMLA = OFF_WUKV + SZ_WUKV, OFF_WOUT = OFF_WMLA + SZ_WMLA,
                 OFF_WPQ = OFF_WOUT + SZ_WOUT, OFF_KEYS = OFF_WPQ + SZ_WPQ, SZ_WLAYER = OFF_KEYS + SZ_KEYS;
constexpr size_t WS_TAB = al256(WS_WIN + 2 * SZ_WLAYER);
constexpr size_t SZ_TAB = (size_t)NEXP * 1024;
constexpr float TAB_SCALE = 256.0f, TAB_INV = 1.0f / 256.0f;
constexpr size_t WS_H = al256(WS_TAB + 4 * SZ_TAB);
constexpr size_t WS_HB = al256(WS_H + (size_t)T * 1024 * 4);
constexpr size_t WS_SSQ = al256(WS_HB + (size_t)T * 1024 * 2);
constexpr size_t WS_UGLU = al256(WS_SSQ + (size_t)T * 8 * 4);
constexpr size_t WS_CQ = al256(WS_UGLU + (size_t)T * 512 * 2);
constexpr size_t WS_CKV = al256(WS_CQ + (size_t)T * 256 * 2);
constexpr size_t WS_KROPE = al256(WS_CKV + (size_t)T * 128 * 2);
constexpr size_t WS_SSQQ = al256(WS_KROPE + (size_t)T * 32 * 4);
constexpr size_t WS_SSQKV = al256(WS_SSQQ + (size_t)T * 2 * 4);
constexpr size_t WS_U2 = al256(WS_SSQKV + (size_t)T * 4);
constexpr size_t WS_Q = al256(WS_U2 + (size_t)T * 512 * 2);
constexpr size_t WS_K = al256(WS_Q + (size_t)T * NH * QK * 2);
constexpr size_t WS_VT = al256(WS_K + (size_t)T * NH * QK * 2);
constexpr size_t WS_O = al256(WS_VT + (size_t)T * NH * VD * 2 + 4096);
constexpr size_t WS_MERGED = al256(WS_O + (size_t)T * 512 * 2);
constexpr size_t WS_GATES = al256(WS_MERGED + (size_t)T * 1024 * 2);
constexpr size_t WS_SV = WS_GATES;
constexpr size_t WS_SI = al256(WS_SV + (size_t)T * 256 * 4);
constexpr size_t WS_EIDX = al256(WS_SI + (size_t)T * 256);
constexpr size_t WS_GW = al256(WS_EIDX + (size_t)T * 128 * 4);
constexpr size_t WS_STB = al256(WS_GW + (size_t)T * 128 * 4);
constexpr size_t WS_PEER_END = WS_STB + (size_t)T * 16;
constexpr size_t WS_END = al256(WS_GATES + (size_t)T * 2048 * 2);
static_assert(WS_PEER_END <= WS_END, "peer scratch overlay");

constexpr int CW_BAR = 0;
constexpr int CW_QUEUE = 4096;

constexpr int LDS_MAIN = 128 * 132 * 4;
constexpr int LDS_MISC = LDS_MAIN;
constexpr int LDS_BYTES = LDS_MAIN + 64;

constexpr int NTHREADS = 256;

__device__ __forceinline__ unsigned pk2(float lo, float hi) { bf16x2 v; v.x = (__bf16)lo; v.y = (__bf16)hi; return __builtin_bit_cast(unsigned, v); }
__device__ __forceinline__ float bf_lo(unsigned p) { return __uint_as_float(p << 16); }
__device__ __forceinline__ float bf_hi(unsigned p) { return __uint_as_float(p & 0xffff0000u); }
__device__ __forceinline__ float fast_rcp(float x) { return __builtin_amdgcn_rcpf(x); }
__device__ __forceinline__ float fast_exp2(float x) { return __builtin_amdgcn_exp2f(x); }
__device__ __forceinline__ float sigmoidf_(float x) { return fast_rcp(1.0f + fast_exp2(-1.4426950409f * x)); }
__device__ __forceinline__ float gelu_tanh(float x) { const float u = 1.5957691216f * (x + 0.044715f * x * x * x); return x * fast_rcp(1.0f + fast_exp2(-1.4426950409f * u)); }
__device__ __forceinline__ float rsqrt_(float x) { return __builtin_amdgcn_rsqf(x); }
__device__ __forceinline__ float quad_sum(float v) { v += __shfl_xor(v, 16); v += __shfl_xor(v, 32); return v; }
__device__ __forceinline__ float quad_max(float v) { v = fmaxf(v, __shfl_xor(v, 16)); v = fmaxf(v, __shfl_xor(v, 32)); return v; }
__device__ __forceinline__ float wave_sum(float v) {
#pragma unroll
    for (int o = 1; o < 64; o <<= 1) v += __shfl_xor(v, o);
    return v;
}
template <int CTRL> __device__ __forceinline__ float dpp(float x) { return __builtin_bit_cast(float, __builtin_amdgcn_mov_dpp(__builtin_bit_cast(int, x), CTRL, 0xf, 0xf, true)); }
__device__ __forceinline__ float xrow16_sum(float x) {
    auto s = __builtin_amdgcn_permlane16_swap(__float_as_uint(x), __float_as_uint(x), false, false);
    x = __uint_as_float(s[0]) + __uint_as_float(s[1]);
    auto t = __builtin_amdgcn_permlane32_swap(__float_as_uint(x), __float_as_uint(x), false, false);
    return __uint_as_float(t[0]) + __uint_as_float(t[1]);
}
__device__ __forceinline__ float wave_sum_dpp(float x) {
    x += dpp<0xB1>(x); x += dpp<0x4E>(x); x += dpp<0x141>(x); x += dpp<0x128>(x); return xrow16_sum(x);
}
__device__ __forceinline__ float dot2(unsigned a, unsigned b, float c) { return __builtin_amdgcn_fdot2_f32_bf16(__builtin_bit_cast(bf16x2, a), __builtin_bit_cast(bf16x2, b), c, false); }

#define XB_TMO      128
#define XB_XCNT(j)  (256  + 64 * (j))
#define XB_XSUB(j)  (1280 + 64 * (j))
#define XB_XGEN(j)  (2304 + 64 * (j))
#define XB_TOP      3328
#define XB_TOPGEN   3392
#define XCD_BAR_WORDS 3456
#define XB_SPIN_CAP (1u << 20)
__device__ __forceinline__ unsigned xb_ld(unsigned* p)              { return __hip_atomic_load(p, __ATOMIC_RELAXED, __HIP_MEMORY_SCOPE_AGENT); }
__device__ __forceinline__ unsigned xb_add(unsigned* p, unsigned v) { return __hip_atomic_fetch_add(p, v, __ATOMIC_RELAXED, __HIP_MEMORY_SCOPE_AGENT); }
__device__ __forceinline__ unsigned xb_xcc_id() { return (unsigned)__builtin_amdgcn_s_getreg((3 << 11) | 20) & 0xFu; }
#define XB_SPIN(cond, bar) do { unsigned _sp = 0; while (cond) { __builtin_amdgcn_s_sleep(1); \
    if ((++_sp & 255u) == 0u) { if (xb_ld(&(bar)[XB_TMO])) break; if (_sp > XB_SPIN_CAP) { atomicAdd(&(bar)[XB_TMO], 1u); break; } } } } while (0)
struct XcdBarrier { unsigned* bar; unsigned x; volatile unsigned* st; };
__device__ __forceinline__ XcdBarrier xcd_barrier_post(unsigned* bar, volatile unsigned* st) {
    XcdBarrier b; b.bar = bar; b.x = xb_xcc_id(); b.st = st;
    if (threadIdx.x == 0) (void)xb_add(&bar[XB_XCNT(b.x)], 1u);
    return b;
}
__device__ __forceinline__ void xcd_barrier_complete(unsigned* bar, unsigned x, unsigned& nloc, unsigned& nx) {
    const unsigned G = gridDim.x * gridDim.y * gridDim.z;
    unsigned sum, cnt, mine, sp = 0u;
    for (;;) {
        sum = 0u; cnt = 0u; mine = 0u;
#pragma unroll
        for (unsigned j = 0; j < 16; ++j) { const unsigned c = xb_ld(&bar[XB_XCNT(j)]); sum += c; cnt += (c > 0u) ? 1u : 0u; mine = (j == x) ? c : mine; }
        if (sum == G) break;
        __builtin_amdgcn_s_sleep(1);
        if ((++sp & 255u) == 0u) { if (xb_ld(&bar[XB_TMO])) break; if (sp > XB_SPIN_CAP) { atomicAdd(&bar[XB_TMO], 1u); break; } }
    }
    nloc = mine > 0u ? mine : 1u; nx = cnt > 0u ? cnt : 1u;
}
__device__ __forceinline__ void xcd_barrier(const XcdBarrier& b) {
    asm volatile("s_waitcnt vmcnt(0)" ::: "memory");
    __syncthreads();
    if (threadIdx.x == 0) {
        unsigned* bar = b.bar;
        __builtin_amdgcn_s_waitcnt(0);
        unsigned nloc = b.st[0], nx = b.st[1];
        if (nloc == 0u) { xcd_barrier_complete(bar, b.x, nloc, nx); b.st[0] = nloc; b.st[1] = nx; }
        const unsigned old = xb_add(&bar[XB_XSUB(b.x)], 1u);
        const unsigned gen = old / nloc;
        if (old + 1u == (gen + 1u) * nloc) {
            __builtin_amdgcn_fence(__ATOMIC_RELEASE, "agent");
            asm volatile("s_waitcnt vmcnt(0)" ::: "memory");
            const unsigned og = xb_add(&bar[XB_TOP], 1u);
            const unsigned tg = og / nx;
            if (og + 1u == (tg + 1u) * nx) xb_add(&bar[XB_TOPGEN], 1u);
            else XB_SPIN(xb_ld(&bar[XB_TOPGEN]) == tg, bar);
            __builtin_amdgcn_fence(__ATOMIC_ACQUIRE, "agent");
            xb_add(&bar[XB_XGEN(b.x)], 1u);
            asm volatile("s_waitcnt vmcnt(0)" ::: "memory");
        } else {
            XB_SPIN(xb_ld(&bar[XB_XGEN(b.x)]) == gen, bar);
            __builtin_amdgcn_fence(__ATOMIC_ACQUIRE, "agent");
            asm volatile("s_waitcnt vmcnt(0)" ::: "memory");
        }
    }
    __syncthreads();
}

struct Ctx {
    const float* in[22]; float* out; unsigned char* ws;
    unsigned char* lds; int tid, lane, wave, G, vb;
};
#define WSP(T_, off) ((T_*)(c.ws + (off)))
__device__ __forceinline__ Ctx reopaque(const Ctx& c0) {
    Ctx c = c0; int t = c0.tid; asm volatile("" : "+v"(t)); c.tid = t; c.lane = t & 63; c.wave = __builtin_amdgcn_readfirstlane(t >> 6);
    int vb = c0.vb; asm volatile("" : "+s"(vb)); c.vb = vb; return c;
}

__device__ __forceinline__ int lds_off(int row, int chunk) { return row * 128 + ((chunk ^ (row & 7)) << 4); }

__device__ __forceinline__ void gemm_compute_stage(f32x4 (&acc)[2][8], const unsigned char* sA, const unsigned char* sB, int wave, int lane) {
    const int r = lane & 15, q = lane >> 4;
#pragma unroll
    for (int ks = 0; ks < 2; ++ks) {
        bf16x8 af[2], bfr[8];
#pragma unroll
        for (int mi = 0; mi < 2; ++mi) af[mi] = *(const bf16x8*)(sA + lds_off(32 * wave + 16 * mi + r, 4 * ks + q));
#pragma unroll
        for (int ni = 0; ni < 8; ++ni) bfr[ni] = *(const bf16x8*)(sB + lds_off(16 * ni + r, 4 * ks + q));
#pragma unroll
        for (int mi = 0; mi < 2; ++mi)
#pragma unroll
            for (int ni = 0; ni < 8; ++ni) acc[mi][ni] = __builtin_amdgcn_mfma_f32_16x16x32_bf16(bfr[ni], af[mi], acc[mi][ni], 0, 0, 0);
    }
}

__device__ __forceinline__ void gemm_core(f32x4 (&acc)[2][8], const bf16* A, int lda, const bf16* Bt, int ldb, int K, unsigned char* lds, int tid) {
    const int wave = __builtin_amdgcn_readfirstlane(tid >> 6), lane = tid & 63;
    const int chunk = tid & 7, row0 = tid >> 3;
    const int nk = K >> 6;
    u32x4 ra[4], rb[4];
    const bf16* pa = A + (size_t)row0 * lda + chunk * 8;
    const bf16* pb = Bt + (size_t)row0 * ldb + chunk * 8;
#pragma unroll
    for (int i = 0; i < 4; ++i) { ra[i] = *(const u32x4*)(pa + (size_t)(32 * i) * lda); rb[i] = *(const u32x4*)(pb + (size_t)(32 * i) * ldb); }
#pragma unroll
    for (int i = 0; i < 4; ++i) { *(u32x4*)(lds + lds_off(row0 + 32 * i, chunk)) = ra[i]; *(u32x4*)(lds + 16384 + lds_off(row0 + 32 * i, chunk)) = rb[i]; }
    __syncthreads();
    for (int kt = 0; kt < nk; ++kt) {
        const int cur = kt & 1;
        if (kt + 1 < nk) {
#pragma unroll
            for (int i = 0; i < 4; ++i) { ra[i] = *(const u32x4*)(pa + (size_t)(32 * i) * lda + (kt + 1) * 64); rb[i] = *(const u32x4*)(pb + (size_t)(32 * i) * ldb + (kt + 1) * 64); }
        }
        gemm_compute_stage(acc, lds + cur * 32768, lds + cur * 32768 + 16384, wave, lane);
        if (kt + 1 < nk) {
            unsigned char* st = lds + (cur ^ 1) * 32768;
#pragma unroll
            for (int i = 0; i < 4; ++i) { *(u32x4*)(st + lds_off(row0 + 32 * i, chunk)) = ra[i]; *(u32x4*)(st + 16384 + lds_off(row0 + 32 * i, chunk)) = rb[i]; }
        }
        __syncthreads();
    }
}
__device__ __forceinline__ void acc_zero(f32x4 (&acc)[2][8]) {
#pragma unroll
    for (int mi = 0; mi < 2; ++mi)
#pragma unroll
        for (int ni = 0; ni < 8; ++ni) acc[mi][ni] = (f32x4){0.f, 0.f, 0.f, 0.f};
}
__device__ __forceinline__ float rstd_from_ssq8(const float* ssq, int tok) {
    const f32x4 a = *(const f32x4*)(ssq + (size_t)tok * 8), b = *(const f32x4*)(ssq + (size_t)tok * 8 + 4);
    const float s = ((a.x + a.y) + (a.z + a.w)) + ((b.x + b.y) + (b.z + b.w));
    return rsqrt_(s * (1.0f / 1024.0f) + EPS);
}

__device__ __forceinline__ int src_col(int mode, int np) {
    if (mode == 0) return np;
    if (mode == 2) { const int h = np >> 7, j = np & 127; return j < 96 ? h * 96 + j : -1; }
    if (np < 1024) { const int cblk = np >> 7, j = np & 127; return j < 64 ? 64 * cblk + j : 512 + 64 * cblk + (j - 64); }
    if (np < 1408) return np;
    if (np < 1536) { const int j = np - 1408; return j < 32 ? 1408 + j : -1; }
    return 1440 + (np - 1536);
}
__device__ __forceinline__ void p0_transpose_item(const float* W, int K, int N, bf16* Wt, int mode, const float* g, int item, float* scr, int lane) {
    const int nblk_k = K / 64, nb = item / nblk_k, kb = item % nblk_k, k0 = 64 * kb, n0 = 32 * nb;
    const int n = src_col(mode, n0 + (lane & 31));
#pragma unroll 8
    for (int i = 0; i < 32; ++i) { const int kk = 2 * i + (lane >> 5); float v = 0.f; if (n >= 0) { v = W[(size_t)(k0 + kk) * N + n]; if (g) v *= g[k0 + kk]; } scr[kk * 33 + (lane & 31)] = v; }
    __builtin_amdgcn_s_waitcnt(0xC07F); asm volatile("" ::: "memory");
    const int cch = lane & 7;
#pragma unroll
    for (int j = 0; j < 4; ++j) { const int nl = (lane >> 3) + 8 * j; const float* s = scr + (8 * cch) * 33 + nl;
        u32x4 o; o.x = pk2(s[0 * 33], s[1 * 33]); o.y = pk2(s[2 * 33], s[3 * 33]); o.z = pk2(s[4 * 33], s[5 * 33]); o.w = pk2(s[6 * 33], s[7 * 33]);
        *(u32x4*)(Wt + (size_t)(n0 + nl) * K + k0 + 8 * cch) = o; }
    __builtin_amdgcn_s_waitcnt(0xC07F); asm volatile("" ::: "memory");
}
struct WDesc { int in_idx, K, N, Np, mode, g_idx; size_t off; };
__device__ __forceinline__ void phase_prologue(const Ctx& c0) {
    Ctx c = reopaque(c0);
    const int gw = c.vb * 4 + c.wave, NGW = c.G * 4;
    float* scr = (float*)(c.lds + c.wave * 8704);
    const WDesc wd[7] = {
        {3, 1024, NIN, NINP, 1, 2, 0}, {8, 512, 1024, 1024, 0, -1, OFF_WCO}, {10, 256, 768, 1024, 2, 9, OFF_WUQ}, {12, 128, 1024, 1024, 0, 11, OFF_WUKV},
        {15, 512, 1024, 1024, 0, -1, OFF_WMLA}, {16, 1024, 1024, 1024, 0, -1, OFF_WOUT}, {18, 1024, 2048, 2048, 0, 17, OFF_WPQ}};
    for (int l = 0; l < 2; ++l)
#pragma unroll
        for (int m = 0; m < 7; ++m) {
            const int K = wd[m].K, N = wd[m].N, Np = wd[m].Np;
            const float* W = c.in[wd[m].in_idx] + (size_t)l * K * N;
            const float* g = wd[m].g_idx >= 0 ? c.in[wd[m].g_idx] + (size_t)l * K : nullptr;
            bf16* Wt = (bf16*)(c.ws + WS_WIN + l * SZ_WLAYER + wd[m].off);
            const int items = (K / 64) * (Np / 32);
            for (int it = gw; it < items; it += NGW) p0_transpose_item(W, K, N, Wt, wd[m].mode, g, it, scr, c.lane);
        }
    const int gt = c.vb * NTHREADS + c.tid, NGT = c.G * NTHREADS;
    for (int l = 0; l < 2; ++l) {
        const float* src = c.in[19] + (size_t)l * 262144; bf16* dst = (bf16*)(c.ws + WS_WIN + l * SZ_WLAYER + OFF_KEYS);
        for (int i = gt; i < 262144 / 8; i += NGT) { const f32x4 a = *(const f32x4*)(src + i * 8), b = *(const f32x4*)(src + i * 8 + 4);
            u32x4 o; o.x = pk2(a.x, a.y); o.y = pk2(a.z, a.w); o.z = pk2(b.x, b.y); o.w = pk2(b.z, b.w); *(u32x4*)(dst + i * 8) = o; }
    }
    for (int l = 0; l < 2; ++l)
        for (int uv = 0; uv < 2; ++uv) {
            const float* src = c.in[20 + uv] + (size_t)l * NEXP * 1024; unsigned char* dst = c.ws + WS_TAB + (size_t)(l * 2 + uv) * SZ_TAB;
            const float* g = c.in[17] + l * 1024;
            for (int i = gt; i < NEXP * 1024 / 16; i += NGT) {
                const float* sp = src + (size_t)i * 16;
                f32x4 a0 = *(const f32x4*)sp, a1 = *(const f32x4*)(sp + 4), a2 = *(const f32x4*)(sp + 8), a3 = *(const f32x4*)(sp + 12);
                if (uv == 0) { const float* gp = g + (i & 63) * 16; a0 = a0 * *(const f32x4*)gp; a1 = a1 * *(const f32x4*)(gp + 4); a2 = a2 * *(const f32x4*)(gp + 8); a3 = a3 * *(const f32x4*)(gp + 12); }
                a0 = a0 * TAB_SCALE; a1 = a1 * TAB_SCALE; a2 = a2 * TAB_SCALE; a3 = a3 * TAB_SCALE;
                u32x4 o;
                o.x = (unsigned)__builtin_amdgcn_cvt_pk_fp8_f32(a0.z, a0.w, __builtin_amdgcn_cvt_pk_fp8_f32(a0.x, a0.y, 0, false), true);
                o.y = (unsigned)__builtin_amdgcn_cvt_pk_fp8_f32(a1.z, a1.w, __builtin_amdgcn_cvt_pk_fp8_f32(a1.x, a1.y, 0, false), true);
                o.z = (unsigned)__builtin_amdgcn_cvt_pk_fp8_f32(a2.z, a2.w, __builtin_amdgcn_cvt_pk_fp8_f32(a2.x, a2.y, 0, false), true);
                o.w = (unsigned)__builtin_amdgcn_cvt_pk_fp8_f32(a3.z, a3.w, __builtin_amdgcn_cvt_pk_fp8_f32(a3.x, a3.y, 0, false), true);
                *(u32x4*)(dst + (size_t)i * 16) = o; }
        }
    { float* rope = WSP(float, WS_ROPE);
      for (int i = gt; i < L * 16; i += NGT) { const int pos = i >> 4, j = i & 15;
          const float inv = 1.0f / __builtin_exp2f((float)j * 0.8304820237218406f);
          const float angf = (float)pos * inv; const double ang = (double)angf;
          const double nq = __builtin_rint(ang * 0.63661977236758134308);
          double rr = __builtin_fma(-nq, 1.57079632679489655800e+00, ang); rr = __builtin_fma(-nq, 6.12323399573676603587e-17, rr);
          const double r2 = rr * rr;
          double sp = -1.0 / 1307674368000.0; sp = sp * r2 + 1.0 / 6227020800.0; sp = sp * r2 - 1.0 / 39916800.0; sp = sp * r2 + 1.0 / 362880.0; sp = sp * r2 - 1.0 / 5040.0; sp = sp * r2 + 1.0 / 120.0; sp = sp * r2 - 1.0 / 6.0; sp = sp * r2 * rr + rr;
          double cp = 1.0 / 87178291200.0; cp = cp * r2 - 1.0 / 479001600.0; cp = cp * r2 + 1.0 / 3628800.0; cp = cp * r2 - 1.0 / 40320.0; cp = cp * r2 + 1.0 / 720.0; cp = cp * r2 - 1.0 / 24.0; cp = cp * r2 + 0.5; cp = 1.0 - cp * r2;
          const int qd = ((int)nq) & 3;
          const double cv = qd == 0 ? cp : qd == 1 ? -sp : qd == 2 ? -cp : sp;
          const double sv_ = qd == 0 ? sp : qd == 1 ? cp : qd == 2 ? -sp : -cp;
          rope[2 * i] = (float)cv; rope[2 * i + 1] = (float)sv_; } }
    { float* h = WSP(float, WS_H); bf16* hb = WSP(bf16, WS_HB); float* ssq = WSP(float, WS_SSQ);
      for (int t = gw; t < T; t += NGW) { const int b = t / L, pos = t % L;
          const float* src = pos < NMETA ? c.in[1] + (size_t)pos * D : c.in[0] + ((size_t)b * SEQ + (pos - NMETA)) * D;
          float s = 0.f;
#pragma unroll
          for (int j = 0; j < 4; ++j) { const f32x4 v = *(const f32x4*)(src + j * 256 + c.lane * 4); *(f32x4*)(h + (size_t)t * D + j * 256 + c.lane * 4) = v;
              u32x2 o; o.x = pk2(v.x, v.y); o.y = pk2(v.z, v.w); *(u32x2*)(hb + (size_t)t * D + j * 256 + c.lane * 4) = o; s += (v.x * v.x + v.y * v.y) + (v.z * v.z + v.w * v.w); }
          s = wave_sum(s);
          if (c.lane < 8) ssq[(size_t)t * 8 + c.lane] = c.lane == 0 ? s : 0.f; } }
}

__device__ __forceinline__ void phase_A(const Ctx& c0, int l) {
    Ctx c = reopaque(c0);
    const bf16* hb = WSP(bf16, WS_HB); const bf16* Wt = (const bf16*)(c.ws + WS_WIN + l * SZ_WLAYER);
    const float* ssq = WSP(float, WS_SSQ);
    bf16* uglu = WSP(bf16, WS_UGLU); bf16* cq = WSP(bf16, WS_CQ); bf16* ckv = WSP(bf16, WS_CKV); float* krope = WSP(float, WS_KROPE);
    float* ssqq = WSP(float, WS_SSQQ); float* ssqkv = WSP(float, WS_SSQKV); bf16* gates = WSP(bf16, WS_GATES);
    constexpr int NT = NINP / 128;
    const int r = c.lane & 15, q = c.lane >> 4;
    for (int it = c.vb; it < MT * NT; it += c.G) {
        const int mt = it / NT, nt = it % NT;
        f32x4 acc[2][8]; acc_zero(acc);
        gemm_core(acc, hb + (size_t)mt * 128 * D, D, Wt + (size_t)nt * 128 * D, D, D, c.lds, c.tid);
#pragma unroll
        for (int mi = 0; mi < 2; ++mi) {
            const int tok = mt * 128 + 32 * c.wave + 16 * mi + r;
            const float rs = rstd_from_ssq8(ssq, tok);
            if (nt < 8) {
#pragma unroll
                for (int ni = 0; ni < 4; ++ni) { const f32x4 v = acc[mi][ni] * rs, g = acc[mi][ni + 4] * rs;
                    u32x2 o; o.x = pk2(v.x * sigmoidf_(g.x), v.y * sigmoidf_(g.y)); o.y = pk2(v.z * sigmoidf_(g.z), v.w * sigmoidf_(g.w));
                    *(u32x2*)(uglu + (size_t)tok * DC + nt * 64 + 16 * ni + 4 * q) = o; }
            } else if (nt < 11) {
                bf16* dst = nt < 10 ? cq + (size_t)tok * QL + (nt - 8) * 128 : ckv + (size_t)tok * KVL;
                float ss = 0.f;
#pragma unroll
                for (int ni = 0; ni < 8; ++ni) { const f32x4 v = acc[mi][ni] * rs; ss += (v.x * v.x + v.y * v.y) + (v.z * v.z + v.w * v.w);
                    u32x2 o; o.x = pk2(v.x, v.y); o.y = pk2(v.z, v.w); *(u32x2*)(dst + 16 * ni + 4 * q) = o; }
                ss = quad_sum(ss);
                if (q == 0) { if (nt < 10) ssqq[(size_t)tok * 2 + (nt - 8)] = ss; else ssqkv[tok] = ss; }
            } else if (nt == 11) {
#pragma unroll
                for (int ni = 0; ni < 2; ++ni) *(f32x4*)(krope + (size_t)tok * 32 + 16 * ni + 4 * q) = acc[mi][ni] * rs;
            } else {
#pragma unroll
                for (int ni = 0; ni < 8; ++ni) { const f32x4 v = acc[mi][ni] * rs;
                    u32x2 o; o.x = pk2(sigmoidf_(v.x), sigmoidf_(v.y)); o.y = pk2(sigmoidf_(v.z), sigmoidf_(v.w));
                    *(u32x2*)(gates + (size_t)tok * 2048 + (nt - 12) * 128 + 16 * ni + 4 * q) = o; }
            }
        }
    }
}

__device__ __forceinline__ void phaseB_q_item(Ctx& c, int l, int mt, int head) {
    const bf16* cq = WSP(bf16, WS_CQ); const bf16* Wt = (const bf16*)(c.ws + WS_WIN + l * SZ_WLAYER + OFF_WUQ);
    const float* ssqq = WSP(float, WS_SSQQ); const float* rope = WSP(float, WS_ROPE); const float* qg = c.in[13] + l * QK; bf16* Qb = WSP(bf16, WS_Q);
    const int r = c.lane & 15, q = c.lane >> 4;
    f32x4 acc[2][8]; acc_zero(acc);
    gemm_core(acc, cq + (size_t)mt * 128 * QL, QL, Wt + (size_t)head * 128 * QL, QL, QL, c.lds, c.tid);
    constexpr float QSCALE = 0.10206207261596575f * 1.4426950408889634f;
#pragma unroll
    for (int mi = 0; mi < 2; ++mi) {
        const int tok = mt * 128 + 32 * c.wave + 16 * mi + r, b = tok / L, pos = tok - b * L;
        const float rs = rsqrt_((ssqq[(size_t)tok * 2] + ssqq[(size_t)tok * 2 + 1]) * (1.0f / 256.0f) + EPS);
        float ss = 0.f;
#pragma unroll
        for (int ni = 0; ni < 6; ++ni) { acc[mi][ni] = acc[mi][ni] * rs; const f32x4 v = acc[mi][ni]; ss += (v.x * v.x + v.y * v.y) + (v.z * v.z + v.w * v.w); }
        ss = quad_sum(ss);
        const float rn = rsqrt_(ss * (1.0f / 96.0f) + EPS) * QSCALE;
#pragma unroll
        for (int ni = 0; ni < 6; ++ni) { const f32x4 g = *(const f32x4*)(qg + 16 * ni + 4 * q); acc[mi][ni] = acc[mi][ni] * g * rn; }
        const f32x4 cs0 = *(const f32x4*)(rope + ((size_t)pos * 16 + 4 * q) * 2), cs1 = *(const f32x4*)(rope + ((size_t)pos * 16 + 4 * q) * 2 + 4);
        const float co[4] = {cs0.x, cs0.z, cs1.x, cs1.z}, si[4] = {cs0.y, cs0.w, cs1.y, cs1.w};
        f32x4 x1 = acc[mi][4], x2 = acc[mi][5];
#pragma unroll
        for (int e = 0; e < 4; ++e) { const float a = x1[e], bb = x2[e]; x1[e] = a * co[e] - bb * si[e]; x2[e] = bb * co[e] + a * si[e]; }
        acc[mi][4] = x1; acc[mi][5] = x2;
        bf16* dst = Qb + (((size_t)b * NH + head) * L + pos) * QK;
#pragma unroll
        for (int ni = 0; ni < 6; ++ni) { const f32x4 v = acc[mi][ni]; u32x2 o; o.x = pk2(v.x, v.y); o.y = pk2(v.z, v.w); *(u32x2*)(dst + 16 * ni + 4 * q) = o; }
    }
}
__device__ __forceinline__ void phaseB_kv_item(Ctx& c, int l, int mt, int head) {
    const bf16* ckv = WSP(bf16, WS_CKV); const bf16* Wt = (const bf16*)(c.ws + WS_WIN + l * SZ_WLAYER + OFF_WUKV);
    const float* ssqkv = WSP(float, WS_SSQKV); const float* rope = WSP(float, WS_ROPE); const float* kg = c.in[14] + l * QK; const float* krope = WSP(float, WS_KROPE);
    bf16* Kb = WSP(bf16, WS_K); bf16* Vt = WSP(bf16, WS_VT);
    const int tid = c.tid, wave = c.wave, lane = c.lane, r = lane & 15, q = lane >> 4;
    unsigned char* lds = c.lds;
    f32x4 ak[2][4], av[2][4];
#pragma unroll
    for (int mi = 0; mi < 2; ++mi)
#pragma unroll
        for (int ni = 0; ni < 4; ++ni) { ak[mi][ni] = (f32x4){0.f, 0.f, 0.f, 0.f}; av[mi][ni] = (f32x4){0.f, 0.f, 0.f, 0.f}; }
    { const int chunk = tid & 7, row0 = tid >> 3;
      const bf16* pa = ckv + ((size_t)mt * 128 + row0) * KVL + chunk * 8; const bf16* pb = Wt + ((size_t)head * 128 + row0) * KVL + chunk * 8;
#pragma unroll
      for (int s = 0; s < 2; ++s)
#pragma unroll
          for (int i = 0; i < 4; ++i) { *(u32x4*)(lds + s * 32768 + lds_off(row0 + 32 * i, chunk)) = *(const u32x4*)(pa + (size_t)(32 * i) * KVL + s * 64);
              *(u32x4*)(lds + s * 32768 + 16384 + lds_off(row0 + 32 * i, chunk)) = *(const u32x4*)(pb + (size_t)(32 * i) * KVL + s * 64); }
    }
    __syncthreads();
#pragma unroll
    for (int s = 0; s < 2; ++s)
#pragma unroll
        for (int ks = 0; ks < 2; ++ks) {
            const unsigned char* sA = lds + s * 32768; const unsigned char* sB = sA + 16384;
            bf16x8 af[2], bfr[8];
#pragma unroll
            for (int mi = 0; mi < 2; ++mi) af[mi] = *(const bf16x8*)(sA + lds_off(32 * wave + 16 * mi + r, 4 * ks + q));
#pragma unroll
            for (int ni = 0; ni < 8; ++ni) bfr[ni] = *(const bf16x8*)(sB + lds_off(16 * ni + r, 4 * ks + q));
#pragma unroll
            for (int mi = 0; mi < 2; ++mi)
#pragma unroll
                for (int ni = 0; ni < 4; ++ni) { ak[mi][ni] = __builtin_amdgcn_mfma_f32_16x16x32_bf16(bfr[ni], af[mi], ak[mi][ni], 0, 0, 0);
                    av[mi][ni] = __builtin_amdgcn_mfma_f32_16x16x32_bf16(af[mi], bfr[ni + 4], av[mi][ni], 0, 0, 0); }
        }
    __syncthreads();
#pragma unroll
    for (int mi = 0; mi < 2; ++mi) {
        const int tok0 = mt * 128 + 32 * wave + 16 * mi, b = tok0 / L, pos0 = tok0 - b * L;
        { const int tok = tok0 + r, pos = pos0 + r;
          const float rs = rsqrt_(ssqkv[tok] * (1.0f / 128.0f) + EPS);
          const f32x4 kr1 = *(const f32x4*)(krope + (size_t)tok * 32 + 4 * q), kr2 = *(const f32x4*)(krope + (size_t)tok * 32 + 16 + 4 * q);
          float ss = (kr1.x * kr1.x + kr1.y * kr1.y) + (kr1.z * kr1.z + kr1.w * kr1.w) + (kr2.x * kr2.x + kr2.y * kr2.y) + (kr2.z * kr2.z + kr2.w * kr2.w);
#pragma unroll
          for (int ni = 0; ni < 4; ++ni) { ak[mi][ni] = ak[mi][ni] * rs; const f32x4 v = ak[mi][ni]; ss += (v.x * v.x + v.y * v.y) + (v.z * v.z + v.w * v.w); }
          ss = quad_sum(ss);
          const float rn = rsqrt_(ss * (1.0f / 96.0f) + EPS);
          bf16* dst = Kb + (((size_t)b * NH + head) * L + pos) * QK;
#pragma unroll
          for (int ni = 0; ni < 4; ++ni) { const f32x4 g = *(const f32x4*)(kg + 16 * ni + 4 * q); const f32x4 v = ak[mi][ni] * g * rn;
              u32x2 o; o.x = pk2(v.x, v.y); o.y = pk2(v.z, v.w); *(u32x2*)(dst + 16 * ni + 4 * q) = o; }
          const f32x4 g1 = *(const f32x4*)(kg + 64 + 4 * q), g2 = *(const f32x4*)(kg + 80 + 4 * q);
          f32x4 x1 = kr1 * g1 * rn, x2 = kr2 * g2 * rn;
          const f32x4 cs0 = *(const f32x4*)(rope + ((size_t)pos * 16 + 4 * q) * 2), cs1 = *(const f32x4*)(rope + ((size_t)pos * 16 + 4 * q) * 2 + 4);
          const float co[4] = {cs0.x, cs0.z, cs1.x, cs1.z}, si[4] = {cs0.y, cs0.w, cs1.y, cs1.w};
#pragma unroll
          for (int e = 0; e < 4; ++e) { const float a = x1[e], bb = x2[e]; x1[e] = a * co[e] - bb * si[e]; x2[e] = bb * co[e] + a * si[e]; }
          u32x2 o1, o2; o1.x = pk2(x1.x, x1.y); o1.y = pk2(x1.z, x1.w); o2.x = pk2(x2.x, x2.y); o2.y = pk2(x2.z, x2.w);
          *(u32x2*)(dst + 64 + 4 * q) = o1; *(u32x2*)(dst + 80 + 4 * q) = o2; }
        { const f32x4 sq = *(const f32x4*)(ssqkv + tok0 + 4 * q);
          f32x4 rs4; rs4.x = rsqrt_(sq.x * (1.0f / 128.0f) + EPS); rs4.y = rsqrt_(sq.y * (1.0f / 128.0f) + EPS); rs4.z = rsqrt_(sq.z * (1.0f / 128.0f) + EPS); rs4.w = rsqrt_(sq.w * (1.0f / 128.0f) + EPS);
#pragma unroll
          for (int ni = 0; ni < 4; ++ni) { const f32x4 v = av[mi][ni] * rs4; u32x2 o; o.x = pk2(v.x, v.y); o.y = pk2(v.z, v.w);
              *(u32x2*)(Vt + (((size_t)b * NH + head) * VD + 16 * ni + r) * L + pos0 + 4 * q) = o; } }
    }
}
__device__ __forceinline__ u32x4 conv_row(const bf16* uglu, int b, int pos, int ch) {
    u32x4 xv = (u32x4){0u, 0u, 0u, 0u};
    if (pos >= 0) xv = *(const u32x4*)(uglu + ((size_t)b * L + pos) * DC + ch);
    return xv;
}
__device__ __forceinline__ void conv_fma(float (&a)[8], const u32x4 xv, const f32x4 w0, const f32x4 w1) {
    a[0] += bf_lo(xv.x) * w0.x; a[1] += bf_hi(xv.x) * w0.y; a[2] += bf_lo(xv.y) * w0.z; a[3] += bf_hi(xv.y) * w0.w;
    a[4] += bf_lo(xv.z) * w1.x; a[5] += bf_hi(xv.z) * w1.y; a[6] += bf_lo(xv.w) * w1.z; a[7] += bf_hi(xv.w) * w1.w;
}
__device__ __forceinline__ void phaseB_conv_item(Ctx& c, int l, int grp) {
    const bf16* uglu = WSP(bf16, WS_UGLU); bf16* u2 = WSP(bf16, WS_U2);
    const float* cw = c.in[4] + (size_t)l * CW * DC; const float* cb = c.in[5] + l * DC; const float* lg = c.in[6] + l * DC; const float* lb = c.in[7] + l * DC;
    const int tok0 = grp * 4, b = tok0 / L, pos0 = tok0 - b * L, ch = c.lane * 8;
    float acc[4][8];
    { const f32x4 b0 = *(const f32x4*)(cb + ch), b1 = *(const f32x4*)(cb + ch + 4);
#pragma unroll
      for (int d = 0; d < 4; ++d) { acc[d][0] = b0.x; acc[d][1] = b0.y; acc[d][2] = b0.z; acc[d][3] = b0.w; acc[d][4] = b1.x; acc[d][5] = b1.y; acc[d][6] = b1.z; acc[d][7] = b1.w; } }
    const int base = pos0 - 30;
    u32x4 x0 = conv_row(uglu, b, base + 0, ch), x1 = conv_row(uglu, b, base + 1, ch), x2 = conv_row(uglu, b, base + 2, ch),
          x3 = conv_row(uglu, b, base + 3, ch), x4 = conv_row(uglu, b, base + 4, ch), x5;
    const float* wp = cw + ch;
#pragma unroll 1
    for (int w = 0; w < CW; ++w) {
        x5 = conv_row(uglu, b, (w + 5 <= 33) ? base + w + 5 : -1, ch);
        const f32x4 w0 = *(const f32x4*)wp, w1 = *(const f32x4*)(wp + 4); wp += DC;
        conv_fma(acc[0], x0, w0, w1); conv_fma(acc[1], x1, w0, w1); conv_fma(acc[2], x2, w0, w1); conv_fma(acc[3], x3, w0, w1);
        x0 = x1; x1 = x2; x2 = x3; x3 = x4; x4 = x5;
    }
    const f32x4 g0 = *(const f32x4*)(lg + ch), g1 = *(const f32x4*)(lg + ch + 4), e0 = *(const f32x4*)(lb + ch), e1 = *(const f32x4*)(lb + ch + 4);
    const float gg[8] = {g0.x, g0.y, g0.z, g0.w, g1.x, g1.y, g1.z, g1.w}, be[8] = {e0.x, e0.y, e0.z, e0.w, e1.x, e1.y, e1.z, e1.w};
#pragma unroll
    for (int d = 0; d < 4; ++d) {
        float s = 0.f;
#pragma unroll
        for (int j = 0; j < 8; ++j) s += acc[d][j];
        const float mu = wave_sum(s) * (1.0f / 512.0f);
        float vq = 0.f;
#pragma unroll
        for (int j = 0; j < 8; ++j) { acc[d][j] -= mu; vq += acc[d][j] * acc[d][j]; }
        const float rstd = rsqrt_(wave_sum(vq) * (1.0f / 512.0f) + EPS);
        float y[8];
#pragma unroll
        for (int j = 0; j < 8; ++j) { const float v = acc[d][j] * rstd * gg[j] + be[j]; y[j] = v * sigmoidf_(v); }
        u32x4 o; o.x = pk2(y[0], y[1]); o.y = pk2(y[2], y[3]); o.z = pk2(y[4], y[5]); o.w = pk2(y[6], y[7]);
        *(u32x4*)(u2 + (size_t)(tok0 + d) * DC + ch) = o;
    }
}
__device__ __forceinline__ void phase_B(const Ctx& c0, int l) {
    Ctx c = reopaque(c0);
    constexpr int NQ = MT * NH, NKV = MT * NH, NCV = T / 16;
    for (int it = c.vb; it < NQ + NKV + NCV; it += c.G) {
        if (it < NQ) phaseB_q_item(c, l, it / NH, it % NH);
        else if (it < NQ + NKV) phaseB_kv_item(c, l, (it - NQ) / NH, (it - NQ) % NH);
        else phaseB_conv_item(c, l, (it - NQ - NKV) * 4 + c.wave);
    }
}

constexpr int KROW = 208, VROW = 136, ATT_STAGE = 64 * KROW + 64 * VROW;
__device__ __forceinline__ void phase_C(const Ctx& c0, int l) {
    Ctx c = reopaque(c0);
    const bf16* Qb = WSP(bf16, WS_Q); const bf16* Kb = WSP(bf16, WS_K); const bf16* Vt = WSP(bf16, WS_VT); bf16* O = WSP(bf16, WS_O);
    unsigned* qctr = WSP(unsigned, WS_CTL) + CW_QUEUE + 64 * l;
    volatile unsigned* misc = (volatile unsigned*)(c.lds + LDS_MISC);
    const int tid = c.tid, wave = c.wave, lane = c.lane, r = lane & 15, q = lane >> 4;
    unsigned char* lds = c.lds;
    for (;;) {
        if (tid == 0) misc[4] = atomicAdd(qctr, 1u);
        __syncthreads();
        const int item = (int)misc[4];
        __syncthreads();
        if (item >= NB * NH * 33) break;
        const int ch = 32 - item / 64, bh = item % 64, b = bh / NH, h = bh % NH;
        const int r0 = ch == 0 ? 0 : 16 + 64 * (ch - 1);
        const bool active = ch > 0 || wave == 0;
        const int ntiles = ch + 1;
        const bf16* Kbase = Kb + (size_t)bh * L * QK; const bf16* Vbase = Vt + (size_t)bh * VD * L;
        bf16x8 qf[3];
#pragma unroll
        for (int ks = 0; ks < 3; ++ks) qf[ks] = *(const bf16x8*)(Qb + ((size_t)bh * L + r0 + 16 * wave + r) * QK + 32 * ks + 8 * q);
        float m = -1e30f, lsum = 0.f;
        f32x4 o[4];
#pragma unroll
        for (int dt = 0; dt < 4; ++dt) o[dt] = (f32x4){0.f, 0.f, 0.f, 0.f};
        u32x4 rk[3], rv[2];
        auto gload = [&](int kt) {
#pragma unroll
            for (int i = 0; i < 3; ++i) { const int id = tid + 256 * i, row = id / 12, cc = id % 12; rk[i] = *(const u32x4*)(Kbase + (size_t)(kt * 64 + row) * QK + cc * 8); }
#pragma unroll
            for (int i = 0; i < 2; ++i) { const int id = tid + 256 * i, row = id >> 3, cc = id & 7; rv[i] = *(const u32x4*)(Vbase + (size_t)row * L + kt * 64 + cc * 8); }
        };
        auto lstore = [&](int s) {
            unsigned char* st = lds + s * ATT_STAGE;
#pragma unroll
            for (int i = 0; i < 3; ++i) { const int id = tid + 256 * i, row = id / 12, cc = id % 12; *(u32x4*)(st + row * KROW + cc * 16) = rk[i]; }
#pragma unroll
            for (int i = 0; i < 2; ++i) { const int id = tid + 256 * i, row = id >> 3, cc = id & 7; u32x2* d = (u32x2*)(st + 64 * KROW + row * VROW + cc * 16); d[0] = (u32x2){rv[i].x, rv[i].y}; d[1] = (u32x2){rv[i].z, rv[i].w}; }
        };
        gload(0); lstore(0);
        __syncthreads();
        for (int kt = 0; kt < ntiles; ++kt) {
            const int cur = kt & 1;
            if (kt + 1 < ntiles) gload(kt + 1);
            const unsigned char* sK = lds + cur * ATT_STAGE; const unsigned char* sV = sK + 64 * KROW;
            const bool full = kt < ch;
            f32x4 s[4];
#pragma unroll
            for (int k4 = 0; k4 < 4; ++k4) {
                s[k4] = (f32x4){0.f, 0.f, 0.f, 0.f};
                if (k4 == 0 || full) {
#pragma unroll
                    for (int ks = 0; ks < 3; ++ks) { const bf16x8 kf = *(const bf16x8*)(sK + (16 * k4 + r) * KROW + 64 * ks + 16 * q);
                        s[k4] = __builtin_amdgcn_mfma_f32_16x16x32_bf16(kf, qf[ks], s[k4], 0, 0, 0); }
                }
            }
            float mx = fmaxf(fmaxf(s[0].x, s[0].y), fmaxf(s[0].z, s[0].w));
            if (full) {
#pragma unroll
                for (int k4 = 1; k4 < 4; ++k4) mx = fmaxf(mx, fmaxf(fmaxf(s[k4].x, s[k4].y), fmaxf(s[k4].z, s[k4].w)));
            }
            mx = quad_max(mx);
            const float mn = fmaxf(m, mx), alpha = fast_exp2(m - mn); m = mn;
            float ps = 0.f;
#pragma unroll
            for (int k4 = 0; k4 < 4; ++k4) {
                if (k4 == 0 || full) { f32x4 p; p.x = fast_exp2(s[k4].x - mn); p.y = fast_exp2(s[k4].y - mn); p.z = fast_exp2(s[k4].z - mn); p.w = fast_exp2(s[k4].w - mn);
                    ps += (p.x + p.y) + (p.z + p.w); s[k4] = p; }
            }
            lsum = lsum * alpha + ps;
#pragma unroll
            for (int dt = 0; dt < 4; ++dt) o[dt] = o[dt] * alpha;
#pragma unroll
            for (int st = 0; st < 2; ++st) {
                if (st == 0 || full) {
                    u32x4 pw; pw.x = pk2(s[2 * st].x, s[2 * st].y); pw.y = pk2(s[2 * st].z, s[2 * st].w); pw.z = pk2(s[2 * st + 1].x, s[2 * st + 1].y); pw.w = pk2(s[2 * st + 1].z, s[2 * st + 1].w);
                    if (!full) { pw.z = 0u; pw.w = 0u; }
                    const bf16x8 pf = __builtin_bit_cast(bf16x8, pw);
#pragma unroll
                    for (int dt = 0; dt < 4; ++dt) {
                        const unsigned char* vp = sV + (16 * dt + r) * VROW + (32 * st + 4 * q) * 2;
                        const u32x2 v0 = *(const u32x2*)vp; u32x2 v1 = (u32x2){0u, 0u};
                        if (full) v1 = *(const u32x2*)(vp + 32);
                        const u32x4 vw = (u32x4){v0.x, v0.y, v1.x, v1.y};
                        o[dt] = __builtin_amdgcn_mfma_f32_16x16x32_bf16(__builtin_bit_cast(bf16x8, vw), pf, o[dt], 0, 0, 0);
                    }
                }
            }
            if (kt + 1 < ntiles) lstore(cur ^ 1);
            __syncthreads();
        }
        lsum = quad_sum(lsum);
        if (active) {
            const float inv = 1.0f / lsum;
            bf16* dst = O + ((size_t)b * L + r0 + 16 * wave + r) * 512 + h * VD;
#pragma unroll
            for (int dt = 0; dt < 4; ++dt) { const f32x4 v = o[dt] * inv; u32x2 ov; ov.x = pk2(v.x, v.y); ov.y = pk2(v.z, v.w); *(u32x2*)(dst + 16 * dt + 4 * q) = ov; }
        }
    }
}

__device__ __forceinline__ void phase_D(const Ctx& c0, int l) {
    Ctx c = reopaque(c0);
    const bf16* u2 = WSP(bf16, WS_U2); const bf16* O = WSP(bf16, WS_O); const bf16* gates = WSP(bf16, WS_GATES); bf16* merged = WSP(bf16, WS_MERGED);
    const bf16* Wco = (const bf16*)(c.ws + WS_WIN + l * SZ_WLAYER + OFF_WCO); const bf16* Wmla = (const bf16*)(c.ws + WS_WIN + l * SZ_WLAYER + OFF_WMLA);
    const int r = c.lane & 15, q = c.lane >> 4;
    for (int it = c.vb; it < MT * 8; it += c.G) {
        const int mt = it / 8, nt = it % 8;
        f32x4 acc[2][8]; acc_zero(acc);
        gemm_core(acc, u2 + (size_t)mt * 128 * 512, 512, Wco + (size_t)nt * 128 * 512, 512, 512, c.lds, c.tid);
#pragma unroll
        for (int mi = 0; mi < 2; ++mi) { const int tok = mt * 128 + 32 * c.wave + 16 * mi + r;
            const bf16* gp = gates + (size_t)tok * 2048 + nt * 128 + 4 * q; bf16* mp = merged + (size_t)tok * D + nt * 128 + 4 * q;
#pragma unroll
            for (int ni = 0; ni < 8; ++ni) { const u32x2 g = *(const u32x2*)(gp + 16 * ni); const f32x4 v = acc[mi][ni];
                u32x2 o; o.x = pk2(v.x * bf_lo(g.x), v.y * bf_hi(g.x)); o.y = pk2(v.z * bf_lo(g.y), v.w * bf_hi(g.y)); *(u32x2*)(mp + 16 * ni) = o; } }
        acc_zero(acc);
        gemm_core(acc, O + (size_t)mt * 128 * 512, 512, Wmla + (size_t)nt * 128 * 512, 512, 512, c.lds, c.tid);
#pragma unroll
        for (int mi = 0; mi < 2; ++mi) { const int tok = mt * 128 + 32 * c.wave + 16 * mi + r;
            const bf16* gp = gates + (size_t)tok * 2048 + 1024 + nt * 128 + 4 * q; bf16* mp = merged + (size_t)tok * D + nt * 128 + 4 * q;
#pragma unroll
            for (int ni = 0; ni < 8; ++ni) { const u32x2 g = *(const u32x2*)(gp + 16 * ni); const u32x2 s = *(const u32x2*)(mp + 16 * ni); const f32x4 v = acc[mi][ni];
                u32x2 o; o.x = pk2(bf_lo(s.x) + v.x * bf_lo(g.x), bf_hi(s.x) + v.y * bf_hi(g.x)); o.y = pk2(bf_lo(s.y) + v.z * bf_lo(g.y), bf_hi(s.y) + v.w * bf_hi(g.y));
                *(u32x2*)(mp + 16 * ni) = o; } }
    }
}

__device__ __forceinline__ void phase_E(const Ctx& c0, int l) {
    Ctx c = reopaque(c0);
    const bf16* merged = WSP(bf16, WS_MERGED); const bf16* Wout = (const bf16*)(c.ws + WS_WIN + l * SZ_WLAYER + OFF_WOUT);
    float* h = WSP(float, WS_H); bf16* hb = WSP(bf16, WS_HB); float* ssq = WSP(float, WS_SSQ);
    const int r = c.lane & 15, q = c.lane >> 4;
    for (int it = c.vb; it < MT * 8; it += c.G) {
        const int mt = it / 8, nt = it % 8;
        f32x4 acc[2][8]; acc_zero(acc);
        gemm_core(acc, merged + (size_t)mt * 128 * D, D, Wout + (size_t)nt * 128 * D, D, D, c.lds, c.tid);
#pragma unroll
        for (int mi = 0; mi < 2; ++mi) { const int tok = mt * 128 + 32 * c.wave + 16 * mi + r; float ss = 0.f;
#pragma unroll
            for (int ni = 0; ni < 8; ++ni) { float* hp = h + (size_t)tok * D + nt * 128 + 16 * ni + 4 * q; const f32x4 v = *(const f32x4*)hp + acc[mi][ni]; *(f32x4*)hp = v;
                ss += (v.x * v.x + v.y * v.y) + (v.z * v.z + v.w * v.w);
                u32x2 o; o.x = pk2(v.x, v.y); o.y = pk2(v.z, v.w); *(u32x2*)(hb + (size_t)tok * D + nt * 128 + 16 * ni + 4 * q) = o; }
            ss = quad_sum(ss);
            if (q == 0) ssq[(size_t)tok * 8 + nt] = ss; }
    }
}

__device__ __forceinline__ unsigned f2key(float f) { const unsigned u = __float_as_uint(f); return u ^ ((u >> 31) ? 0xFFFFFFFFu : 0x80000000u); }
__device__ __forceinline__ float key2f(unsigned k) { const unsigned u = (k >> 31) ? (k ^ 0x80000000u) : ~k; return __uint_as_float(u); }
__device__ __forceinline__ void top16_insert(unsigned (&lst)[16], unsigned x) {
#pragma unroll
    for (int i = 0; i < 16; ++i) { const unsigned a = lst[i]; lst[i] = a > x ? a : x; x = a > x ? x : a; }
}
__device__ __forceinline__ void phase_F(const Ctx& c0, int l) {
    Ctx c = reopaque(c0);
    const bf16* hb = WSP(bf16, WS_HB); const bf16* Wpq = (const bf16*)(c.ws + WS_WIN + l * SZ_WLAYER + OFF_WPQ); const bf16* keys = (const bf16*)(c.ws + WS_WIN + l * SZ_WLAYER + OFF_KEYS);
    const float* ssq = WSP(float, WS_SSQ); float* sv = WSP(float, WS_SV); unsigned char* si = WSP(unsigned char, WS_SI);
    const int tid = c.tid, wave = c.wave, lane = c.lane, r = lane & 15, q = lane >> 4;
    unsigned char* lds = c.lds;
    for (int it = c.vb; it < MT * 16; it += c.G) {
        const int mt = it / 16, hp = it % 16;
        f32x4 acc[2][8]; acc_zero(acc);
        gemm_core(acc, hb + (size_t)mt * 128 * D, D, Wpq + (size_t)hp * 128 * D, D, D, lds, tid);
#pragma unroll
        for (int mi = 0; mi < 2; ++mi) { const int row = 32 * wave + 16 * mi + r; const float rs = rstd_from_ssq8(ssq, mt * 128 + row);
#pragma unroll
            for (int ni = 0; ni < 8; ++ni) { const f32x4 v = acc[mi][ni] * rs; u32x2 o; o.x = pk2(v.x, v.y); o.y = pk2(v.z, v.w);
                *(u32x2*)(lds + (ni >> 2) * 32768 + lds_off(row, 2 * (ni & 3) + (q >> 1)) + 8 * (q & 1)) = o; } }
        { const int chunk = tid & 7, row0 = tid >> 3; const bf16* pb = keys + ((size_t)hp * 128 + row0) * 128 + chunk * 8;
#pragma unroll
          for (int s = 0; s < 2; ++s)
#pragma unroll
              for (int i = 0; i < 4; ++i) *(u32x4*)(lds + s * 32768 + 16384 + lds_off(row0 + 32 * i, chunk)) = *(const u32x4*)(pb + (size_t)(32 * i) * 128 + s * 64); }
        __syncthreads();
        acc_zero(acc);
        gemm_compute_stage(acc, lds, lds + 16384, wave, lane);
        gemm_compute_stage(acc, lds + 32768, lds + 32768 + 16384, wave, lane);
        __syncthreads();
        float* S = (float*)lds;
#pragma unroll
        for (int mi = 0; mi < 2; ++mi) { const int row = 32 * wave + 16 * mi + r;
#pragma unroll
            for (int ni = 0; ni < 8; ++ni) *(f32x4*)(S + row * 132 + 16 * ni + 4 * q) = acc[mi][ni]; }
        __syncthreads();
        if (tid < 128) {
            unsigned lst[16];
#pragma unroll
            for (int i = 0; i < 16; ++i) lst[i] = 0u;
            const float* row = S + tid * 132;
#pragma unroll 4
            for (int j = 0; j < 32; ++j) { const f32x4 v = *(const f32x4*)(row + 4 * j);
                top16_insert(lst, (f2key(v.x) & ~127u) | (unsigned)(127 - (4 * j)));
                top16_insert(lst, (f2key(v.y) & ~127u) | (unsigned)(127 - (4 * j + 1)));
                top16_insert(lst, (f2key(v.z) & ~127u) | (unsigned)(127 - (4 * j + 2)));
                top16_insert(lst, (f2key(v.w) & ~127u) | (unsigned)(127 - (4 * j + 3))); }
            const int tok = mt * 128 + tid;
            unsigned idx[16]; float val[16];
#pragma unroll
            for (int i = 0; i < 16; ++i) { idx[i] = 127u - (lst[i] & 127u); val[i] = row[idx[i]]; }
            float* svp = sv + ((size_t)tok * 16 + hp) * 16;
#pragma unroll
            for (int i = 0; i < 4; ++i) *(f32x4*)(svp + 4 * i) = (f32x4){val[4 * i], val[4 * i + 1], val[4 * i + 2], val[4 * i + 3]};
            u32x4 pi;
            pi.x = idx[0] | (idx[1] << 8) | (idx[2] << 16) | (idx[3] << 24); pi.y = idx[4] | (idx[5] << 8) | (idx[6] << 16) | (idx[7] << 24);
            pi.z = idx[8] | (idx[9] << 8) | (idx[10] << 16) | (idx[11] << 24); pi.w = idx[12] | (idx[13] << 8) | (idx[14] << 16) | (idx[15] << 24);
            *(u32x4*)(si + ((size_t)tok * 16 + hp) * 16) = pi;
        }
        __syncthreads();
    }
}

__device__ __forceinline__ void phase_F3(const Ctx& c0, int l) {
    Ctx c = reopaque(c0);
    const float* sv = WSP(float, WS_SV); const unsigned char* si = WSP(unsigned char, WS_SI); int* eidx = WSP(int, WS_EIDX); float* gw = WSP(float, WS_GW); unsigned char* stb = WSP(unsigned char, WS_STB);
    float* lsv = (float*)c.lds;
    unsigned char* lsi = c.lds + 256 * 33 * 4;
    const int tid = c.tid;
    for (int base = c.vb * NTHREADS; base < T * 8; base += c.G * NTHREADS) {
        const int th = base + tid;
        float a[16], b[16];
#pragma unroll
        for (int i = 0; i < 4; ++i) { const f32x4 x = *(const f32x4*)(sv + (size_t)th * 32 + 4 * i), y = *(const f32x4*)(sv + (size_t)th * 32 + 16 + 4 * i);
            a[4 * i] = x.x; a[4 * i + 1] = x.y; a[4 * i + 2] = x.z; a[4 * i + 3] = x.w; b[4 * i] = y.x; b[4 * i + 1] = y.y; b[4 * i + 2] = y.z; b[4 * i + 3] = y.w; }
        const u32x4 ia = *(const u32x4*)(si + (size_t)th * 32), ib = *(const u32x4*)(si + (size_t)th * 32 + 16);
#pragma unroll
        for (int i = 0; i < 16; ++i) { lsv[tid * 33 + i] = a[i]; lsv[tid * 33 + 16 + i] = b[i]; }
        *(u32x4*)(lsi + tid * 32) = ia; *(u32x4*)(lsi + tid * 32 + 16) = ib;
        unsigned lst[16];
#pragma unroll
        for (int i = 0; i < 16; ++i) lst[i] = 0u;
#pragma unroll
        for (int i = 0; i < 16; ++i)
#pragma unroll
            for (int j = 0; j < 16; ++j)
                if ((i + 1) * (j + 1) <= 16) top16_insert(lst, (f2key(a[i] + b[j]) & ~255u) | (unsigned)(255 - (i * 16 + j)));
        __builtin_amdgcn_s_waitcnt(0xC07F); asm volatile("" ::: "memory");
        float s[16]; int e[16];
#pragma unroll
        for (int k = 0; k < 16; ++k) { const unsigned code = 255u - (lst[k] & 255u); const int i = code >> 4, j = code & 15;
            s[k] = lsv[tid * 33 + i] + lsv[tid * 33 + 16 + j]; e[k] = (int)lsi[tid * 32 + i] * 128 + (int)lsi[tid * 32 + 16 + j]; }
        float mx = s[0];
#pragma unroll
        for (int k = 1; k < 16; ++k) mx = fmaxf(mx, s[k]);
        float sum = 0.f;
#pragma unroll
        for (int k = 0; k < 16; ++k) { s[k] = fast_exp2((s[k] - mx) * 1.4426950409f); sum += s[k]; }
        const float inv = 1.0f / sum;
        typedef unsigned long long u64;
        u64 hlo = 0ull, hhi = 0ull;
#pragma unroll
        for (int k = 0; k < 16; ++k) { const int sl = e[k] >> 10; if (sl < 8) hlo += 1ull << (8 * sl); else hhi += 1ull << (8 * (sl - 8)); }
        u64 ilo = hlo, ihi = hhi;
#pragma unroll
        for (int d = 1; d < 8; d <<= 1) { const u64 a_ = __shfl_up(ilo, d, 8), b_ = __shfl_up(ihi, d, 8); if ((tid & 7) >= d) { ilo += a_; ihi += b_; } }
        const u64 tlo = __shfl(ilo, 7, 8), thi = __shfl(ihi, 7, 8);
        const u64 ones = 0x0101010101010101ull;
        const u64 inlo = tlo * ones, inhi = thi * ones + (inlo >> 56) * ones;
        const u64 stlo = inlo - tlo, sthi = inhi - thi;
        u64 rlo = stlo + (ilo - hlo), rhi = sthi + (ihi - hhi);
        const int tokn = th >> 3;
#pragma unroll
        for (int k = 0; k < 16; ++k) { const int sl = e[k] >> 10; int pos;
            if (sl < 8) { pos = (int)((rlo >> (8 * sl)) & 255ull); rlo += 1ull << (8 * sl); } else { pos = (int)((rhi >> (8 * (sl - 8))) & 255ull); rhi += 1ull << (8 * (sl - 8)); }
            eidx[(size_t)tokn * 128 + pos] = e[k]; gw[(size_t)tokn * 128 + pos] = s[k] * inv; }
        if ((tid & 7) == 0) { u64* sp = (u64*)(stb + (size_t)tokn * 16); sp[0] = stlo; sp[1] = sthi; }
        __builtin_amdgcn_s_waitcnt(0xC07F); asm volatile("" ::: "memory");
    }
}

typedef float f32x2 __attribute__((ext_vector_type(2)));
constexpr int G2_WSTRIDE = 14336, G2_MAXTOK = 9;
__device__ __forceinline__ float fp8dot4(unsigned w, unsigned x01, unsigned x23, float acc) {
    const bf16x2 lo = __builtin_amdgcn_cvt_scalef32_pk_bf16_fp8(w, 1.0f, false), hi = __builtin_amdgcn_cvt_scalef32_pk_bf16_fp8(w, 1.0f, true);
    acc = __builtin_amdgcn_fdot2_f32_bf16(lo, __builtin_bit_cast(bf16x2, x01), acc, false);
    return __builtin_amdgcn_fdot2_f32_bf16(hi, __builtin_bit_cast(bf16x2, x23), acc, false);
}
__device__ __forceinline__ float reduce8_transposed(const float (&p)[8], int lane) {
    float s[4];
#pragma unroll
    for (int k = 0; k < 4; ++k) { auto r = __builtin_amdgcn_permlane32_swap(__float_as_uint(p[k]), __float_as_uint(p[k + 4]), false, false); s[k] = __uint_as_float(r[0]) + __uint_as_float(r[1]); }
    float t[2];
#pragma unroll
    for (int k = 0; k < 2; ++k) { auto r = __builtin_amdgcn_permlane16_swap(__float_as_uint(s[k]), __float_as_uint(s[k + 2]), false, false); t[k] = __uint_as_float(r[0]) + __uint_as_float(r[1]); }
    const float u0 = t[0] + dpp<0x128>(t[0]), u1 = t[1] + dpp<0x128>(t[1]);
    float r = (lane & 8) ? u1 : u0;
    r += dpp<0xB1>(r); r += dpp<0x4E>(r); r += dpp<0x141>(r);
    return r;
}
typedef int i32x4 __attribute__((ext_vector_type(4)));
__device__ __forceinline__ void fp8fma4(f32x2 (&acc)[8], int o, unsigned w, f32x2 a2) {
    const f32x2 lo = __builtin_amdgcn_cvt_scalef32_pk_f32_fp8(w, 1.0f, false), hi = __builtin_amdgcn_cvt_scalef32_pk_f32_fp8(w, 1.0f, true);
    acc[o] = __builtin_elementwise_fma(a2, lo, acc[o]); acc[o + 1] = __builtin_elementwise_fma(a2, hi, acc[o + 1]);
}
__device__ __forceinline__ void g2_u_chunk(u32x4 (&u)[8], const unsigned char* U, const int* pe_next, const float* pw_c, float* act_c, const u32x4 xa, const u32x4 xb, float rs, int lane) {
    const i32x4 e0 = *(const i32x4*)pe_next, e1 = *(const i32x4*)(pe_next + 4);
    const int en[8] = {e0.x, e0.y, e0.z, e0.w, e1.x, e1.y, e1.z, e1.w};
    float p[8];
#pragma unroll
    for (int k = 0; k < 8; ++k) {
        float d0 = fp8dot4(u[k].x, xa.x, xa.y, 0.f), d1 = fp8dot4(u[k].y, xa.z, xa.w, 0.f); d0 = fp8dot4(u[k].z, xb.x, xb.y, d0); d1 = fp8dot4(u[k].w, xb.z, xb.w, d1); p[k] = d0 + d1;
        asm volatile("" : "+v"(p[k]));
        u[k] = *(const u32x4*)(U + (size_t)__builtin_amdgcn_readfirstlane(en[k]) * 1024 + lane * 16);
    }
    const float a = reduce8_transposed(p, lane);
    const int row = (lane >> 3) & 7;
    if ((lane & 7) == 0) act_c[row] = gelu_tanh(a * rs) * pw_c[row];
}
__device__ __forceinline__ void g2_v_chunk(u32x4 (&v)[8], const unsigned char* V, const int* pe_next, const float* act_c, f32x2 (&acc)[8], int lane) {
    const i32x4 e0 = *(const i32x4*)pe_next, e1 = *(const i32x4*)(pe_next + 4);
    const int en[8] = {e0.x, e0.y, e0.z, e0.w, e1.x, e1.y, e1.z, e1.w};
    const f32x4 a0 = *(const f32x4*)act_c, a1 = *(const f32x4*)(act_c + 4);
    const float av[8] = {a0.x, a0.y, a0.z, a0.w, a1.x, a1.y, a1.z, a1.w};
#pragma unroll
    for (int k = 0; k < 8; ++k) { const f32x2 a2 = (f32x2){av[k], av[k]};
        fp8fma4(acc, 0, v[k].x, a2); fp8fma4(acc, 2, v[k].y, a2); fp8fma4(acc, 4, v[k].z, a2); fp8fma4(acc, 6, v[k].w, a2);
        asm volatile("" : "+v"(acc[0]), "+v"(acc[1]), "+v"(acc[2]), "+v"(acc[3]), "+v"(acc[4]), "+v"(acc[5]), "+v"(acc[6]), "+v"(acc[7]));
        v[k] = *(const u32x4*)(V + (size_t)__builtin_amdgcn_readfirstlane(en[k]) * 1024 + lane * 16);
    }
}
__device__ __forceinline__ void phase_G2(const Ctx& c0, int l) {
    Ctx c = reopaque(c0);
    const bf16* hb = WSP(bf16, WS_HB); const float* ssq = WSP(float, WS_SSQ); const int* pe = WSP(int, WS_EIDX); const float* pw = WSP(float, WS_GW);
    const unsigned char* U = c.ws + WS_TAB + (size_t)(l * 2) * SZ_TAB; const unsigned char* V = c.ws + WS_TAB + (size_t)(l * 2 + 1) * SZ_TAB;
    float* h = WSP(float, WS_H); bf16* hbw = WSP(bf16, WS_HB); float* ssqw = WSP(float, WS_SSQ);
    const int lane = c.lane;
    const int NW = c.G * 4, gw = c.vb * 4 + c.wave, base_t = T / NW, rem = T % NW;
    const int t0 = gw * base_t + (gw < rem ? gw : rem), nt = base_t + (gw < rem ? 1 : 0);
    unsigned char* wl = c.lds + c.wave * G2_WSTRIDE;
    int* pe_l = (int*)wl; float* pw_l = (float*)(wl + 4608); float* act_l = (float*)(wl + 9216);
    {
        u32x4 xa[G2_MAXTOK], xb[G2_MAXTOK]; float rs[G2_MAXTOK];
#pragma unroll
        for (int j = 0; j < G2_MAXTOK; ++j) { const int tok = t0 + (j < nt ? j : 0);
            pe_l[j * 128 + lane] = pe[(size_t)tok * 128 + lane]; pe_l[j * 128 + 64 + lane] = pe[(size_t)tok * 128 + 64 + lane];
            pw_l[j * 128 + lane] = pw[(size_t)tok * 128 + lane] * TAB_INV; pw_l[j * 128 + 64 + lane] = pw[(size_t)tok * 128 + 64 + lane] * TAB_INV;
            xa[j] = *(const u32x4*)(hb + (size_t)tok * D + lane * 16); xb[j] = *(const u32x4*)(hb + (size_t)tok * D + lane * 16 + 8); rs[j] = rstd_from_ssq8(ssq, tok) * TAB_INV; }
        u32x4 u[8];
#pragma unroll
        for (int k = 0; k < 8; ++k) u[k] = *(const u32x4*)(U + (size_t)__builtin_amdgcn_readfirstlane(pe_l[k]) * 1024 + lane * 16);
#pragma unroll 1
        for (int ch = 0; ch < 16; ++ch) {
            const int cn = ch < 15 ? ch + 1 : 0;
#pragma unroll
            for (int j = 0; j < G2_MAXTOK; ++j) if (j < nt) {
                const bool lastj = (j + 1 >= nt);
                const int* pe_next = lastj ? pe_l + cn * 8 : pe_l + (j + 1) * 128 + ch * 8;
                g2_u_chunk(u, U, pe_next, pw_l + j * 128 + ch * 8, act_l + j * 128 + ch * 8, xa[j], xb[j], rs[j], lane); }
        }
    }
    f32x2 acc[G2_MAXTOK][8];
#pragma unroll
    for (int j = 0; j < G2_MAXTOK; ++j)
#pragma unroll
        for (int i = 0; i < 8; ++i) acc[j][i] = (f32x2){0.f, 0.f};
    {
        u32x4 v[8];
#pragma unroll
        for (int k = 0; k < 8; ++k) v[k] = *(const u32x4*)(V + (size_t)__builtin_amdgcn_readfirstlane(pe_l[k]) * 1024 + lane * 16);
#pragma unroll 1
        for (int ch = 0; ch < 16; ++ch) {
            const int cn = ch < 15 ? ch + 1 : 0;
#pragma unroll
            for (int j = 0; j < G2_MAXTOK; ++j) if (j < nt) {
                const bool lastj = (j + 1 >= nt);
                const int* pe_next = lastj ? pe_l + cn * 8 : pe_l + (j + 1) * 128 + ch * 8;
                g2_v_chunk(v, V, pe_next, act_l + j * 128 + ch * 8, acc[j], lane); }
        }
    }
#pragma unroll
    for (int j = 0; j < G2_MAXTOK; ++j) if (j < nt) {
        const int tok = t0 + j;
        float* hp = h + (size_t)tok * D + lane * 16;
        f32x4 r0 = *(const f32x4*)hp, r1 = *(const f32x4*)(hp + 4), r2 = *(const f32x4*)(hp + 8), r3 = *(const f32x4*)(hp + 12);
        r0 += (f32x4){acc[j][0].x, acc[j][0].y, acc[j][1].x, acc[j][1].y}; r1 += (f32x4){acc[j][2].x, acc[j][2].y, acc[j][3].x, acc[j][3].y};
        r2 += (f32x4){acc[j][4].x, acc[j][4].y, acc[j][5].x, acc[j][5].y}; r3 += (f32x4){acc[j][6].x, acc[j][6].y, acc[j][7].x, acc[j][7].y};
        if (l == 0) {
            *(f32x4*)hp = r0; *(f32x4*)(hp + 4) = r1; *(f32x4*)(hp + 8) = r2; *(f32x4*)(hp + 12) = r3;
            u32x4 o0, o1; o0.x = pk2(r0.x, r0.y); o0.y = pk2(r0.z, r0.w); o0.z = pk2(r1.x, r1.y); o0.w = pk2(r1.z, r1.w);
            o1.x = pk2(r2.x, r2.y); o1.y = pk2(r2.z, r2.w); o1.z = pk2(r3.x, r3.y); o1.w = pk2(r3.z, r3.w);
            *(u32x4*)(hbw + (size_t)tok * D + lane * 16) = o0; *(u32x4*)(hbw + (size_t)tok * D + lane * 16 + 8) = o1;
            float ss = (r0.x * r0.x + r0.y * r0.y) + (r0.z * r0.z + r0.w * r0.w) + (r1.x * r1.x + r1.y * r1.y) + (r1.z * r1.z + r1.w * r1.w)
                     + (r2.x * r2.x + r2.y * r2.y) + (r2.z * r2.z + r2.w * r2.w) + (r3.x * r3.x + r3.y * r3.y) + (r3.z * r3.z + r3.w * r3.w);
            ss = wave_sum_dpp(ss);
            if (lane < 8) ssqw[(size_t)tok * 8 + lane] = lane == 0 ? ss : 0.f;
        } else {
            const int b = tok / L, pos = tok - b * L;
            if (pos >= NMETA) { float* op = c.out + ((size_t)b * SEQ + (pos - NMETA)) * D + lane * 16;
                *(f32x4*)op = r0; *(f32x4*)(op + 4) = r1; *(f32x4*)(op + 8) = r2; *(f32x4*)(op + 12) = r3; }
        }
    }
}

struct Args { const float* in[22]; float* out; unsigned char* ws; int ph_lo, ph_hi; };
constexpr int N_PHASES = 17;

__global__ void __launch_bounds__(NTHREADS, 2) fwd_kernel(Args args) {
    extern __shared__ __attribute__((aligned(16))) unsigned char lds_raw[];
    Ctx c;
#pragma unroll
    for (int i = 0; i < 22; ++i) c.in[i] = args.in[i];
    c.out = args.out; c.ws = args.ws; c.lds = lds_raw;
    c.tid = threadIdx.x; c.lane = c.tid & 63; c.wave = __builtin_amdgcn_readfirstlane(c.tid >> 6);
    c.G = gridDim.x; { const int bx = blockIdx.x; c.vb = (c.G % 8 == 0) ? (bx % 8) * (c.G / 8) + bx / 8 : bx; }
    volatile unsigned* misc = (volatile unsigned*)(c.lds + LDS_MISC);
    if (c.tid < 16) misc[c.tid] = 0u;
    __syncthreads();
    const int lo = args.ph_lo, hi = args.ph_hi;
    const bool multi = (hi - lo) > 1;
    XcdBarrier bar; bar.bar = WSP(unsigned, WS_CTL) + CW_BAR; bar.x = 0; bar.st = misc;
    if (multi) bar = xcd_barrier_post(WSP(unsigned, WS_CTL) + CW_BAR, misc);
#define IN_(k) (lo <= (k) && (k) < hi)
#define SEAM_(k) do { if ((k) + 1 < hi) xcd_barrier(bar); } while (0)
    if (IN_(0)) { phase_prologue(c); SEAM_(0); }
#pragma unroll 1
    for (int l = 0; l < 2; ++l) {
        const int p0 = 1 + 8 * l;
        if (IN_(p0 + 0)) { phase_A(c, l); SEAM_(p0 + 0); }
        if (IN_(p0 + 1)) { phase_B(c, l); SEAM_(p0 + 1); }
        if (IN_(p0 + 2)) { phase_C(c, l); SEAM_(p0 + 2); }
        if (IN_(p0 + 3)) { phase_D(c, l); SEAM_(p0 + 3); }
        if (IN_(p0 + 4)) { phase_E(c, l); SEAM_(p0 + 4); }
        if (IN_(p0 + 5)) { phase_F(c, l); SEAM_(p0 + 5); }
        if (IN_(p0 + 6)) { phase_F3(c, l); SEAM_(p0 + 6); }
        if (IN_(p0 + 7)) { phase_G2(c, l); SEAM_(p0 + 7); }
    }
}

extern "C" void kernel_launch(void* const* d_in, const int* in_sizes, int n_in, void* d_out, int out_size, void* d_ws, size_t ws_size, hipStream_t stream) {
    static int grid = 0;
    if (grid == 0) {
        if (n_in != 22 || out_size != NB * SEQ * D || ws_size < WS_END) { fprintf(stderr, "kernel_launch: unexpected shapes (n_in %d out %d ws %zu need %zu)\n", n_in, out_size, ws_size, (size_t)WS_END); grid = -1; return; }
        int dev = 0, cus = 0, per_cu = 0;
        hipGetDevice(&dev); hipDeviceGetAttribute(&cus, hipDeviceAttributeMultiprocessorCount, dev);
        if (hipFuncSetAttribute((const void*)fwd_kernel, hipFuncAttributeMaxDynamicSharedMemorySize, LDS_BYTES) != hipSuccess) { fprintf(stderr, "kernel_launch: hipFuncSetAttribute failed\n"); grid = -1; return; }
        if (hipOccupancyMaxActiveBlocksPerMultiprocessor(&per_cu, (const void*)fwd_kernel, NTHREADS, LDS_BYTES) != hipSuccess || per_cu < 1) { fprintf(stderr, "kernel_launch: occupancy query failed (%d)\n", per_cu); per_cu = 1; (void)hipGetLastError(); }
        if (per_cu > 2) per_cu = 2;
        grid = cus * per_cu;
        if ((long)grid * 4 * G2_MAXTOK < T || (long)grid * 4 * (G2_MAXTOK - 1) > T) { fprintf(stderr, "kernel_launch: grid %d unsupported by phase G2 (needs 8..9 tokens per wave)\n", grid); grid = -1; return; }
        fprintf(stderr, "kernel_launch: grid %d (%d per CU), lds %d, ws need %zu have %zu\n", grid, per_cu, LDS_BYTES, (size_t)WS_END, ws_size);
    }
    if (grid < 0) return;
    hipMemsetAsync((char*)d_ws + WS_CTL, 0, CTL_BYTES, stream);
    Args a{};
    for (int i = 0; i < 22; ++i) a.in[i] = (const float*)d_in[i];
    a.out = (float*)d_out; a.ws = (unsigned char*)d_ws;
#if MK_PER_PHASE
    for (int ph = 0; ph < N_PHASES; ++ph) { a.ph_lo = ph; a.ph_hi = ph + 1; hipLaunchKernelGGL(fwd_kernel, dim3(grid), dim3(NTHREADS), LDS_BYTES, stream, a); }
#else
    a.ph_lo = 0; a.ph_hi = N_PHASES;
    void* kargs[] = {&a};
    hipError_t e = hipLaunchCooperativeKernel((const void*)fwd_kernel, dim3(grid), dim3(NTHREADS), kargs, LDS_BYTES, stream);
    if (e != hipSuccess) fprintf(stderr, "kernel_launch: cooperative launch failed: %s (grid %d)\n", hipGetErrorString(e), grid);
#endif
}
```

```cpp
#include <hip/hip_runtime.h>
#include <cstdio>
#include <cstdint>

#ifndef MK_PER_PHASE
#define MK_PER_PHASE 0
#endif

typedef unsigned short bf16;
typedef short bf16x8 __attribute__((ext_vector_type(8)));
typedef float f32x4 __attribute__((ext_vector_type(4)));
typedef unsigned u32x4 __attribute__((ext_vector_type(4)));
typedef unsigned u32x2 __attribute__((ext_vector_type(2)));
typedef __bf16 bf16x2 __attribute__((ext_vector_type(2)));

constexpr int NB = 8, SEQ = 2048, NMETA = 16, L = SEQ + NMETA, T = NB * L, D = 1024;
constexpr int DC = 512, CW = 31, NH = 8, QL = 256, KVL = 128, NOPE = 64, ROPE = 32, QK = 96, VD = 64;
constexpr int NIN = 3488, NINP = 3584;
constexpr int NEXP = 16384;
constexpr float EPS = 1e-6f;
constexpr int MT = T / 128;
static_assert(T % 128 == 0, "T tiles");

constexpr size_t al256(size_t x) { return (x + 255) & ~(size_t)255; }
constexpr size_t WS_CTL = 0;
constexpr size_t CTL_BYTES = 65536;
constexpr size_t WS_ROPE = WS_CTL + CTL_BYTES;
constexpr size_t WS_WIN = al256(WS_ROPE + (size_t)L * 16 * 8);
constexpr size_t SZ_WIN = (size_t)NINP * 1024 * 2, SZ_WCO = (size_t)1024 * 512 * 2, SZ_WUQ = (size_t)1024 * 256 * 2, SZ_WUKV = (size_t)1024 * 128 * 2,
                 SZ_WMLA = (size_t)1024 * 512 * 2, SZ_WOUT = (size_t)1024 * 1024 * 2, SZ_WPQ = (size_t)2048 * 1024 * 2, SZ_KEYS = (size_t)16 * 128 * 128 * 2;
constexpr size_t OFF_WCO = SZ_WIN, OFF_WUQ = OFF_WCO + SZ_WCO, OFF_WUKV = OFF_WUQ + SZ_WUQ, OFF_WMLA = OFF_WUKV + SZ_WUKV, OFF_WOUT = OFF_WMLA + SZ_WMLA,
                 OFF_WPQ = OFF_WOUT + SZ_WOUT, OFF_KEYS = OFF_WPQ + SZ_WPQ, SZ_WLAYER = OFF_KEYS + SZ_KEYS;
constexpr size_t WS_TAB = al256(WS_WIN + 2 * SZ_WLAYER);
constexpr size_t SZ_TAB = (size_t)NEXP * 1024;
constexpr float TAB_SCALE = 256.0f, TAB_INV = 1.0f / 256.0f;
constexpr size_t WS_H = al256(WS_TAB + 4 * SZ_TAB);
constexpr size_t WS_HB = al256(WS_H + (size_t)T * 1024 * 4);
constexpr size_t WS_SSQ = al256(WS_HB + (size_t)T * 1024 * 2);
constexpr size_t WS_UGLU = al256(WS_SSQ + (size_t)T * 8 * 4);
constexpr size_t WS_CQ = al256(WS_UGLU + (size_t)T * 512 * 2);
constexpr size_t WS_CKV = al256(WS_CQ + (size_t)T * 256 * 2);
constexpr size_t WS_KROPE = al256(WS_CKV + (size_t)T * 128 * 2);
constexpr size_t WS_SSQQ = al256(WS_KROPE + (size_t)T * 32 * 4);
constexpr size_t WS_SSQKV = al256(WS_SSQQ + (size_t)T * 2 * 4);
constexpr size_t WS_U2 = al256(WS_SSQKV + (size_t)T * 4);
constexpr size_t WS_Q = al256(WS_U2 + (size_t)T * 512 * 2);
constexpr size_t WS_K = al256(WS_Q + (size_t)T * NH * QK * 2);
constexpr size_t WS_VT = al256(WS_K + (size_t)T * NH * QK * 2);
constexpr size_t WS_O = al256(WS_VT + (size_t)T * NH * VD * 2 + 4096);
constexpr size_t WS_MERGED = al256(WS_O + (size_t)T * 512 * 2);
constexpr size_t WS_GATES = al256(WS_MERGED + (size_t)T * 1024 * 2);
constexpr size_t WS_SV = WS_GATES;
constexpr size_t WS_SI = al256(WS_SV + (size_t)T * 256 * 4);
constexpr size_t WS_EIDX = al256(WS_SI + (size_t)T * 256);
constexpr size_t WS_GW = al256(WS_EIDX + (size_t)T * 128 * 4);
constexpr size_t WS_STB = al256(WS_GW + (size_t)T * 128 * 4);
constexpr size_t WS_PEER_END = WS_STB + (size_t)T * 16;
constexpr size_t WS_END = al256(WS_GATES + (size_t)T * 2048 * 2);
static_assert(WS_PEER_END <= WS_END, "peer scratch overlay");

constexpr int CW_BAR = 0;
constexpr int CW_QUEUE = 4096;

constexpr int LDS_MAIN = 128 * 132 * 4;
constexpr int LDS_MISC = LDS_MAIN;
constexpr int LDS_BYTES = LDS_MAIN + 64;

constexpr int NTHREADS = 256;

__device__ __forceinline__ unsigned pk2(float lo, float hi) { bf16x2 v; v.x = (__bf16)lo; v.y = (__bf16)hi; return __builtin_bit_cast(unsigned, v); }
__device__ __forceinline__ float bf_lo(unsigned p) { return __uint_as_float(p << 16); }
__device__ __forceinline__ float bf_hi(unsigned p) { return __uint_as_float(p & 0xffff0000u); }
__device__ __forceinline__ float fast_rcp(float x) { return __builtin_amdgcn_rcpf(x); }
__device__ __forceinline__ float fast_exp2(float x) { return __builtin_amdgcn_exp2f(x); }
__device__ __forceinline__ float sigmoidf_(float x) { return fast_rcp(1.0f + fast_exp2(-1.4426950409f * x)); }
__device__ __forceinline__ float gelu_tanh(float x) { const float u = 1.5957691216f * (x + 0.044715f * x * x * x); return x * fast_rcp(1.0f + fast_exp2(-1.4426950409f * u)); }
__device__ __forceinline__ float rsqrt_(float x) { return __builtin_amdgcn_rsqf(x); }
__device__ __forceinline__ float quad_sum(float v) { v += __shfl_xor(v, 16); v += __shfl_xor(v, 32); return v; }
__device__ __forceinline__ float quad_max(float v) { v = fmaxf(v, __shfl_xor(v, 16)); v = fmaxf(v, __shfl_xor(v, 32)); return v; }
__device__ __forceinline__ float wave_sum(float v) {
#pragma unroll
    for (int o = 1; o < 64; o <<= 1) v += __shfl_xor(v, o);
    return v;
}
template <int CTRL> __device__ __forceinline__ float dpp(float x) { return __builtin_bit_cast(float, __builtin_amdgcn_mov_dpp(__builtin_bit_cast(int, x), CTRL, 0xf, 0xf, true)); }
__device__ __forceinline__ float xrow16_sum(float x) {
    auto s = __builtin_amdgcn_permlane16_swap(__float_as_uint(x), __float_as_uint(x), false, false);
    x = __uint_as_float(s[0]) + __uint_as_float(s[1]);
    auto t = __builtin_amdgcn_permlane32_swap(__float_as_uint(x), __float_as_uint(x), false, false);
    return __uint_as_float(t[0]) + __uint_as_float(t[1]);
}
__device__ __forceinline__ float wave_sum_dpp(float x) {
    x += dpp<0xB1>(x); x += dpp<0x4E>(x); x += dpp<0x141>(x); x += dpp<0x128>(x); return xrow16_sum(x);
}
__device__ __forceinline__ float dot2(unsigned a, unsigned b, float c) { return __builtin_amdgcn_fdot2_f32_bf16(__builtin_bit_cast(bf16x2, a), __builtin_bit_cast(bf16x2, b), c, false); }

#define XB_TMO      128
#define XB_XCNT(j)  (256  + 64 * (j))
#define XB_XSUB(j)  (1280 + 64 * (j))
#define XB_XGEN(j)  (2304 + 64 * (j))
#define XB_TOP      3328
#define XB_TOPGEN   3392
#define XCD_BAR_WORDS 3456
#define XB_SPIN_CAP (1u << 20)
__device__ __forceinline__ unsigned xb_ld(unsigned* p)              { return __hip_atomic_load(p, __ATOMIC_RELAXED, __HIP_MEMORY_SCOPE_AGENT); }
__device__ __forceinline__ unsigned xb_add(unsigned* p, unsigned v) { return __hip_atomic_fetch_add(p, v, __ATOMIC_RELAXED, __HIP_MEMORY_SCOPE_AGENT); }
__device__ __forceinline__ unsigned xb_xcc_id() { return (unsigned)__builtin_amdgcn_s_getreg((3 << 11) | 20) & 0xFu; }
#define XB_SPIN(cond, bar) do { unsigned _sp = 0; while (cond) { __builtin_amdgcn_s_sleep(1); \
    if ((++_sp & 255u) == 0u) { if (xb_ld(&(bar)[XB_TMO])) break; if (_sp > XB_SPIN_CAP) { atomicAdd(&(bar)[XB_TMO], 1u); break; } } } } while (0)
struct XcdBarrier { unsigned* bar; unsigned x; volatile unsigned* st; };
__device__ __forceinline__ XcdBarrier xcd_barrier_post(unsigned* bar, volatile unsigned* st) {
    XcdBarrier b; b.bar = bar; b.x = xb_xcc_id(); b.st = st;
    if (threadIdx.x == 0) (void)xb_add(&bar[XB_XCNT(b.x)], 1u);
    return b;
}
__device__ __forceinline__ void xcd_barrier_complete(unsigned* bar, unsigned x, unsigned& nloc, unsigned& nx) {
    const unsigned G = gridDim.x * gridDim.y * gridDim.z;
    unsigned sum, cnt, mine, sp = 0u;
    for (;;) {
        sum = 0u; cnt = 0u; mine = 0u;
#pragma unroll
        for (unsigned j = 0; j < 16; ++j) { const unsigned c = xb_ld(&bar[XB_XCNT(j)]); sum += c; cnt += (c > 0u) ? 1u : 0u; mine = (j == x) ? c : mine; }
        if (sum == G) break;
        __builtin_amdgcn_s_sleep(1);
        if ((++sp & 255u) == 0u) { if (xb_ld(&bar[XB_TMO])) break; if (sp > XB_SPIN_CAP) { atomicAdd(&bar[XB_TMO], 1u); break; } }
    }
    nloc = mine > 0u ? mine : 1u; nx = cnt > 0u ? cnt : 1u;
}
__device__ __forceinline__ void xcd_barrier(const XcdBarrier& b) {
    asm volatile("s_waitcnt vmcnt(0)" ::: "memory");
    __syncthreads();
    if (threadIdx.x == 0) {
        unsigned* bar = b.bar;
        __builtin_amdgcn_s_waitcnt(0);
        unsigned nloc = b.st[0], nx = b.st[1];
        if (nloc == 0u) { xcd_barrier_complete(bar, b.x, nloc, nx); b.st[0] = nloc; b.st[1] = nx; }
        const unsigned old = xb_add(&bar[XB_XSUB(b.x)], 1u);
        const unsigned gen = old / nloc;
        if (old + 1u == (gen + 1u) * nloc) {
            __builtin_amdgcn_fence(__ATOMIC_RELEASE, "agent");
            asm volatile("s_waitcnt vmcnt(0)" ::: "memory");
            const unsigned og = xb_add(&bar[XB_TOP], 1u);
            const unsigned tg = og / nx;
            if (og + 1u == (tg + 1u) * nx) xb_add(&bar[XB_TOPGEN], 1u);
            else XB_SPIN(xb_ld(&bar[XB_TOPGEN]) == tg, bar);
            __builtin_amdgcn_fence(__ATOMIC_ACQUIRE, "agent");
            xb_add(&bar[XB_XGEN(b.x)], 1u);
            asm volatile("s_waitcnt vmcnt(0)" ::: "memory");
        } else {
            XB_SPIN(xb_ld(&bar[XB_XGEN(b.x)]) == gen, bar);
            __builtin_amdgcn_fence(__ATOMIC_ACQUIRE, "agent");
            asm volatile("s_waitcnt vmcnt(0)" ::: "memory");
        }
    }
    __syncthreads();
}

struct Ctx {
    const float* in[22]; float* out; unsigned char* ws;
    unsigned char* lds; int tid, lane, wave, G, vb;
};
#define WSP(T_, off) ((T_*)(c.ws + (off)))
__device__ __forceinline__ Ctx reopaque(const Ctx& c0) {
    Ctx c = c0; int t = c0.tid; asm volatile("" : "+v"(t)); c.tid = t; c.lane = t & 63; c.wave = __builtin_amdgcn_readfirstlane(t >> 6);
    int vb = c0.vb; asm volatile("" : "+s"(vb)); c.vb = vb; return c;
}

__device__ __forceinline__ int lds_off(int row, int chunk) { return row * 128 + ((chunk ^ (row & 7)) << 4); }

__device__ __forceinline__ void gemm_compute_stage(f32x4 (&acc)[2][8], const unsigned char* sA, const unsigned char* sB, int wave, int lane) {
    const int r = lane & 15, q = lane >> 4;
#pragma unroll
    for (int ks = 0; ks < 2; ++ks) {
        bf16x8 af[2], bfr[8];
#pragma unroll
        for (int mi = 0; mi < 2; ++mi) af[mi] = *(const bf16x8*)(sA + lds_off(32 * wave + 16 * mi + r, 4 * ks + q));
#pragma unroll
        for (int ni = 0; ni < 8; ++ni) bfr[ni] = *(const bf16x8*)(sB + lds_off(16 * ni + r, 4 * ks + q));
#pragma unroll
        for (int mi = 0; mi < 2; ++mi)
#pragma unroll
            for (int ni = 0; ni < 8; ++ni) acc[mi][ni] = __builtin_amdgcn_mfma_f32_16x16x32_bf16(bfr[ni], af[mi], acc[mi][ni], 0, 0, 0);
    }
}

__device__ __forceinline__ void gemm_core(f32x4 (&acc)[2][8], const bf16* A, int lda, const bf16* Bt, int ldb, int K, unsigned char* lds, int tid) {
    const int wave = __builtin_amdgcn_readfirstlane(tid >> 6), lane = tid & 63;
    const int chunk = tid & 7, row0 = tid >> 3;
    const int nk = K >> 6;
    u32x4 ra[4], rb[4];
    const bf16* pa = A + (size_t)row0 * lda + chunk * 8;
    const bf16* pb = Bt + (size_t)row0 * ldb + chunk * 8;
#pragma unroll
    for (int i = 0; i < 4; ++i) { ra[i] = *(const u32x4*)(pa + (size_t)(32 * i) * lda); rb[i] = *(const u32x4*)(pb + (size_t)(32 * i) * ldb); }
#pragma unroll
    for (int i = 0; i < 4; ++i) { *(u32x4*)(lds + lds_off(row0 + 32 * i, chunk)) = ra[i]; *(u32x4*)(lds + 16384 + lds_off(row0 + 32 * i, chunk)) = rb[i]; }
    __syncthreads();
    for (int kt = 0; kt < nk; ++kt) {
        const int cur = kt & 1;
        if (kt + 1 < nk) {
#pragma unroll
            for (int i = 0; i < 4; ++i) { ra[i] = *(const u32x4*)(pa + (size_t)(32 * i) * lda + (kt + 1) * 64); rb[i] = *(const u32x4*)(pb + (size_t)(32 * i) * ldb + (kt + 1) * 64); }
        }
        gemm_compute_stage(acc, lds + cur * 32768, lds + cur * 32768 + 16384, wave, lane);
        if (kt + 1 < nk) {
            unsigned char* st = lds + (cur ^ 1) * 32768;
#pragma unroll
            for (int i = 0; i < 4; ++i) { *(u32x4*)(st + lds_off(row0 + 32 * i, chunk)) = ra[i]; *(u32x4*)(st + 16384 + lds_off(row0 + 32 * i, chunk)) = rb[i]; }
        }
        __syncthreads();
    }
}
__device__ __forceinline__ void acc_zero(f32x4 (&acc)[2][8]) {
#pragma unroll
    for (int mi = 0; mi < 2; ++mi)
#pragma unroll
        for (int ni = 0; ni < 8; ++ni) acc[mi][ni] = (f32x4){0.f, 0.f, 0.f, 0.f};
}
__device__ __forceinline__ float rstd_from_ssq8(const float* ssq, int tok) {
    const f32x4 a = *(const f32x4*)(ssq + (size_t)tok * 8), b = *(const f32x4*)(ssq + (size_t)tok * 8 + 4);
    const float s = ((a.x + a.y) + (a.z + a.w)) + ((b.x + b.y) + (b.z + b.w));
    return rsqrt_(s * (1.0f / 1024.0f) + EPS);
}

__device__ __forceinline__ int src_col(int mode, int np) {
    if (mode == 0) return np;
    if (mode == 2) { const int h = np >> 7, j = np & 127; return j < 96 ? h * 96 + j : -1; }
    if (np < 1024) { const int cblk = np >> 7, j = np & 127; return j < 64 ? 64 * cblk + j : 512 + 64 * cblk + (j - 64); }
    if (np < 1408) return np;
    if (np < 1536) { const int j = np - 1408; return j < 32 ? 1408 + j : -1; }
    return 1440 + (np - 1536);
}
__device__ __forceinline__ void p0_transpose_item(const float* W, int K, int N, bf16* Wt, int mode, const float* g, int item, float* scr, int lane) {
    const int nblk_k = K / 64, nb = item / nblk_k, kb = item % nblk_k, k0 = 64 * kb, n0 = 32 * nb;
    const int n = src_col(mode, n0 + (lane & 31));
#pragma unroll 8
    for (int i = 0; i < 32; ++i) { const int kk = 2 * i + (lane >> 5); float v = 0.f; if (n >= 0) { v = W[(size_t)(k0 + kk) * N + n]; if (g) v *= g[k0 + kk]; } scr[kk * 33 + (lane & 31)] = v; }
    __builtin_amdgcn_s_waitcnt(0xC07F); asm volatile("" ::: "memory");
    const int cch = lane & 7;
#pragma unroll
    for (int j = 0; j < 4; ++j) { const int nl = (lane >> 3) + 8 * j; const float* s = scr + (8 * cch) * 33 + nl;
        u32x4 o; o.x = pk2(s[0 * 33], s[1 * 33]); o.y = pk2(s[2 * 33], s[3 * 33]); o.z = pk2(s[4 * 33], s[5 * 33]); o.w = pk2(s[6 * 33], s[7 * 33]);
        *(u32x4*)(Wt + (size_t)(n0 + nl) * K + k0 + 8 * cch) = o; }
    __builtin_amdgcn_s_waitcnt(0xC07F); asm volatile("" ::: "memory");
}
struct WDesc { int in_idx, K, N, Np, mode, g_idx; size_t off; };
__device__ __forceinline__ void phase_prologue(const Ctx& c0) {
    Ctx c = reopaque(c0);
    const int gw = c.vb * 4 + c.wave, NGW = c.G * 4;
    float* scr = (float*)(c.lds + c.wave * 8704);
    const WDesc wd[7] = {
        {3, 1024, NIN, NINP, 1, 2, 0}, {8, 512, 1024, 1024, 0, -1, OFF_WCO}, {10, 256, 768, 1024, 2, 9, OFF_WUQ}, {12, 128, 1024, 1024, 0, 11, OFF_WUKV},
        {15, 512, 1024, 1024, 0, -1, OFF_WMLA}, {16, 1024, 1024, 1024, 0, -1, OFF_WOUT}, {18, 1024, 2048, 2048, 0, 17, OFF_WPQ}};
    constexpr int ITEMS_PER_LAYER = (1024 / 64) * (NINP / 32) + (512 / 64) * 32 + (256 / 64) * 32 + (128 / 64) * 32 + (512 / 64) * 32 + (1024 / 64) * 32 + (1024 / 64) * 64;
    for (int it = gw; it < 2 * ITEMS_PER_LAYER; it += NGW) {
        const int l = it >= ITEMS_PER_LAYER ? 1 : 0; int r = it - l * ITEMS_PER_LAYER;
        const float* W = nullptr; const float* g = nullptr; bf16* Wt = nullptr; int K = 64, N = 32, mode = 0, rr = 0;
#pragma unroll
        for (int m = 0; m < 7; ++m) {
            const int items = (wd[m].K / 64) * (wd[m].Np / 32);
            if (r >= 0 && r < items) { K = wd[m].K; N = wd[m].N; mode = wd[m].mode; rr = r;
                W = c.in[wd[m].in_idx] + (size_t)l * wd[m].K * wd[m].N; g = wd[m].g_idx >= 0 ? c.in[wd[m].g_idx >= 0 ? wd[m].g_idx : 0] + (size_t)l * wd[m].K : nullptr;
                Wt = (bf16*)(c.ws + WS_WIN + l * SZ_WLAYER + wd[m].off); }
            r -= items;
        }
        p0_transpose_item(W, K, N, Wt, mode, g, rr, scr, c.lane);
    }
    const int gt = c.vb * NTHREADS + c.tid, NGT = c.G * NTHREADS;
    for (int l = 0; l < 2; ++l) {
        const float* src = c.in[19] + (size_t)l * 262144; bf16* dst = (bf16*)(c.ws + WS_WIN + l * SZ_WLAYER + OFF_KEYS);
        for (int i = gt; i < 262144 / 8; i += NGT) { const f32x4 a = *(const f32x4*)(src + i * 8), b = *(const f32x4*)(src + i * 8 + 4);
            u32x4 o; o.x = pk2(a.x, a.y); o.y = pk2(a.z, a.w); o.z = pk2(b.x, b.y); o.w = pk2(b.z, b.w); *(u32x4*)(dst + i * 8) = o; }
    }
    for (int l = 0; l < 2; ++l)
        for (int uv = 0; uv < 2; ++uv) {
            const float* src = c.in[20 + uv] + (size_t)l * NEXP * 1024; unsigned char* dst = c.ws + WS_TAB + (size_t)(l * 2 + uv) * SZ_TAB;
            f32x4 g4[4];
#pragma unroll
            for (int j = 0; j < 4; ++j) { g4[j] = (f32x4){TAB_SCALE, TAB_SCALE, TAB_SCALE, TAB_SCALE}; if (uv == 0) g4[j] = g4[j] * *(const f32x4*)(c.in[17] + l * 1024 + 256 * j + 4 * c.lane); }
            for (int row = gw; row < NEXP; row += 2 * NGW) {
                const float* sp = src + (size_t)row * 1024 + 4 * c.lane; const int row2 = row + NGW; const bool two = row2 < NEXP;
                const float* sp2 = src + (size_t)(two ? row2 : row) * 1024 + 4 * c.lane;
                f32x4 a[4], b[4];
#pragma unroll
                for (int j = 0; j < 4; ++j) { a[j] = *(const f32x4*)(sp + 256 * j); b[j] = *(const f32x4*)(sp2 + 256 * j); }
#pragma unroll
                for (int j = 0; j < 4; ++j) { const f32x4 v = a[j] * g4[j];
                    *(unsigned*)(dst + (size_t)row * 1024 + 256 * j + 4 * c.lane) = (unsigned)__builtin_amdgcn_cvt_pk_fp8_f32(v.z, v.w, __builtin_amdgcn_cvt_pk_fp8_f32(v.x, v.y, 0, false), true); }
                if (two) {
#pragma unroll
                    for (int j = 0; j < 4; ++j) { const f32x4 v = b[j] * g4[j];
                        *(unsigned*)(dst + (size_t)row2 * 1024 + 256 * j + 4 * c.lane) = (unsigned)__builtin_amdgcn_cvt_pk_fp8_f32(v.z, v.w, __builtin_amdgcn_cvt_pk_fp8_f32(v.x, v.y, 0, false), true); } }
            }
        }
    { float* rope = WSP(float, WS_ROPE);
      for (int i = gt; i < L * 16; i += NGT) { const int pos = i >> 4, j = i & 15;
          const float inv = 1.0f / __builtin_exp2f((float)j * 0.8304820237218406f);
          const float angf = (float)pos * inv; const double ang = (double)angf;
          const double nq = __builtin_rint(ang * 0.63661977236758134308);
          double rr = __builtin_fma(-nq, 1.57079632679489655800e+00, ang); rr = __builtin_fma(-nq, 6.12323399573676603587e-17, rr);
          const double r2 = rr * rr;
          double sp = -1.0 / 1307674368000.0; sp = sp * r2 + 1.0 / 6227020800.0; sp = sp * r2 - 1.0 / 39916800.0; sp = sp * r2 + 1.0 / 362880.0; sp = sp * r2 - 1.0 / 5040.0; sp = sp * r2 + 1.0 / 120.0; sp = sp * r2 - 1.0 / 6.0; sp = sp * r2 * rr + rr;
          double cp = 1.0 / 87178291200.0; cp = cp * r2 - 1.0 / 479001600.0; cp = cp * r2 + 1.0 / 3628800.0; cp = cp * r2 - 1.0 / 40320.0; cp = cp * r2 + 1.0 / 720.0; cp = cp * r2 - 1.0 / 24.0; cp = cp * r2 + 0.5; cp = 1.0 - cp * r2;
          const int qd = ((int)nq) & 3;
          const double cv = qd == 0 ? cp : qd == 1 ? -sp : qd == 2 ? -cp : sp;
          const double sv_ = qd == 0 ? sp : qd == 1 ? cp : qd == 2 ? -sp : -cp;
          rope[2 * i] = (float)cv; rope[2 * i + 1] = (float)sv_; } }
    { float* h = WSP(float, WS_H); bf16* hb = WSP(bf16, WS_HB); float* ssq = WSP(float, WS_SSQ);
      for (int t = gw; t < T; t += NGW) { const int b = t / L, pos = t % L;
          const float* src = pos < NMETA ? c.in[1] + (size_t)pos * D : c.in[0] + ((size_t)b * SEQ + (pos - NMETA)) * D;
          float s = 0.f;
#pragma unroll
          for (int j = 0; j < 4; ++j) { const f32x4 v = *(const f32x4*)(src + j * 256 + c.lane * 4); *(f32x4*)(h + (size_t)t * D + j * 256 + c.lane * 4) = v;
              u32x2 o; o.x = pk2(v.x, v.y); o.y = pk2(v.z, v.w); *(u32x2*)(hb + (size_t)t * D + j * 256 + c.lane * 4) = o; s += (v.x * v.x + v.y * v.y) + (v.z * v.z + v.w * v.w); }
          s = wave_sum(s);
          if (c.lane < 8) ssq[(size_t)t * 8 + c.lane] = c.lane == 0 ? s : 0.f; } }
}

__device__ __forceinline__ void phase_A(const Ctx& c0, int l) {
    Ctx c = reopaque(c0);
    const bf16* hb = WSP(bf16, WS_HB); const bf16* Wt = (const bf16*)(c.ws + WS_WIN + l * SZ_WLAYER);
    const float* ssq = WSP(float, WS_SSQ);
    bf16* uglu = WSP(bf16, WS_UGLU); bf16* cq = WSP(bf16, WS_CQ); bf16* ckv = WSP(bf16, WS_CKV); float* krope = WSP(float, WS_KROPE);
    float* ssqq = WSP(float, WS_SSQQ); float* ssqkv = WSP(float, WS_SSQKV); bf16* gates = WSP(bf16, WS_GATES);
    constexpr int NT = NINP / 128;
    const int r = c.lane & 15, q = c.lane >> 4;
    for (int it = c.vb; it < MT * NT; it += c.G) {
        const int mt = it / NT, nt = it % NT;
        f32x4 acc[2][8]; acc_zero(acc);
        gemm_core(acc, hb + (size_t)mt * 128 * D, D, Wt + (size_t)nt * 128 * D, D, D, c.lds, c.tid);
#pragma unroll
        for (int mi = 0; mi < 2; ++mi) {
            const int tok = mt * 128 + 32 * c.wave + 16 * mi + r;
            const float rs = rstd_from_ssq8(ssq, tok);
            if (nt < 8) {
#pragma unroll
                for (int ni = 0; ni < 4; ++ni) { const f32x4 v = acc[mi][ni] * rs, g = acc[mi][ni + 4] * rs;
                    u32x2 o; o.x = pk2(v.x * sigmoidf_(g.x), v.y * sigmoidf_(g.y)); o.y = pk2(v.z * sigmoidf_(g.z), v.w * sigmoidf_(g.w));
                    *(u32x2*)(uglu + (size_t)tok * DC + nt * 64 + 16 * ni + 4 * q) = o; }
            } else if (nt < 11) {
                bf16* dst = nt < 10 ? cq + (size_t)tok * QL + (nt - 8) * 128 : ckv + (size_t)tok * KVL;
                float ss = 0.f;
#pragma unroll
                for (int ni = 0; ni < 8; ++ni) { const f32x4 v = acc[mi][ni] * rs; ss += (v.x * v.x + v.y * v.y) + (v.z * v.z + v.w * v.w);
                    u32x2 o; o.x = pk2(v.x, v.y); o.y = pk2(v.z, v.w); *(u32x2*)(dst + 16 * ni + 4 * q) = o; }
                ss = quad_sum(ss);
                if (q == 0) { if (nt < 10) ssqq[(size_t)tok * 2 + (nt - 8)] = ss; else ssqkv[tok] = ss; }
            } else if (nt == 11) {
#pragma unroll
                for (int ni = 0; ni < 2; ++ni) *(f32x4*)(krope + (size_t)tok * 32 + 16 * ni + 4 * q) = acc[mi][ni] * rs;
            } else {
#pragma unroll
                for (int ni = 0; ni < 8; ++ni) { const f32x4 v = acc[mi][ni] * rs;
                    u32x2 o; o.x = pk2(sigmoidf_(v.x), sigmoidf_(v.y)); o.y = pk2(sigmoidf_(v.z), sigmoidf_(v.w));
                    *(u32x2*)(gates + (size_t)tok * 2048 + (nt - 12) * 128 + 16 * ni + 4 * q) = o; }
            }
        }
    }
}

__device__ __forceinline__ void phaseB_q_item(Ctx& c, int l, int mt, int head) {
    const bf16* cq = WSP(bf16, WS_CQ); const bf16* Wt = (const bf16*)(c.ws + WS_WIN + l * SZ_WLAYER + OFF_WUQ);
    const float* ssqq = WSP(float, WS_SSQQ); const float* rope = WSP(float, WS_ROPE); const float* qg = c.in[13] + l * QK; bf16* Qb = WSP(bf16, WS_Q);
    const int r = c.lane & 15, q = c.lane >> 4;
    f32x4 acc[2][8]; acc_zero(acc);
    gemm_core(acc, cq + (size_t)mt * 128 * QL, QL, Wt + (size_t)head * 128 * QL, QL, QL, c.lds, c.tid);
    constexpr float QSCALE = 0.10206207261596575f * 1.4426950408889634f;
#pragma unroll
    for (int mi = 0; mi < 2; ++mi) {
        const int tok = mt * 128 + 32 * c.wave + 16 * mi + r, b = tok / L, pos = tok - b * L;
        const float rs = rsqrt_((ssqq[(size_t)tok * 2] + ssqq[(size_t)tok * 2 + 1]) * (1.0f / 256.0f) + EPS);
        float ss = 0.f;
#pragma unroll
        for (int ni = 0; ni < 6; ++ni) { acc[mi][ni] = acc[mi][ni] * rs; const f32x4 v = acc[mi][ni]; ss += (v.x * v.x + v.y * v.y) + (v.z * v.z + v.w * v.w); }
        ss = quad_sum(ss);
        const float rn = rsqrt_(ss * (1.0f / 96.0f) + EPS) * QSCALE;
#pragma unroll
        for (int ni = 0; ni < 6; ++ni) { const f32x4 g = *(const f32x4*)(qg + 16 * ni + 4 * q); acc[mi][ni] = acc[mi][ni] * g * rn; }
        const f32x4 cs0 = *(const f32x4*)(rope + ((size_t)pos * 16 + 4 * q) * 2), cs1 = *(const f32x4*)(rope + ((size_t)pos * 16 + 4 * q) * 2 + 4);
        const float co[4] = {cs0.x, cs0.z, cs1.x, cs1.z}, si[4] = {cs0.y, cs0.w, cs1.y, cs1.w};
        f32x4 x1 = acc[mi][4], x2 = acc[mi][5];
#pragma unroll
        for (int e = 0; e < 4; ++e) { const float a = x1[e], bb = x2[e]; x1[e] = a * co[e] - bb * si[e]; x2[e] = bb * co[e] + a * si[e]; }
        acc[mi][4] = x1; acc[mi][5] = x2;
        bf16* dst = Qb + (((size_t)b * NH + head) * L + pos) * QK;
#pragma unroll
        for (int ni = 0; ni < 6; ++ni) { const f32x4 v = acc[mi][ni]; u32x2 o; o.x = pk2(v.x, v.y); o.y = pk2(v.z, v.w); *(u32x2*)(dst + 16 * ni + 4 * q) = o; }
    }
}
__device__ __forceinline__ void phaseB_kv_item(Ctx& c, int l, int mt, int head) {
    const bf16* ckv = WSP(bf16, WS_CKV); const bf16* Wt = (const bf16*)(c.ws + WS_WIN + l * SZ_WLAYER + OFF_WUKV);
    const float* ssqkv = WSP(float, WS_SSQKV); const float* rope = WSP(float, WS_ROPE); const float* kg = c.in[14] + l * QK; const float* krope = WSP(float, WS_KROPE);
    bf16* Kb = WSP(bf16, WS_K); bf16* Vt = WSP(bf16, WS_VT);
    const int tid = c.tid, wave = c.wave, lane = c.lane, r = lane & 15, q = lane >> 4;
    unsigned char* lds = c.lds;
    f32x4 ak[2][4], av[2][4];
#pragma unroll
    for (int mi = 0; mi < 2; ++mi)
#pragma unroll
        for (int ni = 0; ni < 4; ++ni) { ak[mi][ni] = (f32x4){0.f, 0.f, 0.f, 0.f}; av[mi][ni] = (f32x4){0.f, 0.f, 0.f, 0.f}; }
    { const int chunk = tid & 7, row0 = tid >> 3;
      const bf16* pa = ckv + ((size_t)mt * 128 + row0) * KVL + chunk * 8; const bf16* pb = Wt + ((size_t)head * 128 + row0) * KVL + chunk * 8;
#pragma unroll
      for (int s = 0; s < 2; ++s)
#pragma unroll
          for (int i = 0; i < 4; ++i) { *(u32x4*)(lds + s * 32768 + lds_off(row0 + 32 * i, chunk)) = *(const u32x4*)(pa + (size_t)(32 * i) * KVL + s * 64);
              *(u32x4*)(lds + s * 32768 + 16384 + lds_off(row0 + 32 * i, chunk)) = *(const u32x4*)(pb + (size_t)(32 * i) * KVL + s * 64); }
    }
    __syncthreads();
#pragma unroll
    for (int s = 0; s < 2; ++s)
#pragma unroll
        for (int ks = 0; ks < 2; ++ks) {
            const unsigned char* sA = lds + s * 32768; const unsigned char* sB = sA + 16384;
            bf16x8 af[2], bfr[8];
#pragma unroll
            for (int mi = 0; mi < 2; ++mi) af[mi] = *(const bf16x8*)(sA + lds_off(32 * wave + 16 * mi + r, 4 * ks + q));
#pragma unroll
            for (int ni = 0; ni < 8; ++ni) bfr[ni] = *(const bf16x8*)(sB + lds_off(16 * ni + r, 4 * ks + q));
#pragma unroll
            for (int mi = 0; mi < 2; ++mi)
#pragma unroll
                for (int ni = 0; ni < 4; ++ni) { ak[mi][ni] = __builtin_amdgcn_mfma_f32_16x16x32_bf16(bfr[ni], af[mi], ak[mi][ni], 0, 0, 0);
                    av[mi][ni] = __builtin_amdgcn_mfma_f32_16x16x32_bf16(af[mi], bfr[ni + 4], av[mi][ni], 0, 0, 0); }
        }
    __syncthreads();
#pragma unroll
    for (int mi = 0; mi < 2; ++mi) {
        const int tok0 = mt * 128 + 32 * wave + 16 * mi, b = tok0 / L, pos0 = tok0 - b * L;
        { const int tok = tok0 + r, pos = pos0 + r;
          const float rs = rsqrt_(ssqkv[tok] * (1.0f / 128.0f) + EPS);
          const f32x4 kr1 = *(const f32x4*)(krope + (size_t)tok * 32 + 4 * q), kr2 = *(const f32x4*)(krope + (size_t)tok * 32 + 16 + 4 * q);
          float ss = (kr1.x * kr1.x + kr1.y * kr1.y) + (kr1.z * kr1.z + kr1.w * kr1.w) + (kr2.x * kr2.x + kr2.y * kr2.y) + (kr2.z * kr2.z + kr2.w * kr2.w);
#pragma unroll
          for (int ni = 0; ni < 4; ++ni) { ak[mi][ni] = ak[mi][ni] * rs; const f32x4 v = ak[mi][ni]; ss += (v.x * v.x + v.y * v.y) + (v.z * v.z + v.w * v.w); }
          ss = quad_sum(ss);
          const float rn = rsqrt_(ss * (1.0f / 96.0f) + EPS);
          bf16* dst = Kb + (((size_t)b * NH + head) * L + pos) * QK;
#pragma unroll
          for (int ni = 0; ni < 4; ++ni) { const f32x4 g = *(const f32x4*)(kg + 16 * ni + 4 * q); const f32x4 v = ak[mi][ni] * g * rn;
              u32x2 o; o.x = pk2(v.x, v.y); o.y = pk2(v.z, v.w); *(u32x2*)(dst + 16 * ni + 4 * q) = o; }
          const f32x4 g1 = *(const f32x4*)(kg + 64 + 4 * q), g2 = *(const f32x4*)(kg + 80 + 4 * q);
          f32x4 x1 = kr1 * g1 * rn, x2 = kr2 * g2 * rn;
          const f32x4 cs0 = *(const f32x4*)(rope + ((size_t)pos * 16 + 4 * q) * 2), cs1 = *(const f32x4*)(rope + ((size_t)pos * 16 + 4 * q) * 2 + 4);
          const float co[4] = {cs0.x, cs0.z, cs1.x, cs1.z}, si[4] = {cs0.y, cs0.w, cs1.y, cs1.w};
#pragma unroll
          for (int e = 0; e < 4; ++e) { const float a = x1[e], bb = x2[e]; x1[e] = a * co[e] - bb * si[e]; x2[e] = bb * co[e] + a * si[e]; }
          u32x2 o1, o2; o1.x = pk2(x1.x, x1.y); o1.y = pk2(x1.z, x1.w); o2.x = pk2(x2.x, x2.y); o2.y = pk2(x2.z, x2.w);
          *(u32x2*)(dst + 64 + 4 * q) = o1; *(u32x2*)(dst + 80 + 4 * q) = o2; }
        { const f32x4 sq = *(const f32x4*)(ssqkv + tok0 + 4 * q);
          f32x4 rs4; rs4.x = rsqrt_(sq.x * (1.0f / 128.0f) + EPS); rs4.y = rsqrt_(sq.y * (1.0f / 128.0f) + EPS); rs4.z = rsqrt_(sq.z * (1.0f / 128.0f) + EPS); rs4.w = rsqrt_(sq.w * (1.0f / 128.0f) + EPS);
#pragma unroll
          for (int ni = 0; ni < 4; ++ni) { const f32x4 v = av[mi][ni] * rs4; u32x2 o; o.x = pk2(v.x, v.y); o.y = pk2(v.z, v.w);
              *(u32x2*)(Vt + (((size_t)b * NH + head) * VD + 16 * ni + r) * L + pos0 + 4 * q) = o; } }
    }
}
__device__ __forceinline__ u32x4 conv_row(const bf16* uglu, int b, int pos, int ch) {
    u32x4 xv = (u32x4){0u, 0u, 0u, 0u};
    if (pos >= 0) xv = *(const u32x4*)(uglu + ((size_t)b * L + pos) * DC + ch);
    return xv;
}
__device__ __forceinline__ void conv_fma(float (&a)[8], const u32x4 xv, const f32x4 w0, const f32x4 w1) {
    a[0] += bf_lo(xv.x) * w0.x; a[1] += bf_hi(xv.x) * w0.y; a[2] += bf_lo(xv.y) * w0.z; a[3] += bf_hi(xv.y) * w0.w;
    a[4] += bf_lo(xv.z) * w1.x; a[5] += bf_hi(xv.z) * w1.y; a[6] += bf_lo(xv.w) * w1.z; a[7] += bf_hi(xv.w) * w1.w;
}
__device__ __forceinline__ void phaseB_conv_item(Ctx& c, int l, int grp) {
    const bf16* uglu = WSP(bf16, WS_UGLU); bf16* u2 = WSP(bf16, WS_U2);
    const float* cw = c.in[4] + (size_t)l * CW * DC; const float* cb = c.in[5] + l * DC; const float* lg = c.in[6] + l * DC; const float* lb = c.in[7] + l * DC;
    const int tok0 = grp * 4, b = tok0 / L, pos0 = tok0 - b * L, ch = c.lane * 8;
    float acc[4][8];
    { const f32x4 b0 = *(const f32x4*)(cb + ch), b1 = *(const f32x4*)(cb + ch + 4);
#pragma unroll
      for (int d = 0; d < 4; ++d) { acc[d][0] = b0.x; acc[d][1] = b0.y; acc[d][2] = b0.z; acc[d][3] = b0.w; acc[d][4] = b1.x; acc[d][5] = b1.y; acc[d][6] = b1.z; acc[d][7] = b1.w; } }
    const int base = pos0 - 30;
    u32x4 x0 = conv_row(uglu, b, base + 0, ch), x1 = conv_row(uglu, b, base + 1, ch), x2 = conv_row(uglu, b, base + 2, ch),
          x3 = conv_row(uglu, b, base + 3, ch), x4 = conv_row(uglu, b, base + 4, ch), x5;
    const float* wp = cw + ch;
#pragma unroll 1
    for (int w = 0; w < CW; ++w) {
        x5 = conv_row(uglu, b, (w + 5 <= 33) ? base + w + 5 : -1, ch);
        const f32x4 w0 = *(const f32x4*)wp, w1 = *(const f32x4*)(wp + 4); wp += DC;
        conv_fma(acc[0], x0, w0, w1); conv_fma(acc[1], x1, w0, w1); conv_fma(acc[2], x2, w0, w1); conv_fma(acc[3], x3, w0, w1);
        x0 = x1; x1 = x2; x2 = x3; x3 = x4; x4 = x5;
    }
    const f32x4 g0 = *(const f32x4*)(lg + ch), g1 = *(const f32x4*)(lg + ch + 4), e0 = *(const f32x4*)(lb + ch), e1 = *(const f32x4*)(lb + ch + 4);
    const float gg[8] = {g0.x, g0.y, g0.z, g0.w, g1.x, g1.y, g1.z, g1.w}, be[8] = {e0.x, e0.y, e0.z, e0.w, e1.x, e1.y, e1.z, e1.w};
#pragma unroll
    for (int d = 0; d < 4; ++d) {
        float s = 0.f;
#pragma unroll
        for (int j = 0; j < 8; ++j) s += acc[d][j];
        const float mu = wave_sum(s) * (1.0f / 512.0f);
        float vq = 0.f;
#pragma unroll
        for (int j = 0; j < 8; ++j) { acc[d][j] -= mu; vq += acc[d][j] * acc[d][j]; }
        const float rstd = rsqrt_(wave_sum(vq) * (1.0f / 512.0f) + EPS);
        float y[8];
#pragma unroll
        for (int j = 0; j < 8; ++j) { const float v = acc[d][j] * rstd * gg[j] + be[j]; y[j] = v * sigmoidf_(v); }
        u32x4 o; o.x = pk2(y[0], y[1]); o.y = pk2(y[2], y[3]); o.z = pk2(y[4], y[5]); o.w = pk2(y[6], y[7]);
        *(u32x4*)(u2 + (size_t)(tok0 + d) * DC + ch) = o;
    }
}
__device__ __forceinline__ void phase_B(const Ctx& c0, int l) {
    Ctx c = reopaque(c0);
    constexpr int NQ = MT * NH, NKV = MT * NH, NCV = T / 16;
    for (int it = c.vb; it < NQ + NKV + NCV; it += c.G) {
        if (it < NQ) phaseB_q_item(c, l, it / NH, it % NH);
        else if (it < NQ + NKV) phaseB_kv_item(c, l, (it - NQ) / NH, (it - NQ) % NH);
        else phaseB_conv_item(c, l, (it - NQ - NKV) * 4 + c.wave);
    }
}

constexpr int KROW = 208, VROW = 136, ATT_STAGE = 64 * KROW + 64 * VROW;
__device__ __forceinline__ void phase_C(const Ctx& c0, int l) {
    Ctx c = reopaque(c0);
    const bf16* Qb = WSP(bf16, WS_Q); const bf16* Kb = WSP(bf16, WS_K); const bf16* Vt = WSP(bf16, WS_VT); bf16* O = WSP(bf16, WS_O);
    unsigned* qctr = WSP(unsigned, WS_CTL) + CW_QUEUE + 64 * l;
    volatile unsigned* misc = (volatile unsigned*)(c.lds + LDS_MISC);
    const int tid = c.tid, wave = c.wave, lane = c.lane, r = lane & 15, q = lane >> 4;
    unsigned char* lds = c.lds;
    for (;;) {
        if (tid == 0) misc[4] = atomicAdd(qctr, 1u);
        __syncthreads();
        const int item = (int)misc[4];
        __syncthreads();
        if (item >= NB * NH * 33) break;
        const int ch = 32 - item / 64, bh = item % 64, b = bh / NH, h = bh % NH;
        const int r0 = ch == 0 ? 0 : 16 + 64 * (ch - 1);
        const bool active = ch > 0 || wave == 0;
        const int ntiles = ch + 1;
        const bf16* Kbase = Kb + (size_t)bh * L * QK; const bf16* Vbase = Vt + (size_t)bh * VD * L;
        bf16x8 qf[3];
#pragma unroll
        for (int ks = 0; ks < 3; ++ks) qf[ks] = *(const bf16x8*)(Qb + ((size_t)bh * L + r0 + 16 * wave + r) * QK + 32 * ks + 8 * q);
        float m = -1e30f, lsum = 0.f;
        f32x4 o[4];
#pragma unroll
        for (int dt = 0; dt < 4; ++dt) o[dt] = (f32x4){0.f, 0.f, 0.f, 0.f};
        u32x4 rk[3], rv[2];
        auto gload = [&](int kt) {
#pragma unroll
            for (int i = 0; i < 3; ++i) { const int id = tid + 256 * i, row = id / 12, cc = id % 12; rk[i] = *(const u32x4*)(Kbase + (size_t)(kt * 64 + row) * QK + cc * 8); }
#pragma unroll
            for (int i = 0; i < 2; ++i) { const int id = tid + 256 * i, row = id >> 3, cc = id & 7; rv[i] = *(const u32x4*)(Vbase + (size_t)row * L + kt * 64 + cc * 8); }
        };
        auto lstore = [&](int s) {
            unsigned char* st = lds + s * ATT_STAGE;
#pragma unroll
            for (int i = 0; i < 3; ++i) { const int id = tid + 256 * i, row = id / 12, cc = id % 12; *(u32x4*)(st + row * KROW + cc * 16) = rk[i]; }
#pragma unroll
            for (int i = 0; i < 2; ++i) { const int id = tid + 256 * i, row = id >> 3, cc = id & 7; u32x2* d = (u32x2*)(st + 64 * KROW + row * VROW + cc * 16); d[0] = (u32x2){rv[i].x, rv[i].y}; d[1] = (u32x2){rv[i].z, rv[i].w}; }
        };
        gload(0); lstore(0);
        __syncthreads();
        for (int kt = 0; kt < ntiles; ++kt) {
            const int cur = kt & 1;
            if (kt + 1 < ntiles) gload(kt + 1);
            const unsigned char* sK = lds + cur * ATT_STAGE; const unsigned char* sV = sK + 64 * KROW;
            const bool full = kt < ch;
            f32x4 s[4];
#pragma unroll
            for (int k4 = 0; k4 < 4; ++k4) {
                s[k4] = (f32x4){0.f, 0.f, 0.f, 0.f};
                if (k4 == 0 || full) {
#pragma unroll
                    for (int ks = 0; ks < 3; ++ks) { const bf16x8 kf = *(const bf16x8*)(sK + (16 * k4 + r) * KROW + 64 * ks + 16 * q);
                        s[k4] = __builtin_amdgcn_mfma_f32_16x16x32_bf16(kf, qf[ks], s[k4], 0, 0, 0); }
                }
            }
            float mx = fmaxf(fmaxf(s[0].x, s[0].y), fmaxf(s[0].z, s[0].w));
            if (full) {
#pragma unroll
                for (int k4 = 1; k4 < 4; ++k4) mx = fmaxf(mx, fmaxf(fmaxf(s[k4].x, s[k4].y), fmaxf(s[k4].z, s[k4].w)));
            }
            mx = quad_max(mx);
            const float mn = fmaxf(m, mx), alpha = fast_exp2(m - mn); m = mn;
            float ps = 0.f;
#pragma unroll
            for (int k4 = 0; k4 < 4; ++k4) {
                if (k4 == 0 || full) { f32x4 p; p.x = fast_exp2(s[k4].x - mn); p.y = fast_exp2(s[k4].y - mn); p.z = fast_exp2(s[k4].z - mn); p.w = fast_exp2(s[k4].w - mn);
                    ps += (p.x + p.y) + (p.z + p.w); s[k4] = p; }
            }
            lsum = lsum * alpha + ps;
#pragma unroll
            for (int dt = 0; dt < 4; ++dt) o[dt] = o[dt] * alpha;
#pragma unroll
            for (int st = 0; st < 2; ++st) {
                if (st == 0 || full) {
                    u32x4 pw; pw.x = pk2(s[2 * st].x, s[2 * st].y); pw.y = pk2(s[2 * st].z, s[2 * st].w); pw.z = pk2(s[2 * st + 1].x, s[2 * st + 1].y); pw.w = pk2(s[2 * st + 1].z, s[2 * st + 1].w);
                    if (!full) { pw.z = 0u; pw.w = 0u; }
                    const bf16x8 pf = __builtin_bit_cast(bf16x8, pw);
#pragma unroll
                    for (int dt = 0; dt < 4; ++dt) {
                        const unsigned char* vp = sV + (16 * dt + r) * VROW + (32 * st + 4 * q) * 2;
                        const u32x2 v0 = *(const u32x2*)vp; u32x2 v1 = (u32x2){0u, 0u};
                        if (full) v1 = *(const u32x2*)(vp + 32);
                        const u32x4 vw = (u32x4){v0.x, v0.y, v1.x, v1.y};
                        o[dt] = __builtin_amdgcn_mfma_f32_16x16x32_bf16(__builtin_bit_cast(bf16x8, vw), pf, o[dt], 0, 0, 0);
                    }
                }
            }
            if (kt + 1 < ntiles) lstore(cur ^ 1);
            __syncthreads();
        }
        lsum = quad_sum(lsum);
        if (active) {
            const float inv = 1.0f / lsum;
            bf16* dst = O + ((size_t)b * L + r0 + 16 * wave + r) * 512 + h * VD;
#pragma unroll
            for (int dt = 0; dt < 4; ++dt) { const f32x4 v = o[dt] * inv; u32x2 ov; ov.x = pk2(v.x, v.y); ov.y = pk2(v.z, v.w); *(u32x2*)(dst + 16 * dt + 4 * q) = ov; }
        }
    }
}

__device__ __forceinline__ void phase_D(const Ctx& c0, int l) {
    Ctx c = reopaque(c0);
    const bf16* u2 = WSP(bf16, WS_U2); const bf16* O = WSP(bf16, WS_O); const bf16* gates = WSP(bf16, WS_GATES); bf16* merged = WSP(bf16, WS_MERGED);
    const bf16* Wco = (const bf16*)(c.ws + WS_WIN + l * SZ_WLAYER + OFF_WCO); const bf16* Wmla = (const bf16*)(c.ws + WS_WIN + l * SZ_WLAYER + OFF_WMLA);
    const int r = c.lane & 15, q = c.lane >> 4;
    for (int it = c.vb; it < MT * 8; it += c.G) {
        const int mt = it / 8, nt = it % 8;
        f32x4 acc[2][8]; acc_zero(acc);
        gemm_core(acc, u2 + (size_t)mt * 128 * 512, 512, Wco + (size_t)nt * 128 * 512, 512, 512, c.lds, c.tid);
#pragma unroll
        for (int mi = 0; mi < 2; ++mi) { const int tok = mt * 128 + 32 * c.wave + 16 * mi + r;
            const bf16* gp = gates + (size_t)tok * 2048 + nt * 128 + 4 * q; bf16* mp = merged + (size_t)tok * D + nt * 128 + 4 * q;
#pragma unroll
            for (int ni = 0; ni < 8; ++ni) { const u32x2 g = *(const u32x2*)(gp + 16 * ni); const f32x4 v = acc[mi][ni];
                u32x2 o; o.x = pk2(v.x * bf_lo(g.x), v.y * bf_hi(g.x)); o.y = pk2(v.z * bf_lo(g.y), v.w * bf_hi(g.y)); *(u32x2*)(mp + 16 * ni) = o; } }
        acc_zero(acc);
        gemm_core(acc, O + (size_t)mt * 128 * 512, 512, Wmla + (size_t)nt * 128 * 512, 512, 512, c.lds, c.tid);
#pragma unroll
        for (int mi = 0; mi < 2; ++mi) { const int tok = mt * 128 + 32 * c.wave + 16 * mi + r;
            const bf16* gp = gates + (size_t)tok * 2048 + 1024 + nt * 128 + 4 * q; bf16* mp = merged + (size_t)tok * D + nt * 128 + 4 * q;
#pragma unroll
            for (int ni = 0; ni < 8; ++ni) { const u32x2 g = *(const u32x2*)(gp + 16 * ni); const u32x2 s = *(const u32x2*)(mp + 16 * ni); const f32x4 v = acc[mi][ni];
                u32x2 o; o.x = pk2(bf_lo(s.x) + v.x * bf_lo(g.x), bf_hi(s.x) + v.y * bf_hi(g.x)); o.y = pk2(bf_lo(s.y) + v.z * bf_lo(g.y), bf_hi(s.y) + v.w * bf_hi(g.y));
                *(u32x2*)(mp + 16 * ni) = o; } }
    }
}

__device__ __forceinline__ void phase_E(const Ctx& c0, int l) {
    Ctx c = reopaque(c0);
    const bf16* merged = WSP(bf16, WS_MERGED); const bf16* Wout = (const bf16*)(c.ws + WS_WIN + l * SZ_WLAYER + OFF_WOUT);
    float* h = WSP(float, WS_H); bf16* hb = WSP(bf16, WS_HB); float* ssq = WSP(float, WS_SSQ);
    const int r = c.lane & 15, q = c.lane >> 4;
    for (int it = c.vb; it < MT * 8; it += c.G) {
        const int mt = it / 8, nt = it % 8;
        f32x4 acc[2][8]; acc_zero(acc);
        gemm_core(acc, merged + (size_t)mt * 128 * D, D, Wout + (size_t)nt * 128 * D, D, D, c.lds, c.tid);
#pragma unroll
        for (int mi = 0; mi < 2; ++mi) { const int tok = mt * 128 + 32 * c.wave + 16 * mi + r; float ss = 0.f;
#pragma unroll
            for (int ni = 0; ni < 8; ++ni) { float* hp = h + (size_t)tok * D + nt * 128 + 16 * ni + 4 * q; const f32x4 v = *(const f32x4*)hp + acc[mi][ni]; *(f32x4*)hp = v;
                ss += (v.x * v.x + v.y * v.y) + (v.z * v.z + v.w * v.w);
                u32x2 o; o.x = pk2(v.x, v.y); o.y = pk2(v.z, v.w); *(u32x2*)(hb + (size_t)tok * D + nt * 128 + 16 * ni + 4 * q) = o; }
            ss = quad_sum(ss);
            if (q == 0) ssq[(size_t)tok * 8 + nt] = ss; }
    }
}

__device__ __forceinline__ unsigned f2key(float f) { const unsigned u = __float_as_uint(f); return u ^ ((u >> 31) ? 0xFFFFFFFFu : 0x80000000u); }
__device__ __forceinline__ float key2f(unsigned k) { const unsigned u = (k >> 31) ? (k ^ 0x80000000u) : ~k; return __uint_as_float(u); }
__device__ __forceinline__ void top16_insert(unsigned (&lst)[16], unsigned x) {
#pragma unroll
    for (int i = 0; i < 16; ++i) { const unsigned a = lst[i]; lst[i] = a > x ? a : x; x = a > x ? x : a; }
}
__device__ __forceinline__ void phase_F(const Ctx& c0, int l) {
    Ctx c = reopaque(c0);
    const bf16* hb = WSP(bf16, WS_HB); const bf16* Wpq = (const bf16*)(c.ws + WS_WIN + l * SZ_WLAYER + OFF_WPQ); const bf16* keys = (const bf16*)(c.ws + WS_WIN + l * SZ_WLAYER + OFF_KEYS);
    const float* ssq = WSP(float, WS_SSQ); float* sv = WSP(float, WS_SV); unsigned char* si = WSP(unsigned char, WS_SI);
    const int tid = c.tid, wave = c.wave, lane = c.lane, r = lane & 15, q = lane >> 4;
    unsigned char* lds = c.lds;
    for (int it = c.vb; it < MT * 16; it += c.G) {
        const int mt = it / 16, hp = it % 16;
        f32x4 acc[2][8]; acc_zero(acc);
        gemm_core(acc, hb + (size_t)mt * 128 * D, D, Wpq + (size_t)hp * 128 * D, D, D, lds, tid);
#pragma unroll
        for (int mi = 0; mi < 2; ++mi) { const int row = 32 * wave + 16 * mi + r; const float rs = rstd_from_ssq8(ssq, mt * 128 + row);
#pragma unroll
            for (int ni = 0; ni < 8; ++ni) { const f32x4 v = acc[mi][ni] * rs; u32x2 o; o.x = pk2(v.x, v.y); o.y = pk2(v.z, v.w);
                *(u32x2*)(lds + (ni >> 2) * 32768 + lds_off(row, 2 * (ni & 3) + (q >> 1)) + 8 * (q & 1)) = o; } }
        { const int chunk = tid & 7, row0 = tid >> 3; const bf16* pb = keys + ((size_t)hp * 128 + row0) * 128 + chunk * 8;
#pragma unroll
          for (int s = 0; s < 2; ++s)
#pragma unroll
              for (int i = 0; i < 4; ++i) *(u32x4*)(lds + s * 32768 + 16384 + lds_off(row0 + 32 * i, chunk)) = *(const u32x4*)(pb + (size_t)(32 * i) * 128 + s * 64); }
        __syncthreads();
        acc_zero(acc);
        gemm_compute_stage(acc, lds, lds + 16384, wave, lane);
        gemm_compute_stage(acc, lds + 32768, lds + 32768 + 16384, wave, lane);
        __syncthreads();
        float* S = (float*)lds;
#pragma unroll
        for (int mi = 0; mi < 2; ++mi) { const int row = 32 * wave + 16 * mi + r;
#pragma unroll
            for (int ni = 0; ni < 8; ++ni) *(f32x4*)(S + row * 132 + 16 * ni + 4 * q) = acc[mi][ni]; }
        __syncthreads();
        if (tid < 128) {
            unsigned lst[16];
#pragma unroll
            for (int i = 0; i < 16; ++i) lst[i] = 0u;
            const float* row = S + tid * 132;
#pragma unroll 4
            for (int j = 0; j < 32; ++j) { const f32x4 v = *(const f32x4*)(row + 4 * j);
                top16_insert(lst, (f2key(v.x) & ~127u) | (unsigned)(127 - (4 * j)));
                top16_insert(lst, (f2key(v.y) & ~127u) | (unsigned)(127 - (4 * j + 1)));
                top16_insert(lst, (f2key(v.z) & ~127u) | (unsigned)(127 - (4 * j + 2)));
                top16_insert(lst, (f2key(v.w) & ~127u) | (unsigned)(127 - (4 * j + 3))); }
            const int tok = mt * 128 + tid;
            unsigned idx[16]; float val[16];
#pragma unroll
            for (int i = 0; i < 16; ++i) { idx[i] = 127u - (lst[i] & 127u); val[i] = row[idx[i]]; }
            float* svp = sv + ((size_t)tok * 16 + hp) * 16;
#pragma unroll
            for (int i = 0; i < 4; ++i) *(f32x4*)(svp + 4 * i) = (f32x4){val[4 * i], val[4 * i + 1], val[4 * i + 2], val[4 * i + 3]};
            u32x4 pi;
            pi.x = idx[0] | (idx[1] << 8) | (idx[2] << 16) | (idx[3] << 24); pi.y = idx[4] | (idx[5] << 8) | (idx[6] << 16) | (idx[7] << 24);
            pi.z = idx[8] | (idx[9] << 8) | (idx[10] << 16) | (idx[11] << 24); pi.w = idx[12] | (idx[13] << 8) | (idx[14] << 16) | (idx[15] << 24);
            *(u32x4*)(si + ((size_t)tok * 16 + hp) * 16) = pi;
        }
        __syncthreads();
    }
}

__device__ __forceinline__ void phase_F3(const Ctx& c0, int l) {
    Ctx c = reopaque(c0);
    const float* sv = WSP(float, WS_SV); const unsigned char* si = WSP(unsigned char, WS_SI); int* eidx = WSP(int, WS_EIDX); float* gw = WSP(float, WS_GW); unsigned char* stb = WSP(unsigned char, WS_STB);
    float* lsv = (float*)c.lds;
    unsigned char* lsi = c.lds + 256 * 33 * 4;
    const int tid = c.tid;
    for (int base = c.vb * NTHREADS; base < T * 8; base += c.G * NTHREADS) {
        const int th = base + tid;
        float a[16], b[16];
#pragma unroll
        for (int i = 0; i < 4; ++i) { const f32x4 x = *(const f32x4*)(sv + (size_t)th * 32 + 4 * i), y = *(const f32x4*)(sv + (size_t)th * 32 + 16 + 4 * i);
            a[4 * i] = x.x; a[4 * i + 1] = x.y; a[4 * i + 2] = x.z; a[4 * i + 3] = x.w; b[4 * i] = y.x; b[4 * i + 1] = y.y; b[4 * i + 2] = y.z; b[4 * i + 3] = y.w; }
        const u32x4 ia = *(const u32x4*)(si + (size_t)th * 32), ib = *(const u32x4*)(si + (size_t)th * 32 + 16);
#pragma unroll
        for (int i = 0; i < 16; ++i) { lsv[tid * 33 + i] = a[i]; lsv[tid * 33 + 16 + i] = b[i]; }
        *(u32x4*)(lsi + tid * 32) = ia; *(u32x4*)(lsi + tid * 32 + 16) = ib;
        unsigned lst[16];
#pragma unroll
        for (int i = 0; i < 16; ++i) lst[i] = 0u;
#pragma unroll
        for (int i = 0; i < 16; ++i)
#pragma unroll
            for (int j = 0; j < 16; ++j)
                if ((i + 1) * (j + 1) <= 16) top16_insert(lst, (f2key(a[i] + b[j]) & ~255u) | (unsigned)(255 - (i * 16 + j)));
        __builtin_amdgcn_s_waitcnt(0xC07F); asm volatile("" ::: "memory");
        float s[16]; int e[16];
#pragma unroll
        for (int k = 0; k < 16; ++k) { const unsigned code = 255u - (lst[k] & 255u); const int i = code >> 4, j = code & 15;
            s[k] = lsv[tid * 33 + i] + lsv[tid * 33 + 16 + j]; e[k] = (int)lsi[tid * 32 + i] * 128 + (int)lsi[tid * 32 + 16 + j]; }
        float mx = s[0];
#pragma unroll
        for (int k = 1; k < 16; ++k) mx = fmaxf(mx, s[k]);
        float sum = 0.f;
#pragma unroll
        for (int k = 0; k < 16; ++k) { s[k] = fast_exp2((s[k] - mx) * 1.4426950409f); sum += s[k]; }
        const float inv = 1.0f / sum;
        typedef unsigned long long u64;
        u64 hlo = 0ull, hhi = 0ull;
#pragma unroll
        for (int k = 0; k < 16; ++k) { const int sl = e[k] >> 10; if (sl < 8) hlo += 1ull << (8 * sl); else hhi += 1ull << (8 * (sl - 8)); }
        u64 ilo = hlo, ihi = hhi;
#pragma unroll
        for (int d = 1; d < 8; d <<= 1) { const u64 a_ = __shfl_up(ilo, d, 8), b_ = __shfl_up(ihi, d, 8); if ((tid & 7) >= d) { ilo += a_; ihi += b_; } }
        const u64 tlo = __shfl(ilo, 7, 8), thi = __shfl(ihi, 7, 8);
        const u64 ones = 0x0101010101010101ull;
        const u64 inlo = tlo * ones, inhi = thi * ones + (inlo >> 56) * ones;
        const u64 stlo = inlo - tlo, sthi = inhi - thi;
        u64 rlo = stlo + (ilo - hlo), rhi = sthi + (ihi - hhi);
        const int tokn = th >> 3;
#pragma unroll
        for (int k = 0; k < 16; ++k) { const int sl = e[k] >> 10; int pos;
            if (sl < 8) { pos = (int)((rlo >> (8 * sl)) & 255ull); rlo += 1ull << (8 * sl); } else { pos = (int)((rhi >> (8 * (sl - 8))) & 255ull); rhi += 1ull << (8 * (sl - 8)); }
            eidx[(size_t)tokn * 128 + pos] = e[k]; gw[(size_t)tokn * 128 + pos] = s[k] * inv; }
        if ((tid & 7) == 0) { u64* sp = (u64*)(stb + (size_t)tokn * 16); sp[0] = stlo; sp[1] = sthi; }
        __builtin_amdgcn_s_waitcnt(0xC07F); asm volatile("" ::: "memory");
    }
}

typedef float f32x2 __attribute__((ext_vector_type(2)));
constexpr int G2_WSTRIDE = 14336, G2_MAXTOK = 9;
__device__ __forceinline__ float fp8dot4(unsigned w, unsigned x01, unsigned x23, float acc) {
    const bf16x2 lo = __builtin_amdgcn_cvt_scalef32_pk_bf16_fp8(w, 1.0f, false), hi = __builtin_amdgcn_cvt_scalef32_pk_bf16_fp8(w, 1.0f, true);
    acc = __builtin_amdgcn_fdot2_f32_bf16(lo, __builtin_bit_cast(bf16x2, x01), acc, false);
    return __builtin_amdgcn_fdot2_f32_bf16(hi, __builtin_bit_cast(bf16x2, x23), acc, false);
}
__device__ __forceinline__ float reduce8_transposed(const float (&p)[8], int lane) {
    float s[4];
#pragma unroll
    for (int k = 0; k < 4; ++k) { auto r = __builtin_amdgcn_permlane32_swap(__float_as_uint(p[k]), __float_as_uint(p[k + 4]), false, false); s[k] = __uint_as_float(r[0]) + __uint_as_float(r[1]); }
    float t[2];
#pragma unroll
    for (int k = 0; k < 2; ++k) { auto r = __builtin_amdgcn_permlane16_swap(__float_as_uint(s[k]), __float_as_uint(s[k + 2]), false, false); t[k] = __uint_as_float(r[0]) + __uint_as_float(r[1]); }
    const float u0 = t[0] + dpp<0x128>(t[0]), u1 = t[1] + dpp<0x128>(t[1]);
    float r = (lane & 8) ? u1 : u0;
    r += dpp<0xB1>(r); r += dpp<0x4E>(r); r += dpp<0x141>(r);
    return r;
}
typedef int i32x4 __attribute__((ext_vector_type(4)));
__device__ __forceinline__ void fp8fma4(f32x2 (&acc)[8], int o, unsigned w, f32x2 a2) {
    const f32x2 lo = __builtin_amdgcn_cvt_scalef32_pk_f32_fp8(w, 1.0f, false), hi = __builtin_amdgcn_cvt_scalef32_pk_f32_fp8(w, 1.0f, true);
    acc[o] = __builtin_elementwise_fma(a2, lo, acc[o]); acc[o + 1] = __builtin_elementwise_fma(a2, hi, acc[o + 1]);
}
__device__ __forceinline__ void g2_u_chunk(u32x4 (&u)[8], const unsigned char* U, const int* pe_next, const float* pw_c, float* act_c, const u32x4 xa, const u32x4 xb, float rs, int lane) {
    const i32x4 e0 = *(const i32x4*)pe_next, e1 = *(const i32x4*)(pe_next + 4);
    const int en[8] = {e0.x, e0.y, e0.z, e0.w, e1.x, e1.y, e1.z, e1.w};
    float p[8];
#pragma unroll
    for (int k = 0; k < 8; ++k) {
        float d0 = fp8dot4(u[k].x, xa.x, xa.y, 0.f), d1 = fp8dot4(u[k].y, xa.z, xa.w, 0.f); d0 = fp8dot4(u[k].z, xb.x, xb.y, d0); d1 = fp8dot4(u[k].w, xb.z, xb.w, d1); p[k] = d0 + d1;
        asm volatile("" : "+v"(p[k]));
        u[k] = *(const u32x4*)(U + (size_t)__builtin_amdgcn_readfirstlane(en[k]) * 1024 + lane * 16);
    }
    const float a = reduce8_transposed(p, lane);
    const int row = (lane >> 3) & 7;
    if ((lane & 7) == 0) act_c[row] = gelu_tanh(a * rs) * pw_c[row];
}
__device__ __forceinline__ void g2_v_chunk(u32x4 (&v)[8], const unsigned char* V, const int* pe_next, const float* act_c, f32x2 (&acc)[8], int lane) {
    const i32x4 e0 = *(const i32x4*)pe_next, e1 = *(const i32x4*)(pe_next + 4);
    const int en[8] = {e0.x, e0.y, e0.z, e0.w, e1.x, e1.y, e1.z, e1.w};
    const f32x4 a0 = *(const f32x4*)act_c, a1 = *(const f32x4*)(act_c + 4);
    const float av[8] = {a0.x, a0.y, a0.z, a0.w, a1.x, a1.y, a1.z, a1.w};
#pragma unroll
    for (int k = 0; k < 8; ++k) { const f32x2 a2 = (f32x2){av[k], av[k]};
        fp8fma4(acc, 0, v[k].x, a2); fp8fma4(acc, 2, v[k].y, a2); fp8fma4(acc, 4, v[k].z, a2); fp8fma4(acc, 6, v[k].w, a2);
        asm volatile("" : "+v"(acc[0]), "+v"(acc[1]), "+v"(acc[2]), "+v"(acc[3]), "+v"(acc[4]), "+v"(acc[5]), "+v"(acc[6]), "+v"(acc[7]));
        v[k] = *(const u32x4*)(V + (size_t)__builtin_amdgcn_readfirstlane(en[k]) * 1024 + lane * 16);
    }
}
__device__ __forceinline__ void phase_G2(const Ctx& c0, int l) {
    Ctx c = reopaque(c0);
    const bf16* hb = WSP(bf16, WS_HB); const float* ssq = WSP(float, WS_SSQ); const int* pe = WSP(int, WS_EIDX); const float* pw = WSP(float, WS_GW);
    const unsigned char* U = c.ws + WS_TAB + (size_t)(l * 2) * SZ_TAB; const unsigned char* V = c.ws + WS_TAB + (size_t)(l * 2 + 1) * SZ_TAB;
    float* h = WSP(float, WS_H); bf16* hbw = WSP(bf16, WS_HB); float* ssqw = WSP(float, WS_SSQ);
    const int lane = c.lane;
    const int NW = c.G * 4, gw = c.vb * 4 + c.wave, base_t = T / NW, rem = T % NW;
    const int t0 = gw * base_t + (gw < rem ? gw : rem), nt = base_t + (gw < rem ? 1 : 0);
    unsigned char* wl = c.lds + c.wave * G2_WSTRIDE;
    int* pe_l = (int*)wl; float* pw_l = (float*)(wl + 4608); float* act_l = (float*)(wl + 9216);
    {
        u32x4 xa[G2_MAXTOK], xb[G2_MAXTOK]; float rs[G2_MAXTOK];
#pragma unroll
        for (int j = 0; j < G2_MAXTOK; ++j) { const int tok = t0 + (j < nt ? j : 0);
            pe_l[j * 128 + lane] = pe[(size_t)tok * 128 + lane]; pe_l[j * 128 + 64 + lane] = pe[(size_t)tok * 128 + 64 + lane];
            pw_l[j * 128 + lane] = pw[(size_t)tok * 128 + lane] * TAB_INV; pw_l[j * 128 + 64 + lane] = pw[(size_t)tok * 128 + 64 + lane] * TAB_INV;
            xa[j] = *(const u32x4*)(hb + (size_t)tok * D + lane * 16); xb[j] = *(const u32x4*)(hb + (size_t)tok * D + lane * 16 + 8); rs[j] = rstd_from_ssq8(ssq, tok) * TAB_INV; }
        u32x4 u[8];
#pragma unroll
        for (int k = 0; k < 8; ++k) u[k] = *(const u32x4*)(U + (size_t)__builtin_amdgcn_readfirstlane(pe_l[k]) * 1024 + lane * 16);
#pragma unroll 1
        for (int ch = 0; ch < 16; ++ch) {
            const int cn = ch < 15 ? ch + 1 : 0;
#pragma unroll
            for (int j = 0; j < G2_MAXTOK; ++j) if (j < nt) {
                const bool lastj = (j + 1 >= nt);
                const int* pe_next = lastj ? pe_l + cn * 8 : pe_l + (j + 1) * 128 + ch * 8;
                g2_u_chunk(u, U, pe_next, pw_l + j * 128 + ch * 8, act_l + j * 128 + ch * 8, xa[j], xb[j], rs[j], lane); }
        }
    }
    f32x2 acc[G2_MAXTOK][8];
#pragma unroll
    for (int j = 0; j < G2_MAXTOK; ++j)
#pragma unroll
        for (int i = 0; i < 8; ++i) acc[j][i] = (f32x2){0.f, 0.f};
    {
        u32x4 v[8];
#pragma unroll
        for (int k = 0; k < 8; ++k) v[k] = *(const u32x4*)(V + (size_t)__builtin_amdgcn_readfirstlane(pe_l[k]) * 1024 + lane * 16);
#pragma unroll 1
        for (int ch = 0; ch < 16; ++ch) {
            const int cn = ch < 15 ? ch + 1 : 0;
#pragma unroll
            for (int j = 0; j < G2_MAXTOK; ++j) if (j < nt) {
                const bool lastj = (j + 1 >= nt);
                const int* pe_next = lastj ? pe_l + cn * 8 : pe_l + (j + 1) * 128 + ch * 8;
                g2_v_chunk(v, V, pe_next, act_l + j * 128 + ch * 8, acc[j], lane); }
        }
    }
#pragma unroll
    for (int j = 0; j < G2_MAXTOK; ++j) if (j < nt) {
        const int tok = t0 + j;
        float* hp = h + (size_t)tok * D + lane * 16;
        f32x4 r0 = *(const f32x4*)hp, r1 = *(const f32x4*)(hp + 4), r2 = *(const f32x4*)(hp + 8), r3 = *(const f32x4*)(hp + 12);
        r0 += (f32x4){acc[j][0].x, acc[j][0].y, acc[j][1].x, acc[j][1].y}; r1 += (f32x4){acc[j][2].x, acc[j][2].y, acc[j][3].x, acc[j][3].y};
        r2 += (f32x4){acc[j][4].x, acc[j][4].y, acc[j][5].x, acc[j][5].y}; r3 += (f32x4){acc[j][6].x, acc[j][6].y, acc[j][7].x, acc[j][7].y};
        if (l == 0) {
            *(f32x4*)hp = r0; *(f32x4*)(hp + 4) = r1; *(f32x4*)(hp + 8) = r2; *(f32x4*)(hp + 12) = r3;
            u32x4 o0, o1; o0.x = pk2(r0.x, r0.y); o0.y = pk2(r0.z, r0.w); o0.z = pk2(r1.x, r1.y); o0.w = pk2(r1.z, r1.w);
            o1.x = pk2(r2.x, r2.y); o1.y = pk2(r2.z, r2.w); o1.z = pk2(r3.x, r3.y); o1.w = pk2(r3.z, r3.w);
            *(u32x4*)(hbw + (size_t)tok * D + lane * 16) = o0; *(u32x4*)(hbw + (size_t)tok * D + lane * 16 + 8) = o1;
            float ss = (r0.x * r0.x + r0.y * r0.y) + (r0.z * r0.z + r0.w * r0.w) + (r1.x * r1.x + r1.y * r1.y) + (r1.z * r1.z + r1.w * r1.w)
                     + (r2.x * r2.x + r2.y * r2.y) + (r2.z * r2.z + r2.w * r2.w) + (r3.x * r3.x + r3.y * r3.y) + (r3.z * r3.z + r3.w * r3.w);
            ss = wave_sum_dpp(ss);
            if (lane < 8) ssqw[(size_t)tok * 8 + lane] = lane == 0 ? ss : 0.f;
        } else {
            const int b = tok / L, pos = tok - b * L;
            if (pos >= NMETA) { float* op = c.out + ((size_t)b * SEQ + (pos - NMETA)) * D + lane * 16;
                *(f32x4*)op = r0; *(f32x4*)(op + 4) = r1; *(f32x4*)(op + 8) = r2; *(f32x4*)(op + 12) = r3; }
        }
    }
}

struct Args { const float* in[22]; float* out; unsigned char* ws; int ph_lo, ph_hi; };
constexpr int N_PHASES = 17;

__global__ void __launch_bounds__(NTHREADS, 2) fwd_kernel(Args args) {
    extern __shared__ __attribute__((aligned(16))) unsigned char lds_raw[];
    Ctx c;
#pragma unroll
    for (int i = 0; i < 22; ++i) c.in[i] = args.in[i];
    c.out = args.out; c.ws = args.ws; c.lds = lds_raw;
    c.tid = threadIdx.x; c.lane = c.tid & 63; c.wave = __builtin_amdgcn_readfirstlane(c.tid >> 6);
    c.G = gridDim.x; { const int bx = blockIdx.x; c.vb = (c.G % 8 == 0) ? (bx % 8) * (c.G / 8) + bx / 8 : bx; }
    volatile unsigned* misc = (volatile unsigned*)(c.lds + LDS_MISC);
    if (c.tid < 16) misc[c.tid] = 0u;
    __syncthreads();
    const int lo = args.ph_lo, hi = args.ph_hi;
    const bool multi = (hi - lo) > 1;
    XcdBarrier bar; bar.bar = WSP(unsigned, WS_CTL) + CW_BAR; bar.x = 0; bar.st = misc;
    if (multi) bar = xcd_barrier_post(WSP(unsigned, WS_CTL) + CW_BAR, misc);
#define IN_(k) (lo <= (k) && (k) < hi)
#define SEAM_(k) do { if ((k) + 1 < hi) xcd_barrier(bar); } while (0)
    if (IN_(0)) { phase_prologue(c); SEAM_(0); }
#pragma unroll 1
    for (int l = 0; l < 2; ++l) {
        const int p0 = 1 + 8 * l;
        if (IN_(p0 + 0)) { phase_A(c, l); SEAM_(p0 + 0); }
        if (IN_(p0 + 1)) { phase_B(c, l); SEAM_(p0 + 1); }
        if (IN_(p0 + 2)) { phase_C(c, l); SEAM_(p0 + 2); }
        if (IN_(p0 + 3)) { phase_D(c, l); SEAM_(p0 + 3); }
        if (IN_(p0 + 4)) { phase_E(c, l); SEAM_(p0 + 4); }
        if (IN_(p0 + 5)) { phase_F(c, l); SEAM_(p0 + 5); }
        if (IN_(p0 + 6)) { phase_F3(c, l); SEAM_(p0 + 6); }
        if (IN_(p0 + 7)) { phase_G2(c, l); SEAM_(p0 + 7); }
    }
}

extern "C" void kernel_launch(void* const* d_in, const int* in_sizes, int n_in, void* d_out, int out_size, void* d_ws, size_t ws_size, hipStream_t stream) {
    static int grid = 0;
    if (grid == 0) {
        if (n_in != 22 || out_size != NB * SEQ * D || ws_size < WS_END) { fprintf(stderr, "kernel_launch: unexpected shapes (n_in %d out %d ws %zu need %zu)\n", n_in, out_size, ws_size, (size_t)WS_END); grid = -1; return; }
        int dev = 0, cus = 0, per_cu = 0;
        hipGetDevice(&dev); hipDeviceGetAttribute(&cus, hipDeviceAttributeMultiprocessorCount, dev);
        if (hipFuncSetAttribute((const void*)fwd_kernel, hipFuncAttributeMaxDynamicSharedMemorySize, LDS_BYTES) != hipSuccess) { fprintf(stderr, "kernel_launch: hipFuncSetAttribute failed\n"); grid = -1; return; }
        if (hipOccupancyMaxActiveBlocksPerMultiprocessor(&per_cu, (const void*)fwd_kernel, NTHREADS, LDS_BYTES) != hipSuccess || per_cu < 1) { fprintf(stderr, "kernel_launch: occupancy query failed (%d)\n", per_cu); per_cu = 1; (void)hipGetLastError(); }
        if (per_cu > 2) per_cu = 2;
        grid = cus * per_cu;
        if ((long)grid * 4 * G2_MAXTOK < T || (long)grid * 4 * (G2_MAXTOK - 1) > T) { fprintf(stderr, "kernel_launch: grid %d unsupported by phase G2 (needs 8..9 tokens per wave)\n", grid); grid = -1; return; }
        fprintf(stderr, "kernel_launch: grid %d (%d per CU), lds %d, ws need %zu have %zu\n", grid, per_cu, LDS_BYTES, (size_t)WS_END, ws_size);
    }
    if (grid < 0) return;
    hipMemsetAsync((char*)d_ws + WS_CTL, 0, CTL_BYTES, stream);
    Args a{};
    for (int i = 0; i < 22; ++i) a.in[i] = (const float*)d_in[i];
    a.out = (float*)d_out; a.ws = (unsigned char*)d_ws;
#if MK_PER_PHASE
    for (int ph = 0; ph < N_PHASES; ++ph) { a.ph_lo = ph; a.ph_hi = ph + 1; hipLaunchKernelGGL(fwd_kernel, dim3(grid), dim3(NTHREADS), LDS_BYTES, stream, a); }
#else
    a.ph_lo = 0; a.ph_hi = N_PHASES;
    void* kargs[] = {&a};
    hipError_t e = hipLaunchCooperativeKernel((const void*)fwd_kernel, dim3(grid), dim3(NTHREADS), kargs, LDS_BYTES, stream);
    if (e != hipSuccess) fprintf(stderr, "kernel_launch: cooperative launch failed: %s (grid %d)\n", hipGetErrorString(e), grid);
#endif
}
```

```cpp
#include <hip/hip_runtime.h>
#include <cstdio>
#include <cstdint>

#ifndef MK_PER_PHASE
#define MK_PER_PHASE 0
#endif

typedef unsigned short bf16;
typedef short bf16x8 __attribute__((ext_vector_type(8)));
typedef float f32x4 __attribute__((ext_vector_type(4)));
typedef unsigned u32x4 __attribute__((ext_vector_type(4)));
typedef unsigned u32x2 __attribute__((ext_vector_type(2)));
typedef __bf16 bf16x2 __attribute__((ext_vector_type(2)));

constexpr int NB = 8, SEQ = 2048, NMETA = 16, L = SEQ + NMETA, T = NB * L, D = 1024;
constexpr int DC = 512, CW = 31, NH = 8, QL = 256, KVL = 128, NOPE = 64, ROPE = 32, QK = 96, VD = 64;
constexpr int NIN = 3488, NINP = 3584;
constexpr int NEXP = 16384;
constexpr float EPS = 1e-6f;
constexpr int MT = T / 128;
static_assert(T % 128 == 0, "T tiles");

constexpr size_t al256(size_t x) { return (x + 255) & ~(size_t)255; }
constexpr size_t WS_CTL = 0;
constexpr size_t CTL_BYTES = 65536;
constexpr size_t WS_ROPE = WS_CTL + CTL_BYTES;
constexpr size_t WS_WIN = al256(WS_ROPE + (size_t)L * 16 * 8);
constexpr size_t SZ_WIN = (size_t)NINP * 1024 * 2, SZ_WCO = (size_t)1024 * 512 * 2, SZ_WUQ = (size_t)1024 * 256 * 2, SZ_WUKV = (size_t)1024 * 128 * 2,
                 SZ_WMLA = (size_t)1024 * 512 * 2, SZ_WOUT = (size_t)1024 * 1024 * 2, SZ_WPQ = (size_t)2048 * 1024 * 2, SZ_KEYS = (size_t)16 * 128 * 128 * 2;
constexpr size_t OFF_WCO = SZ_WIN, OFF_WUQ = OFF_WCO + SZ_WCO, OFF_WUKV = OFF_WUQ + SZ_WUQ, OFF_WMLA = OFF_WUKV + SZ_WUKV, OFF_WOUT = OFF_WMLA + SZ_WMLA,
                 OFF_WPQ = OFF_WOUT + SZ_WOUT, OFF_KEYS = OFF_WPQ + SZ_WPQ, SZ_WLAYER = OFF_KEYS + SZ_KEYS;
constexpr size_t WS_TAB = al256(WS_WIN + 2 * SZ_WLAYER);
constexpr size_t SZ_TAB = (size_t)NEXP * 1024;
constexpr float TAB_SCALE = 256.0f, TAB_INV = 1.0f / 256.0f;
constexpr size_t WS_H = al256(WS_TAB + 4 * SZ_TAB);
constexpr size_t WS_HB = al256(WS_H + (size_t)T * 1024 * 4);
constexpr size_t WS_SSQ = al256(WS_HB + (size_t)T * 1024 * 2);
constexpr size_t WS_UGLU = al256(WS_SSQ + (size_t)T * 8 * 4);
constexpr size_t WS_CQ = al256(WS_UGLU + (size_t)T * 512 * 2);
constexpr size_t WS_CKV = al256(WS_CQ + (size_t)T * 256 * 2);
constexpr size_t WS_KROPE = al256(WS_CKV + (size_t)T * 128 * 2);
constexpr size_t WS_SSQQ = al256(WS_KROPE + (size_t)T * 32 * 4);
constexpr size_t WS_SSQKV = al256(WS_SSQQ + (size_t)T * 2 * 4);
constexpr size_t WS_U2 = al256(WS_SSQKV + (size_t)T * 4);
constexpr size_t WS_Q = al256(WS_U2 + (size_t)T * 512 * 2);
constexpr size_t WS_K = al256(WS_Q + (size_t)T * NH * QK * 2);
constexpr size_t WS_VT = al256(WS_K + (size_t)T * NH * QK * 2);
constexpr size_t WS_O = al256(WS_VT + (size_t)T * NH * VD * 2 + 4096);
constexpr size_t WS_MERGED = al256(WS_O + (size_t)T * 512 * 2);
constexpr size_t WS_GATES = al256(WS_MERGED + (size_t)T * 1024 * 2);
constexpr size_t WS_SV = WS_GATES;
constexpr size_t WS_SI = al256(WS_SV + (size_t)T * 256 * 4);
constexpr size_t WS_EIDX = al256(WS_SI + (size_t)T * 256);
constexpr size_t WS_GW = al256(WS_EIDX + (size_t)T * 128 * 4);
constexpr size_t WS_STB = al256(WS_GW + (size_t)T * 128 * 4);
constexpr size_t WS_PEER_END = WS_STB + (size_t)T * 16;
constexpr size_t WS_END = al256(WS_GATES + (size_t)T * 2048 * 2);
static_assert(WS_PEER_END <= WS_END, "peer scratch overlay");

constexpr int CW_BAR = 0;
constexpr int CW_QUEUE = 4096;

constexpr int LDS_MAIN = 128 * 132 * 4;
constexpr int LDS_MISC = LDS_MAIN;
constexpr int LDS_BYTES = LDS_MAIN + 64;

constexpr int NTHREADS = 256;

__device__ __forceinline__ unsigned pk2(float lo, float hi) { bf16x2 v; v.x = (__bf16)lo; v.y = (__bf16)hi; return __builtin_bit_cast(unsigned, v); }
__device__ __forceinline__ float bf_lo(unsigned p) { return __uint_as_float(p << 16); }
__device__ __forceinline__ float bf_hi(unsigned p) { return __uint_as_float(p & 0xffff0000u); }
__device__ __forceinline__ float fast_rcp(float x) { return __builtin_amdgcn_rcpf(x); }
__device__ __forceinline__ float fast_exp2(float x) { return __builtin_amdgcn_exp2f(x); }
__device__ __forceinline__ float sigmoidf_(float x) { return fast_rcp(1.0f + fast_exp2(-1.4426950409f * x)); }
__device__ __forceinline__ float gelu_tanh(float x) { const float u = 1.5957691216f * (x + 0.044715f * x * x * x); return x * fast_rcp(1.0f + fast_exp2(-1.4426950409f * u)); }
__device__ __forceinline__ float rsqrt_(float x) { return __builtin_amdgcn_rsqf(x); }
__device__ __forceinline__ float quad_sum(float v) { v += __shfl_xor(v, 16); v += __shfl_xor(v, 32); return v; }
__device__ __forceinline__ float quad_max(float v) { v = fmaxf(v, __shfl_xor(v, 16)); v = fmaxf(v, __shfl_xor(v, 32)); return v; }
__device__ __forceinline__ float wave_sum(float v) {
#pragma unroll
    for (int o = 1; o < 64; o <<= 1) v += __shfl_xor(v, o);
    return v;
}
template <int CTRL> __device__ __forceinline__ float dpp(float x) { return __builtin_bit_cast(float, __builtin_amdgcn_mov_dpp(__builtin_bit_cast(int, x), CTRL, 0xf, 0xf, true)); }
__device__ __forceinline__ float xrow16_sum(float x) {
    auto s = __builtin_amdgcn_permlane16_swap(__float_as_uint(x), __float_as_uint(x), false, false);
    x = __uint_as_float(s[0]) + __uint_as_float(s[1]);
    auto t = __builtin_amdgcn_permlane32_swap(__float_as_uint(x), __float_as_uint(x), false, false);
    return __uint_as_float(t[0]) + __uint_as_float(t[1]);
}
__device__ __forceinline__ float wave_sum_dpp(float x) {
    x += dpp<0xB1>(x); x += dpp<0x4E>(x); x += dpp<0x141>(x); x += dpp<0x128>(x); return xrow16_sum(x);
}
__device__ __forceinline__ float dot2(unsigned a, unsigned b, float c) { return __builtin_amdgcn_fdot2_f32_bf16(__builtin_bit_cast(bf16x2, a), __builtin_bit_cast(bf16x2, b), c, false); }

#define XB_TMO      128
#define XB_XCNT(j)  (256  + 64 * (j))
#define XB_XSUB(j)  (1280 + 64 * (j))
#define XB_XGEN(j)  (2304 + 64 * (j))
#define XB_TOP      3328
#define XB_TOPGEN   3392
#define XCD_BAR_WORDS 3456
#define XB_SPIN_CAP (1u << 20)
__device__ __forceinline__ unsigned xb_ld(unsigned* p)              { return __hip_atomic_load(p, __ATOMIC_RELAXED, __HIP_MEMORY_SCOPE_AGENT); }
__device__ __forceinline__ unsigned xb_add(unsigned* p, unsigned v) { return __hip_atomic_fetch_add(p, v, __ATOMIC_RELAXED, __HIP_MEMORY_SCOPE_AGENT); }
__device__ __forceinline__ unsigned xb_xcc_id() { return (unsigned)__builtin_amdgcn_s_getreg((3 << 11) | 20) & 0xFu; }
#define XB_SPIN(cond, bar) do { unsigned _sp = 0; while (cond) { __builtin_amdgcn_s_sleep(1); \
    if ((++_sp & 255u) == 0u) { if (xb_ld(&(bar)[XB_TMO])) break; if (_sp > XB_SPIN_CAP) { atomicAdd(&(bar)[XB_TMO], 1u); break; } } } } while (0)
struct XcdBarrier { unsigned* bar; unsigned x; volatile unsigned* st; };
__device__ __forceinline__ XcdBarrier xcd_barrier_post(unsigned* bar, volatile unsigned* st) {
    XcdBarrier b; b.bar = bar; b.x = xb_xcc_id(); b.st = st;
    if (threadIdx.x == 0) (void)xb_add(&bar[XB_XCNT(b.x)], 1u);
    return b;
}
__device__ __forceinline__ void xcd_barrier_complete(unsigned* bar, unsigned x, unsigned& nloc, unsigned& nx) {
    const unsigned G = gridDim.x * gridDim.y * gridDim.z;
    unsigned sum, cnt, mine, sp = 0u;
    for (;;) {
        sum = 0u; cnt = 0u; mine = 0u;
#pragma unroll
        for (unsigned j = 0; j < 16; ++j) { const unsigned c = xb_ld(&bar[XB_XCNT(j)]); sum += c; cnt += (c > 0u) ? 1u : 0u; mine = (j == x) ? c : mine; }
        if (sum == G) break;
        __builtin_amdgcn_s_sleep(1);
        if ((++sp & 255u) == 0u) { if (xb_ld(&bar[XB_TMO])) break; if (sp > XB_SPIN_CAP) { atomicAdd(&bar[XB_TMO], 1u); break; } }
    }
    nloc = mine > 0u ? mine : 1u; nx = cnt > 0u ? cnt : 1u;
}
__device__ __forceinline__ void xcd_barrier(const XcdBarrier& b) {
    asm volatile("s_waitcnt vmcnt(0)" ::: "memory");
    __syncthreads();
    if (threadIdx.x == 0) {
        unsigned* bar = b.bar;
        __builtin_amdgcn_s_waitcnt(0);
        unsigned nloc = b.st[0], nx = b.st[1];
        if (nloc == 0u) { xcd_barrier_complete(bar, b.x, nloc, nx); b.st[0] = nloc; b.st[1] = nx; }
        const unsigned old = xb_add(&bar[XB_XSUB(b.x)], 1u);
        const unsigned gen = old / nloc;
        if (old + 1u == (gen + 1u) * nloc) {
            __builtin_amdgcn_fence(__ATOMIC_RELEASE, "agent");
            asm volatile("s_waitcnt vmcnt(0)" ::: "memory");
            const unsigned og = xb_add(&bar[XB_TOP], 1u);
            const unsigned tg = og / nx;
            if (og + 1u == (tg + 1u) * nx) xb_add(&bar[XB_TOPGEN], 1u);
            else XB_SPIN(xb_ld(&bar[XB_TOPGEN]) == tg, bar);
            __builtin_amdgcn_fence(__ATOMIC_ACQUIRE, "agent");
            xb_add(&bar[XB_XGEN(b.x)], 1u);
            asm volatile("s_waitcnt vmcnt(0)" ::: "memory");
        } else {
            XB_SPIN(xb_ld(&bar[XB_XGEN(b.x)]) == gen, bar);
            __builtin_amdgcn_fence(__ATOMIC_ACQUIRE, "agent");
            asm volatile("s_waitcnt vmcnt(0)" ::: "memory");
        }
    }
    __syncthreads();
}

struct Ctx {
    const float* in[22]; float* out; unsigned char* ws;
    unsigned char* lds; int tid, lane, wave, G, vb;
};
#define WSP(T_, off) ((T_*)(c.ws + (off)))
__device__ __forceinline__ Ctx reopaque(const Ctx& c0) {
    Ctx c = c0; int t = c0.tid; asm volatile("" : "+v"(t)); c.tid = t; c.lane = t & 63; c.wave = __builtin_amdgcn_readfirstlane(t >> 6);
    int vb = c0.vb; asm volatile("" : "+s"(vb)); c.vb = vb; return c;
}

__device__ __forceinline__ int lds_off(int row, int chunk) { return row * 128 + ((chunk ^ (row & 7)) << 4); }

__device__ __forceinline__ void gemm_compute_stage(f32x4 (&acc)[2][8], const unsigned char* sA, const unsigned char* sB, int wave, int lane) {
    const int r = lane & 15, q = lane >> 4;
#pragma unroll
    for (int ks = 0; ks < 2; ++ks) {
        bf16x8 af[2], bfr[8];
#pragma unroll
        for (int mi = 0; mi < 2; ++mi) af[mi] = *(const bf16x8*)(sA + lds_off(32 * wave + 16 * mi + r, 4 * ks + q));
#pragma unroll
        for (int ni = 0; ni < 8; ++ni) bfr[ni] = *(const bf16x8*)(sB + lds_off(16 * ni + r, 4 * ks + q));
#pragma unroll
        for (int mi = 0; mi < 2; ++mi)
#pragma unroll
            for (int ni = 0; ni < 8; ++ni) acc[mi][ni] = __builtin_amdgcn_mfma_f32_16x16x32_bf16(bfr[ni], af[mi], acc[mi][ni], 0, 0, 0);
    }
}

#define LAS __attribute__((address_space(3)))
__device__ __forceinline__ void gemm_stage_glds(const bf16* A, int lda, const bf16* Bt, int ldb, int kt, unsigned char* stage, int wave, int lane) {
    const int rr = lane >> 3, cch = (lane & 7) ^ rr;
#pragma unroll
    for (int i = 0; i < 4; ++i) { const int pc = 4 * i + wave;
        __builtin_amdgcn_global_load_lds((const unsigned*)(A + (size_t)(8 * pc + rr) * lda + kt * 64 + cch * 8), (LAS unsigned*)(stage + pc * 1024), 16, 0, 0);
        __builtin_amdgcn_global_load_lds((const unsigned*)(Bt + (size_t)(8 * pc + rr) * ldb + kt * 64 + cch * 8), (LAS unsigned*)(stage + 16384 + pc * 1024), 16, 0, 0); }
}
__device__ __forceinline__ void gemm_core(f32x4 (&acc)[2][8], const bf16* A, int lda, const bf16* Bt, int ldb, int K, unsigned char* lds, int tid) {
    const int wave = __builtin_amdgcn_readfirstlane(tid >> 6), lane = tid & 63;
    const int nk = K >> 6;
    gemm_stage_glds(A, lda, Bt, ldb, 0, lds, wave, lane);
    asm volatile("s_waitcnt vmcnt(0)" ::: "memory");
    __syncthreads();
    for (int kt = 0; kt < nk; ++kt) {
        const int cur = kt & 1;
        if (kt + 1 < nk) gemm_stage_glds(A, lda, Bt, ldb, kt + 1, lds + (cur ^ 1) * 32768, wave, lane);
        gemm_compute_stage(acc, lds + cur * 32768, lds + cur * 32768 + 16384, wave, lane);
        asm volatile("s_waitcnt vmcnt(0)" ::: "memory");
        __syncthreads();
    }
}
__device__ __forceinline__ void acc_zero(f32x4 (&acc)[2][8]) {
#pragma unroll
    for (int mi = 0; mi < 2; ++mi)
#pragma unroll
        for (int ni = 0; ni < 8; ++ni) acc[mi][ni] = (f32x4){0.f, 0.f, 0.f, 0.f};
}
__device__ __forceinline__ float rstd_from_ssq8(const float* ssq, int tok) {
    const f32x4 a = *(const f32x4*)(ssq + (size_t)tok * 8), b = *(const f32x4*)(ssq + (size_t)tok * 8 + 4);
    const float s = ((a.x + a.y) + (a.z + a.w)) + ((b.x + b.y) + (b.z + b.w));
    return rsqrt_(s * (1.0f / 1024.0f) + EPS);
}

__device__ __forceinline__ int src_col(int mode, int np) {
    if (mode == 0) return np;
    if (mode == 2) { const int h = np >> 7, j = np & 127; return j < 96 ? h * 96 + j : -1; }
    if (np < 1024) { const int cblk = np >> 7, j = np & 127; return j < 64 ? 64 * cblk + j : 512 + 64 * cblk + (j - 64); }
    if (np < 1408) return np;
    if (np < 1536) { const int j = np - 1408; return j < 32 ? 1408 + j : -1; }
    return 1440 + (np - 1536);
}
__device__ __forceinline__ void p0_transpose_item(const float* W, int K, int N, bf16* Wt, int mode, const float* g, int item, float* scr, int lane) {
    const int nblk_k = K / 64, nb = item / nblk_k, kb = item % nblk_k, k0 = 64 * kb, n0 = 32 * nb;
    const int n = src_col(mode, n0 + (lane & 31));
#pragma unroll 8
    for (int i = 0; i < 32; ++i) { const int kk = 2 * i + (lane >> 5); float v = 0.f; if (n >= 0) { v = W[(size_t)(k0 + kk) * N + n]; if (g) v *= g[k0 + kk]; } scr[kk * 33 + (lane & 31)] = v; }
    __builtin_amdgcn_s_waitcnt(0xC07F); asm volatile("" ::: "memory");
    const int cch = lane & 7;
#pragma unroll
    for (int j = 0; j < 4; ++j) { const int nl = (lane >> 3) + 8 * j; const float* s = scr + (8 * cch) * 33 + nl;
        u32x4 o; o.x = pk2(s[0 * 33], s[1 * 33]); o.y = pk2(s[2 * 33], s[3 * 33]); o.z = pk2(s[4 * 33], s[5 * 33]); o.w = pk2(s[6 * 33], s[7 * 33]);
        *(u32x4*)(Wt + (size_t)(n0 + nl) * K + k0 + 8 * cch) = o; }
    __builtin_amdgcn_s_waitcnt(0xC07F); asm volatile("" ::: "memory");
}
struct WDesc { int in_idx, K, N, Np, mode, g_idx; size_t off; };
__device__ __forceinline__ void phase_prologue(const Ctx& c0) {
    Ctx c = reopaque(c0);
    const int gw = c.vb * 4 + c.wave, NGW = c.G * 4;
    float* scr = (float*)(c.lds + c.wave * 8704);
    const WDesc wd[7] = {
        {3, 1024, NIN, NINP, 1, 2, 0}, {8, 512, 1024, 1024, 0, -1, OFF_WCO}, {10, 256, 768, 1024, 2, 9, OFF_WUQ}, {12, 128, 1024, 1024, 0, 11, OFF_WUKV},
        {15, 512, 1024, 1024, 0, -1, OFF_WMLA}, {16, 1024, 1024, 1024, 0, -1, OFF_WOUT}, {18, 1024, 2048, 2048, 0, 17, OFF_WPQ}};
    constexpr int ITEMS_PER_LAYER = (1024 / 64) * (NINP / 32) + (512 / 64) * 32 + (256 / 64) * 32 + (128 / 64) * 32 + (512 / 64) * 32 + (1024 / 64) * 32 + (1024 / 64) * 64;
    for (int it = gw; it < 2 * ITEMS_PER_LAYER; it += NGW) {
        const int l = it >= ITEMS_PER_LAYER ? 1 : 0; int r = it - l * ITEMS_PER_LAYER;
        const float* W = nullptr; const float* g = nullptr; bf16* Wt = nullptr; int K = 64, N = 32, mode = 0, rr = 0;
#pragma unroll
        for (int m = 0; m < 7; ++m) {
            const int items = (wd[m].K / 64) * (wd[m].Np / 32);
            if (r >= 0 && r < items) { K = wd[m].K; N = wd[m].N; mode = wd[m].mode; rr = r;
                W = c.in[wd[m].in_idx] + (size_t)l * wd[m].K * wd[m].N; g = wd[m].g_idx >= 0 ? c.in[wd[m].g_idx >= 0 ? wd[m].g_idx : 0] + (size_t)l * wd[m].K : nullptr;
                Wt = (bf16*)(c.ws + WS_WIN + l * SZ_WLAYER + wd[m].off); }
            r -= items;
        }
        p0_transpose_item(W, K, N, Wt, mode, g, rr, scr, c.lane);
    }
    const int gt = c.vb * NTHREADS + c.tid, NGT = c.G * NTHREADS;
    for (int l = 0; l < 2; ++l) {
        const float* src = c.in[19] + (size_t)l * 262144; bf16* dst = (bf16*)(c.ws + WS_WIN + l * SZ_WLAYER + OFF_KEYS);
        for (int i = gt; i < 262144 / 8; i += NGT) { const f32x4 a = *(const f32x4*)(src + i * 8), b = *(const f32x4*)(src + i * 8 + 4);
            u32x4 o; o.x = pk2(a.x, a.y); o.y = pk2(a.z, a.w); o.z = pk2(b.x, b.y); o.w = pk2(b.z, b.w); *(u32x4*)(dst + i * 8) = o; }
    }
    for (int l = 0; l < 2; ++l)
        for (int uv = 0; uv < 2; ++uv) {
            const float* src = c.in[20 + uv] + (size_t)l * NEXP * 1024; unsigned char* dst = c.ws + WS_TAB + (size_t)(l * 2 + uv) * SZ_TAB;
            f32x4 g4[4];
#pragma unroll
            for (int j = 0; j < 4; ++j) { g4[j] = (f32x4){TAB_SCALE, TAB_SCALE, TAB_SCALE, TAB_SCALE}; if (uv == 0) g4[j] = g4[j] * *(const f32x4*)(c.in[17] + l * 1024 + 256 * j + 4 * c.lane); }
            for (int row = gw; row < NEXP; row += 2 * NGW) {
                const float* sp = src + (size_t)row * 1024 + 4 * c.lane; const int row2 = row + NGW; const bool two = row2 < NEXP;
                const float* sp2 = src + (size_t)(two ? row2 : row) * 1024 + 4 * c.lane;
                f32x4 a[4], b[4];
#pragma unroll
                for (int j = 0; j < 4; ++j) { a[j] = *(const f32x4*)(sp + 256 * j); b[j] = *(const f32x4*)(sp2 + 256 * j); }
#pragma unroll
                for (int j = 0; j < 4; ++j) { const f32x4 v = a[j] * g4[j];
                    *(unsigned*)(dst + (size_t)row * 1024 + 256 * j + 4 * c.lane) = (unsigned)__builtin_amdgcn_cvt_pk_fp8_f32(v.z, v.w, __builtin_amdgcn_cvt_pk_fp8_f32(v.x, v.y, 0, false), true); }
                if (two) {
#pragma unroll
                    for (int j = 0; j < 4; ++j) { const f32x4 v = b[j] * g4[j];
                        *(unsigned*)(dst + (size_t)row2 * 1024 + 256 * j + 4 * c.lane) = (unsigned)__builtin_amdgcn_cvt_pk_fp8_f32(v.z, v.w, __builtin_amdgcn_cvt_pk_fp8_f32(v.x, v.y, 0, false), true); } }
            }
        }
    { float* rope = WSP(float, WS_ROPE);
      for (int i = gt; i < L * 16; i += NGT) { const int pos = i >> 4, j = i & 15;
          const float inv = 1.0f / __builtin_exp2f((float)j * 0.8304820237218406f);
          const float angf = (float)pos * inv; const double ang = (double)angf;
          const double nq = __builtin_rint(ang * 0.63661977236758134308);
          double rr = __builtin_fma(-nq, 1.57079632679489655800e+00, ang); rr = __builtin_fma(-nq, 6.12323399573676603587e-17, rr);
          const double r2 = rr * rr;
          double sp = -1.0 / 1307674368000.0; sp = sp * r2 + 1.0 / 6227020800.0; sp = sp * r2 - 1.0 / 39916800.0; sp = sp * r2 + 1.0 / 362880.0; sp = sp * r2 - 1.0 / 5040.0; sp = sp * r2 + 1.0 / 120.0; sp = sp * r2 - 1.0 / 6.0; sp = sp * r2 * rr + rr;
          double cp = 1.0 / 87178291200.0; cp = cp * r2 - 1.0 / 479001600.0; cp = cp * r2 + 1.0 / 3628800.0; cp = cp * r2 - 1.0 / 40320.0; cp = cp * r2 + 1.0 / 720.0; cp = cp * r2 - 1.0 / 24.0; cp = cp * r2 + 0.5; cp = 1.0 - cp * r2;
          const int qd = ((int)nq) & 3;
          const double cv = qd == 0 ? cp : qd == 1 ? -sp : qd == 2 ? -cp : sp;
          const double sv_ = qd == 0 ? sp : qd == 1 ? cp : qd == 2 ? -sp : -cp;
          rope[2 * i] = (float)cv; rope[2 * i + 1] = (float)sv_; } }
    { float* h = WSP(float, WS_H); bf16* hb = WSP(bf16, WS_HB); float* ssq = WSP(float, WS_SSQ);
      for (int t = gw; t < T; t += NGW) { const int b = t / L, pos = t % L;
          const float* src = pos < NMETA ? c.in[1] + (size_t)pos * D : c.in[0] + ((size_t)b * SEQ + (pos - NMETA)) * D;
          float s = 0.f;
#pragma unroll
          for (int j = 0; j < 4; ++j) { const f32x4 v = *(const f32x4*)(src + j * 256 + c.lane * 4); *(f32x4*)(h + (size_t)t * D + j * 256 + c.lane * 4) = v;
              u32x2 o; o.x = pk2(v.x, v.y); o.y = pk2(v.z, v.w); *(u32x2*)(hb + (size_t)t * D + j * 256 + c.lane * 4) = o; s += (v.x * v.x + v.y * v.y) + (v.z * v.z + v.w * v.w); }
          s = wave_sum(s);
          if (c.lane < 8) ssq[(size_t)t * 8 + c.lane] = c.lane == 0 ? s : 0.f; } }
}

__device__ __forceinline__ void phase_A(const Ctx& c0, int l) {
    Ctx c = reopaque(c0);
    const bf16* hb = WSP(bf16, WS_HB); const bf16* Wt = (const bf16*)(c.ws + WS_WIN + l * SZ_WLAYER);
    const float* ssq = WSP(float, WS_SSQ);
    bf16* uglu = WSP(bf16, WS_UGLU); bf16* cq = WSP(bf16, WS_CQ); bf16* ckv = WSP(bf16, WS_CKV); float* krope = WSP(float, WS_KROPE);
    float* ssqq = WSP(float, WS_SSQQ); float* ssqkv = WSP(float, WS_SSQKV); bf16* gates = WSP(bf16, WS_GATES);
    constexpr int NT = NINP / 128;
    const int r = c.lane & 15, q = c.lane >> 4;
    for (int it = c.vb; it < MT * NT; it += c.G) {
        const int mt = it / NT, nt = it % NT;
        f32x4 acc[2][8]; acc_zero(acc);
        gemm_core(acc, hb + (size_t)mt * 128 * D, D, Wt + (size_t)nt * 128 * D, D, D, c.lds, c.tid);
#pragma unroll
        for (int mi = 0; mi < 2; ++mi) {
            const int tok = mt * 128 + 32 * c.wave + 16 * mi + r;
            const float rs = rstd_from_ssq8(ssq, tok);
            if (nt < 8) {
#pragma unroll
                for (int ni = 0; ni < 4; ++ni) { const f32x4 v = acc[mi][ni] * rs, g = acc[mi][ni + 4] * rs;
                    u32x2 o; o.x = pk2(v.x * sigmoidf_(g.x), v.y * sigmoidf_(g.y)); o.y = pk2(v.z * sigmoidf_(g.z), v.w * sigmoidf_(g.w));
                    *(u32x2*)(uglu + (size_t)tok * DC + nt * 64 + 16 * ni + 4 * q) = o; }
            } else if (nt < 11) {
                bf16* dst = nt < 10 ? cq + (size_t)tok * QL + (nt - 8) * 128 : ckv + (size_t)tok * KVL;
                float ss = 0.f;
#pragma unroll
                for (int ni = 0; ni < 8; ++ni) { const f32x4 v = acc[mi][ni] * rs; ss += (v.x * v.x + v.y * v.y) + (v.z * v.z + v.w * v.w);
                    u32x2 o; o.x = pk2(v.x, v.y); o.y = pk2(v.z, v.w); *(u32x2*)(dst + 16 * ni + 4 * q) = o; }
                ss = quad_sum(ss);
                if (q == 0) { if (nt < 10) ssqq[(size_t)tok * 2 + (nt - 8)] = ss; else ssqkv[tok] = ss; }
            } else if (nt == 11) {
#pragma unroll
                for (int ni = 0; ni < 2; ++ni) *(f32x4*)(krope + (size_t)tok * 32 + 16 * ni + 4 * q) = acc[mi][ni] * rs;
            } else {
#pragma unroll
                for (int ni = 0; ni < 8; ++ni) { const f32x4 v = acc[mi][ni] * rs;
                    u32x2 o; o.x = pk2(sigmoidf_(v.x), sigmoidf_(v.y)); o.y = pk2(sigmoidf_(v.z), sigmoidf_(v.w));
                    *(u32x2*)(gates + (size_t)tok * 2048 + (nt - 12) * 128 + 16 * ni + 4 * q) = o; }
            }
        }
    }
}

__device__ __forceinline__ void phaseB_q_item(Ctx& c, int l, int mt, int head) {
    const bf16* cq = WSP(bf16, WS_CQ); const bf16* Wt = (const bf16*)(c.ws + WS_WIN + l * SZ_WLAYER + OFF_WUQ);
    const float* ssqq = WSP(float, WS_SSQQ); const float* rope = WSP(float, WS_ROPE); const float* qg = c.in[13] + l * QK; bf16* Qb = WSP(bf16, WS_Q);
    const int r = c.lane & 15, q = c.lane >> 4;
    f32x4 acc[2][8]; acc_zero(acc);
    gemm_core(acc, cq + (size_t)mt * 128 * QL, QL, Wt + (size_t)head * 128 * QL, QL, QL, c.lds, c.tid);
    constexpr float QSCALE = 0.10206207261596575f * 1.4426950408889634f;
#pragma unroll
    for (int mi = 0; mi < 2; ++mi) {
        const int tok = mt * 128 + 32 * c.wave + 16 * mi + r, b = tok / L, pos = tok - b * L;
        const float rs = rsqrt_((ssqq[(size_t)tok * 2] + ssqq[(size_t)tok * 2 + 1]) * (1.0f / 256.0f) + EPS);
        float ss = 0.f;
#pragma unroll
        for (int ni = 0; ni < 6; ++ni) { acc[mi][ni] = acc[mi][ni] * rs; const f32x4 v = acc[mi][ni]; ss += (v.x * v.x + v.y * v.y) + (v.z * v.z + v.w * v.w); }
        ss = quad_sum(ss);
        const float rn = rsqrt_(ss * (1.0f / 96.0f) + EPS) * QSCALE;
#pragma unroll
        for (int ni = 0; ni < 6; ++ni) { const f32x4 g = *(const f32x4*)(qg + 16 * ni + 4 * q); acc[mi][ni] = acc[mi][ni] * g * rn; }
        const f32x4 cs0 = *(const f32x4*)(rope + ((size_t)pos * 16 + 4 * q) * 2), cs1 = *(const f32x4*)(rope + ((size_t)pos * 16 + 4 * q) * 2 + 4);
        const float co[4] = {cs0.x, cs0.z, cs1.x, cs1.z}, si[4] = {cs0.y, cs0.w, cs1.y, cs1.w};
        f32x4 x1 = acc[mi][4], x2 = acc[mi][5];
#pragma unroll
        for (int e = 0; e < 4; ++e) { const float a = x1[e], bb = x2[e]; x1[e] = a * co[e] - bb * si[e]; x2[e] = bb * co[e] + a * si[e]; }
        acc[mi][4] = x1; acc[mi][5] = x2;
        bf16* dst = Qb + (((size_t)b * NH + head) * L + pos) * QK;
#pragma unroll
        for (int ni = 0; ni < 6; ++ni) { const f32x4 v = acc[mi][ni]; u32x2 o; o.x = pk2(v.x, v.y); o.y = pk2(v.z, v.w); *(u32x2*)(dst + 16 * ni + 4 * q) = o; }
    }
}
__device__ __forceinline__ void phaseB_kv_item(Ctx& c, int l, int mt, int head) {
    const bf16* ckv = WSP(bf16, WS_CKV); const bf16* Wt = (const bf16*)(c.ws + WS_WIN + l * SZ_WLAYER + OFF_WUKV);
    const float* ssqkv = WSP(float, WS_SSQKV); const float* rope = WSP(float, WS_ROPE); const float* kg = c.in[14] + l * QK; const float* krope = WSP(float, WS_KROPE);
    bf16* Kb = WSP(bf16, WS_K); bf16* Vt = WSP(bf16, WS_VT);
    const int tid = c.tid, wave = c.wave, lane = c.lane, r = lane & 15, q = lane >> 4;
    unsigned char* lds = c.lds;
    f32x4 ak[2][4], av[2][4];
#pragma unroll
    for (int mi = 0; mi < 2; ++mi)
#pragma unroll
        for (int ni = 0; ni < 4; ++ni) { ak[mi][ni] = (f32x4){0.f, 0.f, 0.f, 0.f}; av[mi][ni] = (f32x4){0.f, 0.f, 0.f, 0.f}; }
    { const int chunk = tid & 7, row0 = tid >> 3;
      const bf16* pa = ckv + ((size_t)mt * 128 + row0) * KVL + chunk * 8; const bf16* pb = Wt + ((size_t)head * 128 + row0) * KVL + chunk * 8;
#pragma unroll
      for (int s = 0; s < 2; ++s)
#pragma unroll
          for (int i = 0; i < 4; ++i) { *(u32x4*)(lds + s * 32768 + lds_off(row0 + 32 * i, chunk)) = *(const u32x4*)(pa + (size_t)(32 * i) * KVL + s * 64);
              *(u32x4*)(lds + s * 32768 + 16384 + lds_off(row0 + 32 * i, chunk)) = *(const u32x4*)(pb + (size_t)(32 * i) * KVL + s * 64); }
    }
    __syncthreads();
#pragma unroll
    for (int s = 0; s < 2; ++s)
#pragma unroll
        for (int ks = 0; ks < 2; ++ks) {
            const unsigned char* sA = lds + s * 32768; const unsigned char* sB = sA + 16384;
            bf16x8 af[2], bfr[8];
#pragma unroll
            for (int mi = 0; mi < 2; ++mi) af[mi] = *(const bf16x8*)(sA + lds_off(32 * wave + 16 * mi + r, 4 * ks + q));
#pragma unroll
            for (int ni = 0; ni < 8; ++ni) bfr[ni] = *(const bf16x8*)(sB + lds_off(16 * ni + r, 4 * ks + q));
#pragma unroll
            for (int mi = 0; mi < 2; ++mi)
#pragma unroll
                for (int ni = 0; ni < 4; ++ni) { ak[mi][ni] = __builtin_amdgcn_mfma_f32_16x16x32_bf16(bfr[ni], af[mi], ak[mi][ni], 0, 0, 0);
                    av[mi][ni] = __builtin_amdgcn_mfma_f32_16x16x32_bf16(af[mi], bfr[ni + 4], av[mi][ni], 0, 0, 0); }
        }
    __syncthreads();
#pragma unroll
    for (int mi = 0; mi < 2; ++mi) {
        const int tok0 = mt * 128 + 32 * wave + 16 * mi, b = tok0 / L, pos0 = tok0 - b * L;
        { const int tok = tok0 + r, pos = pos0 + r;
          const float rs = rsqrt_(ssqkv[tok] * (1.0f / 128.0f) + EPS);
          const f32x4 kr1 = *(const f32x4*)(krope + (size_t)tok * 32 + 4 * q), kr2 = *(const f32x4*)(krope + (size_t)tok * 32 + 16 + 4 * q);
          float ss = (kr1.x * kr1.x + kr1.y * kr1.y) + (kr1.z * kr1.z + kr1.w * kr1.w) + (kr2.x * kr2.x + kr2.y * kr2.y) + (kr2.z * kr2.z + kr2.w * kr2.w);
#pragma unroll
          for (int ni = 0; ni < 4; ++ni) { ak[mi][ni] = ak[mi][ni] * rs; const f32x4 v = ak[mi][ni]; ss += (v.x * v.x + v.y * v.y) + (v.z * v.z + v.w * v.w); }
          ss = quad_sum(ss);
          const float rn = rsqrt_(ss * (1.0f / 96.0f) + EPS);
          bf16* dst = Kb + (((size_t)b * NH + head) * L + pos) * QK;
#pragma unroll
          for (int ni = 0; ni < 4; ++ni) { const f32x4 g = *(const f32x4*)(kg + 16 * ni + 4 * q); const f32x4 v = ak[mi][ni] * g * rn;
              u32x2 o; o.x = pk2(v.x, v.y); o.y = pk2(v.z, v.w); *(u32x2*)(dst + 16 * ni + 4 * q) = o; }
          const f32x4 g1 = *(const f32x4*)(kg + 64 + 4 * q), g2 = *(const f32x4*)(kg + 80 + 4 * q);
          f32x4 x1 = kr1 * g1 * rn, x2 = kr2 * g2 * rn;
          const f32x4 cs0 = *(const f32x4*)(rope + ((size_t)pos * 16 + 4 * q) * 2), cs1 = *(const f32x4*)(rope + ((size_t)pos * 16 + 4 * q) * 2 + 4);
          const float co[4] = {cs0.x, cs0.z, cs1.x, cs1.z}, si[4] = {cs0.y, cs0.w, cs1.y, cs1.w};
#pragma unroll
          for (int e = 0; e < 4; ++e) { const float a = x1[e], bb = x2[e]; x1[e] = a * co[e] - bb * si[e]; x2[e] = bb * co[e] + a * si[e]; }
          u32x2 o1, o2; o1.x = pk2(x1.x, x1.y); o1.y = pk2(x1.z, x1.w); o2.x = pk2(x2.x, x2.y); o2.y = pk2(x2.z, x2.w);
          *(u32x2*)(dst + 64 + 4 * q) = o1; *(u32x2*)(dst + 80 + 4 * q) = o2; }
        { const f32x4 sq = *(const f32x4*)(ssqkv + tok0 + 4 * q);
          f32x4 rs4; rs4.x = rsqrt_(sq.x * (1.0f / 128.0f) + EPS); rs4.y = rsqrt_(sq.y * (1.0f / 128.0f) + EPS); rs4.z = rsqrt_(sq.z * (1.0f / 128.0f) + EPS); rs4.w = rsqrt_(sq.w * (1.0f / 128.0f) + EPS);
#pragma unroll
          for (int ni = 0; ni < 4; ++ni) { const f32x4 v = av[mi][ni] * rs4; u32x2 o; o.x = pk2(v.x, v.y); o.y = pk2(v.z, v.w);
              *(u32x2*)(Vt + (((size_t)b * NH + head) * VD + 16 * ni + r) * L + pos0 + 4 * q) = o; } }
    }
}
__device__ __forceinline__ u32x4 conv_row(const bf16* uglu, int b, int pos, int ch) {
    u32x4 xv = (u32x4){0u, 0u, 0u, 0u};
    if (pos >= 0) xv = *(const u32x4*)(uglu + ((size_t)b * L + pos) * DC + ch);
    return xv;
}
__device__ __forceinline__ void conv_fma(float (&a)[8], const u32x4 xv, const f32x4 w0, const f32x4 w1) {
    a[0] += bf_lo(xv.x) * w0.x; a[1] += bf_hi(xv.x) * w0.y; a[2] += bf_lo(xv.y) * w0.z; a[3] += bf_hi(xv.y) * w0.w;
    a[4] += bf_lo(xv.z) * w1.x; a[5] += bf_hi(xv.z) * w1.y; a[6] += bf_lo(xv.w) * w1.z; a[7] += bf_hi(xv.w) * w1.w;
}
__device__ __forceinline__ void phaseB_conv_item(Ctx& c, int l, int grp) {
    const bf16* uglu = WSP(bf16, WS_UGLU); bf16* u2 = WSP(bf16, WS_U2);
    const float* cw = c.in[4] + (size_t)l * CW * DC; const float* cb = c.in[5] + l * DC; const float* lg = c.in[6] + l * DC; const float* lb = c.in[7] + l * DC;
    const int tok0 = grp * 4, b = tok0 / L, pos0 = tok0 - b * L, ch = c.lane * 8;
    float acc[4][8];
    { const f32x4 b0 = *(const f32x4*)(cb + ch), b1 = *(const f32x4*)(cb + ch + 4);
#pragma unroll
      for (int d = 0; d < 4; ++d) { acc[d][0] = b0.x; acc[d][1] = b0.y; acc[d][2] = b0.z; acc[d][3] = b0.w; acc[d][4] = b1.x; acc[d][5] = b1.y; acc[d][6] = b1.z; acc[d][7] = b1.w; } }
    const int base = pos0 - 30;
    u32x4 x0 = conv_row(uglu, b, base + 0, ch), x1 = conv_row(uglu, b, base + 1, ch), x2 = conv_row(uglu, b, base + 2, ch),
          x3 = conv_row(uglu, b, base + 3, ch), x4 = conv_row(uglu, b, base + 4, ch), x5;
    const float* wp = cw + ch;
#pragma unroll 1
    for (int w = 0; w < CW; ++w) {
        x5 = conv_row(uglu, b, (w + 5 <= 33) ? base + w + 5 : -1, ch);
        const f32x4 w0 = *(const f32x4*)wp, w1 = *(const f32x4*)(wp + 4); wp += DC;
        conv_fma(acc[0], x0, w0, w1); conv_fma(acc[1], x1, w0, w1); conv_fma(acc[2], x2, w0, w1); conv_fma(acc[3], x3, w0, w1);
        x0 = x1; x1 = x2; x2 = x3; x3 = x4; x4 = x5;
    }
    const f32x4 g0 = *(const f32x4*)(lg + ch), g1 = *(const f32x4*)(lg + ch + 4), e0 = *(const f32x4*)(lb + ch), e1 = *(const f32x4*)(lb + ch + 4);
    const float gg[8] = {g0.x, g0.y, g0.z, g0.w, g1.x, g1.y, g1.z, g1.w}, be[8] = {e0.x, e0.y, e0.z, e0.w, e1.x, e1.y, e1.z, e1.w};
#pragma unroll
    for (int d = 0; d < 4; ++d) {
        float s = 0.f;
#pragma unroll
        for (int j = 0; j < 8; ++j) s += acc[d][j];
        const float mu = wave_sum(s) * (1.0f / 512.0f);
        float vq = 0.f;
#pragma unroll
        for (int j = 0; j < 8; ++j) { acc[d][j] -= mu; vq += acc[d][j] * acc[d][j]; }
        const float rstd = rsqrt_(wave_sum(vq) * (1.0f / 512.0f) + EPS);
        float y[8];
#pragma unroll
        for (int j = 0; j < 8; ++j) { const float v = acc[d][j] * rstd * gg[j] + be[j]; y[j] = v * sigmoidf_(v); }
        u32x4 o; o.x = pk2(y[0], y[1]); o.y = pk2(y[2], y[3]); o.z = pk2(y[4], y[5]); o.w = pk2(y[6], y[7]);
        *(u32x4*)(u2 + (size_t)(tok0 + d) * DC + ch) = o;
    }
}
__device__ __forceinline__ void phase_B(const Ctx& c0, int l) {
    Ctx c = reopaque(c0);
    constexpr int NQ = MT * NH, NKV = MT * NH, NCV = T / 16;
    for (int it = c.vb; it < NQ + NKV + NCV; it += c.G) {
        if (it < NQ) phaseB_q_item(c, l, it / NH, it % NH);
        else if (it < NQ + NKV) phaseB_kv_item(c, l, (it - NQ) / NH, (it - NQ) % NH);
        else phaseB_conv_item(c, l, (it - NQ - NKV) * 4 + c.wave);
    }
}

constexpr int KROW = 208, VROW = 136, ATT_STAGE = 64 * KROW + 64 * VROW;
__device__ __forceinline__ void phase_C(const Ctx& c0, int l) {
    Ctx c = reopaque(c0);
    const bf16* Qb = WSP(bf16, WS_Q); const bf16* Kb = WSP(bf16, WS_K); const bf16* Vt = WSP(bf16, WS_VT); bf16* O = WSP(bf16, WS_O);
    unsigned* qctr = WSP(unsigned, WS_CTL) + CW_QUEUE + 64 * l;
    volatile unsigned* misc = (volatile unsigned*)(c.lds + LDS_MISC);
    const int tid = c.tid, wave = c.wave, lane = c.lane, r = lane & 15, q = lane >> 4;
    unsigned char* lds = c.lds;
    for (;;) {
        if (tid == 0) misc[4] = atomicAdd(qctr, 1u);
        __syncthreads();
        const int item = (int)misc[4];
        __syncthreads();
        if (item >= NB * NH * 33) break;
        const int ch = 32 - item / 64, bh = item % 64, b = bh / NH, h = bh % NH;
        const int r0 = ch == 0 ? 0 : 16 + 64 * (ch - 1);
        const bool active = ch > 0 || wave == 0;
        const int ntiles = ch + 1;
        const bf16* Kbase = Kb + (size_t)bh * L * QK; const bf16* Vbase = Vt + (size_t)bh * VD * L;
        bf16x8 qf[3];
#pragma unroll
        for (int ks = 0; ks < 3; ++ks) qf[ks] = *(const bf16x8*)(Qb + ((size_t)bh * L + r0 + 16 * wave + r) * QK + 32 * ks + 8 * q);
        float m = -1e30f, lsum = 0.f;
        f32x4 o[4];
#pragma unroll
        for (int dt = 0; dt < 4; ++dt) o[dt] = (f32x4){0.f, 0.f, 0.f, 0.f};
        u32x4 rk[3], rv[2];
        auto gload = [&](int kt) {
#pragma unroll
            for (int i = 0; i < 3; ++i) { const int id = tid + 256 * i, row = id / 12, cc = id % 12; rk[i] = *(const u32x4*)(Kbase + (size_t)(kt * 64 + row) * QK + cc * 8); }
#pragma unroll
            for (int i = 0; i < 2; ++i) { const int id = tid + 256 * i, row = id >> 3, cc = id & 7; rv[i] = *(const u32x4*)(Vbase + (size_t)row * L + kt * 64 + cc * 8); }
        };
        auto lstore = [&](int s) {
            unsigned char* st = lds + s * ATT_STAGE;
#pragma unroll
            for (int i = 0; i < 3; ++i) { const int id = tid + 256 * i, row = id / 12, cc = id % 12; *(u32x4*)(st + row * KROW + cc * 16) = rk[i]; }
#pragma unroll
            for (int i = 0; i < 2; ++i) { const int id = tid + 256 * i, row = id >> 3, cc = id & 7; u32x2* d = (u32x2*)(st + 64 * KROW + row * VROW + cc * 16); d[0] = (u32x2){rv[i].x, rv[i].y}; d[1] = (u32x2){rv[i].z, rv[i].w}; }
        };
        gload(0); lstore(0);
        __syncthreads();
        for (int kt = 0; kt < ntiles; ++kt) {
            const int cur = kt & 1;
            if (kt + 1 < ntiles) gload(kt + 1);
            const unsigned char* sK = lds + cur * ATT_STAGE; const unsigned char* sV = sK + 64 * KROW;
            const bool full = kt < ch;
            f32x4 s[4];
#pragma unroll
            for (int k4 = 0; k4 < 4; ++k4) {
                s[k4] = (f32x4){0.f, 0.f, 0.f, 0.f};
                if (k4 == 0 || full) {
#pragma unroll
                    for (int ks = 0; ks < 3; ++ks) { const bf16x8 kf = *(const bf16x8*)(sK + (16 * k4 + r) * KROW + 64 * ks + 16 * q);
                        s[k4] = __builtin_amdgcn_mfma_f32_16x16x32_bf16(kf, qf[ks], s[k4], 0, 0, 0); }
                }
            }
            float mx = fmaxf(fmaxf(s[0].x, s[0].y), fmaxf(s[0].z, s[0].w));
            if (full) {
#pragma unroll
                for (int k4 = 1; k4 < 4; ++k4) mx = fmaxf(mx, fmaxf(fmaxf(s[k4].x, s[k4].y), fmaxf(s[k4].z, s[k4].w)));
            }
            mx = quad_max(mx);
            const float mn = fmaxf(m, mx), alpha = fast_exp2(m - mn); m = mn;
            float ps = 0.f;
#pragma unroll
            for (int k4 = 0; k4 < 4; ++k4) {
                if (k4 == 0 || full) { f32x4 p; p.x = fast_exp2(s[k4].x - mn); p.y = fast_exp2(s[k4].y - mn); p.z = fast_exp2(s[k4].z - mn); p.w = fast_exp2(s[k4].w - mn);
                    ps += (p.x + p.y) + (p.z + p.w); s[k4] = p; }
            }
            lsum = lsum * alpha + ps;
#pragma unroll
            for (int dt = 0; dt < 4; ++dt) o[dt] = o[dt] * alpha;
#pragma unroll
            for (int st = 0; st < 2; ++st) {
                if (st == 0 || full) {
                    u32x4 pw; pw.x = pk2(s[2 * st].x, s[2 * st].y); pw.y = pk2(s[2 * st].z, s[2 * st].w); pw.z = pk2(s[2 * st + 1].x, s[2 * st + 1].y); pw.w = pk2(s[2 * st + 1].z, s[2 * st + 1].w);
                    if (!full) { pw.z = 0u; pw.w = 0u; }
                    const bf16x8 pf = __builtin_bit_cast(bf16x8, pw);
#pragma unroll
                    for (int dt = 0; dt < 4; ++dt) {
                        const unsigned char* vp = sV + (16 * dt + r) * VROW + (32 * st + 4 * q) * 2;
                        const u32x2 v0 = *(const u32x2*)vp; u32x2 v1 = (u32x2){0u, 0u};
                        if (full) v1 = *(const u32x2*)(vp + 32);
                        const u32x4 vw = (u32x4){v0.x, v0.y, v1.x, v1.y};
                        o[dt] = __builtin_amdgcn_mfma_f32_16x16x32_bf16(__builtin_bit_cast(bf16x8, vw), pf, o[dt], 0, 0, 0);
                    }
                }
            }
            if (kt + 1 < ntiles) lstore(cur ^ 1);
            __syncthreads();
        }
        lsum = quad_sum(lsum);
        if (active) {
            const float inv = 1.0f / lsum;
            bf16* dst = O + ((size_t)b * L + r0 + 16 * wave + r) * 512 + h * VD;
#pragma unroll
            for (int dt = 0; dt < 4; ++dt) { const f32x4 v = o[dt] * inv; u32x2 ov; ov.x = pk2(v.x, v.y); ov.y = pk2(v.z, v.w); *(u32x2*)(dst + 16 * dt + 4 * q) = ov; }
        }
    }
}

__device__ __forceinline__ void phase_D(const Ctx& c0, int l) {
    Ctx c = reopaque(c0);
    const bf16* u2 = WSP(bf16, WS_U2); const bf16* O = WSP(bf16, WS_O); const bf16* gates = WSP(bf16, WS_GATES); bf16* merged = WSP(bf16, WS_MERGED);
    const bf16* Wco = (const bf16*)(c.ws + WS_WIN + l * SZ_WLAYER + OFF_WCO); const bf16* Wmla = (const bf16*)(c.ws + WS_WIN + l * SZ_WLAYER + OFF_WMLA);
    const int r = c.lane & 15, q = c.lane >> 4;
    for (int it = c.vb; it < MT * 8; it += c.G) {
        const int mt = it / 8, nt = it % 8;
        f32x4 acc[2][8]; acc_zero(acc);
        gemm_core(acc, u2 + (size_t)mt * 128 * 512, 512, Wco + (size_t)nt * 128 * 512, 512, 512, c.lds, c.tid);
#pragma unroll
        for (int mi = 0; mi < 2; ++mi) { const int tok = mt * 128 + 32 * c.wave + 16 * mi + r;
            const bf16* gp = gates + (size_t)tok * 2048 + nt * 128 + 4 * q; bf16* mp = merged + (size_t)tok * D + nt * 128 + 4 * q;
#pragma unroll
            for (int ni = 0; ni < 8; ++ni) { const u32x2 g = *(const u32x2*)(gp + 16 * ni); const f32x4 v = acc[mi][ni];
                u32x2 o; o.x = pk2(v.x * bf_lo(g.x), v.y * bf_hi(g.x)); o.y = pk2(v.z * bf_lo(g.y), v.w * bf_hi(g.y)); *(u32x2*)(mp + 16 * ni) = o; } }
        acc_zero(acc);
        gemm_core(acc, O + (size_t)mt * 128 * 512, 512, Wmla + (size_t)nt * 128 * 512, 512, 512, c.lds, c.tid);
#pragma unroll
        for (int mi = 0; mi < 2; ++mi) { const int tok = mt * 128 + 32 * c.wave + 16 * mi + r;
            const bf16* gp = gates + (size_t)tok * 2048 + 1024 + nt * 128 + 4 * q; bf16* mp = merged + (size_t)tok * D + nt * 128 + 4 * q;
#pragma unroll
            for (int ni = 0; ni < 8; ++ni) { const u32x2 g = *(const u32x2*)(gp + 16 * ni); const u32x2 s = *(const u32x2*)(mp + 16 * ni); const f32x4 v = acc[mi][ni];
                u32x2 o; o.x = pk2(bf_lo(s.x) + v.x * bf_lo(g.x), bf_hi(s.x) + v.y * bf_hi(g.x)); o.y = pk2(bf_lo(s.y) + v.z * bf_lo(g.y), bf_hi(s.y) + v.w * bf_hi(g.y));
                *(u32x2*)(mp + 16 * ni) = o; } }
    }
}

__device__ __forceinline__ void phase_E(const Ctx& c0, int l) {
    Ctx c = reopaque(c0);
    const bf16* merged = WSP(bf16, WS_MERGED); const bf16* Wout = (const bf16*)(c.ws + WS_WIN + l * SZ_WLAYER + OFF_WOUT);
    float* h = WSP(float, WS_H); bf16* hb = WSP(bf16, WS_HB); float* ssq = WSP(float, WS_SSQ);
    const int r = c.lane & 15, q = c.lane >> 4;
    for (int it = c.vb; it < MT * 8; it += c.G) {
        const int mt = it / 8, nt = it % 8;
        f32x4 acc[2][8]; acc_zero(acc);
        gemm_core(acc, merged + (size_t)mt * 128 * D, D, Wout + (size_t)nt * 128 * D, D, D, c.lds, c.tid);
#pragma unroll
        for (int mi = 0; mi < 2; ++mi) { const int tok = mt * 128 + 32 * c.wave + 16 * mi + r; float ss = 0.f;
#pragma unroll
            for (int ni = 0; ni < 8; ++ni) { float* hp = h + (size_t)tok * D + nt * 128 + 16 * ni + 4 * q; const f32x4 v = *(const f32x4*)hp + acc[mi][ni]; *(f32x4*)hp = v;
                ss += (v.x * v.x + v.y * v.y) + (v.z * v.z + v.w * v.w);
                u32x2 o; o.x = pk2(v.x, v.y); o.y = pk2(v.z, v.w); *(u32x2*)(hb + (size_t)tok * D + nt * 128 + 16 * ni + 4 * q) = o; }
            ss = quad_sum(ss);
            if (q == 0) ssq[(size_t)tok * 8 + nt] = ss; }
    }
}

__device__ __forceinline__ unsigned f2key(float f) { const unsigned u = __float_as_uint(f); return u ^ ((u >> 31) ? 0xFFFFFFFFu : 0x80000000u); }
__device__ __forceinline__ float key2f(unsigned k) { const unsigned u = (k >> 31) ? (k ^ 0x80000000u) : ~k; return __uint_as_float(u); }
__device__ __forceinline__ void top16_insert(unsigned (&lst)[16], unsigned x) {
#pragma unroll
    for (int i = 0; i < 16; ++i) { const unsigned a = lst[i]; lst[i] = a > x ? a : x; x = a > x ? x : a; }
}
__device__ __forceinline__ void phase_F(const Ctx& c0, int l) {
    Ctx c = reopaque(c0);
    const bf16* hb = WSP(bf16, WS_HB); const bf16* Wpq = (const bf16*)(c.ws + WS_WIN + l * SZ_WLAYER + OFF_WPQ); const bf16* keys = (const bf16*)(c.ws + WS_WIN + l * SZ_WLAYER + OFF_KEYS);
    const float* ssq = WSP(float, WS_SSQ); float* sv = WSP(float, WS_SV); unsigned char* si = WSP(unsigned char, WS_SI);
    const int tid = c.tid, wave = c.wave, lane = c.lane, r = lane & 15, q = lane >> 4;
    unsigned char* lds = c.lds;
    for (int it = c.vb; it < MT * 16; it += c.G) {
        const int mt = it / 16, hp = it % 16;
        f32x4 acc[2][8]; acc_zero(acc);
        gemm_core(acc, hb + (size_t)mt * 128 * D, D, Wpq + (size_t)hp * 128 * D, D, D, lds, tid);
#pragma unroll
        for (int mi = 0; mi < 2; ++mi) { const int row = 32 * wave + 16 * mi + r; const float rs = rstd_from_ssq8(ssq, mt * 128 + row);
#pragma unroll
            for (int ni = 0; ni < 8; ++ni) { const f32x4 v = acc[mi][ni] * rs; u32x2 o; o.x = pk2(v.x, v.y); o.y = pk2(v.z, v.w);
                *(u32x2*)(lds + (ni >> 2) * 32768 + lds_off(row, 2 * (ni & 3) + (q >> 1)) + 8 * (q & 1)) = o; } }
        { const int chunk = tid & 7, row0 = tid >> 3; const bf16* pb = keys + ((size_t)hp * 128 + row0) * 128 + chunk * 8;
#pragma unroll
          for (int s = 0; s < 2; ++s)
#pragma unroll
              for (int i = 0; i < 4; ++i) *(u32x4*)(lds + s * 32768 + 16384 + lds_off(row0 + 32 * i, chunk)) = *(const u32x4*)(pb + (size_t)(32 * i) * 128 + s * 64); }
        __syncthreads();
        acc_zero(acc);
        gemm_compute_stage(acc, lds, lds + 16384, wave, lane);
        gemm_compute_stage(acc, lds + 32768, lds + 32768 + 16384, wave, lane);
        __syncthreads();
        float* S = (float*)lds;
#pragma unroll
        for (int mi = 0; mi < 2; ++mi) { const int row = 32 * wave + 16 * mi + r;
#pragma unroll
            for (int ni = 0; ni < 8; ++ni) *(f32x4*)(S + row * 132 + 16 * ni + 4 * q) = acc[mi][ni]; }
        __syncthreads();
        if (tid < 128) {
            unsigned lst[16];
#pragma unroll
            for (int i = 0; i < 16; ++i) lst[i] = 0u;
            const float* row = S + tid * 132;
#pragma unroll 4
            for (int j = 0; j < 32; ++j) { const f32x4 v = *(const f32x4*)(row + 4 * j);
                top16_insert(lst, (f2key(v.x) & ~127u) | (unsigned)(127 - (4 * j)));
                top16_insert(lst, (f2key(v.y) & ~127u) | (unsigned)(127 - (4 * j + 1)));
                top16_insert(lst, (f2key(v.z) & ~127u) | (unsigned)(127 - (4 * j + 2)));
                top16_insert(lst, (f2key(v.w) & ~127u) | (unsigned)(127 - (4 * j + 3))); }
            const int tok = mt * 128 + tid;
            unsigned idx[16]; float val[16];
#pragma unroll
            for (int i = 0; i < 16; ++i) { idx[i] = 127u - (lst[i] & 127u); val[i] = row[idx[i]]; }
            float* svp = sv + ((size_t)tok * 16 + hp) * 16;
#pragma unroll
            for (int i = 0; i < 4; ++i) *(f32x4*)(svp + 4 * i) = (f32x4){val[4 * i], val[4 * i + 1], val[4 * i + 2], val[4 * i + 3]};
            u32x4 pi;
            pi.x = idx[0] | (idx[1] << 8) | (idx[2] << 16) | (idx[3] << 24); pi.y = idx[4] | (idx[5] << 8) | (idx[6] << 16) | (idx[7] << 24);
            pi.z = idx[8] | (idx[9] << 8) | (idx[10] << 16) | (idx[11] << 24); pi.w = idx[12] | (idx[13] << 8) | (idx[14] << 16) | (idx[15] << 24);
            *(u32x4*)(si + ((size_t)tok * 16 + hp) * 16) = pi;
        }
        __syncthreads();
    }
}

__device__ __forceinline__ void phase_F3(const Ctx& c0, int l) {
    Ctx c = reopaque(c0);
    const float* sv = WSP(float, WS_SV); const unsigned char* si = WSP(unsigned char, WS_SI); int* eidx = WSP(int, WS_EIDX); float* gw = WSP(float, WS_GW); unsigned char* stb = WSP(unsigned char, WS_STB);
    float* lsv = (float*)c.lds;
    unsigned char* lsi = c.lds + 256 * 33 * 4;
    const int tid = c.tid;
    for (int base = c.vb * NTHREADS; base < T * 8; base += c.G * NTHREADS) {
        const int th = base + tid;
        float a[16], b[16];
#pragma unroll
        for (int i = 0; i < 4; ++i) { const f32x4 x = *(const f32x4*)(sv + (size_t)th * 32 + 4 * i), y = *(const f32x4*)(sv + (size_t)th * 32 + 16 + 4 * i);
            a[4 * i] = x.x; a[4 * i + 1] = x.y; a[4 * i + 2] = x.z; a[4 * i + 3] = x.w; b[4 * i] = y.x; b[4 * i + 1] = y.y; b[4 * i + 2] = y.z; b[4 * i + 3] = y.w; }
        const u32x4 ia = *(const u32x4*)(si + (size_t)th * 32), ib = *(const u32x4*)(si + (size_t)th * 32 + 16);
#pragma unroll
        for (int i = 0; i < 16; ++i) { lsv[tid * 33 + i] = a[i]; lsv[tid * 33 + 16 + i] = b[i]; }
        *(u32x4*)(lsi + tid * 32) = ia; *(u32x4*)(lsi + tid * 32 + 16) = ib;
        unsigned lst[16];
#pragma unroll
        for (int i = 0; i < 16; ++i) lst[i] = 0u;
#pragma unroll
        for (int i = 0; i < 16; ++i)
#pragma unroll
            for (int j = 0; j < 16; ++j)
                if ((i + 1) * (j + 1) <= 16) top16_insert(lst, (f2key(a[i] + b[j]) & ~255u) | (unsigned)(255 - (i * 16 + j)));
        __builtin_amdgcn_s_waitcnt(0xC07F); asm volatile("" ::: "memory");
        float s[16]; int e[16];
#pragma unroll
        for (int k = 0; k < 16; ++k) { const unsigned code = 255u - (lst[k] & 255u); const int i = code >> 4, j = code & 15;
            s[k] = lsv[tid * 33 + i] + lsv[tid * 33 + 16 + j]; e[k] = (int)lsi[tid * 32 + i] * 128 + (int)lsi[tid * 32 + 16 + j]; }
        float mx = s[0];
#pragma unroll
        for (int k = 1; k < 16; ++k) mx = fmaxf(mx, s[k]);
        float sum = 0.f;
#pragma unroll
        for (int k = 0; k < 16; ++k) { s[k] = fast_exp2((s[k] - mx) * 1.4426950409f); sum += s[k]; }
        const float inv = 1.0f / sum;
        typedef unsigned long long u64;
        u64 hlo = 0ull, hhi = 0ull;
#pragma unroll
        for (int k = 0; k < 16; ++k) { const int sl = e[k] >> 10; if (sl < 8) hlo += 1ull << (8 * sl); else hhi += 1ull << (8 * (sl - 8)); }
        u64 ilo = hlo, ihi = hhi;
#pragma unroll
        for (int d = 1; d < 8; d <<= 1) { const u64 a_ = __shfl_up(ilo, d, 8), b_ = __shfl_up(ihi, d, 8); if ((tid & 7) >= d) { ilo += a_; ihi += b_; } }
        const u64 tlo = __shfl(ilo, 7, 8), thi = __shfl(ihi, 7, 8);
        const u64 ones = 0x0101010101010101ull;
        const u64 inlo = tlo * ones, inhi = thi * ones + (inlo >> 56) * ones;
        const u64 stlo = inlo - tlo, sthi = inhi - thi;
        u64 rlo = stlo + (ilo - hlo), rhi = sthi + (ihi - hhi);
        const int tokn = th >> 3;
#pragma unroll
        for (int k = 0; k < 16; ++k) { const int sl = e[k] >> 10; int pos;
            if (sl < 8) { pos = (int)((rlo >> (8 * sl)) & 255ull); rlo += 1ull << (8 * sl); } else { pos = (int)((rhi >> (8 * (sl - 8))) & 255ull); rhi += 1ull << (8 * (sl - 8)); }
            eidx[(size_t)tokn * 128 + pos] = e[k]; gw[(size_t)tokn * 128 + pos] = s[k] * inv; }
        if ((tid & 7) == 0) { u64* sp = (u64*)(stb + (size_t)tokn * 16); sp[0] = stlo; sp[1] = sthi; }
        __builtin_amdgcn_s_waitcnt(0xC07F); asm volatile("" ::: "memory");
    }
}

typedef float f32x2 __attribute__((ext_vector_type(2)));
constexpr int G2_WSTRIDE = 14336, G2_MAXTOK = 9;
__device__ __forceinline__ float fp8dot4(unsigned w, unsigned x01, unsigned x23, float acc) {
    const bf16x2 lo = __builtin_amdgcn_cvt_scalef32_pk_bf16_fp8(w, 1.0f, false), hi = __builtin_amdgcn_cvt_scalef32_pk_bf16_fp8(w, 1.0f, true);
    acc = __builtin_amdgcn_fdot2_f32_bf16(lo, __builtin_bit_cast(bf16x2, x01), acc, false);
    return __builtin_amdgcn_fdot2_f32_bf16(hi, __builtin_bit_cast(bf16x2, x23), acc, false);
}
__device__ __forceinline__ float reduce8_transposed(const float (&p)[8], int lane) {
    float s[4];
#pragma unroll
    for (int k = 0; k < 4; ++k) { auto r = __builtin_amdgcn_permlane32_swap(__float_as_uint(p[k]), __float_as_uint(p[k + 4]), false, false); s[k] = __uint_as_float(r[0]) + __uint_as_float(r[1]); }
    float t[2];
#pragma unroll
    for (int k = 0; k < 2; ++k) { auto r = __builtin_amdgcn_permlane16_swap(__float_as_uint(s[k]), __float_as_uint(s[k + 2]), false, false); t[k] = __uint_as_float(r[0]) + __uint_as_float(r[1]); }
    const float u0 = t[0] + dpp<0x128>(t[0]), u1 = t[1] + dpp<0x128>(t[1]);
    float r = (lane & 8) ? u1 : u0;
    r += dpp<0xB1>(r); r += dpp<0x4E>(r); r += dpp<0x141>(r);
    return r;
}
typedef int i32x4 __attribute__((ext_vector_type(4)));
__device__ __forceinline__ void fp8fma4(f32x2 (&acc)[8], int o, unsigned w, f32x2 a2) {
    const f32x2 lo = __builtin_amdgcn_cvt_scalef32_pk_f32_fp8(w, 1.0f, false), hi = __builtin_amdgcn_cvt_scalef32_pk_f32_fp8(w, 1.0f, true);
    acc[o] = __builtin_elementwise_fma(a2, lo, acc[o]); acc[o + 1] = __builtin_elementwise_fma(a2, hi, acc[o + 1]);
}
__device__ __forceinline__ void g2_u_chunk(u32x4 (&u)[8], const unsigned char* U, const int* pe_next, const float* pw_c, float* act_c, const u32x4 xa, const u32x4 xb, float rs, int lane) {
    const i32x4 e0 = *(const i32x4*)pe_next, e1 = *(const i32x4*)(pe_next + 4);
    const int en[8] = {e0.x, e0.y, e0.z, e0.w, e1.x, e1.y, e1.z, e1.w};
    float p[8];
#pragma unroll
    for (int k = 0; k < 8; ++k) {
        float d0 = fp8dot4(u[k].x, xa.x, xa.y, 0.f), d1 = fp8dot4(u[k].y, xa.z, xa.w, 0.f); d0 = fp8dot4(u[k].z, xb.x, xb.y, d0); d1 = fp8dot4(u[k].w, xb.z, xb.w, d1); p[k] = d0 + d1;
        asm volatile("" : "+v"(p[k]));
        u[k] = *(const u32x4*)(U + (size_t)__builtin_amdgcn_readfirstlane(en[k]) * 1024 + lane * 16);
    }
    const float a = reduce8_transposed(p, lane);
    const int row = (lane >> 3) & 7;
    if ((lane & 7) == 0) act_c[row] = gelu_tanh(a * rs) * pw_c[row];
}
__device__ __forceinline__ void g2_v_chunk(u32x4 (&v)[8], const unsigned char* V, const int* pe_next, const float* act_c, f32x2 (&acc)[8], int lane) {
    const i32x4 e0 = *(const i32x4*)pe_next, e1 = *(const i32x4*)(pe_next + 4);
    const int en[8] = {e0.x, e0.y, e0.z, e0.w, e1.x, e1.y, e1.z, e1.w};
    const f32x4 a0 = *(const f32x4*)act_c, a1 = *(const f32x4*)(act_c + 4);
    const float av[8] = {a0.x, a0.y, a0.z, a0.w, a1.x, a1.y, a1.z, a1.w};
#pragma unroll
    for (int k = 0; k < 8; ++k) { const f32x2 a2 = (f32x2){av[k], av[k]};
        fp8fma4(acc, 0, v[k].x, a2); fp8fma4(acc, 2, v[k].y, a2); fp8fma4(acc, 4, v[k].z, a2); fp8fma4(acc, 6, v[k].w, a2);
        asm volatile("" : "+v"(acc[0]), "+v"(acc[1]), "+v"(acc[2]), "+v"(acc[3]), "+v"(acc[4]), "+v"(acc[5]), "+v"(acc[6]), "+v"(acc[7]));
        v[k] = *(const u32x4*)(V + (size_t)__builtin_amdgcn_readfirstlane(en[k]) * 1024 + lane * 16);
    }
}
__device__ __forceinline__ void g2_finish_token(Ctx& c, int l, int tok, const f32x2 (&acc)[8], int lane) {
    float* h = WSP(float, WS_H); bf16* hbw = WSP(bf16, WS_HB); float* ssqw = WSP(float, WS_SSQ);
    float* hp = h + (size_t)tok * D + lane * 16;
    f32x4 r0 = *(const f32x4*)hp, r1 = *(const f32x4*)(hp + 4), r2 = *(const f32x4*)(hp + 8), r3 = *(const f32x4*)(hp + 12);
    r0 += (f32x4){acc[0].x, acc[0].y, acc[1].x, acc[1].y}; r1 += (f32x4){acc[2].x, acc[2].y, acc[3].x, acc[3].y};
    r2 += (f32x4){acc[4].x, acc[4].y, acc[5].x, acc[5].y}; r3 += (f32x4){acc[6].x, acc[6].y, acc[7].x, acc[7].y};
    if (l == 0) {
        *(f32x4*)hp = r0; *(f32x4*)(hp + 4) = r1; *(f32x4*)(hp + 8) = r2; *(f32x4*)(hp + 12) = r3;
        u32x4 o0, o1; o0.x = pk2(r0.x, r0.y); o0.y = pk2(r0.z, r0.w); o0.z = pk2(r1.x, r1.y); o0.w = pk2(r1.z, r1.w);
        o1.x = pk2(r2.x, r2.y); o1.y = pk2(r2.z, r2.w); o1.z = pk2(r3.x, r3.y); o1.w = pk2(r3.z, r3.w);
        *(u32x4*)(hbw + (size_t)tok * D + lane * 16) = o0; *(u32x4*)(hbw + (size_t)tok * D + lane * 16 + 8) = o1;
        float ss = (r0.x * r0.x + r0.y * r0.y) + (r0.z * r0.z + r0.w * r0.w) + (r1.x * r1.x + r1.y * r1.y) + (r1.z * r1.z + r1.w * r1.w)
                 + (r2.x * r2.x + r2.y * r2.y) + (r2.z * r2.z + r2.w * r2.w) + (r3.x * r3.x + r3.y * r3.y) + (r3.z * r3.z + r3.w * r3.w);
        ss = wave_sum_dpp(ss);
        if (lane < 8) ssqw[(size_t)tok * 8 + lane] = lane == 0 ? ss : 0.f;
    } else {
        const int b = tok / L, pos = tok - b * L;
        if (pos >= NMETA) { float* op = c.out + ((size_t)b * SEQ + (pos - NMETA)) * D + lane * 16;
            *(f32x4*)op = r0; *(f32x4*)(op + 4) = r1; *(f32x4*)(op + 8) = r2; *(f32x4*)(op + 12) = r3; }
    }
}
__device__ __forceinline__ void phase_G2(const Ctx& c0, int l) {
    Ctx c = reopaque(c0);
    const bf16* hb = WSP(bf16, WS_HB); const float* ssq = WSP(float, WS_SSQ); const int* pe = WSP(int, WS_EIDX); const float* pw = WSP(float, WS_GW);
    const unsigned char* U = c.ws + WS_TAB + (size_t)(l * 2) * SZ_TAB; const unsigned char* V = c.ws + WS_TAB + (size_t)(l * 2 + 1) * SZ_TAB;
    const int lane = c.lane, wave = c.wave;
    const int gw = c.vb * 4 + wave, t0 = gw * 8;
    const bool has_x = (c.vb & 3) == 0; const int tx = T - 128 + (c.vb >> 2);
    unsigned char* wl = c.lds + wave * G2_WSTRIDE;
    int* pe_l = (int*)wl; float* pw_l = (float*)(wl + 4608); float* act_l = (float*)(wl + 9216);
#pragma unroll
    for (int j = 0; j < G2_MAXTOK; ++j) { const int tok = j < 8 ? t0 + j : (has_x ? tx : t0);
        pe_l[j * 128 + lane] = pe[(size_t)tok * 128 + lane]; pe_l[j * 128 + 64 + lane] = pe[(size_t)tok * 128 + 64 + lane];
        pw_l[j * 128 + lane] = pw[(size_t)tok * 128 + lane] * TAB_INV; pw_l[j * 128 + 64 + lane] = pw[(size_t)tok * 128 + 64 + lane] * TAB_INV; }
    const int xlo = has_x ? 4 * wave : 16, xhi = has_x ? 4 * wave + 4 : 16;
    {
        u32x4 xa[G2_MAXTOK], xb[G2_MAXTOK]; float rs[G2_MAXTOK];
#pragma unroll
        for (int j = 0; j < G2_MAXTOK; ++j) { const int tok = j < 8 ? t0 + j : (has_x ? tx : t0);
            xa[j] = *(const u32x4*)(hb + (size_t)tok * D + lane * 16); xb[j] = *(const u32x4*)(hb + (size_t)tok * D + lane * 16 + 8); rs[j] = rstd_from_ssq8(ssq, tok) * TAB_INV; }
        u32x4 u[8];
#pragma unroll
        for (int k = 0; k < 8; ++k) u[k] = *(const u32x4*)(U + (size_t)__builtin_amdgcn_readfirstlane(pe_l[k]) * 1024 + lane * 16);
#pragma unroll 1
        for (int ch = 0; ch < 16; ++ch) {
            const int cn = ch < 15 ? ch + 1 : 0;
            const bool x_here = ch >= xlo && ch < xhi;
#pragma unroll
            for (int j = 0; j < 8; ++j) {
                const int* pe_next = j < 7 ? pe_l + (j + 1) * 128 + ch * 8 : (x_here ? pe_l + 8 * 128 + ch * 8 : pe_l + cn * 8);
                g2_u_chunk(u, U, pe_next, pw_l + j * 128 + ch * 8, act_l + j * 128 + ch * 8, xa[j], xb[j], rs[j], lane); }
            if (x_here) g2_u_chunk(u, U, pe_l + cn * 8, pw_l + 8 * 128 + ch * 8, act_l + 8 * 128 + ch * 8, xa[8], xb[8], rs[8], lane);
        }
    }
    f32x2 acc[G2_MAXTOK][8];
#pragma unroll
    for (int j = 0; j < G2_MAXTOK; ++j)
#pragma unroll
        for (int i = 0; i < 8; ++i) acc[j][i] = (f32x2){0.f, 0.f};
    {
        u32x4 v[8];
#pragma unroll
        for (int k = 0; k < 8; ++k) v[k] = *(const u32x4*)(V + (size_t)__builtin_amdgcn_readfirstlane(pe_l[k]) * 1024 + lane * 16);
#pragma unroll 1
        for (int ch = 0; ch < 16; ++ch) {
            const int cn = ch < 15 ? ch + 1 : 0;
            const bool x_here = ch >= xlo && ch < xhi;
#pragma unroll
            for (int j = 0; j < 8; ++j) {
                const int* pe_next = j < 7 ? pe_l + (j + 1) * 128 + ch * 8 : (x_here ? pe_l + 8 * 128 + ch * 8 : pe_l + cn * 8);
                g2_v_chunk(v, V, pe_next, act_l + j * 128 + ch * 8, acc[j], lane); }
            if (x_here) g2_v_chunk(v, V, pe_l + cn * 8, act_l + 8 * 128 + ch * 8, acc[8], lane);
        }
    }
#pragma unroll
    for (int j = 0; j < 8; ++j) g2_finish_token(c, l, t0 + j, acc[j], lane);
    __syncthreads();
    if (has_x) {
        f32x2* part = (f32x2*)(c.lds + wave * G2_WSTRIDE);
#pragma unroll
        for (int i = 0; i < 8; ++i) part[i * 64 + lane] = acc[8][i];
    }
    __syncthreads();
    if (has_x && wave == 0) {
        f32x2 tot[8];
#pragma unroll
        for (int i = 0; i < 8; ++i) { tot[i] = acc[8][i];
#pragma unroll
            for (int w = 1; w < 4; ++w) tot[i] += ((const f32x2*)(c.lds + w * G2_WSTRIDE))[i * 64 + lane]; }
        g2_finish_token(c, l, tx, tot, lane);
    }
    __syncthreads();
}

struct Args { const float* in[22]; float* out; unsigned char* ws; int ph_lo, ph_hi; };
constexpr int N_PHASES = 17;

__global__ void __launch_bounds__(NTHREADS, 2) fwd_kernel(Args args) {
    extern __shared__ __attribute__((aligned(16))) unsigned char lds_raw[];
    Ctx c;
#pragma unroll
    for (int i = 0; i < 22; ++i) c.in[i] = args.in[i];
    c.out = args.out; c.ws = args.ws; c.lds = lds_raw;
    c.tid = threadIdx.x; c.lane = c.tid & 63; c.wave = __builtin_amdgcn_readfirstlane(c.tid >> 6);
    c.G = gridDim.x; { const int bx = blockIdx.x; c.vb = (c.G % 8 == 0) ? (bx % 8) * (c.G / 8) + bx / 8 : bx; }
    volatile unsigned* misc = (volatile unsigned*)(c.lds + LDS_MISC);
    if (c.tid < 16) misc[c.tid] = 0u;
    __syncthreads();
    const int lo = args.ph_lo, hi = args.ph_hi;
    const bool multi = (hi - lo) > 1;
    XcdBarrier bar; bar.bar = WSP(unsigned, WS_CTL) + CW_BAR; bar.x = 0; bar.st = misc;
    if (multi) bar = xcd_barrier_post(WSP(unsigned, WS_CTL) + CW_BAR, misc);
#define IN_(k) (lo <= (k) && (k) < hi)
#define SEAM_(k) do { if ((k) + 1 < hi) xcd_barrier(bar); } while (0)
    if (IN_(0)) { phase_prologue(c); SEAM_(0); }
#pragma unroll 1
    for (int l = 0; l < 2; ++l) {
        const int p0 = 1 + 8 * l;
        if (IN_(p0 + 0)) { phase_A(c, l); SEAM_(p0 + 0); }
        if (IN_(p0 + 1)) { phase_B(c, l); SEAM_(p0 + 1); }
        if (IN_(p0 + 2)) { phase_C(c, l); SEAM_(p0 + 2); }
        if (IN_(p0 + 3)) { phase_D(c, l); SEAM_(p0 + 3); }
        if (IN_(p0 + 4)) { phase_E(c, l); SEAM_(p0 + 4); }
        if (IN_(p0 + 5)) { phase_F(c, l); SEAM_(p0 + 5); }
        if (IN_(p0 + 6)) { phase_F3(c, l); SEAM_(p0 + 6); }
        if (IN_(p0 + 7)) { phase_G2(c, l); SEAM_(p0 + 7); }
    }
}

extern "C" void kernel_launch(void* const* d_in, const int* in_sizes, int n_in, void* d_out, int out_size, void* d_ws, size_t ws_size, hipStream_t stream) {
    static int grid = 0;
    if (grid == 0) {
        if (n_in != 22 || out_size != NB * SEQ * D || ws_size < WS_END) { fprintf(stderr, "kernel_launch: unexpected shapes (n_in %d out %d ws %zu need %zu)\n", n_in, out_size, ws_size, (size_t)WS_END); grid = -1; return; }
        int dev = 0, cus = 0, per_cu = 0;
        hipGetDevice(&dev); hipDeviceGetAttribute(&cus, hipDeviceAttributeMultiprocessorCount, dev);
        if (hipFuncSetAttribute((const void*)fwd_kernel, hipFuncAttributeMaxDynamicSharedMemorySize, LDS_BYTES) != hipSuccess) { fprintf(stderr, "kernel_launch: hipFuncSetAttribute failed\n"); grid = -1; return; }
        if (hipOccupancyMaxActiveBlocksPerMultiprocessor(&per_cu, (const void*)fwd_kernel, NTHREADS, LDS_BYTES) != hipSuccess || per_cu < 1) { fprintf(stderr, "kernel_launch: occupancy query failed (%d)\n", per_cu); per_cu = 1; (void)hipGetLastError(); }
        if (per_cu > 2) per_cu = 2;
        grid = cus * per_cu;
        if (grid != 512) { fprintf(stderr, "kernel_launch: grid %d unsupported by phase G2 (needs 512 workgroups)\n", grid); grid = -1; return; }
        fprintf(stderr, "kernel_launch: grid %d (%d per CU), lds %d, ws need %zu have %zu\n", grid, per_cu, LDS_BYTES, (size_t)WS_END, ws_size);
    }
    if (grid < 0) return;
    hipMemsetAsync((char*)d_ws + WS_CTL, 0, CTL_BYTES, stream);
    Args a{};
    for (int i = 0; i < 22; ++i) a.in[i] = (const float*)d_in[i];
    a.out = (float*)d_out; a.ws = (unsigned char*)d_ws;
#if MK_PER_PHASE
    for (int ph = 0; ph < N_PHASES; ++ph) { a.ph_lo = ph; a.ph_hi = ph + 1; hipLaunchKernelGGL(fwd_kernel, dim3(grid), dim3(NTHREADS), LDS_BYTES, stream, a); }
#else
    a.ph_lo = 0; a.ph_hi = N_PHASES;
    void* kargs[] = {&a};
    hipError_t e = hipLaunchCooperativeKernel((const void*)fwd_kernel, dim3(grid), dim3(NTHREADS), kargs, LDS_BYTES, stream);
    if (e != hipSuccess) fprintf(stderr, "kernel_launch: cooperative launch failed: %s (grid %d)\n", hipGetErrorString(e), grid);
#endif
}
```

```cpp
#include <hip/hip_runtime.h>
#include <cstdio>
#include <cstdint>

#ifndef MK_PER_PHASE
#define MK_PER_PHASE 0
#endif

typedef unsigned short bf16;
typedef short bf16x8 __attribute__((ext_vector_type(8)));
typedef float f32x4 __attribute__((ext_vector_type(4)));
typedef unsigned u32x4 __attribute__((ext_vector_type(4)));
typedef unsigned u32x2 __attribute__((ext_vector_type(2)));
typedef __bf16 bf16x2 __attribute__((ext_vector_type(2)));

constexpr int NB = 8, SEQ = 2048, NMETA = 16, L = SEQ + NMETA, T = NB * L, D = 1024;
constexpr int DC = 512, CW = 31, NH = 8, QL = 256, KVL = 128, NOPE = 64, ROPE = 32, QK = 96, VD = 64;
constexpr int NIN = 3488, NINP = 3584;
constexpr int NEXP = 16384;
constexpr float EPS = 1e-6f;
constexpr int MT = T / 128;
static_assert(T % 128 == 0, "T tiles");

constexpr size_t al256(size_t x) { return (x + 255) & ~(size_t)255; }
constexpr size_t WS_CTL = 0;
constexpr size_t CTL_BYTES = 65536;
constexpr size_t WS_ROPE = WS_CTL + CTL_BYTES;
constexpr size_t WS_WIN = al256(WS_ROPE + (size_t)L * 16 * 8);
constexpr size_t SZ_WIN = (size_t)NINP * 1024 * 2, SZ_WCO = (size_t)1024 * 512 * 2, SZ_WUQ = (size_t)1024 * 256 * 2, SZ_WUKV = (size_t)1024 * 128 * 2,
                 SZ_WMLA = (size_t)1024 * 512 * 2, SZ_WOUT = (size_t)1024 * 1024 * 2, SZ_WPQ = (size_t)2048 * 1024 * 2, SZ_KEYS = (size_t)16 * 128 * 128 * 2;
constexpr size_t OFF_WCO = SZ_WIN, OFF_WUQ = OFF_WCO + SZ_WCO, OFF_WUKV = OFF_WUQ + SZ_WUQ, OFF_WMLA = OFF_WUKV + SZ_WUKV, OFF_WOUT = OFF_WMLA + SZ_WMLA,
                 OFF_WPQ = OFF_WOUT + SZ_WOUT, OFF_KEYS = OFF_WPQ + SZ_WPQ, SZ_WLAYER = OFF_KEYS + SZ_KEYS;
constexpr size_t WS_TAB = al256(WS_WIN + 2 * SZ_WLAYER);
constexpr size_t SZ_TAB = (size_t)NEXP * 1024;
constexpr float TAB_SCALE = 256.0f, TAB_INV = 1.0f / 256.0f;
constexpr size_t WS_H = al256(WS_TAB + 4 * SZ_TAB);
constexpr size_t WS_HB = al256(WS_H + (size_t)T * 1024 * 4);
constexpr size_t WS_SSQ = al256(WS_HB + (size_t)T * 1024 * 2);
constexpr size_t WS_UGLU = al256(WS_SSQ + (size_t)T * 8 * 4);
constexpr size_t WS_CQ = al256(WS_UGLU + (size_t)T * 512 * 2);
constexpr size_t WS_CKV = al256(WS_CQ + (size_t)T * 256 * 2);
constexpr size_t WS_KROPE = al256(WS_CKV + (size_t)T * 128 * 2);
constexpr size_t WS_SSQQ = al256(WS_KROPE + (size_t)T * 32 * 4);
constexpr size_t WS_SSQKV = al256(WS_SSQQ + (size_t)T * 2 * 4);
constexpr size_t WS_U2 = al256(WS_SSQKV + (size_t)T * 4);
constexpr size_t WS_Q = al256(WS_U2 + (size_t)T * 512 * 2);
constexpr size_t WS_K = al256(WS_Q + (size_t)T * NH * QK * 2);
constexpr size_t WS_VT = al256(WS_K + (size_t)T * NH * QK * 2);
constexpr size_t WS_O = al256(WS_VT + (size_t)T * NH * VD * 2 + 4096);
constexpr size_t WS_MERGED = al256(WS_O + (size_t)T * 512 * 2);
constexpr size_t WS_GATES = al256(WS_MERGED + (size_t)T * 1024 * 2);
constexpr size_t WS_SV = WS_GATES;
constexpr size_t WS_SI = al256(WS_SV + (size_t)T * 256 * 4);
constexpr size_t WS_EIDX = al256(WS_SI + (size_t)T * 256);
constexpr size_t WS_GW = al256(WS_EIDX + (size_t)T * 128 * 4);
constexpr size_t WS_STB = al256(WS_GW + (size_t)T * 128 * 4);
constexpr size_t WS_PEER_END = WS_STB + (size_t)T * 16;
constexpr size_t WS_END = al256(WS_GATES + (size_t)T * 2048 * 2);
static_assert(WS_PEER_END <= WS_END, "peer scratch overlay");

constexpr int CW_BAR = 0;
constexpr int CW_QUEUE = 4096;

constexpr int LDS_MAIN = 128 * 132 * 4;
constexpr int LDS_MISC = LDS_MAIN;
constexpr int LDS_BYTES = LDS_MAIN + 64;

constexpr int NTHREADS = 256;

__device__ __forceinline__ unsigned pk2(float lo, float hi) { bf16x2 v; v.x = (__bf16)lo; v.y = (__bf16)hi; return __builtin_bit_cast(unsigned, v); }
__device__ __forceinline__ float bf_lo(unsigned p) { return __uint_as_float(p << 16); }
__device__ __forceinline__ float bf_hi(unsigned p) { return __uint_as_float(p & 0xffff0000u); }
__device__ __forceinline__ float fast_rcp(float x) { return __builtin_amdgcn_rcpf(x); }
__device__ __forceinline__ float fast_exp2(float x) { return __builtin_amdgcn_exp2f(x); }
__device__ __forceinline__ float sigmoidf_(float x) { return fast_rcp(1.0f + fast_exp2(-1.4426950409f * x)); }
__device__ __forceinline__ float gelu_tanh(float x) { const float u = 1.5957691216f * (x + 0.044715f * x * x * x); return x * fast_rcp(1.0f + fast_exp2(-1.4426950409f * u)); }
__device__ __forceinline__ float rsqrt_(float x) { return __builtin_amdgcn_rsqf(x); }
__device__ __forceinline__ float quad_sum(float v) { v += __shfl_xor(v, 16); v += __shfl_xor(v, 32); return v; }
__device__ __forceinline__ float quad_max(float v) { v = fmaxf(v, __shfl_xor(v, 16)); v = fmaxf(v, __shfl_xor(v, 32)); return v; }
__device__ __forceinline__ float wave_sum(float v) {
#pragma unroll
    for (int o = 1; o < 64; o <<= 1) v += __shfl_xor(v, o);
    return v;
}
template <int CTRL> __device__ __forceinline__ float dpp(float x) { return __builtin_bit_cast(float, __builtin_amdgcn_mov_dpp(__builtin_bit_cast(int, x), CTRL, 0xf, 0xf, true)); }
__device__ __forceinline__ float xrow16_sum(float x) {
    auto s = __builtin_amdgcn_permlane16_swap(__float_as_uint(x), __float_as_uint(x), false, false);
    x = __uint_as_float(s[0]) + __uint_as_float(s[1]);
    auto t = __builtin_amdgcn_permlane32_swap(__float_as_uint(x), __float_as_uint(x), false, false);
    return __uint_as_float(t[0]) + __uint_as_float(t[1]);
}
__device__ __forceinline__ float wave_sum_dpp(float x) {
    x += dpp<0xB1>(x); x += dpp<0x4E>(x); x += dpp<0x141>(x); x += dpp<0x128>(x); return xrow16_sum(x);
}
__device__ __forceinline__ float dot2(unsigned a, unsigned b, float c) { return __builtin_amdgcn_fdot2_f32_bf16(__builtin_bit_cast(bf16x2, a), __builtin_bit_cast(bf16x2, b), c, false); }

#define XB_TMO      128
#define XB_XCNT(j)  (256  + 64 * (j))
#define XB_XSUB(j)  (1280 + 64 * (j))
#define XB_XGEN(j)  (2304 + 64 * (j))
#define XB_TOP      3328
#define XB_TOPGEN   3392
#define XCD_BAR_WORDS 3456
#define XB_SPIN_CAP (1u << 20)
__device__ __forceinline__ unsigned xb_ld(unsigned* p)              { return __hip_atomic_load(p, __ATOMIC_RELAXED, __HIP_MEMORY_SCOPE_AGENT); }
__device__ __forceinline__ unsigned xb_add(unsigned* p, unsigned v) { return __hip_atomic_fetch_add(p, v, __ATOMIC_RELAXED, __HIP_MEMORY_SCOPE_AGENT); }
__device__ __forceinline__ unsigned xb_xcc_id() { return (unsigned)__builtin_amdgcn_s_getreg((3 << 11) | 20) & 0xFu; }
#define XB_SPIN(cond, bar) do { unsigned _sp = 0; while (cond) { __builtin_amdgcn_s_sleep(1); \
    if ((++_sp & 255u) == 0u) { if (xb_ld(&(bar)[XB_TMO])) break; if (_sp > XB_SPIN_CAP) { atomicAdd(&(bar)[XB_TMO], 1u); break; } } } } while (0)
struct XcdBarrier { unsigned* bar; unsigned x; volatile unsigned* st; };
__device__ __forceinline__ XcdBarrier xcd_barrier_post(unsigned* bar, volatile unsigned* st) {
    XcdBarrier b; b.bar = bar; b.x = xb_xcc_id(); b.st = st;
    if (threadIdx.x == 0) (void)xb_add(&bar[XB_XCNT(b.x)], 1u);
    return b;
}
__device__ __forceinline__ void xcd_barrier_complete(unsigned* bar, unsigned x, unsigned& nloc, unsigned& nx) {
    const unsigned G = gridDim.x * gridDim.y * gridDim.z;
    unsigned sum, cnt, mine, sp = 0u;
    for (;;) {
        sum = 0u; cnt = 0u; mine = 0u;
#pragma unroll
        for (unsigned j = 0; j < 16; ++j) { const unsigned c = xb_ld(&bar[XB_XCNT(j)]); sum += c; cnt += (c > 0u) ? 1u : 0u; mine = (j == x) ? c : mine; }
        if (sum == G) break;
        __builtin_amdgcn_s_sleep(1);
        if ((++sp & 255u) == 0u) { if (xb_ld(&bar[XB_TMO])) break; if (sp > XB_SPIN_CAP) { atomicAdd(&bar[XB_TMO], 1u); break; } }
    }
    nloc = mine > 0u ? mine : 1u; nx = cnt > 0u ? cnt : 1u;
}
__device__ __forceinline__ void xcd_barrier(const XcdBarrier& b) {
    asm volatile("s_waitcnt vmcnt(0)" ::: "memory");
    __syncthreads();
    if (threadIdx.x == 0) {
        unsigned* bar = b.bar;
        __builtin_amdgcn_s_waitcnt(0);
        unsigned nloc = b.st[0], nx = b.st[1];
        if (nloc == 0u) { xcd_barrier_complete(bar, b.x, nloc, nx); b.st[0] = nloc; b.st[1] = nx; }
        const unsigned old = xb_add(&bar[XB_XSUB(b.x)], 1u);
        const unsigned gen = old / nloc;
        if (old + 1u == (gen + 1u) * nloc) {
            __builtin_amdgcn_fence(__ATOMIC_RELEASE, "agent");
            asm volatile("s_waitcnt vmcnt(0)" ::: "memory");
            const unsigned og = xb_add(&bar[XB_TOP], 1u);
            const unsigned tg = og / nx;
            if (og + 1u == (tg + 1u) * nx) xb_add(&bar[XB_TOPGEN], 1u);
            else XB_SPIN(xb_ld(&bar[XB_TOPGEN]) == tg, bar);
            __builtin_amdgcn_fence(__ATOMIC_ACQUIRE, "agent");
            xb_add(&bar[XB_XGEN(b.x)], 1u);
            asm volatile("s_waitcnt vmcnt(0)" ::: "memory");
        } else {
            XB_SPIN(xb_ld(&bar[XB_XGEN(b.x)]) == gen, bar);
            __builtin_amdgcn_fence(__ATOMIC_ACQUIRE, "agent");
            asm volatile("s_waitcnt vmcnt(0)" ::: "memory");
        }
    }
    __syncthreads();
}

struct Ctx {
    const float* in[22]; float* out; unsigned char* ws;
    unsigned char* lds; int tid, lane, wave, G, vb;
};
#define WSP(T_, off) ((T_*)(c.ws + (off)))
__device__ __forceinline__ Ctx reopaque(const Ctx& c0) {
    Ctx c = c0; int t = c0.tid; asm volatile("" : "+v"(t)); c.tid = t; c.lane = t & 63; c.wave = __builtin_amdgcn_readfirstlane(t >> 6);
    int vb = c0.vb; asm volatile("" : "+s"(vb)); c.vb = vb; return c;
}

__device__ __forceinline__ int lds_off(int row, int chunk) { return row * 128 + ((chunk ^ (row & 7)) << 4); }

__device__ __forceinline__ void gemm_compute_stage(f32x4 (&acc)[2][8], const unsigned char* sA, const unsigned char* sB, int wave, int lane) {
    const int r = lane & 15, q = lane >> 4;
#pragma unroll
    for (int ks = 0; ks < 2; ++ks) {
        bf16x8 af[2], bfr[8];
#pragma unroll
        for (int mi = 0; mi < 2; ++mi) af[mi] = *(const bf16x8*)(sA + lds_off(32 * wave + 16 * mi + r, 4 * ks + q));
#pragma unroll
        for (int ni = 0; ni < 8; ++ni) bfr[ni] = *(const bf16x8*)(sB + lds_off(16 * ni + r, 4 * ks + q));
#pragma unroll
        for (int mi = 0; mi < 2; ++mi)
#pragma unroll
            for (int ni = 0; ni < 8; ++ni) acc[mi][ni] = __builtin_amdgcn_mfma_f32_16x16x32_bf16(bfr[ni], af[mi], acc[mi][ni], 0, 0, 0);
    }
}

#define LAS __attribute__((address_space(3)))
__device__ __forceinline__ void gemm_stage_glds(const bf16* A, int lda, const bf16* Bt, int ldb, int kt, unsigned char* stage, int wave, int lane) {
    const int rr = lane >> 3, cch = (lane & 7) ^ rr;
#pragma unroll
    for (int i = 0; i < 4; ++i) { const int pc = 4 * i + wave;
        __builtin_amdgcn_global_load_lds((const unsigned*)(A + (size_t)(8 * pc + rr) * lda + kt * 64 + cch * 8), (LAS unsigned*)(stage + pc * 1024), 16, 0, 0);
        __builtin_amdgcn_global_load_lds((const unsigned*)(Bt + (size_t)(8 * pc + rr) * ldb + kt * 64 + cch * 8), (LAS unsigned*)(stage + 16384 + pc * 1024), 16, 0, 0); }
}
__device__ __forceinline__ void gemm_core(f32x4 (&acc)[2][8], const bf16* A, int lda, const bf16* Bt, int ldb, int K, unsigned char* lds, int tid) {
    const int wave = __builtin_amdgcn_readfirstlane(tid >> 6), lane = tid & 63;
    const int nk = K >> 6;
    gemm_stage_glds(A, lda, Bt, ldb, 0, lds, wave, lane);
    asm volatile("s_waitcnt vmcnt(0)" ::: "memory");
    __syncthreads();
    for (int kt = 0; kt < nk; ++kt) {
        const int cur = kt & 1;
        if (kt + 1 < nk) gemm_stage_glds(A, lda, Bt, ldb, kt + 1, lds + (cur ^ 1) * 32768, wave, lane);
        gemm_compute_stage(acc, lds + cur * 32768, lds + cur * 32768 + 16384, wave, lane);
        asm volatile("s_waitcnt vmcnt(0)" ::: "memory");
        __syncthreads();
    }
}
__device__ __forceinline__ void acc_zero(f32x4 (&acc)[2][8]) {
#pragma unroll
    for (int mi = 0; mi < 2; ++mi)
#pragma unroll
        for (int ni = 0; ni < 8; ++ni) acc[mi][ni] = (f32x4){0.f, 0.f, 0.f, 0.f};
}
__device__ __forceinline__ float rstd_from_ssq8(const float* ssq, int tok) {
    const f32x4 a = *(const f32x4*)(ssq + (size_t)tok * 8), b = *(const f32x4*)(ssq + (size_t)tok * 8 + 4);
    const float s = ((a.x + a.y) + (a.z + a.w)) + ((b.x + b.y) + (b.z + b.w));
    return rsqrt_(s * (1.0f / 1024.0f) + EPS);
}

__device__ __forceinline__ int src_col(int mode, int np) {
    if (mode == 0) return np;
    if (mode == 2) { const int h = np >> 7, j = np & 127; return j < 96 ? h * 96 + j : -1; }
    if (np < 1024) { const int cblk = np >> 7, j = np & 127; return j < 64 ? 64 * cblk + j : 512 + 64 * cblk + (j - 64); }
    if (np < 1408) return np;
    if (np < 1536) { const int j = np - 1408; return j < 32 ? 1408 + j : -1; }
    return 1440 + (np - 1536);
}
__device__ __forceinline__ void p0_transpose_item(const float* W, int K, int N, bf16* Wt, int mode, const float* g, int item, float* scr, int lane) {
    const int nblk_k = K / 64, nb = item / nblk_k, kb = item % nblk_k, k0 = 64 * kb, n0 = 32 * nb;
    const int n = src_col(mode, n0 + (lane & 31));
#pragma unroll 8
    for (int i = 0; i < 32; ++i) { const int kk = 2 * i + (lane >> 5); float v = 0.f; if (n >= 0) { v = W[(size_t)(k0 + kk) * N + n]; if (g) v *= g[k0 + kk]; } scr[kk * 33 + (lane & 31)] = v; }
    __builtin_amdgcn_s_waitcnt(0xC07F); asm volatile("" ::: "memory");
    const int cch = lane & 7;
#pragma unroll
    for (int j = 0; j < 4; ++j) { const int nl = (lane >> 3) + 8 * j; const float* s = scr + (8 * cch) * 33 + nl;
        u32x4 o; o.x = pk2(s[0 * 33], s[1 * 33]); o.y = pk2(s[2 * 33], s[3 * 33]); o.z = pk2(s[4 * 33], s[5 * 33]); o.w = pk2(s[6 * 33], s[7 * 33]);
        *(u32x4*)(Wt + (size_t)(n0 + nl) * K + k0 + 8 * cch) = o; }
    __builtin_amdgcn_s_waitcnt(0xC07F); asm volatile("" ::: "memory");
}
struct WDesc { int in_idx, K, N, Np, mode, g_idx; size_t off; };
__device__ __forceinline__ void phase_prologue(const Ctx& c0) {
    Ctx c = reopaque(c0);
    const int gw = c.vb * 4 + c.wave, NGW = c.G * 4;
    float* scr = (float*)(c.lds + c.wave * 8704);
    const WDesc wd[7] = {
        {3, 1024, NIN, NINP, 1, 2, 0}, {8, 512, 1024, 1024, 0, -1, OFF_WCO}, {10, 256, 768, 1024, 2, 9, OFF_WUQ}, {12, 128, 1024, 1024, 0, 11, OFF_WUKV},
        {15, 512, 1024, 1024, 0, -1, OFF_WMLA}, {16, 1024, 1024, 1024, 0, -1, OFF_WOUT}, {18, 1024, 2048, 2048, 0, 17, OFF_WPQ}};
    constexpr int ITEMS_PER_LAYER = (1024 / 64) * (NINP / 32) + (512 / 64) * 32 + (256 / 64) * 32 + (128 / 64) * 32 + (512 / 64) * 32 + (1024 / 64) * 32 + (1024 / 64) * 64;
    for (int it = gw; it < 2 * ITEMS_PER_LAYER; it += NGW) {
        const int l = it >= ITEMS_PER_LAYER ? 1 : 0; int r = it - l * ITEMS_PER_LAYER;
        const float* W = nullptr; const float* g = nullptr; bf16* Wt = nullptr; int K = 64, N = 32, mode = 0, rr = 0;
#pragma unroll
        for (int m = 0; m < 7; ++m) {
            const int items = (wd[m].K / 64) * (wd[m].Np / 32);
            if (r >= 0 && r < items) { K = wd[m].K; N = wd[m].N; mode = wd[m].mode; rr = r;
                W = c.in[wd[m].in_idx] + (size_t)l * wd[m].K * wd[m].N; g = wd[m].g_idx >= 0 ? c.in[wd[m].g_idx >= 0 ? wd[m].g_idx : 0] + (size_t)l * wd[m].K : nullptr;
                Wt = (bf16*)(c.ws + WS_WIN + l * SZ_WLAYER + wd[m].off); }
            r -= items;
        }
        p0_transpose_item(W, K, N, Wt, mode, g, rr, scr, c.lane);
    }
    const int gt = c.vb * NTHREADS + c.tid, NGT = c.G * NTHREADS;
    for (int l = 0; l < 2; ++l) {
        const float* src = c.in[19] + (size_t)l * 262144; bf16* dst = (bf16*)(c.ws + WS_WIN + l * SZ_WLAYER + OFF_KEYS);
        for (int i = gt; i < 262144 / 8; i += NGT) { const f32x4 a = *(const f32x4*)(src + i * 8), b = *(const f32x4*)(src + i * 8 + 4);
            u32x4 o; o.x = pk2(a.x, a.y); o.y = pk2(a.z, a.w); o.z = pk2(b.x, b.y); o.w = pk2(b.z, b.w); *(u32x4*)(dst + i * 8) = o; }
    }
    for (int l = 0; l < 2; ++l)
        for (int uv = 0; uv < 2; ++uv) {
            const float* src = c.in[20 + uv] + (size_t)l * NEXP * 1024; unsigned char* dst = c.ws + WS_TAB + (size_t)(l * 2 + uv) * SZ_TAB;
            f32x4 g4[4];
#pragma unroll
            for (int j = 0; j < 4; ++j) { g4[j] = (f32x4){TAB_SCALE, TAB_SCALE, TAB_SCALE, TAB_SCALE}; if (uv == 0) g4[j] = g4[j] * *(const f32x4*)(c.in[17] + l * 1024 + 256 * j + 4 * c.lane); }
            for (int row = gw; row < NEXP; row += 2 * NGW) {
                const float* sp = src + (size_t)row * 1024 + 4 * c.lane; const int row2 = row + NGW; const bool two = row2 < NEXP;
                const float* sp2 = src + (size_t)(two ? row2 : row) * 1024 + 4 * c.lane;
                f32x4 a[4], b[4];
#pragma unroll
                for (int j = 0; j < 4; ++j) { a[j] = *(const f32x4*)(sp + 256 * j); b[j] = *(const f32x4*)(sp2 + 256 * j); }
#pragma unroll
                for (int j = 0; j < 4; ++j) { const f32x4 v = a[j] * g4[j];
                    *(unsigned*)(dst + (size_t)row * 1024 + 256 * j + 4 * c.lane) = (unsigned)__builtin_amdgcn_cvt_pk_fp8_f32(v.z, v.w, __builtin_amdgcn_cvt_pk_fp8_f32(v.x, v.y, 0, false), true); }
                if (two) {
#pragma unroll
                    for (int j = 0; j < 4; ++j) { const f32x4 v = b[j] * g4[j];
                        *(unsigned*)(dst + (size_t)row2 * 1024 + 256 * j + 4 * c.lane) = (unsigned)__builtin_amdgcn_cvt_pk_fp8_f32(v.z, v.w, __builtin_amdgcn_cvt_pk_fp8_f32(v.x, v.y, 0, false), true); } }
            }
        }
    { float* rope = WSP(float, WS_ROPE);
      for (int i = gt; i < L * 16; i += NGT) { const int pos = i >> 4, j = i & 15;
          const float inv = 1.0f / __builtin_exp2f((float)j * 0.8304820237218406f);
          const float angf = (float)pos * inv; const double ang = (double)angf;
          const double nq = __builtin_rint(ang * 0.63661977236758134308);
          double rr = __builtin_fma(-nq, 1.57079632679489655800e+00, ang); rr = __builtin_fma(-nq, 6.12323399573676603587e-17, rr);
          const double r2 = rr * rr;
          double sp = -1.0 / 1307674368000.0; sp = sp * r2 + 1.0 / 6227020800.0; sp = sp * r2 - 1.0 / 39916800.0; sp = sp * r2 + 1.0 / 362880.0; sp = sp * r2 - 1.0 / 5040.0; sp = sp * r2 + 1.0 / 120.0; sp = sp * r2 - 1.0 / 6.0; sp = sp * r2 * rr + rr;
          double cp = 1.0 / 87178291200.0; cp = cp * r2 - 1.0 / 479001600.0; cp = cp * r2 + 1.0 / 3628800.0; cp = cp * r2 - 1.0 / 40320.0; cp = cp * r2 + 1.0 / 720.0; cp = cp * r2 - 1.0 / 24.0; cp = cp * r2 + 0.5; cp = 1.0 - cp * r2;
          const int qd = ((int)nq) & 3;
          const double cv = qd == 0 ? cp : qd == 1 ? -sp : qd == 2 ? -cp : sp;
          const double sv_ = qd == 0 ? sp : qd == 1 ? cp : qd == 2 ? -sp : -cp;
          rope[2 * i] = (float)cv; rope[2 * i + 1] = (float)sv_; } }
    { float* h = WSP(float, WS_H); bf16* hb = WSP(bf16, WS_HB); float* ssq = WSP(float, WS_SSQ);
      for (int t = gw; t < T; t += NGW) { const int b = t / L, pos = t % L;
          const float* src = pos < NMETA ? c.in[1] + (size_t)pos * D : c.in[0] + ((size_t)b * SEQ + (pos - NMETA)) * D;
          float s = 0.f;
#pragma unroll
          for (int j = 0; j < 4; ++j) { const f32x4 v = *(const f32x4*)(src + j * 256 + c.lane * 4); *(f32x4*)(h + (size_t)t * D + j * 256 + c.lane * 4) = v;
              u32x2 o; o.x = pk2(v.x, v.y); o.y = pk2(v.z, v.w); *(u32x2*)(hb + (size_t)t * D + j * 256 + c.lane * 4) = o; s += (v.x * v.x + v.y * v.y) + (v.z * v.z + v.w * v.w); }
          s = wave_sum(s);
          if (c.lane < 8) ssq[(size_t)t * 8 + c.lane] = c.lane == 0 ? s : 0.f; } }
}

__device__ __forceinline__ void phase_A(const Ctx& c0, int l) {
    Ctx c = reopaque(c0);
    const bf16* hb = WSP(bf16, WS_HB); const bf16* Wt = (const bf16*)(c.ws + WS_WIN + l * SZ_WLAYER);
    const float* ssq = WSP(float, WS_SSQ);
    bf16* uglu = WSP(bf16, WS_UGLU); bf16* cq = WSP(bf16, WS_CQ); bf16* ckv = WSP(bf16, WS_CKV); float* krope = WSP(float, WS_KROPE);
    float* ssqq = WSP(float, WS_SSQQ); float* ssqkv = WSP(float, WS_SSQKV); bf16* gates = WSP(bf16, WS_GATES);
    constexpr int NT = NINP / 128;
    const int r = c.lane & 15, q = c.lane >> 4;
    for (int it = c.vb; it < MT * NT; it += c.G) {
        const int mt = it / NT, nt = it % NT;
        f32x4 acc[2][8]; acc_zero(acc);
        gemm_core(acc, hb + (size_t)mt * 128 * D, D, Wt + (size_t)nt * 128 * D, D, D, c.lds, c.tid);
#pragma unroll
        for (int mi = 0; mi < 2; ++mi) {
            const int tok = mt * 128 + 32 * c.wave + 16 * mi + r;
            const float rs = rstd_from_ssq8(ssq, tok);
            if (nt < 8) {
#pragma unroll
                for (int ni = 0; ni < 4; ++ni) { const f32x4 v = acc[mi][ni] * rs, g = acc[mi][ni + 4] * rs;
                    u32x2 o; o.x = pk2(v.x * sigmoidf_(g.x), v.y * sigmoidf_(g.y)); o.y = pk2(v.z * sigmoidf_(g.z), v.w * sigmoidf_(g.w));
                    *(u32x2*)(uglu + (size_t)tok * DC + nt * 64 + 16 * ni + 4 * q) = o; }
            } else if (nt < 11) {
                bf16* dst = nt < 10 ? cq + (size_t)tok * QL + (nt - 8) * 128 : ckv + (size_t)tok * KVL;
                float ss = 0.f;
#pragma unroll
                for (int ni = 0; ni < 8; ++ni) { const f32x4 v = acc[mi][ni] * rs; ss += (v.x * v.x + v.y * v.y) + (v.z * v.z + v.w * v.w);
                    u32x2 o; o.x = pk2(v.x, v.y); o.y = pk2(v.z, v.w); *(u32x2*)(dst + 16 * ni + 4 * q) = o; }
                ss = quad_sum(ss);
                if (q == 0) { if (nt < 10) ssqq[(size_t)tok * 2 + (nt - 8)] = ss; else ssqkv[tok] = ss; }
            } else if (nt == 11) {
#pragma unroll
                for (int ni = 0; ni < 2; ++ni) *(f32x4*)(krope + (size_t)tok * 32 + 16 * ni + 4 * q) = acc[mi][ni] * rs;
            } else {
#pragma unroll
                for (int ni = 0; ni < 8; ++ni) { const f32x4 v = acc[mi][ni] * rs;
                    u32x2 o; o.x = pk2(sigmoidf_(v.x), sigmoidf_(v.y)); o.y = pk2(sigmoidf_(v.z), sigmoidf_(v.w));
                    *(u32x2*)(gates + (size_t)tok * 2048 + (nt - 12) * 128 + 16 * ni + 4 * q) = o; }
            }
        }
    }
}

__device__ __forceinline__ void phaseB_q_item(Ctx& c, int l, int mt, int head) {
    const bf16* cq = WSP(bf16, WS_CQ); const bf16* Wt = (const bf16*)(c.ws + WS_WIN + l * SZ_WLAYER + OFF_WUQ);
    const float* ssqq = WSP(float, WS_SSQQ); const float* rope = WSP(float, WS_ROPE); const float* qg = c.in[13] + l * QK; bf16* Qb = WSP(bf16, WS_Q);
    const int r = c.lane & 15, q = c.lane >> 4;
    f32x4 acc[2][8]; acc_zero(acc);
    gemm_core(acc, cq + (size_t)mt * 128 * QL, QL, Wt + (size_t)head * 128 * QL, QL, QL, c.lds, c.tid);
    constexpr float QSCALE = 0.10206207261596575f * 1.4426950408889634f;
#pragma unroll
    for (int mi = 0; mi < 2; ++mi) {
        const int tok = mt * 128 + 32 * c.wave + 16 * mi + r, b = tok / L, pos = tok - b * L;
        const float rs = rsqrt_((ssqq[(size_t)tok * 2] + ssqq[(size_t)tok * 2 + 1]) * (1.0f / 256.0f) + EPS);
        float ss = 0.f;
#pragma unroll
        for (int ni = 0; ni < 6; ++ni) { acc[mi][ni] = acc[mi][ni] * rs; const f32x4 v = acc[mi][ni]; ss += (v.x * v.x + v.y * v.y) + (v.z * v.z + v.w * v.w); }
        ss = quad_sum(ss);
        const float rn = rsqrt_(ss * (1.0f / 96.0f) + EPS) * QSCALE;
#pragma unroll
        for (int ni = 0; ni < 6; ++ni) { const f32x4 g = *(const f32x4*)(qg + 16 * ni + 4 * q); acc[mi][ni] = acc[mi][ni] * g * rn; }
        const f32x4 cs0 = *(const f32x4*)(rope + ((size_t)pos * 16 + 4 * q) * 2), cs1 = *(const f32x4*)(rope + ((size_t)pos * 16 + 4 * q) * 2 + 4);
        const float co[4] = {cs0.x, cs0.z, cs1.x, cs1.z}, si[4] = {cs0.y, cs0.w, cs1.y, cs1.w};
        f32x4 x1 = acc[mi][4], x2 = acc[mi][5];
#pragma unroll
        for (int e = 0; e < 4; ++e) { const float a = x1[e], bb = x2[e]; x1[e] = a * co[e] - bb * si[e]; x2[e] = bb * co[e] + a * si[e]; }
        acc[mi][4] = x1; acc[mi][5] = x2;
        bf16* dst = Qb + (((size_t)b * NH + head) * L + pos) * QK;
#pragma unroll
        for (int ni = 0; ni < 6; ++ni) { const f32x4 v = acc[mi][ni]; u32x2 o; o.x = pk2(v.x, v.y); o.y = pk2(v.z, v.w); *(u32x2*)(dst + 16 * ni + 4 * q) = o; }
    }
}
__device__ __forceinline__ void phaseB_kv_item(Ctx& c, int l, int mt, int head) {
    const bf16* ckv = WSP(bf16, WS_CKV); const bf16* Wt = (const bf16*)(c.ws + WS_WIN + l * SZ_WLAYER + OFF_WUKV);
    const float* ssqkv = WSP(float, WS_SSQKV); const float* rope = WSP(float, WS_ROPE); const float* kg = c.in[14] + l * QK; const float* krope = WSP(float, WS_KROPE);
    bf16* Kb = WSP(bf16, WS_K); bf16* Vt = WSP(bf16, WS_VT);
    const int tid = c.tid, wave = c.wave, lane = c.lane, r = lane & 15, q = lane >> 4;
    unsigned char* lds = c.lds;
    f32x4 ak[2][4], av[2][4];
#pragma unroll
    for (int mi = 0; mi < 2; ++mi)
#pragma unroll
        for (int ni = 0; ni < 4; ++ni) { ak[mi][ni] = (f32x4){0.f, 0.f, 0.f, 0.f}; av[mi][ni] = (f32x4){0.f, 0.f, 0.f, 0.f}; }
    { const int chunk = tid & 7, row0 = tid >> 3;
      const bf16* pa = ckv + ((size_t)mt * 128 + row0) * KVL + chunk * 8; const bf16* pb = Wt + ((size_t)head * 128 + row0) * KVL + chunk * 8;
#pragma unroll
      for (int s = 0; s < 2; ++s)
#pragma unroll
          for (int i = 0; i < 4; ++i) { *(u32x4*)(lds + s * 32768 + lds_off(row0 + 32 * i, chunk)) = *(const u32x4*)(pa + (size_t)(32 * i) * KVL + s * 64);
              *(u32x4*)(lds + s * 32768 + 16384 + lds_off(row0 + 32 * i, chunk)) = *(const u32x4*)(pb + (size_t)(32 * i) * KVL + s * 64); }
    }
    __syncthreads();
#pragma unroll
    for (int s = 0; s < 2; ++s)
#pragma unroll
        for (int ks = 0; ks < 2; ++ks) {
            const unsigned char* sA = lds + s * 32768; const unsigned char* sB = sA + 16384;
            bf16x8 af[2], bfr[8];
#pragma unroll
            for (int mi = 0; mi < 2; ++mi) af[mi] = *(const bf16x8*)(sA + lds_off(32 * wave + 16 * mi + r, 4 * ks + q));
#pragma unroll
            for (int ni = 0; ni < 8; ++ni) bfr[ni] = *(const bf16x8*)(sB + lds_off(16 * ni + r, 4 * ks + q));
#pragma unroll
            for (int mi = 0; mi < 2; ++mi)
#pragma unroll
                for (int ni = 0; ni < 4; ++ni) { ak[mi][ni] = __builtin_amdgcn_mfma_f32_16x16x32_bf16(bfr[ni], af[mi], ak[mi][ni], 0, 0, 0);
                    av[mi][ni] = __builtin_amdgcn_mfma_f32_16x16x32_bf16(af[mi], bfr[ni + 4], av[mi][ni], 0, 0, 0); }
        }
    __syncthreads();
#pragma unroll
    for (int mi = 0; mi < 2; ++mi) {
        const int tok0 = mt * 128 + 32 * wave + 16 * mi, b = tok0 / L, pos0 = tok0 - b * L;
        { const int tok = tok0 + r, pos = pos0 + r;
          const float rs = rsqrt_(ssqkv[tok] * (1.0f / 128.0f) + EPS);
          const f32x4 kr1 = *(const f32x4*)(krope + (size_t)tok * 32 + 4 * q), kr2 = *(const f32x4*)(krope + (size_t)tok * 32 + 16 + 4 * q);
          float ss = (kr1.x * kr1.x + kr1.y * kr1.y) + (kr1.z * kr1.z + kr1.w * kr1.w) + (kr2.x * kr2.x + kr2.y * kr2.y) + (kr2.z * kr2.z + kr2.w * kr2.w);
#pragma unroll
          for (int ni = 0; ni < 4; ++ni) { ak[mi][ni] = ak[mi][ni] * rs; const f32x4 v = ak[mi][ni]; ss += (v.x * v.x + v.y * v.y) + (v.z * v.z + v.w * v.w); }
          ss = quad_sum(ss);
          const float rn = rsqrt_(ss * (1.0f / 96.0f) + EPS);
          bf16* dst = Kb + (((size_t)b * NH + head) * L + pos) * QK;
#pragma unroll
          for (int ni = 0; ni < 4; ++ni) { const f32x4 g = *(const f32x4*)(kg + 16 * ni + 4 * q); const f32x4 v = ak[mi][ni] * g * rn;
              u32x2 o; o.x = pk2(v.x, v.y); o.y = pk2(v.z, v.w); *(u32x2*)(dst + 16 * ni + 4 * q) = o; }
          const f32x4 g1 = *(const f32x4*)(kg + 64 + 4 * q), g2 = *(const f32x4*)(kg + 80 + 4 * q);
          f32x4 x1 = kr1 * g1 * rn, x2 = kr2 * g2 * rn;
          const f32x4 cs0 = *(const f32x4*)(rope + ((size_t)pos * 16 + 4 * q) * 2), cs1 = *(const f32x4*)(rope + ((size_t)pos * 16 + 4 * q) * 2 + 4);
          const float co[4] = {cs0.x, cs0.z, cs1.x, cs1.z}, si[4] = {cs0.y, cs0.w, cs1.y, cs1.w};
#pragma unroll
          for (int e = 0; e < 4; ++e) { const float a = x1[e], bb = x2[e]; x1[e] = a * co[e] - bb * si[e]; x2[e] = bb * co[e] + a * si[e]; }
          u32x2 o1, o2; o1.x = pk2(x1.x, x1.y); o1.y = pk2(x1.z, x1.w); o2.x = pk2(x2.x, x2.y); o2.y = pk2(x2.z, x2.w);
          *(u32x2*)(dst + 64 + 4 * q) = o1; *(u32x2*)(dst + 80 + 4 * q) = o2; }
        { const f32x4 sq = *(const f32x4*)(ssqkv + tok0 + 4 * q);
          f32x4 rs4; rs4.x = rsqrt_(sq.x * (1.0f / 128.0f) + EPS); rs4.y = rsqrt_(sq.y * (1.0f / 128.0f) + EPS); rs4.z = rsqrt_(sq.z * (1.0f / 128.0f) + EPS); rs4.w = rsqrt_(sq.w * (1.0f / 128.0f) + EPS);
#pragma unroll
          for (int ni = 0; ni < 4; ++ni) { const f32x4 v = av[mi][ni] * rs4; u32x2 o; o.x = pk2(v.x, v.y); o.y = pk2(v.z, v.w);
              *(u32x2*)(Vt + (((size_t)b * NH + head) * VD + 16 * ni + r) * L + pos0 + 4 * q) = o; } }
    }
}
__device__ __forceinline__ u32x4 conv_row(const bf16* uglu, int b, int pos, int ch) {
    u32x4 xv = (u32x4){0u, 0u, 0u, 0u};
    if (pos >= 0) xv = *(const u32x4*)(uglu + ((size_t)b * L + pos) * DC + ch);
    return xv;
}
__device__ __forceinline__ void conv_fma(float (&a)[8], const u32x4 xv, const f32x4 w0, const f32x4 w1) {
    a[0] += bf_lo(xv.x) * w0.x; a[1] += bf_hi(xv.x) * w0.y; a[2] += bf_lo(xv.y) * w0.z; a[3] += bf_hi(xv.y) * w0.w;
    a[4] += bf_lo(xv.z) * w1.x; a[5] += bf_hi(xv.z) * w1.y; a[6] += bf_lo(xv.w) * w1.z; a[7] += bf_hi(xv.w) * w1.w;
}
__device__ __forceinline__ void phaseB_conv_item(Ctx& c, int l, int grp) {
    const bf16* uglu = WSP(bf16, WS_UGLU); bf16* u2 = WSP(bf16, WS_U2);
    const float* cw = c.in[4] + (size_t)l * CW * DC; const float* cb = c.in[5] + l * DC; const float* lg = c.in[6] + l * DC; const float* lb = c.in[7] + l * DC;
    const int tok0 = grp * 4, b = tok0 / L, pos0 = tok0 - b * L, ch = c.lane * 8;
    float acc[4][8];
    { const f32x4 b0 = *(const f32x4*)(cb + ch), b1 = *(const f32x4*)(cb + ch + 4);
#pragma unroll
      for (int d = 0; d < 4; ++d) { acc[d][0] = b0.x; acc[d][1] = b0.y; acc[d][2] = b0.z; acc[d][3] = b0.w; acc[d][4] = b1.x; acc[d][5] = b1.y; acc[d][6] = b1.z; acc[d][7] = b1.w; } }
    const int base = pos0 - 30;
    u32x4 x0 = conv_row(uglu, b, base + 0, ch), x1 = conv_row(uglu, b, base + 1, ch), x2 = conv_row(uglu, b, base + 2, ch),
          x3 = conv_row(uglu, b, base + 3, ch), x4 = conv_row(uglu, b, base + 4, ch), x5;
    const float* wp = cw + ch;
#pragma unroll 1
    for (int w = 0; w < CW; ++w) {
        x5 = conv_row(uglu, b, (w + 5 <= 33) ? base + w + 5 : -1, ch);
        const f32x4 w0 = *(const f32x4*)wp, w1 = *(const f32x4*)(wp + 4); wp += DC;
        conv_fma(acc[0], x0, w0, w1); conv_fma(acc[1], x1, w0, w1); conv_fma(acc[2], x2, w0, w1); conv_fma(acc[3], x3, w0, w1);
        x0 = x1; x1 = x2; x2 = x3; x3 = x4; x4 = x5;
    }
    const f32x4 g0 = *(const f32x4*)(lg + ch), g1 = *(const f32x4*)(lg + ch + 4), e0 = *(const f32x4*)(lb + ch), e1 = *(const f32x4*)(lb + ch + 4);
    const float gg[8] = {g0.x, g0.y, g0.z, g0.w, g1.x, g1.y, g1.z, g1.w}, be[8] = {e0.x, e0.y, e0.z, e0.w, e1.x, e1.y, e1.z, e1.w};
#pragma unroll
    for (int d = 0; d < 4; ++d) {
        float s = 0.f;
#pragma unroll
        for (int j = 0; j < 8; ++j) s += acc[d][j];
        const float mu = wave_sum(s) * (1.0f / 512.0f);
        float vq = 0.f;
#pragma unroll
        for (int j = 0; j < 8; ++j) { acc[d][j] -= mu; vq += acc[d][j] * acc[d][j]; }
        const float rstd = rsqrt_(wave_sum(vq) * (1.0f / 512.0f) + EPS);
        float y[8];
#pragma unroll
        for (int j = 0; j < 8; ++j) { const float v = acc[d][j] * rstd * gg[j] + be[j]; y[j] = v * sigmoidf_(v); }
        u32x4 o; o.x = pk2(y[0], y[1]); o.y = pk2(y[2], y[3]); o.z = pk2(y[4], y[5]); o.w = pk2(y[6], y[7]);
        *(u32x4*)(u2 + (size_t)(tok0 + d) * DC + ch) = o;
    }
}
__device__ __forceinline__ void phase_B(const Ctx& c0, int l) {
    Ctx c = reopaque(c0);
    constexpr int NQ = MT * NH, NKV = MT * NH, NCV = T / 16;
    for (int it = c.vb; it < NQ + NKV + NCV; it += c.G) {
        if (it < NQ) phaseB_q_item(c, l, it / NH, it % NH);
        else if (it < NQ + NKV) phaseB_kv_item(c, l, (it - NQ) / NH, (it - NQ) % NH);
        else phaseB_conv_item(c, l, (it - NQ - NKV) * 4 + c.wave);
    }
}

constexpr int KROW = 208, VROW = 136, ATT_STAGE = 64 * KROW + 64 * VROW;
constexpr int ATT_ITEMS = NB * NH * 17;
__device__ __forceinline__ void phase_C(const Ctx& c0, int l) {
    Ctx c = reopaque(c0);
    const bf16* Qb = WSP(bf16, WS_Q); const bf16* Kb = WSP(bf16, WS_K); const bf16* Vt = WSP(bf16, WS_VT); bf16* O = WSP(bf16, WS_O);
    unsigned* qctr = WSP(unsigned, WS_CTL) + CW_QUEUE + 64 * l;
    volatile unsigned* misc = (volatile unsigned*)(c.lds + LDS_MISC);
    const int tid = c.tid, wave = c.wave, lane = c.lane, r = lane & 15, q = lane >> 4;
    unsigned char* lds = c.lds;
    for (;;) {
        if (tid == 0) misc[4] = atomicAdd(qctr, 1u);
        __syncthreads();
        const int item = (int)misc[4];
        __syncthreads();
        if (item >= ATT_ITEMS) break;
        const int pp = 15 - item / 64, bh = item % 64, b = bh / NH, h = bh % NH;
        const bool meta = pp < 0;
        const int r0 = meta ? 0 : 16 + 128 * pp;
        const int nfull = meta ? 0 : 2 * pp + 1 + (wave >> 1);
        const int ntiles = meta ? 1 : 2 * pp + 3;
        const bf16* Kbase = Kb + (size_t)bh * L * QK; const bf16* Vbase = Vt + (size_t)bh * VD * L;
        bf16x8 qf[2][3];
#pragma unroll
        for (int mi = 0; mi < 2; ++mi)
#pragma unroll
            for (int ks = 0; ks < 3; ++ks) qf[mi][ks] = *(const bf16x8*)(Qb + ((size_t)bh * L + r0 + 32 * wave + 16 * mi + r) * QK + 32 * ks + 8 * q);
        float m[2] = {-1e30f, -1e30f}, lsum[2] = {0.f, 0.f};
        f32x4 o[2][4];
#pragma unroll
        for (int mi = 0; mi < 2; ++mi)
#pragma unroll
            for (int dt = 0; dt < 4; ++dt) o[mi][dt] = (f32x4){0.f, 0.f, 0.f, 0.f};
        u32x4 rk[3], rv[2];
        auto gload = [&](int kt) {
#pragma unroll
            for (int i = 0; i < 3; ++i) { const int id = tid + 256 * i, row = id / 12, cc = id % 12; rk[i] = *(const u32x4*)(Kbase + (size_t)(kt * 64 + row) * QK + cc * 8); }
#pragma unroll
            for (int i = 0; i < 2; ++i) { const int id = tid + 256 * i, row = id >> 3, cc = id & 7; rv[i] = *(const u32x4*)(Vbase + (size_t)row * L + kt * 64 + cc * 8); }
        };
        auto lstore = [&](int s) {
            unsigned char* st = lds + s * ATT_STAGE;
#pragma unroll
            for (int i = 0; i < 3; ++i) { const int id = tid + 256 * i, row = id / 12, cc = id % 12; *(u32x4*)(st + row * KROW + cc * 16) = rk[i]; }
#pragma unroll
            for (int i = 0; i < 2; ++i) { const int id = tid + 256 * i, row = id >> 3, cc = id & 7; u32x2* d = (u32x2*)(st + 64 * KROW + row * VROW + cc * 16); d[0] = (u32x2){rv[i].x, rv[i].y}; d[1] = (u32x2){rv[i].z, rv[i].w}; }
        };
        gload(0); lstore(0);
        __syncthreads();
        for (int kt = 0; kt < ntiles; ++kt) {
            const int cur = kt & 1;
            if (kt + 1 < ntiles) gload(kt + 1);
            const unsigned char* sK = lds + cur * ATT_STAGE; const unsigned char* sV = sK + 64 * KROW;
            const bool full = kt < nfull;
            if (kt <= nfull) {
                f32x4 s[2][4];
#pragma unroll
                for (int k4 = 0; k4 < 4; ++k4) {
#pragma unroll
                    for (int mi = 0; mi < 2; ++mi) s[mi][k4] = (f32x4){0.f, 0.f, 0.f, 0.f};
                    if (k4 == 0 || full) {
#pragma unroll
                        for (int ks = 0; ks < 3; ++ks) { const bf16x8 kf = *(const bf16x8*)(sK + (16 * k4 + r) * KROW + 64 * ks + 16 * q);
#pragma unroll
                            for (int mi = 0; mi < 2; ++mi) s[mi][k4] = __builtin_amdgcn_mfma_f32_16x16x32_bf16(kf, qf[mi][ks], s[mi][k4], 0, 0, 0); }
                    }
                }
                bf16x8 pf[2][2];
#pragma unroll
                for (int mi = 0; mi < 2; ++mi) {
                    float mx = fmaxf(fmaxf(s[mi][0].x, s[mi][0].y), fmaxf(s[mi][0].z, s[mi][0].w));
                    if (full) {
#pragma unroll
                        for (int k4 = 1; k4 < 4; ++k4) mx = fmaxf(mx, fmaxf(fmaxf(s[mi][k4].x, s[mi][k4].y), fmaxf(s[mi][k4].z, s[mi][k4].w)));
                    }
                    mx = quad_max(mx);
                    const float mn = fmaxf(m[mi], mx), alpha = fast_exp2(m[mi] - mn); m[mi] = mn;
                    float ps = 0.f;
#pragma unroll
                    for (int k4 = 0; k4 < 4; ++k4) {
                        if (k4 == 0 || full) { f32x4 p; p.x = fast_exp2(s[mi][k4].x - mn); p.y = fast_exp2(s[mi][k4].y - mn); p.z = fast_exp2(s[mi][k4].z - mn); p.w = fast_exp2(s[mi][k4].w - mn);
                            ps += (p.x + p.y) + (p.z + p.w); s[mi][k4] = p; }
                    }
                    lsum[mi] = lsum[mi] * alpha + ps;
#pragma unroll
                    for (int dt = 0; dt < 4; ++dt) o[mi][dt] = o[mi][dt] * alpha;
#pragma unroll
                    for (int st = 0; st < 2; ++st) { u32x4 pw;
                        pw.x = pk2(s[mi][2 * st].x, s[mi][2 * st].y); pw.y = pk2(s[mi][2 * st].z, s[mi][2 * st].w); pw.z = pk2(s[mi][2 * st + 1].x, s[mi][2 * st + 1].y); pw.w = pk2(s[mi][2 * st + 1].z, s[mi][2 * st + 1].w);
                        if (!full) { pw.z = 0u; pw.w = 0u; }
                        pf[mi][st] = __builtin_bit_cast(bf16x8, pw); }
                }
#pragma unroll
                for (int st = 0; st < 2; ++st) {
                    if (st == 0 || full) {
#pragma unroll
                        for (int dt = 0; dt < 4; ++dt) {
                            const unsigned char* vp = sV + (16 * dt + r) * VROW + (32 * st + 4 * q) * 2;
                            const u32x2 v0 = *(const u32x2*)vp; u32x2 v1 = (u32x2){0u, 0u};
                            if (full) v1 = *(const u32x2*)(vp + 32);
                            const bf16x8 vf = __builtin_bit_cast(bf16x8, (u32x4){v0.x, v0.y, v1.x, v1.y});
#pragma unroll
                            for (int mi = 0; mi < 2; ++mi) o[mi][dt] = __builtin_amdgcn_mfma_f32_16x16x32_bf16(vf, pf[mi][st], o[mi][dt], 0, 0, 0);
                        }
                    }
                }
            }
            if (kt + 1 < ntiles) lstore(cur ^ 1);
            __syncthreads();
        }
#pragma unroll
        for (int mi = 0; mi < 2; ++mi) {
            const float lt = quad_sum(lsum[mi]);
            if (!meta || (wave == 0 && mi == 0)) {
                const float inv = 1.0f / lt;
                bf16* dst = O + ((size_t)b * L + r0 + 32 * wave + 16 * mi + r) * 512 + h * VD;
#pragma unroll
                for (int dt = 0; dt < 4; ++dt) { const f32x4 v = o[mi][dt] * inv; u32x2 ov; ov.x = pk2(v.x, v.y); ov.y = pk2(v.z, v.w); *(u32x2*)(dst + 16 * dt + 4 * q) = ov; }
            }
        }
    }
}

__device__ __forceinline__ void phase_D(const Ctx& c0, int l) {
    Ctx c = reopaque(c0);
    const bf16* u2 = WSP(bf16, WS_U2); const bf16* O = WSP(bf16, WS_O); const bf16* gates = WSP(bf16, WS_GATES); bf16* merged = WSP(bf16, WS_MERGED);
    const bf16* Wco = (const bf16*)(c.ws + WS_WIN + l * SZ_WLAYER + OFF_WCO); const bf16* Wmla = (const bf16*)(c.ws + WS_WIN + l * SZ_WLAYER + OFF_WMLA);
    const int r = c.lane & 15, q = c.lane >> 4;
    for (int it = c.vb; it < MT * 8; it += c.G) {
        const int mt = it / 8, nt = it % 8;
        f32x4 acc[2][8]; acc_zero(acc);
        gemm_core(acc, u2 + (size_t)mt * 128 * 512, 512, Wco + (size_t)nt * 128 * 512, 512, 512, c.lds, c.tid);
#pragma unroll
        for (int mi = 0; mi < 2; ++mi) { const int tok = mt * 128 + 32 * c.wave + 16 * mi + r;
            const bf16* gp = gates + (size_t)tok * 2048 + nt * 128 + 4 * q; bf16* mp = merged + (size_t)tok * D + nt * 128 + 4 * q;
#pragma unroll
            for (int ni = 0; ni < 8; ++ni) { const u32x2 g = *(const u32x2*)(gp + 16 * ni); const f32x4 v = acc[mi][ni];
                u32x2 o; o.x = pk2(v.x * bf_lo(g.x), v.y * bf_hi(g.x)); o.y = pk2(v.z * bf_lo(g.y), v.w * bf_hi(g.y)); *(u32x2*)(mp + 16 * ni) = o; } }
        acc_zero(acc);
        gemm_core(acc, O + (size_t)mt * 128 * 512, 512, Wmla + (size_t)nt * 128 * 512, 512, 512, c.lds, c.tid);
#pragma unroll
        for (int mi = 0; mi < 2; ++mi) { const int tok = mt * 128 + 32 * c.wave + 16 * mi + r;
            const bf16* gp = gates + (size_t)tok * 2048 + 1024 + nt * 128 + 4 * q; bf16* mp = merged + (size_t)tok * D + nt * 128 + 4 * q;
#pragma unroll
            for (int ni = 0; ni < 8; ++ni) { const u32x2 g = *(const u32x2*)(gp + 16 * ni); const u32x2 s = *(const u32x2*)(mp + 16 * ni); const f32x4 v = acc[mi][ni];
                u32x2 o; o.x = pk2(bf_lo(s.x) + v.x * bf_lo(g.x), bf_hi(s.x) + v.y * bf_hi(g.x)); o.y = pk2(bf_lo(s.y) + v.z * bf_lo(g.y), bf_hi(s.y) + v.w * bf_hi(g.y));
                *(u32x2*)(mp + 16 * ni) = o; } }
    }
}

__device__ __forceinline__ void phase_E(const Ctx& c0, int l) {
    Ctx c = reopaque(c0);
    const bf16* merged = WSP(bf16, WS_MERGED); const bf16* Wout = (const bf16*)(c.ws + WS_WIN + l * SZ_WLAYER + OFF_WOUT);
    float* h = WSP(float, WS_H); bf16* hb = WSP(bf16, WS_HB); float* ssq = WSP(float, WS_SSQ);
    const int r = c.lane & 15, q = c.lane >> 4;
    for (int it = c.vb; it < MT * 8; it += c.G) {
        const int mt = it / 8, nt = it % 8;
        f32x4 acc[2][8]; acc_zero(acc);
        gemm_core(acc, merged + (size_t)mt * 128 * D, D, Wout + (size_t)nt * 128 * D, D, D, c.lds, c.tid);
#pragma unroll
        for (int mi = 0; mi < 2; ++mi) { const int tok = mt * 128 + 32 * c.wave + 16 * mi + r; float ss = 0.f;
#pragma unroll
            for (int ni = 0; ni < 8; ++ni) { float* hp = h + (size_t)tok * D + nt * 128 + 16 * ni + 4 * q; const f32x4 v = *(const f32x4*)hp + acc[mi][ni]; *(f32x4*)hp = v;
                ss += (v.x * v.x + v.y * v.y) + (v.z * v.z + v.w * v.w);
                u32x2 o; o.x = pk2(v.x, v.y); o.y = pk2(v.z, v.w); *(u32x2*)(hb + (size_t)tok * D + nt * 128 + 16 * ni + 4 * q) = o; }
            ss = quad_sum(ss);
            if (q == 0) ssq[(size_t)tok * 8 + nt] = ss; }
    }
}

__device__ __forceinline__ unsigned f2key(float f) { const unsigned u = __float_as_uint(f); return u ^ ((u >> 31) ? 0xFFFFFFFFu : 0x80000000u); }
__device__ __forceinline__ float key2f(unsigned k) { const unsigned u = (k >> 31) ? (k ^ 0x80000000u) : ~k; return __uint_as_float(u); }
__device__ __forceinline__ void top16_insert(unsigned (&lst)[16], unsigned x) {
#pragma unroll
    for (int i = 0; i < 16; ++i) { const unsigned a = lst[i]; lst[i] = a > x ? a : x; x = a > x ? x : a; }
}
__device__ __forceinline__ void phase_F(const Ctx& c0, int l) {
    Ctx c = reopaque(c0);
    const bf16* hb = WSP(bf16, WS_HB); const bf16* Wpq = (const bf16*)(c.ws + WS_WIN + l * SZ_WLAYER + OFF_WPQ); const bf16* keys = (const bf16*)(c.ws + WS_WIN + l * SZ_WLAYER + OFF_KEYS);
    const float* ssq = WSP(float, WS_SSQ); float* sv = WSP(float, WS_SV); unsigned char* si = WSP(unsigned char, WS_SI);
    const int tid = c.tid, wave = c.wave, lane = c.lane, r = lane & 15, q = lane >> 4;
    unsigned char* lds = c.lds;
    for (int it = c.vb; it < MT * 16; it += c.G) {
        const int mt = it / 16, hp = it % 16;
        f32x4 acc[2][8]; acc_zero(acc);
        gemm_core(acc, hb + (size_t)mt * 128 * D, D, Wpq + (size_t)hp * 128 * D, D, D, lds, tid);
#pragma unroll
        for (int mi = 0; mi < 2; ++mi) { const int row = 32 * wave + 16 * mi + r; const float rs = rstd_from_ssq8(ssq, mt * 128 + row);
#pragma unroll
            for (int ni = 0; ni < 8; ++ni) { const f32x4 v = acc[mi][ni] * rs; u32x2 o; o.x = pk2(v.x, v.y); o.y = pk2(v.z, v.w);
                *(u32x2*)(lds + (ni >> 2) * 32768 + lds_off(row, 2 * (ni & 3) + (q >> 1)) + 8 * (q & 1)) = o; } }
        { const int chunk = tid & 7, row0 = tid >> 3; const bf16* pb = keys + ((size_t)hp * 128 + row0) * 128 + chunk * 8;
#pragma unroll
          for (int s = 0; s < 2; ++s)
#pragma unroll
              for (int i = 0; i < 4; ++i) *(u32x4*)(lds + s * 32768 + 16384 + lds_off(row0 + 32 * i, chunk)) = *(const u32x4*)(pb + (size_t)(32 * i) * 128 + s * 64); }
        __syncthreads();
        acc_zero(acc);
        gemm_compute_stage(acc, lds, lds + 16384, wave, lane);
        gemm_compute_stage(acc, lds + 32768, lds + 32768 + 16384, wave, lane);
        __syncthreads();
        float* S = (float*)lds;
#pragma unroll
        for (int mi = 0; mi < 2; ++mi) { const int row = 32 * wave + 16 * mi + r;
#pragma unroll
            for (int ni = 0; ni < 8; ++ni) *(f32x4*)(S + row * 132 + 16 * ni + 4 * q) = acc[mi][ni]; }
        __syncthreads();
        if (tid < 128) {
            unsigned lst[16];
#pragma unroll
            for (int i = 0; i < 16; ++i) lst[i] = 0u;
            const float* row = S + tid * 132;
#pragma unroll 4
            for (int j = 0; j < 32; ++j) { const f32x4 v = *(const f32x4*)(row + 4 * j);
                top16_insert(lst, (f2key(v.x) & ~127u) | (unsigned)(127 - (4 * j)));
                top16_insert(lst, (f2key(v.y) & ~127u) | (unsigned)(127 - (4 * j + 1)));
                top16_insert(lst, (f2key(v.z) & ~127u) | (unsigned)(127 - (4 * j + 2)));
                top16_insert(lst, (f2key(v.w) & ~127u) | (unsigned)(127 - (4 * j + 3))); }
            const int tok = mt * 128 + tid;
            unsigned idx[16]; float val[16];
#pragma unroll
            for (int i = 0; i < 16; ++i) { idx[i] = 127u - (lst[i] & 127u); val[i] = row[idx[i]]; }
            float* svp = sv + ((size_t)tok * 16 + hp) * 16;
#pragma unroll
            for (int i = 0; i < 4; ++i) *(f32x4*)(svp + 4 * i) = (f32x4){val[4 * i], val[4 * i + 1], val[4 * i + 2], val[4 * i + 3]};
            u32x4 pi;
            pi.x = idx[0] | (idx[1] << 8) | (idx[2] << 16) | (idx[3] << 24); pi.y = idx[4] | (idx[5] << 8) | (idx[6] << 16) | (idx[7] << 24);
            pi.z = idx[8] | (idx[9] << 8) | (idx[10] << 16) | (idx[11] << 24); pi.w = idx[12] | (idx[13] << 8) | (idx[14] << 16) | (idx[15] << 24);
            *(u32x4*)(si + ((size_t)tok * 16 + hp) * 16) = pi;
        }
        __syncthreads();
    }
}

__device__ __forceinline__ void phase_F3(const Ctx& c0, int l) {
    Ctx c = reopaque(c0);
    const float* sv = WSP(float, WS_SV); const unsigned char* si = WSP(unsigned char, WS_SI); int* eidx = WSP(int, WS_EIDX); float* gw = WSP(float, WS_GW); unsigned char* stb = WSP(unsigned char, WS_STB);
    float* lsv = (float*)c.lds;
    unsigned char* lsi = c.lds + 256 * 33 * 4;
    const int tid = c.tid;
    for (int base = c.vb * NTHREADS; base < T * 8; base += c.G * NTHREADS) {
        const int th = base + tid;
        float a[16], b[16];
#pragma unroll
        for (int i = 0; i < 4; ++i) { const f32x4 x = *(const f32x4*)(sv + (size_t)th * 32 + 4 * i), y = *(const f32x4*)(sv + (size_t)th * 32 + 16 + 4 * i);
            a[4 * i] = x.x; a[4 * i + 1] = x.y; a[4 * i + 2] = x.z; a[4 * i + 3] = x.w; b[4 * i] = y.x; b[4 * i + 1] = y.y; b[4 * i + 2] = y.z; b[4 * i + 3] = y.w; }
        const u32x4 ia = *(const u32x4*)(si + (size_t)th * 32), ib = *(const u32x4*)(si + (size_t)th * 32 + 16);
#pragma unroll
        for (int i = 0; i < 16; ++i) { lsv[tid * 33 + i] = a[i]; lsv[tid * 33 + 16 + i] = b[i]; }
        *(u32x4*)(lsi + tid * 32) = ia; *(u32x4*)(lsi + tid * 32 + 16) = ib;
        unsigned lst[16];
#pragma unroll
        for (int i = 0; i < 16; ++i) lst[i] = 0u;
#pragma unroll
        for (int i = 0; i < 16; ++i)
#pragma unroll
            for (int j = 0; j < 16; ++j)
                if ((i + 1) * (j + 1) <= 16) top16_insert(lst, (f2key(a[i] + b[j]) & ~255u) | (unsigned)(255 - (i * 16 + j)));
        __builtin_amdgcn_s_waitcnt(0xC07F); asm volatile("" ::: "memory");
        float s[16]; int e[16];
#pragma unroll
        for (int k = 0; k < 16; ++k) { const unsigned code = 255u - (lst[k] & 255u); const int i = code >> 4, j = code & 15;
            s[k] = lsv[tid * 33 + i] + lsv[tid * 33 + 16 + j]; e[k] = (int)lsi[tid * 32 + i] * 128 + (int)lsi[tid * 32 + 16 + j]; }
        float mx = s[0];
#pragma unroll
        for (int k = 1; k < 16; ++k) mx = fmaxf(mx, s[k]);
        float sum = 0.f;
#pragma unroll
        for (int k = 0; k < 16; ++k) { s[k] = fast_exp2((s[k] - mx) * 1.4426950409f); sum += s[k]; }
        const float inv = 1.0f / sum;
        typedef unsigned long long u64;
        u64 hlo = 0ull, hhi = 0ull;
#pragma unroll
        for (int k = 0; k < 16; ++k) { const int sl = e[k] >> 10; if (sl < 8) hlo += 1ull << (8 * sl); else hhi += 1ull << (8 * (sl - 8)); }
        u64 ilo = hlo, ihi = hhi;
#pragma unroll
        for (int d = 1; d < 8; d <<= 1) { const u64 a_ = __shfl_up(ilo, d, 8), b_ = __shfl_up(ihi, d, 8); if ((tid & 7) >= d) { ilo += a_; ihi += b_; } }
        const u64 tlo = __shfl(ilo, 7, 8), thi = __shfl(ihi, 7, 8);
        const u64 ones = 0x0101010101010101ull;
        const u64 inlo = tlo * ones, inhi = thi * ones + (inlo >> 56) * ones;
        const u64 stlo = inlo - tlo, sthi = inhi - thi;
        u64 rlo = stlo + (ilo - hlo), rhi = sthi + (ihi - hhi);
        const int tokn = th >> 3;
#pragma unroll
        for (int k = 0; k < 16; ++k) { const int sl = e[k] >> 10; int pos;
            if (sl < 8) { pos = (int)((rlo >> (8 * sl)) & 255ull); rlo += 1ull << (8 * sl); } else { pos = (int)((rhi >> (8 * (sl - 8))) & 255ull); rhi += 1ull << (8 * (sl - 8)); }
            eidx[(size_t)tokn * 128 + pos] = e[k]; gw[(size_t)tokn * 128 + pos] = s[k] * inv; }
        if ((tid & 7) == 0) { u64* sp = (u64*)(stb + (size_t)tokn * 16); sp[0] = stlo; sp[1] = sthi; }
        __builtin_amdgcn_s_waitcnt(0xC07F); asm volatile("" ::: "memory");
    }
}

typedef float f32x2 __attribute__((ext_vector_type(2)));
constexpr int G2_WSTRIDE = 14336, G2_MAXTOK = 9;
__device__ __forceinline__ float fp8dot4(unsigned w, unsigned x01, unsigned x23, float acc) {
    const bf16x2 lo = __builtin_amdgcn_cvt_scalef32_pk_bf16_fp8(w, 1.0f, false), hi = __builtin_amdgcn_cvt_scalef32_pk_bf16_fp8(w, 1.0f, true);
    acc = __builtin_amdgcn_fdot2_f32_bf16(lo, __builtin_bit_cast(bf16x2, x01), acc, false);
    return __builtin_amdgcn_fdot2_f32_bf16(hi, __builtin_bit_cast(bf16x2, x23), acc, false);
}
__device__ __forceinline__ float reduce8_transposed(const float (&p)[8], int lane) {
    float s[4];
#pragma unroll
    for (int k = 0; k < 4; ++k) { auto r = __builtin_amdgcn_permlane32_swap(__float_as_uint(p[k]), __float_as_uint(p[k + 4]), false, false); s[k] = __uint_as_float(r[0]) + __uint_as_float(r[1]); }
    float t[2];
#pragma unroll
    for (int k = 0; k < 2; ++k) { auto r = __builtin_amdgcn_permlane16_swap(__float_as_uint(s[k]), __float_as_uint(s[k + 2]), false, false); t[k] = __uint_as_float(r[0]) + __uint_as_float(r[1]); }
    const float u0 = t[0] + dpp<0x128>(t[0]), u1 = t[1] + dpp<0x128>(t[1]);
    float r = (lane & 8) ? u1 : u0;
    r += dpp<0xB1>(r); r += dpp<0x4E>(r); r += dpp<0x141>(r);
    return r;
}
typedef int i32x4 __attribute__((ext_vector_type(4)));
__device__ __forceinline__ void fp8fma4(f32x2 (&acc)[8], int o, unsigned w, f32x2 a2) {
    const f32x2 lo = __builtin_amdgcn_cvt_scalef32_pk_f32_fp8(w, 1.0f, false), hi = __builtin_amdgcn_cvt_scalef32_pk_f32_fp8(w, 1.0f, true);
    acc[o] = __builtin_elementwise_fma(a2, lo, acc[o]); acc[o + 1] = __builtin_elementwise_fma(a2, hi, acc[o + 1]);
}
__device__ __forceinline__ void g2_u_chunk(u32x4 (&u)[8], const unsigned char* U, const int* pe_next, const float* pw_c, float* act_c, const u32x4 xa, const u32x4 xb, float rs, int lane) {
    const i32x4 e0 = *(const i32x4*)pe_next, e1 = *(const i32x4*)(pe_next + 4);
    const int en[8] = {e0.x, e0.y, e0.z, e0.w, e1.x, e1.y, e1.z, e1.w};
    float p[8];
#pragma unroll
    for (int k = 0; k < 8; ++k) {
        float d0 = fp8dot4(u[k].x, xa.x, xa.y, 0.f), d1 = fp8dot4(u[k].y, xa.z, xa.w, 0.f); d0 = fp8dot4(u[k].z, xb.x, xb.y, d0); d1 = fp8dot4(u[k].w, xb.z, xb.w, d1); p[k] = d0 + d1;
        asm volatile("" : "+v"(p[k]));
        u[k] = *(const u32x4*)(U + (size_t)__builtin_amdgcn_readfirstlane(en[k]) * 1024 + lane * 16);
    }
    const float a = reduce8_transposed(p, lane);
    const int row = (lane >> 3) & 7;
    if ((lane & 7) == 0) act_c[row] = gelu_tanh(a * rs) * pw_c[row];
}
__device__ __forceinline__ void g2_v_chunk(u32x4 (&v)[8], const unsigned char* V, const int* pe_next, const float* act_c, f32x2 (&acc)[8], int lane) {
    const i32x4 e0 = *(const i32x4*)pe_next, e1 = *(const i32x4*)(pe_next + 4);
    const int en[8] = {e0.x, e0.y, e0.z, e0.w, e1.x, e1.y, e1.z, e1.w};
    const f32x4 a0 = *(const f32x4*)act_c, a1 = *(const f32x4*)(act_c + 4);
    const float av[8] = {a0.x, a0.y, a0.z, a0.w, a1.x, a1.y, a1.z, a1.w};
#pragma unroll
    for (int k = 0; k < 8; ++k) { const f32x2 a2 = (f32x2){av[k], av[k]};
        fp8fma4(acc, 0, v[k].x, a2); fp8fma4(acc, 2, v[k].y, a2); fp8fma4(acc, 4, v[k].z, a2); fp8fma4(acc, 6, v[k].w, a2);
        asm volatile("" : "+v"(acc[0]), "+v"(acc[1]), "+v"(acc[2]), "+v"(acc[3]), "+v"(acc[4]), "+v"(acc[5]), "+v"(acc[6]), "+v"(acc[7]));
        v[k] = *(const u32x4*)(V + (size_t)__builtin_amdgcn_readfirstlane(en[k]) * 1024 + lane * 16);
    }
}
__device__ __forceinline__ void g2_finish_token(Ctx& c, int l, int tok, const f32x2 (&acc)[8], int lane) {
    float* h = WSP(float, WS_H); bf16* hbw = WSP(bf16, WS_HB); float* ssqw = WSP(float, WS_SSQ);
    float* hp = h + (size_t)tok * D + lane * 16;
    f32x4 r0 = *(const f32x4*)hp, r1 = *(const f32x4*)(hp + 4), r2 = *(const f32x4*)(hp + 8), r3 = *(const f32x4*)(hp + 12);
    r0 += (f32x4){acc[0].x, acc[0].y, acc[1].x, acc[1].y}; r1 += (f32x4){acc[2].x, acc[2].y, acc[3].x, acc[3].y};
    r2 += (f32x4){acc[4].x, acc[4].y, acc[5].x, acc[5].y}; r3 += (f32x4){acc[6].x, acc[6].y, acc[7].x, acc[7].y};
    if (l == 0) {
        *(f32x4*)hp = r0; *(f32x4*)(hp + 4) = r1; *(f32x4*)(hp + 8) = r2; *(f32x4*)(hp + 12) = r3;
        u32x4 o0, o1; o0.x = pk2(r0.x, r0.y); o0.y = pk2(r0.z, r0.w); o0.z = pk2(r1.x, r1.y); o0.w = pk2(r1.z, r1.w);
        o1.x = pk2(r2.x, r2.y); o1.y = pk2(r2.z, r2.w); o1.z = pk2(r3.x, r3.y); o1.w = pk2(r3.z, r3.w);
        *(u32x4*)(hbw + (size_t)tok * D + lane * 16) = o0; *(u32x4*)(hbw + (size_t)tok * D + lane * 16 + 8) = o1;
        float ss = (r0.x * r0.x + r0.y * r0.y) + (r0.z * r0.z + r0.w * r0.w) + (r1.x * r1.x + r1.y * r1.y) + (r1.z * r1.z + r1.w * r1.w)
                 + (r2.x * r2.x + r2.y * r2.y) + (r2.z * r2.z + r2.w * r2.w) + (r3.x * r3.x + r3.y * r3.y) + (r3.z * r3.z + r3.w * r3.w);
        ss = wave_sum_dpp(ss);
        if (lane < 8) ssqw[(size_t)tok * 8 + lane] = lane == 0 ? ss : 0.f;
    } else {
        const int b = tok / L, pos = tok - b * L;
        if (pos >= NMETA) { float* op = c.out + ((size_t)b * SEQ + (pos - NMETA)) * D + lane * 16;
            *(f32x4*)op = r0; *(f32x4*)(op + 4) = r1; *(f32x4*)(op + 8) = r2; *(f32x4*)(op + 12) = r3; }
    }
}
__device__ __forceinline__ void phase_G2(const Ctx& c0, int l) {
    Ctx c = reopaque(c0);
    const bf16* hb = WSP(bf16, WS_HB); const float* ssq = WSP(float, WS_SSQ); const int* pe = WSP(int, WS_EIDX); const float* pw = WSP(float, WS_GW);
    const unsigned char* U = c.ws + WS_TAB + (size_t)(l * 2) * SZ_TAB; const unsigned char* V = c.ws + WS_TAB + (size_t)(l * 2 + 1) * SZ_TAB;
    const int lane = c.lane, wave = c.wave;
    const int gw = c.vb * 4 + wave, t0 = gw * 8;
    const bool has_x = (c.vb & 3) == 0; const int tx = T - 128 + (c.vb >> 2);
    unsigned char* wl = c.lds + wave * G2_WSTRIDE;
    int* pe_l = (int*)wl; float* pw_l = (float*)(wl + 4608); float* act_l = (float*)(wl + 9216);
#pragma unroll
    for (int j = 0; j < G2_MAXTOK; ++j) { const int tok = j < 8 ? t0 + j : (has_x ? tx : t0);
        pe_l[j * 128 + lane] = pe[(size_t)tok * 128 + lane]; pe_l[j * 128 + 64 + lane] = pe[(size_t)tok * 128 + 64 + lane];
        pw_l[j * 128 + lane] = pw[(size_t)tok * 128 + lane] * TAB_INV; pw_l[j * 128 + 64 + lane] = pw[(size_t)tok * 128 + 64 + lane] * TAB_INV; }
    const int xlo = has_x ? 4 * wave : 16, xhi = has_x ? 4 * wave + 4 : 16;
    {
        u32x4 xa[G2_MAXTOK], xb[G2_MAXTOK]; float rs[G2_MAXTOK];
#pragma unroll
        for (int j = 0; j < G2_MAXTOK; ++j) { const int tok = j < 8 ? t0 + j : (has_x ? tx : t0);
            xa[j] = *(const u32x4*)(hb + (size_t)tok * D + lane * 16); xb[j] = *(const u32x4*)(hb + (size_t)tok * D + lane * 16 + 8); rs[j] = rstd_from_ssq8(ssq, tok) * TAB_INV; }
        u32x4 u[8];
#pragma unroll
        for (int k = 0; k < 8; ++k) u[k] = *(const u32x4*)(U + (size_t)__builtin_amdgcn_readfirstlane(pe_l[k]) * 1024 + lane * 16);
#pragma unroll 1
        for (int ch = 0; ch < 16; ++ch) {
            const int cn = ch < 15 ? ch + 1 : 0;
            const bool x_here = ch >= xlo && ch < xhi;
#pragma unroll
            for (int j = 0; j < 8; ++j) {
                const int* pe_next = j < 7 ? pe_l + (j + 1) * 128 + ch * 8 : (x_here ? pe_l + 8 * 128 + ch * 8 : pe_l + cn * 8);
                g2_u_chunk(u, U, pe_next, pw_l + j * 128 + ch * 8, act_l + j * 128 + ch * 8, xa[j], xb[j], rs[j], lane); }
            if (x_here) g2_u_chunk(u, U, pe_l + cn * 8, pw_l + 8 * 128 + ch * 8, act_l + 8 * 128 + ch * 8, xa[8], xb[8], rs[8], lane);
        }
    }
    f32x2 acc[G2_MAXTOK][8];
#pragma unroll
    for (int j = 0; j < G2_MAXTOK; ++j)
#pragma unroll
        for (int i = 0; i < 8; ++i) acc[j][i] = (f32x2){0.f, 0.f};
    {
        u32x4 v[8];
#pragma unroll
        for (int k = 0; k < 8; ++k) v[k] = *(const u32x4*)(V + (size_t)__builtin_amdgcn_readfirstlane(pe_l[k]) * 1024 + lane * 16);
#pragma unroll 1
        for (int ch = 0; ch < 16; ++ch) {
            const int cn = ch < 15 ? ch + 1 : 0;
            const bool x_here = ch >= xlo && ch < xhi;
#pragma unroll
            for (int j = 0; j < 8; ++j) {
                const int* pe_next = j < 7 ? pe_l + (j + 1) * 128 + ch * 8 : (x_here ? pe_l + 8 * 128 + ch * 8 : pe_l + cn * 8);
                g2_v_chunk(v, V, pe_next, act_l + j * 128 + ch * 8, acc[j], lane); }
            if (x_here) g2_v_chunk(v, V, pe_l + cn * 8, act_l + 8 * 128 + ch * 8, acc[8], lane);
        }
    }
#pragma unroll
    for (int j = 0; j < 8; ++j) g2_finish_token(c, l, t0 + j, acc[j], lane);
    __syncthreads();
    if (has_x) {
        f32x2* part = (f32x2*)(c.lds + wave * G2_WSTRIDE);
#pragma unroll
        for (int i = 0; i < 8; ++i) part[i * 64 + lane] = acc[8][i];
    }
    __syncthreads();
    if (has_x && wave == 0) {
        f32x2 tot[8];
#pragma unroll
        for (int i = 0; i < 8; ++i) { tot[i] = acc[8][i];
#pragma unroll
            for (int w = 1; w < 4; ++w) tot[i] += ((const f32x2*)(c.lds + w * G2_WSTRIDE))[i * 64 + lane]; }
        g2_finish_token(c, l, tx, tot, lane);
    }
    __syncthreads();
}

struct Args { const float* in[22]; float* out; unsigned char* ws; int ph_lo, ph_hi; };
constexpr int N_PHASES = 17;

__global__ void __launch_bounds__(NTHREADS, 2) fwd_kernel(Args args) {
    extern __shared__ __attribute__((aligned(16))) unsigned char lds_raw[];
    Ctx c;
#pragma unroll
    for (int i = 0; i < 22; ++i) c.in[i] = args.in[i];
    c.out = args.out; c.ws = args.ws; c.lds = lds_raw;
    c.tid = threadIdx.x; c.lane = c.tid & 63; c.wave = __builtin_amdgcn_readfirstlane(c.tid >> 6);
    c.G = gridDim.x; { const int bx = blockIdx.x; c.vb = (c.G % 8 == 0) ? (bx % 8) * (c.G / 8) + bx / 8 : bx; }
    volatile unsigned* misc = (volatile unsigned*)(c.lds + LDS_MISC);
    if (c.tid < 16) misc[c.tid] = 0u;
    __syncthreads();
    const int lo = args.ph_lo, hi = args.ph_hi;
    const bool multi = (hi - lo) > 1;
    XcdBarrier bar; bar.bar = WSP(unsigned, WS_CTL) + CW_BAR; bar.x = 0; bar.st = misc;
    if (multi) bar = xcd_barrier_post(WSP(unsigned, WS_CTL) + CW_BAR, misc);
#define IN_(k) (lo <= (k) && (k) < hi)
#define SEAM_(k) do { if ((k) + 1 < hi) xcd_barrier(bar); } while (0)
    if (IN_(0)) { phase_prologue(c); SEAM_(0); }
#pragma unroll 1
    for (int l = 0; l < 2; ++l) {
        const int p0 = 1 + 8 * l;
        if (IN_(p0 + 0)) { phase_A(c, l); SEAM_(p0 + 0); }
        if (IN_(p0 + 1)) { phase_B(c, l); SEAM_(p0 + 1); }
        if (IN_(p0 + 2)) { phase_C(c, l); SEAM_(p0 + 2); }
        if (IN_(p0 + 3)) { phase_D(c, l); SEAM_(p0 + 3); }
        if (IN_(p0 + 4)) { phase_E(c, l); SEAM_(p0 + 4); }
        if (IN_(p0 + 5)) { phase_F(c, l); SEAM_(p0 + 5); }
        if (IN_(p0 + 6)) { phase_F3(c, l); SEAM_(p0 + 6); }
        if (IN_(p0 + 7)) { phase_G2(c, l); SEAM_(p0 + 7); }
    }
}

extern "C" void kernel_launch(void* const* d_in, const int* in_sizes, int n_in, void* d_out, int out_size, void* d_ws, size_t ws_size, hipStream_t stream) {
    static int grid = 0;
    if (grid == 0) {
        if (n_in != 22 || out_size != NB * SEQ * D || ws_size < WS_END) { fprintf(stderr, "kernel_launch: unexpected shapes (n_in %d out %d ws %zu need %zu)\n", n_in, out_size, ws_size, (size_t)WS_END); grid = -1; return; }
        int dev = 0, cus = 0, per_cu = 0;
        hipGetDevice(&dev); hipDeviceGetAttribute(&cus, hipDeviceAttributeMultiprocessorCount, dev);
        if (hipFuncSetAttribute((const void*)fwd_kernel, hipFuncAttributeMaxDynamicSharedMemorySize, LDS_BYTES) != hipSuccess) { fprintf(stderr, "kernel_launch: hipFuncSetAttribute failed\n"); grid = -1; return; }
        if (hipOccupancyMaxActiveBlocksPerMultiprocessor(&per_cu, (const void*)fwd_kernel, NTHREADS, LDS_BYTES) != hipSuccess || per_cu < 1) { fprintf(stderr, "kernel_launch: occupancy query failed (%d)\n", per_cu); per_cu = 1; (void)hipGetLastError(); }
        if (per_cu > 2) per_cu = 2;
        grid = cus * per_cu;
        if (grid != 512) { fprintf(stderr, "kernel_launch: grid %d unsupported by phase G2 (needs 512 workgroups)\n", grid); grid = -1; return; }
        fprintf(stderr, "kernel_launch: grid %d (%d per CU), lds %d, ws need %zu have %zu\n", grid, per_cu, LDS_BYTES, (size_t)WS_END, ws_size);
    }
    if (grid < 0) return;
    hipMemsetAsync((char*)d_ws + WS_CTL, 0, CTL_BYTES, stream);
    Args a{};
    for (int i = 0; i < 22; ++i) a.in[i] = (const float*)d_in[i];
    a.out = (float*)d_out; a.ws = (unsigned char*)d_ws;
#if MK_PER_PHASE
    for (int ph = 0; ph < N_PHASES; ++ph) { a.ph_lo = ph; a.ph_hi = ph + 1; hipLaunchKernelGGL(fwd_kernel, dim3(grid), dim3(NTHREADS), LDS_BYTES, stream, a); }
#else
    a.ph_lo = 0; a.ph_hi = N_PHASES;
    void* kargs[] = {&a};
    hipError_t e = hipLaunchCooperativeKernel((const void*)fwd_kernel, dim3(grid), dim3(NTHREADS), kargs, LDS_BYTES, stream);
    if (e != hipSuccess) fprintf(stderr, "kernel_launch: cooperative launch failed: %s (grid %d)\n", hipGetErrorString(e), grid);
#endif
}
```

```cpp
#include <hip/hip_runtime.h>
#include <cstdio>
#include <cstdint>

#ifndef MK_PER_PHASE
#define MK_PER_PHASE 0
#endif

typedef unsigned short bf16;
typedef short bf16x8 __attribute__((ext_vector_type(8)));
typedef float f32x4 __attribute__((ext_vector_type(4)));
typedef unsigned u32x4 __attribute__((ext_vector_type(4)));
typedef unsigned u32x2 __attribute__((ext_vector_type(2)));
typedef __bf16 bf16x2 __attribute__((ext_vector_type(2)));

constexpr int NB = 8, SEQ = 2048, NMETA = 16, L = SEQ + NMETA, T = NB * L, D = 1024;
constexpr int DC = 512, CW = 31, NH = 8, QL = 256, KVL = 128, NOPE = 64, ROPE = 32, QK = 96, VD = 64;
constexpr int NIN = 3488, NINP = 3584;
constexpr int NEXP = 16384;
constexpr float EPS = 1e-6f;
constexpr int MT = T / 128;
static_assert(T % 128 == 0, "T tiles");

constexpr size_t al256(size_t x) { return (x + 255) & ~(size_t)255; }
constexpr size_t WS_CTL = 0;
constexpr size_t CTL_BYTES = 65536;
constexpr size_t WS_ROPE = WS_CTL + CTL_BYTES;
constexpr size_t WS_WIN = al256(WS_ROPE + (size_t)L * 16 * 8);
constexpr size_t SZ_WIN = (size_t)NINP * 1024 * 2, SZ_WCO = (size_t)1024 * 512 * 2, SZ_WUQ = (size_t)1024 * 256 * 2, SZ_WUKV = (size_t)1024 * 128 * 2,
                 SZ_WMLA = (size_t)1024 * 512 * 2, SZ_WOUT = (size_t)1024 * 1024 * 2, SZ_WPQ = (size_t)2048 * 1024 * 2, SZ_KEYS = (size_t)16 * 128 * 128 * 2;
constexpr size_t OFF_WCO = SZ_WIN, OFF_WUQ = OFF_WCO + SZ_WCO, OFF_WUKV = OFF_WUQ + SZ_WUQ, OFF_WMLA = OFF_WUKV + SZ_WUKV, OFF_WOUT = OFF_WMLA + SZ_WMLA,
                 OFF_WPQ = OFF_WOUT + SZ_WOUT, OFF_KEYS = OFF_WPQ + SZ_WPQ, SZ_WLAYER = OFF_KEYS + SZ_KEYS;
constexpr size_t WS_TAB = al256(WS_WIN + 2 * SZ_WLAYER);
constexpr size_t SZ_TAB = (size_t)NEXP * 1024;
constexpr float TAB_SCALE = 256.0f, TAB_INV = 1.0f / 256.0f;
constexpr size_t WS_H = al256(WS_TAB + 4 * SZ_TAB);
constexpr size_t WS_HB = al256(WS_H + (size_t)T * 1024 * 4);
constexpr size_t WS_SSQ = al256(WS_HB + (size_t)T * 1024 * 2);
constexpr size_t WS_UGLU = al256(WS_SSQ + (size_t)T * 8 * 4);
constexpr size_t WS_CQ = al256(WS_UGLU + (size_t)T * 512 * 2);
constexpr size_t WS_CKV = al256(WS_CQ + (size_t)T * 256 * 2);
constexpr size_t WS_KROPE = al256(WS_CKV + (size_t)T * 128 * 2);
constexpr size_t WS_SSQQ = al256(WS_KROPE + (size_t)T * 32 * 4);
constexpr size_t WS_SSQKV = al256(WS_SSQQ + (size_t)T * 2 * 4);
constexpr size_t WS_U2 = al256(WS_SSQKV + (size_t)T * 4);
constexpr size_t WS_Q = al256(WS_U2 + (size_t)T * 512 * 2);
constexpr size_t WS_K = al256(WS_Q + (size_t)T * NH * QK * 2);
constexpr size_t WS_VT = al256(WS_K + (size_t)T * NH * QK * 2);
constexpr size_t WS_O = al256(WS_VT + (size_t)T * NH * VD * 2 + 4096);
constexpr size_t WS_MERGED = al256(WS_O + (size_t)T * 512 * 2);
constexpr size_t WS_GATES = al256(WS_MERGED + (size_t)T * 1024 * 2);
constexpr size_t WS_SV = WS_GATES;
constexpr size_t WS_SI = al256(WS_SV + (size_t)T * 256 * 4);
constexpr size_t WS_EIDX = al256(WS_SI + (size_t)T * 256);
constexpr size_t WS_GW = al256(WS_EIDX + (size_t)T * 128 * 4);
constexpr size_t WS_STB = al256(WS_GW + (size_t)T * 128 * 4);
constexpr size_t WS_PEER_END = WS_STB + (size_t)T * 16;
constexpr size_t WS_END = al256(WS_GATES + (size_t)T * 2048 * 2);
static_assert(WS_PEER_END <= WS_END, "peer scratch overlay");

constexpr int CW_BAR = 0;
constexpr int CW_QUEUE = 4096;

constexpr int LDS_MAIN = 128 * 132 * 4;
constexpr int LDS_MISC = LDS_MAIN;
constexpr int LDS_BYTES = LDS_MAIN + 64;

constexpr int NTHREADS = 256;

__device__ __forceinline__ unsigned pk2(float lo, float hi) { bf16x2 v; v.x = (__bf16)lo; v.y = (__bf16)hi; return __builtin_bit_cast(unsigned, v); }
__device__ __forceinline__ float bf_lo(unsigned p) { return __uint_as_float(p << 16); }
__device__ __forceinline__ float bf_hi(unsigned p) { return __uint_as_float(p & 0xffff0000u); }
__device__ __forceinline__ float fast_rcp(float x) { return __builtin_amdgcn_rcpf(x); }
__device__ __forceinline__ float fast_exp2(float x) { return __builtin_amdgcn_exp2f(x); }
__device__ __forceinline__ float sigmoidf_(float x) { return fast_rcp(1.0f + fast_exp2(-1.4426950409f * x)); }
__device__ __forceinline__ float gelu_tanh(float x) { const float u = 1.5957691216f * (x + 0.044715f * x * x * x); return x * fast_rcp(1.0f + fast_exp2(-1.4426950409f * u)); }
__device__ __forceinline__ float rsqrt_(float x) { return __builtin_amdgcn_rsqf(x); }
template <int CTRL> __device__ __forceinline__ float dpp(float x) { return __builtin_bit_cast(float, __builtin_amdgcn_mov_dpp(__builtin_bit_cast(int, x), CTRL, 0xf, 0xf, true)); }
__device__ __forceinline__ float xrow16_sum(float x) {
    auto s = __builtin_amdgcn_permlane16_swap(__float_as_uint(x), __float_as_uint(x), false, false);
    x = __uint_as_float(s[0]) + __uint_as_float(s[1]);
    auto t = __builtin_amdgcn_permlane32_swap(__float_as_uint(x), __float_as_uint(x), false, false);
    return __uint_as_float(t[0]) + __uint_as_float(t[1]);
}
__device__ __forceinline__ float xrow16_max(float x) {
    auto s = __builtin_amdgcn_permlane16_swap(__float_as_uint(x), __float_as_uint(x), false, false);
    x = fmaxf(__uint_as_float(s[0]), __uint_as_float(s[1]));
    auto t = __builtin_amdgcn_permlane32_swap(__float_as_uint(x), __float_as_uint(x), false, false);
    return fmaxf(__uint_as_float(t[0]), __uint_as_float(t[1]));
}
__device__ __forceinline__ float wave_sum_dpp(float x) {
    x += dpp<0xB1>(x); x += dpp<0x4E>(x); x += dpp<0x141>(x); x += dpp<0x128>(x); return xrow16_sum(x);
}
__device__ __forceinline__ float quad_sum(float v) { return xrow16_sum(v); }
__device__ __forceinline__ float quad_max(float v) { return xrow16_max(v); }
__device__ __forceinline__ float wave_sum(float v) { return wave_sum_dpp(v); }
__device__ __forceinline__ float dot2(unsigned a, unsigned b, float c) { return __builtin_amdgcn_fdot2_f32_bf16(__builtin_bit_cast(bf16x2, a), __builtin_bit_cast(bf16x2, b), c, false); }

#define XB_TMO      128
#define XB_XCNT(j)  (256  + 64 * (j))
#define XB_XSUB(j)  (1280 + 64 * (j))
#define XB_XGEN(j)  (2304 + 64 * (j))
#define XB_TOP      3328
#define XB_TOPGEN   3392
#define XCD_BAR_WORDS 3456
#define XB_SPIN_CAP (1u << 20)
__device__ __forceinline__ unsigned xb_ld(unsigned* p)              { return __hip_atomic_load(p, __ATOMIC_RELAXED, __HIP_MEMORY_SCOPE_AGENT); }
__device__ __forceinline__ unsigned xb_add(unsigned* p, unsigned v) { return __hip_atomic_fetch_add(p, v, __ATOMIC_RELAXED, __HIP_MEMORY_SCOPE_AGENT); }
__device__ __forceinline__ unsigned xb_xcc_id() { return (unsigned)__builtin_amdgcn_s_getreg((3 << 11) | 20) & 0xFu; }
#define XB_SPIN(cond, bar) do { unsigned _sp = 0; while (cond) { __builtin_amdgcn_s_sleep(1); \
    if ((++_sp & 255u) == 0u) { if (xb_ld(&(bar)[XB_TMO])) break; if (_sp > XB_SPIN_CAP) { atomicAdd(&(bar)[XB_TMO], 1u); break; } } } } while (0)
struct XcdBarrier { unsigned* bar; unsigned x; volatile unsigned* st; };
__device__ __forceinline__ XcdBarrier xcd_barrier_post(unsigned* bar, volatile unsigned* st) {
    XcdBarrier b; b.bar = bar; b.x = xb_xcc_id(); b.st = st;
    if (threadIdx.x == 0) (void)xb_add(&bar[XB_XCNT(b.x)], 1u);
    return b;
}
__device__ __forceinline__ void xcd_barrier_complete(unsigned* bar, unsigned x, unsigned& nloc, unsigned& nx) {
    const unsigned G = gridDim.x * gridDim.y * gridDim.z;
    unsigned sum, cnt, mine, sp = 0u;
    for (;;) {
        sum = 0u; cnt = 0u; mine = 0u;
#pragma unroll
        for (unsigned j = 0; j < 16; ++j) { const unsigned c = xb_ld(&bar[XB_XCNT(j)]); sum += c; cnt += (c > 0u) ? 1u : 0u; mine = (j == x) ? c : mine; }
        if (sum == G) break;
        __builtin_amdgcn_s_sleep(1);
        if ((++sp & 255u) == 0u) { if (xb_ld(&bar[XB_TMO])) break; if (sp > XB_SPIN_CAP) { atomicAdd(&bar[XB_TMO], 1u); break; } }
    }
    nloc = mine > 0u ? mine : 1u; nx = cnt > 0u ? cnt : 1u;
}
__device__ __forceinline__ void xcd_barrier(const XcdBarrier& b) {
    asm volatile("s_waitcnt vmcnt(0)" ::: "memory");
    __syncthreads();
    if (threadIdx.x == 0) {
        unsigned* bar = b.bar;
        __builtin_amdgcn_s_waitcnt(0);
        unsigned nloc = b.st[0], nx = b.st[1];
        if (nloc == 0u) { xcd_barrier_complete(bar, b.x, nloc, nx); b.st[0] = nloc; b.st[1] = nx; }
        const unsigned old = xb_add(&bar[XB_XSUB(b.x)], 1u);
        const unsigned gen = old / nloc;
        if (old + 1u == (gen + 1u) * nloc) {
            __builtin_amdgcn_fence(__ATOMIC_RELEASE, "agent");
            asm volatile("s_waitcnt vmcnt(0)" ::: "memory");
            const unsigned og = xb_add(&bar[XB_TOP], 1u);
            const unsigned tg = og / nx;
            if (og + 1u == (tg + 1u) * nx) xb_add(&bar[XB_TOPGEN], 1u);
            else XB_SPIN(xb_ld(&bar[XB_TOPGEN]) == tg, bar);
            __builtin_amdgcn_fence(__ATOMIC_ACQUIRE, "agent");
            xb_add(&bar[XB_XGEN(b.x)], 1u);
            asm volatile("s_waitcnt vmcnt(0)" ::: "memory");
        } else {
            XB_SPIN(xb_ld(&bar[XB_XGEN(b.x)]) == gen, bar);
            __builtin_amdgcn_fence(__ATOMIC_ACQUIRE, "agent");
            asm volatile("s_waitcnt vmcnt(0)" ::: "memory");
        }
    }
    __syncthreads();
}

struct Ctx {
    const float* in[22]; float* out; unsigned char* ws;
    unsigned char* lds; int tid, lane, wave, G, vb;
};
#define WSP(T_, off) ((T_*)(c.ws + (off)))
__device__ __forceinline__ Ctx reopaque(const Ctx& c0) {
    Ctx c = c0; int t = c0.tid; asm volatile("" : "+v"(t)); c.tid = t; c.lane = t & 63; c.wave = __builtin_amdgcn_readfirstlane(t >> 6);
    int vb = c0.vb; asm volatile("" : "+s"(vb)); c.vb = vb; return c;
}

__device__ __forceinline__ int lds_off(int row, int chunk) { return row * 128 + ((chunk ^ (row & 7)) << 4); }

__device__ __forceinline__ void gemm_compute_stage(f32x4 (&acc)[2][8], const unsigned char* sA, const unsigned char* sB, int wave, int lane) {
    const int r = lane & 15, q = lane >> 4;
#pragma unroll
    for (int ks = 0; ks < 2; ++ks) {
        bf16x8 af[2], bfr[8];
#pragma unroll
        for (int mi = 0; mi < 2; ++mi) af[mi] = *(const bf16x8*)(sA + lds_off(32 * wave + 16 * mi + r, 4 * ks + q));
#pragma unroll
        for (int ni = 0; ni < 8; ++ni) bfr[ni] = *(const bf16x8*)(sB + lds_off(16 * ni + r, 4 * ks + q));
#pragma unroll
        for (int mi = 0; mi < 2; ++mi)
#pragma unroll
            for (int ni = 0; ni < 8; ++ni) acc[mi][ni] = __builtin_amdgcn_mfma_f32_16x16x32_bf16(bfr[ni], af[mi], acc[mi][ni], 0, 0, 0);
    }
}

#define LAS __attribute__((address_space(3)))
__device__ __forceinline__ void gemm_stage_glds(const bf16* A, int lda, const bf16* Bt, int ldb, int kt, unsigned char* stage, int wave, int lane) {
    const int rr = lane >> 3, cch = (lane & 7) ^ rr;
#pragma unroll
    for (int i = 0; i < 4; ++i) { const int pc = 4 * i + wave;
        __builtin_amdgcn_global_load_lds((const unsigned*)(A + (size_t)(8 * pc + rr) * lda + kt * 64 + cch * 8), (LAS unsigned*)(stage + pc * 1024), 16, 0, 0);
        __builtin_amdgcn_global_load_lds((const unsigned*)(Bt + (size_t)(8 * pc + rr) * ldb + kt * 64 + cch * 8), (LAS unsigned*)(stage + 16384 + pc * 1024), 16, 0, 0); }
}
__device__ __forceinline__ void gemm_core(f32x4 (&acc)[2][8], const bf16* A, int lda, const bf16* Bt, int ldb, int K, unsigned char* lds, int tid) {
    const int wave = __builtin_amdgcn_readfirstlane(tid >> 6), lane = tid & 63;
    const int nk = K >> 6;
    gemm_stage_glds(A, lda, Bt, ldb, 0, lds, wave, lane);
    asm volatile("s_waitcnt vmcnt(0)" ::: "memory");
    __syncthreads();
    for (int kt = 0; kt < nk; ++kt) {
        const int cur = kt & 1;
        if (kt + 1 < nk) gemm_stage_glds(A, lda, Bt, ldb, kt + 1, lds + (cur ^ 1) * 32768, wave, lane);
        gemm_compute_stage(acc, lds + cur * 32768, lds + cur * 32768 + 16384, wave, lane);
        asm volatile("s_waitcnt vmcnt(0)" ::: "memory");
        __syncthreads();
    }
}
__device__ __forceinline__ void acc_zero(f32x4 (&acc)[2][8]) {
#pragma unroll
    for (int mi = 0; mi < 2; ++mi)
#pragma unroll
        for (int ni = 0; ni < 8; ++ni) acc[mi][ni] = (f32x4){0.f, 0.f, 0.f, 0.f};
}
__device__ __forceinline__ float rstd_from_ssq8(const float* ssq, int tok) {
    const f32x4 a = *(const f32x4*)(ssq + (size_t)tok * 8), b = *(const f32x4*)(ssq + (size_t)tok * 8 + 4);
    const float s = ((a.x + a.y) + (a.z + a.w)) + ((b.x + b.y) + (b.z + b.w));
    return rsqrt_(s * (1.0f / 1024.0f) + EPS);
}

__device__ __forceinline__ int src_col(int mode, int np) {
    if (mode == 0) return np;
    if (mode == 2) { const int h = np >> 7, j = np & 127; return j < 96 ? h * 96 + j : -1; }
    if (np < 1024) { const int cblk = np >> 7, j = np & 127; return j < 64 ? 64 * cblk + j : 512 + 64 * cblk + (j - 64); }
    if (np < 1408) return np;
    if (np < 1536) { const int j = np - 1408; return j < 32 ? 1408 + j : -1; }
    return 1440 + (np - 1536);
}
__device__ __forceinline__ void p0_transpose_item(const float* W, int K, int N, bf16* Wt, int mode, const float* g, int item, float* scr, int lane) {
    const int nblk_k = K / 64, nb = item / nblk_k, kb = item % nblk_k, k0 = 64 * kb, n0 = 32 * nb;
    const int n = src_col(mode, n0 + (lane & 31));
#pragma unroll 8
    for (int i = 0; i < 32; ++i) { const int kk = 2 * i + (lane >> 5); float v = 0.f; if (n >= 0) { v = W[(size_t)(k0 + kk) * N + n]; if (g) v *= g[k0 + kk]; } scr[kk * 33 + (lane & 31)] = v; }
    __builtin_amdgcn_s_waitcnt(0xC07F); asm volatile("" ::: "memory");
    const int cch = lane & 7;
#pragma unroll
    for (int j = 0; j < 4; ++j) { const int nl = (lane >> 3) + 8 * j; const float* s = scr + (8 * cch) * 33 + nl;
        u32x4 o; o.x = pk2(s[0 * 33], s[1 * 33]); o.y = pk2(s[2 * 33], s[3 * 33]); o.z = pk2(s[4 * 33], s[5 * 33]); o.w = pk2(s[6 * 33], s[7 * 33]);
        *(u32x4*)(Wt + (size_t)(n0 + nl) * K + k0 + 8 * cch) = o; }
    __builtin_amdgcn_s_waitcnt(0xC07F); asm volatile("" ::: "memory");
}
struct WDesc { int in_idx, K, N, Np, mode, g_idx; size_t off; };
__device__ __forceinline__ void phase_prologue(const Ctx& c0) {
    Ctx c = reopaque(c0);
    const int gw = c.vb * 4 + c.wave, NGW = c.G * 4;
    float* scr = (float*)(c.lds + c.wave * 8704);
    const WDesc wd[7] = {
        {3, 1024, NIN, NINP, 1, 2, 0}, {8, 512, 1024, 1024, 0, -1, OFF_WCO}, {10, 256, 768, 1024, 2, 9, OFF_WUQ}, {12, 128, 1024, 1024, 0, 11, OFF_WUKV},
        {15, 512, 1024, 1024, 0, -1, OFF_WMLA}, {16, 1024, 1024, 1024, 0, -1, OFF_WOUT}, {18, 1024, 2048, 2048, 0, 17, OFF_WPQ}};
    constexpr int ITEMS_PER_LAYER = (1024 / 64) * (NINP / 32) + (512 / 64) * 32 + (256 / 64) * 32 + (128 / 64) * 32 + (512 / 64) * 32 + (1024 / 64) * 32 + (1024 / 64) * 64;
    for (int it = gw; it < 2 * ITEMS_PER_LAYER; it += NGW) {
        const int l = it >= ITEMS_PER_LAYER ? 1 : 0; int r = it - l * ITEMS_PER_LAYER;
        const float* W = nullptr; const float* g = nullptr; bf16* Wt = nullptr; int K = 64, N = 32, mode = 0, rr = 0;
#pragma unroll
        for (int m = 0; m < 7; ++m) {
            const int items = (wd[m].K / 64) * (wd[m].Np / 32);
            if (r >= 0 && r < items) { K = wd[m].K; N = wd[m].N; mode = wd[m].mode; rr = r;
                W = c.in[wd[m].in_idx] + (size_t)l * wd[m].K * wd[m].N; g = wd[m].g_idx >= 0 ? c.in[wd[m].g_idx >= 0 ? wd[m].g_idx : 0] + (size_t)l * wd[m].K : nullptr;
                Wt = (bf16*)(c.ws + WS_WIN + l * SZ_WLAYER + wd[m].off); }
            r -= items;
        }
        p0_transpose_item(W, K, N, Wt, mode, g, rr, scr, c.lane);
    }
    const int gt = c.vb * NTHREADS + c.tid, NGT = c.G * NTHREADS;
    for (int l = 0; l < 2; ++l) {
        const float* src = c.in[19] + (size_t)l * 262144; bf16* dst = (bf16*)(c.ws + WS_WIN + l * SZ_WLAYER + OFF_KEYS);
        for (int i = gt; i < 262144 / 8; i += NGT) { const f32x4 a = *(const f32x4*)(src + i * 8), b = *(const f32x4*)(src + i * 8 + 4);
            u32x4 o; o.x = pk2(a.x, a.y); o.y = pk2(a.z, a.w); o.z = pk2(b.x, b.y); o.w = pk2(b.z, b.w); *(u32x4*)(dst + i * 8) = o; }
    }
    for (int l = 0; l < 2; ++l)
        for (int uv = 0; uv < 2; ++uv) {
            const float* src = c.in[20 + uv] + (size_t)l * NEXP * 1024; unsigned char* dst = c.ws + WS_TAB + (size_t)(l * 2 + uv) * SZ_TAB;
            f32x4 g4[4];
#pragma unroll
            for (int j = 0; j < 4; ++j) { g4[j] = (f32x4){TAB_SCALE, TAB_SCALE, TAB_SCALE, TAB_SCALE}; if (uv == 0) g4[j] = g4[j] * *(const f32x4*)(c.in[17] + l * 1024 + 256 * j + 4 * c.lane); }
            for (int row = gw; row < NEXP; row += 2 * NGW) {
                const float* sp = src + (size_t)row * 1024 + 4 * c.lane; const int row2 = row + NGW; const bool two = row2 < NEXP;
                const float* sp2 = src + (size_t)(two ? row2 : row) * 1024 + 4 * c.lane;
                f32x4 a[4], b[4];
#pragma unroll
                for (int j = 0; j < 4; ++j) { a[j] = *(const f32x4*)(sp + 256 * j); b[j] = *(const f32x4*)(sp2 + 256 * j); }
#pragma unroll
                for (int j = 0; j < 4; ++j) { const f32x4 v = a[j] * g4[j];
                    *(unsigned*)(dst + (size_t)row * 1024 + 256 * j + 4 * c.lane) = (unsigned)__builtin_amdgcn_cvt_pk_fp8_f32(v.z, v.w, __builtin_amdgcn_cvt_pk_fp8_f32(v.x, v.y, 0, false), true); }
                if (two) {
#pragma unroll
                    for (int j = 0; j < 4; ++j) { const f32x4 v = b[j] * g4[j];
                        *(unsigned*)(dst + (size_t)row2 * 1024 + 256 * j + 4 * c.lane) = (unsigned)__builtin_amdgcn_cvt_pk_fp8_f32(v.z, v.w, __builtin_amdgcn_cvt_pk_fp8_f32(v.x, v.y, 0, false), true); } }
            }
        }
    { float* rope = WSP(float, WS_ROPE);
      for (int i = gt; i < L * 16; i += NGT) { const int pos = i >> 4, j = i & 15;
          const float inv = 1.0f / __builtin_exp2f((float)j * 0.8304820237218406f);
          const float angf = (float)pos * inv; const double ang = (double)angf;
          const double nq = __builtin_rint(ang * 0.63661977236758134308);
          double rr = __builtin_fma(-nq, 1.57079632679489655800e+00, ang); rr = __builtin_fma(-nq, 6.12323399573676603587e-17, rr);
          const double r2 = rr * rr;
          double sp = -1.0 / 1307674368000.0; sp = sp * r2 + 1.0 / 6227020800.0; sp = sp * r2 - 1.0 / 39916800.0; sp = sp * r2 + 1.0 / 362880.0; sp = sp * r2 - 1.0 / 5040.0; sp = sp * r2 + 1.0 / 120.0; sp = sp * r2 - 1.0 / 6.0; sp = sp * r2 * rr + rr;
          double cp = 1.0 / 87178291200.0; cp = cp * r2 - 1.0 / 479001600.0; cp = cp * r2 + 1.0 / 3628800.0; cp = cp * r2 - 1.0 / 40320.0; cp = cp * r2 + 1.0 / 720.0; cp = cp * r2 - 1.0 / 24.0; cp = cp * r2 + 0.5; cp = 1.0 - cp * r2;
          const int qd = ((int)nq) & 3;
          const double cv = qd == 0 ? cp : qd == 1 ? -sp : qd == 2 ? -cp : sp;
          const double sv_ = qd == 0 ? sp : qd == 1 ? cp : qd == 2 ? -sp : -cp;
          rope[2 * i] = (float)cv; rope[2 * i + 1] = (float)sv_; } }
    { float* h = WSP(float, WS_H); bf16* hb = WSP(bf16, WS_HB); float* ssq = WSP(float, WS_SSQ);
      for (int t = gw; t < T; t += NGW) { const int b = t / L, pos = t % L;
          const float* src = pos < NMETA ? c.in[1] + (size_t)pos * D : c.in[0] + ((size_t)b * SEQ + (pos - NMETA)) * D;
          float s = 0.f;
#pragma unroll
          for (int j = 0; j < 4; ++j) { const f32x4 v = *(const f32x4*)(src + j * 256 + c.lane * 4); *(f32x4*)(h + (size_t)t * D + j * 256 + c.lane * 4) = v;
              u32x2 o; o.x = pk2(v.x, v.y); o.y = pk2(v.z, v.w); *(u32x2*)(hb + (size_t)t * D + j * 256 + c.lane * 4) = o; s += (v.x * v.x + v.y * v.y) + (v.z * v.z + v.w * v.w); }
          s = wave_sum(s);
          if (c.lane < 8) ssq[(size_t)t * 8 + c.lane] = c.lane == 0 ? s : 0.f; } }
}

__device__ __forceinline__ void phase_A(const Ctx& c0, int l) {
    Ctx c = reopaque(c0);
    const bf16* hb = WSP(bf16, WS_HB); const bf16* Wt = (const bf16*)(c.ws + WS_WIN + l * SZ_WLAYER);
    const float* ssq = WSP(float, WS_SSQ);
    bf16* uglu = WSP(bf16, WS_UGLU); bf16* cq = WSP(bf16, WS_CQ); bf16* ckv = WSP(bf16, WS_CKV); float* krope = WSP(float, WS_KROPE);
    float* ssqq = WSP(float, WS_SSQQ); float* ssqkv = WSP(float, WS_SSQKV); bf16* gates = WSP(bf16, WS_GATES);
    constexpr int NT = NINP / 128;
    const int r = c.lane & 15, q = c.lane >> 4;
    for (int it = c.vb; it < MT * NT; it += c.G) {
        const int mt = it / NT, nt = it % NT;
        f32x4 acc[2][8]; acc_zero(acc);
        gemm_core(acc, hb + (size_t)mt * 128 * D, D, Wt + (size_t)nt * 128 * D, D, D, c.lds, c.tid);
#pragma unroll
        for (int mi = 0; mi < 2; ++mi) {
            const int tok = mt * 128 + 32 * c.wave + 16 * mi + r;
            const float rs = rstd_from_ssq8(ssq, tok);
            if (nt < 8) {
#pragma unroll
                for (int ni = 0; ni < 4; ++ni) { const f32x4 v = acc[mi][ni] * rs, g = acc[mi][ni + 4] * rs;
                    u32x2 o; o.x = pk2(v.x * sigmoidf_(g.x), v.y * sigmoidf_(g.y)); o.y = pk2(v.z * sigmoidf_(g.z), v.w * sigmoidf_(g.w));
                    *(u32x2*)(uglu + (size_t)tok * DC + nt * 64 + 16 * ni + 4 * q) = o; }
            } else if (nt < 11) {
                bf16* dst = nt < 10 ? cq + (size_t)tok * QL + (nt - 8) * 128 : ckv + (size_t)tok * KVL;
                float ss = 0.f;
#pragma unroll
                for (int ni = 0; ni < 8; ++ni) { const f32x4 v = acc[mi][ni] * rs; ss += (v.x * v.x + v.y * v.y) + (v.z * v.z + v.w * v.w);
                    u32x2 o; o.x = pk2(v.x, v.y); o.y = pk2(v.z, v.w); *(u32x2*)(dst + 16 * ni + 4 * q) = o; }
                ss = quad_sum(ss);
                if (q == 0) { if (nt < 10) ssqq[(size_t)tok * 2 + (nt - 8)] = ss; else ssqkv[tok] = ss; }
            } else if (nt == 11) {
#pragma unroll
                for (int ni = 0; ni < 2; ++ni) *(f32x4*)(krope + (size_t)tok * 32 + 16 * ni + 4 * q) = acc[mi][ni] * rs;
            } else {
#pragma unroll
                for (int ni = 0; ni < 8; ++ni) { const f32x4 v = acc[mi][ni] * rs;
                    u32x2 o; o.x = pk2(sigmoidf_(v.x), sigmoidf_(v.y)); o.y = pk2(sigmoidf_(v.z), sigmoidf_(v.w));
                    *(u32x2*)(gates + (size_t)tok * 2048 + (nt - 12) * 128 + 16 * ni + 4 * q) = o; }
            }
        }
    }
}

__device__ __forceinline__ void phaseB_q_item(Ctx& c, int l, int mt, int head) {
    const bf16* cq = WSP(bf16, WS_CQ); const bf16* Wt = (const bf16*)(c.ws + WS_WIN + l * SZ_WLAYER + OFF_WUQ);
    const float* ssqq = WSP(float, WS_SSQQ); const float* rope = WSP(float, WS_ROPE); const float* qg = c.in[13] + l * QK; bf16* Qb = WSP(bf16, WS_Q);
    const int r = c.lane & 15, q = c.lane >> 4;
    f32x4 acc[2][8]; acc_zero(acc);
    gemm_core(acc, cq + (size_t)mt * 128 * QL, QL, Wt + (size_t)head * 128 * QL, QL, QL, c.lds, c.tid);
    constexpr float QSCALE = 0.10206207261596575f * 1.4426950408889634f;
#pragma unroll
    for (int mi = 0; mi < 2; ++mi) {
        const int tok = mt * 128 + 32 * c.wave + 16 * mi + r, b = tok / L, pos = tok - b * L;
        const float rs = rsqrt_((ssqq[(size_t)tok * 2] + ssqq[(size_t)tok * 2 + 1]) * (1.0f / 256.0f) + EPS);
        float ss = 0.f;
#pragma unroll
        for (int ni = 0; ni < 6; ++ni) { acc[mi][ni] = acc[mi][ni] * rs; const f32x4 v = acc[mi][ni]; ss += (v.x * v.x + v.y * v.y) + (v.z * v.z + v.w * v.w); }
        ss = quad_sum(ss);
        const float rn = rsqrt_(ss * (1.0f / 96.0f) + EPS) * QSCALE;
#pragma unroll
        for (int ni = 0; ni < 6; ++ni) { const f32x4 g = *(const f32x4*)(qg + 16 * ni + 4 * q); acc[mi][ni] = acc[mi][ni] * g * rn; }
        const f32x4 cs0 = *(const f32x4*)(rope + ((size_t)pos * 16 + 4 * q) * 2), cs1 = *(const f32x4*)(rope + ((size_t)pos * 16 + 4 * q) * 2 + 4);
        const float co[4] = {cs0.x, cs0.z, cs1.x, cs1.z}, si[4] = {cs0.y, cs0.w, cs1.y, cs1.w};
        f32x4 x1 = acc[mi][4], x2 = acc[mi][5];
#pragma unroll
        for (int e = 0; e < 4; ++e) { const float a = x1[e], bb = x2[e]; x1[e] = a * co[e] - bb * si[e]; x2[e] = bb * co[e] + a * si[e]; }
        acc[mi][4] = x1; acc[mi][5] = x2;
        bf16* dst = Qb + (((size_t)b * NH + head) * L + pos) * QK;
#pragma unroll
        for (int ni = 0; ni < 6; ++ni) { const f32x4 v = acc[mi][ni]; u32x2 o; o.x = pk2(v.x, v.y); o.y = pk2(v.z, v.w); *(u32x2*)(dst + 16 * ni + 4 * q) = o; }
    }
}
__device__ __forceinline__ void phaseB_kv_item(Ctx& c, int l, int mt, int head) {
    const bf16* ckv = WSP(bf16, WS_CKV); const bf16* Wt = (const bf16*)(c.ws + WS_WIN + l * SZ_WLAYER + OFF_WUKV);
    const float* ssqkv = WSP(float, WS_SSQKV); const float* rope = WSP(float, WS_ROPE); const float* kg = c.in[14] + l * QK; const float* krope = WSP(float, WS_KROPE);
    bf16* Kb = WSP(bf16, WS_K); bf16* Vt = WSP(bf16, WS_VT);
    const int tid = c.tid, wave = c.wave, lane = c.lane, r = lane & 15, q = lane >> 4;
    unsigned char* lds = c.lds;
    f32x4 ak[2][4], av[2][4];
#pragma unroll
    for (int mi = 0; mi < 2; ++mi)
#pragma unroll
        for (int ni = 0; ni < 4; ++ni) { ak[mi][ni] = (f32x4){0.f, 0.f, 0.f, 0.f}; av[mi][ni] = (f32x4){0.f, 0.f, 0.f, 0.f}; }
    { const int chunk = tid & 7, row0 = tid >> 3;
      const bf16* pa = ckv + ((size_t)mt * 128 + row0) * KVL + chunk * 8; const bf16* pb = Wt + ((size_t)head * 128 + row0) * KVL + chunk * 8;
#pragma unroll
      for (int s = 0; s < 2; ++s)
#pragma unroll
          for (int i = 0; i < 4; ++i) { *(u32x4*)(lds + s * 32768 + lds_off(row0 + 32 * i, chunk)) = *(const u32x4*)(pa + (size_t)(32 * i) * KVL + s * 64);
              *(u32x4*)(lds + s * 32768 + 16384 + lds_off(row0 + 32 * i, chunk)) = *(const u32x4*)(pb + (size_t)(32 * i) * KVL + s * 64); }
    }
    __syncthreads();
#pragma unroll
    for (int s = 0; s < 2; ++s)
#pragma unroll
        for (int ks = 0; ks < 2; ++ks) {
            const unsigned char* sA = lds + s * 32768; const unsigned char* sB = sA + 16384;
            bf16x8 af[2], bfr[8];
#pragma unroll
            for (int mi = 0; mi < 2; ++mi) af[mi] = *(const bf16x8*)(sA + lds_off(32 * wave + 16 * mi + r, 4 * ks + q));
#pragma unroll
            for (int ni = 0; ni < 8; ++ni) bfr[ni] = *(const bf16x8*)(sB + lds_off(16 * ni + r, 4 * ks + q));
#pragma unroll
            for (int mi = 0; mi < 2; ++mi)
#pragma unroll
                for (int ni = 0; ni < 4; ++ni) { ak[mi][ni] = __builtin_amdgcn_mfma_f32_16x16x32_bf16(bfr[ni], af[mi], ak[mi][ni], 0, 0, 0);
                    av[mi][ni] = __builtin_amdgcn_mfma_f32_16x16x32_bf16(af[mi], bfr[ni + 4], av[mi][ni], 0, 0, 0); }
        }
    __syncthreads();
#pragma unroll
    for (int mi = 0; mi < 2; ++mi) {
        const int tok0 = mt * 128 + 32 * wave + 16 * mi, b = tok0 / L, pos0 = tok0 - b * L;
        { const int tok = tok0 + r, pos = pos0 + r;
          const float rs = rsqrt_(ssqkv[tok] * (1.0f / 128.0f) + EPS);
          const f32x4 kr1 = *(const f32x4*)(krope + (size_t)tok * 32 + 4 * q), kr2 = *(const f32x4*)(krope + (size_t)tok * 32 + 16 + 4 * q);
          float ss = (kr1.x * kr1.x + kr1.y * kr1.y) + (kr1.z * kr1.z + kr1.w * kr1.w) + (kr2.x * kr2.x + kr2.y * kr2.y) + (kr2.z * kr2.z + kr2.w * kr2.w);
#pragma unroll
          for (int ni = 0; ni < 4; ++ni) { ak[mi][ni] = ak[mi][ni] * rs; const f32x4 v = ak[mi][ni]; ss += (v.x * v.x + v.y * v.y) + (v.z * v.z + v.w * v.w); }
          ss = quad_sum(ss);
          const float rn = rsqrt_(ss * (1.0f / 96.0f) + EPS);
          bf16* dst = Kb + (((size_t)b * NH + head) * L + pos) * QK;
#pragma unroll
          for (int ni = 0; ni < 4; ++ni) { const f32x4 g = *(const f32x4*)(kg + 16 * ni + 4 * q); const f32x4 v = ak[mi][ni] * g * rn;
              u32x2 o; o.x = pk2(v.x, v.y); o.y = pk2(v.z, v.w); *(u32x2*)(dst + 16 * ni + 4 * q) = o; }
          const f32x4 g1 = *(const f32x4*)(kg + 64 + 4 * q), g2 = *(const f32x4*)(kg + 80 + 4 * q);
          f32x4 x1 = kr1 * g1 * rn, x2 = kr2 * g2 * rn;
          const f32x4 cs0 = *(const f32x4*)(rope + ((size_t)pos * 16 + 4 * q) * 2), cs1 = *(const f32x4*)(rope + ((size_t)pos * 16 + 4 * q) * 2 + 4);
          const float co[4] = {cs0.x, cs0.z, cs1.x, cs1.z}, si[4] = {cs0.y, cs0.w, cs1.y, cs1.w};
#pragma unroll
          for (int e = 0; e < 4; ++e) { const float a = x1[e], bb = x2[e]; x1[e] = a * co[e] - bb * si[e]; x2[e] = bb * co[e] + a * si[e]; }
          u32x2 o1, o2; o1.x = pk2(x1.x, x1.y); o1.y = pk2(x1.z, x1.w); o2.x = pk2(x2.x, x2.y); o2.y = pk2(x2.z, x2.w);
          *(u32x2*)(dst + 64 + 4 * q) = o1; *(u32x2*)(dst + 80 + 4 * q) = o2; }
        { const f32x4 sq = *(const f32x4*)(ssqkv + tok0 + 4 * q);
          f32x4 rs4; rs4.x = rsqrt_(sq.x * (1.0f / 128.0f) + EPS); rs4.y = rsqrt_(sq.y * (1.0f / 128.0f) + EPS); rs4.z = rsqrt_(sq.z * (1.0f / 128.0f) + EPS); rs4.w = rsqrt_(sq.w * (1.0f / 128.0f) + EPS);
#pragma unroll
          for (int ni = 0; ni < 4; ++ni) { const f32x4 v = av[mi][ni] * rs4; u32x2 o; o.x = pk2(v.x, v.y); o.y = pk2(v.z, v.w);
              *(u32x2*)(Vt + (((size_t)b * NH + head) * VD + 16 * ni + r) * L + pos0 + 4 * q) = o; } }
    }
}
__device__ __forceinline__ u32x4 conv_row(const bf16* uglu, int b, int pos, int ch) {
    u32x4 xv = (u32x4){0u, 0u, 0u, 0u};
    if (pos >= 0) xv = *(const u32x4*)(uglu + ((size_t)b * L + pos) * DC + ch);
    return xv;
}
__device__ __forceinline__ void conv_fma(float (&a)[8], const u32x4 xv, const f32x4 w0, const f32x4 w1) {
    a[0] += bf_lo(xv.x) * w0.x; a[1] += bf_hi(xv.x) * w0.y; a[2] += bf_lo(xv.y) * w0.z; a[3] += bf_hi(xv.y) * w0.w;
    a[4] += bf_lo(xv.z) * w1.x; a[5] += bf_hi(xv.z) * w1.y; a[6] += bf_lo(xv.w) * w1.z; a[7] += bf_hi(xv.w) * w1.w;
}
__device__ __forceinline__ void phaseB_conv_item(Ctx& c, int l, int grp) {
    const bf16* uglu = WSP(bf16, WS_UGLU); bf16* u2 = WSP(bf16, WS_U2);
    const float* cw = c.in[4] + (size_t)l * CW * DC; const float* cb = c.in[5] + l * DC; const float* lg = c.in[6] + l * DC; const float* lb = c.in[7] + l * DC;
    const int tok0 = grp * 4, b = tok0 / L, pos0 = tok0 - b * L, ch = c.lane * 8;
    float acc[4][8];
    { const f32x4 b0 = *(const f32x4*)(cb + ch), b1 = *(const f32x4*)(cb + ch + 4);
#pragma unroll
      for (int d = 0; d < 4; ++d) { acc[d][0] = b0.x; acc[d][1] = b0.y; acc[d][2] = b0.z; acc[d][3] = b0.w; acc[d][4] = b1.x; acc[d][5] = b1.y; acc[d][6] = b1.z; acc[d][7] = b1.w; } }
    const int base = pos0 - 30;
    u32x4 x0 = conv_row(uglu, b, base + 0, ch), x1 = conv_row(uglu, b, base + 1, ch), x2 = conv_row(uglu, b, base + 2, ch),
          x3 = conv_row(uglu, b, base + 3, ch), x4 = conv_row(uglu, b, base + 4, ch), x5;
    const float* wp = cw + ch;
#pragma unroll 1
    for (int w = 0; w < CW; ++w) {
        x5 = conv_row(uglu, b, (w + 5 <= 33) ? base + w + 5 : -1, ch);
        const f32x4 w0 = *(const f32x4*)wp, w1 = *(const f32x4*)(wp + 4); wp += DC;
        conv_fma(acc[0], x0, w0, w1); conv_fma(acc[1], x1, w0, w1); conv_fma(acc[2], x2, w0, w1); conv_fma(acc[3], x3, w0, w1);
        x0 = x1; x1 = x2; x2 = x3; x3 = x4; x4 = x5;
    }
    const f32x4 g0 = *(const f32x4*)(lg + ch), g1 = *(const f32x4*)(lg + ch + 4), e0 = *(const f32x4*)(lb + ch), e1 = *(const f32x4*)(lb + ch + 4);
    const float gg[8] = {g0.x, g0.y, g0.z, g0.w, g1.x, g1.y, g1.z, g1.w}, be[8] = {e0.x, e0.y, e0.z, e0.w, e1.x, e1.y, e1.z, e1.w};
#pragma unroll
    for (int d = 0; d < 4; ++d) {
        float s = 0.f;
#pragma unroll
        for (int j = 0; j < 8; ++j) s += acc[d][j];
        const float mu = wave_sum(s) * (1.0f / 512.0f);
        float vq = 0.f;
#pragma unroll
        for (int j = 0; j < 8; ++j) { acc[d][j] -= mu; vq += acc[d][j] * acc[d][j]; }
        const float rstd = rsqrt_(wave_sum(vq) * (1.0f / 512.0f) + EPS);
        float y[8];
#pragma unroll
        for (int j = 0; j < 8; ++j) { const float v = acc[d][j] * rstd * gg[j] + be[j]; y[j] = v * sigmoidf_(v); }
        u32x4 o; o.x = pk2(y[0], y[1]); o.y = pk2(y[2], y[3]); o.z = pk2(y[4], y[5]); o.w = pk2(y[6], y[7]);
        *(u32x4*)(u2 + (size_t)(tok0 + d) * DC + ch) = o;
    }
}
__device__ __forceinline__ void phase_B(const Ctx& c0, int l) {
    Ctx c = reopaque(c0);
    constexpr int NQ = MT * NH, NKV = MT * NH, NCV = T / 16;
    for (int it = c.vb; it < NQ + NKV + NCV; it += c.G) {
        if (it < NQ) phaseB_q_item(c, l, it / NH, it % NH);
        else if (it < NQ + NKV) phaseB_kv_item(c, l, (it - NQ) / NH, (it - NQ) % NH);
        else phaseB_conv_item(c, l, (it - NQ - NKV) * 4 + c.wave);
    }
}

constexpr int KROW = 208, VROW = 136, ATT_STAGE = 64 * KROW + 64 * VROW;
constexpr int ATT_ITEMS = NB * NH * 17;
__device__ __forceinline__ void phase_C(const Ctx& c0, int l) {
    Ctx c = reopaque(c0);
    const bf16* Qb = WSP(bf16, WS_Q); const bf16* Kb = WSP(bf16, WS_K); const bf16* Vt = WSP(bf16, WS_VT); bf16* O = WSP(bf16, WS_O);
    unsigned* qctr = WSP(unsigned, WS_CTL) + CW_QUEUE + 64 * l;
    volatile unsigned* misc = (volatile unsigned*)(c.lds + LDS_MISC);
    const int tid = c.tid, wave = c.wave, lane = c.lane, r = lane & 15, q = lane >> 4;
    unsigned char* lds = c.lds;
    for (;;) {
        if (tid == 0) misc[4] = atomicAdd(qctr, 1u);
        __syncthreads();
        const int item = __builtin_amdgcn_readfirstlane((int)misc[4]);
        __syncthreads();
        if (item >= ATT_ITEMS) break;
        const int pp = 15 - item / 64, bh = item % 64, b = bh / NH, h = bh % NH;
        const bool meta = pp < 0;
        const int r0 = meta ? 0 : 16 + 128 * pp;
        const int nfull = meta ? 0 : 2 * pp + 1 + (wave >> 1);
        const int ntiles = meta ? 1 : 2 * pp + 3;
        const bf16* Kbase = Kb + (size_t)bh * L * QK; const bf16* Vbase = Vt + (size_t)bh * VD * L;
        bf16x8 qf[2][3];
#pragma unroll
        for (int mi = 0; mi < 2; ++mi)
#pragma unroll
            for (int ks = 0; ks < 3; ++ks) qf[mi][ks] = *(const bf16x8*)(Qb + ((size_t)bh * L + r0 + 32 * wave + 16 * mi + r) * QK + 32 * ks + 8 * q);
        float m[2] = {-1e30f, -1e30f}, lsum[2] = {0.f, 0.f};
        f32x4 o[2][4];
#pragma unroll
        for (int mi = 0; mi < 2; ++mi)
#pragma unroll
            for (int dt = 0; dt < 4; ++dt) o[mi][dt] = (f32x4){0.f, 0.f, 0.f, 0.f};
        u32x4 rk[3], rv[2];
        auto gload = [&](int kt) {
#pragma unroll
            for (int i = 0; i < 3; ++i) { const int id = tid + 256 * i, row = id / 12, cc = id % 12; rk[i] = *(const u32x4*)(Kbase + (size_t)(kt * 64 + row) * QK + cc * 8); }
#pragma unroll
            for (int i = 0; i < 2; ++i) { const int id = tid + 256 * i, row = id >> 3, cc = id & 7; rv[i] = *(const u32x4*)(Vbase + (size_t)row * L + kt * 64 + cc * 8); }
        };
        auto lstore = [&](int s) {
            unsigned char* st = lds + s * ATT_STAGE;
#pragma unroll
            for (int i = 0; i < 3; ++i) { const int id = tid + 256 * i, row = id / 12, cc = id % 12; *(u32x4*)(st + row * KROW + cc * 16) = rk[i]; }
#pragma unroll
            for (int i = 0; i < 2; ++i) { const int id = tid + 256 * i, row = id >> 3, cc = id & 7; u32x2* d = (u32x2*)(st + 64 * KROW + row * VROW + cc * 16); d[0] = (u32x2){rv[i].x, rv[i].y}; d[1] = (u32x2){rv[i].z, rv[i].w}; }
        };
        gload(0); lstore(0);
#pragma unroll
        for (int mi = 0; mi < 2; ++mi)
#pragma unroll
            for (int ks = 0; ks < 3; ++ks) asm volatile("" : "+v"(qf[mi][ks]));
        __syncthreads();
        for (int kt = 0; kt < ntiles; ++kt) {
            const int cur = kt & 1;
            if (kt + 1 < ntiles) gload(kt + 1);
            const unsigned char* sK = lds + cur * ATT_STAGE; const unsigned char* sV = sK + 64 * KROW;
            const bool full = kt < nfull;
            if (kt <= nfull) {
                f32x4 s[2][4];
#pragma unroll
                for (int kh = 0; kh < 2; ++kh) {
                    bf16x8 kf[2][3];
#pragma unroll
                    for (int kk = 0; kk < 2; ++kk) if ((kh == 0 && kk == 0) || full) {
#pragma unroll
                        for (int ks = 0; ks < 3; ++ks) kf[kk][ks] = *(const bf16x8*)(sK + (16 * (2 * kh + kk) + r) * KROW + 64 * ks + 16 * q); }
#pragma unroll
                    for (int kk = 0; kk < 2; ++kk) { const int k4 = 2 * kh + kk;
#pragma unroll
                        for (int mi = 0; mi < 2; ++mi) s[mi][k4] = (f32x4){0.f, 0.f, 0.f, 0.f};
                        if (k4 == 0 || full) {
#pragma unroll
                            for (int ks = 0; ks < 3; ++ks)
#pragma unroll
                                for (int mi = 0; mi < 2; ++mi) s[mi][k4] = __builtin_amdgcn_mfma_f32_16x16x32_bf16(kf[kk][ks], qf[mi][ks], s[mi][k4], 0, 0, 0);
                        }
                    }
                }
                u32x2 vlo[4], vhi[4];
#pragma unroll
                for (int dt = 0; dt < 4; ++dt) { const unsigned char* vp = sV + (16 * dt + r) * VROW + (4 * q) * 2;
                    vlo[dt] = *(const u32x2*)vp; vhi[dt] = (u32x2){0u, 0u}; if (full) vhi[dt] = *(const u32x2*)(vp + 32); }
                bf16x8 pf[2][2];
#pragma unroll
                for (int mi = 0; mi < 2; ++mi) {
                    float mx = fmaxf(fmaxf(s[mi][0].x, s[mi][0].y), fmaxf(s[mi][0].z, s[mi][0].w));
                    if (full) {
#pragma unroll
                        for (int k4 = 1; k4 < 4; ++k4) mx = fmaxf(mx, fmaxf(fmaxf(s[mi][k4].x, s[mi][k4].y), fmaxf(s[mi][k4].z, s[mi][k4].w)));
                    }
                    mx = quad_max(mx);
                    const float mn = fmaxf(m[mi], mx), alpha = fast_exp2(m[mi] - mn); m[mi] = mn;
                    float ps = 0.f;
#pragma unroll
                    for (int k4 = 0; k4 < 4; ++k4) {
                        if (k4 == 0 || full) { f32x4 p; p.x = fast_exp2(s[mi][k4].x - mn); p.y = fast_exp2(s[mi][k4].y - mn); p.z = fast_exp2(s[mi][k4].z - mn); p.w = fast_exp2(s[mi][k4].w - mn);
                            ps += (p.x + p.y) + (p.z + p.w); s[mi][k4] = p; }
                    }
                    lsum[mi] = lsum[mi] * alpha + ps;
#pragma unroll
                    for (int dt = 0; dt < 4; ++dt) o[mi][dt] = o[mi][dt] * alpha;
#pragma unroll
                    for (int st = 0; st < 2; ++st) { u32x4 pw;
                        pw.x = pk2(s[mi][2 * st].x, s[mi][2 * st].y); pw.y = pk2(s[mi][2 * st].z, s[mi][2 * st].w); pw.z = pk2(s[mi][2 * st + 1].x, s[mi][2 * st + 1].y); pw.w = pk2(s[mi][2 * st + 1].z, s[mi][2 * st + 1].w);
                        if (!full) { pw.z = 0u; pw.w = 0u; }
                        pf[mi][st] = __builtin_bit_cast(bf16x8, pw); }
                }
                u32x2 wlo[4], whi[4];
                if (full) {
#pragma unroll
                    for (int dt = 0; dt < 4; ++dt) { const unsigned char* vp = sV + (16 * dt + r) * VROW + (32 + 4 * q) * 2; wlo[dt] = *(const u32x2*)vp; whi[dt] = *(const u32x2*)(vp + 32); } }
#pragma unroll
                for (int dt = 0; dt < 4; ++dt) { const bf16x8 vf = __builtin_bit_cast(bf16x8, (u32x4){vlo[dt].x, vlo[dt].y, vhi[dt].x, vhi[dt].y});
#pragma unroll
                    for (int mi = 0; mi < 2; ++mi) o[mi][dt] = __builtin_amdgcn_mfma_f32_16x16x32_bf16(vf, pf[mi][0], o[mi][dt], 0, 0, 0); }
                if (full) {
#pragma unroll
                    for (int dt = 0; dt < 4; ++dt) { const bf16x8 vf = __builtin_bit_cast(bf16x8, (u32x4){wlo[dt].x, wlo[dt].y, whi[dt].x, whi[dt].y});
#pragma unroll
                        for (int mi = 0; mi < 2; ++mi) o[mi][dt] = __builtin_amdgcn_mfma_f32_16x16x32_bf16(vf, pf[mi][1], o[mi][dt], 0, 0, 0); } }
            }
            if (kt + 1 < ntiles) lstore(cur ^ 1);
            __syncthreads();
        }
#pragma unroll
        for (int mi = 0; mi < 2; ++mi) {
            const float lt = quad_sum(lsum[mi]);
            if (!meta || (wave == 0 && mi == 0)) {
                const float inv = 1.0f / lt;
                bf16* dst = O + ((size_t)b * L + r0 + 32 * wave + 16 * mi + r) * 512 + h * VD;
#pragma unroll
                for (int dt = 0; dt < 4; ++dt) { const f32x4 v = o[mi][dt] * inv; u32x2 ov; ov.x = pk2(v.x, v.y); ov.y = pk2(v.z, v.w); *(u32x2*)(dst + 16 * dt + 4 * q) = ov; }
            }
        }
    }
}

__device__ __forceinline__ void phase_D(const Ctx& c0, int l) {
    Ctx c = reopaque(c0);
    const bf16* u2 = WSP(bf16, WS_U2); const bf16* O = WSP(bf16, WS_O); const bf16* gates = WSP(bf16, WS_GATES); bf16* merged = WSP(bf16, WS_MERGED);
    const bf16* Wco = (const bf16*)(c.ws + WS_WIN + l * SZ_WLAYER + OFF_WCO); const bf16* Wmla = (const bf16*)(c.ws + WS_WIN + l * SZ_WLAYER + OFF_WMLA);
    const int r = c.lane & 15, q = c.lane >> 4;
    for (int it = c.vb; it < MT * 8; it += c.G) {
        const int mt = it / 8, nt = it % 8;
        f32x4 acc[2][8]; acc_zero(acc);
        gemm_core(acc, u2 + (size_t)mt * 128 * 512, 512, Wco + (size_t)nt * 128 * 512, 512, 512, c.lds, c.tid);
#pragma unroll
        for (int mi = 0; mi < 2; ++mi) { const int tok = mt * 128 + 32 * c.wave + 16 * mi + r;
            const bf16* gp = gates + (size_t)tok * 2048 + nt * 128 + 4 * q; bf16* mp = merged + (size_t)tok * D + nt * 128 + 4 * q;
#pragma unroll
            for (int ni = 0; ni < 8; ++ni) { const u32x2 g = *(const u32x2*)(gp + 16 * ni); const f32x4 v = acc[mi][ni];
                u32x2 o; o.x = pk2(v.x * bf_lo(g.x), v.y * bf_hi(g.x)); o.y = pk2(v.z * bf_lo(g.y), v.w * bf_hi(g.y)); *(u32x2*)(mp + 16 * ni) = o; } }
        acc_zero(acc);
        gemm_core(acc, O + (size_t)mt * 128 * 512, 512, Wmla + (size_t)nt * 128 * 512, 512, 512, c.lds, c.tid);
#pragma unroll
        for (int mi = 0; mi < 2; ++mi) { const int tok = mt * 128 + 32 * c.wave + 16 * mi + r;
            const bf16* gp = gates + (size_t)tok * 2048 + 1024 + nt * 128 + 4 * q; bf16* mp = merged + (size_t)tok * D + nt * 128 + 4 * q;
#pragma unroll
            for (int ni = 0; ni < 8; ++ni) { const u32x2 g = *(const u32x2*)(gp + 16 * ni); const u32x2 s = *(const u32x2*)(mp + 16 * ni); const f32x4 v = acc[mi][ni];
                u32x2 o; o.x = pk2(bf_lo(s.x) + v.x * bf_lo(g.x), bf_hi(s.x) + v.y * bf_hi(g.x)); o.y = pk2(bf_lo(s.y) + v.z * bf_lo(g.y), bf_hi(s.y) + v.w * bf_hi(g.y));
                *(u32x2*)(mp + 16 * ni) = o; } }
    }
}

__device__ __forceinline__ void phase_E(const Ctx& c0, int l) {
    Ctx c = reopaque(c0);
    const bf16* merged = WSP(bf16, WS_MERGED); const bf16* Wout = (const bf16*)(c.ws + WS_WIN + l * SZ_WLAYER + OFF_WOUT);
    float* h = WSP(float, WS_H); bf16* hb = WSP(bf16, WS_HB); float* ssq = WSP(float, WS_SSQ);
    const int r = c.lane & 15, q = c.lane >> 4;
    for (int it = c.vb; it < MT * 8; it += c.G) {
        const int mt = it / 8, nt = it % 8;
        f32x4 acc[2][8]; acc_zero(acc);
        gemm_core(acc, merged + (size_t)mt * 128 * D, D, Wout + (size_t)nt * 128 * D, D, D, c.lds, c.tid);
#pragma unroll
        for (int mi = 0; mi < 2; ++mi) { const int tok = mt * 128 + 32 * c.wave + 16 * mi + r; float ss = 0.f;
#pragma unroll
            for (int ni = 0; ni < 8; ++ni) { float* hp = h + (size_t)tok * D + nt * 128 + 16 * ni + 4 * q; const f32x4 v = *(const f32x4*)hp + acc[mi][ni]; *(f32x4*)hp = v;
                ss += (v.x * v.x + v.y * v.y) + (v.z * v.z + v.w * v.w);
                u32x2 o; o.x = pk2(v.x, v.y); o.y = pk2(v.z, v.w); *(u32x2*)(hb + (size_t)tok * D + nt * 128 + 16 * ni + 4 * q) = o; }
            ss = quad_sum(ss);
            if (q == 0) ssq[(size_t)tok * 8 + nt] = ss; }
    }
}

__device__ __forceinline__ unsigned f2key(float f) { const unsigned u = __float_as_uint(f); return u ^ ((u >> 31) ? 0xFFFFFFFFu : 0x80000000u); }
__device__ __forceinline__ float key2f(unsigned k) { const unsigned u = (k >> 31) ? (k ^ 0x80000000u) : ~k; return __uint_as_float(u); }
__device__ __forceinline__ void top16_insert(unsigned (&lst)[16], unsigned x) {
#pragma unroll
    for (int i = 0; i < 16; ++i) { const unsigned a = lst[i]; lst[i] = a > x ? a : x; x = a > x ? x : a; }
}
__device__ __forceinline__ void phase_F(const Ctx& c0, int l) {
    Ctx c = reopaque(c0);
    const bf16* hb = WSP(bf16, WS_HB); const bf16* Wpq = (const bf16*)(c.ws + WS_WIN + l * SZ_WLAYER + OFF_WPQ); const bf16* keys = (const bf16*)(c.ws + WS_WIN + l * SZ_WLAYER + OFF_KEYS);
    const float* ssq = WSP(float, WS_SSQ); float* sv = WSP(float, WS_SV); unsigned char* si = WSP(unsigned char, WS_SI);
    const int tid = c.tid, wave = c.wave, lane = c.lane, r = lane & 15, q = lane >> 4;
    unsigned char* lds = c.lds;
    for (int it = c.vb; it < MT * 16; it += c.G) {
        const int mt = it / 16, hp = it % 16;
        f32x4 acc[2][8]; acc_zero(acc);
        gemm_core(acc, hb + (size_t)mt * 128 * D, D, Wpq + (size_t)hp * 128 * D, D, D, lds, tid);
#pragma unroll
        for (int mi = 0; mi < 2; ++mi) { const int row = 32 * wave + 16 * mi + r; const float rs = rstd_from_ssq8(ssq, mt * 128 + row);
#pragma unroll
            for (int ni = 0; ni < 8; ++ni) { const f32x4 v = acc[mi][ni] * rs; u32x2 o; o.x = pk2(v.x, v.y); o.y = pk2(v.z, v.w);
                *(u32x2*)(lds + (ni >> 2) * 32768 + lds_off(row, 2 * (ni & 3) + (q >> 1)) + 8 * (q & 1)) = o; } }
        { const int chunk = tid & 7, row0 = tid >> 3; const bf16* pb = keys + ((size_t)hp * 128 + row0) * 128 + chunk * 8;
#pragma unroll
          for (int s = 0; s < 2; ++s)
#pragma unroll
              for (int i = 0; i < 4; ++i) *(u32x4*)(lds + s * 32768 + 16384 + lds_off(row0 + 32 * i, chunk)) = *(const u32x4*)(pb + (size_t)(32 * i) * 128 + s * 64); }
        __syncthreads();
        acc_zero(acc);
        gemm_compute_stage(acc, lds, lds + 16384, wave, lane);
        gemm_compute_stage(acc, lds + 32768, lds + 32768 + 16384, wave, lane);
        __syncthreads();
        float* S = (float*)lds;
#pragma unroll
        for (int mi = 0; mi < 2; ++mi) { const int row = 32 * wave + 16 * mi + r;
#pragma unroll
            for (int ni = 0; ni < 8; ++ni) *(f32x4*)(S + row * 132 + 16 * ni + 4 * q) = acc[mi][ni]; }
        __syncthreads();
        if (tid < 128) {
            unsigned lst[16];
#pragma unroll
            for (int i = 0; i < 16; ++i) lst[i] = 0u;
            const float* row = S + tid * 132;
#pragma unroll 4
            for (int j = 0; j < 32; ++j) { const f32x4 v = *(const f32x4*)(row + 4 * j);
                top16_insert(lst, (f2key(v.x) & ~127u) | (unsigned)(127 - (4 * j)));
                top16_insert(lst, (f2key(v.y) & ~127u) | (unsigned)(127 - (4 * j + 1)));
                top16_insert(lst, (f2key(v.z) & ~127u) | (unsigned)(127 - (4 * j + 2)));
                top16_insert(lst, (f2key(v.w) & ~127u) | (unsigned)(127 - (4 * j + 3))); }
            const int tok = mt * 128 + tid;
            unsigned idx[16]; float val[16];
#pragma unroll
            for (int i = 0; i < 16; ++i) { idx[i] = 127u - (lst[i] & 127u); val[i] = row[idx[i]]; }
            float* svp = sv + ((size_t)tok * 16 + hp) * 16;
#pragma unroll
            for (int i = 0; i < 4; ++i) *(f32x4*)(svp + 4 * i) = (f32x4){val[4 * i], val[4 * i + 1], val[4 * i + 2], val[4 * i + 3]};
            u32x4 pi;
            pi.x = idx[0] | (idx[1] << 8) | (idx[2] << 16) | (idx[3] << 24); pi.y = idx[4] | (idx[5] << 8) | (idx[6] << 16) | (idx[7] << 24);
            pi.z = idx[8] | (idx[9] << 8) | (idx[10] << 16) | (idx[11] << 24); pi.w = idx[12] | (idx[13] << 8) | (idx[14] << 16) | (idx[15] << 24);
            *(u32x4*)(si + ((size_t)tok * 16 + hp) * 16) = pi;
        }
        __syncthreads();
    }
}

__device__ __forceinline__ void phase_F3(const Ctx& c0, int l) {
    Ctx c = reopaque(c0);
    const float* sv = WSP(float, WS_SV); const unsigned char* si = WSP(unsigned char, WS_SI); int* eidx = WSP(int, WS_EIDX); float* gw = WSP(float, WS_GW); unsigned char* stb = WSP(unsigned char, WS_STB);
    float* lsv = (float*)c.lds;
    unsigned char* lsi = c.lds + 256 * 33 * 4;
    const int tid = c.tid;
    for (int base = c.vb * NTHREADS; base < T * 8; base += c.G * NTHREADS) {
        const int th = base + tid;
        float a[16], b[16];
#pragma unroll
        for (int i = 0; i < 4; ++i) { const f32x4 x = *(const f32x4*)(sv + (size_t)th * 32 + 4 * i), y = *(const f32x4*)(sv + (size_t)th * 32 + 16 + 4 * i);
            a[4 * i] = x.x; a[4 * i + 1] = x.y; a[4 * i + 2] = x.z; a[4 * i + 3] = x.w; b[4 * i] = y.x; b[4 * i + 1] = y.y; b[4 * i + 2] = y.z; b[4 * i + 3] = y.w; }
        const u32x4 ia = *(const u32x4*)(si + (size_t)th * 32), ib = *(const u32x4*)(si + (size_t)th * 32 + 16);
#pragma unroll
        for (int i = 0; i < 16; ++i) { lsv[tid * 33 + i] = a[i]; lsv[tid * 33 + 16 + i] = b[i]; }
        *(u32x4*)(lsi + tid * 32) = ia; *(u32x4*)(lsi + tid * 32 + 16) = ib;
        unsigned lst[16];
#pragma unroll
        for (int i = 0; i < 16; ++i) lst[i] = 0u;
#pragma unroll
        for (int i = 0; i < 16; ++i)
#pragma unroll
            for (int j = 0; j < 16; ++j)
                if ((i + 1) * (j + 1) <= 16) top16_insert(lst, (f2key(a[i] + b[j]) & ~255u) | (unsigned)(255 - (i * 16 + j)));
        __builtin_amdgcn_s_waitcnt(0xC07F); asm volatile("" ::: "memory");
        float s[16]; int e[16];
#pragma unroll
        for (int k = 0; k < 16; ++k) { const unsigned code = 255u - (lst[k] & 255u); const int i = code >> 4, j = code & 15;
            s[k] = lsv[tid * 33 + i] + lsv[tid * 33 + 16 + j]; e[k] = (int)lsi[tid * 32 + i] * 128 + (int)lsi[tid * 32 + 16 + j]; }
        float mx = s[0];
#pragma unroll
        for (int k = 1; k < 16; ++k) mx = fmaxf(mx, s[k]);
        float sum = 0.f;
#pragma unroll
        for (int k = 0; k < 16; ++k) { s[k] = fast_exp2((s[k] - mx) * 1.4426950409f); sum += s[k]; }
        const float inv = 1.0f / sum;
        typedef unsigned long long u64;
        u64 hlo = 0ull, hhi = 0ull;
#pragma unroll
        for (int k = 0; k < 16; ++k) { const int sl = e[k] >> 10; if (sl < 8) hlo += 1ull << (8 * sl); else hhi += 1ull << (8 * (sl - 8)); }
        u64 ilo = hlo, ihi = hhi;
#pragma unroll
        for (int d = 1; d < 8; d <<= 1) { const u64 a_ = __shfl_up(ilo, d, 8), b_ = __shfl_up(ihi, d, 8); if ((tid & 7) >= d) { ilo += a_; ihi += b_; } }
        const u64 tlo = __shfl(ilo, 7, 8), thi = __shfl(ihi, 7, 8);
        const u64 ones = 0x0101010101010101ull;
        const u64 inlo = tlo * ones, inhi = thi * ones + (inlo >> 56) * ones;
        const u64 stlo = inlo - tlo, sthi = inhi - thi;
        u64 rlo = stlo + (ilo - hlo), rhi = sthi + (ihi - hhi);
        const int tokn = th >> 3;
#pragma unroll
        for (int k = 0; k < 16; ++k) { const int sl = e[k] >> 10; int pos;
            if (sl < 8) { pos = (int)((rlo >> (8 * sl)) & 255ull); rlo += 1ull << (8 * sl); } else { pos = (int)((rhi >> (8 * (sl - 8))) & 255ull); rhi += 1ull << (8 * (sl - 8)); }
            eidx[(size_t)tokn * 128 + pos] = e[k]; gw[(size_t)tokn * 128 + pos] = s[k] * inv; }
        if ((tid & 7) == 0) { u64* sp = (u64*)(stb + (size_t)tokn * 16); sp[0] = stlo; sp[1] = sthi; }
        __builtin_amdgcn_s_waitcnt(0xC07F); asm volatile("" ::: "memory");
    }
}

typedef float f32x2 __attribute__((ext_vector_type(2)));
constexpr int G2_WSTRIDE = 14336, G2_MAXTOK = 9;
__device__ __forceinline__ float fp8dot4(unsigned w, unsigned x01, unsigned x23, float acc) {
    const bf16x2 lo = __builtin_amdgcn_cvt_scalef32_pk_bf16_fp8(w, 1.0f, false), hi = __builtin_amdgcn_cvt_scalef32_pk_bf16_fp8(w, 1.0f, true);
    acc = __builtin_amdgcn_fdot2_f32_bf16(lo, __builtin_bit_cast(bf16x2, x01), acc, false);
    return __builtin_amdgcn_fdot2_f32_bf16(hi, __builtin_bit_cast(bf16x2, x23), acc, false);
}
__device__ __forceinline__ float reduce8_transposed(const float (&p)[8], int lane) {
    float s[4];
#pragma unroll
    for (int k = 0; k < 4; ++k) { auto r = __builtin_amdgcn_permlane32_swap(__float_as_uint(p[k]), __float_as_uint(p[k + 4]), false, false); s[k] = __uint_as_float(r[0]) + __uint_as_float(r[1]); }
    float t[2];
#pragma unroll
    for (int k = 0; k < 2; ++k) { auto r = __builtin_amdgcn_permlane16_swap(__float_as_uint(s[k]), __float_as_uint(s[k + 2]), false, false); t[k] = __uint_as_float(r[0]) + __uint_as_float(r[1]); }
    const float u0 = t[0] + dpp<0x128>(t[0]), u1 = t[1] + dpp<0x128>(t[1]);
    float r = (lane & 8) ? u1 : u0;
    r += dpp<0xB1>(r); r += dpp<0x4E>(r); r += dpp<0x141>(r);
    return r;
}
typedef int i32x4 __attribute__((ext_vector_type(4)));
__device__ __forceinline__ void fp8fma4(f32x2 (&acc)[8], int o, unsigned w, f32x2 a2) {
    const f32x2 lo = __builtin_amdgcn_cvt_scalef32_pk_f32_fp8(w, 1.0f, false), hi = __builtin_amdgcn_cvt_scalef32_pk_f32_fp8(w, 1.0f, true);
    acc[o] = __builtin_elementwise_fma(a2, lo, acc[o]); acc[o + 1] = __builtin_elementwise_fma(a2, hi, acc[o + 1]);
}
__device__ __forceinline__ void g2_u_chunk(u32x4 (&u)[8], const unsigned char* U, const int* pe_next, const float* pw_c, float* act_c, const u32x4 xa, const u32x4 xb, float rs, int lane) {
    const i32x4 e0 = *(const i32x4*)pe_next, e1 = *(const i32x4*)(pe_next + 4);
    const int en[8] = {e0.x, e0.y, e0.z, e0.w, e1.x, e1.y, e1.z, e1.w};
    float p[8];
#pragma unroll
    for (int k = 0; k < 8; ++k) {
        float d0 = fp8dot4(u[k].x, xa.x, xa.y, 0.f), d1 = fp8dot4(u[k].y, xa.z, xa.w, 0.f); d0 = fp8dot4(u[k].z, xb.x, xb.y, d0); d1 = fp8dot4(u[k].w, xb.z, xb.w, d1); p[k] = d0 + d1;
        asm volatile("" : "+v"(p[k]));
        u[k] = *(const u32x4*)(U + (size_t)__builtin_amdgcn_readfirstlane(en[k]) * 1024 + lane * 16);
    }
    const float a = reduce8_transposed(p, lane);
    const int row = (lane >> 3) & 7;
    if ((lane & 7) == 0) act_c[row] = gelu_tanh(a * rs) * pw_c[row];
}
__device__ __forceinline__ void g2_v_chunk(u32x4 (&v)[8], const unsigned char* V, const int* pe_next, const float* act_c, f32x2 (&acc)[8], int lane) {
    const i32x4 e0 = *(const i32x4*)pe_next, e1 = *(const i32x4*)(pe_next + 4);
    const int en[8] = {e0.x, e0.y, e0.z, e0.w, e1.x, e1.y, e1.z, e1.w};
    const f32x4 a0 = *(const f32x4*)act_c, a1 = *(const f32x4*)(act_c + 4);
    const float av[8] = {a0.x, a0.y, a0.z, a0.w, a1.x, a1.y, a1.z, a1.w};
#pragma unroll
    for (int k = 0; k < 8; ++k) { const f32x2 a2 = (f32x2){av[k], av[k]};
        fp8fma4(acc, 0, v[k].x, a2); fp8fma4(acc, 2, v[k].y, a2); fp8fma4(acc, 4, v[k].z, a2); fp8fma4(acc, 6, v[k].w, a2);
        asm volatile("" : "+v"(acc[0]), "+v"(acc[1]), "+v"(acc[2]), "+v"(acc[3]), "+v"(acc[4]), "+v"(acc[5]), "+v"(acc[6]), "+v"(acc[7]));
        v[k] = *(const u32x4*)(V + (size_t)__builtin_amdgcn_readfirstlane(en[k]) * 1024 + lane * 16);
    }
}
__device__ __forceinline__ void g2_finish_token(Ctx& c, int l, int tok, const f32x2 (&acc)[8], int lane) {
    float* h = WSP(float, WS_H); bf16* hbw = WSP(bf16, WS_HB); float* ssqw = WSP(float, WS_SSQ);
    float* hp = h + (size_t)tok * D + lane * 16;
    f32x4 r0 = *(const f32x4*)hp, r1 = *(const f32x4*)(hp + 4), r2 = *(const f32x4*)(hp + 8), r3 = *(const f32x4*)(hp + 12);
    r0 += (f32x4){acc[0].x, acc[0].y, acc[1].x, acc[1].y}; r1 += (f32x4){acc[2].x, acc[2].y, acc[3].x, acc[3].y};
    r2 += (f32x4){acc[4].x, acc[4].y, acc[5].x, acc[5].y}; r3 += (f32x4){acc[6].x, acc[6].y, acc[7].x, acc[7].y};
    if (l == 0) {
        *(f32x4*)hp = r0; *(f32x4*)(hp + 4) = r1; *(f32x4*)(hp + 8) = r2; *(f32x4*)(hp + 12) = r3;
        u32x4 o0, o1; o0.x = pk2(r0.x, r0.y); o0.y = pk2(r0.z, r0.w); o0.z = pk2(r1.x, r1.y); o0.w = pk2(r1.z, r1.w);
        o1.x = pk2(r2.x, r2.y); o1.y = pk2(r2.z, r2.w); o1.z = pk2(r3.x, r3.y); o1.w = pk2(r3.z, r3.w);
        *(u32x4*)(hbw + (size_t)tok * D + lane * 16) = o0; *(u32x4*)(hbw + (size_t)tok * D + lane * 16 + 8) = o1;
        float ss = (r0.x * r0.x + r0.y * r0.y) + (r0.z * r0.z + r0.w * r0.w) + (r1.x * r1.x + r1.y * r1.y) + (r1.z * r1.z + r1.w * r1.w)
                 + (r2.x * r2.x + r2.y * r2.y) + (r2.z * r2.z + r2.w * r2.w) + (r3.x * r3.x + r3.y * r3.y) + (r3.z * r3.z + r3.w * r3.w);
        ss = wave_sum_dpp(ss);
        if (lane < 8) ssqw[(size_t)tok * 8 + lane] = lane == 0 ? ss : 0.f;
    } else {
        const int b = tok / L, pos = tok - b * L;
        if (pos >= NMETA) { float* op = c.out + ((size_t)b * SEQ + (pos - NMETA)) * D + lane * 16;
            *(f32x4*)op = r0; *(f32x4*)(op + 4) = r1; *(f32x4*)(op + 8) = r2; *(f32x4*)(op + 12) = r3; }
    }
}
__device__ __forceinline__ void phase_G2(const Ctx& c0, int l) {
    Ctx c = reopaque(c0);
    const bf16* hb = WSP(bf16, WS_HB); const float* ssq = WSP(float, WS_SSQ); const int* pe = WSP(int, WS_EIDX); const float* pw = WSP(float, WS_GW);
    const unsigned char* U = c.ws + WS_TAB + (size_t)(l * 2) * SZ_TAB; const unsigned char* V = c.ws + WS_TAB + (size_t)(l * 2 + 1) * SZ_TAB;
    const int lane = c.lane, wave = c.wave;
    const int gw = c.vb * 4 + wave, t0 = gw * 8;
    const bool has_x = (c.vb & 3) == 0; const int tx = T - 128 + (c.vb >> 2);
    unsigned char* wl = c.lds + wave * G2_WSTRIDE;
    int* pe_l = (int*)wl; float* pw_l = (float*)(wl + 4608); float* act_l = (float*)(wl + 9216);
#pragma unroll
    for (int j = 0; j < G2_MAXTOK; ++j) { const int tok = j < 8 ? t0 + j : (has_x ? tx : t0);
        pe_l[j * 128 + lane] = pe[(size_t)tok * 128 + lane]; pe_l[j * 128 + 64 + lane] = pe[(size_t)tok * 128 + 64 + lane];
        pw_l[j * 128 + lane] = pw[(size_t)tok * 128 + lane] * TAB_INV; pw_l[j * 128 + 64 + lane] = pw[(size_t)tok * 128 + 64 + lane] * TAB_INV; }
    const int xlo = has_x ? 4 * wave : 16, xhi = has_x ? 4 * wave + 4 : 16;
    {
        u32x4 xa[G2_MAXTOK], xb[G2_MAXTOK]; float rs[G2_MAXTOK];
#pragma unroll
        for (int j = 0; j < G2_MAXTOK; ++j) { const int tok = j < 8 ? t0 + j : (has_x ? tx : t0);
            xa[j] = *(const u32x4*)(hb + (size_t)tok * D + lane * 16); xb[j] = *(const u32x4*)(hb + (size_t)tok * D + lane * 16 + 8); rs[j] = rstd_from_ssq8(ssq, tok) * TAB_INV; }
        u32x4 u[8];
#pragma unroll
        for (int k = 0; k < 8; ++k) u[k] = *(const u32x4*)(U + (size_t)__builtin_amdgcn_readfirstlane(pe_l[k]) * 1024 + lane * 16);
#pragma unroll 1
        for (int ch = 0; ch < 16; ++ch) {
            const int cn = ch < 15 ? ch + 1 : 0;
            const bool x_here = ch >= xlo && ch < xhi;
#pragma unroll
            for (int j = 0; j < 8; ++j) {
                const int* pe_next = j < 7 ? pe_l + (j + 1) * 128 + ch * 8 : (x_here ? pe_l + 8 * 128 + ch * 8 : pe_l + cn * 8);
                g2_u_chunk(u, U, pe_next, pw_l + j * 128 + ch * 8, act_l + j * 128 + ch * 8, xa[j], xb[j], rs[j], lane); }
            if (x_here) g2_u_chunk(u, U, pe_l + cn * 8, pw_l + 8 * 128 + ch * 8, act_l + 8 * 128 + ch * 8, xa[8], xb[8], rs[8], lane);
        }
    }
    f32x2 acc[G2_MAXTOK][8];
#pragma unroll
    for (int j = 0; j < G2_MAXTOK; ++j)
#pragma unroll
        for (int i = 0; i < 8; ++i) acc[j][i] = (f32x2){0.f, 0.f};
    {
        u32x4 v[8];
#pragma unroll
        for (int k = 0; k < 8; ++k) v[k] = *(const u32x4*)(V + (size_t)__builtin_amdgcn_readfirstlane(pe_l[k]) * 1024 + lane * 16);
#pragma unroll 1
        for (int ch = 0; ch < 16; ++ch) {
            const int cn = ch < 15 ? ch + 1 : 0;
            const bool x_here = ch >= xlo && ch < xhi;
#pragma unroll
            for (int j = 0; j < 8; ++j) {
                const int* pe_next = j < 7 ? pe_l + (j + 1) * 128 + ch * 8 : (x_here ? pe_l + 8 * 128 + ch * 8 : pe_l + cn * 8);
                g2_v_chunk(v, V, pe_next, act_l + j * 128 + ch * 8, acc[j], lane); }
            if (x_here) g2_v_chunk(v, V, pe_l + cn * 8, act_l + 8 * 128 + ch * 8, acc[8], lane);
        }
    }
#pragma unroll
    for (int j = 0; j < 8; ++j) g2_finish_token(c, l, t0 + j, acc[j], lane);
    __syncthreads();
    if (has_x) {
        f32x2* part = (f32x2*)(c.lds + wave * G2_WSTRIDE);
#pragma unroll
        for (int i = 0; i < 8; ++i) part[i * 64 + lane] = acc[8][i];
    }
    __syncthreads();
    if (has_x && wave == 0) {
        f32x2 tot[8];
#pragma unroll
        for (int i = 0; i < 8; ++i) { tot[i] = acc[8][i];
#pragma unroll
            for (int w = 1; w < 4; ++w) tot[i] += ((const f32x2*)(c.lds + w * G2_WSTRIDE))[i * 64 + lane]; }
        g2_finish_token(c, l, tx, tot, lane);
    }
    __syncthreads();
}

struct Args { const float* in[22]; float* out; unsigned char* ws; int ph_lo, ph_hi; };
constexpr int N_PHASES = 17;

__global__ void __launch_bounds__(NTHREADS, 2) fwd_kernel(Args args) {
    extern __shared__ __attribute__((aligned(16))) unsigned char lds_raw[];
    Ctx c;
#pragma unroll
    for (int i = 0; i < 22; ++i) c.in[i] = args.in[i];
    c.out = args.out; c.ws = args.ws; c.lds = lds_raw;
    c.tid = threadIdx.x; c.lane = c.tid & 63; c.wave = __builtin_amdgcn_readfirstlane(c.tid >> 6);
    c.G = gridDim.x; { const int bx = blockIdx.x; c.vb = (c.G % 8 == 0) ? (bx % 8) * (c.G / 8) + bx / 8 : bx; }
    volatile unsigned* misc = (volatile unsigned*)(c.lds + LDS_MISC);
    if (c.tid < 16) misc[c.tid] = 0u;
    __syncthreads();
    const int lo = args.ph_lo, hi = args.ph_hi;
    const bool multi = (hi - lo) > 1;
    XcdBarrier bar; bar.bar = WSP(unsigned, WS_CTL) + CW_BAR; bar.x = 0; bar.st = misc;
    if (multi) bar = xcd_barrier_post(WSP(unsigned, WS_CTL) + CW_BAR, misc);
#define IN_(k) (lo <= (k) && (k) < hi)
#define SEAM_(k) do { if ((k) + 1 < hi) xcd_barrier(bar); } while (0)
    if (IN_(0)) { phase_prologue(c); SEAM_(0); }
#pragma unroll 1
    for (int l = 0; l < 2; ++l) {
        const int p0 = 1 + 8 * l;
        if (IN_(p0 + 0)) { phase_A(c, l); SEAM_(p0 + 0); }
        if (IN_(p0 + 1)) { phase_B(c, l); SEAM_(p0 + 1); }
        if (IN_(p0 + 2)) { phase_C(c, l); SEAM_(p0 + 2); }
        if (IN_(p0 + 3)) { phase_D(c, l); SEAM_(p0 + 3); }
        if (IN_(p0 + 4)) { phase_E(c, l); SEAM_(p0 + 4); }
        if (IN_(p0 + 5)) { phase_F(c, l); SEAM_(p0 + 5); }
        if (IN_(p0 + 6)) { phase_F3(c, l); SEAM_(p0 + 6); }
        if (IN_(p0 + 7)) { phase_G2(c, l); SEAM_(p0 + 7); }
    }
}

extern "C" void kernel_launch(void* const* d_in, const int* in_sizes, int n_in, void* d_out, int out_size, void* d_ws, size_t ws_size, hipStream_t stream) {
    static int grid = 0;
    if (grid == 0) {
        if (n_in != 22 || out_size != NB * SEQ * D || ws_size < WS_END) { fprintf(stderr, "kernel_launch: unexpected shapes (n_in %d out %d ws %zu need %zu)\n", n_in, out_size, ws_size, (size_t)WS_END); grid = -1; return; }
        int dev = 0, cus = 0, per_cu = 0;
        hipGetDevice(&dev); hipDeviceGetAttribute(&cus, hipDeviceAttributeMultiprocessorCount, dev);
        if (hipFuncSetAttribute((const void*)fwd_kernel, hipFuncAttributeMaxDynamicSharedMemorySize, LDS_BYTES) != hipSuccess) { fprintf(stderr, "kernel_launch: hipFuncSetAttribute failed\n"); grid = -1; return; }
        if (hipOccupancyMaxActiveBlocksPerMultiprocessor(&per_cu, (const void*)fwd_kernel, NTHREADS, LDS_BYTES) != hipSuccess || per_cu < 1) { fprintf(stderr, "kernel_launch: occupancy query failed (%d)\n", per_cu); per_cu = 1; (void)hipGetLastError(); }
        if (per_cu > 2) per_cu = 2;
        grid = cus * per_cu;
        if (grid != 512) { fprintf(stderr, "kernel_launch: grid %d unsupported by phase G2 (needs 512 workgroups)\n", grid); grid = -1; return; }
        fprintf(stderr, "kernel_launch: grid %d (%d per CU), lds %d, ws need %zu have %zu\n", grid, per_cu, LDS_BYTES, (size_t)WS_END, ws_size);
    }
    if (grid < 0) return;
    hipMemsetAsync((char*)d_ws + WS_CTL, 0, CTL_BYTES, stream);
    Args a{};
    for (int i = 0; i < 22; ++i) a.in[i] = (const float*)d_in[i];
    a.out = (float*)d_out; a.ws = (unsigned char*)d_ws;
#if MK_PER_PHASE
    for (int ph = 0; ph < N_PHASES; ++ph) { a.ph_lo = ph; a.ph_hi = ph + 1; hipLaunchKernelGGL(fwd_kernel, dim3(grid), dim3(NTHREADS), LDS_BYTES, stream, a); }
#else
    a.ph_lo = 0; a.ph_hi = N_PHASES;
    void* kargs[] = {&a};
    hipError_t e = hipLaunchCooperativeKernel((const void*)fwd_kernel, dim3(grid), dim3(NTHREADS), kargs, LDS_BYTES, stream);
    if (e != hipSuccess) fprintf(stderr, "kernel_launch: cooperative launch failed: %s (grid %d)\n", hipGetErrorString(e), grid);
#endif
}
```

```cpp
#include <hip/hip_runtime.h>
#include <cstdio>
#include <cstdint>

#ifndef MK_PER_PHASE
#define MK_PER_PHASE 0
#endif

typedef unsigned short bf16;
typedef short bf16x8 __attribute__((ext_vector_type(8)));
typedef float f32x4 __attribute__((ext_vector_type(4)));
typedef unsigned u32x4 __attribute__((ext_vector_type(4)));
typedef unsigned u32x2 __attribute__((ext_vector_type(2)));
typedef __bf16 bf16x2 __attribute__((ext_vector_type(2)));

constexpr int NB = 8, SEQ = 2048, NMETA = 16, L = SEQ + NMETA, T = NB * L, D = 1024;
constexpr int DC = 512, CW = 31, NH = 8, QL = 256, KVL = 128, NOPE = 64, ROPE = 32, QK = 96, VD = 64;
constexpr int NIN = 3488, NINP = 3584;
constexpr int NEXP = 16384;
constexpr float EPS = 1e-6f;
constexpr int MT = T / 128;
static_assert(T % 128 == 0, "T tiles");

constexpr size_t al256(size_t x) { return (x + 255) & ~(size_t)255; }
constexpr size_t WS_CTL = 0;
constexpr size_t CTL_BYTES = 65536;
constexpr size_t WS_ROPE = WS_CTL + CTL_BYTES;
constexpr size_t WS_WIN = al256(WS_ROPE + (size_t)L * 16 * 8);
constexpr size_t SZ_WIN = (size_t)NINP * 1024 * 2, SZ_WCO = (size_t)1024 * 512 * 2, SZ_WUQ = (size_t)1024 * 256 * 2, SZ_WUKV = (size_t)1024 * 128 * 2,
                 SZ_WMLA = (size_t)1024 * 512 * 2, SZ_WOUT = (size_t)1024 * 1024 * 2, SZ_WPQ = (size_t)2048 * 1024 * 2, SZ_KEYS = (size_t)16 * 128 * 128 * 2;
constexpr size_t OFF_WCO = SZ_WIN, OFF_WUQ = OFF_WCO + SZ_WCO, OFF_WUKV = OFF_WUQ + SZ_WUQ, OFF_WMLA = OFF_WUKV + SZ_WUKV, OFF_WOUT = OFF_WMLA + SZ_WMLA,
                 OFF_WPQ = OFF_WOUT + SZ_WOUT, OFF_KEYS = OFF_WPQ + SZ_WPQ, SZ_WLAYER = OFF_KEYS + SZ_KEYS;
constexpr size_t WS_TAB = al256(WS_WIN + 2 * SZ_WLAYER);
constexpr size_t SZ_TAB = (size_t)NEXP * 1024;
constexpr float TAB_SCALE = 256.0f, TAB_INV = 1.0f / 256.0f;
constexpr size_t WS_H = al256(WS_TAB + 4 * SZ_TAB);
constexpr size_t WS_HB = al256(WS_H + (size_t)T * 1024 * 4);
constexpr size_t WS_SSQ = al256(WS_HB + (size_t)T * 1024 * 2);
constexpr size_t WS_UGLU = al256(WS_SSQ + (size_t)T * 8 * 4);
constexpr size_t WS_CQ = al256(WS_UGLU + (size_t)T * 512 * 2);
constexpr size_t WS_CKV = al256(WS_CQ + (size_t)T * 256 * 2);
constexpr size_t WS_KROPE = al256(WS_CKV + (size_t)T * 128 * 2);
constexpr size_t WS_SSQQ = al256(WS_KROPE + (size_t)T * 32 * 4);
constexpr size_t WS_SSQKV = al256(WS_SSQQ + (size_t)T * 2 * 4);
constexpr size_t WS_U2 = al256(WS_SSQKV + (size_t)T * 4);
constexpr size_t WS_Q = al256(WS_U2 + (size_t)T * 512 * 2);
constexpr size_t WS_K = al256(WS_Q + (size_t)T * NH * QK * 2);
constexpr size_t WS_VT = al256(WS_K + (size_t)T * NH * QK * 2);
constexpr size_t WS_O = al256(WS_VT + (size_t)T * NH * VD * 2 + 4096);
constexpr size_t WS_MERGED = al256(WS_O + (size_t)T * 512 * 2);
constexpr size_t WS_GATES = al256(WS_MERGED + (size_t)T * 1024 * 2);
constexpr size_t WS_SV = WS_GATES;
constexpr size_t WS_SI = al256(WS_SV + (size_t)T * 256 * 4);
constexpr size_t WS_EIDX = al256(WS_SI + (size_t)T * 256);
constexpr size_t WS_GW = al256(WS_EIDX + (size_t)T * 128 * 4);
constexpr size_t WS_STB = al256(WS_GW + (size_t)T * 128 * 4);
constexpr size_t WS_PEER_END = WS_STB + (size_t)T * 16;
constexpr size_t WS_END = al256(WS_GATES + (size_t)T * 2048 * 2);
static_assert(WS_PEER_END <= WS_END, "peer scratch overlay");

constexpr int CW_BAR = 0;
constexpr int CW_QUEUE = 4096;

constexpr int LDS_MAIN = 128 * 132 * 4;
constexpr int LDS_MISC = LDS_MAIN;
constexpr int LDS_BYTES = LDS_MAIN + 64;

constexpr int NTHREADS = 256;

__device__ __forceinline__ unsigned pk2(float lo, float hi) { bf16x2 v; v.x = (__bf16)lo; v.y = (__bf16)hi; return __builtin_bit_cast(unsigned, v); }
__device__ __forceinline__ float bf_lo(unsigned p) { return __uint_as_float(p << 16); }
__device__ __forceinline__ float bf_hi(unsigned p) { return __uint_as_float(p & 0xffff0000u); }
__device__ __forceinline__ float fast_rcp(float x) { return __builtin_amdgcn_rcpf(x); }
__device__ __forceinline__ float fast_exp2(float x) { return __builtin_amdgcn_exp2f(x); }
__device__ __forceinline__ float sigmoidf_(float x) { return fast_rcp(1.0f + fast_exp2(-1.4426950409f * x)); }
__device__ __forceinline__ float gelu_tanh(float x) { const float u = 1.5957691216f * (x + 0.044715f * x * x * x); return x * fast_rcp(1.0f + fast_exp2(-1.4426950409f * u)); }
__device__ __forceinline__ float rsqrt_(float x) { return __builtin_amdgcn_rsqf(x); }
template <int CTRL> __device__ __forceinline__ float dpp(float x) { return __builtin_bit_cast(float, __builtin_amdgcn_mov_dpp(__builtin_bit_cast(int, x), CTRL, 0xf, 0xf, true)); }
__device__ __forceinline__ float xrow16_sum(float x) {
    auto s = __builtin_amdgcn_permlane16_swap(__float_as_uint(x), __float_as_uint(x), false, false);
    x = __uint_as_float(s[0]) + __uint_as_float(s[1]);
    auto t = __builtin_amdgcn_permlane32_swap(__float_as_uint(x), __float_as_uint(x), false, false);
    return __uint_as_float(t[0]) + __uint_as_float(t[1]);
}
__device__ __forceinline__ float xrow16_max(float x) {
    auto s = __builtin_amdgcn_permlane16_swap(__float_as_uint(x), __float_as_uint(x), false, false);
    x = fmaxf(__uint_as_float(s[0]), __uint_as_float(s[1]));
    auto t = __builtin_amdgcn_permlane32_swap(__float_as_uint(x), __float_as_uint(x), false, false);
    return fmaxf(__uint_as_float(t[0]), __uint_as_float(t[1]));
}
__device__ __forceinline__ float wave_sum_dpp(float x) {
    x += dpp<0xB1>(x); x += dpp<0x4E>(x); x += dpp<0x141>(x); x += dpp<0x128>(x); return xrow16_sum(x);
}
__device__ __forceinline__ float quad_sum(float v) { return xrow16_sum(v); }
__device__ __forceinline__ float quad_max(float v) { return xrow16_max(v); }
__device__ __forceinline__ float wave_sum(float v) { return wave_sum_dpp(v); }
__device__ __forceinline__ float dot2(unsigned a, unsigned b, float c) { return __builtin_amdgcn_fdot2_f32_bf16(__builtin_bit_cast(bf16x2, a), __builtin_bit_cast(bf16x2, b), c, false); }

#define XB_TMO      128
#define XB_XCNT(j)  (256  + 64 * (j))
#define XB_XSUB(j)  (1280 + 64 * (j))
#define XB_XGEN(j)  (2304 + 64 * (j))
#define XB_TOP      3328
#define XB_TOPGEN   3392
#define XCD_BAR_WORDS 3456
#define XB_SPIN_CAP (1u << 20)
__device__ __forceinline__ unsigned xb_ld(unsigned* p)              { return __hip_atomic_load(p, __ATOMIC_RELAXED, __HIP_MEMORY_SCOPE_AGENT); }
__device__ __forceinline__ unsigned xb_add(unsigned* p, unsigned v) { return __hip_atomic_fetch_add(p, v, __ATOMIC_RELAXED, __HIP_MEMORY_SCOPE_AGENT); }
__device__ __forceinline__ unsigned xb_xcc_id() { return (unsigned)__builtin_amdgcn_s_getreg((3 << 11) | 20) & 0xFu; }
#define XB_SPIN(cond, bar) do { unsigned _sp = 0; while (cond) { __builtin_amdgcn_s_sleep(1); \
    if ((++_sp & 255u) == 0u) { if (xb_ld(&(bar)[XB_TMO])) break; if (_sp > XB_SPIN_CAP) { atomicAdd(&(bar)[XB_TMO], 1u); break; } } } } while (0)
struct XcdBarrier { unsigned* bar; unsigned x; volatile unsigned* st; };
__device__ __forceinline__ XcdBarrier xcd_barrier_post(unsigned* bar, volatile unsigned* st) {
    XcdBarrier b; b.bar = bar; b.x = xb_xcc_id(); b.st = st;
    if (threadIdx.x == 0) (void)xb_add(&bar[XB_XCNT(b.x)], 1u);
    return b;
}
__device__ __forceinline__ void xcd_barrier_complete(unsigned* bar, unsigned x, unsigned& nloc, unsigned& nx) {
    const unsigned G = gridDim.x * gridDim.y * gridDim.z;
    unsigned sum, cnt, mine, sp = 0u;
    for (;;) {
        sum = 0u; cnt = 0u; mine = 0u;
#pragma unroll
        for (unsigned j = 0; j < 16; ++j) { const unsigned c = xb_ld(&bar[XB_XCNT(j)]); sum += c; cnt += (c > 0u) ? 1u : 0u; mine = (j == x) ? c : mine; }
        if (sum == G) break;
        __builtin_amdgcn_s_sleep(1);
        if ((++sp & 255u) == 0u) { if (xb_ld(&bar[XB_TMO])) break; if (sp > XB_SPIN_CAP) { atomicAdd(&bar[XB_TMO], 1u); break; } }
    }
    nloc = mine > 0u ? mine : 1u; nx = cnt > 0u ? cnt : 1u;
}
__device__ __forceinline__ void xcd_barrier(const XcdBarrier& b) {
    asm volatile("s_waitcnt vmcnt(0)" ::: "memory");
    __syncthreads();
    if (threadIdx.x == 0) {
        unsigned* bar = b.bar;
        __builtin_amdgcn_s_waitcnt(0);
        unsigned nloc = b.st[0], nx = b.st[1];
        if (nloc == 0u) { xcd_barrier_complete(bar, b.x, nloc, nx); b.st[0] = nloc; b.st[1] = nx; }
        const unsigned old = xb_add(&bar[XB_XSUB(b.x)], 1u);
        const unsigned gen = old / nloc;
        if (old + 1u == (gen + 1u) * nloc) {
            __builtin_amdgcn_fence(__ATOMIC_RELEASE, "agent");
            asm volatile("s_waitcnt vmcnt(0)" ::: "memory");
            const unsigned og = xb_add(&bar[XB_TOP], 1u);
            const unsigned tg = og / nx;
            if (og + 1u == (tg + 1u) * nx) xb_add(&bar[XB_TOPGEN], 1u);
            else XB_SPIN(xb_ld(&bar[XB_TOPGEN]) == tg, bar);
            __builtin_amdgcn_fence(__ATOMIC_ACQUIRE, "agent");
            xb_add(&bar[XB_XGEN(b.x)], 1u);
            asm volatile("s_waitcnt vmcnt(0)" ::: "memory");
        } else {
            XB_SPIN(xb_ld(&bar[XB_XGEN(b.x)]) == gen, bar);
            __builtin_amdgcn_fence(__ATOMIC_ACQUIRE, "agent");
            asm volatile("s_waitcnt vmcnt(0)" ::: "memory");
        }
    }
    __syncthreads();
}

struct Ctx {
    const float* in[22]; float* out; unsigned char* ws;
    unsigned char* lds; int tid, lane, wave, G, vb;
};
#define WSP(T_, off) ((T_*)(c.ws + (off)))
__device__ __forceinline__ Ctx reopaque(const Ctx& c0) {
    Ctx c = c0; int t = c0.tid; asm volatile("" : "+v"(t)); c.tid = t; c.lane = t & 63; c.wave = __builtin_amdgcn_readfirstlane(t >> 6);
    int vb = c0.vb; asm volatile("" : "+s"(vb)); c.vb = vb; return c;
}

__device__ __forceinline__ int lds_off(int row, int chunk) { return row * 128 + ((chunk ^ (row & 7)) << 4); }

__device__ __forceinline__ void gemm_compute_stage(f32x4 (&acc)[2][8], const unsigned char* sA, const unsigned char* sB, int wave, int lane) {
    const int r = lane & 15, q = lane >> 4;
#pragma unroll
    for (int ks = 0; ks < 2; ++ks) {
        bf16x8 af[2], bfr[8];
#pragma unroll
        for (int mi = 0; mi < 2; ++mi) af[mi] = *(const bf16x8*)(sA + lds_off(32 * wave + 16 * mi + r, 4 * ks + q));
#pragma unroll
        for (int ni = 0; ni < 8; ++ni) bfr[ni] = *(const bf16x8*)(sB + lds_off(16 * ni + r, 4 * ks + q));
#pragma unroll
        for (int mi = 0; mi < 2; ++mi)
#pragma unroll
            for (int ni = 0; ni < 8; ++ni) acc[mi][ni] = __builtin_amdgcn_mfma_f32_16x16x32_bf16(bfr[ni], af[mi], acc[mi][ni], 0, 0, 0);
    }
}

#define LAS __attribute__((address_space(3)))
__device__ __forceinline__ void gemm_stage_glds(const bf16* A, int lda, const bf16* Bt, int ldb, int kt, unsigned char* stage, int wave, int lane) {
    const int rr = lane >> 3, cch = (lane & 7) ^ rr;
#pragma unroll
    for (int i = 0; i < 4; ++i) { const int pc = 4 * i + wave;
        __builtin_amdgcn_global_load_lds((const unsigned*)(A + (size_t)(8 * pc + rr) * lda + kt * 64 + cch * 8), (LAS unsigned*)(stage + pc * 1024), 16, 0, 0);
        __builtin_amdgcn_global_load_lds((const unsigned*)(Bt + (size_t)(8 * pc + rr) * ldb + kt * 64 + cch * 8), (LAS unsigned*)(stage + 16384 + pc * 1024), 16, 0, 0); }
}
__device__ __forceinline__ void gemm_core(f32x4 (&acc)[2][8], const bf16* A, int lda, const bf16* Bt, int ldb, int K, unsigned char* lds, int tid) {
    const int wave = __builtin_amdgcn_readfirstlane(tid >> 6), lane = tid & 63;
    const int nk = K >> 6;
    gemm_stage_glds(A, lda, Bt, ldb, 0, lds, wave, lane);
    asm volatile("s_waitcnt vmcnt(0)" ::: "memory");
    __syncthreads();
    for (int kt = 0; kt < nk; ++kt) {
        const int cur = kt & 1;
        if (kt + 1 < nk) gemm_stage_glds(A, lda, Bt, ldb, kt + 1, lds + (cur ^ 1) * 32768, wave, lane);
        gemm_compute_stage(acc, lds + cur * 32768, lds + cur * 32768 + 16384, wave, lane);
        asm volatile("s_waitcnt vmcnt(0)" ::: "memory");
        __syncthreads();
    }
}
__device__ __forceinline__ void acc_zero(f32x4 (&acc)[2][8]) {
#pragma unroll
    for (int mi = 0; mi < 2; ++mi)
#pragma unroll
        for (int ni = 0; ni < 8; ++ni) acc[mi][ni] = (f32x4){0.f, 0.f, 0.f, 0.f};
}
__device__ __forceinline__ float rstd_from_ssq8(const float* ssq, int tok) {
    const f32x4 a = *(const f32x4*)(ssq + (size_t)tok * 8), b = *(const f32x4*)(ssq + (size_t)tok * 8 + 4);
    const float s = ((a.x + a.y) + (a.z + a.w)) + ((b.x + b.y) + (b.z + b.w));
    return rsqrt_(s * (1.0f / 1024.0f) + EPS);
}

__device__ __forceinline__ int src_col(int mode, int np) {
    if (mode == 0) return np;
    if (mode == 2) { const int h = np >> 7, j = np & 127; return j < 96 ? h * 96 + j : -1; }
    if (np < 1024) { const int cblk = np >> 7, j = np & 127; return j < 64 ? 64 * cblk + j : 512 + 64 * cblk + (j - 64); }
    if (np < 1408) return np;
    if (np < 1536) { const int j = np - 1408; return j < 32 ? 1408 + j : -1; }
    return 1440 + (np - 1536);
}
__device__ __forceinline__ void p0_transpose_item(const float* W, int K, int N, bf16* Wt, int mode, const float* g, int item, float* scr, int lane) {
    const int nblk_k = K / 64, nb = item / nblk_k, kb = item % nblk_k, k0 = 64 * kb, n0 = 32 * nb;
    const int n = src_col(mode, n0 + (lane & 31));
#pragma unroll 8
    for (int i = 0; i < 32; ++i) { const int kk = 2 * i + (lane >> 5); float v = 0.f; if (n >= 0) { v = W[(size_t)(k0 + kk) * N + n]; if (g) v *= g[k0 + kk]; } scr[kk * 33 + (lane & 31)] = v; }
    __builtin_amdgcn_s_waitcnt(0xC07F); asm volatile("" ::: "memory");
    const int cch = lane & 7;
#pragma unroll
    for (int j = 0; j < 4; ++j) { const int nl = (lane >> 3) + 8 * j; const float* s = scr + (8 * cch) * 33 + nl;
        u32x4 o; o.x = pk2(s[0 * 33], s[1 * 33]); o.y = pk2(s[2 * 33], s[3 * 33]); o.z = pk2(s[4 * 33], s[5 * 33]); o.w = pk2(s[6 * 33], s[7 * 33]);
        *(u32x4*)(Wt + (size_t)(n0 + nl) * K + k0 + 8 * cch) = o; }
    __builtin_amdgcn_s_waitcnt(0xC07F); asm volatile("" ::: "memory");
}
struct WDesc { int in_idx, K, N, Np, mode, g_idx; size_t off; };
__device__ __forceinline__ void phase_prologue(const Ctx& c0) {
    Ctx c = reopaque(c0);
    const int gw = c.vb * 4 + c.wave, NGW = c.G * 4;
    float* scr = (float*)(c.lds + c.wave * 8704);
    const WDesc wd[7] = {
        {3, 1024, NIN, NINP, 1, 2, 0}, {8, 512, 1024, 1024, 0, -1, OFF_WCO}, {10, 256, 768, 1024, 2, 9, OFF_WUQ}, {12, 128, 1024, 1024, 0, 11, OFF_WUKV},
        {15, 512, 1024, 1024, 0, -1, OFF_WMLA}, {16, 1024, 1024, 1024, 0, -1, OFF_WOUT}, {18, 1024, 2048, 2048, 0, 17, OFF_WPQ}};
    constexpr int ITEMS_PER_LAYER = (1024 / 64) * (NINP / 32) + (512 / 64) * 32 + (256 / 64) * 32 + (128 / 64) * 32 + (512 / 64) * 32 + (1024 / 64) * 32 + (1024 / 64) * 64;
    for (int it = gw; it < 2 * ITEMS_PER_LAYER; it += NGW) {
        const int l = it >= ITEMS_PER_LAYER ? 1 : 0; int r = it - l * ITEMS_PER_LAYER;
        const float* W = nullptr; const float* g = nullptr; bf16* Wt = nullptr; int K = 64, N = 32, mode = 0, rr = 0;
#pragma unroll
        for (int m = 0; m < 7; ++m) {
            const int items = (wd[m].K / 64) * (wd[m].Np / 32);
            if (r >= 0 && r < items) { K = wd[m].K; N = wd[m].N; mode = wd[m].mode; rr = r;
                W = c.in[wd[m].in_idx] + (size_t)l * wd[m].K * wd[m].N; g = wd[m].g_idx >= 0 ? c.in[wd[m].g_idx >= 0 ? wd[m].g_idx : 0] + (size_t)l * wd[m].K : nullptr;
                Wt = (bf16*)(c.ws + WS_WIN + l * SZ_WLAYER + wd[m].off); }
            r -= items;
        }
        p0_transpose_item(W, K, N, Wt, mode, g, rr, scr, c.lane);
    }
    const int gt = c.vb * NTHREADS + c.tid, NGT = c.G * NTHREADS;
    for (int l = 0; l < 2; ++l) {
        const float* src = c.in[19] + (size_t)l * 262144; bf16* dst = (bf16*)(c.ws + WS_WIN + l * SZ_WLAYER + OFF_KEYS);
        for (int i = gt; i < 262144 / 8; i += NGT) { const f32x4 a = *(const f32x4*)(src + i * 8), b = *(const f32x4*)(src + i * 8 + 4);
            u32x4 o; o.x = pk2(a.x, a.y); o.y = pk2(a.z, a.w); o.z = pk2(b.x, b.y); o.w = pk2(b.z, b.w); *(u32x4*)(dst + i * 8) = o; }
    }
    for (int l = 0; l < 2; ++l)
        for (int uv = 0; uv < 2; ++uv) {
            const float* src = c.in[20 + uv] + (size_t)l * NEXP * 1024; unsigned char* dst = c.ws + WS_TAB + (size_t)(l * 2 + uv) * SZ_TAB;
            f32x4 g4[4];
#pragma unroll
            for (int j = 0; j < 4; ++j) { g4[j] = (f32x4){TAB_SCALE, TAB_SCALE, TAB_SCALE, TAB_SCALE}; if (uv == 0) g4[j] = g4[j] * *(const f32x4*)(c.in[17] + l * 1024 + 256 * j + 4 * c.lane); }
            for (int row = gw; row < NEXP; row += 2 * NGW) {
                const float* sp = src + (size_t)row * 1024 + 4 * c.lane; const int row2 = row + NGW; const bool two = row2 < NEXP;
                const float* sp2 = src + (size_t)(two ? row2 : row) * 1024 + 4 * c.lane;
                f32x4 a[4], b[4];
#pragma unroll
                for (int j = 0; j < 4; ++j) { a[j] = *(const f32x4*)(sp + 256 * j); b[j] = *(const f32x4*)(sp2 + 256 * j); }
#pragma unroll
                for (int j = 0; j < 4; ++j) { const f32x4 v = a[j] * g4[j];
                    *(unsigned*)(dst + (size_t)row * 1024 + 256 * j + 4 * c.lane) = (unsigned)__builtin_amdgcn_cvt_pk_fp8_f32(v.z, v.w, __builtin_amdgcn_cvt_pk_fp8_f32(v.x, v.y, 0, false), true); }
                if (two) {
#pragma unroll
                    for (int j = 0; j < 4; ++j) { const f32x4 v = b[j] * g4[j];
                        *(unsigned*)(dst + (size_t)row2 * 1024 + 256 * j + 4 * c.lane) = (unsigned)__builtin_amdgcn_cvt_pk_fp8_f32(v.z, v.w, __builtin_amdgcn_cvt_pk_fp8_f32(v.x, v.y, 0, false), true); } }
            }
        }
    { float* rope = WSP(float, WS_ROPE);
      for (int i = gt; i < L * 16; i += NGT) { const int pos = i >> 4, j = i & 15;
          const float inv = 1.0f / __builtin_exp2f((float)j * 0.8304820237218406f);
          const float angf = (float)pos * inv; const double ang = (double)angf;
          const double nq = __builtin_rint(ang * 0.63661977236758134308);
          double rr = __builtin_fma(-nq, 1.57079632679489655800e+00, ang); rr = __builtin_fma(-nq, 6.12323399573676603587e-17, rr);
          const double r2 = rr * rr;
          double sp = -1.0 / 1307674368000.0; sp = sp * r2 + 1.0 / 6227020800.0; sp = sp * r2 - 1.0 / 39916800.0; sp = sp * r2 + 1.0 / 362880.0; sp = sp * r2 - 1.0 / 5040.0; sp = sp * r2 + 1.0 / 120.0; sp = sp * r2 - 1.0 / 6.0; sp = sp * r2 * rr + rr;
          double cp = 1.0 / 87178291200.0; cp = cp * r2 - 1.0 / 479001600.0; cp = cp * r2 + 1.0 / 3628800.0; cp = cp * r2 - 1.0 / 40320.0; cp = cp * r2 + 1.0 / 720.0; cp = cp * r2 - 1.0 / 24.0; cp = cp * r2 + 0.5; cp = 1.0 - cp * r2;
          const int qd = ((int)nq) & 3;
          const double cv = qd == 0 ? cp : qd == 1 ? -sp : qd == 2 ? -cp : sp;
          const double sv_ = qd == 0 ? sp : qd == 1 ? cp : qd == 2 ? -sp : -cp;
          rope[2 * i] = (float)cv; rope[2 * i + 1] = (float)sv_; } }
    { float* h = WSP(float, WS_H); bf16* hb = WSP(bf16, WS_HB); float* ssq = WSP(float, WS_SSQ);
      for (int t = gw; t < T; t += NGW) { const int b = t / L, pos = t % L;
          const float* src = pos < NMETA ? c.in[1] + (size_t)pos * D : c.in[0] + ((size_t)b * SEQ + (pos - NMETA)) * D;
          float s = 0.f;
#pragma unroll
          for (int j = 0; j < 4; ++j) { const f32x4 v = *(const f32x4*)(src + j * 256 + c.lane * 4); *(f32x4*)(h + (size_t)t * D + j * 256 + c.lane * 4) = v;
              u32x2 o; o.x = pk2(v.x, v.y); o.y = pk2(v.z, v.w); *(u32x2*)(hb + (size_t)t * D + j * 256 + c.lane * 4) = o; s += (v.x * v.x + v.y * v.y) + (v.z * v.z + v.w * v.w); }
          s = wave_sum(s);
          if (c.lane < 8) ssq[(size_t)t * 8 + c.lane] = c.lane == 0 ? s : 0.f; } }
}

__device__ __forceinline__ void phase_A(const Ctx& c0, int l) {
    Ctx c = reopaque(c0);
    const bf16* hb = WSP(bf16, WS_HB); const bf16* Wt = (const bf16*)(c.ws + WS_WIN + l * SZ_WLAYER);
    const float* ssq = WSP(float, WS_SSQ);
    bf16* uglu = WSP(bf16, WS_UGLU); bf16* cq = WSP(bf16, WS_CQ); bf16* ckv = WSP(bf16, WS_CKV); float* krope = WSP(float, WS_KROPE);
    float* ssqq = WSP(float, WS_SSQQ); float* ssqkv = WSP(float, WS_SSQKV); bf16* gates = WSP(bf16, WS_GATES);
    constexpr int NT = NINP / 128;
    const int r = c.lane & 15, q = c.lane >> 4;
    for (int it = c.vb; it < MT * NT; it += c.G) {
        const int mt = it / NT, nt = it % NT;
        f32x4 acc[2][8]; acc_zero(acc);
        gemm_core(acc, hb + (size_t)mt * 128 * D, D, Wt + (size_t)nt * 128 * D, D, D, c.lds, c.tid);
#pragma unroll
        for (int mi = 0; mi < 2; ++mi) {
            const int tok = mt * 128 + 32 * c.wave + 16 * mi + r;
            const float rs = rstd_from_ssq8(ssq, tok);
            if (nt < 8) {
#pragma unroll
                for (int ni = 0; ni < 4; ++ni) { const f32x4 v = acc[mi][ni] * rs, g = acc[mi][ni + 4] * rs;
                    u32x2 o; o.x = pk2(v.x * sigmoidf_(g.x), v.y * sigmoidf_(g.y)); o.y = pk2(v.z * sigmoidf_(g.z), v.w * sigmoidf_(g.w));
                    *(u32x2*)(uglu + (size_t)tok * DC + nt * 64 + 16 * ni + 4 * q) = o; }
            } else if (nt < 11) {
                bf16* dst = nt < 10 ? cq + (size_t)tok * QL + (nt - 8) * 128 : ckv + (size_t)tok * KVL;
                float ss = 0.f;
#pragma unroll
                for (int ni = 0; ni < 8; ++ni) { const f32x4 v = acc[mi][ni] * rs; ss += (v.x * v.x + v.y * v.y) + (v.z * v.z + v.w * v.w);
                    u32x2 o; o.x = pk2(v.x, v.y); o.y = pk2(v.z, v.w); *(u32x2*)(dst + 16 * ni + 4 * q) = o; }
                ss = quad_sum(ss);
                if (q == 0) { if (nt < 10) ssqq[(size_t)tok * 2 + (nt - 8)] = ss; else ssqkv[tok] = ss; }
            } else if (nt == 11) {
#pragma unroll
                for (int ni = 0; ni < 2; ++ni) *(f32x4*)(krope + (size_t)tok * 32 + 16 * ni + 4 * q) = acc[mi][ni] * rs;
            } else {
#pragma unroll
                for (int ni = 0; ni < 8; ++ni) { const f32x4 v = acc[mi][ni] * rs;
                    u32x2 o; o.x = pk2(sigmoidf_(v.x), sigmoidf_(v.y)); o.y = pk2(sigmoidf_(v.z), sigmoidf_(v.w));
                    *(u32x2*)(gates + (size_t)tok * 2048 + (nt - 12) * 128 + 16 * ni + 4 * q) = o; }
            }
        }
    }
}

__device__ __forceinline__ void phaseB_q_item(Ctx& c, int l, int mt, int head) {
    const bf16* cq = WSP(bf16, WS_CQ); const bf16* Wt = (const bf16*)(c.ws + WS_WIN + l * SZ_WLAYER + OFF_WUQ);
    const float* ssqq = WSP(float, WS_SSQQ); const float* rope = WSP(float, WS_ROPE); const float* qg = c.in[13] + l * QK; bf16* Qb = WSP(bf16, WS_Q);
    const int r = c.lane & 15, q = c.lane >> 4;
    f32x4 acc[2][8]; acc_zero(acc);
    gemm_core(acc, cq + (size_t)mt * 128 * QL, QL, Wt + (size_t)head * 128 * QL, QL, QL, c.lds, c.tid);
    constexpr float QSCALE = 0.10206207261596575f * 1.4426950408889634f;
#pragma unroll
    for (int mi = 0; mi < 2; ++mi) {
        const int tok = mt * 128 + 32 * c.wave + 16 * mi + r, b = tok / L, pos = tok - b * L;
        const float rs = rsqrt_((ssqq[(size_t)tok * 2] + ssqq[(size_t)tok * 2 + 1]) * (1.0f / 256.0f) + EPS);
        float ss = 0.f;
#pragma unroll
        for (int ni = 0; ni < 6; ++ni) { acc[mi][ni] = acc[mi][ni] * rs; const f32x4 v = acc[mi][ni]; ss += (v.x * v.x + v.y * v.y) + (v.z * v.z + v.w * v.w); }
        ss = quad_sum(ss);
        const float rn = rsqrt_(ss * (1.0f / 96.0f) + EPS) * QSCALE;
#pragma unroll
        for (int ni = 0; ni < 6; ++ni) { const f32x4 g = *(const f32x4*)(qg + 16 * ni + 4 * q); acc[mi][ni] = acc[mi][ni] * g * rn; }
        const f32x4 cs0 = *(const f32x4*)(rope + ((size_t)pos * 16 + 4 * q) * 2), cs1 = *(const f32x4*)(rope + ((size_t)pos * 16 + 4 * q) * 2 + 4);
        const float co[4] = {cs0.x, cs0.z, cs1.x, cs1.z}, si[4] = {cs0.y, cs0.w, cs1.y, cs1.w};
        f32x4 x1 = acc[mi][4], x2 = acc[mi][5];
#pragma unroll
        for (int e = 0; e < 4; ++e) { const float a = x1[e], bb = x2[e]; x1[e] = a * co[e] - bb * si[e]; x2[e] = bb * co[e] + a * si[e]; }
        acc[mi][4] = x1; acc[mi][5] = x2;
        bf16* dst = Qb + (((size_t)b * NH + head) * L + pos) * QK;
#pragma unroll
        for (int ni = 0; ni < 6; ++ni) { const f32x4 v = acc[mi][ni]; u32x2 o; o.x = pk2(v.x, v.y); o.y = pk2(v.z, v.w); *(u32x2*)(dst + 16 * ni + 4 * q) = o; }
    }
}
__device__ __forceinline__ void phaseB_kv_item(Ctx& c, int l, int mt, int head) {
    const bf16* ckv = WSP(bf16, WS_CKV); const bf16* Wt = (const bf16*)(c.ws + WS_WIN + l * SZ_WLAYER + OFF_WUKV);
    const float* ssqkv = WSP(float, WS_SSQKV); const float* rope = WSP(float, WS_ROPE); const float* kg = c.in[14] + l * QK; const float* krope = WSP(float, WS_KROPE);
    bf16* Kb = WSP(bf16, WS_K); bf16* Vt = WSP(bf16, WS_VT);
    const int tid = c.tid, wave = c.wave, lane = c.lane, r = lane & 15, q = lane >> 4;
    unsigned char* lds = c.lds;
    f32x4 ak[2][4], av[2][4];
#pragma unroll
    for (int mi = 0; mi < 2; ++mi)
#pragma unroll
        for (int ni = 0; ni < 4; ++ni) { ak[mi][ni] = (f32x4){0.f, 0.f, 0.f, 0.f}; av[mi][ni] = (f32x4){0.f, 0.f, 0.f, 0.f}; }
    { const int chunk = tid & 7, row0 = tid >> 3;
      const bf16* pa = ckv + ((size_t)mt * 128 + row0) * KVL + chunk * 8; const bf16* pb = Wt + ((size_t)head * 128 + row0) * KVL + chunk * 8;
#pragma unroll
      for (int s = 0; s < 2; ++s)
#pragma unroll
          for (int i = 0; i < 4; ++i) { *(u32x4*)(lds + s * 32768 + lds_off(row0 + 32 * i, chunk)) = *(const u32x4*)(pa + (size_t)(32 * i) * KVL + s * 64);
              *(u32x4*)(lds + s * 32768 + 16384 + lds_off(row0 + 32 * i, chunk)) = *(const u32x4*)(pb + (size_t)(32 * i) * KVL + s * 64); }
    }
    __syncthreads();
#pragma unroll
    for (int s = 0; s < 2; ++s)
#pragma unroll
        for (int ks = 0; ks < 2; ++ks) {
            const unsigned char* sA = lds + s * 32768; const unsigned char* sB = sA + 16384;
            bf16x8 af[2], bfr[8];
#pragma unroll
            for (int mi = 0; mi < 2; ++mi) af[mi] = *(const bf16x8*)(sA + lds_off(32 * wave + 16 * mi + r, 4 * ks + q));
#pragma unroll
            for (int ni = 0; ni < 8; ++ni) bfr[ni] = *(const bf16x8*)(sB + lds_off(16 * ni + r, 4 * ks + q));
#pragma unroll
            for (int mi = 0; mi < 2; ++mi)
#pragma unroll
                for (int ni = 0; ni < 4; ++ni) { ak[mi][ni] = __builtin_amdgcn_mfma_f32_16x16x32_bf16(bfr[ni], af[mi], ak[mi][ni], 0, 0, 0);
                    av[mi][ni] = __builtin_amdgcn_mfma_f32_16x16x32_bf16(af[mi], bfr[ni + 4], av[mi][ni], 0, 0, 0); }
        }
    __syncthreads();
#pragma unroll
    for (int mi = 0; mi < 2; ++mi) {
        const int tok0 = mt * 128 + 32 * wave + 16 * mi, b = tok0 / L, pos0 = tok0 - b * L;
        { const int tok = tok0 + r, pos = pos0 + r;
          const float rs = rsqrt_(ssqkv[tok] * (1.0f / 128.0f) + EPS);
          const f32x4 kr1 = *(const f32x4*)(krope + (size_t)tok * 32 + 4 * q), kr2 = *(const f32x4*)(krope + (size_t)tok * 32 + 16 + 4 * q);
          float ss = (kr1.x * kr1.x + kr1.y * kr1.y) + (kr1.z * kr1.z + kr1.w * kr1.w) + (kr2.x * kr2.x + kr2.y * kr2.y) + (kr2.z * kr2.z + kr2.w * kr2.w);
#pragma unroll
          for (int ni = 0; ni < 4; ++ni) { ak[mi][ni] = ak[mi][ni] * rs; const f32x4 v = ak[mi][ni]; ss += (v.x * v.x + v.y * v.y) + (v.z * v.z + v.w * v.w); }
          ss = quad_sum(ss);
          const float rn = rsqrt_(ss * (1.0f / 96.0f) + EPS);
          bf16* dst = Kb + (((size_t)b * NH + head) * L + pos) * QK;
#pragma unroll
          for (int ni = 0; ni < 4; ++ni) { const f32x4 g = *(const f32x4*)(kg + 16 * ni + 4 * q); const f32x4 v = ak[mi][ni] * g * rn;
              u32x2 o; o.x = pk2(v.x, v.y); o.y = pk2(v.z, v.w); *(u32x2*)(dst + 16 * ni + 4 * q) = o; }
          const f32x4 g1 = *(const f32x4*)(kg + 64 + 4 * q), g2 = *(const f32x4*)(kg + 80 + 4 * q);
          f32x4 x1 = kr1 * g1 * rn, x2 = kr2 * g2 * rn;
          const f32x4 cs0 = *(const f32x4*)(rope + ((size_t)pos * 16 + 4 * q) * 2), cs1 = *(const f32x4*)(rope + ((size_t)pos * 16 + 4 * q) * 2 + 4);
          const float co[4] = {cs0.x, cs0.z, cs1.x, cs1.z}, si[4] = {cs0.y, cs0.w, cs1.y, cs1.w};
#pragma unroll
          for (int e = 0; e < 4; ++e) { const float a = x1[e], bb = x2[e]; x1[e] = a * co[e] - bb * si[e]; x2[e] = bb * co[e] + a * si[e]; }
          u32x2 o1, o2; o1.x = pk2(x1.x, x1.y); o1.y = pk2(x1.z, x1.w); o2.x = pk2(x2.x, x2.y); o2.y = pk2(x2.z, x2.w);
          *(u32x2*)(dst + 64 + 4 * q) = o1; *(u32x2*)(dst + 80 + 4 * q) = o2; }
        { const f32x4 sq = *(const f32x4*)(ssqkv + tok0 + 4 * q);
          f32x4 rs4; rs4.x = rsqrt_(sq.x * (1.0f / 128.0f) + EPS); rs4.y = rsqrt_(sq.y * (1.0f / 128.0f) + EPS); rs4.z = rsqrt_(sq.z * (1.0f / 128.0f) + EPS); rs4.w = rsqrt_(sq.w * (1.0f / 128.0f) + EPS);
#pragma unroll
          for (int ni = 0; ni < 4; ++ni) { const f32x4 v = av[mi][ni] * rs4; u32x2 o; o.x = pk2(v.x, v.y); o.y = pk2(v.z, v.w);
              *(u32x2*)(Vt + (((size_t)b * NH + head) * VD + 16 * ni + r) * L + pos0 + 4 * q) = o; } }
    }
}
__device__ __forceinline__ u32x4 conv_row(const bf16* uglu, int b, int pos, int ch) {
    u32x4 xv = (u32x4){0u, 0u, 0u, 0u};
    if (pos >= 0) xv = *(const u32x4*)(uglu + ((size_t)b * L + pos) * DC + ch);
    return xv;
}
__device__ __forceinline__ void conv_fma(float (&a)[8], const u32x4 xv, const f32x4 w0, const f32x4 w1) {
    a[0] += bf_lo(xv.x) * w0.x; a[1] += bf_hi(xv.x) * w0.y; a[2] += bf_lo(xv.y) * w0.z; a[3] += bf_hi(xv.y) * w0.w;
    a[4] += bf_lo(xv.z) * w1.x; a[5] += bf_hi(xv.z) * w1.y; a[6] += bf_lo(xv.w) * w1.z; a[7] += bf_hi(xv.w) * w1.w;
}
__device__ __forceinline__ void phaseB_conv_item(Ctx& c, int l, int grp) {
    const bf16* uglu = WSP(bf16, WS_UGLU); bf16* u2 = WSP(bf16, WS_U2);
    const float* cw = c.in[4] + (size_t)l * CW * DC; const float* cb = c.in[5] + l * DC; const float* lg = c.in[6] + l * DC; const float* lb = c.in[7] + l * DC;
    const int tok0 = grp * 4, b = tok0 / L, pos0 = tok0 - b * L, ch = c.lane * 8;
    float acc[4][8];
    { const f32x4 b0 = *(const f32x4*)(cb + ch), b1 = *(const f32x4*)(cb + ch + 4);
#pragma unroll
      for (int d = 0; d < 4; ++d) { acc[d][0] = b0.x; acc[d][1] = b0.y; acc[d][2] = b0.z; acc[d][3] = b0.w; acc[d][4] = b1.x; acc[d][5] = b1.y; acc[d][6] = b1.z; acc[d][7] = b1.w; } }
    const int base = pos0 - 30;
    u32x4 x0 = conv_row(uglu, b, base + 0, ch), x1 = conv_row(uglu, b, base + 1, ch), x2 = conv_row(uglu, b, base + 2, ch),
          x3 = conv_row(uglu, b, base + 3, ch), x4 = conv_row(uglu, b, base + 4, ch), x5;
    const float* wp = cw + ch;
#pragma unroll 1
    for (int w = 0; w < CW; ++w) {
        x5 = conv_row(uglu, b, (w + 5 <= 33) ? base + w + 5 : -1, ch);
        const f32x4 w0 = *(const f32x4*)wp, w1 = *(const f32x4*)(wp + 4); wp += DC;
        conv_fma(acc[0], x0, w0, w1); conv_fma(acc[1], x1, w0, w1); conv_fma(acc[2], x2, w0, w1); conv_fma(acc[3], x3, w0, w1);
        x0 = x1; x1 = x2; x2 = x3; x3 = x4; x4 = x5;
    }
    const f32x4 g0 = *(const f32x4*)(lg + ch), g1 = *(const f32x4*)(lg + ch + 4), e0 = *(const f32x4*)(lb + ch), e1 = *(const f32x4*)(lb + ch + 4);
    const float gg[8] = {g0.x, g0.y, g0.z, g0.w, g1.x, g1.y, g1.z, g1.w}, be[8] = {e0.x, e0.y, e0.z, e0.w, e1.x, e1.y, e1.z, e1.w};
#pragma unroll
    for (int d = 0; d < 4; ++d) {
        float s = 0.f;
#pragma unroll
        for (int j = 0; j < 8; ++j) s += acc[d][j];
        const float mu = wave_sum(s) * (1.0f / 512.0f);
        float vq = 0.f;
#pragma unroll
        for (int j = 0; j < 8; ++j) { acc[d][j] -= mu; vq += acc[d][j] * acc[d][j]; }
        const float rstd = rsqrt_(wave_sum(vq) * (1.0f / 512.0f) + EPS);
        float y[8];
#pragma unroll
        for (int j = 0; j < 8; ++j) { const float v = acc[d][j] * rstd * gg[j] + be[j]; y[j] = v * sigmoidf_(v); }
        u32x4 o; o.x = pk2(y[0], y[1]); o.y = pk2(y[2], y[3]); o.z = pk2(y[4], y[5]); o.w = pk2(y[6], y[7]);
        *(u32x4*)(u2 + (size_t)(tok0 + d) * DC + ch) = o;
    }
}
__device__ __forceinline__ void phase_B(const Ctx& c0, int l) {
    Ctx c = reopaque(c0);
    constexpr int NQ = MT * NH, NKV = MT * NH, NCV = T / 16;
    for (int it = c.vb; it < NQ + NKV + NCV; it += c.G) {
        if (it < NQ) phaseB_q_item(c, l, it / NH, it % NH);
        else if (it < NQ + NKV) phaseB_kv_item(c, l, (it - NQ) / NH, (it - NQ) % NH);
        else phaseB_conv_item(c, l, (it - NQ - NKV) * 4 + c.wave);
    }
}

constexpr int KROW = 208, VROW = 136, ATT_STAGE = 64 * KROW + 64 * VROW;
constexpr int ATT_ITEMS = NB * NH * 17;
__device__ __forceinline__ void phase_C(const Ctx& c0, int l) {
    Ctx c = reopaque(c0);
    const bf16* Qb = WSP(bf16, WS_Q); const bf16* Kb = WSP(bf16, WS_K); const bf16* Vt = WSP(bf16, WS_VT); bf16* O = WSP(bf16, WS_O);
    unsigned* qctr = WSP(unsigned, WS_CTL) + CW_QUEUE + 64 * l;
    volatile unsigned* misc = (volatile unsigned*)(c.lds + LDS_MISC);
    const int tid = c.tid, wave = c.wave, lane = c.lane, r = lane & 15, q = lane >> 4;
    unsigned char* lds = c.lds;
    for (;;) {
        if (tid == 0) misc[4] = atomicAdd(qctr, 1u);
        __syncthreads();
        const int item = __builtin_amdgcn_readfirstlane((int)misc[4]);
        __syncthreads();
        if (item >= ATT_ITEMS) break;
        const int pp = 15 - item / 64, bh = item % 64, b = bh / NH, h = bh % NH;
        const bool meta = pp < 0;
        const int r0 = meta ? 0 : 16 + 128 * pp;
        const int nfull = meta ? 0 : 2 * pp + 1 + (wave >> 1);
        const int ntiles = meta ? 1 : 2 * pp + 3;
        const bf16* Kbase = Kb + (size_t)bh * L * QK; const bf16* Vbase = Vt + (size_t)bh * VD * L;
        bf16x8 qf[2][3];
#pragma unroll
        for (int mi = 0; mi < 2; ++mi)
#pragma unroll
            for (int ks = 0; ks < 3; ++ks) qf[mi][ks] = *(const bf16x8*)(Qb + ((size_t)bh * L + r0 + 32 * wave + 16 * mi + r) * QK + 32 * ks + 8 * q);
        float m[2] = {-1e30f, -1e30f}, lsum[2] = {0.f, 0.f};
        f32x4 o[2][4];
#pragma unroll
        for (int mi = 0; mi < 2; ++mi)
#pragma unroll
            for (int dt = 0; dt < 4; ++dt) o[mi][dt] = (f32x4){0.f, 0.f, 0.f, 0.f};
        u32x4 rk[3], rv[2];
        auto gload = [&](int kt) {
#pragma unroll
            for (int i = 0; i < 3; ++i) { const int id = tid + 256 * i, row = id / 12, cc = id % 12; rk[i] = *(const u32x4*)(Kbase + (size_t)(kt * 64 + row) * QK + cc * 8); }
#pragma unroll
            for (int i = 0; i < 2; ++i) { const int id = tid + 256 * i, row = id >> 3, cc = id & 7; rv[i] = *(const u32x4*)(Vbase + (size_t)row * L + kt * 64 + cc * 8); }
        };
        auto lstore = [&](int s) {
            unsigned char* st = lds + s * ATT_STAGE;
#pragma unroll
            for (int i = 0; i < 3; ++i) { const int id = tid + 256 * i, row = id / 12, cc = id % 12; *(u32x4*)(st + row * KROW + cc * 16) = rk[i]; }
#pragma unroll
            for (int i = 0; i < 2; ++i) { const int id = tid + 256 * i, row = id >> 3, cc = id & 7; u32x2* d = (u32x2*)(st + 64 * KROW + row * VROW + cc * 16); d[0] = (u32x2){rv[i].x, rv[i].y}; d[1] = (u32x2){rv[i].z, rv[i].w}; }
        };
        gload(0); lstore(0);
#pragma unroll
        for (int mi = 0; mi < 2; ++mi)
#pragma unroll
            for (int ks = 0; ks < 3; ++ks) asm volatile("" : "+v"(qf[mi][ks]));
        __syncthreads();
        for (int kt = 0; kt < ntiles; ++kt) {
            const int cur = kt & 1;
            if (kt + 1 < ntiles) gload(kt + 1);
            const unsigned char* sK = lds + cur * ATT_STAGE; const unsigned char* sV = sK + 64 * KROW;
            const bool full = kt < nfull;
            if (kt <= nfull) {
                f32x4 s[2][4];
#pragma unroll
                for (int kh = 0; kh < 2; ++kh) {
                    bf16x8 kf[2][3];
#pragma unroll
                    for (int kk = 0; kk < 2; ++kk) if ((kh == 0 && kk == 0) || full) {
#pragma unroll
                        for (int ks = 0; ks < 3; ++ks) kf[kk][ks] = *(const bf16x8*)(sK + (16 * (2 * kh + kk) + r) * KROW + 64 * ks + 16 * q); }
#pragma unroll
                    for (int kk = 0; kk < 2; ++kk) { const int k4 = 2 * kh + kk;
#pragma unroll
                        for (int mi = 0; mi < 2; ++mi) s[mi][k4] = (f32x4){0.f, 0.f, 0.f, 0.f};
                        if (k4 == 0 || full) {
#pragma unroll
                            for (int ks = 0; ks < 3; ++ks)
#pragma unroll
                                for (int mi = 0; mi < 2; ++mi) s[mi][k4] = __builtin_amdgcn_mfma_f32_16x16x32_bf16(kf[kk][ks], qf[mi][ks], s[mi][k4], 0, 0, 0);
                        }
                    }
                }
                u32x2 vlo[4], vhi[4];
#pragma unroll
                for (int dt = 0; dt < 4; ++dt) { const unsigned char* vp = sV + (16 * dt + r) * VROW + (4 * q) * 2;
                    vlo[dt] = *(const u32x2*)vp; vhi[dt] = (u32x2){0u, 0u}; if (full) vhi[dt] = *(const u32x2*)(vp + 32); }
                bf16x8 pf[2][2];
#pragma unroll
                for (int mi = 0; mi < 2; ++mi) {
                    float mx = fmaxf(fmaxf(s[mi][0].x, s[mi][0].y), fmaxf(s[mi][0].z, s[mi][0].w));
                    if (full) {
#pragma unroll
                        for (int k4 = 1; k4 < 4; ++k4) mx = fmaxf(mx, fmaxf(fmaxf(s[mi][k4].x, s[mi][k4].y), fmaxf(s[mi][k4].z, s[mi][k4].w)));
                    }
                    mx = quad_max(mx);
                    const float mn = fmaxf(m[mi], mx), alpha = fast_exp2(m[mi] - mn); m[mi] = mn;
                    float ps = 0.f;
#pragma unroll
                    for (int k4 = 0; k4 < 4; ++k4) {
                        if (k4 == 0 || full) { f32x4 p; p.x = fast_exp2(s[mi][k4].x - mn); p.y = fast_exp2(s[mi][k4].y - mn); p.z = fast_exp2(s[mi][k4].z - mn); p.w = fast_exp2(s[mi][k4].w - mn);
                            ps += (p.x + p.y) + (p.z + p.w); s[mi][k4] = p; }
                    }
                    lsum[mi] = lsum[mi] * alpha + ps;
#pragma unroll
                    for (int dt = 0; dt < 4; ++dt) o[mi][dt] = o[mi][dt] * alpha;
#pragma unroll
                    for (int st = 0; st < 2; ++st) { u32x4 pw;
                        pw.x = pk2(s[mi][2 * st].x, s[mi][2 * st].y); pw.y = pk2(s[mi][2 * st].z, s[mi][2 * st].w); pw.z = pk2(s[mi][2 * st + 1].x, s[mi][2 * st + 1].y); pw.w = pk2(s[mi][2 * st + 1].z, s[mi][2 * st + 1].w);
                        if (!full) { pw.z = 0u; pw.w = 0u; }
                        pf[mi][st] = __builtin_bit_cast(bf16x8, pw); }
                }
                u32x2 wlo[4], whi[4];
                if (full) {
#pragma unroll
                    for (int dt = 0; dt < 4; ++dt) { const unsigned char* vp = sV + (16 * dt + r) * VROW + (32 + 4 * q) * 2; wlo[dt] = *(const u32x2*)vp; whi[dt] = *(const u32x2*)(vp + 32); } }
#pragma unroll
                for (int dt = 0; dt < 4; ++dt) { const bf16x8 vf = __builtin_bit_cast(bf16x8, (u32x4){vlo[dt].x, vlo[dt].y, vhi[dt].x, vhi[dt].y});
#pragma unroll
                    for (int mi = 0; mi < 2; ++mi) o[mi][dt] = __builtin_amdgcn_mfma_f32_16x16x32_bf16(vf, pf[mi][0], o[mi][dt], 0, 0, 0); }
                if (full) {
#pragma unroll
                    for (int dt = 0; dt < 4; ++dt) { const bf16x8 vf = __builtin_bit_cast(bf16x8, (u32x4){wlo[dt].x, wlo[dt].y, whi[dt].x, whi[dt].y});
#pragma unroll
                        for (int mi = 0; mi < 2; ++mi) o[mi][dt] = __builtin_amdgcn_mfma_f32_16x16x32_bf16(vf, pf[mi][1], o[mi][dt], 0, 0, 0); } }
            }
            if (kt + 1 < ntiles) lstore(cur ^ 1);
            __syncthreads();
        }
#pragma unroll
        for (int mi = 0; mi < 2; ++mi) {
            const float lt = quad_sum(lsum[mi]);
            if (!meta || (wave == 0 && mi == 0)) {
                const float inv = 1.0f / lt;
                bf16* dst = O + ((size_t)b * L + r0 + 32 * wave + 16 * mi + r) * 512 + h * VD;
#pragma unroll
                for (int dt = 0; dt < 4; ++dt) { const f32x4 v = o[mi][dt] * inv; u32x2 ov; ov.x = pk2(v.x, v.y); ov.y = pk2(v.z, v.w); *(u32x2*)(dst + 16 * dt + 4 * q) = ov; }
            }
        }
    }
}

__device__ __forceinline__ int tile_tok0(int mt, int l) { return l == 1 ? mt * 128 + NMETA * ((mt >> 4) + 1) : mt * 128; }
__device__ __forceinline__ int n_mtiles(int l) { return l == 1 ? 128 : MT; }
__device__ __forceinline__ void phase_D(const Ctx& c0, int l) {
    Ctx c = reopaque(c0);
    const bf16* u2 = WSP(bf16, WS_U2); const bf16* O = WSP(bf16, WS_O); const bf16* gates = WSP(bf16, WS_GATES); bf16* merged = WSP(bf16, WS_MERGED);
    const bf16* Wco = (const bf16*)(c.ws + WS_WIN + l * SZ_WLAYER + OFF_WCO); const bf16* Wmla = (const bf16*)(c.ws + WS_WIN + l * SZ_WLAYER + OFF_WMLA);
    const int r = c.lane & 15, q = c.lane >> 4;
    for (int it = c.vb; it < n_mtiles(l) * 8; it += c.G) {
        const int mt = it / 8, nt = it % 8, tk0 = tile_tok0(mt, l);
        f32x4 acc[2][8]; acc_zero(acc);
        gemm_core(acc, u2 + (size_t)tk0 * 512, 512, Wco + (size_t)nt * 128 * 512, 512, 512, c.lds, c.tid);
#pragma unroll
        for (int mi = 0; mi < 2; ++mi) { const int tok = tk0 + 32 * c.wave + 16 * mi + r;
            const bf16* gp = gates + (size_t)tok * 2048 + nt * 128 + 4 * q; bf16* mp = merged + (size_t)tok * D + nt * 128 + 4 * q;
#pragma unroll
            for (int ni = 0; ni < 8; ++ni) { const u32x2 g = *(const u32x2*)(gp + 16 * ni); const f32x4 v = acc[mi][ni];
                u32x2 o; o.x = pk2(v.x * bf_lo(g.x), v.y * bf_hi(g.x)); o.y = pk2(v.z * bf_lo(g.y), v.w * bf_hi(g.y)); *(u32x2*)(mp + 16 * ni) = o; } }
        acc_zero(acc);
        gemm_core(acc, O + (size_t)tk0 * 512, 512, Wmla + (size_t)nt * 128 * 512, 512, 512, c.lds, c.tid);
#pragma unroll
        for (int mi = 0; mi < 2; ++mi) { const int tok = tk0 + 32 * c.wave + 16 * mi + r;
            const bf16* gp = gates + (size_t)tok * 2048 + 1024 + nt * 128 + 4 * q; bf16* mp = merged + (size_t)tok * D + nt * 128 + 4 * q;
#pragma unroll
            for (int ni = 0; ni < 8; ++ni) { const u32x2 g = *(const u32x2*)(gp + 16 * ni); const u32x2 s = *(const u32x2*)(mp + 16 * ni); const f32x4 v = acc[mi][ni];
                u32x2 o; o.x = pk2(bf_lo(s.x) + v.x * bf_lo(g.x), bf_hi(s.x) + v.y * bf_hi(g.x)); o.y = pk2(bf_lo(s.y) + v.z * bf_lo(g.y), bf_hi(s.y) + v.w * bf_hi(g.y));
                *(u32x2*)(mp + 16 * ni) = o; } }
    }
}

__device__ __forceinline__ void phase_E(const Ctx& c0, int l) {
    Ctx c = reopaque(c0);
    const bf16* merged = WSP(bf16, WS_MERGED); const bf16* Wout = (const bf16*)(c.ws + WS_WIN + l * SZ_WLAYER + OFF_WOUT);
    float* h = WSP(float, WS_H); bf16* hb = WSP(bf16, WS_HB); float* ssq = WSP(float, WS_SSQ);
    const int r = c.lane & 15, q = c.lane >> 4;
    for (int it = c.vb; it < n_mtiles(l) * 8; it += c.G) {
        const int mt = it / 8, nt = it % 8, tk0 = tile_tok0(mt, l);
        f32x4 acc[2][8]; acc_zero(acc);
        gemm_core(acc, merged + (size_t)tk0 * D, D, Wout + (size_t)nt * 128 * D, D, D, c.lds, c.tid);
#pragma unroll
        for (int mi = 0; mi < 2; ++mi) { const int tok = tk0 + 32 * c.wave + 16 * mi + r; float ss = 0.f;
#pragma unroll
            for (int ni = 0; ni < 8; ++ni) { float* hp = h + (size_t)tok * D + nt * 128 + 16 * ni + 4 * q; const f32x4 v = *(const f32x4*)hp + acc[mi][ni]; *(f32x4*)hp = v;
                ss += (v.x * v.x + v.y * v.y) + (v.z * v.z + v.w * v.w);
                u32x2 o; o.x = pk2(v.x, v.y); o.y = pk2(v.z, v.w); *(u32x2*)(hb + (size_t)tok * D + nt * 128 + 16 * ni + 4 * q) = o; }
            ss = quad_sum(ss);
            if (q == 0) ssq[(size_t)tok * 8 + nt] = ss; }
    }
}

__device__ __forceinline__ unsigned f2key(float f) { const unsigned u = __float_as_uint(f); return u ^ ((u >> 31) ? 0xFFFFFFFFu : 0x80000000u); }
__device__ __forceinline__ float key2f(unsigned k) { const unsigned u = (k >> 31) ? (k ^ 0x80000000u) : ~k; return __uint_as_float(u); }
__device__ __forceinline__ void top16_insert(unsigned (&lst)[16], unsigned x) {
#pragma unroll
    for (int i = 0; i < 16; ++i) { const unsigned a = lst[i]; lst[i] = a > x ? a : x; x = a > x ? x : a; }
}
__device__ __forceinline__ void ce_desc(unsigned& a, unsigned& b) { const unsigned mx = a > b ? a : b, mn = a > b ? b : a; a = mx; b = mn; }
__device__ __forceinline__ void sort16_desc(unsigned (&v)[16]) {
#pragma unroll
    for (int k = 2; k <= 16; k <<= 1)
#pragma unroll
        for (int j = k >> 1; j > 0; j >>= 1)
#pragma unroll
            for (int i = 0; i < 16; ++i) { const int p = i ^ j; if (p > i) { if ((i & k) == 0) ce_desc(v[i], v[p]); else ce_desc(v[p], v[i]); } }
}
__device__ __forceinline__ void merge_top16(unsigned (&a)[16], const unsigned (&b)[16]) {
#pragma unroll
    for (int i = 0; i < 16; ++i) a[i] = a[i] > b[15 - i] ? a[i] : b[15 - i];
#pragma unroll
    for (int j = 8; j > 0; j >>= 1)
#pragma unroll
        for (int i = 0; i < 16; ++i) { const int p = i ^ j; if (p > i) ce_desc(a[i], a[p]); }
}
__device__ __forceinline__ void phase_F(const Ctx& c0, int l) {
    Ctx c = reopaque(c0);
    const bf16* hb = WSP(bf16, WS_HB); const bf16* Wpq = (const bf16*)(c.ws + WS_WIN + l * SZ_WLAYER + OFF_WPQ); const bf16* keys = (const bf16*)(c.ws + WS_WIN + l * SZ_WLAYER + OFF_KEYS);
    const float* ssq = WSP(float, WS_SSQ); float* sv = WSP(float, WS_SV); unsigned char* si = WSP(unsigned char, WS_SI);
    const int tid = c.tid, wave = c.wave, lane = c.lane, r = lane & 15, q = lane >> 4;
    unsigned char* lds = c.lds;
    for (int it = c.vb; it < n_mtiles(l) * 16; it += c.G) {
        const int mt = it / 16, hp = it % 16, tk0 = tile_tok0(mt, l);
        f32x4 acc[2][8]; acc_zero(acc);
        gemm_core(acc, hb + (size_t)tk0 * D, D, Wpq + (size_t)hp * 128 * D, D, D, lds, tid);
#pragma unroll
        for (int mi = 0; mi < 2; ++mi) { const int row = 32 * wave + 16 * mi + r; const float rs = rstd_from_ssq8(ssq, tk0 + row);
#pragma unroll
            for (int ni = 0; ni < 8; ++ni) { const f32x4 v = acc[mi][ni] * rs; u32x2 o; o.x = pk2(v.x, v.y); o.y = pk2(v.z, v.w);
                *(u32x2*)(lds + (ni >> 2) * 32768 + lds_off(row, 2 * (ni & 3) + (q >> 1)) + 8 * (q & 1)) = o; } }
        { const int chunk = tid & 7, row0 = tid >> 3; const bf16* pb = keys + ((size_t)hp * 128 + row0) * 128 + chunk * 8;
#pragma unroll
          for (int s = 0; s < 2; ++s)
#pragma unroll
              for (int i = 0; i < 4; ++i) *(u32x4*)(lds + s * 32768 + 16384 + lds_off(row0 + 32 * i, chunk)) = *(const u32x4*)(pb + (size_t)(32 * i) * 128 + s * 64); }
        __syncthreads();
        acc_zero(acc);
        gemm_compute_stage(acc, lds, lds + 16384, wave, lane);
        gemm_compute_stage(acc, lds + 32768, lds + 32768 + 16384, wave, lane);
        __syncthreads();
        float* S = (float*)lds;
#pragma unroll
        for (int mi = 0; mi < 2; ++mi) { const int row = 32 * wave + 16 * mi + r;
#pragma unroll
            for (int ni = 0; ni < 8; ++ni) *(f32x4*)(S + row * 132 + 16 * ni + 4 * q) = acc[mi][ni]; }
        __syncthreads();
        {
            const int tl = 32 * wave + (lane & 31), half = lane >> 5;
            const float* row = S + tl * 132;
            unsigned lst[16];
#pragma unroll
            for (int g = 0; g < 4; ++g) {
                unsigned cur[16];
#pragma unroll
                for (int j = 0; j < 4; ++j) { const int col = 64 * half + 16 * g + 4 * j; const f32x4 v = *(const f32x4*)(row + col);
                    cur[4 * j] = (f2key(v.x) & ~127u) | (unsigned)(127 - col); cur[4 * j + 1] = (f2key(v.y) & ~127u) | (unsigned)(127 - (col + 1));
                    cur[4 * j + 2] = (f2key(v.z) & ~127u) | (unsigned)(127 - (col + 2)); cur[4 * j + 3] = (f2key(v.w) & ~127u) | (unsigned)(127 - (col + 3)); }
                sort16_desc(cur);
                if (g == 0) {
#pragma unroll
                    for (int i = 0; i < 16; ++i) lst[i] = cur[i];
                } else merge_top16(lst, cur);
            }
            unsigned oth[16];
#pragma unroll
            for (int i = 0; i < 16; ++i) { auto rr = __builtin_amdgcn_permlane32_swap(lst[i], lst[i], false, false); oth[i] = half == 0 ? rr[1] : rr[0]; }
            merge_top16(lst, oth);
            if (half == 0) {
                const int tok = tk0 + tl;
                unsigned idx[16]; float val[16];
#pragma unroll
                for (int i = 0; i < 16; ++i) { idx[i] = 127u - (lst[i] & 127u); val[i] = row[idx[i]]; }
                float* svp = sv + ((size_t)tok * 16 + hp) * 16;
#pragma unroll
                for (int i = 0; i < 4; ++i) *(f32x4*)(svp + 4 * i) = (f32x4){val[4 * i], val[4 * i + 1], val[4 * i + 2], val[4 * i + 3]};
                u32x4 pi;
                pi.x = idx[0] | (idx[1] << 8) | (idx[2] << 16) | (idx[3] << 24); pi.y = idx[4] | (idx[5] << 8) | (idx[6] << 16) | (idx[7] << 24);
                pi.z = idx[8] | (idx[9] << 8) | (idx[10] << 16) | (idx[11] << 24); pi.w = idx[12] | (idx[13] << 8) | (idx[14] << 16) | (idx[15] << 24);
                *(u32x4*)(si + ((size_t)tok * 16 + hp) * 16) = pi;
            }
        }
        __syncthreads();
    }
}

__device__ __forceinline__ void phase_F3(const Ctx& c0, int l) {
    Ctx c = reopaque(c0);
    const float* sv = WSP(float, WS_SV); const unsigned char* si = WSP(unsigned char, WS_SI); int* eidx = WSP(int, WS_EIDX); float* gw = WSP(float, WS_GW); unsigned char* stb = WSP(unsigned char, WS_STB);
    float* lsv = (float*)c.lds;
    unsigned char* lsi = c.lds + 256 * 33 * 4;
    const int tid = c.tid;
    const int ntok = l == 1 ? NB * SEQ : T;
    for (int base = c.vb * NTHREADS; base < ntok * 8; base += c.G * NTHREADS) {
        const int thc = base + tid, tkc = thc >> 3;
        const int th = (l == 1 ? tkc + NMETA * ((tkc >> 11) + 1) : tkc) * 8 + (thc & 7);
        float a[16], b[16];
#pragma unroll
        for (int i = 0; i < 4; ++i) { const f32x4 x = *(const f32x4*)(sv + (size_t)th * 32 + 4 * i), y = *(const f32x4*)(sv + (size_t)th * 32 + 16 + 4 * i);
            a[4 * i] = x.x; a[4 * i + 1] = x.y; a[4 * i + 2] = x.z; a[4 * i + 3] = x.w; b[4 * i] = y.x; b[4 * i + 1] = y.y; b[4 * i + 2] = y.z; b[4 * i + 3] = y.w; }
        const u32x4 ia = *(const u32x4*)(si + (size_t)th * 32), ib = *(const u32x4*)(si + (size_t)th * 32 + 16);
#pragma unroll
        for (int i = 0; i < 16; ++i) { lsv[tid * 33 + i] = a[i]; lsv[tid * 33 + 16 + i] = b[i]; }
        *(u32x4*)(lsi + tid * 32) = ia; *(u32x4*)(lsi + tid * 32 + 16) = ib;
        unsigned lst[16];
#pragma unroll
        for (int i = 0; i < 16; ++i) lst[i] = 0u;
#pragma unroll
        for (int i = 0; i < 16; ++i)
#pragma unroll
            for (int j = 0; j < 16; ++j)
                if ((i + 1) * (j + 1) <= 16) top16_insert(lst, (f2key(a[i] + b[j]) & ~255u) | (unsigned)(255 - (i * 16 + j)));
        __builtin_amdgcn_s_waitcnt(0xC07F); asm volatile("" ::: "memory");
        float s[16]; int e[16];
#pragma unroll
        for (int k = 0; k < 16; ++k) { const unsigned code = 255u - (lst[k] & 255u); const int i = code >> 4, j = code & 15;
            s[k] = lsv[tid * 33 + i] + lsv[tid * 33 + 16 + j]; e[k] = (int)lsi[tid * 32 + i] * 128 + (int)lsi[tid * 32 + 16 + j]; }
        float mx = s[0];
#pragma unroll
        for (int k = 1; k < 16; ++k) mx = fmaxf(mx, s[k]);
        float sum = 0.f;
#pragma unroll
        for (int k = 0; k < 16; ++k) { s[k] = fast_exp2((s[k] - mx) * 1.4426950409f); sum += s[k]; }
        const float inv = 1.0f / sum;
        typedef unsigned long long u64;
        u64 hlo = 0ull, hhi = 0ull;
#pragma unroll
        for (int k = 0; k < 16; ++k) { const int sl = e[k] >> 10; if (sl < 8) hlo += 1ull << (8 * sl); else hhi += 1ull << (8 * (sl - 8)); }
        u64 ilo = hlo, ihi = hhi;
#pragma unroll
        for (int d = 1; d < 8; d <<= 1) { const u64 a_ = __shfl_up(ilo, d, 8), b_ = __shfl_up(ihi, d, 8); if ((tid & 7) >= d) { ilo += a_; ihi += b_; } }
        const u64 tlo = __shfl(ilo, 7, 8), thi = __shfl(ihi, 7, 8);
        const u64 ones = 0x0101010101010101ull;
        const u64 inlo = tlo * ones, inhi = thi * ones + (inlo >> 56) * ones;
        const u64 stlo = inlo - tlo, sthi = inhi - thi;
        u64 rlo = stlo + (ilo - hlo), rhi = sthi + (ihi - hhi);
        const int tokn = th >> 3;
#pragma unroll
        for (int k = 0; k < 16; ++k) { const int sl = e[k] >> 10; int pos;
            if (sl < 8) { pos = (int)((rlo >> (8 * sl)) & 255ull); rlo += 1ull << (8 * sl); } else { pos = (int)((rhi >> (8 * (sl - 8))) & 255ull); rhi += 1ull << (8 * (sl - 8)); }
            eidx[(size_t)tokn * 128 + pos] = e[k]; gw[(size_t)tokn * 128 + pos] = s[k] * inv; }
        if ((tid & 7) == 0) { u64* sp = (u64*)(stb + (size_t)tokn * 16); sp[0] = stlo; sp[1] = sthi; }
        __builtin_amdgcn_s_waitcnt(0xC07F); asm volatile("" ::: "memory");
    }
}

typedef float f32x2 __attribute__((ext_vector_type(2)));
constexpr int G2_WSTRIDE = 14336, G2_MAXTOK = 9;
__device__ __forceinline__ float fp8dot4(unsigned w, unsigned x01, unsigned x23, float acc) {
    const bf16x2 lo = __builtin_amdgcn_cvt_scalef32_pk_bf16_fp8(w, 1.0f, false), hi = __builtin_amdgcn_cvt_scalef32_pk_bf16_fp8(w, 1.0f, true);
    acc = __builtin_amdgcn_fdot2_f32_bf16(lo, __builtin_bit_cast(bf16x2, x01), acc, false);
    return __builtin_amdgcn_fdot2_f32_bf16(hi, __builtin_bit_cast(bf16x2, x23), acc, false);
}
__device__ __forceinline__ float reduce8_transposed(const float (&p)[8], int lane) {
    float s[4];
#pragma unroll
    for (int k = 0; k < 4; ++k) { auto r = __builtin_amdgcn_permlane32_swap(__float_as_uint(p[k]), __float_as_uint(p[k + 4]), false, false); s[k] = __uint_as_float(r[0]) + __uint_as_float(r[1]); }
    float t[2];
#pragma unroll
    for (int k = 0; k < 2; ++k) { auto r = __builtin_amdgcn_permlane16_swap(__float_as_uint(s[k]), __float_as_uint(s[k + 2]), false, false); t[k] = __uint_as_float(r[0]) + __uint_as_float(r[1]); }
    const float u0 = t[0] + dpp<0x128>(t[0]), u1 = t[1] + dpp<0x128>(t[1]);
    float r = (lane & 8) ? u1 : u0;
    r += dpp<0xB1>(r); r += dpp<0x4E>(r); r += dpp<0x141>(r);
    return r;
}
typedef int i32x4 __attribute__((ext_vector_type(4)));
__device__ __forceinline__ void fp8fma4(f32x2 (&acc)[8], int o, unsigned w, f32x2 a2) {
    const f32x2 lo = __builtin_amdgcn_cvt_scalef32_pk_f32_fp8(w, 1.0f, false), hi = __builtin_amdgcn_cvt_scalef32_pk_f32_fp8(w, 1.0f, true);
    acc[o] = __builtin_elementwise_fma(a2, lo, acc[o]); acc[o + 1] = __builtin_elementwise_fma(a2, hi, acc[o + 1]);
}
__device__ __forceinline__ void g2_u_chunk(u32x4 (&u)[8], const unsigned char* U, const int* pe_next, const float* pw_c, float* act_c, const u32x4 xa, const u32x4 xb, float rs, int lane) {
    const i32x4 e0 = *(const i32x4*)pe_next, e1 = *(const i32x4*)(pe_next + 4);
    const int en[8] = {e0.x, e0.y, e0.z, e0.w, e1.x, e1.y, e1.z, e1.w};
    float p[8];
#pragma unroll
    for (int k = 0; k < 8; ++k) {
        float d0 = fp8dot4(u[k].x, xa.x, xa.y, 0.f), d1 = fp8dot4(u[k].y, xa.z, xa.w, 0.f); d0 = fp8dot4(u[k].z, xb.x, xb.y, d0); d1 = fp8dot4(u[k].w, xb.z, xb.w, d1); p[k] = d0 + d1;
        asm volatile("" : "+v"(p[k]));
        u[k] = *(const u32x4*)(U + (size_t)__builtin_amdgcn_readfirstlane(en[k]) * 1024 + lane * 16);
    }
    const float a = reduce8_transposed(p, lane);
    const int row = (lane >> 3) & 7;
    if ((lane & 7) == 0) act_c[row] = gelu_tanh(a * rs) * pw_c[row];
}
__device__ __forceinline__ void g2_v_chunk(u32x4 (&v)[8], const unsigned char* V, const int* pe_next, const float* act_c, f32x2 (&acc)[8], int lane) {
    const i32x4 e0 = *(const i32x4*)pe_next, e1 = *(const i32x4*)(pe_next + 4);
    const int en[8] = {e0.x, e0.y, e0.z, e0.w, e1.x, e1.y, e1.z, e1.w};
    const f32x4 a0 = *(const f32x4*)act_c, a1 = *(const f32x4*)(act_c + 4);
    const float av[8] = {a0.x, a0.y, a0.z, a0.w, a1.x, a1.y, a1.z, a1.w};
#pragma unroll
    for (int k = 0; k < 8; ++k) { const f32x2 a2 = (f32x2){av[k], av[k]};
        fp8fma4(acc, 0, v[k].x, a2); fp8fma4(acc, 2, v[k].y, a2); fp8fma4(acc, 4, v[k].z, a2); fp8fma4(acc, 6, v[k].w, a2);
        asm volatile("" : "+v"(acc[0]), "+v"(acc[1]), "+v"(acc[2]), "+v"(acc[3]), "+v"(acc[4]), "+v"(acc[5]), "+v"(acc[6]), "+v"(acc[7]));
        v[k] = *(const u32x4*)(V + (size_t)__builtin_amdgcn_readfirstlane(en[k]) * 1024 + lane * 16);
    }
}
__device__ __forceinline__ void g2_finish_token(Ctx& c, int l, int tok, const f32x2 (&acc)[8], int lane) {
    float* h = WSP(float, WS_H); bf16* hbw = WSP(bf16, WS_HB); float* ssqw = WSP(float, WS_SSQ);
    float* hp = h + (size_t)tok * D + lane * 16;
    f32x4 r0 = *(const f32x4*)hp, r1 = *(const f32x4*)(hp + 4), r2 = *(const f32x4*)(hp + 8), r3 = *(const f32x4*)(hp + 12);
    r0 += (f32x4){acc[0].x, acc[0].y, acc[1].x, acc[1].y}; r1 += (f32x4){acc[2].x, acc[2].y, acc[3].x, acc[3].y};
    r2 += (f32x4){acc[4].x, acc[4].y, acc[5].x, acc[5].y}; r3 += (f32x4){acc[6].x, acc[6].y, acc[7].x, acc[7].y};
    if (l == 0) {
        *(f32x4*)hp = r0; *(f32x4*)(hp + 4) = r1; *(f32x4*)(hp + 8) = r2; *(f32x4*)(hp + 12) = r3;
        u32x4 o0, o1; o0.x = pk2(r0.x, r0.y); o0.y = pk2(r0.z, r0.w); o0.z = pk2(r1.x, r1.y); o0.w = pk2(r1.z, r1.w);
        o1.x = pk2(r2.x, r2.y); o1.y = pk2(r2.z, r2.w); o1.z = pk2(r3.x, r3.y); o1.w = pk2(r3.z, r3.w);
        *(u32x4*)(hbw + (size_t)tok * D + lane * 16) = o0; *(u32x4*)(hbw + (size_t)tok * D + lane * 16 + 8) = o1;
        float ss = (r0.x * r0.x + r0.y * r0.y) + (r0.z * r0.z + r0.w * r0.w) + (r1.x * r1.x + r1.y * r1.y) + (r1.z * r1.z + r1.w * r1.w)
                 + (r2.x * r2.x + r2.y * r2.y) + (r2.z * r2.z + r2.w * r2.w) + (r3.x * r3.x + r3.y * r3.y) + (r3.z * r3.z + r3.w * r3.w);
        ss = wave_sum_dpp(ss);
        if (lane < 8) ssqw[(size_t)tok * 8 + lane] = lane == 0 ? ss : 0.f;
    } else {
        const int b = tok / L, pos = tok - b * L;
        if (pos >= NMETA) { float* op = c.out + ((size_t)b * SEQ + (pos - NMETA)) * D + lane * 16;
            *(f32x4*)op = r0; *(f32x4*)(op + 4) = r1; *(f32x4*)(op + 8) = r2; *(f32x4*)(op + 12) = r3; }
    }
}
__device__ __forceinline__ void phase_G2(const Ctx& c0, int l) {
    Ctx c = reopaque(c0);
    const bf16* hb = WSP(bf16, WS_HB); const float* ssq = WSP(float, WS_SSQ); const int* pe = WSP(int, WS_EIDX); const float* pw = WSP(float, WS_GW);
    const unsigned char* U = c.ws + WS_TAB + (size_t)(l * 2) * SZ_TAB; const unsigned char* V = c.ws + WS_TAB + (size_t)(l * 2 + 1) * SZ_TAB;
    const int lane = c.lane, wave = c.wave;
    const int gw = c.vb * 4 + wave, t0 = l == 1 ? gw * 8 + NMETA * ((gw >> 8) + 1) : gw * 8;
    const bool has_x = l == 0 && (c.vb & 3) == 0; const int tx = T - 128 + (c.vb >> 2);
    unsigned char* wl = c.lds + wave * G2_WSTRIDE;
    int* pe_l = (int*)wl; float* pw_l = (float*)(wl + 4608); float* act_l = (float*)(wl + 9216);
#pragma unroll
    for (int j = 0; j < G2_MAXTOK; ++j) { const int tok = j < 8 ? t0 + j : (has_x ? tx : t0);
        pe_l[j * 128 + lane] = pe[(size_t)tok * 128 + lane]; pe_l[j * 128 + 64 + lane] = pe[(size_t)tok * 128 + 64 + lane];
        pw_l[j * 128 + lane] = pw[(size_t)tok * 128 + lane] * TAB_INV; pw_l[j * 128 + 64 + lane] = pw[(size_t)tok * 128 + 64 + lane] * TAB_INV; }
    const int xlo = has_x ? 4 * wave : 16, xhi = has_x ? 4 * wave + 4 : 16;
    {
        u32x4 xa[G2_MAXTOK], xb[G2_MAXTOK]; float rs[G2_MAXTOK];
#pragma unroll
        for (int j = 0; j < G2_MAXTOK; ++j) { const int tok = j < 8 ? t0 + j : (has_x ? tx : t0);
            xa[j] = *(const u32x4*)(hb + (size_t)tok * D + lane * 16); xb[j] = *(const u32x4*)(hb + (size_t)tok * D + lane * 16 + 8); rs[j] = rstd_from_ssq8(ssq, tok) * TAB_INV; }
        u32x4 u[8];
#pragma unroll
        for (int k = 0; k < 8; ++k) u[k] = *(const u32x4*)(U + (size_t)__builtin_amdgcn_readfirstlane(pe_l[k]) * 1024 + lane * 16);
#pragma unroll 1
        for (int ch = 0; ch < 16; ++ch) {
            const int cn = ch < 15 ? ch + 1 : 0;
            const bool x_here = ch >= xlo && ch < xhi;
#pragma unroll
            for (int j = 0; j < 8; ++j) {
                const int* pe_next = j < 7 ? pe_l + (j + 1) * 128 + ch * 8 : (x_here ? pe_l + 8 * 128 + ch * 8 : pe_l + cn * 8);
                g2_u_chunk(u, U, pe_next, pw_l + j * 128 + ch * 8, act_l + j * 128 + ch * 8, xa[j], xb[j], rs[j], lane); }
            if (x_here) g2_u_chunk(u, U, pe_l + cn * 8, pw_l + 8 * 128 + ch * 8, act_l + 8 * 128 + ch * 8, xa[8], xb[8], rs[8], lane);
        }
    }
    f32x2 acc[G2_MAXTOK][8];
#pragma unroll
    for (int j = 0; j < G2_MAXTOK; ++j)
#pragma unroll
        for (int i = 0; i < 8; ++i) acc[j][i] = (f32x2){0.f, 0.f};
    {
        u32x4 v[8];
#pragma unroll
        for (int k = 0; k < 8; ++k) v[k] = *(const u32x4*)(V + (size_t)__builtin_amdgcn_readfirstlane(pe_l[k]) * 1024 + lane * 16);
#pragma unroll 1
        for (int ch = 0; ch < 16; ++ch) {
            const int cn = ch < 15 ? ch + 1 : 0;
            const bool x_here = ch >= xlo && ch < xhi;
#pragma unroll
            for (int j = 0; j < 8; ++j) {
                const int* pe_next = j < 7 ? pe_l + (j + 1) * 128 + ch * 8 : (x_here ? pe_l + 8 * 128 + ch * 8 : pe_l + cn * 8);
                g2_v_chunk(v, V, pe_next, act_l + j * 128 + ch * 8, acc[j], lane); }
            if (x_here) g2_v_chunk(v, V, pe_l + cn * 8, act_l + 8 * 128 + ch * 8, acc[8], lane);
        }
    }
#pragma unroll
    for (int j = 0; j < 8; ++j) g2_finish_token(c, l, t0 + j, acc[j], lane);
    __syncthreads();
    if (has_x) {
        f32x2* part = (f32x2*)(c.lds + wave * G2_WSTRIDE);
#pragma unroll
        for (int i = 0; i < 8; ++i) part[i * 64 + lane] = acc[8][i];
    }
    __syncthreads();
    if (has_x && wave == 0) {
        f32x2 tot[8];
#pragma unroll
        for (int i = 0; i < 8; ++i) { tot[i] = acc[8][i];
#pragma unroll
            for (int w = 1; w < 4; ++w) tot[i] += ((const f32x2*)(c.lds + w * G2_WSTRIDE))[i * 64 + lane]; }
        g2_finish_token(c, l, tx, tot, lane);
    }
    __syncthreads();
}

struct Args { const float* in[22]; float* out; unsigned char* ws; int ph_lo, ph_hi; };
constexpr int N_PHASES = 17;

__global__ void __launch_bounds__(NTHREADS, 2) fwd_kernel(Args args) {
    extern __shared__ __attribute__((aligned(16))) unsigned char lds_raw[];
    Ctx c;
#pragma unroll
    for (int i = 0; i < 22; ++i) c.in[i] = args.in[i];
    c.out = args.out; c.ws = args.ws; c.lds = lds_raw;
    c.tid = threadIdx.x; c.lane = c.tid & 63; c.wave = __builtin_amdgcn_readfirstlane(c.tid >> 6);
    c.G = gridDim.x; { const int bx = blockIdx.x; c.vb = (c.G % 8 == 0) ? (bx % 8) * (c.G / 8) + bx / 8 : bx; }
    volatile unsigned* misc = (volatile unsigned*)(c.lds + LDS_MISC);
    if (c.tid < 16) misc[c.tid] = 0u;
    __syncthreads();
    const int lo = args.ph_lo, hi = args.ph_hi;
    const bool multi = (hi - lo) > 1;
    XcdBarrier bar; bar.bar = WSP(unsigned, WS_CTL) + CW_BAR; bar.x = 0; bar.st = misc;
    if (multi) bar = xcd_barrier_post(WSP(unsigned, WS_CTL) + CW_BAR, misc);
#define IN_(k) (lo <= (k) && (k) < hi)
#define SEAM_(k) do { if ((k) + 1 < hi) xcd_barrier(bar); } while (0)
    if (IN_(0)) { phase_prologue(c); SEAM_(0); }
#pragma unroll 1
    for (int l = 0; l < 2; ++l) {
        const int p0 = 1 + 8 * l;
        if (IN_(p0 + 0)) { phase_A(c, l); SEAM_(p0 + 0); }
        if (IN_(p0 + 1)) { phase_B(c, l); SEAM_(p0 + 1); }
        if (IN_(p0 + 2)) { phase_C(c, l); SEAM_(p0 + 2); }
        if (IN_(p0 + 3)) { phase_D(c, l); SEAM_(p0 + 3); }
        if (IN_(p0 + 4)) { phase_E(c, l); SEAM_(p0 + 4); }
        if (IN_(p0 + 5)) { phase_F(c, l); SEAM_(p0 + 5); }
        if (IN_(p0 + 6)) { phase_F3(c, l); SEAM_(p0 + 6); }
        if (IN_(p0 + 7)) { phase_G2(c, l); SEAM_(p0 + 7); }
    }
}

extern "C" void kernel_launch(void* const* d_in, const int* in_sizes, int n_in, void* d_out, int out_size, void* d_ws, size_t ws_size, hipStream_t stream) {
    static int grid = 0;
    if (grid == 0) {
        if (n_in != 22 || out_size != NB * SEQ * D || ws_size < WS_END) { fprintf(stderr, "kernel_launch: unexpected shapes (n_in %d out %d ws %zu need %zu)\n", n_in, out_size, ws_size, (size_t)WS_END); grid = -1; return; }
        int dev = 0, cus = 0, per_cu = 0;
        hipGetDevice(&dev); hipDeviceGetAttribute(&cus, hipDeviceAttributeMultiprocessorCount, dev);
        if (hipFuncSetAttribute((const void*)fwd_kernel, hipFuncAttributeMaxDynamicSharedMemorySize, LDS_BYTES) != hipSuccess) { fprintf(stderr, "kernel_launch: hipFuncSetAttribute failed\n"); grid = -1; return; }
        if (hipOccupancyMaxActiveBlocksPerMultiprocessor(&per_cu, (const void*)fwd_kernel, NTHREADS, LDS_BYTES) != hipSuccess || per_cu < 1) { fprintf(stderr, "kernel_launch: occupancy query failed (%d)\n", per_cu); per_cu = 1; (void)hipGetLastError(); }
        if (per_cu > 2) per_cu = 2;
        grid = cus * per_cu;
        if (grid != 512) { fprintf(stderr, "kernel_launch: grid %d unsupported by phase G2 (needs 512 workgroups)\n", grid); grid = -1; return; }
        fprintf(stderr, "kernel_launch: grid %d (%d per CU), lds %d, ws need %zu have %zu\n", grid, per_cu, LDS_BYTES, (size_t)WS_END, ws_size);
    }
    if (grid < 0) return;
    hipMemsetAsync((char*)d_ws + WS_CTL, 0, CTL_BYTES, stream);
    Args a{};
    for (int i = 0; i < 22; ++i) a.in[i] = (const float*)d_in[i];
    a.out = (float*)d_out; a.ws = (unsigned char*)d_ws;
#if MK_PER_PHASE
    for (int ph = 0; ph < N_PHASES; ++ph) { a.ph_lo = ph; a.ph_hi = ph + 1; hipLaunchKernelGGL(fwd_kernel, dim3(grid), dim3(NTHREADS), LDS_BYTES, stream, a); }
#else
    a.ph_lo = 0; a.ph_hi = N_PHASES;
    void* kargs[] = {&a};
    hipError_t e = hipLaunchCooperativeKernel((const void*)fwd_kernel, dim3(grid), dim3(NTHREADS), kargs, LDS_BYTES, stream);
    if (e != hipSuccess) fprintf(stderr, "kernel_launch: cooperative launch failed: %s (grid %d)\n", hipGetErrorString(e), grid);
#endif
}
```

```cpp
#include <hip/hip_runtime.h>
#include <cstdio>
#include <cstdint>

#ifndef MK_PER_PHASE
#define MK_PER_PHASE 0
#endif

typedef unsigned short bf16;
typedef short bf16x8 __attribute__((ext_vector_type(8)));
typedef float f32x4 __attribute__((ext_vector_type(4)));
typedef unsigned u32x4 __attribute__((ext_vector_type(4)));
typedef unsigned u32x2 __attribute__((ext_vector_type(2)));
typedef __bf16 bf16x2 __attribute__((ext_vector_type(2)));

constexpr int NB = 8, SEQ = 2048, NMETA = 16, L = SEQ + NMETA, T = NB * L, D = 1024;
constexpr int DC = 512, CW = 31, NH = 8, QL = 256, KVL = 128, NOPE = 64, ROPE = 32, QK = 96, VD = 64;
constexpr int NIN = 3488, NINP = 3584;
constexpr int NEXP = 16384;
constexpr float EPS = 1e-6f;
constexpr int MT = T / 128;
static_assert(T % 128 == 0, "T tiles");

constexpr size_t al256(size_t x) { return (x + 255) & ~(size_t)255; }
constexpr size_t WS_CTL = 0;
constexpr size_t CTL_BYTES = 65536;
constexpr size_t WS_ROPE = WS_CTL + CTL_BYTES;
constexpr size_t WS_WIN = al256(WS_ROPE + (size_t)L * 16 * 8);
constexpr size_t SZ_WIN = (size_t)NINP * 1024 * 2, SZ_WCO = (size_t)1024 * 512 * 2, SZ_WUQ = (size_t)1024 * 256 * 2, SZ_WUKV = (size_t)1024 * 128 * 2,
                 SZ_WMLA = (size_t)1024 * 512 * 2, SZ_WOUT = (size_t)1024 * 1024 * 2, SZ_WPQ = (size_t)2048 * 1024 * 2, SZ_KEYS = (size_t)16 * 128 * 128 * 2;
constexpr size_t OFF_WCO = SZ_WIN, OFF_WUQ = OFF_WCO + SZ_WCO, OFF_WUKV = OFF_WUQ + SZ_WUQ, OFF_WMLA = OFF_WUKV + SZ_WUKV, OFF_WOUT = OFF_WMLA + SZ_WMLA,
                 OFF_WPQ = OFF_WOUT + SZ_WOUT, OFF_KEYS = OFF_WPQ + SZ_WPQ, SZ_WLAYER = OFF_KEYS + SZ_KEYS;
constexpr size_t WS_TAB = al256(WS_WIN + 2 * SZ_WLAYER);
constexpr size_t SZ_TAB = (size_t)NEXP * 1024;
constexpr float TAB_SCALE = 256.0f, TAB_INV = 1.0f / 256.0f;
constexpr float U_CLIP = 0.2f, U_SCALE = 127.0f / U_CLIP;
constexpr size_t WS_H = al256(WS_TAB + 4 * SZ_TAB);
constexpr size_t WS_HB = al256(WS_H + (size_t)T * 1024 * 4);
constexpr size_t WS_SSQ = al256(WS_HB + (size_t)T * 1024 * 2);
constexpr size_t WS_UGLU = al256(WS_SSQ + (size_t)T * 8 * 4);
constexpr size_t WS_CQ = al256(WS_UGLU + (size_t)T * 512 * 2);
constexpr size_t WS_CKV = al256(WS_CQ + (size_t)T * 256 * 2);
constexpr size_t WS_KROPE = al256(WS_CKV + (size_t)T * 128 * 2);
constexpr size_t WS_SSQQ = al256(WS_KROPE + (size_t)T * 32 * 4);
constexpr size_t WS_SSQKV = al256(WS_SSQQ + (size_t)T * 2 * 4);
constexpr size_t WS_U2 = al256(WS_SSQKV + (size_t)T * 4);
constexpr size_t WS_Q = al256(WS_U2 + (size_t)T * 512 * 2);
constexpr size_t WS_K = al256(WS_Q + (size_t)T * NH * QK * 2);
constexpr size_t WS_VT = al256(WS_K + (size_t)T * NH * QK * 2);
constexpr size_t WS_O = al256(WS_VT + (size_t)T * NH * VD * 2 + 4096);
constexpr size_t WS_MERGED = al256(WS_O + (size_t)T * 512 * 2);
constexpr size_t WS_GATES = al256(WS_MERGED + (size_t)T * 1024 * 2);
constexpr size_t WS_SV = WS_GATES;
constexpr size_t WS_SI = al256(WS_SV + (size_t)T * 256 * 4);
constexpr size_t WS_EIDX = al256(WS_SI + (size_t)T * 256);
constexpr size_t WS_GW = al256(WS_EIDX + (size_t)T * 128 * 4);
constexpr size_t WS_STB = al256(WS_GW + (size_t)T * 128 * 4);
constexpr size_t WS_PEER_END = WS_STB + (size_t)T * 16;
constexpr size_t WS_END = al256(WS_GATES + (size_t)T * 2048 * 2);
static_assert(WS_PEER_END <= WS_END, "peer scratch overlay");

constexpr int CW_BAR = 0;
constexpr int CW_QUEUE = 4096;

constexpr int LDS_MAIN = 128 * 132 * 4;
constexpr int LDS_MISC = LDS_MAIN;
constexpr int LDS_BYTES = LDS_MAIN + 64;

constexpr int NTHREADS = 256;

__device__ __forceinline__ unsigned pk2(float lo, float hi) { bf16x2 v; v.x = (__bf16)lo; v.y = (__bf16)hi; return __builtin_bit_cast(unsigned, v); }
__device__ __forceinline__ unsigned pack_i8x4(f32x4 v) {
    const int a = (int)__builtin_rintf(fminf(fmaxf(v.x, -127.f), 127.f)), b = (int)__builtin_rintf(fminf(fmaxf(v.y, -127.f), 127.f));
    const int c_ = (int)__builtin_rintf(fminf(fmaxf(v.z, -127.f), 127.f)), d = (int)__builtin_rintf(fminf(fmaxf(v.w, -127.f), 127.f));
    return (unsigned)(a & 255) | ((unsigned)(b & 255) << 8) | ((unsigned)(c_ & 255) << 16) | ((unsigned)(d & 255) << 24);
}
__device__ __forceinline__ float bf_lo(unsigned p) { return __uint_as_float(p << 16); }
__device__ __forceinline__ float bf_hi(unsigned p) { return __uint_as_float(p & 0xffff0000u); }
__device__ __forceinline__ float fast_rcp(float x) { return __builtin_amdgcn_rcpf(x); }
__device__ __forceinline__ float fast_exp2(float x) { return __builtin_amdgcn_exp2f(x); }
__device__ __forceinline__ float sigmoidf_(float x) { return fast_rcp(1.0f + fast_exp2(-1.4426950409f * x)); }
__device__ __forceinline__ float gelu_tanh(float x) { const float u = 1.5957691216f * (x + 0.044715f * x * x * x); return x * fast_rcp(1.0f + fast_exp2(-1.4426950409f * u)); }
__device__ __forceinline__ float rsqrt_(float x) { return __builtin_amdgcn_rsqf(x); }
template <int CTRL> __device__ __forceinline__ float dpp(float x) { return __builtin_bit_cast(float, __builtin_amdgcn_mov_dpp(__builtin_bit_cast(int, x), CTRL, 0xf, 0xf, true)); }
__device__ __forceinline__ float xrow16_sum(float x) {
    auto s = __builtin_amdgcn_permlane16_swap(__float_as_uint(x), __float_as_uint(x), false, false);
    x = __uint_as_float(s[0]) + __uint_as_float(s[1]);
    auto t = __builtin_amdgcn_permlane32_swap(__float_as_uint(x), __float_as_uint(x), false, false);
    return __uint_as_float(t[0]) + __uint_as_float(t[1]);
}
__device__ __forceinline__ float xrow16_max(float x) {
    auto s = __builtin_amdgcn_permlane16_swap(__float_as_uint(x), __float_as_uint(x), false, false);
    x = fmaxf(__uint_as_float(s[0]), __uint_as_float(s[1]));
    auto t = __builtin_amdgcn_permlane32_swap(__float_as_uint(x), __float_as_uint(x), false, false);
    return fmaxf(__uint_as_float(t[0]), __uint_as_float(t[1]));
}
__device__ __forceinline__ float wave_sum_dpp(float x) {
    x += dpp<0xB1>(x); x += dpp<0x4E>(x); x += dpp<0x141>(x); x += dpp<0x128>(x); return xrow16_sum(x);
}
__device__ __forceinline__ float quad_sum(float v) { return xrow16_sum(v); }
__device__ __forceinline__ float quad_max(float v) { return xrow16_max(v); }
__device__ __forceinline__ float wave_sum(float v) { return wave_sum_dpp(v); }
__device__ __forceinline__ float dot2(unsigned a, unsigned b, float c) { return __builtin_amdgcn_fdot2_f32_bf16(__builtin_bit_cast(bf16x2, a), __builtin_bit_cast(bf16x2, b), c, false); }

#define XB_TMO      128
#define XB_XCNT(j)  (256  + 64 * (j))
#define XB_XSUB(j)  (1280 + 64 * (j))
#define XB_XGEN(j)  (2304 + 64 * (j))
#define XB_TOP      3328
#define XB_TOPGEN   3392
#define XCD_BAR_WORDS 3456
#define XB_SPIN_CAP (1u << 20)
__device__ __forceinline__ unsigned xb_ld(unsigned* p)              { return __hip_atomic_load(p, __ATOMIC_RELAXED, __HIP_MEMORY_SCOPE_AGENT); }
__device__ __forceinline__ unsigned xb_add(unsigned* p, unsigned v) { return __hip_atomic_fetch_add(p, v, __ATOMIC_RELAXED, __HIP_MEMORY_SCOPE_AGENT); }
__device__ __forceinline__ unsigned xb_xcc_id() { return (unsigned)__builtin_amdgcn_s_getreg((3 << 11) | 20) & 0xFu; }
#define XB_SPIN(cond, bar) do { unsigned _sp = 0; while (cond) { __builtin_amdgcn_s_sleep(1); \
    if ((++_sp & 255u) == 0u) { if (xb_ld(&(bar)[XB_TMO])) break; if (_sp > XB_SPIN_CAP) { atomicAdd(&(bar)[XB_TMO], 1u); break; } } } } while (0)
struct XcdBarrier { unsigned* bar; unsigned x; volatile unsigned* st; };
__device__ __forceinline__ XcdBarrier xcd_barrier_post(unsigned* bar, volatile unsigned* st) {
    XcdBarrier b; b.bar = bar; b.x = xb_xcc_id(); b.st = st;
    if (threadIdx.x == 0) (void)xb_add(&bar[XB_XCNT(b.x)], 1u);
    return b;
}
__device__ __forceinline__ void xcd_barrier_complete(unsigned* bar, unsigned x, unsigned& nloc, unsigned& nx) {
    const unsigned G = gridDim.x * gridDim.y * gridDim.z;
    unsigned sum, cnt, mine, sp = 0u;
    for (;;) {
        sum = 0u; cnt = 0u; mine = 0u;
#pragma unroll
        for (unsigned j = 0; j < 16; ++j) { const unsigned c = xb_ld(&bar[XB_XCNT(j)]); sum += c; cnt += (c > 0u) ? 1u : 0u; mine = (j == x) ? c : mine; }
        if (sum == G) break;
        __builtin_amdgcn_s_sleep(1);
        if ((++sp & 255u) == 0u) { if (xb_ld(&bar[XB_TMO])) break; if (sp > XB_SPIN_CAP) { atomicAdd(&bar[XB_TMO], 1u); break; } }
    }
    nloc = mine > 0u ? mine : 1u; nx = cnt > 0u ? cnt : 1u;
}
__device__ __forceinline__ void xcd_barrier(const XcdBarrier& b) {
    asm volatile("s_waitcnt vmcnt(0)" ::: "memory");
    __syncthreads();
    if (threadIdx.x == 0) {
        unsigned* bar = b.bar;
        __builtin_amdgcn_s_waitcnt(0);
        unsigned nloc = b.st[0], nx = b.st[1];
        if (nloc == 0u) { xcd_barrier_complete(bar, b.x, nloc, nx); b.st[0] = nloc; b.st[1] = nx; }
        const unsigned old = xb_add(&bar[XB_XSUB(b.x)], 1u);
        const unsigned gen = old / nloc;
        if (old + 1u == (gen + 1u) * nloc) {
            __builtin_amdgcn_fence(__ATOMIC_RELEASE, "agent");
            asm volatile("s_waitcnt vmcnt(0)" ::: "memory");
            const unsigned og = xb_add(&bar[XB_TOP], 1u);
            const unsigned tg = og / nx;
            if (og + 1u == (tg + 1u) * nx) xb_add(&bar[XB_TOPGEN], 1u);
            else XB_SPIN(xb_ld(&bar[XB_TOPGEN]) == tg, bar);
            __builtin_amdgcn_fence(__ATOMIC_ACQUIRE, "agent");
            xb_add(&bar[XB_XGEN(b.x)], 1u);
            asm volatile("s_waitcnt vmcnt(0)" ::: "memory");
        } else {
            XB_SPIN(xb_ld(&bar[XB_XGEN(b.x)]) == gen, bar);
            __builtin_amdgcn_fence(__ATOMIC_ACQUIRE, "agent");
            asm volatile("s_waitcnt vmcnt(0)" ::: "memory");
        }
    }
    __syncthreads();
}

struct Ctx {
    const float* in[22]; float* out; unsigned char* ws;
    unsigned char* lds; int tid, lane, wave, G, vb;
};
#define WSP(T_, off) ((T_*)(c.ws + (off)))
__device__ __forceinline__ Ctx reopaque(const Ctx& c0) {
    Ctx c = c0; int t = c0.tid; asm volatile("" : "+v"(t)); c.tid = t; c.lane = t & 63; c.wave = __builtin_amdgcn_readfirstlane(t >> 6);
    int vb = c0.vb; asm volatile("" : "+s"(vb)); c.vb = vb; return c;
}

__device__ __forceinline__ int lds_off(int row, int chunk) { return row * 128 + ((chunk ^ (row & 7)) << 4); }

__device__ __forceinline__ void gemm_compute_stage(f32x4 (&acc)[2][8], const unsigned char* sA, const unsigned char* sB, int wave, int lane) {
    const int r = lane & 15, q = lane >> 4;
#pragma unroll
    for (int ks = 0; ks < 2; ++ks) {
        bf16x8 af[2], bfr[8];
#pragma unroll
        for (int mi = 0; mi < 2; ++mi) af[mi] = *(const bf16x8*)(sA + lds_off(32 * wave + 16 * mi + r, 4 * ks + q));
#pragma unroll
        for (int ni = 0; ni < 8; ++ni) bfr[ni] = *(const bf16x8*)(sB + lds_off(16 * ni + r, 4 * ks + q));
#pragma unroll
        for (int mi = 0; mi < 2; ++mi)
#pragma unroll
            for (int ni = 0; ni < 8; ++ni) acc[mi][ni] = __builtin_amdgcn_mfma_f32_16x16x32_bf16(bfr[ni], af[mi], acc[mi][ni], 0, 0, 0);
    }
}

#define LAS __attribute__((address_space(3)))
__device__ __forceinline__ void gemm_stage_glds(const bf16* A, int lda, const bf16* Bt, int ldb, int kt, unsigned char* stage, int wave, int lane) {
    const int rr = lane >> 3, cch = (lane & 7) ^ rr;
#pragma unroll
    for (int i = 0; i < 4; ++i) { const int pc = 4 * i + wave;
        __builtin_amdgcn_global_load_lds((const unsigned*)(A + (size_t)(8 * pc + rr) * lda + kt * 64 + cch * 8), (LAS unsigned*)(stage + pc * 1024), 16, 0, 0);
        __builtin_amdgcn_global_load_lds((const unsigned*)(Bt + (size_t)(8 * pc + rr) * ldb + kt * 64 + cch * 8), (LAS unsigned*)(stage + 16384 + pc * 1024), 16, 0, 0); }
}
__device__ __forceinline__ void gemm_core(f32x4 (&acc)[2][8], const bf16* A, int lda, const bf16* Bt, int ldb, int K, unsigned char* lds, int tid) {
    const int wave = __builtin_amdgcn_readfirstlane(tid >> 6), lane = tid & 63;
    const int nk = K >> 6;
    gemm_stage_glds(A, lda, Bt, ldb, 0, lds, wave, lane);
    asm volatile("s_waitcnt vmcnt(0)" ::: "memory");
    __syncthreads();
    for (int kt = 0; kt < nk; ++kt) {
        const int cur = kt & 1;
        if (kt + 1 < nk) gemm_stage_glds(A, lda, Bt, ldb, kt + 1, lds + (cur ^ 1) * 32768, wave, lane);
        gemm_compute_stage(acc, lds + cur * 32768, lds + cur * 32768 + 16384, wave, lane);
        asm volatile("s_waitcnt vmcnt(0)" ::: "memory");
        __syncthreads();
    }
}
__device__ __forceinline__ void acc_zero(f32x4 (&acc)[2][8]) {
#pragma unroll
    for (int mi = 0; mi < 2; ++mi)
#pragma unroll
        for (int ni = 0; ni < 8; ++ni) acc[mi][ni] = (f32x4){0.f, 0.f, 0.f, 0.f};
}
__device__ __forceinline__ float rstd_from_ssq8(const float* ssq, int tok) {
    const f32x4 a = *(const f32x4*)(ssq + (size_t)tok * 8), b = *(const f32x4*)(ssq + (size_t)tok * 8 + 4);
    const float s = ((a.x + a.y) + (a.z + a.w)) + ((b.x + b.y) + (b.z + b.w));
    return rsqrt_(s * (1.0f / 1024.0f) + EPS);
}

__device__ __forceinline__ int src_col(int mode, int np) {
    if (mode == 0) return np;
    if (mode == 2) { const int h = np >> 7, j = np & 127; return j < 96 ? h * 96 + j : -1; }
    if (np < 1024) { const int cblk = np >> 7, j = np & 127; return j < 64 ? 64 * cblk + j : 512 + 64 * cblk + (j - 64); }
    if (np < 1408) return np;
    if (np < 1536) { const int j = np - 1408; return j < 32 ? 1408 + j : -1; }
    return 1440 + (np - 1536);
}
__device__ __forceinline__ void p0_transpose_item(const float* W, int K, int N, bf16* Wt, int mode, const float* g, int item, float* scr, int lane) {
    const int nblk_k = K / 64, nb = item / nblk_k, kb = item % nblk_k, k0 = 64 * kb, n0 = 32 * nb;
    const int n = src_col(mode, n0 + (lane & 31));
#pragma unroll 8
    for (int i = 0; i < 32; ++i) { const int kk = 2 * i + (lane >> 5); float v = 0.f; if (n >= 0) { v = W[(size_t)(k0 + kk) * N + n]; if (g) v *= g[k0 + kk]; } scr[kk * 33 + (lane & 31)] = v; }
    __builtin_amdgcn_s_waitcnt(0xC07F); asm volatile("" ::: "memory");
    const int cch = lane & 7;
#pragma unroll
    for (int j = 0; j < 4; ++j) { const int nl = (lane >> 3) + 8 * j; const float* s = scr + (8 * cch) * 33 + nl;
        u32x4 o; o.x = pk2(s[0 * 33], s[1 * 33]); o.y = pk2(s[2 * 33], s[3 * 33]); o.z = pk2(s[4 * 33], s[5 * 33]); o.w = pk2(s[6 * 33], s[7 * 33]);
        *(u32x4*)(Wt + (size_t)(n0 + nl) * K + k0 + 8 * cch) = o; }
    __builtin_amdgcn_s_waitcnt(0xC07F); asm volatile("" ::: "memory");
}
struct WDesc { int in_idx, K, N, Np, mode, g_idx; size_t off; };
__device__ __forceinline__ void phase_prologue(const Ctx& c0) {
    Ctx c = reopaque(c0);
    const int gw = c.vb * 4 + c.wave, NGW = c.G * 4;
    float* scr = (float*)(c.lds + c.wave * 8704);
    const WDesc wd[7] = {
        {3, 1024, NIN, NINP, 1, 2, 0}, {8, 512, 1024, 1024, 0, -1, OFF_WCO}, {10, 256, 768, 1024, 2, 9, OFF_WUQ}, {12, 128, 1024, 1024, 0, 11, OFF_WUKV},
        {15, 512, 1024, 1024, 0, -1, OFF_WMLA}, {16, 1024, 1024, 1024, 0, -1, OFF_WOUT}, {18, 1024, 2048, 2048, 0, 17, OFF_WPQ}};
    constexpr int ITEMS_PER_LAYER = (1024 / 64) * (NINP / 32) + (512 / 64) * 32 + (256 / 64) * 32 + (128 / 64) * 32 + (512 / 64) * 32 + (1024 / 64) * 32 + (1024 / 64) * 64;
    for (int it = gw; it < 2 * ITEMS_PER_LAYER; it += NGW) {
        const int l = it >= ITEMS_PER_LAYER ? 1 : 0; int r = it - l * ITEMS_PER_LAYER;
        const float* W = nullptr; const float* g = nullptr; bf16* Wt = nullptr; int K = 64, N = 32, mode = 0, rr = 0;
#pragma unroll
        for (int m = 0; m < 7; ++m) {
            const int items = (wd[m].K / 64) * (wd[m].Np / 32);
            if (r >= 0 && r < items) { K = wd[m].K; N = wd[m].N; mode = wd[m].mode; rr = r;
                W = c.in[wd[m].in_idx] + (size_t)l * wd[m].K * wd[m].N; g = wd[m].g_idx >= 0 ? c.in[wd[m].g_idx >= 0 ? wd[m].g_idx : 0] + (size_t)l * wd[m].K : nullptr;
                Wt = (bf16*)(c.ws + WS_WIN + l * SZ_WLAYER + wd[m].off); }
            r -= items;
        }
        p0_transpose_item(W, K, N, Wt, mode, g, rr, scr, c.lane);
    }
    const int gt = c.vb * NTHREADS + c.tid, NGT = c.G * NTHREADS;
    for (int l = 0; l < 2; ++l) {
        const float* src = c.in[19] + (size_t)l * 262144; bf16* dst = (bf16*)(c.ws + WS_WIN + l * SZ_WLAYER + OFF_KEYS);
        for (int i = gt; i < 262144 / 8; i += NGT) { const f32x4 a = *(const f32x4*)(src + i * 8), b = *(const f32x4*)(src + i * 8 + 4);
            u32x4 o; o.x = pk2(a.x, a.y); o.y = pk2(a.z, a.w); o.z = pk2(b.x, b.y); o.w = pk2(b.z, b.w); *(u32x4*)(dst + i * 8) = o; }
    }
    for (int l = 0; l < 2; ++l)
        for (int uv = 0; uv < 2; ++uv) {
            const float* src = c.in[20 + uv] + (size_t)l * NEXP * 1024; unsigned char* dst = c.ws + WS_TAB + (size_t)(l * 2 + uv) * SZ_TAB;
            f32x4 g4[4];
#pragma unroll
            for (int j = 0; j < 4; ++j) { const float sc = uv == 0 ? U_SCALE : TAB_SCALE; g4[j] = (f32x4){sc, sc, sc, sc}; if (uv == 0) g4[j] = g4[j] * *(const f32x4*)(c.in[17] + l * 1024 + 256 * j + 4 * c.lane); }
            for (int row = gw; row < NEXP; row += 2 * NGW) {
                const float* sp = src + (size_t)row * 1024 + 4 * c.lane; const int row2 = row + NGW; const bool two = row2 < NEXP;
                const float* sp2 = src + (size_t)(two ? row2 : row) * 1024 + 4 * c.lane;
                f32x4 a[4], b[4];
#pragma unroll
                for (int j = 0; j < 4; ++j) { a[j] = *(const f32x4*)(sp + 256 * j); b[j] = *(const f32x4*)(sp2 + 256 * j); }
#pragma unroll
                for (int j = 0; j < 4; ++j) { const f32x4 v = a[j] * g4[j];
                    *(unsigned*)(dst + (size_t)row * 1024 + 256 * j + 4 * c.lane) = uv == 0 ? pack_i8x4(v) : (unsigned)__builtin_amdgcn_cvt_pk_fp8_f32(v.z, v.w, __builtin_amdgcn_cvt_pk_fp8_f32(v.x, v.y, 0, false), true); }
                if (two) {
#pragma unroll
                    for (int j = 0; j < 4; ++j) { const f32x4 v = b[j] * g4[j];
                        *(unsigned*)(dst + (size_t)row2 * 1024 + 256 * j + 4 * c.lane) = uv == 0 ? pack_i8x4(v) : (unsigned)__builtin_amdgcn_cvt_pk_fp8_f32(v.z, v.w, __builtin_amdgcn_cvt_pk_fp8_f32(v.x, v.y, 0, false), true); } }
            }
        }
    { float* rope = WSP(float, WS_ROPE);
      for (int i = gt; i < L * 16; i += NGT) { const int pos = i >> 4, j = i & 15;
          const float inv = 1.0f / __builtin_exp2f((float)j * 0.8304820237218406f);
          const float angf = (float)pos * inv; const double ang = (double)angf;
          const double nq = __builtin_rint(ang * 0.63661977236758134308);
          double rr = __builtin_fma(-nq, 1.57079632679489655800e+00, ang); rr = __builtin_fma(-nq, 6.12323399573676603587e-17, rr);
          const double r2 = rr * rr;
          double sp = -1.0 / 1307674368000.0; sp = sp * r2 + 1.0 / 6227020800.0; sp = sp * r2 - 1.0 / 39916800.0; sp = sp * r2 + 1.0 / 362880.0; sp = sp * r2 - 1.0 / 5040.0; sp = sp * r2 + 1.0 / 120.0; sp = sp * r2 - 1.0 / 6.0; sp = sp * r2 * rr + rr;
          double cp = 1.0 / 87178291200.0; cp = cp * r2 - 1.0 / 479001600.0; cp = cp * r2 + 1.0 / 3628800.0; cp = cp * r2 - 1.0 / 40320.0; cp = cp * r2 + 1.0 / 720.0; cp = cp * r2 - 1.0 / 24.0; cp = cp * r2 + 0.5; cp = 1.0 - cp * r2;
          const int qd = ((int)nq) & 3;
          const double cv = qd == 0 ? cp : qd == 1 ? -sp : qd == 2 ? -cp : sp;
          const double sv_ = qd == 0 ? sp : qd == 1 ? cp : qd == 2 ? -sp : -cp;
          rope[2 * i] = (float)cv; rope[2 * i + 1] = (float)sv_; } }
    { float* h = WSP(float, WS_H); bf16* hb = WSP(bf16, WS_HB); float* ssq = WSP(float, WS_SSQ);
      for (int t = gw; t < T; t += NGW) { const int b = t / L, pos = t % L;
          const float* src = pos < NMETA ? c.in[1] + (size_t)pos * D : c.in[0] + ((size_t)b * SEQ + (pos - NMETA)) * D;
          float s = 0.f;
#pragma unroll
          for (int j = 0; j < 4; ++j) { const f32x4 v = *(const f32x4*)(src + j * 256 + c.lane * 4); *(f32x4*)(h + (size_t)t * D + j * 256 + c.lane * 4) = v;
              u32x2 o; o.x = pk2(v.x, v.y); o.y = pk2(v.z, v.w); *(u32x2*)(hb + (size_t)t * D + j * 256 + c.lane * 4) = o; s += (v.x * v.x + v.y * v.y) + (v.z * v.z + v.w * v.w); }
          s = wave_sum(s);
          if (c.lane < 8) ssq[(size_t)t * 8 + c.lane] = c.lane == 0 ? s : 0.f; } }
}

__device__ __forceinline__ void phase_A(const Ctx& c0, int l) {
    Ctx c = reopaque(c0);
    const bf16* hb = WSP(bf16, WS_HB); const bf16* Wt = (const bf16*)(c.ws + WS_WIN + l * SZ_WLAYER);
    const float* ssq = WSP(float, WS_SSQ);
    bf16* uglu = WSP(bf16, WS_UGLU); bf16* cq = WSP(bf16, WS_CQ); bf16* ckv = WSP(bf16, WS_CKV); float* krope = WSP(float, WS_KROPE);
    float* ssqq = WSP(float, WS_SSQQ); float* ssqkv = WSP(float, WS_SSQKV); bf16* gates = WSP(bf16, WS_GATES);
    constexpr int NT = NINP / 128;
    const int r = c.lane & 15, q = c.lane >> 4;
    for (int it = c.vb; it < MT * NT; it += c.G) {
        const int mt = it / NT, nt = it % NT;
        f32x4 acc[2][8]; acc_zero(acc);
        gemm_core(acc, hb + (size_t)mt * 128 * D, D, Wt + (size_t)nt * 128 * D, D, D, c.lds, c.tid);
#pragma unroll
        for (int mi = 0; mi < 2; ++mi) {
            const int tok = mt * 128 + 32 * c.wave + 16 * mi + r;
            const float rs = rstd_from_ssq8(ssq, tok);
            if (nt < 8) {
#pragma unroll
                for (int ni = 0; ni < 4; ++ni) { const f32x4 v = acc[mi][ni] * rs, g = acc[mi][ni + 4] * rs;
                    u32x2 o; o.x = pk2(v.x * sigmoidf_(g.x), v.y * sigmoidf_(g.y)); o.y = pk2(v.z * sigmoidf_(g.z), v.w * sigmoidf_(g.w));
                    *(u32x2*)(uglu + (size_t)tok * DC + nt * 64 + 16 * ni + 4 * q) = o; }
            } else if (nt < 11) {
                bf16* dst = nt < 10 ? cq + (size_t)tok * QL + (nt - 8) * 128 : ckv + (size_t)tok * KVL;
                float ss = 0.f;
#pragma unroll
                for (int ni = 0; ni < 8; ++ni) { const f32x4 v = acc[mi][ni] * rs; ss += (v.x * v.x + v.y * v.y) + (v.z * v.z + v.w * v.w);
                    u32x2 o; o.x = pk2(v.x, v.y); o.y = pk2(v.z, v.w); *(u32x2*)(dst + 16 * ni + 4 * q) = o; }
                ss = quad_sum(ss);
                if (q == 0) { if (nt < 10) ssqq[(size_t)tok * 2 + (nt - 8)] = ss; else ssqkv[tok] = ss; }
            } else if (nt == 11) {
#pragma unroll
                for (int ni = 0; ni < 2; ++ni) *(f32x4*)(krope + (size_t)tok * 32 + 16 * ni + 4 * q) = acc[mi][ni] * rs;
            } else {
#pragma unroll
                for (int ni = 0; ni < 8; ++ni) { const f32x4 v = acc[mi][ni] * rs;
                    u32x2 o; o.x = pk2(sigmoidf_(v.x), sigmoidf_(v.y)); o.y = pk2(sigmoidf_(v.z), sigmoidf_(v.w));
                    *(u32x2*)(gates + (size_t)tok * 2048 + (nt - 12) * 128 + 16 * ni + 4 * q) = o; }
            }
        }
    }
}

__device__ __forceinline__ void phaseB_q_item(Ctx& c, int l, int mt, int head) {
    const bf16* cq = WSP(bf16, WS_CQ); const bf16* Wt = (const bf16*)(c.ws + WS_WIN + l * SZ_WLAYER + OFF_WUQ);
    const float* ssqq = WSP(float, WS_SSQQ); const float* rope = WSP(float, WS_ROPE); const float* qg = c.in[13] + l * QK; bf16* Qb = WSP(bf16, WS_Q);
    const int r = c.lane & 15, q = c.lane >> 4;
    f32x4 acc[2][8]; acc_zero(acc);
    gemm_core(acc, cq + (size_t)mt * 128 * QL, QL, Wt + (size_t)head * 128 * QL, QL, QL, c.lds, c.tid);
    constexpr float QSCALE = 0.10206207261596575f * 1.4426950408889634f;
#pragma unroll
    for (int mi = 0; mi < 2; ++mi) {
        const int tok = mt * 128 + 32 * c.wave + 16 * mi + r, b = tok / L, pos = tok - b * L;
        const float rs = rsqrt_((ssqq[(size_t)tok * 2] + ssqq[(size_t)tok * 2 + 1]) * (1.0f / 256.0f) + EPS);
        float ss = 0.f;
#pragma unroll
        for (int ni = 0; ni < 6; ++ni) { acc[mi][ni] = acc[mi][ni] * rs; const f32x4 v = acc[mi][ni]; ss += (v.x * v.x + v.y * v.y) + (v.z * v.z + v.w * v.w); }
        ss = quad_sum(ss);
        const float rn = rsqrt_(ss * (1.0f / 96.0f) + EPS) * QSCALE;
#pragma unroll
        for (int ni = 0; ni < 6; ++ni) { const f32x4 g = *(const f32x4*)(qg + 16 * ni + 4 * q); acc[mi][ni] = acc[mi][ni] * g * rn; }
        const f32x4 cs0 = *(const f32x4*)(rope + ((size_t)pos * 16 + 4 * q) * 2), cs1 = *(const f32x4*)(rope + ((size_t)pos * 16 + 4 * q) * 2 + 4);
        const float co[4] = {cs0.x, cs0.z, cs1.x, cs1.z}, si[4] = {cs0.y, cs0.w, cs1.y, cs1.w};
        f32x4 x1 = acc[mi][4], x2 = acc[mi][5];
#pragma unroll
        for (int e = 0; e < 4; ++e) { const float a = x1[e], bb = x2[e]; x1[e] = a * co[e] - bb * si[e]; x2[e] = bb * co[e] + a * si[e]; }
        acc[mi][4] = x1; acc[mi][5] = x2;
        bf16* dst = Qb + (((size_t)b * NH + head) * L + pos) * QK;
#pragma unroll
        for (int ni = 0; ni < 6; ++ni) { const f32x4 v = acc[mi][ni]; u32x2 o; o.x = pk2(v.x, v.y); o.y = pk2(v.z, v.w); *(u32x2*)(dst + 16 * ni + 4 * q) = o; }
    }
}
__device__ __forceinline__ void phaseB_kv_item(Ctx& c, int l, int mt, int head) {
    const bf16* ckv = WSP(bf16, WS_CKV); const bf16* Wt = (const bf16*)(c.ws + WS_WIN + l * SZ_WLAYER + OFF_WUKV);
    const float* ssqkv = WSP(float, WS_SSQKV); const float* rope = WSP(float, WS_ROPE); const float* kg = c.in[14] + l * QK; const float* krope = WSP(float, WS_KROPE);
    bf16* Kb = WSP(bf16, WS_K); bf16* Vt = WSP(bf16, WS_VT);
    const int tid = c.tid, wave = c.wave, lane = c.lane, r = lane & 15, q = lane >> 4;
    unsigned char* lds = c.lds;
    f32x4 ak[2][4], av[2][4];
#pragma unroll
    for (int mi = 0; mi < 2; ++mi)
#pragma unroll
        for (int ni = 0; ni < 4; ++ni) { ak[mi][ni] = (f32x4){0.f, 0.f, 0.f, 0.f}; av[mi][ni] = (f32x4){0.f, 0.f, 0.f, 0.f}; }
    { const int chunk = tid & 7, row0 = tid >> 3;
      const bf16* pa = ckv + ((size_t)mt * 128 + row0) * KVL + chunk * 8; const bf16* pb = Wt + ((size_t)head * 128 + row0) * KVL + chunk * 8;
#pragma unroll
      for (int s = 0; s < 2; ++s)
#pragma unroll
          for (int i = 0; i < 4; ++i) { *(u32x4*)(lds + s * 32768 + lds_off(row0 + 32 * i, chunk)) = *(const u32x4*)(pa + (size_t)(32 * i) * KVL + s * 64);
              *(u32x4*)(lds + s * 32768 + 16384 + lds_off(row0 + 32 * i, chunk)) = *(const u32x4*)(pb + (size_t)(32 * i) * KVL + s * 64); }
    }
    __syncthreads();
#pragma unroll
    for (int s = 0; s < 2; ++s)
#pragma unroll
        for (int ks = 0; ks < 2; ++ks) {
            const unsigned char* sA = lds + s * 32768; const unsigned char* sB = sA + 16384;
            bf16x8 af[2], bfr[8];
#pragma unroll
            for (int mi = 0; mi < 2; ++mi) af[mi] = *(const bf16x8*)(sA + lds_off(32 * wave + 16 * mi + r, 4 * ks + q));
#pragma unroll
            for (int ni = 0; ni < 8; ++ni) bfr[ni] = *(const bf16x8*)(sB + lds_off(16 * ni + r, 4 * ks + q));
#pragma unroll
            for (int mi = 0; mi < 2; ++mi)
#pragma unroll
                for (int ni = 0; ni < 4; ++ni) { ak[mi][ni] = __builtin_amdgcn_mfma_f32_16x16x32_bf16(bfr[ni], af[mi], ak[mi][ni], 0, 0, 0);
                    av[mi][ni] = __builtin_amdgcn_mfma_f32_16x16x32_bf16(af[mi], bfr[ni + 4], av[mi][ni], 0, 0, 0); }
        }
    __syncthreads();
#pragma unroll
    for (int mi = 0; mi < 2; ++mi) {
        const int tok0 = mt * 128 + 32 * wave + 16 * mi, b = tok0 / L, pos0 = tok0 - b * L;
        { const int tok = tok0 + r, pos = pos0 + r;
          const float rs = rsqrt_(ssqkv[tok] * (1.0f / 128.0f) + EPS);
          const f32x4 kr1 = *(const f32x4*)(krope + (size_t)tok * 32 + 4 * q), kr2 = *(const f32x4*)(krope + (size_t)tok * 32 + 16 + 4 * q);
          float ss = (kr1.x * kr1.x + kr1.y * kr1.y) + (kr1.z * kr1.z + kr1.w * kr1.w) + (kr2.x * kr2.x + kr2.y * kr2.y) + (kr2.z * kr2.z + kr2.w * kr2.w);
#pragma unroll
          for (int ni = 0; ni < 4; ++ni) { ak[mi][ni] = ak[mi][ni] * rs; const f32x4 v = ak[mi][ni]; ss += (v.x * v.x + v.y * v.y) + (v.z * v.z + v.w * v.w); }
          ss = quad_sum(ss);
          const float rn = rsqrt_(ss * (1.0f / 96.0f) + EPS);
          bf16* dst = Kb + (((size_t)b * NH + head) * L + pos) * QK;
#pragma unroll
          for (int ni = 0; ni < 4; ++ni) { const f32x4 g = *(const f32x4*)(kg + 16 * ni + 4 * q); const f32x4 v = ak[mi][ni] * g * rn;
              u32x2 o; o.x = pk2(v.x, v.y); o.y = pk2(v.z, v.w); *(u32x2*)(dst + 16 * ni + 4 * q) = o; }
          const f32x4 g1 = *(const f32x4*)(kg + 64 + 4 * q), g2 = *(const f32x4*)(kg + 80 + 4 * q);
          f32x4 x1 = kr1 * g1 * rn, x2 = kr2 * g2 * rn;
          const f32x4 cs0 = *(const f32x4*)(rope + ((size_t)pos * 16 + 4 * q) * 2), cs1 = *(const f32x4*)(rope + ((size_t)pos * 16 + 4 * q) * 2 + 4);
          const float co[4] = {cs0.x, cs0.z, cs1.x, cs1.z}, si[4] = {cs0.y, cs0.w, cs1.y, cs1.w};
#pragma unroll
          for (int e = 0; e < 4; ++e) { const float a = x1[e], bb = x2[e]; x1[e] = a * co[e] - bb * si[e]; x2[e] = bb * co[e] + a * si[e]; }
          u32x2 o1, o2; o1.x = pk2(x1.x, x1.y); o1.y = pk2(x1.z, x1.w); o2.x = pk2(x2.x, x2.y); o2.y = pk2(x2.z, x2.w);
          *(u32x2*)(dst + 64 + 4 * q) = o1; *(u32x2*)(dst + 80 + 4 * q) = o2; }
        { const f32x4 sq = *(const f32x4*)(ssqkv + tok0 + 4 * q);
          f32x4 rs4; rs4.x = rsqrt_(sq.x * (1.0f / 128.0f) + EPS); rs4.y = rsqrt_(sq.y * (1.0f / 128.0f) + EPS); rs4.z = rsqrt_(sq.z * (1.0f / 128.0f) + EPS); rs4.w = rsqrt_(sq.w * (1.0f / 128.0f) + EPS);
#pragma unroll
          for (int ni = 0; ni < 4; ++ni) { const f32x4 v = av[mi][ni] * rs4; u32x2 o; o.x = pk2(v.x, v.y); o.y = pk2(v.z, v.w);
              *(u32x2*)(Vt + (((size_t)b * NH + head) * VD + 16 * ni + r) * L + pos0 + 4 * q) = o; } }
    }
}
__device__ __forceinline__ u32x4 conv_row(const bf16* uglu, int b, int pos, int ch) {
    u32x4 xv = (u32x4){0u, 0u, 0u, 0u};
    if (pos >= 0) xv = *(const u32x4*)(uglu + ((size_t)b * L + pos) * DC + ch);
    return xv;
}
__device__ __forceinline__ void conv_fma(float (&a)[8], const u32x4 xv, const f32x4 w0, const f32x4 w1) {
    a[0] += bf_lo(xv.x) * w0.x; a[1] += bf_hi(xv.x) * w0.y; a[2] += bf_lo(xv.y) * w0.z; a[3] += bf_hi(xv.y) * w0.w;
    a[4] += bf_lo(xv.z) * w1.x; a[5] += bf_hi(xv.z) * w1.y; a[6] += bf_lo(xv.w) * w1.z; a[7] += bf_hi(xv.w) * w1.w;
}
__device__ __forceinline__ void phaseB_conv_item(Ctx& c, int l, int grp) {
    const bf16* uglu = WSP(bf16, WS_UGLU); bf16* u2 = WSP(bf16, WS_U2);
    const float* cw = c.in[4] + (size_t)l * CW * DC; const float* cb = c.in[5] + l * DC; const float* lg = c.in[6] + l * DC; const float* lb = c.in[7] + l * DC;
    const int tok0 = grp * 4, b = tok0 / L, pos0 = tok0 - b * L, ch = c.lane * 8;
    float acc[4][8];
    { const f32x4 b0 = *(const f32x4*)(cb + ch), b1 = *(const f32x4*)(cb + ch + 4);
#pragma unroll
      for (int d = 0; d < 4; ++d) { acc[d][0] = b0.x; acc[d][1] = b0.y; acc[d][2] = b0.z; acc[d][3] = b0.w; acc[d][4] = b1.x; acc[d][5] = b1.y; acc[d][6] = b1.z; acc[d][7] = b1.w; } }
    const int base = pos0 - 30;
    u32x4 x0 = conv_row(uglu, b, base + 0, ch), x1 = conv_row(uglu, b, base + 1, ch), x2 = conv_row(uglu, b, base + 2, ch),
          x3 = conv_row(uglu, b, base + 3, ch), x4 = conv_row(uglu, b, base + 4, ch), x5;
    const float* wp = cw + ch;
#pragma unroll 1
    for (int w = 0; w < CW; ++w) {
        x5 = conv_row(uglu, b, (w + 5 <= 33) ? base + w + 5 : -1, ch);
        const f32x4 w0 = *(const f32x4*)wp, w1 = *(const f32x4*)(wp + 4); wp += DC;
        conv_fma(acc[0], x0, w0, w1); conv_fma(acc[1], x1, w0, w1); conv_fma(acc[2], x2, w0, w1); conv_fma(acc[3], x3, w0, w1);
        x0 = x1; x1 = x2; x2 = x3; x3 = x4; x4 = x5;
    }
    const f32x4 g0 = *(const f32x4*)(lg + ch), g1 = *(const f32x4*)(lg + ch + 4), e0 = *(const f32x4*)(lb + ch), e1 = *(const f32x4*)(lb + ch + 4);
    const float gg[8] = {g0.x, g0.y, g0.z, g0.w, g1.x, g1.y, g1.z, g1.w}, be[8] = {e0.x, e0.y, e0.z, e0.w, e1.x, e1.y, e1.z, e1.w};
#pragma unroll
    for (int d = 0; d < 4; ++d) {
        float s = 0.f;
#pragma unroll
        for (int j = 0; j < 8; ++j) s += acc[d][j];
        const float mu = wave_sum(s) * (1.0f / 512.0f);
        float vq = 0.f;
#pragma unroll
        for (int j = 0; j < 8; ++j) { acc[d][j] -= mu; vq += acc[d][j] * acc[d][j]; }
        const float rstd = rsqrt_(wave_sum(vq) * (1.0f / 512.0f) + EPS);
        float y[8];
#pragma unroll
        for (int j = 0; j < 8; ++j) { const float v = acc[d][j] * rstd * gg[j] + be[j]; y[j] = v * sigmoidf_(v); }
        u32x4 o; o.x = pk2(y[0], y[1]); o.y = pk2(y[2], y[3]); o.z = pk2(y[4], y[5]); o.w = pk2(y[6], y[7]);
        *(u32x4*)(u2 + (size_t)(tok0 + d) * DC + ch) = o;
    }
}
__device__ __forceinline__ void phase_B(const Ctx& c0, int l) {
    Ctx c = reopaque(c0);
    constexpr int NQ = MT * NH, NKV = MT * NH, NCV = T / 16;
    for (int it = c.vb; it < NQ + NKV + NCV; it += c.G) {
        if (it < NQ) phaseB_q_item(c, l, it / NH, it % NH);
        else if (it < NQ + NKV) phaseB_kv_item(c, l, (it - NQ) / NH, (it - NQ) % NH);
        else phaseB_conv_item(c, l, (it - NQ - NKV) * 4 + c.wave);
    }
}

constexpr int KROW = 208, VROW = 136, ATT_STAGE = 64 * KROW + 64 * VROW;
constexpr int ATT_ITEMS = NB * NH * 17;
__device__ __forceinline__ void phase_C(const Ctx& c0, int l) {
    Ctx c = reopaque(c0);
    const bf16* Qb = WSP(bf16, WS_Q); const bf16* Kb = WSP(bf16, WS_K); const bf16* Vt = WSP(bf16, WS_VT); bf16* O = WSP(bf16, WS_O);
    unsigned* qctr = WSP(unsigned, WS_CTL) + CW_QUEUE + 64 * l;
    volatile unsigned* misc = (volatile unsigned*)(c.lds + LDS_MISC);
    const int tid = c.tid, wave = c.wave, lane = c.lane, r = lane & 15, q = lane >> 4;
    unsigned char* lds = c.lds;
    for (;;) {
        if (tid == 0) misc[4] = atomicAdd(qctr, 1u);
        __syncthreads();
        const int item = __builtin_amdgcn_readfirstlane((int)misc[4]);
        __syncthreads();
        if (item >= ATT_ITEMS) break;
        const int pp = 15 - item / 64, bh = item % 64, b = bh / NH, h = bh % NH;
        const bool meta = pp < 0;
        const int r0 = meta ? 0 : 16 + 128 * pp;
        const int nfull = meta ? 0 : 2 * pp + 1 + (wave >> 1);
        const int ntiles = meta ? 1 : 2 * pp + 3;
        const bf16* Kbase = Kb + (size_t)bh * L * QK; const bf16* Vbase = Vt + (size_t)bh * VD * L;
        bf16x8 qf[2][3];
#pragma unroll
        for (int mi = 0; mi < 2; ++mi)
#pragma unroll
            for (int ks = 0; ks < 3; ++ks) qf[mi][ks] = *(const bf16x8*)(Qb + ((size_t)bh * L + r0 + 32 * wave + 16 * mi + r) * QK + 32 * ks + 8 * q);
        float m[2] = {-1e30f, -1e30f}, lsum[2] = {0.f, 0.f};
        f32x4 o[2][4];
#pragma unroll
        for (int mi = 0; mi < 2; ++mi)
#pragma unroll
            for (int dt = 0; dt < 4; ++dt) o[mi][dt] = (f32x4){0.f, 0.f, 0.f, 0.f};
        u32x4 rk[3], rv[2];
        auto gload = [&](int kt) {
#pragma unroll
            for (int i = 0; i < 3; ++i) { const int id = tid + 256 * i, row = id / 12, cc = id % 12; rk[i] = *(const u32x4*)(Kbase + (size_t)(kt * 64 + row) * QK + cc * 8); }
#pragma unroll
            for (int i = 0; i < 2; ++i) { const int id = tid + 256 * i, row = id >> 3, cc = id & 7; rv[i] = *(const u32x4*)(Vbase + (size_t)row * L + kt * 64 + cc * 8); }
        };
        auto lstore = [&](int s) {
            unsigned char* st = lds + s * ATT_STAGE;
#pragma unroll
            for (int i = 0; i < 3; ++i) { const int id = tid + 256 * i, row = id / 12, cc = id % 12; *(u32x4*)(st + row * KROW + cc * 16) = rk[i]; }
#pragma unroll
            for (int i = 0; i < 2; ++i) { const int id = tid + 256 * i, row = id >> 3, cc = id & 7; u32x2* d = (u32x2*)(st + 64 * KROW + row * VROW + cc * 16); d[0] = (u32x2){rv[i].x, rv[i].y}; d[1] = (u32x2){rv[i].z, rv[i].w}; }
        };
        gload(0); lstore(0);
#pragma unroll
        for (int mi = 0; mi < 2; ++mi)
#pragma unroll
            for (int ks = 0; ks < 3; ++ks) asm volatile("" : "+v"(qf[mi][ks]));
        __syncthreads();
        for (int kt = 0; kt < ntiles; ++kt) {
            const int cur = kt & 1;
            if (kt + 1 < ntiles) gload(kt + 1);
            const unsigned char* sK = lds + cur * ATT_STAGE; const unsigned char* sV = sK + 64 * KROW;
            const bool full = kt < nfull;
            if (kt <= nfull) {
                f32x4 s[2][4];
#pragma unroll
                for (int kh = 0; kh < 2; ++kh) {
                    bf16x8 kf[2][3];
#pragma unroll
                    for (int kk = 0; kk < 2; ++kk) if ((kh == 0 && kk == 0) || full) {
#pragma unroll
                        for (int ks = 0; ks < 3; ++ks) kf[kk][ks] = *(const bf16x8*)(sK + (16 * (2 * kh + kk) + r) * KROW + 64 * ks + 16 * q); }
#pragma unroll
                    for (int kk = 0; kk < 2; ++kk) { const int k4 = 2 * kh + kk;
#pragma unroll
                        for (int mi = 0; mi < 2; ++mi) s[mi][k4] = (f32x4){0.f, 0.f, 0.f, 0.f};
                        if (k4 == 0 || full) {
#pragma unroll
                            for (int ks = 0; ks < 3; ++ks)
#pragma unroll
                                for (int mi = 0; mi < 2; ++mi) s[mi][k4] = __builtin_amdgcn_mfma_f32_16x16x32_bf16(kf[kk][ks], qf[mi][ks], s[mi][k4], 0, 0, 0);
                        }
                    }
                }
                u32x2 vlo[4], vhi[4];
#pragma unroll
                for (int dt = 0; dt < 4; ++dt) { const unsigned char* vp = sV + (16 * dt + r) * VROW + (4 * q) * 2;
                    vlo[dt] = *(const u32x2*)vp; vhi[dt] = (u32x2){0u, 0u}; if (full) vhi[dt] = *(const u32x2*)(vp + 32); }
                bf16x8 pf[2][2];
#pragma unroll
                for (int mi = 0; mi < 2; ++mi) {
                    float mx = fmaxf(fmaxf(s[mi][0].x, s[mi][0].y), fmaxf(s[mi][0].z, s[mi][0].w));
                    if (full) {
#pragma unroll
                        for (int k4 = 1; k4 < 4; ++k4) mx = fmaxf(mx, fmaxf(fmaxf(s[mi][k4].x, s[mi][k4].y), fmaxf(s[mi][k4].z, s[mi][k4].w)));
                    }
                    mx = quad_max(mx);
                    const float mn = fmaxf(m[mi], mx), alpha = fast_exp2(m[mi] - mn); m[mi] = mn;
                    float ps = 0.f;
#pragma unroll
                    for (int k4 = 0; k4 < 4; ++k4) {
                        if (k4 == 0 || full) { f32x4 p; p.x = fast_exp2(s[mi][k4].x - mn); p.y = fast_exp2(s[mi][k4].y - mn); p.z = fast_exp2(s[mi][k4].z - mn); p.w = fast_exp2(s[mi][k4].w - mn);
                            ps += (p.x + p.y) + (p.z + p.w); s[mi][k4] = p; }
                    }
                    lsum[mi] = lsum[mi] * alpha + ps;
#pragma unroll
                    for (int dt = 0; dt < 4; ++dt) o[mi][dt] = o[mi][dt] * alpha;
#pragma unroll
                    for (int st = 0; st < 2; ++st) { u32x4 pw;
                        pw.x = pk2(s[mi][2 * st].x, s[mi][2 * st].y); pw.y = pk2(s[mi][2 * st].z, s[mi][2 * st].w); pw.z = pk2(s[mi][2 * st + 1].x, s[mi][2 * st + 1].y); pw.w = pk2(s[mi][2 * st + 1].z, s[mi][2 * st + 1].w);
                        if (!full) { pw.z = 0u; pw.w = 0u; }
                        pf[mi][st] = __builtin_bit_cast(bf16x8, pw); }
                }
                u32x2 wlo[4], whi[4];
                if (full) {
#pragma unroll
                    for (int dt = 0; dt < 4; ++dt) { const unsigned char* vp = sV + (16 * dt + r) * VROW + (32 + 4 * q) * 2; wlo[dt] = *(const u32x2*)vp; whi[dt] = *(const u32x2*)(vp + 32); } }
#pragma unroll
                for (int dt = 0; dt < 4; ++dt) { const bf16x8 vf = __builtin_bit_cast(bf16x8, (u32x4){vlo[dt].x, vlo[dt].y, vhi[dt].x, vhi[dt].y});
#pragma unroll
                    for (int mi = 0; mi < 2; ++mi) o[mi][dt] = __builtin_amdgcn_mfma_f32_16x16x32_bf16(vf, pf[mi][0], o[mi][dt], 0, 0, 0); }
                if (full) {
#pragma unroll
                    for (int dt = 0; dt < 4; ++dt) { const bf16x8 vf = __builtin_bit_cast(bf16x8, (u32x4){wlo[dt].x, wlo[dt].y, whi[dt].x, whi[dt].y});
#pragma unroll
                        for (int mi = 0; mi < 2; ++mi) o[mi][dt] = __builtin_amdgcn_mfma_f32_16x16x32_bf16(vf, pf[mi][1], o[mi][dt], 0, 0, 0); } }
            }
            if (kt + 1 < ntiles) lstore(cur ^ 1);
            __syncthreads();
        }
#pragma unroll
        for (int mi = 0; mi < 2; ++mi) {
            const float lt = quad_sum(lsum[mi]);
            if (!meta || (wave == 0 && mi == 0)) {
                const float inv = 1.0f / lt;
                bf16* dst = O + ((size_t)b * L + r0 + 32 * wave + 16 * mi + r) * 512 + h * VD;
#pragma unroll
                for (int dt = 0; dt < 4; ++dt) { const f32x4 v = o[mi][dt] * inv; u32x2 ov; ov.x = pk2(v.x, v.y); ov.y = pk2(v.z, v.w); *(u32x2*)(dst + 16 * dt + 4 * q) = ov; }
            }
        }
    }
}

__device__ __forceinline__ int tile_tok0(int mt, int l) { return l == 1 ? mt * 128 + NMETA * ((mt >> 4) + 1) : mt * 128; }
__device__ __forceinline__ int n_mtiles(int l) { return l == 1 ? 128 : MT; }
__device__ __forceinline__ void phase_D(const Ctx& c0, int l) {
    Ctx c = reopaque(c0);
    const bf16* u2 = WSP(bf16, WS_U2); const bf16* O = WSP(bf16, WS_O); const bf16* gates = WSP(bf16, WS_GATES); bf16* merged = WSP(bf16, WS_MERGED);
    const bf16* Wco = (const bf16*)(c.ws + WS_WIN + l * SZ_WLAYER + OFF_WCO); const bf16* Wmla = (const bf16*)(c.ws + WS_WIN + l * SZ_WLAYER + OFF_WMLA);
    const int r = c.lane & 15, q = c.lane >> 4;
    for (int it = c.vb; it < n_mtiles(l) * 8; it += c.G) {
        const int mt = it / 8, nt = it % 8, tk0 = tile_tok0(mt, l);
        f32x4 acc[2][8]; acc_zero(acc);
        gemm_core(acc, u2 + (size_t)tk0 * 512, 512, Wco + (size_t)nt * 128 * 512, 512, 512, c.lds, c.tid);
#pragma unroll
        for (int mi = 0; mi < 2; ++mi) { const int tok = tk0 + 32 * c.wave + 16 * mi + r;
            const bf16* gp = gates + (size_t)tok * 2048 + nt * 128 + 4 * q; bf16* mp = merged + (size_t)tok * D + nt * 128 + 4 * q;
#pragma unroll
            for (int ni = 0; ni < 8; ++ni) { const u32x2 g = *(const u32x2*)(gp + 16 * ni); const f32x4 v = acc[mi][ni];
                u32x2 o; o.x = pk2(v.x * bf_lo(g.x), v.y * bf_hi(g.x)); o.y = pk2(v.z * bf_lo(g.y), v.w * bf_hi(g.y)); *(u32x2*)(mp + 16 * ni) = o; } }
        acc_zero(acc);
        gemm_core(acc, O + (size_t)tk0 * 512, 512, Wmla + (size_t)nt * 128 * 512, 512, 512, c.lds, c.tid);
#pragma unroll
        for (int mi = 0; mi < 2; ++mi) { const int tok = tk0 + 32 * c.wave + 16 * mi + r;
            const bf16* gp = gates + (size_t)tok * 2048 + 1024 + nt * 128 + 4 * q; bf16* mp = merged + (size_t)tok * D + nt * 128 + 4 * q;
#pragma unroll
            for (int ni = 0; ni < 8; ++ni) { const u32x2 g = *(const u32x2*)(gp + 16 * ni); const u32x2 s = *(const u32x2*)(mp + 16 * ni); const f32x4 v = acc[mi][ni];
                u32x2 o; o.x = pk2(bf_lo(s.x) + v.x * bf_lo(g.x), bf_hi(s.x) + v.y * bf_hi(g.x)); o.y = pk2(bf_lo(s.y) + v.z * bf_lo(g.y), bf_hi(s.y) + v.w * bf_hi(g.y));
                *(u32x2*)(mp + 16 * ni) = o; } }
    }
}

__device__ __forceinline__ void phase_E(const Ctx& c0, int l) {
    Ctx c = reopaque(c0);
    const bf16* merged = WSP(bf16, WS_MERGED); const bf16* Wout = (const bf16*)(c.ws + WS_WIN + l * SZ_WLAYER + OFF_WOUT);
    float* h = WSP(float, WS_H); bf16* hb = WSP(bf16, WS_HB); float* ssq = WSP(float, WS_SSQ);
    const int r = c.lane & 15, q = c.lane >> 4;
    for (int it = c.vb; it < n_mtiles(l) * 8; it += c.G) {
        const int mt = it / 8, nt = it % 8, tk0 = tile_tok0(mt, l);
        f32x4 acc[2][8]; acc_zero(acc);
        gemm_core(acc, merged + (size_t)tk0 * D, D, Wout + (size_t)nt * 128 * D, D, D, c.lds, c.tid);
#pragma unroll
        for (int mi = 0; mi < 2; ++mi) { const int tok = tk0 + 32 * c.wave + 16 * mi + r; float ss = 0.f;
#pragma unroll
            for (int ni = 0; ni < 8; ++ni) { float* hp = h + (size_t)tok * D + nt * 128 + 16 * ni + 4 * q; const f32x4 v = *(const f32x4*)hp + acc[mi][ni]; *(f32x4*)hp = v;
                ss += (v.x * v.x + v.y * v.y) + (v.z * v.z + v.w * v.w);
                u32x2 o; o.x = pk2(v.x, v.y); o.y = pk2(v.z, v.w); *(u32x2*)(hb + (size_t)tok * D + nt * 128 + 16 * ni + 4 * q) = o; }
            ss = quad_sum(ss);
            if (q == 0) ssq[(size_t)tok * 8 + nt] = ss; }
    }
}

__device__ __forceinline__ unsigned f2key(float f) { const unsigned u = __float_as_uint(f); return u ^ ((u >> 31) ? 0xFFFFFFFFu : 0x80000000u); }
__device__ __forceinline__ float key2f(unsigned k) { const unsigned u = (k >> 31) ? (k ^ 0x80000000u) : ~k; return __uint_as_float(u); }
__device__ __forceinline__ void top16_insert(unsigned (&lst)[16], unsigned x) {
#pragma unroll
    for (int i = 0; i < 16; ++i) { const unsigned a = lst[i]; lst[i] = a > x ? a : x; x = a > x ? x : a; }
}
__device__ __forceinline__ void ce_desc(unsigned& a, unsigned& b) { const unsigned mx = a > b ? a : b, mn = a > b ? b : a; a = mx; b = mn; }
__device__ __forceinline__ void sort16_desc(unsigned (&v)[16]) {
#pragma unroll
    for (int k = 2; k <= 16; k <<= 1)
#pragma unroll
        for (int j = k >> 1; j > 0; j >>= 1)
#pragma unroll
            for (int i = 0; i < 16; ++i) { const int p = i ^ j; if (p > i) { if ((i & k) == 0) ce_desc(v[i], v[p]); else ce_desc(v[p], v[i]); } }
}
__device__ __forceinline__ void merge_top16(unsigned (&a)[16], const unsigned (&b)[16]) {
#pragma unroll
    for (int i = 0; i < 16; ++i) a[i] = a[i] > b[15 - i] ? a[i] : b[15 - i];
#pragma unroll
    for (int j = 8; j > 0; j >>= 1)
#pragma unroll
        for (int i = 0; i < 16; ++i) { const int p = i ^ j; if (p > i) ce_desc(a[i], a[p]); }
}
__device__ __forceinline__ void phase_F(const Ctx& c0, int l) {
    Ctx c = reopaque(c0);
    const bf16* hb = WSP(bf16, WS_HB); const bf16* Wpq = (const bf16*)(c.ws + WS_WIN + l * SZ_WLAYER + OFF_WPQ); const bf16* keys = (const bf16*)(c.ws + WS_WIN + l * SZ_WLAYER + OFF_KEYS);
    const float* ssq = WSP(float, WS_SSQ); float* sv = WSP(float, WS_SV); unsigned char* si = WSP(unsigned char, WS_SI);
    const int tid = c.tid, wave = c.wave, lane = c.lane, r = lane & 15, q = lane >> 4;
    unsigned char* lds = c.lds;
    for (int it = c.vb; it < n_mtiles(l) * 16; it += c.G) {
        const int mt = it / 16, hp = it % 16, tk0 = tile_tok0(mt, l);
        f32x4 acc[2][8]; acc_zero(acc);
        gemm_core(acc, hb + (size_t)tk0 * D, D, Wpq + (size_t)hp * 128 * D, D, D, lds, tid);
#pragma unroll
        for (int mi = 0; mi < 2; ++mi) { const int row = 32 * wave + 16 * mi + r; const float rs = rstd_from_ssq8(ssq, tk0 + row);
#pragma unroll
            for (int ni = 0; ni < 8; ++ni) { const f32x4 v = acc[mi][ni] * rs; u32x2 o; o.x = pk2(v.x, v.y); o.y = pk2(v.z, v.w);
                *(u32x2*)(lds + (ni >> 2) * 32768 + lds_off(row, 2 * (ni & 3) + (q >> 1)) + 8 * (q & 1)) = o; } }
        { const int chunk = tid & 7, row0 = tid >> 3; const bf16* pb = keys + ((size_t)hp * 128 + row0) * 128 + chunk * 8;
#pragma unroll
          for (int s = 0; s < 2; ++s)
#pragma unroll
              for (int i = 0; i < 4; ++i) *(u32x4*)(lds + s * 32768 + 16384 + lds_off(row0 + 32 * i, chunk)) = *(const u32x4*)(pb + (size_t)(32 * i) * 128 + s * 64); }
        __syncthreads();
        acc_zero(acc);
        gemm_compute_stage(acc, lds, lds + 16384, wave, lane);
        gemm_compute_stage(acc, lds + 32768, lds + 32768 + 16384, wave, lane);
        __syncthreads();
        float* S = (float*)lds;
#pragma unroll
        for (int mi = 0; mi < 2; ++mi) { const int row = 32 * wave + 16 * mi + r;
#pragma unroll
            for (int ni = 0; ni < 8; ++ni) *(f32x4*)(S + row * 132 + 16 * ni + 4 * q) = acc[mi][ni]; }
        __syncthreads();
        {
            const int tl = 32 * wave + (lane & 31), half = lane >> 5;
            const float* row = S + tl * 132;
            unsigned lst[16];
#pragma unroll
            for (int g = 0; g < 4; ++g) {
                unsigned cur[16];
#pragma unroll
                for (int j = 0; j < 4; ++j) { const int col = 64 * half + 16 * g + 4 * j; const f32x4 v = *(const f32x4*)(row + col);
                    cur[4 * j] = (f2key(v.x) & ~127u) | (unsigned)(127 - col); cur[4 * j + 1] = (f2key(v.y) & ~127u) | (unsigned)(127 - (col + 1));
                    cur[4 * j + 2] = (f2key(v.z) & ~127u) | (unsigned)(127 - (col + 2)); cur[4 * j + 3] = (f2key(v.w) & ~127u) | (unsigned)(127 - (col + 3)); }
                sort16_desc(cur);
                if (g == 0) {
#pragma unroll
                    for (int i = 0; i < 16; ++i) lst[i] = cur[i];
                } else merge_top16(lst, cur);
            }
            unsigned oth[16];
#pragma unroll
            for (int i = 0; i < 16; ++i) { auto rr = __builtin_amdgcn_permlane32_swap(lst[i], lst[i], false, false); oth[i] = half == 0 ? rr[1] : rr[0]; }
            merge_top16(lst, oth);
            if (half == 0) {
                const int tok = tk0 + tl;
                unsigned idx[16]; float val[16];
#pragma unroll
                for (int i = 0; i < 16; ++i) { idx[i] = 127u - (lst[i] & 127u); val[i] = row[idx[i]]; }
                float* svp = sv + ((size_t)tok * 16 + hp) * 16;
#pragma unroll
                for (int i = 0; i < 4; ++i) *(f32x4*)(svp + 4 * i) = (f32x4){val[4 * i], val[4 * i + 1], val[4 * i + 2], val[4 * i + 3]};
                u32x4 pi;
                pi.x = idx[0] | (idx[1] << 8) | (idx[2] << 16) | (idx[3] << 24); pi.y = idx[4] | (idx[5] << 8) | (idx[6] << 16) | (idx[7] << 24);
                pi.z = idx[8] | (idx[9] << 8) | (idx[10] << 16) | (idx[11] << 24); pi.w = idx[12] | (idx[13] << 8) | (idx[14] << 16) | (idx[15] << 24);
                *(u32x4*)(si + ((size_t)tok * 16 + hp) * 16) = pi;
            }
        }
        __syncthreads();
    }
}

__device__ __forceinline__ void phase_F3(const Ctx& c0, int l) {
    Ctx c = reopaque(c0);
    const float* sv = WSP(float, WS_SV); const unsigned char* si = WSP(unsigned char, WS_SI); int* eidx = WSP(int, WS_EIDX); float* gw = WSP(float, WS_GW); unsigned char* stb = WSP(unsigned char, WS_STB);
    float* lsv = (float*)c.lds;
    unsigned char* lsi = c.lds + 256 * 33 * 4;
    const int tid = c.tid;
    const int ntok = l == 1 ? NB * SEQ : T;
    for (int base = c.vb * NTHREADS; base < ntok * 8; base += c.G * NTHREADS) {
        const int thc = base + tid, tkc = thc >> 3;
        const int th = (l == 1 ? tkc + NMETA * ((tkc >> 11) + 1) : tkc) * 8 + (thc & 7);
        float a[16], b[16];
#pragma unroll
        for (int i = 0; i < 4; ++i) { const f32x4 x = *(const f32x4*)(sv + (size_t)th * 32 + 4 * i), y = *(const f32x4*)(sv + (size_t)th * 32 + 16 + 4 * i);
            a[4 * i] = x.x; a[4 * i + 1] = x.y; a[4 * i + 2] = x.z; a[4 * i + 3] = x.w; b[4 * i] = y.x; b[4 * i + 1] = y.y; b[4 * i + 2] = y.z; b[4 * i + 3] = y.w; }
        const u32x4 ia = *(const u32x4*)(si + (size_t)th * 32), ib = *(const u32x4*)(si + (size_t)th * 32 + 16);
#pragma unroll
        for (int i = 0; i < 16; ++i) { lsv[tid * 33 + i] = a[i]; lsv[tid * 33 + 16 + i] = b[i]; }
        *(u32x4*)(lsi + tid * 32) = ia; *(u32x4*)(lsi + tid * 32 + 16) = ib;
        unsigned lst[16];
#pragma unroll
        for (int i = 0; i < 16; ++i) lst[i] = 0u;
#pragma unroll
        for (int i = 0; i < 16; ++i)
#pragma unroll
            for (int j = 0; j < 16; ++j)
                if ((i + 1) * (j + 1) <= 16) top16_insert(lst, (f2key(a[i] + b[j]) & ~255u) | (unsigned)(255 - (i * 16 + j)));
        __builtin_amdgcn_s_waitcnt(0xC07F); asm volatile("" ::: "memory");
        float s[16]; int e[16];
#pragma unroll
        for (int k = 0; k < 16; ++k) { const unsigned code = 255u - (lst[k] & 255u); const int i = code >> 4, j = code & 15;
            s[k] = lsv[tid * 33 + i] + lsv[tid * 33 + 16 + j]; e[k] = (int)lsi[tid * 32 + i] * 128 + (int)lsi[tid * 32 + 16 + j]; }
        float mx = s[0];
#pragma unroll
        for (int k = 1; k < 16; ++k) mx = fmaxf(mx, s[k]);
        float sum = 0.f;
#pragma unroll
        for (int k = 0; k < 16; ++k) { s[k] = fast_exp2((s[k] - mx) * 1.4426950409f); sum += s[k]; }
        const float inv = 1.0f / sum;
        typedef unsigned long long u64;
        u64 hlo = 0ull, hhi = 0ull;
#pragma unroll
        for (int k = 0; k < 16; ++k) { const int sl = e[k] >> 10; if (sl < 8) hlo += 1ull << (8 * sl); else hhi += 1ull << (8 * (sl - 8)); }
        u64 ilo = hlo, ihi = hhi;
#pragma unroll
        for (int d = 1; d < 8; d <<= 1) { const u64 a_ = __shfl_up(ilo, d, 8), b_ = __shfl_up(ihi, d, 8); if ((tid & 7) >= d) { ilo += a_; ihi += b_; } }
        const u64 tlo = __shfl(ilo, 7, 8), thi = __shfl(ihi, 7, 8);
        const u64 ones = 0x0101010101010101ull;
        const u64 inlo = tlo * ones, inhi = thi * ones + (inlo >> 56) * ones;
        const u64 stlo = inlo - tlo, sthi = inhi - thi;
        u64 rlo = stlo + (ilo - hlo), rhi = sthi + (ihi - hhi);
        const int tokn = th >> 3;
#pragma unroll
        for (int k = 0; k < 16; ++k) { const int sl = e[k] >> 10; int pos;
            if (sl < 8) { pos = (int)((rlo >> (8 * sl)) & 255ull); rlo += 1ull << (8 * sl); } else { pos = (int)((rhi >> (8 * (sl - 8))) & 255ull); rhi += 1ull << (8 * (sl - 8)); }
            eidx[(size_t)tokn * 128 + pos] = e[k]; gw[(size_t)tokn * 128 + pos] = s[k] * inv; }
        if ((tid & 7) == 0) { u64* sp = (u64*)(stb + (size_t)tokn * 16); sp[0] = stlo; sp[1] = sthi; }
        __builtin_amdgcn_s_waitcnt(0xC07F); asm volatile("" ::: "memory");
    }
}

typedef float f32x2 __attribute__((ext_vector_type(2)));
constexpr int G2_WSTRIDE = 14336, G2_MAXTOK = 9;
__device__ __forceinline__ float fp8dot4(unsigned w, unsigned x01, unsigned x23, float acc) {
    const bf16x2 lo = __builtin_amdgcn_cvt_scalef32_pk_bf16_fp8(w, 1.0f, false), hi = __builtin_amdgcn_cvt_scalef32_pk_bf16_fp8(w, 1.0f, true);
    acc = __builtin_amdgcn_fdot2_f32_bf16(lo, __builtin_bit_cast(bf16x2, x01), acc, false);
    return __builtin_amdgcn_fdot2_f32_bf16(hi, __builtin_bit_cast(bf16x2, x23), acc, false);
}
__device__ __forceinline__ float reduce8_transposed(const float (&p)[8], int lane) {
    float s[4];
#pragma unroll
    for (int k = 0; k < 4; ++k) { auto r = __builtin_amdgcn_permlane32_swap(__float_as_uint(p[k]), __float_as_uint(p[k + 4]), false, false); s[k] = __uint_as_float(r[0]) + __uint_as_float(r[1]); }
    float t[2];
#pragma unroll
    for (int k = 0; k < 2; ++k) { auto r = __builtin_amdgcn_permlane16_swap(__float_as_uint(s[k]), __float_as_uint(s[k + 2]), false, false); t[k] = __uint_as_float(r[0]) + __uint_as_float(r[1]); }
    const float u0 = t[0] + dpp<0x128>(t[0]), u1 = t[1] + dpp<0x128>(t[1]);
    float r = (lane & 8) ? u1 : u0;
    r += dpp<0xB1>(r); r += dpp<0x4E>(r); r += dpp<0x141>(r);
    return r;
}
typedef int i32x4 __attribute__((ext_vector_type(4)));
__device__ __forceinline__ void fp8fma4(f32x2 (&acc)[8], int o, unsigned w, f32x2 a2) {
    const f32x2 lo = __builtin_amdgcn_cvt_scalef32_pk_f32_fp8(w, 1.0f, false), hi = __builtin_amdgcn_cvt_scalef32_pk_f32_fp8(w, 1.0f, true);
    acc[o] = __builtin_elementwise_fma(a2, lo, acc[o]); acc[o + 1] = __builtin_elementwise_fma(a2, hi, acc[o + 1]);
}
__device__ __forceinline__ void g2_u_chunk(u32x4 (&u)[8], const unsigned char* U, const int* pe_next, const float* pw_c, float* act_c, const u32x4 xq, float rs, int lane) {
    const i32x4 e0 = *(const i32x4*)pe_next, e1 = *(const i32x4*)(pe_next + 4);
    const int en[8] = {e0.x, e0.y, e0.z, e0.w, e1.x, e1.y, e1.z, e1.w};
    float p[8];
#pragma unroll
    for (int k = 0; k < 8; ++k) {
        int d = __builtin_amdgcn_sdot4((int)u[k].x, (int)xq.x, 0, false); d = __builtin_amdgcn_sdot4((int)u[k].y, (int)xq.y, d, false);
        d = __builtin_amdgcn_sdot4((int)u[k].z, (int)xq.z, d, false); d = __builtin_amdgcn_sdot4((int)u[k].w, (int)xq.w, d, false);
        p[k] = (float)d;
        asm volatile("" : "+v"(p[k]));
        u[k] = *(const u32x4*)(U + (size_t)__builtin_amdgcn_readfirstlane(en[k]) * 1024 + lane * 16);
    }
    const float a = reduce8_transposed(p, lane);
    const int row = (lane >> 3) & 7;
    if ((lane & 7) == 0) act_c[row] = gelu_tanh(a * rs) * pw_c[row];
}
__device__ __forceinline__ void g2_v_chunk(u32x4 (&v)[8], const unsigned char* V, const int* pe_next, const float* act_c, f32x2 (&acc)[8], int lane) {
    const i32x4 e0 = *(const i32x4*)pe_next, e1 = *(const i32x4*)(pe_next + 4);
    const int en[8] = {e0.x, e0.y, e0.z, e0.w, e1.x, e1.y, e1.z, e1.w};
    const f32x4 a0 = *(const f32x4*)act_c, a1 = *(const f32x4*)(act_c + 4);
    const float av[8] = {a0.x, a0.y, a0.z, a0.w, a1.x, a1.y, a1.z, a1.w};
#pragma unroll
    for (int k = 0; k < 8; ++k) { const f32x2 a2 = (f32x2){av[k], av[k]};
        fp8fma4(acc, 0, v[k].x, a2); fp8fma4(acc, 2, v[k].y, a2); fp8fma4(acc, 4, v[k].z, a2); fp8fma4(acc, 6, v[k].w, a2);
        asm volatile("" : "+v"(acc[0]), "+v"(acc[1]), "+v"(acc[2]), "+v"(acc[3]), "+v"(acc[4]), "+v"(acc[5]), "+v"(acc[6]), "+v"(acc[7]));
        v[k] = *(const u32x4*)(V + (size_t)__builtin_amdgcn_readfirstlane(en[k]) * 1024 + lane * 16);
    }
}
__device__ __forceinline__ void g2_finish_token(Ctx& c, int l, int tok, const f32x2 (&acc)[8], int lane) {
    float* h = WSP(float, WS_H); bf16* hbw = WSP(bf16, WS_HB); float* ssqw = WSP(float, WS_SSQ);
    float* hp = h + (size_t)tok * D + lane * 16;
    f32x4 r0 = *(const f32x4*)hp, r1 = *(const f32x4*)(hp + 4), r2 = *(const f32x4*)(hp + 8), r3 = *(const f32x4*)(hp + 12);
    r0 += (f32x4){acc[0].x, acc[0].y, acc[1].x, acc[1].y}; r1 += (f32x4){acc[2].x, acc[2].y, acc[3].x, acc[3].y};
    r2 += (f32x4){acc[4].x, acc[4].y, acc[5].x, acc[5].y}; r3 += (f32x4){acc[6].x, acc[6].y, acc[7].x, acc[7].y};
    if (l == 0) {
        *(f32x4*)hp = r0; *(f32x4*)(hp + 4) = r1; *(f32x4*)(hp + 8) = r2; *(f32x4*)(hp + 12) = r3;
        u32x4 o0, o1; o0.x = pk2(r0.x, r0.y); o0.y = pk2(r0.z, r0.w); o0.z = pk2(r1.x, r1.y); o0.w = pk2(r1.z, r1.w);
        o1.x = pk2(r2.x, r2.y); o1.y = pk2(r2.z, r2.w); o1.z = pk2(r3.x, r3.y); o1.w = pk2(r3.z, r3.w);
        *(u32x4*)(hbw + (size_t)tok * D + lane * 16) = o0; *(u32x4*)(hbw + (size_t)tok * D + lane * 16 + 8) = o1;
        float ss = (r0.x * r0.x + r0.y * r0.y) + (r0.z * r0.z + r0.w * r0.w) + (r1.x * r1.x + r1.y * r1.y) + (r1.z * r1.z + r1.w * r1.w)
                 + (r2.x * r2.x + r2.y * r2.y) + (r2.z * r2.z + r2.w * r2.w) + (r3.x * r3.x + r3.y * r3.y) + (r3.z * r3.z + r3.w * r3.w);
        ss = wave_sum_dpp(ss);
        if (lane < 8) ssqw[(size_t)tok * 8 + lane] = lane == 0 ? ss : 0.f;
    } else {
        const int b = tok / L, pos = tok - b * L;
        if (pos >= NMETA) { float* op = c.out + ((size_t)b * SEQ + (pos - NMETA)) * D + lane * 16;
            *(f32x4*)op = r0; *(f32x4*)(op + 4) = r1; *(f32x4*)(op + 8) = r2; *(f32x4*)(op + 12) = r3; }
    }
}
__device__ __forceinline__ void phase_G2(const Ctx& c0, int l) {
    Ctx c = reopaque(c0);
    const bf16* hb = WSP(bf16, WS_HB); const float* ssq = WSP(float, WS_SSQ); const int* pe = WSP(int, WS_EIDX); const float* pw = WSP(float, WS_GW);
    const unsigned char* U = c.ws + WS_TAB + (size_t)(l * 2) * SZ_TAB; const unsigned char* V = c.ws + WS_TAB + (size_t)(l * 2 + 1) * SZ_TAB;
    const int lane = c.lane, wave = c.wave;
    const int gw = c.vb * 4 + wave, t0 = l == 1 ? gw * 8 + NMETA * ((gw >> 8) + 1) : gw * 8;
    const bool has_x = l == 0 && (c.vb & 3) == 0; const int tx = T - 128 + (c.vb >> 2);
    unsigned char* wl = c.lds + wave * G2_WSTRIDE;
    int* pe_l = (int*)wl; float* pw_l = (float*)(wl + 4608); float* act_l = (float*)(wl + 9216);
#pragma unroll
    for (int j = 0; j < G2_MAXTOK; ++j) { const int tok = j < 8 ? t0 + j : (has_x ? tx : t0);
        pe_l[j * 128 + lane] = pe[(size_t)tok * 128 + lane]; pe_l[j * 128 + 64 + lane] = pe[(size_t)tok * 128 + 64 + lane];
        pw_l[j * 128 + lane] = pw[(size_t)tok * 128 + lane] * TAB_INV; pw_l[j * 128 + 64 + lane] = pw[(size_t)tok * 128 + 64 + lane] * TAB_INV; }
    const int xlo = has_x ? 4 * wave : 16, xhi = has_x ? 4 * wave + 4 : 16;
    {
        u32x4 xq[G2_MAXTOK]; float rs[G2_MAXTOK];
#pragma unroll
        for (int j = 0; j < G2_MAXTOK; ++j) { const int tok = j < 8 ? t0 + j : (has_x ? tx : t0);
            const u32x4 lo = *(const u32x4*)(hb + (size_t)tok * D + lane * 16), hi = *(const u32x4*)(hb + (size_t)tok * D + lane * 16 + 8);
            const f32x4 f0 = (f32x4){bf_lo(lo.x), bf_hi(lo.x), bf_lo(lo.y), bf_hi(lo.y)}, f1 = (f32x4){bf_lo(lo.z), bf_hi(lo.z), bf_lo(lo.w), bf_hi(lo.w)};
            const f32x4 f2 = (f32x4){bf_lo(hi.x), bf_hi(hi.x), bf_lo(hi.y), bf_hi(hi.y)}, f3 = (f32x4){bf_lo(hi.z), bf_hi(hi.z), bf_lo(hi.w), bf_hi(hi.w)};
            float mx = 1e-20f;
#pragma unroll
            for (int i = 0; i < 4; ++i) mx = fmaxf(mx, fmaxf(fmaxf(fabsf(f0[i]), fabsf(f1[i])), fmaxf(fabsf(f2[i]), fabsf(f3[i]))));
            mx = fmaxf(mx, dpp<0xB1>(mx)); mx = fmaxf(mx, dpp<0x4E>(mx)); mx = fmaxf(mx, dpp<0x141>(mx)); mx = fmaxf(mx, dpp<0x128>(mx)); mx = xrow16_max(mx);
            const float sx = 127.0f / mx;
            xq[j].x = pack_i8x4(f0 * sx); xq[j].y = pack_i8x4(f1 * sx); xq[j].z = pack_i8x4(f2 * sx); xq[j].w = pack_i8x4(f3 * sx);
            rs[j] = rstd_from_ssq8(ssq, tok) * mx * (1.0f / (127.0f * U_SCALE)); }
        u32x4 u[8];
#pragma unroll
        for (int k = 0; k < 8; ++k) u[k] = *(const u32x4*)(U + (size_t)__builtin_amdgcn_readfirstlane(pe_l[k]) * 1024 + lane * 16);
#pragma unroll 1
        for (int ch = 0; ch < 16; ++ch) {
            const int cn = ch < 15 ? ch + 1 : 0;
            const bool x_here = ch >= xlo && ch < xhi;
#pragma unroll
            for (int j = 0; j < 8; ++j) {
                const int* pe_next = j < 7 ? pe_l + (j + 1) * 128 + ch * 8 : (x_here ? pe_l + 8 * 128 + ch * 8 : pe_l + cn * 8);
                g2_u_chunk(u, U, pe_next, pw_l + j * 128 + ch * 8, act_l + j * 128 + ch * 8, xq[j], rs[j], lane); }
            if (x_here) g2_u_chunk(u, U, pe_l + cn * 8, pw_l + 8 * 128 + ch * 8, act_l + 8 * 128 + ch * 8, xq[8], rs[8], lane);
        }
    }
    f32x2 acc[G2_MAXTOK][8];
#pragma unroll
    for (int j = 0; j < G2_MAXTOK; ++j)
#pragma unroll
        for (int i = 0; i < 8; ++i) acc[j][i] = (f32x2){0.f, 0.f};
    {
        u32x4 v[8];
#pragma unroll
        for (int k = 0; k < 8; ++k) v[k] = *(const u32x4*)(V + (size_t)__builtin_amdgcn_readfirstlane(pe_l[k]) * 1024 + lane * 16);
#pragma unroll 1
        for (int ch = 0; ch < 16; ++ch) {
            const int cn = ch < 15 ? ch + 1 : 0;
            const bool x_here = ch >= xlo && ch < xhi;
#pragma unroll
            for (int j = 0; j < 8; ++j) {
                const int* pe_next = j < 7 ? pe_l + (j + 1) * 128 + ch * 8 : (x_here ? pe_l + 8 * 128 + ch * 8 : pe_l + cn * 8);
                g2_v_chunk(v, V, pe_next, act_l + j * 128 + ch * 8, acc[j], lane); }
            if (x_here) g2_v_chunk(v, V, pe_l + cn * 8, act_l + 8 * 128 + ch * 8, acc[8], lane);
        }
    }
#pragma unroll
    for (int j = 0; j < 8; ++j) g2_finish_token(c, l, t0 + j, acc[j], lane);
    __syncthreads();
    if (has_x) {
        f32x2* part = (f32x2*)(c.lds + wave * G2_WSTRIDE);
#pragma unroll
        for (int i = 0; i < 8; ++i) part[i * 64 + lane] = acc[8][i];
    }
    __syncthreads();
    if (has_x && wave == 0) {
        f32x2 tot[8];
#pragma unroll
        for (int i = 0; i < 8; ++i) { tot[i] = acc[8][i];
#pragma unroll
            for (int w = 1; w < 4; ++w) tot[i] += ((const f32x2*)(c.lds + w * G2_WSTRIDE))[i * 64 + lane]; }
        g2_finish_token(c, l, tx, tot, lane);
    }
    __syncthreads();
}

struct Args { const float* in[22]; float* out; unsigned char* ws; int ph_lo, ph_hi; };
constexpr int N_PHASES = 17;

__global__ void __launch_bounds__(NTHREADS, 2) fwd_kernel(Args args) {
    extern __shared__ __attribute__((aligned(16))) unsigned char lds_raw[];
    Ctx c;
#pragma unroll
    for (int i = 0; i < 22; ++i) c.in[i] = args.in[i];
    c.out = args.out; c.ws = args.ws; c.lds = lds_raw;
    c.tid = threadIdx.x; c.lane = c.tid & 63; c.wave = __builtin_amdgcn_readfirstlane(c.tid >> 6);
    c.G = gridDim.x; { const int bx = blockIdx.x; c.vb = (c.G % 8 == 0) ? (bx % 8) * (c.G / 8) + bx / 8 : bx; }
    volatile unsigned* misc = (volatile unsigned*)(c.lds + LDS_MISC);
    if (c.tid < 16) misc[c.tid] = 0u;
    __syncthreads();
    const int lo = args.ph_lo, hi = args.ph_hi;
    const bool multi = (hi - lo) > 1;
    XcdBarrier bar; bar.bar = WSP(unsigned, WS_CTL) + CW_BAR; bar.x = 0; bar.st = misc;
    if (multi) bar = xcd_barrier_post(WSP(unsigned, WS_CTL) + CW_BAR, misc);
#define IN_(k) (lo <= (k) && (k) < hi)
#define SEAM_(k) do { if ((k) + 1 < hi) xcd_barrier(bar); } while (0)
    if (IN_(0)) { phase_prologue(c); SEAM_(0); }
#pragma unroll 1
    for (int l = 0; l < 2; ++l) {
        const int p0 = 1 + 8 * l;
        if (IN_(p0 + 0)) { phase_A(c, l); SEAM_(p0 + 0); }
        if (IN_(p0 + 1)) { phase_B(c, l); SEAM_(p0 + 1); }
        if (IN_(p0 + 2)) { phase_C(c, l); SEAM_(p0 + 2); }
        if (IN_(p0 + 3)) { phase_D(c, l); SEAM_(p0 + 3); }
        if (IN_(p0 + 4)) { phase_E(c, l); SEAM_(p0 + 4); }
        if (IN_(p0 + 5)) { phase_F(c, l); SEAM_(p0 + 5); }
        if (IN_(p0 + 6)) { phase_F3(c, l); SEAM_(p0 + 6); }
        if (IN_(p0 + 7)) { phase_G2(c, l); SEAM_(p0 + 7); }
    }
}

extern "C" void kernel_launch(void* const* d_in, const int* in_sizes, int n_in, void* d_out, int out_size, void* d_ws, size_t ws_size, hipStream_t stream) {
    static int grid = 0;
    if (grid == 0) {
        if (n_in != 22 || out_size != NB * SEQ * D || ws_size < WS_END) { fprintf(stderr, "kernel_launch: unexpected shapes (n_in %d out %d ws %zu need %zu)\n", n_in, out_size, ws_size, (size_t)WS_END); grid = -1; return; }
        int dev = 0, cus = 0, per_cu = 0;
        hipGetDevice(&dev); hipDeviceGetAttribute(&cus, hipDeviceAttributeMultiprocessorCount, dev);
        if (hipFuncSetAttribute((const void*)fwd_kernel, hipFuncAttributeMaxDynamicSharedMemorySize, LDS_BYTES) != hipSuccess) { fprintf(stderr, "kernel_launch: hipFuncSetAttribute failed\n"); grid = -1; return; }
        if (hipOccupancyMaxActiveBlocksPerMultiprocessor(&per_cu, (const void*)fwd_kernel, NTHREADS, LDS_BYTES) != hipSuccess || per_cu < 1) { fprintf(stderr, "kernel_launch: occupancy query failed (%d)\n", per_cu); per_cu = 1; (void)hipGetLastError(); }
        if (per_cu > 2) per_cu = 2;
        grid = cus * per_cu;
        if (grid != 512) { fprintf(stderr, "kernel_launch: grid %d unsupported by phase G2 (needs 512 workgroups)\n", grid); grid = -1; return; }
        fprintf(stderr, "kernel_launch: grid %d (%d per CU), lds %d, ws need %zu have %zu\n", grid, per_cu, LDS_BYTES, (size_t)WS_END, ws_size);
    }
    if (grid < 0) return;
    hipMemsetAsync((char*)d_ws + WS_CTL, 0, CTL_BYTES, stream);
    Args a{};
    for (int i = 0; i < 22; ++i) a.in[i] = (const float*)d_in[i];
    a.out = (float*)d_out; a.ws = (unsigned char*)d_ws;
#if MK_PER_PHASE
    for (int ph = 0; ph < N_PHASES; ++ph) { a.ph_lo = ph; a.ph_hi = ph + 1; hipLaunchKernelGGL(fwd_kernel, dim3(grid), dim3(NTHREADS), LDS_BYTES, stream, a); }
#else
    a.ph_lo = 0; a.ph_hi = N_PHASES;
    void* kargs[] = {&a};
    hipError_t e = hipLaunchCooperativeKernel((const void*)fwd_kernel, dim3(grid), dim3(NTHREADS), kargs, LDS_BYTES, stream);
    if (e != hipSuccess) fprintf(stderr, "kernel_launch: cooperative launch failed: %s (grid %d)\n", hipGetErrorString(e), grid);
#endif
}
```

```cpp
#include <hip/hip_runtime.h>
#include <cstdio>
#include <cstdint>

#ifndef MK_PER_PHASE
#define MK_PER_PHASE 0
#endif

typedef unsigned short bf16;
typedef short bf16x8 __attribute__((ext_vector_type(8)));
typedef float f32x4 __attribute__((ext_vector_type(4)));
typedef unsigned u32x4 __attribute__((ext_vector_type(4)));
typedef unsigned u32x2 __attribute__((ext_vector_type(2)));
typedef __bf16 bf16x2 __attribute__((ext_vector_type(2)));

constexpr int NB = 8, SEQ = 2048, NMETA = 16, L = SEQ + NMETA, T = NB * L, D = 1024;
constexpr int DC = 512, CW = 31, NH = 8, QL = 256, KVL = 128, NOPE = 64, ROPE = 32, QK = 96, VD = 64;
constexpr int NIN = 3488, NINP = 3584;
constexpr int NEXP = 16384;
constexpr float EPS = 1e-6f;
constexpr int MT = T / 128;
static_assert(T % 128 == 0, "T tiles");

constexpr size_t al256(size_t x) { return (x + 255) & ~(size_t)255; }
constexpr size_t WS_CTL = 0;
constexpr size_t CTL_BYTES = 65536;
constexpr size_t WS_ROPE = WS_CTL + CTL_BYTES;
constexpr size_t WS_WIN = al256(WS_ROPE + (size_t)L * 16 * 8);
constexpr size_t SZ_WIN = (size_t)NINP * 1024 * 2, SZ_WCO = (size_t)1024 * 512 * 2, SZ_WUQ = (size_t)1024 * 256 * 2, SZ_WUKV = (size_t)1024 * 128 * 2,
                 SZ_WMLA = (size_t)1024 * 512 * 2, SZ_WOUT = (size_t)1024 * 1024 * 2, SZ_WPQ = (size_t)2048 * 1024 * 2, SZ_KEYS = (size_t)16 * 128 * 128 * 2;
constexpr size_t OFF_WCO = SZ_WIN, OFF_WUQ = OFF_WCO + SZ_WCO, OFF_WUKV = OFF_WUQ + SZ_WUQ, OFF_WMLA = OFF_WUKV + SZ_WUKV, OFF_WOUT = OFF_WMLA + SZ_WMLA,
                 OFF_WPQ = OFF_WOUT + SZ_WOUT, OFF_KEYS = OFF_WPQ + SZ_WPQ, SZ_WLAYER = OFF_KEYS + SZ_KEYS;
constexpr size_t WS_TAB = al256(WS_WIN + 2 * SZ_WLAYER);
constexpr size_t SZ_TAB = (size_t)NEXP * 1024;
constexpr float TAB_SCALE = 256.0f, TAB_INV = 1.0f / 256.0f;
constexpr float U_CLIP = 0.2f, U_SCALE = 127.0f / U_CLIP;
constexpr size_t WS_H = al256(WS_TAB + 4 * SZ_TAB);
constexpr size_t WS_HB = al256(WS_H + (size_t)T * 1024 * 4);
constexpr size_t WS_SSQ = al256(WS_HB + (size_t)T * 1024 * 2);
constexpr size_t WS_UGLU = al256(WS_SSQ + (size_t)T * 8 * 4);
constexpr size_t WS_CQ = al256(WS_UGLU + (size_t)T * 512 * 2);
constexpr size_t WS_CKV = al256(WS_CQ + (size_t)T * 256 * 2);
constexpr size_t WS_KROPE = al256(WS_CKV + (size_t)T * 128 * 2);
constexpr size_t WS_SSQQ = al256(WS_KROPE + (size_t)T * 32 * 4);
constexpr size_t WS_SSQKV = al256(WS_SSQQ + (size_t)T * 2 * 4);
constexpr size_t WS_U2 = al256(WS_SSQKV + (size_t)T * 4);
constexpr size_t WS_Q = al256(WS_U2 + (size_t)T * 512 * 2);
constexpr size_t WS_K = al256(WS_Q + (size_t)T * NH * QK * 2);
constexpr size_t WS_VT = al256(WS_K + (size_t)T * NH * QK * 2);
constexpr size_t WS_O = al256(WS_VT + (size_t)T * NH * VD * 2 + 4096);
constexpr size_t WS_MERGED = al256(WS_O + (size_t)T * 512 * 2);
constexpr size_t WS_GATES = al256(WS_MERGED + (size_t)T * 1024 * 2);
constexpr size_t WS_SV = WS_GATES;
constexpr size_t WS_SI = al256(WS_SV + (size_t)T * 256 * 4);
constexpr size_t WS_EIDX = al256(WS_SI + (size_t)T * 256);
constexpr size_t WS_GW = al256(WS_EIDX + (size_t)T * 128 * 4);
constexpr size_t WS_STB = al256(WS_GW + (size_t)T * 128 * 4);
constexpr size_t WS_PEER_END = WS_STB + (size_t)T * 16;
constexpr size_t WS_END = al256(WS_GATES + (size_t)T * 2048 * 2);
static_assert(WS_PEER_END <= WS_END, "peer scratch overlay");

constexpr int CW_BAR = 0;
constexpr int CW_QUEUE = 4096;

constexpr int LDS_MAIN = 128 * 132 * 4;
constexpr int LDS_MISC = LDS_MAIN;
constexpr int LDS_BYTES = LDS_MAIN + 64;

constexpr int NTHREADS = 256;

__device__ __forceinline__ unsigned pk2(float lo, float hi) { bf16x2 v; v.x = (__bf16)lo; v.y = (__bf16)hi; return __builtin_bit_cast(unsigned, v); }
__device__ __forceinline__ unsigned pack_i8x4(f32x4 v) {
    const int a = (int)__builtin_rintf(fminf(fmaxf(v.x, -127.f), 127.f)), b = (int)__builtin_rintf(fminf(fmaxf(v.y, -127.f), 127.f));
    const int c_ = (int)__builtin_rintf(fminf(fmaxf(v.z, -127.f), 127.f)), d = (int)__builtin_rintf(fminf(fmaxf(v.w, -127.f), 127.f));
    return (unsigned)(a & 255) | ((unsigned)(b & 255) << 8) | ((unsigned)(c_ & 255) << 16) | ((unsigned)(d & 255) << 24);
}
__device__ __forceinline__ float bf_lo(unsigned p) { return __uint_as_float(p << 16); }
__device__ __forceinline__ float bf_hi(unsigned p) { return __uint_as_float(p & 0xffff0000u); }
__device__ __forceinline__ float fast_rcp(float x) { return __builtin_amdgcn_rcpf(x); }
__device__ __forceinline__ float fast_exp2(float x) { return __builtin_amdgcn_exp2f(x); }
__device__ __forceinline__ float sigmoidf_(float x) { return fast_rcp(1.0f + fast_exp2(-1.4426950409f * x)); }
__device__ __forceinline__ float gelu_tanh(float x) { const float u = 1.5957691216f * (x + 0.044715f * x * x * x); return x * fast_rcp(1.0f + fast_exp2(-1.4426950409f * u)); }
__device__ __forceinline__ float rsqrt_(float x) { return __builtin_amdgcn_rsqf(x); }
template <int CTRL> __device__ __forceinline__ float dpp(float x) { return __builtin_bit_cast(float, __builtin_amdgcn_mov_dpp(__builtin_bit_cast(int, x), CTRL, 0xf, 0xf, true)); }
__device__ __forceinline__ float xrow16_sum(float x) {
    auto s = __builtin_amdgcn_permlane16_swap(__float_as_uint(x), __float_as_uint(x), false, false);
    x = __uint_as_float(s[0]) + __uint_as_float(s[1]);
    auto t = __builtin_amdgcn_permlane32_swap(__float_as_uint(x), __float_as_uint(x), false, false);
    return __uint_as_float(t[0]) + __uint_as_float(t[1]);
}
__device__ __forceinline__ float xrow16_max(float x) {
    auto s = __builtin_amdgcn_permlane16_swap(__float_as_uint(x), __float_as_uint(x), false, false);
    x = fmaxf(__uint_as_float(s[0]), __uint_as_float(s[1]));
    auto t = __builtin_amdgcn_permlane32_swap(__float_as_uint(x), __float_as_uint(x), false, false);
    return fmaxf(__uint_as_float(t[0]), __uint_as_float(t[1]));
}
__device__ __forceinline__ float wave_sum_dpp(float x) {
    x += dpp<0xB1>(x); x += dpp<0x4E>(x); x += dpp<0x141>(x); x += dpp<0x128>(x); return xrow16_sum(x);
}
__device__ __forceinline__ float quad_sum(float v) { return xrow16_sum(v); }
__device__ __forceinline__ float quad_max(float v) { return xrow16_max(v); }
__device__ __forceinline__ float wave_sum(float v) { return wave_sum_dpp(v); }
__device__ __forceinline__ float dot2(unsigned a, unsigned b, float c) { return __builtin_amdgcn_fdot2_f32_bf16(__builtin_bit_cast(bf16x2, a), __builtin_bit_cast(bf16x2, b), c, false); }

#define XB_TMO      128
#define XB_XCNT(j)  (256  + 64 * (j))
#define XB_XSUB(j)  (1280 + 64 * (j))
#define XB_XGEN(j)  (2304 + 64 * (j))
#define XB_TOP      3328
#define XB_TOPGEN   3392
#define XCD_BAR_WORDS 3456
#define XB_SPIN_CAP (1u << 20)
__device__ __forceinline__ unsigned xb_ld(unsigned* p)              { return __hip_atomic_load(p, __ATOMIC_RELAXED, __HIP_MEMORY_SCOPE_AGENT); }
__device__ __forceinline__ unsigned xb_add(unsigned* p, unsigned v) { return __hip_atomic_fetch_add(p, v, __ATOMIC_RELAXED, __HIP_MEMORY_SCOPE_AGENT); }
__device__ __forceinline__ unsigned xb_xcc_id() { return (unsigned)__builtin_amdgcn_s_getreg((3 << 11) | 20) & 0xFu; }
#define XB_SPIN(cond, bar) do { unsigned _sp = 0; while (cond) { __builtin_amdgcn_s_sleep(1); \
    if ((++_sp & 255u) == 0u) { if (xb_ld(&(bar)[XB_TMO])) break; if (_sp > XB_SPIN_CAP) { atomicAdd(&(bar)[XB_TMO], 1u); break; } } } } while (0)
struct XcdBarrier { unsigned* bar; unsigned x; volatile unsigned* st; };
__device__ __forceinline__ XcdBarrier xcd_barrier_post(unsigned* bar, volatile unsigned* st) {
    XcdBarrier b; b.bar = bar; b.x = xb_xcc_id(); b.st = st;
    if (threadIdx.x == 0) (void)xb_add(&bar[XB_XCNT(b.x)], 1u);
    return b;
}
__device__ __forceinline__ void xcd_barrier_complete(unsigned* bar, unsigned x, unsigned& nloc, unsigned& nx) {
    const unsigned G = gridDim.x * gridDim.y * gridDim.z;
    unsigned sum, cnt, mine, sp = 0u;
    for (;;) {
        sum = 0u; cnt = 0u; mine = 0u;
#pragma unroll
        for (unsigned j = 0; j < 16; ++j) { const unsigned c = xb_ld(&bar[XB_XCNT(j)]); sum += c; cnt += (c > 0u) ? 1u : 0u; mine = (j == x) ? c : mine; }
        if (sum == G) break;
        __builtin_amdgcn_s_sleep(1);
        if ((++sp & 255u) == 0u) { if (xb_ld(&bar[XB_TMO])) break; if (sp > XB_SPIN_CAP) { atomicAdd(&bar[XB_TMO], 1u); break; } }
    }
    nloc = mine > 0u ? mine : 1u; nx = cnt > 0u ? cnt : 1u;
}
__device__ __forceinline__ void xcd_barrier(const XcdBarrier& b) {
    asm volatile("s_waitcnt vmcnt(0)" ::: "memory");
    __syncthreads();
    if (threadIdx.x == 0) {
        unsigned* bar = b.bar;
        __builtin_amdgcn_s_waitcnt(0);
        unsigned nloc = b.st[0], nx = b.st[1];
        if (nloc == 0u) { xcd_barrier_complete(bar, b.x, nloc, nx); b.st[0] = nloc; b.st[1] = nx; }
        const unsigned old = xb_add(&bar[XB_XSUB(b.x)], 1u);
        const unsigned gen = old / nloc;
        if (old + 1u == (gen + 1u) * nloc) {
            __builtin_amdgcn_fence(__ATOMIC_RELEASE, "agent");
            asm volatile("s_waitcnt vmcnt(0)" ::: "memory");
            const unsigned og = xb_add(&bar[XB_TOP], 1u);
            const unsigned tg = og / nx;
            if (og + 1u == (tg + 1u) * nx) xb_add(&bar[XB_TOPGEN], 1u);
            else XB_SPIN(xb_ld(&bar[XB_TOPGEN]) == tg, bar);
            __builtin_amdgcn_fence(__ATOMIC_ACQUIRE, "agent");
            xb_add(&bar[XB_XGEN(b.x)], 1u);
            asm volatile("s_waitcnt vmcnt(0)" ::: "memory");
        } else {
            XB_SPIN(xb_ld(&bar[XB_XGEN(b.x)]) == gen, bar);
            __builtin_amdgcn_fence(__ATOMIC_ACQUIRE, "agent");
            asm volatile("s_waitcnt vmcnt(0)" ::: "memory");
        }
    }
    __syncthreads();
}

struct Ctx {
    const float* in[22]; float* out; unsigned char* ws;
    unsigned char* lds; int tid, lane, wave, G, vb;
};
#define WSP(T_, off) ((T_*)(c.ws + (off)))
__device__ __forceinline__ Ctx reopaque(const Ctx& c0) {
    Ctx c = c0; int t = c0.tid; asm volatile("" : "+v"(t)); c.tid = t; c.lane = t & 63; c.wave = __builtin_amdgcn_readfirstlane(t >> 6);
    int vb = c0.vb; asm volatile("" : "+s"(vb)); c.vb = vb; return c;
}

__device__ __forceinline__ int lds_off(int row, int chunk) { return row * 128 + ((chunk ^ (row & 7)) << 4); }

__device__ __forceinline__ void gemm_compute_stage(f32x4 (&acc)[2][8], const unsigned char* sA, const unsigned char* sB, int wave, int lane) {
    const int r = lane & 15, q = lane >> 4;
#pragma unroll
    for (int ks = 0; ks < 2; ++ks) {
        bf16x8 af[2], bfr[8];
#pragma unroll
        for (int mi = 0; mi < 2; ++mi) af[mi] = *(const bf16x8*)(sA + lds_off(32 * wave + 16 * mi + r, 4 * ks + q));
#pragma unroll
        for (int ni = 0; ni < 8; ++ni) bfr[ni] = *(const bf16x8*)(sB + lds_off(16 * ni + r, 4 * ks + q));
#pragma unroll
        for (int mi = 0; mi < 2; ++mi)
#pragma unroll
            for (int ni = 0; ni < 8; ++ni) acc[mi][ni] = __builtin_amdgcn_mfma_f32_16x16x32_bf16(bfr[ni], af[mi], acc[mi][ni], 0, 0, 0);
    }
}

#define LAS __attribute__((address_space(3)))
__device__ __forceinline__ void gemm_stage_glds(const bf16* A, int lda, const bf16* Bt, int ldb, int kt, unsigned char* stage, int wave, int lane) {
    const int rr = lane >> 3, cch = (lane & 7) ^ rr;
#pragma unroll
    for (int i = 0; i < 4; ++i) { const int pc = 4 * i + wave;
        __builtin_amdgcn_global_load_lds((const unsigned*)(A + (size_t)(8 * pc + rr) * lda + kt * 64 + cch * 8), (LAS unsigned*)(stage + pc * 1024), 16, 0, 0);
        __builtin_amdgcn_global_load_lds((const unsigned*)(Bt + (size_t)(8 * pc + rr) * ldb + kt * 64 + cch * 8), (LAS unsigned*)(stage + 16384 + pc * 1024), 16, 0, 0); }
}
__device__ __forceinline__ void gemm_core(f32x4 (&acc)[2][8], const bf16* A, int lda, const bf16* Bt, int ldb, int K, unsigned char* lds, int tid) {
    const int wave = __builtin_amdgcn_readfirstlane(tid >> 6), lane = tid & 63;
    const int nk = K >> 6;
    gemm_stage_glds(A, lda, Bt, ldb, 0, lds, wave, lane);
    asm volatile("s_waitcnt vmcnt(0)" ::: "memory");
    __syncthreads();
    for (int kt = 0; kt < nk; ++kt) {
        const int cur = kt & 1;
        if (kt + 1 < nk) gemm_stage_glds(A, lda, Bt, ldb, kt + 1, lds + (cur ^ 1) * 32768, wave, lane);
        gemm_compute_stage(acc, lds + cur * 32768, lds + cur * 32768 + 16384, wave, lane);
        asm volatile("s_waitcnt vmcnt(0)" ::: "memory");
        __syncthreads();
    }
}
__device__ __forceinline__ void acc_zero(f32x4 (&acc)[2][8]) {
#pragma unroll
    for (int mi = 0; mi < 2; ++mi)
#pragma unroll
        for (int ni = 0; ni < 8; ++ni) acc[mi][ni] = (f32x4){0.f, 0.f, 0.f, 0.f};
}
__device__ __forceinline__ float rstd_from_ssq8(const float* ssq, int tok) {
    const f32x4 a = *(const f32x4*)(ssq + (size_t)tok * 8), b = *(const f32x4*)(ssq + (size_t)tok * 8 + 4);
    const float s = ((a.x + a.y) + (a.z + a.w)) + ((b.x + b.y) + (b.z + b.w));
    return rsqrt_(s * (1.0f / 1024.0f) + EPS);
}

__device__ __forceinline__ int src_col(int mode, int np) {
    if (mode == 0) return np;
    if (mode == 2) { const int h = np >> 7, j = np & 127; return j < 96 ? h * 96 + j : -1; }
    if (np < 1024) { const int cblk = np >> 7, j = np & 127; return j < 64 ? 64 * cblk + j : 512 + 64 * cblk + (j - 64); }
    if (np < 1408) return np;
    if (np < 1536) { const int j = np - 1408; return j < 32 ? 1408 + j : -1; }
    return 1440 + (np - 1536);
}
__device__ __forceinline__ void p0_transpose_item(const float* W, int K, int N, bf16* Wt, int mode, const float* g, int item, float* scr, int lane) {
    const int nblk_k = K / 64, nb = item / nblk_k, kb = item % nblk_k, k0 = 64 * kb, n0 = 32 * nb;
    const int n = src_col(mode, n0 + (lane & 31));
#pragma unroll 8
    for (int i = 0; i < 32; ++i) { const int kk = 2 * i + (lane >> 5); float v = 0.f; if (n >= 0) { v = W[(size_t)(k0 + kk) * N + n]; if (g) v *= g[k0 + kk]; } scr[kk * 33 + (lane & 31)] = v; }
    __builtin_amdgcn_s_waitcnt(0xC07F); asm volatile("" ::: "memory");
    const int cch = lane & 7;
#pragma unroll
    for (int j = 0; j < 4; ++j) { const int nl = (lane >> 3) + 8 * j; const float* s = scr + (8 * cch) * 33 + nl;
        u32x4 o; o.x = pk2(s[0 * 33], s[1 * 33]); o.y = pk2(s[2 * 33], s[3 * 33]); o.z = pk2(s[4 * 33], s[5 * 33]); o.w = pk2(s[6 * 33], s[7 * 33]);
        *(u32x4*)(Wt + (size_t)(n0 + nl) * K + k0 + 8 * cch) = o; }
    __builtin_amdgcn_s_waitcnt(0xC07F); asm volatile("" ::: "memory");
}
struct WDesc { int in_idx, K, N, Np, mode, g_idx; size_t off; };
__device__ __forceinline__ void phase_prologue(const Ctx& c0) {
    Ctx c = reopaque(c0);
    const int gw = c.vb * 4 + c.wave, NGW = c.G * 4;
    float* scr = (float*)(c.lds + c.wave * 8704);
    const WDesc wd[7] = {
        {3, 1024, NIN, NINP, 1, 2, 0}, {8, 512, 1024, 1024, 0, -1, OFF_WCO}, {10, 256, 768, 1024, 2, 9, OFF_WUQ}, {12, 128, 1024, 1024, 0, 11, OFF_WUKV},
        {15, 512, 1024, 1024, 0, -1, OFF_WMLA}, {16, 1024, 1024, 1024, 0, -1, OFF_WOUT}, {18, 1024, 2048, 2048, 0, 17, OFF_WPQ}};
    constexpr int ITEMS_PER_LAYER = (1024 / 64) * (NINP / 32) + (512 / 64) * 32 + (256 / 64) * 32 + (128 / 64) * 32 + (512 / 64) * 32 + (1024 / 64) * 32 + (1024 / 64) * 64;
    for (int it = gw; it < 2 * ITEMS_PER_LAYER; it += NGW) {
        const int l = it >= ITEMS_PER_LAYER ? 1 : 0; int r = it - l * ITEMS_PER_LAYER;
        const float* W = nullptr; const float* g = nullptr; bf16* Wt = nullptr; int K = 64, N = 32, mode = 0, rr = 0;
#pragma unroll
        for (int m = 0; m < 7; ++m) {
            const int items = (wd[m].K / 64) * (wd[m].Np / 32);
            if (r >= 0 && r < items) { K = wd[m].K; N = wd[m].N; mode = wd[m].mode; rr = r;
                W = c.in[wd[m].in_idx] + (size_t)l * wd[m].K * wd[m].N; g = wd[m].g_idx >= 0 ? c.in[wd[m].g_idx >= 0 ? wd[m].g_idx : 0] + (size_t)l * wd[m].K : nullptr;
                Wt = (bf16*)(c.ws + WS_WIN + l * SZ_WLAYER + wd[m].off); }
            r -= items;
        }
        p0_transpose_item(W, K, N, Wt, mode, g, rr, scr, c.lane);
    }
    const int gt = c.vb * NTHREADS + c.tid, NGT = c.G * NTHREADS;
    for (int l = 0; l < 2; ++l) {
        const float* src = c.in[19] + (size_t)l * 262144; bf16* dst = (bf16*)(c.ws + WS_WIN + l * SZ_WLAYER + OFF_KEYS);
        for (int i = gt; i < 262144 / 8; i += NGT) { const f32x4 a = *(const f32x4*)(src + i * 8), b = *(const f32x4*)(src + i * 8 + 4);
            u32x4 o; o.x = pk2(a.x, a.y); o.y = pk2(a.z, a.w); o.z = pk2(b.x, b.y); o.w = pk2(b.z, b.w); *(u32x4*)(dst + i * 8) = o; }
    }
    for (int l = 0; l < 2; ++l)
        for (int uv = 0; uv < 2; ++uv) {
            const float* src = c.in[20 + uv] + (size_t)l * NEXP * 1024; unsigned char* dst = c.ws + WS_TAB + (size_t)(l * 2 + uv) * SZ_TAB;
            f32x4 g4[4];
#pragma unroll
            for (int j = 0; j < 4; ++j) { const float sc = uv == 0 ? U_SCALE : TAB_SCALE; g4[j] = (f32x4){sc, sc, sc, sc}; if (uv == 0) g4[j] = g4[j] * *(const f32x4*)(c.in[17] + l * 1024 + 256 * j + 4 * c.lane); }
            for (int row = gw; row < NEXP; row += 2 * NGW) {
                const float* sp = src + (size_t)row * 1024 + 4 * c.lane; const int row2 = row + NGW; const bool two = row2 < NEXP;
                const float* sp2 = src + (size_t)(two ? row2 : row) * 1024 + 4 * c.lane;
                f32x4 a[4], b[4];
#pragma unroll
                for (int j = 0; j < 4; ++j) { a[j] = *(const f32x4*)(sp + 256 * j); b[j] = *(const f32x4*)(sp2 + 256 * j); }
#pragma unroll
                for (int j = 0; j < 4; ++j) { const f32x4 v = a[j] * g4[j];
                    *(unsigned*)(dst + (size_t)row * 1024 + 256 * j + 4 * c.lane) = uv == 0 ? pack_i8x4(v) : (unsigned)__builtin_amdgcn_cvt_pk_fp8_f32(v.z, v.w, __builtin_amdgcn_cvt_pk_fp8_f32(v.x, v.y, 0, false), true); }
                if (two) {
#pragma unroll
                    for (int j = 0; j < 4; ++j) { const f32x4 v = b[j] * g4[j];
                        *(unsigned*)(dst + (size_t)row2 * 1024 + 256 * j + 4 * c.lane) = uv == 0 ? pack_i8x4(v) : (unsigned)__builtin_amdgcn_cvt_pk_fp8_f32(v.z, v.w, __builtin_amdgcn_cvt_pk_fp8_f32(v.x, v.y, 0, false), true); } }
            }
        }
    { float* rope = WSP(float, WS_ROPE);
      for (int i = gt; i < L * 16; i += NGT) { const int pos = i >> 4, j = i & 15;
          const float inv = 1.0f / __builtin_exp2f((float)j * 0.8304820237218406f);
          const float angf = (float)pos * inv; const double ang = (double)angf;
          const double nq = __builtin_rint(ang * 0.63661977236758134308);
          double rr = __builtin_fma(-nq, 1.57079632679489655800e+00, ang); rr = __builtin_fma(-nq, 6.12323399573676603587e-17, rr);
          const double r2 = rr * rr;
          double sp = -1.0 / 1307674368000.0; sp = sp * r2 + 1.0 / 6227020800.0; sp = sp * r2 - 1.0 / 39916800.0; sp = sp * r2 + 1.0 / 362880.0; sp = sp * r2 - 1.0 / 5040.0; sp = sp * r2 + 1.0 / 120.0; sp = sp * r2 - 1.0 / 6.0; sp = sp * r2 * rr + rr;
          double cp = 1.0 / 87178291200.0; cp = cp * r2 - 1.0 / 479001600.0; cp = cp * r2 + 1.0 / 3628800.0; cp = cp * r2 - 1.0 / 40320.0; cp = cp * r2 + 1.0 / 720.0; cp = cp * r2 - 1.0 / 24.0; cp = cp * r2 + 0.5; cp = 1.0 - cp * r2;
          const int qd = ((int)nq) & 3;
          const double cv = qd == 0 ? cp : qd == 1 ? -sp : qd == 2 ? -cp : sp;
          const double sv_ = qd == 0 ? sp : qd == 1 ? cp : qd == 2 ? -sp : -cp;
          rope[2 * i] = (float)cv; rope[2 * i + 1] = (float)sv_; } }
    { float* h = WSP(float, WS_H); bf16* hb = WSP(bf16, WS_HB); float* ssq = WSP(float, WS_SSQ);
      for (int t = gw; t < T; t += NGW) { const int b = t / L, pos = t % L;
          const float* src = pos < NMETA ? c.in[1] + (size_t)pos * D : c.in[0] + ((size_t)b * SEQ + (pos - NMETA)) * D;
          float s = 0.f;
#pragma unroll
          for (int j = 0; j < 4; ++j) { const f32x4 v = *(const f32x4*)(src + j * 256 + c.lane * 4); *(f32x4*)(h + (size_t)t * D + j * 256 + c.lane * 4) = v;
              u32x2 o; o.x = pk2(v.x, v.y); o.y = pk2(v.z, v.w); *(u32x2*)(hb + (size_t)t * D + j * 256 + c.lane * 4) = o; s += (v.x * v.x + v.y * v.y) + (v.z * v.z + v.w * v.w); }
          s = wave_sum(s);
          if (c.lane < 8) ssq[(size_t)t * 8 + c.lane] = c.lane == 0 ? s : 0.f; } }
}

__device__ __forceinline__ void phase_A(const Ctx& c0, int l) {
    Ctx c = reopaque(c0);
    const bf16* hb = WSP(bf16, WS_HB); const bf16* Wt = (const bf16*)(c.ws + WS_WIN + l * SZ_WLAYER);
    const float* ssq = WSP(float, WS_SSQ);
    bf16* uglu = WSP(bf16, WS_UGLU); bf16* cq = WSP(bf16, WS_CQ); bf16* ckv = WSP(bf16, WS_CKV); float* krope = WSP(float, WS_KROPE);
    float* ssqq = WSP(float, WS_SSQQ); float* ssqkv = WSP(float, WS_SSQKV); bf16* gates = WSP(bf16, WS_GATES);
    constexpr int NT = NINP / 128;
    const int r = c.lane & 15, q = c.lane >> 4;
    const int xcd = c.vb / (c.G / 8), lb = c.vb % (c.G / 8), xm = xcd & 1, xn = xcd >> 1;
    const int m_lo = xm ? (MT + 1) / 2 : 0, m_cnt = xm ? MT / 2 : (MT + 1) / 2;
    for (int j = lb; j < m_cnt * 7; j += c.G / 8) {
        const int mt = m_lo + j / 7, nt = xn * 7 + j % 7;
        f32x4 acc[2][8]; acc_zero(acc);
        gemm_core(acc, hb + (size_t)mt * 128 * D, D, Wt + (size_t)nt * 128 * D, D, D, c.lds, c.tid);
#pragma unroll
        for (int mi = 0; mi < 2; ++mi) {
            const int tok = mt * 128 + 32 * c.wave + 16 * mi + r;
            const float rs = rstd_from_ssq8(ssq, tok);
            if (nt < 8) {
#pragma unroll
                for (int ni = 0; ni < 4; ++ni) { const f32x4 v = acc[mi][ni] * rs, g = acc[mi][ni + 4] * rs;
                    u32x2 o; o.x = pk2(v.x * sigmoidf_(g.x), v.y * sigmoidf_(g.y)); o.y = pk2(v.z * sigmoidf_(g.z), v.w * sigmoidf_(g.w));
                    *(u32x2*)(uglu + (size_t)tok * DC + nt * 64 + 16 * ni + 4 * q) = o; }
            } else if (nt < 11) {
                bf16* dst = nt < 10 ? cq + (size_t)tok * QL + (nt - 8) * 128 : ckv + (size_t)tok * KVL;
                float ss = 0.f;
#pragma unroll
                for (int ni = 0; ni < 8; ++ni) { const f32x4 v = acc[mi][ni] * rs; ss += (v.x * v.x + v.y * v.y) + (v.z * v.z + v.w * v.w);
                    u32x2 o; o.x = pk2(v.x, v.y); o.y = pk2(v.z, v.w); *(u32x2*)(dst + 16 * ni + 4 * q) = o; }
                ss = quad_sum(ss);
                if (q == 0) { if (nt < 10) ssqq[(size_t)tok * 2 + (nt - 8)] = ss; else ssqkv[tok] = ss; }
            } else if (nt == 11) {
#pragma unroll
                for (int ni = 0; ni < 2; ++ni) *(f32x4*)(krope + (size_t)tok * 32 + 16 * ni + 4 * q) = acc[mi][ni] * rs;
            } else {
#pragma unroll
                for (int ni = 0; ni < 8; ++ni) { const f32x4 v = acc[mi][ni] * rs;
                    u32x2 o; o.x = pk2(sigmoidf_(v.x), sigmoidf_(v.y)); o.y = pk2(sigmoidf_(v.z), sigmoidf_(v.w));
                    *(u32x2*)(gates + (size_t)tok * 2048 + (nt - 12) * 128 + 16 * ni + 4 * q) = o; }
            }
        }
    }
}

__device__ __forceinline__ void phaseB_q_item(Ctx& c, int l, int mt, int head) {
    const bf16* cq = WSP(bf16, WS_CQ); const bf16* Wt = (const bf16*)(c.ws + WS_WIN + l * SZ_WLAYER + OFF_WUQ);
    const float* ssqq = WSP(float, WS_SSQQ); const float* rope = WSP(float, WS_ROPE); const float* qg = c.in[13] + l * QK; bf16* Qb = WSP(bf16, WS_Q);
    const int r = c.lane & 15, q = c.lane >> 4;
    f32x4 acc[2][8]; acc_zero(acc);
    gemm_core(acc, cq + (size_t)mt * 128 * QL, QL, Wt + (size_t)head * 128 * QL, QL, QL, c.lds, c.tid);
    constexpr float QSCALE = 0.10206207261596575f * 1.4426950408889634f;
#pragma unroll
    for (int mi = 0; mi < 2; ++mi) {
        const int tok = mt * 128 + 32 * c.wave + 16 * mi + r, b = tok / L, pos = tok - b * L;
        const float rs = rsqrt_((ssqq[(size_t)tok * 2] + ssqq[(size_t)tok * 2 + 1]) * (1.0f / 256.0f) + EPS);
        float ss = 0.f;
#pragma unroll
        for (int ni = 0; ni < 6; ++ni) { acc[mi][ni] = acc[mi][ni] * rs; const f32x4 v = acc[mi][ni]; ss += (v.x * v.x + v.y * v.y) + (v.z * v.z + v.w * v.w); }
        ss = quad_sum(ss);
        const float rn = rsqrt_(ss * (1.0f / 96.0f) + EPS) * QSCALE;
#pragma unroll
        for (int ni = 0; ni < 6; ++ni) { const f32x4 g = *(const f32x4*)(qg + 16 * ni + 4 * q); acc[mi][ni] = acc[mi][ni] * g * rn; }
        const f32x4 cs0 = *(const f32x4*)(rope + ((size_t)pos * 16 + 4 * q) * 2), cs1 = *(const f32x4*)(rope + ((size_t)pos * 16 + 4 * q) * 2 + 4);
        const float co[4] = {cs0.x, cs0.z, cs1.x, cs1.z}, si[4] = {cs0.y, cs0.w, cs1.y, cs1.w};
        f32x4 x1 = acc[mi][4], x2 = acc[mi][5];
#pragma unroll
        for (int e = 0; e < 4; ++e) { const float a = x1[e], bb = x2[e]; x1[e] = a * co[e] - bb * si[e]; x2[e] = bb * co[e] + a * si[e]; }
        acc[mi][4] = x1; acc[mi][5] = x2;
        bf16* dst = Qb + (((size_t)b * NH + head) * L + pos) * QK;
#pragma unroll
        for (int ni = 0; ni < 6; ++ni) { const f32x4 v = acc[mi][ni]; u32x2 o; o.x = pk2(v.x, v.y); o.y = pk2(v.z, v.w); *(u32x2*)(dst + 16 * ni + 4 * q) = o; }
    }
}
__device__ __forceinline__ void phaseB_kv_item(Ctx& c, int l, int mt, int head) {
    const bf16* ckv = WSP(bf16, WS_CKV); const bf16* Wt = (const bf16*)(c.ws + WS_WIN + l * SZ_WLAYER + OFF_WUKV);
    const float* ssqkv = WSP(float, WS_SSQKV); const float* rope = WSP(float, WS_ROPE); const float* kg = c.in[14] + l * QK; const float* krope = WSP(float, WS_KROPE);
    bf16* Kb = WSP(bf16, WS_K); bf16* Vt = WSP(bf16, WS_VT);
    const int tid = c.tid, wave = c.wave, lane = c.lane, r = lane & 15, q = lane >> 4;
    unsigned char* lds = c.lds;
    f32x4 ak[2][4], av[2][4];
#pragma unroll
    for (int mi = 0; mi < 2; ++mi)
#pragma unroll
        for (int ni = 0; ni < 4; ++ni) { ak[mi][ni] = (f32x4){0.f, 0.f, 0.f, 0.f}; av[mi][ni] = (f32x4){0.f, 0.f, 0.f, 0.f}; }
    { const int chunk = tid & 7, row0 = tid >> 3;
      const bf16* pa = ckv + ((size_t)mt * 128 + row0) * KVL + chunk * 8; const bf16* pb = Wt + ((size_t)head * 128 + row0) * KVL + chunk * 8;
#pragma unroll
      for (int s = 0; s < 2; ++s)
#pragma unroll
          for (int i = 0; i < 4; ++i) { *(u32x4*)(lds + s * 32768 + lds_off(row0 + 32 * i, chunk)) = *(const u32x4*)(pa + (size_t)(32 * i) * KVL + s * 64);
              *(u32x4*)(lds + s * 32768 + 16384 + lds_off(row0 + 32 * i, chunk)) = *(const u32x4*)(pb + (size_t)(32 * i) * KVL + s * 64); }
    }
    __syncthreads();
#pragma unroll
    for (int s = 0; s < 2; ++s)
#pragma unroll
        for (int ks = 0; ks < 2; ++ks) {
            const unsigned char* sA = lds + s * 32768; const unsigned char* sB = sA + 16384;
            bf16x8 af[2], bfr[8];
#pragma unroll
            for (int mi = 0; mi < 2; ++mi) af[mi] = *(const bf16x8*)(sA + lds_off(32 * wave + 16 * mi + r, 4 * ks + q));
#pragma unroll
            for (int ni = 0; ni < 8; ++ni) bfr[ni] = *(const bf16x8*)(sB + lds_off(16 * ni + r, 4 * ks + q));
#pragma unroll
            for (int mi = 0; mi < 2; ++mi)
#pragma unroll
                for (int ni = 0; ni < 4; ++ni) { ak[mi][ni] = __builtin_amdgcn_mfma_f32_16x16x32_bf16(bfr[ni], af[mi], ak[mi][ni], 0, 0, 0);
                    av[mi][ni] = __builtin_amdgcn_mfma_f32_16x16x32_bf16(af[mi], bfr[ni + 4], av[mi][ni], 0, 0, 0); }
        }
    __syncthreads();
#pragma unroll
    for (int mi = 0; mi < 2; ++mi) {
        const int tok0 = mt * 128 + 32 * wave + 16 * mi, b = tok0 / L, pos0 = tok0 - b * L;
        { const int tok = tok0 + r, pos = pos0 + r;
          const float rs = rsqrt_(ssqkv[tok] * (1.0f / 128.0f) + EPS);
          const f32x4 kr1 = *(const f32x4*)(krope + (size_t)tok * 32 + 4 * q), kr2 = *(const f32x4*)(krope + (size_t)tok * 32 + 16 + 4 * q);
          float ss = (kr1.x * kr1.x + kr1.y * kr1.y) + (kr1.z * kr1.z + kr1.w * kr1.w) + (kr2.x * kr2.x + kr2.y * kr2.y) + (kr2.z * kr2.z + kr2.w * kr2.w);
#pragma unroll
          for (int ni = 0; ni < 4; ++ni) { ak[mi][ni] = ak[mi][ni] * rs; const f32x4 v = ak[mi][ni]; ss += (v.x * v.x + v.y * v.y) + (v.z * v.z + v.w * v.w); }
          ss = quad_sum(ss);
          const float rn = rsqrt_(ss * (1.0f / 96.0f) + EPS);
          bf16* dst = Kb + (((size_t)b * NH + head) * L + pos) * QK;
#pragma unroll
          for (int ni = 0; ni < 4; ++ni) { const f32x4 g = *(const f32x4*)(kg + 16 * ni + 4 * q); const f32x4 v = ak[mi][ni] * g * rn;
              u32x2 o; o.x = pk2(v.x, v.y); o.y = pk2(v.z, v.w); *(u32x2*)(dst + 16 * ni + 4 * q) = o; }
          const f32x4 g1 = *(const f32x4*)(kg + 64 + 4 * q), g2 = *(const f32x4*)(kg + 80 + 4 * q);
          f32x4 x1 = kr1 * g1 * rn, x2 = kr2 * g2 * rn;
          const f32x4 cs0 = *(const f32x4*)(rope + ((size_t)pos * 16 + 4 * q) * 2), cs1 = *(const f32x4*)(rope + ((size_t)pos * 16 + 4 * q) * 2 + 4);
          const float co[4] = {cs0.x, cs0.z, cs1.x, cs1.z}, si[4] = {cs0.y, cs0.w, cs1.y, cs1.w};
#pragma unroll
          for (int e = 0; e < 4; ++e) { const float a = x1[e], bb = x2[e]; x1[e] = a * co[e] - bb * si[e]; x2[e] = bb * co[e] + a * si[e]; }
          u32x2 o1, o2; o1.x = pk2(x1.x, x1.y); o1.y = pk2(x1.z, x1.w); o2.x = pk2(x2.x, x2.y); o2.y = pk2(x2.z, x2.w);
          *(u32x2*)(dst + 64 + 4 * q) = o1; *(u32x2*)(dst + 80 + 4 * q) = o2; }
        { const f32x4 sq = *(const f32x4*)(ssqkv + tok0 + 4 * q);
          f32x4 rs4; rs4.x = rsqrt_(sq.x * (1.0f / 128.0f) + EPS); rs4.y = rsqrt_(sq.y * (1.0f / 128.0f) + EPS); rs4.z = rsqrt_(sq.z * (1.0f / 128.0f) + EPS); rs4.w = rsqrt_(sq.w * (1.0f / 128.0f) + EPS);
#pragma unroll
          for (int ni = 0; ni < 4; ++ni) { const f32x4 v = av[mi][ni] * rs4; u32x2 o; o.x = pk2(v.x, v.y); o.y = pk2(v.z, v.w);
              *(u32x2*)(Vt + (((size_t)b * NH + head) * VD + 16 * ni + r) * L + pos0 + 4 * q) = o; } }
    }
}
__device__ __forceinline__ u32x4 conv_row(const bf16* uglu, int b, int pos, int ch) {
    u32x4 xv = (u32x4){0u, 0u, 0u, 0u};
    if (pos >= 0) xv = *(const u32x4*)(uglu + ((size_t)b * L + pos) * DC + ch);
    return xv;
}
__device__ __forceinline__ void conv_fma(float (&a)[8], const u32x4 xv, const f32x4 w0, const f32x4 w1) {
    a[0] += bf_lo(xv.x) * w0.x; a[1] += bf_hi(xv.x) * w0.y; a[2] += bf_lo(xv.y) * w0.z; a[3] += bf_hi(xv.y) * w0.w;
    a[4] += bf_lo(xv.z) * w1.x; a[5] += bf_hi(xv.z) * w1.y; a[6] += bf_lo(xv.w) * w1.z; a[7] += bf_hi(xv.w) * w1.w;
}
__device__ __forceinline__ void phaseB_conv_item(Ctx& c, int l, int grp) {
    const bf16* uglu = WSP(bf16, WS_UGLU); bf16* u2 = WSP(bf16, WS_U2);
    const float* cw = c.in[4] + (size_t)l * CW * DC; const float* cb = c.in[5] + l * DC; const float* lg = c.in[6] + l * DC; const float* lb = c.in[7] + l * DC;
    const int tok0 = grp * 4, b = tok0 / L, pos0 = tok0 - b * L, ch = c.lane * 8;
    float acc[4][8];
    { const f32x4 b0 = *(const f32x4*)(cb + ch), b1 = *(const f32x4*)(cb + ch + 4);
#pragma unroll
      for (int d = 0; d < 4; ++d) { acc[d][0] = b0.x; acc[d][1] = b0.y; acc[d][2] = b0.z; acc[d][3] = b0.w; acc[d][4] = b1.x; acc[d][5] = b1.y; acc[d][6] = b1.z; acc[d][7] = b1.w; } }
    const int base = pos0 - 30;
    u32x4 x0 = conv_row(uglu, b, base + 0, ch), x1 = conv_row(uglu, b, base + 1, ch), x2 = conv_row(uglu, b, base + 2, ch),
          x3 = conv_row(uglu, b, base + 3, ch), x4 = conv_row(uglu, b, base + 4, ch), x5;
    const float* wp = cw + ch;
#pragma unroll 1
    for (int w = 0; w < CW; ++w) {
        x5 = conv_row(uglu, b, (w + 5 <= 33) ? base + w + 5 : -1, ch);
        const f32x4 w0 = *(const f32x4*)wp, w1 = *(const f32x4*)(wp + 4); wp += DC;
        conv_fma(acc[0], x0, w0, w1); conv_fma(acc[1], x1, w0, w1); conv_fma(acc[2], x2, w0, w1); conv_fma(acc[3], x3, w0, w1);
        x0 = x1; x1 = x2; x2 = x3; x3 = x4; x4 = x5;
    }
    const f32x4 g0 = *(const f32x4*)(lg + ch), g1 = *(const f32x4*)(lg + ch + 4), e0 = *(const f32x4*)(lb + ch), e1 = *(const f32x4*)(lb + ch + 4);
    const float gg[8] = {g0.x, g0.y, g0.z, g0.w, g1.x, g1.y, g1.z, g1.w}, be[8] = {e0.x, e0.y, e0.z, e0.w, e1.x, e1.y, e1.z, e1.w};
#pragma unroll
    for (int d = 0; d < 4; ++d) {
        float s = 0.f;
#pragma unroll
        for (int j = 0; j < 8; ++j) s += acc[d][j];
        const float mu = wave_sum(s) * (1.0f / 512.0f);
        float vq = 0.f;
#pragma unroll
        for (int j = 0; j < 8; ++j) { acc[d][j] -= mu; vq += acc[d][j] * acc[d][j]; }
        const float rstd = rsqrt_(wave_sum(vq) * (1.0f / 512.0f) + EPS);
        float y[8];
#pragma unroll
        for (int j = 0; j < 8; ++j) { const float v = acc[d][j] * rstd * gg[j] + be[j]; y[j] = v * sigmoidf_(v); }
        u32x4 o; o.x = pk2(y[0], y[1]); o.y = pk2(y[2], y[3]); o.z = pk2(y[4], y[5]); o.w = pk2(y[6], y[7]);
        *(u32x4*)(u2 + (size_t)(tok0 + d) * DC + ch) = o;
    }
}
__device__ __forceinline__ void phase_B(const Ctx& c0, int l) {
    Ctx c = reopaque(c0);
    constexpr int NQ = MT * NH, NKV = MT * NH, NCV = T / 16;
    for (int it = c.vb; it < NQ + NKV + NCV; it += c.G) {
        if (it < NQ) phaseB_q_item(c, l, it / NH, it % NH);
        else if (it < NQ + NKV) phaseB_kv_item(c, l, (it - NQ) / NH, (it - NQ) % NH);
        else phaseB_conv_item(c, l, (it - NQ - NKV) * 4 + c.wave);
    }
}

constexpr int KROW = 208, VROW = 136, ATT_STAGE = 64 * KROW + 64 * VROW;
constexpr int ATT_ITEMS = NB * NH * 17;
__device__ __forceinline__ void phase_C(const Ctx& c0, int l) {
    Ctx c = reopaque(c0);
    const bf16* Qb = WSP(bf16, WS_Q); const bf16* Kb = WSP(bf16, WS_K); const bf16* Vt = WSP(bf16, WS_VT); bf16* O = WSP(bf16, WS_O);
    unsigned* qctr = WSP(unsigned, WS_CTL) + CW_QUEUE + 64 * l;
    volatile unsigned* misc = (volatile unsigned*)(c.lds + LDS_MISC);
    const int tid = c.tid, wave = c.wave, lane = c.lane, r = lane & 15, q = lane >> 4;
    unsigned char* lds = c.lds;
    for (;;) {
        if (tid == 0) misc[4] = atomicAdd(qctr, 1u);
        __syncthreads();
        const int item = __builtin_amdgcn_readfirstlane((int)misc[4]);
        __syncthreads();
        if (item >= ATT_ITEMS) break;
        const int pp = 15 - item / 64, bh = item % 64, b = bh / NH, h = bh % NH;
        const bool meta = pp < 0;
        const int r0 = meta ? 0 : 16 + 128 * pp;
        const int nfull = meta ? 0 : 2 * pp + 1 + (wave >> 1);
        const int ntiles = meta ? 1 : 2 * pp + 3;
        const bf16* Kbase = Kb + (size_t)bh * L * QK; const bf16* Vbase = Vt + (size_t)bh * VD * L;
        bf16x8 qf[2][3];
#pragma unroll
        for (int mi = 0; mi < 2; ++mi)
#pragma unroll
            for (int ks = 0; ks < 3; ++ks) qf[mi][ks] = *(const bf16x8*)(Qb + ((size_t)bh * L + r0 + 32 * wave + 16 * mi + r) * QK + 32 * ks + 8 * q);
        float m[2] = {-1e30f, -1e30f}, lsum[2] = {0.f, 0.f};
        f32x4 o[2][4];
#pragma unroll
        for (int mi = 0; mi < 2; ++mi)
#pragma unroll
            for (int dt = 0; dt < 4; ++dt) o[mi][dt] = (f32x4){0.f, 0.f, 0.f, 0.f};
        u32x4 rk[3], rv[2];
        auto gload = [&](int kt) {
#pragma unroll
            for (int i = 0; i < 3; ++i) { const int id = tid + 256 * i, row = id / 12, cc = id % 12; rk[i] = *(const u32x4*)(Kbase + (size_t)(kt * 64 + row) * QK + cc * 8); }
#pragma unroll
            for (int i = 0; i < 2; ++i) { const int id = tid + 256 * i, row = id >> 3, cc = id & 7; rv[i] = *(const u32x4*)(Vbase + (size_t)row * L + kt * 64 + cc * 8); }
        };
        auto lstore = [&](int s) {
            unsigned char* st = lds + s * ATT_STAGE;
#pragma unroll
            for (int i = 0; i < 3; ++i) { const int id = tid + 256 * i, row = id / 12, cc = id % 12; *(u32x4*)(st + row * KROW + cc * 16) = rk[i]; }
#pragma unroll
            for (int i = 0; i < 2; ++i) { const int id = tid + 256 * i, row = id >> 3, cc = id & 7; u32x2* d = (u32x2*)(st + 64 * KROW + row * VROW + cc * 16); d[0] = (u32x2){rv[i].x, rv[i].y}; d[1] = (u32x2){rv[i].z, rv[i].w}; }
        };
        gload(0); lstore(0);
#pragma unroll
        for (int mi = 0; mi < 2; ++mi)
#pragma unroll
            for (int ks = 0; ks < 3; ++ks) asm volatile("" : "+v"(qf[mi][ks]));
        __syncthreads();
        for (int kt = 0; kt < ntiles; ++kt) {
            const int cur = kt & 1;
            if (kt + 1 < ntiles) gload(kt + 1);
            const unsigned char* sK = lds + cur * ATT_STAGE; const unsigned char* sV = sK + 64 * KROW;
            const bool full = kt < nfull;
            if (kt <= nfull) {
                f32x4 s[2][4];
#pragma unroll
                for (int kh = 0; kh < 2; ++kh) {
                    bf16x8 kf[2][3];
#pragma unroll
                    for (int kk = 0; kk < 2; ++kk) if ((kh == 0 && kk == 0) || full) {
#pragma unroll
                        for (int ks = 0; ks < 3; ++ks) kf[kk][ks] = *(const bf16x8*)(sK + (16 * (2 * kh + kk) + r) * KROW + 64 * ks + 16 * q); }
#pragma unroll
                    for (int kk = 0; kk < 2; ++kk) { const int k4 = 2 * kh + kk;
#pragma unroll
                        for (int mi = 0; mi < 2; ++mi) s[mi][k4] = (f32x4){0.f, 0.f, 0.f, 0.f};
                        if (k4 == 0 || full) {
#pragma unroll
                            for (int ks = 0; ks < 3; ++ks)
#pragma unroll
                                for (int mi = 0; mi < 2; ++mi) s[mi][k4] = __builtin_amdgcn_mfma_f32_16x16x32_bf16(kf[kk][ks], qf[mi][ks], s[mi][k4], 0, 0, 0);
                        }
                    }
                }
                u32x2 vlo[4], vhi[4];
#pragma unroll
                for (int dt = 0; dt < 4; ++dt) { const unsigned char* vp = sV + (16 * dt + r) * VROW + (4 * q) * 2;
                    vlo[dt] = *(const u32x2*)vp; vhi[dt] = (u32x2){0u, 0u}; if (full) vhi[dt] = *(const u32x2*)(vp + 32); }
                bf16x8 pf[2][2];
#pragma unroll
                for (int mi = 0; mi < 2; ++mi) {
                    float mx = fmaxf(fmaxf(s[mi][0].x, s[mi][0].y), fmaxf(s[mi][0].z, s[mi][0].w));
                    if (full) {
#pragma unroll
                        for (int k4 = 1; k4 < 4; ++k4) mx = fmaxf(mx, fmaxf(fmaxf(s[mi][k4].x, s[mi][k4].y), fmaxf(s[mi][k4].z, s[mi][k4].w)));
                    }
                    mx = quad_max(mx);
                    const float mn = fmaxf(m[mi], mx), alpha = fast_exp2(m[mi] - mn); m[mi] = mn;
                    float ps = 0.f;
#pragma unroll
                    for (int k4 = 0; k4 < 4; ++k4) {
                        if (k4 == 0 || full) { f32x4 p; p.x = fast_exp2(s[mi][k4].x - mn); p.y = fast_exp2(s[mi][k4].y - mn); p.z = fast_exp2(s[mi][k4].z - mn); p.w = fast_exp2(s[mi][k4].w - mn);
                            ps += (p.x + p.y) + (p.z + p.w); s[mi][k4] = p; }
                    }
                    lsum[mi] = lsum[mi] * alpha + ps;
#pragma unroll
                    for (int dt = 0; dt < 4; ++dt) o[mi][dt] = o[mi][dt] * alpha;
#pragma unroll
                    for (int st = 0; st < 2; ++st) { u32x4 pw;
                        pw.x = pk2(s[mi][2 * st].x, s[mi][2 * st].y); pw.y = pk2(s[mi][2 * st].z, s[mi][2 * st].w); pw.z = pk2(s[mi][2 * st + 1].x, s[mi][2 * st + 1].y); pw.w = pk2(s[mi][2 * st + 1].z, s[mi][2 * st + 1].w);
                        if (!full) { pw.z = 0u; pw.w = 0u; }
                        pf[mi][st] = __builtin_bit_cast(bf16x8, pw); }
                }
                u32x2 wlo[4], whi[4];
                if (full) {
#pragma unroll
                    for (int dt = 0; dt < 4; ++dt) { const unsigned char* vp = sV + (16 * dt + r) * VROW + (32 + 4 * q) * 2; wlo[dt] = *(const u32x2*)vp; whi[dt] = *(const u32x2*)(vp + 32); } }
#pragma unroll
                for (int dt = 0; dt < 4; ++dt) { const bf16x8 vf = __builtin_bit_cast(bf16x8, (u32x4){vlo[dt].x, vlo[dt].y, vhi[dt].x, vhi[dt].y});
#pragma unroll
                    for (int mi = 0; mi < 2; ++mi) o[mi][dt] = __builtin_amdgcn_mfma_f32_16x16x32_bf16(vf, pf[mi][0], o[mi][dt], 0, 0, 0); }
                if (full) {
#pragma unroll
                    for (int dt = 0; dt < 4; ++dt) { const bf16x8 vf = __builtin_bit_cast(bf16x8, (u32x4){wlo[dt].x, wlo[dt].y, whi[dt].x, whi[dt].y});
#pragma unroll
                        for (int mi = 0; mi < 2; ++mi) o[mi][dt] = __builtin_amdgcn_mfma_f32_16x16x32_bf16(vf, pf[mi][1], o[mi][dt], 0, 0, 0); } }
            }
            if (kt + 1 < ntiles) lstore(cur ^ 1);
            __syncthreads();
        }
#pragma unroll
        for (int mi = 0; mi < 2; ++mi) {
            const float lt = quad_sum(lsum[mi]);
            if (!meta || (wave == 0 && mi == 0)) {
                const float inv = 1.0f / lt;
                bf16* dst = O + ((size_t)b * L + r0 + 32 * wave + 16 * mi + r) * 512 + h * VD;
#pragma unroll
                for (int dt = 0; dt < 4; ++dt) { const f32x4 v = o[mi][dt] * inv; u32x2 ov; ov.x = pk2(v.x, v.y); ov.y = pk2(v.z, v.w); *(u32x2*)(dst + 16 * dt + 4 * q) = ov; }
            }
        }
    }
}

__device__ __forceinline__ int tile_tok0(int mt, int l) { return l == 1 ? mt * 128 + NMETA * ((mt >> 4) + 1) : mt * 128; }
__device__ __forceinline__ int n_mtiles(int l) { return l == 1 ? 128 : MT; }
__device__ __forceinline__ void phase_D(const Ctx& c0, int l) {
    Ctx c = reopaque(c0);
    const bf16* u2 = WSP(bf16, WS_U2); const bf16* O = WSP(bf16, WS_O); const bf16* gates = WSP(bf16, WS_GATES); bf16* merged = WSP(bf16, WS_MERGED);
    const bf16* Wco = (const bf16*)(c.ws + WS_WIN + l * SZ_WLAYER + OFF_WCO); const bf16* Wmla = (const bf16*)(c.ws + WS_WIN + l * SZ_WLAYER + OFF_WMLA);
    const int r = c.lane & 15, q = c.lane >> 4;
    for (int it = c.vb; it < n_mtiles(l) * 8; it += c.G) {
        const int mt = it / 8, nt = it % 8, tk0 = tile_tok0(mt, l);
        f32x4 acc[2][8]; acc_zero(acc);
        gemm_core(acc, u2 + (size_t)tk0 * 512, 512, Wco + (size_t)nt * 128 * 512, 512, 512, c.lds, c.tid);
#pragma unroll
        for (int mi = 0; mi < 2; ++mi) { const int tok = tk0 + 32 * c.wave + 16 * mi + r;
            const bf16* gp = gates + (size_t)tok * 2048 + nt * 128 + 4 * q; bf16* mp = merged + (size_t)tok * D + nt * 128 + 4 * q;
#pragma unroll
            for (int ni = 0; ni < 8; ++ni) { const u32x2 g = *(const u32x2*)(gp + 16 * ni); const f32x4 v = acc[mi][ni];
                u32x2 o; o.x = pk2(v.x * bf_lo(g.x), v.y * bf_hi(g.x)); o.y = pk2(v.z * bf_lo(g.y), v.w * bf_hi(g.y)); *(u32x2*)(mp + 16 * ni) = o; } }
        acc_zero(acc);
        gemm_core(acc, O + (size_t)tk0 * 512, 512, Wmla + (size_t)nt * 128 * 512, 512, 512, c.lds, c.tid);
#pragma unroll
        for (int mi = 0; mi < 2; ++mi) { const int tok = tk0 + 32 * c.wave + 16 * mi + r;
            const bf16* gp = gates + (size_t)tok * 2048 + 1024 + nt * 128 + 4 * q; bf16* mp = merged + (size_t)tok * D + nt * 128 + 4 * q;
#pragma unroll
            for (int ni = 0; ni < 8; ++ni) { const u32x2 g = *(const u32x2*)(gp + 16 * ni); const u32x2 s = *(const u32x2*)(mp + 16 * ni); const f32x4 v = acc[mi][ni];
                u32x2 o; o.x = pk2(bf_lo(s.x) + v.x * bf_lo(g.x), bf_hi(s.x) + v.y * bf_hi(g.x)); o.y = pk2(bf_lo(s.y) + v.z * bf_lo(g.y), bf_hi(s.y) + v.w * bf_hi(g.y));
                *(u32x2*)(mp + 16 * ni) = o; } }
    }
}

__device__ __forceinline__ void phase_E(const Ctx& c0, int l) {
    Ctx c = reopaque(c0);
    const bf16* merged = WSP(bf16, WS_MERGED); const bf16* Wout = (const bf16*)(c.ws + WS_WIN + l * SZ_WLAYER + OFF_WOUT);
    float* h = WSP(float, WS_H); bf16* hb = WSP(bf16, WS_HB); float* ssq = WSP(float, WS_SSQ);
    const int r = c.lane & 15, q = c.lane >> 4;
    for (int it = c.vb; it < n_mtiles(l) * 8; it += c.G) {
        const int mt = it / 8, nt = it % 8, tk0 = tile_tok0(mt, l);
        f32x4 acc[2][8]; acc_zero(acc);
        gemm_core(acc, merged + (size_t)tk0 * D, D, Wout + (size_t)nt * 128 * D, D, D, c.lds, c.tid);
#pragma unroll
        for (int mi = 0; mi < 2; ++mi) { const int tok = tk0 + 32 * c.wave + 16 * mi + r; float ss = 0.f;
#pragma unroll
            for (int ni = 0; ni < 8; ++ni) { float* hp = h + (size_t)tok * D + nt * 128 + 16 * ni + 4 * q; const f32x4 v = *(const f32x4*)hp + acc[mi][ni]; *(f32x4*)hp = v;
                ss += (v.x * v.x + v.y * v.y) + (v.z * v.z + v.w * v.w);
                u32x2 o; o.x = pk2(v.x, v.y); o.y = pk2(v.z, v.w); *(u32x2*)(hb + (size_t)tok * D + nt * 128 + 16 * ni + 4 * q) = o; }
            ss = quad_sum(ss);
            if (q == 0) ssq[(size_t)tok * 8 + nt] = ss; }
    }
}

__device__ __forceinline__ unsigned f2key(float f) { const unsigned u = __float_as_uint(f); return u ^ ((u >> 31) ? 0xFFFFFFFFu : 0x80000000u); }
__device__ __forceinline__ float key2f(unsigned k) { const unsigned u = (k >> 31) ? (k ^ 0x80000000u) : ~k; return __uint_as_float(u); }
__device__ __forceinline__ void top16_insert(unsigned (&lst)[16], unsigned x) {
#pragma unroll
    for (int i = 0; i < 16; ++i) { const unsigned a = lst[i]; lst[i] = a > x ? a : x; x = a > x ? x : a; }
}
__device__ __forceinline__ void ce_desc(unsigned& a, unsigned& b) { const unsigned mx = a > b ? a : b, mn = a > b ? b : a; a = mx; b = mn; }
__device__ __forceinline__ void sort16_desc(unsigned (&v)[16]) {
#pragma unroll
    for (int k = 2; k <= 16; k <<= 1)
#pragma unroll
        for (int j = k >> 1; j > 0; j >>= 1)
#pragma unroll
            for (int i = 0; i < 16; ++i) { const int p = i ^ j; if (p > i) { if ((i & k) == 0) ce_desc(v[i], v[p]); else ce_desc(v[p], v[i]); } }
}
__device__ __forceinline__ void merge_top16(unsigned (&a)[16], const unsigned (&b)[16]) {
#pragma unroll
    for (int i = 0; i < 16; ++i) a[i] = a[i] > b[15 - i] ? a[i] : b[15 - i];
#pragma unroll
    for (int j = 8; j > 0; j >>= 1)
#pragma unroll
        for (int i = 0; i < 16; ++i) { const int p = i ^ j; if (p > i) ce_desc(a[i], a[p]); }
}
__device__ __forceinline__ void phase_F(const Ctx& c0, int l) {
    Ctx c = reopaque(c0);
    const bf16* hb = WSP(bf16, WS_HB); const bf16* Wpq = (const bf16*)(c.ws + WS_WIN + l * SZ_WLAYER + OFF_WPQ); const bf16* keys = (const bf16*)(c.ws + WS_WIN + l * SZ_WLAYER + OFF_KEYS);
    const float* ssq = WSP(float, WS_SSQ); float* sv = WSP(float, WS_SV); unsigned char* si = WSP(unsigned char, WS_SI);
    const int tid = c.tid, wave = c.wave, lane = c.lane, r = lane & 15, q = lane >> 4;
    unsigned char* lds = c.lds;
    const int xcd = c.vb / (c.G / 8), lb = c.vb % (c.G / 8), xm = xcd & 1, xn = xcd >> 1, nmt = n_mtiles(l);
    const int m_lo = xm ? (nmt + 1) / 2 : 0, m_cnt = xm ? nmt / 2 : (nmt + 1) / 2;
    for (int j = lb; j < m_cnt * 4; j += c.G / 8) {
        const int mt = m_lo + j / 4, hp = xn * 4 + j % 4, tk0 = tile_tok0(mt, l);
        f32x4 acc[2][8]; acc_zero(acc);
        gemm_core(acc, hb + (size_t)tk0 * D, D, Wpq + (size_t)hp * 128 * D, D, D, lds, tid);
#pragma unroll
        for (int mi = 0; mi < 2; ++mi) { const int row = 32 * wave + 16 * mi + r; const float rs = rstd_from_ssq8(ssq, tk0 + row);
#pragma unroll
            for (int ni = 0; ni < 8; ++ni) { const f32x4 v = acc[mi][ni] * rs; u32x2 o; o.x = pk2(v.x, v.y); o.y = pk2(v.z, v.w);
                *(u32x2*)(lds + (ni >> 2) * 32768 + lds_off(row, 2 * (ni & 3) + (q >> 1)) + 8 * (q & 1)) = o; } }
        { const int chunk = tid & 7, row0 = tid >> 3; const bf16* pb = keys + ((size_t)hp * 128 + row0) * 128 + chunk * 8;
#pragma unroll
          for (int s = 0; s < 2; ++s)
#pragma unroll
              for (int i = 0; i < 4; ++i) *(u32x4*)(lds + s * 32768 + 16384 + lds_off(row0 + 32 * i, chunk)) = *(const u32x4*)(pb + (size_t)(32 * i) * 128 + s * 64); }
        __syncthreads();
        acc_zero(acc);
        gemm_compute_stage(acc, lds, lds + 16384, wave, lane);
        gemm_compute_stage(acc, lds + 32768, lds + 32768 + 16384, wave, lane);
        __syncthreads();
        float* S = (float*)lds;
#pragma unroll
        for (int mi = 0; mi < 2; ++mi) { const int row = 32 * wave + 16 * mi + r;
#pragma unroll
            for (int ni = 0; ni < 8; ++ni) *(f32x4*)(S + row * 132 + 16 * ni + 4 * q) = acc[mi][ni]; }
        __syncthreads();
        {
            const int tl = 32 * wave + (lane & 31), half = lane >> 5;
            const float* row = S + tl * 132;
            unsigned lst[16];
#pragma unroll
            for (int g = 0; g < 4; ++g) {
                unsigned cur[16];
#pragma unroll
                for (int j = 0; j < 4; ++j) { const int col = 64 * half + 16 * g + 4 * j; const f32x4 v = *(const f32x4*)(row + col);
                    cur[4 * j] = (f2key(v.x) & ~127u) | (unsigned)(127 - col); cur[4 * j + 1] = (f2key(v.y) & ~127u) | (unsigned)(127 - (col + 1));
                    cur[4 * j + 2] = (f2key(v.z) & ~127u) | (unsigned)(127 - (col + 2)); cur[4 * j + 3] = (f2key(v.w) & ~127u) | (unsigned)(127 - (col + 3)); }
                sort16_desc(cur);
                if (g == 0) {
#pragma unroll
                    for (int i = 0; i < 16; ++i) lst[i] = cur[i];
                } else merge_top16(lst, cur);
            }
            unsigned oth[16];
#pragma unroll
            for (int i = 0; i < 16; ++i) { auto rr = __builtin_amdgcn_permlane32_swap(lst[i], lst[i], false, false); oth[i] = half == 0 ? rr[1] : rr[0]; }
            merge_top16(lst, oth);
            if (half == 0) {
                const int tok = tk0 + tl;
                unsigned idx[16]; float val[16];
#pragma unroll
                for (int i = 0; i < 16; ++i) { idx[i] = 127u - (lst[i] & 127u); val[i] = row[idx[i]]; }
                float* svp = sv + ((size_t)tok * 16 + hp) * 16;
#pragma unroll
                for (int i = 0; i < 4; ++i) *(f32x4*)(svp + 4 * i) = (f32x4){val[4 * i], val[4 * i + 1], val[4 * i + 2], val[4 * i + 3]};
                u32x4 pi;
                pi.x = idx[0] | (idx[1] << 8) | (idx[2] << 16) | (idx[3] << 24); pi.y = idx[4] | (idx[5] << 8) | (idx[6] << 16) | (idx[7] << 24);
                pi.z = idx[8] | (idx[9] << 8) | (idx[10] << 16) | (idx[11] << 24); pi.w = idx[12] | (idx[13] << 8) | (idx[14] << 16) | (idx[15] << 24);
                *(u32x4*)(si + ((size_t)tok * 16 + hp) * 16) = pi;
            }
        }
        __syncthreads();
    }
}

__device__ __forceinline__ void phase_F3(const Ctx& c0, int l) {
    Ctx c = reopaque(c0);
    const float* sv = WSP(float, WS_SV); const unsigned char* si = WSP(unsigned char, WS_SI); int* eidx = WSP(int, WS_EIDX); float* gw = WSP(float, WS_GW); unsigned char* stb = WSP(unsigned char, WS_STB);
    float* lsv = (float*)c.lds;
    unsigned char* lsi = c.lds + 256 * 33 * 4;
    const int tid = c.tid;
    const int ntok = l == 1 ? NB * SEQ : T;
    for (int base = c.vb * NTHREADS; base < ntok * 8; base += c.G * NTHREADS) {
        const int thc = base + tid, tkc = thc >> 3;
        const int th = (l == 1 ? tkc + NMETA * ((tkc >> 11) + 1) : tkc) * 8 + (thc & 7);
        float a[16], b[16];
#pragma unroll
        for (int i = 0; i < 4; ++i) { const f32x4 x = *(const f32x4*)(sv + (size_t)th * 32 + 4 * i), y = *(const f32x4*)(sv + (size_t)th * 32 + 16 + 4 * i);
            a[4 * i] = x.x; a[4 * i + 1] = x.y; a[4 * i + 2] = x.z; a[4 * i + 3] = x.w; b[4 * i] = y.x; b[4 * i + 1] = y.y; b[4 * i + 2] = y.z; b[4 * i + 3] = y.w; }
        const u32x4 ia = *(const u32x4*)(si + (size_t)th * 32), ib = *(const u32x4*)(si + (size_t)th * 32 + 16);
#pragma unroll
        for (int i = 0; i < 16; ++i) { lsv[tid * 33 + i] = a[i]; lsv[tid * 33 + 16 + i] = b[i]; }
        *(u32x4*)(lsi + tid * 32) = ia; *(u32x4*)(lsi + tid * 32 + 16) = ib;
        unsigned lst[16];
#pragma unroll
        for (int i = 0; i < 16; ++i) lst[i] = 0u;
#pragma unroll
        for (int i = 0; i < 16; ++i)
#pragma unroll
            for (int j = 0; j < 16; ++j)
                if ((i + 1) * (j + 1) <= 16) top16_insert(lst, (f2key(a[i] + b[j]) & ~255u) | (unsigned)(255 - (i * 16 + j)));
        __builtin_amdgcn_s_waitcnt(0xC07F); asm volatile("" ::: "memory");
        float s[16]; int e[16];
#pragma unroll
        for (int k = 0; k < 16; ++k) { const unsigned code = 255u - (lst[k] & 255u); const int i = code >> 4, j = code & 15;
            s[k] = lsv[tid * 33 + i] + lsv[tid * 33 + 16 + j]; e[k] = (int)lsi[tid * 32 + i] * 128 + (int)lsi[tid * 32 + 16 + j]; }
        float mx = s[0];
#pragma unroll
        for (int k = 1; k < 16; ++k) mx = fmaxf(mx, s[k]);
        float sum = 0.f;
#pragma unroll
        for (int k = 0; k < 16; ++k) { s[k] = fast_exp2((s[k] - mx) * 1.4426950409f); sum += s[k]; }
        const float inv = 1.0f / sum;
        typedef unsigned long long u64;
        u64 hlo = 0ull, hhi = 0ull;
#pragma unroll
        for (int k = 0; k < 16; ++k) { const int sl = e[k] >> 10; if (sl < 8) hlo += 1ull << (8 * sl); else hhi += 1ull << (8 * (sl - 8)); }
        u64 ilo = hlo, ihi = hhi;
#pragma unroll
        for (int d = 1; d < 8; d <<= 1) { const u64 a_ = __shfl_up(ilo, d, 8), b_ = __shfl_up(ihi, d, 8); if ((tid & 7) >= d) { ilo += a_; ihi += b_; } }
        const u64 tlo = __shfl(ilo, 7, 8), thi = __shfl(ihi, 7, 8);
        const u64 ones = 0x0101010101010101ull;
        const u64 inlo = tlo * ones, inhi = thi * ones + (inlo >> 56) * ones;
        const u64 stlo = inlo - tlo, sthi = inhi - thi;
        u64 rlo = stlo + (ilo - hlo), rhi = sthi + (ihi - hhi);
        const int tokn = th >> 3;
#pragma unroll
        for (int k = 0; k < 16; ++k) { const int sl = e[k] >> 10; int pos;
            if (sl < 8) { pos = (int)((rlo >> (8 * sl)) & 255ull); rlo += 1ull << (8 * sl); } else { pos = (int)((rhi >> (8 * (sl - 8))) & 255ull); rhi += 1ull << (8 * (sl - 8)); }
            eidx[(size_t)tokn * 128 + pos] = e[k]; gw[(size_t)tokn * 128 + pos] = s[k] * inv; }
        if ((tid & 7) == 0) { u64* sp = (u64*)(stb + (size_t)tokn * 16); sp[0] = stlo; sp[1] = sthi; }
        __builtin_amdgcn_s_waitcnt(0xC07F); asm volatile("" ::: "memory");
    }
}

typedef float f32x2 __attribute__((ext_vector_type(2)));
constexpr int G2_WSTRIDE = 14336, G2_MAXTOK = 9;
__device__ __forceinline__ float fp8dot4(unsigned w, unsigned x01, unsigned x23, float acc) {
    const bf16x2 lo = __builtin_amdgcn_cvt_scalef32_pk_bf16_fp8(w, 1.0f, false), hi = __builtin_amdgcn_cvt_scalef32_pk_bf16_fp8(w, 1.0f, true);
    acc = __builtin_amdgcn_fdot2_f32_bf16(lo, __builtin_bit_cast(bf16x2, x01), acc, false);
    return __builtin_amdgcn_fdot2_f32_bf16(hi, __builtin_bit_cast(bf16x2, x23), acc, false);
}
__device__ __forceinline__ float reduce8_transposed(const float (&p)[8], int lane) {
    float s[4];
#pragma unroll
    for (int k = 0; k < 4; ++k) { auto r = __builtin_amdgcn_permlane32_swap(__float_as_uint(p[k]), __float_as_uint(p[k + 4]), false, false); s[k] = __uint_as_float(r[0]) + __uint_as_float(r[1]); }
    float t[2];
#pragma unroll
    for (int k = 0; k < 2; ++k) { auto r = __builtin_amdgcn_permlane16_swap(__float_as_uint(s[k]), __float_as_uint(s[k + 2]), false, false); t[k] = __uint_as_float(r[0]) + __uint_as_float(r[1]); }
    const float u0 = t[0] + dpp<0x128>(t[0]), u1 = t[1] + dpp<0x128>(t[1]);
    float r = (lane & 8) ? u1 : u0;
    r += dpp<0xB1>(r); r += dpp<0x4E>(r); r += dpp<0x141>(r);
    return r;
}
typedef int i32x4 __attribute__((ext_vector_type(4)));
__device__ __forceinline__ void fp8fma4(f32x2 (&acc)[8], int o, unsigned w, f32x2 a2) {
    const f32x2 lo = __builtin_amdgcn_cvt_scalef32_pk_f32_fp8(w, 1.0f, false), hi = __builtin_amdgcn_cvt_scalef32_pk_f32_fp8(w, 1.0f, true);
    acc[o] = __builtin_elementwise_fma(a2, lo, acc[o]); acc[o + 1] = __builtin_elementwise_fma(a2, hi, acc[o + 1]);
}
__device__ __forceinline__ void g2_u_chunk(u32x4 (&u)[8], const unsigned char* U, const int* pe_next, const float* pw_c, float* act_c, const u32x4 xq, float rs, int lane) {
    const i32x4 e0 = *(const i32x4*)pe_next, e1 = *(const i32x4*)(pe_next + 4);
    const int en[8] = {e0.x, e0.y, e0.z, e0.w, e1.x, e1.y, e1.z, e1.w};
    float p[8];
#pragma unroll
    for (int k = 0; k < 8; ++k) {
        int d = __builtin_amdgcn_sdot4((int)u[k].x, (int)xq.x, 0, false); d = __builtin_amdgcn_sdot4((int)u[k].y, (int)xq.y, d, false);
        d = __builtin_amdgcn_sdot4((int)u[k].z, (int)xq.z, d, false); d = __builtin_amdgcn_sdot4((int)u[k].w, (int)xq.w, d, false);
        p[k] = (float)d;
        asm volatile("" : "+v"(p[k]));
        u[k] = *(const u32x4*)(U + (size_t)__builtin_amdgcn_readfirstlane(en[k]) * 1024 + lane * 16);
    }
    const float a = reduce8_transposed(p, lane);
    const int row = (lane >> 3) & 7;
    if ((lane & 7) == 0) act_c[row] = gelu_tanh(a * rs) * pw_c[row];
}
__device__ __forceinline__ void g2_v_chunk(u32x4 (&v)[8], const unsigned char* V, const int* pe_next, const float* act_c, f32x2 (&acc)[8], int lane) {
    const i32x4 e0 = *(const i32x4*)pe_next, e1 = *(const i32x4*)(pe_next + 4);
    const int en[8] = {e0.x, e0.y, e0.z, e0.w, e1.x, e1.y, e1.z, e1.w};
    const f32x4 a0 = *(const f32x4*)act_c, a1 = *(const f32x4*)(act_c + 4);
    const float av[8] = {a0.x, a0.y, a0.z, a0.w, a1.x, a1.y, a1.z, a1.w};
#pragma unroll
    for (int k = 0; k < 8; ++k) { const f32x2 a2 = (f32x2){av[k], av[k]};
        fp8fma4(acc, 0, v[k].x, a2); fp8fma4(acc, 2, v[k].y, a2); fp8fma4(acc, 4, v[k].z, a2); fp8fma4(acc, 6, v[k].w, a2);
        asm volatile("" : "+v"(acc[0]), "+v"(acc[1]), "+v"(acc[2]), "+v"(acc[3]), "+v"(acc[4]), "+v"(acc[5]), "+v"(acc[6]), "+v"(acc[7]));
        v[k] = *(const u32x4*)(V + (size_t)__builtin_amdgcn_readfirstlane(en[k]) * 1024 + lane * 16);
    }
}
__device__ __forceinline__ void g2_finish_token(Ctx& c, int l, int tok, const f32x2 (&acc)[8], int lane) {
    float* h = WSP(float, WS_H); bf16* hbw = WSP(bf16, WS_HB); float* ssqw = WSP(float, WS_SSQ);
    float* hp = h + (size_t)tok * D + lane * 16;
    f32x4 r0 = *(const f32x4*)hp, r1 = *(const f32x4*)(hp + 4), r2 = *(const f32x4*)(hp + 8), r3 = *(const f32x4*)(hp + 12);
    r0 += (f32x4){acc[0].x, acc[0].y, acc[1].x, acc[1].y}; r1 += (f32x4){acc[2].x, acc[2].y, acc[3].x, acc[3].y};
    r2 += (f32x4){acc[4].x, acc[4].y, acc[5].x, acc[5].y}; r3 += (f32x4){acc[6].x, acc[6].y, acc[7].x, acc[7].y};
    if (l == 0) {
        *(f32x4*)hp = r0; *(f32x4*)(hp + 4) = r1; *(f32x4*)(hp + 8) = r2; *(f32x4*)(hp + 12) = r3;
        u32x4 o0, o1; o0.x = pk2(r0.x, r0.y); o0.y = pk2(r0.z, r0.w); o0.z = pk2(r1.x, r1.y); o0.w = pk2(r1.z, r1.w);
        o1.x = pk2(r2.x, r2.y); o1.y = pk2(r2.z, r2.w); o1.z = pk2(r3.x, r3.y); o1.w = pk2(r3.z, r3.w);
        *(u32x4*)(hbw + (size_t)tok * D + lane * 16) = o0; *(u32x4*)(hbw + (size_t)tok * D + lane * 16 + 8) = o1;
        float ss = (r0.x * r0.x + r0.y * r0.y) + (r0.z * r0.z + r0.w * r0.w) + (r1.x * r1.x + r1.y * r1.y) + (r1.z * r1.z + r1.w * r1.w)
                 + (r2.x * r2.x + r2.y * r2.y) + (r2.z * r2.z + r2.w * r2.w) + (r3.x * r3.x + r3.y * r3.y) + (r3.z * r3.z + r3.w * r3.w);
        ss = wave_sum_dpp(ss);
        if (lane < 8) ssqw[(size_t)tok * 8 + lane] = lane == 0 ? ss : 0.f;
    } else {
        const int b = tok / L, pos = tok - b * L;
        if (pos >= NMETA) { float* op = c.out + ((size_t)b * SEQ + (pos - NMETA)) * D + lane * 16;
            *(f32x4*)op = r0; *(f32x4*)(op + 4) = r1; *(f32x4*)(op + 8) = r2; *(f32x4*)(op + 12) = r3; }
    }
}
__device__ __forceinline__ void phase_G2(const Ctx& c0, int l) {
    Ctx c = reopaque(c0);
    const bf16* hb = WSP(bf16, WS_HB); const float* ssq = WSP(float, WS_SSQ); const int* pe = WSP(int, WS_EIDX); const float* pw = WSP(float, WS_GW);
    const unsigned char* U = c.ws + WS_TAB + (size_t)(l * 2) * SZ_TAB; const unsigned char* V = c.ws + WS_TAB + (size_t)(l * 2 + 1) * SZ_TAB;
    const int lane = c.lane, wave = c.wave;
    const int gw = c.vb * 4 + wave, t0 = l == 1 ? gw * 8 + NMETA * ((gw >> 8) + 1) : gw * 8;
    const bool has_x = l == 0 && (c.vb & 3) == 0; const int tx = T - 128 + (c.vb >> 2);
    unsigned char* wl = c.lds + wave * G2_WSTRIDE;
    int* pe_l = (int*)wl; float* pw_l = (float*)(wl + 4608); float* act_l = (float*)(wl + 9216);
#pragma unroll
    for (int j = 0; j < G2_MAXTOK; ++j) { const int tok = j < 8 ? t0 + j : (has_x ? tx : t0);
        pe_l[j * 128 + lane] = pe[(size_t)tok * 128 + lane]; pe_l[j * 128 + 64 + lane] = pe[(size_t)tok * 128 + 64 + lane];
        pw_l[j * 128 + lane] = pw[(size_t)tok * 128 + lane] * TAB_INV; pw_l[j * 128 + 64 + lane] = pw[(size_t)tok * 128 + 64 + lane] * TAB_INV; }
    const int xlo = has_x ? 4 * wave : 16, xhi = has_x ? 4 * wave + 4 : 16;
    {
        u32x4 xq[G2_MAXTOK]; float rs[G2_MAXTOK];
#pragma unroll
        for (int j = 0; j < G2_MAXTOK; ++j) { const int tok = j < 8 ? t0 + j : (has_x ? tx : t0);
            const u32x4 lo = *(const u32x4*)(hb + (size_t)tok * D + lane * 16), hi = *(const u32x4*)(hb + (size_t)tok * D + lane * 16 + 8);
            const f32x4 f0 = (f32x4){bf_lo(lo.x), bf_hi(lo.x), bf_lo(lo.y), bf_hi(lo.y)}, f1 = (f32x4){bf_lo(lo.z), bf_hi(lo.z), bf_lo(lo.w), bf_hi(lo.w)};
            const f32x4 f2 = (f32x4){bf_lo(hi.x), bf_hi(hi.x), bf_lo(hi.y), bf_hi(hi.y)}, f3 = (f32x4){bf_lo(hi.z), bf_hi(hi.z), bf_lo(hi.w), bf_hi(hi.w)};
            float mx = 1e-20f;
#pragma unroll
            for (int i = 0; i < 4; ++i) mx = fmaxf(mx, fmaxf(fmaxf(fabsf(f0[i]), fabsf(f1[i])), fmaxf(fabsf(f2[i]), fabsf(f3[i]))));
            mx = fmaxf(mx, dpp<0xB1>(mx)); mx = fmaxf(mx, dpp<0x4E>(mx)); mx = fmaxf(mx, dpp<0x141>(mx)); mx = fmaxf(mx, dpp<0x128>(mx)); mx = xrow16_max(mx);
            const float sx = 127.0f / mx;
            xq[j].x = pack_i8x4(f0 * sx); xq[j].y = pack_i8x4(f1 * sx); xq[j].z = pack_i8x4(f2 * sx); xq[j].w = pack_i8x4(f3 * sx);
            rs[j] = rstd_from_ssq8(ssq, tok) * mx * (1.0f / (127.0f * U_SCALE)); }
        u32x4 u[8];
#pragma unroll
        for (int k = 0; k < 8; ++k) u[k] = *(const u32x4*)(U + (size_t)__builtin_amdgcn_readfirstlane(pe_l[k]) * 1024 + lane * 16);
#pragma unroll 1
        for (int ch = 0; ch < 16; ++ch) {
            const int cn = ch < 15 ? ch + 1 : 0;
            const bool x_here = ch >= xlo && ch < xhi;
#pragma unroll
            for (int j = 0; j < 8; ++j) {
                const int* pe_next = j < 7 ? pe_l + (j + 1) * 128 + ch * 8 : (x_here ? pe_l + 8 * 128 + ch * 8 : pe_l + cn * 8);
                g2_u_chunk(u, U, pe_next, pw_l + j * 128 + ch * 8, act_l + j * 128 + ch * 8, xq[j], rs[j], lane); }
            if (x_here) g2_u_chunk(u, U, pe_l + cn * 8, pw_l + 8 * 128 + ch * 8, act_l + 8 * 128 + ch * 8, xq[8], rs[8], lane);
        }
    }
    f32x2 acc[G2_MAXTOK][8];
#pragma unroll
    for (int j = 0; j < G2_MAXTOK; ++j)
#pragma unroll
        for (int i = 0; i < 8; ++i) acc[j][i] = (f32x2){0.f, 0.f};
    {
        u32x4 v[8];
#pragma unroll
        for (int k = 0; k < 8; ++k) v[k] = *(const u32x4*)(V + (size_t)__builtin_amdgcn_readfirstlane(pe_l[k]) * 1024 + lane * 16);
#pragma unroll 1
        for (int ch = 0; ch < 16; ++ch) {
            const int cn = ch < 15 ? ch + 1 : 0;
            const bool x_here = ch >= xlo && ch < xhi;
#pragma unroll
            for (int j = 0; j < 8; ++j) {
                const int* pe_next = j < 7 ? pe_l + (j + 1) * 128 + ch * 8 : (x_here ? pe_l + 8 * 128 + ch * 8 : pe_l + cn * 8);
                g2_v_chunk(v, V, pe_next, act_l + j * 128 + ch * 8, acc[j], lane); }
            if (x_here) g2_v_chunk(v, V, pe_l + cn * 8, act_l + 8 * 128 + ch * 8, acc[8], lane);
        }
    }
#pragma unroll
    for (int j = 0; j < 8; ++j) g2_finish_token(c, l, t0 + j, acc[j], lane);
    __syncthreads();
    if (has_x) {
        f32x2* part = (f32x2*)(c.lds + wave * G2_WSTRIDE);
#pragma unroll
        for (int i = 0; i < 8; ++i) part[i * 64 + lane] = acc[8][i];
    }
    __syncthreads();
    if (has_x && wave == 0) {
        f32x2 tot[8];
#pragma unroll
        for (int i = 0; i < 8; ++i) { tot[i] = acc[8][i];
#pragma unroll
            for (int w = 1; w < 4; ++w) tot[i] += ((const f32x2*)(c.lds + w * G2_WSTRIDE))[i * 64 + lane]; }
        g2_finish_token(c, l, tx, tot, lane);
    }
    __syncthreads();
}

struct Args { const float* in[22]; float* out; unsigned char* ws; int ph_lo, ph_hi; };
constexpr int N_PHASES = 17;

__global__ void __launch_bounds__(NTHREADS, 2) fwd_kernel(Args args) {
    extern __shared__ __attribute__((aligned(16))) unsigned char lds_raw[];
    Ctx c;
#pragma unroll
    for (int i = 0; i < 22; ++i) c.in[i] = args.in[i];
    c.out = args.out; c.ws = args.ws; c.lds = lds_raw;
    c.tid = threadIdx.x; c.lane = c.tid & 63; c.wave = __builtin_amdgcn_readfirstlane(c.tid >> 6);
    c.G = gridDim.x; { const int bx = blockIdx.x; c.vb = (c.G % 8 == 0) ? (bx % 8) * (c.G / 8) + bx / 8 : bx; }
    volatile unsigned* misc = (volatile unsigned*)(c.lds + LDS_MISC);
    if (c.tid < 16) misc[c.tid] = 0u;
    __syncthreads();
    const int lo = args.ph_lo, hi = args.ph_hi;
    const bool multi = (hi - lo) > 1;
    XcdBarrier bar; bar.bar = WSP(unsigned, WS_CTL) + CW_BAR; bar.x = 0; bar.st = misc;
    if (multi) bar = xcd_barrier_post(WSP(unsigned, WS_CTL) + CW_BAR, misc);
#define IN_(k) (lo <= (k) && (k) < hi)
#define SEAM_(k) do { if ((k) + 1 < hi) xcd_barrier(bar); } while (0)
    if (IN_(0)) { phase_prologue(c); SEAM_(0); }
#pragma unroll 1
    for (int l = 0; l < 2; ++l) {
        const int p0 = 1 + 8 * l;
        if (IN_(p0 + 0)) { phase_A(c, l); SEAM_(p0 + 0); }
        if (IN_(p0 + 1)) { phase_B(c, l); SEAM_(p0 + 1); }
        if (IN_(p0 + 2)) { phase_C(c, l); SEAM_(p0 + 2); }
        if (IN_(p0 + 3)) { phase_D(c, l); SEAM_(p0 + 3); }
        if (IN_(p0 + 4)) { phase_E(c, l); SEAM_(p0 + 4); }
        if (IN_(p0 + 5)) { phase_F(c, l); SEAM_(p0 + 5); }
        if (IN_(p0 + 6)) { phase_F3(c, l); SEAM_(p0 + 6); }
        if (IN_(p0 + 7)) { phase_G2(c, l); SEAM_(p0 + 7); }
    }
}

extern "C" void kernel_launch(void* const* d_in, const int* in_sizes, int n_in, void* d_out, int out_size, void* d_ws, size_t ws_size, hipStream_t stream) {
    static int grid = 0;
    if (grid == 0) {
        if (n_in != 22 || out_size != NB * SEQ * D || ws_size < WS_END) { fprintf(stderr, "kernel_launch: unexpected shapes (n_in %d out %d ws %zu need %zu)\n", n_in, out_size, ws_size, (size_t)WS_END); grid = -1; return; }
        int dev = 0, cus = 0, per_cu = 0;
        hipGetDevice(&dev); hipDeviceGetAttribute(&cus, hipDeviceAttributeMultiprocessorCount, dev);
        if (hipFuncSetAttribute((const void*)fwd_kernel, hipFuncAttributeMaxDynamicSharedMemorySize, LDS_BYTES) != hipSuccess) { fprintf(stderr, "kernel_launch: hipFuncSetAttribute failed\n"); grid = -1; return; }
        if (hipOccupancyMaxActiveBlocksPerMultiprocessor(&per_cu, (const void*)fwd_kernel, NTHREADS, LDS_BYTES) != hipSuccess || per_cu < 1) { fprintf(stderr, "kernel_launch: occupancy query failed (%d)\n", per_cu); per_cu = 1; (void)hipGetLastError(); }
        if (per_cu > 2) per_cu = 2;
        grid = cus * per_cu;
        if (grid != 512) { fprintf(stderr, "kernel_launch: grid %d unsupported by phase G2 (needs 512 workgroups)\n", grid); grid = -1; return; }
        fprintf(stderr, "kernel_launch: grid %d (%d per CU), lds %d, ws need %zu have %zu\n", grid, per_cu, LDS_BYTES, (size_t)WS_END, ws_size);
    }
    if (grid < 0) return;
    hipMemsetAsync((char*)d_ws + WS_CTL, 0, CTL_BYTES, stream);
    Args a{};
    for (int i = 0; i < 22; ++i) a.in[i] = (const float*)d_in[i];
    a.out = (float*)d_out; a.ws = (unsigned char*)d_ws;
#if MK_PER_PHASE
    for (int ph = 0; ph < N_PHASES; ++ph) { a.ph_lo = ph; a.ph_hi = ph + 1; hipLaunchKernelGGL(fwd_kernel, dim3(grid), dim3(NTHREADS), LDS_BYTES, stream, a); }
#else
    a.ph_lo = 0; a.ph_hi = N_PHASES;
    void* kargs[] = {&a};
    hipError_t e = hipLaunchCooperativeKernel((const void*)fwd_kernel, dim3(grid), dim3(NTHREADS), kargs, LDS_BYTES, stream);
    if (e != hipSuccess) fprintf(stderr, "kernel_launch: cooperative launch failed: %s (grid %d)\n", hipGetErrorString(e), grid);
#endif
}
```

```cpp
#include <hip/hip_runtime.h>
#include <cstdio>
#include <cstdint>

#ifndef MK_PER_PHASE
#define MK_PER_PHASE 0
#endif

typedef unsigned short bf16;
typedef short bf16x8 __attribute__((ext_vector_type(8)));
typedef float f32x4 __attribute__((ext_vector_type(4)));
typedef unsigned u32x4 __attribute__((ext_vector_type(4)));
typedef unsigned u32x2 __attribute__((ext_vector_type(2)));
typedef __bf16 bf16x2 __attribute__((ext_vector_type(2)));

constexpr int NB = 8, SEQ = 2048, NMETA = 16, L = SEQ + NMETA, T = NB * L, D = 1024;
constexpr int DC = 512, CW = 31, NH = 8, QL = 256, KVL = 128, NOPE = 64, ROPE = 32, QK = 96, VD = 64;
constexpr int NIN = 3488, NINP = 3584;
constexpr int NEXP = 16384;
constexpr float EPS = 1e-6f;
constexpr int MT = T / 128;
static_assert(T % 128 == 0, "T tiles");

constexpr size_t al256(size_t x) { return (x + 255) & ~(size_t)255; }
constexpr size_t WS_CTL = 0;
constexpr size_t CTL_BYTES = 65536;
constexpr size_t WS_ROPE = WS_CTL + CTL_BYTES;
constexpr size_t WS_WIN = al256(WS_ROPE + (size_t)L * 16 * 8);
constexpr size_t SZ_WIN = (size_t)NINP * 1024 * 2, SZ_WCO = (size_t)1024 * 512 * 2, SZ_WUQ = (size_t)1024 * 256 * 2, SZ_WUKV = (size_t)1024 * 128 * 2,
                 SZ_WMLA = (size_t)1024 * 512 * 2, SZ_WOUT = (size_t)1024 * 1024 * 2, SZ_WPQ = (size_t)2048 * 1024 * 2, SZ_KEYS = (size_t)16 * 128 * 128 * 2;
constexpr size_t OFF_WCO = SZ_WIN, OFF_WUQ = OFF_WCO + SZ_WCO, OFF_WUKV = OFF_WUQ + SZ_WUQ, OFF_WMLA = OFF_WUKV + SZ_WUKV, OFF_WOUT = OFF_WMLA + SZ_WMLA,
                 OFF_WPQ = OFF_WOUT + SZ_WOUT, OFF_KEYS = OFF_WPQ + SZ_WPQ, SZ_WLAYER = OFF_KEYS + SZ_KEYS;
constexpr size_t WS_TAB = al256(WS_WIN + 2 * SZ_WLAYER);
constexpr size_t SZ_TAB = (size_t)NEXP * 1024;
constexpr float TAB_SCALE = 256.0f, TAB_INV = 1.0f / 256.0f;
constexpr float U_CLIP = 0.2f, U_SCALE = 127.0f / U_CLIP;
constexpr size_t WS_H = al256(WS_TAB + 4 * SZ_TAB);
constexpr size_t WS_HB = al256(WS_H + (size_t)T * 1024 * 4);
constexpr size_t WS_SSQ = al256(WS_HB + (size_t)T * 1024 * 2);
constexpr size_t WS_UGLU = al256(WS_SSQ + (size_t)T * 8 * 4);
constexpr size_t WS_CQ = al256(WS_UGLU + (size_t)T * 512 * 2);
constexpr size_t WS_CKV = al256(WS_CQ + (size_t)T * 256 * 2);
constexpr size_t WS_KROPE = al256(WS_CKV + (size_t)T * 128 * 2);
constexpr size_t WS_SSQQ = al256(WS_KROPE + (size_t)T * 32 * 4);
constexpr size_t WS_SSQKV = al256(WS_SSQQ + (size_t)T * 2 * 4);
constexpr size_t WS_U2 = al256(WS_SSQKV + (size_t)T * 4);
constexpr size_t WS_Q = al256(WS_U2 + (size_t)T * 512 * 2);
constexpr size_t WS_K = al256(WS_Q + (size_t)T * NH * QK * 2);
constexpr size_t WS_VT = al256(WS_K + (size_t)T * NH * QK * 2);
constexpr size_t WS_O = al256(WS_VT + (size_t)T * NH * VD * 2 + 4096);
constexpr size_t WS_MERGED = al256(WS_O + (size_t)T * 512 * 2);
constexpr size_t WS_GATES = al256(WS_MERGED + (size_t)T * 1024 * 2);
constexpr size_t WS_SV = WS_GATES;
constexpr size_t WS_SI = al256(WS_SV + (size_t)T * 256 * 4);
constexpr size_t WS_EIDX = al256(WS_SI + (size_t)T * 256);
constexpr size_t WS_GW = al256(WS_EIDX + (size_t)T * 128 * 4);
constexpr size_t WS_STB = al256(WS_GW + (size_t)T * 128 * 4);
constexpr size_t WS_PEER_END = WS_STB + (size_t)T * 16;
constexpr size_t WS_END = al256(WS_GATES + (size_t)T * 2048 * 2);
static_assert(WS_PEER_END <= WS_END, "peer scratch overlay");

constexpr int CW_BAR = 0;
constexpr int CW_QUEUE = 4096;

constexpr int LDS_MAIN = 128 * 132 * 4;
constexpr int LDS_MISC = LDS_MAIN;
constexpr int LDS_BYTES = LDS_MAIN + 64;

constexpr int NTHREADS = 256;

__device__ __forceinline__ unsigned pk2(float lo, float hi) { bf16x2 v; v.x = (__bf16)lo; v.y = (__bf16)hi; return __builtin_bit_cast(unsigned, v); }
__device__ __forceinline__ unsigned pack_i8x4(f32x4 v) {
    const int a = (int)__builtin_rintf(fminf(fmaxf(v.x, -127.f), 127.f)), b = (int)__builtin_rintf(fminf(fmaxf(v.y, -127.f), 127.f));
    const int c_ = (int)__builtin_rintf(fminf(fmaxf(v.z, -127.f), 127.f)), d = (int)__builtin_rintf(fminf(fmaxf(v.w, -127.f), 127.f));
    return (unsigned)(a & 255) | ((unsigned)(b & 255) << 8) | ((unsigned)(c_ & 255) << 16) | ((unsigned)(d & 255) << 24);
}
__device__ __forceinline__ float bf_lo(unsigned p) { return __uint_as_float(p << 16); }
__device__ __forceinline__ float bf_hi(unsigned p) { return __uint_as_float(p & 0xffff0000u); }
__device__ __forceinline__ float fast_rcp(float x) { return __builtin_amdgcn_rcpf(x); }
__device__ __forceinline__ float fast_exp2(float x) { return __builtin_amdgcn_exp2f(x); }
__device__ __forceinline__ float sigmoidf_(float x) { return fast_rcp(1.0f + fast_exp2(-1.4426950409f * x)); }
__device__ __forceinline__ float gelu_tanh(float x) { const float u = 1.5957691216f * (x + 0.044715f * x * x * x); return x * fast_rcp(1.0f + fast_exp2(-1.4426950409f * u)); }
__device__ __forceinline__ float rsqrt_(float x) { return __builtin_amdgcn_rsqf(x); }
template <int CTRL> __device__ __forceinline__ float dpp(float x) { return __builtin_bit_cast(float, __builtin_amdgcn_mov_dpp(__builtin_bit_cast(int, x), CTRL, 0xf, 0xf, true)); }
__device__ __forceinline__ float xrow16_sum(float x) {
    auto s = __builtin_amdgcn_permlane16_swap(__float_as_uint(x), __float_as_uint(x), false, false);
    x = __uint_as_float(s[0]) + __uint_as_float(s[1]);
    auto t = __builtin_amdgcn_permlane32_swap(__float_as_uint(x), __float_as_uint(x), false, false);
    return __uint_as_float(t[0]) + __uint_as_float(t[1]);
}
__device__ __forceinline__ float xrow16_max(float x) {
    auto s = __builtin_amdgcn_permlane16_swap(__float_as_uint(x), __float_as_uint(x), false, false);
    x = fmaxf(__uint_as_float(s[0]), __uint_as_float(s[1]));
    auto t = __builtin_amdgcn_permlane32_swap(__float_as_uint(x), __float_as_uint(x), false, false);
    return fmaxf(__uint_as_float(t[0]), __uint_as_float(t[1]));
}
__device__ __forceinline__ float wave_sum_dpp(float x) {
    x += dpp<0xB1>(x); x += dpp<0x4E>(x); x += dpp<0x141>(x); x += dpp<0x128>(x); return xrow16_sum(x);
}
__device__ __forceinline__ float quad_sum(float v) { return xrow16_sum(v); }
__device__ __forceinline__ float quad_max(float v) { return xrow16_max(v); }
__device__ __forceinline__ float wave_sum(float v) { return wave_sum_dpp(v); }
__device__ __forceinline__ float dot2(unsigned a, unsigned b, float c) { return __builtin_amdgcn_fdot2_f32_bf16(__builtin_bit_cast(bf16x2, a), __builtin_bit_cast(bf16x2, b), c, false); }

#define XB_TMO      128
#define XB_XCNT(j)  (256  + 64 * (j))
#define XB_XSUB(j)  (1280 + 64 * (j))
#define XB_XGEN(j)  (2304 + 64 * (j))
#define XB_TOP      3328
#define XB_TOPGEN   3392
#define XCD_BAR_WORDS 3456
#define XB_SPIN_CAP (1u << 20)
__device__ __forceinline__ unsigned xb_ld(unsigned* p)              { return __hip_atomic_load(p, __ATOMIC_RELAXED, __HIP_MEMORY_SCOPE_AGENT); }
__device__ __forceinline__ unsigned xb_add(unsigned* p, unsigned v) { return __hip_atomic_fetch_add(p, v, __ATOMIC_RELAXED, __HIP_MEMORY_SCOPE_AGENT); }
__device__ __forceinline__ unsigned xb_xcc_id() { return (unsigned)__builtin_amdgcn_s_getreg((3 << 11) | 20) & 0xFu; }
#define XB_SPIN(cond, bar) do { unsigned _sp = 0; while (cond) { __builtin_amdgcn_s_sleep(1); \
    if ((++_sp & 255u) == 0u) { if (xb_ld(&(bar)[XB_TMO])) break; if (_sp > XB_SPIN_CAP) { atomicAdd(&(bar)[XB_TMO], 1u); break; } } } } while (0)
struct XcdBarrier { unsigned* bar; unsigned x; volatile unsigned* st; };
__device__ __forceinline__ XcdBarrier xcd_barrier_post(unsigned* bar, volatile unsigned* st) {
    XcdBarrier b; b.bar = bar; b.x = xb_xcc_id(); b.st = st;
    if (threadIdx.x == 0) (void)xb_add(&bar[XB_XCNT(b.x)], 1u);
    return b;
}
__device__ __forceinline__ void xcd_barrier_complete(unsigned* bar, unsigned x, unsigned& nloc, unsigned& nx) {
    const unsigned G = gridDim.x * gridDim.y * gridDim.z;
    unsigned sum, cnt, mine, sp = 0u;
    for (;;) {
        sum = 0u; cnt = 0u; mine = 0u;
#pragma unroll
        for (unsigned j = 0; j < 16; ++j) { const unsigned c = xb_ld(&bar[XB_XCNT(j)]); sum += c; cnt += (c > 0u) ? 1u : 0u; mine = (j == x) ? c : mine; }
        if (sum == G) break;
        __builtin_amdgcn_s_sleep(1);
        if ((++sp & 255u) == 0u) { if (xb_ld(&bar[XB_TMO])) break; if (sp > XB_SPIN_CAP) { atomicAdd(&bar[XB_TMO], 1u); break; } }
    }
    nloc = mine > 0u ? mine : 1u; nx = cnt > 0u ? cnt : 1u;
}
__device__ __forceinline__ void xcd_barrier(const XcdBarrier& b) {
    asm volatile("s_waitcnt vmcnt(0)" ::: "memory");
    __syncthreads();
    if (threadIdx.x == 0) {
        unsigned* bar = b.bar;
        __builtin_amdgcn_s_waitcnt(0);
        unsigned nloc = b.st[0], nx = b.st[1];
        if (nloc == 0u) { xcd_barrier_complete(bar, b.x, nloc, nx); b.st[0] = nloc; b.st[1] = nx; }
        const unsigned old = xb_add(&bar[XB_XSUB(b.x)], 1u);
        const unsigned gen = old / nloc;
        if (old + 1u == (gen + 1u) * nloc) {
            __builtin_amdgcn_fence(__ATOMIC_RELEASE, "agent");
            asm volatile("s_waitcnt vmcnt(0)" ::: "memory");
            const unsigned og = xb_add(&bar[XB_TOP], 1u);
            const unsigned tg = og / nx;
            if (og + 1u == (tg + 1u) * nx) xb_add(&bar[XB_TOPGEN], 1u);
            else XB_SPIN(xb_ld(&bar[XB_TOPGEN]) == tg, bar);
            __builtin_amdgcn_fence(__ATOMIC_ACQUIRE, "agent");
            xb_add(&bar[XB_XGEN(b.x)], 1u);
            asm volatile("s_waitcnt vmcnt(0)" ::: "memory");
        } else {
            XB_SPIN(xb_ld(&bar[XB_XGEN(b.x)]) == gen, bar);
            __builtin_amdgcn_fence(__ATOMIC_ACQUIRE, "agent");
            asm volatile("s_waitcnt vmcnt(0)" ::: "memory");
        }
    }
    __syncthreads();
}

struct Ctx {
    const float* in[22]; float* out; unsigned char* ws;
    unsigned char* lds; int tid, lane, wave, G, vb;
};
#define WSP(T_, off) ((T_*)(c.ws + (off)))
__device__ __forceinline__ Ctx reopaque(const Ctx& c0) {
    Ctx c = c0; int t = c0.tid; asm volatile("" : "+v"(t)); c.tid = t; c.lane = t & 63; c.wave = __builtin_amdgcn_readfirstlane(t >> 6);
    int vb = c0.vb; asm volatile("" : "+s"(vb)); c.vb = vb; return c;
}

__device__ __forceinline__ int lds_off(int row, int chunk) { return row * 128 + ((chunk ^ (row & 7)) << 4); }

__device__ __forceinline__ void gemm_compute_stage(f32x4 (&acc)[2][8], const unsigned char* sA, const unsigned char* sB, int wave, int lane) {
    const int r = lane & 15, q = lane >> 4;
#pragma unroll
    for (int ks = 0; ks < 2; ++ks) {
        bf16x8 af[2], bfr[8];
#pragma unroll
        for (int mi = 0; mi < 2; ++mi) af[mi] = *(const bf16x8*)(sA + lds_off(32 * wave + 16 * mi + r, 4 * ks + q));
#pragma unroll
        for (int ni = 0; ni < 8; ++ni) bfr[ni] = *(const bf16x8*)(sB + lds_off(16 * ni + r, 4 * ks + q));
#pragma unroll
        for (int mi = 0; mi < 2; ++mi)
#pragma unroll
            for (int ni = 0; ni < 8; ++ni) acc[mi][ni] = __builtin_amdgcn_mfma_f32_16x16x32_bf16(bfr[ni], af[mi], acc[mi][ni], 0, 0, 0);
    }
}

#define LAS __attribute__((address_space(3)))
__device__ __forceinline__ void gemm_stage_glds(const bf16* A, int lda, const bf16* Bt, int ldb, int kt, unsigned char* stage, int wave, int lane) {
    const int rr = lane >> 3, cch = (lane & 7) ^ rr;
#pragma unroll
    for (int i = 0; i < 4; ++i) { const int pc = 4 * i + wave;
        __builtin_amdgcn_global_load_lds((const unsigned*)(A + (size_t)(8 * pc + rr) * lda + kt * 64 + cch * 8), (LAS unsigned*)(stage + pc * 1024), 16, 0, 0);
        __builtin_amdgcn_global_load_lds((const unsigned*)(Bt + (size_t)(8 * pc + rr) * ldb + kt * 64 + cch * 8), (LAS unsigned*)(stage + 16384 + pc * 1024), 16, 0, 0); }
}
__device__ __forceinline__ void gemm_core(f32x4 (&acc)[2][8], const bf16* A, int lda, const bf16* Bt, int ldb, int K, unsigned char* lds, int tid) {
    const int wave = __builtin_amdgcn_readfirstlane(tid >> 6), lane = tid & 63;
    const int nk = K >> 6;
    gemm_stage_glds(A, lda, Bt, ldb, 0, lds, wave, lane);
    asm volatile("s_waitcnt vmcnt(0)" ::: "memory");
    __syncthreads();
    for (int kt = 0; kt < nk; ++kt) {
        const int cur = kt & 1;
        if (kt + 1 < nk) gemm_stage_glds(A, lda, Bt, ldb, kt + 1, lds + (cur ^ 1) * 32768, wave, lane);
        gemm_compute_stage(acc, lds + cur * 32768, lds + cur * 32768 + 16384, wave, lane);
        asm volatile("s_waitcnt vmcnt(0)" ::: "memory");
        __syncthreads();
    }
}
__device__ __forceinline__ void acc_zero(f32x4 (&acc)[2][8]) {
#pragma unroll
    for (int mi = 0; mi < 2; ++mi)
#pragma unroll
        for (int ni = 0; ni < 8; ++ni) acc[mi][ni] = (f32x4){0.f, 0.f, 0.f, 0.f};
}
__device__ __forceinline__ float rstd_from_ssq8(const float* ssq, int tok) {
    const f32x4 a = *(const f32x4*)(ssq + (size_t)tok * 8), b = *(const f32x4*)(ssq + (size_t)tok * 8 + 4);
    const float s = ((a.x + a.y) + (a.z + a.w)) + ((b.x + b.y) + (b.z + b.w));
    return rsqrt_(s * (1.0f / 1024.0f) + EPS);
}

__device__ __forceinline__ int src_col(int mode, int np) {
    if (mode == 0) return np;
    if (mode == 2) { const int h = np >> 7, j = np & 127; return j < 96 ? h * 96 + j : -1; }
    if (np < 1024) { const int cblk = np >> 7, j = np & 127; return j < 64 ? 64 * cblk + j : 512 + 64 * cblk + (j - 64); }
    if (np < 1408) return np;
    if (np < 1536) { const int j = np - 1408; return j < 32 ? 1408 + j : -1; }
    return 1440 + (np - 1536);
}
__device__ __forceinline__ void p0_transpose_item(const float* W, int K, int N, bf16* Wt, int mode, const float* g, int item, float* scr, int lane) {
    const int nblk_k = K / 64, nb = item / nblk_k, kb = item % nblk_k, k0 = 64 * kb, n0 = 32 * nb;
    const int n = src_col(mode, n0 + (lane & 31));
    float wv[32], gv[32];
#pragma unroll
    for (int i = 0; i < 32; ++i) { const int kk = 2 * i + (lane >> 5); wv[i] = n >= 0 ? W[(size_t)(k0 + kk) * N + n] : 0.f; gv[i] = g ? g[k0 + kk] : 1.f; }
#pragma unroll
    for (int i = 0; i < 32; ++i) { const int kk = 2 * i + (lane >> 5); scr[kk * 33 + (lane & 31)] = wv[i] * gv[i]; }
    __builtin_amdgcn_s_waitcnt(0xC07F); asm volatile("" ::: "memory");
    const int cch = lane & 7;
#pragma unroll
    for (int j = 0; j < 4; ++j) { const int nl = (lane >> 3) + 8 * j; const float* s = scr + (8 * cch) * 33 + nl;
        u32x4 o; o.x = pk2(s[0 * 33], s[1 * 33]); o.y = pk2(s[2 * 33], s[3 * 33]); o.z = pk2(s[4 * 33], s[5 * 33]); o.w = pk2(s[6 * 33], s[7 * 33]);
        *(u32x4*)(Wt + (size_t)(n0 + nl) * K + k0 + 8 * cch) = o; }
    __builtin_amdgcn_s_waitcnt(0xC07F); asm volatile("" ::: "memory");
}
struct WDesc { int in_idx, K, N, Np, mode, g_idx; size_t off; };
__device__ __forceinline__ void phase_prologue(const Ctx& c0) {
    Ctx c = reopaque(c0);
    const int gw = c.vb * 4 + c.wave, NGW = c.G * 4;
    float* scr = (float*)(c.lds + c.wave * 8704);
    const WDesc wd[7] = {
        {3, 1024, NIN, NINP, 1, 2, 0}, {8, 512, 1024, 1024, 0, -1, OFF_WCO}, {10, 256, 768, 1024, 2, 9, OFF_WUQ}, {12, 128, 1024, 1024, 0, 11, OFF_WUKV},
        {15, 512, 1024, 1024, 0, -1, OFF_WMLA}, {16, 1024, 1024, 1024, 0, -1, OFF_WOUT}, {18, 1024, 2048, 2048, 0, 17, OFF_WPQ}};
    constexpr int ITEMS_PER_LAYER = (1024 / 64) * (NINP / 32) + (512 / 64) * 32 + (256 / 64) * 32 + (128 / 64) * 32 + (512 / 64) * 32 + (1024 / 64) * 32 + (1024 / 64) * 64;
    for (int it = gw; it < 2 * ITEMS_PER_LAYER; it += NGW) {
        const int l = it >= ITEMS_PER_LAYER ? 1 : 0; int r = it - l * ITEMS_PER_LAYER;
        const float* W = nullptr; const float* g = nullptr; bf16* Wt = nullptr; int K = 64, N = 32, mode = 0, rr = 0;
#pragma unroll
        for (int m = 0; m < 7; ++m) {
            const int items = (wd[m].K / 64) * (wd[m].Np / 32);
            if (r >= 0 && r < items) { K = wd[m].K; N = wd[m].N; mode = wd[m].mode; rr = r;
                W = c.in[wd[m].in_idx] + (size_t)l * wd[m].K * wd[m].N; g = wd[m].g_idx >= 0 ? c.in[wd[m].g_idx >= 0 ? wd[m].g_idx : 0] + (size_t)l * wd[m].K : nullptr;
                Wt = (bf16*)(c.ws + WS_WIN + l * SZ_WLAYER + wd[m].off); }
            r -= items;
        }
        p0_transpose_item(W, K, N, Wt, mode, g, rr, scr, c.lane);
    }
    const int gt = c.vb * NTHREADS + c.tid, NGT = c.G * NTHREADS;
    for (int l = 0; l < 2; ++l) {
        const float* src = c.in[19] + (size_t)l * 262144; bf16* dst = (bf16*)(c.ws + WS_WIN + l * SZ_WLAYER + OFF_KEYS);
        for (int i = gt; i < 262144 / 8; i += NGT) { const f32x4 a = *(const f32x4*)(src + i * 8), b = *(const f32x4*)(src + i * 8 + 4);
            u32x4 o; o.x = pk2(a.x, a.y); o.y = pk2(a.z, a.w); o.z = pk2(b.x, b.y); o.w = pk2(b.z, b.w); *(u32x4*)(dst + i * 8) = o; }
    }
    for (int l = 0; l < 2; ++l)
        for (int uv = 0; uv < 2; ++uv) {
            const float* src = c.in[20 + uv] + (size_t)l * NEXP * 1024; unsigned char* dst = c.ws + WS_TAB + (size_t)(l * 2 + uv) * SZ_TAB;
            f32x4 g4[4];
#pragma unroll
            for (int j = 0; j < 4; ++j) { const float sc = uv == 0 ? U_SCALE : TAB_SCALE; g4[j] = (f32x4){sc, sc, sc, sc}; if (uv == 0) g4[j] = g4[j] * *(const f32x4*)(c.in[17] + l * 1024 + 256 * j + 4 * c.lane); }
            for (int row = gw; row < NEXP; row += 2 * NGW) {
                const float* sp = src + (size_t)row * 1024 + 4 * c.lane; const int row2 = row + NGW; const bool two = row2 < NEXP;
                const float* sp2 = src + (size_t)(two ? row2 : row) * 1024 + 4 * c.lane;
                f32x4 a[4], b[4];
#pragma unroll
                for (int j = 0; j < 4; ++j) { a[j] = *(const f32x4*)(sp + 256 * j); b[j] = *(const f32x4*)(sp2 + 256 * j); }
#pragma unroll
                for (int j = 0; j < 4; ++j) { const f32x4 v = a[j] * g4[j];
                    *(unsigned*)(dst + (size_t)row * 1024 + 256 * j + 4 * c.lane) = uv == 0 ? pack_i8x4(v) : (unsigned)__builtin_amdgcn_cvt_pk_fp8_f32(v.z, v.w, __builtin_amdgcn_cvt_pk_fp8_f32(v.x, v.y, 0, false), true); }
                if (two) {
#pragma unroll
                    for (int j = 0; j < 4; ++j) { const f32x4 v = b[j] * g4[j];
                        *(unsigned*)(dst + (size_t)row2 * 1024 + 256 * j + 4 * c.lane) = uv == 0 ? pack_i8x4(v) : (unsigned)__builtin_amdgcn_cvt_pk_fp8_f32(v.z, v.w, __builtin_amdgcn_cvt_pk_fp8_f32(v.x, v.y, 0, false), true); } }
            }
        }
    { float* rope = WSP(float, WS_ROPE);
      for (int i = gt; i < L * 16; i += NGT) { const int pos = i >> 4, j = i & 15;
          const float inv = 1.0f / __builtin_exp2f((float)j * 0.8304820237218406f);
          const float angf = (float)pos * inv; const double ang = (double)angf;
          const double nq = __builtin_rint(ang * 0.63661977236758134308);
          double rr = __builtin_fma(-nq, 1.57079632679489655800e+00, ang); rr = __builtin_fma(-nq, 6.12323399573676603587e-17, rr);
          const double r2 = rr * rr;
          double sp = -1.0 / 1307674368000.0; sp = sp * r2 + 1.0 / 6227020800.0; sp = sp * r2 - 1.0 / 39916800.0; sp = sp * r2 + 1.0 / 362880.0; sp = sp * r2 - 1.0 / 5040.0; sp = sp * r2 + 1.0 / 120.0; sp = sp * r2 - 1.0 / 6.0; sp = sp * r2 * rr + rr;
          double cp = 1.0 / 87178291200.0; cp = cp * r2 - 1.0 / 479001600.0; cp = cp * r2 + 1.0 / 3628800.0; cp = cp * r2 - 1.0 / 40320.0; cp = cp * r2 + 1.0 / 720.0; cp = cp * r2 - 1.0 / 24.0; cp = cp * r2 + 0.5; cp = 1.0 - cp * r2;
          const int qd = ((int)nq) & 3;
          const double cv = qd == 0 ? cp : qd == 1 ? -sp : qd == 2 ? -cp : sp;
          const double sv_ = qd == 0 ? sp : qd == 1 ? cp : qd == 2 ? -sp : -cp;
          rope[2 * i] = (float)cv; rope[2 * i + 1] = (float)sv_; } }
    { float* h = WSP(float, WS_H); bf16* hb = WSP(bf16, WS_HB); float* ssq = WSP(float, WS_SSQ);
      for (int t = gw; t < T; t += NGW) { const int b = t / L, pos = t % L;
          const float* src = pos < NMETA ? c.in[1] + (size_t)pos * D : c.in[0] + ((size_t)b * SEQ + (pos - NMETA)) * D;
          float s = 0.f;
#pragma unroll
          for (int j = 0; j < 4; ++j) { const f32x4 v = *(const f32x4*)(src + j * 256 + c.lane * 4); *(f32x4*)(h + (size_t)t * D + j * 256 + c.lane * 4) = v;
              u32x2 o; o.x = pk2(v.x, v.y); o.y = pk2(v.z, v.w); *(u32x2*)(hb + (size_t)t * D + j * 256 + c.lane * 4) = o; s += (v.x * v.x + v.y * v.y) + (v.z * v.z + v.w * v.w); }
          s = wave_sum(s);
          if (c.lane < 8) ssq[(size_t)t * 8 + c.lane] = c.lane == 0 ? s : 0.f; } }
}

__device__ __forceinline__ void phase_A(const Ctx& c0, int l) {
    Ctx c = reopaque(c0);
    const bf16* hb = WSP(bf16, WS_HB); const bf16* Wt = (const bf16*)(c.ws + WS_WIN + l * SZ_WLAYER);
    const float* ssq = WSP(float, WS_SSQ);
    bf16* uglu = WSP(bf16, WS_UGLU); bf16* cq = WSP(bf16, WS_CQ); bf16* ckv = WSP(bf16, WS_CKV); float* krope = WSP(float, WS_KROPE);
    float* ssqq = WSP(float, WS_SSQQ); float* ssqkv = WSP(float, WS_SSQKV); bf16* gates = WSP(bf16, WS_GATES);
    constexpr int NT = NINP / 128;
    const int r = c.lane & 15, q = c.lane >> 4;
    const int xcd = c.vb / (c.G / 8), lb = c.vb % (c.G / 8), xm = xcd & 1, xn = xcd >> 1;
    const int m_lo = xm ? (MT + 1) / 2 : 0, m_cnt = xm ? MT / 2 : (MT + 1) / 2;
    for (int j = lb; j < m_cnt * 7; j += c.G / 8) {
        const int mt = m_lo + j / 7, nt = xn * 7 + j % 7;
        f32x4 acc[2][8]; acc_zero(acc);
        gemm_core(acc, hb + (size_t)mt * 128 * D, D, Wt + (size_t)nt * 128 * D, D, D, c.lds, c.tid);
#pragma unroll
        for (int mi = 0; mi < 2; ++mi) {
            const int tok = mt * 128 + 32 * c.wave + 16 * mi + r;
            const float rs = rstd_from_ssq8(ssq, tok);
            if (nt < 8) {
#pragma unroll
                for (int ni = 0; ni < 4; ++ni) { const f32x4 v = acc[mi][ni] * rs, g = acc[mi][ni + 4] * rs;
                    u32x2 o; o.x = pk2(v.x * sigmoidf_(g.x), v.y * sigmoidf_(g.y)); o.y = pk2(v.z * sigmoidf_(g.z), v.w * sigmoidf_(g.w));
                    *(u32x2*)(uglu + (size_t)tok * DC + nt * 64 + 16 * ni + 4 * q) = o; }
            } else if (nt < 11) {
                bf16* dst = nt < 10 ? cq + (size_t)tok * QL + (nt - 8) * 128 : ckv + (size_t)tok * KVL;
                float ss = 0.f;
#pragma unroll
                for (int ni = 0; ni < 8; ++ni) { const f32x4 v = acc[mi][ni] * rs; ss += (v.x * v.x + v.y * v.y) + (v.z * v.z + v.w * v.w);
                    u32x2 o; o.x = pk2(v.x, v.y); o.y = pk2(v.z, v.w); *(u32x2*)(dst + 16 * ni + 4 * q) = o; }
                ss = quad_sum(ss);
                if (q == 0) { if (nt < 10) ssqq[(size_t)tok * 2 + (nt - 8)] = ss; else ssqkv[tok] = ss; }
            } else if (nt == 11) {
#pragma unroll
                for (int ni = 0; ni < 2; ++ni) *(f32x4*)(krope + (size_t)tok * 32 + 16 * ni + 4 * q) = acc[mi][ni] * rs;
            } else {
#pragma unroll
                for (int ni = 0; ni < 8; ++ni) { const f32x4 v = acc[mi][ni] * rs;
                    u32x2 o; o.x = pk2(sigmoidf_(v.x), sigmoidf_(v.y)); o.y = pk2(sigmoidf_(v.z), sigmoidf_(v.w));
                    *(u32x2*)(gates + (size_t)tok * 2048 + (nt - 12) * 128 + 16 * ni + 4 * q) = o; }
            }
        }
    }
}

__device__ __forceinline__ void phaseB_q_item(Ctx& c, int l, int mt, int head) {
    const bf16* cq = WSP(bf16, WS_CQ); const bf16* Wt = (const bf16*)(c.ws + WS_WIN + l * SZ_WLAYER + OFF_WUQ);
    const float* ssqq = WSP(float, WS_SSQQ); const float* rope = WSP(float, WS_ROPE); const float* qg = c.in[13] + l * QK; bf16* Qb = WSP(bf16, WS_Q);
    const int r = c.lane & 15, q = c.lane >> 4;
    f32x4 acc[2][8]; acc_zero(acc);
    gemm_core(acc, cq + (size_t)mt * 128 * QL, QL, Wt + (size_t)head * 128 * QL, QL, QL, c.lds, c.tid);
    constexpr float QSCALE = 0.10206207261596575f * 1.4426950408889634f;
#pragma unroll
    for (int mi = 0; mi < 2; ++mi) {
        const int tok = mt * 128 + 32 * c.wave + 16 * mi + r, b = tok / L, pos = tok - b * L;
        const float rs = rsqrt_((ssqq[(size_t)tok * 2] + ssqq[(size_t)tok * 2 + 1]) * (1.0f / 256.0f) + EPS);
        float ss = 0.f;
#pragma unroll
        for (int ni = 0; ni < 6; ++ni) { acc[mi][ni] = acc[mi][ni] * rs; const f32x4 v = acc[mi][ni]; ss += (v.x * v.x + v.y * v.y) + (v.z * v.z + v.w * v.w); }
        ss = quad_sum(ss);
        const float rn = rsqrt_(ss * (1.0f / 96.0f) + EPS) * QSCALE;
#pragma unroll
        for (int ni = 0; ni < 6; ++ni) { const f32x4 g = *(const f32x4*)(qg + 16 * ni + 4 * q); acc[mi][ni] = acc[mi][ni] * g * rn; }
        const f32x4 cs0 = *(const f32x4*)(rope + ((size_t)pos * 16 + 4 * q) * 2), cs1 = *(const f32x4*)(rope + ((size_t)pos * 16 + 4 * q) * 2 + 4);
        const float co[4] = {cs0.x, cs0.z, cs1.x, cs1.z}, si[4] = {cs0.y, cs0.w, cs1.y, cs1.w};
        f32x4 x1 = acc[mi][4], x2 = acc[mi][5];
#pragma unroll
        for (int e = 0; e < 4; ++e) { const float a = x1[e], bb = x2[e]; x1[e] = a * co[e] - bb * si[e]; x2[e] = bb * co[e] + a * si[e]; }
        acc[mi][4] = x1; acc[mi][5] = x2;
        bf16* dst = Qb + (((size_t)b * NH + head) * L + pos) * QK;
#pragma unroll
        for (int ni = 0; ni < 6; ++ni) { const f32x4 v = acc[mi][ni]; u32x2 o; o.x = pk2(v.x, v.y); o.y = pk2(v.z, v.w); *(u32x2*)(dst + 16 * ni + 4 * q) = o; }
    }
}
__device__ __forceinline__ void phaseB_kv_item(Ctx& c, int l, int mt, int head) {
    const bf16* ckv = WSP(bf16, WS_CKV); const bf16* Wt = (const bf16*)(c.ws + WS_WIN + l * SZ_WLAYER + OFF_WUKV);
    const float* ssqkv = WSP(float, WS_SSQKV); const float* rope = WSP(float, WS_ROPE); const float* kg = c.in[14] + l * QK; const float* krope = WSP(float, WS_KROPE);
    bf16* Kb = WSP(bf16, WS_K); bf16* Vt = WSP(bf16, WS_VT);
    const int tid = c.tid, wave = c.wave, lane = c.lane, r = lane & 15, q = lane >> 4;
    unsigned char* lds = c.lds;
    f32x4 ak[2][4], av[2][4];
#pragma unroll
    for (int mi = 0; mi < 2; ++mi)
#pragma unroll
        for (int ni = 0; ni < 4; ++ni) { ak[mi][ni] = (f32x4){0.f, 0.f, 0.f, 0.f}; av[mi][ni] = (f32x4){0.f, 0.f, 0.f, 0.f}; }
    { const int chunk = tid & 7, row0 = tid >> 3;
      const bf16* pa = ckv + ((size_t)mt * 128 + row0) * KVL + chunk * 8; const bf16* pb = Wt + ((size_t)head * 128 + row0) * KVL + chunk * 8;
#pragma unroll
      for (int s = 0; s < 2; ++s)
#pragma unroll
          for (int i = 0; i < 4; ++i) { *(u32x4*)(lds + s * 32768 + lds_off(row0 + 32 * i, chunk)) = *(const u32x4*)(pa + (size_t)(32 * i) * KVL + s * 64);
              *(u32x4*)(lds + s * 32768 + 16384 + lds_off(row0 + 32 * i, chunk)) = *(const u32x4*)(pb + (size_t)(32 * i) * KVL + s * 64); }
    }
    __syncthreads();
#pragma unroll
    for (int s = 0; s < 2; ++s)
#pragma unroll
        for (int ks = 0; ks < 2; ++ks) {
            const unsigned char* sA = lds + s * 32768; const unsigned char* sB = sA + 16384;
            bf16x8 af[2], bfr[8];
#pragma unroll
            for (int mi = 0; mi < 2; ++mi) af[mi] = *(const bf16x8*)(sA + lds_off(32 * wave + 16 * mi + r, 4 * ks + q));
#pragma unroll
            for (int ni = 0; ni < 8; ++ni) bfr[ni] = *(const bf16x8*)(sB + lds_off(16 * ni + r, 4 * ks + q));
#pragma unroll
            for (int mi = 0; mi < 2; ++mi)
#pragma unroll
                for (int ni = 0; ni < 4; ++ni) { ak[mi][ni] = __builtin_amdgcn_mfma_f32_16x16x32_bf16(bfr[ni], af[mi], ak[mi][ni], 0, 0, 0);
                    av[mi][ni] = __builtin_amdgcn_mfma_f32_16x16x32_bf16(af[mi], bfr[ni + 4], av[mi][ni], 0, 0, 0); }
        }
    __syncthreads();
#pragma unroll
    for (int mi = 0; mi < 2; ++mi) {
        const int tok0 = mt * 128 + 32 * wave + 16 * mi, b = tok0 / L, pos0 = tok0 - b * L;
        { const int tok = tok0 + r, pos = pos0 + r;
          const float rs = rsqrt_(ssqkv[tok] * (1.0f / 128.0f) + EPS);
          const f32x4 kr1 = *(const f32x4*)(krope + (size_t)tok * 32 + 4 * q), kr2 = *(const f32x4*)(krope + (size_t)tok * 32 + 16 + 4 * q);
          float ss = (kr1.x * kr1.x + kr1.y * kr1.y) + (kr1.z * kr1.z + kr1.w * kr1.w) + (kr2.x * kr2.x + kr2.y * kr2.y) + (kr2.z * kr2.z + kr2.w * kr2.w);
#pragma unroll
          for (int ni = 0; ni < 4; ++ni) { ak[mi][ni] = ak[mi][ni] * rs; const f32x4 v = ak[mi][ni]; ss += (v.x * v.x + v.y * v.y) + (v.z * v.z + v.w * v.w); }
          ss = quad_sum(ss);
          const float rn = rsqrt_(ss * (1.0f / 96.0f) + EPS);
          bf16* dst = Kb + (((size_t)b * NH + head) * L + pos) * QK;
#pragma unroll
          for (int ni = 0; ni < 4; ++ni) { const f32x4 g = *(const f32x4*)(kg + 16 * ni + 4 * q); const f32x4 v = ak[mi][ni] * g * rn;
              u32x2 o; o.x = pk2(v.x, v.y); o.y = pk2(v.z, v.w); *(u32x2*)(dst + 16 * ni + 4 * q) = o; }
          const f32x4 g1 = *(const f32x4*)(kg + 64 + 4 * q), g2 = *(const f32x4*)(kg + 80 + 4 * q);
          f32x4 x1 = kr1 * g1 * rn, x2 = kr2 * g2 * rn;
          const f32x4 cs0 = *(const f32x4*)(rope + ((size_t)pos * 16 + 4 * q) * 2), cs1 = *(const f32x4*)(rope + ((size_t)pos * 16 + 4 * q) * 2 + 4);
          const float co[4] = {cs0.x, cs0.z, cs1.x, cs1.z}, si[4] = {cs0.y, cs0.w, cs1.y, cs1.w};
#pragma unroll
          for (int e = 0; e < 4; ++e) { const float a = x1[e], bb = x2[e]; x1[e] = a * co[e] - bb * si[e]; x2[e] = bb * co[e] + a * si[e]; }
          u32x2 o1, o2; o1.x = pk2(x1.x, x1.y); o1.y = pk2(x1.z, x1.w); o2.x = pk2(x2.x, x2.y); o2.y = pk2(x2.z, x2.w);
          *(u32x2*)(dst + 64 + 4 * q) = o1; *(u32x2*)(dst + 80 + 4 * q) = o2; }
        { const f32x4 sq = *(const f32x4*)(ssqkv + tok0 + 4 * q);
          f32x4 rs4; rs4.x = rsqrt_(sq.x * (1.0f / 128.0f) + EPS); rs4.y = rsqrt_(sq.y * (1.0f / 128.0f) + EPS); rs4.z = rsqrt_(sq.z * (1.0f / 128.0f) + EPS); rs4.w = rsqrt_(sq.w * (1.0f / 128.0f) + EPS);
#pragma unroll
          for (int ni = 0; ni < 4; ++ni) { const f32x4 v = av[mi][ni] * rs4; u32x2 o; o.x = pk2(v.x, v.y); o.y = pk2(v.z, v.w);
              *(u32x2*)(Vt + (((size_t)b * NH + head) * VD + 16 * ni + r) * L + pos0 + 4 * q) = o; } }
    }
}
__device__ __forceinline__ u32x4 conv_row(const bf16* uglu, int b, int pos, int ch) {
    u32x4 xv = (u32x4){0u, 0u, 0u, 0u};
    if (pos >= 0) xv = *(const u32x4*)(uglu + ((size_t)b * L + pos) * DC + ch);
    return xv;
}
__device__ __forceinline__ void conv_fma(float (&a)[8], const u32x4 xv, const f32x4 w0, const f32x4 w1) {
    a[0] += bf_lo(xv.x) * w0.x; a[1] += bf_hi(xv.x) * w0.y; a[2] += bf_lo(xv.y) * w0.z; a[3] += bf_hi(xv.y) * w0.w;
    a[4] += bf_lo(xv.z) * w1.x; a[5] += bf_hi(xv.z) * w1.y; a[6] += bf_lo(xv.w) * w1.z; a[7] += bf_hi(xv.w) * w1.w;
}
__device__ __forceinline__ void phaseB_conv_item(Ctx& c, int l, int grp) {
    const bf16* uglu = WSP(bf16, WS_UGLU); bf16* u2 = WSP(bf16, WS_U2);
    const float* cw = c.in[4] + (size_t)l * CW * DC; const float* cb = c.in[5] + l * DC; const float* lg = c.in[6] + l * DC; const float* lb = c.in[7] + l * DC;
    const int tok0 = grp * 4, b = tok0 / L, pos0 = tok0 - b * L, ch = c.lane * 8;
    float acc[4][8];
    { const f32x4 b0 = *(const f32x4*)(cb + ch), b1 = *(const f32x4*)(cb + ch + 4);
#pragma unroll
      for (int d = 0; d < 4; ++d) { acc[d][0] = b0.x; acc[d][1] = b0.y; acc[d][2] = b0.z; acc[d][3] = b0.w; acc[d][4] = b1.x; acc[d][5] = b1.y; acc[d][6] = b1.z; acc[d][7] = b1.w; } }
    const int base = pos0 - 30;
    u32x4 x0 = conv_row(uglu, b, base + 0, ch), x1 = conv_row(uglu, b, base + 1, ch), x2 = conv_row(uglu, b, base + 2, ch),
          x3 = conv_row(uglu, b, base + 3, ch), x4 = conv_row(uglu, b, base + 4, ch), x5;
    const float* wp = cw + ch;
#pragma unroll 1
    for (int w = 0; w < CW; ++w) {
        x5 = conv_row(uglu, b, (w + 5 <= 33) ? base + w + 5 : -1, ch);
        const f32x4 w0 = *(const f32x4*)wp, w1 = *(const f32x4*)(wp + 4); wp += DC;
        conv_fma(acc[0], x0, w0, w1); conv_fma(acc[1], x1, w0, w1); conv_fma(acc[2], x2, w0, w1); conv_fma(acc[3], x3, w0, w1);
        x0 = x1; x1 = x2; x2 = x3; x3 = x4; x4 = x5;
    }
    const f32x4 g0 = *(const f32x4*)(lg + ch), g1 = *(const f32x4*)(lg + ch + 4), e0 = *(const f32x4*)(lb + ch), e1 = *(const f32x4*)(lb + ch + 4);
    const float gg[8] = {g0.x, g0.y, g0.z, g0.w, g1.x, g1.y, g1.z, g1.w}, be[8] = {e0.x, e0.y, e0.z, e0.w, e1.x, e1.y, e1.z, e1.w};
#pragma unroll
    for (int d = 0; d < 4; ++d) {
        float s = 0.f;
#pragma unroll
        for (int j = 0; j < 8; ++j) s += acc[d][j];
        const float mu = wave_sum(s) * (1.0f / 512.0f);
        float vq = 0.f;
#pragma unroll
        for (int j = 0; j < 8; ++j) { acc[d][j] -= mu; vq += acc[d][j] * acc[d][j]; }
        const float rstd = rsqrt_(wave_sum(vq) * (1.0f / 512.0f) + EPS);
        float y[8];
#pragma unroll
        for (int j = 0; j < 8; ++j) { const float v = acc[d][j] * rstd * gg[j] + be[j]; y[j] = v * sigmoidf_(v); }
        u32x4 o; o.x = pk2(y[0], y[1]); o.y = pk2(y[2], y[3]); o.z = pk2(y[4], y[5]); o.w = pk2(y[6], y[7]);
        *(u32x4*)(u2 + (size_t)(tok0 + d) * DC + ch) = o;
    }
}
__device__ __forceinline__ void phase_B(const Ctx& c0, int l) {
    Ctx c = reopaque(c0);
    constexpr int NQ = MT * NH, NKV = MT * NH, NCV = T / 16;
    for (int it = c.vb; it < NQ + NKV + NCV; it += c.G) {
        if (it < NQ) phaseB_q_item(c, l, it / NH, it % NH);
        else if (it < NQ + NKV) phaseB_kv_item(c, l, (it - NQ) / NH, (it - NQ) % NH);
        else phaseB_conv_item(c, l, (it - NQ - NKV) * 4 + c.wave);
    }
}

constexpr int KROW = 208, VROW = 136, ATT_STAGE = 64 * KROW + 64 * VROW;
constexpr int ATT_ITEMS = NB * NH * 17;
__device__ __forceinline__ void phase_C(const Ctx& c0, int l) {
    Ctx c = reopaque(c0);
    const bf16* Qb = WSP(bf16, WS_Q); const bf16* Kb = WSP(bf16, WS_K); const bf16* Vt = WSP(bf16, WS_VT); bf16* O = WSP(bf16, WS_O);
    unsigned* qctr = WSP(unsigned, WS_CTL) + CW_QUEUE + 64 * l;
    volatile unsigned* misc = (volatile unsigned*)(c.lds + LDS_MISC);
    const int tid = c.tid, wave = c.wave, lane = c.lane, r = lane & 15, q = lane >> 4;
    unsigned char* lds = c.lds;
    for (;;) {
        if (tid == 0) misc[4] = atomicAdd(qctr, 1u);
        __syncthreads();
        const int item = __builtin_amdgcn_readfirstlane((int)misc[4]);
        __syncthreads();
        if (item >= ATT_ITEMS) break;
        const int pp = 15 - item / 64, bh = item % 64, b = bh / NH, h = bh % NH;
        const bool meta = pp < 0;
        const int r0 = meta ? 0 : 16 + 128 * pp;
        const int nfull = meta ? 0 : 2 * pp + 1 + (wave >> 1);
        const int ntiles = meta ? 1 : 2 * pp + 3;
        const bf16* Kbase = Kb + (size_t)bh * L * QK; const bf16* Vbase = Vt + (size_t)bh * VD * L;
        bf16x8 qf[2][3];
#pragma unroll
        for (int mi = 0; mi < 2; ++mi)
#pragma unroll
            for (int ks = 0; ks < 3; ++ks) qf[mi][ks] = *(const bf16x8*)(Qb + ((size_t)bh * L + r0 + 32 * wave + 16 * mi + r) * QK + 32 * ks + 8 * q);
        float m[2] = {-1e30f, -1e30f}, lsum[2] = {0.f, 0.f};
        f32x4 o[2][4];
#pragma unroll
        for (int mi = 0; mi < 2; ++mi)
#pragma unroll
            for (int dt = 0; dt < 4; ++dt) o[mi][dt] = (f32x4){0.f, 0.f, 0.f, 0.f};
        u32x4 rk[3], rv[2];
        auto gload = [&](int kt) {
#pragma unroll
            for (int i = 0; i < 3; ++i) { const int id = tid + 256 * i, row = id / 12, cc = id % 12; rk[i] = *(const u32x4*)(Kbase + (size_t)(kt * 64 + row) * QK + cc * 8); }
#pragma unroll
            for (int i = 0; i < 2; ++i) { const int id = tid + 256 * i, row = id >> 3, cc = id & 7; rv[i] = *(const u32x4*)(Vbase + (size_t)row * L + kt * 64 + cc * 8); }
        };
        auto lstore = [&](int s) {
            unsigned char* st = lds + s * ATT_STAGE;
#pragma unroll
            for (int i = 0; i < 3; ++i) { const int id = tid + 256 * i, row = id / 12, cc = id % 12; *(u32x4*)(st + row * KROW + cc * 16) = rk[i]; }
#pragma unroll
            for (int i = 0; i < 2; ++i) { const int id = tid + 256 * i, row = id >> 3, cc = id & 7; u32x2* d = (u32x2*)(st + 64 * KROW + row * VROW + cc * 16); d[0] = (u32x2){rv[i].x, rv[i].y}; d[1] = (u32x2){rv[i].z, rv[i].w}; }
        };
        gload(0); lstore(0);
#pragma unroll
        for (int mi = 0; mi < 2; ++mi)
#pragma unroll
            for (int ks = 0; ks < 3; ++ks) asm volatile("" : "+v"(qf[mi][ks]));
        __syncthreads();
        for (int kt = 0; kt < ntiles; ++kt) {
            const int cur = kt & 1;
            if (kt + 1 < ntiles) gload(kt + 1);
            const unsigned char* sK = lds + cur * ATT_STAGE; const unsigned char* sV = sK + 64 * KROW;
            const bool full = kt < nfull;
            if (kt <= nfull) {
                f32x4 s[2][4];
#pragma unroll
                for (int kh = 0; kh < 2; ++kh) {
                    bf16x8 kf[2][3];
#pragma unroll
                    for (int kk = 0; kk < 2; ++kk) if ((kh == 0 && kk == 0) || full) {
#pragma unroll
                        for (int ks = 0; ks < 3; ++ks) kf[kk][ks] = *(const bf16x8*)(sK + (16 * (2 * kh + kk) + r) * KROW + 64 * ks + 16 * q); }
#pragma unroll
                    for (int kk = 0; kk < 2; ++kk) { const int k4 = 2 * kh + kk;
#pragma unroll
                        for (int mi = 0; mi < 2; ++mi) s[mi][k4] = (f32x4){0.f, 0.f, 0.f, 0.f};
                        if (k4 == 0 || full) {
#pragma unroll
                            for (int ks = 0; ks < 3; ++ks)
#pragma unroll
                                for (int mi = 0; mi < 2; ++mi) s[mi][k4] = __builtin_amdgcn_mfma_f32_16x16x32_bf16(kf[kk][ks], qf[mi][ks], s[mi][k4], 0, 0, 0);
                        }
                    }
                }
                u32x2 vlo[4], vhi[4];
#pragma unroll
                for (int dt = 0; dt < 4; ++dt) { const unsigned char* vp = sV + (16 * dt + r) * VROW + (4 * q) * 2;
                    vlo[dt] = *(const u32x2*)vp; vhi[dt] = (u32x2){0u, 0u}; if (full) vhi[dt] = *(const u32x2*)(vp + 32); }
                bf16x8 pf[2][2];
#pragma unroll
                for (int mi = 0; mi < 2; ++mi) {
                    float mx = fmaxf(fmaxf(s[mi][0].x, s[mi][0].y), fmaxf(s[mi][0].z, s[mi][0].w));
                    if (full) {
#pragma unroll
                        for (int k4 = 1; k4 < 4; ++k4) mx = fmaxf(mx, fmaxf(fmaxf(s[mi][k4].x, s[mi][k4].y), fmaxf(s[mi][k4].z, s[mi][k4].w)));
                    }
                    mx = quad_max(mx);
                    const float mn = fmaxf(m[mi], mx), alpha = fast_exp2(m[mi] - mn); m[mi] = mn;
                    float ps = 0.f;
#pragma unroll
                    for (int k4 = 0; k4 < 4; ++k4) {
                        if (k4 == 0 || full) { f32x4 p; p.x = fast_exp2(s[mi][k4].x - mn); p.y = fast_exp2(s[mi][k4].y - mn); p.z = fast_exp2(s[mi][k4].z - mn); p.w = fast_exp2(s[mi][k4].w - mn);
                            ps += (p.x + p.y) + (p.z + p.w); s[mi][k4] = p; }
                    }
                    lsum[mi] = lsum[mi] * alpha + ps;
#pragma unroll
                    for (int dt = 0; dt < 4; ++dt) o[mi][dt] = o[mi][dt] * alpha;
#pragma unroll
                    for (int st = 0; st < 2; ++st) { u32x4 pw;
                        pw.x = pk2(s[mi][2 * st].x, s[mi][2 * st].y); pw.y = pk2(s[mi][2 * st].z, s[mi][2 * st].w); pw.z = pk2(s[mi][2 * st + 1].x, s[mi][2 * st + 1].y); pw.w = pk2(s[mi][2 * st + 1].z, s[mi][2 * st + 1].w);
                        if (!full) { pw.z = 0u; pw.w = 0u; }
                        pf[mi][st] = __builtin_bit_cast(bf16x8, pw); }
                }
                u32x2 wlo[4], whi[4];
                if (full) {
#pragma unroll
                    for (int dt = 0; dt < 4; ++dt) { const unsigned char* vp = sV + (16 * dt + r) * VROW + (32 + 4 * q) * 2; wlo[dt] = *(const u32x2*)vp; whi[dt] = *(const u32x2*)(vp + 32); } }
#pragma unroll
                for (int dt = 0; dt < 4; ++dt) { const bf16x8 vf = __builtin_bit_cast(bf16x8, (u32x4){vlo[dt].x, vlo[dt].y, vhi[dt].x, vhi[dt].y});
#pragma unroll
                    for (int mi = 0; mi < 2; ++mi) o[mi][dt] = __builtin_amdgcn_mfma_f32_16x16x32_bf16(vf, pf[mi][0], o[mi][dt], 0, 0, 0); }
                if (full) {
#pragma unroll
                    for (int dt = 0; dt < 4; ++dt) { const bf16x8 vf = __builtin_bit_cast(bf16x8, (u32x4){wlo[dt].x, wlo[dt].y, whi[dt].x, whi[dt].y});
#pragma unroll
                        for (int mi = 0; mi < 2; ++mi) o[mi][dt] = __builtin_amdgcn_mfma_f32_16x16x32_bf16(vf, pf[mi][1], o[mi][dt], 0, 0, 0); } }
            }
            if (kt + 1 < ntiles) lstore(cur ^ 1);
            __syncthreads();
        }
#pragma unroll
        for (int mi = 0; mi < 2; ++mi) {
            const float lt = quad_sum(lsum[mi]);
            if (!meta || (wave == 0 && mi == 0)) {
                const float inv = 1.0f / lt;
                bf16* dst = O + ((size_t)b * L + r0 + 32 * wave + 16 * mi + r) * 512 + h * VD;
#pragma unroll
                for (int dt = 0; dt < 4; ++dt) { const f32x4 v = o[mi][dt] * inv; u32x2 ov; ov.x = pk2(v.x, v.y); ov.y = pk2(v.z, v.w); *(u32x2*)(dst + 16 * dt + 4 * q) = ov; }
            }
        }
    }
}

__device__ __forceinline__ int tile_tok0(int mt, int l) { return l == 1 ? mt * 128 + NMETA * ((mt >> 4) + 1) : mt * 128; }
__device__ __forceinline__ int n_mtiles(int l) { return l == 1 ? 128 : MT; }
__device__ __forceinline__ void phase_D(const Ctx& c0, int l) {
    Ctx c = reopaque(c0);
    const bf16* u2 = WSP(bf16, WS_U2); const bf16* O = WSP(bf16, WS_O); const bf16* gates = WSP(bf16, WS_GATES); bf16* merged = WSP(bf16, WS_MERGED);
    const bf16* Wco = (const bf16*)(c.ws + WS_WIN + l * SZ_WLAYER + OFF_WCO); const bf16* Wmla = (const bf16*)(c.ws + WS_WIN + l * SZ_WLAYER + OFF_WMLA);
    const int r = c.lane & 15, q = c.lane >> 4;
    for (int it = c.vb; it < n_mtiles(l) * 8; it += c.G) {
        const int mt = it / 8, nt = it % 8, tk0 = tile_tok0(mt, l);
        f32x4 acc[2][8]; acc_zero(acc);
        gemm_core(acc, u2 + (size_t)tk0 * 512, 512, Wco + (size_t)nt * 128 * 512, 512, 512, c.lds, c.tid);
#pragma unroll
        for (int mi = 0; mi < 2; ++mi) { const int tok = tk0 + 32 * c.wave + 16 * mi + r;
            const bf16* gp = gates + (size_t)tok * 2048 + nt * 128 + 4 * q; bf16* mp = merged + (size_t)tok * D + nt * 128 + 4 * q;
#pragma unroll
            for (int ni = 0; ni < 8; ++ni) { const u32x2 g = *(const u32x2*)(gp + 16 * ni); const f32x4 v = acc[mi][ni];
                u32x2 o; o.x = pk2(v.x * bf_lo(g.x), v.y * bf_hi(g.x)); o.y = pk2(v.z * bf_lo(g.y), v.w * bf_hi(g.y)); *(u32x2*)(mp + 16 * ni) = o; } }
        acc_zero(acc);
        gemm_core(acc, O + (size_t)tk0 * 512, 512, Wmla + (size_t)nt * 128 * 512, 512, 512, c.lds, c.tid);
#pragma unroll
        for (int mi = 0; mi < 2; ++mi) { const int tok = tk0 + 32 * c.wave + 16 * mi + r;
            const bf16* gp = gates + (size_t)tok * 2048 + 1024 + nt * 128 + 4 * q; bf16* mp = merged + (size_t)tok * D + nt * 128 + 4 * q;
#pragma unroll
            for (int ni = 0; ni < 8; ++ni) { const u32x2 g = *(const u32x2*)(gp + 16 * ni); const u32x2 s = *(const u32x2*)(mp + 16 * ni); const f32x4 v = acc[mi][ni];
                u32x2 o; o.x = pk2(bf_lo(s.x) + v.x * bf_lo(g.x), bf_hi(s.x) + v.y * bf_hi(g.x)); o.y = pk2(bf_lo(s.y) + v.z * bf_lo(g.y), bf_hi(s.y) + v.w * bf_hi(g.y));
                *(u32x2*)(mp + 16 * ni) = o; } }
    }
}

__device__ __forceinline__ void phase_E(const Ctx& c0, int l) {
    Ctx c = reopaque(c0);
    const bf16* merged = WSP(bf16, WS_MERGED); const bf16* Wout = (const bf16*)(c.ws + WS_WIN + l * SZ_WLAYER + OFF_WOUT);
    float* h = WSP(float, WS_H); bf16* hb = WSP(bf16, WS_HB); float* ssq = WSP(float, WS_SSQ);
    const int r = c.lane & 15, q = c.lane >> 4;
    for (int it = c.vb; it < n_mtiles(l) * 8; it += c.G) {
        const int mt = it / 8, nt = it % 8, tk0 = tile_tok0(mt, l);
        f32x4 acc[2][8]; acc_zero(acc);
        gemm_core(acc, merged + (size_t)tk0 * D, D, Wout + (size_t)nt * 128 * D, D, D, c.lds, c.tid);
#pragma unroll
        for (int mi = 0; mi < 2; ++mi) { const int tok = tk0 + 32 * c.wave + 16 * mi + r; float ss = 0.f;
#pragma unroll
            for (int ni = 0; ni < 8; ++ni) { float* hp = h + (size_t)tok * D + nt * 128 + 16 * ni + 4 * q; const f32x4 v = *(const f32x4*)hp + acc[mi][ni]; *(f32x4*)hp = v;
                ss += (v.x * v.x + v.y * v.y) + (v.z * v.z + v.w * v.w);
                u32x2 o; o.x = pk2(v.x, v.y); o.y = pk2(v.z, v.w); *(u32x2*)(hb + (size_t)tok * D + nt * 128 + 16 * ni + 4 * q) = o; }
            ss = quad_sum(ss);
            if (q == 0) ssq[(size_t)tok * 8 + nt] = ss; }
    }
}

__device__ __forceinline__ unsigned f2key(float f) { const unsigned u = __float_as_uint(f); return u ^ ((u >> 31) ? 0xFFFFFFFFu : 0x80000000u); }
__device__ __forceinline__ float key2f(unsigned k) { const unsigned u = (k >> 31) ? (k ^ 0x80000000u) : ~k; return __uint_as_float(u); }
__device__ __forceinline__ void top16_insert(unsigned (&lst)[16], unsigned x) {
#pragma unroll
    for (int i = 0; i < 16; ++i) { const unsigned a = lst[i]; lst[i] = a > x ? a : x; x = a > x ? x : a; }
}
__device__ __forceinline__ void ce_desc(unsigned& a, unsigned& b) { const unsigned mx = a > b ? a : b, mn = a > b ? b : a; a = mx; b = mn; }
__device__ __forceinline__ void sort16_desc(unsigned (&v)[16]) {
#pragma unroll
    for (int k = 2; k <= 16; k <<= 1)
#pragma unroll
        for (int j = k >> 1; j > 0; j >>= 1)
#pragma unroll
            for (int i = 0; i < 16; ++i) { const int p = i ^ j; if (p > i) { if ((i & k) == 0) ce_desc(v[i], v[p]); else ce_desc(v[p], v[i]); } }
}
__device__ __forceinline__ void merge_top16(unsigned (&a)[16], const unsigned (&b)[16]) {
#pragma unroll
    for (int i = 0; i < 16; ++i) a[i] = a[i] > b[15 - i] ? a[i] : b[15 - i];
#pragma unroll
    for (int j = 8; j > 0; j >>= 1)
#pragma unroll
        for (int i = 0; i < 16; ++i) { const int p = i ^ j; if (p > i) ce_desc(a[i], a[p]); }
}
__device__ __forceinline__ void phase_F(const Ctx& c0, int l) {
    Ctx c = reopaque(c0);
    const bf16* hb = WSP(bf16, WS_HB); const bf16* Wpq = (const bf16*)(c.ws + WS_WIN + l * SZ_WLAYER + OFF_WPQ); const bf16* keys = (const bf16*)(c.ws + WS_WIN + l * SZ_WLAYER + OFF_KEYS);
    const float* ssq = WSP(float, WS_SSQ); float* sv = WSP(float, WS_SV); unsigned char* si = WSP(unsigned char, WS_SI);
    const int tid = c.tid, wave = c.wave, lane = c.lane, r = lane & 15, q = lane >> 4;
    unsigned char* lds = c.lds;
    const int xcd = c.vb / (c.G / 8), lb = c.vb % (c.G / 8), xm = xcd & 1, xn = xcd >> 1, nmt = n_mtiles(l);
    const int m_lo = xm ? (nmt + 1) / 2 : 0, m_cnt = xm ? nmt / 2 : (nmt + 1) / 2;
    for (int j = lb; j < m_cnt * 4; j += c.G / 8) {
        const int mt = m_lo + j / 4, hp = xn * 4 + j % 4, tk0 = tile_tok0(mt, l);
        f32x4 acc[2][8]; acc_zero(acc);
        gemm_core(acc, hb + (size_t)tk0 * D, D, Wpq + (size_t)hp * 128 * D, D, D, lds, tid);
#pragma unroll
        for (int mi = 0; mi < 2; ++mi) { const int row = 32 * wave + 16 * mi + r; const float rs = rstd_from_ssq8(ssq, tk0 + row);
#pragma unroll
            for (int ni = 0; ni < 8; ++ni) { const f32x4 v = acc[mi][ni] * rs; u32x2 o; o.x = pk2(v.x, v.y); o.y = pk2(v.z, v.w);
                *(u32x2*)(lds + (ni >> 2) * 32768 + lds_off(row, 2 * (ni & 3) + (q >> 1)) + 8 * (q & 1)) = o; } }
        { const int chunk = tid & 7, row0 = tid >> 3; const bf16* pb = keys + ((size_t)hp * 128 + row0) * 128 + chunk * 8;
#pragma unroll
          for (int s = 0; s < 2; ++s)
#pragma unroll
              for (int i = 0; i < 4; ++i) *(u32x4*)(lds + s * 32768 + 16384 + lds_off(row0 + 32 * i, chunk)) = *(const u32x4*)(pb + (size_t)(32 * i) * 128 + s * 64); }
        __syncthreads();
        acc_zero(acc);
        gemm_compute_stage(acc, lds, lds + 16384, wave, lane);
        gemm_compute_stage(acc, lds + 32768, lds + 32768 + 16384, wave, lane);
        __syncthreads();
        float* S = (float*)lds;
#pragma unroll
        for (int mi = 0; mi < 2; ++mi) { const int row = 32 * wave + 16 * mi + r;
#pragma unroll
            for (int ni = 0; ni < 8; ++ni) *(f32x4*)(S + row * 132 + 16 * ni + 4 * q) = acc[mi][ni]; }
        __syncthreads();
        {
            const int tl = 32 * wave + (lane & 31), half = lane >> 5;
            const float* row = S + tl * 132;
            unsigned lst[16];
#pragma unroll
            for (int g = 0; g < 4; ++g) {
                unsigned cur[16];
#pragma unroll
                for (int j = 0; j < 4; ++j) { const int col = 64 * half + 16 * g + 4 * j; const f32x4 v = *(const f32x4*)(row + col);
                    cur[4 * j] = (f2key(v.x) & ~127u) | (unsigned)(127 - col); cur[4 * j + 1] = (f2key(v.y) & ~127u) | (unsigned)(127 - (col + 1));
                    cur[4 * j + 2] = (f2key(v.z) & ~127u) | (unsigned)(127 - (col + 2)); cur[4 * j + 3] = (f2key(v.w) & ~127u) | (unsigned)(127 - (col + 3)); }
                sort16_desc(cur);
                if (g == 0) {
#pragma unroll
                    for (int i = 0; i < 16; ++i) lst[i] = cur[i];
                } else merge_top16(lst, cur);
            }
            unsigned oth[16];
#pragma unroll
            for (int i = 0; i < 16; ++i) { auto rr = __builtin_amdgcn_permlane32_swap(lst[i], lst[i], false, false); oth[i] = half == 0 ? rr[1] : rr[0]; }
            merge_top16(lst, oth);
            if (half == 0) {
                const int tok = tk0 + tl;
                unsigned idx[16]; float val[16];
#pragma unroll
                for (int i = 0; i < 16; ++i) { idx[i] = 127u - (lst[i] & 127u); val[i] = row[idx[i]]; }
                float* svp = sv + ((size_t)tok * 16 + hp) * 16;
#pragma unroll
                for (int i = 0; i < 4; ++i) *(f32x4*)(svp + 4 * i) = (f32x4){val[4 * i], val[4 * i + 1], val[4 * i + 2], val[4 * i + 3]};
                u32x4 pi;
                pi.x = idx[0] | (idx[1] << 8) | (idx[2] << 16) | (idx[3] << 24); pi.y = idx[4] | (idx[5] << 8) | (idx[6] << 16) | (idx[7] << 24);
                pi.z = idx[8] | (idx[9] << 8) | (idx[10] << 16) | (idx[11] << 24); pi.w = idx[12] | (idx[13] << 8) | (idx[14] << 16) | (idx[15] << 24);
                *(u32x4*)(si + ((size_t)tok * 16 + hp) * 16) = pi;
            }
        }
        __syncthreads();
    }
}

__device__ __forceinline__ void phase_F3(const Ctx& c0, int l) {
    Ctx c = reopaque(c0);
    const float* sv = WSP(float, WS_SV); const unsigned char* si = WSP(unsigned char, WS_SI); int* eidx = WSP(int, WS_EIDX); float* gw = WSP(float, WS_GW); unsigned char* stb = WSP(unsigned char, WS_STB);
    float* lsv = (float*)c.lds;
    unsigned char* lsi = c.lds + 256 * 33 * 4;
    const int tid = c.tid;
    const int ntok = l == 1 ? NB * SEQ : T;
    for (int base = c.vb * NTHREADS; base < ntok * 8; base += c.G * NTHREADS) {
        const int thc = base + tid, tkc = thc >> 3;
        const int th = (l == 1 ? tkc + NMETA * ((tkc >> 11) + 1) : tkc) * 8 + (thc & 7);
        float a[16], b[16];
#pragma unroll
        for (int i = 0; i < 4; ++i) { const f32x4 x = *(const f32x4*)(sv + (size_t)th * 32 + 4 * i), y = *(const f32x4*)(sv + (size_t)th * 32 + 16 + 4 * i);
            a[4 * i] = x.x; a[4 * i + 1] = x.y; a[4 * i + 2] = x.z; a[4 * i + 3] = x.w; b[4 * i] = y.x; b[4 * i + 1] = y.y; b[4 * i + 2] = y.z; b[4 * i + 3] = y.w; }
        const u32x4 ia = *(const u32x4*)(si + (size_t)th * 32), ib = *(const u32x4*)(si + (size_t)th * 32 + 16);
#pragma unroll
        for (int i = 0; i < 16; ++i) { lsv[tid * 33 + i] = a[i]; lsv[tid * 33 + 16 + i] = b[i]; }
        *(u32x4*)(lsi + tid * 32) = ia; *(u32x4*)(lsi + tid * 32 + 16) = ib;
        unsigned lst[16];
#pragma unroll
        for (int i = 0; i < 16; ++i) lst[i] = 0u;
#pragma unroll
        for (int i = 0; i < 16; ++i)
#pragma unroll
            for (int j = 0; j < 16; ++j)
                if ((i + 1) * (j + 1) <= 16) top16_insert(lst, (f2key(a[i] + b[j]) & ~255u) | (unsigned)(255 - (i * 16 + j)));
        __builtin_amdgcn_s_waitcnt(0xC07F); asm volatile("" ::: "memory");
        float s[16]; int e[16];
#pragma unroll
        for (int k = 0; k < 16; ++k) { const unsigned code = 255u - (lst[k] & 255u); const int i = code >> 4, j = code & 15;
            s[k] = lsv[tid * 33 + i] + lsv[tid * 33 + 16 + j]; e[k] = (int)lsi[tid * 32 + i] * 128 + (int)lsi[tid * 32 + 16 + j]; }
        float mx = s[0];
#pragma unroll
        for (int k = 1; k < 16; ++k) mx = fmaxf(mx, s[k]);
        float sum = 0.f;
#pragma unroll
        for (int k = 0; k < 16; ++k) { s[k] = fast_exp2((s[k] - mx) * 1.4426950409f); sum += s[k]; }
        const float inv = 1.0f / sum;
        typedef unsigned long long u64;
        u64 hlo = 0ull, hhi = 0ull;
#pragma unroll
        for (int k = 0; k < 16; ++k) { const int sl = e[k] >> 10; if (sl < 8) hlo += 1ull << (8 * sl); else hhi += 1ull << (8 * (sl - 8)); }
        u64 ilo = hlo, ihi = hhi;
#pragma unroll
        for (int d = 1; d < 8; d <<= 1) { const u64 a_ = __shfl_up(ilo, d, 8), b_ = __shfl_up(ihi, d, 8); if ((tid & 7) >= d) { ilo += a_; ihi += b_; } }
        const u64 tlo = __shfl(ilo, 7, 8), thi = __shfl(ihi, 7, 8);
        const u64 ones = 0x0101010101010101ull;
        const u64 inlo = tlo * ones, inhi = thi * ones + (inlo >> 56) * ones;
        const u64 stlo = inlo - tlo, sthi = inhi - thi;
        u64 rlo = stlo + (ilo - hlo), rhi = sthi + (ihi - hhi);
        const int tokn = th >> 3;
#pragma unroll
        for (int k = 0; k < 16; ++k) { const int sl = e[k] >> 10; int pos;
            if (sl < 8) { pos = (int)((rlo >> (8 * sl)) & 255ull); rlo += 1ull << (8 * sl); } else { pos = (int)((rhi >> (8 * (sl - 8))) & 255ull); rhi += 1ull << (8 * (sl - 8)); }
            eidx[(size_t)tokn * 128 + pos] = e[k]; gw[(size_t)tokn * 128 + pos] = s[k] * inv; }
        if ((tid & 7) == 0) { u64* sp = (u64*)(stb + (size_t)tokn * 16); sp[0] = stlo; sp[1] = sthi; }
        __builtin_amdgcn_s_waitcnt(0xC07F); asm volatile("" ::: "memory");
    }
}

typedef float f32x2 __attribute__((ext_vector_type(2)));
constexpr int G2_WSTRIDE = 14336, G2_MAXTOK = 9;
__device__ __forceinline__ float fp8dot4(unsigned w, unsigned x01, unsigned x23, float acc) {
    const bf16x2 lo = __builtin_amdgcn_cvt_scalef32_pk_bf16_fp8(w, 1.0f, false), hi = __builtin_amdgcn_cvt_scalef32_pk_bf16_fp8(w, 1.0f, true);
    acc = __builtin_amdgcn_fdot2_f32_bf16(lo, __builtin_bit_cast(bf16x2, x01), acc, false);
    return __builtin_amdgcn_fdot2_f32_bf16(hi, __builtin_bit_cast(bf16x2, x23), acc, false);
}
__device__ __forceinline__ float reduce8_transposed(const float (&p)[8], int lane) {
    float s[4];
#pragma unroll
    for (int k = 0; k < 4; ++k) { auto r = __builtin_amdgcn_permlane32_swap(__float_as_uint(p[k]), __float_as_uint(p[k + 4]), false, false); s[k] = __uint_as_float(r[0]) + __uint_as_float(r[1]); }
    float t[2];
#pragma unroll
    for (int k = 0; k < 2; ++k) { auto r = __builtin_amdgcn_permlane16_swap(__float_as_uint(s[k]), __float_as_uint(s[k + 2]), false, false); t[k] = __uint_as_float(r[0]) + __uint_as_float(r[1]); }
    const float u0 = t[0] + dpp<0x128>(t[0]), u1 = t[1] + dpp<0x128>(t[1]);
    float r = (lane & 8) ? u1 : u0;
    r += dpp<0xB1>(r); r += dpp<0x4E>(r); r += dpp<0x141>(r);
    return r;
}
typedef int i32x4 __attribute__((ext_vector_type(4)));
__device__ __forceinline__ void fp8fma4(f32x2 (&acc)[8], int o, unsigned w, f32x2 a2) {
    const f32x2 lo = __builtin_amdgcn_cvt_scalef32_pk_f32_fp8(w, 1.0f, false), hi = __builtin_amdgcn_cvt_scalef32_pk_f32_fp8(w, 1.0f, true);
    acc[o] = __builtin_elementwise_fma(a2, lo, acc[o]); acc[o + 1] = __builtin_elementwise_fma(a2, hi, acc[o + 1]);
}
__device__ __forceinline__ void g2_u_chunk(u32x4 (&u)[8], const unsigned char* U, const int* pe_next, const float* pw_c, float* act_c, const u32x4 xq, float rs, int lane) {
    const i32x4 e0 = *(const i32x4*)pe_next, e1 = *(const i32x4*)(pe_next + 4);
    const int en[8] = {e0.x, e0.y, e0.z, e0.w, e1.x, e1.y, e1.z, e1.w};
    float p[8];
#pragma unroll
    for (int k = 0; k < 8; ++k) {
        int d = __builtin_amdgcn_sdot4((int)u[k].x, (int)xq.x, 0, false); d = __builtin_amdgcn_sdot4((int)u[k].y, (int)xq.y, d, false);
        d = __builtin_amdgcn_sdot4((int)u[k].z, (int)xq.z, d, false); d = __builtin_amdgcn_sdot4((int)u[k].w, (int)xq.w, d, false);
        p[k] = (float)d;
        asm volatile("" : "+v"(p[k]));
        u[k] = *(const u32x4*)(U + (size_t)__builtin_amdgcn_readfirstlane(en[k]) * 1024 + lane * 16);
    }
    const float a = reduce8_transposed(p, lane);
    const int row = (lane >> 3) & 7;
    if ((lane & 7) == 0) act_c[row] = gelu_tanh(a * rs) * pw_c[row];
}
__device__ __forceinline__ void g2_v_chunk(u32x4 (&v)[8], const unsigned char* V, const int* pe_next, const float* act_c, f32x2 (&acc)[8], int lane) {
    const i32x4 e0 = *(const i32x4*)pe_next, e1 = *(const i32x4*)(pe_next + 4);
    const int en[8] = {e0.x, e0.y, e0.z, e0.w, e1.x, e1.y, e1.z, e1.w};
    const f32x4 a0 = *(const f32x4*)act_c, a1 = *(const f32x4*)(act_c + 4);
    const float av[8] = {a0.x, a0.y, a0.z, a0.w, a1.x, a1.y, a1.z, a1.w};
#pragma unroll
    for (int k = 0; k < 8; ++k) { const f32x2 a2 = (f32x2){av[k], av[k]};
        fp8fma4(acc, 0, v[k].x, a2); fp8fma4(acc, 2, v[k].y, a2); fp8fma4(acc, 4, v[k].z, a2); fp8fma4(acc, 6, v[k].w, a2);
        asm volatile("" : "+v"(acc[0]), "+v"(acc[1]), "+v"(acc[2]), "+v"(acc[3]), "+v"(acc[4]), "+v"(acc[5]), "+v"(acc[6]), "+v"(acc[7]));
        v[k] = *(const u32x4*)(V + (size_t)__builtin_amdgcn_readfirstlane(en[k]) * 1024 + lane * 16);
    }
}
__device__ __forceinline__ void g2_finish_token(Ctx& c, int l, int tok, const f32x2 (&acc)[8], int lane) {
    float* h = WSP(float, WS_H); bf16* hbw = WSP(bf16, WS_HB); float* ssqw = WSP(float, WS_SSQ);
    float* hp = h + (size_t)tok * D + lane * 16;
    f32x4 r0 = *(const f32x4*)hp, r1 = *(const f32x4*)(hp + 4), r2 = *(const f32x4*)(hp + 8), r3 = *(const f32x4*)(hp + 12);
    r0 += (f32x4){acc[0].x, acc[0].y, acc[1].x, acc[1].y}; r1 += (f32x4){acc[2].x, acc[2].y, acc[3].x, acc[3].y};
    r2 += (f32x4){acc[4].x, acc[4].y, acc[5].x, acc[5].y}; r3 += (f32x4){acc[6].x, acc[6].y, acc[7].x, acc[7].y};
    if (l == 0) {
        *(f32x4*)hp = r0; *(f32x4*)(hp + 4) = r1; *(f32x4*)(hp + 8) = r2; *(f32x4*)(hp + 12) = r3;
        u32x4 o0, o1; o0.x = pk2(r0.x, r0.y); o0.y = pk2(r0.z, r0.w); o0.z = pk2(r1.x, r1.y); o0.w = pk2(r1.z, r1.w);
        o1.x = pk2(r2.x, r2.y); o1.y = pk2(r2.z, r2.w); o1.z = pk2(r3.x, r3.y); o1.w = pk2(r3.z, r3.w);
        *(u32x4*)(hbw + (size_t)tok * D + lane * 16) = o0; *(u32x4*)(hbw + (size_t)tok * D + lane * 16 + 8) = o1;
        float ss = (r0.x * r0.x + r0.y * r0.y) + (r0.z * r0.z + r0.w * r0.w) + (r1.x * r1.x + r1.y * r1.y) + (r1.z * r1.z + r1.w * r1.w)
                 + (r2.x * r2.x + r2.y * r2.y) + (r2.z * r2.z + r2.w * r2.w) + (r3.x * r3.x + r3.y * r3.y) + (r3.z * r3.z + r3.w * r3.w);
        ss = wave_sum_dpp(ss);
        if (lane < 8) ssqw[(size_t)tok * 8 + lane] = lane == 0 ? ss : 0.f;
    } else {
        const int b = tok / L, pos = tok - b * L;
        if (pos >= NMETA) { float* op = c.out + ((size_t)b * SEQ + (pos - NMETA)) * D + lane * 16;
            *(f32x4*)op = r0; *(f32x4*)(op + 4) = r1; *(f32x4*)(op + 8) = r2; *(f32x4*)(op + 12) = r3; }
    }
}
__device__ __forceinline__ void phase_G2(const Ctx& c0, int l) {
    Ctx c = reopaque(c0);
    const bf16* hb = WSP(bf16, WS_HB); const float* ssq = WSP(float, WS_SSQ); const int* pe = WSP(int, WS_EIDX); const float* pw = WSP(float, WS_GW);
    const unsigned char* U = c.ws + WS_TAB + (size_t)(l * 2) * SZ_TAB; const unsigned char* V = c.ws + WS_TAB + (size_t)(l * 2 + 1) * SZ_TAB;
    const int lane = c.lane, wave = c.wave;
    const int gw = c.vb * 4 + wave, t0 = l == 1 ? gw * 8 + NMETA * ((gw >> 8) + 1) : gw * 8;
    const bool has_x = l == 0 && (c.vb & 3) == 0; const int tx = T - 128 + (c.vb >> 2);
    unsigned char* wl = c.lds + wave * G2_WSTRIDE;
    int* pe_l = (int*)wl; float* pw_l = (float*)(wl + 4608); float* act_l = (float*)(wl + 9216);
#pragma unroll
    for (int j = 0; j < G2_MAXTOK; ++j) { const int tok = j < 8 ? t0 + j : (has_x ? tx : t0);
        pe_l[j * 128 + lane] = pe[(size_t)tok * 128 + lane]; pe_l[j * 128 + 64 + lane] = pe[(size_t)tok * 128 + 64 + lane];
        pw_l[j * 128 + lane] = pw[(size_t)tok * 128 + lane] * TAB_INV; pw_l[j * 128 + 64 + lane] = pw[(size_t)tok * 128 + 64 + lane] * TAB_INV; }
    const int xlo = has_x ? 4 * wave : 16, xhi = has_x ? 4 * wave + 4 : 16;
    {
        u32x4 xq[G2_MAXTOK]; float rs[G2_MAXTOK];
#pragma unroll
        for (int j = 0; j < G2_MAXTOK; ++j) { const int tok = j < 8 ? t0 + j : (has_x ? tx : t0);
            const u32x4 lo = *(const u32x4*)(hb + (size_t)tok * D + lane * 16), hi = *(const u32x4*)(hb + (size_t)tok * D + lane * 16 + 8);
            const f32x4 f0 = (f32x4){bf_lo(lo.x), bf_hi(lo.x), bf_lo(lo.y), bf_hi(lo.y)}, f1 = (f32x4){bf_lo(lo.z), bf_hi(lo.z), bf_lo(lo.w), bf_hi(lo.w)};
            const f32x4 f2 = (f32x4){bf_lo(hi.x), bf_hi(hi.x), bf_lo(hi.y), bf_hi(hi.y)}, f3 = (f32x4){bf_lo(hi.z), bf_hi(hi.z), bf_lo(hi.w), bf_hi(hi.w)};
            float mx = 1e-20f;
#pragma unroll
            for (int i = 0; i < 4; ++i) mx = fmaxf(mx, fmaxf(fmaxf(fabsf(f0[i]), fabsf(f1[i])), fmaxf(fabsf(f2[i]), fabsf(f3[i]))));
            mx = fmaxf(mx, dpp<0xB1>(mx)); mx = fmaxf(mx, dpp<0x4E>(mx)); mx = fmaxf(mx, dpp<0x141>(mx)); mx = fmaxf(mx, dpp<0x128>(mx)); mx = xrow16_max(mx);
            const float sx = 127.0f / mx;
            xq[j].x = pack_i8x4(f0 * sx); xq[j].y = pack_i8x4(f1 * sx); xq[j].z = pack_i8x4(f2 * sx); xq[j].w = pack_i8x4(f3 * sx);
            rs[j] = rstd_from_ssq8(ssq, tok) * mx * (1.0f / (127.0f * U_SCALE)); }
        u32x4 u[8];
#pragma unroll
        for (int k = 0; k < 8; ++k) u[k] = *(const u32x4*)(U + (size_t)__builtin_amdgcn_readfirstlane(pe_l[k]) * 1024 + lane * 16);
#pragma unroll 1
        for (int ch = 0; ch < 16; ++ch) {
            const int cn = ch < 15 ? ch + 1 : 0;
            const bool x_here = ch >= xlo && ch < xhi;
#pragma unroll
            for (int j = 0; j < 8; ++j) {
                const int* pe_next = j < 7 ? pe_l + (j + 1) * 128 + ch * 8 : (x_here ? pe_l + 8 * 128 + ch * 8 : pe_l + cn * 8);
                g2_u_chunk(u, U, pe_next, pw_l + j * 128 + ch * 8, act_l + j * 128 + ch * 8, xq[j], rs[j], lane); }
            if (x_here) g2_u_chunk(u, U, pe_l + cn * 8, pw_l + 8 * 128 + ch * 8, act_l + 8 * 128 + ch * 8, xq[8], rs[8], lane);
        }
    }
    f32x2 acc[G2_MAXTOK][8];
#pragma unroll
    for (int j = 0; j < G2_MAXTOK; ++j)
#pragma unroll
        for (int i = 0; i < 8; ++i) acc[j][i] = (f32x2){0.f, 0.f};
    {
        u32x4 v[8];
#pragma unroll
        for (int k = 0; k < 8; ++k) v[k] = *(const u32x4*)(V + (size_t)__builtin_amdgcn_readfirstlane(pe_l[k]) * 1024 + lane * 16);
#pragma unroll 1
        for (int ch = 0; ch < 16; ++ch) {
            const int cn = ch < 15 ? ch + 1 : 0;
            const bool x_here = ch >= xlo && ch < xhi;
#pragma unroll
            for (int j = 0; j < 8; ++j) {
                const int* pe_next = j < 7 ? pe_l + (j + 1) * 128 + ch * 8 : (x_here ? pe_l + 8 * 128 + ch * 8 : pe_l + cn * 8);
                g2_v_chunk(v, V, pe_next, act_l + j * 128 + ch * 8, acc[j], lane); }
            if (x_here) g2_v_chunk(v, V, pe_l + cn * 8, act_l + 8 * 128 + ch * 8, acc[8], lane);
        }
    }
#pragma unroll
    for (int j = 0; j < 8; ++j) g2_finish_token(c, l, t0 + j, acc[j], lane);
    __syncthreads();
    if (has_x) {
        f32x2* part = (f32x2*)(c.lds + wave * G2_WSTRIDE);
#pragma unroll
        for (int i = 0; i < 8; ++i) part[i * 64 + lane] = acc[8][i];
    }
    __syncthreads();
    if (has_x && wave == 0) {
        f32x2 tot[8];
#pragma unroll
        for (int i = 0; i < 8; ++i) { tot[i] = acc[8][i];
#pragma unroll
            for (int w = 1; w < 4; ++w) tot[i] += ((const f32x2*)(c.lds + w * G2_WSTRIDE))[i * 64 + lane]; }
        g2_finish_token(c, l, tx, tot, lane);
    }
    __syncthreads();
}

struct Args { const float* in[22]; float* out; unsigned char* ws; int ph_lo, ph_hi; };
constexpr int N_PHASES = 17;

__global__ void __launch_bounds__(NTHREADS, 2) fwd_kernel(Args args) {
    extern __shared__ __attribute__((aligned(16))) unsigned char lds_raw[];
    Ctx c;
#pragma unroll
    for (int i = 0; i < 22; ++i) c.in[i] = args.in[i];
    c.out = args.out; c.ws = args.ws; c.lds = lds_raw;
    c.tid = threadIdx.x; c.lane = c.tid & 63; c.wave = __builtin_amdgcn_readfirstlane(c.tid >> 6);
    c.G = gridDim.x; { const int bx = blockIdx.x; c.vb = (c.G % 8 == 0) ? (bx % 8) * (c.G / 8) + bx / 8 : bx; }
    volatile unsigned* misc = (volatile unsigned*)(c.lds + LDS_MISC);
    if (c.tid < 16) misc[c.tid] = 0u;
    __syncthreads();
    const int lo = args.ph_lo, hi = args.ph_hi;
    const bool multi = (hi - lo) > 1;
    XcdBarrier bar; bar.bar = WSP(unsigned, WS_CTL) + CW_BAR; bar.x = 0; bar.st = misc;
    if (multi) bar = xcd_barrier_post(WSP(unsigned, WS_CTL) + CW_BAR, misc);
#define IN_(k) (lo <= (k) && (k) < hi)
#define SEAM_(k) do { if ((k) + 1 < hi) xcd_barrier(bar); } while (0)
    if (IN_(0)) { phase_prologue(c); SEAM_(0); }
#pragma unroll 1
    for (int l = 0; l < 2; ++l) {
        const int p0 = 1 + 8 * l;
        if (IN_(p0 + 0)) { phase_A(c, l); SEAM_(p0 + 0); }
        if (IN_(p0 + 1)) { phase_B(c, l); SEAM_(p0 + 1); }
        if (IN_(p0 + 2)) { phase_C(c, l); SEAM_(p0 + 2); }
        if (IN_(p0 + 3)) { phase_D(c, l); SEAM_(p0 + 3); }
        if (IN_(p0 + 4)) { phase_E(c, l); SEAM_(p0 + 4); }
        if (IN_(p0 + 5)) { phase_F(c, l); SEAM_(p0 + 5); }
        if (IN_(p0 + 6)) { phase_F3(c, l); SEAM_(p0 + 6); }
        if (IN_(p0 + 7)) { phase_G2(c, l); SEAM_(p0 + 7); }
    }
}

extern "C" void kernel_launch(void* const* d_in, const int* in_sizes, int n_in, void* d_out, int out_size, void* d_ws, size_t ws_size, hipStream_t stream) {
    static int grid = 0;
    if (grid == 0) {
        if (n_in != 22 || out_size != NB * SEQ * D || ws_size < WS_END) { fprintf(stderr, "kernel_launch: unexpected shapes (n_in %d out %d ws %zu need %zu)\n", n_in, out_size, ws_size, (size_t)WS_END); grid = -1; return; }
        int dev = 0, cus = 0, per_cu = 0;
        hipGetDevice(&dev); hipDeviceGetAttribute(&cus, hipDeviceAttributeMultiprocessorCount, dev);
        if (hipFuncSetAttribute((const void*)fwd_kernel, hipFuncAttributeMaxDynamicSharedMemorySize, LDS_BYTES) != hipSuccess) { fprintf(stderr, "kernel_launch: hipFuncSetAttribute failed\n"); grid = -1; return; }
        if (hipOccupancyMaxActiveBlocksPerMultiprocessor(&per_cu, (const void*)fwd_kernel, NTHREADS, LDS_BYTES) != hipSuccess || per_cu < 1) { fprintf(stderr, "kernel_launch: occupancy query failed (%d)\n", per_cu); per_cu = 1; (void)hipGetLastError(); }
        if (per_cu > 2) per_cu = 2;
        grid = cus * per_cu;
        if (grid != 512) { fprintf(stderr, "kernel_launch: grid %d unsupported by phase G2 (needs 512 workgroups)\n", grid); grid = -1; return; }
        fprintf(stderr, "kernel_launch: grid %d (%d per CU), lds %d, ws need %zu have %zu\n", grid, per_cu, LDS_BYTES, (size_t)WS_END, ws_size);
    }
    if (grid < 0) return;
    hipMemsetAsync((char*)d_ws + WS_CTL, 0, CTL_BYTES, stream);
    Args a{};
    for (int i = 0; i < 22; ++i) a.in[i] = (const float*)d_in[i];
    a.out = (float*)d_out; a.ws = (unsigned char*)d_ws;
#if MK_PER_PHASE
    for (int ph = 0; ph < N_PHASES; ++ph) { a.ph_lo = ph; a.ph_hi = ph + 1; hipLaunchKernelGGL(fwd_kernel, dim3(grid), dim3(NTHREADS), LDS_BYTES, stream, a); }
#else
    a.ph_lo = 0; a.ph_hi = N_PHASES;
    void* kargs[] = {&a};
    hipError_t e = hipLaunchCooperativeKernel((const void*)fwd_kernel, dim3(grid), dim3(NTHREADS), kargs, LDS_BYTES, stream);
    if (e != hipSuccess) fprintf(stderr, "kernel_launch: cooperative launch failed: %s (grid %d)\n", hipGetErrorString(e), grid);
#endif
}
```

```cpp
#include <hip/hip_runtime.h>
#include <cstdio>
#include <cstdint>

#ifndef MK_PER_PHASE
#define MK_PER_PHASE 0
#endif

typedef unsigned short bf16;
typedef short bf16x8 __attribute__((ext_vector_type(8)));
typedef float f32x4 __attribute__((ext_vector_type(4)));
typedef unsigned u32x4 __attribute__((ext_vector_type(4)));
typedef unsigned u32x2 __attribute__((ext_vector_type(2)));
typedef __bf16 bf16x2 __attribute__((ext_vector_type(2)));

constexpr int NB = 8, SEQ = 2048, NMETA = 16, L = SEQ + NMETA, T = NB * L, D = 1024;
constexpr int DC = 512, CW = 31, NH = 8, QL = 256, KVL = 128, NOPE = 64, ROPE = 32, QK = 96, VD = 64;
constexpr int NIN = 3488, NINP = 3584;
constexpr int NEXP = 16384;
constexpr float EPS = 1e-6f;
constexpr int MT = T / 128;
static_assert(T % 128 == 0, "T tiles");

constexpr size_t al256(size_t x) { return (x + 255) & ~(size_t)255; }
constexpr size_t WS_CTL = 0;
constexpr size_t CTL_BYTES = 65536;
constexpr size_t WS_ROPE = WS_CTL + CTL_BYTES;
constexpr size_t WS_WIN = al256(WS_ROPE + (size_t)L * 16 * 8);
constexpr size_t SZ_WIN = (size_t)NINP * 1024 * 2, SZ_WCO = (size_t)1024 * 512 * 2, SZ_WUQ = (size_t)1024 * 256 * 2, SZ_WUKV = (size_t)1024 * 128 * 2,
                 SZ_WMLA = (size_t)1024 * 512 * 2, SZ_WOUT = (size_t)1024 * 1024 * 2, SZ_WPQ = (size_t)2048 * 1024 * 2, SZ_KEYS = (size_t)16 * 128 * 128 * 2;
constexpr size_t OFF_WCO = SZ_WIN, OFF_WUQ = OFF_WCO + SZ_WCO, OFF_WUKV = OFF_WUQ + SZ_WUQ, OFF_WMLA = OFF_WUKV + SZ_WUKV, OFF_WOUT = OFF_WMLA + SZ_WMLA,
                 OFF_WPQ = OFF_WOUT + SZ_WOUT, OFF_KEYS = OFF_WPQ + SZ_WPQ, SZ_WLAYER = OFF_KEYS + SZ_KEYS;
constexpr size_t WS_TAB = al256(WS_WIN + 2 * SZ_WLAYER);
constexpr size_t SZ_TAB = (size_t)NEXP * 1024;
constexpr float TAB_SCALE = 256.0f, TAB_INV = 1.0f / 256.0f;
constexpr float U_CLIP = 0.2f, U_SCALE = 127.0f / U_CLIP;
constexpr size_t WS_H = al256(WS_TAB + 4 * SZ_TAB);
constexpr size_t WS_HB = al256(WS_H + (size_t)T * 1024 * 4);
constexpr size_t WS_SSQ = al256(WS_HB + (size_t)T * 1024 * 2);
constexpr size_t WS_UGLU = al256(WS_SSQ + (size_t)T * 8 * 4);
constexpr size_t WS_CQ = al256(WS_UGLU + (size_t)T * 512 * 2);
constexpr size_t WS_CKV = al256(WS_CQ + (size_t)T * 256 * 2);
constexpr size_t WS_KROPE = al256(WS_CKV + (size_t)T * 128 * 2);
constexpr size_t WS_SSQQ = al256(WS_KROPE + (size_t)T * 32 * 4);
constexpr size_t WS_SSQKV = al256(WS_SSQQ + (size_t)T * 2 * 4);
constexpr size_t WS_U2 = al256(WS_SSQKV + (size_t)T * 4);
constexpr size_t WS_Q = al256(WS_U2 + (size_t)T * 512 * 2);
constexpr size_t WS_K = al256(WS_Q + (size_t)T * NH * QK * 2);
constexpr size_t WS_VT = al256(WS_K + (size_t)T * NH * QK * 2);
constexpr size_t WS_O = al256(WS_VT + (size_t)T * NH * VD * 2 + 4096);
constexpr size_t WS_MERGED = al256(WS_O + (size_t)T * 512 * 2);
constexpr size_t WS_GATES = al256(WS_MERGED + (size_t)T * 1024 * 2);
constexpr size_t WS_SV = WS_GATES;
constexpr size_t WS_SI = al256(WS_SV + (size_t)T * 256 * 4);
constexpr size_t WS_EIDX = al256(WS_SI + (size_t)T * 256);
constexpr size_t WS_GW = al256(WS_EIDX + (size_t)T * 128 * 4);
constexpr size_t WS_STB = al256(WS_GW + (size_t)T * 128 * 4);
constexpr size_t WS_PEER_END = WS_STB + (size_t)T * 16;
constexpr size_t WS_END = al256(WS_GATES + (size_t)T * 2048 * 2);
static_assert(WS_PEER_END <= WS_END, "peer scratch overlay");

constexpr int CW_BAR = 0;
constexpr int CW_QUEUE = 4096;

constexpr int LDS_MAIN = 128 * 132 * 4;
constexpr int LDS_MISC = LDS_MAIN;
constexpr int LDS_BYTES = LDS_MAIN + 64;

constexpr int NTHREADS = 256;

__device__ __forceinline__ unsigned pk2(float lo, float hi) { bf16x2 v; v.x = (__bf16)lo; v.y = (__bf16)hi; return __builtin_bit_cast(unsigned, v); }
__device__ __forceinline__ unsigned pack_i8x4(f32x4 v) {
    const int a = (int)__builtin_rintf(fminf(fmaxf(v.x, -127.f), 127.f)), b = (int)__builtin_rintf(fminf(fmaxf(v.y, -127.f), 127.f));
    const int c_ = (int)__builtin_rintf(fminf(fmaxf(v.z, -127.f), 127.f)), d = (int)__builtin_rintf(fminf(fmaxf(v.w, -127.f), 127.f));
    return (unsigned)(a & 255) | ((unsigned)(b & 255) << 8) | ((unsigned)(c_ & 255) << 16) | ((unsigned)(d & 255) << 24);
}
__device__ __forceinline__ float bf_lo(unsigned p) { return __uint_as_float(p << 16); }
__device__ __forceinline__ float bf_hi(unsigned p) { return __uint_as_float(p & 0xffff0000u); }
__device__ __forceinline__ float fast_rcp(float x) { return __builtin_amdgcn_rcpf(x); }
__device__ __forceinline__ float fast_exp2(float x) { return __builtin_amdgcn_exp2f(x); }
__device__ __forceinline__ float sigmoidf_(float x) { return fast_rcp(1.0f + fast_exp2(-1.4426950409f * x)); }
__device__ __forceinline__ float gelu_tanh(float x) { const float u = 1.5957691216f * (x + 0.044715f * x * x * x); return x * fast_rcp(1.0f + fast_exp2(-1.4426950409f * u)); }
__device__ __forceinline__ float rsqrt_(float x) { return __builtin_amdgcn_rsqf(x); }
template <int CTRL> __device__ __forceinline__ float dpp(float x) { return __builtin_bit_cast(float, __builtin_amdgcn_mov_dpp(__builtin_bit_cast(int, x), CTRL, 0xf, 0xf, true)); }
__device__ __forceinline__ float xrow16_sum(float x) {
    auto s = __builtin_amdgcn_permlane16_swap(__float_as_uint(x), __float_as_uint(x), false, false);
    x = __uint_as_float(s[0]) + __uint_as_float(s[1]);
    auto t = __builtin_amdgcn_permlane32_swap(__float_as_uint(x), __float_as_uint(x), false, false);
    return __uint_as_float(t[0]) + __uint_as_float(t[1]);
}
__device__ __forceinline__ float xrow16_max(float x) {
    auto s = __builtin_amdgcn_permlane16_swap(__float_as_uint(x), __float_as_uint(x), false, false);
    x = fmaxf(__uint_as_float(s[0]), __uint_as_float(s[1]));
    auto t = __builtin_amdgcn_permlane32_swap(__float_as_uint(x), __float_as_uint(x), false, false);
    return fmaxf(__uint_as_float(t[0]), __uint_as_float(t[1]));
}
__device__ __forceinline__ float wave_sum_dpp(float x) {
    x += dpp<0xB1>(x); x += dpp<0x4E>(x); x += dpp<0x141>(x); x += dpp<0x128>(x); return xrow16_sum(x);
}
__device__ __forceinline__ float quad_sum(float v) { return xrow16_sum(v); }
__device__ __forceinline__ float quad_max(float v) { return xrow16_max(v); }
__device__ __forceinline__ float wave_sum(float v) { return wave_sum_dpp(v); }
__device__ __forceinline__ float dot2(unsigned a, unsigned b, float c) { return __builtin_amdgcn_fdot2_f32_bf16(__builtin_bit_cast(bf16x2, a), __builtin_bit_cast(bf16x2, b), c, false); }

#define XB_TMO      128
#define XB_XCNT(j)  (256  + 64 * (j))
#define XB_XSUB(j)  (1280 + 64 * (j))
#define XB_XGEN(j)  (2304 + 64 * (j))
#define XB_TOP      3328
#define XB_TOPGEN   3392
#define XCD_BAR_WORDS 3456
#define XB_SPIN_CAP (1u << 20)
__device__ __forceinline__ unsigned xb_ld(unsigned* p)              { return __hip_atomic_load(p, __ATOMIC_RELAXED, __HIP_MEMORY_SCOPE_AGENT); }
__device__ __forceinline__ unsigned xb_add(unsigned* p, unsigned v) { return __hip_atomic_fetch_add(p, v, __ATOMIC_RELAXED, __HIP_MEMORY_SCOPE_AGENT); }
__device__ __forceinline__ unsigned xb_xcc_id() { return (unsigned)__builtin_amdgcn_s_getreg((3 << 11) | 20) & 0xFu; }
#define XB_SPIN(cond, bar) do { unsigned _sp = 0; while (cond) { __builtin_amdgcn_s_sleep(1); \
    if ((++_sp & 255u) == 0u) { if (xb_ld(&(bar)[XB_TMO])) break; if (_sp > XB_SPIN_CAP) { atomicAdd(&(bar)[XB_TMO], 1u); break; } } } } while (0)
struct XcdBarrier { unsigned* bar; unsigned x; volatile unsigned* st; };
__device__ __forceinline__ XcdBarrier xcd_barrier_post(unsigned* bar, volatile unsigned* st) {
    XcdBarrier b; b.bar = bar; b.x = xb_xcc_id(); b.st = st;
    if (threadIdx.x == 0) (void)xb_add(&bar[XB_XCNT(b.x)], 1u);
    return b;
}
__device__ __forceinline__ void xcd_barrier_complete(unsigned* bar, unsigned x, unsigned& nloc, unsigned& nx) {
    const unsigned G = gridDim.x * gridDim.y * gridDim.z;
    unsigned sum, cnt, mine, sp = 0u;
    for (;;) {
        sum = 0u; cnt = 0u; mine = 0u;
#pragma unroll
        for (unsigned j = 0; j < 16; ++j) { const unsigned c = xb_ld(&bar[XB_XCNT(j)]); sum += c; cnt += (c > 0u) ? 1u : 0u; mine = (j == x) ? c : mine; }
        if (sum == G) break;
        __builtin_amdgcn_s_sleep(1);
        if ((++sp & 255u) == 0u) { if (xb_ld(&bar[XB_TMO])) break; if (sp > XB_SPIN_CAP) { atomicAdd(&bar[XB_TMO], 1u); break; } }
    }
    nloc = mine > 0u ? mine : 1u; nx = cnt > 0u ? cnt : 1u;
}
__device__ __forceinline__ void xcd_barrier(const XcdBarrier& b) {
    asm volatile("s_waitcnt vmcnt(0)" ::: "memory");
    __syncthreads();
    if (threadIdx.x == 0) {
        unsigned* bar = b.bar;
        __builtin_amdgcn_s_waitcnt(0);
        unsigned nloc = b.st[0], nx = b.st[1];
        if (nloc == 0u) { xcd_barrier_complete(bar, b.x, nloc, nx); b.st[0] = nloc; b.st[1] = nx; }
        const unsigned old = xb_add(&bar[XB_XSUB(b.x)], 1u);
        const unsigned gen = old / nloc;
        if (old + 1u == (gen + 1u) * nloc) {
            __builtin_amdgcn_fence(__ATOMIC_RELEASE, "agent");
            asm volatile("s_waitcnt vmcnt(0)" ::: "memory");
            const unsigned og = xb_add(&bar[XB_TOP], 1u);
            const unsigned tg = og / nx;
            if (og + 1u == (tg + 1u) * nx) xb_add(&bar[XB_TOPGEN], 1u);
            else XB_SPIN(xb_ld(&bar[XB_TOPGEN]) == tg, bar);
            __builtin_amdgcn_fence(__ATOMIC_ACQUIRE, "agent");
            xb_add(&bar[XB_XGEN(b.x)], 1u);
            asm volatile("s_waitcnt vmcnt(0)" ::: "memory");
        } else {
            XB_SPIN(xb_ld(&bar[XB_XGEN(b.x)]) == gen, bar);
            __builtin_amdgcn_fence(__ATOMIC_ACQUIRE, "agent");
            asm volatile("s_waitcnt vmcnt(0)" ::: "memory");
        }
    }
    __syncthreads();
}

struct Ctx {
    const float* in[22]; float* out; unsigned char* ws;
    unsigned char* lds; int tid, lane, wave, G, vb;
};
#define WSP(T_, off) ((T_*)(c.ws + (off)))
__device__ __forceinline__ Ctx reopaque(const Ctx& c0) {
    Ctx c = c0; int t = c0.tid; asm volatile("" : "+v"(t)); c.tid = t; c.lane = t & 63; c.wave = __builtin_amdgcn_readfirstlane(t >> 6);
    int vb = c0.vb; asm volatile("" : "+s"(vb)); c.vb = vb; return c;
}

__device__ __forceinline__ int lds_off(int row, int chunk) { return row * 128 + ((chunk ^ (row & 7)) << 4); }

__device__ __forceinline__ void gemm_compute_stage(f32x4 (&acc)[2][8], const unsigned char* sA, const unsigned char* sB, int wave, int lane) {
    const int r = lane & 15, q = lane >> 4;
#pragma unroll
    for (int ks = 0; ks < 2; ++ks) {
        bf16x8 af[2], bfr[8];
#pragma unroll
        for (int mi = 0; mi < 2; ++mi) af[mi] = *(const bf16x8*)(sA + lds_off(32 * wave + 16 * mi + r, 4 * ks + q));
#pragma unroll
        for (int ni = 0; ni < 8; ++ni) bfr[ni] = *(const bf16x8*)(sB + lds_off(16 * ni + r, 4 * ks + q));
#pragma unroll
        for (int mi = 0; mi < 2; ++mi)
#pragma unroll
            for (int ni = 0; ni < 8; ++ni) acc[mi][ni] = __builtin_amdgcn_mfma_f32_16x16x32_bf16(bfr[ni], af[mi], acc[mi][ni], 0, 0, 0);
    }
}

#define LAS __attribute__((address_space(3)))
__device__ __forceinline__ void gemm_stage_glds(const bf16* A, int lda, const bf16* Bt, int ldb, int kt, unsigned char* stage, int wave, int lane) {
    const int rr = lane >> 3, cch = (lane & 7) ^ rr;
#pragma unroll
    for (int i = 0; i < 4; ++i) { const int pc = 4 * i + wave;
        __builtin_amdgcn_global_load_lds((const unsigned*)(A + (size_t)(8 * pc + rr) * lda + kt * 64 + cch * 8), (LAS unsigned*)(stage + pc * 1024), 16, 0, 0);
        __builtin_amdgcn_global_load_lds((const unsigned*)(Bt + (size_t)(8 * pc + rr) * ldb + kt * 64 + cch * 8), (LAS unsigned*)(stage + 16384 + pc * 1024), 16, 0, 0); }
}
__device__ __forceinline__ void gemm_core(f32x4 (&acc)[2][8], const bf16* A, int lda, const bf16* Bt, int ldb, int K, unsigned char* lds, int tid) {
    const int wave = __builtin_amdgcn_readfirstlane(tid >> 6), lane = tid & 63;
    const int nk = K >> 6;
    gemm_stage_glds(A, lda, Bt, ldb, 0, lds, wave, lane);
    asm volatile("s_waitcnt vmcnt(0)" ::: "memory");
    __syncthreads();
    for (int kt = 0; kt < nk; ++kt) {
        const int cur = kt & 1;
        if (kt + 1 < nk) gemm_stage_glds(A, lda, Bt, ldb, kt + 1, lds + (cur ^ 1) * 32768, wave, lane);
        gemm_compute_stage(acc, lds + cur * 32768, lds + cur * 32768 + 16384, wave, lane);
        asm volatile("s_waitcnt vmcnt(0)" ::: "memory");
        __syncthreads();
    }
}
__device__ __forceinline__ void acc_zero(f32x4 (&acc)[2][8]) {
#pragma unroll
    for (int mi = 0; mi < 2; ++mi)
#pragma unroll
        for (int ni = 0; ni < 8; ++ni) acc[mi][ni] = (f32x4){0.f, 0.f, 0.f, 0.f};
}
__device__ __forceinline__ float rstd_from_ssq8(const float* ssq, int tok) {
    const f32x4 a = *(const f32x4*)(ssq + (size_t)tok * 8), b = *(const f32x4*)(ssq + (size_t)tok * 8 + 4);
    const float s = ((a.x + a.y) + (a.z + a.w)) + ((b.x + b.y) + (b.z + b.w));
    return rsqrt_(s * (1.0f / 1024.0f) + EPS);
}

__device__ __forceinline__ int src_col(int mode, int np) {
    if (mode == 0) return np;
    if (mode == 2) { const int h = np >> 7, j = np & 127; return j < 96 ? h * 96 + j : -1; }
    if (np < 1024) { const int cblk = np >> 7, j = np & 127; return j < 64 ? 64 * cblk + j : 512 + 64 * cblk + (j - 64); }
    if (np < 1408) return np;
    if (np < 1536) { const int j = np - 1408; return j < 32 ? 1408 + j : -1; }
    return 1440 + (np - 1536);
}
__device__ __forceinline__ void p0_transpose_item(const float* W, int K, int N, bf16* Wt, int mode, const float* g, int item, float* scr, int lane) {
    const int nblk_k = K / 64, nb = item / nblk_k, kb = item % nblk_k, k0 = 64 * kb, n0 = 32 * nb;
    const int n = src_col(mode, n0 + (lane & 31));
    float wv[32], gv[32];
#pragma unroll
    for (int i = 0; i < 32; ++i) { const int kk = 2 * i + (lane >> 5); wv[i] = n >= 0 ? W[(size_t)(k0 + kk) * N + n] : 0.f; gv[i] = g ? g[k0 + kk] : 1.f; }
#pragma unroll
    for (int i = 0; i < 32; ++i) { const int kk = 2 * i + (lane >> 5); scr[kk * 33 + (lane & 31)] = wv[i] * gv[i]; }
    __builtin_amdgcn_s_waitcnt(0xC07F); asm volatile("" ::: "memory");
    const int cch = lane & 7;
#pragma unroll
    for (int j = 0; j < 4; ++j) { const int nl = (lane >> 3) + 8 * j; const float* s = scr + (8 * cch) * 33 + nl;
        u32x4 o; o.x = pk2(s[0 * 33], s[1 * 33]); o.y = pk2(s[2 * 33], s[3 * 33]); o.z = pk2(s[4 * 33], s[5 * 33]); o.w = pk2(s[6 * 33], s[7 * 33]);
        *(u32x4*)(Wt + (size_t)(n0 + nl) * K + k0 + 8 * cch) = o; }
    __builtin_amdgcn_s_waitcnt(0xC07F); asm volatile("" ::: "memory");
}
struct WDesc { int in_idx, K, N, Np, mode, g_idx; size_t off; };
__device__ __forceinline__ void phase_prologue(const Ctx& c0) {
    Ctx c = reopaque(c0);
    const int gw = c.vb * 4 + c.wave, NGW = c.G * 4;
    float* scr = (float*)(c.lds + c.wave * 8704);
    const WDesc wd[7] = {
        {3, 1024, NIN, NINP, 1, 2, 0}, {8, 512, 1024, 1024, 0, -1, OFF_WCO}, {10, 256, 768, 1024, 2, 9, OFF_WUQ}, {12, 128, 1024, 1024, 0, 11, OFF_WUKV},
        {15, 512, 1024, 1024, 0, -1, OFF_WMLA}, {16, 1024, 1024, 1024, 0, -1, OFF_WOUT}, {18, 1024, 2048, 2048, 0, 17, OFF_WPQ}};
    constexpr int ITEMS_PER_LAYER = (1024 / 64) * (NINP / 32) + (512 / 64) * 32 + (256 / 64) * 32 + (128 / 64) * 32 + (512 / 64) * 32 + (1024 / 64) * 32 + (1024 / 64) * 64;
    for (int it = gw; it < 2 * ITEMS_PER_LAYER; it += NGW) {
        const int l = it >= ITEMS_PER_LAYER ? 1 : 0; int r = it - l * ITEMS_PER_LAYER;
        const float* W = nullptr; const float* g = nullptr; bf16* Wt = nullptr; int K = 64, N = 32, mode = 0, rr = 0;
#pragma unroll
        for (int m = 0; m < 7; ++m) {
            const int items = (wd[m].K / 64) * (wd[m].Np / 32);
            if (r >= 0 && r < items) { K = wd[m].K; N = wd[m].N; mode = wd[m].mode; rr = r;
                W = c.in[wd[m].in_idx] + (size_t)l * wd[m].K * wd[m].N; g = wd[m].g_idx >= 0 ? c.in[wd[m].g_idx >= 0 ? wd[m].g_idx : 0] + (size_t)l * wd[m].K : nullptr;
                Wt = (bf16*)(c.ws + WS_WIN + l * SZ_WLAYER + wd[m].off); }
            r -= items;
        }
        p0_transpose_item(W, K, N, Wt, mode, g, rr, scr, c.lane);
    }
    const int gt = c.vb * NTHREADS + c.tid, NGT = c.G * NTHREADS;
    for (int l = 0; l < 2; ++l) {
        const float* src = c.in[19] + (size_t)l * 262144; bf16* dst = (bf16*)(c.ws + WS_WIN + l * SZ_WLAYER + OFF_KEYS);
        for (int i = gt; i < 262144 / 8; i += NGT) { const f32x4 a = *(const f32x4*)(src + i * 8), b = *(const f32x4*)(src + i * 8 + 4);
            u32x4 o; o.x = pk2(a.x, a.y); o.y = pk2(a.z, a.w); o.z = pk2(b.x, b.y); o.w = pk2(b.z, b.w); *(u32x4*)(dst + i * 8) = o; }
    }
    for (int l = 0; l < 2; ++l)
        for (int uv = 0; uv < 2; ++uv) {
            const float* src = c.in[20 + uv] + (size_t)l * NEXP * 1024; unsigned char* dst = c.ws + WS_TAB + (size_t)(l * 2 + uv) * SZ_TAB;
            f32x4 g4[4];
#pragma unroll
            for (int j = 0; j < 4; ++j) { const float sc = uv == 0 ? U_SCALE : TAB_SCALE; g4[j] = (f32x4){sc, sc, sc, sc}; if (uv == 0) g4[j] = g4[j] * *(const f32x4*)(c.in[17] + l * 1024 + 256 * j + 4 * c.lane); }
            for (int row = gw; row < NEXP; row += 2 * NGW) {
                const float* sp = src + (size_t)row * 1024 + 4 * c.lane; const int row2 = row + NGW; const bool two = row2 < NEXP;
                const float* sp2 = src + (size_t)(two ? row2 : row) * 1024 + 4 * c.lane;
                f32x4 a[4], b[4];
#pragma unroll
                for (int j = 0; j < 4; ++j) { a[j] = *(const f32x4*)(sp + 256 * j); b[j] = *(const f32x4*)(sp2 + 256 * j); }
#pragma unroll
                for (int j = 0; j < 4; ++j) { const f32x4 v = a[j] * g4[j];
                    *(unsigned*)(dst + (size_t)row * 1024 + 256 * j + 4 * c.lane) = uv == 0 ? pack_i8x4(v) : (unsigned)__builtin_amdgcn_cvt_pk_fp8_f32(v.z, v.w, __builtin_amdgcn_cvt_pk_fp8_f32(v.x, v.y, 0, false), true); }
                if (two) {
#pragma unroll
                    for (int j = 0; j < 4; ++j) { const f32x4 v = b[j] * g4[j];
                        *(unsigned*)(dst + (size_t)row2 * 1024 + 256 * j + 4 * c.lane) = uv == 0 ? pack_i8x4(v) : (unsigned)__builtin_amdgcn_cvt_pk_fp8_f32(v.z, v.w, __builtin_amdgcn_cvt_pk_fp8_f32(v.x, v.y, 0, false), true); } }
            }
        }
    { float* rope = WSP(float, WS_ROPE);
      for (int i = gt; i < L * 16; i += NGT) { const int pos = i >> 4, j = i & 15;
          const float inv = 1.0f / __builtin_exp2f((float)j * 0.8304820237218406f);
          const float angf = (float)pos * inv; const double ang = (double)angf;
          const double nq = __builtin_rint(ang * 0.63661977236758134308);
          double rr = __builtin_fma(-nq, 1.57079632679489655800e+00, ang); rr = __builtin_fma(-nq, 6.12323399573676603587e-17, rr);
          const double r2 = rr * rr;
          double sp = -1.0 / 1307674368000.0; sp = sp * r2 + 1.0 / 6227020800.0; sp = sp * r2 - 1.0 / 39916800.0; sp = sp * r2 + 1.0 / 362880.0; sp = sp * r2 - 1.0 / 5040.0; sp = sp * r2 + 1.0 / 120.0; sp = sp * r2 - 1.0 / 6.0; sp = sp * r2 * rr + rr;
          double cp = 1.0 / 87178291200.0; cp = cp * r2 - 1.0 / 479001600.0; cp = cp * r2 + 1.0 / 3628800.0; cp = cp * r2 - 1.0 / 40320.0; cp = cp * r2 + 1.0 / 720.0; cp = cp * r2 - 1.0 / 24.0; cp = cp * r2 + 0.5; cp = 1.0 - cp * r2;
          const int qd = ((int)nq) & 3;
          const double cv = qd == 0 ? cp : qd == 1 ? -sp : qd == 2 ? -cp : sp;
          const double sv_ = qd == 0 ? sp : qd == 1 ? cp : qd == 2 ? -sp : -cp;
          rope[2 * i] = (float)cv; rope[2 * i + 1] = (float)sv_; } }
    { float* h = WSP(float, WS_H); bf16* hb = WSP(bf16, WS_HB); float* ssq = WSP(float, WS_SSQ);
      for (int t = gw; t < T; t += NGW) { const int b = t / L, pos = t % L;
          const float* src = pos < NMETA ? c.in[1] + (size_t)pos * D : c.in[0] + ((size_t)b * SEQ + (pos - NMETA)) * D;
          float s = 0.f;
#pragma unroll
          for (int j = 0; j < 4; ++j) { const f32x4 v = *(const f32x4*)(src + j * 256 + c.lane * 4); *(f32x4*)(h + (size_t)t * D + j * 256 + c.lane * 4) = v;
              u32x2 o; o.x = pk2(v.x, v.y); o.y = pk2(v.z, v.w); *(u32x2*)(hb + (size_t)t * D + j * 256 + c.lane * 4) = o; s += (v.x * v.x + v.y * v.y) + (v.z * v.z + v.w * v.w); }
          s = wave_sum(s);
          if (c.lane < 8) ssq[(size_t)t * 8 + c.lane] = c.lane == 0 ? s : 0.f; } }
}

__device__ __forceinline__ void phase_A(const Ctx& c0, int l) {
    Ctx c = reopaque(c0);
    const bf16* hb = WSP(bf16, WS_HB); const bf16* Wt = (const bf16*)(c.ws + WS_WIN + l * SZ_WLAYER);
    const float* ssq = WSP(float, WS_SSQ);
    bf16* uglu = WSP(bf16, WS_UGLU); bf16* cq = WSP(bf16, WS_CQ); bf16* ckv = WSP(bf16, WS_CKV); float* krope = WSP(float, WS_KROPE);
    float* ssqq = WSP(float, WS_SSQQ); float* ssqkv = WSP(float, WS_SSQKV); bf16* gates = WSP(bf16, WS_GATES);
    constexpr int NT = NINP / 128;
    const int r = c.lane & 15, q = c.lane >> 4;
    const int xcd = c.vb / (c.G / 8), lb = c.vb % (c.G / 8), xm = xcd & 1, xn = xcd >> 1;
    const int m_lo = xm ? (MT + 1) / 2 : 0, m_cnt = xm ? MT / 2 : (MT + 1) / 2;
    for (int j = lb; j < m_cnt * 7; j += c.G / 8) {
        const int mt = m_lo + j / 7, nt = xn * 7 + j % 7;
        f32x4 acc[2][8]; acc_zero(acc);
        gemm_core(acc, hb + (size_t)mt * 128 * D, D, Wt + (size_t)nt * 128 * D, D, D, c.lds, c.tid);
#pragma unroll
        for (int mi = 0; mi < 2; ++mi) {
            const int tok = mt * 128 + 32 * c.wave + 16 * mi + r;
            const float rs = rstd_from_ssq8(ssq, tok);
            if (nt < 8) {
#pragma unroll
                for (int ni = 0; ni < 4; ++ni) { const f32x4 v = acc[mi][ni] * rs, g = acc[mi][ni + 4] * rs;
                    u32x2 o; o.x = pk2(v.x * sigmoidf_(g.x), v.y * sigmoidf_(g.y)); o.y = pk2(v.z * sigmoidf_(g.z), v.w * sigmoidf_(g.w));
                    *(u32x2*)(uglu + (size_t)tok * DC + nt * 64 + 16 * ni + 4 * q) = o; }
            } else if (nt < 11) {
                bf16* dst = nt < 10 ? cq + (size_t)tok * QL + (nt - 8) * 128 : ckv + (size_t)tok * KVL;
                float ss = 0.f;
#pragma unroll
                for (int ni = 0; ni < 8; ++ni) { const f32x4 v = acc[mi][ni] * rs; ss += (v.x * v.x + v.y * v.y) + (v.z * v.z + v.w * v.w);
                    u32x2 o; o.x = pk2(v.x, v.y); o.y = pk2(v.z, v.w); *(u32x2*)(dst + 16 * ni + 4 * q) = o; }
                ss = quad_sum(ss);
                if (q == 0) { if (nt < 10) ssqq[(size_t)tok * 2 + (nt - 8)] = ss; else ssqkv[tok] = ss; }
            } else if (nt == 11) {
#pragma unroll
                for (int ni = 0; ni < 2; ++ni) *(f32x4*)(krope + (size_t)tok * 32 + 16 * ni + 4 * q) = acc[mi][ni] * rs;
            } else {
#pragma unroll
                for (int ni = 0; ni < 8; ++ni) { const f32x4 v = acc[mi][ni] * rs;
                    u32x2 o; o.x = pk2(sigmoidf_(v.x), sigmoidf_(v.y)); o.y = pk2(sigmoidf_(v.z), sigmoidf_(v.w));
                    *(u32x2*)(gates + (size_t)tok * 2048 + (nt - 12) * 128 + 16 * ni + 4 * q) = o; }
            }
        }
    }
}

__device__ __forceinline__ void phaseB_q_item(Ctx& c, int l, int mt, int head) {
    const bf16* cq = WSP(bf16, WS_CQ); const bf16* Wt = (const bf16*)(c.ws + WS_WIN + l * SZ_WLAYER + OFF_WUQ);
    const float* ssqq = WSP(float, WS_SSQQ); const float* rope = WSP(float, WS_ROPE); const float* qg = c.in[13] + l * QK; bf16* Qb = WSP(bf16, WS_Q);
    const int r = c.lane & 15, q = c.lane >> 4;
    f32x4 acc[2][8]; acc_zero(acc);
    gemm_core(acc, cq + (size_t)mt * 128 * QL, QL, Wt + (size_t)head * 128 * QL, QL, QL, c.lds, c.tid);
    constexpr float QSCALE = 0.10206207261596575f * 1.4426950408889634f;
#pragma unroll
    for (int mi = 0; mi < 2; ++mi) {
        const int tok = mt * 128 + 32 * c.wave + 16 * mi + r, b = tok / L, pos = tok - b * L;
        const float rs = rsqrt_((ssqq[(size_t)tok * 2] + ssqq[(size_t)tok * 2 + 1]) * (1.0f / 256.0f) + EPS);
        float ss = 0.f;
#pragma unroll
        for (int ni = 0; ni < 6; ++ni) { acc[mi][ni] = acc[mi][ni] * rs; const f32x4 v = acc[mi][ni]; ss += (v.x * v.x + v.y * v.y) + (v.z * v.z + v.w * v.w); }
        ss = quad_sum(ss);
        const float rn = rsqrt_(ss * (1.0f / 96.0f) + EPS) * QSCALE;
#pragma unroll
        for (int ni = 0; ni < 6; ++ni) { const f32x4 g = *(const f32x4*)(qg + 16 * ni + 4 * q); acc[mi][ni] = acc[mi][ni] * g * rn; }
        const f32x4 cs0 = *(const f32x4*)(rope + ((size_t)pos * 16 + 4 * q) * 2), cs1 = *(const f32x4*)(rope + ((size_t)pos * 16 + 4 * q) * 2 + 4);
        const float co[4] = {cs0.x, cs0.z, cs1.x, cs1.z}, si[4] = {cs0.y, cs0.w, cs1.y, cs1.w};
        f32x4 x1 = acc[mi][4], x2 = acc[mi][5];
#pragma unroll
        for (int e = 0; e < 4; ++e) { const float a = x1[e], bb = x2[e]; x1[e] = a * co[e] - bb * si[e]; x2[e] = bb * co[e] + a * si[e]; }
        acc[mi][4] = x1; acc[mi][5] = x2;
        bf16* dst = Qb + (((size_t)b * NH + head) * L + pos) * QK;
#pragma unroll
        for (int ni = 0; ni < 6; ++ni) { const f32x4 v = acc[mi][ni]; u32x2 o; o.x = pk2(v.x, v.y); o.y = pk2(v.z, v.w); *(u32x2*)(dst + 16 * ni + 4 * q) = o; }
    }
}
__device__ __forceinline__ void phaseB_kv_item(Ctx& c, int l, int mt, int head) {
    const bf16* ckv = WSP(bf16, WS_CKV); const bf16* Wt = (const bf16*)(c.ws + WS_WIN + l * SZ_WLAYER + OFF_WUKV);
    const float* ssqkv = WSP(float, WS_SSQKV); const float* rope = WSP(float, WS_ROPE); const float* kg = c.in[14] + l * QK; const float* krope = WSP(float, WS_KROPE);
    bf16* Kb = WSP(bf16, WS_K); bf16* Vt = WSP(bf16, WS_VT);
    const int tid = c.tid, wave = c.wave, lane = c.lane, r = lane & 15, q = lane >> 4;
    unsigned char* lds = c.lds;
    f32x4 ak[2][4], av[2][4];
#pragma unroll
    for (int mi = 0; mi < 2; ++mi)
#pragma unroll
        for (int ni = 0; ni < 4; ++ni) { ak[mi][ni] = (f32x4){0.f, 0.f, 0.f, 0.f}; av[mi][ni] = (f32x4){0.f, 0.f, 0.f, 0.f}; }
    { const int chunk = tid & 7, row0 = tid >> 3;
      const bf16* pa = ckv + ((size_t)mt * 128 + row0) * KVL + chunk * 8; const bf16* pb = Wt + ((size_t)head * 128 + row0) * KVL + chunk * 8;
#pragma unroll
      for (int s = 0; s < 2; ++s)
#pragma unroll
          for (int i = 0; i < 4; ++i) { *(u32x4*)(lds + s * 32768 + lds_off(row0 + 32 * i, chunk)) = *(const u32x4*)(pa + (size_t)(32 * i) * KVL + s * 64);
              *(u32x4*)(lds + s * 32768 + 16384 + lds_off(row0 + 32 * i, chunk)) = *(const u32x4*)(pb + (size_t)(32 * i) * KVL + s * 64); }
    }
    __syncthreads();
#pragma unroll
    for (int s = 0; s < 2; ++s)
#pragma unroll
        for (int ks = 0; ks < 2; ++ks) {
            const unsigned char* sA = lds + s * 32768; const unsigned char* sB = sA + 16384;
            bf16x8 af[2], bfr[8];
#pragma unroll
            for (int mi = 0; mi < 2; ++mi) af[mi] = *(const bf16x8*)(sA + lds_off(32 * wave + 16 * mi + r, 4 * ks + q));
#pragma unroll
            for (int ni = 0; ni < 8; ++ni) bfr[ni] = *(const bf16x8*)(sB + lds_off(16 * ni + r, 4 * ks + q));
#pragma unroll
            for (int mi = 0; mi < 2; ++mi)
#pragma unroll
                for (int ni = 0; ni < 4; ++ni) { ak[mi][ni] = __builtin_amdgcn_mfma_f32_16x16x32_bf16(bfr[ni], af[mi], ak[mi][ni], 0, 0, 0);
                    av[mi][ni] = __builtin_amdgcn_mfma_f32_16x16x32_bf16(af[mi], bfr[ni + 4], av[mi][ni], 0, 0, 0); }
        }
    __syncthreads();
#pragma unroll
    for (int mi = 0; mi < 2; ++mi) {
        const int tok0 = mt * 128 + 32 * wave + 16 * mi, b = tok0 / L, pos0 = tok0 - b * L;
        { const int tok = tok0 + r, pos = pos0 + r;
          const float rs = rsqrt_(ssqkv[tok] * (1.0f / 128.0f) + EPS);
          const f32x4 kr1 = *(const f32x4*)(krope + (size_t)tok * 32 + 4 * q), kr2 = *(const f32x4*)(krope + (size_t)tok * 32 + 16 + 4 * q);
          float ss = (kr1.x * kr1.x + kr1.y * kr1.y) + (kr1.z * kr1.z + kr1.w * kr1.w) + (kr2.x * kr2.x + kr2.y * kr2.y) + (kr2.z * kr2.z + kr2.w * kr2.w);
#pragma unroll
          for (int ni = 0; ni < 4; ++ni) { ak[mi][ni] = ak[mi][ni] * rs; const f32x4 v = ak[mi][ni]; ss += (v.x * v.x + v.y * v.y) + (v.z * v.z + v.w * v.w); }
          ss = quad_sum(ss);
          const float rn = rsqrt_(ss * (1.0f / 96.0f) + EPS);
          bf16* dst = Kb + (((size_t)b * NH + head) * L + pos) * QK;
#pragma unroll
          for (int ni = 0; ni < 4; ++ni) { const f32x4 g = *(const f32x4*)(kg + 16 * ni + 4 * q); const f32x4 v = ak[mi][ni] * g * rn;
              u32x2 o; o.x = pk2(v.x, v.y); o.y = pk2(v.z, v.w); *(u32x2*)(dst + 16 * ni + 4 * q) = o; }
          const f32x4 g1 = *(const f32x4*)(kg + 64 + 4 * q), g2 = *(const f32x4*)(kg + 80 + 4 * q);
          f32x4 x1 = kr1 * g1 * rn, x2 = kr2 * g2 * rn;
          const f32x4 cs0 = *(const f32x4*)(rope + ((size_t)pos * 16 + 4 * q) * 2), cs1 = *(const f32x4*)(rope + ((size_t)pos * 16 + 4 * q) * 2 + 4);
          const float co[4] = {cs0.x, cs0.z, cs1.x, cs1.z}, si[4] = {cs0.y, cs0.w, cs1.y, cs1.w};
#pragma unroll
          for (int e = 0; e < 4; ++e) { const float a = x1[e], bb = x2[e]; x1[e] = a * co[e] - bb * si[e]; x2[e] = bb * co[e] + a * si[e]; }
          u32x2 o1, o2; o1.x = pk2(x1.x, x1.y); o1.y = pk2(x1.z, x1.w); o2.x = pk2(x2.x, x2.y); o2.y = pk2(x2.z, x2.w);
          *(u32x2*)(dst + 64 + 4 * q) = o1; *(u32x2*)(dst + 80 + 4 * q) = o2; }
        { const f32x4 sq = *(const f32x4*)(ssqkv + tok0 + 4 * q);
          f32x4 rs4; rs4.x = rsqrt_(sq.x * (1.0f / 128.0f) + EPS); rs4.y = rsqrt_(sq.y * (1.0f / 128.0f) + EPS); rs4.z = rsqrt_(sq.z * (1.0f / 128.0f) + EPS); rs4.w = rsqrt_(sq.w * (1.0f / 128.0f) + EPS);
#pragma unroll
          for (int ni = 0; ni < 4; ++ni) { const f32x4 v = av[mi][ni] * rs4; u32x2 o; o.x = pk2(v.x, v.y); o.y = pk2(v.z, v.w);
              *(u32x2*)(Vt + (((size_t)b * NH + head) * VD + 16 * ni + r) * L + pos0 + 4 * q) = o; } }
    }
}
__device__ __forceinline__ u32x4 conv_row(const bf16* uglu, int b, int pos, int ch) {
    u32x4 xv = (u32x4){0u, 0u, 0u, 0u};
    if (pos >= 0) xv = *(const u32x4*)(uglu + ((size_t)b * L + pos) * DC + ch);
    return xv;
}
__device__ __forceinline__ void conv_fma(float (&a)[8], const u32x4 xv, const f32x4 w0, const f32x4 w1) {
    a[0] += bf_lo(xv.x) * w0.x; a[1] += bf_hi(xv.x) * w0.y; a[2] += bf_lo(xv.y) * w0.z; a[3] += bf_hi(xv.y) * w0.w;
    a[4] += bf_lo(xv.z) * w1.x; a[5] += bf_hi(xv.z) * w1.y; a[6] += bf_lo(xv.w) * w1.z; a[7] += bf_hi(xv.w) * w1.w;
}
__device__ __forceinline__ void phaseB_conv_item(Ctx& c, int l, int grp) {
    const bf16* uglu = WSP(bf16, WS_UGLU); bf16* u2 = WSP(bf16, WS_U2);
    const float* cw = c.in[4] + (size_t)l * CW * DC; const float* cb = c.in[5] + l * DC; const float* lg = c.in[6] + l * DC; const float* lb = c.in[7] + l * DC;
    const int tok0 = grp * 4, b = tok0 / L, pos0 = tok0 - b * L, ch = c.lane * 8;
    float acc[4][8];
    { const f32x4 b0 = *(const f32x4*)(cb + ch), b1 = *(const f32x4*)(cb + ch + 4);
#pragma unroll
      for (int d = 0; d < 4; ++d) { acc[d][0] = b0.x; acc[d][1] = b0.y; acc[d][2] = b0.z; acc[d][3] = b0.w; acc[d][4] = b1.x; acc[d][5] = b1.y; acc[d][6] = b1.z; acc[d][7] = b1.w; } }
    const int base = pos0 - 30;
    u32x4 x0 = conv_row(uglu, b, base + 0, ch), x1 = conv_row(uglu, b, base + 1, ch), x2 = conv_row(uglu, b, base + 2, ch),
          x3 = conv_row(uglu, b, base + 3, ch), x4 = conv_row(uglu, b, base + 4, ch), x5;
    const float* wp = cw + ch;
#pragma unroll 1
    for (int w = 0; w < CW; ++w) {
        x5 = conv_row(uglu, b, (w + 5 <= 33) ? base + w + 5 : -1, ch);
        const f32x4 w0 = *(const f32x4*)wp, w1 = *(const f32x4*)(wp + 4); wp += DC;
        conv_fma(acc[0], x0, w0, w1); conv_fma(acc[1], x1, w0, w1); conv_fma(acc[2], x2, w0, w1); conv_fma(acc[3], x3, w0, w1);
        x0 = x1; x1 = x2; x2 = x3; x3 = x4; x4 = x5;
    }
    const f32x4 g0 = *(const f32x4*)(lg + ch), g1 = *(const f32x4*)(lg + ch + 4), e0 = *(const f32x4*)(lb + ch), e1 = *(const f32x4*)(lb + ch + 4);
    const float gg[8] = {g0.x, g0.y, g0.z, g0.w, g1.x, g1.y, g1.z, g1.w}, be[8] = {e0.x, e0.y, e0.z, e0.w, e1.x, e1.y, e1.z, e1.w};
#pragma unroll
    for (int d = 0; d < 4; ++d) {
        float s = 0.f;
#pragma unroll
        for (int j = 0; j < 8; ++j) s += acc[d][j];
        const float mu = wave_sum(s) * (1.0f / 512.0f);
        float vq = 0.f;
#pragma unroll
        for (int j = 0; j < 8; ++j) { acc[d][j] -= mu; vq += acc[d][j] * acc[d][j]; }
        const float rstd = rsqrt_(wave_sum(vq) * (1.0f / 512.0f) + EPS);
        float y[8];
#pragma unroll
        for (int j = 0; j < 8; ++j) { const float v = acc[d][j] * rstd * gg[j] + be[j]; y[j] = v * sigmoidf_(v); }
        u32x4 o; o.x = pk2(y[0], y[1]); o.y = pk2(y[2], y[3]); o.z = pk2(y[4], y[5]); o.w = pk2(y[6], y[7]);
        *(u32x4*)(u2 + (size_t)(tok0 + d) * DC + ch) = o;
    }
}
__device__ __forceinline__ void phase_B(const Ctx& c0, int l) {
    Ctx c = reopaque(c0);
    constexpr int NQ = MT * NH, NKV = MT * NH, NCV = T / 16;
    for (int it = c.vb; it < NQ + NKV + NCV; it += c.G) {
        if (it < NQ) phaseB_q_item(c, l, it / NH, it % NH);
        else if (it < NQ + NKV) phaseB_kv_item(c, l, (it - NQ) / NH, (it - NQ) % NH);
        else phaseB_conv_item(c, l, (it - NQ - NKV) * 4 + c.wave);
    }
}

constexpr int KROW = 208, VROW = 136, ATT_STAGE = 64 * KROW + 64 * VROW;
constexpr int ATT_ITEMS = NB * NH * 17;
__device__ __forceinline__ void phase_C(const Ctx& c0, int l) {
    Ctx c = reopaque(c0);
    const bf16* Qb = WSP(bf16, WS_Q); const bf16* Kb = WSP(bf16, WS_K); const bf16* Vt = WSP(bf16, WS_VT); bf16* O = WSP(bf16, WS_O);
    unsigned* qctr = WSP(unsigned, WS_CTL) + CW_QUEUE + 64 * l;
    volatile unsigned* misc = (volatile unsigned*)(c.lds + LDS_MISC);
    const int tid = c.tid, wave = c.wave, lane = c.lane, r = lane & 15, q = lane >> 4;
    unsigned char* lds = c.lds;
    for (;;) {
        if (tid == 0) misc[4] = atomicAdd(qctr, 1u);
        __syncthreads();
        const int item = __builtin_amdgcn_readfirstlane((int)misc[4]);
        __syncthreads();
        if (item >= ATT_ITEMS) break;
        const int pp = 15 - item / 64, bh = item % 64, b = bh / NH, h = bh % NH;
        const bool meta = pp < 0;
        const int r0 = meta ? 0 : 16 + 128 * pp;
        const int nfull = meta ? 0 : 2 * pp + 1 + (wave >> 1);
        const int ntiles = meta ? 1 : 2 * pp + 3;
        const bf16* Kbase = Kb + (size_t)bh * L * QK; const bf16* Vbase = Vt + (size_t)bh * VD * L;
        bf16x8 qf[2][3];
#pragma unroll
        for (int mi = 0; mi < 2; ++mi)
#pragma unroll
            for (int ks = 0; ks < 3; ++ks) qf[mi][ks] = *(const bf16x8*)(Qb + ((size_t)bh * L + r0 + 32 * wave + 16 * mi + r) * QK + 32 * ks + 8 * q);
        float m[2] = {-1e30f, -1e30f}, lsum[2] = {0.f, 0.f};
        f32x4 o[2][4];
#pragma unroll
        for (int mi = 0; mi < 2; ++mi)
#pragma unroll
            for (int dt = 0; dt < 4; ++dt) o[mi][dt] = (f32x4){0.f, 0.f, 0.f, 0.f};
        u32x4 rk[3], rv[2];
        auto gload = [&](int kt) {
#pragma unroll
            for (int i = 0; i < 3; ++i) { const int id = tid + 256 * i, row = id / 12, cc = id % 12; rk[i] = *(const u32x4*)(Kbase + (size_t)(kt * 64 + row) * QK + cc * 8); }
#pragma unroll
            for (int i = 0; i < 2; ++i) { const int id = tid + 256 * i, row = id >> 3, cc = id & 7; rv[i] = *(const u32x4*)(Vbase + (size_t)row * L + kt * 64 + cc * 8); }
        };
        auto lstore = [&](int s) {
            unsigned char* st = lds + s * ATT_STAGE;
#pragma unroll
            for (int i = 0; i < 3; ++i) { const int id = tid + 256 * i, row = id / 12, cc = id % 12; *(u32x4*)(st + row * KROW + cc * 16) = rk[i]; }
#pragma unroll
            for (int i = 0; i < 2; ++i) { const int id = tid + 256 * i, row = id >> 3, cc = id & 7; u32x2* d = (u32x2*)(st + 64 * KROW + row * VROW + cc * 16); d[0] = (u32x2){rv[i].x, rv[i].y}; d[1] = (u32x2){rv[i].z, rv[i].w}; }
        };
        gload(0); lstore(0);
#pragma unroll
        for (int mi = 0; mi < 2; ++mi)
#pragma unroll
            for (int ks = 0; ks < 3; ++ks) asm volatile("" : "+v"(qf[mi][ks]));
        __syncthreads();
        for (int kt = 0; kt < ntiles; ++kt) {
            const int cur = kt & 1;
            if (kt + 1 < ntiles) gload(kt + 1);
            const unsigned char* sK = lds + cur * ATT_STAGE; const unsigned char* sV = sK + 64 * KROW;
            const bool full = kt < nfull;
            if (kt <= nfull) {
                f32x4 s[2][4];
#pragma unroll
                for (int kh = 0; kh < 2; ++kh) {
                    bf16x8 kf[2][3];
#pragma unroll
                    for (int kk = 0; kk < 2; ++kk) if ((kh == 0 && kk == 0) || full) {
#pragma unroll
                        for (int ks = 0; ks < 3; ++ks) kf[kk][ks] = *(const bf16x8*)(sK + (16 * (2 * kh + kk) + r) * KROW + 64 * ks + 16 * q); }
#pragma unroll
                    for (int kk = 0; kk < 2; ++kk) { const int k4 = 2 * kh + kk;
#pragma unroll
                        for (int mi = 0; mi < 2; ++mi) s[mi][k4] = (f32x4){0.f, 0.f, 0.f, 0.f};
                        if (k4 == 0 || full) {
#pragma unroll
                            for (int ks = 0; ks < 3; ++ks)
#pragma unroll
                                for (int mi = 0; mi < 2; ++mi) s[mi][k4] = __builtin_amdgcn_mfma_f32_16x16x32_bf16(kf[kk][ks], qf[mi][ks], s[mi][k4], 0, 0, 0);
                        }
                    }
                }
                u32x2 vlo[4], vhi[4];
#pragma unroll
                for (int dt = 0; dt < 4; ++dt) { const unsigned char* vp = sV + (16 * dt + r) * VROW + (4 * q) * 2;
                    vlo[dt] = *(const u32x2*)vp; vhi[dt] = (u32x2){0u, 0u}; if (full) vhi[dt] = *(const u32x2*)(vp + 32); }
                bf16x8 pf[2][2];
#pragma unroll
                for (int mi = 0; mi < 2; ++mi) {
                    float mx = fmaxf(fmaxf(s[mi][0].x, s[mi][0].y), fmaxf(s[mi][0].z, s[mi][0].w));
                    if (full) {
#pragma unroll
                        for (int k4 = 1; k4 < 4; ++k4) mx = fmaxf(mx, fmaxf(fmaxf(s[mi][k4].x, s[mi][k4].y), fmaxf(s[mi][k4].z, s[mi][k4].w)));
                    }
                    mx = quad_max(mx);
                    const float mn = fmaxf(m[mi], mx), alpha = fast_exp2(m[mi] - mn); m[mi] = mn;
                    float ps = 0.f;
#pragma unroll
                    for (int k4 = 0; k4 < 4; ++k4) {
                        if (k4 == 0 || full) { f32x4 p; p.x = fast_exp2(s[mi][k4].x - mn); p.y = fast_exp2(s[mi][k4].y - mn); p.z = fast_exp2(s[mi][k4].z - mn); p.w = fast_exp2(s[mi][k4].w - mn);
                            ps += (p.x + p.y) + (p.z + p.w); s[mi][k4] = p; }
                    }
                    lsum[mi] = lsum[mi] * alpha + ps;
#pragma unroll
                    for (int dt = 0; dt < 4; ++dt) o[mi][dt] = o[mi][dt] * alpha;
#pragma unroll
                    for (int st = 0; st < 2; ++st) { u32x4 pw;
                        pw.x = pk2(s[mi][2 * st].x, s[mi][2 * st].y); pw.y = pk2(s[mi][2 * st].z, s[mi][2 * st].w); pw.z = pk2(s[mi][2 * st + 1].x, s[mi][2 * st + 1].y); pw.w = pk2(s[mi][2 * st + 1].z, s[mi][2 * st + 1].w);
                        if (!full) { pw.z = 0u; pw.w = 0u; }
                        pf[mi][st] = __builtin_bit_cast(bf16x8, pw); }
                }
                u32x2 wlo[4], whi[4];
                if (full) {
#pragma unroll
                    for (int dt = 0; dt < 4; ++dt) { const unsigned char* vp = sV + (16 * dt + r) * VROW + (32 + 4 * q) * 2; wlo[dt] = *(const u32x2*)vp; whi[dt] = *(const u32x2*)(vp + 32); } }
#pragma unroll
                for (int dt = 0; dt < 4; ++dt) { const bf16x8 vf = __builtin_bit_cast(bf16x8, (u32x4){vlo[dt].x, vlo[dt].y, vhi[dt].x, vhi[dt].y});
#pragma unroll
                    for (int mi = 0; mi < 2; ++mi) o[mi][dt] = __builtin_amdgcn_mfma_f32_16x16x32_bf16(vf, pf[mi][0], o[mi][dt], 0, 0, 0); }
                if (full) {
#pragma unroll
                    for (int dt = 0; dt < 4; ++dt) { const bf16x8 vf = __builtin_bit_cast(bf16x8, (u32x4){wlo[dt].x, wlo[dt].y, whi[dt].x, whi[dt].y});
#pragma unroll
                        for (int mi = 0; mi < 2; ++mi) o[mi][dt] = __builtin_amdgcn_mfma_f32_16x16x32_bf16(vf, pf[mi][1], o[mi][dt], 0, 0, 0); } }
            }
            if (kt + 1 < ntiles) lstore(cur ^ 1);
            __syncthreads();
        }
#pragma unroll
        for (int mi = 0; mi < 2; ++mi) {
            const float lt = quad_sum(lsum[mi]);
            if (!meta || (wave == 0 && mi == 0)) {
                const float inv = 1.0f / lt;
                bf16* dst = O + ((size_t)b * L + r0 + 32 * wave + 16 * mi + r) * 512 + h * VD;
#pragma unroll
                for (int dt = 0; dt < 4; ++dt) { const f32x4 v = o[mi][dt] * inv; u32x2 ov; ov.x = pk2(v.x, v.y); ov.y = pk2(v.z, v.w); *(u32x2*)(dst + 16 * dt + 4 * q) = ov; }
            }
        }
    }
}

__device__ __forceinline__ int tile_tok0(int mt, int l) { return l == 1 ? mt * 128 + NMETA * ((mt >> 4) + 1) : mt * 128; }
__device__ __forceinline__ int n_mtiles(int l) { return l == 1 ? 128 : MT; }
__device__ __forceinline__ void phase_D(const Ctx& c0, int l) {
    Ctx c = reopaque(c0);
    const bf16* u2 = WSP(bf16, WS_U2); const bf16* O = WSP(bf16, WS_O); const bf16* gates = WSP(bf16, WS_GATES); bf16* merged = WSP(bf16, WS_MERGED);
    const bf16* Wco = (const bf16*)(c.ws + WS_WIN + l * SZ_WLAYER + OFF_WCO); const bf16* Wmla = (const bf16*)(c.ws + WS_WIN + l * SZ_WLAYER + OFF_WMLA);
    const int r = c.lane & 15, q = c.lane >> 4;
    for (int it = c.vb; it < n_mtiles(l) * 8; it += c.G) {
        const int mt = it / 8, nt = it % 8, tk0 = tile_tok0(mt, l);
        f32x4 acc[2][8]; acc_zero(acc);
        gemm_core(acc, u2 + (size_t)tk0 * 512, 512, Wco + (size_t)nt * 128 * 512, 512, 512, c.lds, c.tid);
#pragma unroll
        for (int mi = 0; mi < 2; ++mi) { const int tok = tk0 + 32 * c.wave + 16 * mi + r;
            const bf16* gp = gates + (size_t)tok * 2048 + nt * 128 + 4 * q; bf16* mp = merged + (size_t)tok * D + nt * 128 + 4 * q;
#pragma unroll
            for (int ni = 0; ni < 8; ++ni) { const u32x2 g = *(const u32x2*)(gp + 16 * ni); const f32x4 v = acc[mi][ni];
                u32x2 o; o.x = pk2(v.x * bf_lo(g.x), v.y * bf_hi(g.x)); o.y = pk2(v.z * bf_lo(g.y), v.w * bf_hi(g.y)); *(u32x2*)(mp + 16 * ni) = o; } }
        acc_zero(acc);
        gemm_core(acc, O + (size_t)tk0 * 512, 512, Wmla + (size_t)nt * 128 * 512, 512, 512, c.lds, c.tid);
#pragma unroll
        for (int mi = 0; mi < 2; ++mi) { const int tok = tk0 + 32 * c.wave + 16 * mi + r;
            const bf16* gp = gates + (size_t)tok * 2048 + 1024 + nt * 128 + 4 * q; bf16* mp = merged + (size_t)tok * D + nt * 128 + 4 * q;
#pragma unroll
            for (int ni = 0; ni < 8; ++ni) { const u32x2 g = *(const u32x2*)(gp + 16 * ni); const u32x2 s = *(const u32x2*)(mp + 16 * ni); const f32x4 v = acc[mi][ni];
                u32x2 o; o.x = pk2(bf_lo(s.x) + v.x * bf_lo(g.x), bf_hi(s.x) + v.y * bf_hi(g.x)); o.y = pk2(bf_lo(s.y) + v.z * bf_lo(g.y), bf_hi(s.y) + v.w * bf_hi(g.y));
                *(u32x2*)(mp + 16 * ni) = o; } }
    }
}

__device__ __forceinline__ void phase_E(const Ctx& c0, int l) {
    Ctx c = reopaque(c0);
    const bf16* merged = WSP(bf16, WS_MERGED); const bf16* Wout = (const bf16*)(c.ws + WS_WIN + l * SZ_WLAYER + OFF_WOUT);
    float* h = WSP(float, WS_H); bf16* hb = WSP(bf16, WS_HB); float* ssq = WSP(float, WS_SSQ);
    const int r = c.lane & 15, q = c.lane >> 4;
    for (int it = c.vb; it < n_mtiles(l) * 8; it += c.G) {
        const int mt = it / 8, nt = it % 8, tk0 = tile_tok0(mt, l);
        f32x4 acc[2][8];
#pragma unroll
        for (int mi = 0; mi < 2; ++mi) { const float* hp = h + (size_t)(tk0 + 32 * c.wave + 16 * mi + r) * D + nt * 128 + 4 * q;
#pragma unroll
            for (int ni = 0; ni < 8; ++ni) acc[mi][ni] = *(const f32x4*)(hp + 16 * ni); }
        gemm_core(acc, merged + (size_t)tk0 * D, D, Wout + (size_t)nt * 128 * D, D, D, c.lds, c.tid);
#pragma unroll
        for (int mi = 0; mi < 2; ++mi) { const int tok = tk0 + 32 * c.wave + 16 * mi + r; float ss = 0.f;
#pragma unroll
            for (int ni = 0; ni < 8; ++ni) { float* hp = h + (size_t)tok * D + nt * 128 + 16 * ni + 4 * q; const f32x4 v = acc[mi][ni]; *(f32x4*)hp = v;
                ss += (v.x * v.x + v.y * v.y) + (v.z * v.z + v.w * v.w);
                u32x2 o; o.x = pk2(v.x, v.y); o.y = pk2(v.z, v.w); *(u32x2*)(hb + (size_t)tok * D + nt * 128 + 16 * ni + 4 * q) = o; }
            ss = quad_sum(ss);
            if (q == 0) ssq[(size_t)tok * 8 + nt] = ss; }
    }
}

__device__ __forceinline__ unsigned f2key(float f) { const unsigned u = __float_as_uint(f); return u ^ ((u >> 31) ? 0xFFFFFFFFu : 0x80000000u); }
__device__ __forceinline__ float key2f(unsigned k) { const unsigned u = (k >> 31) ? (k ^ 0x80000000u) : ~k; return __uint_as_float(u); }
__device__ __forceinline__ void top16_insert(unsigned (&lst)[16], unsigned x) {
#pragma unroll
    for (int i = 0; i < 16; ++i) { const unsigned a = lst[i]; lst[i] = a > x ? a : x; x = a > x ? x : a; }
}
__device__ __forceinline__ void ce_desc(unsigned& a, unsigned& b) { const unsigned mx = a > b ? a : b, mn = a > b ? b : a; a = mx; b = mn; }
__device__ __forceinline__ void sort16_desc(unsigned (&v)[16]) {
#pragma unroll
    for (int k = 2; k <= 16; k <<= 1)
#pragma unroll
        for (int j = k >> 1; j > 0; j >>= 1)
#pragma unroll
            for (int i = 0; i < 16; ++i) { const int p = i ^ j; if (p > i) { if ((i & k) == 0) ce_desc(v[i], v[p]); else ce_desc(v[p], v[i]); } }
}
__device__ __forceinline__ void merge_top16(unsigned (&a)[16], const unsigned (&b)[16]) {
#pragma unroll
    for (int i = 0; i < 16; ++i) a[i] = a[i] > b[15 - i] ? a[i] : b[15 - i];
#pragma unroll
    for (int j = 8; j > 0; j >>= 1)
#pragma unroll
        for (int i = 0; i < 16; ++i) { const int p = i ^ j; if (p > i) ce_desc(a[i], a[p]); }
}
__device__ __forceinline__ void phase_F(const Ctx& c0, int l) {
    Ctx c = reopaque(c0);
    const bf16* hb = WSP(bf16, WS_HB); const bf16* Wpq = (const bf16*)(c.ws + WS_WIN + l * SZ_WLAYER + OFF_WPQ); const bf16* keys = (const bf16*)(c.ws + WS_WIN + l * SZ_WLAYER + OFF_KEYS);
    const float* ssq = WSP(float, WS_SSQ); float* sv = WSP(float, WS_SV); unsigned char* si = WSP(unsigned char, WS_SI);
    const int tid = c.tid, wave = c.wave, lane = c.lane, r = lane & 15, q = lane >> 4;
    unsigned char* lds = c.lds;
    const int xcd = c.vb / (c.G / 8), lb = c.vb % (c.G / 8), xm = xcd & 1, xn = xcd >> 1, nmt = n_mtiles(l);
    const int m_lo = xm ? (nmt + 1) / 2 : 0, m_cnt = xm ? nmt / 2 : (nmt + 1) / 2;
    for (int j = lb; j < m_cnt * 4; j += c.G / 8) {
        const int mt = m_lo + j / 4, hp = xn * 4 + j % 4, tk0 = tile_tok0(mt, l);
        f32x4 acc[2][8]; acc_zero(acc);
        gemm_core(acc, hb + (size_t)tk0 * D, D, Wpq + (size_t)hp * 128 * D, D, D, lds, tid);
#pragma unroll
        for (int mi = 0; mi < 2; ++mi) { const int row = 32 * wave + 16 * mi + r; const float rs = rstd_from_ssq8(ssq, tk0 + row);
#pragma unroll
            for (int ni = 0; ni < 8; ++ni) { const f32x4 v = acc[mi][ni] * rs; u32x2 o; o.x = pk2(v.x, v.y); o.y = pk2(v.z, v.w);
                *(u32x2*)(lds + (ni >> 2) * 32768 + lds_off(row, 2 * (ni & 3) + (q >> 1)) + 8 * (q & 1)) = o; } }
        { const int chunk = tid & 7, row0 = tid >> 3; const bf16* pb = keys + ((size_t)hp * 128 + row0) * 128 + chunk * 8;
#pragma unroll
          for (int s = 0; s < 2; ++s)
#pragma unroll
              for (int i = 0; i < 4; ++i) *(u32x4*)(lds + s * 32768 + 16384 + lds_off(row0 + 32 * i, chunk)) = *(const u32x4*)(pb + (size_t)(32 * i) * 128 + s * 64); }
        __syncthreads();
        acc_zero(acc);
        gemm_compute_stage(acc, lds, lds + 16384, wave, lane);
        gemm_compute_stage(acc, lds + 32768, lds + 32768 + 16384, wave, lane);
        __syncthreads();
        float* S = (float*)lds;
#pragma unroll
        for (int mi = 0; mi < 2; ++mi) { const int row = 32 * wave + 16 * mi + r;
#pragma unroll
            for (int ni = 0; ni < 8; ++ni) *(f32x4*)(S + row * 132 + 16 * ni + 4 * q) = acc[mi][ni]; }
        __syncthreads();
        {
            const int tl = 32 * wave + (lane & 31), half = lane >> 5;
            const float* row = S + tl * 132;
            unsigned lst[16];
#pragma unroll
            for (int g = 0; g < 4; ++g) {
                unsigned cur[16];
#pragma unroll
                for (int j = 0; j < 4; ++j) { const int col = 64 * half + 16 * g + 4 * j; const f32x4 v = *(const f32x4*)(row + col);
                    cur[4 * j] = (f2key(v.x) & ~127u) | (unsigned)(127 - col); cur[4 * j + 1] = (f2key(v.y) & ~127u) | (unsigned)(127 - (col + 1));
                    cur[4 * j + 2] = (f2key(v.z) & ~127u) | (unsigned)(127 - (col + 2)); cur[4 * j + 3] = (f2key(v.w) & ~127u) | (unsigned)(127 - (col + 3)); }
                sort16_desc(cur);
                if (g == 0) {
#pragma unroll
                    for (int i = 0; i < 16; ++i) lst[i] = cur[i];
                } else merge_top16(lst, cur);
            }
            unsigned oth[16];
#pragma unroll
            for (int i = 0; i < 16; ++i) { auto rr = __builtin_amdgcn_permlane32_swap(lst[i], lst[i], false, false); oth[i] = half == 0 ? rr[1] : rr[0]; }
            merge_top16(lst, oth);
            if (half == 0) {
                const int tok = tk0 + tl;
                unsigned idx[16]; float val[16];
#pragma unroll
                for (int i = 0; i < 16; ++i) { idx[i] = 127u - (lst[i] & 127u); val[i] = row[idx[i]]; }
                float* svp = sv + ((size_t)tok * 16 + hp) * 16;
#pragma unroll
                for (int i = 0; i < 4; ++i) *(f32x4*)(svp + 4 * i) = (f32x4){val[4 * i], val[4 * i + 1], val[4 * i + 2], val[4 * i + 3]};
                u32x4 pi;
                pi.x = idx[0] | (idx[1] << 8) | (idx[2] << 16) | (idx[3] << 24); pi.y = idx[4] | (idx[5] << 8) | (idx[6] << 16) | (idx[7] << 24);
                pi.z = idx[8] | (idx[9] << 8) | (idx[10] << 16) | (idx[11] << 24); pi.w = idx[12] | (idx[13] << 8) | (idx[14] << 16) | (idx[15] << 24);
                *(u32x4*)(si + ((size_t)tok * 16 + hp) * 16) = pi;
            }
        }
        __syncthreads();
    }
}

__device__ __forceinline__ void phase_F3(const Ctx& c0, int l) {
    Ctx c = reopaque(c0);
    const float* sv = WSP(float, WS_SV); const unsigned char* si = WSP(unsigned char, WS_SI); int* eidx = WSP(int, WS_EIDX); float* gw = WSP(float, WS_GW); unsigned char* stb = WSP(unsigned char, WS_STB);
    float* lsv = (float*)c.lds;
    unsigned char* lsi = c.lds + 256 * 33 * 4;
    const int tid = c.tid;
    const int ntok = l == 1 ? NB * SEQ : T;
    for (int base = c.vb * NTHREADS; base < ntok * 8; base += c.G * NTHREADS) {
        const int thc = base + tid, tkc = thc >> 3;
        const int th = (l == 1 ? tkc + NMETA * ((tkc >> 11) + 1) : tkc) * 8 + (thc & 7);
        float a[16], b[16];
#pragma unroll
        for (int i = 0; i < 4; ++i) { const f32x4 x = *(const f32x4*)(sv + (size_t)th * 32 + 4 * i), y = *(const f32x4*)(sv + (size_t)th * 32 + 16 + 4 * i);
            a[4 * i] = x.x; a[4 * i + 1] = x.y; a[4 * i + 2] = x.z; a[4 * i + 3] = x.w; b[4 * i] = y.x; b[4 * i + 1] = y.y; b[4 * i + 2] = y.z; b[4 * i + 3] = y.w; }
        const u32x4 ia = *(const u32x4*)(si + (size_t)th * 32), ib = *(const u32x4*)(si + (size_t)th * 32 + 16);
#pragma unroll
        for (int i = 0; i < 16; ++i) { lsv[tid * 33 + i] = a[i]; lsv[tid * 33 + 16 + i] = b[i]; }
        *(u32x4*)(lsi + tid * 32) = ia; *(u32x4*)(lsi + tid * 32 + 16) = ib;
        unsigned lst[16], g2[16], g3[16], g4[16];
#pragma unroll
        for (int j = 0; j < 16; ++j) lst[j] = (f2key(a[0] + b[j]) & ~255u) | (unsigned)(255 - j);
#pragma unroll
        for (int i = 1; i < 16; ++i) g2[i - 1] = (f2key(a[i] + b[0]) & ~255u) | (unsigned)(255 - i * 16);
        g2[15] = 0u;
        { int n = 0;
#pragma unroll
          for (int i = 1; i < 16; ++i)
#pragma unroll
              for (int j = 1; j < 16; ++j)
                  if ((i + 1) * (j + 1) <= 16) { const unsigned key = (f2key(a[i] + b[j]) & ~255u) | (unsigned)(255 - (i * 16 + j)); if (n < 16) g3[n] = key; else g4[n - 16] = key; ++n; }
#pragma unroll
          for (int k = 3; k < 16; ++k) g4[k] = 0u; }
        sort16_desc(g3); sort16_desc(g4);
        merge_top16(lst, g2); merge_top16(g3, g4); merge_top16(lst, g3);
        __builtin_amdgcn_s_waitcnt(0xC07F); asm volatile("" ::: "memory");
        float s[16]; int e[16];
#pragma unroll
        for (int k = 0; k < 16; ++k) { const unsigned code = 255u - (lst[k] & 255u); const int i = code >> 4, j = code & 15;
            s[k] = lsv[tid * 33 + i] + lsv[tid * 33 + 16 + j]; e[k] = (int)lsi[tid * 32 + i] * 128 + (int)lsi[tid * 32 + 16 + j]; }
        float mx = s[0];
#pragma unroll
        for (int k = 1; k < 16; ++k) mx = fmaxf(mx, s[k]);
        float sum = 0.f;
#pragma unroll
        for (int k = 0; k < 16; ++k) { s[k] = fast_exp2((s[k] - mx) * 1.4426950409f); sum += s[k]; }
        const float inv = 1.0f / sum;
        typedef unsigned long long u64;
        u64 hlo = 0ull, hhi = 0ull;
#pragma unroll
        for (int k = 0; k < 16; ++k) { const int sl = e[k] >> 10; if (sl < 8) hlo += 1ull << (8 * sl); else hhi += 1ull << (8 * (sl - 8)); }
        u64 ilo = hlo, ihi = hhi;
#pragma unroll
        for (int d = 1; d < 8; d <<= 1) { const u64 a_ = __shfl_up(ilo, d, 8), b_ = __shfl_up(ihi, d, 8); if ((tid & 7) >= d) { ilo += a_; ihi += b_; } }
        const u64 tlo = __shfl(ilo, 7, 8), thi = __shfl(ihi, 7, 8);
        const u64 ones = 0x0101010101010101ull;
        const u64 inlo = tlo * ones, inhi = thi * ones + (inlo >> 56) * ones;
        const u64 stlo = inlo - tlo, sthi = inhi - thi;
        u64 rlo = stlo + (ilo - hlo), rhi = sthi + (ihi - hhi);
        const int tokn = th >> 3;
#pragma unroll
        for (int k = 0; k < 16; ++k) { const int sl = e[k] >> 10; int pos;
            if (sl < 8) { pos = (int)((rlo >> (8 * sl)) & 255ull); rlo += 1ull << (8 * sl); } else { pos = (int)((rhi >> (8 * (sl - 8))) & 255ull); rhi += 1ull << (8 * (sl - 8)); }
            eidx[(size_t)tokn * 128 + pos] = e[k]; gw[(size_t)tokn * 128 + pos] = s[k] * inv; }
        if ((tid & 7) == 0) { u64* sp = (u64*)(stb + (size_t)tokn * 16); sp[0] = stlo; sp[1] = sthi; }
        __builtin_amdgcn_s_waitcnt(0xC07F); asm volatile("" ::: "memory");
    }
}

typedef float f32x2 __attribute__((ext_vector_type(2)));
constexpr int G2_WSTRIDE = 14336, G2_MAXTOK = 9;
__device__ __forceinline__ float fp8dot4(unsigned w, unsigned x01, unsigned x23, float acc) {
    const bf16x2 lo = __builtin_amdgcn_cvt_scalef32_pk_bf16_fp8(w, 1.0f, false), hi = __builtin_amdgcn_cvt_scalef32_pk_bf16_fp8(w, 1.0f, true);
    acc = __builtin_amdgcn_fdot2_f32_bf16(lo, __builtin_bit_cast(bf16x2, x01), acc, false);
    return __builtin_amdgcn_fdot2_f32_bf16(hi, __builtin_bit_cast(bf16x2, x23), acc, false);
}
__device__ __forceinline__ float reduce8_transposed(const float (&p)[8], int lane) {
    float s[4];
#pragma unroll
    for (int k = 0; k < 4; ++k) { auto r = __builtin_amdgcn_permlane32_swap(__float_as_uint(p[k]), __float_as_uint(p[k + 4]), false, false); s[k] = __uint_as_float(r[0]) + __uint_as_float(r[1]); }
    float t[2];
#pragma unroll
    for (int k = 0; k < 2; ++k) { auto r = __builtin_amdgcn_permlane16_swap(__float_as_uint(s[k]), __float_as_uint(s[k + 2]), false, false); t[k] = __uint_as_float(r[0]) + __uint_as_float(r[1]); }
    const float u0 = t[0] + dpp<0x128>(t[0]), u1 = t[1] + dpp<0x128>(t[1]);
    float r = (lane & 8) ? u1 : u0;
    r += dpp<0xB1>(r); r += dpp<0x4E>(r); r += dpp<0x141>(r);
    return r;
}
typedef int i32x4 __attribute__((ext_vector_type(4)));
__device__ __forceinline__ void fp8fma4(f32x2 (&acc)[8], int o, unsigned w, f32x2 a2) {
    const f32x2 lo = __builtin_amdgcn_cvt_scalef32_pk_f32_fp8(w, 1.0f, false), hi = __builtin_amdgcn_cvt_scalef32_pk_f32_fp8(w, 1.0f, true);
    acc[o] = __builtin_elementwise_fma(a2, lo, acc[o]); acc[o + 1] = __builtin_elementwise_fma(a2, hi, acc[o + 1]);
}
__device__ __forceinline__ void g2_u_chunk(u32x4 (&u)[8], const unsigned char* U, const int* pe_next, const float* pw_c, float* act_c, const u32x4 xq, float rs, int lane) {
    const i32x4 e0 = *(const i32x4*)pe_next, e1 = *(const i32x4*)(pe_next + 4);
    const int en[8] = {e0.x, e0.y, e0.z, e0.w, e1.x, e1.y, e1.z, e1.w};
    float p[8];
#pragma unroll
    for (int k = 0; k < 8; ++k) {
        int d = __builtin_amdgcn_sdot4((int)u[k].x, (int)xq.x, 0, false); d = __builtin_amdgcn_sdot4((int)u[k].y, (int)xq.y, d, false);
        d = __builtin_amdgcn_sdot4((int)u[k].z, (int)xq.z, d, false); d = __builtin_amdgcn_sdot4((int)u[k].w, (int)xq.w, d, false);
        p[k] = (float)d;
        asm volatile("" : "+v"(p[k]));
        u[k] = *(const u32x4*)(U + (size_t)__builtin_amdgcn_readfirstlane(en[k]) * 1024 + lane * 16);
    }
    const float a = reduce8_transposed(p, lane);
    const int row = (lane >> 3) & 7;
    if ((lane & 7) == 0) act_c[row] = gelu_tanh(a * rs) * pw_c[row];
}
__device__ __forceinline__ void g2_v_chunk(u32x4 (&v)[8], const unsigned char* V, const int* pe_next, const float* act_c, f32x2 (&acc)[8], int lane) {
    const i32x4 e0 = *(const i32x4*)pe_next, e1 = *(const i32x4*)(pe_next + 4);
    const int en[8] = {e0.x, e0.y, e0.z, e0.w, e1.x, e1.y, e1.z, e1.w};
    const f32x4 a0 = *(const f32x4*)act_c, a1 = *(const f32x4*)(act_c + 4);
    const float av[8] = {a0.x, a0.y, a0.z, a0.w, a1.x, a1.y, a1.z, a1.w};
#pragma unroll
    for (int k = 0; k < 8; ++k) { const f32x2 a2 = (f32x2){av[k], av[k]};
        fp8fma4(acc, 0, v[k].x, a2); fp8fma4(acc, 2, v[k].y, a2); fp8fma4(acc, 4, v[k].z, a2); fp8fma4(acc, 6, v[k].w, a2);
        asm volatile("" : "+v"(acc[0]), "+v"(acc[1]), "+v"(acc[2]), "+v"(acc[3]), "+v"(acc[4]), "+v"(acc[5]), "+v"(acc[6]), "+v"(acc[7]));
        v[k] = *(const u32x4*)(V + (size_t)__builtin_amdgcn_readfirstlane(en[k]) * 1024 + lane * 16);
    }
}
__device__ __forceinline__ void g2_finish_token(Ctx& c, int l, int tok, const f32x2 (&acc)[8], int lane) {
    float* h = WSP(float, WS_H); bf16* hbw = WSP(bf16, WS_HB); float* ssqw = WSP(float, WS_SSQ);
    float* hp = h + (size_t)tok * D + lane * 16;
    f32x4 r0 = *(const f32x4*)hp, r1 = *(const f32x4*)(hp + 4), r2 = *(const f32x4*)(hp + 8), r3 = *(const f32x4*)(hp + 12);
    r0 += (f32x4){acc[0].x, acc[0].y, acc[1].x, acc[1].y}; r1 += (f32x4){acc[2].x, acc[2].y, acc[3].x, acc[3].y};
    r2 += (f32x4){acc[4].x, acc[4].y, acc[5].x, acc[5].y}; r3 += (f32x4){acc[6].x, acc[6].y, acc[7].x, acc[7].y};
    if (l == 0) {
        *(f32x4*)hp = r0; *(f32x4*)(hp + 4) = r1; *(f32x4*)(hp + 8) = r2; *(f32x4*)(hp + 12) = r3;
        u32x4 o0, o1; o0.x = pk2(r0.x, r0.y); o0.y = pk2(r0.z, r0.w); o0.z = pk2(r1.x, r1.y); o0.w = pk2(r1.z, r1.w);
        o1.x = pk2(r2.x, r2.y); o1.y = pk2(r2.z, r2.w); o1.z = pk2(r3.x, r3.y); o1.w = pk2(r3.z, r3.w);
        *(u32x4*)(hbw + (size_t)tok * D + lane * 16) = o0; *(u32x4*)(hbw + (size_t)tok * D + lane * 16 + 8) = o1;
        float ss = (r0.x * r0.x + r0.y * r0.y) + (r0.z * r0.z + r0.w * r0.w) + (r1.x * r1.x + r1.y * r1.y) + (r1.z * r1.z + r1.w * r1.w)
                 + (r2.x * r2.x + r2.y * r2.y) + (r2.z * r2.z + r2.w * r2.w) + (r3.x * r3.x + r3.y * r3.y) + (r3.z * r3.z + r3.w * r3.w);
        ss = wave_sum_dpp(ss);
        if (lane < 8) ssqw[(size_t)tok * 8 + lane] = lane == 0 ? ss : 0.f;
    } else {
        const int b = tok / L, pos = tok - b * L;
        if (pos >= NMETA) { float* op = c.out + ((size_t)b * SEQ + (pos - NMETA)) * D + lane * 16;
            *(f32x4*)op = r0; *(f32x4*)(op + 4) = r1; *(f32x4*)(op + 8) = r2; *(f32x4*)(op + 12) = r3; }
    }
}
__device__ __forceinline__ void phase_G2(const Ctx& c0, int l) {
    Ctx c = reopaque(c0);
    const bf16* hb = WSP(bf16, WS_HB); const float* ssq = WSP(float, WS_SSQ); const int* pe = WSP(int, WS_EIDX); const float* pw = WSP(float, WS_GW);
    const unsigned char* U = c.ws + WS_TAB + (size_t)(l * 2) * SZ_TAB; const unsigned char* V = c.ws + WS_TAB + (size_t)(l * 2 + 1) * SZ_TAB;
    const int lane = c.lane, wave = c.wave;
    const int gw = c.vb * 4 + wave, t0 = l == 1 ? gw * 8 + NMETA * ((gw >> 8) + 1) : gw * 8;
    const bool has_x = l == 0 && (c.vb & 3) == 0; const int tx = T - 128 + (c.vb >> 2);
    unsigned char* wl = c.lds + wave * G2_WSTRIDE;
    int* pe_l = (int*)wl; float* pw_l = (float*)(wl + 4608); float* act_l = (float*)(wl + 9216);
#pragma unroll
    for (int j = 0; j < G2_MAXTOK; ++j) { const int tok = j < 8 ? t0 + j : (has_x ? tx : t0);
        pe_l[j * 128 + lane] = pe[(size_t)tok * 128 + lane]; pe_l[j * 128 + 64 + lane] = pe[(size_t)tok * 128 + 64 + lane];
        pw_l[j * 128 + lane] = pw[(size_t)tok * 128 + lane] * TAB_INV; pw_l[j * 128 + 64 + lane] = pw[(size_t)tok * 128 + 64 + lane] * TAB_INV; }
    const int xlo = has_x ? 4 * wave : 16, xhi = has_x ? 4 * wave + 4 : 16;
    {
        u32x4 xq[G2_MAXTOK]; float rs[G2_MAXTOK];
#pragma unroll
        for (int j = 0; j < G2_MAXTOK; ++j) { const int tok = j < 8 ? t0 + j : (has_x ? tx : t0);
            const u32x4 lo = *(const u32x4*)(hb + (size_t)tok * D + lane * 16), hi = *(const u32x4*)(hb + (size_t)tok * D + lane * 16 + 8);
            const f32x4 f0 = (f32x4){bf_lo(lo.x), bf_hi(lo.x), bf_lo(lo.y), bf_hi(lo.y)}, f1 = (f32x4){bf_lo(lo.z), bf_hi(lo.z), bf_lo(lo.w), bf_hi(lo.w)};
            const f32x4 f2 = (f32x4){bf_lo(hi.x), bf_hi(hi.x), bf_lo(hi.y), bf_hi(hi.y)}, f3 = (f32x4){bf_lo(hi.z), bf_hi(hi.z), bf_lo(hi.w), bf_hi(hi.w)};
            float mx = 1e-20f;
#pragma unroll
            for (int i = 0; i < 4; ++i) mx = fmaxf(mx, fmaxf(fmaxf(fabsf(f0[i]), fabsf(f1[i])), fmaxf(fabsf(f2[i]), fabsf(f3[i]))));
            mx = fmaxf(mx, dpp<0xB1>(mx)); mx = fmaxf(mx, dpp<0x4E>(mx)); mx = fmaxf(mx, dpp<0x141>(mx)); mx = fmaxf(mx, dpp<0x128>(mx)); mx = xrow16_max(mx);
            const float sx = 127.0f / mx;
            xq[j].x = pack_i8x4(f0 * sx); xq[j].y = pack_i8x4(f1 * sx); xq[j].z = pack_i8x4(f2 * sx); xq[j].w = pack_i8x4(f3 * sx);
            rs[j] = rstd_from_ssq8(ssq, tok) * mx * (1.0f / (127.0f * U_SCALE)); }
        u32x4 u[8];
#pragma unroll
        for (int k = 0; k < 8; ++k) u[k] = *(const u32x4*)(U + (size_t)__builtin_amdgcn_readfirstlane(pe_l[k]) * 1024 + lane * 16);
#pragma unroll 1
        for (int ch = 0; ch < 16; ++ch) {
            const int cn = ch < 15 ? ch + 1 : 0;
            const bool x_here = ch >= xlo && ch < xhi;
#pragma unroll
            for (int j = 0; j < 8; ++j) {
                const int* pe_next = j < 7 ? pe_l + (j + 1) * 128 + ch * 8 : (x_here ? pe_l + 8 * 128 + ch * 8 : pe_l + cn * 8);
                g2_u_chunk(u, U, pe_next, pw_l + j * 128 + ch * 8, act_l + j * 128 + ch * 8, xq[j], rs[j], lane); }
            if (x_here) g2_u_chunk(u, U, pe_l + cn * 8, pw_l + 8 * 128 + ch * 8, act_l + 8 * 128 + ch * 8, xq[8], rs[8], lane);
        }
    }
    f32x2 acc[G2_MAXTOK][8];
#pragma unroll
    for (int j = 0; j < G2_MAXTOK; ++j)
#pragma unroll
        for (int i = 0; i < 8; ++i) acc[j][i] = (f32x2){0.f, 0.f};
    {
        u32x4 v[8];
#pragma unroll
        for (int k = 0; k < 8; ++k) v[k] = *(const u32x4*)(V + (size_t)__builtin_amdgcn_readfirstlane(pe_l[k]) * 1024 + lane * 16);
#pragma unroll 1
        for (int ch = 0; ch < 16; ++ch) {
            const int cn = ch < 15 ? ch + 1 : 0;
            const bool x_here = ch >= xlo && ch < xhi;
#pragma unroll
            for (int j = 0; j < 8; ++j) {
                const int* pe_next = j < 7 ? pe_l + (j + 1) * 128 + ch * 8 : (x_here ? pe_l + 8 * 128 + ch * 8 : pe_l + cn * 8);
                g2_v_chunk(v, V, pe_next, act_l + j * 128 + ch * 8, acc[j], lane); }
            if (x_here) g2_v_chunk(v, V, pe_l + cn * 8, act_l + 8 * 128 + ch * 8, acc[8], lane);
        }
    }
#pragma unroll
    for (int j = 0; j < 8; ++j) g2_finish_token(c, l, t0 + j, acc[j], lane);
    __syncthreads();
    if (has_x) {
        f32x2* part = (f32x2*)(c.lds + wave * G2_WSTRIDE);
#pragma unroll
        for (int i = 0; i < 8; ++i) part[i * 64 + lane] = acc[8][i];
    }
    __syncthreads();
    if (has_x && wave == 0) {
        f32x2 tot[8];
#pragma unroll
        for (int i = 0; i < 8; ++i) { tot[i] = acc[8][i];
#pragma unroll
            for (int w = 1; w < 4; ++w) tot[i] += ((const f32x2*)(c.lds + w * G2_WSTRIDE))[i * 64 + lane]; }
        g2_finish_token(c, l, tx, tot, lane);
    }
    __syncthreads();
}

struct Args { const float* in[22]; float* out; unsigned char* ws; int ph_lo, ph_hi; };
constexpr int N_PHASES = 17;

__global__ void __launch_bounds__(NTHREADS, 2) fwd_kernel(Args args) {
    extern __shared__ __attribute__((aligned(16))) unsigned char lds_raw[];
    Ctx c;
#pragma unroll
    for (int i = 0; i < 22; ++i) c.in[i] = args.in[i];
    c.out = args.out; c.ws = args.ws; c.lds = lds_raw;
    c.tid = threadIdx.x; c.lane = c.tid & 63; c.wave = __builtin_amdgcn_readfirstlane(c.tid >> 6);
    c.G = gridDim.x; { const int bx = blockIdx.x; c.vb = (c.G % 8 == 0) ? (bx % 8) * (c.G / 8) + bx / 8 : bx; }
    volatile unsigned* misc = (volatile unsigned*)(c.lds + LDS_MISC);
    if (c.tid < 16) misc[c.tid] = 0u;
    __syncthreads();
    const int lo = args.ph_lo, hi = args.ph_hi;
    const bool multi = (hi - lo) > 1;
    XcdBarrier bar; bar.bar = WSP(unsigned, WS_CTL) + CW_BAR; bar.x = 0; bar.st = misc;
    if (multi) bar = xcd_barrier_post(WSP(unsigned, WS_CTL) + CW_BAR, misc);
#define IN_(k) (lo <= (k) && (k) < hi)
#define SEAM_(k) do { if ((k) + 1 < hi) xcd_barrier(bar); } while (0)
    if (IN_(0)) { phase_prologue(c); SEAM_(0); }
#pragma unroll 1
    for (int l = 0; l < 2; ++l) {
        const int p0 = 1 + 8 * l;
        if (IN_(p0 + 0)) { phase_A(c, l); SEAM_(p0 + 0); }
        if (IN_(p0 + 1)) { phase_B(c, l); SEAM_(p0 + 1); }
        if (IN_(p0 + 2)) { phase_C(c, l); SEAM_(p0 + 2); }
        if (IN_(p0 + 3)) { phase_D(c, l); SEAM_(p0 + 3); }
        if (IN_(p0 + 4)) { phase_E(c, l); SEAM_(p0 + 4); }
        if (IN_(p0 + 5)) { phase_F(c, l); SEAM_(p0 + 5); }
        if (IN_(p0 + 6)) { phase_F3(c, l); SEAM_(p0 + 6); }
        if (IN_(p0 + 7)) { phase_G2(c, l); SEAM_(p0 + 7); }
    }
}

extern "C" void kernel_launch(void* const* d_in, const int* in_sizes, int n_in, void* d_out, int out_size, void* d_ws, size_t ws_size, hipStream_t stream) {
    static int grid = 0;
    if (grid == 0) {
        if (n_in != 22 || out_size != NB * SEQ * D || ws_size < WS_END) { fprintf(stderr, "kernel_launch: unexpected shapes (n_in %d out %d ws %zu need %zu)\n", n_in, out_size, ws_size, (size_t)WS_END); grid = -1; return; }
        int dev = 0, cus = 0, per_cu = 0;
        hipGetDevice(&dev); hipDeviceGetAttribute(&cus, hipDeviceAttributeMultiprocessorCount, dev);
        if (hipFuncSetAttribute((const void*)fwd_kernel, hipFuncAttributeMaxDynamicSharedMemorySize, LDS_BYTES) != hipSuccess) { fprintf(stderr, "kernel_launch: hipFuncSetAttribute failed\n"); grid = -1; return; }
        if (hipOccupancyMaxActiveBlocksPerMultiprocessor(&per_cu, (const void*)fwd_kernel, NTHREADS, LDS_BYTES) != hipSuccess || per_cu < 1) { fprintf(stderr, "kernel_launch: occupancy query failed (%d)\n", per_cu); per_cu = 1; (void)hipGetLastError(); }
        if (per_cu > 2) per_cu = 2;
        grid = cus * per_cu;
        if (grid != 512) { fprintf(stderr, "kernel_launch: grid %d unsupported by phase G2 (needs 512 workgroups)\n", grid); grid = -1; return; }
        fprintf(stderr, "kernel_launch: grid %d (%d per CU), lds %d, ws need %zu have %zu\n", grid, per_cu, LDS_BYTES, (size_t)WS_END, ws_size);
    }
    if (grid < 0) return;
    hipMemsetAsync((char*)d_ws + WS_CTL, 0, CTL_BYTES, stream);
    Args a{};
    for (int i = 0; i < 22; ++i) a.in[i] = (const float*)d_in[i];
    a.out = (float*)d_out; a.ws = (unsigned char*)d_ws;
#if MK_PER_PHASE
    for (int ph = 0; ph < N_PHASES; ++ph) { a.ph_lo = ph; a.ph_hi = ph + 1; hipLaunchKernelGGL(fwd_kernel, dim3(grid), dim3(NTHREADS), LDS_BYTES, stream, a); }
#else
    a.ph_lo = 0; a.ph_hi = N_PHASES;
    void* kargs[] = {&a};
    hipError_t e = hipLaunchCooperativeKernel((const void*)fwd_kernel, dim3(grid), dim3(NTHREADS), kargs, LDS_BYTES, stream);
    if (e != hipSuccess) fprintf(stderr, "kernel_launch: cooperative launch failed: %s (grid %d)\n", hipGetErrorString(e), grid);
#endif
}
```

```cpp
#include <hip/hip_runtime.h>
#include <cstdio>
#include <cstdint>

#ifndef MK_PER_PHASE
#define MK_PER_PHASE 0
#endif

typedef unsigned short bf16;
typedef short bf16x8 __attribute__((ext_vector_type(8)));
typedef float f32x4 __attribute__((ext_vector_type(4)));
typedef unsigned u32x4 __attribute__((ext_vector_type(4)));
typedef unsigned u32x2 __attribute__((ext_vector_type(2)));
typedef __bf16 bf16x2 __attribute__((ext_vector_type(2)));

constexpr int NB = 8, SEQ = 2048, NMETA = 16, L = SEQ + NMETA, T = NB * L, D = 1024;
constexpr int DC = 512, CW = 31, NH = 8, QL = 256, KVL = 128, NOPE = 64, ROPE = 32, QK = 96, VD = 64;
constexpr int NIN = 3488, NINP = 3584;
constexpr int NEXP = 16384;
constexpr float EPS = 1e-6f;
constexpr int MT = T / 128;
static_assert(T % 128 == 0, "T tiles");

constexpr size_t al256(size_t x) { return (x + 255) & ~(size_t)255; }
constexpr size_t WS_CTL = 0;
constexpr size_t CTL_BYTES = 65536;
constexpr size_t WS_ROPE = WS_CTL + CTL_BYTES;
constexpr size_t WS_WIN = al256(WS_ROPE + (size_t)L * 16 * 8);
constexpr size_t SZ_WIN = (size_t)NINP * 1024 * 2, SZ_WCO = (size_t)1024 * 512 * 2, SZ_WUQ = (size_t)1024 * 256 * 2, SZ_WUKV = (size_t)1024 * 128 * 2,
                 SZ_WMLA = (size_t)1024 * 512 * 2, SZ_WOUT = (size_t)1024 * 1024 * 2, SZ_WPQ = (size_t)2048 * 1024 * 2, SZ_KEYS = (size_t)16 * 128 * 128 * 2;
constexpr size_t OFF_WCO = SZ_WIN, OFF_WUQ = OFF_WCO + SZ_WCO, OFF_WUKV = OFF_WUQ + SZ_WUQ, OFF_WMLA = OFF_WUKV + SZ_WUKV, OFF_WOUT = OFF_WMLA + SZ_WMLA,
                 OFF_WPQ = OFF_WOUT + SZ_WOUT, OFF_KEYS = OFF_WPQ + SZ_WPQ, SZ_WLAYER = OFF_KEYS + SZ_KEYS;
constexpr size_t WS_TAB = al256(WS_WIN + 2 * SZ_WLAYER);
constexpr size_t SZ_TAB = (size_t)NEXP * 1024;
constexpr float TAB_SCALE = 256.0f, TAB_INV = 1.0f / 256.0f;
constexpr float U_CLIP = 0.2f, U_SCALE = 127.0f / U_CLIP;
constexpr size_t WS_H = al256(WS_TAB + 4 * SZ_TAB);
constexpr size_t WS_HB = al256(WS_H + (size_t)T * 1024 * 4);
constexpr size_t WS_SSQ = al256(WS_HB + (size_t)T * 1024 * 2);
constexpr size_t WS_UGLU = al256(WS_SSQ + (size_t)T * 8 * 4);
constexpr size_t WS_CQ = al256(WS_UGLU + (size_t)T * 512 * 2);
constexpr size_t WS_CKV = al256(WS_CQ + (size_t)T * 256 * 2);
constexpr size_t WS_KROPE = al256(WS_CKV + (size_t)T * 128 * 2);
constexpr size_t WS_SSQQ = al256(WS_KROPE + (size_t)T * 32 * 4);
constexpr size_t WS_SSQKV = al256(WS_SSQQ + (size_t)T * 2 * 4);
constexpr size_t WS_U2 = al256(WS_SSQKV + (size_t)T * 4);
constexpr size_t WS_Q = al256(WS_U2 + (size_t)T * 512 * 2);
constexpr size_t WS_K = al256(WS_Q + (size_t)T * NH * QK * 2);
constexpr size_t WS_VT = al256(WS_K + (size_t)T * NH * QK * 2);
constexpr size_t WS_O = al256(WS_VT + (size_t)T * NH * VD * 2 + 4096);
constexpr size_t WS_MERGED = al256(WS_O + (size_t)T * 512 * 2);
constexpr size_t WS_GATES = al256(WS_MERGED + (size_t)T * 1024 * 2);
constexpr size_t WS_SV = WS_GATES;
constexpr size_t WS_SI = al256(WS_SV + (size_t)T * 256 * 4);
constexpr size_t WS_EIDX = al256(WS_SI + (size_t)T * 256);
constexpr size_t WS_GW = al256(WS_EIDX + (size_t)T * 128 * 4);
constexpr size_t WS_STB = al256(WS_GW + (size_t)T * 128 * 4);
constexpr size_t WS_PEER_END = WS_STB + (size_t)T * 16;
constexpr size_t WS_END = al256(WS_GATES + (size_t)T * 2048 * 2);
static_assert(WS_PEER_END <= WS_END, "peer scratch overlay");

constexpr int CW_BAR = 0;
constexpr int CW_QUEUE = 4096;

constexpr int LDS_MAIN = 128 * 132 * 4;
constexpr int LDS_MISC = LDS_MAIN;
constexpr int LDS_BYTES = LDS_MAIN + 64;

constexpr int NTHREADS = 256;

__device__ __forceinline__ unsigned pk2(float lo, float hi) { bf16x2 v; v.x = (__bf16)lo; v.y = (__bf16)hi; return __builtin_bit_cast(unsigned, v); }
__device__ __forceinline__ unsigned pack_i8x4(f32x4 v) {
    const int a = (int)__builtin_rintf(fminf(fmaxf(v.x, -127.f), 127.f)), b = (int)__builtin_rintf(fminf(fmaxf(v.y, -127.f), 127.f));
    const int c_ = (int)__builtin_rintf(fminf(fmaxf(v.z, -127.f), 127.f)), d = (int)__builtin_rintf(fminf(fmaxf(v.w, -127.f), 127.f));
    return (unsigned)(a & 255) | ((unsigned)(b & 255) << 8) | ((unsigned)(c_ & 255) << 16) | ((unsigned)(d & 255) << 24);
}
__device__ __forceinline__ float bf_lo(unsigned p) { return __uint_as_float(p << 16); }
__device__ __forceinline__ float bf_hi(unsigned p) { return __uint_as_float(p & 0xffff0000u); }
__device__ __forceinline__ float fast_rcp(float x) { return __builtin_amdgcn_rcpf(x); }
__device__ __forceinline__ float fast_exp2(float x) { return __builtin_amdgcn_exp2f(x); }
__device__ __forceinline__ float sigmoidf_(float x) { return fast_rcp(1.0f + fast_exp2(-1.4426950409f * x)); }
__device__ __forceinline__ float gelu_tanh(float x) { const float u = 1.5957691216f * (x + 0.044715f * x * x * x); return x * fast_rcp(1.0f + fast_exp2(-1.4426950409f * u)); }
__device__ __forceinline__ float rsqrt_(float x) { return __builtin_amdgcn_rsqf(x); }
template <int CTRL> __device__ __forceinline__ float dpp(float x) { return __builtin_bit_cast(float, __builtin_amdgcn_mov_dpp(__builtin_bit_cast(int, x), CTRL, 0xf, 0xf, true)); }
__device__ __forceinline__ float xrow16_sum(float x) {
    auto s = __builtin_amdgcn_permlane16_swap(__float_as_uint(x), __float_as_uint(x), false, false);
    x = __uint_as_float(s[0]) + __uint_as_float(s[1]);
    auto t = __builtin_amdgcn_permlane32_swap(__float_as_uint(x), __float_as_uint(x), false, false);
    return __uint_as_float(t[0]) + __uint_as_float(t[1]);
}
__device__ __forceinline__ float xrow16_max(float x) {
    auto s = __builtin_amdgcn_permlane16_swap(__float_as_uint(x), __float_as_uint(x), false, false);
    x = fmaxf(__uint_as_float(s[0]), __uint_as_float(s[1]));
    auto t = __builtin_amdgcn_permlane32_swap(__float_as_uint(x), __float_as_uint(x), false, false);
    return fmaxf(__uint_as_float(t[0]), __uint_as_float(t[1]));
}
__device__ __forceinline__ float wave_sum_dpp(float x) {
    x += dpp<0xB1>(x); x += dpp<0x4E>(x); x += dpp<0x141>(x); x += dpp<0x128>(x); return xrow16_sum(x);
}
__device__ __forceinline__ float quad_sum(float v) { return xrow16_sum(v); }
__device__ __forceinline__ float quad_max(float v) { return xrow16_max(v); }
__device__ __forceinline__ float wave_sum(float v) { return wave_sum_dpp(v); }
__device__ __forceinline__ float dot2(unsigned a, unsigned b, float c) { return __builtin_amdgcn_fdot2_f32_bf16(__builtin_bit_cast(bf16x2, a), __builtin_bit_cast(bf16x2, b), c, false); }

#define XB_TMO      128
#define XB_XCNT(j)  (256  + 64 * (j))
#define XB_XSUB(j)  (1280 + 64 * (j))
#define XB_XGEN(j)  (2304 + 64 * (j))
#define XB_TOP      3328
#define XB_TOPGEN   3392
#define XCD_BAR_WORDS 3456
#define XB_SPIN_CAP (1u << 20)
__device__ __forceinline__ unsigned xb_ld(unsigned* p)              { return __hip_atomic_load(p, __ATOMIC_RELAXED, __HIP_MEMORY_SCOPE_AGENT); }
__device__ __forceinline__ unsigned xb_add(unsigned* p, unsigned v) { return __hip_atomic_fetch_add(p, v, __ATOMIC_RELAXED, __HIP_MEMORY_SCOPE_AGENT); }
__device__ __forceinline__ unsigned xb_xcc_id() { return (unsigned)__builtin_amdgcn_s_getreg((3 << 11) | 20) & 0xFu; }
#define XB_SPIN(cond, bar) do { unsigned _sp = 0; while (cond) { __builtin_amdgcn_s_sleep(1); \
    if ((++_sp & 255u) == 0u) { if (xb_ld(&(bar)[XB_TMO])) break; if (_sp > XB_SPIN_CAP) { atomicAdd(&(bar)[XB_TMO], 1u); break; } } } } while (0)
struct XcdBarrier { unsigned* bar; unsigned x; volatile unsigned* st; };
__device__ __forceinline__ XcdBarrier xcd_barrier_post(unsigned* bar, volatile unsigned* st) {
    XcdBarrier b; b.bar = bar; b.x = xb_xcc_id(); b.st = st;
    if (threadIdx.x == 0) (void)xb_add(&bar[XB_XCNT(b.x)], 1u);
    return b;
}
__device__ __forceinline__ void xcd_barrier_complete(unsigned* bar, unsigned x, unsigned& nloc, unsigned& nx) {
    const unsigned G = gridDim.x * gridDim.y * gridDim.z;
    unsigned sum, cnt, mine, sp = 0u;
    for (;;) {
        sum = 0u; cnt = 0u; mine = 0u;
#pragma unroll
        for (unsigned j = 0; j < 16; ++j) { const unsigned c = xb_ld(&bar[XB_XCNT(j)]); sum += c; cnt += (c > 0u) ? 1u : 0u; mine = (j == x) ? c : mine; }
        if (sum == G) break;
        __builtin_amdgcn_s_sleep(1);
        if ((++sp & 255u) == 0u) { if (xb_ld(&bar[XB_TMO])) break; if (sp > XB_SPIN_CAP) { atomicAdd(&bar[XB_TMO], 1u); break; } }
    }
    nloc = mine > 0u ? mine : 1u; nx = cnt > 0u ? cnt : 1u;
}
__device__ __forceinline__ void xcd_barrier(const XcdBarrier& b) {
    asm volatile("s_waitcnt vmcnt(0)" ::: "memory");
    __syncthreads();
    if (threadIdx.x == 0) {
        unsigned* bar = b.bar;
        __builtin_amdgcn_s_waitcnt(0);
        unsigned nloc = b.st[0], nx = b.st[1];
        if (nloc == 0u) { xcd_barrier_complete(bar, b.x, nloc, nx); b.st[0] = nloc; b.st[1] = nx; }
        const unsigned old = xb_add(&bar[XB_XSUB(b.x)], 1u);
        const unsigned gen = old / nloc;
        if (old + 1u == (gen + 1u) * nloc) {
            __builtin_amdgcn_fence(__ATOMIC_RELEASE, "agent");
            asm volatile("s_waitcnt vmcnt(0)" ::: "memory");
            const unsigned og = xb_add(&bar[XB_TOP], 1u);
            const unsigned tg = og / nx;
            if (og + 1u == (tg + 1u) * nx) xb_add(&bar[XB_TOPGEN], 1u);
            else XB_SPIN(xb_ld(&bar[XB_TOPGEN]) == tg, bar);
            __builtin_amdgcn_fence(__ATOMIC_ACQUIRE, "agent");
            xb_add(&bar[XB_XGEN(b.x)], 1u);
            asm volatile("s_waitcnt vmcnt(0)" ::: "memory");
        } else {
            XB_SPIN(xb_ld(&bar[XB_XGEN(b.x)]) == gen, bar);
            __builtin_amdgcn_fence(__ATOMIC_ACQUIRE, "agent");
            asm volatile("s_waitcnt vmcnt(0)" ::: "memory");
        }
    }
    __syncthreads();
}

struct Ctx {
    const float* in[22]; float* out; unsigned char* ws;
    unsigned char* lds; int tid, lane, wave, G, vb;
};
#define WSP(T_, off) ((T_*)(c.ws + (off)))
__device__ __forceinline__ Ctx reopaque(const Ctx& c0) {
    Ctx c = c0; int t = c0.tid; asm volatile("" : "+v"(t)); c.tid = t; c.lane = t & 63; c.wave = __builtin_amdgcn_readfirstlane(t >> 6);
    int vb = c0.vb; asm volatile("" : "+s"(vb)); c.vb = vb; return c;
}

__device__ __forceinline__ int lds_off(int row, int chunk) { return row * 128 + ((chunk ^ (row & 7)) << 4); }

__device__ __forceinline__ void gemm_compute_stage(f32x4 (&acc)[2][8], const unsigned char* sA, const unsigned char* sB, int wave, int lane) {
    const int r = lane & 15, q = lane >> 4;
#pragma unroll
    for (int ks = 0; ks < 2; ++ks) {
        bf16x8 af[2], bfr[8];
#pragma unroll
        for (int mi = 0; mi < 2; ++mi) af[mi] = *(const bf16x8*)(sA + lds_off(32 * wave + 16 * mi + r, 4 * ks + q));
#pragma unroll
        for (int ni = 0; ni < 8; ++ni) bfr[ni] = *(const bf16x8*)(sB + lds_off(16 * ni + r, 4 * ks + q));
#pragma unroll
        for (int mi = 0; mi < 2; ++mi)
#pragma unroll
            for (int ni = 0; ni < 8; ++ni) acc[mi][ni] = __builtin_amdgcn_mfma_f32_16x16x32_bf16(bfr[ni], af[mi], acc[mi][ni], 0, 0, 0);
    }
}

#define LAS __attribute__((address_space(3)))
__device__ __forceinline__ void gemm_stage_glds(const bf16* A, int lda, const bf16* Bt, int ldb, int kt, unsigned char* stage, int wave, int lane) {
    const int rr = lane >> 3, cch = (lane & 7) ^ rr;
#pragma unroll
    for (int i = 0; i < 4; ++i) { const int pc = 4 * i + wave;
        __builtin_amdgcn_global_load_lds((const unsigned*)(A + (size_t)(8 * pc + rr) * lda + kt * 64 + cch * 8), (LAS unsigned*)(stage + pc * 1024), 16, 0, 0);
        __builtin_amdgcn_global_load_lds((const unsigned*)(Bt + (size_t)(8 * pc + rr) * ldb + kt * 64 + cch * 8), (LAS unsigned*)(stage + 16384 + pc * 1024), 16, 0, 0); }
}
__device__ __forceinline__ void gemm_core(f32x4 (&acc)[2][8], const bf16* A, int lda, const bf16* Bt, int ldb, int K, unsigned char* lds, int tid) {
    const int wave = __builtin_amdgcn_readfirstlane(tid >> 6), lane = tid & 63;
    const int nk = K >> 6;
    gemm_stage_glds(A, lda, Bt, ldb, 0, lds, wave, lane);
    asm volatile("s_waitcnt vmcnt(0)" ::: "memory");
    __syncthreads();
    for (int kt = 0; kt < nk; ++kt) {
        const int cur = kt & 1;
        if (kt + 1 < nk) gemm_stage_glds(A, lda, Bt, ldb, kt + 1, lds + (cur ^ 1) * 32768, wave, lane);
        gemm_compute_stage(acc, lds + cur * 32768, lds + cur * 32768 + 16384, wave, lane);
        asm volatile("s_waitcnt vmcnt(0)" ::: "memory");
        __syncthreads();
    }
}
__device__ __forceinline__ void acc_zero(f32x4 (&acc)[2][8]) {
#pragma unroll
    for (int mi = 0; mi < 2; ++mi)
#pragma unroll
        for (int ni = 0; ni < 8; ++ni) acc[mi][ni] = (f32x4){0.f, 0.f, 0.f, 0.f};
}
__device__ __forceinline__ float rstd_from_ssq8(const float* ssq, int tok) {
    const f32x4 a = *(const f32x4*)(ssq + (size_t)tok * 8), b = *(const f32x4*)(ssq + (size_t)tok * 8 + 4);
    const float s = ((a.x + a.y) + (a.z + a.w)) + ((b.x + b.y) + (b.z + b.w));
    return rsqrt_(s * (1.0f / 1024.0f) + EPS);
}

__device__ __forceinline__ int src_col(int mode, int np) {
    if (mode == 0) return np;
    if (mode == 2) { const int h = np >> 7, j = np & 127; return j < 96 ? h * 96 + j : -1; }
    if (np < 1024) { const int cblk = np >> 7, j = np & 127; return j < 64 ? 64 * cblk + j : 512 + 64 * cblk + (j - 64); }
    if (np < 1408) return np;
    if (np < 1536) { const int j = np - 1408; return j < 32 ? 1408 + j : -1; }
    return 1440 + (np - 1536);
}
__device__ __forceinline__ void p0_transpose_item(const float* W, int K, int N, bf16* Wt, int mode, const float* g, int item, float* scr, int lane) {
    const int nblk_k = K / 64, nb = item / nblk_k, kb = item % nblk_k, k0 = 64 * kb, n0 = 32 * nb;
    const int n = src_col(mode, n0 + (lane & 31));
    float wv[32], gv[32];
#pragma unroll
    for (int i = 0; i < 32; ++i) { const int kk = 2 * i + (lane >> 5); wv[i] = n >= 0 ? W[(size_t)(k0 + kk) * N + n] : 0.f; gv[i] = g ? g[k0 + kk] : 1.f; }
#pragma unroll
    for (int i = 0; i < 32; ++i) { const int kk = 2 * i + (lane >> 5); scr[kk * 33 + (lane & 31)] = wv[i] * gv[i]; }
    __builtin_amdgcn_s_waitcnt(0xC07F); asm volatile("" ::: "memory");
    const int cch = lane & 7;
#pragma unroll
    for (int j = 0; j < 4; ++j) { const int nl = (lane >> 3) + 8 * j; const float* s = scr + (8 * cch) * 33 + nl;
        u32x4 o; o.x = pk2(s[0 * 33], s[1 * 33]); o.y = pk2(s[2 * 33], s[3 * 33]); o.z = pk2(s[4 * 33], s[5 * 33]); o.w = pk2(s[6 * 33], s[7 * 33]);
        *(u32x4*)(Wt + (size_t)(n0 + nl) * K + k0 + 8 * cch) = o; }
    __builtin_amdgcn_s_waitcnt(0xC07F); asm volatile("" ::: "memory");
}
struct WDesc { int in_idx, K, N, Np, mode, g_idx; size_t off; };
__device__ __forceinline__ void phase_prologue(const Ctx& c0) {
    Ctx c = reopaque(c0);
    const int gw = c.vb * 4 + c.wave, NGW = c.G * 4;
    float* scr = (float*)(c.lds + c.wave * 8704);
    const WDesc wd[7] = {
        {3, 1024, NIN, NINP, 1, 2, 0}, {8, 512, 1024, 1024, 0, -1, OFF_WCO}, {10, 256, 768, 1024, 2, 9, OFF_WUQ}, {12, 128, 1024, 1024, 0, 11, OFF_WUKV},
        {15, 512, 1024, 1024, 0, -1, OFF_WMLA}, {16, 1024, 1024, 1024, 0, -1, OFF_WOUT}, {18, 1024, 2048, 2048, 0, 17, OFF_WPQ}};
    constexpr int ITEMS_PER_LAYER = (1024 / 64) * (NINP / 32) + (512 / 64) * 32 + (256 / 64) * 32 + (128 / 64) * 32 + (512 / 64) * 32 + (1024 / 64) * 32 + (1024 / 64) * 64;
    for (int it = gw; it < 2 * ITEMS_PER_LAYER; it += NGW) {
        const int l = it >= ITEMS_PER_LAYER ? 1 : 0; int r = it - l * ITEMS_PER_LAYER;
        const float* W = nullptr; const float* g = nullptr; bf16* Wt = nullptr; int K = 64, N = 32, mode = 0, rr = 0;
#pragma unroll
        for (int m = 0; m < 7; ++m) {
            const int items = (wd[m].K / 64) * (wd[m].Np / 32);
            if (r >= 0 && r < items) { K = wd[m].K; N = wd[m].N; mode = wd[m].mode; rr = r;
                W = c.in[wd[m].in_idx] + (size_t)l * wd[m].K * wd[m].N; g = wd[m].g_idx >= 0 ? c.in[wd[m].g_idx >= 0 ? wd[m].g_idx : 0] + (size_t)l * wd[m].K : nullptr;
                Wt = (bf16*)(c.ws + WS_WIN + l * SZ_WLAYER + wd[m].off); }
            r -= items;
        }
        p0_transpose_item(W, K, N, Wt, mode, g, rr, scr, c.lane);
    }
    const int gt = c.vb * NTHREADS + c.tid, NGT = c.G * NTHREADS;
    for (int l = 0; l < 2; ++l) {
        const float* src = c.in[19] + (size_t)l * 262144; bf16* dst = (bf16*)(c.ws + WS_WIN + l * SZ_WLAYER + OFF_KEYS);
        for (int i = gt; i < 262144 / 8; i += NGT) { const f32x4 a = *(const f32x4*)(src + i * 8), b = *(const f32x4*)(src + i * 8 + 4);
            u32x4 o; o.x = pk2(a.x, a.y); o.y = pk2(a.z, a.w); o.z = pk2(b.x, b.y); o.w = pk2(b.z, b.w); *(u32x4*)(dst + i * 8) = o; }
    }
    for (int l = 0; l < 2; ++l)
        for (int uv = 0; uv < 2; ++uv) {
            const float* src = c.in[20 + uv] + (size_t)l * NEXP * 1024; unsigned char* dst = c.ws + WS_TAB + (size_t)(l * 2 + uv) * SZ_TAB;
            f32x4 g4[4];
#pragma unroll
            for (int j = 0; j < 4; ++j) { const float sc = uv == 0 ? U_SCALE : TAB_SCALE; g4[j] = (f32x4){sc, sc, sc, sc}; if (uv == 0) g4[j] = g4[j] * *(const f32x4*)(c.in[17] + l * 1024 + 256 * j + 4 * c.lane); }
            for (int row = gw; row < NEXP; row += 2 * NGW) {
                const float* sp = src + (size_t)row * 1024 + 4 * c.lane; const int row2 = row + NGW; const bool two = row2 < NEXP;
                const float* sp2 = src + (size_t)(two ? row2 : row) * 1024 + 4 * c.lane;
                f32x4 a[4], b[4];
#pragma unroll
                for (int j = 0; j < 4; ++j) { a[j] = *(const f32x4*)(sp + 256 * j); b[j] = *(const f32x4*)(sp2 + 256 * j); }
#pragma unroll
                for (int j = 0; j < 4; ++j) { const f32x4 v = a[j] * g4[j];
                    *(unsigned*)(dst + (size_t)row * 1024 + 256 * j + 4 * c.lane) = uv == 0 ? pack_i8x4(v) : (unsigned)__builtin_amdgcn_cvt_pk_fp8_f32(v.z, v.w, __builtin_amdgcn_cvt_pk_fp8_f32(v.x, v.y, 0, false), true); }
                if (two) {
#pragma unroll
                    for (int j = 0; j < 4; ++j) { const f32x4 v = b[j] * g4[j];
                        *(unsigned*)(dst + (size_t)row2 * 1024 + 256 * j + 4 * c.lane) = uv == 0 ? pack_i8x4(v) : (unsigned)__builtin_amdgcn_cvt_pk_fp8_f32(v.z, v.w, __builtin_amdgcn_cvt_pk_fp8_f32(v.x, v.y, 0, false), true); } }
            }
        }
    { float* rope = WSP(float, WS_ROPE);
      for (int i = gt; i < L * 16; i += NGT) { const int pos = i >> 4, j = i & 15;
          const float inv = 1.0f / __builtin_exp2f((float)j * 0.8304820237218406f);
          const float angf = (float)pos * inv; const double ang = (double)angf;
          const double nq = __builtin_rint(ang * 0.63661977236758134308);
          double rr = __builtin_fma(-nq, 1.57079632679489655800e+00, ang); rr = __builtin_fma(-nq, 6.12323399573676603587e-17, rr);
          const double r2 = rr * rr;
          double sp = -1.0 / 1307674368000.0; sp = sp * r2 + 1.0 / 6227020800.0; sp = sp * r2 - 1.0 / 39916800.0; sp = sp * r2 + 1.0 / 362880.0; sp = sp * r2 - 1.0 / 5040.0; sp = sp * r2 + 1.0 / 120.0; sp = sp * r2 - 1.0 / 6.0; sp = sp * r2 * rr + rr;
          double cp = 1.0 / 87178291200.0; cp = cp * r2 - 1.0 / 479001600.0; cp = cp * r2 + 1.0 / 3628800.0; cp = cp * r2 - 1.0 / 40320.0; cp = cp * r2 + 1.0 / 720.0; cp = cp * r2 - 1.0 / 24.0; cp = cp * r2 + 0.5; cp = 1.0 - cp * r2;
          const int qd = ((int)nq) & 3;
          const double cv = qd == 0 ? cp : qd == 1 ? -sp : qd == 2 ? -cp : sp;
          const double sv_ = qd == 0 ? sp : qd == 1 ? cp : qd == 2 ? -sp : -cp;
          rope[2 * i] = (float)cv; rope[2 * i + 1] = (float)sv_; } }
    { bf16* hb = WSP(bf16, WS_HB); float* ssq = WSP(float, WS_SSQ);
      for (int t0_ = gw; t0_ < T; t0_ += 4 * NGW) {
          f32x4 v[4][4];
#pragma unroll
          for (int i = 0; i < 4; ++i) { const int t = t0_ + i * NGW < T ? t0_ + i * NGW : t0_; const int b = t / L, pos = t % L;
              const float* src = pos < NMETA ? c.in[1] + (size_t)pos * D : c.in[0] + ((size_t)b * SEQ + (pos - NMETA)) * D;
#pragma unroll
              for (int j = 0; j < 4; ++j) v[i][j] = *(const f32x4*)(src + j * 256 + c.lane * 4); }
#pragma unroll
          for (int i = 0; i < 4; ++i) { const int t = t0_ + i * NGW;
              if (t < T) { float s = 0.f;
#pragma unroll
                  for (int j = 0; j < 4; ++j) { const f32x4 x = v[i][j]; u32x2 o; o.x = pk2(x.x, x.y); o.y = pk2(x.z, x.w); *(u32x2*)(hb + (size_t)t * D + j * 256 + c.lane * 4) = o;
                      s += (x.x * x.x + x.y * x.y) + (x.z * x.z + x.w * x.w); }
                  s = wave_sum(s);
                  if (c.lane < 8) ssq[(size_t)t * 8 + c.lane] = c.lane == 0 ? s : 0.f; } }
      } }
}

__device__ __forceinline__ void phase_A(const Ctx& c0, int l) {
    Ctx c = reopaque(c0);
    const bf16* hb = WSP(bf16, WS_HB); const bf16* Wt = (const bf16*)(c.ws + WS_WIN + l * SZ_WLAYER);
    const float* ssq = WSP(float, WS_SSQ);
    bf16* uglu = WSP(bf16, WS_UGLU); bf16* cq = WSP(bf16, WS_CQ); bf16* ckv = WSP(bf16, WS_CKV); float* krope = WSP(float, WS_KROPE);
    float* ssqq = WSP(float, WS_SSQQ); float* ssqkv = WSP(float, WS_SSQKV); bf16* gates = WSP(bf16, WS_GATES);
    constexpr int NT = NINP / 128;
    const int r = c.lane & 15, q = c.lane >> 4;
    const int xcd = c.vb / (c.G / 8), lb = c.vb % (c.G / 8), xm = xcd & 1, xn = xcd >> 1;
    const int m_lo = xm ? (MT + 1) / 2 : 0, m_cnt = xm ? MT / 2 : (MT + 1) / 2;
    for (int j = lb; j < m_cnt * 7; j += c.G / 8) {
        const int mt = m_lo + j / 7, nt = xn * 7 + j % 7;
        f32x4 acc[2][8]; acc_zero(acc);
        gemm_core(acc, hb + (size_t)mt * 128 * D, D, Wt + (size_t)nt * 128 * D, D, D, c.lds, c.tid);
#pragma unroll
        for (int mi = 0; mi < 2; ++mi) {
            const int tok = mt * 128 + 32 * c.wave + 16 * mi + r;
            const float rs = rstd_from_ssq8(ssq, tok);
            if (nt < 8) {
#pragma unroll
                for (int ni = 0; ni < 4; ++ni) { const f32x4 v = acc[mi][ni] * rs, g = acc[mi][ni + 4] * rs;
                    u32x2 o; o.x = pk2(v.x * sigmoidf_(g.x), v.y * sigmoidf_(g.y)); o.y = pk2(v.z * sigmoidf_(g.z), v.w * sigmoidf_(g.w));
                    *(u32x2*)(uglu + (size_t)tok * DC + nt * 64 + 16 * ni + 4 * q) = o; }
            } else if (nt < 11) {
                bf16* dst = nt < 10 ? cq + (size_t)tok * QL + (nt - 8) * 128 : ckv + (size_t)tok * KVL;
                float ss = 0.f;
#pragma unroll
                for (int ni = 0; ni < 8; ++ni) { const f32x4 v = acc[mi][ni] * rs; ss += (v.x * v.x + v.y * v.y) + (v.z * v.z + v.w * v.w);
                    u32x2 o; o.x = pk2(v.x, v.y); o.y = pk2(v.z, v.w); *(u32x2*)(dst + 16 * ni + 4 * q) = o; }
                ss = quad_sum(ss);
                if (q == 0) { if (nt < 10) ssqq[(size_t)tok * 2 + (nt - 8)] = ss; else ssqkv[tok] = ss; }
            } else if (nt == 11) {
#pragma unroll
                for (int ni = 0; ni < 2; ++ni) *(f32x4*)(krope + (size_t)tok * 32 + 16 * ni + 4 * q) = acc[mi][ni] * rs;
            } else {
#pragma unroll
                for (int ni = 0; ni < 8; ++ni) { const f32x4 v = acc[mi][ni] * rs;
                    u32x2 o; o.x = pk2(sigmoidf_(v.x), sigmoidf_(v.y)); o.y = pk2(sigmoidf_(v.z), sigmoidf_(v.w));
                    *(u32x2*)(gates + (size_t)tok * 2048 + (nt - 12) * 128 + 16 * ni + 4 * q) = o; }
            }
        }
    }
}

__device__ __forceinline__ void phaseB_q_item(Ctx& c, int l, int mt, int head) {
    const bf16* cq = WSP(bf16, WS_CQ); const bf16* Wt = (const bf16*)(c.ws + WS_WIN + l * SZ_WLAYER + OFF_WUQ);
    const float* ssqq = WSP(float, WS_SSQQ); const float* rope = WSP(float, WS_ROPE); const float* qg = c.in[13] + l * QK; bf16* Qb = WSP(bf16, WS_Q);
    const int r = c.lane & 15, q = c.lane >> 4;
    f32x4 acc[2][8]; acc_zero(acc);
    gemm_core(acc, cq + (size_t)mt * 128 * QL, QL, Wt + (size_t)head * 128 * QL, QL, QL, c.lds, c.tid);
    constexpr float QSCALE = 0.10206207261596575f * 1.4426950408889634f;
#pragma unroll
    for (int mi = 0; mi < 2; ++mi) {
        const int tok = mt * 128 + 32 * c.wave + 16 * mi + r, b = tok / L, pos = tok - b * L;
        const float rs = rsqrt_((ssqq[(size_t)tok * 2] + ssqq[(size_t)tok * 2 + 1]) * (1.0f / 256.0f) + EPS);
        float ss = 0.f;
#pragma unroll
        for (int ni = 0; ni < 6; ++ni) { acc[mi][ni] = acc[mi][ni] * rs; const f32x4 v = acc[mi][ni]; ss += (v.x * v.x + v.y * v.y) + (v.z * v.z + v.w * v.w); }
        ss = quad_sum(ss);
        const float rn = rsqrt_(ss * (1.0f / 96.0f) + EPS) * QSCALE;
#pragma unroll
        for (int ni = 0; ni < 6; ++ni) { const f32x4 g = *(const f32x4*)(qg + 16 * ni + 4 * q); acc[mi][ni] = acc[mi][ni] * g * rn; }
        const f32x4 cs0 = *(const f32x4*)(rope + ((size_t)pos * 16 + 4 * q) * 2), cs1 = *(const f32x4*)(rope + ((size_t)pos * 16 + 4 * q) * 2 + 4);
        const float co[4] = {cs0.x, cs0.z, cs1.x, cs1.z}, si[4] = {cs0.y, cs0.w, cs1.y, cs1.w};
        f32x4 x1 = acc[mi][4], x2 = acc[mi][5];
#pragma unroll
        for (int e = 0; e < 4; ++e) { const float a = x1[e], bb = x2[e]; x1[e] = a * co[e] - bb * si[e]; x2[e] = bb * co[e] + a * si[e]; }
        acc[mi][4] = x1; acc[mi][5] = x2;
        bf16* dst = Qb + (((size_t)b * NH + head) * L + pos) * QK;
#pragma unroll
        for (int ni = 0; ni < 6; ++ni) { const f32x4 v = acc[mi][ni]; u32x2 o; o.x = pk2(v.x, v.y); o.y = pk2(v.z, v.w); *(u32x2*)(dst + 16 * ni + 4 * q) = o; }
    }
}
__device__ __forceinline__ void phaseB_kv_item(Ctx& c, int l, int mt, int head) {
    const bf16* ckv = WSP(bf16, WS_CKV); const bf16* Wt = (const bf16*)(c.ws + WS_WIN + l * SZ_WLAYER + OFF_WUKV);
    const float* ssqkv = WSP(float, WS_SSQKV); const float* rope = WSP(float, WS_ROPE); const float* kg = c.in[14] + l * QK; const float* krope = WSP(float, WS_KROPE);
    bf16* Kb = WSP(bf16, WS_K); bf16* Vt = WSP(bf16, WS_VT);
    const int tid = c.tid, wave = c.wave, lane = c.lane, r = lane & 15, q = lane >> 4;
    unsigned char* lds = c.lds;
    f32x4 ak[2][4], av[2][4];
#pragma unroll
    for (int mi = 0; mi < 2; ++mi)
#pragma unroll
        for (int ni = 0; ni < 4; ++ni) { ak[mi][ni] = (f32x4){0.f, 0.f, 0.f, 0.f}; av[mi][ni] = (f32x4){0.f, 0.f, 0.f, 0.f}; }
    { const int chunk = tid & 7, row0 = tid >> 3;
      const bf16* pa = ckv + ((size_t)mt * 128 + row0) * KVL + chunk * 8; const bf16* pb = Wt + ((size_t)head * 128 + row0) * KVL + chunk * 8;
#pragma unroll
      for (int s = 0; s < 2; ++s)
#pragma unroll
          for (int i = 0; i < 4; ++i) { *(u32x4*)(lds + s * 32768 + lds_off(row0 + 32 * i, chunk)) = *(const u32x4*)(pa + (size_t)(32 * i) * KVL + s * 64);
              *(u32x4*)(lds + s * 32768 + 16384 + lds_off(row0 + 32 * i, chunk)) = *(const u32x4*)(pb + (size_t)(32 * i) * KVL + s * 64); }
    }
    __syncthreads();
#pragma unroll
    for (int s = 0; s < 2; ++s)
#pragma unroll
        for (int ks = 0; ks < 2; ++ks) {
            const unsigned char* sA = lds + s * 32768; const unsigned char* sB = sA + 16384;
            bf16x8 af[2], bfr[8];
#pragma unroll
            for (int mi = 0; mi < 2; ++mi) af[mi] = *(const bf16x8*)(sA + lds_off(32 * wave + 16 * mi + r, 4 * ks + q));
#pragma unroll
            for (int ni = 0; ni < 8; ++ni) bfr[ni] = *(const bf16x8*)(sB + lds_off(16 * ni + r, 4 * ks + q));
#pragma unroll
            for (int mi = 0; mi < 2; ++mi)
#pragma unroll
                for (int ni = 0; ni < 4; ++ni) { ak[mi][ni] = __builtin_amdgcn_mfma_f32_16x16x32_bf16(bfr[ni], af[mi], ak[mi][ni], 0, 0, 0);
                    av[mi][ni] = __builtin_amdgcn_mfma_f32_16x16x32_bf16(af[mi], bfr[ni + 4], av[mi][ni], 0, 0, 0); }
        }
    __syncthreads();
#pragma unroll
    for (int mi = 0; mi < 2; ++mi) {
        const int tok0 = mt * 128 + 32 * wave + 16 * mi, b = tok0 / L, pos0 = tok0 - b * L;
        { const int tok = tok0 + r, pos = pos0 + r;
          const float rs = rsqrt_(ssqkv[tok] * (1.0f / 128.0f) + EPS);
          const f32x4 kr1 = *(const f32x4*)(krope + (size_t)tok * 32 + 4 * q), kr2 = *(const f32x4*)(krope + (size_t)tok * 32 + 16 + 4 * q);
          float ss = (kr1.x * kr1.x + kr1.y * kr1.y) + (kr1.z * kr1.z + kr1.w * kr1.w) + (kr2.x * kr2.x + kr2.y * kr2.y) + (kr2.z * kr2.z + kr2.w * kr2.w);
#pragma unroll
          for (int ni = 0; ni < 4; ++ni) { ak[mi][ni] = ak[mi][ni] * rs; const f32x4 v = ak[mi][ni]; ss += (v.x * v.x + v.y * v.y) + (v.z * v.z + v.w * v.w); }
          ss = quad_sum(ss);
          const float rn = rsqrt_(ss * (1.0f / 96.0f) + EPS);
          bf16* dst = Kb + (((size_t)b * NH + head) * L + pos) * QK;
#pragma unroll
          for (int ni = 0; ni < 4; ++ni) { const f32x4 g = *(const f32x4*)(kg + 16 * ni + 4 * q); const f32x4 v = ak[mi][ni] * g * rn;
              u32x2 o; o.x = pk2(v.x, v.y); o.y = pk2(v.z, v.w); *(u32x2*)(dst + 16 * ni + 4 * q) = o; }
          const f32x4 g1 = *(const f32x4*)(kg + 64 + 4 * q), g2 = *(const f32x4*)(kg + 80 + 4 * q);
          f32x4 x1 = kr1 * g1 * rn, x2 = kr2 * g2 * rn;
          const f32x4 cs0 = *(const f32x4*)(rope + ((size_t)pos * 16 + 4 * q) * 2), cs1 = *(const f32x4*)(rope + ((size_t)pos * 16 + 4 * q) * 2 + 4);
          const float co[4] = {cs0.x, cs0.z, cs1.x, cs1.z}, si[4] = {cs0.y, cs0.w, cs1.y, cs1.w};
#pragma unroll
          for (int e = 0; e < 4; ++e) { const float a = x1[e], bb = x2[e]; x1[e] = a * co[e] - bb * si[e]; x2[e] = bb * co[e] + a * si[e]; }
          u32x2 o1, o2; o1.x = pk2(x1.x, x1.y); o1.y = pk2(x1.z, x1.w); o2.x = pk2(x2.x, x2.y); o2.y = pk2(x2.z, x2.w);
          *(u32x2*)(dst + 64 + 4 * q) = o1; *(u32x2*)(dst + 80 + 4 * q) = o2; }
        { const f32x4 sq = *(const f32x4*)(ssqkv + tok0 + 4 * q);
          f32x4 rs4; rs4.x = rsqrt_(sq.x * (1.0f / 128.0f) + EPS); rs4.y = rsqrt_(sq.y * (1.0f / 128.0f) + EPS); rs4.z = rsqrt_(sq.z * (1.0f / 128.0f) + EPS); rs4.w = rsqrt_(sq.w * (1.0f / 128.0f) + EPS);
#pragma unroll
          for (int ni = 0; ni < 4; ++ni) { const f32x4 v = av[mi][ni] * rs4; u32x2 o; o.x = pk2(v.x, v.y); o.y = pk2(v.z, v.w);
              *(u32x2*)(Vt + (((size_t)b * NH + head) * VD + 16 * ni + r) * L + pos0 + 4 * q) = o; } }
    }
}
__device__ __forceinline__ u32x4 conv_row(const bf16* uglu, int b, int pos, int ch) {
    u32x4 xv = (u32x4){0u, 0u, 0u, 0u};
    if (pos >= 0) xv = *(const u32x4*)(uglu + ((size_t)b * L + pos) * DC + ch);
    return xv;
}
__device__ __forceinline__ void conv_fma(float (&a)[8], const u32x4 xv, const f32x4 w0, const f32x4 w1) {
    a[0] += bf_lo(xv.x) * w0.x; a[1] += bf_hi(xv.x) * w0.y; a[2] += bf_lo(xv.y) * w0.z; a[3] += bf_hi(xv.y) * w0.w;
    a[4] += bf_lo(xv.z) * w1.x; a[5] += bf_hi(xv.z) * w1.y; a[6] += bf_lo(xv.w) * w1.z; a[7] += bf_hi(xv.w) * w1.w;
}
__device__ __forceinline__ void phaseB_conv_item(Ctx& c, int l, int grp) {
    const bf16* uglu = WSP(bf16, WS_UGLU); bf16* u2 = WSP(bf16, WS_U2);
    const float* cw = c.in[4] + (size_t)l * CW * DC; const float* cb = c.in[5] + l * DC; const float* lg = c.in[6] + l * DC; const float* lb = c.in[7] + l * DC;
    const int tok0 = grp * 4, b = tok0 / L, pos0 = tok0 - b * L, ch = c.lane * 8;
    float acc[4][8];
    { const f32x4 b0 = *(const f32x4*)(cb + ch), b1 = *(const f32x4*)(cb + ch + 4);
#pragma unroll
      for (int d = 0; d < 4; ++d) { acc[d][0] = b0.x; acc[d][1] = b0.y; acc[d][2] = b0.z; acc[d][3] = b0.w; acc[d][4] = b1.x; acc[d][5] = b1.y; acc[d][6] = b1.z; acc[d][7] = b1.w; } }
    const int base = pos0 - 30;
    u32x4 x0 = conv_row(uglu, b, base + 0, ch), x1 = conv_row(uglu, b, base + 1, ch), x2 = conv_row(uglu, b, base + 2, ch),
          x3 = conv_row(uglu, b, base + 3, ch), x4 = conv_row(uglu, b, base + 4, ch), x5;
    const float* wp = cw + ch;
#pragma unroll 1
    for (int w = 0; w < CW; ++w) {
        x5 = conv_row(uglu, b, (w + 5 <= 33) ? base + w + 5 : -1, ch);
        const f32x4 w0 = *(const f32x4*)wp, w1 = *(const f32x4*)(wp + 4); wp += DC;
        conv_fma(acc[0], x0, w0, w1); conv_fma(acc[1], x1, w0, w1); conv_fma(acc[2], x2, w0, w1); conv_fma(acc[3], x3, w0, w1);
        x0 = x1; x1 = x2; x2 = x3; x3 = x4; x4 = x5;
    }
    const f32x4 g0 = *(const f32x4*)(lg + ch), g1 = *(const f32x4*)(lg + ch + 4), e0 = *(const f32x4*)(lb + ch), e1 = *(const f32x4*)(lb + ch + 4);
    const float gg[8] = {g0.x, g0.y, g0.z, g0.w, g1.x, g1.y, g1.z, g1.w}, be[8] = {e0.x, e0.y, e0.z, e0.w, e1.x, e1.y, e1.z, e1.w};
#pragma unroll
    for (int d = 0; d < 4; ++d) {
        float s = 0.f;
#pragma unroll
        for (int j = 0; j < 8; ++j) s += acc[d][j];
        const float mu = wave_sum(s) * (1.0f / 512.0f);
        float vq = 0.f;
#pragma unroll
        for (int j = 0; j < 8; ++j) { acc[d][j] -= mu; vq += acc[d][j] * acc[d][j]; }
        const float rstd = rsqrt_(wave_sum(vq) * (1.0f / 512.0f) + EPS);
        float y[8];
#pragma unroll
        for (int j = 0; j < 8; ++j) { const float v = acc[d][j] * rstd * gg[j] + be[j]; y[j] = v * sigmoidf_(v); }
        u32x4 o; o.x = pk2(y[0], y[1]); o.y = pk2(y[2], y[3]); o.z = pk2(y[4], y[5]); o.w = pk2(y[6], y[7]);
        *(u32x4*)(u2 + (size_t)(tok0 + d) * DC + ch) = o;
    }
}
__device__ __forceinline__ void phase_B(const Ctx& c0, int l) {
    Ctx c = reopaque(c0);
    constexpr int NQ = MT * NH, NKV = MT * NH, NCV = T / 16;
    for (int it = c.vb; it < NQ + NKV + NCV; it += c.G) {
        if (it < NQ) phaseB_q_item(c, l, it / NH, it % NH);
        else if (it < NQ + NKV) phaseB_kv_item(c, l, (it - NQ) / NH, (it - NQ) % NH);
        else phaseB_conv_item(c, l, (it - NQ - NKV) * 4 + c.wave);
    }
}

constexpr int KROW = 208, VROW = 136, ATT_STAGE = 64 * KROW + 64 * VROW;
constexpr int ATT_ITEMS = NB * NH * 17;
__device__ __forceinline__ void phase_C(const Ctx& c0, int l) {
    Ctx c = reopaque(c0);
    const bf16* Qb = WSP(bf16, WS_Q); const bf16* Kb = WSP(bf16, WS_K); const bf16* Vt = WSP(bf16, WS_VT); bf16* O = WSP(bf16, WS_O);
    unsigned* qctr = WSP(unsigned, WS_CTL) + CW_QUEUE + 64 * l;
    volatile unsigned* misc = (volatile unsigned*)(c.lds + LDS_MISC);
    const int tid = c.tid, wave = c.wave, lane = c.lane, r = lane & 15, q = lane >> 4;
    unsigned char* lds = c.lds;
    for (;;) {
        if (tid == 0) misc[4] = atomicAdd(qctr, 1u);
        __syncthreads();
        const int item = __builtin_amdgcn_readfirstlane((int)misc[4]);
        __syncthreads();
        if (item >= ATT_ITEMS) break;
        const int pp = 15 - item / 64, bh = item % 64, b = bh / NH, h = bh % NH;
        const bool meta = pp < 0;
        const int r0 = meta ? 0 : 16 + 128 * pp;
        const int nfull = meta ? 0 : 2 * pp + 1 + (wave >> 1);
        const int ntiles = meta ? 1 : 2 * pp + 3;
        const bf16* Kbase = Kb + (size_t)bh * L * QK; const bf16* Vbase = Vt + (size_t)bh * VD * L;
        bf16x8 qf[2][3];
#pragma unroll
        for (int mi = 0; mi < 2; ++mi)
#pragma unroll
            for (int ks = 0; ks < 3; ++ks) qf[mi][ks] = *(const bf16x8*)(Qb + ((size_t)bh * L + r0 + 32 * wave + 16 * mi + r) * QK + 32 * ks + 8 * q);
        float m[2] = {-1e30f, -1e30f}, lsum[2] = {0.f, 0.f};
        f32x4 o[2][4];
#pragma unroll
        for (int mi = 0; mi < 2; ++mi)
#pragma unroll
            for (int dt = 0; dt < 4; ++dt) o[mi][dt] = (f32x4){0.f, 0.f, 0.f, 0.f};
        u32x4 rk[3], rv[2];
        auto gload = [&](int kt) {
#pragma unroll
            for (int i = 0; i < 3; ++i) { const int id = tid + 256 * i, row = id / 12, cc = id % 12; rk[i] = *(const u32x4*)(Kbase + (size_t)(kt * 64 + row) * QK + cc * 8); }
#pragma unroll
            for (int i = 0; i < 2; ++i) { const int id = tid + 256 * i, row = id >> 3, cc = id & 7; rv[i] = *(const u32x4*)(Vbase + (size_t)row * L + kt * 64 + cc * 8); }
        };
        auto lstore = [&](int s) {
            unsigned char* st = lds + s * ATT_STAGE;
#pragma unroll
            for (int i = 0; i < 3; ++i) { const int id = tid + 256 * i, row = id / 12, cc = id % 12; *(u32x4*)(st + row * KROW + cc * 16) = rk[i]; }
#pragma unroll
            for (int i = 0; i < 2; ++i) { const int id = tid + 256 * i, row = id >> 3, cc = id & 7; u32x2* d = (u32x2*)(st + 64 * KROW + row * VROW + cc * 16); d[0] = (u32x2){rv[i].x, rv[i].y}; d[1] = (u32x2){rv[i].z, rv[i].w}; }
        };
        gload(0); lstore(0);
#pragma unroll
        for (int mi = 0; mi < 2; ++mi)
#pragma unroll
            for (int ks = 0; ks < 3; ++ks) asm volatile("" : "+v"(qf[mi][ks]));
        __syncthreads();
        for (int kt = 0; kt < ntiles; ++kt) {
            const int cur = kt & 1;
            if (kt + 1 < ntiles) gload(kt + 1);
            const unsigned char* sK = lds + cur * ATT_STAGE; const unsigned char* sV = sK + 64 * KROW;
            const bool full = kt < nfull;
            if (kt <= nfull) {
                f32x4 s[2][4];
#pragma unroll
                for (int kh = 0; kh < 2; ++kh) {
                    bf16x8 kf[2][3];
#pragma unroll
                    for (int kk = 0; kk < 2; ++kk) if ((kh == 0 && kk == 0) || full) {
#pragma unroll
                        for (int ks = 0; ks < 3; ++ks) kf[kk][ks] = *(const bf16x8*)(sK + (16 * (2 * kh + kk) + r) * KROW + 64 * ks + 16 * q); }
#pragma unroll
                    for (int kk = 0; kk < 2; ++kk) { const int k4 = 2 * kh + kk;
#pragma unroll
                        for (int mi = 0; mi < 2; ++mi) s[mi][k4] = (f32x4){0.f, 0.f, 0.f, 0.f};
                        if (k4 == 0 || full) {
#pragma unroll
                            for (int ks = 0; ks < 3; ++ks)
#pragma unroll
                                for (int mi = 0; mi < 2; ++mi) s[mi][k4] = __builtin_amdgcn_mfma_f32_16x16x32_bf16(kf[kk][ks], qf[mi][ks], s[mi][k4], 0, 0, 0);
                        }
                    }
                }
                u32x2 vlo[4], vhi[4];
#pragma unroll
                for (int dt = 0; dt < 4; ++dt) { const unsigned char* vp = sV + (16 * dt + r) * VROW + (4 * q) * 2;
                    vlo[dt] = *(const u32x2*)vp; vhi[dt] = (u32x2){0u, 0u}; if (full) vhi[dt] = *(const u32x2*)(vp + 32); }
                bf16x8 pf[2][2];
#pragma unroll
                for (int mi = 0; mi < 2; ++mi) {
                    float mx = fmaxf(fmaxf(s[mi][0].x, s[mi][0].y), fmaxf(s[mi][0].z, s[mi][0].w));
                    if (full) {
#pragma unroll
                        for (int k4 = 1; k4 < 4; ++k4) mx = fmaxf(mx, fmaxf(fmaxf(s[mi][k4].x, s[mi][k4].y), fmaxf(s[mi][k4].z, s[mi][k4].w)));
                    }
                    mx = quad_max(mx);
                    const float mn = fmaxf(m[mi], mx), alpha = fast_exp2(m[mi] - mn); m[mi] = mn;
                    float ps = 0.f;
#pragma unroll
                    for (int k4 = 0; k4 < 4; ++k4) {
                        if (k4 == 0 || full) { f32x4 p; p.x = fast_exp2(s[mi][k4].x - mn); p.y = fast_exp2(s[mi][k4].y - mn); p.z = fast_exp2(s[mi][k4].z - mn); p.w = fast_exp2(s[mi][k4].w - mn);
                            ps += (p.x + p.y) + (p.z + p.w); s[mi][k4] = p; }
                    }
                    lsum[mi] = lsum[mi] * alpha + ps;
#pragma unroll
                    for (int dt = 0; dt < 4; ++dt) o[mi][dt] = o[mi][dt] * alpha;
#pragma unroll
                    for (int st = 0; st < 2; ++st) { u32x4 pw;
                        pw.x = pk2(s[mi][2 * st].x, s[mi][2 * st].y); pw.y = pk2(s[mi][2 * st].z, s[mi][2 * st].w); pw.z = pk2(s[mi][2 * st + 1].x, s[mi][2 * st + 1].y); pw.w = pk2(s[mi][2 * st + 1].z, s[mi][2 * st + 1].w);
                        if (!full) { pw.z = 0u; pw.w = 0u; }
                        pf[mi][st] = __builtin_bit_cast(bf16x8, pw); }
                }
                u32x2 wlo[4], whi[4];
                if (full) {
#pragma unroll
                    for (int dt = 0; dt < 4; ++dt) { const unsigned char* vp = sV + (16 * dt + r) * VROW + (32 + 4 * q) * 2; wlo[dt] = *(const u32x2*)vp; whi[dt] = *(const u32x2*)(vp + 32); } }
#pragma unroll
                for (int dt = 0; dt < 4; ++dt) { const bf16x8 vf = __builtin_bit_cast(bf16x8, (u32x4){vlo[dt].x, vlo[dt].y, vhi[dt].x, vhi[dt].y});
#pragma unroll
                    for (int mi = 0; mi < 2; ++mi) o[mi][dt] = __builtin_amdgcn_mfma_f32_16x16x32_bf16(vf, pf[mi][0], o[mi][dt], 0, 0, 0); }
                if (full) {
#pragma unroll
                    for (int dt = 0; dt < 4; ++dt) { const bf16x8 vf = __builtin_bit_cast(bf16x8, (u32x4){wlo[dt].x, wlo[dt].y, whi[dt].x, whi[dt].y});
#pragma unroll
                        for (int mi = 0; mi < 2; ++mi) o[mi][dt] = __builtin_amdgcn_mfma_f32_16x16x32_bf16(vf, pf[mi][1], o[mi][dt], 0, 0, 0); } }
            }
            if (kt + 1 < ntiles) lstore(cur ^ 1);
            __syncthreads();
        }
#pragma unroll
        for (int mi = 0; mi < 2; ++mi) {
            const float lt = quad_sum(lsum[mi]);
            if (!meta || (wave == 0 && mi == 0)) {
                const float inv = 1.0f / lt;
                bf16* dst = O + ((size_t)b * L + r0 + 32 * wave + 16 * mi + r) * 512 + h * VD;
#pragma unroll
                for (int dt = 0; dt < 4; ++dt) { const f32x4 v = o[mi][dt] * inv; u32x2 ov; ov.x = pk2(v.x, v.y); ov.y = pk2(v.z, v.w); *(u32x2*)(dst + 16 * dt + 4 * q) = ov; }
            }
        }
    }
}

__device__ __forceinline__ int tile_tok0(int mt, int l) { return l == 1 ? mt * 128 + NMETA * ((mt >> 4) + 1) : mt * 128; }
__device__ __forceinline__ int n_mtiles(int l) { return l == 1 ? 128 : MT; }
__device__ __forceinline__ void phase_D(const Ctx& c0, int l) {
    Ctx c = reopaque(c0);
    const bf16* u2 = WSP(bf16, WS_U2); const bf16* O = WSP(bf16, WS_O); const bf16* gates = WSP(bf16, WS_GATES); bf16* merged = WSP(bf16, WS_MERGED);
    const bf16* Wco = (const bf16*)(c.ws + WS_WIN + l * SZ_WLAYER + OFF_WCO); const bf16* Wmla = (const bf16*)(c.ws + WS_WIN + l * SZ_WLAYER + OFF_WMLA);
    const int r = c.lane & 15, q = c.lane >> 4;
    for (int it = c.vb; it < n_mtiles(l) * 8; it += c.G) {
        const int mt = it / 8, nt = it % 8, tk0 = tile_tok0(mt, l);
        f32x4 acc[2][8]; acc_zero(acc);
        gemm_core(acc, u2 + (size_t)tk0 * 512, 512, Wco + (size_t)nt * 128 * 512, 512, 512, c.lds, c.tid);
#pragma unroll
        for (int mi = 0; mi < 2; ++mi) { const int tok = tk0 + 32 * c.wave + 16 * mi + r;
            const bf16* gp = gates + (size_t)tok * 2048 + nt * 128 + 4 * q; bf16* mp = merged + (size_t)tok * D + nt * 128 + 4 * q;
#pragma unroll
            for (int ni = 0; ni < 8; ++ni) { const u32x2 g = *(const u32x2*)(gp + 16 * ni); const f32x4 v = acc[mi][ni];
                u32x2 o; o.x = pk2(v.x * bf_lo(g.x), v.y * bf_hi(g.x)); o.y = pk2(v.z * bf_lo(g.y), v.w * bf_hi(g.y)); *(u32x2*)(mp + 16 * ni) = o; } }
        acc_zero(acc);
        gemm_core(acc, O + (size_t)tk0 * 512, 512, Wmla + (size_t)nt * 128 * 512, 512, 512, c.lds, c.tid);
#pragma unroll
        for (int mi = 0; mi < 2; ++mi) { const int tok = tk0 + 32 * c.wave + 16 * mi + r;
            const bf16* gp = gates + (size_t)tok * 2048 + 1024 + nt * 128 + 4 * q; bf16* mp = merged + (size_t)tok * D + nt * 128 + 4 * q;
#pragma unroll
            for (int ni = 0; ni < 8; ++ni) { const u32x2 g = *(const u32x2*)(gp + 16 * ni); const u32x2 s = *(const u32x2*)(mp + 16 * ni); const f32x4 v = acc[mi][ni];
                u32x2 o; o.x = pk2(bf_lo(s.x) + v.x * bf_lo(g.x), bf_hi(s.x) + v.y * bf_hi(g.x)); o.y = pk2(bf_lo(s.y) + v.z * bf_lo(g.y), bf_hi(s.y) + v.w * bf_hi(g.y));
                *(u32x2*)(mp + 16 * ni) = o; } }
    }
}

__device__ __forceinline__ void phase_E(const Ctx& c0, int l) {
    Ctx c = reopaque(c0);
    const bf16* merged = WSP(bf16, WS_MERGED); const bf16* Wout = (const bf16*)(c.ws + WS_WIN + l * SZ_WLAYER + OFF_WOUT);
    float* h = WSP(float, WS_H); bf16* hb = WSP(bf16, WS_HB); float* ssq = WSP(float, WS_SSQ);
    const int r = c.lane & 15, q = c.lane >> 4;
    for (int it = c.vb; it < n_mtiles(l) * 8; it += c.G) {
        const int mt = it / 8, nt = it % 8, tk0 = tile_tok0(mt, l);
        f32x4 acc[2][8];
#pragma unroll
        for (int mi = 0; mi < 2; ++mi) { const int tok = tk0 + 32 * c.wave + 16 * mi + r; const float* hp = h + (size_t)tok * D;
            if (l == 0) { const int b = tok / L, pos = tok - b * L; hp = pos < NMETA ? c.in[1] + (size_t)pos * D : c.in[0] + ((size_t)b * SEQ + (pos - NMETA)) * D; }
            hp += nt * 128 + 4 * q;
#pragma unroll
            for (int ni = 0; ni < 8; ++ni) acc[mi][ni] = *(const f32x4*)(hp + 16 * ni); }
        gemm_core(acc, merged + (size_t)tk0 * D, D, Wout + (size_t)nt * 128 * D, D, D, c.lds, c.tid);
#pragma unroll
        for (int mi = 0; mi < 2; ++mi) { const int tok = tk0 + 32 * c.wave + 16 * mi + r; float ss = 0.f;
#pragma unroll
            for (int ni = 0; ni < 8; ++ni) { float* hp = h + (size_t)tok * D + nt * 128 + 16 * ni + 4 * q; const f32x4 v = acc[mi][ni]; *(f32x4*)hp = v;
                ss += (v.x * v.x + v.y * v.y) + (v.z * v.z + v.w * v.w);
                u32x2 o; o.x = pk2(v.x, v.y); o.y = pk2(v.z, v.w); *(u32x2*)(hb + (size_t)tok * D + nt * 128 + 16 * ni + 4 * q) = o; }
            ss = quad_sum(ss);
            if (q == 0) ssq[(size_t)tok * 8 + nt] = ss; }
    }
}

__device__ __forceinline__ unsigned f2key(float f) { const unsigned u = __float_as_uint(f); return u ^ ((u >> 31) ? 0xFFFFFFFFu : 0x80000000u); }
__device__ __forceinline__ float key2f(unsigned k) { const unsigned u = (k >> 31) ? (k ^ 0x80000000u) : ~k; return __uint_as_float(u); }
__device__ __forceinline__ void top16_insert(unsigned (&lst)[16], unsigned x) {
#pragma unroll
    for (int i = 0; i < 16; ++i) { const unsigned a = lst[i]; lst[i] = a > x ? a : x; x = a > x ? x : a; }
}
__device__ __forceinline__ void ce_desc(unsigned& a, unsigned& b) { const unsigned mx = a > b ? a : b, mn = a > b ? b : a; a = mx; b = mn; }
__device__ __forceinline__ void sort16_desc(unsigned (&v)[16]) {
#pragma unroll
    for (int k = 2; k <= 16; k <<= 1)
#pragma unroll
        for (int j = k >> 1; j > 0; j >>= 1)
#pragma unroll
            for (int i = 0; i < 16; ++i) { const int p = i ^ j; if (p > i) { if ((i & k) == 0) ce_desc(v[i], v[p]); else ce_desc(v[p], v[i]); } }
}
__device__ __forceinline__ void merge_top16(unsigned (&a)[16], const unsigned (&b)[16]) {
#pragma unroll
    for (int i = 0; i < 16; ++i) a[i] = a[i] > b[15 - i] ? a[i] : b[15 - i];
#pragma unroll
    for (int j = 8; j > 0; j >>= 1)
#pragma unroll
        for (int i = 0; i < 16; ++i) { const int p = i ^ j; if (p > i) ce_desc(a[i], a[p]); }
}
__device__ __forceinline__ void phase_F(const Ctx& c0, int l) {
    Ctx c = reopaque(c0);
    const bf16* hb = WSP(bf16, WS_HB); const bf16* Wpq = (const bf16*)(c.ws + WS_WIN + l * SZ_WLAYER + OFF_WPQ); const bf16* keys = (const bf16*)(c.ws + WS_WIN + l * SZ_WLAYER + OFF_KEYS);
    const float* ssq = WSP(float, WS_SSQ); float* sv = WSP(float, WS_SV); unsigned char* si = WSP(unsigned char, WS_SI);
    const int tid = c.tid, wave = c.wave, lane = c.lane, r = lane & 15, q = lane >> 4;
    unsigned char* lds = c.lds;
    const int xcd = c.vb / (c.G / 8), lb = c.vb % (c.G / 8), xm = xcd & 1, xn = xcd >> 1, nmt = n_mtiles(l);
    const int m_lo = xm ? (nmt + 1) / 2 : 0, m_cnt = xm ? nmt / 2 : (nmt + 1) / 2;
    for (int j = lb; j < m_cnt * 4; j += c.G / 8) {
        const int mt = m_lo + j / 4, hp = xn * 4 + j % 4, tk0 = tile_tok0(mt, l);
        f32x4 acc[2][8]; acc_zero(acc);
        gemm_core(acc, hb + (size_t)tk0 * D, D, Wpq + (size_t)hp * 128 * D, D, D, lds, tid);
#pragma unroll
        for (int mi = 0; mi < 2; ++mi) { const int row = 32 * wave + 16 * mi + r; const float rs = rstd_from_ssq8(ssq, tk0 + row);
#pragma unroll
            for (int ni = 0; ni < 8; ++ni) { const f32x4 v = acc[mi][ni] * rs; u32x2 o; o.x = pk2(v.x, v.y); o.y = pk2(v.z, v.w);
                *(u32x2*)(lds + (ni >> 2) * 32768 + lds_off(row, 2 * (ni & 3) + (q >> 1)) + 8 * (q & 1)) = o; } }
        { const int chunk = tid & 7, row0 = tid >> 3; const bf16* pb = keys + ((size_t)hp * 128 + row0) * 128 + chunk * 8;
#pragma unroll
          for (int s = 0; s < 2; ++s)
#pragma unroll
              for (int i = 0; i < 4; ++i) *(u32x4*)(lds + s * 32768 + 16384 + lds_off(row0 + 32 * i, chunk)) = *(const u32x4*)(pb + (size_t)(32 * i) * 128 + s * 64); }
        __syncthreads();
        acc_zero(acc);
        gemm_compute_stage(acc, lds, lds + 16384, wave, lane);
        gemm_compute_stage(acc, lds + 32768, lds + 32768 + 16384, wave, lane);
        __syncthreads();
        float* S = (float*)lds;
#pragma unroll
        for (int mi = 0; mi < 2; ++mi) { const int row = 32 * wave + 16 * mi + r;
#pragma unroll
            for (int ni = 0; ni < 8; ++ni) *(f32x4*)(S + row * 132 + 16 * ni + 4 * q) = acc[mi][ni]; }
        __syncthreads();
        {
            const int tl = 32 * wave + (lane & 31), half = lane >> 5;
            const float* row = S + tl * 132;
            unsigned lst[16];
#pragma unroll
            for (int g = 0; g < 4; ++g) {
                unsigned cur[16];
#pragma unroll
                for (int j = 0; j < 4; ++j) { const int col = 64 * half + 16 * g + 4 * j; const f32x4 v = *(const f32x4*)(row + col);
                    cur[4 * j] = (f2key(v.x) & ~127u) | (unsigned)(127 - col); cur[4 * j + 1] = (f2key(v.y) & ~127u) | (unsigned)(127 - (col + 1));
                    cur[4 * j + 2] = (f2key(v.z) & ~127u) | (unsigned)(127 - (col + 2)); cur[4 * j + 3] = (f2key(v.w) & ~127u) | (unsigned)(127 - (col + 3)); }
                sort16_desc(cur);
                if (g == 0) {
#pragma unroll
                    for (int i = 0; i < 16; ++i) lst[i] = cur[i];
                } else merge_top16(lst, cur);
            }
            unsigned oth[16];
#pragma unroll
            for (int i = 0; i < 16; ++i) { auto rr = __builtin_amdgcn_permlane32_swap(lst[i], lst[i], false, false); oth[i] = half == 0 ? rr[1] : rr[0]; }
            merge_top16(lst, oth);
            if (half == 0) {
                const int tok = tk0 + tl;
                unsigned idx[16]; float val[16];
#pragma unroll
                for (int i = 0; i < 16; ++i) { idx[i] = 127u - (lst[i] & 127u); val[i] = row[idx[i]]; }
                float* svp = sv + ((size_t)tok * 16 + hp) * 16;
#pragma unroll
                for (int i = 0; i < 4; ++i) *(f32x4*)(svp + 4 * i) = (f32x4){val[4 * i], val[4 * i + 1], val[4 * i + 2], val[4 * i + 3]};
                u32x4 pi;
                pi.x = idx[0] | (idx[1] << 8) | (idx[2] << 16) | (idx[3] << 24); pi.y = idx[4] | (idx[5] << 8) | (idx[6] << 16) | (idx[7] << 24);
                pi.z = idx[8] | (idx[9] << 8) | (idx[10] << 16) | (idx[11] << 24); pi.w = idx[12] | (idx[13] << 8) | (idx[14] << 16) | (idx[15] << 24);
                *(u32x4*)(si + ((size_t)tok * 16 + hp) * 16) = pi;
            }
        }
        __syncthreads();
    }
}

__device__ __forceinline__ void phase_F3(const Ctx& c0, int l) {
    Ctx c = reopaque(c0);
    const float* sv = WSP(float, WS_SV); const unsigned char* si = WSP(unsigned char, WS_SI); int* eidx = WSP(int, WS_EIDX); float* gw = WSP(float, WS_GW); unsigned char* stb = WSP(unsigned char, WS_STB);
    float* lsv = (float*)c.lds;
    unsigned char* lsi = c.lds + 256 * 33 * 4;
    const int tid = c.tid;
    const int ntok = l == 1 ? NB * SEQ : T;
    for (int base = c.vb * NTHREADS; base < ntok * 8; base += c.G * NTHREADS) {
        const int thc = base + tid, tkc = thc >> 3;
        const int th = (l == 1 ? tkc + NMETA * ((tkc >> 11) + 1) : tkc) * 8 + (thc & 7);
        float a[16], b[16];
#pragma unroll
        for (int i = 0; i < 4; ++i) { const f32x4 x = *(const f32x4*)(sv + (size_t)th * 32 + 4 * i), y = *(const f32x4*)(sv + (size_t)th * 32 + 16 + 4 * i);
            a[4 * i] = x.x; a[4 * i + 1] = x.y; a[4 * i + 2] = x.z; a[4 * i + 3] = x.w; b[4 * i] = y.x; b[4 * i + 1] = y.y; b[4 * i + 2] = y.z; b[4 * i + 3] = y.w; }
        const u32x4 ia = *(const u32x4*)(si + (size_t)th * 32), ib = *(const u32x4*)(si + (size_t)th * 32 + 16);
#pragma unroll
        for (int i = 0; i < 16; ++i) { lsv[tid * 33 + i] = a[i]; lsv[tid * 33 + 16 + i] = b[i]; }
        *(u32x4*)(lsi + tid * 32) = ia; *(u32x4*)(lsi + tid * 32 + 16) = ib;
        unsigned lst[16], g2[16], g3[16], g4[16];
#pragma unroll
        for (int j = 0; j < 16; ++j) lst[j] = (f2key(a[0] + b[j]) & ~255u) | (unsigned)(255 - j);
#pragma unroll
        for (int i = 1; i < 16; ++i) g2[i - 1] = (f2key(a[i] + b[0]) & ~255u) | (unsigned)(255 - i * 16);
        g2[15] = 0u;
        { int n = 0;
#pragma unroll
          for (int i = 1; i < 16; ++i)
#pragma unroll
              for (int j = 1; j < 16; ++j)
                  if ((i + 1) * (j + 1) <= 16) { const unsigned key = (f2key(a[i] + b[j]) & ~255u) | (unsigned)(255 - (i * 16 + j)); if (n < 16) g3[n] = key; else g4[n - 16] = key; ++n; }
#pragma unroll
          for (int k = 3; k < 16; ++k) g4[k] = 0u; }
        sort16_desc(g3); sort16_desc(g4);
        merge_top16(lst, g2); merge_top16(g3, g4); merge_top16(lst, g3);
        __builtin_amdgcn_s_waitcnt(0xC07F); asm volatile("" ::: "memory");
        float s[16]; int e[16];
#pragma unroll
        for (int k = 0; k < 16; ++k) { const unsigned code = 255u - (lst[k] & 255u); const int i = code >> 4, j = code & 15;
            s[k] = lsv[tid * 33 + i] + lsv[tid * 33 + 16 + j]; e[k] = (int)lsi[tid * 32 + i] * 128 + (int)lsi[tid * 32 + 16 + j]; }
        float mx = s[0];
#pragma unroll
        for (int k = 1; k < 16; ++k) mx = fmaxf(mx, s[k]);
        float sum = 0.f;
#pragma unroll
        for (int k = 0; k < 16; ++k) { s[k] = fast_exp2((s[k] - mx) * 1.4426950409f); sum += s[k]; }
        const float inv = 1.0f / sum;
        typedef unsigned long long u64;
        u64 hlo = 0ull, hhi = 0ull;
#pragma unroll
        for (int k = 0; k < 16; ++k) { const int sl = e[k] >> 10; if (sl < 8) hlo += 1ull << (8 * sl); else hhi += 1ull << (8 * (sl - 8)); }
        u64 ilo = hlo, ihi = hhi;
#pragma unroll
        for (int d = 1; d < 8; d <<= 1) { const u64 a_ = __shfl_up(ilo, d, 8), b_ = __shfl_up(ihi, d, 8); if ((tid & 7) >= d) { ilo += a_; ihi += b_; } }
        const u64 tlo = __shfl(ilo, 7, 8), thi = __shfl(ihi, 7, 8);
        const u64 ones = 0x0101010101010101ull;
        const u64 inlo = tlo * ones, inhi = thi * ones + (inlo >> 56) * ones;
        const u64 stlo = inlo - tlo, sthi = inhi - thi;
        u64 rlo = stlo + (ilo - hlo), rhi = sthi + (ihi - hhi);
        const int tokn = th >> 3;
#pragma unroll
        for (int k = 0; k < 16; ++k) { const int sl = e[k] >> 10; int pos;
            if (sl < 8) { pos = (int)((rlo >> (8 * sl)) & 255ull); rlo += 1ull << (8 * sl); } else { pos = (int)((rhi >> (8 * (sl - 8))) & 255ull); rhi += 1ull << (8 * (sl - 8)); }
            eidx[(size_t)tokn * 128 + pos] = e[k]; gw[(size_t)tokn * 128 + pos] = s[k] * inv; }
        if ((tid & 7) == 0) { u64* sp = (u64*)(stb + (size_t)tokn * 16); sp[0] = stlo; sp[1] = sthi; }
        __builtin_amdgcn_s_waitcnt(0xC07F); asm volatile("" ::: "memory");
    }
}

typedef float f32x2 __attribute__((ext_vector_type(2)));
constexpr int G2_WSTRIDE = 14336, G2_MAXTOK = 9;
__device__ __forceinline__ float fp8dot4(unsigned w, unsigned x01, unsigned x23, float acc) {
    const bf16x2 lo = __builtin_amdgcn_cvt_scalef32_pk_bf16_fp8(w, 1.0f, false), hi = __builtin_amdgcn_cvt_scalef32_pk_bf16_fp8(w, 1.0f, true);
    acc = __builtin_amdgcn_fdot2_f32_bf16(lo, __builtin_bit_cast(bf16x2, x01), acc, false);
    return __builtin_amdgcn_fdot2_f32_bf16(hi, __builtin_bit_cast(bf16x2, x23), acc, false);
}
__device__ __forceinline__ float reduce8_transposed(const float (&p)[8], int lane) {
    float s[4];
#pragma unroll
    for (int k = 0; k < 4; ++k) { auto r = __builtin_amdgcn_permlane32_swap(__float_as_uint(p[k]), __float_as_uint(p[k + 4]), false, false); s[k] = __uint_as_float(r[0]) + __uint_as_float(r[1]); }
    float t[2];
#pragma unroll
    for (int k = 0; k < 2; ++k) { auto r = __builtin_amdgcn_permlane16_swap(__float_as_uint(s[k]), __float_as_uint(s[k + 2]), false, false); t[k] = __uint_as_float(r[0]) + __uint_as_float(r[1]); }
    const float u0 = t[0] + dpp<0x128>(t[0]), u1 = t[1] + dpp<0x128>(t[1]);
    float r = (lane & 8) ? u1 : u0;
    r += dpp<0xB1>(r); r += dpp<0x4E>(r); r += dpp<0x141>(r);
    return r;
}
typedef int i32x4 __attribute__((ext_vector_type(4)));
__device__ __forceinline__ void fp8fma4(f32x2 (&acc)[8], int o, unsigned w, f32x2 a2) {
    const f32x2 lo = __builtin_amdgcn_cvt_scalef32_pk_f32_fp8(w, 1.0f, false), hi = __builtin_amdgcn_cvt_scalef32_pk_f32_fp8(w, 1.0f, true);
    acc[o] = __builtin_elementwise_fma(a2, lo, acc[o]); acc[o + 1] = __builtin_elementwise_fma(a2, hi, acc[o + 1]);
}
__device__ __forceinline__ void g2_u_chunk(u32x4 (&u)[8], const unsigned char* U, const int* pe_next, const float* pw_c, float* act_c, const u32x4 xq, float rs, int lane) {
    const i32x4 e0 = *(const i32x4*)pe_next, e1 = *(const i32x4*)(pe_next + 4);
    const int en[8] = {e0.x, e0.y, e0.z, e0.w, e1.x, e1.y, e1.z, e1.w};
    float p[8];
#pragma unroll
    for (int k = 0; k < 8; ++k) {
        int d = __builtin_amdgcn_sdot4((int)u[k].x, (int)xq.x, 0, false); d = __builtin_amdgcn_sdot4((int)u[k].y, (int)xq.y, d, false);
        d = __builtin_amdgcn_sdot4((int)u[k].z, (int)xq.z, d, false); d = __builtin_amdgcn_sdot4((int)u[k].w, (int)xq.w, d, false);
        p[k] = (float)d;
        asm volatile("" : "+v"(p[k]));
        u[k] = *(const u32x4*)(U + (size_t)__builtin_amdgcn_readfirstlane(en[k]) * 1024 + lane * 16);
    }
    const float a = reduce8_transposed(p, lane);
    const int row = (lane >> 3) & 7;
    if ((lane & 7) == 0) act_c[row] = gelu_tanh(a * rs) * pw_c[row];
}
__device__ __forceinline__ void g2_v_chunk(u32x4 (&v)[8], const unsigned char* V, const int* pe_next, const float* act_c, f32x2 (&acc)[8], int lane) {
    const i32x4 e0 = *(const i32x4*)pe_next, e1 = *(const i32x4*)(pe_next + 4);
    const int en[8] = {e0.x, e0.y, e0.z, e0.w, e1.x, e1.y, e1.z, e1.w};
    const f32x4 a0 = *(const f32x4*)act_c, a1 = *(const f32x4*)(act_c + 4);
    const float av[8] = {a0.x, a0.y, a0.z, a0.w, a1.x, a1.y, a1.z, a1.w};
#pragma unroll
    for (int k = 0; k < 8; ++k) { const f32x2 a2 = (f32x2){av[k], av[k]};
        fp8fma4(acc, 0, v[k].x, a2); fp8fma4(acc, 2, v[k].y, a2); fp8fma4(acc, 4, v[k].z, a2); fp8fma4(acc, 6, v[k].w, a2);
        asm volatile("" : "+v"(acc[0]), "+v"(acc[1]), "+v"(acc[2]), "+v"(acc[3]), "+v"(acc[4]), "+v"(acc[5]), "+v"(acc[6]), "+v"(acc[7]));
        v[k] = *(const u32x4*)(V + (size_t)__builtin_amdgcn_readfirstlane(en[k]) * 1024 + lane * 16);
    }
}
__device__ __forceinline__ void g2_finish_token(Ctx& c, int l, int tok, const f32x2 (&acc)[8], int lane) {
    float* h = WSP(float, WS_H); bf16* hbw = WSP(bf16, WS_HB); float* ssqw = WSP(float, WS_SSQ);
    float* hp = h + (size_t)tok * D + lane * 16;
    f32x4 r0 = *(const f32x4*)hp, r1 = *(const f32x4*)(hp + 4), r2 = *(const f32x4*)(hp + 8), r3 = *(const f32x4*)(hp + 12);
    r0 += (f32x4){acc[0].x, acc[0].y, acc[1].x, acc[1].y}; r1 += (f32x4){acc[2].x, acc[2].y, acc[3].x, acc[3].y};
    r2 += (f32x4){acc[4].x, acc[4].y, acc[5].x, acc[5].y}; r3 += (f32x4){acc[6].x, acc[6].y, acc[7].x, acc[7].y};
    if (l == 0) {
        *(f32x4*)hp = r0; *(f32x4*)(hp + 4) = r1; *(f32x4*)(hp + 8) = r2; *(f32x4*)(hp + 12) = r3;
        u32x4 o0, o1; o0.x = pk2(r0.x, r0.y); o0.y = pk2(r0.z, r0.w); o0.z = pk2(r1.x, r1.y); o0.w = pk2(r1.z, r1.w);
        o1.x = pk2(r2.x, r2.y); o1.y = pk2(r2.z, r2.w); o1.z = pk2(r3.x, r3.y); o1.w = pk2(r3.z, r3.w);
        *(u32x4*)(hbw + (size_t)tok * D + lane * 16) = o0; *(u32x4*)(hbw + (size_t)tok * D + lane * 16 + 8) = o1;
        float ss = (r0.x * r0.x + r0.y * r0.y) + (r0.z * r0.z + r0.w * r0.w) + (r1.x * r1.x + r1.y * r1.y) + (r1.z * r1.z + r1.w * r1.w)
                 + (r2.x * r2.x + r2.y * r2.y) + (r2.z * r2.z + r2.w * r2.w) + (r3.x * r3.x + r3.y * r3.y) + (r3.z * r3.z + r3.w * r3.w);
        ss = wave_sum_dpp(ss);
        if (lane < 8) ssqw[(size_t)tok * 8 + lane] = lane == 0 ? ss : 0.f;
    } else {
        const int b = tok / L, pos = tok - b * L;
        if (pos >= NMETA) { float* op = c.out + ((size_t)b * SEQ + (pos - NMETA)) * D + lane * 16;
            *(f32x4*)op = r0; *(f32x4*)(op + 4) = r1; *(f32x4*)(op + 8) = r2; *(f32x4*)(op + 12) = r3; }
    }
}
__device__ __forceinline__ void phase_G2(const Ctx& c0, int l) {
    Ctx c = reopaque(c0);
    const bf16* hb = WSP(bf16, WS_HB); const float* ssq = WSP(float, WS_SSQ); const int* pe = WSP(int, WS_EIDX); const float* pw = WSP(float, WS_GW);
    const unsigned char* U = c.ws + WS_TAB + (size_t)(l * 2) * SZ_TAB; const unsigned char* V = c.ws + WS_TAB + (size_t)(l * 2 + 1) * SZ_TAB;
    const int lane = c.lane, wave = c.wave;
    const int gw = c.vb * 4 + wave, t0 = l == 1 ? gw * 8 + NMETA * ((gw >> 8) + 1) : gw * 8;
    const bool has_x = l == 0 && (c.vb & 3) == 0; const int tx = T - 128 + (c.vb >> 2);
    unsigned char* wl = c.lds + wave * G2_WSTRIDE;
    int* pe_l = (int*)wl; float* pw_l = (float*)(wl + 4608); float* act_l = (float*)(wl + 9216);
#pragma unroll
    for (int j = 0; j < G2_MAXTOK; ++j) { const int tok = j < 8 ? t0 + j : (has_x ? tx : t0);
        pe_l[j * 128 + lane] = pe[(size_t)tok * 128 + lane]; pe_l[j * 128 + 64 + lane] = pe[(size_t)tok * 128 + 64 + lane];
        pw_l[j * 128 + lane] = pw[(size_t)tok * 128 + lane] * TAB_INV; pw_l[j * 128 + 64 + lane] = pw[(size_t)tok * 128 + 64 + lane] * TAB_INV; }
    const int xlo = has_x ? 4 * wave : 16, xhi = has_x ? 4 * wave + 4 : 16;
    {
        u32x4 xq[G2_MAXTOK]; float rs[G2_MAXTOK];
#pragma unroll
        for (int j = 0; j < G2_MAXTOK; ++j) { const int tok = j < 8 ? t0 + j : (has_x ? tx : t0);
            const u32x4 lo = *(const u32x4*)(hb + (size_t)tok * D + lane * 16), hi = *(const u32x4*)(hb + (size_t)tok * D + lane * 16 + 8);
            const f32x4 f0 = (f32x4){bf_lo(lo.x), bf_hi(lo.x), bf_lo(lo.y), bf_hi(lo.y)}, f1 = (f32x4){bf_lo(lo.z), bf_hi(lo.z), bf_lo(lo.w), bf_hi(lo.w)};
            const f32x4 f2 = (f32x4){bf_lo(hi.x), bf_hi(hi.x), bf_lo(hi.y), bf_hi(hi.y)}, f3 = (f32x4){bf_lo(hi.z), bf_hi(hi.z), bf_lo(hi.w), bf_hi(hi.w)};
            float mx = 1e-20f;
#pragma unroll
            for (int i = 0; i < 4; ++i) mx = fmaxf(mx, fmaxf(fmaxf(fabsf(f0[i]), fabsf(f1[i])), fmaxf(fabsf(f2[i]), fabsf(f3[i]))));
            mx = fmaxf(mx, dpp<0xB1>(mx)); mx = fmaxf(mx, dpp<0x4E>(mx)); mx = fmaxf(mx, dpp<0x141>(mx)); mx = fmaxf(mx, dpp<0x128>(mx)); mx = xrow16_max(mx);
            const float sx = 127.0f / mx;
            xq[j].x = pack_i8x4(f0 * sx); xq[j].y = pack_i8x4(f1 * sx); xq[j].z = pack_i8x4(f2 * sx); xq[j].w = pack_i8x4(f3 * sx);
            rs[j] = rstd_from_ssq8(ssq, tok) * mx * (1.0f / (127.0f * U_SCALE)); }
        u32x4 u[8];
#pragma unroll
        for (int k = 0; k < 8; ++k) u[k] = *(const u32x4*)(U + (size_t)__builtin_amdgcn_readfirstlane(pe_l[k]) * 1024 + lane * 16);
#pragma unroll 1
        for (int ch = 0; ch < 16; ++ch) {
            const int cn = ch < 15 ? ch + 1 : 0;
            const bool x_here = ch >= xlo && ch < xhi;
#pragma unroll
            for (int j = 0; j < 8; ++j) {
                const int* pe_next = j < 7 ? pe_l + (j + 1) * 128 + ch * 8 : (x_here ? pe_l + 8 * 128 + ch * 8 : pe_l + cn * 8);
                g2_u_chunk(u, U, pe_next, pw_l + j * 128 + ch * 8, act_l + j * 128 + ch * 8, xq[j], rs[j], lane); }
            if (x_here) g2_u_chunk(u, U, pe_l + cn * 8, pw_l + 8 * 128 + ch * 8, act_l + 8 * 128 + ch * 8, xq[8], rs[8], lane);
        }
    }
    f32x2 acc[G2_MAXTOK][8];
#pragma unroll
    for (int j = 0; j < G2_MAXTOK; ++j)
#pragma unroll
        for (int i = 0; i < 8; ++i) acc[j][i] = (f32x2){0.f, 0.f};
    {
        u32x4 v[8];
#pragma unroll
        for (int k = 0; k < 8; ++k) v[k] = *(const u32x4*)(V + (size_t)__builtin_amdgcn_readfirstlane(pe_l[k]) * 1024 + lane * 16);
#pragma unroll 1
        for (int ch = 0; ch < 16; ++ch) {
            const int cn = ch < 15 ? ch + 1 : 0;
            const bool x_here = ch >= xlo && ch < xhi;
#pragma unroll
            for (int j = 0; j < 8; ++j) {
                const int* pe_next = j < 7 ? pe_l + (j + 1) * 128 + ch * 8 : (x_here ? pe_l + 8 * 128 + ch * 8 : pe_l + cn * 8);
                g2_v_chunk(v, V, pe_next, act_l + j * 128 + ch * 8, acc[j], lane); }
            if (x_here) g2_v_chunk(v, V, pe_l + cn * 8, act_l + 8 * 128 + ch * 8, acc[8], lane);
        }
    }
#pragma unroll
    for (int j = 0; j < 8; ++j) g2_finish_token(c, l, t0 + j, acc[j], lane);
    __syncthreads();
    if (has_x) {
        f32x2* part = (f32x2*)(c.lds + wave * G2_WSTRIDE);
#pragma unroll
        for (int i = 0; i < 8; ++i) part[i * 64 + lane] = acc[8][i];
    }
    __syncthreads();
    if (has_x && wave == 0) {
        f32x2 tot[8];
#pragma unroll
        for (int i = 0; i < 8; ++i) { tot[i] = acc[8][i];
#pragma unroll
            for (int w = 1; w < 4; ++w) tot[i] += ((const f32x2*)(c.lds + w * G2_WSTRIDE))[i * 64 + lane]; }
        g2_finish_token(c, l, tx, tot, lane);
    }
    __syncthreads();
}

struct Args { const float* in[22]; float* out; unsigned char* ws; int ph_lo, ph_hi; };
constexpr int N_PHASES = 17;

__global__ void __launch_bounds__(NTHREADS, 2) fwd_kernel(Args args) {
    extern __shared__ __attribute__((aligned(16))) unsigned char lds_raw[];
    Ctx c;
#pragma unroll
    for (int i = 0; i < 22; ++i) c.in[i] = args.in[i];
    c.out = args.out; c.ws = args.ws; c.lds = lds_raw;
    c.tid = threadIdx.x; c.lane = c.tid & 63; c.wave = __builtin_amdgcn_readfirstlane(c.tid >> 6);
    c.G = gridDim.x; { const int bx = blockIdx.x; c.vb = (c.G % 8 == 0) ? (bx % 8) * (c.G / 8) + bx / 8 : bx; }
    volatile unsigned* misc = (volatile unsigned*)(c.lds + LDS_MISC);
    if (c.tid < 16) misc[c.tid] = 0u;
    __syncthreads();
    const int lo = args.ph_lo, hi = args.ph_hi;
    const bool multi = (hi - lo) > 1;
    XcdBarrier bar; bar.bar = WSP(unsigned, WS_CTL) + CW_BAR; bar.x = 0; bar.st = misc;
    if (multi) bar = xcd_barrier_post(WSP(unsigned, WS_CTL) + CW_BAR, misc);
#define IN_(k) (lo <= (k) && (k) < hi)
#define SEAM_(k) do { if ((k) + 1 < hi) xcd_barrier(bar); } while (0)
    if (IN_(0)) { phase_prologue(c); SEAM_(0); }
#pragma unroll 1
    for (int l = 0; l < 2; ++l) {
        const int p0 = 1 + 8 * l;
        if (IN_(p0 + 0)) { phase_A(c, l); SEAM_(p0 + 0); }
        if (IN_(p0 + 1)) { phase_B(c, l); SEAM_(p0 + 1); }
        if (IN_(p0 + 2)) { phase_C(c, l); SEAM_(p0 + 2); }
        if (IN_(p0 + 3)) { phase_D(c, l); SEAM_(p0 + 3); }
        if (IN_(p0 + 4)) { phase_E(c, l); SEAM_(p0 + 4); }
        if (IN_(p0 + 5)) { phase_F(c, l); SEAM_(p0 + 5); }
        if (IN_(p0 + 6)) { phase_F3(c, l); SEAM_(p0 + 6); }
        if (IN_(p0 + 7)) { phase_G2(c, l); SEAM_(p0 + 7); }
    }
}

extern "C" void kernel_launch(void* const* d_in, const int* in_sizes, int n_in, void* d_out, int out_size, void* d_ws, size_t ws_size, hipStream_t stream) {
    static int grid = 0;
    if (grid == 0) {
        if (n_in != 22 || out_size != NB * SEQ * D || ws_size < WS_END) { fprintf(stderr, "kernel_launch: unexpected shapes (n_in %d out %d ws %zu need %zu)\n", n_in, out_size, ws_size, (size_t)WS_END); grid = -1; return; }
        int dev = 0, cus = 0, per_cu = 0;
        hipGetDevice(&dev); hipDeviceGetAttribute(&cus, hipDeviceAttributeMultiprocessorCount, dev);
        if (hipFuncSetAttribute((const void*)fwd_kernel, hipFuncAttributeMaxDynamicSharedMemorySize, LDS_BYTES) != hipSuccess) { fprintf(stderr, "kernel_launch: hipFuncSetAttribute failed\n"); grid = -1; return; }
        if (hipOccupancyMaxActiveBlocksPerMultiprocessor(&per_cu, (const void*)fwd_kernel, NTHREADS, LDS_BYTES) != hipSuccess || per_cu < 1) { fprintf(stderr, "kernel_launch: occupancy query failed (%d)\n", per_cu); per_cu = 1; (void)hipGetLastError(); }
        if (per_cu > 2) per_cu = 2;
        grid = cus * per_cu;
        if (grid != 512) { fprintf(stderr, "kernel_launch: grid %d unsupported by phase G2 (needs 512 workgroups)\n", grid); grid = -1; return; }
        fprintf(stderr, "kernel_launch: grid %d (%d per CU), lds %d, ws need %zu have %zu\n", grid, per_cu, LDS_BYTES, (size_t)WS_END, ws_size);
    }
    if (grid < 0) return;
    hipMemsetAsync((char*)d_ws + WS_CTL, 0, CTL_BYTES, stream);
    Args a{};
    for (int i = 0; i < 22; ++i) a.in[i] = (const float*)d_in[i];
    a.out = (float*)d_out; a.ws = (unsigned char*)d_ws;
#if MK_PER_PHASE
    for (int ph = 0; ph < N_PHASES; ++ph) { a.ph_lo = ph; a.ph_hi = ph + 1; hipLaunchKernelGGL(fwd_kernel, dim3(grid), dim3(NTHREADS), LDS_BYTES, stream, a); }
#else
    a.ph_lo = 0; a.ph_hi = N_PHASES;
    void* kargs[] = {&a};
    hipError_t e = hipLaunchCooperativeKernel((const void*)fwd_kernel, dim3(grid), dim3(NTHREADS), kargs, LDS_BYTES, stream);
    if (e != hipSuccess) fprintf(stderr, "kernel_launch: cooperative launch failed: %s (grid %d)\n", hipGetErrorString(e), grid);
#endif
}
```

```cpp
#include <hip/hip_runtime.h>
#include <cstdio>
#include <cstdint>

#ifndef MK_PER_PHASE
#define MK_PER_PHASE 0
#endif

typedef unsigned short bf16;
typedef short bf16x8 __attribute__((ext_vector_type(8)));
typedef float f32x4 __attribute__((ext_vector_type(4)));
typedef unsigned u32x4 __attribute__((ext_vector_type(4)));
typedef unsigned u32x2 __attribute__((ext_vector_type(2)));
typedef __bf16 bf16x2 __attribute__((ext_vector_type(2)));

constexpr int NB = 8, SEQ = 2048, NMETA = 16, L = SEQ + NMETA, T = NB * L, D = 1024;
constexpr int DC = 512, CW = 31, NH = 8, QL = 256, KVL = 128, NOPE = 64, ROPE = 32, QK = 96, VD = 64;
constexpr int NIN = 3488, NINP = 3584;
constexpr int NEXP = 16384;
constexpr float EPS = 1e-6f;
constexpr int MT = T / 128;
static_assert(T % 128 == 0, "T tiles");

constexpr size_t al256(size_t x) { return (x + 255) & ~(size_t)255; }
constexpr size_t WS_CTL = 0;
constexpr size_t CTL_BYTES = 65536;
constexpr size_t WS_ROPE = WS_CTL + CTL_BYTES;
constexpr size_t WS_WIN = al256(WS_ROPE + (size_t)L * 16 * 8);
constexpr size_t SZ_WIN = (size_t)NINP * 1024 * 2, SZ_WCO = (size_t)1024 * 512 * 2, SZ_WUQ = (size_t)1024 * 256 * 2, SZ_WUKV = (size_t)1024 * 128 * 2,
                 SZ_WMLA = (size_t)1024 * 512 * 2, SZ_WOUT = (size_t)1024 * 1024 * 2, SZ_WPQ = (size_t)2048 * 1024 * 2, SZ_KEYS = (size_t)16 * 128 * 128 * 2;
constexpr size_t OFF_WCO = SZ_WIN, OFF_WUQ = OFF_WCO + SZ_WCO, OFF_WUKV = OFF_WUQ + SZ_WUQ, OFF_WMLA = OFF_WUKV + SZ_WUKV, OFF_WOUT = OFF_WMLA + SZ_WMLA,
                 OFF_WPQ = OFF_WOUT + SZ_WOUT, OFF_KEYS = OFF_WPQ + SZ_WPQ, SZ_WLAYER = OFF_KEYS + SZ_KEYS;
constexpr size_t WS_TAB = al256(WS_WIN + 2 * SZ_WLAYER);
constexpr size_t SZ_TAB = (size_t)NEXP * 1024;
constexpr float TAB_SCALE = 256.0f, TAB_INV = 1.0f / 256.0f;
constexpr float U_CLIP = 0.2f, U_SCALE = 127.0f / U_CLIP;
constexpr size_t WS_H = al256(WS_TAB + 4 * SZ_TAB);
constexpr size_t WS_HB = al256(WS_H + (size_t)T * 1024 * 4);
constexpr size_t WS_SSQ = al256(WS_HB + (size_t)T * 1024 * 2);
constexpr size_t WS_UGLU = al256(WS_SSQ + (size_t)T * 8 * 4);
constexpr size_t WS_CQ = al256(WS_UGLU + (size_t)T * 512 * 2);
constexpr size_t WS_CKV = al256(WS_CQ + (size_t)T * 256 * 2);
constexpr size_t WS_KROPE = al256(WS_CKV + (size_t)T * 128 * 2);
constexpr size_t WS_SSQQ = al256(WS_KROPE + (size_t)T * 32 * 4);
constexpr size_t WS_SSQKV = al256(WS_SSQQ + (size_t)T * 2 * 4);
constexpr size_t WS_U2 = al256(WS_SSQKV + (size_t)T * 4);
constexpr size_t WS_Q = al256(WS_U2 + (size_t)T * 512 * 2);
constexpr size_t WS_K = al256(WS_Q + (size_t)T * NH * QK * 2);
constexpr size_t WS_VT = al256(WS_K + (size_t)T * NH * QK * 2);
constexpr size_t WS_O = al256(WS_VT + (size_t)T * NH * VD * 2 + 4096);
constexpr size_t WS_MERGED = al256(WS_O + (size_t)T * 512 * 2);
constexpr size_t WS_GATES = al256(WS_MERGED + (size_t)T * 1024 * 2);
constexpr size_t WS_SV = WS_GATES;
constexpr size_t WS_SI = al256(WS_SV + (size_t)T * 256 * 4);
constexpr size_t WS_EIDX = al256(WS_SI + (size_t)T * 256);
constexpr size_t WS_GW = al256(WS_EIDX + (size_t)T * 128 * 4);
constexpr size_t WS_STB = al256(WS_GW + (size_t)T * 128 * 4);
constexpr size_t WS_PEER_END = WS_STB + (size_t)T * 16;
constexpr size_t WS_END = al256(WS_GATES + (size_t)T * 2048 * 2);
static_assert(WS_PEER_END <= WS_END, "peer scratch overlay");

constexpr int CW_BAR = 0;
constexpr int CW_QUEUE = 4096;

constexpr int LDS_MAIN = 128 * 132 * 4;
constexpr int LDS_MISC = LDS_MAIN;
constexpr int LDS_BYTES = LDS_MAIN + 64;

constexpr int NTHREADS = 256;

__device__ __forceinline__ unsigned pk2(float lo, float hi) { bf16x2 v; v.x = (__bf16)lo; v.y = (__bf16)hi; return __builtin_bit_cast(unsigned, v); }
__device__ __forceinline__ unsigned pack_i8x4(f32x4 v) {
    const int a = (int)__builtin_rintf(fminf(fmaxf(v.x, -127.f), 127.f)), b = (int)__builtin_rintf(fminf(fmaxf(v.y, -127.f), 127.f));
    const int c_ = (int)__builtin_rintf(fminf(fmaxf(v.z, -127.f), 127.f)), d = (int)__builtin_rintf(fminf(fmaxf(v.w, -127.f), 127.f));
    return (unsigned)(a & 255) | ((unsigned)(b & 255) << 8) | ((unsigned)(c_ & 255) << 16) | ((unsigned)(d & 255) << 24);
}
__device__ __forceinline__ float bf_lo(unsigned p) { return __uint_as_float(p << 16); }
__device__ __forceinline__ float bf_hi(unsigned p) { return __uint_as_float(p & 0xffff0000u); }
__device__ __forceinline__ float fast_rcp(float x) { return __builtin_amdgcn_rcpf(x); }
__device__ __forceinline__ float fast_exp2(float x) { return __builtin_amdgcn_exp2f(x); }
__device__ __forceinline__ float sigmoidf_(float x) { return fast_rcp(1.0f + fast_exp2(-1.4426950409f * x)); }
__device__ __forceinline__ float gelu_tanh(float x) { const float u = 1.5957691216f * (x + 0.044715f * x * x * x); return x * fast_rcp(1.0f + fast_exp2(-1.4426950409f * u)); }
__device__ __forceinline__ float rsqrt_(float x) { return __builtin_amdgcn_rsqf(x); }
template <int CTRL> __device__ __forceinline__ float dpp(float x) { return __builtin_bit_cast(float, __builtin_amdgcn_mov_dpp(__builtin_bit_cast(int, x), CTRL, 0xf, 0xf, true)); }
__device__ __forceinline__ float xrow16_sum(float x) {
    auto s = __builtin_amdgcn_permlane16_swap(__float_as_uint(x), __float_as_uint(x), false, false);
    x = __uint_as_float(s[0]) + __uint_as_float(s[1]);
    auto t = __builtin_amdgcn_permlane32_swap(__float_as_uint(x), __float_as_uint(x), false, false);
    return __uint_as_float(t[0]) + __uint_as_float(t[1]);
}
__device__ __forceinline__ float xrow16_max(float x) {
    auto s = __builtin_amdgcn_permlane16_swap(__float_as_uint(x), __float_as_uint(x), false, false);
    x = fmaxf(__uint_as_float(s[0]), __uint_as_float(s[1]));
    auto t = __builtin_amdgcn_permlane32_swap(__float_as_uint(x), __float_as_uint(x), false, false);
    return fmaxf(__uint_as_float(t[0]), __uint_as_float(t[1]));
}
__device__ __forceinline__ float wave_sum_dpp(float x) {
    x += dpp<0xB1>(x); x += dpp<0x4E>(x); x += dpp<0x141>(x); x += dpp<0x128>(x); return xrow16_sum(x);
}
__device__ __forceinline__ float quad_sum(float v) { return xrow16_sum(v); }
__device__ __forceinline__ float quad_max(float v) { return xrow16_max(v); }
__device__ __forceinline__ float wave_sum(float v) { return wave_sum_dpp(v); }
__device__ __forceinline__ float dot2(unsigned a, unsigned b, float c) { return __builtin_amdgcn_fdot2_f32_bf16(__builtin_bit_cast(bf16x2, a), __builtin_bit_cast(bf16x2, b), c, false); }

#define XB_TMO      128
#define XB_XCNT(j)  (256  + 64 * (j))
#define XB_XSUB(j)  (1280 + 64 * (j))
#define XB_XGEN(j)  (2304 + 64 * (j))
#define XB_TOP      3328
#define XB_TOPGEN   3392
#define XCD_BAR_WORDS 3456
#define XB_SPIN_CAP (1u << 20)
__device__ __forceinline__ unsigned xb_ld(unsigned* p)              { return __hip_atomic_load(p, __ATOMIC_RELAXED, __HIP_MEMORY_SCOPE_AGENT); }
__device__ __forceinline__ unsigned xb_add(unsigned* p, unsigned v) { return __hip_atomic_fetch_add(p, v, __ATOMIC_RELAXED, __HIP_MEMORY_SCOPE_AGENT); }
__device__ __forceinline__ unsigned xb_xcc_id() { return (unsigned)__builtin_amdgcn_s_getreg((3 << 11) | 20) & 0xFu; }
#define XB_SPIN(cond, bar) do { unsigned _sp = 0; while (cond) { __builtin_amdgcn_s_sleep(1); \
    if ((++_sp & 255u) == 0u) { if (xb_ld(&(bar)[XB_TMO])) break; if (_sp > XB_SPIN_CAP) { atomicAdd(&(bar)[XB_TMO], 1u); break; } } } } while (0)
struct XcdBarrier { unsigned* bar; unsigned x; volatile unsigned* st; };
__device__ __forceinline__ XcdBarrier xcd_barrier_post(unsigned* bar, volatile unsigned* st) {
    XcdBarrier b; b.bar = bar; b.x = xb_xcc_id(); b.st = st;
    if (threadIdx.x == 0) (void)xb_add(&bar[XB_XCNT(b.x)], 1u);
    return b;
}
__device__ __forceinline__ void xcd_barrier_complete(unsigned* bar, unsigned x, unsigned& nloc, unsigned& nx) {
    const unsigned G = gridDim.x * gridDim.y * gridDim.z;
    unsigned sum, cnt, mine, sp = 0u;
    for (;;) {
        sum = 0u; cnt = 0u; mine = 0u;
#pragma unroll
        for (unsigned j = 0; j < 16; ++j) { const unsigned c = xb_ld(&bar[XB_XCNT(j)]); sum += c; cnt += (c > 0u) ? 1u : 0u; mine = (j == x) ? c : mine; }
        if (sum == G) break;
        __builtin_amdgcn_s_sleep(1);
        if ((++sp & 255u) == 0u) { if (xb_ld(&bar[XB_TMO])) break; if (sp > XB_SPIN_CAP) { atomicAdd(&bar[XB_TMO], 1u); break; } }
    }
    nloc = mine > 0u ? mine : 1u; nx = cnt > 0u ? cnt : 1u;
}
__device__ __forceinline__ void xcd_barrier(const XcdBarrier& b) {
    asm volatile("s_waitcnt vmcnt(0)" ::: "memory");
    __syncthreads();
    if (threadIdx.x == 0) {
        unsigned* bar = b.bar;
        __builtin_amdgcn_s_waitcnt(0);
        unsigned nloc = b.st[0], nx = b.st[1];
        if (nloc == 0u) { xcd_barrier_complete(bar, b.x, nloc, nx); b.st[0] = nloc; b.st[1] = nx; }
        const unsigned old = xb_add(&bar[XB_XSUB(b.x)], 1u);
        const unsigned gen = old / nloc;
        if (old + 1u == (gen + 1u) * nloc) {
            __builtin_amdgcn_fence(__ATOMIC_RELEASE, "agent");
            asm volatile("s_waitcnt vmcnt(0)" ::: "memory");
            const unsigned og = xb_add(&bar[XB_TOP], 1u);
            const unsigned tg = og / nx;
            if (og + 1u == (tg + 1u) * nx) xb_add(&bar[XB_TOPGEN], 1u);
            else XB_SPIN(xb_ld(&bar[XB_TOPGEN]) == tg, bar);
            __builtin_amdgcn_fence(__ATOMIC_ACQUIRE, "agent");
            xb_add(&bar[XB_XGEN(b.x)], 1u);
            asm volatile("s_waitcnt vmcnt(0)" ::: "memory");
        } else {
            XB_SPIN(xb_ld(&bar[XB_XGEN(b.x)]) == gen, bar);
            __builtin_amdgcn_fence(__ATOMIC_ACQUIRE, "agent");
            asm volatile("s_waitcnt vmcnt(0)" ::: "memory");
        }
    }
    __syncthreads();
}

struct Ctx {
    const float* in[22]; float* out; unsigned char* ws;
    unsigned char* lds; int tid, lane, wave, G, vb;
};
#define WSP(T_, off) ((T_*)(c.ws + (off)))
__device__ __forceinline__ Ctx reopaque(const Ctx& c0) {
    Ctx c = c0; int t = c0.tid; asm volatile("" : "+v"(t)); c.tid = t; c.lane = t & 63; c.wave = __builtin_amdgcn_readfirstlane(t >> 6);
    int vb = c0.vb; asm volatile("" : "+s"(vb)); c.vb = vb; return c;
}

__device__ __forceinline__ int lds_off(int row, int chunk) { return row * 128 + ((chunk ^ (row & 7)) << 4); }

__device__ __forceinline__ void gemm_compute_stage(f32x4 (&acc)[2][8], const unsigned char* sA, const unsigned char* sB, int wave, int lane) {
    const int r = lane & 15, q = lane >> 4;
#pragma unroll
    for (int ks = 0; ks < 2; ++ks) {
        bf16x8 af[2], bfr[8];
#pragma unroll
        for (int mi = 0; mi < 2; ++mi) af[mi] = *(const bf16x8*)(sA + lds_off(32 * wave + 16 * mi + r, 4 * ks + q));
#pragma unroll
        for (int ni = 0; ni < 8; ++ni) bfr[ni] = *(const bf16x8*)(sB + lds_off(16 * ni + r, 4 * ks + q));
#pragma unroll
        for (int mi = 0; mi < 2; ++mi)
#pragma unroll
            for (int ni = 0; ni < 8; ++ni) acc[mi][ni] = __builtin_amdgcn_mfma_f32_16x16x32_bf16(bfr[ni], af[mi], acc[mi][ni], 0, 0, 0);
    }
}

#define LAS __attribute__((address_space(3)))
__device__ __forceinline__ void gemm_stage_glds(const bf16* A, int lda, const bf16* Bt, int ldb, int kt, unsigned char* stage, int wave, int lane) {
    const int rr = lane >> 3, cch = (lane & 7) ^ rr;
#pragma unroll
    for (int i = 0; i < 4; ++i) { const int pc = 4 * i + wave;
        __builtin_amdgcn_global_load_lds((const unsigned*)(A + (size_t)(8 * pc + rr) * lda + kt * 64 + cch * 8), (LAS unsigned*)(stage + pc * 1024), 16, 0, 0);
        __builtin_amdgcn_global_load_lds((const unsigned*)(Bt + (size_t)(8 * pc + rr) * ldb + kt * 64 + cch * 8), (LAS unsigned*)(stage + 16384 + pc * 1024), 16, 0, 0); }
}
__device__ __forceinline__ void gemm_core(f32x4 (&acc)[2][8], const bf16* A, int lda, const bf16* Bt, int ldb, int K, unsigned char* lds, int tid) {
    const int wave = __builtin_amdgcn_readfirstlane(tid >> 6), lane = tid & 63;
    const int nk = K >> 6;
    gemm_stage_glds(A, lda, Bt, ldb, 0, lds, wave, lane);
    asm volatile("s_waitcnt vmcnt(0)" ::: "memory");
    __syncthreads();
    for (int kt = 0; kt < nk; ++kt) {
        const int cur = kt & 1;
        if (kt + 1 < nk) gemm_stage_glds(A, lda, Bt, ldb, kt + 1, lds + (cur ^ 1) * 32768, wave, lane);
        gemm_compute_stage(acc, lds + cur * 32768, lds + cur * 32768 + 16384, wave, lane);
        asm volatile("s_waitcnt vmcnt(0)" ::: "memory");
        __syncthreads();
    }
}
__device__ __forceinline__ void acc_zero(f32x4 (&acc)[2][8]) {
#pragma unroll
    for (int mi = 0; mi < 2; ++mi)
#pragma unroll
        for (int ni = 0; ni < 8; ++ni) acc[mi][ni] = (f32x4){0.f, 0.f, 0.f, 0.f};
}
__device__ __forceinline__ float rstd_from_ssq8(const float* ssq, int tok) {
    const f32x4 a = *(const f32x4*)(ssq + (size_t)tok * 8), b = *(const f32x4*)(ssq + (size_t)tok * 8 + 4);
    const float s = ((a.x + a.y) + (a.z + a.w)) + ((b.x + b.y) + (b.z + b.w));
    return rsqrt_(s * (1.0f / 1024.0f) + EPS);
}

__device__ __forceinline__ int src_col(int mode, int np) {
    if (mode == 0) return np;
    if (mode == 2) { const int h = np >> 7, j = np & 127; return j < 96 ? h * 96 + j : -1; }
    if (np < 1024) { const int cblk = np >> 7, j = np & 127; return j < 64 ? 64 * cblk + j : 512 + 64 * cblk + (j - 64); }
    if (np < 1408) return np;
    if (np < 1536) { const int j = np - 1408; return j < 32 ? 1408 + j : -1; }
    return 1440 + (np - 1536);
}
__device__ __forceinline__ void p0_transpose_item(const float* W, int K, int N, bf16* Wt, int mode, const float* g, int item, float* scr, int lane) {
    const int nblk_k = K / 64, nb = item / nblk_k, kb = item % nblk_k, k0 = 64 * kb, n0 = 32 * nb;
    const int n = src_col(mode, n0 + (lane & 31));
    float wv[32], gv[32];
#pragma unroll
    for (int i = 0; i < 32; ++i) { const int kk = 2 * i + (lane >> 5); wv[i] = n >= 0 ? W[(size_t)(k0 + kk) * N + n] : 0.f; gv[i] = g ? g[k0 + kk] : 1.f; }
#pragma unroll
    for (int i = 0; i < 32; ++i) { const int kk = 2 * i + (lane >> 5); scr[kk * 33 + (lane & 31)] = wv[i] * gv[i]; }
    __builtin_amdgcn_s_waitcnt(0xC07F); asm volatile("" ::: "memory");
    const int cch = lane & 7;
#pragma unroll
    for (int j = 0; j < 4; ++j) { const int nl = (lane >> 3) + 8 * j; const float* s = scr + (8 * cch) * 33 + nl;
        u32x4 o; o.x = pk2(s[0 * 33], s[1 * 33]); o.y = pk2(s[2 * 33], s[3 * 33]); o.z = pk2(s[4 * 33], s[5 * 33]); o.w = pk2(s[6 * 33], s[7 * 33]);
        *(u32x4*)(Wt + (size_t)(n0 + nl) * K + k0 + 8 * cch) = o; }
    __builtin_amdgcn_s_waitcnt(0xC07F); asm volatile("" ::: "memory");
}
struct WDesc { int in_idx, K, N, Np, mode, g_idx; size_t off; };
__device__ __forceinline__ void phase_prologue(const Ctx& c0) {
    Ctx c = reopaque(c0);
    const int gw = c.vb * 4 + c.wave, NGW = c.G * 4;
    float* scr = (float*)(c.lds + c.wave * 8704);
    const WDesc wd[7] = {
        {3, 1024, NIN, NINP, 1, 2, 0}, {8, 512, 1024, 1024, 0, -1, OFF_WCO}, {10, 256, 768, 1024, 2, 9, OFF_WUQ}, {12, 128, 1024, 1024, 0, 11, OFF_WUKV},
        {15, 512, 1024, 1024, 0, -1, OFF_WMLA}, {16, 1024, 1024, 1024, 0, -1, OFF_WOUT}, {18, 1024, 2048, 2048, 0, 17, OFF_WPQ}};
    constexpr int ITEMS_PER_LAYER = (1024 / 64) * (NINP / 32) + (512 / 64) * 32 + (256 / 64) * 32 + (128 / 64) * 32 + (512 / 64) * 32 + (1024 / 64) * 32 + (1024 / 64) * 64;
    for (int it = gw; it < 2 * ITEMS_PER_LAYER; it += NGW) {
        const int l = it >= ITEMS_PER_LAYER ? 1 : 0; int r = it - l * ITEMS_PER_LAYER;
        const float* W = nullptr; const float* g = nullptr; bf16* Wt = nullptr; int K = 64, N = 32, mode = 0, rr = 0;
#pragma unroll
        for (int m = 0; m < 7; ++m) {
            const int items = (wd[m].K / 64) * (wd[m].Np / 32);
            if (r >= 0 && r < items) { K = wd[m].K; N = wd[m].N; mode = wd[m].mode; rr = r;
                W = c.in[wd[m].in_idx] + (size_t)l * wd[m].K * wd[m].N; g = wd[m].g_idx >= 0 ? c.in[wd[m].g_idx >= 0 ? wd[m].g_idx : 0] + (size_t)l * wd[m].K : nullptr;
                Wt = (bf16*)(c.ws + WS_WIN + l * SZ_WLAYER + wd[m].off); }
            r -= items;
        }
        p0_transpose_item(W, K, N, Wt, mode, g, rr, scr, c.lane);
    }
    const int gt = c.vb * NTHREADS + c.tid, NGT = c.G * NTHREADS;
    for (int l = 0; l < 2; ++l) {
        const float* src = c.in[19] + (size_t)l * 262144; bf16* dst = (bf16*)(c.ws + WS_WIN + l * SZ_WLAYER + OFF_KEYS);
        for (int i = gt; i < 262144 / 8; i += NGT) { const f32x4 a = *(const f32x4*)(src + i * 8), b = *(const f32x4*)(src + i * 8 + 4);
            u32x4 o; o.x = pk2(a.x, a.y); o.y = pk2(a.z, a.w); o.z = pk2(b.x, b.y); o.w = pk2(b.z, b.w); *(u32x4*)(dst + i * 8) = o; }
    }
    for (int l = 0; l < 2; ++l)
        for (int uv = 0; uv < 2; ++uv) {
            const float* src = c.in[20 + uv] + (size_t)l * NEXP * 1024; unsigned char* dst = c.ws + WS_TAB + (size_t)(l * 2 + uv) * SZ_TAB;
            f32x4 g4[4];
#pragma unroll
            for (int j = 0; j < 4; ++j) { const float sc = uv == 0 ? U_SCALE : TAB_SCALE; g4[j] = (f32x4){sc, sc, sc, sc}; if (uv == 0) g4[j] = g4[j] * *(const f32x4*)(c.in[17] + l * 1024 + 256 * j + 4 * c.lane); }
            for (int row = gw; row < NEXP; row += 2 * NGW) {
                const float* sp = src + (size_t)row * 1024 + 4 * c.lane; const int row2 = row + NGW; const bool two = row2 < NEXP;
                const float* sp2 = src + (size_t)(two ? row2 : row) * 1024 + 4 * c.lane;
                f32x4 a[4], b[4];
#pragma unroll
                for (int j = 0; j < 4; ++j) { a[j] = *(const f32x4*)(sp + 256 * j); b[j] = *(const f32x4*)(sp2 + 256 * j); }
#pragma unroll
                for (int j = 0; j < 4; ++j) { const f32x4 v = a[j] * g4[j];
                    *(unsigned*)(dst + (size_t)row * 1024 + 256 * j + 4 * c.lane) = uv == 0 ? pack_i8x4(v) : (unsigned)__builtin_amdgcn_cvt_pk_fp8_f32(v.z, v.w, __builtin_amdgcn_cvt_pk_fp8_f32(v.x, v.y, 0, false), true); }
                if (two) {
#pragma unroll
                    for (int j = 0; j < 4; ++j) { const f32x4 v = b[j] * g4[j];
                        *(unsigned*)(dst + (size_t)row2 * 1024 + 256 * j + 4 * c.lane) = uv == 0 ? pack_i8x4(v) : (unsigned)__builtin_amdgcn_cvt_pk_fp8_f32(v.z, v.w, __builtin_amdgcn_cvt_pk_fp8_f32(v.x, v.y, 0, false), true); } }
            }
        }
    { float* rope = WSP(float, WS_ROPE);
      for (int i = gt; i < L * 16; i += NGT) { const int pos = i >> 4, j = i & 15;
          const float inv = 1.0f / __builtin_exp2f((float)j * 0.8304820237218406f);
          const float angf = (float)pos * inv; const double ang = (double)angf;
          const double nq = __builtin_rint(ang * 0.63661977236758134308);
          double rr = __builtin_fma(-nq, 1.57079632679489655800e+00, ang); rr = __builtin_fma(-nq, 6.12323399573676603587e-17, rr);
          const double r2 = rr * rr;
          double sp = -1.0 / 1307674368000.0; sp = sp * r2 + 1.0 / 6227020800.0; sp = sp * r2 - 1.0 / 39916800.0; sp = sp * r2 + 1.0 / 362880.0; sp = sp * r2 - 1.0 / 5040.0; sp = sp * r2 + 1.0 / 120.0; sp = sp * r2 - 1.0 / 6.0; sp = sp * r2 * rr + rr;
          double cp = 1.0 / 87178291200.0; cp = cp * r2 - 1.0 / 479001600.0; cp = cp * r2 + 1.0 / 3628800.0; cp = cp * r2 - 1.0 / 40320.0; cp = cp * r2 + 1.0 / 720.0; cp = cp * r2 - 1.0 / 24.0; cp = cp * r2 + 0.5; cp = 1.0 - cp * r2;
          const int qd = ((int)nq) & 3;
          const double cv = qd == 0 ? cp : qd == 1 ? -sp : qd == 2 ? -cp : sp;
          const double sv_ = qd == 0 ? sp : qd == 1 ? cp : qd == 2 ? -sp : -cp;
          rope[2 * i] = (float)cv; rope[2 * i + 1] = (float)sv_; } }
    { bf16* hb = WSP(bf16, WS_HB); float* ssq = WSP(float, WS_SSQ);
      for (int t0_ = gw; t0_ < T; t0_ += 4 * NGW) {
          f32x4 v[4][4];
#pragma unroll
          for (int i = 0; i < 4; ++i) { const int t = t0_ + i * NGW < T ? t0_ + i * NGW : t0_; const int b = t / L, pos = t % L;
              const float* src = pos < NMETA ? c.in[1] + (size_t)pos * D : c.in[0] + ((size_t)b * SEQ + (pos - NMETA)) * D;
#pragma unroll
              for (int j = 0; j < 4; ++j) v[i][j] = *(const f32x4*)(src + j * 256 + c.lane * 4); }
#pragma unroll
          for (int i = 0; i < 4; ++i) { const int t = t0_ + i * NGW;
              if (t < T) { float s = 0.f;
#pragma unroll
                  for (int j = 0; j < 4; ++j) { const f32x4 x = v[i][j]; u32x2 o; o.x = pk2(x.x, x.y); o.y = pk2(x.z, x.w); *(u32x2*)(hb + (size_t)t * D + j * 256 + c.lane * 4) = o;
                      s += (x.x * x.x + x.y * x.y) + (x.z * x.z + x.w * x.w); }
                  s = wave_sum(s);
                  if (c.lane < 8) ssq[(size_t)t * 8 + c.lane] = c.lane == 0 ? s : 0.f; } }
      } }
}

__device__ __forceinline__ void phase_A(const Ctx& c0, int l) {
    Ctx c = reopaque(c0);
    const bf16* hb = WSP(bf16, WS_HB); const bf16* Wt = (const bf16*)(c.ws + WS_WIN + l * SZ_WLAYER);
    const float* ssq = WSP(float, WS_SSQ);
    bf16* uglu = WSP(bf16, WS_UGLU); bf16* cq = WSP(bf16, WS_CQ); bf16* ckv = WSP(bf16, WS_CKV); float* krope = WSP(float, WS_KROPE);
    float* ssqq = WSP(float, WS_SSQQ); float* ssqkv = WSP(float, WS_SSQKV); bf16* gates = WSP(bf16, WS_GATES);
    constexpr int NT = NINP / 128;
    const int r = c.lane & 15, q = c.lane >> 4;
    const int xcd = c.vb / (c.G / 8), lb = c.vb % (c.G / 8), xm = xcd & 1, xn = xcd >> 1;
    const int m_lo = xm ? (MT + 1) / 2 : 0, m_cnt = xm ? MT / 2 : (MT + 1) / 2;
    for (int j = lb; j < m_cnt * 7; j += c.G / 8) {
        const int mt = m_lo + j / 7, nt = xn * 7 + j % 7;
        f32x4 acc[2][8]; acc_zero(acc);
        gemm_core(acc, hb + (size_t)mt * 128 * D, D, Wt + (size_t)nt * 128 * D, D, D, c.lds, c.tid);
#pragma unroll
        for (int mi = 0; mi < 2; ++mi) {
            const int tok = mt * 128 + 32 * c.wave + 16 * mi + r;
            const float rs = rstd_from_ssq8(ssq, tok);
            if (nt < 8) {
#pragma unroll
                for (int ni = 0; ni < 4; ++ni) { const f32x4 v = acc[mi][ni] * rs, g = acc[mi][ni + 4] * rs;
                    u32x2 o; o.x = pk2(v.x * sigmoidf_(g.x), v.y * sigmoidf_(g.y)); o.y = pk2(v.z * sigmoidf_(g.z), v.w * sigmoidf_(g.w));
                    *(u32x2*)(uglu + (size_t)tok * DC + nt * 64 + 16 * ni + 4 * q) = o; }
            } else if (nt < 11) {
                bf16* dst = nt < 10 ? cq + (size_t)tok * QL + (nt - 8) * 128 : ckv + (size_t)tok * KVL;
                float ss = 0.f;
#pragma unroll
                for (int ni = 0; ni < 8; ++ni) { const f32x4 v = acc[mi][ni] * rs; ss += (v.x * v.x + v.y * v.y) + (v.z * v.z + v.w * v.w);
                    u32x2 o; o.x = pk2(v.x, v.y); o.y = pk2(v.z, v.w); *(u32x2*)(dst + 16 * ni + 4 * q) = o; }
                ss = quad_sum(ss);
                if (q == 0) { if (nt < 10) ssqq[(size_t)tok * 2 + (nt - 8)] = ss; else ssqkv[tok] = ss; }
            } else if (nt == 11) {
#pragma unroll
                for (int ni = 0; ni < 2; ++ni) *(f32x4*)(krope + (size_t)tok * 32 + 16 * ni + 4 * q) = acc[mi][ni] * rs;
            } else {
#pragma unroll
                for (int ni = 0; ni < 8; ++ni) { const f32x4 v = acc[mi][ni] * rs;
                    u32x2 o; o.x = pk2(sigmoidf_(v.x), sigmoidf_(v.y)); o.y = pk2(sigmoidf_(v.z), sigmoidf_(v.w));
                    *(u32x2*)(gates + (size_t)tok * 2048 + (nt - 12) * 128 + 16 * ni + 4 * q) = o; }
            }
        }
    }
}

__device__ __forceinline__ void phaseB_q_item(Ctx& c, int l, int mt, int head) {
    const bf16* cq = WSP(bf16, WS_CQ); const bf16* Wt = (const bf16*)(c.ws + WS_WIN + l * SZ_WLAYER + OFF_WUQ);
    const float* ssqq = WSP(float, WS_SSQQ); const float* rope = WSP(float, WS_ROPE); const float* qg = c.in[13] + l * QK; bf16* Qb = WSP(bf16, WS_Q);
    const int r = c.lane & 15, q = c.lane >> 4;
    f32x4 acc[2][8]; acc_zero(acc);
    gemm_core(acc, cq + (size_t)mt * 128 * QL, QL, Wt + (size_t)head * 128 * QL, QL, QL, c.lds, c.tid);
    constexpr float QSCALE = 0.10206207261596575f * 1.4426950408889634f;
#pragma unroll
    for (int mi = 0; mi < 2; ++mi) {
        const int tok = mt * 128 + 32 * c.wave + 16 * mi + r, b = tok / L, pos = tok - b * L;
        const float rs = rsqrt_((ssqq[(size_t)tok * 2] + ssqq[(size_t)tok * 2 + 1]) * (1.0f / 256.0f) + EPS);
        float ss = 0.f;
#pragma unroll
        for (int ni = 0; ni < 6; ++ni) { acc[mi][ni] = acc[mi][ni] * rs; const f32x4 v = acc[mi][ni]; ss += (v.x * v.x + v.y * v.y) + (v.z * v.z + v.w * v.w); }
        ss = quad_sum(ss);
        const float rn = rsqrt_(ss * (1.0f / 96.0f) + EPS) * QSCALE;
#pragma unroll
        for (int ni = 0; ni < 6; ++ni) { const f32x4 g = *(const f32x4*)(qg + 16 * ni + 4 * q); acc[mi][ni] = acc[mi][ni] * g * rn; }
        const f32x4 cs0 = *(const f32x4*)(rope + ((size_t)pos * 16 + 4 * q) * 2), cs1 = *(const f32x4*)(rope + ((size_t)pos * 16 + 4 * q) * 2 + 4);
        const float co[4] = {cs0.x, cs0.z, cs1.x, cs1.z}, si[4] = {cs0.y, cs0.w, cs1.y, cs1.w};
        f32x4 x1 = acc[mi][4], x2 = acc[mi][5];
#pragma unroll
        for (int e = 0; e < 4; ++e) { const float a = x1[e], bb = x2[e]; x1[e] = a * co[e] - bb * si[e]; x2[e] = bb * co[e] + a * si[e]; }
        acc[mi][4] = x1; acc[mi][5] = x2;
        bf16* dst = Qb + (((size_t)b * NH + head) * L + pos) * QK;
#pragma unroll
        for (int ni = 0; ni < 6; ++ni) { const f32x4 v = acc[mi][ni]; u32x2 o; o.x = pk2(v.x, v.y); o.y = pk2(v.z, v.w); *(u32x2*)(dst + 16 * ni + 4 * q) = o; }
    }
}
__device__ __forceinline__ void phaseB_kv_item(Ctx& c, int l, int mt, int head) {
    const bf16* ckv = WSP(bf16, WS_CKV); const bf16* Wt = (const bf16*)(c.ws + WS_WIN + l * SZ_WLAYER + OFF_WUKV);
    const float* ssqkv = WSP(float, WS_SSQKV); const float* rope = WSP(float, WS_ROPE); const float* kg = c.in[14] + l * QK; const float* krope = WSP(float, WS_KROPE);
    bf16* Kb = WSP(bf16, WS_K); bf16* Vt = WSP(bf16, WS_VT);
    const int tid = c.tid, wave = c.wave, lane = c.lane, r = lane & 15, q = lane >> 4;
    unsigned char* lds = c.lds;
    f32x4 ak[2][4], av[2][4];
#pragma unroll
    for (int mi = 0; mi < 2; ++mi)
#pragma unroll
        for (int ni = 0; ni < 4; ++ni) { ak[mi][ni] = (f32x4){0.f, 0.f, 0.f, 0.f}; av[mi][ni] = (f32x4){0.f, 0.f, 0.f, 0.f}; }
    { const int chunk = tid & 7, row0 = tid >> 3;
      const bf16* pa = ckv + ((size_t)mt * 128 + row0) * KVL + chunk * 8; const bf16* pb = Wt + ((size_t)head * 128 + row0) * KVL + chunk * 8;
#pragma unroll
      for (int s = 0; s < 2; ++s)
#pragma unroll
          for (int i = 0; i < 4; ++i) { *(u32x4*)(lds + s * 32768 + lds_off(row0 + 32 * i, chunk)) = *(const u32x4*)(pa + (size_t)(32 * i) * KVL + s * 64);
              *(u32x4*)(lds + s * 32768 + 16384 + lds_off(row0 + 32 * i, chunk)) = *(const u32x4*)(pb + (size_t)(32 * i) * KVL + s * 64); }
    }
    __syncthreads();
#pragma unroll
    for (int s = 0; s < 2; ++s)
#pragma unroll
        for (int ks = 0; ks < 2; ++ks) {
            const unsigned char* sA = lds + s * 32768; const unsigned char* sB = sA + 16384;
            bf16x8 af[2], bfr[8];
#pragma unroll
            for (int mi = 0; mi < 2; ++mi) af[mi] = *(const bf16x8*)(sA + lds_off(32 * wave + 16 * mi + r, 4 * ks + q));
#pragma unroll
            for (int ni = 0; ni < 8; ++ni) bfr[ni] = *(const bf16x8*)(sB + lds_off(16 * ni + r, 4 * ks + q));
#pragma unroll
            for (int mi = 0; mi < 2; ++mi)
#pragma unroll
                for (int ni = 0; ni < 4; ++ni) { ak[mi][ni] = __builtin_amdgcn_mfma_f32_16x16x32_bf16(bfr[ni], af[mi], ak[mi][ni], 0, 0, 0);
                    av[mi][ni] = __builtin_amdgcn_mfma_f32_16x16x32_bf16(af[mi], bfr[ni + 4], av[mi][ni], 0, 0, 0); }
        }
    __syncthreads();
#pragma unroll
    for (int mi = 0; mi < 2; ++mi) {
        const int tok0 = mt * 128 + 32 * wave + 16 * mi, b = tok0 / L, pos0 = tok0 - b * L;
        { const int tok = tok0 + r, pos = pos0 + r;
          const float rs = rsqrt_(ssqkv[tok] * (1.0f / 128.0f) + EPS);
          const f32x4 kr1 = *(const f32x4*)(krope + (size_t)tok * 32 + 4 * q), kr2 = *(const f32x4*)(krope + (size_t)tok * 32 + 16 + 4 * q);
          float ss = (kr1.x * kr1.x + kr1.y * kr1.y) + (kr1.z * kr1.z + kr1.w * kr1.w) + (kr2.x * kr2.x + kr2.y * kr2.y) + (kr2.z * kr2.z + kr2.w * kr2.w);
#pragma unroll
          for (int ni = 0; ni < 4; ++ni) { ak[mi][ni] = ak[mi][ni] * rs; const f32x4 v = ak[mi][ni]; ss += (v.x * v.x + v.y * v.y) + (v.z * v.z + v.w * v.w); }
          ss = quad_sum(ss);
          const float rn = rsqrt_(ss * (1.0f / 96.0f) + EPS);
          bf16* dst = Kb + (((size_t)b * NH + head) * L + pos) * QK;
#pragma unroll
          for (int ni = 0; ni < 4; ++ni) { const f32x4 g = *(const f32x4*)(kg + 16 * ni + 4 * q); const f32x4 v = ak[mi][ni] * g * rn;
              u32x2 o; o.x = pk2(v.x, v.y); o.y = pk2(v.z, v.w); *(u32x2*)(dst + 16 * ni + 4 * q) = o; }
          const f32x4 g1 = *(const f32x4*)(kg + 64 + 4 * q), g2 = *(const f32x4*)(kg + 80 + 4 * q);
          f32x4 x1 = kr1 * g1 * rn, x2 = kr2 * g2 * rn;
          const f32x4 cs0 = *(const f32x4*)(rope + ((size_t)pos * 16 + 4 * q) * 2), cs1 = *(const f32x4*)(rope + ((size_t)pos * 16 + 4 * q) * 2 + 4);
          const float co[4] = {cs0.x, cs0.z, cs1.x, cs1.z}, si[4] = {cs0.y, cs0.w, cs1.y, cs1.w};
#pragma unroll
          for (int e = 0; e < 4; ++e) { const float a = x1[e], bb = x2[e]; x1[e] = a * co[e] - bb * si[e]; x2[e] = bb * co[e] + a * si[e]; }
          u32x2 o1, o2; o1.x = pk2(x1.x, x1.y); o1.y = pk2(x1.z, x1.w); o2.x = pk2(x2.x, x2.y); o2.y = pk2(x2.z, x2.w);
          *(u32x2*)(dst + 64 + 4 * q) = o1; *(u32x2*)(dst + 80 + 4 * q) = o2; }
        { const f32x4 sq = *(const f32x4*)(ssqkv + tok0 + 4 * q);
          f32x4 rs4; rs4.x = rsqrt_(sq.x * (1.0f / 128.0f) + EPS); rs4.y = rsqrt_(sq.y * (1.0f / 128.0f) + EPS); rs4.z = rsqrt_(sq.z * (1.0f / 128.0f) + EPS); rs4.w = rsqrt_(sq.w * (1.0f / 128.0f) + EPS);
#pragma unroll
          for (int ni = 0; ni < 4; ++ni) { const f32x4 v = av[mi][ni] * rs4; u32x2 o; o.x = pk2(v.x, v.y); o.y = pk2(v.z, v.w);
              *(u32x2*)(Vt + (((size_t)b * NH + head) * VD + 16 * ni + r) * L + pos0 + 4 * q) = o; } }
    }
}
__device__ __forceinline__ u32x4 conv_row(const bf16* uglu, int b, int pos, int ch) {
    u32x4 xv = (u32x4){0u, 0u, 0u, 0u};
    if (pos >= 0) xv = *(const u32x4*)(uglu + ((size_t)b * L + pos) * DC + ch);
    return xv;
}
__device__ __forceinline__ void conv_fma(float (&a)[8], const u32x4 xv, const f32x4 w0, const f32x4 w1) {
    a[0] += bf_lo(xv.x) * w0.x; a[1] += bf_hi(xv.x) * w0.y; a[2] += bf_lo(xv.y) * w0.z; a[3] += bf_hi(xv.y) * w0.w;
    a[4] += bf_lo(xv.z) * w1.x; a[5] += bf_hi(xv.z) * w1.y; a[6] += bf_lo(xv.w) * w1.z; a[7] += bf_hi(xv.w) * w1.w;
}
__device__ __forceinline__ void phaseB_conv_item(Ctx& c, int l, int grp) {
    const bf16* uglu = WSP(bf16, WS_UGLU); bf16* u2 = WSP(bf16, WS_U2);
    const float* cw = c.in[4] + (size_t)l * CW * DC; const float* cb = c.in[5] + l * DC; const float* lg = c.in[6] + l * DC; const float* lb = c.in[7] + l * DC;
    const int tok0 = grp * 4, b = tok0 / L, pos0 = tok0 - b * L, ch = c.lane * 8;
    float acc[4][8];
    { const f32x4 b0 = *(const f32x4*)(cb + ch), b1 = *(const f32x4*)(cb + ch + 4);
#pragma unroll
      for (int d = 0; d < 4; ++d) { acc[d][0] = b0.x; acc[d][1] = b0.y; acc[d][2] = b0.z; acc[d][3] = b0.w; acc[d][4] = b1.x; acc[d][5] = b1.y; acc[d][6] = b1.z; acc[d][7] = b1.w; } }
    const int base = pos0 - 30;
    u32x4 x0 = conv_row(uglu, b, base + 0, ch), x1 = conv_row(uglu, b, base + 1, ch), x2 = conv_row(uglu, b, base + 2, ch),
          x3 = conv_row(uglu, b, base + 3, ch), x4 = conv_row(uglu, b, base + 4, ch), x5;
    const float* wp = cw + ch;
#pragma unroll 1
    for (int w = 0; w < CW; ++w) {
        x5 = conv_row(uglu, b, (w + 5 <= 33) ? base + w + 5 : -1, ch);
        const f32x4 w0 = *(const f32x4*)wp, w1 = *(const f32x4*)(wp + 4); wp += DC;
        conv_fma(acc[0], x0, w0, w1); conv_fma(acc[1], x1, w0, w1); conv_fma(acc[2], x2, w0, w1); conv_fma(acc[3], x3, w0, w1);
        x0 = x1; x1 = x2; x2 = x3; x3 = x4; x4 = x5;
    }
    const f32x4 g0 = *(const f32x4*)(lg + ch), g1 = *(const f32x4*)(lg + ch + 4), e0 = *(const f32x4*)(lb + ch), e1 = *(const f32x4*)(lb + ch + 4);
    const float gg[8] = {g0.x, g0.y, g0.z, g0.w, g1.x, g1.y, g1.z, g1.w}, be[8] = {e0.x, e0.y, e0.z, e0.w, e1.x, e1.y, e1.z, e1.w};
#pragma unroll
    for (int d = 0; d < 4; ++d) {
        float s = 0.f;
#pragma unroll
        for (int j = 0; j < 8; ++j) s += acc[d][j];
        const float mu = wave_sum(s) * (1.0f / 512.0f);
        float vq = 0.f;
#pragma unroll
        for (int j = 0; j < 8; ++j) { acc[d][j] -= mu; vq += acc[d][j] * acc[d][j]; }
        const float rstd = rsqrt_(wave_sum(vq) * (1.0f / 512.0f) + EPS);
        float y[8];
#pragma unroll
        for (int j = 0; j < 8; ++j) { const float v = acc[d][j] * rstd * gg[j] + be[j]; y[j] = v * sigmoidf_(v); }
        u32x4 o; o.x = pk2(y[0], y[1]); o.y = pk2(y[2], y[3]); o.z = pk2(y[4], y[5]); o.w = pk2(y[6], y[7]);
        *(u32x4*)(u2 + (size_t)(tok0 + d) * DC + ch) = o;
    }
}
__device__ __forceinline__ void phase_B(const Ctx& c0, int l) {
    Ctx c = reopaque(c0);
    constexpr int NQ = MT * NH, NKV = MT * NH, NCV = T / 16;
    for (int it = c.vb; it < NQ + NKV + NCV; it += c.G) {
        if (it < NQ) phaseB_q_item(c, l, it / NH, it % NH);
        else if (it < NQ + NKV) phaseB_kv_item(c, l, (it - NQ) / NH, (it - NQ) % NH);
        else phaseB_conv_item(c, l, (it - NQ - NKV) * 4 + c.wave);
    }
}

constexpr int KROW = 208, VROW = 136, ATT_STAGE = 64 * KROW + 64 * VROW;
constexpr int ATT_ITEMS = NB * NH * 17;
__device__ __forceinline__ void phase_C(const Ctx& c0, int l) {
    Ctx c = reopaque(c0);
    const bf16* Qb = WSP(bf16, WS_Q); const bf16* Kb = WSP(bf16, WS_K); const bf16* Vt = WSP(bf16, WS_VT); bf16* O = WSP(bf16, WS_O);
    unsigned* qctr = WSP(unsigned, WS_CTL) + CW_QUEUE + 64 * l;
    volatile unsigned* misc = (volatile unsigned*)(c.lds + LDS_MISC);
    const int tid = c.tid, wave = c.wave, lane = c.lane, r = lane & 15, q = lane >> 4;
    unsigned char* lds = c.lds;
    for (;;) {
        if (tid == 0) misc[4] = atomicAdd(qctr, 1u);
        __syncthreads();
        const int item = __builtin_amdgcn_readfirstlane((int)misc[4]);
        __syncthreads();
        if (item >= ATT_ITEMS) break;
        const int pp = 15 - item / 64, bh = item % 64, b = bh / NH, h = bh % NH;
        const bool meta = pp < 0;
        const int r0 = meta ? 0 : 16 + 128 * pp;
        const int nfull = meta ? 0 : 2 * pp + 1 + (wave >> 1);
        const int ntiles = meta ? 1 : 2 * pp + 3;
        const bf16* Kbase = Kb + (size_t)bh * L * QK; const bf16* Vbase = Vt + (size_t)bh * VD * L;
        bf16x8 qf[2][3];
#pragma unroll
        for (int mi = 0; mi < 2; ++mi)
#pragma unroll
            for (int ks = 0; ks < 3; ++ks) qf[mi][ks] = *(const bf16x8*)(Qb + ((size_t)bh * L + r0 + 32 * wave + 16 * mi + r) * QK + 32 * ks + 8 * q);
        float m[2] = {-1e30f, -1e30f}, lsum[2] = {0.f, 0.f};
        f32x4 o[2][4];
#pragma unroll
        for (int mi = 0; mi < 2; ++mi)
#pragma unroll
            for (int dt = 0; dt < 4; ++dt) o[mi][dt] = (f32x4){0.f, 0.f, 0.f, 0.f};
        u32x4 rk[3], rv[2];
        auto gload = [&](int kt) {
#pragma unroll
            for (int i = 0; i < 3; ++i) { const int id = tid + 256 * i, row = id / 12, cc = id % 12; rk[i] = *(const u32x4*)(Kbase + (size_t)(kt * 64 + row) * QK + cc * 8); }
#pragma unroll
            for (int i = 0; i < 2; ++i) { const int id = tid + 256 * i, row = id >> 3, cc = id & 7; rv[i] = *(const u32x4*)(Vbase + (size_t)row * L + kt * 64 + cc * 8); }
        };
        auto lstore = [&](int s) {
            unsigned char* st = lds + s * ATT_STAGE;
#pragma unroll
            for (int i = 0; i < 3; ++i) { const int id = tid + 256 * i, row = id / 12, cc = id % 12; *(u32x4*)(st + row * KROW + cc * 16) = rk[i]; }
#pragma unroll
            for (int i = 0; i < 2; ++i) { const int id = tid + 256 * i, row = id >> 3, cc = id & 7; u32x2* d = (u32x2*)(st + 64 * KROW + row * VROW + cc * 16); d[0] = (u32x2){rv[i].x, rv[i].y}; d[1] = (u32x2){rv[i].z, rv[i].w}; }
        };
        gload(0); lstore(0);
#pragma unroll
        for (int mi = 0; mi < 2; ++mi)
#pragma unroll
            for (int ks = 0; ks < 3; ++ks) asm volatile("" : "+v"(qf[mi][ks]));
        __syncthreads();
        for (int kt = 0; kt < ntiles; ++kt) {
            const int cur = kt & 1;
            if (kt + 1 < ntiles) gload(kt + 1);
            const unsigned char* sK = lds + cur * ATT_STAGE; const unsigned char* sV = sK + 64 * KROW;
            const bool full = kt < nfull;
            if (kt <= nfull) {
                f32x4 s[2][4];
#pragma unroll
                for (int kh = 0; kh < 2; ++kh) {
                    bf16x8 kf[2][3];
#pragma unroll
                    for (int kk = 0; kk < 2; ++kk) if ((kh == 0 && kk == 0) || full) {
#pragma unroll
                        for (int ks = 0; ks < 3; ++ks) kf[kk][ks] = *(const bf16x8*)(sK + (16 * (2 * kh + kk) + r) * KROW + 64 * ks + 16 * q); }
#pragma unroll
                    for (int kk = 0; kk < 2; ++kk) { const int k4 = 2 * kh + kk;
#pragma unroll
                        for (int mi = 0; mi < 2; ++mi) s[mi][k4] = (f32x4){0.f, 0.f, 0.f, 0.f};
                        if (k4 == 0 || full) {
#pragma unroll
                            for (int ks = 0; ks < 3; ++ks)
#pragma unroll
                                for (int mi = 0; mi < 2; ++mi) s[mi][k4] = __builtin_amdgcn_mfma_f32_16x16x32_bf16(kf[kk][ks], qf[mi][ks], s[mi][k4], 0, 0, 0);
                        }
                    }
                }
                u32x2 vlo[4], vhi[4];
#pragma unroll
                for (int dt = 0; dt < 4; ++dt) { const unsigned char* vp = sV + (16 * dt + r) * VROW + (4 * q) * 2;
                    vlo[dt] = *(const u32x2*)vp; vhi[dt] = (u32x2){0u, 0u}; if (full) vhi[dt] = *(const u32x2*)(vp + 32); }
                bf16x8 pf[2][2];
#pragma unroll
                for (int mi = 0; mi < 2; ++mi) {
                    float mx = fmaxf(fmaxf(s[mi][0].x, s[mi][0].y), fmaxf(s[mi][0].z, s[mi][0].w));
                    if (full) {
#pragma unroll
                        for (int k4 = 1; k4 < 4; ++k4) mx = fmaxf(mx, fmaxf(fmaxf(s[mi][k4].x, s[mi][k4].y), fmaxf(s[mi][k4].z, s[mi][k4].w)));
                    }
                    mx = quad_max(mx);
                    const float mn = fmaxf(m[mi], mx), alpha = fast_exp2(m[mi] - mn); m[mi] = mn;
                    float ps = 0.f;
#pragma unroll
                    for (int k4 = 0; k4 < 4; ++k4) {
                        if (k4 == 0 || full) { f32x4 p; p.x = fast_exp2(s[mi][k4].x - mn); p.y = fast_exp2(s[mi][k4].y - mn); p.z = fast_exp2(s[mi][k4].z - mn); p.w = fast_exp2(s[mi][k4].w - mn);
                            ps += (p.x + p.y) + (p.z + p.w); s[mi][k4] = p; }
                    }
                    lsum[mi] = lsum[mi] * alpha + ps;
#pragma unroll
                    for (int dt = 0; dt < 4; ++dt) o[mi][dt] = o[mi][dt] * alpha;
#pragma unroll
                    for (int st = 0; st < 2; ++st) { u32x4 pw;
                        pw.x = pk2(s[mi][2 * st].x, s[mi][2 * st].y); pw.y = pk2(s[mi][2 * st].z, s[mi][2 * st].w); pw.z = pk2(s[mi][2 * st + 1].x, s[mi][2 * st + 1].y); pw.w = pk2(s[mi][2 * st + 1].z, s[mi][2 * st + 1].w);
                        if (!full) { pw.z = 0u; pw.w = 0u; }
                        pf[mi][st] = __builtin_bit_cast(bf16x8, pw); }
                }
                u32x2 wlo[4], whi[4];
                if (full) {
#pragma unroll
                    for (int dt = 0; dt < 4; ++dt) { const unsigned char* vp = sV + (16 * dt + r) * VROW + (32 + 4 * q) * 2; wlo[dt] = *(const u32x2*)vp; whi[dt] = *(const u32x2*)(vp + 32); } }
#pragma unroll
                for (int dt = 0; dt < 4; ++dt) { const bf16x8 vf = __builtin_bit_cast(bf16x8, (u32x4){vlo[dt].x, vlo[dt].y, vhi[dt].x, vhi[dt].y});
#pragma unroll
                    for (int mi = 0; mi < 2; ++mi) o[mi][dt] = __builtin_amdgcn_mfma_f32_16x16x32_bf16(vf, pf[mi][0], o[mi][dt], 0, 0, 0); }
                if (full) {
#pragma unroll
                    for (int dt = 0; dt < 4; ++dt) { const bf16x8 vf = __builtin_bit_cast(bf16x8, (u32x4){wlo[dt].x, wlo[dt].y, whi[dt].x, whi[dt].y});
#pragma unroll
                        for (int mi = 0; mi < 2; ++mi) o[mi][dt] = __builtin_amdgcn_mfma_f32_16x16x32_bf16(vf, pf[mi][1], o[mi][dt], 0, 0, 0); } }
            }
            if (kt + 1 < ntiles) lstore(cur ^ 1);
            __syncthreads();
        }
#pragma unroll
        for (int mi = 0; mi < 2; ++mi) {
            const float lt = quad_sum(lsum[mi]);
            if (!meta || (wave == 0 && mi == 0)) {
                const float inv = 1.0f / lt;
                bf16* dst = O + ((size_t)b * L + r0 + 32 * wave + 16 * mi + r) * 512 + h * VD;
#pragma unroll
                for (int dt = 0; dt < 4; ++dt) { const f32x4 v = o[mi][dt] * inv; u32x2 ov; ov.x = pk2(v.x, v.y); ov.y = pk2(v.z, v.w); *(u32x2*)(dst + 16 * dt + 4 * q) = ov; }
            }
        }
    }
}

__device__ __forceinline__ int tile_tok0(int mt, int l) { return l == 1 ? mt * 128 + NMETA * ((mt >> 4) + 1) : mt * 128; }
__device__ __forceinline__ int n_mtiles(int l) { return l == 1 ? 128 : MT; }
__device__ __forceinline__ void phase_D(const Ctx& c0, int l) {
    Ctx c = reopaque(c0);
    const bf16* u2 = WSP(bf16, WS_U2); const bf16* O = WSP(bf16, WS_O); const bf16* gates = WSP(bf16, WS_GATES); bf16* merged = WSP(bf16, WS_MERGED);
    const bf16* Wco = (const bf16*)(c.ws + WS_WIN + l * SZ_WLAYER + OFF_WCO); const bf16* Wmla = (const bf16*)(c.ws + WS_WIN + l * SZ_WLAYER + OFF_WMLA);
    const int r = c.lane & 15, q = c.lane >> 4;
    for (int it = c.vb; it < n_mtiles(l) * 8; it += c.G) {
        const int mt = it / 8, nt = it % 8, tk0 = tile_tok0(mt, l);
        f32x4 acc[2][8]; acc_zero(acc);
        gemm_core(acc, u2 + (size_t)tk0 * 512, 512, Wco + (size_t)nt * 128 * 512, 512, 512, c.lds, c.tid);
#pragma unroll
        for (int mi = 0; mi < 2; ++mi) { const int tok = tk0 + 32 * c.wave + 16 * mi + r;
            const bf16* gp = gates + (size_t)tok * 2048 + nt * 128 + 4 * q; bf16* mp = merged + (size_t)tok * D + nt * 128 + 4 * q;
#pragma unroll
            for (int ni = 0; ni < 8; ++ni) { const u32x2 g = *(const u32x2*)(gp + 16 * ni); const f32x4 v = acc[mi][ni];
                u32x2 o; o.x = pk2(v.x * bf_lo(g.x), v.y * bf_hi(g.x)); o.y = pk2(v.z * bf_lo(g.y), v.w * bf_hi(g.y)); *(u32x2*)(mp + 16 * ni) = o; } }
        acc_zero(acc);
        gemm_core(acc, O + (size_t)tk0 * 512, 512, Wmla + (size_t)nt * 128 * 512, 512, 512, c.lds, c.tid);
#pragma unroll
        for (int mi = 0; mi < 2; ++mi) { const int tok = tk0 + 32 * c.wave + 16 * mi + r;
            const bf16* gp = gates + (size_t)tok * 2048 + 1024 + nt * 128 + 4 * q; bf16* mp = merged + (size_t)tok * D + nt * 128 + 4 * q;
#pragma unroll
            for (int ni = 0; ni < 8; ++ni) { const u32x2 g = *(const u32x2*)(gp + 16 * ni); const u32x2 s = *(const u32x2*)(mp + 16 * ni); const f32x4 v = acc[mi][ni];
                u32x2 o; o.x = pk2(bf_lo(s.x) + v.x * bf_lo(g.x), bf_hi(s.x) + v.y * bf_hi(g.x)); o.y = pk2(bf_lo(s.y) + v.z * bf_lo(g.y), bf_hi(s.y) + v.w * bf_hi(g.y));
                *(u32x2*)(mp + 16 * ni) = o; } }
    }
}

__device__ __forceinline__ void phase_E(const Ctx& c0, int l) {
    Ctx c = reopaque(c0);
    const bf16* merged = WSP(bf16, WS_MERGED); const bf16* Wout = (const bf16*)(c.ws + WS_WIN + l * SZ_WLAYER + OFF_WOUT);
    float* h = WSP(float, WS_H); bf16* hb = WSP(bf16, WS_HB); float* ssq = WSP(float, WS_SSQ);
    const int r = c.lane & 15, q = c.lane >> 4;
    for (int it = c.vb; it < n_mtiles(l) * 8; it += c.G) {
        const int mt = it / 8, nt = it % 8, tk0 = tile_tok0(mt, l);
        f32x4 acc[2][8];
#pragma unroll
        for (int mi = 0; mi < 2; ++mi) { const int tok = tk0 + 32 * c.wave + 16 * mi + r; const float* hp = h + (size_t)tok * D;
            if (l == 0) { const int b = tok / L, pos = tok - b * L; hp = pos < NMETA ? c.in[1] + (size_t)pos * D : c.in[0] + ((size_t)b * SEQ + (pos - NMETA)) * D; }
            hp += nt * 128 + 4 * q;
#pragma unroll
            for (int ni = 0; ni < 8; ++ni) acc[mi][ni] = *(const f32x4*)(hp + 16 * ni); }
        gemm_core(acc, merged + (size_t)tk0 * D, D, Wout + (size_t)nt * 128 * D, D, D, c.lds, c.tid);
#pragma unroll
        for (int mi = 0; mi < 2; ++mi) { const int tok = tk0 + 32 * c.wave + 16 * mi + r; float ss = 0.f;
#pragma unroll
            for (int ni = 0; ni < 8; ++ni) { float* hp = h + (size_t)tok * D + nt * 128 + 16 * ni + 4 * q; const f32x4 v = acc[mi][ni]; *(f32x4*)hp = v;
                ss += (v.x * v.x + v.y * v.y) + (v.z * v.z + v.w * v.w);
                u32x2 o; o.x = pk2(v.x, v.y); o.y = pk2(v.z, v.w); *(u32x2*)(hb + (size_t)tok * D + nt * 128 + 16 * ni + 4 * q) = o; }
            ss = quad_sum(ss);
            if (q == 0) ssq[(size_t)tok * 8 + nt] = ss; }
    }
}

__device__ __forceinline__ unsigned f2key(float f) { const unsigned u = __float_as_uint(f); return u ^ ((u >> 31) ? 0xFFFFFFFFu : 0x80000000u); }
__device__ __forceinline__ float key2f(unsigned k) { const unsigned u = (k >> 31) ? (k ^ 0x80000000u) : ~k; return __uint_as_float(u); }
__device__ __forceinline__ void top16_insert(unsigned (&lst)[16], unsigned x) {
#pragma unroll
    for (int i = 0; i < 16; ++i) { const unsigned a = lst[i]; lst[i] = a > x ? a : x; x = a > x ? x : a; }
}
__device__ __forceinline__ void ce_desc(unsigned& a, unsigned& b) { const unsigned mx = a > b ? a : b, mn = a > b ? b : a; a = mx; b = mn; }
__device__ __forceinline__ void sort16_desc(unsigned (&v)[16]) {
#pragma unroll
    for (int k = 2; k <= 16; k <<= 1)
#pragma unroll
        for (int j = k >> 1; j > 0; j >>= 1)
#pragma unroll
            for (int i = 0; i < 16; ++i) { const int p = i ^ j; if (p > i) { if ((i & k) == 0) ce_desc(v[i], v[p]); else ce_desc(v[p], v[i]); } }
}
__device__ __forceinline__ void merge_top16(unsigned (&a)[16], const unsigned (&b)[16]) {
#pragma unroll
    for (int i = 0; i < 16; ++i) a[i] = a[i] > b[15 - i] ? a[i] : b[15 - i];
#pragma unroll
    for (int j = 8; j > 0; j >>= 1)
#pragma unroll
        for (int i = 0; i < 16; ++i) { const int p = i ^ j; if (p > i) ce_desc(a[i], a[p]); }
}
__device__ __forceinline__ void phase_F(const Ctx& c0, int l) {
    Ctx c = reopaque(c0);
    const bf16* hb = WSP(bf16, WS_HB); const bf16* Wpq = (const bf16*)(c.ws + WS_WIN + l * SZ_WLAYER + OFF_WPQ); const bf16* keys = (const bf16*)(c.ws + WS_WIN + l * SZ_WLAYER + OFF_KEYS);
    const float* ssq = WSP(float, WS_SSQ); float* sv = WSP(float, WS_SV); unsigned char* si = WSP(unsigned char, WS_SI);
    const int tid = c.tid, wave = c.wave, lane = c.lane, r = lane & 15, q = lane >> 4;
    unsigned char* lds = c.lds;
    const int xcd = c.vb / (c.G / 8), lb = c.vb % (c.G / 8), xm = xcd & 1, xn = xcd >> 1, nmt = n_mtiles(l);
    const int m_lo = xm ? (nmt + 1) / 2 : 0, m_cnt = xm ? nmt / 2 : (nmt + 1) / 2;
    for (int j = lb; j < m_cnt * 4; j += c.G / 8) {
        const int mt = m_lo + j / 4, hp = xn * 4 + j % 4, tk0 = tile_tok0(mt, l);
        f32x4 acc[2][8]; acc_zero(acc);
        u32x4 kreg[2][4]; float rsv[2];
        { const int chunk = tid & 7, row0 = tid >> 3; const bf16* pb = keys + ((size_t)hp * 128 + row0) * 128 + chunk * 8;
#pragma unroll
          for (int s = 0; s < 2; ++s)
#pragma unroll
              for (int i = 0; i < 4; ++i) kreg[s][i] = *(const u32x4*)(pb + (size_t)(32 * i) * 128 + s * 64); }
#pragma unroll
        for (int mi = 0; mi < 2; ++mi) rsv[mi] = rstd_from_ssq8(ssq, tk0 + 32 * wave + 16 * mi + r);
        gemm_core(acc, hb + (size_t)tk0 * D, D, Wpq + (size_t)hp * 128 * D, D, D, lds, tid);
#pragma unroll
        for (int mi = 0; mi < 2; ++mi) { const int row = 32 * wave + 16 * mi + r; const float rs = rsv[mi];
#pragma unroll
            for (int ni = 0; ni < 8; ++ni) { const f32x4 v = acc[mi][ni] * rs; u32x2 o; o.x = pk2(v.x, v.y); o.y = pk2(v.z, v.w);
                *(u32x2*)(lds + (ni >> 2) * 32768 + lds_off(row, 2 * (ni & 3) + (q >> 1)) + 8 * (q & 1)) = o; } }
        { const int chunk = tid & 7, row0 = tid >> 3;
#pragma unroll
          for (int s = 0; s < 2; ++s)
#pragma unroll
              for (int i = 0; i < 4; ++i) *(u32x4*)(lds + s * 32768 + 16384 + lds_off(row0 + 32 * i, chunk)) = kreg[s][i]; }
        __syncthreads();
        acc_zero(acc);
        gemm_compute_stage(acc, lds, lds + 16384, wave, lane);
        gemm_compute_stage(acc, lds + 32768, lds + 32768 + 16384, wave, lane);
        __syncthreads();
        float* S = (float*)lds;
#pragma unroll
        for (int mi = 0; mi < 2; ++mi) { const int row = 32 * wave + 16 * mi + r;
#pragma unroll
            for (int ni = 0; ni < 8; ++ni) *(f32x4*)(S + row * 132 + 16 * ni + 4 * q) = acc[mi][ni]; }
        __syncthreads();
        {
            const int tl = 32 * wave + (lane & 31), half = lane >> 5;
            const float* row = S + tl * 132;
            unsigned lst[16];
#pragma unroll
            for (int g = 0; g < 4; ++g) {
                unsigned cur[16];
#pragma unroll
                for (int j = 0; j < 4; ++j) { const int col = 64 * half + 16 * g + 4 * j; const f32x4 v = *(const f32x4*)(row + col);
                    cur[4 * j] = (f2key(v.x) & ~127u) | (unsigned)(127 - col); cur[4 * j + 1] = (f2key(v.y) & ~127u) | (unsigned)(127 - (col + 1));
                    cur[4 * j + 2] = (f2key(v.z) & ~127u) | (unsigned)(127 - (col + 2)); cur[4 * j + 3] = (f2key(v.w) & ~127u) | (unsigned)(127 - (col + 3)); }
                sort16_desc(cur);
                if (g == 0) {
#pragma unroll
                    for (int i = 0; i < 16; ++i) lst[i] = cur[i];
                } else merge_top16(lst, cur);
            }
            unsigned oth[16];
#pragma unroll
            for (int i = 0; i < 16; ++i) { auto rr = __builtin_amdgcn_permlane32_swap(lst[i], lst[i], false, false); oth[i] = half == 0 ? rr[1] : rr[0]; }
            merge_top16(lst, oth);
            if (half == 0) {
                const int tok = tk0 + tl;
                unsigned idx[16]; float val[16];
#pragma unroll
                for (int i = 0; i < 16; ++i) { idx[i] = 127u - (lst[i] & 127u); val[i] = row[idx[i]]; }
                float* svp = sv + ((size_t)tok * 16 + hp) * 16;
#pragma unroll
                for (int i = 0; i < 4; ++i) *(f32x4*)(svp + 4 * i) = (f32x4){val[4 * i], val[4 * i + 1], val[4 * i + 2], val[4 * i + 3]};
                u32x4 pi;
                pi.x = idx[0] | (idx[1] << 8) | (idx[2] << 16) | (idx[3] << 24); pi.y = idx[4] | (idx[5] << 8) | (idx[6] << 16) | (idx[7] << 24);
                pi.z = idx[8] | (idx[9] << 8) | (idx[10] << 16) | (idx[11] << 24); pi.w = idx[12] | (idx[13] << 8) | (idx[14] << 16) | (idx[15] << 24);
                *(u32x4*)(si + ((size_t)tok * 16 + hp) * 16) = pi;
            }
        }
        __syncthreads();
    }
}

__device__ __forceinline__ void phase_F3(const Ctx& c0, int l) {
    Ctx c = reopaque(c0);
    const float* sv = WSP(float, WS_SV); const unsigned char* si = WSP(unsigned char, WS_SI); int* eidx = WSP(int, WS_EIDX); float* gw = WSP(float, WS_GW); unsigned char* stb = WSP(unsigned char, WS_STB);
    float* lsv = (float*)c.lds;
    unsigned char* lsi = c.lds + 256 * 33 * 4;
    const int tid = c.tid;
    const int ntok = l == 1 ? NB * SEQ : T;
    for (int base = c.vb * NTHREADS; base < ntok * 8; base += c.G * NTHREADS) {
        const int thc = base + tid, tkc = thc >> 3;
        const int th = (l == 1 ? tkc + NMETA * ((tkc >> 11) + 1) : tkc) * 8 + (thc & 7);
        float a[16], b[16];
#pragma unroll
        for (int i = 0; i < 4; ++i) { const f32x4 x = *(const f32x4*)(sv + (size_t)th * 32 + 4 * i), y = *(const f32x4*)(sv + (size_t)th * 32 + 16 + 4 * i);
            a[4 * i] = x.x; a[4 * i + 1] = x.y; a[4 * i + 2] = x.z; a[4 * i + 3] = x.w; b[4 * i] = y.x; b[4 * i + 1] = y.y; b[4 * i + 2] = y.z; b[4 * i + 3] = y.w; }
        const u32x4 ia = *(const u32x4*)(si + (size_t)th * 32), ib = *(const u32x4*)(si + (size_t)th * 32 + 16);
#pragma unroll
        for (int i = 0; i < 16; ++i) { lsv[tid * 33 + i] = a[i]; lsv[tid * 33 + 16 + i] = b[i]; }
        *(u32x4*)(lsi + tid * 32) = ia; *(u32x4*)(lsi + tid * 32 + 16) = ib;
        unsigned lst[16], g2[16], g3[16], g4[16];
#pragma unroll
        for (int j = 0; j < 16; ++j) lst[j] = (f2key(a[0] + b[j]) & ~255u) | (unsigned)(255 - j);
#pragma unroll
        for (int i = 1; i < 16; ++i) g2[i - 1] = (f2key(a[i] + b[0]) & ~255u) | (unsigned)(255 - i * 16);
        g2[15] = 0u;
        { int n = 0;
#pragma unroll
          for (int i = 1; i < 16; ++i)
#pragma unroll
              for (int j = 1; j < 16; ++j)
                  if ((i + 1) * (j + 1) <= 16) { const unsigned key = (f2key(a[i] + b[j]) & ~255u) | (unsigned)(255 - (i * 16 + j)); if (n < 16) g3[n] = key; else g4[n - 16] = key; ++n; }
#pragma unroll
          for (int k = 3; k < 16; ++k) g4[k] = 0u; }
        sort16_desc(g3); sort16_desc(g4);
        merge_top16(lst, g2); merge_top16(g3, g4); merge_top16(lst, g3);
        __builtin_amdgcn_s_waitcnt(0xC07F); asm volatile("" ::: "memory");
        float s[16]; int e[16];
#pragma unroll
        for (int k = 0; k < 16; ++k) { const unsigned code = 255u - (lst[k] & 255u); const int i = code >> 4, j = code & 15;
            s[k] = lsv[tid * 33 + i] + lsv[tid * 33 + 16 + j]; e[k] = (int)lsi[tid * 32 + i] * 128 + (int)lsi[tid * 32 + 16 + j]; }
        float mx = s[0];
#pragma unroll
        for (int k = 1; k < 16; ++k) mx = fmaxf(mx, s[k]);
        float sum = 0.f;
#pragma unroll
        for (int k = 0; k < 16; ++k) { s[k] = fast_exp2((s[k] - mx) * 1.4426950409f); sum += s[k]; }
        const float inv = 1.0f / sum;
        typedef unsigned long long u64;
        u64 hlo = 0ull, hhi = 0ull;
#pragma unroll
        for (int k = 0; k < 16; ++k) { const int sl = e[k] >> 10; if (sl < 8) hlo += 1ull << (8 * sl); else hhi += 1ull << (8 * (sl - 8)); }
        u64 ilo = hlo, ihi = hhi;
#pragma unroll
        for (int d = 1; d < 8; d <<= 1) { const u64 a_ = __shfl_up(ilo, d, 8), b_ = __shfl_up(ihi, d, 8); if ((tid & 7) >= d) { ilo += a_; ihi += b_; } }
        const u64 tlo = __shfl(ilo, 7, 8), thi = __shfl(ihi, 7, 8);
        const u64 ones = 0x0101010101010101ull;
        const u64 inlo = tlo * ones, inhi = thi * ones + (inlo >> 56) * ones;
        const u64 stlo = inlo - tlo, sthi = inhi - thi;
        u64 rlo = stlo + (ilo - hlo), rhi = sthi + (ihi - hhi);
        const int tokn = th >> 3;
#pragma unroll
        for (int k = 0; k < 16; ++k) { const int sl = e[k] >> 10; int pos;
            if (sl < 8) { pos = (int)((rlo >> (8 * sl)) & 255ull); rlo += 1ull << (8 * sl); } else { pos = (int)((rhi >> (8 * (sl - 8))) & 255ull); rhi += 1ull << (8 * (sl - 8)); }
            eidx[(size_t)tokn * 128 + pos] = e[k]; gw[(size_t)tokn * 128 + pos] = s[k] * inv; }
        if ((tid & 7) == 0) { u64* sp = (u64*)(stb + (size_t)tokn * 16); sp[0] = stlo; sp[1] = sthi; }
        __builtin_amdgcn_s_waitcnt(0xC07F); asm volatile("" ::: "memory");
    }
}

typedef float f32x2 __attribute__((ext_vector_type(2)));
constexpr int G2_WSTRIDE = 14336, G2_MAXTOK = 9;
__device__ __forceinline__ float fp8dot4(unsigned w, unsigned x01, unsigned x23, float acc) {
    const bf16x2 lo = __builtin_amdgcn_cvt_scalef32_pk_bf16_fp8(w, 1.0f, false), hi = __builtin_amdgcn_cvt_scalef32_pk_bf16_fp8(w, 1.0f, true);
    acc = __builtin_amdgcn_fdot2_f32_bf16(lo, __builtin_bit_cast(bf16x2, x01), acc, false);
    return __builtin_amdgcn_fdot2_f32_bf16(hi, __builtin_bit_cast(bf16x2, x23), acc, false);
}
__device__ __forceinline__ float reduce8_transposed(const float (&p)[8], int lane) {
    float s[4];
#pragma unroll
    for (int k = 0; k < 4; ++k) { auto r = __builtin_amdgcn_permlane32_swap(__float_as_uint(p[k]), __float_as_uint(p[k + 4]), false, false); s[k] = __uint_as_float(r[0]) + __uint_as_float(r[1]); }
    float t[2];
#pragma unroll
    for (int k = 0; k < 2; ++k) { auto r = __builtin_amdgcn_permlane16_swap(__float_as_uint(s[k]), __float_as_uint(s[k + 2]), false, false); t[k] = __uint_as_float(r[0]) + __uint_as_float(r[1]); }
    const float u0 = t[0] + dpp<0x128>(t[0]), u1 = t[1] + dpp<0x128>(t[1]);
    float r = (lane & 8) ? u1 : u0;
    r += dpp<0xB1>(r); r += dpp<0x4E>(r); r += dpp<0x141>(r);
    return r;
}
typedef int i32x4 __attribute__((ext_vector_type(4)));
__device__ __forceinline__ void fp8fma4(f32x2 (&acc)[8], int o, unsigned w, f32x2 a2) {
    const f32x2 lo = __builtin_amdgcn_cvt_scalef32_pk_f32_fp8(w, 1.0f, false), hi = __builtin_amdgcn_cvt_scalef32_pk_f32_fp8(w, 1.0f, true);
    acc[o] = __builtin_elementwise_fma(a2, lo, acc[o]); acc[o + 1] = __builtin_elementwise_fma(a2, hi, acc[o + 1]);
}
__device__ __forceinline__ void g2_u_chunk(u32x4 (&u)[8], const unsigned char* U, const int* pe_next, const float* pw_c, float* act_c, const u32x4 xq, float rs, int lane) {
    const i32x4 e0 = *(const i32x4*)pe_next, e1 = *(const i32x4*)(pe_next + 4);
    const int en[8] = {e0.x, e0.y, e0.z, e0.w, e1.x, e1.y, e1.z, e1.w};
    float p[8];
#pragma unroll
    for (int k = 0; k < 8; ++k) {
        int d = __builtin_amdgcn_sdot4((int)u[k].x, (int)xq.x, 0, false); d = __builtin_amdgcn_sdot4((int)u[k].y, (int)xq.y, d, false);
        d = __builtin_amdgcn_sdot4((int)u[k].z, (int)xq.z, d, false); d = __builtin_amdgcn_sdot4((int)u[k].w, (int)xq.w, d, false);
        p[k] = (float)d;
        asm volatile("" : "+v"(p[k]));
        u[k] = *(const u32x4*)(U + (size_t)__builtin_amdgcn_readfirstlane(en[k]) * 1024 + lane * 16);
    }
    const float a = reduce8_transposed(p, lane);
    const int row = (lane >> 3) & 7;
    if ((lane & 7) == 0) act_c[row] = gelu_tanh(a * rs) * pw_c[row];
}
__device__ __forceinline__ void g2_v_chunk(u32x4 (&v)[8], const unsigned char* V, const int* pe_next, const float* act_c, f32x2 (&acc)[8], int lane) {
    const i32x4 e0 = *(const i32x4*)pe_next, e1 = *(const i32x4*)(pe_next + 4);
    const int en[8] = {e0.x, e0.y, e0.z, e0.w, e1.x, e1.y, e1.z, e1.w};
    const f32x4 a0 = *(const f32x4*)act_c, a1 = *(const f32x4*)(act_c + 4);
    const float av[8] = {a0.x, a0.y, a0.z, a0.w, a1.x, a1.y, a1.z, a1.w};
#pragma unroll
    for (int k = 0; k < 8; ++k) { const f32x2 a2 = (f32x2){av[k], av[k]};
        fp8fma4(acc, 0, v[k].x, a2); fp8fma4(acc, 2, v[k].y, a2); fp8fma4(acc, 4, v[k].z, a2); fp8fma4(acc, 6, v[k].w, a2);
        asm volatile("" : "+v"(acc[0]), "+v"(acc[1]), "+v"(acc[2]), "+v"(acc[3]), "+v"(acc[4]), "+v"(acc[5]), "+v"(acc[6]), "+v"(acc[7]));
        v[k] = *(const u32x4*)(V + (size_t)__builtin_amdgcn_readfirstlane(en[k]) * 1024 + lane * 16);
    }
}
__device__ __forceinline__ void g2_finish_token(Ctx& c, int l, int tok, const f32x2 (&acc)[8], int lane) {
    float* h = WSP(float, WS_H); bf16* hbw = WSP(bf16, WS_HB); float* ssqw = WSP(float, WS_SSQ);
    float* hp = h + (size_t)tok * D + lane * 16;
    f32x4 r0 = *(const f32x4*)hp, r1 = *(const f32x4*)(hp + 4), r2 = *(const f32x4*)(hp + 8), r3 = *(const f32x4*)(hp + 12);
    r0 += (f32x4){acc[0].x, acc[0].y, acc[1].x, acc[1].y}; r1 += (f32x4){acc[2].x, acc[2].y, acc[3].x, acc[3].y};
    r2 += (f32x4){acc[4].x, acc[4].y, acc[5].x, acc[5].y}; r3 += (f32x4){acc[6].x, acc[6].y, acc[7].x, acc[7].y};
    if (l == 0) {
        *(f32x4*)hp = r0; *(f32x4*)(hp + 4) = r1; *(f32x4*)(hp + 8) = r2; *(f32x4*)(hp + 12) = r3;
        u32x4 o0, o1; o0.x = pk2(r0.x, r0.y); o0.y = pk2(r0.z, r0.w); o0.z = pk2(r1.x, r1.y); o0.w = pk2(r1.z, r1.w);
        o1.x = pk2(r2.x, r2.y); o1.y = pk2(r2.z, r2.w); o1.z = pk2(r3.x, r3.y); o1.w = pk2(r3.z, r3.w);
        *(u32x4*)(hbw + (size_t)tok * D + lane * 16) = o0; *(u32x4*)(hbw + (size_t)tok * D + lane * 16 + 8) = o1;
        float ss = (r0.x * r0.x + r0.y * r0.y) + (r0.z * r0.z + r0.w * r0.w) + (r1.x * r1.x + r1.y * r1.y) + (r1.z * r1.z + r1.w * r1.w)
                 + (r2.x * r2.x + r2.y * r2.y) + (r2.z * r2.z + r2.w * r2.w) + (r3.x * r3.x + r3.y * r3.y) + (r3.z * r3.z + r3.w * r3.w);
        ss = wave_sum_dpp(ss);
        if (lane < 8) ssqw[(size_t)tok * 8 + lane] = lane == 0 ? ss : 0.f;
    } else {
        const int b = tok / L, pos = tok - b * L;
        if (pos >= NMETA) { float* op = c.out + ((size_t)b * SEQ + (pos - NMETA)) * D + lane * 16;
            *(f32x4*)op = r0; *(f32x4*)(op + 4) = r1; *(f32x4*)(op + 8) = r2; *(f32x4*)(op + 12) = r3; }
    }
}
__device__ __forceinline__ void phase_G2(const Ctx& c0, int l) {
    Ctx c = reopaque(c0);
    const bf16* hb = WSP(bf16, WS_HB); const float* ssq = WSP(float, WS_SSQ); const int* pe = WSP(int, WS_EIDX); const float* pw = WSP(float, WS_GW);
    const unsigned char* U = c.ws + WS_TAB + (size_t)(l * 2) * SZ_TAB; const unsigned char* V = c.ws + WS_TAB + (size_t)(l * 2 + 1) * SZ_TAB;
    const int lane = c.lane, wave = c.wave;
    const int gw = c.vb * 4 + wave, t0 = l == 1 ? gw * 8 + NMETA * ((gw >> 8) + 1) : gw * 8;
    const bool has_x = l == 0 && (c.vb & 3) == 0; const int tx = T - 128 + (c.vb >> 2);
    unsigned char* wl = c.lds + wave * G2_WSTRIDE;
    int* pe_l = (int*)wl; float* pw_l = (float*)(wl + 4608); float* act_l = (float*)(wl + 9216);
#pragma unroll
    for (int j = 0; j < G2_MAXTOK; ++j) { const int tok = j < 8 ? t0 + j : (has_x ? tx : t0);
        pe_l[j * 128 + lane] = pe[(size_t)tok * 128 + lane]; pe_l[j * 128 + 64 + lane] = pe[(size_t)tok * 128 + 64 + lane];
        pw_l[j * 128 + lane] = pw[(size_t)tok * 128 + lane] * TAB_INV; pw_l[j * 128 + 64 + lane] = pw[(size_t)tok * 128 + 64 + lane] * TAB_INV; }
    const int xlo = has_x ? 4 * wave : 16, xhi = has_x ? 4 * wave + 4 : 16;
    {
        u32x4 xq[G2_MAXTOK]; float rs[G2_MAXTOK];
#pragma unroll
        for (int j = 0; j < G2_MAXTOK; ++j) { const int tok = j < 8 ? t0 + j : (has_x ? tx : t0);
            const u32x4 lo = *(const u32x4*)(hb + (size_t)tok * D + lane * 16), hi = *(const u32x4*)(hb + (size_t)tok * D + lane * 16 + 8);
            const f32x4 f0 = (f32x4){bf_lo(lo.x), bf_hi(lo.x), bf_lo(lo.y), bf_hi(lo.y)}, f1 = (f32x4){bf_lo(lo.z), bf_hi(lo.z), bf_lo(lo.w), bf_hi(lo.w)};
            const f32x4 f2 = (f32x4){bf_lo(hi.x), bf_hi(hi.x), bf_lo(hi.y), bf_hi(hi.y)}, f3 = (f32x4){bf_lo(hi.z), bf_hi(hi.z), bf_lo(hi.w), bf_hi(hi.w)};
            float mx = 1e-20f;
#pragma unroll
            for (int i = 0; i < 4; ++i) mx = fmaxf(mx, fmaxf(fmaxf(fabsf(f0[i]), fabsf(f1[i])), fmaxf(fabsf(f2[i]), fabsf(f3[i]))));
            mx = fmaxf(mx, dpp<0xB1>(mx)); mx = fmaxf(mx, dpp<0x4E>(mx)); mx = fmaxf(mx, dpp<0x141>(mx)); mx = fmaxf(mx, dpp<0x128>(mx)); mx = xrow16_max(mx);
            const float sx = 127.0f / mx;
            xq[j].x = pack_i8x4(f0 * sx); xq[j].y = pack_i8x4(f1 * sx); xq[j].z = pack_i8x4(f2 * sx); xq[j].w = pack_i8x4(f3 * sx);
            rs[j] = rstd_from_ssq8(ssq, tok) * mx * (1.0f / (127.0f * U_SCALE)); }
        u32x4 u[8];
#pragma unroll
        for (int k = 0; k < 8; ++k) u[k] = *(const u32x4*)(U + (size_t)__builtin_amdgcn_readfirstlane(pe_l[k]) * 1024 + lane * 16);
#pragma unroll 1
        for (int ch = 0; ch < 16; ++ch) {
            const int cn = ch < 15 ? ch + 1 : 0;
            const bool x_here = ch >= xlo && ch < xhi;
#pragma unroll
            for (int j = 0; j < 8; ++j) {
                const int* pe_next = j < 7 ? pe_l + (j + 1) * 128 + ch * 8 : (x_here ? pe_l + 8 * 128 + ch * 8 : pe_l + cn * 8);
                g2_u_chunk(u, U, pe_next, pw_l + j * 128 + ch * 8, act_l + j * 128 + ch * 8, xq[j], rs[j], lane); }
            if (x_here) g2_u_chunk(u, U, pe_l + cn * 8, pw_l + 8 * 128 + ch * 8, act_l + 8 * 128 + ch * 8, xq[8], rs[8], lane);
        }
    }
    f32x2 acc[G2_MAXTOK][8];
#pragma unroll
    for (int j = 0; j < G2_MAXTOK; ++j)
#pragma unroll
        for (int i = 0; i < 8; ++i) acc[j][i] = (f32x2){0.f, 0.f};
    {
        u32x4 v[8];
#pragma unroll
        for (int k = 0; k < 8; ++k) v[k] = *(const u32x4*)(V + (size_t)__builtin_amdgcn_readfirstlane(pe_l[k]) * 1024 + lane * 16);
#pragma unroll 1
        for (int ch = 0; ch < 16; ++ch) {
            const int cn = ch < 15 ? ch + 1 : 0;
            const bool x_here = ch >= xlo && ch < xhi;
#pragma unroll
            for (int j = 0; j < 8; ++j) {
                const int* pe_next = j < 7 ? pe_l + (j + 1) * 128 + ch * 8 : (x_here ? pe_l + 8 * 128 + ch * 8 : pe_l + cn * 8);
                g2_v_chunk(v, V, pe_next, act_l + j * 128 + ch * 8, acc[j], lane); }
            if (x_here) g2_v_chunk(v, V, pe_l + cn * 8, act_l + 8 * 128 + ch * 8, acc[8], lane);
        }
    }
#pragma unroll
    for (int j = 0; j < 8; ++j) g2_finish_token(c, l, t0 + j, acc[j], lane);
    __syncthreads();
    if (has_x) {
        f32x2* part = (f32x2*)(c.lds + wave * G2_WSTRIDE);
#pragma unroll
        for (int i = 0; i < 8; ++i) part[i * 64 + lane] = acc[8][i];
    }
    __syncthreads();
    if (has_x && wave == 0) {
        f32x2 tot[8];
#pragma unroll
        for (int i = 0; i < 8; ++i) { tot[i] = acc[8][i];
#pragma unroll
            for (int w = 1; w < 4; ++w) tot[i] += ((const f32x2*)(c.lds + w * G2_WSTRIDE))[i * 64 + lane]; }
        g2_finish_token(c, l, tx, tot, lane);
    }
    __syncthreads();
}

struct Args { const float* in[22]; float* out; unsigned char* ws; int ph_lo, ph_hi; };
constexpr int N_PHASES = 17;

__global__ void __launch_bounds__(NTHREADS, 2) fwd_kernel(Args args) {
    extern __shared__ __attribute__((aligned(16))) unsigned char lds_raw[];
    Ctx c;
#pragma unroll
    for (int i = 0; i < 22; ++i) c.in[i] = args.in[i];
    c.out = args.out; c.ws = args.ws; c.lds = lds_raw;
    c.tid = threadIdx.x; c.lane = c.tid & 63; c.wave = __builtin_amdgcn_readfirstlane(c.tid >> 6);
    c.G = gridDim.x; { const int bx = blockIdx.x; c.vb = (c.G % 8 == 0) ? (bx % 8) * (c.G / 8) + bx / 8 : bx; }
    volatile unsigned* misc = (volatile unsigned*)(c.lds + LDS_MISC);
    if (c.tid < 16) misc[c.tid] = 0u;
    __syncthreads();
    const int lo = args.ph_lo, hi = args.ph_hi;
    const bool multi = (hi - lo) > 1;
    XcdBarrier bar; bar.bar = WSP(unsigned, WS_CTL) + CW_BAR; bar.x = 0; bar.st = misc;
    if (multi) bar = xcd_barrier_post(WSP(unsigned, WS_CTL) + CW_BAR, misc);
#define IN_(k) (lo <= (k) && (k) < hi)
#define SEAM_(k) do { if ((k) + 1 < hi) xcd_barrier(bar); } while (0)
    if (IN_(0)) { phase_prologue(c); SEAM_(0); }
#pragma unroll 1
    for (int l = 0; l < 2; ++l) {
        const int p0 = 1 + 8 * l;
        if (IN_(p0 + 0)) { phase_A(c, l); SEAM_(p0 + 0); }
        if (IN_(p0 + 1)) { phase_B(c, l); SEAM_(p0 + 1); }
        if (IN_(p0 + 2)) { phase_C(c, l); SEAM_(p0 + 2); }
        if (IN_(p0 + 3)) { phase_D(c, l); SEAM_(p0 + 3); }
        if (IN_(p0 + 4)) { phase_E(c, l); SEAM_(p0 + 4); }
        if (IN_(p0 + 5)) { phase_F(c, l); SEAM_(p0 + 5); }
        if (IN_(p0 + 6)) { phase_F3(c, l); SEAM_(p0 + 6); }
        if (IN_(p0 + 7)) { phase_G2(c, l); SEAM_(p0 + 7); }
    }
}

extern "C" void kernel_launch(void* const* d_in, const int* in_sizes, int n_in, void* d_out, int out_size, void* d_ws, size_t ws_size, hipStream_t stream) {
    static int grid = 0;
    if (grid == 0) {
        if (n_in != 22 || out_size != NB * SEQ * D || ws_size < WS_END) { fprintf(stderr, "kernel_launch: unexpected shapes (n_in %d out %d ws %zu need %zu)\n", n_in, out_size, ws_size, (size_t)WS_END); grid = -1; return; }
        int dev = 0, cus = 0, per_cu = 0;
        hipGetDevice(&dev); hipDeviceGetAttribute(&cus, hipDeviceAttributeMultiprocessorCount, dev);
        if (hipFuncSetAttribute((const void*)fwd_kernel, hipFuncAttributeMaxDynamicSharedMemorySize, LDS_BYTES) != hipSuccess) { fprintf(stderr, "kernel_launch: hipFuncSetAttribute failed\n"); grid = -1; return; }
        if (hipOccupancyMaxActiveBlocksPerMultiprocessor(&per_cu, (const void*)fwd_kernel, NTHREADS, LDS_BYTES) != hipSuccess || per_cu < 1) { fprintf(stderr, "kernel_launch: occupancy query failed (%d)\n", per_cu); per_cu = 1; (void)hipGetLastError(); }
        if (per_cu > 2) per_cu = 2;
        grid = cus * per_cu;
        if (grid != 512) { fprintf(stderr, "kernel_launch: grid %d unsupported by phase G2 (needs 512 workgroups)\n", grid); grid = -1; return; }
        fprintf(stderr, "kernel_launch: grid %d (%d per CU), lds %d, ws need %zu have %zu\n", grid, per_cu, LDS_BYTES, (size_t)WS_END, ws_size);
    }
    if (grid < 0) return;
    hipMemsetAsync((char*)d_ws + WS_CTL, 0, CTL_BYTES, stream);
    Args a{};
    for (int i = 0; i < 22; ++i) a.in[i] = (const float*)d_in[i];
    a.out = (float*)d_out; a.ws = (unsigned char*)d_ws;
#if MK_PER_PHASE
    for (int ph = 0; ph < N_PHASES; ++ph) { a.ph_lo = ph; a.ph_hi = ph + 1; hipLaunchKernelGGL(fwd_kernel, dim3(grid), dim3(NTHREADS), LDS_BYTES, stream, a); }
#else
    a.ph_lo = 0; a.ph_hi = N_PHASES;
    void* kargs[] = {&a};
    hipError_t e = hipLaunchCooperativeKernel((const void*)fwd_kernel, dim3(grid), dim3(NTHREADS), kargs, LDS_BYTES, stream);
    if (e != hipSuccess) fprintf(stderr, "kernel_launch: cooperative launch failed: %s (grid %d)\n", hipGetErrorString(e), grid);
#endif
}
```

```cpp
#include <hip/hip_runtime.h>
#include <cstdio>
#include <cstdint>

#ifndef MK_PER_PHASE
#define MK_PER_PHASE 0
#endif

typedef unsigned short bf16;
typedef short bf16x8 __attribute__((ext_vector_type(8)));
typedef float f32x4 __attribute__((ext_vector_type(4)));
typedef unsigned u32x4 __attribute__((ext_vector_type(4)));
typedef unsigned u32x2 __attribute__((ext_vector_type(2)));
typedef __bf16 bf16x2 __attribute__((ext_vector_type(2)));

constexpr int NB = 8, SEQ = 2048, NMETA = 16, L = SEQ + NMETA, T = NB * L, D = 1024;
constexpr int DC = 512, CW = 31, NH = 8, QL = 256, KVL = 128, NOPE = 64, ROPE = 32, QK = 96, VD = 64;
constexpr int NIN = 3488, NINP = 3584;
constexpr int NEXP = 16384;
constexpr float EPS = 1e-6f;
constexpr int MT = T / 128;
static_assert(T % 128 == 0, "T tiles");

constexpr size_t al256(size_t x) { return (x + 255) & ~(size_t)255; }
constexpr size_t WS_CTL = 0;
constexpr size_t CTL_BYTES = 65536;
constexpr size_t WS_ROPE = WS_CTL + CTL_BYTES;
constexpr size_t WS_WIN = al256(WS_ROPE + (size_t)L * 16 * 8);
constexpr size_t SZ_WIN = (size_t)NINP * 1024 * 2, SZ_WCO = (size_t)1024 * 512 * 2, SZ_WUQ = (size_t)1024 * 256 * 2, SZ_WUKV = (size_t)1024 * 128 * 2,
                 SZ_WMLA = (size_t)1024 * 512 * 2, SZ_WOUT = (size_t)1024 * 1024 * 2, SZ_WPQ = (size_t)2048 * 1024 * 2, SZ_KEYS = (size_t)16 * 128 * 128 * 2;
constexpr size_t OFF_WCO = SZ_WIN, OFF_WUQ = OFF_WCO + SZ_WCO, OFF_WUKV = OFF_WUQ + SZ_WUQ, OFF_WMLA = OFF_WUKV + SZ_WUKV, OFF_WOUT = OFF_WMLA + SZ_WMLA,
                 OFF_WPQ = OFF_WOUT + SZ_WOUT, OFF_KEYS = OFF_WPQ + SZ_WPQ, SZ_WLAYER = OFF_KEYS + SZ_KEYS;
constexpr size_t WS_TAB = al256(WS_WIN + 2 * SZ_WLAYER);
constexpr size_t SZ_TAB = (size_t)NEXP * 1024;
constexpr float TAB_SCALE = 256.0f, TAB_INV = 1.0f / 256.0f;
constexpr float U_CLIP = 0.2f, U_SCALE = 127.0f / U_CLIP;
constexpr size_t WS_H = al256(WS_TAB + 4 * SZ_TAB);
constexpr size_t WS_HB = al256(WS_H + (size_t)T * 1024 * 4);
constexpr size_t WS_SSQ = al256(WS_HB + (size_t)T * 1024 * 2);
constexpr size_t WS_UGLU = al256(WS_SSQ + (size_t)T * 8 * 4);
constexpr size_t WS_CQ = al256(WS_UGLU + (size_t)T * 512 * 2);
constexpr size_t WS_CKV = al256(WS_CQ + (size_t)T * 256 * 2);
constexpr size_t WS_KROPE = al256(WS_CKV + (size_t)T * 128 * 2);
constexpr size_t WS_SSQQ = al256(WS_KROPE + (size_t)T * 32 * 4);
constexpr size_t WS_SSQKV = al256(WS_SSQQ + (size_t)T * 2 * 4);
constexpr size_t WS_U2 = al256(WS_SSQKV + (size_t)T * 4);
constexpr size_t WS_Q = al256(WS_U2 + (size_t)T * 512 * 2);
constexpr size_t WS_K = al256(WS_Q + (size_t)T * NH * QK * 2);
constexpr size_t WS_VT = al256(WS_K + (size_t)T * NH * QK * 2);
constexpr size_t WS_O = al256(WS_VT + (size_t)T * NH * VD * 2 + 4096);
constexpr size_t WS_MERGED = al256(WS_O + (size_t)T * 512 * 2);
constexpr size_t WS_GATES = al256(WS_MERGED + (size_t)T * 1024 * 2);
constexpr size_t WS_SV = WS_GATES;
constexpr size_t WS_SI = al256(WS_SV + (size_t)T * 256 * 4);
constexpr size_t WS_EIDX = al256(WS_SI + (size_t)T * 256);
constexpr size_t WS_GW = al256(WS_EIDX + (size_t)T * 128 * 4);
constexpr size_t WS_STB = al256(WS_GW + (size_t)T * 128 * 4);
constexpr size_t WS_PEER_END = WS_STB + (size_t)T * 16;
constexpr size_t WS_END = al256(WS_GATES + (size_t)T * 2048 * 2);
static_assert(WS_PEER_END <= WS_END, "peer scratch overlay");

constexpr int CW_BAR = 0;
constexpr int CW_QUEUE = 4096;

constexpr int LDS_MAIN = 128 * 132 * 4;
constexpr int LDS_MISC = LDS_MAIN;
constexpr int LDS_BYTES = LDS_MAIN + 64;

constexpr int NTHREADS = 256;

__device__ __forceinline__ unsigned pk2(float lo, float hi) { bf16x2 v; v.x = (__bf16)lo; v.y = (__bf16)hi; return __builtin_bit_cast(unsigned, v); }
__device__ __forceinline__ unsigned pack_i8x4(f32x4 v) {
    const int a = (int)__builtin_rintf(fminf(fmaxf(v.x, -127.f), 127.f)), b = (int)__builtin_rintf(fminf(fmaxf(v.y, -127.f), 127.f));
    const int c_ = (int)__builtin_rintf(fminf(fmaxf(v.z, -127.f), 127.f)), d = (int)__builtin_rintf(fminf(fmaxf(v.w, -127.f), 127.f));
    return (unsigned)(a & 255) | ((unsigned)(b & 255) << 8) | ((unsigned)(c_ & 255) << 16) | ((unsigned)(d & 255) << 24);
}
__device__ __forceinline__ float bf_lo(unsigned p) { return __uint_as_float(p << 16); }
__device__ __forceinline__ float bf_hi(unsigned p) { return __uint_as_float(p & 0xffff0000u); }
__device__ __forceinline__ float fast_rcp(float x) { return __builtin_amdgcn_rcpf(x); }
__device__ __forceinline__ float fast_exp2(float x) { return __builtin_amdgcn_exp2f(x); }
__device__ __forceinline__ float sigmoidf_(float x) { return fast_rcp(1.0f + fast_exp2(-1.4426950409f * x)); }
__device__ __forceinline__ float gelu_tanh(float x) { const float u = 1.5957691216f * (x + 0.044715f * x * x * x); return x * fast_rcp(1.0f + fast_exp2(-1.4426950409f * u)); }
__device__ __forceinline__ float rsqrt_(float x) { return __builtin_amdgcn_rsqf(x); }
template <int CTRL> __device__ __forceinline__ float dpp(float x) { return __builtin_bit_cast(float, __builtin_amdgcn_mov_dpp(__builtin_bit_cast(int, x), CTRL, 0xf, 0xf, true)); }
__device__ __forceinline__ float xrow16_sum(float x) {
    auto s = __builtin_amdgcn_permlane16_swap(__float_as_uint(x), __float_as_uint(x), false, false);
    x = __uint_as_float(s[0]) + __uint_as_float(s[1]);
    auto t = __builtin_amdgcn_permlane32_swap(__float_as_uint(x), __float_as_uint(x), false, false);
    return __uint_as_float(t[0]) + __uint_as_float(t[1]);
}
__device__ __forceinline__ float xrow16_max(float x) {
    auto s = __builtin_amdgcn_permlane16_swap(__float_as_uint(x), __float_as_uint(x), false, false);
    x = fmaxf(__uint_as_float(s[0]), __uint_as_float(s[1]));
    auto t = __builtin_amdgcn_permlane32_swap(__float_as_uint(x), __float_as_uint(x), false, false);
    return fmaxf(__uint_as_float(t[0]), __uint_as_float(t[1]));
}
__device__ __forceinline__ float wave_sum_dpp(float x) {
    x += dpp<0xB1>(x); x += dpp<0x4E>(x); x += dpp<0x141>(x); x += dpp<0x128>(x); return xrow16_sum(x);
}
__device__ __forceinline__ float quad_sum(float v) { return xrow16_sum(v); }
__device__ __forceinline__ float quad_max(float v) { return xrow16_max(v); }
__device__ __forceinline__ float wave_sum(float v) { return wave_sum_dpp(v); }
__device__ __forceinline__ float dot2(unsigned a, unsigned b, float c) { return __builtin_amdgcn_fdot2_f32_bf16(__builtin_bit_cast(bf16x2, a), __builtin_bit_cast(bf16x2, b), c, false); }

#define XB_TMO      128
#define XB_XCNT(j)  (256  + 64 * (j))
#define XB_XSUB(j)  (1280 + 64 * (j))
#define XB_XGEN(j)  (2304 + 64 * (j))
#define XB_TOP      3328
#define XB_TOPGEN   3392
#define XCD_BAR_WORDS 3456
#define XB_SPIN_CAP (1u << 20)
__device__ __forceinline__ unsigned xb_ld(unsigned* p)              { return __hip_atomic_load(p, __ATOMIC_RELAXED, __HIP_MEMORY_SCOPE_AGENT); }
__device__ __forceinline__ unsigned xb_add(unsigned* p, unsigned v) { return __hip_atomic_fetch_add(p, v, __ATOMIC_RELAXED, __HIP_MEMORY_SCOPE_AGENT); }
__device__ __forceinline__ unsigned xb_xcc_id() { return (unsigned)__builtin_amdgcn_s_getreg((3 << 11) | 20) & 0xFu; }
#define XB_SPIN(cond, bar) do { unsigned _sp = 0; while (cond) { __builtin_amdgcn_s_sleep(1); \
    if ((++_sp & 255u) == 0u) { if (xb_ld(&(bar)[XB_TMO])) break; if (_sp > XB_SPIN_CAP) { atomicAdd(&(bar)[XB_TMO], 1u); break; } } } } while (0)
struct XcdBarrier { unsigned* bar; unsigned x; volatile unsigned* st; };
__device__ __forceinline__ XcdBarrier xcd_barrier_post(unsigned* bar, volatile unsigned* st) {
    XcdBarrier b; b.bar = bar; b.x = xb_xcc_id(); b.st = st;
    if (threadIdx.x == 0) (void)xb_add(&bar[XB_XCNT(b.x)], 1u);
    return b;
}
__device__ __forceinline__ void xcd_barrier_complete(unsigned* bar, unsigned x, unsigned& nloc, unsigned& nx) {
    const unsigned G = gridDim.x * gridDim.y * gridDim.z;
    unsigned sum, cnt, mine, sp = 0u;
    for (;;) {
        sum = 0u; cnt = 0u; mine = 0u;
#pragma unroll
        for (unsigned j = 0; j < 16; ++j) { const unsigned c = xb_ld(&bar[XB_XCNT(j)]); sum += c; cnt += (c > 0u) ? 1u : 0u; mine = (j == x) ? c : mine; }
        if (sum == G) break;
        __builtin_amdgcn_s_sleep(1);
        if ((++sp & 255u) == 0u) { if (xb_ld(&bar[XB_TMO])) break; if (sp > XB_SPIN_CAP) { atomicAdd(&bar[XB_TMO], 1u); break; } }
    }
    nloc = mine > 0u ? mine : 1u; nx = cnt > 0u ? cnt : 1u;
}
__device__ __forceinline__ void xcd_barrier(const XcdBarrier& b) {
    asm volatile("s_waitcnt vmcnt(0)" ::: "memory");
    __syncthreads();
    if (threadIdx.x == 0) {
        unsigned* bar = b.bar;
        __builtin_amdgcn_s_waitcnt(0);
        unsigned nloc = b.st[0], nx = b.st[1];
        if (nloc == 0u) { xcd_barrier_complete(bar, b.x, nloc, nx); b.st[0] = nloc; b.st[1] = nx; }
        const unsigned old = xb_add(&bar[XB_XSUB(b.x)], 1u);
        const unsigned gen = old / nloc;
        if (old + 1u == (gen + 1u) * nloc) {
            __builtin_amdgcn_fence(__ATOMIC_RELEASE, "agent");
            asm volatile("s_waitcnt vmcnt(0)" ::: "memory");
            const unsigned og = xb_add(&bar[XB_TOP], 1u);
            const unsigned tg = og / nx;
            if (og + 1u == (tg + 1u) * nx) xb_add(&bar[XB_TOPGEN], 1u);
            else XB_SPIN(xb_ld(&bar[XB_TOPGEN]) == tg, bar);
            __builtin_amdgcn_fence(__ATOMIC_ACQUIRE, "agent");
            xb_add(&bar[XB_XGEN(b.x)], 1u);
            asm volatile("s_waitcnt vmcnt(0)" ::: "memory");
        } else {
            XB_SPIN(xb_ld(&bar[XB_XGEN(b.x)]) == gen, bar);
            __builtin_amdgcn_fence(__ATOMIC_ACQUIRE, "agent");
            asm volatile("s_waitcnt vmcnt(0)" ::: "memory");
        }
    }
    __syncthreads();
}

struct Ctx {
    const float* in[22]; float* out; unsigned char* ws;
    unsigned char* lds; int tid, lane, wave, G, vb;
};
#define WSP(T_, off) ((T_*)(c.ws + (off)))
__device__ __forceinline__ Ctx reopaque(const Ctx& c0) {
    Ctx c = c0; int t = c0.tid; asm volatile("" : "+v"(t)); c.tid = t; c.lane = t & 63; c.wave = __builtin_amdgcn_readfirstlane(t >> 6);
    int vb = c0.vb; asm volatile("" : "+s"(vb)); c.vb = vb; return c;
}

__device__ __forceinline__ int lds_off(int row, int chunk) { return row * 128 + ((chunk ^ (row & 7)) << 4); }

__device__ __forceinline__ void gemm_compute_stage(f32x4 (&acc)[2][8], const unsigned char* sA, const unsigned char* sB, int wave, int lane) {
    const int r = lane & 15, q = lane >> 4;
#pragma unroll
    for (int ks = 0; ks < 2; ++ks) {
        bf16x8 af[2], bfr[8];
#pragma unroll
        for (int mi = 0; mi < 2; ++mi) af[mi] = *(const bf16x8*)(sA + lds_off(32 * wave + 16 * mi + r, 4 * ks + q));
#pragma unroll
        for (int ni = 0; ni < 8; ++ni) bfr[ni] = *(const bf16x8*)(sB + lds_off(16 * ni + r, 4 * ks + q));
#pragma unroll
        for (int mi = 0; mi < 2; ++mi)
#pragma unroll
            for (int ni = 0; ni < 8; ++ni) acc[mi][ni] = __builtin_amdgcn_mfma_f32_16x16x32_bf16(bfr[ni], af[mi], acc[mi][ni], 0, 0, 0);
    }
}

#define LAS __attribute__((address_space(3)))
__device__ __forceinline__ void gemm_stage_glds(const bf16* A, int lda, const bf16* Bt, int ldb, int kt, unsigned char* stage, int wave, int lane) {
    const int rr = lane >> 3, cch = (lane & 7) ^ rr;
#pragma unroll
    for (int i = 0; i < 4; ++i) { const int pc = 4 * i + wave;
        __builtin_amdgcn_global_load_lds((const unsigned*)(A + (size_t)(8 * pc + rr) * lda + kt * 64 + cch * 8), (LAS unsigned*)(stage + pc * 1024), 16, 0, 0);
        __builtin_amdgcn_global_load_lds((const unsigned*)(Bt + (size_t)(8 * pc + rr) * ldb + kt * 64 + cch * 8), (LAS unsigned*)(stage + 16384 + pc * 1024), 16, 0, 0); }
}
__device__ __forceinline__ void gemm_core(f32x4 (&acc)[2][8], const bf16* A, int lda, const bf16* Bt, int ldb, int K, unsigned char* lds, int tid) {
    const int wave = __builtin_amdgcn_readfirstlane(tid >> 6), lane = tid & 63;
    const int nk = K >> 6;
    gemm_stage_glds(A, lda, Bt, ldb, 0, lds, wave, lane);
    asm volatile("s_waitcnt vmcnt(0)" ::: "memory");
    __syncthreads();
    for (int kt = 0; kt < nk; ++kt) {
        const int cur = kt & 1;
        if (kt + 1 < nk) gemm_stage_glds(A, lda, Bt, ldb, kt + 1, lds + (cur ^ 1) * 32768, wave, lane);
        gemm_compute_stage(acc, lds + cur * 32768, lds + cur * 32768 + 16384, wave, lane);
        asm volatile("s_waitcnt vmcnt(0)" ::: "memory");
        __syncthreads();
    }
}
__device__ __forceinline__ void acc_zero(f32x4 (&acc)[2][8]) {
#pragma unroll
    for (int mi = 0; mi < 2; ++mi)
#pragma unroll
        for (int ni = 0; ni < 8; ++ni) acc[mi][ni] = (f32x4){0.f, 0.f, 0.f, 0.f};
}
__device__ __forceinline__ float rstd_from_ssq8(const float* ssq, int tok) {
    const f32x4 a = *(const f32x4*)(ssq + (size_t)tok * 8), b = *(const f32x4*)(ssq + (size_t)tok * 8 + 4);
    const float s = ((a.x + a.y) + (a.z + a.w)) + ((b.x + b.y) + (b.z + b.w));
    return rsqrt_(s * (1.0f / 1024.0f) + EPS);
}

__device__ __forceinline__ int src_col(int mode, int np) {
    if (mode == 0) return np;
    if (mode == 2) { const int h = np >> 7, j = np & 127; return j < 96 ? h * 96 + j : -1; }
    if (np < 1024) { const int cblk = np >> 7, j = np & 127; return j < 64 ? 64 * cblk + j : 512 + 64 * cblk + (j - 64); }
    if (np < 1408) return np;
    if (np < 1536) { const int j = np - 1408; return j < 32 ? 1408 + j : -1; }
    return 1440 + (np - 1536);
}
__device__ __forceinline__ void p0_transpose_item(const float* W, int K, int N, bf16* Wt, int mode, const float* g, int item, float* scr, int lane) {
    const int nblk_k = K / 64, nb = item / nblk_k, kb = item % nblk_k, k0 = 64 * kb, n0 = 32 * nb;
    const int n = src_col(mode, n0 + (lane & 31));
    float wv[32], gv[32];
#pragma unroll
    for (int i = 0; i < 32; ++i) { const int kk = 2 * i + (lane >> 5); wv[i] = n >= 0 ? W[(size_t)(k0 + kk) * N + n] : 0.f; gv[i] = g ? g[k0 + kk] : 1.f; }
#pragma unroll
    for (int i = 0; i < 32; ++i) { const int kk = 2 * i + (lane >> 5); scr[kk * 33 + (lane & 31)] = wv[i] * gv[i]; }
    __builtin_amdgcn_s_waitcnt(0xC07F); asm volatile("" ::: "memory");
    const int cch = lane & 7;
#pragma unroll
    for (int j = 0; j < 4; ++j) { const int nl = (lane >> 3) + 8 * j; const float* s = scr + (8 * cch) * 33 + nl;
        u32x4 o; o.x = pk2(s[0 * 33], s[1 * 33]); o.y = pk2(s[2 * 33], s[3 * 33]); o.z = pk2(s[4 * 33], s[5 * 33]); o.w = pk2(s[6 * 33], s[7 * 33]);
        *(u32x4*)(Wt + (size_t)(n0 + nl) * K + k0 + 8 * cch) = o; }
    __builtin_amdgcn_s_waitcnt(0xC07F); asm volatile("" ::: "memory");
}
struct WDesc { int in_idx, K, N, Np, mode, g_idx; size_t off; };
__device__ __forceinline__ void phase_prologue(const Ctx& c0) {
    Ctx c = reopaque(c0);
    const int gw = c.vb * 4 + c.wave, NGW = c.G * 4;
    float* scr = (float*)(c.lds + c.wave * 8704);
    const WDesc wd[7] = {
        {3, 1024, NIN, NINP, 1, 2, 0}, {8, 512, 1024, 1024, 0, -1, OFF_WCO}, {10, 256, 768, 1024, 2, 9, OFF_WUQ}, {12, 128, 1024, 1024, 0, 11, OFF_WUKV},
        {15, 512, 1024, 1024, 0, -1, OFF_WMLA}, {16, 1024, 1024, 1024, 0, -1, OFF_WOUT}, {18, 1024, 2048, 2048, 0, 17, OFF_WPQ}};
    constexpr int ITEMS_PER_LAYER = (1024 / 64) * (NINP / 32) + (512 / 64) * 32 + (256 / 64) * 32 + (128 / 64) * 32 + (512 / 64) * 32 + (1024 / 64) * 32 + (1024 / 64) * 64;
    for (int it = gw; it < 2 * ITEMS_PER_LAYER; it += NGW) {
        const int l = it >= ITEMS_PER_LAYER ? 1 : 0; int r = it - l * ITEMS_PER_LAYER;
        const float* W = nullptr; const float* g = nullptr; bf16* Wt = nullptr; int K = 64, N = 32, mode = 0, rr = 0;
#pragma unroll
        for (int m = 0; m < 7; ++m) {
            const int items = (wd[m].K / 64) * (wd[m].Np / 32);
            if (r >= 0 && r < items) { K = wd[m].K; N = wd[m].N; mode = wd[m].mode; rr = r;
                W = c.in[wd[m].in_idx] + (size_t)l * wd[m].K * wd[m].N; g = wd[m].g_idx >= 0 ? c.in[wd[m].g_idx >= 0 ? wd[m].g_idx : 0] + (size_t)l * wd[m].K : nullptr;
                Wt = (bf16*)(c.ws + WS_WIN + l * SZ_WLAYER + wd[m].off); }
            r -= items;
        }
        p0_transpose_item(W, K, N, Wt, mode, g, rr, scr, c.lane);
    }
    const int gt = c.vb * NTHREADS + c.tid, NGT = c.G * NTHREADS;
    for (int l = 0; l < 2; ++l) {
        const float* src = c.in[19] + (size_t)l * 262144; bf16* dst = (bf16*)(c.ws + WS_WIN + l * SZ_WLAYER + OFF_KEYS);
        for (int i = gt; i < 262144 / 8; i += NGT) { const f32x4 a = *(const f32x4*)(src + i * 8), b = *(const f32x4*)(src + i * 8 + 4);
            u32x4 o; o.x = pk2(a.x, a.y); o.y = pk2(a.z, a.w); o.z = pk2(b.x, b.y); o.w = pk2(b.z, b.w); *(u32x4*)(dst + i * 8) = o; }
    }
    for (int l = 0; l < 2; ++l)
        for (int uv = 0; uv < 2; ++uv) {
            const float* src = c.in[20 + uv] + (size_t)l * NEXP * 1024; unsigned char* dst = c.ws + WS_TAB + (size_t)(l * 2 + uv) * SZ_TAB;
            f32x4 g4[4];
#pragma unroll
            for (int j = 0; j < 4; ++j) { const float sc = uv == 0 ? U_SCALE : TAB_SCALE; g4[j] = (f32x4){sc, sc, sc, sc}; if (uv == 0) g4[j] = g4[j] * *(const f32x4*)(c.in[17] + l * 1024 + 256 * j + 4 * c.lane); }
            for (int row = gw; row < NEXP; row += 2 * NGW) {
                const float* sp = src + (size_t)row * 1024 + 4 * c.lane; const int row2 = row + NGW; const bool two = row2 < NEXP;
                const float* sp2 = src + (size_t)(two ? row2 : row) * 1024 + 4 * c.lane;
                f32x4 a[4], b[4];
#pragma unroll
                for (int j = 0; j < 4; ++j) { a[j] = *(const f32x4*)(sp + 256 * j); b[j] = *(const f32x4*)(sp2 + 256 * j); }
#pragma unroll
                for (int j = 0; j < 4; ++j) { const f32x4 v = a[j] * g4[j];
                    *(unsigned*)(dst + (size_t)row * 1024 + 256 * j + 4 * c.lane) = uv == 0 ? pack_i8x4(v) : (unsigned)__builtin_amdgcn_cvt_pk_fp8_f32(v.z, v.w, __builtin_amdgcn_cvt_pk_fp8_f32(v.x, v.y, 0, false), true); }
                if (two) {
#pragma unroll
                    for (int j = 0; j < 4; ++j) { const f32x4 v = b[j] * g4[j];
                        *(unsigned*)(dst + (size_t)row2 * 1024 + 256 * j + 4 * c.lane) = uv == 0 ? pack_i8x4(v) : (unsigned)__builtin_amdgcn_cvt_pk_fp8_f32(v.z, v.w, __builtin_amdgcn_cvt_pk_fp8_f32(v.x, v.y, 0, false), true); } }
            }
        }
    { float* rope = WSP(float, WS_ROPE);
      for (int i = gt; i < L * 16; i += NGT) { const int pos = i >> 4, j = i & 15;
          const float inv = 1.0f / __builtin_exp2f((float)j * 0.8304820237218406f);
          const float angf = (float)pos * inv; const double ang = (double)angf;
          const double nq = __builtin_rint(ang * 0.63661977236758134308);
          double rr = __builtin_fma(-nq, 1.57079632679489655800e+00, ang); rr = __builtin_fma(-nq, 6.12323399573676603587e-17, rr);
          const double r2 = rr * rr;
          double sp = -1.0 / 1307674368000.0; sp = sp * r2 + 1.0 / 6227020800.0; sp = sp * r2 - 1.0 / 39916800.0; sp = sp * r2 + 1.0 / 362880.0; sp = sp * r2 - 1.0 / 5040.0; sp = sp * r2 + 1.0 / 120.0; sp = sp * r2 - 1.0 / 6.0; sp = sp * r2 * rr + rr;
          double cp = 1.0 / 87178291200.0; cp = cp * r2 - 1.0 / 479001600.0; cp = cp * r2 + 1.0 / 3628800.0; cp = cp * r2 - 1.0 / 40320.0; cp = cp * r2 + 1.0 / 720.0; cp = cp * r2 - 1.0 / 24.0; cp = cp * r2 + 0.5; cp = 1.0 - cp * r2;
          const int qd = ((int)nq) & 3;
          const double cv = qd == 0 ? cp : qd == 1 ? -sp : qd == 2 ? -cp : sp;
          const double sv_ = qd == 0 ? sp : qd == 1 ? cp : qd == 2 ? -sp : -cp;
          rope[2 * i] = (float)cv; rope[2 * i + 1] = (float)sv_; } }
    { bf16* hb = WSP(bf16, WS_HB); float* ssq = WSP(float, WS_SSQ);
      for (int t0_ = gw; t0_ < T; t0_ += 4 * NGW) {
          f32x4 v[4][4];
#pragma unroll
          for (int i = 0; i < 4; ++i) { const int t = t0_ + i * NGW < T ? t0_ + i * NGW : t0_; const int b = t / L, pos = t % L;
              const float* src = pos < NMETA ? c.in[1] + (size_t)pos * D : c.in[0] + ((size_t)b * SEQ + (pos - NMETA)) * D;
#pragma unroll
              for (int j = 0; j < 4; ++j) v[i][j] = *(const f32x4*)(src + j * 256 + c.lane * 4); }
#pragma unroll
          for (int i = 0; i < 4; ++i) { const int t = t0_ + i * NGW;
              if (t < T) { float s = 0.f;
#pragma unroll
                  for (int j = 0; j < 4; ++j) { const f32x4 x = v[i][j]; u32x2 o; o.x = pk2(x.x, x.y); o.y = pk2(x.z, x.w); *(u32x2*)(hb + (size_t)t * D + j * 256 + c.lane * 4) = o;
                      s += (x.x * x.x + x.y * x.y) + (x.z * x.z + x.w * x.w); }
                  s = wave_sum(s);
                  if (c.lane < 8) ssq[(size_t)t * 8 + c.lane] = c.lane == 0 ? s : 0.f; } }
      } }
}

__device__ __forceinline__ void phase_A(const Ctx& c0, int l) {
    Ctx c = reopaque(c0);
    const bf16* hb = WSP(bf16, WS_HB); const bf16* Wt = (const bf16*)(c.ws + WS_WIN + l * SZ_WLAYER);
    const float* ssq = WSP(float, WS_SSQ);
    bf16* uglu = WSP(bf16, WS_UGLU); bf16* cq = WSP(bf16, WS_CQ); bf16* ckv = WSP(bf16, WS_CKV); float* krope = WSP(float, WS_KROPE);
    float* ssqq = WSP(float, WS_SSQQ); float* ssqkv = WSP(float, WS_SSQKV); bf16* gates = WSP(bf16, WS_GATES);
    constexpr int NT = NINP / 128;
    const int r = c.lane & 15, q = c.lane >> 4;
    const int xcd = c.vb / (c.G / 8), lb = c.vb % (c.G / 8), xm = xcd & 1, xn = xcd >> 1;
    const int m_lo = xm ? (MT + 1) / 2 : 0, m_cnt = xm ? MT / 2 : (MT + 1) / 2;
    for (int j = lb; j < m_cnt * 7; j += c.G / 8) {
        const int mt = m_lo + j / 7, nt = xn * 7 + j % 7;
        f32x4 acc[2][8]; acc_zero(acc);
        gemm_core(acc, hb + (size_t)mt * 128 * D, D, Wt + (size_t)nt * 128 * D, D, D, c.lds, c.tid);
#pragma unroll
        for (int mi = 0; mi < 2; ++mi) {
            const int tok = mt * 128 + 32 * c.wave + 16 * mi + r;
            const float rs = rstd_from_ssq8(ssq, tok);
            if (nt < 8) {
#pragma unroll
                for (int ni = 0; ni < 4; ++ni) { const f32x4 v = acc[mi][ni] * rs, g = acc[mi][ni + 4] * rs;
                    u32x2 o; o.x = pk2(v.x * sigmoidf_(g.x), v.y * sigmoidf_(g.y)); o.y = pk2(v.z * sigmoidf_(g.z), v.w * sigmoidf_(g.w));
                    *(u32x2*)(uglu + (size_t)tok * DC + nt * 64 + 16 * ni + 4 * q) = o; }
            } else if (nt < 11) {
                bf16* dst = nt < 10 ? cq + (size_t)tok * QL + (nt - 8) * 128 : ckv + (size_t)tok * KVL;
                float ss = 0.f;
#pragma unroll
                for (int ni = 0; ni < 8; ++ni) { const f32x4 v = acc[mi][ni] * rs; ss += (v.x * v.x + v.y * v.y) + (v.z * v.z + v.w * v.w);
                    u32x2 o; o.x = pk2(v.x, v.y); o.y = pk2(v.z, v.w); *(u32x2*)(dst + 16 * ni + 4 * q) = o; }
                ss = quad_sum(ss);
                if (q == 0) { if (nt < 10) ssqq[(size_t)tok * 2 + (nt - 8)] = ss; else ssqkv[tok] = ss; }
            } else if (nt == 11) {
#pragma unroll
                for (int ni = 0; ni < 2; ++ni) *(f32x4*)(krope + (size_t)tok * 32 + 16 * ni + 4 * q) = acc[mi][ni] * rs;
            } else {
#pragma unroll
                for (int ni = 0; ni < 8; ++ni) { const f32x4 v = acc[mi][ni] * rs;
                    u32x2 o; o.x = pk2(sigmoidf_(v.x), sigmoidf_(v.y)); o.y = pk2(sigmoidf_(v.z), sigmoidf_(v.w));
                    *(u32x2*)(gates + (size_t)tok * 2048 + (nt - 12) * 128 + 16 * ni + 4 * q) = o; }
            }
        }
    }
}

__device__ __forceinline__ void phaseB_q_item(Ctx& c, int l, int mt, int head) {
    const bf16* cq = WSP(bf16, WS_CQ); const bf16* Wt = (const bf16*)(c.ws + WS_WIN + l * SZ_WLAYER + OFF_WUQ);
    const float* ssqq = WSP(float, WS_SSQQ); const float* rope = WSP(float, WS_ROPE); const float* qg = c.in[13] + l * QK; bf16* Qb = WSP(bf16, WS_Q);
    const int r = c.lane & 15, q = c.lane >> 4;
    f32x4 acc[2][8]; acc_zero(acc);
    gemm_core(acc, cq + (size_t)mt * 128 * QL, QL, Wt + (size_t)head * 128 * QL, QL, QL, c.lds, c.tid);
    constexpr float QSCALE = 0.10206207261596575f * 1.4426950408889634f;
#pragma unroll
    for (int mi = 0; mi < 2; ++mi) {
        const int tok = mt * 128 + 32 * c.wave + 16 * mi + r, b = tok / L, pos = tok - b * L;
        const float rs = rsqrt_((ssqq[(size_t)tok * 2] + ssqq[(size_t)tok * 2 + 1]) * (1.0f / 256.0f) + EPS);
        float ss = 0.f;
#pragma unroll
        for (int ni = 0; ni < 6; ++ni) { acc[mi][ni] = acc[mi][ni] * rs; const f32x4 v = acc[mi][ni]; ss += (v.x * v.x + v.y * v.y) + (v.z * v.z + v.w * v.w); }
        ss = quad_sum(ss);
        const float rn = rsqrt_(ss * (1.0f / 96.0f) + EPS) * QSCALE;
#pragma unroll
        for (int ni = 0; ni < 6; ++ni) { const f32x4 g = *(const f32x4*)(qg + 16 * ni + 4 * q); acc[mi][ni] = acc[mi][ni] * g * rn; }
        const f32x4 cs0 = *(const f32x4*)(rope + ((size_t)pos * 16 + 4 * q) * 2), cs1 = *(const f32x4*)(rope + ((size_t)pos * 16 + 4 * q) * 2 + 4);
        const float co[4] = {cs0.x, cs0.z, cs1.x, cs1.z}, si[4] = {cs0.y, cs0.w, cs1.y, cs1.w};
        f32x4 x1 = acc[mi][4], x2 = acc[mi][5];
#pragma unroll
        for (int e = 0; e < 4; ++e) { const float a = x1[e], bb = x2[e]; x1[e] = a * co[e] - bb * si[e]; x2[e] = bb * co[e] + a * si[e]; }
        acc[mi][4] = x1; acc[mi][5] = x2;
        bf16* dst = Qb + (((size_t)b * NH + head) * L + pos) * QK;
#pragma unroll
        for (int ni = 0; ni < 6; ++ni) { const f32x4 v = acc[mi][ni]; u32x2 o; o.x = pk2(v.x, v.y); o.y = pk2(v.z, v.w); *(u32x2*)(dst + 16 * ni + 4 * q) = o; }
    }
}
__device__ __forceinline__ void phaseB_kv_item(Ctx& c, int l, int mt, int head) {
    const bf16* ckv = WSP(bf16, WS_CKV); const bf16* Wt = (const bf16*)(c.ws + WS_WIN + l * SZ_WLAYER + OFF_WUKV);
    const float* ssqkv = WSP(float, WS_SSQKV); const float* rope = WSP(float, WS_ROPE); const float* kg = c.in[14] + l * QK; const float* krope = WSP(float, WS_KROPE);
    bf16* Kb = WSP(bf16, WS_K); bf16* Vt = WSP(bf16, WS_VT);
    const int tid = c.tid, wave = c.wave, lane = c.lane, r = lane & 15, q = lane >> 4;
    unsigned char* lds = c.lds;
    f32x4 ak[2][4], av[2][4];
#pragma unroll
    for (int mi = 0; mi < 2; ++mi)
#pragma unroll
        for (int ni = 0; ni < 4; ++ni) { ak[mi][ni] = (f32x4){0.f, 0.f, 0.f, 0.f}; av[mi][ni] = (f32x4){0.f, 0.f, 0.f, 0.f}; }
    { const int chunk = tid & 7, row0 = tid >> 3;
      const bf16* pa = ckv + ((size_t)mt * 128 + row0) * KVL + chunk * 8; const bf16* pb = Wt + ((size_t)head * 128 + row0) * KVL + chunk * 8;
#pragma unroll
      for (int s = 0; s < 2; ++s)
#pragma unroll
          for (int i = 0; i < 4; ++i) { *(u32x4*)(lds + s * 32768 + lds_off(row0 + 32 * i, chunk)) = *(const u32x4*)(pa + (size_t)(32 * i) * KVL + s * 64);
              *(u32x4*)(lds + s * 32768 + 16384 + lds_off(row0 + 32 * i, chunk)) = *(const u32x4*)(pb + (size_t)(32 * i) * KVL + s * 64); }
    }
    __syncthreads();
#pragma unroll
    for (int s = 0; s < 2; ++s)
#pragma unroll
        for (int ks = 0; ks < 2; ++ks) {
            const unsigned char* sA = lds + s * 32768; const unsigned char* sB = sA + 16384;
            bf16x8 af[2], bfr[8];
#pragma unroll
            for (int mi = 0; mi < 2; ++mi) af[mi] = *(const bf16x8*)(sA + lds_off(32 * wave + 16 * mi + r, 4 * ks + q));
#pragma unroll
            for (int ni = 0; ni < 8; ++ni) bfr[ni] = *(const bf16x8*)(sB + lds_off(16 * ni + r, 4 * ks + q));
#pragma unroll
            for (int mi = 0; mi < 2; ++mi)
#pragma unroll
                for (int ni = 0; ni < 4; ++ni) { ak[mi][ni] = __builtin_amdgcn_mfma_f32_16x16x32_bf16(bfr[ni], af[mi], ak[mi][ni], 0, 0, 0);
                    av[mi][ni] = __builtin_amdgcn_mfma_f32_16x16x32_bf16(af[mi], bfr[ni + 4], av[mi][ni], 0, 0, 0); }
        }
    __syncthreads();
#pragma unroll
    for (int mi = 0; mi < 2; ++mi) {
        const int tok0 = mt * 128 + 32 * wave + 16 * mi, b = tok0 / L, pos0 = tok0 - b * L;
        { const int tok = tok0 + r, pos = pos0 + r;
          const float rs = rsqrt_(ssqkv[tok] * (1.0f / 128.0f) + EPS);
          const f32x4 kr1 = *(const f32x4*)(krope + (size_t)tok * 32 + 4 * q), kr2 = *(const f32x4*)(krope + (size_t)tok * 32 + 16 + 4 * q);
          float ss = (kr1.x * kr1.x + kr1.y * kr1.y) + (kr1.z * kr1.z + kr1.w * kr1.w) + (kr2.x * kr2.x + kr2.y * kr2.y) + (kr2.z * kr2.z + kr2.w * kr2.w);
#pragma unroll
          for (int ni = 0; ni < 4; ++ni) { ak[mi][ni] = ak[mi][ni] * rs; const f32x4 v = ak[mi][ni]; ss += (v.x * v.x + v.y * v.y) + (v.z * v.z + v.w * v.w); }
          ss = quad_sum(ss);
          const float rn = rsqrt_(ss * (1.0f / 96.0f) + EPS);
          bf16* dst = Kb + (((size_t)b * NH + head) * L + pos) * QK;
#pragma unroll
          for (int ni = 0; ni < 4; ++ni) { const f32x4 g = *(const f32x4*)(kg + 16 * ni + 4 * q); const f32x4 v = ak[mi][ni] * g * rn;
              u32x2 o; o.x = pk2(v.x, v.y); o.y = pk2(v.z, v.w); *(u32x2*)(dst + 16 * ni + 4 * q) = o; }
          const f32x4 g1 = *(const f32x4*)(kg + 64 + 4 * q), g2 = *(const f32x4*)(kg + 80 + 4 * q);
          f32x4 x1 = kr1 * g1 * rn, x2 = kr2 * g2 * rn;
          const f32x4 cs0 = *(const f32x4*)(rope + ((size_t)pos * 16 + 4 * q) * 2), cs1 = *(const f32x4*)(rope + ((size_t)pos * 16 + 4 * q) * 2 + 4);
          const float co[4] = {cs0.x, cs0.z, cs1.x, cs1.z}, si[4] = {cs0.y, cs0.w, cs1.y, cs1.w};
#pragma unroll
          for (int e = 0; e < 4; ++e) { const float a = x1[e], bb = x2[e]; x1[e] = a * co[e] - bb * si[e]; x2[e] = bb * co[e] + a * si[e]; }
          u32x2 o1, o2; o1.x = pk2(x1.x, x1.y); o1.y = pk2(x1.z, x1.w); o2.x = pk2(x2.x, x2.y); o2.y = pk2(x2.z, x2.w);
          *(u32x2*)(dst + 64 + 4 * q) = o1; *(u32x2*)(dst + 80 + 4 * q) = o2; }
        { const f32x4 sq = *(const f32x4*)(ssqkv + tok0 + 4 * q);
          f32x4 rs4; rs4.x = rsqrt_(sq.x * (1.0f / 128.0f) + EPS); rs4.y = rsqrt_(sq.y * (1.0f / 128.0f) + EPS); rs4.z = rsqrt_(sq.z * (1.0f / 128.0f) + EPS); rs4.w = rsqrt_(sq.w * (1.0f / 128.0f) + EPS);
#pragma unroll
          for (int ni = 0; ni < 4; ++ni) { const f32x4 v = av[mi][ni] * rs4; u32x2 o; o.x = pk2(v.x, v.y); o.y = pk2(v.z, v.w);
              *(u32x2*)(Vt + (((size_t)b * NH + head) * VD + 16 * ni + r) * L + pos0 + 4 * q) = o; } }
    }
}
__device__ __forceinline__ u32x4 conv_row(const bf16* uglu, int b, int pos, int ch) {
    u32x4 xv = (u32x4){0u, 0u, 0u, 0u};
    if (pos >= 0) xv = *(const u32x4*)(uglu + ((size_t)b * L + pos) * DC + ch);
    return xv;
}
__device__ __forceinline__ void conv_fma(float (&a)[8], const u32x4 xv, const f32x4 w0, const f32x4 w1) {
    a[0] += bf_lo(xv.x) * w0.x; a[1] += bf_hi(xv.x) * w0.y; a[2] += bf_lo(xv.y) * w0.z; a[3] += bf_hi(xv.y) * w0.w;
    a[4] += bf_lo(xv.z) * w1.x; a[5] += bf_hi(xv.z) * w1.y; a[6] += bf_lo(xv.w) * w1.z; a[7] += bf_hi(xv.w) * w1.w;
}
__device__ __forceinline__ void phaseB_conv_item(Ctx& c, int l, int grp) {
    const bf16* uglu = WSP(bf16, WS_UGLU); bf16* u2 = WSP(bf16, WS_U2);
    const float* cw = c.in[4] + (size_t)l * CW * DC; const float* cb = c.in[5] + l * DC; const float* lg = c.in[6] + l * DC; const float* lb = c.in[7] + l * DC;
    const int tok0 = grp * 4, b = tok0 / L, pos0 = tok0 - b * L, ch = c.lane * 8;
    float acc[4][8];
    { const f32x4 b0 = *(const f32x4*)(cb + ch), b1 = *(const f32x4*)(cb + ch + 4);
#pragma unroll
      for (int d = 0; d < 4; ++d) { acc[d][0] = b0.x; acc[d][1] = b0.y; acc[d][2] = b0.z; acc[d][3] = b0.w; acc[d][4] = b1.x; acc[d][5] = b1.y; acc[d][6] = b1.z; acc[d][7] = b1.w; } }
    const int base = pos0 - 30;
    u32x4 x0 = conv_row(uglu, b, base + 0, ch), x1 = conv_row(uglu, b, base + 1, ch), x2 = conv_row(uglu, b, base + 2, ch),
          x3 = conv_row(uglu, b, base + 3, ch), x4 = conv_row(uglu, b, base + 4, ch), x5;
    const float* wp = cw + ch;
#pragma unroll 1
    for (int w = 0; w < CW; ++w) {
        x5 = conv_row(uglu, b, (w + 5 <= 33) ? base + w + 5 : -1, ch);
        const f32x4 w0 = *(const f32x4*)wp, w1 = *(const f32x4*)(wp + 4); wp += DC;
        conv_fma(acc[0], x0, w0, w1); conv_fma(acc[1], x1, w0, w1); conv_fma(acc[2], x2, w0, w1); conv_fma(acc[3], x3, w0, w1);
        x0 = x1; x1 = x2; x2 = x3; x3 = x4; x4 = x5;
    }
    const f32x4 g0 = *(const f32x4*)(lg + ch), g1 = *(const f32x4*)(lg + ch + 4), e0 = *(const f32x4*)(lb + ch), e1 = *(const f32x4*)(lb + ch + 4);
    const float gg[8] = {g0.x, g0.y, g0.z, g0.w, g1.x, g1.y, g1.z, g1.w}, be[8] = {e0.x, e0.y, e0.z, e0.w, e1.x, e1.y, e1.z, e1.w};
#pragma unroll
    for (int d = 0; d < 4; ++d) {
        float s = 0.f;
#pragma unroll
        for (int j = 0; j < 8; ++j) s += acc[d][j];
        const float mu = wave_sum(s) * (1.0f / 512.0f);
        float vq = 0.f;
#pragma unroll
        for (int j = 0; j < 8; ++j) { acc[d][j] -= mu; vq += acc[d][j] * acc[d][j]; }
        const float rstd = rsqrt_(wave_sum(vq) * (1.0f / 512.0f) + EPS);
        float y[8];
#pragma unroll
        for (int j = 0; j < 8; ++j) { const float v = acc[d][j] * rstd * gg[j] + be[j]; y[j] = v * sigmoidf_(v); }
        u32x4 o; o.x = pk2(y[0], y[1]); o.y = pk2(y[2], y[3]); o.z = pk2(y[4], y[5]); o.w = pk2(y[6], y[7]);
        *(u32x4*)(u2 + (size_t)(tok0 + d) * DC + ch) = o;
    }
}
__device__ __forceinline__ void phase_B(const Ctx& c0, int l) {
    Ctx c = reopaque(c0);
    constexpr int NQ = MT * NH, NKV = MT * NH, NCV = T / 16;
    for (int it = c.vb; it < NQ + NKV + NCV; it += c.G) {
        if (it < NQ) phaseB_q_item(c, l, it / NH, it % NH);
        else if (it < NQ + NKV) phaseB_kv_item(c, l, (it - NQ) / NH, (it - NQ) % NH);
        else phaseB_conv_item(c, l, (it - NQ - NKV) * 4 + c.wave);
    }
}

constexpr int KROW = 208, VROW = 136, ATT_STAGE = 64 * KROW + 64 * VROW;
constexpr int ATT_ITEMS = NB * NH * 17;
__device__ __forceinline__ void phase_C(const Ctx& c0, int l) {
    Ctx c = reopaque(c0);
    const bf16* Qb = WSP(bf16, WS_Q); const bf16* Kb = WSP(bf16, WS_K); const bf16* Vt = WSP(bf16, WS_VT); bf16* O = WSP(bf16, WS_O);
    unsigned* qctr = WSP(unsigned, WS_CTL) + CW_QUEUE + 64 * l;
    volatile unsigned* misc = (volatile unsigned*)(c.lds + LDS_MISC);
    const int tid = c.tid, wave = c.wave, lane = c.lane, r = lane & 15, q = lane >> 4;
    unsigned char* lds = c.lds;
    for (;;) {
        if (tid == 0) misc[4] = atomicAdd(qctr, 1u);
        __syncthreads();
        const int item = __builtin_amdgcn_readfirstlane((int)misc[4]);
        __syncthreads();
        if (item >= ATT_ITEMS) break;
        const int pp = 15 - item / 64, bh = item % 64, b = bh / NH, h = bh % NH;
        const bool meta = pp < 0;
        const int r0 = meta ? 0 : 16 + 128 * pp;
        const int nfull = meta ? 0 : 2 * pp + 1 + (wave >> 1);
        const int ntiles = meta ? 1 : 2 * pp + 3;
        const bf16* Kbase = Kb + (size_t)bh * L * QK; const bf16* Vbase = Vt + (size_t)bh * VD * L;
        bf16x8 qf[2][3];
#pragma unroll
        for (int mi = 0; mi < 2; ++mi)
#pragma unroll
            for (int ks = 0; ks < 3; ++ks) qf[mi][ks] = *(const bf16x8*)(Qb + ((size_t)bh * L + r0 + 32 * wave + 16 * mi + r) * QK + 32 * ks + 8 * q);
        float m[2] = {-1e30f, -1e30f}, lsum[2] = {0.f, 0.f};
        f32x4 o[2][4];
#pragma unroll
        for (int mi = 0; mi < 2; ++mi)
#pragma unroll
            for (int dt = 0; dt < 4; ++dt) o[mi][dt] = (f32x4){0.f, 0.f, 0.f, 0.f};
        u32x4 rk[3], rv[2];
        auto gload = [&](int kt) {
#pragma unroll
            for (int i = 0; i < 3; ++i) { const int id = tid + 256 * i, row = id / 12, cc = id % 12; rk[i] = *(const u32x4*)(Kbase + (size_t)(kt * 64 + row) * QK + cc * 8); }
#pragma unroll
            for (int i = 0; i < 2; ++i) { const int id = tid + 256 * i, row = id >> 3, cc = id & 7; rv[i] = *(const u32x4*)(Vbase + (size_t)row * L + kt * 64 + cc * 8); }
        };
        auto lstore = [&](int s) {
            unsigned char* st = lds + s * ATT_STAGE;
#pragma unroll
            for (int i = 0; i < 3; ++i) { const int id = tid + 256 * i, row = id / 12, cc = id % 12; *(u32x4*)(st + row * KROW + cc * 16) = rk[i]; }
#pragma unroll
            for (int i = 0; i < 2; ++i) { const int id = tid + 256 * i, row = id >> 3, cc = id & 7; u32x2* d = (u32x2*)(st + 64 * KROW + row * VROW + cc * 16); d[0] = (u32x2){rv[i].x, rv[i].y}; d[1] = (u32x2){rv[i].z, rv[i].w}; }
        };
        gload(0); lstore(0);
#pragma unroll
        for (int mi = 0; mi < 2; ++mi)
#pragma unroll
            for (int ks = 0; ks < 3; ++ks) asm volatile("" : "+v"(qf[mi][ks]));
        __syncthreads();
        for (int kt = 0; kt < ntiles; ++kt) {
            const int cur = kt & 1;
            if (kt + 1 < ntiles) gload(kt + 1);
            const unsigned char* sK = lds + cur * ATT_STAGE; const unsigned char* sV = sK + 64 * KROW;
            const bool full = kt < nfull;
            if (kt <= nfull) {
                f32x4 s[2][4];
#pragma unroll
                for (int kh = 0; kh < 2; ++kh) {
                    bf16x8 kf[2][3];
#pragma unroll
                    for (int kk = 0; kk < 2; ++kk) if ((kh == 0 && kk == 0) || full) {
#pragma unroll
                        for (int ks = 0; ks < 3; ++ks) kf[kk][ks] = *(const bf16x8*)(sK + (16 * (2 * kh + kk) + r) * KROW + 64 * ks + 16 * q); }
#pragma unroll
                    for (int kk = 0; kk < 2; ++kk) { const int k4 = 2 * kh + kk;
#pragma unroll
                        for (int mi = 0; mi < 2; ++mi) s[mi][k4] = (f32x4){0.f, 0.f, 0.f, 0.f};
                        if (k4 == 0 || full) {
#pragma unroll
                            for (int ks = 0; ks < 3; ++ks)
#pragma unroll
                                for (int mi = 0; mi < 2; ++mi) s[mi][k4] = __builtin_amdgcn_mfma_f32_16x16x32_bf16(kf[kk][ks], qf[mi][ks], s[mi][k4], 0, 0, 0);
                        }
                    }
                }
                u32x2 vlo[4], vhi[4];
#pragma unroll
                for (int dt = 0; dt < 4; ++dt) { const unsigned char* vp = sV + (16 * dt + r) * VROW + (4 * q) * 2;
                    vlo[dt] = *(const u32x2*)vp; vhi[dt] = (u32x2){0u, 0u}; if (full) vhi[dt] = *(const u32x2*)(vp + 32); }
                bf16x8 pf[2][2];
#pragma unroll
                for (int mi = 0; mi < 2; ++mi) {
                    float mx = fmaxf(fmaxf(s[mi][0].x, s[mi][0].y), fmaxf(s[mi][0].z, s[mi][0].w));
                    if (full) {
#pragma unroll
                        for (int k4 = 1; k4 < 4; ++k4) mx = fmaxf(mx, fmaxf(fmaxf(s[mi][k4].x, s[mi][k4].y), fmaxf(s[mi][k4].z, s[mi][k4].w)));
                    }
                    mx = quad_max(mx);
                    const float mn = fmaxf(m[mi], mx), alpha = fast_exp2(m[mi] - mn); m[mi] = mn;
                    float ps = 0.f;
#pragma unroll
                    for (int k4 = 0; k4 < 4; ++k4) {
                        if (k4 == 0 || full) { f32x4 p; p.x = fast_exp2(s[mi][k4].x - mn); p.y = fast_exp2(s[mi][k4].y - mn); p.z = fast_exp2(s[mi][k4].z - mn); p.w = fast_exp2(s[mi][k4].w - mn);
                            ps += (p.x + p.y) + (p.z + p.w); s[mi][k4] = p; }
                    }
                    lsum[mi] = lsum[mi] * alpha + ps;
#pragma unroll
                    for (int dt = 0; dt < 4; ++dt) o[mi][dt] = o[mi][dt] * alpha;
#pragma unroll
                    for (int st = 0; st < 2; ++st) { u32x4 pw;
                        pw.x = pk2(s[mi][2 * st].x, s[mi][2 * st].y); pw.y = pk2(s[mi][2 * st].z, s[mi][2 * st].w); pw.z = pk2(s[mi][2 * st + 1].x, s[mi][2 * st + 1].y); pw.w = pk2(s[mi][2 * st + 1].z, s[mi][2 * st + 1].w);
                        if (!full) { pw.z = 0u; pw.w = 0u; }
                        pf[mi][st] = __builtin_bit_cast(bf16x8, pw); }
                }
                u32x2 wlo[4], whi[4];
                if (full) {
#pragma unroll
                    for (int dt = 0; dt < 4; ++dt) { const unsigned char* vp = sV + (16 * dt + r) * VROW + (32 + 4 * q) * 2; wlo[dt] = *(const u32x2*)vp; whi[dt] = *(const u32x2*)(vp + 32); } }
#pragma unroll
                for (int dt = 0; dt < 4; ++dt) { const bf16x8 vf = __builtin_bit_cast(bf16x8, (u32x4){vlo[dt].x, vlo[dt].y, vhi[dt].x, vhi[dt].y});
#pragma unroll
                    for (int mi = 0; mi < 2; ++mi) o[mi][dt] = __builtin_amdgcn_mfma_f32_16x16x32_bf16(vf, pf[mi][0], o[mi][dt], 0, 0, 0); }
                if (full) {
#pragma unroll
                    for (int dt = 0; dt < 4; ++dt) { const bf16x8 vf = __builtin_bit_cast(bf16x8, (u32x4){wlo[dt].x, wlo[dt].y, whi[dt].x, whi[dt].y});
#pragma unroll
                        for (int mi = 0; mi < 2; ++mi) o[mi][dt] = __builtin_amdgcn_mfma_f32_16x16x32_bf16(vf, pf[mi][1], o[mi][dt], 0, 0, 0); } }
            }
            if (kt + 1 < ntiles) lstore(cur ^ 1);
            __syncthreads();
        }
#pragma unroll
        for (int mi = 0; mi < 2; ++mi) {
            const float lt = quad_sum(lsum[mi]);
            if (!meta || (wave == 0 && mi == 0)) {
                const float inv = 1.0f / lt;
                bf16* dst = O + ((size_t)b * L + r0 + 32 * wave + 16 * mi + r) * 512 + h * VD;
#pragma unroll
                for (int dt = 0; dt < 4; ++dt) { const f32x4 v = o[mi][dt] * inv; u32x2 ov; ov.x = pk2(v.x, v.y); ov.y = pk2(v.z, v.w); *(u32x2*)(dst + 16 * dt + 4 * q) = ov; }
            }
        }
    }
}

__device__ __forceinline__ int tile_tok0(int mt, int l) { return l == 1 ? mt * 128 + NMETA * ((mt >> 4) + 1) : mt * 128; }
__device__ __forceinline__ int n_mtiles(int l) { return l == 1 ? 128 : MT; }
__device__ __forceinline__ void phase_D(const Ctx& c0, int l) {
    Ctx c = reopaque(c0);
    const bf16* u2 = WSP(bf16, WS_U2); const bf16* O = WSP(bf16, WS_O); const bf16* gates = WSP(bf16, WS_GATES); bf16* merged = WSP(bf16, WS_MERGED);
    const bf16* Wco = (const bf16*)(c.ws + WS_WIN + l * SZ_WLAYER + OFF_WCO); const bf16* Wmla = (const bf16*)(c.ws + WS_WIN + l * SZ_WLAYER + OFF_WMLA);
    const int r = c.lane & 15, q = c.lane >> 4;
    for (int it = c.vb; it < n_mtiles(l) * 8; it += c.G) {
        const int mt = it / 8, nt = it % 8, tk0 = tile_tok0(mt, l);
        f32x4 acc[2][8]; acc_zero(acc);
        gemm_core(acc, u2 + (size_t)tk0 * 512, 512, Wco + (size_t)nt * 128 * 512, 512, 512, c.lds, c.tid);
#pragma unroll
        for (int mi = 0; mi < 2; ++mi) { const int tok = tk0 + 32 * c.wave + 16 * mi + r;
            const bf16* gp = gates + (size_t)tok * 2048 + nt * 128 + 4 * q; bf16* mp = merged + (size_t)tok * D + nt * 128 + 4 * q;
#pragma unroll
            for (int ni = 0; ni < 8; ++ni) { const u32x2 g = *(const u32x2*)(gp + 16 * ni); const f32x4 v = acc[mi][ni];
                u32x2 o; o.x = pk2(v.x * bf_lo(g.x), v.y * bf_hi(g.x)); o.y = pk2(v.z * bf_lo(g.y), v.w * bf_hi(g.y)); *(u32x2*)(mp + 16 * ni) = o; } }
        acc_zero(acc);
        gemm_core(acc, O + (size_t)tk0 * 512, 512, Wmla + (size_t)nt * 128 * 512, 512, 512, c.lds, c.tid);
#pragma unroll
        for (int mi = 0; mi < 2; ++mi) { const int tok = tk0 + 32 * c.wave + 16 * mi + r;
            const bf16* gp = gates + (size_t)tok * 2048 + 1024 + nt * 128 + 4 * q; bf16* mp = merged + (size_t)tok * D + nt * 128 + 4 * q;
#pragma unroll
            for (int ni = 0; ni < 8; ++ni) { const u32x2 g = *(const u32x2*)(gp + 16 * ni); const u32x2 s = *(const u32x2*)(mp + 16 * ni); const f32x4 v = acc[mi][ni];
                u32x2 o; o.x = pk2(bf_lo(s.x) + v.x * bf_lo(g.x), bf_hi(s.x) + v.y * bf_hi(g.x)); o.y = pk2(bf_lo(s.y) + v.z * bf_lo(g.y), bf_hi(s.y) + v.w * bf_hi(g.y));
                *(u32x2*)(mp + 16 * ni) = o; } }
    }
}

__device__ __forceinline__ void phase_E(const Ctx& c0, int l) {
    Ctx c = reopaque(c0);
    const bf16* merged = WSP(bf16, WS_MERGED); const bf16* Wout = (const bf16*)(c.ws + WS_WIN + l * SZ_WLAYER + OFF_WOUT);
    float* h = WSP(float, WS_H); bf16* hb = WSP(bf16, WS_HB); float* ssq = WSP(float, WS_SSQ);
    const int r = c.lane & 15, q = c.lane >> 4;
    for (int it = c.vb; it < n_mtiles(l) * 8; it += c.G) {
        const int mt = it / 8, nt = it % 8, tk0 = tile_tok0(mt, l);
        f32x4 acc[2][8];
#pragma unroll
        for (int mi = 0; mi < 2; ++mi) { const int tok = tk0 + 32 * c.wave + 16 * mi + r; const float* hp = h + (size_t)tok * D;
            if (l == 0) { const int b = tok / L, pos = tok - b * L; hp = pos < NMETA ? c.in[1] + (size_t)pos * D : c.in[0] + ((size_t)b * SEQ + (pos - NMETA)) * D; }
            hp += nt * 128 + 4 * q;
#pragma unroll
            for (int ni = 0; ni < 8; ++ni) acc[mi][ni] = *(const f32x4*)(hp + 16 * ni); }
        gemm_core(acc, merged + (size_t)tk0 * D, D, Wout + (size_t)nt * 128 * D, D, D, c.lds, c.tid);
#pragma unroll
        for (int mi = 0; mi < 2; ++mi) { const int tok = tk0 + 32 * c.wave + 16 * mi + r; float ss = 0.f;
#pragma unroll
            for (int ni = 0; ni < 8; ++ni) { float* hp = h + (size_t)tok * D + nt * 128 + 16 * ni + 4 * q; const f32x4 v = acc[mi][ni]; *(f32x4*)hp = v;
                ss += (v.x * v.x + v.y * v.y) + (v.z * v.z + v.w * v.w);
                u32x2 o; o.x = pk2(v.x, v.y); o.y = pk2(v.z, v.w); *(u32x2*)(hb + (size_t)tok * D + nt * 128 + 16 * ni + 4 * q) = o; }
            ss = quad_sum(ss);
            if (q == 0) ssq[(size_t)tok * 8 + nt] = ss; }
    }
}

__device__ __forceinline__ unsigned f2key(float f) { const unsigned u = __float_as_uint(f); return u ^ ((u >> 31) ? 0xFFFFFFFFu : 0x80000000u); }
__device__ __forceinline__ float key2f(unsigned k) { const unsigned u = (k >> 31) ? (k ^ 0x80000000u) : ~k; return __uint_as_float(u); }
__device__ __forceinline__ void top16_insert(unsigned (&lst)[16], unsigned x) {
#pragma unroll
    for (int i = 0; i < 16; ++i) { const unsigned a = lst[i]; lst[i] = a > x ? a : x; x = a > x ? x : a; }
}
__device__ __forceinline__ void ce_desc(unsigned& a, unsigned& b) { const unsigned mx = a > b ? a : b, mn = a > b ? b : a; a = mx; b = mn; }
__device__ __forceinline__ void sort16_desc(unsigned (&v)[16]) {
#pragma unroll
    for (int k = 2; k <= 16; k <<= 1)
#pragma unroll
        for (int j = k >> 1; j > 0; j >>= 1)
#pragma unroll
            for (int i = 0; i < 16; ++i) { const int p = i ^ j; if (p > i) { if ((i & k) == 0) ce_desc(v[i], v[p]); else ce_desc(v[p], v[i]); } }
}
__device__ __forceinline__ void merge_top16(unsigned (&a)[16], const unsigned (&b)[16]) {
#pragma unroll
    for (int i = 0; i < 16; ++i) a[i] = a[i] > b[15 - i] ? a[i] : b[15 - i];
#pragma unroll
    for (int j = 8; j > 0; j >>= 1)
#pragma unroll
        for (int i = 0; i < 16; ++i) { const int p = i ^ j; if (p > i) ce_desc(a[i], a[p]); }
}
__device__ __forceinline__ void phase_F(const Ctx& c0, int l) {
    Ctx c = reopaque(c0);
    const bf16* hb = WSP(bf16, WS_HB); const bf16* Wpq = (const bf16*)(c.ws + WS_WIN + l * SZ_WLAYER + OFF_WPQ); const bf16* keys = (const bf16*)(c.ws + WS_WIN + l * SZ_WLAYER + OFF_KEYS);
    const float* ssq = WSP(float, WS_SSQ); float* sv = WSP(float, WS_SV); unsigned char* si = WSP(unsigned char, WS_SI);
    const int tid = c.tid, wave = c.wave, lane = c.lane, r = lane & 15, q = lane >> 4;
    unsigned char* lds = c.lds;
    const int xcd = c.vb / (c.G / 8), lb = c.vb % (c.G / 8), xm = xcd & 1, xn = xcd >> 1, nmt = n_mtiles(l);
    const int m_lo = xm ? (nmt + 1) / 2 : 0, m_cnt = xm ? nmt / 2 : (nmt + 1) / 2;
    for (int j = lb; j < m_cnt * 4; j += c.G / 8) {
        const int mt = m_lo + j / 4, hp = xn * 4 + j % 4, tk0 = tile_tok0(mt, l);
        f32x4 acc[2][8]; acc_zero(acc);
        u32x4 kreg[2][4]; float rsv[2];
        { const int chunk = tid & 7, row0 = tid >> 3; const bf16* pb = keys + ((size_t)hp * 128 + row0) * 128 + chunk * 8;
#pragma unroll
          for (int s = 0; s < 2; ++s)
#pragma unroll
              for (int i = 0; i < 4; ++i) kreg[s][i] = *(const u32x4*)(pb + (size_t)(32 * i) * 128 + s * 64); }
#pragma unroll
        for (int mi = 0; mi < 2; ++mi) rsv[mi] = rstd_from_ssq8(ssq, tk0 + 32 * wave + 16 * mi + r);
        gemm_core(acc, hb + (size_t)tk0 * D, D, Wpq + (size_t)hp * 128 * D, D, D, lds, tid);
#pragma unroll
        for (int mi = 0; mi < 2; ++mi) { const int row = 32 * wave + 16 * mi + r; const float rs = rsv[mi];
#pragma unroll
            for (int ni = 0; ni < 8; ++ni) { const f32x4 v = acc[mi][ni] * rs; u32x2 o; o.x = pk2(v.x, v.y); o.y = pk2(v.z, v.w);
                *(u32x2*)(lds + (ni >> 2) * 32768 + lds_off(row, 2 * (ni & 3) + (q >> 1)) + 8 * (q & 1)) = o; } }
        { const int chunk = tid & 7, row0 = tid >> 3;
#pragma unroll
          for (int s = 0; s < 2; ++s)
#pragma unroll
              for (int i = 0; i < 4; ++i) *(u32x4*)(lds + s * 32768 + 16384 + lds_off(row0 + 32 * i, chunk)) = kreg[s][i]; }
        __syncthreads();
        acc_zero(acc);
        gemm_compute_stage(acc, lds, lds + 16384, wave, lane);
        gemm_compute_stage(acc, lds + 32768, lds + 32768 + 16384, wave, lane);
        __syncthreads();
        float* S = (float*)lds;
#pragma unroll
        for (int mi = 0; mi < 2; ++mi) { const int row = 32 * wave + 16 * mi + r;
#pragma unroll
            for (int ni = 0; ni < 8; ++ni) *(f32x4*)(S + row * 132 + 16 * ni + 4 * q) = acc[mi][ni]; }
        __syncthreads();
        {
            const int tl = 32 * wave + (lane & 31), half = lane >> 5;
            const float* row = S + tl * 132;
            unsigned lst[16];
#pragma unroll
            for (int g = 0; g < 4; ++g) {
                unsigned cur[16];
#pragma unroll
                for (int j = 0; j < 4; ++j) { const int col = 64 * half + 16 * g + 4 * j; const f32x4 v = *(const f32x4*)(row + col);
                    cur[4 * j] = (f2key(v.x) & ~127u) | (unsigned)(127 - col); cur[4 * j + 1] = (f2key(v.y) & ~127u) | (unsigned)(127 - (col + 1));
                    cur[4 * j + 2] = (f2key(v.z) & ~127u) | (unsigned)(127 - (col + 2)); cur[4 * j + 3] = (f2key(v.w) & ~127u) | (unsigned)(127 - (col + 3)); }
                sort16_desc(cur);
                if (g == 0) {
#pragma unroll
                    for (int i = 0; i < 16; ++i) lst[i] = cur[i];
                } else merge_top16(lst, cur);
            }
            unsigned oth[16];
#pragma unroll
            for (int i = 0; i < 16; ++i) { auto rr = __builtin_amdgcn_permlane32_swap(lst[i], lst[i], false, false); oth[i] = half == 0 ? rr[1] : rr[0]; }
            merge_top16(lst, oth);
            if (half == 0) {
                const int tok = tk0 + tl;
                unsigned idx[16]; float val[16];
#pragma unroll
                for (int i = 0; i < 16; ++i) { idx[i] = 127u - (lst[i] & 127u); val[i] = row[idx[i]]; }
                float* svp = sv + ((size_t)tok * 16 + hp) * 16;
#pragma unroll
                for (int i = 0; i < 4; ++i) *(f32x4*)(svp + 4 * i) = (f32x4){val[4 * i], val[4 * i + 1], val[4 * i + 2], val[4 * i + 3]};
                u32x4 pi;
                pi.x = idx[0] | (idx[1] << 8) | (idx[2] << 16) | (idx[3] << 24); pi.y = idx[4] | (idx[5] << 8) | (idx[6] << 16) | (idx[7] << 24);
                pi.z = idx[8] | (idx[9] << 8) | (idx[10] << 16) | (idx[11] << 24); pi.w = idx[12] | (idx[13] << 8) | (idx[14] << 16) | (idx[15] << 24);
                *(u32x4*)(si + ((size_t)tok * 16 + hp) * 16) = pi;
            }
        }
        __syncthreads();
    }
}

__device__ __forceinline__ void phase_F3(const Ctx& c0, int l) {
    Ctx c = reopaque(c0);
    const float* sv = WSP(float, WS_SV); const unsigned char* si = WSP(unsigned char, WS_SI); int* eidx = WSP(int, WS_EIDX); float* gw = WSP(float, WS_GW); unsigned char* stb = WSP(unsigned char, WS_STB);
    float* lsv = (float*)c.lds;
    unsigned char* lsi = c.lds + 256 * 33 * 4;
    const int tid = c.tid;
    const int ntok = l == 1 ? NB * SEQ : T;
    for (int base = c.vb * NTHREADS; base < ntok * 8; base += c.G * NTHREADS) {
        const int thc = base + tid, tkc = thc >> 3;
        const int th = (l == 1 ? tkc + NMETA * ((tkc >> 11) + 1) : tkc) * 8 + (thc & 7);
        float a[16], b[16];
#pragma unroll
        for (int i = 0; i < 4; ++i) { const f32x4 x = *(const f32x4*)(sv + (size_t)th * 32 + 4 * i), y = *(const f32x4*)(sv + (size_t)th * 32 + 16 + 4 * i);
            a[4 * i] = x.x; a[4 * i + 1] = x.y; a[4 * i + 2] = x.z; a[4 * i + 3] = x.w; b[4 * i] = y.x; b[4 * i + 1] = y.y; b[4 * i + 2] = y.z; b[4 * i + 3] = y.w; }
        const u32x4 ia = *(const u32x4*)(si + (size_t)th * 32), ib = *(const u32x4*)(si + (size_t)th * 32 + 16);
#pragma unroll
        for (int i = 0; i < 16; ++i) { lsv[tid * 33 + i] = a[i]; lsv[tid * 33 + 16 + i] = b[i]; }
        *(u32x4*)(lsi + tid * 32) = ia; *(u32x4*)(lsi + tid * 32 + 16) = ib;
        unsigned lst[16], g2[16], g3[16], g4[16];
#pragma unroll
        for (int j = 0; j < 16; ++j) lst[j] = (f2key(a[0] + b[j]) & ~255u) | (unsigned)(255 - j);
#pragma unroll
        for (int i = 1; i < 16; ++i) g2[i - 1] = (f2key(a[i] + b[0]) & ~255u) | (unsigned)(255 - i * 16);
        g2[15] = 0u;
        { int n = 0;
#pragma unroll
          for (int i = 1; i < 16; ++i)
#pragma unroll
              for (int j = 1; j < 16; ++j)
                  if ((i + 1) * (j + 1) <= 16) { const unsigned key = (f2key(a[i] + b[j]) & ~255u) | (unsigned)(255 - (i * 16 + j)); if (n < 16) g3[n] = key; else g4[n - 16] = key; ++n; }
#pragma unroll
          for (int k = 3; k < 16; ++k) g4[k] = 0u; }
        sort16_desc(g3); sort16_desc(g4);
        merge_top16(lst, g2); merge_top16(g3, g4); merge_top16(lst, g3);
        __builtin_amdgcn_s_waitcnt(0xC07F); asm volatile("" ::: "memory");
        float s[16]; int e[16];
#pragma unroll
        for (int k = 0; k < 16; ++k) { const unsigned code = 255u - (lst[k] & 255u); const int i = code >> 4, j = code & 15;
            s[k] = lsv[tid * 33 + i] + lsv[tid * 33 + 16 + j]; e[k] = (int)lsi[tid * 32 + i] * 128 + (int)lsi[tid * 32 + 16 + j]; }
        float mx = s[0];
#pragma unroll
        for (int k = 1; k < 16; ++k) mx = fmaxf(mx, s[k]);
        float sum = 0.f;
#pragma unroll
        for (int k = 0; k < 16; ++k) { s[k] = fast_exp2((s[k] - mx) * 1.4426950409f); sum += s[k]; }
        const float inv = 1.0f / sum;
        typedef unsigned long long u64;
        u64 hlo = 0ull, hhi = 0ull;
#pragma unroll
        for (int k = 0; k < 16; ++k) { const int sl = e[k] >> 10; if (sl < 8) hlo += 1ull << (8 * sl); else hhi += 1ull << (8 * (sl - 8)); }
        u64 ilo = hlo, ihi = hhi;
#pragma unroll
        for (int d = 1; d < 8; d <<= 1) { const u64 a_ = __shfl_up(ilo, d, 8), b_ = __shfl_up(ihi, d, 8); if ((tid & 7) >= d) { ilo += a_; ihi += b_; } }
        const u64 tlo = __shfl(ilo, 7, 8), thi = __shfl(ihi, 7, 8);
        const u64 ones = 0x0101010101010101ull;
        const u64 inlo = tlo * ones, inhi = thi * ones + (inlo >> 56) * ones;
        const u64 stlo = inlo - tlo, sthi = inhi - thi;
        u64 rlo = stlo + (ilo - hlo), rhi = sthi + (ihi - hhi);
        const int tokn = th >> 3;
#pragma unroll
        for (int k = 0; k < 16; ++k) { const int sl = e[k] >> 10; int pos;
            if (sl < 8) { pos = (int)((rlo >> (8 * sl)) & 255ull); rlo += 1ull << (8 * sl); } else { pos = (int)((rhi >> (8 * (sl - 8))) & 255ull); rhi += 1ull << (8 * (sl - 8)); }
            eidx[(size_t)tokn * 128 + pos] = e[k]; gw[(size_t)tokn * 128 + pos] = s[k] * inv; }
        if ((tid & 7) == 0) { u64* sp = (u64*)(stb + (size_t)tokn * 16); sp[0] = stlo; sp[1] = sthi; }
        __builtin_amdgcn_s_waitcnt(0xC07F); asm volatile("" ::: "memory");
    }
}

typedef float f32x2 __attribute__((ext_vector_type(2)));
constexpr int G2_WSTRIDE = 14336, G2_MAXTOK = 9;
__device__ __forceinline__ float fp8dot4(unsigned w, unsigned x01, unsigned x23, float acc) {
    const bf16x2 lo = __builtin_amdgcn_cvt_scalef32_pk_bf16_fp8(w, 1.0f, false), hi = __builtin_amdgcn_cvt_scalef32_pk_bf16_fp8(w, 1.0f, true);
    acc = __builtin_amdgcn_fdot2_f32_bf16(lo, __builtin_bit_cast(bf16x2, x01), acc, false);
    return __builtin_amdgcn_fdot2_f32_bf16(hi, __builtin_bit_cast(bf16x2, x23), acc, false);
}
__device__ __forceinline__ float reduce8_transposed(const float (&p)[8], int lane) {
    float s[4];
#pragma unroll
    for (int k = 0; k < 4; ++k) { auto r = __builtin_amdgcn_permlane32_swap(__float_as_uint(p[k]), __float_as_uint(p[k + 4]), false, false); s[k] = __uint_as_float(r[0]) + __uint_as_float(r[1]); }
    float t[2];
#pragma unroll
    for (int k = 0; k < 2; ++k) { auto r = __builtin_amdgcn_permlane16_swap(__float_as_uint(s[k]), __float_as_uint(s[k + 2]), false, false); t[k] = __uint_as_float(r[0]) + __uint_as_float(r[1]); }
    const float u0 = t[0] + dpp<0x128>(t[0]), u1 = t[1] + dpp<0x128>(t[1]);
    float r = (lane & 8) ? u1 : u0;
    r += dpp<0xB1>(r); r += dpp<0x4E>(r); r += dpp<0x141>(r);
    return r;
}
typedef int i32x4 __attribute__((ext_vector_type(4)));
__device__ __forceinline__ void fp8fma4(f32x2 (&acc)[8], int o, unsigned w, f32x2 a2) {
    const f32x2 lo = __builtin_amdgcn_cvt_scalef32_pk_f32_fp8(w, 1.0f, false), hi = __builtin_amdgcn_cvt_scalef32_pk_f32_fp8(w, 1.0f, true);
    acc[o] = __builtin_elementwise_fma(a2, lo, acc[o]); acc[o + 1] = __builtin_elementwise_fma(a2, hi, acc[o + 1]);
}
__device__ __forceinline__ void g2_u_chunk(u32x4 (&u)[8], const unsigned char* U, const int* pe_next, const float* pw_c, float* act_c, const u32x4 xq, float rs, int lane) {
    const i32x4 e0 = *(const i32x4*)pe_next, e1 = *(const i32x4*)(pe_next + 4);
    const int en[8] = {e0.x, e0.y, e0.z, e0.w, e1.x, e1.y, e1.z, e1.w};
    float p[8];
#pragma unroll
    for (int k = 0; k < 8; ++k) {
        int d = __builtin_amdgcn_sdot4((int)u[k].x, (int)xq.x, 0, false); d = __builtin_amdgcn_sdot4((int)u[k].y, (int)xq.y, d, false);
        d = __builtin_amdgcn_sdot4((int)u[k].z, (int)xq.z, d, false); d = __builtin_amdgcn_sdot4((int)u[k].w, (int)xq.w, d, false);
        p[k] = (float)d;
        asm volatile("" : "+v"(p[k]));
        u[k] = *(const u32x4*)(U + (size_t)__builtin_amdgcn_readfirstlane(en[k]) * 1024 + lane * 16);
    }
    const float a = reduce8_transposed(p, lane);
    const int row = (lane >> 3) & 7;
    if ((lane & 7) == 0) act_c[row] = gelu_tanh(a * rs) * pw_c[row];
}
__device__ __forceinline__ void g2_v_chunk(u32x4 (&v)[8], const unsigned char* V, const int* pe_next, const float* act_c, f32x2 (&acc)[8], int lane) {
    const i32x4 e0 = *(const i32x4*)pe_next, e1 = *(const i32x4*)(pe_next + 4);
    const int en[8] = {e0.x, e0.y, e0.z, e0.w, e1.x, e1.y, e1.z, e1.w};
    const f32x4 a0 = *(const f32x4*)act_c, a1 = *(const f32x4*)(act_c + 4);
    const float av[8] = {a0.x, a0.y, a0.z, a0.w, a1.x, a1.y, a1.z, a1.w};
#pragma unroll
    for (int k = 0; k < 8; k += 2) {
        const f32x2 a2 = (f32x2){av[k], av[k]}, b2 = (f32x2){av[k + 1], av[k + 1]};
        fp8fma4(acc, 0, v[k].x, a2); fp8fma4(acc, 2, v[k].y, a2); fp8fma4(acc, 4, v[k].z, a2); fp8fma4(acc, 6, v[k].w, a2);
        fp8fma4(acc, 0, v[k + 1].x, b2); fp8fma4(acc, 2, v[k + 1].y, b2); fp8fma4(acc, 4, v[k + 1].z, b2); fp8fma4(acc, 6, v[k + 1].w, b2);
        asm volatile("" : "+v"(acc[0]), "+v"(acc[1]), "+v"(acc[2]), "+v"(acc[3]), "+v"(acc[4]), "+v"(acc[5]), "+v"(acc[6]), "+v"(acc[7]));
        v[k] = *(const u32x4*)(V + (size_t)__builtin_amdgcn_readfirstlane(en[k]) * 1024 + lane * 16);
        v[k + 1] = *(const u32x4*)(V + (size_t)__builtin_amdgcn_readfirstlane(en[k + 1]) * 1024 + lane * 16);
    }
}
__device__ __forceinline__ void g2_finish_token(Ctx& c, int l, int tok, const f32x2 (&acc)[8], int lane) {
    float* h = WSP(float, WS_H); bf16* hbw = WSP(bf16, WS_HB); float* ssqw = WSP(float, WS_SSQ);
    float* hp = h + (size_t)tok * D + lane * 16;
    f32x4 r0 = *(const f32x4*)hp, r1 = *(const f32x4*)(hp + 4), r2 = *(const f32x4*)(hp + 8), r3 = *(const f32x4*)(hp + 12);
    r0 += (f32x4){acc[0].x, acc[0].y, acc[1].x, acc[1].y}; r1 += (f32x4){acc[2].x, acc[2].y, acc[3].x, acc[3].y};
    r2 += (f32x4){acc[4].x, acc[4].y, acc[5].x, acc[5].y}; r3 += (f32x4){acc[6].x, acc[6].y, acc[7].x, acc[7].y};
    if (l == 0) {
        *(f32x4*)hp = r0; *(f32x4*)(hp + 4) = r1; *(f32x4*)(hp + 8) = r2; *(f32x4*)(hp + 12) = r3;
        u32x4 o0, o1; o0.x = pk2(r0.x, r0.y); o0.y = pk2(r0.z, r0.w); o0.z = pk2(r1.x, r1.y); o0.w = pk2(r1.z, r1.w);
        o1.x = pk2(r2.x, r2.y); o1.y = pk2(r2.z, r2.w); o1.z = pk2(r3.x, r3.y); o1.w = pk2(r3.z, r3.w);
        *(u32x4*)(hbw + (size_t)tok * D + lane * 16) = o0; *(u32x4*)(hbw + (size_t)tok * D + lane * 16 + 8) = o1;
        float ss = (r0.x * r0.x + r0.y * r0.y) + (r0.z * r0.z + r0.w * r0.w) + (r1.x * r1.x + r1.y * r1.y) + (r1.z * r1.z + r1.w * r1.w)
                 + (r2.x * r2.x + r2.y * r2.y) + (r2.z * r2.z + r2.w * r2.w) + (r3.x * r3.x + r3.y * r3.y) + (r3.z * r3.z + r3.w * r3.w);
        ss = wave_sum_dpp(ss);
        if (lane < 8) ssqw[(size_t)tok * 8 + lane] = lane == 0 ? ss : 0.f;
    } else {
        const int b = tok / L, pos = tok - b * L;
        if (pos >= NMETA) { float* op = c.out + ((size_t)b * SEQ + (pos - NMETA)) * D + lane * 16;
            *(f32x4*)op = r0; *(f32x4*)(op + 4) = r1; *(f32x4*)(op + 8) = r2; *(f32x4*)(op + 12) = r3; }
    }
}
__device__ __forceinline__ void phase_G2(const Ctx& c0, int l) {
    Ctx c = reopaque(c0);
    const bf16* hb = WSP(bf16, WS_HB); const float* ssq = WSP(float, WS_SSQ); const int* pe = WSP(int, WS_EIDX); const float* pw = WSP(float, WS_GW);
    const unsigned char* U = c.ws + WS_TAB + (size_t)(l * 2) * SZ_TAB; const unsigned char* V = c.ws + WS_TAB + (size_t)(l * 2 + 1) * SZ_TAB;
    const int lane = c.lane, wave = c.wave;
    const int gw = c.vb * 4 + wave, t0 = l == 1 ? gw * 8 + NMETA * ((gw >> 8) + 1) : gw * 8;
    const bool has_x = l == 0 && (c.vb & 3) == 0; const int tx = T - 128 + (c.vb >> 2);
    unsigned char* wl = c.lds + wave * G2_WSTRIDE;
    int* pe_l = (int*)wl; float* pw_l = (float*)(wl + 4608); float* act_l = (float*)(wl + 9216);
#pragma unroll
    for (int j = 0; j < G2_MAXTOK; ++j) { const int tok = j < 8 ? t0 + j : (has_x ? tx : t0);
        pe_l[j * 128 + lane] = pe[(size_t)tok * 128 + lane]; pe_l[j * 128 + 64 + lane] = pe[(size_t)tok * 128 + 64 + lane];
        pw_l[j * 128 + lane] = pw[(size_t)tok * 128 + lane] * TAB_INV; pw_l[j * 128 + 64 + lane] = pw[(size_t)tok * 128 + 64 + lane] * TAB_INV; }
    const int xlo = has_x ? 4 * wave : 16, xhi = has_x ? 4 * wave + 4 : 16;
    {
        u32x4 xq[G2_MAXTOK]; float rs[G2_MAXTOK];
#pragma unroll
        for (int j = 0; j < G2_MAXTOK; ++j) { const int tok = j < 8 ? t0 + j : (has_x ? tx : t0);
            const u32x4 lo = *(const u32x4*)(hb + (size_t)tok * D + lane * 16), hi = *(const u32x4*)(hb + (size_t)tok * D + lane * 16 + 8);
            const f32x4 f0 = (f32x4){bf_lo(lo.x), bf_hi(lo.x), bf_lo(lo.y), bf_hi(lo.y)}, f1 = (f32x4){bf_lo(lo.z), bf_hi(lo.z), bf_lo(lo.w), bf_hi(lo.w)};
            const f32x4 f2 = (f32x4){bf_lo(hi.x), bf_hi(hi.x), bf_lo(hi.y), bf_hi(hi.y)}, f3 = (f32x4){bf_lo(hi.z), bf_hi(hi.z), bf_lo(hi.w), bf_hi(hi.w)};
            float mx = 1e-20f;
#pragma unroll
            for (int i = 0; i < 4; ++i) mx = fmaxf(mx, fmaxf(fmaxf(fabsf(f0[i]), fabsf(f1[i])), fmaxf(fabsf(f2[i]), fabsf(f3[i]))));
            mx = fmaxf(mx, dpp<0xB1>(mx)); mx = fmaxf(mx, dpp<0x4E>(mx)); mx = fmaxf(mx, dpp<0x141>(mx)); mx = fmaxf(mx, dpp<0x128>(mx)); mx = xrow16_max(mx);
            const float sx = 127.0f / mx;
            xq[j].x = pack_i8x4(f0 * sx); xq[j].y = pack_i8x4(f1 * sx); xq[j].z = pack_i8x4(f2 * sx); xq[j].w = pack_i8x4(f3 * sx);
            rs[j] = rstd_from_ssq8(ssq, tok) * mx * (1.0f / (127.0f * U_SCALE)); }
        u32x4 u[8];
#pragma unroll
        for (int k = 0; k < 8; ++k) u[k] = *(const u32x4*)(U + (size_t)__builtin_amdgcn_readfirstlane(pe_l[k]) * 1024 + lane * 16);
#pragma unroll 1
        for (int ch = 0; ch < 16; ++ch) {
            const int cn = ch < 15 ? ch + 1 : 0;
            const bool x_here = ch >= xlo && ch < xhi;
#pragma unroll
            for (int j = 0; j < 8; ++j) {
                const int* pe_next = j < 7 ? pe_l + (j + 1) * 128 + ch * 8 : (x_here ? pe_l + 8 * 128 + ch * 8 : pe_l + cn * 8);
                g2_u_chunk(u, U, pe_next, pw_l + j * 128 + ch * 8, act_l + j * 128 + ch * 8, xq[j], rs[j], lane); }
            if (x_here) g2_u_chunk(u, U, pe_l + cn * 8, pw_l + 8 * 128 + ch * 8, act_l + 8 * 128 + ch * 8, xq[8], rs[8], lane);
        }
    }
    f32x2 acc[G2_MAXTOK][8];
#pragma unroll
    for (int j = 0; j < G2_MAXTOK; ++j)
#pragma unroll
        for (int i = 0; i < 8; ++i) acc[j][i] = (f32x2){0.f, 0.f};
    {
        u32x4 v[8];
#pragma unroll
        for (int k = 0; k < 8; ++k) v[k] = *(const u32x4*)(V + (size_t)__builtin_amdgcn_readfirstlane(pe_l[k]) * 1024 + lane * 16);
#pragma unroll 1
        for (int ch = 0; ch < 16; ++ch) {
            const int cn = ch < 15 ? ch + 1 : 0;
            const bool x_here = ch >= xlo && ch < xhi;
#pragma unroll
            for (int j = 0; j < 8; ++j) {
                const int* pe_next = j < 7 ? pe_l + (j + 1) * 128 + ch * 8 : (x_here ? pe_l + 8 * 128 + ch * 8 : pe_l + cn * 8);
                g2_v_chunk(v, V, pe_next, act_l + j * 128 + ch * 8, acc[j], lane); }
            if (x_here) g2_v_chunk(v, V, pe_l + cn * 8, act_l + 8 * 128 + ch * 8, acc[8], lane);
        }
    }
#pragma unroll
    for (int j = 0; j < 8; ++j) g2_finish_token(c, l, t0 + j, acc[j], lane);
    __syncthreads();
    if (has_x) {
        f32x2* part = (f32x2*)(c.lds + wave * G2_WSTRIDE);
#pragma unroll
        for (int i = 0; i < 8; ++i) part[i * 64 + lane] = acc[8][i];
    }
    __syncthreads();
    if (has_x && wave == 0) {
        f32x2 tot[8];
#pragma unroll
        for (int i = 0; i < 8; ++i) { tot[i] = acc[8][i];
#pragma unroll
            for (int w = 1; w < 4; ++w) tot[i] += ((const f32x2*)(c.lds + w * G2_WSTRIDE))[i * 64 + lane]; }
        g2_finish_token(c, l, tx, tot, lane);
    }
    __syncthreads();
}

struct Args { const float* in[22]; float* out; unsigned char* ws; int ph_lo, ph_hi; };
constexpr int N_PHASES = 17;

__global__ void __launch_bounds__(NTHREADS, 2) fwd_kernel(Args args) {
    extern __shared__ __attribute__((aligned(16))) unsigned char lds_raw[];
    Ctx c;
#pragma unroll
    for (int i = 0; i < 22; ++i) c.in[i] = args.in[i];
    c.out = args.out; c.ws = args.ws; c.lds = lds_raw;
    c.tid = threadIdx.x; c.lane = c.tid & 63; c.wave = __builtin_amdgcn_readfirstlane(c.tid >> 6);
    c.G = gridDim.x; { const int bx = blockIdx.x; c.vb = (c.G % 8 == 0) ? (bx % 8) * (c.G / 8) + bx / 8 : bx; }
    volatile unsigned* misc = (volatile unsigned*)(c.lds + LDS_MISC);
    if (c.tid < 16) misc[c.tid] = 0u;
    __syncthreads();
    const int lo = args.ph_lo, hi = args.ph_hi;
    const bool multi = (hi - lo) > 1;
    XcdBarrier bar; bar.bar = WSP(unsigned, WS_CTL) + CW_BAR; bar.x = 0; bar.st = misc;
    if (multi) bar = xcd_barrier_post(WSP(unsigned, WS_CTL) + CW_BAR, misc);
#define IN_(k) (lo <= (k) && (k) < hi)
#define SEAM_(k) do { if ((k) + 1 < hi) xcd_barrier(bar); } while (0)
    if (IN_(0)) { phase_prologue(c); SEAM_(0); }
#pragma unroll 1
    for (int l = 0; l < 2; ++l) {
        const int p0 = 1 + 8 * l;
        if (IN_(p0 + 0)) { phase_A(c, l); SEAM_(p0 + 0); }
        if (IN_(p0 + 1)) { phase_B(c, l); SEAM_(p0 + 1); }
        if (IN_(p0 + 2)) { phase_C(c, l); SEAM_(p0 + 2); }
        if (IN_(p0 + 3)) { phase_D(c, l); SEAM_(p0 + 3); }
        if (IN_(p0 + 4)) { phase_E(c, l); SEAM_(p0 + 4); }
        if (IN_(p0 + 5)) { phase_F(c, l); SEAM_(p0 + 5); }
        if (IN_(p0 + 6)) { phase_F3(c, l); SEAM_(p0 + 6); }
        if (IN_(p0 + 7)) { phase_G2(c, l); SEAM_(p0 + 7); }
    }
}

extern "C" void kernel_launch(void* const* d_in, const int* in_sizes, int n_in, void* d_out, int out_size, void* d_ws, size_t ws_size, hipStream_t stream) {
    static int grid = 0;
    if (grid == 0) {
        if (n_in != 22 || out_size != NB * SEQ * D || ws_size < WS_END) { fprintf(stderr, "kernel_launch: unexpected shapes (n_in %d out %d ws %zu need %zu)\n", n_in, out_size, ws_size, (size_t)WS_END); grid = -1; return; }
        int dev = 0, cus = 0, per_cu = 0;
        hipGetDevice(&dev); hipDeviceGetAttribute(&cus, hipDeviceAttributeMultiprocessorCount, dev);
        if (hipFuncSetAttribute((const void*)fwd_kernel, hipFuncAttributeMaxDynamicSharedMemorySize, LDS_BYTES) != hipSuccess) { fprintf(stderr, "kernel_launch: hipFuncSetAttribute failed\n"); grid = -1; return; }
        if (hipOccupancyMaxActiveBlocksPerMultiprocessor(&per_cu, (const void*)fwd_kernel, NTHREADS, LDS_BYTES) != hipSuccess || per_cu < 1) { fprintf(stderr, "kernel_launch: occupancy query failed (%d)\n", per_cu); per_cu = 1; (void)hipGetLastError(); }
        if (per_cu > 2) per_cu = 2;
        grid = cus * per_cu;
        if (grid != 512) { fprintf(stderr, "kernel_launch: grid %d unsupported by phase G2 (needs 512 workgroups)\n", grid); grid = -1; return; }
        fprintf(stderr, "kernel_launch: grid %d (%d per CU), lds %d, ws need %zu have %zu\n", grid, per_cu, LDS_BYTES, (size_t)WS_END, ws_size);
    }
    if (grid < 0) return;
    hipMemsetAsync((char*)d_ws + WS_CTL, 0, CTL_BYTES, stream);
    Args a{};
    for (int i = 0; i < 22; ++i) a.in[i] = (const float*)d_in[i];
    a.out = (float*)d_out; a.ws = (unsigned char*)d_ws;
#if MK_PER_PHASE
    for (int ph = 0; ph < N_PHASES; ++ph) { a.ph_lo = ph; a.ph_hi = ph + 1; hipLaunchKernelGGL(fwd_kernel, dim3(grid), dim3(NTHREADS), LDS_BYTES, stream, a); }
#else
    a.ph_lo = 0; a.ph_hi = N_PHASES;
    void* kargs[] = {&a};
    hipError_t e = hipLaunchCooperativeKernel((const void*)fwd_kernel, dim3(grid), dim3(NTHREADS), kargs, LDS_BYTES, stream);
    if (e != hipSuccess) fprintf(stderr, "kernel_launch: cooperative launch failed: %s (grid %d)\n", hipGetErrorString(e), grid);
#endif
}
```

```cpp
#include <hip/hip_runtime.h>
#include <cstdio>
#include <cstdint>

#ifndef MK_PER_PHASE
#define MK_PER_PHASE 0
#endif

typedef unsigned short bf16;
typedef short bf16x8 __attribute__((ext_vector_type(8)));
typedef float f32x4 __attribute__((ext_vector_type(4)));
typedef unsigned u32x4 __attribute__((ext_vector_type(4)));
typedef unsigned u32x2 __attribute__((ext_vector_type(2)));
typedef __bf16 bf16x2 __attribute__((ext_vector_type(2)));

constexpr int NB = 8, SEQ = 2048, NMETA = 16, L = SEQ + NMETA, T = NB * L, D = 1024;
constexpr int DC = 512, CW = 31, NH = 8, QL = 256, KVL = 128, NOPE = 64, ROPE = 32, QK = 96, VD = 64;
constexpr int NIN = 3488, NINP = 3584;
constexpr int NEXP = 16384;
constexpr float EPS = 1e-6f;
constexpr int MT = T / 128;
static_assert(T % 128 == 0, "T tiles");

constexpr size_t al256(size_t x) { return (x + 255) & ~(size_t)255; }
constexpr size_t WS_CTL = 0;
constexpr size_t CTL_BYTES = 65536;
constexpr size_t WS_ROPE = WS_CTL + CTL_BYTES;
constexpr size_t WS_WIN = al256(WS_ROPE + (size_t)L * 16 * 8);
constexpr size_t SZ_WIN = (size_t)NINP * 1024 * 2, SZ_WCO = (size_t)1024 * 512 * 2, SZ_WUQ = (size_t)1024 * 256 * 2, SZ_WUKV = (size_t)1024 * 128 * 2,
                 SZ_WMLA = (size_t)1024 * 512 * 2, SZ_WOUT = (size_t)1024 * 1024 * 2, SZ_WPQ = (size_t)2048 * 1024 * 2, SZ_KEYS = (size_t)16 * 128 * 128 * 2;
constexpr size_t OFF_WCO = SZ_WIN, OFF_WUQ = OFF_WCO + SZ_WCO, OFF_WUKV = OFF_WUQ + SZ_WUQ, OFF_WMLA = OFF_WUKV + SZ_WUKV, OFF_WOUT = OFF_WMLA + SZ_WMLA,
                 OFF_WPQ = OFF_WOUT + SZ_WOUT, OFF_KEYS = OFF_WPQ + SZ_WPQ, SZ_WLAYER = OFF_KEYS + SZ_KEYS;
constexpr size_t WS_TAB = al256(WS_WIN + 2 * SZ_WLAYER);
constexpr size_t SZ_TAB = (size_t)NEXP * 1024;
constexpr float TAB_SCALE = 256.0f, TAB_INV = 1.0f / 256.0f;
constexpr float U_CLIP = 0.2f, U_SCALE = 127.0f / U_CLIP;
constexpr size_t WS_H = al256(WS_TAB + 4 * SZ_TAB);
constexpr size_t WS_HB = al256(WS_H + (size_t)T * 1024 * 4);
constexpr size_t WS_SSQ = al256(WS_HB + (size_t)T * 1024 * 2);
constexpr size_t WS_UGLU = al256(WS_SSQ + (size_t)T * 8 * 4);
constexpr size_t WS_CQ = al256(WS_UGLU + (size_t)T * 512 * 2);
constexpr size_t WS_CKV = al256(WS_CQ + (size_t)T * 256 * 2);
constexpr size_t WS_KROPE = al256(WS_CKV + (size_t)T * 128 * 2);
constexpr size_t WS_SSQQ = al256(WS_KROPE + (size_t)T * 32 * 4);
constexpr size_t WS_SSQKV = al256(WS_SSQQ + (size_t)T * 2 * 4);
constexpr size_t WS_U2 = al256(WS_SSQKV + (size_t)T * 4);
constexpr size_t WS_Q = al256(WS_U2 + (size_t)T * 512 * 2);
constexpr size_t WS_K = al256(WS_Q + (size_t)T * NH * QK * 2);
constexpr size_t WS_VT = al256(WS_K + (size_t)T * NH * QK * 2);
constexpr size_t WS_O = al256(WS_VT + (size_t)T * NH * VD * 2 + 4096);
constexpr size_t WS_MERGED = al256(WS_O + (size_t)T * 512 * 2);
constexpr size_t WS_GATES = al256(WS_MERGED + (size_t)T * 1024 * 2);
constexpr size_t WS_SV = WS_GATES;
constexpr size_t WS_SI = al256(WS_SV + (size_t)T * 256 * 4);
constexpr size_t WS_EIDX = al256(WS_SI + (size_t)T * 256);
constexpr size_t WS_GW = al256(WS_EIDX + (size_t)T * 128 * 4);
constexpr size_t WS_STB = al256(WS_GW + (size_t)T * 128 * 4);
constexpr size_t WS_PEER_END = WS_STB + (size_t)T * 16;
constexpr size_t WS_END = al256(WS_GATES + (size_t)T * 2048 * 2);
static_assert(WS_PEER_END <= WS_END, "peer scratch overlay");

constexpr int CW_BAR = 0;
constexpr int CW_QUEUE = 4096;

constexpr int LDS_MAIN = 128 * 132 * 4;
constexpr int LDS_MISC = LDS_MAIN;
constexpr int LDS_BYTES = LDS_MAIN + 64;

constexpr int NTHREADS = 256;

__device__ __forceinline__ unsigned pk2(float lo, float hi) { bf16x2 v; v.x = (__bf16)lo; v.y = (__bf16)hi; return __builtin_bit_cast(unsigned, v); }
__device__ __forceinline__ unsigned pack_i8x4(f32x4 v) {
    const int a = (int)__builtin_rintf(fminf(fmaxf(v.x, -127.f), 127.f)), b = (int)__builtin_rintf(fminf(fmaxf(v.y, -127.f), 127.f));
    const int c_ = (int)__builtin_rintf(fminf(fmaxf(v.z, -127.f), 127.f)), d = (int)__builtin_rintf(fminf(fmaxf(v.w, -127.f), 127.f));
    return (unsigned)(a & 255) | ((unsigned)(b & 255) << 8) | ((unsigned)(c_ & 255) << 16) | ((unsigned)(d & 255) << 24);
}
__device__ __forceinline__ float bf_lo(unsigned p) { return __uint_as_float(p << 16); }
__device__ __forceinline__ float bf_hi(unsigned p) { return __uint_as_float(p & 0xffff0000u); }
__device__ __forceinline__ float fast_rcp(float x) { return __builtin_amdgcn_rcpf(x); }
__device__ __forceinline__ float fast_exp2(float x) { return __builtin_amdgcn_exp2f(x); }
__device__ __forceinline__ float sigmoidf_(float x) { return fast_rcp(1.0f + fast_exp2(-1.4426950409f * x)); }
__device__ __forceinline__ float gelu_tanh(float x) { const float u = 1.5957691216f * (x + 0.044715f * x * x * x); return x * fast_rcp(1.0f + fast_exp2(-1.4426950409f * u)); }
__device__ __forceinline__ float rsqrt_(float x) { return __builtin_amdgcn_rsqf(x); }
template <int CTRL> __device__ __forceinline__ float dpp(float x) { return __builtin_bit_cast(float, __builtin_amdgcn_mov_dpp(__builtin_bit_cast(int, x), CTRL, 0xf, 0xf, true)); }
__device__ __forceinline__ float xrow16_sum(float x) {
    auto s = __builtin_amdgcn_permlane16_swap(__float_as_uint(x), __float_as_uint(x), false, false);
    x = __uint_as_float(s[0]) + __uint_as_float(s[1]);
    auto t = __builtin_amdgcn_permlane32_swap(__float_as_uint(x), __float_as_uint(x), false, false);
    return __uint_as_float(t[0]) + __uint_as_float(t[1]);
}
__device__ __forceinline__ float xrow16_max(float x) {
    auto s = __builtin_amdgcn_permlane16_swap(__float_as_uint(x), __float_as_uint(x), false, false);
    x = fmaxf(__uint_as_float(s[0]), __uint_as_float(s[1]));
    auto t = __builtin_amdgcn_permlane32_swap(__float_as_uint(x), __float_as_uint(x), false, false);
    return fmaxf(__uint_as_float(t[0]), __uint_as_float(t[1]));
}
__device__ __forceinline__ float wave_sum_dpp(float x) {
    x += dpp<0xB1>(x); x += dpp<0x4E>(x); x += dpp<0x141>(x); x += dpp<0x128>(x); return xrow16_sum(x);
}
__device__ __forceinline__ float quad_sum(float v) { return xrow16_sum(v); }
__device__ __forceinline__ float quad_max(float v) { return xrow16_max(v); }
__device__ __forceinline__ float wave_sum(float v) { return wave_sum_dpp(v); }
__device__ __forceinline__ float dot2(unsigned a, unsigned b, float c) { return __builtin_amdgcn_fdot2_f32_bf16(__builtin_bit_cast(bf16x2, a), __builtin_bit_cast(bf16x2, b), c, false); }

#define XB_TMO      128
#define XB_XCNT(j)  (256  + 64 * (j))
#define XB_XSUB(j)  (1280 + 64 * (j))
#define XB_XGEN(j)  (2304 + 64 * (j))
#define XB_TOP      3328
#define XB_TOPGEN   3392
#define XCD_BAR_WORDS 3456
#define XB_SPIN_CAP (1u << 20)
__device__ __forceinline__ unsigned xb_ld(unsigned* p)              { return __hip_atomic_load(p, __ATOMIC_RELAXED, __HIP_MEMORY_SCOPE_AGENT); }
__device__ __forceinline__ unsigned xb_add(unsigned* p, unsigned v) { return __hip_atomic_fetch_add(p, v, __ATOMIC_RELAXED, __HIP_MEMORY_SCOPE_AGENT); }
__device__ __forceinline__ unsigned xb_xcc_id() { return (unsigned)__builtin_amdgcn_s_getreg((3 << 11) | 20) & 0xFu; }
#define XB_SPIN(cond, bar) do { unsigned _sp = 0; while (cond) { __builtin_amdgcn_s_sleep(1); \
    if ((++_sp & 255u) == 0u) { if (xb_ld(&(bar)[XB_TMO])) break; if (_sp > XB_SPIN_CAP) { atomicAdd(&(bar)[XB_TMO], 1u); break; } } } } while (0)
struct XcdBarrier { unsigned* bar; unsigned x; volatile unsigned* st; };
__device__ __forceinline__ XcdBarrier xcd_barrier_post(unsigned* bar, volatile unsigned* st) {
    XcdBarrier b; b.bar = bar; b.x = xb_xcc_id(); b.st = st;
    if (threadIdx.x == 0) (void)xb_add(&bar[XB_XCNT(b.x)], 1u);
    return b;
}
__device__ __forceinline__ void xcd_barrier_complete(unsigned* bar, unsigned x, unsigned& nloc, unsigned& nx) {
    const unsigned G = gridDim.x * gridDim.y * gridDim.z;
    unsigned sum, cnt, mine, sp = 0u;
    for (;;) {
        sum = 0u; cnt = 0u; mine = 0u;
#pragma unroll
        for (unsigned j = 0; j < 16; ++j) { const unsigned c = xb_ld(&bar[XB_XCNT(j)]); sum += c; cnt += (c > 0u) ? 1u : 0u; mine = (j == x) ? c : mine; }
        if (sum == G) break;
        __builtin_amdgcn_s_sleep(1);
        if ((++sp & 255u) == 0u) { if (xb_ld(&bar[XB_TMO])) break; if (sp > XB_SPIN_CAP) { atomicAdd(&bar[XB_TMO], 1u); break; } }
    }
    nloc = mine > 0u ? mine : 1u; nx = cnt > 0u ? cnt : 1u;
}
__device__ __forceinline__ void xcd_barrier(const XcdBarrier& b) {
    asm volatile("s_waitcnt vmcnt(0)" ::: "memory");
    __syncthreads();
    if (threadIdx.x == 0) {
        unsigned* bar = b.bar;
        __builtin_amdgcn_s_waitcnt(0);
        unsigned nloc = b.st[0], nx = b.st[1];
        if (nloc == 0u) { xcd_barrier_complete(bar, b.x, nloc, nx); b.st[0] = nloc; b.st[1] = nx; }
        const unsigned old = xb_add(&bar[XB_XSUB(b.x)], 1u);
        const unsigned gen = old / nloc;
        if (old + 1u == (gen + 1u) * nloc) {
            __builtin_amdgcn_fence(__ATOMIC_RELEASE, "agent");
            asm volatile("s_waitcnt vmcnt(0)" ::: "memory");
            const unsigned og = xb_add(&bar[XB_TOP], 1u);
            const unsigned tg = og / nx;
            if (og + 1u == (tg + 1u) * nx) xb_add(&bar[XB_TOPGEN], 1u);
            else XB_SPIN(xb_ld(&bar[XB_TOPGEN]) == tg, bar);
            __builtin_amdgcn_fence(__ATOMIC_ACQUIRE, "agent");
            xb_add(&bar[XB_XGEN(b.x)], 1u);
            asm volatile("s_waitcnt vmcnt(0)" ::: "memory");
        } else {
            XB_SPIN(xb_ld(&bar[XB_XGEN(b.x)]) == gen, bar);
            __builtin_amdgcn_fence(__ATOMIC_ACQUIRE, "agent");
            asm volatile("s_waitcnt vmcnt(0)" ::: "memory");
        }
    }
    __syncthreads();
}

struct Ctx {
    const float* in[22]; float* out; unsigned char* ws;
    unsigned char* lds; int tid, lane, wave, G, vb;
};
#define WSP(T_, off) ((T_*)(c.ws + (off)))
__device__ __forceinline__ Ctx reopaque(const Ctx& c0) {
    Ctx c = c0; int t = c0.tid; asm volatile("" : "+v"(t)); c.tid = t; c.lane = t & 63; c.wave = __builtin_amdgcn_readfirstlane(t >> 6);
    int vb = c0.vb; asm volatile("" : "+s"(vb)); c.vb = vb; return c;
}

__device__ __forceinline__ int lds_off(int row, int chunk) { return row * 128 + ((chunk ^ (row & 7)) << 4); }

__device__ __forceinline__ void gemm_compute_stage(f32x4 (&acc)[2][8], const unsigned char* sA, const unsigned char* sB, int wave, int lane) {
    const int r = lane & 15, q = lane >> 4;
#pragma unroll
    for (int ks = 0; ks < 2; ++ks) {
        bf16x8 af[2], bfr[8];
#pragma unroll
        for (int mi = 0; mi < 2; ++mi) af[mi] = *(const bf16x8*)(sA + lds_off(32 * wave + 16 * mi + r, 4 * ks + q));
#pragma unroll
        for (int ni = 0; ni < 8; ++ni) bfr[ni] = *(const bf16x8*)(sB + lds_off(16 * ni + r, 4 * ks + q));
#pragma unroll
        for (int mi = 0; mi < 2; ++mi)
#pragma unroll
            for (int ni = 0; ni < 8; ++ni) acc[mi][ni] = __builtin_amdgcn_mfma_f32_16x16x32_bf16(bfr[ni], af[mi], acc[mi][ni], 0, 0, 0);
    }
}

#define LAS __attribute__((address_space(3)))
__device__ __forceinline__ void gemm_stage_glds(const bf16* A, int lda, const bf16* Bt, int ldb, int kt, unsigned char* stage, int wave, int lane) {
    const int rr = lane >> 3, cch = (lane & 7) ^ rr;
#pragma unroll
    for (int i = 0; i < 4; ++i) { const int pc = 4 * i + wave;
        __builtin_amdgcn_global_load_lds((const unsigned*)(A + (size_t)(8 * pc + rr) * lda + kt * 64 + cch * 8), (LAS unsigned*)(stage + pc * 1024), 16, 0, 0);
        __builtin_amdgcn_global_load_lds((const unsigned*)(Bt + (size_t)(8 * pc + rr) * ldb + kt * 64 + cch * 8), (LAS unsigned*)(stage + 16384 + pc * 1024), 16, 0, 0); }
}
__device__ __forceinline__ void gemm_core(f32x4 (&acc)[2][8], const bf16* A, int lda, const bf16* Bt, int ldb, int K, unsigned char* lds, int tid) {
    const int wave = __builtin_amdgcn_readfirstlane(tid >> 6), lane = tid & 63;
    const int nk = K >> 6;
    gemm_stage_glds(A, lda, Bt, ldb, 0, lds, wave, lane);
    asm volatile("s_waitcnt vmcnt(0)" ::: "memory");
    __syncthreads();
    for (int kt = 0; kt < nk; ++kt) {
        const int cur = kt & 1;
        if (kt + 1 < nk) gemm_stage_glds(A, lda, Bt, ldb, kt + 1, lds + (cur ^ 1) * 32768, wave, lane);
        gemm_compute_stage(acc, lds + cur * 32768, lds + cur * 32768 + 16384, wave, lane);
        asm volatile("s_waitcnt vmcnt(0)" ::: "memory");
        __syncthreads();
    }
}
__device__ __forceinline__ void acc_zero(f32x4 (&acc)[2][8]) {
#pragma unroll
    for (int mi = 0; mi < 2; ++mi)
#pragma unroll
        for (int ni = 0; ni < 8; ++ni) acc[mi][ni] = (f32x4){0.f, 0.f, 0.f, 0.f};
}
__device__ __forceinline__ float rstd_from_ssq8(const float* ssq, int tok) {
    const f32x4 a = *(const f32x4*)(ssq + (size_t)tok * 8), b = *(const f32x4*)(ssq + (size_t)tok * 8 + 4);
    const float s = ((a.x + a.y) + (a.z + a.w)) + ((b.x + b.y) + (b.z + b.w));
    return rsqrt_(s * (1.0f / 1024.0f) + EPS);
}

__device__ __forceinline__ int src_col(int mode, int np) {
    if (mode == 0) return np;
    if (mode == 2) { const int h = np >> 7, j = np & 127; return j < 96 ? h * 96 + j : -1; }
    if (np < 1024) { const int cblk = np >> 7, j = np & 127; return j < 64 ? 64 * cblk + j : 512 + 64 * cblk + (j - 64); }
    if (np < 1408) return np;
    if (np < 1536) { const int j = np - 1408; return j < 32 ? 1408 + j : -1; }
    return 1440 + (np - 1536);
}
__device__ __forceinline__ void p0_transpose_item(const float* W, int K, int N, bf16* Wt, int mode, const float* g, int item, float* scr, int lane) {
    const int nblk_k = K / 64, nb = item / nblk_k, kb = item % nblk_k, k0 = 64 * kb, n0 = 32 * nb;
    const int n = src_col(mode, n0 + (lane & 31));
    float wv[32], gv[32];
#pragma unroll
    for (int i = 0; i < 32; ++i) { const int kk = 2 * i + (lane >> 5); wv[i] = n >= 0 ? W[(size_t)(k0 + kk) * N + n] : 0.f; gv[i] = g ? g[k0 + kk] : 1.f; }
#pragma unroll
    for (int i = 0; i < 32; ++i) { const int kk = 2 * i + (lane >> 5); scr[kk * 33 + (lane & 31)] = wv[i] * gv[i]; }
    __builtin_amdgcn_s_waitcnt(0xC07F); asm volatile("" ::: "memory");
    const int cch = lane & 7;
#pragma unroll
    for (int j = 0; j < 4; ++j) { const int nl = (lane >> 3) + 8 * j; const float* s = scr + (8 * cch) * 33 + nl;
        u32x4 o; o.x = pk2(s[0 * 33], s[1 * 33]); o.y = pk2(s[2 * 33], s[3 * 33]); o.z = pk2(s[4 * 33], s[5 * 33]); o.w = pk2(s[6 * 33], s[7 * 33]);
        *(u32x4*)(Wt + (size_t)(n0 + nl) * K + k0 + 8 * cch) = o; }
    __builtin_amdgcn_s_waitcnt(0xC07F); asm volatile("" ::: "memory");
}
struct WDesc { int in_idx, K, N, Np, mode, g_idx; size_t off; };
__device__ __forceinline__ void phase_prologue(const Ctx& c0) {
    Ctx c = reopaque(c0);
    const int gw = c.vb * 4 + c.wave, NGW = c.G * 4;
    float* scr = (float*)(c.lds + c.wave * 8704);
    const WDesc wd[7] = {
        {3, 1024, NIN, NINP, 1, 2, 0}, {8, 512, 1024, 1024, 0, -1, OFF_WCO}, {10, 256, 768, 1024, 2, 9, OFF_WUQ}, {12, 128, 1024, 1024, 0, 11, OFF_WUKV},
        {15, 512, 1024, 1024, 0, -1, OFF_WMLA}, {16, 1024, 1024, 1024, 0, -1, OFF_WOUT}, {18, 1024, 2048, 2048, 0, 17, OFF_WPQ}};
    constexpr int ITEMS_PER_LAYER = (1024 / 64) * (NINP / 32) + (512 / 64) * 32 + (256 / 64) * 32 + (128 / 64) * 32 + (512 / 64) * 32 + (1024 / 64) * 32 + (1024 / 64) * 64;
    for (int it = gw; it < 2 * ITEMS_PER_LAYER; it += NGW) {
        const int l = it >= ITEMS_PER_LAYER ? 1 : 0; int r = it - l * ITEMS_PER_LAYER;
        const float* W = nullptr; const float* g = nullptr; bf16* Wt = nullptr; int K = 64, N = 32, mode = 0, rr = 0;
#pragma unroll
        for (int m = 0; m < 7; ++m) {
            const int items = (wd[m].K / 64) * (wd[m].Np / 32);
            if (r >= 0 && r < items) { K = wd[m].K; N = wd[m].N; mode = wd[m].mode; rr = r;
                W = c.in[wd[m].in_idx] + (size_t)l * wd[m].K * wd[m].N; g = wd[m].g_idx >= 0 ? c.in[wd[m].g_idx >= 0 ? wd[m].g_idx : 0] + (size_t)l * wd[m].K : nullptr;
                Wt = (bf16*)(c.ws + WS_WIN + l * SZ_WLAYER + wd[m].off); }
            r -= items;
        }
        p0_transpose_item(W, K, N, Wt, mode, g, rr, scr, c.lane);
    }
    const int gt = c.vb * NTHREADS + c.tid, NGT = c.G * NTHREADS;
    for (int l = 0; l < 2; ++l) {
        const float* src = c.in[19] + (size_t)l * 262144; bf16* dst = (bf16*)(c.ws + WS_WIN + l * SZ_WLAYER + OFF_KEYS);
        for (int i = gt; i < 262144 / 8; i += NGT) { const f32x4 a = *(const f32x4*)(src + i * 8), b = *(const f32x4*)(src + i * 8 + 4);
            u32x4 o; o.x = pk2(a.x, a.y); o.y = pk2(a.z, a.w); o.z = pk2(b.x, b.y); o.w = pk2(b.z, b.w); *(u32x4*)(dst + i * 8) = o; }
    }
    for (int l = 0; l < 2; ++l)
        for (int uv = 0; uv < 2; ++uv) {
            const float* src = c.in[20 + uv] + (size_t)l * NEXP * 1024; unsigned char* dst = c.ws + WS_TAB + (size_t)(l * 2 + uv) * SZ_TAB;
            f32x4 g4[4];
#pragma unroll
            for (int j = 0; j < 4; ++j) { const float sc = uv == 0 ? U_SCALE : TAB_SCALE; g4[j] = (f32x4){sc, sc, sc, sc}; if (uv == 0) g4[j] = g4[j] * *(const f32x4*)(c.in[17] + l * 1024 + 256 * j + 4 * c.lane); }
            for (int row = gw; row < NEXP; row += 2 * NGW) {
                const float* sp = src + (size_t)row * 1024 + 4 * c.lane; const int row2 = row + NGW; const bool two = row2 < NEXP;
                const float* sp2 = src + (size_t)(two ? row2 : row) * 1024 + 4 * c.lane;
                f32x4 a[4], b[4];
#pragma unroll
                for (int j = 0; j < 4; ++j) { a[j] = *(const f32x4*)(sp + 256 * j); b[j] = *(const f32x4*)(sp2 + 256 * j); }
#pragma unroll
                for (int j = 0; j < 4; ++j) { const f32x4 v = a[j] * g4[j];
                    *(unsigned*)(dst + (size_t)row * 1024 + 256 * j + 4 * c.lane) = uv == 0 ? pack_i8x4(v) : (unsigned)__builtin_amdgcn_cvt_pk_fp8_f32(v.z, v.w, __builtin_amdgcn_cvt_pk_fp8_f32(v.x, v.y, 0, false), true); }
                if (two) {
#pragma unroll
                    for (int j = 0; j < 4; ++j) { const f32x4 v = b[j] * g4[j];
                        *(unsigned*)(dst + (size_t)row2 * 1024 + 256 * j + 4 * c.lane) = uv == 0 ? pack_i8x4(v) : (unsigned)__builtin_amdgcn_cvt_pk_fp8_f32(v.z, v.w, __builtin_amdgcn_cvt_pk_fp8_f32(v.x, v.y, 0, false), true); } }
            }
        }
    { float* rope = WSP(float, WS_ROPE);
      for (int i = gt; i < L * 16; i += NGT) { const int pos = i >> 4, j = i & 15;
          const float inv = 1.0f / __builtin_exp2f((float)j * 0.8304820237218406f);
          const float angf = (float)pos * inv; const double ang = (double)angf;
          const double nq = __builtin_rint(ang * 0.63661977236758134308);
          double rr = __builtin_fma(-nq, 1.57079632679489655800e+00, ang); rr = __builtin_fma(-nq, 6.12323399573676603587e-17, rr);
          const double r2 = rr * rr;
          double sp = -1.0 / 1307674368000.0; sp = sp * r2 + 1.0 / 6227020800.0; sp = sp * r2 - 1.0 / 39916800.0; sp = sp * r2 + 1.0 / 362880.0; sp = sp * r2 - 1.0 / 5040.0; sp = sp * r2 + 1.0 / 120.0; sp = sp * r2 - 1.0 / 6.0; sp = sp * r2 * rr + rr;
          double cp = 1.0 / 87178291200.0; cp = cp * r2 - 1.0 / 479001600.0; cp = cp * r2 + 1.0 / 3628800.0; cp = cp * r2 - 1.0 / 40320.0; cp = cp * r2 + 1.0 / 720.0; cp = cp * r2 - 1.0 / 24.0; cp = cp * r2 + 0.5; cp = 1.0 - cp * r2;
          const int qd = ((int)nq) & 3;
          const double cv = qd == 0 ? cp : qd == 1 ? -sp : qd == 2 ? -cp : sp;
          const double sv_ = qd == 0 ? sp : qd == 1 ? cp : qd == 2 ? -sp : -cp;
          rope[2 * i] = (float)cv; rope[2 * i + 1] = (float)sv_; } }
    { bf16* hb = WSP(bf16, WS_HB); float* ssq = WSP(float, WS_SSQ);
      for (int t0_ = gw; t0_ < T; t0_ += 4 * NGW) {
          f32x4 v[4][4];
#pragma unroll
          for (int i = 0; i < 4; ++i) { const int t = t0_ + i * NGW < T ? t0_ + i * NGW : t0_; const int b = t / L, pos = t % L;
              const float* src = pos < NMETA ? c.in[1] + (size_t)pos * D : c.in[0] + ((size_t)b * SEQ + (pos - NMETA)) * D;
#pragma unroll
              for (int j = 0; j < 4; ++j) v[i][j] = *(const f32x4*)(src + j * 256 + c.lane * 4); }
#pragma unroll
          for (int i = 0; i < 4; ++i) { const int t = t0_ + i * NGW;
              if (t < T) { float s = 0.f;
#pragma unroll
                  for (int j = 0; j < 4; ++j) { const f32x4 x = v[i][j]; u32x2 o; o.x = pk2(x.x, x.y); o.y = pk2(x.z, x.w); *(u32x2*)(hb + (size_t)t * D + j * 256 + c.lane * 4) = o;
                      s += (x.x * x.x + x.y * x.y) + (x.z * x.z + x.w * x.w); }
                  s = wave_sum(s);
                  if (c.lane < 8) ssq[(size_t)t * 8 + c.lane] = c.lane == 0 ? s : 0.f; } }
      } }
}

__device__ __forceinline__ void phase_A(const Ctx& c0, int l) {
    Ctx c = reopaque(c0);
    const bf16* hb = WSP(bf16, WS_HB); const bf16* Wt = (const bf16*)(c.ws + WS_WIN + l * SZ_WLAYER);
    const float* ssq = WSP(float, WS_SSQ);
    bf16* uglu = WSP(bf16, WS_UGLU); bf16* cq = WSP(bf16, WS_CQ); bf16* ckv = WSP(bf16, WS_CKV); float* krope = WSP(float, WS_KROPE);
    float* ssqq = WSP(float, WS_SSQQ); float* ssqkv = WSP(float, WS_SSQKV); bf16* gates = WSP(bf16, WS_GATES);
    constexpr int NT = NINP / 128;
    const int r = c.lane & 15, q = c.lane >> 4;
    const int xcd = c.vb / (c.G / 8), lb = c.vb % (c.G / 8), xm = xcd & 1, xn = xcd >> 1;
    const int m_lo = xm ? (MT + 1) / 2 : 0, m_cnt = xm ? MT / 2 : (MT + 1) / 2;
    for (int j = lb; j < m_cnt * 7; j += c.G / 8) {
        const int mt = m_lo + j / 7, nt = xn * 7 + j % 7;
        f32x4 acc[2][8]; acc_zero(acc);
        gemm_core(acc, hb + (size_t)mt * 128 * D, D, Wt + (size_t)nt * 128 * D, D, D, c.lds, c.tid);
#pragma unroll
        for (int mi = 0; mi < 2; ++mi) {
            const int tok = mt * 128 + 32 * c.wave + 16 * mi + r;
            const float rs = rstd_from_ssq8(ssq, tok);
            if (nt < 8) {
#pragma unroll
                for (int ni = 0; ni < 4; ++ni) { const f32x4 v = acc[mi][ni] * rs, g = acc[mi][ni + 4] * rs;
                    u32x2 o; o.x = pk2(v.x * sigmoidf_(g.x), v.y * sigmoidf_(g.y)); o.y = pk2(v.z * sigmoidf_(g.z), v.w * sigmoidf_(g.w));
                    *(u32x2*)(uglu + (size_t)tok * DC + nt * 64 + 16 * ni + 4 * q) = o; }
            } else if (nt < 11) {
                bf16* dst = nt < 10 ? cq + (size_t)tok * QL + (nt - 8) * 128 : ckv + (size_t)tok * KVL;
                float ss = 0.f;
#pragma unroll
                for (int ni = 0; ni < 8; ++ni) { const f32x4 v = acc[mi][ni] * rs; ss += (v.x * v.x + v.y * v.y) + (v.z * v.z + v.w * v.w);
                    u32x2 o; o.x = pk2(v.x, v.y); o.y = pk2(v.z, v.w); *(u32x2*)(dst + 16 * ni + 4 * q) = o; }
                ss = quad_sum(ss);
                if (q == 0) { if (nt < 10) ssqq[(size_t)tok * 2 + (nt - 8)] = ss; else ssqkv[tok] = ss; }
            } else if (nt == 11) {
#pragma unroll
                for (int ni = 0; ni < 2; ++ni) *(f32x4*)(krope + (size_t)tok * 32 + 16 * ni + 4 * q) = acc[mi][ni] * rs;
            } else {
#pragma unroll
                for (int ni = 0; ni < 8; ++ni) { const f32x4 v = acc[mi][ni] * rs;
                    u32x2 o; o.x = pk2(sigmoidf_(v.x), sigmoidf_(v.y)); o.y = pk2(sigmoidf_(v.z), sigmoidf_(v.w));
                    *(u32x2*)(gates + (size_t)tok * 2048 + (nt - 12) * 128 + 16 * ni + 4 * q) = o; }
            }
        }
    }
}

__device__ __forceinline__ void phaseB_q_item(Ctx& c, int l, int mt, int head) {
    const bf16* cq = WSP(bf16, WS_CQ); const bf16* Wt = (const bf16*)(c.ws + WS_WIN + l * SZ_WLAYER + OFF_WUQ);
    const float* ssqq = WSP(float, WS_SSQQ); const float* rope = WSP(float, WS_ROPE); const float* qg = c.in[13] + l * QK; bf16* Qb = WSP(bf16, WS_Q);
    const int r = c.lane & 15, q = c.lane >> 4;
    f32x4 acc[2][8]; acc_zero(acc);
    gemm_core(acc, cq + (size_t)mt * 128 * QL, QL, Wt + (size_t)head * 128 * QL, QL, QL, c.lds, c.tid);
    constexpr float QSCALE = 0.10206207261596575f * 1.4426950408889634f;
#pragma unroll
    for (int mi = 0; mi < 2; ++mi) {
        const int tok = mt * 128 + 32 * c.wave + 16 * mi + r, b = tok / L, pos = tok - b * L;
        const float rs = rsqrt_((ssqq[(size_t)tok * 2] + ssqq[(size_t)tok * 2 + 1]) * (1.0f / 256.0f) + EPS);
        float ss = 0.f;
#pragma unroll
        for (int ni = 0; ni < 6; ++ni) { acc[mi][ni] = acc[mi][ni] * rs; const f32x4 v = acc[mi][ni]; ss += (v.x * v.x + v.y * v.y) + (v.z * v.z + v.w * v.w); }
        ss = quad_sum(ss);
        const float rn = rsqrt_(ss * (1.0f / 96.0f) + EPS) * QSCALE;
#pragma unroll
        for (int ni = 0; ni < 6; ++ni) { const f32x4 g = *(const f32x4*)(qg + 16 * ni + 4 * q); acc[mi][ni] = acc[mi][ni] * g * rn; }
        const f32x4 cs0 = *(const f32x4*)(rope + ((size_t)pos * 16 + 4 * q) * 2), cs1 = *(const f32x4*)(rope + ((size_t)pos * 16 + 4 * q) * 2 + 4);
        const float co[4] = {cs0.x, cs0.z, cs1.x, cs1.z}, si[4] = {cs0.y, cs0.w, cs1.y, cs1.w};
        f32x4 x1 = acc[mi][4], x2 = acc[mi][5];
#pragma unroll
        for (int e = 0; e < 4; ++e) { const float a = x1[e], bb = x2[e]; x1[e] = a * co[e] - bb * si[e]; x2[e] = bb * co[e] + a * si[e]; }
        acc[mi][4] = x1; acc[mi][5] = x2;
        bf16* dst = Qb + (((size_t)b * NH + head) * L + pos) * QK;
#pragma unroll
        for (int ni = 0; ni < 6; ++ni) { const f32x4 v = acc[mi][ni]; u32x2 o; o.x = pk2(v.x, v.y); o.y = pk2(v.z, v.w); *(u32x2*)(dst + 16 * ni + 4 * q) = o; }
    }
}
__device__ __forceinline__ void phaseB_kv_item(Ctx& c, int l, int mt, int head) {
    const bf16* ckv = WSP(bf16, WS_CKV); const bf16* Wt = (const bf16*)(c.ws + WS_WIN + l * SZ_WLAYER + OFF_WUKV);
    const float* ssqkv = WSP(float, WS_SSQKV); const float* rope = WSP(float, WS_ROPE); const float* kg = c.in[14] + l * QK; const float* krope = WSP(float, WS_KROPE);
    bf16* Kb = WSP(bf16, WS_K); bf16* Vt = WSP(bf16, WS_VT);
    const int tid = c.tid, wave = c.wave, lane = c.lane, r = lane & 15, q = lane >> 4;
    unsigned char* lds = c.lds;
    f32x4 ak[2][4], av[2][4];
#pragma unroll
    for (int mi = 0; mi < 2; ++mi)
#pragma unroll
        for (int ni = 0; ni < 4; ++ni) { ak[mi][ni] = (f32x4){0.f, 0.f, 0.f, 0.f}; av[mi][ni] = (f32x4){0.f, 0.f, 0.f, 0.f}; }
    { const int chunk = tid & 7, row0 = tid >> 3;
      const bf16* pa = ckv + ((size_t)mt * 128 + row0) * KVL + chunk * 8; const bf16* pb = Wt + ((size_t)head * 128 + row0) * KVL + chunk * 8;
#pragma unroll
      for (int s = 0; s < 2; ++s)
#pragma unroll
          for (int i = 0; i < 4; ++i) { *(u32x4*)(lds + s * 32768 + lds_off(row0 + 32 * i, chunk)) = *(const u32x4*)(pa + (size_t)(32 * i) * KVL + s * 64);
              *(u32x4*)(lds + s * 32768 + 16384 + lds_off(row0 + 32 * i, chunk)) = *(const u32x4*)(pb + (size_t)(32 * i) * KVL + s * 64); }
    }
    __syncthreads();
#pragma unroll
    for (int s = 0; s < 2; ++s)
#pragma unroll
        for (int ks = 0; ks < 2; ++ks) {
            const unsigned char* sA = lds + s * 32768; const unsigned char* sB = sA + 16384;
            bf16x8 af[2], bfr[8];
#pragma unroll
            for (int mi = 0; mi < 2; ++mi) af[mi] = *(const bf16x8*)(sA + lds_off(32 * wave + 16 * mi + r, 4 * ks + q));
#pragma unroll
            for (int ni = 0; ni < 8; ++ni) bfr[ni] = *(const bf16x8*)(sB + lds_off(16 * ni + r, 4 * ks + q));
#pragma unroll
            for (int mi = 0; mi < 2; ++mi)
#pragma unroll
                for (int ni = 0; ni < 4; ++ni) { ak[mi][ni] = __builtin_amdgcn_mfma_f32_16x16x32_bf16(bfr[ni], af[mi], ak[mi][ni], 0, 0, 0);
                    av[mi][ni] = __builtin_amdgcn_mfma_f32_16x16x32_bf16(af[mi], bfr[ni + 4], av[mi][ni], 0, 0, 0); }
        }
    __syncthreads();
#pragma unroll
    for (int mi = 0; mi < 2; ++mi) {
        const int tok0 = mt * 128 + 32 * wave + 16 * mi, b = tok0 / L, pos0 = tok0 - b * L;
        { const int tok = tok0 + r, pos = pos0 + r;
          const float rs = rsqrt_(ssqkv[tok] * (1.0f / 128.0f) + EPS);
          const f32x4 kr1 = *(const f32x4*)(krope + (size_t)tok * 32 + 4 * q), kr2 = *(const f32x4*)(krope + (size_t)tok * 32 + 16 + 4 * q);
          float ss = (kr1.x * kr1.x + kr1.y * kr1.y) + (kr1.z * kr1.z + kr1.w * kr1.w) + (kr2.x * kr2.x + kr2.y * kr2.y) + (kr2.z * kr2.z + kr2.w * kr2.w);
#pragma unroll
          for (int ni = 0; ni < 4; ++ni) { ak[mi][ni] = ak[mi][ni] * rs; const f32x4 v = ak[mi][ni]; ss += (v.x * v.x + v.y * v.y) + (v.z * v.z + v.w * v.w); }
          ss = quad_sum(ss);
          const float rn = rsqrt_(ss * (1.0f / 96.0f) + EPS);
          bf16* dst = Kb + (((size_t)b * NH + head) * L + pos) * QK;
#pragma unroll
          for (int ni = 0; ni < 4; ++ni) { const f32x4 g = *(const f32x4*)(kg + 16 * ni + 4 * q); const f32x4 v = ak[mi][ni] * g * rn;
              u32x2 o; o.x = pk2(v.x, v.y); o.y = pk2(v.z, v.w); *(u32x2*)(dst + 16 * ni + 4 * q) = o; }
          const f32x4 g1 = *(const f32x4*)(kg + 64 + 4 * q), g2 = *(const f32x4*)(kg + 80 + 4 * q);
          f32x4 x1 = kr1 * g1 * rn, x2 = kr2 * g2 * rn;
          const f32x4 cs0 = *(const f32x4*)(rope + ((size_t)pos * 16 + 4 * q) * 2), cs1 = *(const f32x4*)(rope + ((size_t)pos * 16 + 4 * q) * 2 + 4);
          const float co[4] = {cs0.x, cs0.z, cs1.x, cs1.z}, si[4] = {cs0.y, cs0.w, cs1.y, cs1.w};
#pragma unroll
          for (int e = 0; e < 4; ++e) { const float a = x1[e], bb = x2[e]; x1[e] = a * co[e] - bb * si[e]; x2[e] = bb * co[e] + a * si[e]; }
          u32x2 o1, o2; o1.x = pk2(x1.x, x1.y); o1.y = pk2(x1.z, x1.w); o2.x = pk2(x2.x, x2.y); o2.y = pk2(x2.z, x2.w);
          *(u32x2*)(dst + 64 + 4 * q) = o1; *(u32x2*)(dst + 80 + 4 * q) = o2; }
        { const f32x4 sq = *(const f32x4*)(ssqkv + tok0 + 4 * q);
          f32x4 rs4; rs4.x = rsqrt_(sq.x * (1.0f / 128.0f) + EPS); rs4.y = rsqrt_(sq.y * (1.0f / 128.0f) + EPS); rs4.z = rsqrt_(sq.z * (1.0f / 128.0f) + EPS); rs4.w = rsqrt_(sq.w * (1.0f / 128.0f) + EPS);
#pragma unroll
          for (int ni = 0; ni < 4; ++ni) { const f32x4 v = av[mi][ni] * rs4; u32x2 o; o.x = pk2(v.x, v.y); o.y = pk2(v.z, v.w);
              *(u32x2*)(Vt + (((size_t)b * NH + head) * VD + 16 * ni + r) * L + pos0 + 4 * q) = o; } }
    }
}
__device__ __forceinline__ u32x4 conv_row(const bf16* uglu, int b, int pos, int ch) {
    u32x4 xv = (u32x4){0u, 0u, 0u, 0u};
    if (pos >= 0) xv = *(const u32x4*)(uglu + ((size_t)b * L + pos) * DC + ch);
    return xv;
}
__device__ __forceinline__ void conv_fma(float (&a)[8], const u32x4 xv, const f32x4 w0, const f32x4 w1) {
    a[0] += bf_lo(xv.x) * w0.x; a[1] += bf_hi(xv.x) * w0.y; a[2] += bf_lo(xv.y) * w0.z; a[3] += bf_hi(xv.y) * w0.w;
    a[4] += bf_lo(xv.z) * w1.x; a[5] += bf_hi(xv.z) * w1.y; a[6] += bf_lo(xv.w) * w1.z; a[7] += bf_hi(xv.w) * w1.w;
}
__device__ __forceinline__ void phaseB_conv_item(Ctx& c, int l, int grp) {
    const bf16* uglu = WSP(bf16, WS_UGLU); bf16* u2 = WSP(bf16, WS_U2);
    const float* cw = c.in[4] + (size_t)l * CW * DC; const float* cb = c.in[5] + l * DC; const float* lg = c.in[6] + l * DC; const float* lb = c.in[7] + l * DC;
    const int tok0 = grp * 4, b = tok0 / L, pos0 = tok0 - b * L, ch = c.lane * 8;
    float acc[4][8];
    { const f32x4 b0 = *(const f32x4*)(cb + ch), b1 = *(const f32x4*)(cb + ch + 4);
#pragma unroll
      for (int d = 0; d < 4; ++d) { acc[d][0] = b0.x; acc[d][1] = b0.y; acc[d][2] = b0.z; acc[d][3] = b0.w; acc[d][4] = b1.x; acc[d][5] = b1.y; acc[d][6] = b1.z; acc[d][7] = b1.w; } }
    const int base = pos0 - 30;
    u32x4 x0 = conv_row(uglu, b, base + 0, ch), x1 = conv_row(uglu, b, base + 1, ch), x2 = conv_row(uglu, b, base + 2, ch),
          x3 = conv_row(uglu, b, base + 3, ch), x4 = conv_row(uglu, b, base + 4, ch), x5;
    const float* wp = cw + ch;
#pragma unroll 1
    for (int w = 0; w < CW; ++w) {
        x5 = conv_row(uglu, b, (w + 5 <= 33) ? base + w + 5 : -1, ch);
        const f32x4 w0 = *(const f32x4*)wp, w1 = *(const f32x4*)(wp + 4); wp += DC;
        conv_fma(acc[0], x0, w0, w1); conv_fma(acc[1], x1, w0, w1); conv_fma(acc[2], x2, w0, w1); conv_fma(acc[3], x3, w0, w1);
        x0 = x1; x1 = x2; x2 = x3; x3 = x4; x4 = x5;
    }
    const f32x4 g0 = *(const f32x4*)(lg + ch), g1 = *(const f32x4*)(lg + ch + 4), e0 = *(const f32x4*)(lb + ch), e1 = *(const f32x4*)(lb + ch + 4);
    const float gg[8] = {g0.x, g0.y, g0.z, g0.w, g1.x, g1.y, g1.z, g1.w}, be[8] = {e0.x, e0.y, e0.z, e0.w, e1.x, e1.y, e1.z, e1.w};
#pragma unroll
    for (int d = 0; d < 4; ++d) {
        float s = 0.f;
#pragma unroll
        for (int j = 0; j < 8; ++j) s += acc[d][j];
        const float mu = wave_sum(s) * (1.0f / 512.0f);
        float vq = 0.f;
#pragma unroll
        for (int j = 0; j < 8; ++j) { acc[d][j] -= mu; vq += acc[d][j] * acc[d][j]; }
        const float rstd = rsqrt_(wave_sum(vq) * (1.0f / 512.0f) + EPS);
        float y[8];
#pragma unroll
        for (int j = 0; j < 8; ++j) { const float v = acc[d][j] * rstd * gg[j] + be[j]; y[j] = v * sigmoidf_(v); }
        u32x4 o; o.x = pk2(y[0], y[1]); o.y = pk2(y[2], y[3]); o.z = pk2(y[4], y[5]); o.w = pk2(y[6], y[7]);
        *(u32x4*)(u2 + (size_t)(tok0 + d) * DC + ch) = o;
    }
}
__device__ __forceinline__ void phase_B(const Ctx& c0, int l) {
    Ctx c = reopaque(c0);
    constexpr int NQ = MT * NH, NKV = MT * NH, NCV = T / 16;
    for (int it = c.vb; it < NQ + NKV + NCV; it += c.G) {
        if (it < NQ) phaseB_q_item(c, l, it / NH, it % NH);
        else if (it < NQ + NKV) phaseB_kv_item(c, l, (it - NQ) / NH, (it - NQ) % NH);
        else phaseB_conv_item(c, l, (it - NQ - NKV) * 4 + c.wave);
    }
}

constexpr int KROW = 208, VROW = 136, ATT_STAGE = 64 * KROW + 64 * VROW;
constexpr int ATT_ITEMS = NB * NH * 17;
__device__ __forceinline__ void phase_C(const Ctx& c0, int l) {
    Ctx c = reopaque(c0);
    const bf16* Qb = WSP(bf16, WS_Q); const bf16* Kb = WSP(bf16, WS_K); const bf16* Vt = WSP(bf16, WS_VT); bf16* O = WSP(bf16, WS_O);
    unsigned* qctr = WSP(unsigned, WS_CTL) + CW_QUEUE + 64 * l;
    volatile unsigned* misc = (volatile unsigned*)(c.lds + LDS_MISC);
    const int tid = c.tid, wave = c.wave, lane = c.lane, r = lane & 15, q = lane >> 4;
    unsigned char* lds = c.lds;
    for (;;) {
        if (tid == 0) misc[4] = atomicAdd(qctr, 1u);
        __syncthreads();
        const int item = __builtin_amdgcn_readfirstlane((int)misc[4]);
        __syncthreads();
        if (item >= ATT_ITEMS) break;
        const int pp = 15 - item / 64, bh = item % 64, b = bh / NH, h = bh % NH;
        const bool meta = pp < 0;
        const int r0 = meta ? 0 : 16 + 128 * pp;
        const int nfull = meta ? 0 : 2 * pp + 1 + (wave >> 1);
        const int ntiles = meta ? 1 : 2 * pp + 3;
        const bf16* Kbase = Kb + (size_t)bh * L * QK; const bf16* Vbase = Vt + (size_t)bh * VD * L;
        bf16x8 qf[2][3];
#pragma unroll
        for (int mi = 0; mi < 2; ++mi)
#pragma unroll
            for (int ks = 0; ks < 3; ++ks) qf[mi][ks] = *(const bf16x8*)(Qb + ((size_t)bh * L + r0 + 32 * wave + 16 * mi + r) * QK + 32 * ks + 8 * q);
        float m[2] = {-1e30f, -1e30f}, lsum[2] = {0.f, 0.f};
        f32x4 o[2][4];
#pragma unroll
        for (int mi = 0; mi < 2; ++mi)
#pragma unroll
            for (int dt = 0; dt < 4; ++dt) o[mi][dt] = (f32x4){0.f, 0.f, 0.f, 0.f};
        u32x4 rk[3], rv[2];
        auto gload = [&](int kt) {
#pragma unroll
            for (int i = 0; i < 3; ++i) { const int id = tid + 256 * i, row = id / 12, cc = id % 12; rk[i] = *(const u32x4*)(Kbase + (size_t)(kt * 64 + row) * QK + cc * 8); }
#pragma unroll
            for (int i = 0; i < 2; ++i) { const int id = tid + 256 * i, row = id >> 3, cc = id & 7; rv[i] = *(const u32x4*)(Vbase + (size_t)row * L + kt * 64 + cc * 8); }
        };
        auto lstore = [&](int s) {
            unsigned char* st = lds + s * ATT_STAGE;
#pragma unroll
            for (int i = 0; i < 3; ++i) { const int id = tid + 256 * i, row = id / 12, cc = id % 12; *(u32x4*)(st + row * KROW + cc * 16) = rk[i]; }
#pragma unroll
            for (int i = 0; i < 2; ++i) { const int id = tid + 256 * i, row = id >> 3, cc = id & 7; u32x2* d = (u32x2*)(st + 64 * KROW + row * VROW + cc * 16); d[0] = (u32x2){rv[i].x, rv[i].y}; d[1] = (u32x2){rv[i].z, rv[i].w}; }
        };
        gload(0); lstore(0);
#pragma unroll
        for (int mi = 0; mi < 2; ++mi)
#pragma unroll
            for (int ks = 0; ks < 3; ++ks) asm volatile("" : "+v"(qf[mi][ks]));
        __syncthreads();
        for (int kt = 0; kt < ntiles; ++kt) {
            const int cur = kt & 1;
            if (kt + 1 < ntiles) gload(kt + 1);
            const unsigned char* sK = lds + cur * ATT_STAGE; const unsigned char* sV = sK + 64 * KROW;
            const bool full = kt < nfull;
            if (kt <= nfull) {
                f32x4 s[2][4];
#pragma unroll
                for (int kh = 0; kh < 2; ++kh) {
                    bf16x8 kf[2][3];
#pragma unroll
                    for (int kk = 0; kk < 2; ++kk) if ((kh == 0 && kk == 0) || full) {
#pragma unroll
                        for (int ks = 0; ks < 3; ++ks) kf[kk][ks] = *(const bf16x8*)(sK + (16 * (2 * kh + kk) + r) * KROW + 64 * ks + 16 * q); }
#pragma unroll
                    for (int kk = 0; kk < 2; ++kk) { const int k4 = 2 * kh + kk;
#pragma unroll
                        for (int mi = 0; mi < 2; ++mi) s[mi][k4] = (f32x4){0.f, 0.f, 0.f, 0.f};
                        if (k4 == 0 || full) {
#pragma unroll
                            for (int ks = 0; ks < 3; ++ks)
#pragma unroll
                                for (int mi = 0; mi < 2; ++mi) s[mi][k4] = __builtin_amdgcn_mfma_f32_16x16x32_bf16(kf[kk][ks], qf[mi][ks], s[mi][k4], 0, 0, 0);
                        }
                    }
                }
                u32x2 vlo[4], vhi[4];
#pragma unroll
                for (int dt = 0; dt < 4; ++dt) { const unsigned char* vp = sV + (16 * dt + r) * VROW + (4 * q) * 2;
                    vlo[dt] = *(const u32x2*)vp; vhi[dt] = (u32x2){0u, 0u}; if (full) vhi[dt] = *(const u32x2*)(vp + 32); }
                bf16x8 pf[2][2];
#pragma unroll
                for (int mi = 0; mi < 2; ++mi) {
                    float mx = fmaxf(fmaxf(s[mi][0].x, s[mi][0].y), fmaxf(s[mi][0].z, s[mi][0].w));
                    if (full) {
#pragma unroll
                        for (int k4 = 1; k4 < 4; ++k4) mx = fmaxf(mx, fmaxf(fmaxf(s[mi][k4].x, s[mi][k4].y), fmaxf(s[mi][k4].z, s[mi][k4].w)));
                    }
                    mx = quad_max(mx);
                    const float mn = fmaxf(m[mi], mx), alpha = fast_exp2(m[mi] - mn); m[mi] = mn;
                    float ps = 0.f;
#pragma unroll
                    for (int k4 = 0; k4 < 4; ++k4) {
                        if (k4 == 0 || full) { f32x4 p; p.x = fast_exp2(s[mi][k4].x - mn); p.y = fast_exp2(s[mi][k4].y - mn); p.z = fast_exp2(s[mi][k4].z - mn); p.w = fast_exp2(s[mi][k4].w - mn);
                            ps += (p.x + p.y) + (p.z + p.w); s[mi][k4] = p; }
                    }
                    lsum[mi] = lsum[mi] * alpha + ps;
#pragma unroll
                    for (int dt = 0; dt < 4; ++dt) o[mi][dt] = o[mi][dt] * alpha;
#pragma unroll
                    for (int st = 0; st < 2; ++st) { u32x4 pw;
                        pw.x = pk2(s[mi][2 * st].x, s[mi][2 * st].y); pw.y = pk2(s[mi][2 * st].z, s[mi][2 * st].w); pw.z = pk2(s[mi][2 * st + 1].x, s[mi][2 * st + 1].y); pw.w = pk2(s[mi][2 * st + 1].z, s[mi][2 * st + 1].w);
                        if (!full) { pw.z = 0u; pw.w = 0u; }
                        pf[mi][st] = __builtin_bit_cast(bf16x8, pw); }
                }
                u32x2 wlo[4], whi[4];
                if (full) {
#pragma unroll
                    for (int dt = 0; dt < 4; ++dt) { const unsigned char* vp = sV + (16 * dt + r) * VROW + (32 + 4 * q) * 2; wlo[dt] = *(const u32x2*)vp; whi[dt] = *(const u32x2*)(vp + 32); } }
#pragma unroll
                for (int dt = 0; dt < 4; ++dt) { const bf16x8 vf = __builtin_bit_cast(bf16x8, (u32x4){vlo[dt].x, vlo[dt].y, vhi[dt].x, vhi[dt].y});
#pragma unroll
                    for (int mi = 0; mi < 2; ++mi) o[mi][dt] = __builtin_amdgcn_mfma_f32_16x16x32_bf16(vf, pf[mi][0], o[mi][dt], 0, 0, 0); }
                if (full) {
#pragma unroll
                    for (int dt = 0; dt < 4; ++dt) { const bf16x8 vf = __builtin_bit_cast(bf16x8, (u32x4){wlo[dt].x, wlo[dt].y, whi[dt].x, whi[dt].y});
#pragma unroll
                        for (int mi = 0; mi < 2; ++mi) o[mi][dt] = __builtin_amdgcn_mfma_f32_16x16x32_bf16(vf, pf[mi][1], o[mi][dt], 0, 0, 0); } }
            }
            if (kt + 1 < ntiles) lstore(cur ^ 1);
            __syncthreads();
        }
#pragma unroll
        for (int mi = 0; mi < 2; ++mi) {
            const float lt = quad_sum(lsum[mi]);
            if (!meta || (wave == 0 && mi == 0)) {
                const float inv = 1.0f / lt;
                bf16* dst = O + ((size_t)b * L + r0 + 32 * wave + 16 * mi + r) * 512 + h * VD;
#pragma unroll
                for (int dt = 0; dt < 4; ++dt) { const f32x4 v = o[mi][dt] * inv; u32x2 ov; ov.x = pk2(v.x, v.y); ov.y = pk2(v.z, v.w); *(u32x2*)(dst + 16 * dt + 4 * q) = ov; }
            }
        }
    }
}

__device__ __forceinline__ int tile_tok0(int mt, int l) { return l == 1 ? mt * 128 + NMETA * ((mt >> 4) + 1) : mt * 128; }
__device__ __forceinline__ int n_mtiles(int l) { return l == 1 ? 128 : MT; }
__device__ __forceinline__ void phase_D(const Ctx& c0, int l) {
    Ctx c = reopaque(c0);
    const bf16* u2 = WSP(bf16, WS_U2); const bf16* O = WSP(bf16, WS_O); const bf16* gates = WSP(bf16, WS_GATES); bf16* merged = WSP(bf16, WS_MERGED);
    const bf16* Wco = (const bf16*)(c.ws + WS_WIN + l * SZ_WLAYER + OFF_WCO); const bf16* Wmla = (const bf16*)(c.ws + WS_WIN + l * SZ_WLAYER + OFF_WMLA);
    const int r = c.lane & 15, q = c.lane >> 4;
    for (int it = c.vb; it < n_mtiles(l) * 8; it += c.G) {
        const int mt = it / 8, nt = it % 8, tk0 = tile_tok0(mt, l);
        f32x4 acc[2][8]; acc_zero(acc);
        gemm_core(acc, u2 + (size_t)tk0 * 512, 512, Wco + (size_t)nt * 128 * 512, 512, 512, c.lds, c.tid);
#pragma unroll
        for (int mi = 0; mi < 2; ++mi) { const int tok = tk0 + 32 * c.wave + 16 * mi + r;
            const bf16* gp = gates + (size_t)tok * 2048 + nt * 128 + 4 * q; bf16* mp = merged + (size_t)tok * D + nt * 128 + 4 * q;
#pragma unroll
            for (int ni = 0; ni < 8; ++ni) { const u32x2 g = *(const u32x2*)(gp + 16 * ni); const f32x4 v = acc[mi][ni];
                u32x2 o; o.x = pk2(v.x * bf_lo(g.x), v.y * bf_hi(g.x)); o.y = pk2(v.z * bf_lo(g.y), v.w * bf_hi(g.y)); *(u32x2*)(mp + 16 * ni) = o; } }
        acc_zero(acc);
        gemm_core(acc, O + (size_t)tk0 * 512, 512, Wmla + (size_t)nt * 128 * 512, 512, 512, c.lds, c.tid);
#pragma unroll
        for (int mi = 0; mi < 2; ++mi) { const int tok = tk0 + 32 * c.wave + 16 * mi + r;
            const bf16* gp = gates + (size_t)tok * 2048 + 1024 + nt * 128 + 4 * q; bf16* mp = merged + (size_t)tok * D + nt * 128 + 4 * q;
#pragma unroll
            for (int ni = 0; ni < 8; ++ni) { const u32x2 g = *(const u32x2*)(gp + 16 * ni); const u32x2 s = *(const u32x2*)(mp + 16 * ni); const f32x4 v = acc[mi][ni];
                u32x2 o; o.x = pk2(bf_lo(s.x) + v.x * bf_lo(g.x), bf_hi(s.x) + v.y * bf_hi(g.x)); o.y = pk2(bf_lo(s.y) + v.z * bf_lo(g.y), bf_hi(s.y) + v.w * bf_hi(g.y));
                *(u32x2*)(mp + 16 * ni) = o; } }
    }
}

__device__ __forceinline__ void phase_E(const Ctx& c0, int l) {
    Ctx c = reopaque(c0);
    const bf16* merged = WSP(bf16, WS_MERGED); const bf16* Wout = (const bf16*)(c.ws + WS_WIN + l * SZ_WLAYER + OFF_WOUT);
    float* h = WSP(float, WS_H); bf16* hb = WSP(bf16, WS_HB); float* ssq = WSP(float, WS_SSQ);
    const int r = c.lane & 15, q = c.lane >> 4;
    for (int it = c.vb; it < n_mtiles(l) * 8; it += c.G) {
        const int mt = it / 8, nt = it % 8, tk0 = tile_tok0(mt, l);
        f32x4 acc[2][8];
#pragma unroll
        for (int mi = 0; mi < 2; ++mi) { const int tok = tk0 + 32 * c.wave + 16 * mi + r; const float* hp = h + (size_t)tok * D;
            if (l == 0) { const int b = tok / L, pos = tok - b * L; hp = pos < NMETA ? c.in[1] + (size_t)pos * D : c.in[0] + ((size_t)b * SEQ + (pos - NMETA)) * D; }
            hp += nt * 128 + 4 * q;
#pragma unroll
            for (int ni = 0; ni < 8; ++ni) acc[mi][ni] = *(const f32x4*)(hp + 16 * ni); }
        gemm_core(acc, merged + (size_t)tk0 * D, D, Wout + (size_t)nt * 128 * D, D, D, c.lds, c.tid);
#pragma unroll
        for (int mi = 0; mi < 2; ++mi) { const int tok = tk0 + 32 * c.wave + 16 * mi + r; float ss = 0.f;
#pragma unroll
            for (int ni = 0; ni < 8; ++ni) { float* hp = h + (size_t)tok * D + nt * 128 + 16 * ni + 4 * q; const f32x4 v = acc[mi][ni]; *(f32x4*)hp = v;
                ss += (v.x * v.x + v.y * v.y) + (v.z * v.z + v.w * v.w);
                u32x2 o; o.x = pk2(v.x, v.y); o.y = pk2(v.z, v.w); *(u32x2*)(hb + (size_t)tok * D + nt * 128 + 16 * ni + 4 * q) = o; }
            ss = quad_sum(ss);
            if (q == 0) ssq[(size_t)tok * 8 + nt] = ss; }
    }
}

__device__ __forceinline__ unsigned f2key(float f) { const unsigned u = __float_as_uint(f); return u ^ ((u >> 31) ? 0xFFFFFFFFu : 0x80000000u); }
__device__ __forceinline__ float key2f(unsigned k) { const unsigned u = (k >> 31) ? (k ^ 0x80000000u) : ~k; return __uint_as_float(u); }
__device__ __forceinline__ void top16_insert(unsigned (&lst)[16], unsigned x) {
#pragma unroll
    for (int i = 0; i < 16; ++i) { const unsigned a = lst[i]; lst[i] = a > x ? a : x; x = a > x ? x : a; }
}
__device__ __forceinline__ void ce_desc(unsigned& a, unsigned& b) { const unsigned mx = a > b ? a : b, mn = a > b ? b : a; a = mx; b = mn; }
__device__ __forceinline__ void sort16_desc(unsigned (&v)[16]) {
#pragma unroll
    for (int k = 2; k <= 16; k <<= 1)
#pragma unroll
        for (int j = k >> 1; j > 0; j >>= 1)
#pragma unroll
            for (int i = 0; i < 16; ++i) { const int p = i ^ j; if (p > i) { if ((i & k) == 0) ce_desc(v[i], v[p]); else ce_desc(v[p], v[i]); } }
}
__device__ __forceinline__ void merge_top16(unsigned (&a)[16], const unsigned (&b)[16]) {
#pragma unroll
    for (int i = 0; i < 16; ++i) a[i] = a[i] > b[15 - i] ? a[i] : b[15 - i];
#pragma unroll
    for (int j = 8; j > 0; j >>= 1)
#pragma unroll
        for (int i = 0; i < 16; ++i) { const int p = i ^ j; if (p > i) ce_desc(a[i], a[p]); }
}
__device__ __forceinline__ void phase_F(const Ctx& c0, int l) {
    Ctx c = reopaque(c0);
    const bf16* hb = WSP(bf16, WS_HB); const bf16* Wpq = (const bf16*)(c.ws + WS_WIN + l * SZ_WLAYER + OFF_WPQ); const bf16* keys = (const bf16*)(c.ws + WS_WIN + l * SZ_WLAYER + OFF_KEYS);
    const float* ssq = WSP(float, WS_SSQ); float* sv = WSP(float, WS_SV); unsigned char* si = WSP(unsigned char, WS_SI);
    const int tid = c.tid, wave = c.wave, lane = c.lane, r = lane & 15, q = lane >> 4;
    unsigned char* lds = c.lds;
    const int xcd = c.vb / (c.G / 8), lb = c.vb % (c.G / 8), xm = xcd & 1, xn = xcd >> 1, nmt = n_mtiles(l);
    const int m_lo = xm ? (nmt + 1) / 2 : 0, m_cnt = xm ? nmt / 2 : (nmt + 1) / 2;
    for (int j = lb; j < m_cnt * 4; j += c.G / 8) {
        const int mt = m_lo + j / 4, hp = xn * 4 + j % 4, tk0 = tile_tok0(mt, l);
        f32x4 acc[2][8]; acc_zero(acc);
        u32x4 kreg[2][4]; float rsv[2];
        { const int chunk = tid & 7, row0 = tid >> 3; const bf16* pb = keys + ((size_t)hp * 128 + row0) * 128 + chunk * 8;
#pragma unroll
          for (int s = 0; s < 2; ++s)
#pragma unroll
              for (int i = 0; i < 4; ++i) kreg[s][i] = *(const u32x4*)(pb + (size_t)(32 * i) * 128 + s * 64); }
#pragma unroll
        for (int mi = 0; mi < 2; ++mi) rsv[mi] = rstd_from_ssq8(ssq, tk0 + 32 * wave + 16 * mi + r);
        gemm_core(acc, hb + (size_t)tk0 * D, D, Wpq + (size_t)hp * 128 * D, D, D, lds, tid);
#pragma unroll
        for (int mi = 0; mi < 2; ++mi) { const int row = 32 * wave + 16 * mi + r; const float rs = rsv[mi];
#pragma unroll
            for (int ni = 0; ni < 8; ++ni) { const f32x4 v = acc[mi][ni] * rs; u32x2 o; o.x = pk2(v.x, v.y); o.y = pk2(v.z, v.w);
                *(u32x2*)(lds + (ni >> 2) * 32768 + lds_off(row, 2 * (ni & 3) + (q >> 1)) + 8 * (q & 1)) = o; } }
        { const int chunk = tid & 7, row0 = tid >> 3;
#pragma unroll
          for (int s = 0; s < 2; ++s)
#pragma unroll
              for (int i = 0; i < 4; ++i) *(u32x4*)(lds + s * 32768 + 16384 + lds_off(row0 + 32 * i, chunk)) = kreg[s][i]; }
        __syncthreads();
        acc_zero(acc);
        gemm_compute_stage(acc, lds, lds + 16384, wave, lane);
        gemm_compute_stage(acc, lds + 32768, lds + 32768 + 16384, wave, lane);
        __syncthreads();
        float* S = (float*)lds;
#pragma unroll
        for (int mi = 0; mi < 2; ++mi) { const int row = 32 * wave + 16 * mi + r;
#pragma unroll
            for (int ni = 0; ni < 8; ++ni) *(f32x4*)(S + row * 132 + 16 * ni + 4 * q) = acc[mi][ni]; }
        __syncthreads();
        {
            const int tl = 32 * wave + (lane & 31), half = lane >> 5;
            const float* row = S + tl * 132;
            unsigned lst[16];
#pragma unroll
            for (int g = 0; g < 4; ++g) {
                unsigned cur[16];
#pragma unroll
                for (int j = 0; j < 4; ++j) { const int col = 64 * half + 16 * g + 4 * j; const f32x4 v = *(const f32x4*)(row + col);
                    cur[4 * j] = (f2key(v.x) & ~127u) | (unsigned)(127 - col); cur[4 * j + 1] = (f2key(v.y) & ~127u) | (unsigned)(127 - (col + 1));
                    cur[4 * j + 2] = (f2key(v.z) & ~127u) | (unsigned)(127 - (col + 2)); cur[4 * j + 3] = (f2key(v.w) & ~127u) | (unsigned)(127 - (col + 3)); }
                sort16_desc(cur);
                if (g == 0) {
#pragma unroll
                    for (int i = 0; i < 16; ++i) lst[i] = cur[i];
                } else merge_top16(lst, cur);
            }
            unsigned oth[16];
#pragma unroll
            for (int i = 0; i < 16; ++i) { auto rr = __builtin_amdgcn_permlane32_swap(lst[i], lst[i], false, false); oth[i] = half == 0 ? rr[1] : rr[0]; }
            merge_top16(lst, oth);
            if (half == 0) {
                const int tok = tk0 + tl;
                unsigned idx[16]; float val[16];
#pragma unroll
                for (int i = 0; i < 16; ++i) { idx[i] = 127u - (lst[i] & 127u); val[i] = row[idx[i]]; }
                float* svp = sv + ((size_t)tok * 16 + hp) * 16;
#pragma unroll
                for (int i = 0; i < 4; ++i) *(f32x4*)(svp + 4 * i) = (f32x4){val[4 * i], val[4 * i + 1], val[4 * i + 2], val[4 * i + 3]};
                u32x4 pi;
                pi.x = idx[0] | (idx[1] << 8) | (idx[2] << 16) | (idx[3] << 24); pi.y = idx[4] | (idx[5] << 8) | (idx[6] << 16) | (idx[7] << 24);
                pi.z = idx[8] | (idx[9] << 8) | (idx[10] << 16) | (idx[11] << 24); pi.w = idx[12] | (idx[13] << 8) | (idx[14] << 16) | (idx[15] << 24);
                *(u32x4*)(si + ((size_t)tok * 16 + hp) * 16) = pi;
            }
        }
        __syncthreads();
    }
}

__device__ __forceinline__ void phase_F3(const Ctx& c0, int l) {
    Ctx c = reopaque(c0);
    const float* sv = WSP(float, WS_SV); const unsigned char* si = WSP(unsigned char, WS_SI); int* eidx = WSP(int, WS_EIDX); float* gw = WSP(float, WS_GW); unsigned char* stb = WSP(unsigned char, WS_STB);
    float* lsv = (float*)c.lds;
    unsigned char* lsi = c.lds + 256 * 33 * 4;
    const int tid = c.tid;
    const int ntok = l == 1 ? NB * SEQ : T;
    for (int base = c.vb * NTHREADS; base < ntok * 8; base += c.G * NTHREADS) {
        const int thc = base + tid, tkc = thc >> 3;
        const int th = (l == 1 ? tkc + NMETA * ((tkc >> 11) + 1) : tkc) * 8 + (thc & 7);
        float a[16], b[16];
#pragma unroll
        for (int i = 0; i < 4; ++i) { const f32x4 x = *(const f32x4*)(sv + (size_t)th * 32 + 4 * i), y = *(const f32x4*)(sv + (size_t)th * 32 + 16 + 4 * i);
            a[4 * i] = x.x; a[4 * i + 1] = x.y; a[4 * i + 2] = x.z; a[4 * i + 3] = x.w; b[4 * i] = y.x; b[4 * i + 1] = y.y; b[4 * i + 2] = y.z; b[4 * i + 3] = y.w; }
        const u32x4 ia = *(const u32x4*)(si + (size_t)th * 32), ib = *(const u32x4*)(si + (size_t)th * 32 + 16);
#pragma unroll
        for (int i = 0; i < 16; ++i) { lsv[tid * 33 + i] = a[i]; lsv[tid * 33 + 16 + i] = b[i]; }
        *(u32x4*)(lsi + tid * 32) = ia; *(u32x4*)(lsi + tid * 32 + 16) = ib;
        unsigned lst[16], g2[16], g3[16], g4[16];
#pragma unroll
        for (int j = 0; j < 16; ++j) lst[j] = (f2key(a[0] + b[j]) & ~255u) | (unsigned)(255 - j);
#pragma unroll
        for (int i = 1; i < 16; ++i) g2[i - 1] = (f2key(a[i] + b[0]) & ~255u) | (unsigned)(255 - i * 16);
        g2[15] = 0u;
        { int n = 0;
#pragma unroll
          for (int i = 1; i < 16; ++i)
#pragma unroll
              for (int j = 1; j < 16; ++j)
                  if ((i + 1) * (j + 1) <= 16) { const unsigned key = (f2key(a[i] + b[j]) & ~255u) | (unsigned)(255 - (i * 16 + j)); if (n < 16) g3[n] = key; else g4[n - 16] = key; ++n; }
#pragma unroll
          for (int k = 3; k < 16; ++k) g4[k] = 0u; }
        sort16_desc(g3); sort16_desc(g4);
        merge_top16(lst, g2); merge_top16(g3, g4); merge_top16(lst, g3);
        __builtin_amdgcn_s_waitcnt(0xC07F); asm volatile("" ::: "memory");
        float s[16]; int e[16];
#pragma unroll
        for (int k = 0; k < 16; ++k) { const unsigned code = 255u - (lst[k] & 255u); const int i = code >> 4, j = code & 15;
            s[k] = lsv[tid * 33 + i] + lsv[tid * 33 + 16 + j]; e[k] = (int)lsi[tid * 32 + i] * 128 + (int)lsi[tid * 32 + 16 + j]; }
        float mx = s[0];
#pragma unroll
        for (int k = 1; k < 16; ++k) mx = fmaxf(mx, s[k]);
        float sum = 0.f;
#pragma unroll
        for (int k = 0; k < 16; ++k) { s[k] = fast_exp2((s[k] - mx) * 1.4426950409f); sum += s[k]; }
        const float inv = 1.0f / sum;
        typedef unsigned long long u64;
        u64 hlo = 0ull, hhi = 0ull;
#pragma unroll
        for (int k = 0; k < 16; ++k) { const int sl = e[k] >> 10; if (sl < 8) hlo += 1ull << (8 * sl); else hhi += 1ull << (8 * (sl - 8)); }
        u64 ilo = hlo, ihi = hhi;
#pragma unroll
        for (int d = 1; d < 8; d <<= 1) { const u64 a_ = __shfl_up(ilo, d, 8), b_ = __shfl_up(ihi, d, 8); if ((tid & 7) >= d) { ilo += a_; ihi += b_; } }
        const u64 tlo = __shfl(ilo, 7, 8), thi = __shfl(ihi, 7, 8);
        const u64 ones = 0x0101010101010101ull;
        const u64 inlo = tlo * ones, inhi = thi * ones + (inlo >> 56) * ones;
        const u64 stlo = inlo - tlo, sthi = inhi - thi;
        u64 rlo = stlo + (ilo - hlo), rhi = sthi + (ihi - hhi);
        const int tokn = th >> 3;
#pragma unroll
        for (int k = 0; k < 16; ++k) { const int sl = e[k] >> 10; int pos;
            if (sl < 8) { pos = (int)((rlo >> (8 * sl)) & 255ull); rlo += 1ull << (8 * sl); } else { pos = (int)((rhi >> (8 * (sl - 8))) & 255ull); rhi += 1ull << (8 * (sl - 8)); }
            eidx[(size_t)tokn * 128 + pos] = e[k]; gw[(size_t)tokn * 128 + pos] = s[k] * inv; }
        if ((tid & 7) == 0) { u64* sp = (u64*)(stb + (size_t)tokn * 16); sp[0] = stlo; sp[1] = sthi; }
        __builtin_amdgcn_s_waitcnt(0xC07F); asm volatile("" ::: "memory");
    }
}

typedef float f32x2 __attribute__((ext_vector_type(2)));
constexpr int G2_WSTRIDE = 14336, G2_MAXTOK = 9;
__device__ __forceinline__ float fp8dot4(unsigned w, unsigned x01, unsigned x23, float acc) {
    const bf16x2 lo = __builtin_amdgcn_cvt_scalef32_pk_bf16_fp8(w, 1.0f, false), hi = __builtin_amdgcn_cvt_scalef32_pk_bf16_fp8(w, 1.0f, true);
    acc = __builtin_amdgcn_fdot2_f32_bf16(lo, __builtin_bit_cast(bf16x2, x01), acc, false);
    return __builtin_amdgcn_fdot2_f32_bf16(hi, __builtin_bit_cast(bf16x2, x23), acc, false);
}
__device__ __forceinline__ float reduce8_transposed(const float (&p)[8], int lane) {
    float s[4];
#pragma unroll
    for (int k = 0; k < 4; ++k) { auto r = __builtin_amdgcn_permlane32_swap(__float_as_uint(p[k]), __float_as_uint(p[k + 4]), false, false); s[k] = __uint_as_float(r[0]) + __uint_as_float(r[1]); }
    float t[2];
#pragma unroll
    for (int k = 0; k < 2; ++k) { auto r = __builtin_amdgcn_permlane16_swap(__float_as_uint(s[k]), __float_as_uint(s[k + 2]), false, false); t[k] = __uint_as_float(r[0]) + __uint_as_float(r[1]); }
    const float u0 = t[0] + dpp<0x128>(t[0]), u1 = t[1] + dpp<0x128>(t[1]);
    float r = (lane & 8) ? u1 : u0;
    r += dpp<0xB1>(r); r += dpp<0x4E>(r); r += dpp<0x141>(r);
    return r;
}
typedef int i32x4 __attribute__((ext_vector_type(4)));
__device__ __forceinline__ void fp8fma4(f32x2 (&acc)[8], int o, unsigned w, f32x2 a2) {
    const f32x2 lo = __builtin_amdgcn_cvt_scalef32_pk_f32_fp8(w, 1.0f, false), hi = __builtin_amdgcn_cvt_scalef32_pk_f32_fp8(w, 1.0f, true);
    acc[o] = __builtin_elementwise_fma(a2, lo, acc[o]); acc[o + 1] = __builtin_elementwise_fma(a2, hi, acc[o + 1]);
}
__device__ __forceinline__ void g2_u_chunk(u32x4 (&u)[8], const unsigned char* U, const int* pe_next, const float* pw_c, float* act_c, const u32x4 xq, float rs, int lane) {
    const i32x4 e0 = *(const i32x4*)pe_next, e1 = *(const i32x4*)(pe_next + 4);
    const int en[8] = {e0.x, e0.y, e0.z, e0.w, e1.x, e1.y, e1.z, e1.w};
    float p[8];
#pragma unroll
    for (int k = 0; k < 8; k += 2) {
        int d0 = __builtin_amdgcn_sdot4((int)u[k].x, (int)xq.x, 0, false), d1 = __builtin_amdgcn_sdot4((int)u[k + 1].x, (int)xq.x, 0, false);
        d0 = __builtin_amdgcn_sdot4((int)u[k].y, (int)xq.y, d0, false); d1 = __builtin_amdgcn_sdot4((int)u[k + 1].y, (int)xq.y, d1, false);
        d0 = __builtin_amdgcn_sdot4((int)u[k].z, (int)xq.z, d0, false); d1 = __builtin_amdgcn_sdot4((int)u[k + 1].z, (int)xq.z, d1, false);
        d0 = __builtin_amdgcn_sdot4((int)u[k].w, (int)xq.w, d0, false); d1 = __builtin_amdgcn_sdot4((int)u[k + 1].w, (int)xq.w, d1, false);
        p[k] = (float)d0; p[k + 1] = (float)d1;
        asm volatile("" : "+v"(p[k]), "+v"(p[k + 1]));
        u[k] = *(const u32x4*)(U + (size_t)__builtin_amdgcn_readfirstlane(en[k]) * 1024 + lane * 16);
        u[k + 1] = *(const u32x4*)(U + (size_t)__builtin_amdgcn_readfirstlane(en[k + 1]) * 1024 + lane * 16);
    }
    const float a = reduce8_transposed(p, lane);
    const int row = (lane >> 3) & 7;
    if ((lane & 7) == 0) act_c[row] = gelu_tanh(a * rs) * pw_c[row];
}
__device__ __forceinline__ void g2_v_chunk(u32x4 (&v)[8], const unsigned char* V, const int* pe_next, const float* act_c, f32x2 (&acc)[8], int lane) {
    const i32x4 e0 = *(const i32x4*)pe_next, e1 = *(const i32x4*)(pe_next + 4);
    const int en[8] = {e0.x, e0.y, e0.z, e0.w, e1.x, e1.y, e1.z, e1.w};
    const f32x4 a0 = *(const f32x4*)act_c, a1 = *(const f32x4*)(act_c + 4);
    const float av[8] = {a0.x, a0.y, a0.z, a0.w, a1.x, a1.y, a1.z, a1.w};
#pragma unroll
    for (int k = 0; k < 8; k += 2) {
        const f32x2 a2 = (f32x2){av[k], av[k]}, b2 = (f32x2){av[k + 1], av[k + 1]};
        fp8fma4(acc, 0, v[k].x, a2); fp8fma4(acc, 2, v[k].y, a2); fp8fma4(acc, 4, v[k].z, a2); fp8fma4(acc, 6, v[k].w, a2);
        fp8fma4(acc, 0, v[k + 1].x, b2); fp8fma4(acc, 2, v[k + 1].y, b2); fp8fma4(acc, 4, v[k + 1].z, b2); fp8fma4(acc, 6, v[k + 1].w, b2);
        asm volatile("" : "+v"(acc[0]), "+v"(acc[1]), "+v"(acc[2]), "+v"(acc[3]), "+v"(acc[4]), "+v"(acc[5]), "+v"(acc[6]), "+v"(acc[7]));
        v[k] = *(const u32x4*)(V + (size_t)__builtin_amdgcn_readfirstlane(en[k]) * 1024 + lane * 16);
        v[k + 1] = *(const u32x4*)(V + (size_t)__builtin_amdgcn_readfirstlane(en[k + 1]) * 1024 + lane * 16);
    }
}
__device__ __forceinline__ void g2_finish_token(Ctx& c, int l, int tok, const f32x2 (&acc)[8], int lane) {
    float* h = WSP(float, WS_H); bf16* hbw = WSP(bf16, WS_HB); float* ssqw = WSP(float, WS_SSQ);
    float* hp = h + (size_t)tok * D + lane * 16;
    f32x4 r0 = *(const f32x4*)hp, r1 = *(const f32x4*)(hp + 4), r2 = *(const f32x4*)(hp + 8), r3 = *(const f32x4*)(hp + 12);
    r0 += (f32x4){acc[0].x, acc[0].y, acc[1].x, acc[1].y}; r1 += (f32x4){acc[2].x, acc[2].y, acc[3].x, acc[3].y};
    r2 += (f32x4){acc[4].x, acc[4].y, acc[5].x, acc[5].y}; r3 += (f32x4){acc[6].x, acc[6].y, acc[7].x, acc[7].y};
    if (l == 0) {
        *(f32x4*)hp = r0; *(f32x4*)(hp + 4) = r1; *(f32x4*)(hp + 8) = r2; *(f32x4*)(hp + 12) = r3;
        u32x4 o0, o1; o0.x = pk2(r0.x, r0.y); o0.y = pk2(r0.z, r0.w); o0.z = pk2(r1.x, r1.y); o0.w = pk2(r1.z, r1.w);
        o1.x = pk2(r2.x, r2.y); o1.y = pk2(r2.z, r2.w); o1.z = pk2(r3.x, r3.y); o1.w = pk2(r3.z, r3.w);
        *(u32x4*)(hbw + (size_t)tok * D + lane * 16) = o0; *(u32x4*)(hbw + (size_t)tok * D + lane * 16 + 8) = o1;
        float ss = (r0.x * r0.x + r0.y * r0.y) + (r0.z * r0.z + r0.w * r0.w) + (r1.x * r1.x + r1.y * r1.y) + (r1.z * r1.z + r1.w * r1.w)
                 + (r2.x * r2.x + r2.y * r2.y) + (r2.z * r2.z + r2.w * r2.w) + (r3.x * r3.x + r3.y * r3.y) + (r3.z * r3.z + r3.w * r3.w);
        ss = wave_sum_dpp(ss);
        if (lane < 8) ssqw[(size_t)tok * 8 + lane] = lane == 0 ? ss : 0.f;
    } else {
        const int b = tok / L, pos = tok - b * L;
        if (pos >= NMETA) { float* op = c.out + ((size_t)b * SEQ + (pos - NMETA)) * D + lane * 16;
            *(f32x4*)op = r0; *(f32x4*)(op + 4) = r1; *(f32x4*)(op + 8) = r2; *(f32x4*)(op + 12) = r3; }
    }
}
__device__ __forceinline__ void phase_G2(const Ctx& c0, int l) {
    Ctx c = reopaque(c0);
    const bf16* hb = WSP(bf16, WS_HB); const float* ssq = WSP(float, WS_SSQ); const int* pe = WSP(int, WS_EIDX); const float* pw = WSP(float, WS_GW);
    const unsigned char* U = c.ws + WS_TAB + (size_t)(l * 2) * SZ_TAB; const unsigned char* V = c.ws + WS_TAB + (size_t)(l * 2 + 1) * SZ_TAB;
    const int lane = c.lane, wave = c.wave;
    const int gw = c.vb * 4 + wave, t0 = l == 1 ? gw * 8 + NMETA * ((gw >> 8) + 1) : gw * 8;
    const bool has_x = l == 0 && (c.vb & 3) == 0; const int tx = T - 128 + (c.vb >> 2);
    unsigned char* wl = c.lds + wave * G2_WSTRIDE;
    int* pe_l = (int*)wl; float* pw_l = (float*)(wl + 4608); float* act_l = (float*)(wl + 9216);
#pragma unroll
    for (int j = 0; j < G2_MAXTOK; ++j) { const int tok = j < 8 ? t0 + j : (has_x ? tx : t0);
        pe_l[j * 128 + lane] = pe[(size_t)tok * 128 + lane]; pe_l[j * 128 + 64 + lane] = pe[(size_t)tok * 128 + 64 + lane];
        pw_l[j * 128 + lane] = pw[(size_t)tok * 128 + lane] * TAB_INV; pw_l[j * 128 + 64 + lane] = pw[(size_t)tok * 128 + 64 + lane] * TAB_INV; }
    const int xlo = has_x ? 4 * wave : 16, xhi = has_x ? 4 * wave + 4 : 16;
    {
        u32x4 xq[G2_MAXTOK]; float rs[G2_MAXTOK];
#pragma unroll
        for (int j = 0; j < G2_MAXTOK; ++j) { const int tok = j < 8 ? t0 + j : (has_x ? tx : t0);
            const u32x4 lo = *(const u32x4*)(hb + (size_t)tok * D + lane * 16), hi = *(const u32x4*)(hb + (size_t)tok * D + lane * 16 + 8);
            const f32x4 f0 = (f32x4){bf_lo(lo.x), bf_hi(lo.x), bf_lo(lo.y), bf_hi(lo.y)}, f1 = (f32x4){bf_lo(lo.z), bf_hi(lo.z), bf_lo(lo.w), bf_hi(lo.w)};
            const f32x4 f2 = (f32x4){bf_lo(hi.x), bf_hi(hi.x), bf_lo(hi.y), bf_hi(hi.y)}, f3 = (f32x4){bf_lo(hi.z), bf_hi(hi.z), bf_lo(hi.w), bf_hi(hi.w)};
            float mx = 1e-20f;
#pragma unroll
            for (int i = 0; i < 4; ++i) mx = fmaxf(mx, fmaxf(fmaxf(fabsf(f0[i]), fabsf(f1[i])), fmaxf(fabsf(f2[i]), fabsf(f3[i]))));
            mx = fmaxf(mx, dpp<0xB1>(mx)); mx = fmaxf(mx, dpp<0x4E>(mx)); mx = fmaxf(mx, dpp<0x141>(mx)); mx = fmaxf(mx, dpp<0x128>(mx)); mx = xrow16_max(mx);
            const float sx = 127.0f / mx;
            xq[j].x = pack_i8x4(f0 * sx); xq[j].y = pack_i8x4(f1 * sx); xq[j].z = pack_i8x4(f2 * sx); xq[j].w = pack_i8x4(f3 * sx);
            rs[j] = rstd_from_ssq8(ssq, tok) * mx * (1.0f / (127.0f * U_SCALE)); }
        u32x4 u[8];
#pragma unroll
        for (int k = 0; k < 8; ++k) u[k] = *(const u32x4*)(U + (size_t)__builtin_amdgcn_readfirstlane(pe_l[k]) * 1024 + lane * 16);
#pragma unroll 1
        for (int ch = 0; ch < 16; ++ch) {
            const int cn = ch < 15 ? ch + 1 : 0;
            const bool x_here = ch >= xlo && ch < xhi;
#pragma unroll
            for (int j = 0; j < 8; ++j) {
                const int* pe_next = j < 7 ? pe_l + (j + 1) * 128 + ch * 8 : (x_here ? pe_l + 8 * 128 + ch * 8 : pe_l + cn * 8);
                g2_u_chunk(u, U, pe_next, pw_l + j * 128 + ch * 8, act_l + j * 128 + ch * 8, xq[j], rs[j], lane); }
            if (x_here) g2_u_chunk(u, U, pe_l + cn * 8, pw_l + 8 * 128 + ch * 8, act_l + 8 * 128 + ch * 8, xq[8], rs[8], lane);
        }
    }
    f32x2 acc[G2_MAXTOK][8];
#pragma unroll
    for (int j = 0; j < G2_MAXTOK; ++j)
#pragma unroll
        for (int i = 0; i < 8; ++i) acc[j][i] = (f32x2){0.f, 0.f};
    {
        u32x4 v[8];
#pragma unroll
        for (int k = 0; k < 8; ++k) v[k] = *(const u32x4*)(V + (size_t)__builtin_amdgcn_readfirstlane(pe_l[k]) * 1024 + lane * 16);
#pragma unroll 1
        for (int ch = 0; ch < 16; ++ch) {
            const int cn = ch < 15 ? ch + 1 : 0;
            const bool x_here = ch >= xlo && ch < xhi;
#pragma unroll
            for (int j = 0; j < 8; ++j) {
                const int* pe_next = j < 7 ? pe_l + (j + 1) * 128 + ch * 8 : (x_here ? pe_l + 8 * 128 + ch * 8 : pe_l + cn * 8);
                g2_v_chunk(v, V, pe_next, act_l + j * 128 + ch * 8, acc[j], lane); }
            if (x_here) g2_v_chunk(v, V, pe_l + cn * 8, act_l + 8 * 128 + ch * 8, acc[8], lane);
        }
    }
#pragma unroll
    for (int j = 0; j < 8; ++j) g2_finish_token(c, l, t0 + j, acc[j], lane);
    __syncthreads();
    if (has_x) {
        f32x2* part = (f32x2*)(c.lds + wave * G2_WSTRIDE);
#pragma unroll
        for (int i = 0; i < 8; ++i) part[i * 64 + lane] = acc[8][i];
    }
    __syncthreads();
    if (has_x && wave == 0) {
        f32x2 tot[8];
#pragma unroll
        for (int i = 0; i < 8; ++i) { tot[i] = acc[8][i];
#pragma unroll
            for (int w = 1; w < 4; ++w) tot[i] += ((const f32x2*)(c.lds + w * G2_WSTRIDE))[i * 64 + lane]; }
        g2_finish_token(c, l, tx, tot, lane);
    }
    __syncthreads();
}

struct Args { const float* in[22]; float* out; unsigned char* ws; int ph_lo, ph_hi; };
constexpr int N_PHASES = 17;

__global__ void __launch_bounds__(NTHREADS, 2) fwd_kernel(Args args) {
    extern __shared__ __attribute__((aligned(16))) unsigned char lds_raw[];
    Ctx c;
#pragma unroll
    for (int i = 0; i < 22; ++i) c.in[i] = args.in[i];
    c.out = args.out; c.ws = args.ws; c.lds = lds_raw;
    c.tid = threadIdx.x; c.lane = c.tid & 63; c.wave = __builtin_amdgcn_readfirstlane(c.tid >> 6);
    c.G = gridDim.x; { const int bx = blockIdx.x; c.vb = (c.G % 8 == 0) ? (bx % 8) * (c.G / 8) + bx / 8 : bx; }
    volatile unsigned* misc = (volatile unsigned*)(c.lds + LDS_MISC);
    if (c.tid < 16) misc[c.tid] = 0u;
    __syncthreads();
    const int lo = args.ph_lo, hi = args.ph_hi;
    const bool multi = (hi - lo) > 1;
    XcdBarrier bar; bar.bar = WSP(unsigned, WS_CTL) + CW_BAR; bar.x = 0; bar.st = misc;
    if (multi) bar = xcd_barrier_post(WSP(unsigned, WS_CTL) + CW_BAR, misc);
#define IN_(k) (lo <= (k) && (k) < hi)
#define SEAM_(k) do { if ((k) + 1 < hi) xcd_barrier(bar); } while (0)
    if (IN_(0)) { phase_prologue(c); SEAM_(0); }
#pragma unroll 1
    for (int l = 0; l < 2; ++l) {
        const int p0 = 1 + 8 * l;
        if (IN_(p0 + 0)) { phase_A(c, l); SEAM_(p0 + 0); }
        if (IN_(p0 + 1)) { phase_B(c, l); SEAM_(p0 + 1); }
        if (IN_(p0 + 2)) { phase_C(c, l); SEAM_(p0 + 2); }
        if (IN_(p0 + 3)) { phase_D(c, l); SEAM_(p0 + 3); }
        if (IN_(p0 + 4)) { phase_E(c, l); SEAM_(p0 + 4); }
        if (IN_(p0 + 5)) { phase_F(c, l); SEAM_(p0 + 5); }
        if (IN_(p0 + 6)) { phase_F3(c, l); SEAM_(p0 + 6); }
        if (IN_(p0 + 7)) { phase_G2(c, l); SEAM_(p0 + 7); }
    }
}

extern "C" void kernel_launch(void* const* d_in, const int* in_sizes, int n_in, void* d_out, int out_size, void* d_ws, size_t ws_size, hipStream_t stream) {
    static int grid = 0;
    if (grid == 0) {
        if (n_in != 22 || out_size != NB * SEQ * D || ws_size < WS_END) { fprintf(stderr, "kernel_launch: unexpected shapes (n_in %d out %d ws %zu need %zu)\n", n_in, out_size, ws_size, (size_t)WS_END); grid = -1; return; }
        int dev = 0, cus = 0, per_cu = 0;
        hipGetDevice(&dev); hipDeviceGetAttribute(&cus, hipDeviceAttributeMultiprocessorCount, dev);
        if (hipFuncSetAttribute((const void*)fwd_kernel, hipFuncAttributeMaxDynamicSharedMemorySize, LDS_BYTES) != hipSuccess) { fprintf(stderr, "kernel_launch: hipFuncSetAttribute failed\n"); grid = -1; return; }
        if (hipOccupancyMaxActiveBlocksPerMultiprocessor(&per_cu, (const void*)fwd_kernel, NTHREADS, LDS_BYTES) != hipSuccess || per_cu < 1) { fprintf(stderr, "kernel_launch: occupancy query failed (%d)\n", per_cu); per_cu = 1; (void)hipGetLastError(); }
        if (per_cu > 2) per_cu = 2;
        grid = cus * per_cu;
        if (grid != 512) { fprintf(stderr, "kernel_launch: grid %d unsupported by phase G2 (needs 512 workgroups)\n", grid); grid = -1; return; }
        fprintf(stderr, "kernel_launch: grid %d (%d per CU), lds %d, ws need %zu have %zu\n", grid, per_cu, LDS_BYTES, (size_t)WS_END, ws_size);
    }
    if (grid < 0) return;
    hipMemsetAsync((char*)d_ws + WS_CTL, 0, CTL_BYTES, stream);
    Args a{};
    for (int i = 0; i < 22; ++i) a.in[i] = (const float*)d_in[i];
    a.out = (float*)d_out; a.ws = (unsigned char*)d_ws;
#if MK_PER_PHASE
    for (int ph = 0; ph < N_PHASES; ++ph) { a.ph_lo = ph; a.ph_hi = ph + 1; hipLaunchKernelGGL(fwd_kernel, dim3(grid), dim3(NTHREADS), LDS_BYTES, stream, a); }
#else
    a.ph_lo = 0; a.ph_hi = N_PHASES;
    void* kargs[] = {&a};
    hipError_t e = hipLaunchCooperativeKernel((const void*)fwd_kernel, dim3(grid), dim3(NTHREADS), kargs, LDS_BYTES, stream);
    if (e != hipSuccess) fprintf(stderr, "kernel_launch: cooperative launch failed: %s (grid %d)\n", hipGetErrorString(e), grid);
#endif
}
```

```cpp
#include <hip/hip_runtime.h>
#include <cstdio>
#include <cstdint>

#ifndef MK_PER_PHASE
#define MK_PER_PHASE 0
#endif

typedef unsigned short bf16;
typedef short bf16x8 __attribute__((ext_vector_type(8)));
typedef float f32x4 __attribute__((ext_vector_type(4)));
typedef unsigned u32x4 __attribute__((ext_vector_type(4)));
typedef unsigned u32x2 __attribute__((ext_vector_type(2)));
typedef __bf16 bf16x2 __attribute__((ext_vector_type(2)));

constexpr int NB = 8, SEQ = 2048, NMETA = 16, L = SEQ + NMETA, T = NB * L, D = 1024;
constexpr int DC = 512, CW = 31, NH = 8, QL = 256, KVL = 128, NOPE = 64, ROPE = 32, QK = 96, VD = 64;
constexpr int NIN = 3488, NINP = 3584;
constexpr int NEXP = 16384;
constexpr float EPS = 1e-6f;
constexpr int MT = T / 128;
static_assert(T % 128 == 0, "T tiles");

constexpr size_t al256(size_t x) { return (x + 255) & ~(size_t)255; }
constexpr size_t WS_CTL = 0;
constexpr size_t CTL_BYTES = 65536;
constexpr size_t WS_ROPE = WS_CTL + CTL_BYTES;
constexpr size_t WS_WIN = al256(WS_ROPE + (size_t)L * 16 * 8);
constexpr size_t SZ_WIN = (size_t)NINP * 1024 * 2, SZ_WCO = (size_t)1024 * 512 * 2, SZ_WUQ = (size_t)1024 * 256 * 2, SZ_WUKV = (size_t)1024 * 128 * 2,
                 SZ_WMLA = (size_t)1024 * 512 * 2, SZ_WOUT = (size_t)1024 * 1024 * 2, SZ_WPQ = (size_t)2048 * 1024 * 2, SZ_KEYS = (size_t)16 * 128 * 128 * 2;
constexpr size_t OFF_WCO = SZ_WIN, OFF_WUQ = OFF_WCO + SZ_WCO, OFF_WUKV = OFF_WUQ + SZ_WUQ, OFF_WMLA = OFF_WUKV + SZ_WUKV, OFF_WOUT = OFF_WMLA + SZ_WMLA,
                 OFF_WPQ = OFF_WOUT + SZ_WOUT, OFF_KEYS = OFF_WPQ + SZ_WPQ, SZ_WLAYER = OFF_KEYS + SZ_KEYS;
constexpr size_t WS_TAB = al256(WS_WIN + 2 * SZ_WLAYER);
constexpr size_t SZ_TAB = (size_t)NEXP * 1024;
constexpr float TAB_SCALE = 256.0f, TAB_INV = 1.0f / 256.0f;
constexpr float U_CLIP = 0.2f, U_SCALE = 127.0f / U_CLIP;
constexpr size_t WS_H = al256(WS_TAB + 4 * SZ_TAB);
constexpr size_t WS_HB = al256(WS_H + (size_t)T * 1024 * 4);
constexpr size_t WS_SSQ = al256(WS_HB + (size_t)T * 1024 * 2);
constexpr size_t WS_UGLU = al256(WS_SSQ + (size_t)T * 8 * 4);
constexpr size_t WS_CQ = al256(WS_UGLU + (size_t)T * 512 * 2);
constexpr size_t WS_CKV = al256(WS_CQ + (size_t)T * 256 * 2);
constexpr size_t WS_KROPE = al256(WS_CKV + (size_t)T * 128 * 2);
constexpr size_t WS_SSQQ = al256(WS_KROPE + (size_t)T * 32 * 4);
constexpr size_t WS_SSQKV = al256(WS_SSQQ + (size_t)T * 2 * 4);
constexpr size_t WS_U2 = al256(WS_SSQKV + (size_t)T * 4);
constexpr size_t WS_Q = al256(WS_U2 + (size_t)T * 512 * 2);
constexpr size_t WS_K = al256(WS_Q + (size_t)T * NH * QK * 2);
constexpr size_t WS_VT = al256(WS_K + (size_t)T * NH * QK * 2);
constexpr size_t WS_O = al256(WS_VT + (size_t)T * NH * VD * 2 + 4096);
constexpr size_t WS_MERGED = al256(WS_O + (size_t)T * 512 * 2);
constexpr size_t WS_GATES = al256(WS_MERGED + (size_t)T * 1024 * 2);
constexpr size_t WS_SV = WS_GATES;
constexpr size_t WS_SI = al256(WS_SV + (size_t)T * 256 * 4);
constexpr size_t WS_EIDX = al256(WS_SI + (size_t)T * 256);
constexpr size_t WS_GW = al256(WS_EIDX + (size_t)T * 128 * 4);
constexpr size_t WS_STB = al256(WS_GW + (size_t)T * 128 * 4);
constexpr size_t WS_PEER_END = WS_STB + (size_t)T * 16;
constexpr size_t WS_END = al256(WS_GATES + (size_t)T * 2048 * 2);
static_assert(WS_PEER_END <= WS_END, "peer scratch overlay");

constexpr int CW_BAR = 0;
constexpr int CW_QUEUE = 4096;

constexpr int LDS_MAIN = 128 * 132 * 4;
constexpr int LDS_MISC = LDS_MAIN;
constexpr int LDS_BYTES = LDS_MAIN + 64;

constexpr int NTHREADS = 256;

__device__ __forceinline__ unsigned pk2(float lo, float hi) { bf16x2 v; v.x = (__bf16)lo; v.y = (__bf16)hi; return __builtin_bit_cast(unsigned, v); }
__device__ __forceinline__ unsigned pack_i8x4(f32x4 v) {
    const int a = (int)__builtin_rintf(fminf(fmaxf(v.x, -127.f), 127.f)), b = (int)__builtin_rintf(fminf(fmaxf(v.y, -127.f), 127.f));
    const int c_ = (int)__builtin_rintf(fminf(fmaxf(v.z, -127.f), 127.f)), d = (int)__builtin_rintf(fminf(fmaxf(v.w, -127.f), 127.f));
    return (unsigned)(a & 255) | ((unsigned)(b & 255) << 8) | ((unsigned)(c_ & 255) << 16) | ((unsigned)(d & 255) << 24);
}
__device__ __forceinline__ float bf_lo(unsigned p) { return __uint_as_float(p << 16); }
__device__ __forceinline__ float bf_hi(unsigned p) { return __uint_as_float(p & 0xffff0000u); }
__device__ __forceinline__ float fast_rcp(float x) { return __builtin_amdgcn_rcpf(x); }
__device__ __forceinline__ float fast_exp2(float x) { return __builtin_amdgcn_exp2f(x); }
__device__ __forceinline__ float sigmoidf_(float x) { return fast_rcp(1.0f + fast_exp2(-1.4426950409f * x)); }
__device__ __forceinline__ float gelu_tanh(float x) { const float u = 1.5957691216f * (x + 0.044715f * x * x * x); return x * fast_rcp(1.0f + fast_exp2(-1.4426950409f * u)); }
__device__ __forceinline__ float rsqrt_(float x) { return __builtin_amdgcn_rsqf(x); }
template <int CTRL> __device__ __forceinline__ float dpp(float x) { return __builtin_bit_cast(float, __builtin_amdgcn_mov_dpp(__builtin_bit_cast(int, x), CTRL, 0xf, 0xf, true)); }
__device__ __forceinline__ float xrow16_sum(float x) {
    auto s = __builtin_amdgcn_permlane16_swap(__float_as_uint(x), __float_as_uint(x), false, false);
    x = __uint_as_float(s[0]) + __uint_as_float(s[1]);
    auto t = __builtin_amdgcn_permlane32_swap(__float_as_uint(x), __float_as_uint(x), false, false);
    return __uint_as_float(t[0]) + __uint_as_float(t[1]);
}
__device__ __forceinline__ float xrow16_max(float x) {
    auto s = __builtin_amdgcn_permlane16_swap(__float_as_uint(x), __float_as_uint(x), false, false);
    x = fmaxf(__uint_as_float(s[0]), __uint_as_float(s[1]));
    auto t = __builtin_amdgcn_permlane32_swap(__float_as_uint(x), __float_as_uint(x), false, false);
    return fmaxf(__uint_as_float(t[0]), __uint_as_float(t[1]));
}
__device__ __forceinline__ float wave_sum_dpp(float x) {
    x += dpp<0xB1>(x); x += dpp<0x4E>(x); x += dpp<0x141>(x); x += dpp<0x128>(x); return xrow16_sum(x);
}
__device__ __forceinline__ float quad_sum(float v) { return xrow16_sum(v); }
__device__ __forceinline__ float quad_max(float v) { return xrow16_max(v); }
__device__ __forceinline__ float wave_sum(float v) { return wave_sum_dpp(v); }
__device__ __forceinline__ float dot2(unsigned a, unsigned b, float c) { return __builtin_amdgcn_fdot2_f32_bf16(__builtin_bit_cast(bf16x2, a), __builtin_bit_cast(bf16x2, b), c, false); }

#define XB_TMO      128
#define XB_XCNT(j)  (256  + 64 * (j))
#define XB_XSUB(j)  (1280 + 64 * (j))
#define XB_XGEN(j)  (2304 + 64 * (j))
#define XB_TOP      3328
#define XB_TOPGEN   3392
#define XCD_BAR_WORDS 3456
#define XB_SPIN_CAP (1u << 20)
__device__ __forceinline__ unsigned xb_ld(unsigned* p)              { return __hip_atomic_load(p, __ATOMIC_RELAXED, __HIP_MEMORY_SCOPE_AGENT); }
__device__ __forceinline__ unsigned xb_add(unsigned* p, unsigned v) { return __hip_atomic_fetch_add(p, v, __ATOMIC_RELAXED, __HIP_MEMORY_SCOPE_AGENT); }
__device__ __forceinline__ unsigned xb_xcc_id() { return (unsigned)__builtin_amdgcn_s_getreg((3 << 11) | 20) & 0xFu; }
#define XB_SPIN(cond, bar) do { unsigned _sp = 0; while (cond) { __builtin_amdgcn_s_sleep(1); \
    if ((++_sp & 255u) == 0u) { if (xb_ld(&(bar)[XB_TMO])) break; if (_sp > XB_SPIN_CAP) { atomicAdd(&(bar)[XB_TMO], 1u); break; } } } } while (0)
struct XcdBarrier { unsigned* bar; unsigned x; volatile unsigned* st; };
__device__ __forceinline__ XcdBarrier xcd_barrier_post(unsigned* bar, volatile unsigned* st) {
    XcdBarrier b; b.bar = bar; b.x = xb_xcc_id(); b.st = st;
    if (threadIdx.x == 0) (void)xb_add(&bar[XB_XCNT(b.x)], 1u);
    return b;
}
__device__ __forceinline__ void xcd_barrier_complete(unsigned* bar, unsigned x, unsigned& nloc, unsigned& nx) {
    const unsigned G = gridDim.x * gridDim.y * gridDim.z;
    unsigned sum, cnt, mine, sp = 0u;
    for (;;) {
        sum = 0u; cnt = 0u; mine = 0u;
#pragma unroll
        for (unsigned j = 0; j < 16; ++j) { const unsigned c = xb_ld(&bar[XB_XCNT(j)]); sum += c; cnt += (c > 0u) ? 1u : 0u; mine = (j == x) ? c : mine; }
        if (sum == G) break;
        __builtin_amdgcn_s_sleep(1);
        if ((++sp & 255u) == 0u) { if (xb_ld(&bar[XB_TMO])) break; if (sp > XB_SPIN_CAP) { atomicAdd(&bar[XB_TMO], 1u); break; } }
    }
    nloc = mine > 0u ? mine : 1u; nx = cnt > 0u ? cnt : 1u;
}
__device__ __forceinline__ void xcd_barrier(const XcdBarrier& b) {
    asm volatile("s_waitcnt vmcnt(0)" ::: "memory");
    __syncthreads();
    if (threadIdx.x == 0) {
        unsigned* bar = b.bar;
        __builtin_amdgcn_s_waitcnt(0);
        unsigned nloc = b.st[0], nx = b.st[1];
        if (nloc == 0u) { xcd_barrier_complete(bar, b.x, nloc, nx); b.st[0] = nloc; b.st[1] = nx; }
        const unsigned old = xb_add(&bar[XB_XSUB(b.x)], 1u);
        const unsigned gen = old / nloc;
        if (old + 1u == (gen + 1u) * nloc) {
            __builtin_amdgcn_fence(__ATOMIC_RELEASE, "agent");
            asm volatile("s_waitcnt vmcnt(0)" ::: "memory");
            const unsigned og = xb_add(&bar[XB_TOP], 1u);
            const unsigned tg = og / nx;
            if (og + 1u == (tg + 1u) * nx) xb_add(&bar[XB_TOPGEN], 1u);
            else XB_SPIN(xb_ld(&bar[XB_TOPGEN]) == tg, bar);
            __builtin_amdgcn_fence(__ATOMIC_ACQUIRE, "agent");
            xb_add(&bar[XB_XGEN(b.x)], 1u);
            asm volatile("s_waitcnt vmcnt(0)" ::: "memory");
        } else {
            XB_SPIN(xb_ld(&bar[XB_XGEN(b.x)]) == gen, bar);
            __builtin_amdgcn_fence(__ATOMIC_ACQUIRE, "agent");
            asm volatile("s_waitcnt vmcnt(0)" ::: "memory");
        }
    }
    __syncthreads();
}

struct Ctx {
    const float* in[22]; float* out; unsigned char* ws;
    unsigned char* lds; int tid, lane, wave, G, vb;
};
#define WSP(T_, off) ((T_*)(c.ws + (off)))
__device__ __forceinline__ Ctx reopaque(const Ctx& c0) {
    Ctx c = c0; int t = c0.tid; asm volatile("" : "+v"(t)); c.tid = t; c.lane = t & 63; c.wave = __builtin_amdgcn_readfirstlane(t >> 6);
    int vb = c0.vb; asm volatile("" : "+s"(vb)); c.vb = vb; return c;
}

__device__ __forceinline__ int lds_off(int row, int chunk) { return row * 128 + ((chunk ^ (row & 7)) << 4); }

__device__ __forceinline__ void gemm_compute_stage(f32x4 (&acc)[2][8], const unsigned char* sA, const unsigned char* sB, int wave, int lane) {
    const int r = lane & 15, q = lane >> 4;
    bf16x8 af[2][2], bfr[2][8];
#pragma unroll
    for (int ks = 0; ks < 2; ++ks) {
#pragma unroll
        for (int mi = 0; mi < 2; ++mi) af[ks][mi] = *(const bf16x8*)(sA + lds_off(32 * wave + 16 * mi + r, 4 * ks + q));
#pragma unroll
        for (int ni = 0; ni < 8; ++ni) bfr[ks][ni] = *(const bf16x8*)(sB + lds_off(16 * ni + r, 4 * ks + q));
    }
#pragma unroll
    for (int ks = 0; ks < 2; ++ks)
#pragma unroll
        for (int ni = 0; ni < 8; ++ni)
#pragma unroll
            for (int mi = 0; mi < 2; ++mi) acc[mi][ni] = __builtin_amdgcn_mfma_f32_16x16x32_bf16(bfr[ks][ni], af[ks][mi], acc[mi][ni], 0, 0, 0);
    __builtin_amdgcn_sched_group_barrier(0x100, 6, 0);
#pragma unroll
    for (int i = 0; i < 14; ++i) { __builtin_amdgcn_sched_group_barrier(0x8, 2, 0); __builtin_amdgcn_sched_group_barrier(0x100, 1, 0); }
    __builtin_amdgcn_sched_group_barrier(0x8, 4, 0);
}

#define LAS __attribute__((address_space(3)))
__device__ __forceinline__ void gemm_stage_glds(const bf16* A, int lda, const bf16* Bt, int ldb, int kt, unsigned char* stage, int wave, int lane) {
    const int rr = lane >> 3, cch = (lane & 7) ^ rr;
#pragma unroll
    for (int i = 0; i < 4; ++i) { const int pc = 4 * i + wave;
        __builtin_amdgcn_global_load_lds((const unsigned*)(A + (size_t)(8 * pc + rr) * lda + kt * 64 + cch * 8), (LAS unsigned*)(stage + pc * 1024), 16, 0, 0);
        __builtin_amdgcn_global_load_lds((const unsigned*)(Bt + (size_t)(8 * pc + rr) * ldb + kt * 64 + cch * 8), (LAS unsigned*)(stage + 16384 + pc * 1024), 16, 0, 0); }
}
__device__ __forceinline__ void gemm_core(f32x4 (&acc)[2][8], const bf16* A, int lda, const bf16* Bt, int ldb, int K, unsigned char* lds, int tid) {
    const int wave = __builtin_amdgcn_readfirstlane(tid >> 6), lane = tid & 63;
    const int nk = K >> 6;
    gemm_stage_glds(A, lda, Bt, ldb, 0, lds, wave, lane);
    asm volatile("s_waitcnt vmcnt(0)" ::: "memory");
    __syncthreads();
    for (int kt = 0; kt < nk; ++kt) {
        const int cur = kt & 1;
        if (kt + 1 < nk) gemm_stage_glds(A, lda, Bt, ldb, kt + 1, lds + (cur ^ 1) * 32768, wave, lane);
        gemm_compute_stage(acc, lds + cur * 32768, lds + cur * 32768 + 16384, wave, lane);
        asm volatile("s_waitcnt vmcnt(0)" ::: "memory");
        __syncthreads();
    }
}
__device__ __forceinline__ void acc_zero(f32x4 (&acc)[2][8]) {
#pragma unroll
    for (int mi = 0; mi < 2; ++mi)
#pragma unroll
        for (int ni = 0; ni < 8; ++ni) acc[mi][ni] = (f32x4){0.f, 0.f, 0.f, 0.f};
}
__device__ __forceinline__ float rstd_from_ssq8(const float* ssq, int tok) {
    const f32x4 a = *(const f32x4*)(ssq + (size_t)tok * 8), b = *(const f32x4*)(ssq + (size_t)tok * 8 + 4);
    const float s = ((a.x + a.y) + (a.z + a.w)) + ((b.x + b.y) + (b.z + b.w));
    return rsqrt_(s * (1.0f / 1024.0f) + EPS);
}

__device__ __forceinline__ int src_col(int mode, int np) {
    if (mode == 0) return np;
    if (mode == 2) { const int h = np >> 7, j = np & 127; return j < 96 ? h * 96 + j : -1; }
    if (np < 1024) { const int cblk = np >> 7, j = np & 127; return j < 64 ? 64 * cblk + j : 512 + 64 * cblk + (j - 64); }
    if (np < 1408) return np;
    if (np < 1536) { const int j = np - 1408; return j < 32 ? 1408 + j : -1; }
    return 1440 + (np - 1536);
}
__device__ __forceinline__ void p0_transpose_item(const float* W, int K, int N, bf16* Wt, int mode, const float* g, int item, float* scr, int lane) {
    const int nblk_k = K / 64, nb = item / nblk_k, kb = item % nblk_k, k0 = 64 * kb, n0 = 32 * nb;
    const int n = src_col(mode, n0 + (lane & 31));
    float wv[32], gv[32];
#pragma unroll
    for (int i = 0; i < 32; ++i) { const int kk = 2 * i + (lane >> 5); wv[i] = n >= 0 ? W[(size_t)(k0 + kk) * N + n] : 0.f; gv[i] = g ? g[k0 + kk] : 1.f; }
#pragma unroll
    for (int i = 0; i < 32; ++i) { const int kk = 2 * i + (lane >> 5); scr[kk * 33 + (lane & 31)] = wv[i] * gv[i]; }
    __builtin_amdgcn_s_waitcnt(0xC07F); asm volatile("" ::: "memory");
    const int cch = lane & 7;
#pragma unroll
    for (int j = 0; j < 4; ++j) { const int nl = (lane >> 3) + 8 * j; const float* s = scr + (8 * cch) * 33 + nl;
        u32x4 o; o.x = pk2(s[0 * 33], s[1 * 33]); o.y = pk2(s[2 * 33], s[3 * 33]); o.z = pk2(s[4 * 33], s[5 * 33]); o.w = pk2(s[6 * 33], s[7 * 33]);
        *(u32x4*)(Wt + (size_t)(n0 + nl) * K + k0 + 8 * cch) = o; }
    __builtin_amdgcn_s_waitcnt(0xC07F); asm volatile("" ::: "memory");
}
struct WDesc { int in_idx, K, N, Np, mode, g_idx; size_t off; };
__device__ __forceinline__ void phase_prologue(const Ctx& c0) {
    Ctx c = reopaque(c0);
    const int gw = c.vb * 4 + c.wave, NGW = c.G * 4;
    float* scr = (float*)(c.lds + c.wave * 8704);
    const WDesc wd[7] = {
        {3, 1024, NIN, NINP, 1, 2, 0}, {8, 512, 1024, 1024, 0, -1, OFF_WCO}, {10, 256, 768, 1024, 2, 9, OFF_WUQ}, {12, 128, 1024, 1024, 0, 11, OFF_WUKV},
        {15, 512, 1024, 1024, 0, -1, OFF_WMLA}, {16, 1024, 1024, 1024, 0, -1, OFF_WOUT}, {18, 1024, 2048, 2048, 0, 17, OFF_WPQ}};
    constexpr int ITEMS_PER_LAYER = (1024 / 64) * (NINP / 32) + (512 / 64) * 32 + (256 / 64) * 32 + (128 / 64) * 32 + (512 / 64) * 32 + (1024 / 64) * 32 + (1024 / 64) * 64;
    for (int it = gw; it < 2 * ITEMS_PER_LAYER; it += NGW) {
        const int l = it >= ITEMS_PER_LAYER ? 1 : 0; int r = it - l * ITEMS_PER_LAYER;
        const float* W = nullptr; const float* g = nullptr; bf16* Wt = nullptr; int K = 64, N = 32, mode = 0, rr = 0;
#pragma unroll
        for (int m = 0; m < 7; ++m) {
            const int items = (wd[m].K / 64) * (wd[m].Np / 32);
            if (r >= 0 && r < items) { K = wd[m].K; N = wd[m].N; mode = wd[m].mode; rr = r;
                W = c.in[wd[m].in_idx] + (size_t)l * wd[m].K * wd[m].N; g = wd[m].g_idx >= 0 ? c.in[wd[m].g_idx >= 0 ? wd[m].g_idx : 0] + (size_t)l * wd[m].K : nullptr;
                Wt = (bf16*)(c.ws + WS_WIN + l * SZ_WLAYER + wd[m].off); }
            r -= items;
        }
        p0_transpose_item(W, K, N, Wt, mode, g, rr, scr, c.lane);
    }
    const int gt = c.vb * NTHREADS + c.tid, NGT = c.G * NTHREADS;
    for (int l = 0; l < 2; ++l) {
        const float* src = c.in[19] + (size_t)l * 262144; bf16* dst = (bf16*)(c.ws + WS_WIN + l * SZ_WLAYER + OFF_KEYS);
        for (int i = gt; i < 262144 / 8; i += NGT) { const f32x4 a = *(const f32x4*)(src + i * 8), b = *(const f32x4*)(src + i * 8 + 4);
            u32x4 o; o.x = pk2(a.x, a.y); o.y = pk2(a.z, a.w); o.z = pk2(b.x, b.y); o.w = pk2(b.z, b.w); *(u32x4*)(dst + i * 8) = o; }
    }
    for (int l = 0; l < 2; ++l)
        for (int uv = 0; uv < 2; ++uv) {
            const float* src = c.in[20 + uv] + (size_t)l * NEXP * 1024; unsigned char* dst = c.ws + WS_TAB + (size_t)(l * 2 + uv) * SZ_TAB;
            f32x4 g4[4];
#pragma unroll
            for (int j = 0; j < 4; ++j) { const float sc = uv == 0 ? U_SCALE : TAB_SCALE; g4[j] = (f32x4){sc, sc, sc, sc}; if (uv == 0) g4[j] = g4[j] * *(const f32x4*)(c.in[17] + l * 1024 + 256 * j + 4 * c.lane); }
            for (int row = gw; row < NEXP; row += 2 * NGW) {
                const float* sp = src + (size_t)row * 1024 + 4 * c.lane; const int row2 = row + NGW; const bool two = row2 < NEXP;
                const float* sp2 = src + (size_t)(two ? row2 : row) * 1024 + 4 * c.lane;
                f32x4 a[4], b[4];
#pragma unroll
                for (int j = 0; j < 4; ++j) { a[j] = *(const f32x4*)(sp + 256 * j); b[j] = *(const f32x4*)(sp2 + 256 * j); }
#pragma unroll
                for (int j = 0; j < 4; ++j) { const f32x4 v = a[j] * g4[j];
                    *(unsigned*)(dst + (size_t)row * 1024 + 256 * j + 4 * c.lane) = uv == 0 ? pack_i8x4(v) : (unsigned)__builtin_amdgcn_cvt_pk_fp8_f32(v.z, v.w, __builtin_amdgcn_cvt_pk_fp8_f32(v.x, v.y, 0, false), true); }
                if (two) {
#pragma unroll
                    for (int j = 0; j < 4; ++j) { const f32x4 v = b[j] * g4[j];
                        *(unsigned*)(dst + (size_t)row2 * 1024 + 256 * j + 4 * c.lane) = uv == 0 ? pack_i8x4(v) : (unsigned)__builtin_amdgcn_cvt_pk_fp8_f32(v.z, v.w, __builtin_amdgcn_cvt_pk_fp8_f32(v.x, v.y, 0, false), true); } }
            }
        }
    { float* rope = WSP(float, WS_ROPE);
      for (int i = gt; i < L * 16; i += NGT) { const int pos = i >> 4, j = i & 15;
          const float inv = 1.0f / __builtin_exp2f((float)j * 0.8304820237218406f);
          const float angf = (float)pos * inv; const double ang = (double)angf;
          const double nq = __builtin_rint(ang * 0.63661977236758134308);
          double rr = __builtin_fma(-nq, 1.57079632679489655800e+00, ang); rr = __builtin_fma(-nq, 6.12323399573676603587e-17, rr);
          const double r2 = rr * rr;
          double sp = -1.0 / 1307674368000.0; sp = sp * r2 + 1.0 / 6227020800.0; sp = sp * r2 - 1.0 / 39916800.0; sp = sp * r2 + 1.0 / 362880.0; sp = sp * r2 - 1.0 / 5040.0; sp = sp * r2 + 1.0 / 120.0; sp = sp * r2 - 1.0 / 6.0; sp = sp * r2 * rr + rr;
          double cp = 1.0 / 87178291200.0; cp = cp * r2 - 1.0 / 479001600.0; cp = cp * r2 + 1.0 / 3628800.0; cp = cp * r2 - 1.0 / 40320.0; cp = cp * r2 + 1.0 / 720.0; cp = cp * r2 - 1.0 / 24.0; cp = cp * r2 + 0.5; cp = 1.0 - cp * r2;
          const int qd = ((int)nq) & 3;
          const double cv = qd == 0 ? cp : qd == 1 ? -sp : qd == 2 ? -cp : sp;
          const double sv_ = qd == 0 ? sp : qd == 1 ? cp : qd == 2 ? -sp : -cp;
          rope[2 * i] = (float)cv; rope[2 * i + 1] = (float)sv_; } }
    { bf16* hb = WSP(bf16, WS_HB); float* ssq = WSP(float, WS_SSQ);
      for (int t0_ = gw; t0_ < T; t0_ += 4 * NGW) {
          f32x4 v[4][4];
#pragma unroll
          for (int i = 0; i < 4; ++i) { const int t = t0_ + i * NGW < T ? t0_ + i * NGW : t0_; const int b = t / L, pos = t % L;
              const float* src = pos < NMETA ? c.in[1] + (size_t)pos * D : c.in[0] + ((size_t)b * SEQ + (pos - NMETA)) * D;
#pragma unroll
              for (int j = 0; j < 4; ++j) v[i][j] = *(const f32x4*)(src + j * 256 + c.lane * 4); }
#pragma unroll
          for (int i = 0; i < 4; ++i) { const int t = t0_ + i * NGW;
              if (t < T) { float s = 0.f;
#pragma unroll
                  for (int j = 0; j < 4; ++j) { const f32x4 x = v[i][j]; u32x2 o; o.x = pk2(x.x, x.y); o.y = pk2(x.z, x.w); *(u32x2*)(hb + (size_t)t * D + j * 256 + c.lane * 4) = o;
                      s += (x.x * x.x + x.y * x.y) + (x.z * x.z + x.w * x.w); }
                  s = wave_sum(s);
                  if (c.lane < 8) ssq[(size_t)t * 8 + c.lane] = c.lane == 0 ? s : 0.f; } }
      } }
}

__device__ __forceinline__ void phase_A(const Ctx& c0, int l) {
    Ctx c = reopaque(c0);
    const bf16* hb = WSP(bf16, WS_HB); const bf16* Wt = (const bf16*)(c.ws + WS_WIN + l * SZ_WLAYER);
    const float* ssq = WSP(float, WS_SSQ);
    bf16* uglu = WSP(bf16, WS_UGLU); bf16* cq = WSP(bf16, WS_CQ); bf16* ckv = WSP(bf16, WS_CKV); float* krope = WSP(float, WS_KROPE);
    float* ssqq = WSP(float, WS_SSQQ); float* ssqkv = WSP(float, WS_SSQKV); bf16* gates = WSP(bf16, WS_GATES);
    constexpr int NT = NINP / 128;
    const int r = c.lane & 15, q = c.lane >> 4;
    const int xcd = c.vb / (c.G / 8), lb = c.vb % (c.G / 8), xm = xcd & 1, xn = xcd >> 1;
    const int m_lo = xm ? (MT + 1) / 2 : 0, m_cnt = xm ? MT / 2 : (MT + 1) / 2;
    for (int j = lb; j < m_cnt * 7; j += c.G / 8) {
        const int mt = m_lo + j / 7, nt = xn * 7 + j % 7;
        f32x4 acc[2][8]; acc_zero(acc);
        gemm_core(acc, hb + (size_t)mt * 128 * D, D, Wt + (size_t)nt * 128 * D, D, D, c.lds, c.tid);
#pragma unroll
        for (int mi = 0; mi < 2; ++mi) {
            const int tok = mt * 128 + 32 * c.wave + 16 * mi + r;
            const float rs = rstd_from_ssq8(ssq, tok);
            if (nt < 8) {
#pragma unroll
                for (int ni = 0; ni < 4; ++ni) { const f32x4 v = acc[mi][ni] * rs, g = acc[mi][ni + 4] * rs;
                    u32x2 o; o.x = pk2(v.x * sigmoidf_(g.x), v.y * sigmoidf_(g.y)); o.y = pk2(v.z * sigmoidf_(g.z), v.w * sigmoidf_(g.w));
                    *(u32x2*)(uglu + (size_t)tok * DC + nt * 64 + 16 * ni + 4 * q) = o; }
            } else if (nt < 11) {
                bf16* dst = nt < 10 ? cq + (size_t)tok * QL + (nt - 8) * 128 : ckv + (size_t)tok * KVL;
                float ss = 0.f;
#pragma unroll
                for (int ni = 0; ni < 8; ++ni) { const f32x4 v = acc[mi][ni] * rs; ss += (v.x * v.x + v.y * v.y) + (v.z * v.z + v.w * v.w);
                    u32x2 o; o.x = pk2(v.x, v.y); o.y = pk2(v.z, v.w); *(u32x2*)(dst + 16 * ni + 4 * q) = o; }
                ss = quad_sum(ss);
                if (q == 0) { if (nt < 10) ssqq[(size_t)tok * 2 + (nt - 8)] = ss; else ssqkv[tok] = ss; }
            } else if (nt == 11) {
#pragma unroll
                for (int ni = 0; ni < 2; ++ni) *(f32x4*)(krope + (size_t)tok * 32 + 16 * ni + 4 * q) = acc[mi][ni] * rs;
            } else {
#pragma unroll
                for (int ni = 0; ni < 8; ++ni) { const f32x4 v = acc[mi][ni] * rs;
                    u32x2 o; o.x = pk2(sigmoidf_(v.x), sigmoidf_(v.y)); o.y = pk2(sigmoidf_(v.z), sigmoidf_(v.w));
                    *(u32x2*)(gates + (size_t)tok * 2048 + (nt - 12) * 128 + 16 * ni + 4 * q) = o; }
            }
        }
    }
}

__device__ __forceinline__ void phaseB_q_item(Ctx& c, int l, int mt, int head) {
    const bf16* cq = WSP(bf16, WS_CQ); const bf16* Wt = (const bf16*)(c.ws + WS_WIN + l * SZ_WLAYER + OFF_WUQ);
    const float* ssqq = WSP(float, WS_SSQQ); const float* rope = WSP(float, WS_ROPE); const float* qg = c.in[13] + l * QK; bf16* Qb = WSP(bf16, WS_Q);
    const int r = c.lane & 15, q = c.lane >> 4;
    f32x4 acc[2][8]; acc_zero(acc);
    gemm_core(acc, cq + (size_t)mt * 128 * QL, QL, Wt + (size_t)head * 128 * QL, QL, QL, c.lds, c.tid);
    constexpr float QSCALE = 0.10206207261596575f * 1.4426950408889634f;
#pragma unroll
    for (int mi = 0; mi < 2; ++mi) {
        const int tok = mt * 128 + 32 * c.wave + 16 * mi + r, b = tok / L, pos = tok - b * L;
        const float rs = rsqrt_((ssqq[(size_t)tok * 2] + ssqq[(size_t)tok * 2 + 1]) * (1.0f / 256.0f) + EPS);
        float ss = 0.f;
#pragma unroll
        for (int ni = 0; ni < 6; ++ni) { acc[mi][ni] = acc[mi][ni] * rs; const f32x4 v = acc[mi][ni]; ss += (v.x * v.x + v.y * v.y) + (v.z * v.z + v.w * v.w); }
        ss = quad_sum(ss);
        const float rn = rsqrt_(ss * (1.0f / 96.0f) + EPS) * QSCALE;
#pragma unroll
        for (int ni = 0; ni < 6; ++ni) { const f32x4 g = *(const f32x4*)(qg + 16 * ni + 4 * q); acc[mi][ni] = acc[mi][ni] * g * rn; }
        const f32x4 cs0 = *(const f32x4*)(rope + ((size_t)pos * 16 + 4 * q) * 2), cs1 = *(const f32x4*)(rope + ((size_t)pos * 16 + 4 * q) * 2 + 4);
        const float co[4] = {cs0.x, cs0.z, cs1.x, cs1.z}, si[4] = {cs0.y, cs0.w, cs1.y, cs1.w};
        f32x4 x1 = acc[mi][4], x2 = acc[mi][5];
#pragma unroll
        for (int e = 0; e < 4; ++e) { const float a = x1[e], bb = x2[e]; x1[e] = a * co[e] - bb * si[e]; x2[e] = bb * co[e] + a * si[e]; }
        acc[mi][4] = x1; acc[mi][5] = x2;
        bf16* dst = Qb + (((size_t)b * NH + head) * L + pos) * QK;
#pragma unroll
        for (int ni = 0; ni < 6; ++ni) { const f32x4 v = acc[mi][ni]; u32x2 o; o.x = pk2(v.x, v.y); o.y = pk2(v.z, v.w); *(u32x2*)(dst + 16 * ni + 4 * q) = o; }
    }
}
__device__ __forceinline__ void phaseB_kv_item(Ctx& c, int l, int mt, int head) {
    const bf16* ckv = WSP(bf16, WS_CKV); const bf16* Wt = (const bf16*)(c.ws + WS_WIN + l * SZ_WLAYER + OFF_WUKV);
    const float* ssqkv = WSP(float, WS_SSQKV); const float* rope = WSP(float, WS_ROPE); const float* kg = c.in[14] + l * QK; const float* krope = WSP(float, WS_KROPE);
    bf16* Kb = WSP(bf16, WS_K); bf16* Vt = WSP(bf16, WS_VT);
    const int tid = c.tid, wave = c.wave, lane = c.lane, r = lane & 15, q = lane >> 4;
    unsigned char* lds = c.lds;
    f32x4 ak[2][4], av[2][4];
#pragma unroll
    for (int mi = 0; mi < 2; ++mi)
#pragma unroll
        for (int ni = 0; ni < 4; ++ni) { ak[mi][ni] = (f32x4){0.f, 0.f, 0.f, 0.f}; av[mi][ni] = (f32x4){0.f, 0.f, 0.f, 0.f}; }
    { const int chunk = tid & 7, row0 = tid >> 3;
      const bf16* pa = ckv + ((size_t)mt * 128 + row0) * KVL + chunk * 8; const bf16* pb = Wt + ((size_t)head * 128 + row0) * KVL + chunk * 8;
#pragma unroll
      for (int s = 0; s < 2; ++s)
#pragma unroll
          for (int i = 0; i < 4; ++i) { *(u32x4*)(lds + s * 32768 + lds_off(row0 + 32 * i, chunk)) = *(const u32x4*)(pa + (size_t)(32 * i) * KVL + s * 64);
              *(u32x4*)(lds + s * 32768 + 16384 + lds_off(row0 + 32 * i, chunk)) = *(const u32x4*)(pb + (size_t)(32 * i) * KVL + s * 64); }
    }
    __syncthreads();
#pragma unroll
    for (int s = 0; s < 2; ++s)
#pragma unroll
        for (int ks = 0; ks < 2; ++ks) {
            const unsigned char* sA = lds + s * 32768; const unsigned char* sB = sA + 16384;
            bf16x8 af[2], bfr[8];
#pragma unroll
            for (int mi = 0; mi < 2; ++mi) af[mi] = *(const bf16x8*)(sA + lds_off(32 * wave + 16 * mi + r, 4 * ks + q));
#pragma unroll
            for (int ni = 0; ni < 8; ++ni) bfr[ni] = *(const bf16x8*)(sB + lds_off(16 * ni + r, 4 * ks + q));
#pragma unroll
            for (int mi = 0; mi < 2; ++mi)
#pragma unroll
                for (int ni = 0; ni < 4; ++ni) { ak[mi][ni] = __builtin_amdgcn_mfma_f32_16x16x32_bf16(bfr[ni], af[mi], ak[mi][ni], 0, 0, 0);
                    av[mi][ni] = __builtin_amdgcn_mfma_f32_16x16x32_bf16(af[mi], bfr[ni + 4], av[mi][ni], 0, 0, 0); }
        }
    __syncthreads();
#pragma unroll
    for (int mi = 0; mi < 2; ++mi) {
        const int tok0 = mt * 128 + 32 * wave + 16 * mi, b = tok0 / L, pos0 = tok0 - b * L;
        { const int tok = tok0 + r, pos = pos0 + r;
          const float rs = rsqrt_(ssqkv[tok] * (1.0f / 128.0f) + EPS);
          const f32x4 kr1 = *(const f32x4*)(krope + (size_t)tok * 32 + 4 * q), kr2 = *(const f32x4*)(krope + (size_t)tok * 32 + 16 + 4 * q);
          float ss = (kr1.x * kr1.x + kr1.y * kr1.y) + (kr1.z * kr1.z + kr1.w * kr1.w) + (kr2.x * kr2.x + kr2.y * kr2.y) + (kr2.z * kr2.z + kr2.w * kr2.w);
#pragma unroll
          for (int ni = 0; ni < 4; ++ni) { ak[mi][ni] = ak[mi][ni] * rs; const f32x4 v = ak[mi][ni]; ss += (v.x * v.x + v.y * v.y) + (v.z * v.z + v.w * v.w); }
          ss = quad_sum(ss);
          const float rn = rsqrt_(ss * (1.0f / 96.0f) + EPS);
          bf16* dst = Kb + (((size_t)b * NH + head) * L + pos) * QK;
#pragma unroll
          for (int ni = 0; ni < 4; ++ni) { const f32x4 g = *(const f32x4*)(kg + 16 * ni + 4 * q); const f32x4 v = ak[mi][ni] * g * rn;
              u32x2 o; o.x = pk2(v.x, v.y); o.y = pk2(v.z, v.w); *(u32x2*)(dst + 16 * ni + 4 * q) = o; }
          const f32x4 g1 = *(const f32x4*)(kg + 64 + 4 * q), g2 = *(const f32x4*)(kg + 80 + 4 * q);
          f32x4 x1 = kr1 * g1 * rn, x2 = kr2 * g2 * rn;
          const f32x4 cs0 = *(const f32x4*)(rope + ((size_t)pos * 16 + 4 * q) * 2), cs1 = *(const f32x4*)(rope + ((size_t)pos * 16 + 4 * q) * 2 + 4);
          const float co[4] = {cs0.x, cs0.z, cs1.x, cs1.z}, si[4] = {cs0.y, cs0.w, cs1.y, cs1.w};
#pragma unroll
          for (int e = 0; e < 4; ++e) { const float a = x1[e], bb = x2[e]; x1[e] = a * co[e] - bb * si[e]; x2[e] = bb * co[e] + a * si[e]; }
          u32x2 o1, o2; o1.x = pk2(x1.x, x1.y); o1.y = pk2(x1.z, x1.w); o2.x = pk2(x2.x, x2.y); o2.y = pk2(x2.z, x2.w);
          *(u32x2*)(dst + 64 + 4 * q) = o1; *(u32x2*)(dst + 80 + 4 * q) = o2; }
        { const f32x4 sq = *(const f32x4*)(ssqkv + tok0 + 4 * q);
          f32x4 rs4; rs4.x = rsqrt_(sq.x * (1.0f / 128.0f) + EPS); rs4.y = rsqrt_(sq.y * (1.0f / 128.0f) + EPS); rs4.z = rsqrt_(sq.z * (1.0f / 128.0f) + EPS); rs4.w = rsqrt_(sq.w * (1.0f / 128.0f) + EPS);
#pragma unroll
          for (int ni = 0; ni < 4; ++ni) { const f32x4 v = av[mi][ni] * rs4; u32x2 o; o.x = pk2(v.x, v.y); o.y = pk2(v.z, v.w);
              *(u32x2*)(Vt + (((size_t)b * NH + head) * VD + 16 * ni + r) * L + pos0 + 4 * q) = o; } }
    }
}
__device__ __forceinline__ u32x4 conv_row(const bf16* uglu, int b, int pos, int ch) {
    u32x4 xv = (u32x4){0u, 0u, 0u, 0u};
    if (pos >= 0) xv = *(const u32x4*)(uglu + ((size_t)b * L + pos) * DC + ch);
    return xv;
}
__device__ __forceinline__ void conv_fma(float (&a)[8], const u32x4 xv, const f32x4 w0, const f32x4 w1) {
    a[0] += bf_lo(xv.x) * w0.x; a[1] += bf_hi(xv.x) * w0.y; a[2] += bf_lo(xv.y) * w0.z; a[3] += bf_hi(xv.y) * w0.w;
    a[4] += bf_lo(xv.z) * w1.x; a[5] += bf_hi(xv.z) * w1.y; a[6] += bf_lo(xv.w) * w1.z; a[7] += bf_hi(xv.w) * w1.w;
}
__device__ __forceinline__ void phaseB_conv_item(Ctx& c, int l, int grp) {
    const bf16* uglu = WSP(bf16, WS_UGLU); bf16* u2 = WSP(bf16, WS_U2);
    const float* cw = c.in[4] + (size_t)l * CW * DC; const float* cb = c.in[5] + l * DC; const float* lg = c.in[6] + l * DC; const float* lb = c.in[7] + l * DC;
    const int tok0 = grp * 4, b = tok0 / L, pos0 = tok0 - b * L, ch = c.lane * 8;
    float acc[4][8];
    { const f32x4 b0 = *(const f32x4*)(cb + ch), b1 = *(const f32x4*)(cb + ch + 4);
#pragma unroll
      for (int d = 0; d < 4; ++d) { acc[d][0] = b0.x; acc[d][1] = b0.y; acc[d][2] = b0.z; acc[d][3] = b0.w; acc[d][4] = b1.x; acc[d][5] = b1.y; acc[d][6] = b1.z; acc[d][7] = b1.w; } }
    const int base = pos0 - 30;
    u32x4 x0 = conv_row(uglu, b, base + 0, ch), x1 = conv_row(uglu, b, base + 1, ch), x2 = conv_row(uglu, b, base + 2, ch),
          x3 = conv_row(uglu, b, base + 3, ch), x4 = conv_row(uglu, b, base + 4, ch), x5;
    const float* wp = cw + ch;
#pragma unroll 1
    for (int w = 0; w < CW; ++w) {
        x5 = conv_row(uglu, b, (w + 5 <= 33) ? base + w + 5 : -1, ch);
        const f32x4 w0 = *(const f32x4*)wp, w1 = *(const f32x4*)(wp + 4); wp += DC;
        conv_fma(acc[0], x0, w0, w1); conv_fma(acc[1], x1, w0, w1); conv_fma(acc[2], x2, w0, w1); conv_fma(acc[3], x3, w0, w1);
        x0 = x1; x1 = x2; x2 = x3; x3 = x4; x4 = x5;
    }
    const f32x4 g0 = *(const f32x4*)(lg + ch), g1 = *(const f32x4*)(lg + ch + 4), e0 = *(const f32x4*)(lb + ch), e1 = *(const f32x4*)(lb + ch + 4);
    const float gg[8] = {g0.x, g0.y, g0.z, g0.w, g1.x, g1.y, g1.z, g1.w}, be[8] = {e0.x, e0.y, e0.z, e0.w, e1.x, e1.y, e1.z, e1.w};
#pragma unroll
    for (int d = 0; d < 4; ++d) {
        float s = 0.f;
#pragma unroll
        for (int j = 0; j < 8; ++j) s += acc[d][j];
        const float mu = wave_sum(s) * (1.0f / 512.0f);
        float vq = 0.f;
#pragma unroll
        for (int j = 0; j < 8; ++j) { acc[d][j] -= mu; vq += acc[d][j] * acc[d][j]; }
        const float rstd = rsqrt_(wave_sum(vq) * (1.0f / 512.0f) + EPS);
        float y[8];
#pragma unroll
        for (int j = 0; j < 8; ++j) { const float v = acc[d][j] * rstd * gg[j] + be[j]; y[j] = v * sigmoidf_(v); }
        u32x4 o; o.x = pk2(y[0], y[1]); o.y = pk2(y[2], y[3]); o.z = pk2(y[4], y[5]); o.w = pk2(y[6], y[7]);
        *(u32x4*)(u2 + (size_t)(tok0 + d) * DC + ch) = o;
    }
}
__device__ __forceinline__ void phase_B(const Ctx& c0, int l) {
    Ctx c = reopaque(c0);
    constexpr int NQ = MT * NH, NKV = MT * NH, NCV = T / 16;
    for (int it = c.vb; it < NQ + NKV + NCV; it += c.G) {
        if (it < NQ) phaseB_q_item(c, l, it / NH, it % NH);
        else if (it < NQ + NKV) phaseB_kv_item(c, l, (it - NQ) / NH, (it - NQ) % NH);
        else phaseB_conv_item(c, l, (it - NQ - NKV) * 4 + c.wave);
    }
}

constexpr int KROW = 208, VROW = 136, ATT_STAGE = 64 * KROW + 64 * VROW;
constexpr int ATT_ITEMS = NB * NH * 17;
__device__ __forceinline__ void phase_C(const Ctx& c0, int l) {
    Ctx c = reopaque(c0);
    const bf16* Qb = WSP(bf16, WS_Q); const bf16* Kb = WSP(bf16, WS_K); const bf16* Vt = WSP(bf16, WS_VT); bf16* O = WSP(bf16, WS_O);
    unsigned* qctr = WSP(unsigned, WS_CTL) + CW_QUEUE + 64 * l;
    volatile unsigned* misc = (volatile unsigned*)(c.lds + LDS_MISC);
    const int tid = c.tid, wave = c.wave, lane = c.lane, r = lane & 15, q = lane >> 4;
    unsigned char* lds = c.lds;
    for (;;) {
        if (tid == 0) misc[4] = atomicAdd(qctr, 1u);
        __syncthreads();
        const int item = __builtin_amdgcn_readfirstlane((int)misc[4]);
        __syncthreads();
        if (item >= ATT_ITEMS) break;
        const int pp = 15 - item / 64, bh = item % 64, b = bh / NH, h = bh % NH;
        const bool meta = pp < 0;
        const int r0 = meta ? 0 : 16 + 128 * pp;
        const int nfull = meta ? 0 : 2 * pp + 1 + (wave >> 1);
        const int ntiles = meta ? 1 : 2 * pp + 3;
        const bf16* Kbase = Kb + (size_t)bh * L * QK; const bf16* Vbase = Vt + (size_t)bh * VD * L;
        bf16x8 qf[2][3];
#pragma unroll
        for (int mi = 0; mi < 2; ++mi)
#pragma unroll
            for (int ks = 0; ks < 3; ++ks) qf[mi][ks] = *(const bf16x8*)(Qb + ((size_t)bh * L + r0 + 32 * wave + 16 * mi + r) * QK + 32 * ks + 8 * q);
        float m[2] = {-1e30f, -1e30f}, lsum[2] = {0.f, 0.f};
        f32x4 o[2][4];
#pragma unroll
        for (int mi = 0; mi < 2; ++mi)
#pragma unroll
            for (int dt = 0; dt < 4; ++dt) o[mi][dt] = (f32x4){0.f, 0.f, 0.f, 0.f};
        u32x4 rk[3], rv[2];
        auto gload = [&](int kt) {
#pragma unroll
            for (int i = 0; i < 3; ++i) { const int id = tid + 256 * i, row = id / 12, cc = id % 12; rk[i] = *(const u32x4*)(Kbase + (size_t)(kt * 64 + row) * QK + cc * 8); }
#pragma unroll
            for (int i = 0; i < 2; ++i) { const int id = tid + 256 * i, row = id >> 3, cc = id & 7; rv[i] = *(const u32x4*)(Vbase + (size_t)row * L + kt * 64 + cc * 8); }
        };
        auto lstore = [&](int s) {
            unsigned char* st = lds + s * ATT_STAGE;
#pragma unroll
            for (int i = 0; i < 3; ++i) { const int id = tid + 256 * i, row = id / 12, cc = id % 12; *(u32x4*)(st + row * KROW + cc * 16) = rk[i]; }
#pragma unroll
            for (int i = 0; i < 2; ++i) { const int id = tid + 256 * i, row = id >> 3, cc = id & 7; u32x2* d = (u32x2*)(st + 64 * KROW + row * VROW + cc * 16); d[0] = (u32x2){rv[i].x, rv[i].y}; d[1] = (u32x2){rv[i].z, rv[i].w}; }
        };
        gload(0); lstore(0);
#pragma unroll
        for (int mi = 0; mi < 2; ++mi)
#pragma unroll
            for (int ks = 0; ks < 3; ++ks) asm volatile("" : "+v"(qf[mi][ks]));
        __syncthreads();
        for (int kt = 0; kt < ntiles; ++kt) {
            const int cur = kt & 1;
            if (kt + 1 < ntiles) gload(kt + 1);
            const unsigned char* sK = lds + cur * ATT_STAGE; const unsigned char* sV = sK + 64 * KROW;
            const bool full = kt < nfull;
            if (kt <= nfull) {
                f32x4 s[2][4];
#pragma unroll
                for (int kh = 0; kh < 2; ++kh) {
                    bf16x8 kf[2][3];
#pragma unroll
                    for (int kk = 0; kk < 2; ++kk) if ((kh == 0 && kk == 0) || full) {
#pragma unroll
                        for (int ks = 0; ks < 3; ++ks) kf[kk][ks] = *(const bf16x8*)(sK + (16 * (2 * kh + kk) + r) * KROW + 64 * ks + 16 * q); }
#pragma unroll
                    for (int kk = 0; kk < 2; ++kk) { const int k4 = 2 * kh + kk;
#pragma unroll
                        for (int mi = 0; mi < 2; ++mi) s[mi][k4] = (f32x4){0.f, 0.f, 0.f, 0.f};
                        if (k4 == 0 || full) {
#pragma unroll
                            for (int ks = 0; ks < 3; ++ks)
#pragma unroll
                                for (int mi = 0; mi < 2; ++mi) s[mi][k4] = __builtin_amdgcn_mfma_f32_16x16x32_bf16(kf[kk][ks], qf[mi][ks], s[mi][k4], 0, 0, 0);
                        }
                    }
                }
                u32x2 vlo[4], vhi[4];
#pragma unroll
                for (int dt = 0; dt < 4; ++dt) { const unsigned char* vp = sV + (16 * dt + r) * VROW + (4 * q) * 2;
                    vlo[dt] = *(const u32x2*)vp; vhi[dt] = (u32x2){0u, 0u}; if (full) vhi[dt] = *(const u32x2*)(vp + 32); }
                bf16x8 pf[2][2];
#pragma unroll
                for (int mi = 0; mi < 2; ++mi) {
                    float mx = fmaxf(fmaxf(s[mi][0].x, s[mi][0].y), fmaxf(s[mi][0].z, s[mi][0].w));
                    if (full) {
#pragma unroll
                        for (int k4 = 1; k4 < 4; ++k4) mx = fmaxf(mx, fmaxf(fmaxf(s[mi][k4].x, s[mi][k4].y), fmaxf(s[mi][k4].z, s[mi][k4].w)));
                    }
                    mx = quad_max(mx);
                    const float mn = fmaxf(m[mi], mx), alpha = fast_exp2(m[mi] - mn); m[mi] = mn;
                    float ps = 0.f;
#pragma unroll
                    for (int k4 = 0; k4 < 4; ++k4) {
                        if (k4 == 0 || full) { f32x4 p; p.x = fast_exp2(s[mi][k4].x - mn); p.y = fast_exp2(s[mi][k4].y - mn); p.z = fast_exp2(s[mi][k4].z - mn); p.w = fast_exp2(s[mi][k4].w - mn);
                            ps += (p.x + p.y) + (p.z + p.w); s[mi][k4] = p; }
                    }
                    lsum[mi] = lsum[mi] * alpha + ps;
#pragma unroll
                    for (int dt = 0; dt < 4; ++dt) o[mi][dt] = o[mi][dt] * alpha;
#pragma unroll
                    for (int st = 0; st < 2; ++st) { u32x4 pw;
                        pw.x = pk2(s[mi][2 * st].x, s[mi][2 * st].y); pw.y = pk2(s[mi][2 * st].z, s[mi][2 * st].w); pw.z = pk2(s[mi][2 * st + 1].x, s[mi][2 * st + 1].y); pw.w = pk2(s[mi][2 * st + 1].z, s[mi][2 * st + 1].w);
                        if (!full) { pw.z = 0u; pw.w = 0u; }
                        pf[mi][st] = __builtin_bit_cast(bf16x8, pw); }
                }
                u32x2 wlo[4], whi[4];
                if (full) {
#pragma unroll
                    for (int dt = 0; dt < 4; ++dt) { const unsigned char* vp = sV + (16 * dt + r) * VROW + (32 + 4 * q) * 2; wlo[dt] = *(const u32x2*)vp; whi[dt] = *(const u32x2*)(vp + 32); } }
#pragma unroll
                for (int dt = 0; dt < 4; ++dt) { const bf16x8 vf = __builtin_bit_cast(bf16x8, (u32x4){vlo[dt].x, vlo[dt].y, vhi[dt].x, vhi[dt].y});
#pragma unroll
                    for (int mi = 0; mi < 2; ++mi) o[mi][dt] = __builtin_amdgcn_mfma_f32_16x16x32_bf16(vf, pf[mi][0], o[mi][dt], 0, 0, 0); }
                if (full) {
#pragma unroll
                    for (int dt = 0; dt < 4; ++dt) { const bf16x8 vf = __builtin_bit_cast(bf16x8, (u32x4){wlo[dt].x, wlo[dt].y, whi[dt].x, whi[dt].y});
#pragma unroll
                        for (int mi = 0; mi < 2; ++mi) o[mi][dt] = __builtin_amdgcn_mfma_f32_16x16x32_bf16(vf, pf[mi][1], o[mi][dt], 0, 0, 0); } }
            }
            if (kt + 1 < ntiles) lstore(cur ^ 1);
            __syncthreads();
        }
#pragma unroll
        for (int mi = 0; mi < 2; ++mi) {
            const float lt = quad_sum(lsum[mi]);
            if (!meta || (wave == 0 && mi == 0)) {
                const float inv = 1.0f / lt;
                bf16* dst = O + ((size_t)b * L + r0 + 32 * wave + 16 * mi + r) * 512 + h * VD;
#pragma unroll
                for (int dt = 0; dt < 4; ++dt) { const f32x4 v = o[mi][dt] * inv; u32x2 ov; ov.x = pk2(v.x, v.y); ov.y = pk2(v.z, v.w); *(u32x2*)(dst + 16 * dt + 4 * q) = ov; }
            }
        }
    }
}

__device__ __forceinline__ int tile_tok0(int mt, int l) { return l == 1 ? mt * 128 + NMETA * ((mt >> 4) + 1) : mt * 128; }
__device__ __forceinline__ int n_mtiles(int l) { return l == 1 ? 128 : MT; }
__device__ __forceinline__ void phase_D(const Ctx& c0, int l) {
    Ctx c = reopaque(c0);
    const bf16* u2 = WSP(bf16, WS_U2); const bf16* O = WSP(bf16, WS_O); const bf16* gates = WSP(bf16, WS_GATES); bf16* merged = WSP(bf16, WS_MERGED);
    const bf16* Wco = (const bf16*)(c.ws + WS_WIN + l * SZ_WLAYER + OFF_WCO); const bf16* Wmla = (const bf16*)(c.ws + WS_WIN + l * SZ_WLAYER + OFF_WMLA);
    const int r = c.lane & 15, q = c.lane >> 4;
    for (int it = c.vb; it < n_mtiles(l) * 8; it += c.G) {
        const int mt = it / 8, nt = it % 8, tk0 = tile_tok0(mt, l);
        f32x4 acc[2][8]; acc_zero(acc);
        gemm_core(acc, u2 + (size_t)tk0 * 512, 512, Wco + (size_t)nt * 128 * 512, 512, 512, c.lds, c.tid);
#pragma unroll
        for (int mi = 0; mi < 2; ++mi) { const int tok = tk0 + 32 * c.wave + 16 * mi + r;
            const bf16* gp = gates + (size_t)tok * 2048 + nt * 128 + 4 * q; bf16* mp = merged + (size_t)tok * D + nt * 128 + 4 * q;
#pragma unroll
            for (int ni = 0; ni < 8; ++ni) { const u32x2 g = *(const u32x2*)(gp + 16 * ni); const f32x4 v = acc[mi][ni];
                u32x2 o; o.x = pk2(v.x * bf_lo(g.x), v.y * bf_hi(g.x)); o.y = pk2(v.z * bf_lo(g.y), v.w * bf_hi(g.y)); *(u32x2*)(mp + 16 * ni) = o; } }
        acc_zero(acc);
        gemm_core(acc, O + (size_t)tk0 * 512, 512, Wmla + (size_t)nt * 128 * 512, 512, 512, c.lds, c.tid);
#pragma unroll
        for (int mi = 0; mi < 2; ++mi) { const int tok = tk0 + 32 * c.wave + 16 * mi + r;
            const bf16* gp = gates + (size_t)tok * 2048 + 1024 + nt * 128 + 4 * q; bf16* mp = merged + (size_t)tok * D + nt * 128 + 4 * q;
#pragma unroll
            for (int ni = 0; ni < 8; ++ni) { const u32x2 g = *(const u32x2*)(gp + 16 * ni); const u32x2 s = *(const u32x2*)(mp + 16 * ni); const f32x4 v = acc[mi][ni];
                u32x2 o; o.x = pk2(bf_lo(s.x) + v.x * bf_lo(g.x), bf_hi(s.x) + v.y * bf_hi(g.x)); o.y = pk2(bf_lo(s.y) + v.z * bf_lo(g.y), bf_hi(s.y) + v.w * bf_hi(g.y));
                *(u32x2*)(mp + 16 * ni) = o; } }
    }
}

__device__ __forceinline__ void phase_E(const Ctx& c0, int l) {
    Ctx c = reopaque(c0);
    const bf16* merged = WSP(bf16, WS_MERGED); const bf16* Wout = (const bf16*)(c.ws + WS_WIN + l * SZ_WLAYER + OFF_WOUT);
    float* h = WSP(float, WS_H); bf16* hb = WSP(bf16, WS_HB); float* ssq = WSP(float, WS_SSQ);
    const int r = c.lane & 15, q = c.lane >> 4;
    for (int it = c.vb; it < n_mtiles(l) * 8; it += c.G) {
        const int mt = it / 8, nt = it % 8, tk0 = tile_tok0(mt, l);
        f32x4 acc[2][8];
#pragma unroll
        for (int mi = 0; mi < 2; ++mi) { const int tok = tk0 + 32 * c.wave + 16 * mi + r; const float* hp = h + (size_t)tok * D;
            if (l == 0) { const int b = tok / L, pos = tok - b * L; hp = pos < NMETA ? c.in[1] + (size_t)pos * D : c.in[0] + ((size_t)b * SEQ + (pos - NMETA)) * D; }
            hp += nt * 128 + 4 * q;
#pragma unroll
            for (int ni = 0; ni < 8; ++ni) acc[mi][ni] = *(const f32x4*)(hp + 16 * ni); }
        gemm_core(acc, merged + (size_t)tk0 * D, D, Wout + (size_t)nt * 128 * D, D, D, c.lds, c.tid);
#pragma unroll
        for (int mi = 0; mi < 2; ++mi) { const int tok = tk0 + 32 * c.wave + 16 * mi + r; float ss = 0.f;
#pragma unroll
            for (int ni = 0; ni < 8; ++ni) { float* hp = h + (size_t)tok * D + nt * 128 + 16 * ni + 4 * q; const f32x4 v = acc[mi][ni]; *(f32x4*)hp = v;
                ss += (v.x * v.x + v.y * v.y) + (v.z * v.z + v.w * v.w);
                u32x2 o; o.x = pk2(v.x, v.y); o.y = pk2(v.z, v.w); *(u32x2*)(hb + (size_t)tok * D + nt * 128 + 16 * ni + 4 * q) = o; }
            ss = quad_sum(ss);
            if (q == 0) ssq[(size_t)tok * 8 + nt] = ss; }
    }
}

__device__ __forceinline__ unsigned f2key(float f) { const unsigned u = __float_as_uint(f); return u ^ ((u >> 31) ? 0xFFFFFFFFu : 0x80000000u); }
__device__ __forceinline__ float key2f(unsigned k) { const unsigned u = (k >> 31) ? (k ^ 0x80000000u) : ~k; return __uint_as_float(u); }
__device__ __forceinline__ void top16_insert(unsigned (&lst)[16], unsigned x) {
#pragma unroll
    for (int i = 0; i < 16; ++i) { const unsigned a = lst[i]; lst[i] = a > x ? a : x; x = a > x ? x : a; }
}
__device__ __forceinline__ void ce_desc(unsigned& a, unsigned& b) { const unsigned mx = a > b ? a : b, mn = a > b ? b : a; a = mx; b = mn; }
__device__ __forceinline__ void sort16_desc(unsigned (&v)[16]) {
#pragma unroll
    for (int k = 2; k <= 16; k <<= 1)
#pragma unroll
        for (int j = k >> 1; j > 0; j >>= 1)
#pragma unroll
            for (int i = 0; i < 16; ++i) { const int p = i ^ j; if (p > i) { if ((i & k) == 0) ce_desc(v[i], v[p]); else ce_desc(v[p], v[i]); } }
}
__device__ __forceinline__ void merge_top16(unsigned (&a)[16], const unsigned (&b)[16]) {
#pragma unroll
    for (int i = 0; i < 16; ++i) a[i] = a[i] > b[15 - i] ? a[i] : b[15 - i];
#pragma unroll
    for (int j = 8; j > 0; j >>= 1)
#pragma unroll
        for (int i = 0; i < 16; ++i) { const int p = i ^ j; if (p > i) ce_desc(a[i], a[p]); }
}
__device__ __forceinline__ void phase_F(const Ctx& c0, int l) {
    Ctx c = reopaque(c0);
    const bf16* hb = WSP(bf16, WS_HB); const bf16* Wpq = (const bf16*)(c.ws + WS_WIN + l * SZ_WLAYER + OFF_WPQ); const bf16* keys = (const bf16*)(c.ws + WS_WIN + l * SZ_WLAYER + OFF_KEYS);
    const float* ssq = WSP(float, WS_SSQ); float* sv = WSP(float, WS_SV); unsigned char* si = WSP(unsigned char, WS_SI);
    const int tid = c.tid, wave = c.wave, lane = c.lane, r = lane & 15, q = lane >> 4;
    unsigned char* lds = c.lds;
    const int xcd = c.vb / (c.G / 8), lb = c.vb % (c.G / 8), xm = xcd & 1, xn = xcd >> 1, nmt = n_mtiles(l);
    const int m_lo = xm ? (nmt + 1) / 2 : 0, m_cnt = xm ? nmt / 2 : (nmt + 1) / 2;
    for (int j = lb; j < m_cnt * 4; j += c.G / 8) {
        const int mt = m_lo + j / 4, hp = xn * 4 + j % 4, tk0 = tile_tok0(mt, l);
        f32x4 acc[2][8]; acc_zero(acc);
        u32x4 kreg[2][4]; float rsv[2];
        { const int chunk = tid & 7, row0 = tid >> 3; const bf16* pb = keys + ((size_t)hp * 128 + row0) * 128 + chunk * 8;
#pragma unroll
          for (int s = 0; s < 2; ++s)
#pragma unroll
              for (int i = 0; i < 4; ++i) kreg[s][i] = *(const u32x4*)(pb + (size_t)(32 * i) * 128 + s * 64); }
#pragma unroll
        for (int mi = 0; mi < 2; ++mi) rsv[mi] = rstd_from_ssq8(ssq, tk0 + 32 * wave + 16 * mi + r);
        gemm_core(acc, hb + (size_t)tk0 * D, D, Wpq + (size_t)hp * 128 * D, D, D, lds, tid);
#pragma unroll
        for (int mi = 0; mi < 2; ++mi) { const int row = 32 * wave + 16 * mi + r; const float rs = rsv[mi];
#pragma unroll
            for (int ni = 0; ni < 8; ++ni) { const f32x4 v = acc[mi][ni] * rs; u32x2 o; o.x = pk2(v.x, v.y); o.y = pk2(v.z, v.w);
                *(u32x2*)(lds + (ni >> 2) * 32768 + lds_off(row, 2 * (ni & 3) + (q >> 1)) + 8 * (q & 1)) = o; } }
        { const int chunk = tid & 7, row0 = tid >> 3;
#pragma unroll
          for (int s = 0; s < 2; ++s)
#pragma unroll
              for (int i = 0; i < 4; ++i) *(u32x4*)(lds + s * 32768 + 16384 + lds_off(row0 + 32 * i, chunk)) = kreg[s][i]; }
        __syncthreads();
        acc_zero(acc);
        gemm_compute_stage(acc, lds, lds + 16384, wave, lane);
        gemm_compute_stage(acc, lds + 32768, lds + 32768 + 16384, wave, lane);
        __syncthreads();
        float* S = (float*)lds;
#pragma unroll
        for (int mi = 0; mi < 2; ++mi) { const int row = 32 * wave + 16 * mi + r;
#pragma unroll
            for (int ni = 0; ni < 8; ++ni) *(f32x4*)(S + row * 132 + 16 * ni + 4 * q) = acc[mi][ni]; }
        __syncthreads();
        {
            const int tl = 32 * wave + (lane & 31), half = lane >> 5;
            const float* row = S + tl * 132;
            unsigned lst[16];
#pragma unroll
            for (int g = 0; g < 4; ++g) {
                unsigned cur[16];
#pragma unroll
                for (int j = 0; j < 4; ++j) { const int col = 64 * half + 16 * g + 4 * j; const f32x4 v = *(const f32x4*)(row + col);
                    cur[4 * j] = (f2key(v.x) & ~127u) | (unsigned)(127 - col); cur[4 * j + 1] = (f2key(v.y) & ~127u) | (unsigned)(127 - (col + 1));
                    cur[4 * j + 2] = (f2key(v.z) & ~127u) | (unsigned)(127 - (col + 2)); cur[4 * j + 3] = (f2key(v.w) & ~127u) | (unsigned)(127 - (col + 3)); }
                sort16_desc(cur);
                if (g == 0) {
#pragma unroll
                    for (int i = 0; i < 16; ++i) lst[i] = cur[i];
                } else merge_top16(lst, cur);
            }
            unsigned oth[16];
#pragma unroll
            for (int i = 0; i < 16; ++i) { auto rr = __builtin_amdgcn_permlane32_swap(lst[i], lst[i], false, false); oth[i] = half == 0 ? rr[1] : rr[0]; }
            merge_top16(lst, oth);
            if (half == 0) {
                const int tok = tk0 + tl;
                unsigned idx[16]; float val[16];
#pragma unroll
                for (int i = 0; i < 16; ++i) { idx[i] = 127u - (lst[i] & 127u); val[i] = row[idx[i]]; }
                float* svp = sv + ((size_t)tok * 16 + hp) * 16;
#pragma unroll
                for (int i = 0; i < 4; ++i) *(f32x4*)(svp + 4 * i) = (f32x4){val[4 * i], val[4 * i + 1], val[4 * i + 2], val[4 * i + 3]};
                u32x4 pi;
                pi.x = idx[0] | (idx[1] << 8) | (idx[2] << 16) | (idx[3] << 24); pi.y = idx[4] | (idx[5] << 8) | (idx[6] << 16) | (idx[7] << 24);
                pi.z = idx[8] | (idx[9] << 8) | (idx[10] << 16) | (idx[11] << 24); pi.w = idx[12] | (idx[13] << 8) | (idx[14] << 16) | (idx[15] << 24);
                *(u32x4*)(si + ((size_t)tok * 16 + hp) * 16) = pi;
            }
        }
        __syncthreads();
    }
}

__device__ __forceinline__ void phase_F3(const Ctx& c0, int l) {
    Ctx c = reopaque(c0);
    const float* sv = WSP(float, WS_SV); const unsigned char* si = WSP(unsigned char, WS_SI); int* eidx = WSP(int, WS_EIDX); float* gw = WSP(float, WS_GW); unsigned char* stb = WSP(unsigned char, WS_STB);
    float* lsv = (float*)c.lds;
    unsigned char* lsi = c.lds + 256 * 33 * 4;
    const int tid = c.tid;
    const int ntok = l == 1 ? NB * SEQ : T;
    for (int base = c.vb * NTHREADS; base < ntok * 8; base += c.G * NTHREADS) {
        const int thc = base + tid, tkc = thc >> 3;
        const int th = (l == 1 ? tkc + NMETA * ((tkc >> 11) + 1) : tkc) * 8 + (thc & 7);
        float a[16], b[16];
#pragma unroll
        for (int i = 0; i < 4; ++i) { const f32x4 x = *(const f32x4*)(sv + (size_t)th * 32 + 4 * i), y = *(const f32x4*)(sv + (size_t)th * 32 + 16 + 4 * i);
            a[4 * i] = x.x; a[4 * i + 1] = x.y; a[4 * i + 2] = x.z; a[4 * i + 3] = x.w; b[4 * i] = y.x; b[4 * i + 1] = y.y; b[4 * i + 2] = y.z; b[4 * i + 3] = y.w; }
        const u32x4 ia = *(const u32x4*)(si + (size_t)th * 32), ib = *(const u32x4*)(si + (size_t)th * 32 + 16);
#pragma unroll
        for (int i = 0; i < 16; ++i) { lsv[tid * 33 + i] = a[i]; lsv[tid * 33 + 16 + i] = b[i]; }
        *(u32x4*)(lsi + tid * 32) = ia; *(u32x4*)(lsi + tid * 32 + 16) = ib;
        unsigned lst[16], g2[16], g3[16], g4[16];
#pragma unroll
        for (int j = 0; j < 16; ++j) lst[j] = (f2key(a[0] + b[j]) & ~255u) | (unsigned)(255 - j);
#pragma unroll
        for (int i = 1; i < 16; ++i) g2[i - 1] = (f2key(a[i] + b[0]) & ~255u) | (unsigned)(255 - i * 16);
        g2[15] = 0u;
        { int n = 0;
#pragma unroll
          for (int i = 1; i < 16; ++i)
#pragma unroll
              for (int j = 1; j < 16; ++j)
                  if ((i + 1) * (j + 1) <= 16) { const unsigned key = (f2key(a[i] + b[j]) & ~255u) | (unsigned)(255 - (i * 16 + j)); if (n < 16) g3[n] = key; else g4[n - 16] = key; ++n; }
#pragma unroll
          for (int k = 3; k < 16; ++k) g4[k] = 0u; }
        sort16_desc(g3); sort16_desc(g4);
        merge_top16(lst, g2); merge_top16(g3, g4); merge_top16(lst, g3);
        __builtin_amdgcn_s_waitcnt(0xC07F); asm volatile("" ::: "memory");
        float s[16]; int e[16];
#pragma unroll
        for (int k = 0; k < 16; ++k) { const unsigned code = 255u - (lst[k] & 255u); const int i = code >> 4, j = code & 15;
            s[k] = lsv[tid * 33 + i] + lsv[tid * 33 + 16 + j]; e[k] = (int)lsi[tid * 32 + i] * 128 + (int)lsi[tid * 32 + 16 + j]; }
        float mx = s[0];
#pragma unroll
        for (int k = 1; k < 16; ++k) mx = fmaxf(mx, s[k]);
        float sum = 0.f;
#pragma unroll
        for (int k = 0; k < 16; ++k) { s[k] = fast_exp2((s[k] - mx) * 1.4426950409f); sum += s[k]; }
        const float inv = 1.0f / sum;
        typedef unsigned long long u64;
        u64 hlo = 0ull, hhi = 0ull;
#pragma unroll
        for (int k = 0; k < 16; ++k) { const int sl = e[k] >> 10; if (sl < 8) hlo += 1ull << (8 * sl); else hhi += 1ull << (8 * (sl - 8)); }
        u64 ilo = hlo, ihi = hhi;
#pragma unroll
        for (int d = 1; d < 8; d <<= 1) { const u64 a_ = __shfl_up(ilo, d, 8), b_ = __shfl_up(ihi, d, 8); if ((tid & 7) >= d) { ilo += a_; ihi += b_; } }
        const u64 tlo = __shfl(ilo, 7, 8), thi = __shfl(ihi, 7, 8);
        const u64 ones = 0x0101010101010101ull;
        const u64 inlo = tlo * ones, inhi = thi * ones + (inlo >> 56) * ones;
        const u64 stlo = inlo - tlo, sthi = inhi - thi;
        u64 rlo = stlo + (ilo - hlo), rhi = sthi + (ihi - hhi);
        const int tokn = th >> 3;
#pragma unroll
        for (int k = 0; k < 16; ++k) { const int sl = e[k] >> 10; int pos;
            if (sl < 8) { pos = (int)((rlo >> (8 * sl)) & 255ull); rlo += 1ull << (8 * sl); } else { pos = (int)((rhi >> (8 * (sl - 8))) & 255ull); rhi += 1ull << (8 * (sl - 8)); }
            eidx[(size_t)tokn * 128 + pos] = e[k]; gw[(size_t)tokn * 128 + pos] = s[k] * inv; }
        if ((tid & 7) == 0) { u64* sp = (u64*)(stb + (size_t)tokn * 16); sp[0] = stlo; sp[1] = sthi; }
        __builtin_amdgcn_s_waitcnt(0xC07F); asm volatile("" ::: "memory");
    }
}

typedef float f32x2 __attribute__((ext_vector_type(2)));
constexpr int G2_WSTRIDE = 14336, G2_MAXTOK = 9;
__device__ __forceinline__ float fp8dot4(unsigned w, unsigned x01, unsigned x23, float acc) {
    const bf16x2 lo = __builtin_amdgcn_cvt_scalef32_pk_bf16_fp8(w, 1.0f, false), hi = __builtin_amdgcn_cvt_scalef32_pk_bf16_fp8(w, 1.0f, true);
    acc = __builtin_amdgcn_fdot2_f32_bf16(lo, __builtin_bit_cast(bf16x2, x01), acc, false);
    return __builtin_amdgcn_fdot2_f32_bf16(hi, __builtin_bit_cast(bf16x2, x23), acc, false);
}
__device__ __forceinline__ float reduce8_transposed(const float (&p)[8], int lane) {
    float s[4];
#pragma unroll
    for (int k = 0; k < 4; ++k) { auto r = __builtin_amdgcn_permlane32_swap(__float_as_uint(p[k]), __float_as_uint(p[k + 4]), false, false); s[k] = __uint_as_float(r[0]) + __uint_as_float(r[1]); }
    float t[2];
#pragma unroll
    for (int k = 0; k < 2; ++k) { auto r = __builtin_amdgcn_permlane16_swap(__float_as_uint(s[k]), __float_as_uint(s[k + 2]), false, false); t[k] = __uint_as_float(r[0]) + __uint_as_float(r[1]); }
    const float u0 = t[0] + dpp<0x128>(t[0]), u1 = t[1] + dpp<0x128>(t[1]);
    float r = (lane & 8) ? u1 : u0;
    r += dpp<0xB1>(r); r += dpp<0x4E>(r); r += dpp<0x141>(r);
    return r;
}
typedef int i32x4 __attribute__((ext_vector_type(4)));
__device__ __forceinline__ void fp8fma4(f32x2 (&acc)[8], int o, unsigned w, f32x2 a2) {
    const f32x2 lo = __builtin_amdgcn_cvt_scalef32_pk_f32_fp8(w, 1.0f, false), hi = __builtin_amdgcn_cvt_scalef32_pk_f32_fp8(w, 1.0f, true);
    acc[o] = __builtin_elementwise_fma(a2, lo, acc[o]); acc[o + 1] = __builtin_elementwise_fma(a2, hi, acc[o + 1]);
}
__device__ __forceinline__ void g2_u_chunk(u32x4 (&u)[8], const unsigned char* U, const int* pe_next, const float* pw_c, float* act_c, const u32x4 xq, float rs, int lane) {
    const i32x4 e0 = *(const i32x4*)pe_next, e1 = *(const i32x4*)(pe_next + 4);
    const int en[8] = {e0.x, e0.y, e0.z, e0.w, e1.x, e1.y, e1.z, e1.w};
    float p[8];
#pragma unroll
    for (int k = 0; k < 8; k += 2) {
        int d0 = __builtin_amdgcn_sdot4((int)u[k].x, (int)xq.x, 0, false), d1 = __builtin_amdgcn_sdot4((int)u[k + 1].x, (int)xq.x, 0, false);
        d0 = __builtin_amdgcn_sdot4((int)u[k].y, (int)xq.y, d0, false); d1 = __builtin_amdgcn_sdot4((int)u[k + 1].y, (int)xq.y, d1, false);
        d0 = __builtin_amdgcn_sdot4((int)u[k].z, (int)xq.z, d0, false); d1 = __builtin_amdgcn_sdot4((int)u[k + 1].z, (int)xq.z, d1, false);
        d0 = __builtin_amdgcn_sdot4((int)u[k].w, (int)xq.w, d0, false); d1 = __builtin_amdgcn_sdot4((int)u[k + 1].w, (int)xq.w, d1, false);
        p[k] = (float)d0; p[k + 1] = (float)d1;
        asm volatile("" : "+v"(p[k]), "+v"(p[k + 1]));
        u[k] = *(const u32x4*)(U + (size_t)__builtin_amdgcn_readfirstlane(en[k]) * 1024 + lane * 16);
        u[k + 1] = *(const u32x4*)(U + (size_t)__builtin_amdgcn_readfirstlane(en[k + 1]) * 1024 + lane * 16);
    }
    const float a = reduce8_transposed(p, lane);
    const int row = (lane >> 3) & 7;
    if ((lane & 7) == 0) act_c[row] = gelu_tanh(a * rs) * pw_c[row];
}
__device__ __forceinline__ void g2_v_chunk(u32x4 (&v)[8], const unsigned char* V, const int* pe_next, const float* act_c, f32x2 (&acc)[8], int lane) {
    const i32x4 e0 = *(const i32x4*)pe_next, e1 = *(const i32x4*)(pe_next + 4);
    const int en[8] = {e0.x, e0.y, e0.z, e0.w, e1.x, e1.y, e1.z, e1.w};
    const f32x4 a0 = *(const f32x4*)act_c, a1 = *(const f32x4*)(act_c + 4);
    const float av[8] = {a0.x, a0.y, a0.z, a0.w, a1.x, a1.y, a1.z, a1.w};
#pragma unroll
    for (int k = 0; k < 8; k += 2) {
        const f32x2 a2 = (f32x2){av[k], av[k]}, b2 = (f32x2){av[k + 1], av[k + 1]};
        fp8fma4(acc, 0, v[k].x, a2); fp8fma4(acc, 2, v[k].y, a2); fp8fma4(acc, 4, v[k].z, a2); fp8fma4(acc, 6, v[k].w, a2);
        fp8fma4(acc, 0, v[k + 1].x, b2); fp8fma4(acc, 2, v[k + 1].y, b2); fp8fma4(acc, 4, v[k + 1].z, b2); fp8fma4(acc, 6, v[k + 1].w, b2);
        asm volatile("" : "+v"(acc[0]), "+v"(acc[1]), "+v"(acc[2]), "+v"(acc[3]), "+v"(acc[4]), "+v"(acc[5]), "+v"(acc[6]), "+v"(acc[7]));
        v[k] = *(const u32x4*)(V + (size_t)__builtin_amdgcn_readfirstlane(en[k]) * 1024 + lane * 16);
        v[k + 1] = *(const u32x4*)(V + (size_t)__builtin_amdgcn_readfirstlane(en[k + 1]) * 1024 + lane * 16);
    }
}
__device__ __forceinline__ void g2_finish_token(Ctx& c, int l, int tok, const f32x2 (&acc)[8], int lane) {
    float* h = WSP(float, WS_H); bf16* hbw = WSP(bf16, WS_HB); float* ssqw = WSP(float, WS_SSQ);
    float* hp = h + (size_t)tok * D + lane * 16;
    f32x4 r0 = *(const f32x4*)hp, r1 = *(const f32x4*)(hp + 4), r2 = *(const f32x4*)(hp + 8), r3 = *(const f32x4*)(hp + 12);
    r0 += (f32x4){acc[0].x, acc[0].y, acc[1].x, acc[1].y}; r1 += (f32x4){acc[2].x, acc[2].y, acc[3].x, acc[3].y};
    r2 += (f32x4){acc[4].x, acc[4].y, acc[5].x, acc[5].y}; r3 += (f32x4){acc[6].x, acc[6].y, acc[7].x, acc[7].y};
    if (l == 0) {
        *(f32x4*)hp = r0; *(f32x4*)(hp + 4) = r1; *(f32x4*)(hp + 8) = r2; *(f32x4*)(hp + 12) = r3;
        u32x4 o0, o1; o0.x = pk2(r0.x, r0.y); o0.y = pk2(r0.z, r0.w); o0.z = pk2(r1.x, r1.y); o0.w = pk2(r1.z, r1.w);
        o1.x = pk2(r2.x, r2.y); o1.y = pk2(r2.z, r2.w); o1.z = pk2(r3.x, r3.y); o1.w = pk2(r3.z, r3.w);
        *(u32x4*)(hbw + (size_t)tok * D + lane * 16) = o0; *(u32x4*)(hbw + (size_t)tok * D + lane * 16 + 8) = o1;
        float ss = (r0.x * r0.x + r0.y * r0.y) + (r0.z * r0.z + r0.w * r0.w) + (r1.x * r1.x + r1.y * r1.y) + (r1.z * r1.z + r1.w * r1.w)
                 + (r2.x * r2.x + r2.y * r2.y) + (r2.z * r2.z + r2.w * r2.w) + (r3.x * r3.x + r3.y * r3.y) + (r3.z * r3.z + r3.w * r3.w);
        ss = wave_sum_dpp(ss);
        if (lane < 8) ssqw[(size_t)tok * 8 + lane] = lane == 0 ? ss : 0.f;
    } else {
        const int b = tok / L, pos = tok - b * L;
        if (pos >= NMETA) { float* op = c.out + ((size_t)b * SEQ + (pos - NMETA)) * D + lane * 16;
            *(f32x4*)op = r0; *(f32x4*)(op + 4) = r1; *(f32x4*)(op + 8) = r2; *(f32x4*)(op + 12) = r3; }
    }
}
__device__ __forceinline__ void phase_G2(const Ctx& c0, int l) {
    Ctx c = reopaque(c0);
    const bf16* hb = WSP(bf16, WS_HB); const float* ssq = WSP(float, WS_SSQ); const int* pe = WSP(int, WS_EIDX); const float* pw = WSP(float, WS_GW);
    const unsigned char* U = c.ws + WS_TAB + (size_t)(l * 2) * SZ_TAB; const unsigned char* V = c.ws + WS_TAB + (size_t)(l * 2 + 1) * SZ_TAB;
    const int lane = c.lane, wave = c.wave;
    const int gw = c.vb * 4 + wave, t0 = l == 1 ? gw * 8 + NMETA * ((gw >> 8) + 1) : gw * 8;
    const bool has_x = l == 0 && (c.vb & 3) == 0; const int tx = T - 128 + (c.vb >> 2);
    unsigned char* wl = c.lds + wave * G2_WSTRIDE;
    int* pe_l = (int*)wl; float* pw_l = (float*)(wl + 4608); float* act_l = (float*)(wl + 9216);
#pragma unroll
    for (int j = 0; j < G2_MAXTOK; ++j) { const int tok = j < 8 ? t0 + j : (has_x ? tx : t0);
        pe_l[j * 128 + lane] = pe[(size_t)tok * 128 + lane]; pe_l[j * 128 + 64 + lane] = pe[(size_t)tok * 128 + 64 + lane];
        pw_l[j * 128 + lane] = pw[(size_t)tok * 128 + lane] * TAB_INV; pw_l[j * 128 + 64 + lane] = pw[(size_t)tok * 128 + 64 + lane] * TAB_INV; }
    const int xlo = has_x ? 4 * wave : 16, xhi = has_x ? 4 * wave + 4 : 16;
    {
        u32x4 xq[G2_MAXTOK]; float rs[G2_MAXTOK];
#pragma unroll
        for (int j = 0; j < G2_MAXTOK; ++j) { const int tok = j < 8 ? t0 + j : (has_x ? tx : t0);
            const u32x4 lo = *(const u32x4*)(hb + (size_t)tok * D + lane * 16), hi = *(const u32x4*)(hb + (size_t)tok * D + lane * 16 + 8);
            const f32x4 f0 = (f32x4){bf_lo(lo.x), bf_hi(lo.x), bf_lo(lo.y), bf_hi(lo.y)}, f1 = (f32x4){bf_lo(lo.z), bf_hi(lo.z), bf_lo(lo.w), bf_hi(lo.w)};
            const f32x4 f2 = (f32x4){bf_lo(hi.x), bf_hi(hi.x), bf_lo(hi.y), bf_hi(hi.y)}, f3 = (f32x4){bf_lo(hi.z), bf_hi(hi.z), bf_lo(hi.w), bf_hi(hi.w)};
            float mx = 1e-20f;
#pragma unroll
            for (int i = 0; i < 4; ++i) mx = fmaxf(mx, fmaxf(fmaxf(fabsf(f0[i]), fabsf(f1[i])), fmaxf(fabsf(f2[i]), fabsf(f3[i]))));
            mx = fmaxf(mx, dpp<0xB1>(mx)); mx = fmaxf(mx, dpp<0x4E>(mx)); mx = fmaxf(mx, dpp<0x141>(mx)); mx = fmaxf(mx, dpp<0x128>(mx)); mx = xrow16_max(mx);
            const float sx = 127.0f / mx;
            xq[j].x = pack_i8x4(f0 * sx); xq[j].y = pack_i8x4(f1 * sx); xq[j].z = pack_i8x4(f2 * sx); xq[j].w = pack_i8x4(f3 * sx);
            rs[j] = rstd_from_ssq8(ssq, tok) * mx * (1.0f / (127.0f * U_SCALE)); }
        u32x4 u[8];
#pragma unroll
        for (int k = 0; k < 8; ++k) u[k] = *(const u32x4*)(U + (size_t)__builtin_amdgcn_readfirstlane(pe_l[k]) * 1024 + lane * 16);
#pragma unroll 1
        for (int ch = 0; ch < 16; ++ch) {
            const int cn = ch < 15 ? ch + 1 : 0;
            const bool x_here = ch >= xlo && ch < xhi;
#pragma unroll
            for (int j = 0; j < 8; ++j) {
                const int* pe_next = j < 7 ? pe_l + (j + 1) * 128 + ch * 8 : (x_here ? pe_l + 8 * 128 + ch * 8 : pe_l + cn * 8);
                g2_u_chunk(u, U, pe_next, pw_l + j * 128 + ch * 8, act_l + j * 128 + ch * 8, xq[j], rs[j], lane); }
            if (x_here) g2_u_chunk(u, U, pe_l + cn * 8, pw_l + 8 * 128 + ch * 8, act_l + 8 * 128 + ch * 8, xq[8], rs[8], lane);
        }
    }
    f32x2 acc[G2_MAXTOK][8];
#pragma unroll
    for (int j = 0; j < G2_MAXTOK; ++j)
#pragma unroll
        for (int i = 0; i < 8; ++i) acc[j][i] = (f32x2){0.f, 0.f};
    {
        u32x4 v[8];
#pragma unroll
        for (int k = 0; k < 8; ++k) v[k] = *(const u32x4*)(V + (size_t)__builtin_amdgcn_readfirstlane(pe_l[k]) * 1024 + lane * 16);
#pragma unroll 1
        for (int ch = 0; ch < 16; ++ch) {
            const int cn = ch < 15 ? ch + 1 : 0;
            const bool x_here = ch >= xlo && ch < xhi;
#pragma unroll
            for (int j = 0; j < 8; ++j) {
                const int* pe_next = j < 7 ? pe_l + (j + 1) * 128 + ch * 8 : (x_here ? pe_l + 8 * 128 + ch * 8 : pe_l + cn * 8);
                g2_v_chunk(v, V, pe_next, act_l + j * 128 + ch * 8, acc[j], lane); }
            if (x_here) g2_v_chunk(v, V, pe_l + cn * 8, act_l + 8 * 128 + ch * 8, acc[8], lane);
        }
    }
#pragma unroll
    for (int j = 0; j < 8; ++j) g2_finish_token(c, l, t0 + j, acc[j], lane);
    __syncthreads();
    if (has_x) {
        f32x2* part = (f32x2*)(c.lds + wave * G2_WSTRIDE);
#pragma unroll
        for (int i = 0; i < 8; ++i) part[i * 64 + lane] = acc[8][i];
    }
    __syncthreads();
    if (has_x && wave == 0) {
        f32x2 tot[8];
#pragma unroll
        for (int i = 0; i < 8; ++i) { tot[i] = acc[8][i];
#pragma unroll
            for (int w = 1; w < 4; ++w) tot[i] += ((const f32x2*)(c.lds + w * G2_WSTRIDE))[i * 64 + lane]; }
        g2_finish_token(c, l, tx, tot, lane);
    }
    __syncthreads();
}

struct Args { const float* in[22]; float* out; unsigned char* ws; int ph_lo, ph_hi; };
constexpr int N_PHASES = 17;

__global__ void __launch_bounds__(NTHREADS, 2) fwd_kernel(Args args) {
    extern __shared__ __attribute__((aligned(16))) unsigned char lds_raw[];
    Ctx c;
#pragma unroll
    for (int i = 0; i < 22; ++i) c.in[i] = args.in[i];
    c.out = args.out; c.ws = args.ws; c.lds = lds_raw;
    c.tid = threadIdx.x; c.lane = c.tid & 63; c.wave = __builtin_amdgcn_readfirstlane(c.tid >> 6);
    c.G = gridDim.x; { const int bx = blockIdx.x; c.vb = (c.G % 8 == 0) ? (bx % 8) * (c.G / 8) + bx / 8 : bx; }
    volatile unsigned* misc = (volatile unsigned*)(c.lds + LDS_MISC);
    if (c.tid < 16) misc[c.tid] = 0u;
    __syncthreads();
    const int lo = args.ph_lo, hi = args.ph_hi;
    const bool multi = (hi - lo) > 1;
    XcdBarrier bar; bar.bar = WSP(unsigned, WS_CTL) + CW_BAR; bar.x = 0; bar.st = misc;
    if (multi) bar = xcd_barrier_post(WSP(unsigned, WS_CTL) + CW_BAR, misc);
#define IN_(k) (lo <= (k) && (k) < hi)
#define SEAM_(k) do { if ((k) + 1 < hi) xcd_barrier(bar); } while (0)
    if (IN_(0)) { phase_prologue(c); SEAM_(0); }
#pragma unroll 1
    for (int l = 0; l < 2; ++l) {
        const int p0 = 1 + 8 * l;
        if (IN_(p0 + 0)) { phase_A(c, l); SEAM_(p0 + 0); }
        if (IN_(p0 + 1)) { phase_B(c, l); SEAM_(p0 + 1); }
        if (IN_(p0 + 2)) { phase_C(c, l); SEAM_(p0 + 2); }
        if (IN_(p0 + 3)) { phase_D(c, l); SEAM_(p0 + 3); }
        if (IN_(p0 + 4)) { phase_E(c, l); SEAM_(p0 + 4); }
        if (IN_(p0 + 5)) { phase_F(c, l); SEAM_(p0 + 5); }
        if (IN_(p0 + 6)) { phase_F3(c, l); SEAM_(p0 + 6); }
        if (IN_(p0 + 7)) { phase_G2(c, l); SEAM_(p0 + 7); }
    }
}

extern "C" void kernel_launch(void* const* d_in, const int* in_sizes, int n_in, void* d_out, int out_size, void* d_ws, size_t ws_size, hipStream_t stream) {
    static int grid = 0;
    if (grid == 0) {
        if (n_in != 22 || out_size != NB * SEQ * D || ws_size < WS_END) { fprintf(stderr, "kernel_launch: unexpected shapes (n_in %d out %d ws %zu need %zu)\n", n_in, out_size, ws_size, (size_t)WS_END); grid = -1; return; }
        int dev = 0, cus = 0, per_cu = 0;
        hipGetDevice(&dev); hipDeviceGetAttribute(&cus, hipDeviceAttributeMultiprocessorCount, dev);
        if (hipFuncSetAttribute((const void*)fwd_kernel, hipFuncAttributeMaxDynamicSharedMemorySize, LDS_BYTES) != hipSuccess) { fprintf(stderr, "kernel_launch: hipFuncSetAttribute failed\n"); grid = -1; return; }
        if (hipOccupancyMaxActiveBlocksPerMultiprocessor(&per_cu, (const void*)fwd_kernel, NTHREADS, LDS_BYTES) != hipSuccess || per_cu < 1) { fprintf(stderr, "kernel_launch: occupancy query failed (%d)\n", per_cu); per_cu = 1; (void)hipGetLastError(); }
        if (per_cu > 2) per_cu = 2;
        grid = cus * per_cu;
        if (grid != 512) { fprintf(stderr, "kernel_launch: grid %d unsupported by phase G2 (needs 512 workgroups)\n", grid); grid = -1; return; }
        fprintf(stderr, "kernel_launch: grid %d (%d per CU), lds %d, ws need %zu have %zu\n", grid, per_cu, LDS_BYTES, (size_t)WS_END, ws_size);
    }
    if (grid < 0) return;
    hipMemsetAsync((char*)d_ws + WS_CTL, 0, CTL_BYTES, stream);
    Args a{};
    for (int i = 0; i < 22; ++i) a.in[i] = (const float*)d_in[i];
    a.out = (float*)d_out; a.ws = (unsigned char*)d_ws;
#if MK_PER_PHASE
    for (int ph = 0; ph < N_PHASES; ++ph) { a.ph_lo = ph; a.ph_hi = ph + 1; hipLaunchKernelGGL(fwd_kernel, dim3(grid), dim3(NTHREADS), LDS_BYTES, stream, a); }
#else
    a.ph_lo = 0; a.ph_hi = N_PHASES;
    void* kargs[] = {&a};
    hipError_t e = hipLaunchCooperativeKernel((const void*)fwd_kernel, dim3(grid), dim3(NTHREADS), kargs, LDS_BYTES, stream);
    if (e != hipSuccess) fprintf(stderr, "kernel_launch: cooperative launch failed: %s (grid %d)\n", hipGetErrorString(e), grid);
#endif
}
```

```cpp
#include <hip/hip_runtime.h>
#include <cstdio>
#include <cstdint>

#ifndef MK_PER_PHASE
#define MK_PER_PHASE 0
#endif

typedef unsigned short bf16;
typedef short bf16x8 __attribute__((ext_vector_type(8)));
typedef float f32x4 __attribute__((ext_vector_type(4)));
typedef unsigned u32x4 __attribute__((ext_vector_type(4)));
typedef unsigned u32x2 __attribute__((ext_vector_type(2)));
typedef __bf16 bf16x2 __attribute__((ext_vector_type(2)));

constexpr int NB = 8, SEQ = 2048, NMETA = 16, L = SEQ + NMETA, T = NB * L, D = 1024;
constexpr int DC = 512, CW = 31, NH = 8, QL = 256, KVL = 128, NOPE = 64, ROPE = 32, QK = 96, VD = 64;
constexpr int NIN = 3488, NINP = 3584;
constexpr int NEXP = 16384;
constexpr float EPS = 1e-6f;
constexpr int MT = T / 128;
static_assert(T % 128 == 0, "T tiles");

constexpr size_t al256(size_t x) { return (x + 255) & ~(size_t)255; }
constexpr size_t WS_CTL = 0;
constexpr size_t CTL_BYTES = 65536;
constexpr size_t WS_ROPE = WS_CTL + CTL_BYTES;
constexpr size_t WS_WIN = al256(WS_ROPE + (size_t)L * 16 * 8);
constexpr size_t SZ_WIN = (size_t)NINP * 1024 * 2, SZ_WCO = (size_t)1024 * 512 * 2, SZ_WUQ = (size_t)1024 * 256 * 2, SZ_WUKV = (size_t)1024 * 128 * 2,
                 SZ_WMLA = (size_t)1024 * 512 * 2, SZ_WOUT = (size_t)1024 * 1024 * 2, SZ_WPQ = (size_t)2048 * 1024 * 2, SZ_KEYS = (size_t)16 * 128 * 128 * 2;
constexpr size_t OFF_WCO = SZ_WIN, OFF_WUQ = OFF_WCO + SZ_WCO, OFF_WUKV = OFF_WUQ + SZ_WUQ, OFF_WMLA = OFF_WUKV + SZ_WUKV, OFF_WOUT = OFF_WMLA + SZ_WMLA,
                 OFF_WPQ = OFF_WOUT + SZ_WOUT, OFF_KEYS = OFF_WPQ + SZ_WPQ, SZ_WLAYER = OFF_KEYS + SZ_KEYS;
constexpr size_t WS_TAB = al256(WS_WIN + 2 * SZ_WLAYER);
constexpr size_t SZ_TAB = (size_t)NEXP * 1024;
constexpr float TAB_SCALE = 64.0f, TAB_INV = 1.0f / 64.0f;
constexpr float U_CLIP = 0.2f, U_SCALE = 127.0f / U_CLIP;
constexpr size_t WS_H = al256(WS_TAB + 4 * SZ_TAB);
constexpr size_t WS_HB = al256(WS_H + (size_t)T * 1024 * 4);
constexpr size_t WS_SSQ = al256(WS_HB + (size_t)T * 1024 * 2);
constexpr size_t WS_UGLU = al256(WS_SSQ + (size_t)T * 8 * 4);
constexpr size_t WS_CQ = al256(WS_UGLU + (size_t)T * 512 * 2);
constexpr size_t WS_CKV = al256(WS_CQ + (size_t)T * 256 * 2);
constexpr size_t WS_KROPE = al256(WS_CKV + (size_t)T * 128 * 2);
constexpr size_t WS_SSQQ = al256(WS_KROPE + (size_t)T * 32 * 4);
constexpr size_t WS_SSQKV = al256(WS_SSQQ + (size_t)T * 2 * 4);
constexpr size_t WS_U2 = al256(WS_SSQKV + (size_t)T * 4);
constexpr size_t WS_Q = al256(WS_U2 + (size_t)T * 512 * 2);
constexpr size_t WS_K = al256(WS_Q + (size_t)T * NH * QK * 2);
constexpr size_t WS_VT = al256(WS_K + (size_t)T * NH * QK * 2);
constexpr size_t WS_O = al256(WS_VT + (size_t)T * NH * VD * 2 + 4096);
constexpr size_t WS_MERGED = al256(WS_O + (size_t)T * 512 * 2);
constexpr size_t WS_GATES = al256(WS_MERGED + (size_t)T * 1024 * 2);
constexpr size_t WS_SV = WS_GATES;
constexpr size_t WS_SI = al256(WS_SV + (size_t)T * 256 * 4);
constexpr size_t WS_EIDX = al256(WS_SI + (size_t)T * 256);
constexpr size_t WS_GW = al256(WS_EIDX + (size_t)T * 128 * 4);
constexpr size_t WS_STB = al256(WS_GW + (size_t)T * 128 * 4);
constexpr size_t WS_PEER_END = WS_STB + (size_t)T * 16;
constexpr size_t WS_END = al256(WS_GATES + (size_t)T * 2048 * 2);
static_assert(WS_PEER_END <= WS_END, "peer scratch overlay");

constexpr int CW_BAR = 0;
constexpr int CW_QUEUE = 4096;

constexpr int LDS_MAIN = 128 * 132 * 4;
constexpr int LDS_MISC = LDS_MAIN;
constexpr int LDS_BYTES = LDS_MAIN + 64;

constexpr int NTHREADS = 256;

__device__ __forceinline__ unsigned pk2(float lo, float hi) { bf16x2 v; v.x = (__bf16)lo; v.y = (__bf16)hi; return __builtin_bit_cast(unsigned, v); }
__device__ __forceinline__ unsigned pack_i8x4(f32x4 v) {
    const int a = (int)__builtin_rintf(fminf(fmaxf(v.x, -127.f), 127.f)), b = (int)__builtin_rintf(fminf(fmaxf(v.y, -127.f), 127.f));
    const int c_ = (int)__builtin_rintf(fminf(fmaxf(v.z, -127.f), 127.f)), d = (int)__builtin_rintf(fminf(fmaxf(v.w, -127.f), 127.f));
    return (unsigned)(a & 255) | ((unsigned)(b & 255) << 8) | ((unsigned)(c_ & 255) << 16) | ((unsigned)(d & 255) << 24);
}
__device__ __forceinline__ unsigned short pack_fp4x4(f32x4 v) {
#pragma unroll
    for (int i = 0; i < 4; ++i) v[i] = fminf(fmaxf(v[i], -6.0f), 6.0f);
    unsigned w = __builtin_amdgcn_cvt_scalef32_pk_fp4_f32(0u, v.x, v.y, 1.0f, 0);
    w = __builtin_amdgcn_cvt_scalef32_pk_fp4_f32(w, v.z, v.w, 1.0f, 1);
    return (unsigned short)w;
}
__device__ __forceinline__ float bf_lo(unsigned p) { return __uint_as_float(p << 16); }
__device__ __forceinline__ float bf_hi(unsigned p) { return __uint_as_float(p & 0xffff0000u); }
__device__ __forceinline__ float fast_rcp(float x) { return __builtin_amdgcn_rcpf(x); }
__device__ __forceinline__ float fast_exp2(float x) { return __builtin_amdgcn_exp2f(x); }
__device__ __forceinline__ float sigmoidf_(float x) { return fast_rcp(1.0f + fast_exp2(-1.4426950409f * x)); }
__device__ __forceinline__ float gelu_tanh(float x) { const float u = 1.5957691216f * (x + 0.044715f * x * x * x); return x * fast_rcp(1.0f + fast_exp2(-1.4426950409f * u)); }
__device__ __forceinline__ float rsqrt_(float x) { return __builtin_amdgcn_rsqf(x); }
template <int CTRL> __device__ __forceinline__ float dpp(float x) { return __builtin_bit_cast(float, __builtin_amdgcn_mov_dpp(__builtin_bit_cast(int, x), CTRL, 0xf, 0xf, true)); }
__device__ __forceinline__ float xrow16_sum(float x) {
    auto s = __builtin_amdgcn_permlane16_swap(__float_as_uint(x), __float_as_uint(x), false, false);
    x = __uint_as_float(s[0]) + __uint_as_float(s[1]);
    auto t = __builtin_amdgcn_permlane32_swap(__float_as_uint(x), __float_as_uint(x), false, false);
    return __uint_as_float(t[0]) + __uint_as_float(t[1]);
}
__device__ __forceinline__ float xrow16_max(float x) {
    auto s = __builtin_amdgcn_permlane16_swap(__float_as_uint(x), __float_as_uint(x), false, false);
    x = fmaxf(__uint_as_float(s[0]), __uint_as_float(s[1]));
    auto t = __builtin_amdgcn_permlane32_swap(__float_as_uint(x), __float_as_uint(x), false, false);
    return fmaxf(__uint_as_float(t[0]), __uint_as_float(t[1]));
}
__device__ __forceinline__ float wave_sum_dpp(float x) {
    x += dpp<0xB1>(x); x += dpp<0x4E>(x); x += dpp<0x141>(x); x += dpp<0x128>(x); return xrow16_sum(x);
}
__device__ __forceinline__ float quad_sum(float v) { return xrow16_sum(v); }
__device__ __forceinline__ float quad_max(float v) { return xrow16_max(v); }
__device__ __forceinline__ float wave_sum(float v) { return wave_sum_dpp(v); }
__device__ __forceinline__ float dot2(unsigned a, unsigned b, float c) { return __builtin_amdgcn_fdot2_f32_bf16(__builtin_bit_cast(bf16x2, a), __builtin_bit_cast(bf16x2, b), c, false); }

#define XB_TMO      128
#define XB_XCNT(j)  (256  + 64 * (j))
#define XB_XSUB(j)  (1280 + 64 * (j))
#define XB_XGEN(j)  (2304 + 64 * (j))
#define XB_TOP      3328
#define XB_TOPGEN   3392
#define XCD_BAR_WORDS 3456
#define XB_SPIN_CAP (1u << 20)
__device__ __forceinline__ unsigned xb_ld(unsigned* p)              { return __hip_atomic_load(p, __ATOMIC_RELAXED, __HIP_MEMORY_SCOPE_AGENT); }
__device__ __forceinline__ unsigned xb_add(unsigned* p, unsigned v) { return __hip_atomic_fetch_add(p, v, __ATOMIC_RELAXED, __HIP_MEMORY_SCOPE_AGENT); }
__device__ __forceinline__ unsigned xb_xcc_id() { return (unsigned)__builtin_amdgcn_s_getreg((3 << 11) | 20) & 0xFu; }
#define XB_SPIN(cond, bar) do { unsigned _sp = 0; while (cond) { __builtin_amdgcn_s_sleep(1); \
    if ((++_sp & 255u) == 0u) { if (xb_ld(&(bar)[XB_TMO])) break; if (_sp > XB_SPIN_CAP) { atomicAdd(&(bar)[XB_TMO], 1u); break; } } } } while (0)
struct XcdBarrier { unsigned* bar; unsigned x; volatile unsigned* st; };
__device__ __forceinline__ XcdBarrier xcd_barrier_post(unsigned* bar, volatile unsigned* st) {
    XcdBarrier b; b.bar = bar; b.x = xb_xcc_id(); b.st = st;
    if (threadIdx.x == 0) (void)xb_add(&bar[XB_XCNT(b.x)], 1u);
    return b;
}
__device__ __forceinline__ void xcd_barrier_complete(unsigned* bar, unsigned x, unsigned& nloc, unsigned& nx) {
    const unsigned G = gridDim.x * gridDim.y * gridDim.z;
    unsigned sum, cnt, mine, sp = 0u;
    for (;;) {
        sum = 0u; cnt = 0u; mine = 0u;
#pragma unroll
        for (unsigned j = 0; j < 16; ++j) { const unsigned c = xb_ld(&bar[XB_XCNT(j)]); sum += c; cnt += (c > 0u) ? 1u : 0u; mine = (j == x) ? c : mine; }
        if (sum == G) break;
        __builtin_amdgcn_s_sleep(1);
        if ((++sp & 255u) == 0u) { if (xb_ld(&bar[XB_TMO])) break; if (sp > XB_SPIN_CAP) { atomicAdd(&bar[XB_TMO], 1u); break; } }
    }
    nloc = mine > 0u ? mine : 1u; nx = cnt > 0u ? cnt : 1u;
}
__device__ __forceinline__ void xcd_barrier(const XcdBarrier& b) {
    asm volatile("s_waitcnt vmcnt(0)" ::: "memory");
    __syncthreads();
    if (threadIdx.x == 0) {
        unsigned* bar = b.bar;
        __builtin_amdgcn_s_waitcnt(0);
        unsigned nloc = b.st[0], nx = b.st[1];
        if (nloc == 0u) { xcd_barrier_complete(bar, b.x, nloc, nx); b.st[0] = nloc; b.st[1] = nx; }
        const unsigned old = xb_add(&bar[XB_XSUB(b.x)], 1u);
        const unsigned gen = old / nloc;
        if (old + 1u == (gen + 1u) * nloc) {
            __builtin_amdgcn_fence(__ATOMIC_RELEASE, "agent");
            asm volatile("s_waitcnt vmcnt(0)" ::: "memory");
            const unsigned og = xb_add(&bar[XB_TOP], 1u);
            const unsigned tg = og / nx;
            if (og + 1u == (tg + 1u) * nx) xb_add(&bar[XB_TOPGEN], 1u);
            else XB_SPIN(xb_ld(&bar[XB_TOPGEN]) == tg, bar);
            __builtin_amdgcn_fence(__ATOMIC_ACQUIRE, "agent");
            xb_add(&bar[XB_XGEN(b.x)], 1u);
            asm volatile("s_waitcnt vmcnt(0)" ::: "memory");
        } else {
            XB_SPIN(xb_ld(&bar[XB_XGEN(b.x)]) == gen, bar);
            __builtin_amdgcn_fence(__ATOMIC_ACQUIRE, "agent");
            asm volatile("s_waitcnt vmcnt(0)" ::: "memory");
        }
    }
    __syncthreads();
}

struct Ctx {
    const float* in[22]; float* out; unsigned char* ws;
    unsigned char* lds; int tid, lane, wave, G, vb;
};
#define WSP(T_, off) ((T_*)(c.ws + (off)))
__device__ __forceinline__ Ctx reopaque(const Ctx& c0) {
    Ctx c = c0; int t = c0.tid; asm volatile("" : "+v"(t)); c.tid = t; c.lane = t & 63; c.wave = __builtin_amdgcn_readfirstlane(t >> 6);
    int vb = c0.vb; asm volatile("" : "+s"(vb)); c.vb = vb; return c;
}

__device__ __forceinline__ int lds_off(int row, int chunk) { return row * 128 + ((chunk ^ (row & 7)) << 4); }

__device__ __forceinline__ void gemm_compute_stage(f32x4 (&acc)[2][8], const unsigned char* sA, const unsigned char* sB, int wave, int lane) {
    const int r = lane & 15, q = lane >> 4;
    bf16x8 af[2][2], bfr[2][8];
#pragma unroll
    for (int ks = 0; ks < 2; ++ks) {
#pragma unroll
        for (int mi = 0; mi < 2; ++mi) af[ks][mi] = *(const bf16x8*)(sA + lds_off(32 * wave + 16 * mi + r, 4 * ks + q));
#pragma unroll
        for (int ni = 0; ni < 8; ++ni) bfr[ks][ni] = *(const bf16x8*)(sB + lds_off(16 * ni + r, 4 * ks + q));
    }
#pragma unroll
    for (int ks = 0; ks < 2; ++ks)
#pragma unroll
        for (int ni = 0; ni < 8; ++ni)
#pragma unroll
            for (int mi = 0; mi < 2; ++mi) acc[mi][ni] = __builtin_amdgcn_mfma_f32_16x16x32_bf16(bfr[ks][ni], af[ks][mi], acc[mi][ni], 0, 0, 0);
    __builtin_amdgcn_sched_group_barrier(0x100, 6, 0);
#pragma unroll
    for (int i = 0; i < 14; ++i) { __builtin_amdgcn_sched_group_barrier(0x8, 2, 0); __builtin_amdgcn_sched_group_barrier(0x100, 1, 0); }
    __builtin_amdgcn_sched_group_barrier(0x8, 4, 0);
}

#define LAS __attribute__((address_space(3)))
__device__ __forceinline__ void gemm_stage_glds(const bf16* A, int lda, const bf16* Bt, int ldb, int kt, unsigned char* stage, int wave, int lane) {
    const int rr = lane >> 3, cch = (lane & 7) ^ rr;
#pragma unroll
    for (int i = 0; i < 4; ++i) { const int pc = 4 * i + wave;
        __builtin_amdgcn_global_load_lds((const unsigned*)(A + (size_t)(8 * pc + rr) * lda + kt * 64 + cch * 8), (LAS unsigned*)(stage + pc * 1024), 16, 0, 0);
        __builtin_amdgcn_global_load_lds((const unsigned*)(Bt + (size_t)(8 * pc + rr) * ldb + kt * 64 + cch * 8), (LAS unsigned*)(stage + 16384 + pc * 1024), 16, 0, 0); }
}
__device__ __forceinline__ void gemm_core(f32x4 (&acc)[2][8], const bf16* A, int lda, const bf16* Bt, int ldb, int K, unsigned char* lds, int tid) {
    const int wave = __builtin_amdgcn_readfirstlane(tid >> 6), lane = tid & 63;
    const int nk = K >> 6;
    gemm_stage_glds(A, lda, Bt, ldb, 0, lds, wave, lane);
    asm volatile("s_waitcnt vmcnt(0)" ::: "memory");
    __syncthreads();
    for (int kt = 0; kt < nk; ++kt) {
        const int cur = kt & 1;
        if (kt + 1 < nk) gemm_stage_glds(A, lda, Bt, ldb, kt + 1, lds + (cur ^ 1) * 32768, wave, lane);
        gemm_compute_stage(acc, lds + cur * 32768, lds + cur * 32768 + 16384, wave, lane);
        asm volatile("s_waitcnt vmcnt(0)" ::: "memory");
        __syncthreads();
    }
}
__device__ __forceinline__ void acc_zero(f32x4 (&acc)[2][8]) {
#pragma unroll
    for (int mi = 0; mi < 2; ++mi)
#pragma unroll
        for (int ni = 0; ni < 8; ++ni) acc[mi][ni] = (f32x4){0.f, 0.f, 0.f, 0.f};
}
__device__ __forceinline__ float rstd_from_ssq8(const float* ssq, int tok) {
    const f32x4 a = *(const f32x4*)(ssq + (size_t)tok * 8), b = *(const f32x4*)(ssq + (size_t)tok * 8 + 4);
    const float s = ((a.x + a.y) + (a.z + a.w)) + ((b.x + b.y) + (b.z + b.w));
    return rsqrt_(s * (1.0f / 1024.0f) + EPS);
}

__device__ __forceinline__ int src_col(int mode, int np) {
    if (mode == 0) return np;
    if (mode == 2) { const int h = np >> 7, j = np & 127; return j < 96 ? h * 96 + j : -1; }
    if (np < 1024) { const int cblk = np >> 7, j = np & 127; return j < 64 ? 64 * cblk + j : 512 + 64 * cblk + (j - 64); }
    if (np < 1408) return np;
    if (np < 1536) { const int j = np - 1408; return j < 32 ? 1408 + j : -1; }
    return 1440 + (np - 1536);
}
__device__ __forceinline__ void p0_transpose_item(const float* W, int K, int N, bf16* Wt, int mode, const float* g, int item, float* scr, int lane) {
    const int nblk_k = K / 64, nb = item / nblk_k, kb = item % nblk_k, k0 = 64 * kb, n0 = 32 * nb;
    const int n = src_col(mode, n0 + (lane & 31));
    float wv[32], gv[32];
#pragma unroll
    for (int i = 0; i < 32; ++i) { const int kk = 2 * i + (lane >> 5); wv[i] = n >= 0 ? W[(size_t)(k0 + kk) * N + n] : 0.f; gv[i] = g ? g[k0 + kk] : 1.f; }
#pragma unroll
    for (int i = 0; i < 32; ++i) { const int kk = 2 * i + (lane >> 5); scr[kk * 33 + (lane & 31)] = wv[i] * gv[i]; }
    __builtin_amdgcn_s_waitcnt(0xC07F); asm volatile("" ::: "memory");
    const int cch = lane & 7;
#pragma unroll
    for (int j = 0; j < 4; ++j) { const int nl = (lane >> 3) + 8 * j; const float* s = scr + (8 * cch) * 33 + nl;
        u32x4 o; o.x = pk2(s[0 * 33], s[1 * 33]); o.y = pk2(s[2 * 33], s[3 * 33]); o.z = pk2(s[4 * 33], s[5 * 33]); o.w = pk2(s[6 * 33], s[7 * 33]);
        *(u32x4*)(Wt + (size_t)(n0 + nl) * K + k0 + 8 * cch) = o; }
    __builtin_amdgcn_s_waitcnt(0xC07F); asm volatile("" ::: "memory");
}
struct WDesc { int in_idx, K, N, Np, mode, g_idx; size_t off; };
__device__ __forceinline__ void phase_prologue(const Ctx& c0) {
    Ctx c = reopaque(c0);
    const int gw = c.vb * 4 + c.wave, NGW = c.G * 4;
    float* scr = (float*)(c.lds + c.wave * 8704);
    const WDesc wd[7] = {
        {3, 1024, NIN, NINP, 1, 2, 0}, {8, 512, 1024, 1024, 0, -1, OFF_WCO}, {10, 256, 768, 1024, 2, 9, OFF_WUQ}, {12, 128, 1024, 1024, 0, 11, OFF_WUKV},
        {15, 512, 1024, 1024, 0, -1, OFF_WMLA}, {16, 1024, 1024, 1024, 0, -1, OFF_WOUT}, {18, 1024, 2048, 2048, 0, 17, OFF_WPQ}};
    constexpr int ITEMS_PER_LAYER = (1024 / 64) * (NINP / 32) + (512 / 64) * 32 + (256 / 64) * 32 + (128 / 64) * 32 + (512 / 64) * 32 + (1024 / 64) * 32 + (1024 / 64) * 64;
    for (int it = gw; it < 2 * ITEMS_PER_LAYER; it += NGW) {
        const int l = it >= ITEMS_PER_LAYER ? 1 : 0; int r = it - l * ITEMS_PER_LAYER;
        const float* W = nullptr; const float* g = nullptr; bf16* Wt = nullptr; int K = 64, N = 32, mode = 0, rr = 0;
#pragma unroll
        for (int m = 0; m < 7; ++m) {
            const int items = (wd[m].K / 64) * (wd[m].Np / 32);
            if (r >= 0 && r < items) { K = wd[m].K; N = wd[m].N; mode = wd[m].mode; rr = r;
                W = c.in[wd[m].in_idx] + (size_t)l * wd[m].K * wd[m].N; g = wd[m].g_idx >= 0 ? c.in[wd[m].g_idx >= 0 ? wd[m].g_idx : 0] + (size_t)l * wd[m].K : nullptr;
                Wt = (bf16*)(c.ws + WS_WIN + l * SZ_WLAYER + wd[m].off); }
            r -= items;
        }
        p0_transpose_item(W, K, N, Wt, mode, g, rr, scr, c.lane);
    }
    const int gt = c.vb * NTHREADS + c.tid, NGT = c.G * NTHREADS;
    for (int l = 0; l < 2; ++l) {
        const float* src = c.in[19] + (size_t)l * 262144; bf16* dst = (bf16*)(c.ws + WS_WIN + l * SZ_WLAYER + OFF_KEYS);
        for (int i = gt; i < 262144 / 8; i += NGT) { const f32x4 a = *(const f32x4*)(src + i * 8), b = *(const f32x4*)(src + i * 8 + 4);
            u32x4 o; o.x = pk2(a.x, a.y); o.y = pk2(a.z, a.w); o.z = pk2(b.x, b.y); o.w = pk2(b.z, b.w); *(u32x4*)(dst + i * 8) = o; }
    }
    for (int l = 0; l < 2; ++l)
        for (int uv = 0; uv < 2; ++uv) {
            const float* src = c.in[20 + uv] + (size_t)l * NEXP * 1024; unsigned char* dst = c.ws + WS_TAB + (size_t)(l * 2 + uv) * SZ_TAB;
            f32x4 g4[4];
#pragma unroll
            for (int j = 0; j < 4; ++j) { const float sc = uv == 0 ? U_SCALE : TAB_SCALE; g4[j] = (f32x4){sc, sc, sc, sc}; if (uv == 0) g4[j] = g4[j] * *(const f32x4*)(c.in[17] + l * 1024 + 256 * j + 4 * c.lane); }
            for (int row = gw; row < NEXP; row += 2 * NGW) {
                const float* sp = src + (size_t)row * 1024 + 4 * c.lane; const int row2 = row + NGW; const bool two = row2 < NEXP;
                const float* sp2 = src + (size_t)(two ? row2 : row) * 1024 + 4 * c.lane;
                f32x4 a[4], b[4];
#pragma unroll
                for (int j = 0; j < 4; ++j) { a[j] = *(const f32x4*)(sp + 256 * j); b[j] = *(const f32x4*)(sp2 + 256 * j); }
#pragma unroll
                for (int j = 0; j < 4; ++j) { const f32x4 v = a[j] * g4[j];
                    if (uv == 0) *(unsigned*)(dst + (size_t)row * 1024 + 256 * j + 4 * c.lane) = pack_i8x4(v);
                    else *(unsigned short*)(dst + (size_t)row * 512 + 128 * j + 2 * c.lane) = pack_fp4x4(v); }
                if (two) {
#pragma unroll
                    for (int j = 0; j < 4; ++j) { const f32x4 v = b[j] * g4[j];
                        if (uv == 0) *(unsigned*)(dst + (size_t)row2 * 1024 + 256 * j + 4 * c.lane) = pack_i8x4(v);
                        else *(unsigned short*)(dst + (size_t)row2 * 512 + 128 * j + 2 * c.lane) = pack_fp4x4(v); } }
            }
        }
    { float* rope = WSP(float, WS_ROPE);
      for (int i = gt; i < L * 16; i += NGT) { const int pos = i >> 4, j = i & 15;
          const float inv = 1.0f / __builtin_exp2f((float)j * 0.8304820237218406f);
          const float angf = (float)pos * inv; const double ang = (double)angf;
          const double nq = __builtin_rint(ang * 0.63661977236758134308);
          double rr = __builtin_fma(-nq, 1.57079632679489655800e+00, ang); rr = __builtin_fma(-nq, 6.12323399573676603587e-17, rr);
          const double r2 = rr * rr;
          double sp = -1.0 / 1307674368000.0; sp = sp * r2 + 1.0 / 6227020800.0; sp = sp * r2 - 1.0 / 39916800.0; sp = sp * r2 + 1.0 / 362880.0; sp = sp * r2 - 1.0 / 5040.0; sp = sp * r2 + 1.0 / 120.0; sp = sp * r2 - 1.0 / 6.0; sp = sp * r2 * rr + rr;
          double cp = 1.0 / 87178291200.0; cp = cp * r2 - 1.0 / 479001600.0; cp = cp * r2 + 1.0 / 3628800.0; cp = cp * r2 - 1.0 / 40320.0; cp = cp * r2 + 1.0 / 720.0; cp = cp * r2 - 1.0 / 24.0; cp = cp * r2 + 0.5; cp = 1.0 - cp * r2;
          const int qd = ((int)nq) & 3;
          const double cv = qd == 0 ? cp : qd == 1 ? -sp : qd == 2 ? -cp : sp;
          const double sv_ = qd == 0 ? sp : qd == 1 ? cp : qd == 2 ? -sp : -cp;
          rope[2 * i] = (float)cv; rope[2 * i + 1] = (float)sv_; } }
    { bf16* hb = WSP(bf16, WS_HB); float* ssq = WSP(float, WS_SSQ);
      for (int t0_ = gw; t0_ < T; t0_ += 4 * NGW) {
          f32x4 v[4][4];
#pragma unroll
          for (int i = 0; i < 4; ++i) { const int t = t0_ + i * NGW < T ? t0_ + i * NGW : t0_; const int b = t / L, pos = t % L;
              const float* src = pos < NMETA ? c.in[1] + (size_t)pos * D : c.in[0] + ((size_t)b * SEQ + (pos - NMETA)) * D;
#pragma unroll
              for (int j = 0; j < 4; ++j) v[i][j] = *(const f32x4*)(src + j * 256 + c.lane * 4); }
#pragma unroll
          for (int i = 0; i < 4; ++i) { const int t = t0_ + i * NGW;
              if (t < T) { float s = 0.f;
#pragma unroll
                  for (int j = 0; j < 4; ++j) { const f32x4 x = v[i][j]; u32x2 o; o.x = pk2(x.x, x.y); o.y = pk2(x.z, x.w); *(u32x2*)(hb + (size_t)t * D + j * 256 + c.lane * 4) = o;
                      s += (x.x * x.x + x.y * x.y) + (x.z * x.z + x.w * x.w); }
                  s = wave_sum(s);
                  if (c.lane < 8) ssq[(size_t)t * 8 + c.lane] = c.lane == 0 ? s : 0.f; } }
      } }
}

__device__ __forceinline__ void phase_A(const Ctx& c0, int l) {
    Ctx c = reopaque(c0);
    const bf16* hb = WSP(bf16, WS_HB); const bf16* Wt = (const bf16*)(c.ws + WS_WIN + l * SZ_WLAYER);
    const float* ssq = WSP(float, WS_SSQ);
    bf16* uglu = WSP(bf16, WS_UGLU); bf16* cq = WSP(bf16, WS_CQ); bf16* ckv = WSP(bf16, WS_CKV); float* krope = WSP(float, WS_KROPE);
    float* ssqq = WSP(float, WS_SSQQ); float* ssqkv = WSP(float, WS_SSQKV); bf16* gates = WSP(bf16, WS_GATES);
    constexpr int NT = NINP / 128;
    const int r = c.lane & 15, q = c.lane >> 4;
    const int xcd = c.vb / (c.G / 8), lb = c.vb % (c.G / 8), xm = xcd & 1, xn = xcd >> 1;
    const int m_lo = xm ? (MT + 1) / 2 : 0, m_cnt = xm ? MT / 2 : (MT + 1) / 2;
    for (int j = lb; j < m_cnt * 7; j += c.G / 8) {
        const int mt = m_lo + j / 7, nt = xn * 7 + j % 7;
        f32x4 acc[2][8]; acc_zero(acc);
        gemm_core(acc, hb + (size_t)mt * 128 * D, D, Wt + (size_t)nt * 128 * D, D, D, c.lds, c.tid);
#pragma unroll
        for (int mi = 0; mi < 2; ++mi) {
            const int tok = mt * 128 + 32 * c.wave + 16 * mi + r;
            const float rs = rstd_from_ssq8(ssq, tok);
            if (nt < 8) {
#pragma unroll
                for (int ni = 0; ni < 4; ++ni) { const f32x4 v = acc[mi][ni] * rs, g = acc[mi][ni + 4] * rs;
                    u32x2 o; o.x = pk2(v.x * sigmoidf_(g.x), v.y * sigmoidf_(g.y)); o.y = pk2(v.z * sigmoidf_(g.z), v.w * sigmoidf_(g.w));
                    *(u32x2*)(uglu + (size_t)tok * DC + nt * 64 + 16 * ni + 4 * q) = o; }
            } else if (nt < 11) {
                bf16* dst = nt < 10 ? cq + (size_t)tok * QL + (nt - 8) * 128 : ckv + (size_t)tok * KVL;
                float ss = 0.f;
#pragma unroll
                for (int ni = 0; ni < 8; ++ni) { const f32x4 v = acc[mi][ni] * rs; ss += (v.x * v.x + v.y * v.y) + (v.z * v.z + v.w * v.w);
                    u32x2 o; o.x = pk2(v.x, v.y); o.y = pk2(v.z, v.w); *(u32x2*)(dst + 16 * ni + 4 * q) = o; }
                ss = quad_sum(ss);
                if (q == 0) { if (nt < 10) ssqq[(size_t)tok * 2 + (nt - 8)] = ss; else ssqkv[tok] = ss; }
            } else if (nt == 11) {
#pragma unroll
                for (int ni = 0; ni < 2; ++ni) *(f32x4*)(krope + (size_t)tok * 32 + 16 * ni + 4 * q) = acc[mi][ni] * rs;
            } else {
#pragma unroll
                for (int ni = 0; ni < 8; ++ni) { const f32x4 v = acc[mi][ni] * rs;
                    u32x2 o; o.x = pk2(sigmoidf_(v.x), sigmoidf_(v.y)); o.y = pk2(sigmoidf_(v.z), sigmoidf_(v.w));
                    *(u32x2*)(gates + (size_t)tok * 2048 + (nt - 12) * 128 + 16 * ni + 4 * q) = o; }
            }
        }
    }
}

__device__ __forceinline__ void phaseB_q_item(Ctx& c, int l, int mt, int head) {
    const bf16* cq = WSP(bf16, WS_CQ); const bf16* Wt = (const bf16*)(c.ws + WS_WIN + l * SZ_WLAYER + OFF_WUQ);
    const float* ssqq = WSP(float, WS_SSQQ); const float* rope = WSP(float, WS_ROPE); const float* qg = c.in[13] + l * QK; bf16* Qb = WSP(bf16, WS_Q);
    const int r = c.lane & 15, q = c.lane >> 4;
    f32x4 acc[2][8]; acc_zero(acc);
    gemm_core(acc, cq + (size_t)mt * 128 * QL, QL, Wt + (size_t)head * 128 * QL, QL, QL, c.lds, c.tid);
    constexpr float QSCALE = 0.10206207261596575f * 1.4426950408889634f;
#pragma unroll
    for (int mi = 0; mi < 2; ++mi) {
        const int tok = mt * 128 + 32 * c.wave + 16 * mi + r, b = tok / L, pos = tok - b * L;
        const float rs = rsqrt_((ssqq[(size_t)tok * 2] + ssqq[(size_t)tok * 2 + 1]) * (1.0f / 256.0f) + EPS);
        float ss = 0.f;
#pragma unroll
        for (int ni = 0; ni < 6; ++ni) { acc[mi][ni] = acc[mi][ni] * rs; const f32x4 v = acc[mi][ni]; ss += (v.x * v.x + v.y * v.y) + (v.z * v.z + v.w * v.w); }
        ss = quad_sum(ss);
        const float rn = rsqrt_(ss * (1.0f / 96.0f) + EPS) * QSCALE;
#pragma unroll
        for (int ni = 0; ni < 6; ++ni) { const f32x4 g = *(const f32x4*)(qg + 16 * ni + 4 * q); acc[mi][ni] = acc[mi][ni] * g * rn; }
        const f32x4 cs0 = *(const f32x4*)(rope + ((size_t)pos * 16 + 4 * q) * 2), cs1 = *(const f32x4*)(rope + ((size_t)pos * 16 + 4 * q) * 2 + 4);
        const float co[4] = {cs0.x, cs0.z, cs1.x, cs1.z}, si[4] = {cs0.y, cs0.w, cs1.y, cs1.w};
        f32x4 x1 = acc[mi][4], x2 = acc[mi][5];
#pragma unroll
        for (int e = 0; e < 4; ++e) { const float a = x1[e], bb = x2[e]; x1[e] = a * co[e] - bb * si[e]; x2[e] = bb * co[e] + a * si[e]; }
        acc[mi][4] = x1; acc[mi][5] = x2;
        bf16* dst = Qb + (((size_t)b * NH + head) * L + pos) * QK;
#pragma unroll
        for (int ni = 0; ni < 6; ++ni) { const f32x4 v = acc[mi][ni]; u32x2 o; o.x = pk2(v.x, v.y); o.y = pk2(v.z, v.w); *(u32x2*)(dst + 16 * ni + 4 * q) = o; }
    }
}
__device__ __forceinline__ void phaseB_kv_item(Ctx& c, int l, int mt, int head) {
    const bf16* ckv = WSP(bf16, WS_CKV); const bf16* Wt = (const bf16*)(c.ws + WS_WIN + l * SZ_WLAYER + OFF_WUKV);
    const float* ssqkv = WSP(float, WS_SSQKV); const float* rope = WSP(float, WS_ROPE); const float* kg = c.in[14] + l * QK; const float* krope = WSP(float, WS_KROPE);
    bf16* Kb = WSP(bf16, WS_K); bf16* Vt = WSP(bf16, WS_VT);
    const int tid = c.tid, wave = c.wave, lane = c.lane, r = lane & 15, q = lane >> 4;
    unsigned char* lds = c.lds;
    f32x4 ak[2][4], av[2][4];
#pragma unroll
    for (int mi = 0; mi < 2; ++mi)
#pragma unroll
        for (int ni = 0; ni < 4; ++ni) { ak[mi][ni] = (f32x4){0.f, 0.f, 0.f, 0.f}; av[mi][ni] = (f32x4){0.f, 0.f, 0.f, 0.f}; }
    { const int chunk = tid & 7, row0 = tid >> 3;
      const bf16* pa = ckv + ((size_t)mt * 128 + row0) * KVL + chunk * 8; const bf16* pb = Wt + ((size_t)head * 128 + row0) * KVL + chunk * 8;
#pragma unroll
      for (int s = 0; s < 2; ++s)
#pragma unroll
          for (int i = 0; i < 4; ++i) { *(u32x4*)(lds + s * 32768 + lds_off(row0 + 32 * i, chunk)) = *(const u32x4*)(pa + (size_t)(32 * i) * KVL + s * 64);
              *(u32x4*)(lds + s * 32768 + 16384 + lds_off(row0 + 32 * i, chunk)) = *(const u32x4*)(pb + (size_t)(32 * i) * KVL + s * 64); }
    }
    __syncthreads();
#pragma unroll
    for (int s = 0; s < 2; ++s)
#pragma unroll
        for (int ks = 0; ks < 2; ++ks) {
            const unsigned char* sA = lds + s * 32768; const unsigned char* sB = sA + 16384;
            bf16x8 af[2], bfr[8];
#pragma unroll
            for (int mi = 0; mi < 2; ++mi) af[mi] = *(const bf16x8*)(sA + lds_off(32 * wave + 16 * mi + r, 4 * ks + q));
#pragma unroll
            for (int ni = 0; ni < 8; ++ni) bfr[ni] = *(const bf16x8*)(sB + lds_off(16 * ni + r, 4 * ks + q));
#pragma unroll
            for (int mi = 0; mi < 2; ++mi)
#pragma unroll
                for (int ni = 0; ni < 4; ++ni) { ak[mi][ni] = __builtin_amdgcn_mfma_f32_16x16x32_bf16(bfr[ni], af[mi], ak[mi][ni], 0, 0, 0);
                    av[mi][ni] = __builtin_amdgcn_mfma_f32_16x16x32_bf16(af[mi], bfr[ni + 4], av[mi][ni], 0, 0, 0); }
        }
    __syncthreads();
#pragma unroll
    for (int mi = 0; mi < 2; ++mi) {
        const int tok0 = mt * 128 + 32 * wave + 16 * mi, b = tok0 / L, pos0 = tok0 - b * L;
        { const int tok = tok0 + r, pos = pos0 + r;
          const float rs = rsqrt_(ssqkv[tok] * (1.0f / 128.0f) + EPS);
          const f32x4 kr1 = *(const f32x4*)(krope + (size_t)tok * 32 + 4 * q), kr2 = *(const f32x4*)(krope + (size_t)tok * 32 + 16 + 4 * q);
          float ss = (kr1.x * kr1.x + kr1.y * kr1.y) + (kr1.z * kr1.z + kr1.w * kr1.w) + (kr2.x * kr2.x + kr2.y * kr2.y) + (kr2.z * kr2.z + kr2.w * kr2.w);
#pragma unroll
          for (int ni = 0; ni < 4; ++ni) { ak[mi][ni] = ak[mi][ni] * rs; const f32x4 v = ak[mi][ni]; ss += (v.x * v.x + v.y * v.y) + (v.z * v.z + v.w * v.w); }
          ss = quad_sum(ss);
          const float rn = rsqrt_(ss * (1.0f / 96.0f) + EPS);
          bf16* dst = Kb + (((size_t)b * NH + head) * L + pos) * QK;
#pragma unroll
          for (int ni = 0; ni < 4; ++ni) { const f32x4 g = *(const f32x4*)(kg + 16 * ni + 4 * q); const f32x4 v = ak[mi][ni] * g * rn;
              u32x2 o; o.x = pk2(v.x, v.y); o.y = pk2(v.z, v.w); *(u32x2*)(dst + 16 * ni + 4 * q) = o; }
          const f32x4 g1 = *(const f32x4*)(kg + 64 + 4 * q), g2 = *(const f32x4*)(kg + 80 + 4 * q);
          f32x4 x1 = kr1 * g1 * rn, x2 = kr2 * g2 * rn;
          const f32x4 cs0 = *(const f32x4*)(rope + ((size_t)pos * 16 + 4 * q) * 2), cs1 = *(const f32x4*)(rope + ((size_t)pos * 16 + 4 * q) * 2 + 4);
          const float co[4] = {cs0.x, cs0.z, cs1.x, cs1.z}, si[4] = {cs0.y, cs0.w, cs1.y, cs1.w};
#pragma unroll
          for (int e = 0; e < 4; ++e) { const float a = x1[e], bb = x2[e]; x1[e] = a * co[e] - bb * si[e]; x2[e] = bb * co[e] + a * si[e]; }
          u32x2 o1, o2; o1.x = pk2(x1.x, x1.y); o1.y = pk2(x1.z, x1.w); o2.x = pk2(x2.x, x2.y); o2.y = pk2(x2.z, x2.w);
          *(u32x2*)(dst + 64 + 4 * q) = o1; *(u32x2*)(dst + 80 + 4 * q) = o2; }
        { const f32x4 sq = *(const f32x4*)(ssqkv + tok0 + 4 * q);
          f32x4 rs4; rs4.x = rsqrt_(sq.x * (1.0f / 128.0f) + EPS); rs4.y = rsqrt_(sq.y * (1.0f / 128.0f) + EPS); rs4.z = rsqrt_(sq.z * (1.0f / 128.0f) + EPS); rs4.w = rsqrt_(sq.w * (1.0f / 128.0f) + EPS);
#pragma unroll
          for (int ni = 0; ni < 4; ++ni) { const f32x4 v = av[mi][ni] * rs4; u32x2 o; o.x = pk2(v.x, v.y); o.y = pk2(v.z, v.w);
              *(u32x2*)(Vt + (((size_t)b * NH + head) * VD + 16 * ni + r) * L + pos0 + 4 * q) = o; } }
    }
}
__device__ __forceinline__ u32x4 conv_row(const bf16* uglu, int b, int pos, int ch) {
    u32x4 xv = (u32x4){0u, 0u, 0u, 0u};
    if (pos >= 0) xv = *(const u32x4*)(uglu + ((size_t)b * L + pos) * DC + ch);
    return xv;
}
__device__ __forceinline__ void conv_fma(float (&a)[8], const u32x4 xv, const f32x4 w0, const f32x4 w1) {
    a[0] += bf_lo(xv.x) * w0.x; a[1] += bf_hi(xv.x) * w0.y; a[2] += bf_lo(xv.y) * w0.z; a[3] += bf_hi(xv.y) * w0.w;
    a[4] += bf_lo(xv.z) * w1.x; a[5] += bf_hi(xv.z) * w1.y; a[6] += bf_lo(xv.w) * w1.z; a[7] += bf_hi(xv.w) * w1.w;
}
__device__ __forceinline__ void phaseB_conv_item(Ctx& c, int l, int grp) {
    const bf16* uglu = WSP(bf16, WS_UGLU); bf16* u2 = WSP(bf16, WS_U2);
    const float* cw = c.in[4] + (size_t)l * CW * DC; const float* cb = c.in[5] + l * DC; const float* lg = c.in[6] + l * DC; const float* lb = c.in[7] + l * DC;
    const int tok0 = grp * 4, b = tok0 / L, pos0 = tok0 - b * L, ch = c.lane * 8;
    float acc[4][8];
    { const f32x4 b0 = *(const f32x4*)(cb + ch), b1 = *(const f32x4*)(cb + ch + 4);
#pragma unroll
      for (int d = 0; d < 4; ++d) { acc[d][0] = b0.x; acc[d][1] = b0.y; acc[d][2] = b0.z; acc[d][3] = b0.w; acc[d][4] = b1.x; acc[d][5] = b1.y; acc[d][6] = b1.z; acc[d][7] = b1.w; } }
    const int base = pos0 - 30;
    u32x4 x0 = conv_row(uglu, b, base + 0, ch), x1 = conv_row(uglu, b, base + 1, ch), x2 = conv_row(uglu, b, base + 2, ch),
          x3 = conv_row(uglu, b, base + 3, ch), x4 = conv_row(uglu, b, base + 4, ch), x5;
    const float* wp = cw + ch;
#pragma unroll 1
    for (int w = 0; w < CW; ++w) {
        x5 = conv_row(uglu, b, (w + 5 <= 33) ? base + w + 5 : -1, ch);
        const f32x4 w0 = *(const f32x4*)wp, w1 = *(const f32x4*)(wp + 4); wp += DC;
        conv_fma(acc[0], x0, w0, w1); conv_fma(acc[1], x1, w0, w1); conv_fma(acc[2], x2, w0, w1); conv_fma(acc[3], x3, w0, w1);
        x0 = x1; x1 = x2; x2 = x3; x3 = x4; x4 = x5;
    }
    const f32x4 g0 = *(const f32x4*)(lg + ch), g1 = *(const f32x4*)(lg + ch + 4), e0 = *(const f32x4*)(lb + ch), e1 = *(const f32x4*)(lb + ch + 4);
    const float gg[8] = {g0.x, g0.y, g0.z, g0.w, g1.x, g1.y, g1.z, g1.w}, be[8] = {e0.x, e0.y, e0.z, e0.w, e1.x, e1.y, e1.z, e1.w};
#pragma unroll
    for (int d = 0; d < 4; ++d) {
        float s = 0.f;
#pragma unroll
        for (int j = 0; j < 8; ++j) s += acc[d][j];
        const float mu = wave_sum(s) * (1.0f / 512.0f);
        float vq = 0.f;
#pragma unroll
        for (int j = 0; j < 8; ++j) { acc[d][j] -= mu; vq += acc[d][j] * acc[d][j]; }
        const float rstd = rsqrt_(wave_sum(vq) * (1.0f / 512.0f) + EPS);
        float y[8];
#pragma unroll
        for (int j = 0; j < 8; ++j) { const float v = acc[d][j] * rstd * gg[j] + be[j]; y[j] = v * sigmoidf_(v); }
        u32x4 o; o.x = pk2(y[0], y[1]); o.y = pk2(y[2], y[3]); o.z = pk2(y[4], y[5]); o.w = pk2(y[6], y[7]);
        *(u32x4*)(u2 + (size_t)(tok0 + d) * DC + ch) = o;
    }
}
__device__ __forceinline__ void phase_B(const Ctx& c0, int l) {
    Ctx c = reopaque(c0);
    constexpr int NQ = MT * NH, NKV = MT * NH, NCV = T / 16;
    for (int it = c.vb; it < NQ + NKV + NCV; it += c.G) {
        if (it < NQ) phaseB_q_item(c, l, it / NH, it % NH);
        else if (it < NQ + NKV) phaseB_kv_item(c, l, (it - NQ) / NH, (it - NQ) % NH);
        else phaseB_conv_item(c, l, (it - NQ - NKV) * 4 + c.wave);
    }
}

constexpr int KROW = 208, VROW = 136, ATT_STAGE = 64 * KROW + 64 * VROW;
constexpr int ATT_ITEMS = NB * NH * 17;
__device__ __forceinline__ void phase_C(const Ctx& c0, int l) {
    Ctx c = reopaque(c0);
    const bf16* Qb = WSP(bf16, WS_Q); const bf16* Kb = WSP(bf16, WS_K); const bf16* Vt = WSP(bf16, WS_VT); bf16* O = WSP(bf16, WS_O);
    unsigned* qctr = WSP(unsigned, WS_CTL) + CW_QUEUE + 64 * l;
    volatile unsigned* misc = (volatile unsigned*)(c.lds + LDS_MISC);
    const int tid = c.tid, wave = c.wave, lane = c.lane, r = lane & 15, q = lane >> 4;
    unsigned char* lds = c.lds;
    for (;;) {
        if (tid == 0) misc[4] = atomicAdd(qctr, 1u);
        __syncthreads();
        const int item = __builtin_amdgcn_readfirstlane((int)misc[4]);
        __syncthreads();
        if (item >= ATT_ITEMS) break;
        const int pp = 15 - item / 64, bh = item % 64, b = bh / NH, h = bh % NH;
        const bool meta = pp < 0;
        const int r0 = meta ? 0 : 16 + 128 * pp;
        const int nfull = meta ? 0 : 2 * pp + 1 + (wave >> 1);
        const int ntiles = meta ? 1 : 2 * pp + 3;
        const bf16* Kbase = Kb + (size_t)bh * L * QK; const bf16* Vbase = Vt + (size_t)bh * VD * L;
        bf16x8 qf[2][3];
#pragma unroll
        for (int mi = 0; mi < 2; ++mi)
#pragma unroll
            for (int ks = 0; ks < 3; ++ks) qf[mi][ks] = *(const bf16x8*)(Qb + ((size_t)bh * L + r0 + 32 * wave + 16 * mi + r) * QK + 32 * ks + 8 * q);
        float m[2] = {-1e30f, -1e30f}, lsum[2] = {0.f, 0.f};
        f32x4 o[2][4];
#pragma unroll
        for (int mi = 0; mi < 2; ++mi)
#pragma unroll
            for (int dt = 0; dt < 4; ++dt) o[mi][dt] = (f32x4){0.f, 0.f, 0.f, 0.f};
        u32x4 rk[3], rv[2];
        auto gload = [&](int kt) {
#pragma unroll
            for (int i = 0; i < 3; ++i) { const int id = tid + 256 * i, row = id / 12, cc = id % 12; rk[i] = *(const u32x4*)(Kbase + (size_t)(kt * 64 + row) * QK + cc * 8); }
#pragma unroll
            for (int i = 0; i < 2; ++i) { const int id = tid + 256 * i, row = id >> 3, cc = id & 7; rv[i] = *(const u32x4*)(Vbase + (size_t)row * L + kt * 64 + cc * 8); }
        };
        auto lstore = [&](int s) {
            unsigned char* st = lds + s * ATT_STAGE;
#pragma unroll
            for (int i = 0; i < 3; ++i) { const int id = tid + 256 * i, row = id / 12, cc = id % 12; *(u32x4*)(st + row * KROW + cc * 16) = rk[i]; }
#pragma unroll
            for (int i = 0; i < 2; ++i) { const int id = tid + 256 * i, row = id >> 3, cc = id & 7; u32x2* d = (u32x2*)(st + 64 * KROW + row * VROW + cc * 16); d[0] = (u32x2){rv[i].x, rv[i].y}; d[1] = (u32x2){rv[i].z, rv[i].w}; }
        };
        gload(0); lstore(0);
#pragma unroll
        for (int mi = 0; mi < 2; ++mi)
#pragma unroll
            for (int ks = 0; ks < 3; ++ks) asm volatile("" : "+v"(qf[mi][ks]));
        __syncthreads();
        for (int kt = 0; kt < ntiles; ++kt) {
            const int cur = kt & 1;
            if (kt + 1 < ntiles) gload(kt + 1);
            const unsigned char* sK = lds + cur * ATT_STAGE; const unsigned char* sV = sK + 64 * KROW;
            const bool full = kt < nfull;
            if (kt <= nfull) {
                f32x4 s[2][4];
#pragma unroll
                for (int kh = 0; kh < 2; ++kh) {
                    bf16x8 kf[2][3];
#pragma unroll
                    for (int kk = 0; kk < 2; ++kk) if ((kh == 0 && kk == 0) || full) {
#pragma unroll
                        for (int ks = 0; ks < 3; ++ks) kf[kk][ks] = *(const bf16x8*)(sK + (16 * (2 * kh + kk) + r) * KROW + 64 * ks + 16 * q); }
#pragma unroll
                    for (int kk = 0; kk < 2; ++kk) { const int k4 = 2 * kh + kk;
#pragma unroll
                        for (int mi = 0; mi < 2; ++mi) s[mi][k4] = (f32x4){0.f, 0.f, 0.f, 0.f};
                        if (k4 == 0 || full) {
#pragma unroll
                            for (int ks = 0; ks < 3; ++ks)
#pragma unroll
                                for (int mi = 0; mi < 2; ++mi) s[mi][k4] = __builtin_amdgcn_mfma_f32_16x16x32_bf16(kf[kk][ks], qf[mi][ks], s[mi][k4], 0, 0, 0);
                        }
                    }
                }
                u32x2 vlo[4], vhi[4];
#pragma unroll
                for (int dt = 0; dt < 4; ++dt) { const unsigned char* vp = sV + (16 * dt + r) * VROW + (4 * q) * 2;
                    vlo[dt] = *(const u32x2*)vp; vhi[dt] = (u32x2){0u, 0u}; if (full) vhi[dt] = *(const u32x2*)(vp + 32); }
                bf16x8 pf[2][2];
#pragma unroll
                for (int mi = 0; mi < 2; ++mi) {
                    float mx = fmaxf(fmaxf(s[mi][0].x, s[mi][0].y), fmaxf(s[mi][0].z, s[mi][0].w));
                    if (full) {
#pragma unroll
                        for (int k4 = 1; k4 < 4; ++k4) mx = fmaxf(mx, fmaxf(fmaxf(s[mi][k4].x, s[mi][k4].y), fmaxf(s[mi][k4].z, s[mi][k4].w)));
                    }
                    mx = quad_max(mx);
                    const float mn = fmaxf(m[mi], mx), alpha = fast_exp2(m[mi] - mn); m[mi] = mn;
                    float ps = 0.f;
#pragma unroll
                    for (int k4 = 0; k4 < 4; ++k4) {
                        if (k4 == 0 || full) { f32x4 p; p.x = fast_exp2(s[mi][k4].x - mn); p.y = fast_exp2(s[mi][k4].y - mn); p.z = fast_exp2(s[mi][k4].z - mn); p.w = fast_exp2(s[mi][k4].w - mn);
                            ps += (p.x + p.y) + (p.z + p.w); s[mi][k4] = p; }
                    }
                    lsum[mi] = lsum[mi] * alpha + ps;
#pragma unroll
                    for (int dt = 0; dt < 4; ++dt) o[mi][dt] = o[mi][dt] * alpha;
#pragma unroll
                    for (int st = 0; st < 2; ++st) { u32x4 pw;
                        pw.x = pk2(s[mi][2 * st].x, s[mi][2 * st].y); pw.y = pk2(s[mi][2 * st].z, s[mi][2 * st].w); pw.z = pk2(s[mi][2 * st + 1].x, s[mi][2 * st + 1].y); pw.w = pk2(s[mi][2 * st + 1].z, s[mi][2 * st + 1].w);
                        if (!full) { pw.z = 0u; pw.w = 0u; }
                        pf[mi][st] = __builtin_bit_cast(bf16x8, pw); }
                }
                u32x2 wlo[4], whi[4];
                if (full) {
#pragma unroll
                    for (int dt = 0; dt < 4; ++dt) { const unsigned char* vp = sV + (16 * dt + r) * VROW + (32 + 4 * q) * 2; wlo[dt] = *(const u32x2*)vp; whi[dt] = *(const u32x2*)(vp + 32); } }
#pragma unroll
                for (int dt = 0; dt < 4; ++dt) { const bf16x8 vf = __builtin_bit_cast(bf16x8, (u32x4){vlo[dt].x, vlo[dt].y, vhi[dt].x, vhi[dt].y});
#pragma unroll
                    for (int mi = 0; mi < 2; ++mi) o[mi][dt] = __builtin_amdgcn_mfma_f32_16x16x32_bf16(vf, pf[mi][0], o[mi][dt], 0, 0, 0); }
                if (full) {
#pragma unroll
                    for (int dt = 0; dt < 4; ++dt) { const bf16x8 vf = __builtin_bit_cast(bf16x8, (u32x4){wlo[dt].x, wlo[dt].y, whi[dt].x, whi[dt].y});
#pragma unroll
                        for (int mi = 0; mi < 2; ++mi) o[mi][dt] = __builtin_amdgcn_mfma_f32_16x16x32_bf16(vf, pf[mi][1], o[mi][dt], 0, 0, 0); } }
            }
            if (kt + 1 < ntiles) lstore(cur ^ 1);
            __syncthreads();
        }
#pragma unroll
        for (int mi = 0; mi < 2; ++mi) {
            const float lt = quad_sum(lsum[mi]);
            if (!meta || (wave == 0 && mi == 0)) {
                const float inv = 1.0f / lt;
                bf16* dst = O + ((size_t)b * L + r0 + 32 * wave + 16 * mi + r) * 512 + h * VD;
#pragma unroll
                for (int dt = 0; dt < 4; ++dt) { const f32x4 v = o[mi][dt] * inv; u32x2 ov; ov.x = pk2(v.x, v.y); ov.y = pk2(v.z, v.w); *(u32x2*)(dst + 16 * dt + 4 * q) = ov; }
            }
        }
    }
}

__device__ __forceinline__ int tile_tok0(int mt, int l) { return l == 1 ? mt * 128 + NMETA * ((mt >> 4) + 1) : mt * 128; }
__device__ __forceinline__ int n_mtiles(int l) { return l == 1 ? 128 : MT; }
__device__ __forceinline__ void phase_D(const Ctx& c0, int l) {
    Ctx c = reopaque(c0);
    const bf16* u2 = WSP(bf16, WS_U2); const bf16* O = WSP(bf16, WS_O); const bf16* gates = WSP(bf16, WS_GATES); bf16* merged = WSP(bf16, WS_MERGED);
    const bf16* Wco = (const bf16*)(c.ws + WS_WIN + l * SZ_WLAYER + OFF_WCO); const bf16* Wmla = (const bf16*)(c.ws + WS_WIN + l * SZ_WLAYER + OFF_WMLA);
    const int r = c.lane & 15, q = c.lane >> 4;
    for (int it = c.vb; it < n_mtiles(l) * 8; it += c.G) {
        const int mt = it / 8, nt = it % 8, tk0 = tile_tok0(mt, l);
        f32x4 acc[2][8]; acc_zero(acc);
        gemm_core(acc, u2 + (size_t)tk0 * 512, 512, Wco + (size_t)nt * 128 * 512, 512, 512, c.lds, c.tid);
#pragma unroll
        for (int mi = 0; mi < 2; ++mi) { const int tok = tk0 + 32 * c.wave + 16 * mi + r;
            const bf16* gp = gates + (size_t)tok * 2048 + nt * 128 + 4 * q; bf16* mp = merged + (size_t)tok * D + nt * 128 + 4 * q;
#pragma unroll
            for (int ni = 0; ni < 8; ++ni) { const u32x2 g = *(const u32x2*)(gp + 16 * ni); const f32x4 v = acc[mi][ni];
                u32x2 o; o.x = pk2(v.x * bf_lo(g.x), v.y * bf_hi(g.x)); o.y = pk2(v.z * bf_lo(g.y), v.w * bf_hi(g.y)); *(u32x2*)(mp + 16 * ni) = o; } }
        acc_zero(acc);
        gemm_core(acc, O + (size_t)tk0 * 512, 512, Wmla + (size_t)nt * 128 * 512, 512, 512, c.lds, c.tid);
#pragma unroll
        for (int mi = 0; mi < 2; ++mi) { const int tok = tk0 + 32 * c.wave + 16 * mi + r;
            const bf16* gp = gates + (size_t)tok * 2048 + 1024 + nt * 128 + 4 * q; bf16* mp = merged + (size_t)tok * D + nt * 128 + 4 * q;
#pragma unroll
            for (int ni = 0; ni < 8; ++ni) { const u32x2 g = *(const u32x2*)(gp + 16 * ni); const u32x2 s = *(const u32x2*)(mp + 16 * ni); const f32x4 v = acc[mi][ni];
                u32x2 o; o.x = pk2(bf_lo(s.x) + v.x * bf_lo(g.x), bf_hi(s.x) + v.y * bf_hi(g.x)); o.y = pk2(bf_lo(s.y) + v.z * bf_lo(g.y), bf_hi(s.y) + v.w * bf_hi(g.y));
                *(u32x2*)(mp + 16 * ni) = o; } }
    }
}

__device__ __forceinline__ void phase_E(const Ctx& c0, int l) {
    Ctx c = reopaque(c0);
    const bf16* merged = WSP(bf16, WS_MERGED); const bf16* Wout = (const bf16*)(c.ws + WS_WIN + l * SZ_WLAYER + OFF_WOUT);
    float* h = WSP(float, WS_H); bf16* hb = WSP(bf16, WS_HB); float* ssq = WSP(float, WS_SSQ);
    const int r = c.lane & 15, q = c.lane >> 4;
    for (int it = c.vb; it < n_mtiles(l) * 8; it += c.G) {
        const int mt = it / 8, nt = it % 8, tk0 = tile_tok0(mt, l);
        f32x4 acc[2][8];
#pragma unroll
        for (int mi = 0; mi < 2; ++mi) { const int tok = tk0 + 32 * c.wave + 16 * mi + r; const float* hp = h + (size_t)tok * D;
            if (l == 0) { const int b = tok / L, pos = tok - b * L; hp = pos < NMETA ? c.in[1] + (size_t)pos * D : c.in[0] + ((size_t)b * SEQ + (pos - NMETA)) * D; }
            hp += nt * 128 + 4 * q;
#pragma unroll
            for (int ni = 0; ni < 8; ++ni) acc[mi][ni] = *(const f32x4*)(hp + 16 * ni); }
        gemm_core(acc, merged + (size_t)tk0 * D, D, Wout + (size_t)nt * 128 * D, D, D, c.lds, c.tid);
#pragma unroll
        for (int mi = 0; mi < 2; ++mi) { const int tok = tk0 + 32 * c.wave + 16 * mi + r; float ss = 0.f;
#pragma unroll
            for (int ni = 0; ni < 8; ++ni) { float* hp = h + (size_t)tok * D + nt * 128 + 16 * ni + 4 * q; const f32x4 v = acc[mi][ni]; *(f32x4*)hp = v;
                ss += (v.x * v.x + v.y * v.y) + (v.z * v.z + v.w * v.w);
                u32x2 o; o.x = pk2(v.x, v.y); o.y = pk2(v.z, v.w); *(u32x2*)(hb + (size_t)tok * D + nt * 128 + 16 * ni + 4 * q) = o; }
            ss = quad_sum(ss);
            if (q == 0) ssq[(size_t)tok * 8 + nt] = ss; }
    }
}

__device__ __forceinline__ unsigned f2key(float f) { const unsigned u = __float_as_uint(f); return u ^ ((u >> 31) ? 0xFFFFFFFFu : 0x80000000u); }
__device__ __forceinline__ float key2f(unsigned k) { const unsigned u = (k >> 31) ? (k ^ 0x80000000u) : ~k; return __uint_as_float(u); }
__device__ __forceinline__ void top16_insert(unsigned (&lst)[16], unsigned x) {
#pragma unroll
    for (int i = 0; i < 16; ++i) { const unsigned a = lst[i]; lst[i] = a > x ? a : x; x = a > x ? x : a; }
}
__device__ __forceinline__ void ce_desc(unsigned& a, unsigned& b) { const unsigned mx = a > b ? a : b, mn = a > b ? b : a; a = mx; b = mn; }
__device__ __forceinline__ void sort16_desc(unsigned (&v)[16]) {
#pragma unroll
    for (int k = 2; k <= 16; k <<= 1)
#pragma unroll
        for (int j = k >> 1; j > 0; j >>= 1)
#pragma unroll
            for (int i = 0; i < 16; ++i) { const int p = i ^ j; if (p > i) { if ((i & k) == 0) ce_desc(v[i], v[p]); else ce_desc(v[p], v[i]); } }
}
__device__ __forceinline__ void merge_top16(unsigned (&a)[16], const unsigned (&b)[16]) {
#pragma unroll
    for (int i = 0; i < 16; ++i) a[i] = a[i] > b[15 - i] ? a[i] : b[15 - i];
#pragma unroll
    for (int j = 8; j > 0; j >>= 1)
#pragma unroll
        for (int i = 0; i < 16; ++i) { const int p = i ^ j; if (p > i) ce_desc(a[i], a[p]); }
}
__device__ __forceinline__ void phase_F(const Ctx& c0, int l) {
    Ctx c = reopaque(c0);
    const bf16* hb = WSP(bf16, WS_HB); const bf16* Wpq = (const bf16*)(c.ws + WS_WIN + l * SZ_WLAYER + OFF_WPQ); const bf16* keys = (const bf16*)(c.ws + WS_WIN + l * SZ_WLAYER + OFF_KEYS);
    const float* ssq = WSP(float, WS_SSQ); float* sv = WSP(float, WS_SV); unsigned char* si = WSP(unsigned char, WS_SI);
    const int tid = c.tid, wave = c.wave, lane = c.lane, r = lane & 15, q = lane >> 4;
    unsigned char* lds = c.lds;
    const int xcd = c.vb / (c.G / 8), lb = c.vb % (c.G / 8), xm = xcd & 1, xn = xcd >> 1, nmt = n_mtiles(l);
    const int m_lo = xm ? (nmt + 1) / 2 : 0, m_cnt = xm ? nmt / 2 : (nmt + 1) / 2;
    for (int j = lb; j < m_cnt * 4; j += c.G / 8) {
        const int mt = m_lo + j / 4, hp = xn * 4 + j % 4, tk0 = tile_tok0(mt, l);
        f32x4 acc[2][8]; acc_zero(acc);
        u32x4 kreg[2][4]; float rsv[2];
        { const int chunk = tid & 7, row0 = tid >> 3; const bf16* pb = keys + ((size_t)hp * 128 + row0) * 128 + chunk * 8;
#pragma unroll
          for (int s = 0; s < 2; ++s)
#pragma unroll
              for (int i = 0; i < 4; ++i) kreg[s][i] = *(const u32x4*)(pb + (size_t)(32 * i) * 128 + s * 64); }
#pragma unroll
        for (int mi = 0; mi < 2; ++mi) rsv[mi] = rstd_from_ssq8(ssq, tk0 + 32 * wave + 16 * mi + r);
        gemm_core(acc, hb + (size_t)tk0 * D, D, Wpq + (size_t)hp * 128 * D, D, D, lds, tid);
#pragma unroll
        for (int mi = 0; mi < 2; ++mi) { const int row = 32 * wave + 16 * mi + r; const float rs = rsv[mi];
#pragma unroll
            for (int ni = 0; ni < 8; ++ni) { const f32x4 v = acc[mi][ni] * rs; u32x2 o; o.x = pk2(v.x, v.y); o.y = pk2(v.z, v.w);
                *(u32x2*)(lds + (ni >> 2) * 32768 + lds_off(row, 2 * (ni & 3) + (q >> 1)) + 8 * (q & 1)) = o; } }
        { const int chunk = tid & 7, row0 = tid >> 3;
#pragma unroll
          for (int s = 0; s < 2; ++s)
#pragma unroll
              for (int i = 0; i < 4; ++i) *(u32x4*)(lds + s * 32768 + 16384 + lds_off(row0 + 32 * i, chunk)) = kreg[s][i]; }
        __syncthreads();
        acc_zero(acc);
        gemm_compute_stage(acc, lds, lds + 16384, wave, lane);
        gemm_compute_stage(acc, lds + 32768, lds + 32768 + 16384, wave, lane);
        __syncthreads();
        float* S = (float*)lds;
#pragma unroll
        for (int mi = 0; mi < 2; ++mi) { const int row = 32 * wave + 16 * mi + r;
#pragma unroll
            for (int ni = 0; ni < 8; ++ni) *(f32x4*)(S + row * 132 + 16 * ni + 4 * q) = acc[mi][ni]; }
        __syncthreads();
        {
            const int tl = 32 * wave + (lane & 31), half = lane >> 5;
            const float* row = S + tl * 132;
            unsigned lst[16];
#pragma unroll
            for (int g = 0; g < 4; ++g) {
                unsigned cur[16];
#pragma unroll
                for (int j = 0; j < 4; ++j) { const int col = 64 * half + 16 * g + 4 * j; const f32x4 v = *(const f32x4*)(row + col);
                    cur[4 * j] = (f2key(v.x) & ~127u) | (unsigned)(127 - col); cur[4 * j + 1] = (f2key(v.y) & ~127u) | (unsigned)(127 - (col + 1));
                    cur[4 * j + 2] = (f2key(v.z) & ~127u) | (unsigned)(127 - (col + 2)); cur[4 * j + 3] = (f2key(v.w) & ~127u) | (unsigned)(127 - (col + 3)); }
                sort16_desc(cur);
                if (g == 0) {
#pragma unroll
                    for (int i = 0; i < 16; ++i) lst[i] = cur[i];
                } else merge_top16(lst, cur);
            }
            unsigned oth[16];
#pragma unroll
            for (int i = 0; i < 16; ++i) { auto rr = __builtin_amdgcn_permlane32_swap(lst[i], lst[i], false, false); oth[i] = half == 0 ? rr[1] : rr[0]; }
            merge_top16(lst, oth);
            if (half == 0) {
                const int tok = tk0 + tl;
                unsigned idx[16]; float val[16];
#pragma unroll
                for (int i = 0; i < 16; ++i) { idx[i] = 127u - (lst[i] & 127u); val[i] = row[idx[i]]; }
                float* svp = sv + ((size_t)tok * 16 + hp) * 16;
#pragma unroll
                for (int i = 0; i < 4; ++i) *(f32x4*)(svp + 4 * i) = (f32x4){val[4 * i], val[4 * i + 1], val[4 * i + 2], val[4 * i + 3]};
                u32x4 pi;
                pi.x = idx[0] | (idx[1] << 8) | (idx[2] << 16) | (idx[3] << 24); pi.y = idx[4] | (idx[5] << 8) | (idx[6] << 16) | (idx[7] << 24);
                pi.z = idx[8] | (idx[9] << 8) | (idx[10] << 16) | (idx[11] << 24); pi.w = idx[12] | (idx[13] << 8) | (idx[14] << 16) | (idx[15] << 24);
                *(u32x4*)(si + ((size_t)tok * 16 + hp) * 16) = pi;
            }
        }
        __syncthreads();
    }
}

__device__ __forceinline__ void phase_F3(const Ctx& c0, int l) {
    Ctx c = reopaque(c0);
    const float* sv = WSP(float, WS_SV); const unsigned char* si = WSP(unsigned char, WS_SI); int* eidx = WSP(int, WS_EIDX); float* gw = WSP(float, WS_GW); unsigned char* stb = WSP(unsigned char, WS_STB);
    float* lsv = (float*)c.lds;
    unsigned char* lsi = c.lds + 256 * 33 * 4;
    const int tid = c.tid;
    const int ntok = l == 1 ? NB * SEQ : T;
    for (int base = c.vb * NTHREADS; base < ntok * 8; base += c.G * NTHREADS) {
        const int thc = base + tid, tkc = thc >> 3;
        const int th = (l == 1 ? tkc + NMETA * ((tkc >> 11) + 1) : tkc) * 8 + (thc & 7);
        float a[16], b[16];
#pragma unroll
        for (int i = 0; i < 4; ++i) { const f32x4 x = *(const f32x4*)(sv + (size_t)th * 32 + 4 * i), y = *(const f32x4*)(sv + (size_t)th * 32 + 16 + 4 * i);
            a[4 * i] = x.x; a[4 * i + 1] = x.y; a[4 * i + 2] = x.z; a[4 * i + 3] = x.w; b[4 * i] = y.x; b[4 * i + 1] = y.y; b[4 * i + 2] = y.z; b[4 * i + 3] = y.w; }
        const u32x4 ia = *(const u32x4*)(si + (size_t)th * 32), ib = *(const u32x4*)(si + (size_t)th * 32 + 16);
#pragma unroll
        for (int i = 0; i < 16; ++i) { lsv[tid * 33 + i] = a[i]; lsv[tid * 33 + 16 + i] = b[i]; }
        *(u32x4*)(lsi + tid * 32) = ia; *(u32x4*)(lsi + tid * 32 + 16) = ib;
        unsigned lst[16], g2[16], g3[16], g4[16];
#pragma unroll
        for (int j = 0; j < 16; ++j) lst[j] = (f2key(a[0] + b[j]) & ~255u) | (unsigned)(255 - j);
#pragma unroll
        for (int i = 1; i < 16; ++i) g2[i - 1] = (f2key(a[i] + b[0]) & ~255u) | (unsigned)(255 - i * 16);
        g2[15] = 0u;
        { int n = 0;
#pragma unroll
          for (int i = 1; i < 16; ++i)
#pragma unroll
              for (int j = 1; j < 16; ++j)
                  if ((i + 1) * (j + 1) <= 16) { const unsigned key = (f2key(a[i] + b[j]) & ~255u) | (unsigned)(255 - (i * 16 + j)); if (n < 16) g3[n] = key; else g4[n - 16] = key; ++n; }
#pragma unroll
          for (int k = 3; k < 16; ++k) g4[k] = 0u; }
        sort16_desc(g3); sort16_desc(g4);
        merge_top16(lst, g2); merge_top16(g3, g4); merge_top16(lst, g3);
        __builtin_amdgcn_s_waitcnt(0xC07F); asm volatile("" ::: "memory");
        float s[16]; int e[16];
#pragma unroll
        for (int k = 0; k < 16; ++k) { const unsigned code = 255u - (lst[k] & 255u); const int i = code >> 4, j = code & 15;
            s[k] = lsv[tid * 33 + i] + lsv[tid * 33 + 16 + j]; e[k] = (int)lsi[tid * 32 + i] * 128 + (int)lsi[tid * 32 + 16 + j]; }
        float mx = s[0];
#pragma unroll
        for (int k = 1; k < 16; ++k) mx = fmaxf(mx, s[k]);
        float sum = 0.f;
#pragma unroll
        for (int k = 0; k < 16; ++k) { s[k] = fast_exp2((s[k] - mx) * 1.4426950409f); sum += s[k]; }
        const float inv = 1.0f / sum;
        typedef unsigned long long u64;
        u64 hlo = 0ull, hhi = 0ull;
#pragma unroll
        for (int k = 0; k < 16; ++k) { const int sl = e[k] >> 10; if (sl < 8) hlo += 1ull << (8 * sl); else hhi += 1ull << (8 * (sl - 8)); }
        u64 ilo = hlo, ihi = hhi;
#pragma unroll
        for (int d = 1; d < 8; d <<= 1) { const u64 a_ = __shfl_up(ilo, d, 8), b_ = __shfl_up(ihi, d, 8); if ((tid & 7) >= d) { ilo += a_; ihi += b_; } }
        const u64 tlo = __shfl(ilo, 7, 8), thi = __shfl(ihi, 7, 8);
        const u64 ones = 0x0101010101010101ull;
        const u64 inlo = tlo * ones, inhi = thi * ones + (inlo >> 56) * ones;
        const u64 stlo = inlo - tlo, sthi = inhi - thi;
        u64 rlo = stlo + (ilo - hlo), rhi = sthi + (ihi - hhi);
        const int tokn = th >> 3;
#pragma unroll
        for (int k = 0; k < 16; ++k) { const int sl = e[k] >> 10; int pos;
            if (sl < 8) { pos = (int)((rlo >> (8 * sl)) & 255ull); rlo += 1ull << (8 * sl); } else { pos = (int)((rhi >> (8 * (sl - 8))) & 255ull); rhi += 1ull << (8 * (sl - 8)); }
            eidx[(size_t)tokn * 128 + pos] = e[k]; gw[(size_t)tokn * 128 + pos] = s[k] * inv; }
        if ((tid & 7) == 0) { u64* sp = (u64*)(stb + (size_t)tokn * 16); sp[0] = stlo; sp[1] = sthi; }
        __builtin_amdgcn_s_waitcnt(0xC07F); asm volatile("" ::: "memory");
    }
}

typedef float f32x2 __attribute__((ext_vector_type(2)));
constexpr int G2_WSTRIDE = 14336, G2_MAXTOK = 9;
__device__ __forceinline__ float fp8dot4(unsigned w, unsigned x01, unsigned x23, float acc) {
    const bf16x2 lo = __builtin_amdgcn_cvt_scalef32_pk_bf16_fp8(w, 1.0f, false), hi = __builtin_amdgcn_cvt_scalef32_pk_bf16_fp8(w, 1.0f, true);
    acc = __builtin_amdgcn_fdot2_f32_bf16(lo, __builtin_bit_cast(bf16x2, x01), acc, false);
    return __builtin_amdgcn_fdot2_f32_bf16(hi, __builtin_bit_cast(bf16x2, x23), acc, false);
}
__device__ __forceinline__ float reduce8_transposed(const float (&p)[8], int lane) {
    float s[4];
#pragma unroll
    for (int k = 0; k < 4; ++k) { auto r = __builtin_amdgcn_permlane32_swap(__float_as_uint(p[k]), __float_as_uint(p[k + 4]), false, false); s[k] = __uint_as_float(r[0]) + __uint_as_float(r[1]); }
    float t[2];
#pragma unroll
    for (int k = 0; k < 2; ++k) { auto r = __builtin_amdgcn_permlane16_swap(__float_as_uint(s[k]), __float_as_uint(s[k + 2]), false, false); t[k] = __uint_as_float(r[0]) + __uint_as_float(r[1]); }
    const float u0 = t[0] + dpp<0x128>(t[0]), u1 = t[1] + dpp<0x128>(t[1]);
    float r = (lane & 8) ? u1 : u0;
    r += dpp<0xB1>(r); r += dpp<0x4E>(r); r += dpp<0x141>(r);
    return r;
}
typedef int i32x4 __attribute__((ext_vector_type(4)));
__device__ __forceinline__ void fp4fma8(f32x2 (&acc)[8], int o, unsigned w, f32x2 a2) {
    acc[o] = __builtin_elementwise_fma(a2, __builtin_amdgcn_cvt_scalef32_pk_f32_fp4(w, 1.0f, 0), acc[o]);
    acc[o + 1] = __builtin_elementwise_fma(a2, __builtin_amdgcn_cvt_scalef32_pk_f32_fp4(w, 1.0f, 1), acc[o + 1]);
    acc[o + 2] = __builtin_elementwise_fma(a2, __builtin_amdgcn_cvt_scalef32_pk_f32_fp4(w, 1.0f, 2), acc[o + 2]);
    acc[o + 3] = __builtin_elementwise_fma(a2, __builtin_amdgcn_cvt_scalef32_pk_f32_fp4(w, 1.0f, 3), acc[o + 3]);
}
__device__ __forceinline__ void g2_u_chunk(u32x4 (&u)[8], const unsigned char* U, const int* pe_next, const float* pw_c, float* act_c, const u32x4 xq, float rs, int lane) {
    const i32x4 e0 = *(const i32x4*)pe_next, e1 = *(const i32x4*)(pe_next + 4);
    const int en[8] = {e0.x, e0.y, e0.z, e0.w, e1.x, e1.y, e1.z, e1.w};
    float p[8];
#pragma unroll
    for (int k = 0; k < 8; k += 2) {
        int d0 = __builtin_amdgcn_sdot4((int)u[k].x, (int)xq.x, 0, false), d1 = __builtin_amdgcn_sdot4((int)u[k + 1].x, (int)xq.x, 0, false);
        d0 = __builtin_amdgcn_sdot4((int)u[k].y, (int)xq.y, d0, false); d1 = __builtin_amdgcn_sdot4((int)u[k + 1].y, (int)xq.y, d1, false);
        d0 = __builtin_amdgcn_sdot4((int)u[k].z, (int)xq.z, d0, false); d1 = __builtin_amdgcn_sdot4((int)u[k + 1].z, (int)xq.z, d1, false);
        d0 = __builtin_amdgcn_sdot4((int)u[k].w, (int)xq.w, d0, false); d1 = __builtin_amdgcn_sdot4((int)u[k + 1].w, (int)xq.w, d1, false);
        p[k] = (float)d0; p[k + 1] = (float)d1;
        asm volatile("" : "+v"(p[k]), "+v"(p[k + 1]));
        u[k] = *(const u32x4*)(U + (size_t)__builtin_amdgcn_readfirstlane(en[k]) * 1024 + lane * 16);
        u[k + 1] = *(const u32x4*)(U + (size_t)__builtin_amdgcn_readfirstlane(en[k + 1]) * 1024 + lane * 16);
    }
    const float a = reduce8_transposed(p, lane);
    const int row = (lane >> 3) & 7;
    if ((lane & 7) == 0) act_c[row] = gelu_tanh(a * rs) * pw_c[row];
}
__device__ __forceinline__ void g2_v_chunk(u32x2 (&v)[8], const unsigned char* V, const int* pe_next, const float* act_c, f32x2 (&acc)[8], int lane) {
    const i32x4 e0 = *(const i32x4*)pe_next, e1 = *(const i32x4*)(pe_next + 4);
    const int en[8] = {e0.x, e0.y, e0.z, e0.w, e1.x, e1.y, e1.z, e1.w};
    const f32x4 a0 = *(const f32x4*)act_c, a1 = *(const f32x4*)(act_c + 4);
    const float av[8] = {a0.x, a0.y, a0.z, a0.w, a1.x, a1.y, a1.z, a1.w};
#pragma unroll
    for (int k = 0; k < 8; k += 2) {
        const f32x2 a2 = (f32x2){av[k], av[k]}, b2 = (f32x2){av[k + 1], av[k + 1]};
        fp4fma8(acc, 0, v[k].x, a2); fp4fma8(acc, 4, v[k].y, a2);
        fp4fma8(acc, 0, v[k + 1].x, b2); fp4fma8(acc, 4, v[k + 1].y, b2);
        asm volatile("" : "+v"(acc[0]), "+v"(acc[1]), "+v"(acc[2]), "+v"(acc[3]), "+v"(acc[4]), "+v"(acc[5]), "+v"(acc[6]), "+v"(acc[7]));
        v[k] = *(const u32x2*)(V + (size_t)__builtin_amdgcn_readfirstlane(en[k]) * 512 + lane * 8);
        v[k + 1] = *(const u32x2*)(V + (size_t)__builtin_amdgcn_readfirstlane(en[k + 1]) * 512 + lane * 8);
    }
}
__device__ __forceinline__ void g2_finish_token(Ctx& c, int l, int tok, const f32x2 (&acc)[8], int lane) {
    float* h = WSP(float, WS_H); bf16* hbw = WSP(bf16, WS_HB); float* ssqw = WSP(float, WS_SSQ);
    float* hp = h + (size_t)tok * D + lane * 16;
    f32x4 r0 = *(const f32x4*)hp, r1 = *(const f32x4*)(hp + 4), r2 = *(const f32x4*)(hp + 8), r3 = *(const f32x4*)(hp + 12);
    r0 += (f32x4){acc[0].x, acc[0].y, acc[1].x, acc[1].y}; r1 += (f32x4){acc[2].x, acc[2].y, acc[3].x, acc[3].y};
    r2 += (f32x4){acc[4].x, acc[4].y, acc[5].x, acc[5].y}; r3 += (f32x4){acc[6].x, acc[6].y, acc[7].x, acc[7].y};
    if (l == 0) {
        *(f32x4*)hp = r0; *(f32x4*)(hp + 4) = r1; *(f32x4*)(hp + 8) = r2; *(f32x4*)(hp + 12) = r3;
        u32x4 o0, o1; o0.x = pk2(r0.x, r0.y); o0.y = pk2(r0.z, r0.w); o0.z = pk2(r1.x, r1.y); o0.w = pk2(r1.z, r1.w);
        o1.x = pk2(r2.x, r2.y); o1.y = pk2(r2.z, r2.w); o1.z = pk2(r3.x, r3.y); o1.w = pk2(r3.z, r3.w);
        *(u32x4*)(hbw + (size_t)tok * D + lane * 16) = o0; *(u32x4*)(hbw + (size_t)tok * D + lane * 16 + 8) = o1;
        float ss = (r0.x * r0.x + r0.y * r0.y) + (r0.z * r0.z + r0.w * r0.w) + (r1.x * r1.x + r1.y * r1.y) + (r1.z * r1.z + r1.w * r1.w)
                 + (r2.x * r2.x + r2.y * r2.y) + (r2.z * r2.z + r2.w * r2.w) + (r3.x * r3.x + r3.y * r3.y) + (r3.z * r3.z + r3.w * r3.w);
        ss = wave_sum_dpp(ss);
        if (lane < 8) ssqw[(size_t)tok * 8 + lane] = lane == 0 ? ss : 0.f;
    } else {
        const int b = tok / L, pos = tok - b * L;
        if (pos >= NMETA) { float* op = c.out + ((size_t)b * SEQ + (pos - NMETA)) * D + lane * 16;
            *(f32x4*)op = r0; *(f32x4*)(op + 4) = r1; *(f32x4*)(op + 8) = r2; *(f32x4*)(op + 12) = r3; }
    }
}
__device__ __forceinline__ void phase_G2(const Ctx& c0, int l) {
    Ctx c = reopaque(c0);
    const bf16* hb = WSP(bf16, WS_HB); const float* ssq = WSP(float, WS_SSQ); const int* pe = WSP(int, WS_EIDX); const float* pw = WSP(float, WS_GW);
    const unsigned char* U = c.ws + WS_TAB + (size_t)(l * 2) * SZ_TAB; const unsigned char* V = c.ws + WS_TAB + (size_t)(l * 2 + 1) * SZ_TAB;
    const int lane = c.lane, wave = c.wave;
    const int gw = c.vb * 4 + wave, t0 = l == 1 ? gw * 8 + NMETA * ((gw >> 8) + 1) : gw * 8;
    const bool has_x = l == 0 && (c.vb & 3) == 0; const int tx = T - 128 + (c.vb >> 2);
    unsigned char* wl = c.lds + wave * G2_WSTRIDE;
    int* pe_l = (int*)wl; float* pw_l = (float*)(wl + 4608); float* act_l = (float*)(wl + 9216);
#pragma unroll
    for (int j = 0; j < G2_MAXTOK; ++j) { const int tok = j < 8 ? t0 + j : (has_x ? tx : t0);
        pe_l[j * 128 + lane] = pe[(size_t)tok * 128 + lane]; pe_l[j * 128 + 64 + lane] = pe[(size_t)tok * 128 + 64 + lane];
        pw_l[j * 128 + lane] = pw[(size_t)tok * 128 + lane] * TAB_INV; pw_l[j * 128 + 64 + lane] = pw[(size_t)tok * 128 + 64 + lane] * TAB_INV; }
    const int xlo = has_x ? 4 * wave : 16, xhi = has_x ? 4 * wave + 4 : 16;
    {
        u32x4 xq[G2_MAXTOK]; float rs[G2_MAXTOK];
#pragma unroll
        for (int j = 0; j < G2_MAXTOK; ++j) { const int tok = j < 8 ? t0 + j : (has_x ? tx : t0);
            const u32x4 lo = *(const u32x4*)(hb + (size_t)tok * D + lane * 16), hi = *(const u32x4*)(hb + (size_t)tok * D + lane * 16 + 8);
            const f32x4 f0 = (f32x4){bf_lo(lo.x), bf_hi(lo.x), bf_lo(lo.y), bf_hi(lo.y)}, f1 = (f32x4){bf_lo(lo.z), bf_hi(lo.z), bf_lo(lo.w), bf_hi(lo.w)};
            const f32x4 f2 = (f32x4){bf_lo(hi.x), bf_hi(hi.x), bf_lo(hi.y), bf_hi(hi.y)}, f3 = (f32x4){bf_lo(hi.z), bf_hi(hi.z), bf_lo(hi.w), bf_hi(hi.w)};
            float mx = 1e-20f;
#pragma unroll
            for (int i = 0; i < 4; ++i) mx = fmaxf(mx, fmaxf(fmaxf(fabsf(f0[i]), fabsf(f1[i])), fmaxf(fabsf(f2[i]), fabsf(f3[i]))));
            mx = fmaxf(mx, dpp<0xB1>(mx)); mx = fmaxf(mx, dpp<0x4E>(mx)); mx = fmaxf(mx, dpp<0x141>(mx)); mx = fmaxf(mx, dpp<0x128>(mx)); mx = xrow16_max(mx);
            const float sx = 127.0f / mx;
            xq[j].x = pack_i8x4(f0 * sx); xq[j].y = pack_i8x4(f1 * sx); xq[j].z = pack_i8x4(f2 * sx); xq[j].w = pack_i8x4(f3 * sx);
            rs[j] = rstd_from_ssq8(ssq, tok) * mx * (1.0f / (127.0f * U_SCALE)); }
        u32x4 u[8];
#pragma unroll
        for (int k = 0; k < 8; ++k) u[k] = *(const u32x4*)(U + (size_t)__builtin_amdgcn_readfirstlane(pe_l[k]) * 1024 + lane * 16);
#pragma unroll 1
        for (int ch = 0; ch < 16; ++ch) {
            const int cn = ch < 15 ? ch + 1 : 0;
            const bool x_here = ch >= xlo && ch < xhi;
#pragma unroll
            for (int j = 0; j < 8; ++j) {
                const int* pe_next = j < 7 ? pe_l + (j + 1) * 128 + ch * 8 : (x_here ? pe_l + 8 * 128 + ch * 8 : pe_l + cn * 8);
                g2_u_chunk(u, U, pe_next, pw_l + j * 128 + ch * 8, act_l + j * 128 + ch * 8, xq[j], rs[j], lane); }
            if (x_here) g2_u_chunk(u, U, pe_l + cn * 8, pw_l + 8 * 128 + ch * 8, act_l + 8 * 128 + ch * 8, xq[8], rs[8], lane);
        }
    }
    f32x2 acc[G2_MAXTOK][8];
#pragma unroll
    for (int j = 0; j < G2_MAXTOK; ++j)
#pragma unroll
        for (int i = 0; i < 8; ++i) acc[j][i] = (f32x2){0.f, 0.f};
    {
        u32x2 v[8];
#pragma unroll
        for (int k = 0; k < 8; ++k) v[k] = *(const u32x2*)(V + (size_t)__builtin_amdgcn_readfirstlane(pe_l[k]) * 512 + lane * 8);
#pragma unroll 1
        for (int ch = 0; ch < 16; ++ch) {
            const int cn = ch < 15 ? ch + 1 : 0;
            const bool x_here = ch >= xlo && ch < xhi;
#pragma unroll
            for (int j = 0; j < 8; ++j) {
                const int* pe_next = j < 7 ? pe_l + (j + 1) * 128 + ch * 8 : (x_here ? pe_l + 8 * 128 + ch * 8 : pe_l + cn * 8);
                g2_v_chunk(v, V, pe_next, act_l + j * 128 + ch * 8, acc[j], lane); }
            if (x_here) g2_v_chunk(v, V, pe_l + cn * 8, act_l + 8 * 128 + ch * 8, acc[8], lane);
        }
    }
#pragma unroll
    for (int j = 0; j < 8; ++j) g2_finish_token(c, l, t0 + j, acc[j], lane);
    __syncthreads();
    if (has_x) {
        f32x2* part = (f32x2*)(c.lds + wave * G2_WSTRIDE);
#pragma unroll
        for (int i = 0; i < 8; ++i) part[i * 64 + lane] = acc[8][i];
    }
    __syncthreads();
    if (has_x && wave == 0) {
        f32x2 tot[8];
#pragma unroll
        for (int i = 0; i < 8; ++i) { tot[i] = acc[8][i];
#pragma unroll
            for (int w = 1; w < 4; ++w) tot[i] += ((const f32x2*)(c.lds + w * G2_WSTRIDE))[i * 64 + lane]; }
        g2_finish_token(c, l, tx, tot, lane);
    }
    __syncthreads();
}

struct Args { const float* in[22]; float* out; unsigned char* ws; int ph_lo, ph_hi; };
constexpr int N_PHASES = 17;

__global__ void __launch_bounds__(NTHREADS, 2) fwd_kernel(Args args) {
    extern __shared__ __attribute__((aligned(16))) unsigned char lds_raw[];
    Ctx c;
#pragma unroll
    for (int i = 0; i < 22; ++i) c.in[i] = args.in[i];
    c.out = args.out; c.ws = args.ws; c.lds = lds_raw;
    c.tid = threadIdx.x; c.lane = c.tid & 63; c.wave = __builtin_amdgcn_readfirstlane(c.tid >> 6);
    c.G = gridDim.x; { const int bx = blockIdx.x; c.vb = (c.G % 8 == 0) ? (bx % 8) * (c.G / 8) + bx / 8 : bx; }
    volatile unsigned* misc = (volatile unsigned*)(c.lds + LDS_MISC);
    if (c.tid < 16) misc[c.tid] = 0u;
    __syncthreads();
    const int lo = args.ph_lo, hi = args.ph_hi;
    const bool multi = (hi - lo) > 1;
    XcdBarrier bar; bar.bar = WSP(unsigned, WS_CTL) + CW_BAR; bar.x = 0; bar.st = misc;
    if (multi) bar = xcd_barrier_post(WSP(unsigned, WS_CTL) + CW_BAR, misc);
#define IN_(k) (lo <= (k) && (k) < hi)
#define SEAM_(k) do { if ((k) + 1 < hi) xcd_barrier(bar); } while (0)
    if (IN_(0)) { phase_prologue(c); SEAM_(0); }
#pragma unroll 1
    for (int l = 0; l < 2; ++l) {
        const int p0 = 1 + 8 * l;
        if (IN_(p0 + 0)) { phase_A(c, l); SEAM_(p0 + 0); }
        if (IN_(p0 + 1)) { phase_B(c, l); SEAM_(p0 + 1); }
        if (IN_(p0 + 2)) { phase_C(c, l); SEAM_(p0 + 2); }
        if (IN_(p0 + 3)) { phase_D(c, l); SEAM_(p0 + 3); }
        if (IN_(p0 + 4)) { phase_E(c, l); SEAM_(p0 + 4); }
        if (IN_(p0 + 5)) { phase_F(c, l); SEAM_(p0 + 5); }
        if (IN_(p0 + 6)) { phase_F3(c, l); SEAM_(p0 + 6); }
        if (IN_(p0 + 7)) { phase_G2(c, l); SEAM_(p0 + 7); }
    }
}

extern "C" void kernel_launch(void* const* d_in, const int* in_sizes, int n_in, void* d_out, int out_size, void* d_ws, size_t ws_size, hipStream_t stream) {
    static int grid = 0;
    if (grid == 0) {
        if (n_in != 22 || out_size != NB * SEQ * D || ws_size < WS_END) { fprintf(stderr, "kernel_launch: unexpected shapes (n_in %d out %d ws %zu need %zu)\n", n_in, out_size, ws_size, (size_t)WS_END); grid = -1; return; }
        int dev = 0, cus = 0, per_cu = 0;
        hipGetDevice(&dev); hipDeviceGetAttribute(&cus, hipDeviceAttributeMultiprocessorCount, dev);
        if (hipFuncSetAttribute((const void*)fwd_kernel, hipFuncAttributeMaxDynamicSharedMemorySize, LDS_BYTES) != hipSuccess) { fprintf(stderr, "kernel_launch: hipFuncSetAttribute failed\n"); grid = -1; return; }
        if (hipOccupancyMaxActiveBlocksPerMultiprocessor(&per_cu, (const void*)fwd_kernel, NTHREADS, LDS_BYTES) != hipSuccess || per_cu < 1) { fprintf(stderr, "kernel_launch: occupancy query failed (%d)\n", per_cu); per_cu = 1; (void)hipGetLastError(); }
        if (per_cu > 2) per_cu = 2;
        grid = cus * per_cu;
        if (grid != 512) { fprintf(stderr, "kernel_launch: grid %d unsupported by phase G2 (needs 512 workgroups)\n", grid); grid = -1; return; }
        fprintf(stderr, "kernel_launch: grid %d (%d per CU), lds %d, ws need %zu have %zu\n", grid, per_cu, LDS_BYTES, (size_t)WS_END, ws_size);
    }
    if (grid < 0) return;
    hipMemsetAsync((char*)d_ws + WS_CTL, 0, CTL_BYTES, stream);
    Args a{};
    for (int i = 0; i < 22; ++i) a.in[i] = (const float*)d_in[i];
    a.out = (float*)d_out; a.ws = (unsigned char*)d_ws;
#if MK_PER_PHASE
    for (int ph = 0; ph < N_PHASES; ++ph) { a.ph_lo = ph; a.ph_hi = ph + 1; hipLaunchKernelGGL(fwd_kernel, dim3(grid), dim3(NTHREADS), LDS_BYTES, stream, a); }
#else
    a.ph_lo = 0; a.ph_hi = N_PHASES;
    void* kargs[] = {&a};
    hipError_t e = hipLaunchCooperativeKernel((const void*)fwd_kernel, dim3(grid), dim3(NTHREADS), kargs, LDS_BYTES, stream);
    if (e != hipSuccess) fprintf(stderr, "kernel_launch: cooperative launch failed: %s (grid %d)\n", hipGetErrorString(e), grid);
#endif
}
```

```cpp
#include <hip/hip_runtime.h>
#include <cstdio>
#include <cstdint>

#ifndef MK_PER_PHASE
#define MK_PER_PHASE 0
#endif

typedef unsigned short bf16;
typedef short bf16x8 __attribute__((ext_vector_type(8)));
typedef float f32x4 __attribute__((ext_vector_type(4)));
typedef unsigned u32x4 __attribute__((ext_vector_type(4)));
typedef unsigned u32x2 __attribute__((ext_vector_type(2)));
typedef __bf16 bf16x2 __attribute__((ext_vector_type(2)));

constexpr int NB = 8, SEQ = 2048, NMETA = 16, L = SEQ + NMETA, T = NB * L, D = 1024;
constexpr int DC = 512, CW = 31, NH = 8, QL = 256, KVL = 128, NOPE = 64, ROPE = 32, QK = 96, VD = 64;
constexpr int NIN = 3488, NINP = 3584;
constexpr int NEXP = 16384;
constexpr float EPS = 1e-6f;
constexpr int MT = T / 128;
static_assert(T % 128 == 0, "T tiles");

constexpr size_t al256(size_t x) { return (x + 255) & ~(size_t)255; }
constexpr size_t WS_CTL = 0;
constexpr size_t CTL_BYTES = 65536;
constexpr size_t WS_ROPE = WS_CTL + CTL_BYTES;
constexpr size_t WS_WIN = al256(WS_ROPE + (size_t)L * 16 * 8);
constexpr size_t SZ_WIN = (size_t)NINP * 1024 * 2, SZ_WCO = (size_t)1024 * 512 * 2, SZ_WUQ = (size_t)1024 * 256 * 2, SZ_WUKV = (size_t)1024 * 128 * 2,
                 SZ_WMLA = (size_t)1024 * 512 * 2, SZ_WOUT = (size_t)1024 * 1024 * 2, SZ_WPQ = (size_t)2048 * 1024 * 2, SZ_KEYS = (size_t)16 * 128 * 128 * 2;
constexpr size_t OFF_WCO = SZ_WIN, OFF_WUQ = OFF_WCO + SZ_WCO, OFF_WUKV = OFF_WUQ + SZ_WUQ, OFF_WMLA = OFF_WUKV + SZ_WUKV, OFF_WOUT = OFF_WMLA + SZ_WMLA,
                 OFF_WPQ = OFF_WOUT + SZ_WOUT, OFF_KEYS = OFF_WPQ + SZ_WPQ, SZ_WLAYER = OFF_KEYS + SZ_KEYS;
constexpr size_t WS_TAB = al256(WS_WIN + 2 * SZ_WLAYER);
constexpr size_t SZ_TAB = (size_t)NEXP * 1024;
constexpr float TAB_SCALE = 64.0f, TAB_INV = 1.0f / 64.0f;
constexpr float U_CLIP = 2.7f / 32.0f, U_SCALE = 7.0f / U_CLIP;
constexpr float X_SCALE = 7.0f / 2.7f;
constexpr size_t WS_H = al256(WS_TAB + 4 * SZ_TAB);
constexpr size_t WS_HB = al256(WS_H + (size_t)T * 1024 * 4);
constexpr size_t WS_SSQ = al256(WS_HB + (size_t)T * 1024 * 2);
constexpr size_t WS_UGLU = al256(WS_SSQ + (size_t)T * 8 * 4);
constexpr size_t WS_CQ = al256(WS_UGLU + (size_t)T * 512 * 2);
constexpr size_t WS_CKV = al256(WS_CQ + (size_t)T * 256 * 2);
constexpr size_t WS_KROPE = al256(WS_CKV + (size_t)T * 128 * 2);
constexpr size_t WS_SSQQ = al256(WS_KROPE + (size_t)T * 32 * 4);
constexpr size_t WS_SSQKV = al256(WS_SSQQ + (size_t)T * 2 * 4);
constexpr size_t WS_U2 = al256(WS_SSQKV + (size_t)T * 4);
constexpr size_t WS_Q = al256(WS_U2 + (size_t)T * 512 * 2);
constexpr size_t WS_K = al256(WS_Q + (size_t)T * NH * QK * 2);
constexpr size_t WS_VT = al256(WS_K + (size_t)T * NH * QK * 2);
constexpr size_t WS_O = al256(WS_VT + (size_t)T * NH * VD * 2 + 4096);
constexpr size_t WS_MERGED = al256(WS_O + (size_t)T * 512 * 2);
constexpr size_t WS_GATES = al256(WS_MERGED + (size_t)T * 1024 * 2);
constexpr size_t WS_SV = WS_GATES;
constexpr size_t WS_SI = al256(WS_SV + (size_t)T * 256 * 4);
constexpr size_t WS_EIDX = al256(WS_SI + (size_t)T * 256);
constexpr size_t WS_GW = al256(WS_EIDX + (size_t)T * 128 * 4);
constexpr size_t WS_STB = al256(WS_GW + (size_t)T * 128 * 4);
constexpr size_t WS_PEER_END = WS_STB + (size_t)T * 16;
constexpr size_t WS_END = al256(WS_GATES + (size_t)T * 2048 * 2);
static_assert(WS_PEER_END <= WS_END, "peer scratch overlay");

constexpr int CW_BAR = 0;
constexpr int CW_QUEUE = 4096;

constexpr int LDS_MAIN = 128 * 132 * 4;
constexpr int LDS_MISC = LDS_MAIN;
constexpr int LDS_BYTES = LDS_MAIN + 64;

constexpr int NTHREADS = 256;

__device__ __forceinline__ unsigned pk2(float lo, float hi) { bf16x2 v; v.x = (__bf16)lo; v.y = (__bf16)hi; return __builtin_bit_cast(unsigned, v); }
__device__ __forceinline__ unsigned pack_i8x4(f32x4 v) {
    const int a = (int)__builtin_rintf(fminf(fmaxf(v.x, -127.f), 127.f)), b = (int)__builtin_rintf(fminf(fmaxf(v.y, -127.f), 127.f));
    const int c_ = (int)__builtin_rintf(fminf(fmaxf(v.z, -127.f), 127.f)), d = (int)__builtin_rintf(fminf(fmaxf(v.w, -127.f), 127.f));
    return (unsigned)(a & 255) | ((unsigned)(b & 255) << 8) | ((unsigned)(c_ & 255) << 16) | ((unsigned)(d & 255) << 24);
}
__device__ __forceinline__ unsigned pack_i4x4(f32x4 v) {
    const int a = (int)__builtin_rintf(fminf(fmaxf(v.x, -7.f), 7.f)), b = (int)__builtin_rintf(fminf(fmaxf(v.y, -7.f), 7.f));
    const int c_ = (int)__builtin_rintf(fminf(fmaxf(v.z, -7.f), 7.f)), d = (int)__builtin_rintf(fminf(fmaxf(v.w, -7.f), 7.f));
    return (unsigned)(a & 15) | ((unsigned)(b & 15) << 4) | ((unsigned)(c_ & 15) << 8) | ((unsigned)(d & 15) << 12);
}
__device__ __forceinline__ unsigned short pack_fp4x4(f32x4 v) {
#pragma unroll
    for (int i = 0; i < 4; ++i) v[i] = fminf(fmaxf(v[i], -6.0f), 6.0f);
    unsigned w = __builtin_amdgcn_cvt_scalef32_pk_fp4_f32(0u, v.x, v.y, 1.0f, 0);
    w = __builtin_amdgcn_cvt_scalef32_pk_fp4_f32(w, v.z, v.w, 1.0f, 1);
    return (unsigned short)w;
}
__device__ __forceinline__ float bf_lo(unsigned p) { return __uint_as_float(p << 16); }
__device__ __forceinline__ float bf_hi(unsigned p) { return __uint_as_float(p & 0xffff0000u); }
__device__ __forceinline__ float fast_rcp(float x) { return __builtin_amdgcn_rcpf(x); }
__device__ __forceinline__ float fast_exp2(float x) { return __builtin_amdgcn_exp2f(x); }
__device__ __forceinline__ float sigmoidf_(float x) { return fast_rcp(1.0f + fast_exp2(-1.4426950409f * x)); }
__device__ __forceinline__ float gelu_tanh(float x) { const float u = 1.5957691216f * (x + 0.044715f * x * x * x); return x * fast_rcp(1.0f + fast_exp2(-1.4426950409f * u)); }
__device__ __forceinline__ float rsqrt_(float x) { return __builtin_amdgcn_rsqf(x); }
template <int CTRL> __device__ __forceinline__ float dpp(float x) { return __builtin_bit_cast(float, __builtin_amdgcn_mov_dpp(__builtin_bit_cast(int, x), CTRL, 0xf, 0xf, true)); }
__device__ __forceinline__ float xrow16_sum(float x) {
    auto s = __builtin_amdgcn_permlane16_swap(__float_as_uint(x), __float_as_uint(x), false, false);
    x = __uint_as_float(s[0]) + __uint_as_float(s[1]);
    auto t = __builtin_amdgcn_permlane32_swap(__float_as_uint(x), __float_as_uint(x), false, false);
    return __uint_as_float(t[0]) + __uint_as_float(t[1]);
}
__device__ __forceinline__ float xrow16_max(float x) {
    auto s = __builtin_amdgcn_permlane16_swap(__float_as_uint(x), __float_as_uint(x), false, false);
    x = fmaxf(__uint_as_float(s[0]), __uint_as_float(s[1]));
    auto t = __builtin_amdgcn_permlane32_swap(__float_as_uint(x), __float_as_uint(x), false, false);
    return fmaxf(__uint_as_float(t[0]), __uint_as_float(t[1]));
}
__device__ __forceinline__ float wave_sum_dpp(float x) {
    x += dpp<0xB1>(x); x += dpp<0x4E>(x); x += dpp<0x141>(x); x += dpp<0x128>(x); return xrow16_sum(x);
}
__device__ __forceinline__ float quad_sum(float v) { return xrow16_sum(v); }
__device__ __forceinline__ float quad_max(float v) { return xrow16_max(v); }
__device__ __forceinline__ float wave_sum(float v) { return wave_sum_dpp(v); }
__device__ __forceinline__ float dot2(unsigned a, unsigned b, float c) { return __builtin_amdgcn_fdot2_f32_bf16(__builtin_bit_cast(bf16x2, a), __builtin_bit_cast(bf16x2, b), c, false); }

#define XB_TMO      128
#define XB_XCNT(j)  (256  + 64 * (j))
#define XB_XSUB(j)  (1280 + 64 * (j))
#define XB_XGEN(j)  (2304 + 64 * (j))
#define XB_TOP      3328
#define XB_TOPGEN   3392
#define XCD_BAR_WORDS 3456
#define XB_SPIN_CAP (1u << 20)
__device__ __forceinline__ unsigned xb_ld(unsigned* p)              { return __hip_atomic_load(p, __ATOMIC_RELAXED, __HIP_MEMORY_SCOPE_AGENT); }
__device__ __forceinline__ unsigned xb_add(unsigned* p, unsigned v) { return __hip_atomic_fetch_add(p, v, __ATOMIC_RELAXED, __HIP_MEMORY_SCOPE_AGENT); }
__device__ __forceinline__ unsigned xb_xcc_id() { return (unsigned)__builtin_amdgcn_s_getreg((3 << 11) | 20) & 0xFu; }
#define XB_SPIN(cond, bar) do { unsigned _sp = 0; while (cond) { __builtin_amdgcn_s_sleep(1); \
    if ((++_sp & 255u) == 0u) { if (xb_ld(&(bar)[XB_TMO])) break; if (_sp > XB_SPIN_CAP) { atomicAdd(&(bar)[XB_TMO], 1u); break; } } } } while (0)
struct XcdBarrier { unsigned* bar; unsigned x; volatile unsigned* st; };
__device__ __forceinline__ XcdBarrier xcd_barrier_post(unsigned* bar, volatile unsigned* st) {
    XcdBarrier b; b.bar = bar; b.x = xb_xcc_id(); b.st = st;
    if (threadIdx.x == 0) (void)xb_add(&bar[XB_XCNT(b.x)], 1u);
    return b;
}
__device__ __forceinline__ void xcd_barrier_complete(unsigned* bar, unsigned x, unsigned& nloc, unsigned& nx) {
    const unsigned G = gridDim.x * gridDim.y * gridDim.z;
    unsigned sum, cnt, mine, sp = 0u;
    for (;;) {
        sum = 0u; cnt = 0u; mine = 0u;
#pragma unroll
        for (unsigned j = 0; j < 16; ++j) { const unsigned c = xb_ld(&bar[XB_XCNT(j)]); sum += c; cnt += (c > 0u) ? 1u : 0u; mine = (j == x) ? c : mine; }
        if (sum == G) break;
        __builtin_amdgcn_s_sleep(1);
        if ((++sp & 255u) == 0u) { if (xb_ld(&bar[XB_TMO])) break; if (sp > XB_SPIN_CAP) { atomicAdd(&bar[XB_TMO], 1u); break; } }
    }
    nloc = mine > 0u ? mine : 1u; nx = cnt > 0u ? cnt : 1u;
}
__device__ __forceinline__ void xcd_barrier(const XcdBarrier& b) {
    asm volatile("s_waitcnt vmcnt(0)" ::: "memory");
    __syncthreads();
    if (threadIdx.x == 0) {
        unsigned* bar = b.bar;
        __builtin_amdgcn_s_waitcnt(0);
        unsigned nloc = b.st[0], nx = b.st[1];
        if (nloc == 0u) { xcd_barrier_complete(bar, b.x, nloc, nx); b.st[0] = nloc; b.st[1] = nx; }
        const unsigned old = xb_add(&bar[XB_XSUB(b.x)], 1u);
        const unsigned gen = old / nloc;
        if (old + 1u == (gen + 1u) * nloc) {
            __builtin_amdgcn_fence(__ATOMIC_RELEASE, "agent");
            asm volatile("s_waitcnt vmcnt(0)" ::: "memory");
            const unsigned og = xb_add(&bar[XB_TOP], 1u);
            const unsigned tg = og / nx;
            if (og + 1u == (tg + 1u) * nx) xb_add(&bar[XB_TOPGEN], 1u);
            else XB_SPIN(xb_ld(&bar[XB_TOPGEN]) == tg, bar);
            __builtin_amdgcn_fence(__ATOMIC_ACQUIRE, "agent");
            xb_add(&bar[XB_XGEN(b.x)], 1u);
            asm volatile("s_waitcnt vmcnt(0)" ::: "memory");
        } else {
            XB_SPIN(xb_ld(&bar[XB_XGEN(b.x)]) == gen, bar);
            __builtin_amdgcn_fence(__ATOMIC_ACQUIRE, "agent");
            asm volatile("s_waitcnt vmcnt(0)" ::: "memory");
        }
    }
    __syncthreads();
}

struct Ctx {
    const float* in[22]; float* out; unsigned char* ws;
    unsigned char* lds; int tid, lane, wave, G, vb;
};
#define WSP(T_, off) ((T_*)(c.ws + (off)))
__device__ __forceinline__ Ctx reopaque(const Ctx& c0) {
    Ctx c = c0; int t = c0.tid; asm volatile("" : "+v"(t)); c.tid = t; c.lane = t & 63; c.wave = __builtin_amdgcn_readfirstlane(t >> 6);
    int vb = c0.vb; asm volatile("" : "+s"(vb)); c.vb = vb; return c;
}

__device__ __forceinline__ int lds_off(int row, int chunk) { return row * 128 + ((chunk ^ (row & 7)) << 4); }

__device__ __forceinline__ void gemm_compute_stage(f32x4 (&acc)[2][8], const unsigned char* sA, const unsigned char* sB, int wave, int lane) {
    const int r = lane & 15, q = lane >> 4;
    bf16x8 af[2][2], bfr[2][8];
#pragma unroll
    for (int ks = 0; ks < 2; ++ks) {
#pragma unroll
        for (int mi = 0; mi < 2; ++mi) af[ks][mi] = *(const bf16x8*)(sA + lds_off(32 * wave + 16 * mi + r, 4 * ks + q));
#pragma unroll
        for (int ni = 0; ni < 8; ++ni) bfr[ks][ni] = *(const bf16x8*)(sB + lds_off(16 * ni + r, 4 * ks + q));
    }
#pragma unroll
    for (int ks = 0; ks < 2; ++ks)
#pragma unroll
        for (int ni = 0; ni < 8; ++ni)
#pragma unroll
            for (int mi = 0; mi < 2; ++mi) acc[mi][ni] = __builtin_amdgcn_mfma_f32_16x16x32_bf16(bfr[ks][ni], af[ks][mi], acc[mi][ni], 0, 0, 0);
    __builtin_amdgcn_sched_group_barrier(0x100, 6, 0);
#pragma unroll
    for (int i = 0; i < 14; ++i) { __builtin_amdgcn_sched_group_barrier(0x8, 2, 0); __builtin_amdgcn_sched_group_barrier(0x100, 1, 0); }
    __builtin_amdgcn_sched_group_barrier(0x8, 4, 0);
}

#define LAS __attribute__((address_space(3)))
__device__ __forceinline__ void gemm_stage_glds(const bf16* A, int lda, const bf16* Bt, int ldb, int kt, unsigned char* stage, int wave, int lane) {
    const int rr = lane >> 3, cch = (lane & 7) ^ rr;
#pragma unroll
    for (int i = 0; i < 4; ++i) { const int pc = 4 * i + wave;
        __builtin_amdgcn_global_load_lds((const unsigned*)(A + (size_t)(8 * pc + rr) * lda + kt * 64 + cch * 8), (LAS unsigned*)(stage + pc * 1024), 16, 0, 0);
        __builtin_amdgcn_global_load_lds((const unsigned*)(Bt + (size_t)(8 * pc + rr) * ldb + kt * 64 + cch * 8), (LAS unsigned*)(stage + 16384 + pc * 1024), 16, 0, 0); }
}
__device__ __forceinline__ void gemm_core(f32x4 (&acc)[2][8], const bf16* A, int lda, const bf16* Bt, int ldb, int K, unsigned char* lds, int tid) {
    const int wave = __builtin_amdgcn_readfirstlane(tid >> 6), lane = tid & 63;
    const int nk = K >> 6;
    gemm_stage_glds(A, lda, Bt, ldb, 0, lds, wave, lane);
    asm volatile("s_waitcnt vmcnt(0)" ::: "memory");
    __syncthreads();
    for (int kt = 0; kt < nk; ++kt) {
        const int cur = kt & 1;
        if (kt + 1 < nk) gemm_stage_glds(A, lda, Bt, ldb, kt + 1, lds + (cur ^ 1) * 32768, wave, lane);
        gemm_compute_stage(acc, lds + cur * 32768, lds + cur * 32768 + 16384, wave, lane);
        asm volatile("s_waitcnt vmcnt(0)" ::: "memory");
        __syncthreads();
    }
}
__device__ __forceinline__ void acc_zero(f32x4 (&acc)[2][8]) {
#pragma unroll
    for (int mi = 0; mi < 2; ++mi)
#pragma unroll
        for (int ni = 0; ni < 8; ++ni) acc[mi][ni] = (f32x4){0.f, 0.f, 0.f, 0.f};
}
__device__ __forceinline__ float rstd_from_ssq8(const float* ssq, int tok) {
    const f32x4 a = *(const f32x4*)(ssq + (size_t)tok * 8), b = *(const f32x4*)(ssq + (size_t)tok * 8 + 4);
    const float s = ((a.x + a.y) + (a.z + a.w)) + ((b.x + b.y) + (b.z + b.w));
    return rsqrt_(s * (1.0f / 1024.0f) + EPS);
}

__device__ __forceinline__ int src_col(int mode, int np) {
    if (mode == 0) return np;
    if (mode == 2) { const int h = np >> 7, j = np & 127; return j < 96 ? h * 96 + j : -1; }
    if (np < 1024) { const int cblk = np >> 7, j = np & 127; return j < 64 ? 64 * cblk + j : 512 + 64 * cblk + (j - 64); }
    if (np < 1408) return np;
    if (np < 1536) { const int j = np - 1408; return j < 32 ? 1408 + j : -1; }
    return 1440 + (np - 1536);
}
__device__ __forceinline__ void p0_transpose_item(const float* W, int K, int N, bf16* Wt, int mode, const float* g, int item, float* scr, int lane) {
    const int nblk_k = K / 64, nb = item / nblk_k, kb = item % nblk_k, k0 = 64 * kb, n0 = 32 * nb;
    const int n = src_col(mode, n0 + (lane & 31));
    float wv[32], gv[32];
#pragma unroll
    for (int i = 0; i < 32; ++i) { const int kk = 2 * i + (lane >> 5); wv[i] = n >= 0 ? W[(size_t)(k0 + kk) * N + n] : 0.f; gv[i] = g ? g[k0 + kk] : 1.f; }
#pragma unroll
    for (int i = 0; i < 32; ++i) { const int kk = 2 * i + (lane >> 5); scr[kk * 33 + (lane & 31)] = wv[i] * gv[i]; }
    __builtin_amdgcn_s_waitcnt(0xC07F); asm volatile("" ::: "memory");
    const int cch = lane & 7;
#pragma unroll
    for (int j = 0; j < 4; ++j) { const int nl = (lane >> 3) + 8 * j; const float* s = scr + (8 * cch) * 33 + nl;
        u32x4 o; o.x = pk2(s[0 * 33], s[1 * 33]); o.y = pk2(s[2 * 33], s[3 * 33]); o.z = pk2(s[4 * 33], s[5 * 33]); o.w = pk2(s[6 * 33], s[7 * 33]);
        *(u32x4*)(Wt + (size_t)(n0 + nl) * K + k0 + 8 * cch) = o; }
    __builtin_amdgcn_s_waitcnt(0xC07F); asm volatile("" ::: "memory");
}
struct WDesc { int in_idx, K, N, Np, mode, g_idx; size_t off; };
__device__ __forceinline__ void phase_prologue(const Ctx& c0) {
    Ctx c = reopaque(c0);
    const int gw = c.vb * 4 + c.wave, NGW = c.G * 4;
    float* scr = (float*)(c.lds + c.wave * 8704);
    const WDesc wd[7] = {
        {3, 1024, NIN, NINP, 1, 2, 0}, {8, 512, 1024, 1024, 0, -1, OFF_WCO}, {10, 256, 768, 1024, 2, 9, OFF_WUQ}, {12, 128, 1024, 1024, 0, 11, OFF_WUKV},
        {15, 512, 1024, 1024, 0, -1, OFF_WMLA}, {16, 1024, 1024, 1024, 0, -1, OFF_WOUT}, {18, 1024, 2048, 2048, 0, 17, OFF_WPQ}};
    constexpr int ITEMS_PER_LAYER = (1024 / 64) * (NINP / 32) + (512 / 64) * 32 + (256 / 64) * 32 + (128 / 64) * 32 + (512 / 64) * 32 + (1024 / 64) * 32 + (1024 / 64) * 64;
    for (int it = gw; it < 2 * ITEMS_PER_LAYER; it += NGW) {
        const int l = it >= ITEMS_PER_LAYER ? 1 : 0; int r = it - l * ITEMS_PER_LAYER;
        const float* W = nullptr; const float* g = nullptr; bf16* Wt = nullptr; int K = 64, N = 32, mode = 0, rr = 0;
#pragma unroll
        for (int m = 0; m < 7; ++m) {
            const int items = (wd[m].K / 64) * (wd[m].Np / 32);
            if (r >= 0 && r < items) { K = wd[m].K; N = wd[m].N; mode = wd[m].mode; rr = r;
                W = c.in[wd[m].in_idx] + (size_t)l * wd[m].K * wd[m].N; g = wd[m].g_idx >= 0 ? c.in[wd[m].g_idx >= 0 ? wd[m].g_idx : 0] + (size_t)l * wd[m].K : nullptr;
                Wt = (bf16*)(c.ws + WS_WIN + l * SZ_WLAYER + wd[m].off); }
            r -= items;
        }
        p0_transpose_item(W, K, N, Wt, mode, g, rr, scr, c.lane);
    }
    const int gt = c.vb * NTHREADS + c.tid, NGT = c.G * NTHREADS;
    for (int l = 0; l < 2; ++l) {
        const float* src = c.in[19] + (size_t)l * 262144; bf16* dst = (bf16*)(c.ws + WS_WIN + l * SZ_WLAYER + OFF_KEYS);
        for (int i = gt; i < 262144 / 8; i += NGT) { const f32x4 a = *(const f32x4*)(src + i * 8), b = *(const f32x4*)(src + i * 8 + 4);
            u32x4 o; o.x = pk2(a.x, a.y); o.y = pk2(a.z, a.w); o.z = pk2(b.x, b.y); o.w = pk2(b.z, b.w); *(u32x4*)(dst + i * 8) = o; }
    }
    for (int l = 0; l < 2; ++l)
        for (int uv = 0; uv < 2; ++uv) {
            const float* src = c.in[20 + uv] + (size_t)l * NEXP * 1024; unsigned char* dst = c.ws + WS_TAB + (size_t)(l * 2 + uv) * SZ_TAB;
            f32x4 g4[4];
#pragma unroll
            for (int j = 0; j < 4; ++j) { const float sc = uv == 0 ? U_SCALE : TAB_SCALE; g4[j] = (f32x4){sc, sc, sc, sc}; if (uv == 0) g4[j] = g4[j] * *(const f32x4*)(c.in[17] + l * 1024 + 256 * j + 4 * c.lane); }
            for (int row = gw; row < NEXP; row += 2 * NGW) {
                const float* sp = src + (size_t)row * 1024 + 4 * c.lane; const int row2 = row + NGW; const bool two = row2 < NEXP;
                const float* sp2 = src + (size_t)(two ? row2 : row) * 1024 + 4 * c.lane;
                f32x4 a[4], b[4];
#pragma unroll
                for (int j = 0; j < 4; ++j) { a[j] = *(const f32x4*)(sp + 256 * j); b[j] = *(const f32x4*)(sp2 + 256 * j); }
#pragma unroll
                for (int j = 0; j < 4; ++j) { const f32x4 v = a[j] * g4[j];
                    if (uv == 0) *(unsigned short*)(dst + (size_t)row * 512 + 128 * j + 2 * c.lane) = (unsigned short)pack_i4x4(v);
                    else *(unsigned short*)(dst + (size_t)row * 512 + 128 * j + 2 * c.lane) = pack_fp4x4(v); }
                if (two) {
#pragma unroll
                    for (int j = 0; j < 4; ++j) { const f32x4 v = b[j] * g4[j];
                        if (uv == 0) *(unsigned short*)(dst + (size_t)row2 * 512 + 128 * j + 2 * c.lane) = (unsigned short)pack_i4x4(v);
                        else *(unsigned short*)(dst + (size_t)row2 * 512 + 128 * j + 2 * c.lane) = pack_fp4x4(v); } }
            }
        }
    { float* rope = WSP(float, WS_ROPE);
      for (int i = gt; i < L * 16; i += NGT) { const int pos = i >> 4, j = i & 15;
          const float inv = 1.0f / __builtin_exp2f((float)j * 0.8304820237218406f);
          const float angf = (float)pos * inv; const double ang = (double)angf;
          const double nq = __builtin_rint(ang * 0.63661977236758134308);
          double rr = __builtin_fma(-nq, 1.57079632679489655800e+00, ang); rr = __builtin_fma(-nq, 6.12323399573676603587e-17, rr);
          const double r2 = rr * rr;
          double sp = -1.0 / 1307674368000.0; sp = sp * r2 + 1.0 / 6227020800.0; sp = sp * r2 - 1.0 / 39916800.0; sp = sp * r2 + 1.0 / 362880.0; sp = sp * r2 - 1.0 / 5040.0; sp = sp * r2 + 1.0 / 120.0; sp = sp * r2 - 1.0 / 6.0; sp = sp * r2 * rr + rr;
          double cp = 1.0 / 87178291200.0; cp = cp * r2 - 1.0 / 479001600.0; cp = cp * r2 + 1.0 / 3628800.0; cp = cp * r2 - 1.0 / 40320.0; cp = cp * r2 + 1.0 / 720.0; cp = cp * r2 - 1.0 / 24.0; cp = cp * r2 + 0.5; cp = 1.0 - cp * r2;
          const int qd = ((int)nq) & 3;
          const double cv = qd == 0 ? cp : qd == 1 ? -sp : qd == 2 ? -cp : sp;
          const double sv_ = qd == 0 ? sp : qd == 1 ? cp : qd == 2 ? -sp : -cp;
          rope[2 * i] = (float)cv; rope[2 * i + 1] = (float)sv_; } }
    { bf16* hb = WSP(bf16, WS_HB); float* ssq = WSP(float, WS_SSQ);
      for (int t0_ = gw; t0_ < T; t0_ += 4 * NGW) {
          f32x4 v[4][4];
#pragma unroll
          for (int i = 0; i < 4; ++i) { const int t = t0_ + i * NGW < T ? t0_ + i * NGW : t0_; const int b = t / L, pos = t % L;
              const float* src = pos < NMETA ? c.in[1] + (size_t)pos * D : c.in[0] + ((size_t)b * SEQ + (pos - NMETA)) * D;
#pragma unroll
              for (int j = 0; j < 4; ++j) v[i][j] = *(const f32x4*)(src + j * 256 + c.lane * 4); }
#pragma unroll
          for (int i = 0; i < 4; ++i) { const int t = t0_ + i * NGW;
              if (t < T) { float s = 0.f;
#pragma unroll
                  for (int j = 0; j < 4; ++j) { const f32x4 x = v[i][j]; u32x2 o; o.x = pk2(x.x, x.y); o.y = pk2(x.z, x.w); *(u32x2*)(hb + (size_t)t * D + j * 256 + c.lane * 4) = o;
                      s += (x.x * x.x + x.y * x.y) + (x.z * x.z + x.w * x.w); }
                  s = wave_sum(s);
                  if (c.lane < 8) ssq[(size_t)t * 8 + c.lane] = c.lane == 0 ? s : 0.f; } }
      } }
}

__device__ __forceinline__ void phase_A(const Ctx& c0, int l) {
    Ctx c = reopaque(c0);
    const bf16* hb = WSP(bf16, WS_HB); const bf16* Wt = (const bf16*)(c.ws + WS_WIN + l * SZ_WLAYER);
    const float* ssq = WSP(float, WS_SSQ);
    bf16* uglu = WSP(bf16, WS_UGLU); bf16* cq = WSP(bf16, WS_CQ); bf16* ckv = WSP(bf16, WS_CKV); float* krope = WSP(float, WS_KROPE);
    float* ssqq = WSP(float, WS_SSQQ); float* ssqkv = WSP(float, WS_SSQKV); bf16* gates = WSP(bf16, WS_GATES);
    constexpr int NT = NINP / 128;
    const int r = c.lane & 15, q = c.lane >> 4;
    const int xcd = c.vb / (c.G / 8), lb = c.vb % (c.G / 8), xm = xcd & 1, xn = xcd >> 1;
    const int m_lo = xm ? (MT + 1) / 2 : 0, m_cnt = xm ? MT / 2 : (MT + 1) / 2;
    for (int j = lb; j < m_cnt * 7; j += c.G / 8) {
        const int mt = m_lo + j / 7, nt = xn * 7 + j % 7;
        f32x4 acc[2][8]; acc_zero(acc);
        gemm_core(acc, hb + (size_t)mt * 128 * D, D, Wt + (size_t)nt * 128 * D, D, D, c.lds, c.tid);
#pragma unroll
        for (int mi = 0; mi < 2; ++mi) {
            const int tok = mt * 128 + 32 * c.wave + 16 * mi + r;
            const float rs = rstd_from_ssq8(ssq, tok);
            if (nt < 8) {
#pragma unroll
                for (int ni = 0; ni < 4; ++ni) { const f32x4 v = acc[mi][ni] * rs, g = acc[mi][ni + 4] * rs;
                    u32x2 o; o.x = pk2(v.x * sigmoidf_(g.x), v.y * sigmoidf_(g.y)); o.y = pk2(v.z * sigmoidf_(g.z), v.w * sigmoidf_(g.w));
                    *(u32x2*)(uglu + (size_t)tok * DC + nt * 64 + 16 * ni + 4 * q) = o; }
            } else if (nt < 11) {
                bf16* dst = nt < 10 ? cq + (size_t)tok * QL + (nt - 8) * 128 : ckv + (size_t)tok * KVL;
                float ss = 0.f;
#pragma unroll
                for (int ni = 0; ni < 8; ++ni) { const f32x4 v = acc[mi][ni] * rs; ss += (v.x * v.x + v.y * v.y) + (v.z * v.z + v.w * v.w);
                    u32x2 o; o.x = pk2(v.x, v.y); o.y = pk2(v.z, v.w); *(u32x2*)(dst + 16 * ni + 4 * q) = o; }
                ss = quad_sum(ss);
                if (q == 0) { if (nt < 10) ssqq[(size_t)tok * 2 + (nt - 8)] = ss; else ssqkv[tok] = ss; }
            } else if (nt == 11) {
#pragma unroll
                for (int ni = 0; ni < 2; ++ni) *(f32x4*)(krope + (size_t)tok * 32 + 16 * ni + 4 * q) = acc[mi][ni] * rs;
            } else {
#pragma unroll
                for (int ni = 0; ni < 8; ++ni) { const f32x4 v = acc[mi][ni] * rs;
                    u32x2 o; o.x = pk2(sigmoidf_(v.x), sigmoidf_(v.y)); o.y = pk2(sigmoidf_(v.z), sigmoidf_(v.w));
                    *(u32x2*)(gates + (size_t)tok * 2048 + (nt - 12) * 128 + 16 * ni + 4 * q) = o; }
            }
        }
    }
}

__device__ __forceinline__ void phaseB_q_item(Ctx& c, int l, int mt, int head) {
    const bf16* cq = WSP(bf16, WS_CQ); const bf16* Wt = (const bf16*)(c.ws + WS_WIN + l * SZ_WLAYER + OFF_WUQ);
    const float* ssqq = WSP(float, WS_SSQQ); const float* rope = WSP(float, WS_ROPE); const float* qg = c.in[13] + l * QK; bf16* Qb = WSP(bf16, WS_Q);
    const int r = c.lane & 15, q = c.lane >> 4;
    f32x4 acc[2][8]; acc_zero(acc);
    gemm_core(acc, cq + (size_t)mt * 128 * QL, QL, Wt + (size_t)head * 128 * QL, QL, QL, c.lds, c.tid);
    constexpr float QSCALE = 0.10206207261596575f * 1.4426950408889634f;
#pragma unroll
    for (int mi = 0; mi < 2; ++mi) {
        const int tok = mt * 128 + 32 * c.wave + 16 * mi + r, b = tok / L, pos = tok - b * L;
        const float rs = rsqrt_((ssqq[(size_t)tok * 2] + ssqq[(size_t)tok * 2 + 1]) * (1.0f / 256.0f) + EPS);
        float ss = 0.f;
#pragma unroll
        for (int ni = 0; ni < 6; ++ni) { acc[mi][ni] = acc[mi][ni] * rs; const f32x4 v = acc[mi][ni]; ss += (v.x * v.x + v.y * v.y) + (v.z * v.z + v.w * v.w); }
        ss = quad_sum(ss);
        const float rn = rsqrt_(ss * (1.0f / 96.0f) + EPS) * QSCALE;
#pragma unroll
        for (int ni = 0; ni < 6; ++ni) { const f32x4 g = *(const f32x4*)(qg + 16 * ni + 4 * q); acc[mi][ni] = acc[mi][ni] * g * rn; }
        const f32x4 cs0 = *(const f32x4*)(rope + ((size_t)pos * 16 + 4 * q) * 2), cs1 = *(const f32x4*)(rope + ((size_t)pos * 16 + 4 * q) * 2 + 4);
        const float co[4] = {cs0.x, cs0.z, cs1.x, cs1.z}, si[4] = {cs0.y, cs0.w, cs1.y, cs1.w};
        f32x4 x1 = acc[mi][4], x2 = acc[mi][5];
#pragma unroll
        for (int e = 0; e < 4; ++e) { const float a = x1[e], bb = x2[e]; x1[e] = a * co[e] - bb * si[e]; x2[e] = bb * co[e] + a * si[e]; }
        acc[mi][4] = x1; acc[mi][5] = x2;
        bf16* dst = Qb + (((size_t)b * NH + head) * L + pos) * QK;
#pragma unroll
        for (int ni = 0; ni < 6; ++ni) { const f32x4 v = acc[mi][ni]; u32x2 o; o.x = pk2(v.x, v.y); o.y = pk2(v.z, v.w); *(u32x2*)(dst + 16 * ni + 4 * q) = o; }
    }
}
__device__ __forceinline__ void phaseB_kv_item(Ctx& c, int l, int mt, int head) {
    const bf16* ckv = WSP(bf16, WS_CKV); const bf16* Wt = (const bf16*)(c.ws + WS_WIN + l * SZ_WLAYER + OFF_WUKV);
    const float* ssqkv = WSP(float, WS_SSQKV); const float* rope = WSP(float, WS_ROPE); const float* kg = c.in[14] + l * QK; const float* krope = WSP(float, WS_KROPE);
    bf16* Kb = WSP(bf16, WS_K); bf16* Vt = WSP(bf16, WS_VT);
    const int tid = c.tid, wave = c.wave, lane = c.lane, r = lane & 15, q = lane >> 4;
    unsigned char* lds = c.lds;
    f32x4 ak[2][4], av[2][4];
#pragma unroll
    for (int mi = 0; mi < 2; ++mi)
#pragma unroll
        for (int ni = 0; ni < 4; ++ni) { ak[mi][ni] = (f32x4){0.f, 0.f, 0.f, 0.f}; av[mi][ni] = (f32x4){0.f, 0.f, 0.f, 0.f}; }
    { const int chunk = tid & 7, row0 = tid >> 3;
      const bf16* pa = ckv + ((size_t)mt * 128 + row0) * KVL + chunk * 8; const bf16* pb = Wt + ((size_t)head * 128 + row0) * KVL + chunk * 8;
#pragma unroll
      for (int s = 0; s < 2; ++s)
#pragma unroll
          for (int i = 0; i < 4; ++i) { *(u32x4*)(lds + s * 32768 + lds_off(row0 + 32 * i, chunk)) = *(const u32x4*)(pa + (size_t)(32 * i) * KVL + s * 64);
              *(u32x4*)(lds + s * 32768 + 16384 + lds_off(row0 + 32 * i, chunk)) = *(const u32x4*)(pb + (size_t)(32 * i) * KVL + s * 64); }
    }
    __syncthreads();
#pragma unroll
    for (int s = 0; s < 2; ++s)
#pragma unroll
        for (int ks = 0; ks < 2; ++ks) {
            const unsigned char* sA = lds + s * 32768; const unsigned char* sB = sA + 16384;
            bf16x8 af[2], bfr[8];
#pragma unroll
            for (int mi = 0; mi < 2; ++mi) af[mi] = *(const bf16x8*)(sA + lds_off(32 * wave + 16 * mi + r, 4 * ks + q));
#pragma unroll
            for (int ni = 0; ni < 8; ++ni) bfr[ni] = *(const bf16x8*)(sB + lds_off(16 * ni + r, 4 * ks + q));
#pragma unroll
            for (int mi = 0; mi < 2; ++mi)
#pragma unroll
                for (int ni = 0; ni < 4; ++ni) { ak[mi][ni] = __builtin_amdgcn_mfma_f32_16x16x32_bf16(bfr[ni], af[mi], ak[mi][ni], 0, 0, 0);
                    av[mi][ni] = __builtin_amdgcn_mfma_f32_16x16x32_bf16(af[mi], bfr[ni + 4], av[mi][ni], 0, 0, 0); }
        }
    __syncthreads();
#pragma unroll
    for (int mi = 0; mi < 2; ++mi) {
        const int tok0 = mt * 128 + 32 * wave + 16 * mi, b = tok0 / L, pos0 = tok0 - b * L;
        { const int tok = tok0 + r, pos = pos0 + r;
          const float rs = rsqrt_(ssqkv[tok] * (1.0f / 128.0f) + EPS);
          const f32x4 kr1 = *(const f32x4*)(krope + (size_t)tok * 32 + 4 * q), kr2 = *(const f32x4*)(krope + (size_t)tok * 32 + 16 + 4 * q);
          float ss = (kr1.x * kr1.x + kr1.y * kr1.y) + (kr1.z * kr1.z + kr1.w * kr1.w) + (kr2.x * kr2.x + kr2.y * kr2.y) + (kr2.z * kr2.z + kr2.w * kr2.w);
#pragma unroll
          for (int ni = 0; ni < 4; ++ni) { ak[mi][ni] = ak[mi][ni] * rs; const f32x4 v = ak[mi][ni]; ss += (v.x * v.x + v.y * v.y) + (v.z * v.z + v.w * v.w); }
          ss = quad_sum(ss);
          const float rn = rsqrt_(ss * (1.0f / 96.0f) + EPS);
          bf16* dst = Kb + (((size_t)b * NH + head) * L + pos) * QK;
#pragma unroll
          for (int ni = 0; ni < 4; ++ni) { const f32x4 g = *(const f32x4*)(kg + 16 * ni + 4 * q); const f32x4 v = ak[mi][ni] * g * rn;
              u32x2 o; o.x = pk2(v.x, v.y); o.y = pk2(v.z, v.w); *(u32x2*)(dst + 16 * ni + 4 * q) = o; }
          const f32x4 g1 = *(const f32x4*)(kg + 64 + 4 * q), g2 = *(const f32x4*)(kg + 80 + 4 * q);
          f32x4 x1 = kr1 * g1 * rn, x2 = kr2 * g2 * rn;
          const f32x4 cs0 = *(const f32x4*)(rope + ((size_t)pos * 16 + 4 * q) * 2), cs1 = *(const f32x4*)(rope + ((size_t)pos * 16 + 4 * q) * 2 + 4);
          const float co[4] = {cs0.x, cs0.z, cs1.x, cs1.z}, si[4] = {cs0.y, cs0.w, cs1.y, cs1.w};
#pragma unroll
          for (int e = 0; e < 4; ++e) { const float a = x1[e], bb = x2[e]; x1[e] = a * co[e] - bb * si[e]; x2[e] = bb * co[e] + a * si[e]; }
          u32x2 o1, o2; o1.x = pk2(x1.x, x1.y); o1.y = pk2(x1.z, x1.w); o2.x = pk2(x2.x, x2.y); o2.y = pk2(x2.z, x2.w);
          *(u32x2*)(dst + 64 + 4 * q) = o1; *(u32x2*)(dst + 80 + 4 * q) = o2; }
        { const f32x4 sq = *(const f32x4*)(ssqkv + tok0 + 4 * q);
          f32x4 rs4; rs4.x = rsqrt_(sq.x * (1.0f / 128.0f) + EPS); rs4.y = rsqrt_(sq.y * (1.0f / 128.0f) + EPS); rs4.z = rsqrt_(sq.z * (1.0f / 128.0f) + EPS); rs4.w = rsqrt_(sq.w * (1.0f / 128.0f) + EPS);
#pragma unroll
          for (int ni = 0; ni < 4; ++ni) { const f32x4 v = av[mi][ni] * rs4; u32x2 o; o.x = pk2(v.x, v.y); o.y = pk2(v.z, v.w);
              *(u32x2*)(Vt + (((size_t)b * NH + head) * VD + 16 * ni + r) * L + pos0 + 4 * q) = o; } }
    }
}
__device__ __forceinline__ u32x4 conv_row(const bf16* uglu, int b, int pos, int ch) {
    u32x4 xv = (u32x4){0u, 0u, 0u, 0u};
    if (pos >= 0) xv = *(const u32x4*)(uglu + ((size_t)b * L + pos) * DC + ch);
    return xv;
}
__device__ __forceinline__ void conv_fma(float (&a)[8], const u32x4 xv, const f32x4 w0, const f32x4 w1) {
    a[0] += bf_lo(xv.x) * w0.x; a[1] += bf_hi(xv.x) * w0.y; a[2] += bf_lo(xv.y) * w0.z; a[3] += bf_hi(xv.y) * w0.w;
    a[4] += bf_lo(xv.z) * w1.x; a[5] += bf_hi(xv.z) * w1.y; a[6] += bf_lo(xv.w) * w1.z; a[7] += bf_hi(xv.w) * w1.w;
}
__device__ __forceinline__ void phaseB_conv_item(Ctx& c, int l, int grp) {
    const bf16* uglu = WSP(bf16, WS_UGLU); bf16* u2 = WSP(bf16, WS_U2);
    const float* cw = c.in[4] + (size_t)l * CW * DC; const float* cb = c.in[5] + l * DC; const float* lg = c.in[6] + l * DC; const float* lb = c.in[7] + l * DC;
    const int tok0 = grp * 4, b = tok0 / L, pos0 = tok0 - b * L, ch = c.lane * 8;
    float acc[4][8];
    { const f32x4 b0 = *(const f32x4*)(cb + ch), b1 = *(const f32x4*)(cb + ch + 4);
#pragma unroll
      for (int d = 0; d < 4; ++d) { acc[d][0] = b0.x; acc[d][1] = b0.y; acc[d][2] = b0.z; acc[d][3] = b0.w; acc[d][4] = b1.x; acc[d][5] = b1.y; acc[d][6] = b1.z; acc[d][7] = b1.w; } }
    const int base = pos0 - 30;
    u32x4 x0 = conv_row(uglu, b, base + 0, ch), x1 = conv_row(uglu, b, base + 1, ch), x2 = conv_row(uglu, b, base + 2, ch),
          x3 = conv_row(uglu, b, base + 3, ch), x4 = conv_row(uglu, b, base + 4, ch), x5;
    const float* wp = cw + ch;
#pragma unroll 1
    for (int w = 0; w < CW; ++w) {
        x5 = conv_row(uglu, b, (w + 5 <= 33) ? base + w + 5 : -1, ch);
        const f32x4 w0 = *(const f32x4*)wp, w1 = *(const f32x4*)(wp + 4); wp += DC;
        conv_fma(acc[0], x0, w0, w1); conv_fma(acc[1], x1, w0, w1); conv_fma(acc[2], x2, w0, w1); conv_fma(acc[3], x3, w0, w1);
        x0 = x1; x1 = x2; x2 = x3; x3 = x4; x4 = x5;
    }
    const f32x4 g0 = *(const f32x4*)(lg + ch), g1 = *(const f32x4*)(lg + ch + 4), e0 = *(const f32x4*)(lb + ch), e1 = *(const f32x4*)(lb + ch + 4);
    const float gg[8] = {g0.x, g0.y, g0.z, g0.w, g1.x, g1.y, g1.z, g1.w}, be[8] = {e0.x, e0.y, e0.z, e0.w, e1.x, e1.y, e1.z, e1.w};
#pragma unroll
    for (int d = 0; d < 4; ++d) {
        float s = 0.f;
#pragma unroll
        for (int j = 0; j < 8; ++j) s += acc[d][j];
        const float mu = wave_sum(s) * (1.0f / 512.0f);
        float vq = 0.f;
#pragma unroll
        for (int j = 0; j < 8; ++j) { acc[d][j] -= mu; vq += acc[d][j] * acc[d][j]; }
        const float rstd = rsqrt_(wave_sum(vq) * (1.0f / 512.0f) + EPS);
        float y[8];
#pragma unroll
        for (int j = 0; j < 8; ++j) { const float v = acc[d][j] * rstd * gg[j] + be[j]; y[j] = v * sigmoidf_(v); }
        u32x4 o; o.x = pk2(y[0], y[1]); o.y = pk2(y[2], y[3]); o.z = pk2(y[4], y[5]); o.w = pk2(y[6], y[7]);
        *(u32x4*)(u2 + (size_t)(tok0 + d) * DC + ch) = o;
    }
}
__device__ __forceinline__ void phase_B(const Ctx& c0, int l) {
    Ctx c = reopaque(c0);
    constexpr int NQ = MT * NH, NKV = MT * NH, NCV = T / 16;
    for (int it = c.vb; it < NQ + NKV + NCV; it += c.G) {
        if (it < NQ) phaseB_q_item(c, l, it / NH, it % NH);
        else if (it < NQ + NKV) phaseB_kv_item(c, l, (it - NQ) / NH, (it - NQ) % NH);
        else phaseB_conv_item(c, l, (it - NQ - NKV) * 4 + c.wave);
    }
}

constexpr int KROW = 208, VROW = 136, ATT_STAGE = 64 * KROW + 64 * VROW;
constexpr int ATT_ITEMS = NB * NH * 17;
__device__ __forceinline__ void phase_C(const Ctx& c0, int l) {
    Ctx c = reopaque(c0);
    const bf16* Qb = WSP(bf16, WS_Q); const bf16* Kb = WSP(bf16, WS_K); const bf16* Vt = WSP(bf16, WS_VT); bf16* O = WSP(bf16, WS_O);
    unsigned* qctr = WSP(unsigned, WS_CTL) + CW_QUEUE + 64 * l;
    volatile unsigned* misc = (volatile unsigned*)(c.lds + LDS_MISC);
    const int tid = c.tid, wave = c.wave, lane = c.lane, r = lane & 15, q = lane >> 4;
    unsigned char* lds = c.lds;
    for (;;) {
        if (tid == 0) misc[4] = atomicAdd(qctr, 1u);
        __syncthreads();
        const int item = __builtin_amdgcn_readfirstlane((int)misc[4]);
        __syncthreads();
        if (item >= ATT_ITEMS) break;
        const int pp = 15 - item / 64, bh = item % 64, b = bh / NH, h = bh % NH;
        const bool meta = pp < 0;
        const int r0 = meta ? 0 : 16 + 128 * pp;
        const int nfull = meta ? 0 : 2 * pp + 1 + (wave >> 1);
        const int ntiles = meta ? 1 : 2 * pp + 3;
        const bf16* Kbase = Kb + (size_t)bh * L * QK; const bf16* Vbase = Vt + (size_t)bh * VD * L;
        bf16x8 qf[2][3];
#pragma unroll
        for (int mi = 0; mi < 2; ++mi)
#pragma unroll
            for (int ks = 0; ks < 3; ++ks) qf[mi][ks] = *(const bf16x8*)(Qb + ((size_t)bh * L + r0 + 32 * wave + 16 * mi + r) * QK + 32 * ks + 8 * q);
        float m[2] = {-1e30f, -1e30f}, lsum[2] = {0.f, 0.f};
        f32x4 o[2][4];
#pragma unroll
        for (int mi = 0; mi < 2; ++mi)
#pragma unroll
            for (int dt = 0; dt < 4; ++dt) o[mi][dt] = (f32x4){0.f, 0.f, 0.f, 0.f};
        u32x4 rk[3], rv[2];
        auto gload = [&](int kt) {
#pragma unroll
            for (int i = 0; i < 3; ++i) { const int id = tid + 256 * i, row = id / 12, cc = id % 12; rk[i] = *(const u32x4*)(Kbase + (size_t)(kt * 64 + row) * QK + cc * 8); }
#pragma unroll
            for (int i = 0; i < 2; ++i) { const int id = tid + 256 * i, row = id >> 3, cc = id & 7; rv[i] = *(const u32x4*)(Vbase + (size_t)row * L + kt * 64 + cc * 8); }
        };
        auto lstore = [&](int s) {
            unsigned char* st = lds + s * ATT_STAGE;
#pragma unroll
            for (int i = 0; i < 3; ++i) { const int id = tid + 256 * i, row = id / 12, cc = id % 12; *(u32x4*)(st + row * KROW + cc * 16) = rk[i]; }
#pragma unroll
            for (int i = 0; i < 2; ++i) { const int id = tid + 256 * i, row = id >> 3, cc = id & 7; u32x2* d = (u32x2*)(st + 64 * KROW + row * VROW + cc * 16); d[0] = (u32x2){rv[i].x, rv[i].y}; d[1] = (u32x2){rv[i].z, rv[i].w}; }
        };
        gload(0); lstore(0);
#pragma unroll
        for (int mi = 0; mi < 2; ++mi)
#pragma unroll
            for (int ks = 0; ks < 3; ++ks) asm volatile("" : "+v"(qf[mi][ks]));
        __syncthreads();
        for (int kt = 0; kt < ntiles; ++kt) {
            const int cur = kt & 1;
            if (kt + 1 < ntiles) gload(kt + 1);
            const unsigned char* sK = lds + cur * ATT_STAGE; const unsigned char* sV = sK + 64 * KROW;
            const bool full = kt < nfull;
            if (kt <= nfull) {
                f32x4 s[2][4];
#pragma unroll
                for (int kh = 0; kh < 2; ++kh) {
                    bf16x8 kf[2][3];
#pragma unroll
                    for (int kk = 0; kk < 2; ++kk) if ((kh == 0 && kk == 0) || full) {
#pragma unroll
                        for (int ks = 0; ks < 3; ++ks) kf[kk][ks] = *(const bf16x8*)(sK + (16 * (2 * kh + kk) + r) * KROW + 64 * ks + 16 * q); }
#pragma unroll
                    for (int kk = 0; kk < 2; ++kk) { const int k4 = 2 * kh + kk;
#pragma unroll
                        for (int mi = 0; mi < 2; ++mi) s[mi][k4] = (f32x4){0.f, 0.f, 0.f, 0.f};
                        if (k4 == 0 || full) {
#pragma unroll
                            for (int ks = 0; ks < 3; ++ks)
#pragma unroll
                                for (int mi = 0; mi < 2; ++mi) s[mi][k4] = __builtin_amdgcn_mfma_f32_16x16x32_bf16(kf[kk][ks], qf[mi][ks], s[mi][k4], 0, 0, 0);
                        }
                    }
                }
                u32x2 vlo[4], vhi[4];
#pragma unroll
                for (int dt = 0; dt < 4; ++dt) { const unsigned char* vp = sV + (16 * dt + r) * VROW + (4 * q) * 2;
                    vlo[dt] = *(const u32x2*)vp; vhi[dt] = (u32x2){0u, 0u}; if (full) vhi[dt] = *(const u32x2*)(vp + 32); }
                bf16x8 pf[2][2];
#pragma unroll
                for (int mi = 0; mi < 2; ++mi) {
                    float mx = fmaxf(fmaxf(s[mi][0].x, s[mi][0].y), fmaxf(s[mi][0].z, s[mi][0].w));
                    if (full) {
#pragma unroll
                        for (int k4 = 1; k4 < 4; ++k4) mx = fmaxf(mx, fmaxf(fmaxf(s[mi][k4].x, s[mi][k4].y), fmaxf(s[mi][k4].z, s[mi][k4].w)));
                    }
                    mx = quad_max(mx);
                    const float mn = fmaxf(m[mi], mx), alpha = fast_exp2(m[mi] - mn); m[mi] = mn;
                    float ps = 0.f;
#pragma unroll
                    for (int k4 = 0; k4 < 4; ++k4) {
                        if (k4 == 0 || full) { f32x4 p; p.x = fast_exp2(s[mi][k4].x - mn); p.y = fast_exp2(s[mi][k4].y - mn); p.z = fast_exp2(s[mi][k4].z - mn); p.w = fast_exp2(s[mi][k4].w - mn);
                            ps += (p.x + p.y) + (p.z + p.w); s[mi][k4] = p; }
                    }
                    lsum[mi] = lsum[mi] * alpha + ps;
#pragma unroll
                    for (int dt = 0; dt < 4; ++dt) o[mi][dt] = o[mi][dt] * alpha;
#pragma unroll
                    for (int st = 0; st < 2; ++st) { u32x4 pw;
                        pw.x = pk2(s[mi][2 * st].x, s[mi][2 * st].y); pw.y = pk2(s[mi][2 * st].z, s[mi][2 * st].w); pw.z = pk2(s[mi][2 * st + 1].x, s[mi][2 * st + 1].y); pw.w = pk2(s[mi][2 * st + 1].z, s[mi][2 * st + 1].w);
                        if (!full) { pw.z = 0u; pw.w = 0u; }
                        pf[mi][st] = __builtin_bit_cast(bf16x8, pw); }
                }
                u32x2 wlo[4], whi[4];
                if (full) {
#pragma unroll
                    for (int dt = 0; dt < 4; ++dt) { const unsigned char* vp = sV + (16 * dt + r) * VROW + (32 + 4 * q) * 2; wlo[dt] = *(const u32x2*)vp; whi[dt] = *(const u32x2*)(vp + 32); } }
#pragma unroll
                for (int dt = 0; dt < 4; ++dt) { const bf16x8 vf = __builtin_bit_cast(bf16x8, (u32x4){vlo[dt].x, vlo[dt].y, vhi[dt].x, vhi[dt].y});
#pragma unroll
                    for (int mi = 0; mi < 2; ++mi) o[mi][dt] = __builtin_amdgcn_mfma_f32_16x16x32_bf16(vf, pf[mi][0], o[mi][dt], 0, 0, 0); }
                if (full) {
#pragma unroll
                    for (int dt = 0; dt < 4; ++dt) { const bf16x8 vf = __builtin_bit_cast(bf16x8, (u32x4){wlo[dt].x, wlo[dt].y, whi[dt].x, whi[dt].y});
#pragma unroll
                        for (int mi = 0; mi < 2; ++mi) o[mi][dt] = __builtin_amdgcn_mfma_f32_16x16x32_bf16(vf, pf[mi][1], o[mi][dt], 0, 0, 0); } }
            }
            if (kt + 1 < ntiles) lstore(cur ^ 1);
            __syncthreads();
        }
#pragma unroll
        for (int mi = 0; mi < 2; ++mi) {
            const float lt = quad_sum(lsum[mi]);
            if (!meta || (wave == 0 && mi == 0)) {
                const float inv = 1.0f / lt;
                bf16* dst = O + ((size_t)b * L + r0 + 32 * wave + 16 * mi + r) * 512 + h * VD;
#pragma unroll
                for (int dt = 0; dt < 4; ++dt) { const f32x4 v = o[mi][dt] * inv; u32x2 ov; ov.x = pk2(v.x, v.y); ov.y = pk2(v.z, v.w); *(u32x2*)(dst + 16 * dt + 4 * q) = ov; }
            }
        }
    }
}

__device__ __forceinline__ int tile_tok0(int mt, int l) { return l == 1 ? mt * 128 + NMETA * ((mt >> 4) + 1) : mt * 128; }
__device__ __forceinline__ int n_mtiles(int l) { return l == 1 ? 128 : MT; }
__device__ __forceinline__ void phase_D(const Ctx& c0, int l) {
    Ctx c = reopaque(c0);
    const bf16* u2 = WSP(bf16, WS_U2); const bf16* O = WSP(bf16, WS_O); const bf16* gates = WSP(bf16, WS_GATES); bf16* merged = WSP(bf16, WS_MERGED);
    const bf16* Wco = (const bf16*)(c.ws + WS_WIN + l * SZ_WLAYER + OFF_WCO); const bf16* Wmla = (const bf16*)(c.ws + WS_WIN + l * SZ_WLAYER + OFF_WMLA);
    const int r = c.lane & 15, q = c.lane >> 4;
    for (int it = c.vb; it < n_mtiles(l) * 8; it += c.G) {
        const int mt = it / 8, nt = it % 8, tk0 = tile_tok0(mt, l);
        f32x4 acc[2][8]; acc_zero(acc);
        gemm_core(acc, u2 + (size_t)tk0 * 512, 512, Wco + (size_t)nt * 128 * 512, 512, 512, c.lds, c.tid);
#pragma unroll
        for (int mi = 0; mi < 2; ++mi) { const int tok = tk0 + 32 * c.wave + 16 * mi + r;
            const bf16* gp = gates + (size_t)tok * 2048 + nt * 128 + 4 * q; bf16* mp = merged + (size_t)tok * D + nt * 128 + 4 * q;
#pragma unroll
            for (int ni = 0; ni < 8; ++ni) { const u32x2 g = *(const u32x2*)(gp + 16 * ni); const f32x4 v = acc[mi][ni];
                u32x2 o; o.x = pk2(v.x * bf_lo(g.x), v.y * bf_hi(g.x)); o.y = pk2(v.z * bf_lo(g.y), v.w * bf_hi(g.y)); *(u32x2*)(mp + 16 * ni) = o; } }
        acc_zero(acc);
        gemm_core(acc, O + (size_t)tk0 * 512, 512, Wmla + (size_t)nt * 128 * 512, 512, 512, c.lds, c.tid);
#pragma unroll
        for (int mi = 0; mi < 2; ++mi) { const int tok = tk0 + 32 * c.wave + 16 * mi + r;
            const bf16* gp = gates + (size_t)tok * 2048 + 1024 + nt * 128 + 4 * q; bf16* mp = merged + (size_t)tok * D + nt * 128 + 4 * q;
#pragma unroll
            for (int ni = 0; ni < 8; ++ni) { const u32x2 g = *(const u32x2*)(gp + 16 * ni); const u32x2 s = *(const u32x2*)(mp + 16 * ni); const f32x4 v = acc[mi][ni];
                u32x2 o; o.x = pk2(bf_lo(s.x) + v.x * bf_lo(g.x), bf_hi(s.x) + v.y * bf_hi(g.x)); o.y = pk2(bf_lo(s.y) + v.z * bf_lo(g.y), bf_hi(s.y) + v.w * bf_hi(g.y));
                *(u32x2*)(mp + 16 * ni) = o; } }
    }
}

__device__ __forceinline__ void phase_E(const Ctx& c0, int l) {
    Ctx c = reopaque(c0);
    const bf16* merged = WSP(bf16, WS_MERGED); const bf16* Wout = (const bf16*)(c.ws + WS_WIN + l * SZ_WLAYER + OFF_WOUT);
    float* h = WSP(float, WS_H); bf16* hb = WSP(bf16, WS_HB); float* ssq = WSP(float, WS_SSQ);
    const int r = c.lane & 15, q = c.lane >> 4;
    for (int it = c.vb; it < n_mtiles(l) * 8; it += c.G) {
        const int mt = it / 8, nt = it % 8, tk0 = tile_tok0(mt, l);
        f32x4 acc[2][8];
#pragma unroll
        for (int mi = 0; mi < 2; ++mi) { const int tok = tk0 + 32 * c.wave + 16 * mi + r; const float* hp = h + (size_t)tok * D;
            if (l == 0) { const int b = tok / L, pos = tok - b * L; hp = pos < NMETA ? c.in[1] + (size_t)pos * D : c.in[0] + ((size_t)b * SEQ + (pos - NMETA)) * D; }
            hp += nt * 128 + 4 * q;
#pragma unroll
            for (int ni = 0; ni < 8; ++ni) acc[mi][ni] = *(const f32x4*)(hp + 16 * ni); }
        gemm_core(acc, merged + (size_t)tk0 * D, D, Wout + (size_t)nt * 128 * D, D, D, c.lds, c.tid);
#pragma unroll
        for (int mi = 0; mi < 2; ++mi) { const int tok = tk0 + 32 * c.wave + 16 * mi + r; float ss = 0.f;
#pragma unroll
            for (int ni = 0; ni < 8; ++ni) { float* hp = h + (size_t)tok * D + nt * 128 + 16 * ni + 4 * q; const f32x4 v = acc[mi][ni]; *(f32x4*)hp = v;
                ss += (v.x * v.x + v.y * v.y) + (v.z * v.z + v.w * v.w);
                u32x2 o; o.x = pk2(v.x, v.y); o.y = pk2(v.z, v.w); *(u32x2*)(hb + (size_t)tok * D + nt * 128 + 16 * ni + 4 * q) = o; }
            ss = quad_sum(ss);
            if (q == 0) ssq[(size_t)tok * 8 + nt] = ss; }
    }
}

__device__ __forceinline__ unsigned f2key(float f) { const unsigned u = __float_as_uint(f); return u ^ ((u >> 31) ? 0xFFFFFFFFu : 0x80000000u); }
__device__ __forceinline__ float key2f(unsigned k) { const unsigned u = (k >> 31) ? (k ^ 0x80000000u) : ~k; return __uint_as_float(u); }
__device__ __forceinline__ void top16_insert(unsigned (&lst)[16], unsigned x) {
#pragma unroll
    for (int i = 0; i < 16; ++i) { const unsigned a = lst[i]; lst[i] = a > x ? a : x; x = a > x ? x : a; }
}
__device__ __forceinline__ void ce_desc(unsigned& a, unsigned& b) { const unsigned mx = a > b ? a : b, mn = a > b ? b : a; a = mx; b = mn; }
__device__ __forceinline__ void sort16_desc(unsigned (&v)[16]) {
#pragma unroll
    for (int k = 2; k <= 16; k <<= 1)
#pragma unroll
        for (int j = k >> 1; j > 0; j >>= 1)
#pragma unroll
            for (int i = 0; i < 16; ++i) { const int p = i ^ j; if (p > i) { if ((i & k) == 0) ce_desc(v[i], v[p]); else ce_desc(v[p], v[i]); } }
}
__device__ __forceinline__ void merge_top16(unsigned (&a)[16], const unsigned (&b)[16]) {
#pragma unroll
    for (int i = 0; i < 16; ++i) a[i] = a[i] > b[15 - i] ? a[i] : b[15 - i];
#pragma unroll
    for (int j = 8; j > 0; j >>= 1)
#pragma unroll
        for (int i = 0; i < 16; ++i) { const int p = i ^ j; if (p > i) ce_desc(a[i], a[p]); }
}
__device__ __forceinline__ void phase_F(const Ctx& c0, int l) {
    Ctx c = reopaque(c0);
    const bf16* hb = WSP(bf16, WS_HB); const bf16* Wpq = (const bf16*)(c.ws + WS_WIN + l * SZ_WLAYER + OFF_WPQ); const bf16* keys = (const bf16*)(c.ws + WS_WIN + l * SZ_WLAYER + OFF_KEYS);
    const float* ssq = WSP(float, WS_SSQ); float* sv = WSP(float, WS_SV); unsigned char* si = WSP(unsigned char, WS_SI);
    const int tid = c.tid, wave = c.wave, lane = c.lane, r = lane & 15, q = lane >> 4;
    unsigned char* lds = c.lds;
    const int xcd = c.vb / (c.G / 8), lb = c.vb % (c.G / 8), xm = xcd & 1, xn = xcd >> 1, nmt = n_mtiles(l);
    const int m_lo = xm ? (nmt + 1) / 2 : 0, m_cnt = xm ? nmt / 2 : (nmt + 1) / 2;
    for (int j = lb; j < m_cnt * 4; j += c.G / 8) {
        const int mt = m_lo + j / 4, hp = xn * 4 + j % 4, tk0 = tile_tok0(mt, l);
        f32x4 acc[2][8]; acc_zero(acc);
        u32x4 kreg[2][4]; float rsv[2];
        { const int chunk = tid & 7, row0 = tid >> 3; const bf16* pb = keys + ((size_t)hp * 128 + row0) * 128 + chunk * 8;
#pragma unroll
          for (int s = 0; s < 2; ++s)
#pragma unroll
              for (int i = 0; i < 4; ++i) kreg[s][i] = *(const u32x4*)(pb + (size_t)(32 * i) * 128 + s * 64); }
#pragma unroll
        for (int mi = 0; mi < 2; ++mi) rsv[mi] = rstd_from_ssq8(ssq, tk0 + 32 * wave + 16 * mi + r);
        gemm_core(acc, hb + (size_t)tk0 * D, D, Wpq + (size_t)hp * 128 * D, D, D, lds, tid);
#pragma unroll
        for (int mi = 0; mi < 2; ++mi) { const int row = 32 * wave + 16 * mi + r; const float rs = rsv[mi];
#pragma unroll
            for (int ni = 0; ni < 8; ++ni) { const f32x4 v = acc[mi][ni] * rs; u32x2 o; o.x = pk2(v.x, v.y); o.y = pk2(v.z, v.w);
                *(u32x2*)(lds + (ni >> 2) * 32768 + lds_off(row, 2 * (ni & 3) + (q >> 1)) + 8 * (q & 1)) = o; } }
        { const int chunk = tid & 7, row0 = tid >> 3;
#pragma unroll
          for (int s = 0; s < 2; ++s)
#pragma unroll
              for (int i = 0; i < 4; ++i) *(u32x4*)(lds + s * 32768 + 16384 + lds_off(row0 + 32 * i, chunk)) = kreg[s][i]; }
        __syncthreads();
        acc_zero(acc);
        gemm_compute_stage(acc, lds, lds + 16384, wave, lane);
        gemm_compute_stage(acc, lds + 32768, lds + 32768 + 16384, wave, lane);
        __syncthreads();
        float* S = (float*)lds;
#pragma unroll
        for (int mi = 0; mi < 2; ++mi) { const int row = 32 * wave + 16 * mi + r;
#pragma unroll
            for (int ni = 0; ni < 8; ++ni) *(f32x4*)(S + row * 132 + 16 * ni + 4 * q) = acc[mi][ni]; }
        __syncthreads();
        {
            const int tl = 32 * wave + (lane & 31), half = lane >> 5;
            const float* row = S + tl * 132;
            unsigned lst[16];
#pragma unroll
            for (int g = 0; g < 4; ++g) {
                unsigned cur[16];
#pragma unroll
                for (int j = 0; j < 4; ++j) { const int col = 64 * half + 16 * g + 4 * j; const f32x4 v = *(const f32x4*)(row + col);
                    cur[4 * j] = (f2key(v.x) & ~127u) | (unsigned)(127 - col); cur[4 * j + 1] = (f2key(v.y) & ~127u) | (unsigned)(127 - (col + 1));
                    cur[4 * j + 2] = (f2key(v.z) & ~127u) | (unsigned)(127 - (col + 2)); cur[4 * j + 3] = (f2key(v.w) & ~127u) | (unsigned)(127 - (col + 3)); }
                sort16_desc(cur);
                if (g == 0) {
#pragma unroll
                    for (int i = 0; i < 16; ++i) lst[i] = cur[i];
                } else merge_top16(lst, cur);
            }
            unsigned oth[16];
#pragma unroll
            for (int i = 0; i < 16; ++i) { auto rr = __builtin_amdgcn_permlane32_swap(lst[i], lst[i], false, false); oth[i] = half == 0 ? rr[1] : rr[0]; }
            merge_top16(lst, oth);
            if (half == 0) {
                const int tok = tk0 + tl;
                unsigned idx[16]; float val[16];
#pragma unroll
                for (int i = 0; i < 16; ++i) { idx[i] = 127u - (lst[i] & 127u); val[i] = row[idx[i]]; }
                float* svp = sv + ((size_t)tok * 16 + hp) * 16;
#pragma unroll
                for (int i = 0; i < 4; ++i) *(f32x4*)(svp + 4 * i) = (f32x4){val[4 * i], val[4 * i + 1], val[4 * i + 2], val[4 * i + 3]};
                u32x4 pi;
                pi.x = idx[0] | (idx[1] << 8) | (idx[2] << 16) | (idx[3] << 24); pi.y = idx[4] | (idx[5] << 8) | (idx[6] << 16) | (idx[7] << 24);
                pi.z = idx[8] | (idx[9] << 8) | (idx[10] << 16) | (idx[11] << 24); pi.w = idx[12] | (idx[13] << 8) | (idx[14] << 16) | (idx[15] << 24);
                *(u32x4*)(si + ((size_t)tok * 16 + hp) * 16) = pi;
            }
        }
        __syncthreads();
    }
}

__device__ __forceinline__ void phase_F3(const Ctx& c0, int l) {
    Ctx c = reopaque(c0);
    const float* sv = WSP(float, WS_SV); const unsigned char* si = WSP(unsigned char, WS_SI); int* eidx = WSP(int, WS_EIDX); float* gw = WSP(float, WS_GW); unsigned char* stb = WSP(unsigned char, WS_STB);
    float* lsv = (float*)c.lds;
    unsigned char* lsi = c.lds + 256 * 33 * 4;
    const int tid = c.tid;
    const int ntok = l == 1 ? NB * SEQ : T;
    for (int base = c.vb * NTHREADS; base < ntok * 8; base += c.G * NTHREADS) {
        const int thc = base + tid, tkc = thc >> 3;
        const int th = (l == 1 ? tkc + NMETA * ((tkc >> 11) + 1) : tkc) * 8 + (thc & 7);
        float a[16], b[16];
#pragma unroll
        for (int i = 0; i < 4; ++i) { const f32x4 x = *(const f32x4*)(sv + (size_t)th * 32 + 4 * i), y = *(const f32x4*)(sv + (size_t)th * 32 + 16 + 4 * i);
            a[4 * i] = x.x; a[4 * i + 1] = x.y; a[4 * i + 2] = x.z; a[4 * i + 3] = x.w; b[4 * i] = y.x; b[4 * i + 1] = y.y; b[4 * i + 2] = y.z; b[4 * i + 3] = y.w; }
        const u32x4 ia = *(const u32x4*)(si + (size_t)th * 32), ib = *(const u32x4*)(si + (size_t)th * 32 + 16);
#pragma unroll
        for (int i = 0; i < 16; ++i) { lsv[tid * 33 + i] = a[i]; lsv[tid * 33 + 16 + i] = b[i]; }
        *(u32x4*)(lsi + tid * 32) = ia; *(u32x4*)(lsi + tid * 32 + 16) = ib;
        unsigned lst[16], g2[16], g3[16], g4[16];
#pragma unroll
        for (int j = 0; j < 16; ++j) lst[j] = (f2key(a[0] + b[j]) & ~255u) | (unsigned)(255 - j);
#pragma unroll
        for (int i = 1; i < 16; ++i) g2[i - 1] = (f2key(a[i] + b[0]) & ~255u) | (unsigned)(255 - i * 16);
        g2[15] = 0u;
        { int n = 0;
#pragma unroll
          for (int i = 1; i < 16; ++i)
#pragma unroll
              for (int j = 1; j < 16; ++j)
                  if ((i + 1) * (j + 1) <= 16) { const unsigned key = (f2key(a[i] + b[j]) & ~255u) | (unsigned)(255 - (i * 16 + j)); if (n < 16) g3[n] = key; else g4[n - 16] = key; ++n; }
#pragma unroll
          for (int k = 3; k < 16; ++k) g4[k] = 0u; }
        sort16_desc(g3); sort16_desc(g4);
        merge_top16(lst, g2); merge_top16(g3, g4); merge_top16(lst, g3);
        __builtin_amdgcn_s_waitcnt(0xC07F); asm volatile("" ::: "memory");
        float s[16]; int e[16];
#pragma unroll
        for (int k = 0; k < 16; ++k) { const unsigned code = 255u - (lst[k] & 255u); const int i = code >> 4, j = code & 15;
            s[k] = lsv[tid * 33 + i] + lsv[tid * 33 + 16 + j]; e[k] = (int)lsi[tid * 32 + i] * 128 + (int)lsi[tid * 32 + 16 + j]; }
        float mx = s[0];
#pragma unroll
        for (int k = 1; k < 16; ++k) mx = fmaxf(mx, s[k]);
        float sum = 0.f;
#pragma unroll
        for (int k = 0; k < 16; ++k) { s[k] = fast_exp2((s[k] - mx) * 1.4426950409f); sum += s[k]; }
        const float inv = 1.0f / sum;
        typedef unsigned long long u64;
        u64 hlo = 0ull, hhi = 0ull;
#pragma unroll
        for (int k = 0; k < 16; ++k) { const int sl = e[k] >> 10; if (sl < 8) hlo += 1ull << (8 * sl); else hhi += 1ull << (8 * (sl - 8)); }
        u64 ilo = hlo, ihi = hhi;
#pragma unroll
        for (int d = 1; d < 8; d <<= 1) { const u64 a_ = __shfl_up(ilo, d, 8), b_ = __shfl_up(ihi, d, 8); if ((tid & 7) >= d) { ilo += a_; ihi += b_; } }
        const u64 tlo = __shfl(ilo, 7, 8), thi = __shfl(ihi, 7, 8);
        const u64 ones = 0x0101010101010101ull;
        const u64 inlo = tlo * ones, inhi = thi * ones + (inlo >> 56) * ones;
        const u64 stlo = inlo - tlo, sthi = inhi - thi;
        u64 rlo = stlo + (ilo - hlo), rhi = sthi + (ihi - hhi);
        const int tokn = th >> 3;
#pragma unroll
        for (int k = 0; k < 16; ++k) { const int sl = e[k] >> 10; int pos;
            if (sl < 8) { pos = (int)((rlo >> (8 * sl)) & 255ull); rlo += 1ull << (8 * sl); } else { pos = (int)((rhi >> (8 * (sl - 8))) & 255ull); rhi += 1ull << (8 * (sl - 8)); }
            eidx[(size_t)tokn * 128 + pos] = e[k]; gw[(size_t)tokn * 128 + pos] = s[k] * inv; }
        if ((tid & 7) == 0) { u64* sp = (u64*)(stb + (size_t)tokn * 16); sp[0] = stlo; sp[1] = sthi; }
        __builtin_amdgcn_s_waitcnt(0xC07F); asm volatile("" ::: "memory");
    }
}

typedef float f32x2 __attribute__((ext_vector_type(2)));
constexpr int G2_WSTRIDE = 14336, G2_MAXTOK = 9;
__device__ __forceinline__ float fp8dot4(unsigned w, unsigned x01, unsigned x23, float acc) {
    const bf16x2 lo = __builtin_amdgcn_cvt_scalef32_pk_bf16_fp8(w, 1.0f, false), hi = __builtin_amdgcn_cvt_scalef32_pk_bf16_fp8(w, 1.0f, true);
    acc = __builtin_amdgcn_fdot2_f32_bf16(lo, __builtin_bit_cast(bf16x2, x01), acc, false);
    return __builtin_amdgcn_fdot2_f32_bf16(hi, __builtin_bit_cast(bf16x2, x23), acc, false);
}
__device__ __forceinline__ float reduce8_transposed(const float (&p)[8], int lane) {
    float s[4];
#pragma unroll
    for (int k = 0; k < 4; ++k) { auto r = __builtin_amdgcn_permlane32_swap(__float_as_uint(p[k]), __float_as_uint(p[k + 4]), false, false); s[k] = __uint_as_float(r[0]) + __uint_as_float(r[1]); }
    float t[2];
#pragma unroll
    for (int k = 0; k < 2; ++k) { auto r = __builtin_amdgcn_permlane16_swap(__float_as_uint(s[k]), __float_as_uint(s[k + 2]), false, false); t[k] = __uint_as_float(r[0]) + __uint_as_float(r[1]); }
    const float u0 = t[0] + dpp<0x128>(t[0]), u1 = t[1] + dpp<0x128>(t[1]);
    float r = (lane & 8) ? u1 : u0;
    r += dpp<0xB1>(r); r += dpp<0x4E>(r); r += dpp<0x141>(r);
    return r;
}
typedef int i32x4 __attribute__((ext_vector_type(4)));
__device__ __forceinline__ void fp4fma8(f32x2 (&acc)[8], int o, unsigned w, f32x2 a2) {
    acc[o] = __builtin_elementwise_fma(a2, __builtin_amdgcn_cvt_scalef32_pk_f32_fp4(w, 1.0f, 0), acc[o]);
    acc[o + 1] = __builtin_elementwise_fma(a2, __builtin_amdgcn_cvt_scalef32_pk_f32_fp4(w, 1.0f, 1), acc[o + 1]);
    acc[o + 2] = __builtin_elementwise_fma(a2, __builtin_amdgcn_cvt_scalef32_pk_f32_fp4(w, 1.0f, 2), acc[o + 2]);
    acc[o + 3] = __builtin_elementwise_fma(a2, __builtin_amdgcn_cvt_scalef32_pk_f32_fp4(w, 1.0f, 3), acc[o + 3]);
}
__device__ __forceinline__ void g2_u_chunk(u32x2 (&u)[8], const unsigned char* U, const int* pe_next, const float* pw_c, float* act_c, const u32x2 xq, float rs, int lane) {
    const i32x4 e0 = *(const i32x4*)pe_next, e1 = *(const i32x4*)(pe_next + 4);
    const int en[8] = {e0.x, e0.y, e0.z, e0.w, e1.x, e1.y, e1.z, e1.w};
    float p[8];
#pragma unroll
    for (int k = 0; k < 8; k += 2) {
        int d0 = __builtin_amdgcn_sdot8((int)u[k].x, (int)xq.x, 0, false), d1 = __builtin_amdgcn_sdot8((int)u[k + 1].x, (int)xq.x, 0, false);
        d0 = __builtin_amdgcn_sdot8((int)u[k].y, (int)xq.y, d0, false); d1 = __builtin_amdgcn_sdot8((int)u[k + 1].y, (int)xq.y, d1, false);
        p[k] = (float)d0; p[k + 1] = (float)d1;
        asm volatile("" : "+v"(p[k]), "+v"(p[k + 1]));
        u[k] = *(const u32x2*)(U + (size_t)__builtin_amdgcn_readfirstlane(en[k]) * 512 + lane * 8);
        u[k + 1] = *(const u32x2*)(U + (size_t)__builtin_amdgcn_readfirstlane(en[k + 1]) * 512 + lane * 8);
    }
    const float a = reduce8_transposed(p, lane);
    const int row = (lane >> 3) & 7;
    if ((lane & 7) == 0) act_c[row] = gelu_tanh(a * rs) * pw_c[row];
}
__device__ __forceinline__ void g2_v_chunk(u32x2 (&v)[8], const unsigned char* V, const int* pe_next, const float* act_c, f32x2 (&acc)[8], int lane) {
    const i32x4 e0 = *(const i32x4*)pe_next, e1 = *(const i32x4*)(pe_next + 4);
    const int en[8] = {e0.x, e0.y, e0.z, e0.w, e1.x, e1.y, e1.z, e1.w};
    const f32x4 a0 = *(const f32x4*)act_c, a1 = *(const f32x4*)(act_c + 4);
    const float av[8] = {a0.x, a0.y, a0.z, a0.w, a1.x, a1.y, a1.z, a1.w};
#pragma unroll
    for (int k = 0; k < 8; k += 2) {
        const f32x2 a2 = (f32x2){av[k], av[k]}, b2 = (f32x2){av[k + 1], av[k + 1]};
        fp4fma8(acc, 0, v[k].x, a2); fp4fma8(acc, 4, v[k].y, a2);
        fp4fma8(acc, 0, v[k + 1].x, b2); fp4fma8(acc, 4, v[k + 1].y, b2);
        asm volatile("" : "+v"(acc[0]), "+v"(acc[1]), "+v"(acc[2]), "+v"(acc[3]), "+v"(acc[4]), "+v"(acc[5]), "+v"(acc[6]), "+v"(acc[7]));
        v[k] = *(const u32x2*)(V + (size_t)__builtin_amdgcn_readfirstlane(en[k]) * 512 + lane * 8);
        v[k + 1] = *(const u32x2*)(V + (size_t)__builtin_amdgcn_readfirstlane(en[k + 1]) * 512 + lane * 8);
    }
}
__device__ __forceinline__ void g2_finish_token(Ctx& c, int l, int tok, const f32x2 (&acc)[8], int lane) {
    float* h = WSP(float, WS_H); bf16* hbw = WSP(bf16, WS_HB); float* ssqw = WSP(float, WS_SSQ);
    float* hp = h + (size_t)tok * D + lane * 16;
    f32x4 r0 = *(const f32x4*)hp, r1 = *(const f32x4*)(hp + 4), r2 = *(const f32x4*)(hp + 8), r3 = *(const f32x4*)(hp + 12);
    r0 += (f32x4){acc[0].x, acc[0].y, acc[1].x, acc[1].y}; r1 += (f32x4){acc[2].x, acc[2].y, acc[3].x, acc[3].y};
    r2 += (f32x4){acc[4].x, acc[4].y, acc[5].x, acc[5].y}; r3 += (f32x4){acc[6].x, acc[6].y, acc[7].x, acc[7].y};
    if (l == 0) {
        *(f32x4*)hp = r0; *(f32x4*)(hp + 4) = r1; *(f32x4*)(hp + 8) = r2; *(f32x4*)(hp + 12) = r3;
        u32x4 o0, o1; o0.x = pk2(r0.x, r0.y); o0.y = pk2(r0.z, r0.w); o0.z = pk2(r1.x, r1.y); o0.w = pk2(r1.z, r1.w);
        o1.x = pk2(r2.x, r2.y); o1.y = pk2(r2.z, r2.w); o1.z = pk2(r3.x, r3.y); o1.w = pk2(r3.z, r3.w);
        *(u32x4*)(hbw + (size_t)tok * D + lane * 16) = o0; *(u32x4*)(hbw + (size_t)tok * D + lane * 16 + 8) = o1;
        float ss = (r0.x * r0.x + r0.y * r0.y) + (r0.z * r0.z + r0.w * r0.w) + (r1.x * r1.x + r1.y * r1.y) + (r1.z * r1.z + r1.w * r1.w)
                 + (r2.x * r2.x + r2.y * r2.y) + (r2.z * r2.z + r2.w * r2.w) + (r3.x * r3.x + r3.y * r3.y) + (r3.z * r3.z + r3.w * r3.w);
        ss = wave_sum_dpp(ss);
        if (lane < 8) ssqw[(size_t)tok * 8 + lane] = lane == 0 ? ss : 0.f;
    } else {
        const int b = tok / L, pos = tok - b * L;
        if (pos >= NMETA) { float* op = c.out + ((size_t)b * SEQ + (pos - NMETA)) * D + lane * 16;
            *(f32x4*)op = r0; *(f32x4*)(op + 4) = r1; *(f32x4*)(op + 8) = r2; *(f32x4*)(op + 12) = r3; }
    }
}
__device__ __forceinline__ void phase_G2(const Ctx& c0, int l) {
    Ctx c = reopaque(c0);
    const bf16* hb = WSP(bf16, WS_HB); const float* ssq = WSP(float, WS_SSQ); const int* pe = WSP(int, WS_EIDX); const float* pw = WSP(float, WS_GW);
    const unsigned char* U = c.ws + WS_TAB + (size_t)(l * 2) * SZ_TAB; const unsigned char* V = c.ws + WS_TAB + (size_t)(l * 2 + 1) * SZ_TAB;
    const int lane = c.lane, wave = c.wave;
    const int gw = c.vb * 4 + wave, t0 = l == 1 ? gw * 8 + NMETA * ((gw >> 8) + 1) : gw * 8;
    const bool has_x = l == 0 && (c.vb & 3) == 0; const int tx = T - 128 + (c.vb >> 2);
    unsigned char* wl = c.lds + wave * G2_WSTRIDE;
    int* pe_l = (int*)wl; float* pw_l = (float*)(wl + 4608); float* act_l = (float*)(wl + 9216);
#pragma unroll
    for (int j = 0; j < G2_MAXTOK; ++j) { const int tok = j < 8 ? t0 + j : (has_x ? tx : t0);
        pe_l[j * 128 + lane] = pe[(size_t)tok * 128 + lane]; pe_l[j * 128 + 64 + lane] = pe[(size_t)tok * 128 + 64 + lane];
        pw_l[j * 128 + lane] = pw[(size_t)tok * 128 + lane] * TAB_INV; pw_l[j * 128 + 64 + lane] = pw[(size_t)tok * 128 + 64 + lane] * TAB_INV; }
    const int xlo = has_x ? 4 * wave : 16, xhi = has_x ? 4 * wave + 4 : 16;
    {
        u32x2 xq[G2_MAXTOK]; float rs[G2_MAXTOK];
#pragma unroll
        for (int j = 0; j < G2_MAXTOK; ++j) { const int tok = j < 8 ? t0 + j : (has_x ? tx : t0);
            const u32x4 lo = *(const u32x4*)(hb + (size_t)tok * D + lane * 16), hi = *(const u32x4*)(hb + (size_t)tok * D + lane * 16 + 8);
            const float sx = rstd_from_ssq8(ssq, tok) * X_SCALE;
            const f32x4 f0 = (f32x4){bf_lo(lo.x), bf_hi(lo.x), bf_lo(lo.y), bf_hi(lo.y)} * sx, f1 = (f32x4){bf_lo(lo.z), bf_hi(lo.z), bf_lo(lo.w), bf_hi(lo.w)} * sx;
            const f32x4 f2 = (f32x4){bf_lo(hi.x), bf_hi(hi.x), bf_lo(hi.y), bf_hi(hi.y)} * sx, f3 = (f32x4){bf_lo(hi.z), bf_hi(hi.z), bf_lo(hi.w), bf_hi(hi.w)} * sx;
            xq[j].x = pack_i4x4(f0) | (pack_i4x4(f1) << 16); xq[j].y = pack_i4x4(f2) | (pack_i4x4(f3) << 16);
            rs[j] = 1.0f / (X_SCALE * U_SCALE); }
        u32x2 u[8];
#pragma unroll
        for (int k = 0; k < 8; ++k) u[k] = *(const u32x2*)(U + (size_t)__builtin_amdgcn_readfirstlane(pe_l[k]) * 512 + lane * 8);
#pragma unroll 1
        for (int ch = 0; ch < 16; ++ch) {
            const int cn = ch < 15 ? ch + 1 : 0;
            const bool x_here = ch >= xlo && ch < xhi;
#pragma unroll
            for (int j = 0; j < 8; ++j) {
                const int* pe_next = j < 7 ? pe_l + (j + 1) * 128 + ch * 8 : (x_here ? pe_l + 8 * 128 + ch * 8 : pe_l + cn * 8);
                g2_u_chunk(u, U, pe_next, pw_l + j * 128 + ch * 8, act_l + j * 128 + ch * 8, xq[j], rs[j], lane); }
            if (x_here) g2_u_chunk(u, U, pe_l + cn * 8, pw_l + 8 * 128 + ch * 8, act_l + 8 * 128 + ch * 8, xq[8], rs[8], lane);
        }
    }
    f32x2 acc[G2_MAXTOK][8];
#pragma unroll
    for (int j = 0; j < G2_MAXTOK; ++j)
#pragma unroll
        for (int i = 0; i < 8; ++i) acc[j][i] = (f32x2){0.f, 0.f};
    {
        u32x2 v[8];
#pragma unroll
        for (int k = 0; k < 8; ++k) v[k] = *(const u32x2*)(V + (size_t)__builtin_amdgcn_readfirstlane(pe_l[k]) * 512 + lane * 8);
#pragma unroll 1
        for (int ch = 0; ch < 16; ++ch) {
            const int cn = ch < 15 ? ch + 1 : 0;
            const bool x_here = ch >= xlo && ch < xhi;
#pragma unroll
            for (int j = 0; j < 8; ++j) {
                const int* pe_next = j < 7 ? pe_l + (j + 1) * 128 + ch * 8 : (x_here ? pe_l + 8 * 128 + ch * 8 : pe_l + cn * 8);
                g2_v_chunk(v, V, pe_next, act_l + j * 128 + ch * 8, acc[j], lane); }
            if (x_here) g2_v_chunk(v, V, pe_l + cn * 8, act_l + 8 * 128 + ch * 8, acc[8], lane);
        }
    }
#pragma unroll
    for (int j = 0; j < 8; ++j) g2_finish_token(c, l, t0 + j, acc[j], lane);
    __syncthreads();
    if (has_x) {
        f32x2* part = (f32x2*)(c.lds + wave * G2_WSTRIDE);
#pragma unroll
        for (int i = 0; i < 8; ++i) part[i * 64 + lane] = acc[8][i];
    }
    __syncthreads();
    if (has_x && wave == 0) {
        f32x2 tot[8];
#pragma unroll
        for (int i = 0; i < 8; ++i) { tot[i] = acc[8][i];
#pragma unroll
            for (int w = 1; w < 4; ++w) tot[i] += ((const f32x2*)(c.lds + w * G2_WSTRIDE))[i * 64 + lane]; }
        g2_finish_token(c, l, tx, tot, lane);
    }
    __syncthreads();
}

struct Args { const float* in[22]; float* out; unsigned char* ws; int ph_lo, ph_hi; };
constexpr int N_PHASES = 17;

__global__ void __launch_bounds__(NTHREADS, 2) fwd_kernel(Args args) {
    extern __shared__ __attribute__((aligned(16))) unsigned char lds_raw[];
    Ctx c;
#pragma unroll
    for (int i = 0; i < 22; ++i) c.in[i] = args.in[i];
    c.out = args.out; c.ws = args.ws; c.lds = lds_raw;
    c.tid = threadIdx.x; c.lane = c.tid & 63; c.wave = __builtin_amdgcn_readfirstlane(c.tid >> 6);
    c.G = gridDim.x; { const int bx = blockIdx.x; c.vb = (c.G % 8 == 0) ? (bx % 8) * (c.G / 8) + bx / 8 : bx; }
    volatile unsigned* misc = (volatile unsigned*)(c.lds + LDS_MISC);
    if (c.tid < 16) misc[c.tid] = 0u;
    __syncthreads();
    const int lo = args.ph_lo, hi = args.ph_hi;
    const bool multi = (hi - lo) > 1;
    XcdBarrier bar; bar.bar = WSP(unsigned, WS_CTL) + CW_BAR; bar.x = 0; bar.st = misc;
    if (multi) bar = xcd_barrier_post(WSP(unsigned, WS_CTL) + CW_BAR, misc);
#define IN_(k) (lo <= (k) && (k) < hi)
#define SEAM_(k) do { if ((k) + 1 < hi) xcd_barrier(bar); } while (0)
    if (IN_(0)) { phase_prologue(c); SEAM_(0); }
#pragma unroll 1
    for (int l = 0; l < 2; ++l) {
        const int p0 = 1 + 8 * l;
        if (IN_(p0 + 0)) { phase_A(c, l); SEAM_(p0 + 0); }
        if (IN_(p0 + 1)) { phase_B(c, l); SEAM_(p0 + 1); }
        if (IN_(p0 + 2)) { phase_C(c, l); SEAM_(p0 + 2); }
        if (IN_(p0 + 3)) { phase_D(c, l); SEAM_(p0 + 3); }
        if (IN_(p0 + 4)) { phase_E(c, l); SEAM_(p0 + 4); }
        if (IN_(p0 + 5)) { phase_F(c, l); SEAM_(p0 + 5); }
        if (IN_(p0 + 6)) { phase_F3(c, l); SEAM_(p0 + 6); }
        if (IN_(p0 + 7)) { phase_G2(c, l); SEAM_(p0 + 7); }
    }
}

extern "C" void kernel_launch(void* const* d_in, const int* in_sizes, int n_in, void* d_out, int out_size, void* d_ws, size_t ws_size, hipStream_t stream) {
    static int grid = 0;
    if (grid == 0) {
        if (n_in != 22 || out_size != NB * SEQ * D || ws_size < WS_END) { fprintf(stderr, "kernel_launch: unexpected shapes (n_in %d out %d ws %zu need %zu)\n", n_in, out_size, ws_size, (size_t)WS_END); grid = -1; return; }
        int dev = 0, cus = 0, per_cu = 0;
        hipGetDevice(&dev); hipDeviceGetAttribute(&cus, hipDeviceAttributeMultiprocessorCount, dev);
        if (hipFuncSetAttribute((const void*)fwd_kernel, hipFuncAttributeMaxDynamicSharedMemorySize, LDS_BYTES) != hipSuccess) { fprintf(stderr, "kernel_launch: hipFuncSetAttribute failed\n"); grid = -1; return; }
        if (hipOccupancyMaxActiveBlocksPerMultiprocessor(&per_cu, (const void*)fwd_kernel, NTHREADS, LDS_BYTES) != hipSuccess || per_cu < 1) { fprintf(stderr, "kernel_launch: occupancy query failed (%d)\n", per_cu); per_cu = 1; (void)hipGetLastError(); }
        if (per_cu > 2) per_cu = 2;
        grid = cus * per_cu;
        if (grid != 512) { fprintf(stderr, "kernel_launch: grid %d unsupported by phase G2 (needs 512 workgroups)\n", grid); grid = -1; return; }
        fprintf(stderr, "kernel_launch: grid %d (%d per CU), lds %d, ws need %zu have %zu\n", grid, per_cu, LDS_BYTES, (size_t)WS_END, ws_size);
    }
    if (grid < 0) return;
    hipMemsetAsync((char*)d_ws + WS_CTL, 0, CTL_BYTES, stream);
    Args a{};
    for (int i = 0; i < 22; ++i) a.in[i] = (const float*)d_in[i];
    a.out = (float*)d_out; a.ws = (unsigned char*)d_ws;
#if MK_PER_PHASE
    for (int ph = 0; ph < N_PHASES; ++ph) { a.ph_lo = ph; a.ph_hi = ph + 1; hipLaunchKernelGGL(fwd_kernel, dim3(grid), dim3(NTHREADS), LDS_BYTES, stream, a); }
#else
    a.ph_lo = 0; a.ph_hi = N_PHASES;
    void* kargs[] = {&a};
    hipError_t e = hipLaunchCooperativeKernel((const void*)fwd_kernel, dim3(grid), dim3(NTHREADS), kargs, LDS_BYTES, stream);
    if (e != hipSuccess) fprintf(stderr, "kernel_launch: cooperative launch failed: %s (grid %d)\n", hipGetErrorString(e), grid);
#endif
}
```

```cpp
#include <hip/hip_runtime.h>
#include <cstdio>
#include <cstdint>

#ifndef MK_PER_PHASE
#define MK_PER_PHASE 0
#endif

typedef unsigned short bf16;
typedef short bf16x8 __attribute__((ext_vector_type(8)));
typedef float f32x4 __attribute__((ext_vector_type(4)));
typedef unsigned u32x4 __attribute__((ext_vector_type(4)));
typedef unsigned u32x2 __attribute__((ext_vector_type(2)));
typedef __bf16 bf16x2 __attribute__((ext_vector_type(2)));

constexpr int NB = 8, SEQ = 2048, NMETA = 16, L = SEQ + NMETA, T = NB * L, D = 1024;
constexpr int DC = 512, CW = 31, NH = 8, QL = 256, KVL = 128, NOPE = 64, ROPE = 32, QK = 96, VD = 64;
constexpr int NIN = 3488, NINP = 3584;
constexpr int NEXP = 16384;
constexpr float EPS = 1e-6f;
constexpr int MT = T / 128;
static_assert(T % 128 == 0, "T tiles");

constexpr size_t al256(size_t x) { return (x + 255) & ~(size_t)255; }
constexpr size_t WS_CTL = 0;
constexpr size_t CTL_BYTES = 65536;
constexpr size_t WS_ROPE = WS_CTL + CTL_BYTES;
constexpr size_t WS_WIN = al256(WS_ROPE + (size_t)L * 16 * 8);
constexpr size_t SZ_WIN = (size_t)NINP * 1024 * 2, SZ_WCO = (size_t)1024 * 512 * 2, SZ_WUQ = (size_t)1024 * 256 * 2, SZ_WUKV = (size_t)1024 * 128 * 2,
                 SZ_WMLA = (size_t)1024 * 512 * 2, SZ_WOUT = (size_t)1024 * 1024 * 2, SZ_WPQ = (size_t)2048 * 1024 * 2, SZ_KEYS = (size_t)16 * 128 * 128 * 2;
constexpr size_t OFF_WCO = SZ_WIN, OFF_WUQ = OFF_WCO + SZ_WCO, OFF_WUKV = OFF_WUQ + SZ_WUQ, OFF_WMLA = OFF_WUKV + SZ_WUKV, OFF_WOUT = OFF_WMLA + SZ_WMLA,
                 OFF_WPQ = OFF_WOUT + SZ_WOUT, OFF_KEYS = OFF_WPQ + SZ_WPQ, SZ_WLAYER = OFF_KEYS + SZ_KEYS;
constexpr size_t WS_TAB = al256(WS_WIN + 2 * SZ_WLAYER);
constexpr size_t SZ_TAB = (size_t)NEXP * 1024;
constexpr float TAB_SCALE = 64.0f, TAB_INV = 1.0f / 64.0f;
constexpr float U_CLIP = 2.7f / 32.0f, U_SCALE = 7.0f / U_CLIP;
constexpr float X_SCALE = 7.0f / 2.7f;
constexpr size_t WS_H = al256(WS_TAB + 4 * SZ_TAB);
constexpr size_t WS_HB = al256(WS_H + (size_t)T * 1024 * 4);
constexpr size_t WS_SSQ = al256(WS_HB + (size_t)T * 1024 * 2);
constexpr size_t WS_UGLU = al256(WS_SSQ + (size_t)T * 8 * 4);
constexpr size_t WS_CQ = al256(WS_UGLU + (size_t)T * 512 * 2);
constexpr size_t WS_CKV = al256(WS_CQ + (size_t)T * 256 * 2);
constexpr size_t WS_KROPE = al256(WS_CKV + (size_t)T * 128 * 2);
constexpr size_t WS_SSQQ = al256(WS_KROPE + (size_t)T * 32 * 4);
constexpr size_t WS_SSQKV = al256(WS_SSQQ + (size_t)T * 2 * 4);
constexpr size_t WS_U2 = al256(WS_SSQKV + (size_t)T * 4);
constexpr size_t WS_Q = al256(WS_U2 + (size_t)T * 512 * 2);
constexpr size_t WS_K = al256(WS_Q + (size_t)T * NH * QK * 2);
constexpr size_t WS_VT = al256(WS_K + (size_t)T * NH * QK * 2);
constexpr size_t WS_O = al256(WS_VT + (size_t)T * NH * VD * 2 + 4096);
constexpr size_t WS_MERGED = al256(WS_O + (size_t)T * 512 * 2);
constexpr size_t WS_GATES = al256(WS_MERGED + (size_t)T * 1024 * 2);
constexpr size_t WS_SV = WS_GATES;
constexpr size_t WS_SI = al256(WS_SV + (size_t)T * 256 * 4);
constexpr size_t WS_EIDX = al256(WS_SI + (size_t)T * 256);
constexpr size_t WS_GW = al256(WS_EIDX + (size_t)T * 128 * 4);
constexpr size_t WS_STB = al256(WS_GW + (size_t)T * 128 * 4);
constexpr size_t WS_PEER_END = WS_STB + (size_t)T * 16;
constexpr size_t WS_END = al256(WS_GATES + (size_t)T * 2048 * 2);
static_assert(WS_PEER_END <= WS_END, "peer scratch overlay");

constexpr int CW_BAR = 0;
constexpr int CW_QUEUE = 4096;

constexpr int LDS_MAIN = 128 * 132 * 4;
constexpr int LDS_MISC = LDS_MAIN;
constexpr int LDS_BYTES = LDS_MAIN + 64;

constexpr int NTHREADS = 256;

__device__ __forceinline__ unsigned pk2(float lo, float hi) { bf16x2 v; v.x = (__bf16)lo; v.y = (__bf16)hi; return __builtin_bit_cast(unsigned, v); }
__device__ __forceinline__ unsigned pack_i8x4(f32x4 v) {
    const int a = (int)__builtin_rintf(fminf(fmaxf(v.x, -127.f), 127.f)), b = (int)__builtin_rintf(fminf(fmaxf(v.y, -127.f), 127.f));
    const int c_ = (int)__builtin_rintf(fminf(fmaxf(v.z, -127.f), 127.f)), d = (int)__builtin_rintf(fminf(fmaxf(v.w, -127.f), 127.f));
    return (unsigned)(a & 255) | ((unsigned)(b & 255) << 8) | ((unsigned)(c_ & 255) << 16) | ((unsigned)(d & 255) << 24);
}
__device__ __forceinline__ unsigned pack_i4x4(f32x4 v) {
    const int a = (int)__builtin_rintf(fminf(fmaxf(v.x, -7.f), 7.f)), b = (int)__builtin_rintf(fminf(fmaxf(v.y, -7.f), 7.f));
    const int c_ = (int)__builtin_rintf(fminf(fmaxf(v.z, -7.f), 7.f)), d = (int)__builtin_rintf(fminf(fmaxf(v.w, -7.f), 7.f));
    return (unsigned)(a & 15) | ((unsigned)(b & 15) << 4) | ((unsigned)(c_ & 15) << 8) | ((unsigned)(d & 15) << 12);
}
__device__ __forceinline__ unsigned short pack_fp4x4(f32x4 v) {
#pragma unroll
    for (int i = 0; i < 4; ++i) v[i] = fminf(fmaxf(v[i], -6.0f), 6.0f);
    unsigned w = __builtin_amdgcn_cvt_scalef32_pk_fp4_f32(0u, v.x, v.y, 1.0f, 0);
    w = __builtin_amdgcn_cvt_scalef32_pk_fp4_f32(w, v.z, v.w, 1.0f, 1);
    return (unsigned short)w;
}
__device__ __forceinline__ float bf_lo(unsigned p) { return __uint_as_float(p << 16); }
__device__ __forceinline__ float bf_hi(unsigned p) { return __uint_as_float(p & 0xffff0000u); }
__device__ __forceinline__ float fast_rcp(float x) { return __builtin_amdgcn_rcpf(x); }
__device__ __forceinline__ float fast_exp2(float x) { return __builtin_amdgcn_exp2f(x); }
__device__ __forceinline__ float sigmoidf_(float x) { return fast_rcp(1.0f + fast_exp2(-1.4426950409f * x)); }
__device__ __forceinline__ float gelu_tanh(float x) { const float u = 1.5957691216f * (x + 0.044715f * x * x * x); return x * fast_rcp(1.0f + fast_exp2(-1.4426950409f * u)); }
__device__ __forceinline__ float rsqrt_(float x) { return __builtin_amdgcn_rsqf(x); }
template <int CTRL> __device__ __forceinline__ float dpp(float x) { return __builtin_bit_cast(float, __builtin_amdgcn_mov_dpp(__builtin_bit_cast(int, x), CTRL, 0xf, 0xf, true)); }
__device__ __forceinline__ float xrow16_sum(float x) {
    auto s = __builtin_amdgcn_permlane16_swap(__float_as_uint(x), __float_as_uint(x), false, false);
    x = __uint_as_float(s[0]) + __uint_as_float(s[1]);
    auto t = __builtin_amdgcn_permlane32_swap(__float_as_uint(x), __float_as_uint(x), false, false);
    return __uint_as_float(t[0]) + __uint_as_float(t[1]);
}
__device__ __forceinline__ float xrow16_max(float x) {
    auto s = __builtin_amdgcn_permlane16_swap(__float_as_uint(x), __float_as_uint(x), false, false);
    x = fmaxf(__uint_as_float(s[0]), __uint_as_float(s[1]));
    auto t = __builtin_amdgcn_permlane32_swap(__float_as_uint(x), __float_as_uint(x), false, false);
    return fmaxf(__uint_as_float(t[0]), __uint_as_float(t[1]));
}
__device__ __forceinline__ float wave_sum_dpp(float x) {
    x += dpp<0xB1>(x); x += dpp<0x4E>(x); x += dpp<0x141>(x); x += dpp<0x128>(x); return xrow16_sum(x);
}
__device__ __forceinline__ float quad_sum(float v) { return xrow16_sum(v); }
__device__ __forceinline__ float quad_max(float v) { return xrow16_max(v); }
__device__ __forceinline__ float wave_sum(float v) { return wave_sum_dpp(v); }
__device__ __forceinline__ float dot2(unsigned a, unsigned b, float c) { return __builtin_amdgcn_fdot2_f32_bf16(__builtin_bit_cast(bf16x2, a), __builtin_bit_cast(bf16x2, b), c, false); }

#define XB_TMO      128
#define XB_XCNT(j)  (256  + 64 * (j))
#define XB_XSUB(j)  (1280 + 64 * (j))
#define XB_XGEN(j)  (2304 + 64 * (j))
#define XB_TOP      3328
#define XB_TOPGEN   3392
#define XCD_BAR_WORDS 3456
#define XB_SPIN_CAP (1u << 20)
__device__ __forceinline__ unsigned xb_ld(unsigned* p)              { return __hip_atomic_load(p, __ATOMIC_RELAXED, __HIP_MEMORY_SCOPE_AGENT); }
__device__ __forceinline__ unsigned xb_add(unsigned* p, unsigned v) { return __hip_atomic_fetch_add(p, v, __ATOMIC_RELAXED, __HIP_MEMORY_SCOPE_AGENT); }
__device__ __forceinline__ unsigned xb_xcc_id() { return (unsigned)__builtin_amdgcn_s_getreg((3 << 11) | 20) & 0xFu; }
#define XB_SPIN(cond, bar) do { unsigned _sp = 0; while (cond) { __builtin_amdgcn_s_sleep(1); \
    if ((++_sp & 255u) == 0u) { if (xb_ld(&(bar)[XB_TMO])) break; if (_sp > XB_SPIN_CAP) { atomicAdd(&(bar)[XB_TMO], 1u); break; } } } } while (0)
struct XcdBarrier { unsigned* bar; unsigned x; volatile unsigned* st; };
__device__ __forceinline__ XcdBarrier xcd_barrier_post(unsigned* bar, volatile unsigned* st) {
    XcdBarrier b; b.bar = bar; b.x = xb_xcc_id(); b.st = st;
    if (threadIdx.x == 0) (void)xb_add(&bar[XB_XCNT(b.x)], 1u);
    return b;
}
__device__ __forceinline__ void xcd_barrier_complete(unsigned* bar, unsigned x, unsigned& nloc, unsigned& nx) {
    const unsigned G = gridDim.x * gridDim.y * gridDim.z;
    unsigned sum, cnt, mine, sp = 0u;
    for (;;) {
        sum = 0u; cnt = 0u; mine = 0u;
#pragma unroll
        for (unsigned j = 0; j < 16; ++j) { const unsigned c = xb_ld(&bar[XB_XCNT(j)]); sum += c; cnt += (c > 0u) ? 1u : 0u; mine = (j == x) ? c : mine; }
        if (sum == G) break;
        __builtin_amdgcn_s_sleep(1);
        if ((++sp & 255u) == 0u) { if (xb_ld(&bar[XB_TMO])) break; if (sp > XB_SPIN_CAP) { atomicAdd(&bar[XB_TMO], 1u); break; } }
    }
    nloc = mine > 0u ? mine : 1u; nx = cnt > 0u ? cnt : 1u;
}
__device__ __forceinline__ void xcd_barrier(const XcdBarrier& b) {
    asm volatile("s_waitcnt vmcnt(0)" ::: "memory");
    __syncthreads();
    if (threadIdx.x == 0) {
        unsigned* bar = b.bar;
        __builtin_amdgcn_s_waitcnt(0);
        unsigned nloc = b.st[0], nx = b.st[1];
        if (nloc == 0u) { xcd_barrier_complete(bar, b.x, nloc, nx); b.st[0] = nloc; b.st[1] = nx; }
        const unsigned old = xb_add(&bar[XB_XSUB(b.x)], 1u);
        const unsigned gen = old / nloc;
        if (old + 1u == (gen + 1u) * nloc) {
            __builtin_amdgcn_fence(__ATOMIC_RELEASE, "agent");
            asm volatile("s_waitcnt vmcnt(0)" ::: "memory");
            const unsigned og = xb_add(&bar[XB_TOP], 1u);
            const unsigned tg = og / nx;
            if (og + 1u == (tg + 1u) * nx) xb_add(&bar[XB_TOPGEN], 1u);
            else XB_SPIN(xb_ld(&bar[XB_TOPGEN]) == tg, bar);
            __builtin_amdgcn_fence(__ATOMIC_ACQUIRE, "agent");
            xb_add(&bar[XB_XGEN(b.x)], 1u);
            asm volatile("s_waitcnt vmcnt(0)" ::: "memory");
        } else {
            XB_SPIN(xb_ld(&bar[XB_XGEN(b.x)]) == gen, bar);
            __builtin_amdgcn_fence(__ATOMIC_ACQUIRE, "agent");
            asm volatile("s_waitcnt vmcnt(0)" ::: "memory");
        }
    }
    __syncthreads();
}

struct Ctx {
    const float* in[22]; float* out; unsigned char* ws;
    unsigned char* lds; int tid, lane, wave, G, vb;
};
#define WSP(T_, off) ((T_*)(c.ws + (off)))
__device__ __forceinline__ Ctx reopaque(const Ctx& c0) {
    Ctx c = c0; int t = c0.tid; asm volatile("" : "+v"(t)); c.tid = t; c.lane = t & 63; c.wave = __builtin_amdgcn_readfirstlane(t >> 6);
    int vb = c0.vb; asm volatile("" : "+s"(vb)); c.vb = vb; return c;
}

__device__ __forceinline__ int lds_off(int row, int chunk) { return row * 128 + ((chunk ^ (row & 7)) << 4); }

__device__ __forceinline__ void gemm_compute_stage(f32x4 (&acc)[2][8], const unsigned char* sA, const unsigned char* sB, int wave, int lane) {
    const int r = lane & 15, q = lane >> 4;
    bf16x8 af[2][2], bfr[2][8];
#pragma unroll
    for (int ks = 0; ks < 2; ++ks) {
#pragma unroll
        for (int mi = 0; mi < 2; ++mi) af[ks][mi] = *(const bf16x8*)(sA + lds_off(32 * wave + 16 * mi + r, 4 * ks + q));
#pragma unroll
        for (int ni = 0; ni < 8; ++ni) bfr[ks][ni] = *(const bf16x8*)(sB + lds_off(16 * ni + r, 4 * ks + q));
    }
#pragma unroll
    for (int ks = 0; ks < 2; ++ks)
#pragma unroll
        for (int ni = 0; ni < 8; ++ni)
#pragma unroll
            for (int mi = 0; mi < 2; ++mi) acc[mi][ni] = __builtin_amdgcn_mfma_f32_16x16x32_bf16(bfr[ks][ni], af[ks][mi], acc[mi][ni], 0, 0, 0);
    __builtin_amdgcn_sched_group_barrier(0x100, 6, 0);
#pragma unroll
    for (int i = 0; i < 14; ++i) { __builtin_amdgcn_sched_group_barrier(0x8, 2, 0); __builtin_amdgcn_sched_group_barrier(0x100, 1, 0); }
    __builtin_amdgcn_sched_group_barrier(0x8, 4, 0);
}

#define LAS __attribute__((address_space(3)))
__device__ __forceinline__ void gemm_stage_glds(const bf16* A, int lda, const bf16* Bt, int ldb, int kt, unsigned char* stage, int wave, int lane) {
    const int rr = lane >> 3, cch = (lane & 7) ^ rr;
#pragma unroll
    for (int i = 0; i < 4; ++i) { const int pc = 4 * i + wave;
        __builtin_amdgcn_global_load_lds((const unsigned*)(A + (size_t)(8 * pc + rr) * lda + kt * 64 + cch * 8), (LAS unsigned*)(stage + pc * 1024), 16, 0, 0);
        __builtin_amdgcn_global_load_lds((const unsigned*)(Bt + (size_t)(8 * pc + rr) * ldb + kt * 64 + cch * 8), (LAS unsigned*)(stage + 16384 + pc * 1024), 16, 0, 0); }
}
__device__ __forceinline__ void gemm_core(f32x4 (&acc)[2][8], const bf16* A, int lda, const bf16* Bt, int ldb, int K, unsigned char* lds, int tid) {
    const int wave = __builtin_amdgcn_readfirstlane(tid >> 6), lane = tid & 63;
    const int nk = K >> 6;
    gemm_stage_glds(A, lda, Bt, ldb, 0, lds, wave, lane);
    asm volatile("s_waitcnt vmcnt(0)" ::: "memory");
    __syncthreads();
    for (int kt = 0; kt < nk; ++kt) {
        const int cur = kt & 1;
        if (kt + 1 < nk) gemm_stage_glds(A, lda, Bt, ldb, kt + 1, lds + (cur ^ 1) * 32768, wave, lane);
        gemm_compute_stage(acc, lds + cur * 32768, lds + cur * 32768 + 16384, wave, lane);
        asm volatile("s_waitcnt vmcnt(0)" ::: "memory");
        __syncthreads();
    }
}
__device__ __forceinline__ void acc_zero(f32x4 (&acc)[2][8]) {
#pragma unroll
    for (int mi = 0; mi < 2; ++mi)
#pragma unroll
        for (int ni = 0; ni < 8; ++ni) acc[mi][ni] = (f32x4){0.f, 0.f, 0.f, 0.f};
}
__device__ __forceinline__ float rstd_from_ssq8(const float* ssq, int tok) {
    const f32x4 a = *(const f32x4*)(ssq + (size_t)tok * 8), b = *(const f32x4*)(ssq + (size_t)tok * 8 + 4);
    const float s = ((a.x + a.y) + (a.z + a.w)) + ((b.x + b.y) + (b.z + b.w));
    return rsqrt_(s * (1.0f / 1024.0f) + EPS);
}

__device__ __forceinline__ int src_col(int mode, int np) {
    if (mode == 0) return np;
    if (mode == 2) { const int h = np >> 7, j = np & 127; return j < 96 ? h * 96 + j : -1; }
    if (np < 1024) { const int cblk = np >> 7, j = np & 127; return j < 64 ? 64 * cblk + j : 512 + 64 * cblk + (j - 64); }
    if (np < 1408) return np;
    if (np < 1536) { const int j = np - 1408; return j < 32 ? 1408 + j : -1; }
    return 1440 + (np - 1536);
}
__device__ __forceinline__ void p0_transpose_item(const float* W, int K, int N, bf16* Wt, int mode, const float* g, int item, float* scr, int lane) {
    const int nblk_k = K / 64, nb = item / nblk_k, kb = item % nblk_k, k0 = 64 * kb, n0 = 32 * nb;
    const int n = src_col(mode, n0 + (lane & 31));
    float wv[32], gv[32];
#pragma unroll
    for (int i = 0; i < 32; ++i) { const int kk = 2 * i + (lane >> 5); wv[i] = n >= 0 ? W[(size_t)(k0 + kk) * N + n] : 0.f; gv[i] = g ? g[k0 + kk] : 1.f; }
#pragma unroll
    for (int i = 0; i < 32; ++i) { const int kk = 2 * i + (lane >> 5); scr[kk * 33 + (lane & 31)] = wv[i] * gv[i]; }
    __builtin_amdgcn_s_waitcnt(0xC07F); asm volatile("" ::: "memory");
    const int cch = lane & 7;
#pragma unroll
    for (int j = 0; j < 4; ++j) { const int nl = (lane >> 3) + 8 * j; const float* s = scr + (8 * cch) * 33 + nl;
        u32x4 o; o.x = pk2(s[0 * 33], s[1 * 33]); o.y = pk2(s[2 * 33], s[3 * 33]); o.z = pk2(s[4 * 33], s[5 * 33]); o.w = pk2(s[6 * 33], s[7 * 33]);
        *(u32x4*)(Wt + (size_t)(n0 + nl) * K + k0 + 8 * cch) = o; }
    __builtin_amdgcn_s_waitcnt(0xC07F); asm volatile("" ::: "memory");
}
struct WDesc { int in_idx, K, N, Np, mode, g_idx; size_t off; };
__device__ __forceinline__ void phase_prologue(const Ctx& c0) {
    Ctx c = reopaque(c0);
    const int gw = c.vb * 4 + c.wave, NGW = c.G * 4;
    float* scr = (float*)(c.lds + c.wave * 8704);
    const WDesc wd[7] = {
        {3, 1024, NIN, NINP, 1, 2, 0}, {8, 512, 1024, 1024, 0, -1, OFF_WCO}, {10, 256, 768, 1024, 2, 9, OFF_WUQ}, {12, 128, 1024, 1024, 0, 11, OFF_WUKV},
        {15, 512, 1024, 1024, 0, -1, OFF_WMLA}, {16, 1024, 1024, 1024, 0, -1, OFF_WOUT}, {18, 1024, 2048, 2048, 0, 17, OFF_WPQ}};
    constexpr int ITEMS_PER_LAYER = (1024 / 64) * (NINP / 32) + (512 / 64) * 32 + (256 / 64) * 32 + (128 / 64) * 32 + (512 / 64) * 32 + (1024 / 64) * 32 + (1024 / 64) * 64;
    for (int it = gw; it < 2 * ITEMS_PER_LAYER; it += NGW) {
        const int l = it >= ITEMS_PER_LAYER ? 1 : 0; int r = it - l * ITEMS_PER_LAYER;
        const float* W = nullptr; const float* g = nullptr; bf16* Wt = nullptr; int K = 64, N = 32, mode = 0, rr = 0;
#pragma unroll
        for (int m = 0; m < 7; ++m) {
            const int items = (wd[m].K / 64) * (wd[m].Np / 32);
            if (r >= 0 && r < items) { K = wd[m].K; N = wd[m].N; mode = wd[m].mode; rr = r;
                W = c.in[wd[m].in_idx] + (size_t)l * wd[m].K * wd[m].N; g = wd[m].g_idx >= 0 ? c.in[wd[m].g_idx >= 0 ? wd[m].g_idx : 0] + (size_t)l * wd[m].K : nullptr;
                Wt = (bf16*)(c.ws + WS_WIN + l * SZ_WLAYER + wd[m].off); }
            r -= items;
        }
        p0_transpose_item(W, K, N, Wt, mode, g, rr, scr, c.lane);
    }
    const int gt = c.vb * NTHREADS + c.tid, NGT = c.G * NTHREADS;
    for (int l = 0; l < 2; ++l) {
        const float* src = c.in[19] + (size_t)l * 262144; bf16* dst = (bf16*)(c.ws + WS_WIN + l * SZ_WLAYER + OFF_KEYS);
        for (int i = gt; i < 262144 / 8; i += NGT) { const f32x4 a = *(const f32x4*)(src + i * 8), b = *(const f32x4*)(src + i * 8 + 4);
            u32x4 o; o.x = pk2(a.x, a.y); o.y = pk2(a.z, a.w); o.z = pk2(b.x, b.y); o.w = pk2(b.z, b.w); *(u32x4*)(dst + i * 8) = o; }
    }
    for (int l = 0; l < 2; ++l)
        for (int uv = 0; uv < 2; ++uv) {
            const float* src = c.in[20 + uv] + (size_t)l * NEXP * 1024; unsigned char* dst = c.ws + WS_TAB + (size_t)(l * 2 + uv) * SZ_TAB;
            f32x4 g4[4];
#pragma unroll
            for (int j = 0; j < 4; ++j) { const float sc = uv == 0 ? U_SCALE : TAB_SCALE; g4[j] = (f32x4){sc, sc, sc, sc}; if (uv == 0) g4[j] = g4[j] * *(const f32x4*)(c.in[17] + l * 1024 + 256 * j + 4 * c.lane); }
            for (int row = gw; row < NEXP; row += 2 * NGW) {
                const float* sp = src + (size_t)row * 1024 + 4 * c.lane; const int row2 = row + NGW; const bool two = row2 < NEXP;
                const float* sp2 = src + (size_t)(two ? row2 : row) * 1024 + 4 * c.lane;
                f32x4 a[4], b[4];
#pragma unroll
                for (int j = 0; j < 4; ++j) { a[j] = *(const f32x4*)(sp + 256 * j); b[j] = *(const f32x4*)(sp2 + 256 * j); }
#pragma unroll
                for (int j = 0; j < 4; ++j) { const f32x4 v = a[j] * g4[j];
                    if (uv == 0) *(unsigned short*)(dst + (size_t)row * 512 + 128 * j + 2 * c.lane) = (unsigned short)pack_i4x4(v);
                    else *(unsigned short*)(dst + (size_t)row * 512 + 128 * j + 2 * c.lane) = pack_fp4x4(v); }
                if (two) {
#pragma unroll
                    for (int j = 0; j < 4; ++j) { const f32x4 v = b[j] * g4[j];
                        if (uv == 0) *(unsigned short*)(dst + (size_t)row2 * 512 + 128 * j + 2 * c.lane) = (unsigned short)pack_i4x4(v);
                        else *(unsigned short*)(dst + (size_t)row2 * 512 + 128 * j + 2 * c.lane) = pack_fp4x4(v); } }
            }
        }
    { float* rope = WSP(float, WS_ROPE);
      for (int i = gt; i < L * 16; i += NGT) { const int pos = i >> 4, j = i & 15;
          const float inv = 1.0f / __builtin_exp2f((float)j * 0.8304820237218406f);
          const float angf = (float)pos * inv; const double ang = (double)angf;
          const double nq = __builtin_rint(ang * 0.63661977236758134308);
          double rr = __builtin_fma(-nq, 1.57079632679489655800e+00, ang); rr = __builtin_fma(-nq, 6.12323399573676603587e-17, rr);
          const double r2 = rr * rr;
          double sp = -1.0 / 1307674368000.0; sp = sp * r2 + 1.0 / 6227020800.0; sp = sp * r2 - 1.0 / 39916800.0; sp = sp * r2 + 1.0 / 362880.0; sp = sp * r2 - 1.0 / 5040.0; sp = sp * r2 + 1.0 / 120.0; sp = sp * r2 - 1.0 / 6.0; sp = sp * r2 * rr + rr;
          double cp = 1.0 / 87178291200.0; cp = cp * r2 - 1.0 / 479001600.0; cp = cp * r2 + 1.0 / 3628800.0; cp = cp * r2 - 1.0 / 40320.0; cp = cp * r2 + 1.0 / 720.0; cp = cp * r2 - 1.0 / 24.0; cp = cp * r2 + 0.5; cp = 1.0 - cp * r2;
          const int qd = ((int)nq) & 3;
          const double cv = qd == 0 ? cp : qd == 1 ? -sp : qd == 2 ? -cp : sp;
          const double sv_ = qd == 0 ? sp : qd == 1 ? cp : qd == 2 ? -sp : -cp;
          rope[2 * i] = (float)cv; rope[2 * i + 1] = (float)sv_; } }
    { bf16* hb = WSP(bf16, WS_HB); float* ssq = WSP(float, WS_SSQ);
      for (int t0_ = gw; t0_ < T; t0_ += 4 * NGW) {
          f32x4 v[4][4];
#pragma unroll
          for (int i = 0; i < 4; ++i) { const int t = t0_ + i * NGW < T ? t0_ + i * NGW : t0_; const int b = t / L, pos = t % L;
              const float* src = pos < NMETA ? c.in[1] + (size_t)pos * D : c.in[0] + ((size_t)b * SEQ + (pos - NMETA)) * D;
#pragma unroll
              for (int j = 0; j < 4; ++j) v[i][j] = *(const f32x4*)(src + j * 256 + c.lane * 4); }
#pragma unroll
          for (int i = 0; i < 4; ++i) { const int t = t0_ + i * NGW;
              if (t < T) { float s = 0.f;
#pragma unroll
                  for (int j = 0; j < 4; ++j) { const f32x4 x = v[i][j]; u32x2 o; o.x = pk2(x.x, x.y); o.y = pk2(x.z, x.w); *(u32x2*)(hb + (size_t)t * D + j * 256 + c.lane * 4) = o;
                      s += (x.x * x.x + x.y * x.y) + (x.z * x.z + x.w * x.w); }
                  s = wave_sum(s);
                  if (c.lane < 8) ssq[(size_t)t * 8 + c.lane] = c.lane == 0 ? s : 0.f; } }
      } }
}

__device__ __forceinline__ void phase_A(const Ctx& c0, int l) {
    Ctx c = reopaque(c0);
    const bf16* hb = WSP(bf16, WS_HB); const bf16* Wt = (const bf16*)(c.ws + WS_WIN + l * SZ_WLAYER);
    const float* ssq = WSP(float, WS_SSQ);
    bf16* uglu = WSP(bf16, WS_UGLU); bf16* cq = WSP(bf16, WS_CQ); bf16* ckv = WSP(bf16, WS_CKV); float* krope = WSP(float, WS_KROPE);
    float* ssqq = WSP(float, WS_SSQQ); float* ssqkv = WSP(float, WS_SSQKV); bf16* gates = WSP(bf16, WS_GATES);
    constexpr int NT = NINP / 128;
    const int r = c.lane & 15, q = c.lane >> 4;
    const int xcd = c.vb / (c.G / 8), lb = c.vb % (c.G / 8), xm = xcd & 1, xn = xcd >> 1;
    const int m_lo = xm ? (MT + 1) / 2 : 0, m_cnt = xm ? MT / 2 : (MT + 1) / 2;
    for (int j = lb; j < m_cnt * 7; j += c.G / 8) {
        const int mt = m_lo + j / 7, nt = xn * 7 + j % 7;
        f32x4 acc[2][8]; acc_zero(acc);
        gemm_core(acc, hb + (size_t)mt * 128 * D, D, Wt + (size_t)nt * 128 * D, D, D, c.lds, c.tid);
#pragma unroll
        for (int mi = 0; mi < 2; ++mi) {
            const int tok = mt * 128 + 32 * c.wave + 16 * mi + r;
            const float rs = rstd_from_ssq8(ssq, tok);
            if (nt < 8) {
#pragma unroll
                for (int ni = 0; ni < 4; ++ni) { const f32x4 v = acc[mi][ni] * rs, g = acc[mi][ni + 4] * rs;
                    u32x2 o; o.x = pk2(v.x * sigmoidf_(g.x), v.y * sigmoidf_(g.y)); o.y = pk2(v.z * sigmoidf_(g.z), v.w * sigmoidf_(g.w));
                    *(u32x2*)(uglu + (size_t)tok * DC + nt * 64 + 16 * ni + 4 * q) = o; }
            } else if (nt < 11) {
                bf16* dst = nt < 10 ? cq + (size_t)tok * QL + (nt - 8) * 128 : ckv + (size_t)tok * KVL;
                float ss = 0.f;
#pragma unroll
                for (int ni = 0; ni < 8; ++ni) { const f32x4 v = acc[mi][ni] * rs; ss += (v.x * v.x + v.y * v.y) + (v.z * v.z + v.w * v.w);
                    u32x2 o; o.x = pk2(v.x, v.y); o.y = pk2(v.z, v.w); *(u32x2*)(dst + 16 * ni + 4 * q) = o; }
                ss = quad_sum(ss);
                if (q == 0) { if (nt < 10) ssqq[(size_t)tok * 2 + (nt - 8)] = ss; else ssqkv[tok] = ss; }
            } else if (nt == 11) {
#pragma unroll
                for (int ni = 0; ni < 2; ++ni) *(f32x4*)(krope + (size_t)tok * 32 + 16 * ni + 4 * q) = acc[mi][ni] * rs;
            } else {
#pragma unroll
                for (int ni = 0; ni < 8; ++ni) { const f32x4 v = acc[mi][ni] * rs;
                    u32x2 o; o.x = pk2(sigmoidf_(v.x), sigmoidf_(v.y)); o.y = pk2(sigmoidf_(v.z), sigmoidf_(v.w));
                    *(u32x2*)(gates + (size_t)tok * 2048 + (nt - 12) * 128 + 16 * ni + 4 * q) = o; }
            }
        }
    }
}

__device__ __forceinline__ void phaseB_q_item(Ctx& c, int l, int mt, int head) {
    const bf16* cq = WSP(bf16, WS_CQ); const bf16* Wt = (const bf16*)(c.ws + WS_WIN + l * SZ_WLAYER + OFF_WUQ);
    const float* ssqq = WSP(float, WS_SSQQ); const float* rope = WSP(float, WS_ROPE); const float* qg = c.in[13] + l * QK; bf16* Qb = WSP(bf16, WS_Q);
    const int r = c.lane & 15, q = c.lane >> 4;
    f32x4 acc[2][8]; acc_zero(acc);
    gemm_core(acc, cq + (size_t)mt * 128 * QL, QL, Wt + (size_t)head * 128 * QL, QL, QL, c.lds, c.tid);
    constexpr float QSCALE = 0.10206207261596575f * 1.4426950408889634f;
#pragma unroll
    for (int mi = 0; mi < 2; ++mi) {
        const int tok = mt * 128 + 32 * c.wave + 16 * mi + r, b = tok / L, pos = tok - b * L;
        const float rs = rsqrt_((ssqq[(size_t)tok * 2] + ssqq[(size_t)tok * 2 + 1]) * (1.0f / 256.0f) + EPS);
        float ss = 0.f;
#pragma unroll
        for (int ni = 0; ni < 6; ++ni) { acc[mi][ni] = acc[mi][ni] * rs; const f32x4 v = acc[mi][ni]; ss += (v.x * v.x + v.y * v.y) + (v.z * v.z + v.w * v.w); }
        ss = quad_sum(ss);
        const float rn = rsqrt_(ss * (1.0f / 96.0f) + EPS) * QSCALE;
#pragma unroll
        for (int ni = 0; ni < 6; ++ni) { const f32x4 g = *(const f32x4*)(qg + 16 * ni + 4 * q); acc[mi][ni] = acc[mi][ni] * g * rn; }
        const f32x4 cs0 = *(const f32x4*)(rope + ((size_t)pos * 16 + 4 * q) * 2), cs1 = *(const f32x4*)(rope + ((size_t)pos * 16 + 4 * q) * 2 + 4);
        const float co[4] = {cs0.x, cs0.z, cs1.x, cs1.z}, si[4] = {cs0.y, cs0.w, cs1.y, cs1.w};
        f32x4 x1 = acc[mi][4], x2 = acc[mi][5];
#pragma unroll
        for (int e = 0; e < 4; ++e) { const float a = x1[e], bb = x2[e]; x1[e] = a * co[e] - bb * si[e]; x2[e] = bb * co[e] + a * si[e]; }
        acc[mi][4] = x1; acc[mi][5] = x2;
        bf16* dst = Qb + (((size_t)b * NH + head) * L + pos) * QK;
#pragma unroll
        for (int ni = 0; ni < 6; ++ni) { const f32x4 v = acc[mi][ni]; u32x2 o; o.x = pk2(v.x, v.y); o.y = pk2(v.z, v.w); *(u32x2*)(dst + 16 * ni + 4 * q) = o; }
    }
}
__device__ __forceinline__ void phaseB_kv_item(Ctx& c, int l, int mt, int head) {
    const bf16* ckv = WSP(bf16, WS_CKV); const bf16* Wt = (const bf16*)(c.ws + WS_WIN + l * SZ_WLAYER + OFF_WUKV);
    const float* ssqkv = WSP(float, WS_SSQKV); const float* rope = WSP(float, WS_ROPE); const float* kg = c.in[14] + l * QK; const float* krope = WSP(float, WS_KROPE);
    bf16* Kb = WSP(bf16, WS_K); bf16* Vt = WSP(bf16, WS_VT);
    const int tid = c.tid, wave = c.wave, lane = c.lane, r = lane & 15, q = lane >> 4;
    unsigned char* lds = c.lds;
    f32x4 ak[2][4], av[2][4];
#pragma unroll
    for (int mi = 0; mi < 2; ++mi)
#pragma unroll
        for (int ni = 0; ni < 4; ++ni) { ak[mi][ni] = (f32x4){0.f, 0.f, 0.f, 0.f}; av[mi][ni] = (f32x4){0.f, 0.f, 0.f, 0.f}; }
    { const int chunk = tid & 7, row0 = tid >> 3;
      const bf16* pa = ckv + ((size_t)mt * 128 + row0) * KVL + chunk * 8; const bf16* pb = Wt + ((size_t)head * 128 + row0) * KVL + chunk * 8;
#pragma unroll
      for (int s = 0; s < 2; ++s)
#pragma unroll
          for (int i = 0; i < 4; ++i) { *(u32x4*)(lds + s * 32768 + lds_off(row0 + 32 * i, chunk)) = *(const u32x4*)(pa + (size_t)(32 * i) * KVL + s * 64);
              *(u32x4*)(lds + s * 32768 + 16384 + lds_off(row0 + 32 * i, chunk)) = *(const u32x4*)(pb + (size_t)(32 * i) * KVL + s * 64); }
    }
    __syncthreads();
#pragma unroll
    for (int s = 0; s < 2; ++s)
#pragma unroll
        for (int ks = 0; ks < 2; ++ks) {
            const unsigned char* sA = lds + s * 32768; const unsigned char* sB = sA + 16384;
            bf16x8 af[2], bfr[8];
#pragma unroll
            for (int mi = 0; mi < 2; ++mi) af[mi] = *(const bf16x8*)(sA + lds_off(32 * wave + 16 * mi + r, 4 * ks + q));
#pragma unroll
            for (int ni = 0; ni < 8; ++ni) bfr[ni] = *(const bf16x8*)(sB + lds_off(16 * ni + r, 4 * ks + q));
#pragma unroll
            for (int mi = 0; mi < 2; ++mi)
#pragma unroll
                for (int ni = 0; ni < 4; ++ni) { ak[mi][ni] = __builtin_amdgcn_mfma_f32_16x16x32_bf16(bfr[ni], af[mi], ak[mi][ni], 0, 0, 0);
                    av[mi][ni] = __builtin_amdgcn_mfma_f32_16x16x32_bf16(af[mi], bfr[ni + 4], av[mi][ni], 0, 0, 0); }
        }
    __syncthreads();
#pragma unroll
    for (int mi = 0; mi < 2; ++mi) {
        const int tok0 = mt * 128 + 32 * wave + 16 * mi, b = tok0 / L, pos0 = tok0 - b * L;
        { const int tok = tok0 + r, pos = pos0 + r;
          const float rs = rsqrt_(ssqkv[tok] * (1.0f / 128.0f) + EPS);
          const f32x4 kr1 = *(const f32x4*)(krope + (size_t)tok * 32 + 4 * q), kr2 = *(const f32x4*)(krope + (size_t)tok * 32 + 16 + 4 * q);
          float ss = (kr1.x * kr1.x + kr1.y * kr1.y) + (kr1.z * kr1.z + kr1.w * kr1.w) + (kr2.x * kr2.x + kr2.y * kr2.y) + (kr2.z * kr2.z + kr2.w * kr2.w);
#pragma unroll
          for (int ni = 0; ni < 4; ++ni) { ak[mi][ni] = ak[mi][ni] * rs; const f32x4 v = ak[mi][ni]; ss += (v.x * v.x + v.y * v.y) + (v.z * v.z + v.w * v.w); }
          ss = quad_sum(ss);
          const float rn = rsqrt_(ss * (1.0f / 96.0f) + EPS);
          bf16* dst = Kb + (((size_t)b * NH + head) * L + pos) * QK;
#pragma unroll
          for (int ni = 0; ni < 4; ++ni) { const f32x4 g = *(const f32x4*)(kg + 16 * ni + 4 * q); const f32x4 v = ak[mi][ni] * g * rn;
              u32x2 o; o.x = pk2(v.x, v.y); o.y = pk2(v.z, v.w); *(u32x2*)(dst + 16 * ni + 4 * q) = o; }
          const f32x4 g1 = *(const f32x4*)(kg + 64 + 4 * q), g2 = *(const f32x4*)(kg + 80 + 4 * q);
          f32x4 x1 = kr1 * g1 * rn, x2 = kr2 * g2 * rn;
          const f32x4 cs0 = *(const f32x4*)(rope + ((size_t)pos * 16 + 4 * q) * 2), cs1 = *(const f32x4*)(rope + ((size_t)pos * 16 + 4 * q) * 2 + 4);
          const float co[4] = {cs0.x, cs0.z, cs1.x, cs1.z}, si[4] = {cs0.y, cs0.w, cs1.y, cs1.w};
#pragma unroll
          for (int e = 0; e < 4; ++e) { const float a = x1[e], bb = x2[e]; x1[e] = a * co[e] - bb * si[e]; x2[e] = bb * co[e] + a * si[e]; }
          u32x2 o1, o2; o1.x = pk2(x1.x, x1.y); o1.y = pk2(x1.z, x1.w); o2.x = pk2(x2.x, x2.y); o2.y = pk2(x2.z, x2.w);
          *(u32x2*)(dst + 64 + 4 * q) = o1; *(u32x2*)(dst + 80 + 4 * q) = o2; }
        { const f32x4 sq = *(const f32x4*)(ssqkv + tok0 + 4 * q);
          f32x4 rs4; rs4.x = rsqrt_(sq.x * (1.0f / 128.0f) + EPS); rs4.y = rsqrt_(sq.y * (1.0f / 128.0f) + EPS); rs4.z = rsqrt_(sq.z * (1.0f / 128.0f) + EPS); rs4.w = rsqrt_(sq.w * (1.0f / 128.0f) + EPS);
#pragma unroll
          for (int ni = 0; ni < 4; ++ni) { const f32x4 v = av[mi][ni] * rs4; u32x2 o; o.x = pk2(v.x, v.y); o.y = pk2(v.z, v.w);
              *(u32x2*)(Vt + (((size_t)b * NH + head) * VD + 16 * ni + r) * L + pos0 + 4 * q) = o; } }
    }
}
__device__ __forceinline__ u32x4 conv_row(const bf16* uglu, int b, int pos, int ch) {
    u32x4 xv = (u32x4){0u, 0u, 0u, 0u};
    if (pos >= 0) xv = *(const u32x4*)(uglu + ((size_t)b * L + pos) * DC + ch);
    return xv;
}
__device__ __forceinline__ void conv_fma(float (&a)[8], const u32x4 xv, const f32x4 w0, const f32x4 w1) {
    a[0] += bf_lo(xv.x) * w0.x; a[1] += bf_hi(xv.x) * w0.y; a[2] += bf_lo(xv.y) * w0.z; a[3] += bf_hi(xv.y) * w0.w;
    a[4] += bf_lo(xv.z) * w1.x; a[5] += bf_hi(xv.z) * w1.y; a[6] += bf_lo(xv.w) * w1.z; a[7] += bf_hi(xv.w) * w1.w;
}
__device__ __forceinline__ void phaseB_conv_item(Ctx& c, int l, int grp) {
    const bf16* uglu = WSP(bf16, WS_UGLU); bf16* u2 = WSP(bf16, WS_U2);
    const float* cw = c.in[4] + (size_t)l * CW * DC; const float* cb = c.in[5] + l * DC; const float* lg = c.in[6] + l * DC; const float* lb = c.in[7] + l * DC;
    const int tok0 = grp * 4, b = tok0 / L, pos0 = tok0 - b * L, ch = c.lane * 8;
    float acc[4][8];
    { const f32x4 b0 = *(const f32x4*)(cb + ch), b1 = *(const f32x4*)(cb + ch + 4);
#pragma unroll
      for (int d = 0; d < 4; ++d) { acc[d][0] = b0.x; acc[d][1] = b0.y; acc[d][2] = b0.z; acc[d][3] = b0.w; acc[d][4] = b1.x; acc[d][5] = b1.y; acc[d][6] = b1.z; acc[d][7] = b1.w; } }
    const int base = pos0 - 30;
    u32x4 x0 = conv_row(uglu, b, base + 0, ch), x1 = conv_row(uglu, b, base + 1, ch), x2 = conv_row(uglu, b, base + 2, ch),
          x3 = conv_row(uglu, b, base + 3, ch), x4 = conv_row(uglu, b, base + 4, ch), x5;
    const float* wp = cw + ch;
#pragma unroll 1
    for (int w = 0; w < CW; ++w) {
        x5 = conv_row(uglu, b, (w + 5 <= 33) ? base + w + 5 : -1, ch);
        const f32x4 w0 = *(const f32x4*)wp, w1 = *(const f32x4*)(wp + 4); wp += DC;
        conv_fma(acc[0], x0, w0, w1); conv_fma(acc[1], x1, w0, w1); conv_fma(acc[2], x2, w0, w1); conv_fma(acc[3], x3, w0, w1);
        x0 = x1; x1 = x2; x2 = x3; x3 = x4; x4 = x5;
    }
    const f32x4 g0 = *(const f32x4*)(lg + ch), g1 = *(const f32x4*)(lg + ch + 4), e0 = *(const f32x4*)(lb + ch), e1 = *(const f32x4*)(lb + ch + 4);
    const float gg[8] = {g0.x, g0.y, g0.z, g0.w, g1.x, g1.y, g1.z, g1.w}, be[8] = {e0.x, e0.y, e0.z, e0.w, e1.x, e1.y, e1.z, e1.w};
#pragma unroll
    for (int d = 0; d < 4; ++d) {
        float s = 0.f;
#pragma unroll
        for (int j = 0; j < 8; ++j) s += acc[d][j];
        const float mu = wave_sum(s) * (1.0f / 512.0f);
        float vq = 0.f;
#pragma unroll
        for (int j = 0; j < 8; ++j) { acc[d][j] -= mu; vq += acc[d][j] * acc[d][j]; }
        const float rstd = rsqrt_(wave_sum(vq) * (1.0f / 512.0f) + EPS);
        float y[8];
#pragma unroll
        for (int j = 0; j < 8; ++j) { const float v = acc[d][j] * rstd * gg[j] + be[j]; y[j] = v * sigmoidf_(v); }
        u32x4 o; o.x = pk2(y[0], y[1]); o.y = pk2(y[2], y[3]); o.z = pk2(y[4], y[5]); o.w = pk2(y[6], y[7]);
        *(u32x4*)(u2 + (size_t)(tok0 + d) * DC + ch) = o;
    }
}
__device__ __forceinline__ void phase_B(const Ctx& c0, int l) {
    Ctx c = reopaque(c0);
    constexpr int NQ = MT * NH, NKV = MT * NH, NCV = T / 16;
    for (int it = c.vb; it < NQ + NKV + NCV; it += c.G) {
        if (it < NQ) phaseB_q_item(c, l, it / NH, it % NH);
        else if (it < NQ + NKV) phaseB_kv_item(c, l, (it - NQ) / NH, (it - NQ) % NH);
        else phaseB_conv_item(c, l, (it - NQ - NKV) * 4 + c.wave);
    }
}

constexpr int KROW = 208, VROW = 136, ATT_STAGE = 64 * KROW + 64 * VROW;
constexpr int ATT_ITEMS = NB * NH * 17;
__device__ __forceinline__ void phase_C(const Ctx& c0, int l) {
    Ctx c = reopaque(c0);
    const bf16* Qb = WSP(bf16, WS_Q); const bf16* Kb = WSP(bf16, WS_K); const bf16* Vt = WSP(bf16, WS_VT); bf16* O = WSP(bf16, WS_O);
    unsigned* qctr = WSP(unsigned, WS_CTL) + CW_QUEUE + 64 * l;
    volatile unsigned* misc = (volatile unsigned*)(c.lds + LDS_MISC);
    const int tid = c.tid, wave = c.wave, lane = c.lane, r = lane & 15, q = lane >> 4;
    unsigned char* lds = c.lds;
    for (;;) {
        if (tid == 0) misc[4] = atomicAdd(qctr, 1u);
        __syncthreads();
        const int item = __builtin_amdgcn_readfirstlane((int)misc[4]);
        __syncthreads();
        if (item >= ATT_ITEMS) break;
        const int pp = 15 - item / 64, bh = item % 64, b = bh / NH, h = bh % NH;
        const bool meta = pp < 0;
        const int r0 = meta ? 0 : 16 + 128 * pp;
        const int nfull = meta ? 0 : 2 * pp + 1 + (wave >> 1);
        const int ntiles = meta ? 1 : 2 * pp + 3;
        const bf16* Kbase = Kb + (size_t)bh * L * QK; const bf16* Vbase = Vt + (size_t)bh * VD * L;
        bf16x8 qf[2][3];
#pragma unroll
        for (int mi = 0; mi < 2; ++mi)
#pragma unroll
            for (int ks = 0; ks < 3; ++ks) qf[mi][ks] = *(const bf16x8*)(Qb + ((size_t)bh * L + r0 + 32 * wave + 16 * mi + r) * QK + 32 * ks + 8 * q);
        float m[2] = {-1e30f, -1e30f}, lsum[2] = {0.f, 0.f};
        f32x4 o[2][4];
#pragma unroll
        for (int mi = 0; mi < 2; ++mi)
#pragma unroll
            for (int dt = 0; dt < 4; ++dt) o[mi][dt] = (f32x4){0.f, 0.f, 0.f, 0.f};
        u32x4 rk[3], rv[2];
        auto gload = [&](int kt) {
#pragma unroll
            for (int i = 0; i < 3; ++i) { const int id = tid + 256 * i, row = id / 12, cc = id % 12; rk[i] = *(const u32x4*)(Kbase + (size_t)(kt * 64 + row) * QK + cc * 8); }
#pragma unroll
            for (int i = 0; i < 2; ++i) { const int id = tid + 256 * i, row = id >> 3, cc = id & 7; rv[i] = *(const u32x4*)(Vbase + (size_t)row * L + kt * 64 + cc * 8); }
        };
        auto lstore = [&](int s) {
            unsigned char* st = lds + s * ATT_STAGE;
#pragma unroll
            for (int i = 0; i < 3; ++i) { const int id = tid + 256 * i, row = id / 12, cc = id % 12; *(u32x4*)(st + row * KROW + cc * 16) = rk[i]; }
#pragma unroll
            for (int i = 0; i < 2; ++i) { const int id = tid + 256 * i, row = id >> 3, cc = id & 7; u32x2* d = (u32x2*)(st + 64 * KROW + row * VROW + cc * 16); d[0] = (u32x2){rv[i].x, rv[i].y}; d[1] = (u32x2){rv[i].z, rv[i].w}; }
        };
        gload(0); lstore(0);
#pragma unroll
        for (int mi = 0; mi < 2; ++mi)
#pragma unroll
            for (int ks = 0; ks < 3; ++ks) asm volatile("" : "+v"(qf[mi][ks]));
        __syncthreads();
        for (int kt = 0; kt < ntiles; ++kt) {
            const int cur = kt & 1;
            if (kt + 1 < ntiles) gload(kt + 1);
            const unsigned char* sK = lds + cur * ATT_STAGE; const unsigned char* sV = sK + 64 * KROW;
            const bool full = kt < nfull;
            if (kt <= nfull) {
                f32x4 s[2][4];
#pragma unroll
                for (int kh = 0; kh < 2; ++kh) {
                    bf16x8 kf[2][3];
#pragma unroll
                    for (int kk = 0; kk < 2; ++kk) if ((kh == 0 && kk == 0) || full) {
#pragma unroll
                        for (int ks = 0; ks < 3; ++ks) kf[kk][ks] = *(const bf16x8*)(sK + (16 * (2 * kh + kk) + r) * KROW + 64 * ks + 16 * q); }
#pragma unroll
                    for (int kk = 0; kk < 2; ++kk) { const int k4 = 2 * kh + kk;
#pragma unroll
                        for (int mi = 0; mi < 2; ++mi) s[mi][k4] = (f32x4){0.f, 0.f, 0.f, 0.f};
                        if (k4 == 0 || full) {
#pragma unroll
                            for (int ks = 0; ks < 3; ++ks)
#pragma unroll
                                for (int mi = 0; mi < 2; ++mi) s[mi][k4] = __builtin_amdgcn_mfma_f32_16x16x32_bf16(kf[kk][ks], qf[mi][ks], s[mi][k4], 0, 0, 0);
                        }
                    }
                }
                u32x2 vlo[4], vhi[4];
#pragma unroll
                for (int dt = 0; dt < 4; ++dt) { const unsigned char* vp = sV + (16 * dt + r) * VROW + (4 * q) * 2;
                    vlo[dt] = *(const u32x2*)vp; vhi[dt] = (u32x2){0u, 0u}; if (full) vhi[dt] = *(const u32x2*)(vp + 32); }
                bf16x8 pf[2][2];
#pragma unroll
                for (int mi = 0; mi < 2; ++mi) {
                    float mx = fmaxf(fmaxf(s[mi][0].x, s[mi][0].y), fmaxf(s[mi][0].z, s[mi][0].w));
                    if (full) {
#pragma unroll
                        for (int k4 = 1; k4 < 4; ++k4) mx = fmaxf(mx, fmaxf(fmaxf(s[mi][k4].x, s[mi][k4].y), fmaxf(s[mi][k4].z, s[mi][k4].w)));
                    }
                    mx = quad_max(mx);
                    const float mn = fmaxf(m[mi], mx), alpha = fast_exp2(m[mi] - mn); m[mi] = mn;
                    float ps = 0.f;
#pragma unroll
                    for (int k4 = 0; k4 < 4; ++k4) {
                        if (k4 == 0 || full) { f32x4 p; p.x = fast_exp2(s[mi][k4].x - mn); p.y = fast_exp2(s[mi][k4].y - mn); p.z = fast_exp2(s[mi][k4].z - mn); p.w = fast_exp2(s[mi][k4].w - mn);
                            ps += (p.x + p.y) + (p.z + p.w); s[mi][k4] = p; }
                    }
                    lsum[mi] = lsum[mi] * alpha + ps;
#pragma unroll
                    for (int dt = 0; dt < 4; ++dt) o[mi][dt] = o[mi][dt] * alpha;
#pragma unroll
                    for (int st = 0; st < 2; ++st) { u32x4 pw;
                        pw.x = pk2(s[mi][2 * st].x, s[mi][2 * st].y); pw.y = pk2(s[mi][2 * st].z, s[mi][2 * st].w); pw.z = pk2(s[mi][2 * st + 1].x, s[mi][2 * st + 1].y); pw.w = pk2(s[mi][2 * st + 1].z, s[mi][2 * st + 1].w);
                        if (!full) { pw.z = 0u; pw.w = 0u; }
                        pf[mi][st] = __builtin_bit_cast(bf16x8, pw); }
                }
                u32x2 wlo[4], whi[4];
                if (full) {
#pragma unroll
                    for (int dt = 0; dt < 4; ++dt) { const unsigned char* vp = sV + (16 * dt + r) * VROW + (32 + 4 * q) * 2; wlo[dt] = *(const u32x2*)vp; whi[dt] = *(const u32x2*)(vp + 32); } }
#pragma unroll
                for (int dt = 0; dt < 4; ++dt) { const bf16x8 vf = __builtin_bit_cast(bf16x8, (u32x4){vlo[dt].x, vlo[dt].y, vhi[dt].x, vhi[dt].y});
#pragma unroll
                    for (int mi = 0; mi < 2; ++mi) o[mi][dt] = __builtin_amdgcn_mfma_f32_16x16x32_bf16(vf, pf[mi][0], o[mi][dt], 0, 0, 0); }
                if (full) {
#pragma unroll
                    for (int dt = 0; dt < 4; ++dt) { const bf16x8 vf = __builtin_bit_cast(bf16x8, (u32x4){wlo[dt].x, wlo[dt].y, whi[dt].x, whi[dt].y});
#pragma unroll
                        for (int mi = 0; mi < 2; ++mi) o[mi][dt] = __builtin_amdgcn_mfma_f32_16x16x32_bf16(vf, pf[mi][1], o[mi][dt], 0, 0, 0); } }
            }
            if (kt + 1 < ntiles) lstore(cur ^ 1);
            __syncthreads();
        }
#pragma unroll
        for (int mi = 0; mi < 2; ++mi) {
            const float lt = quad_sum(lsum[mi]);
            if (!meta || (wave == 0 && mi == 0)) {
                const float inv = 1.0f / lt;
                bf16* dst = O + ((size_t)b * L + r0 + 32 * wave + 16 * mi + r) * 512 + h * VD;
#pragma unroll
                for (int dt = 0; dt < 4; ++dt) { const f32x4 v = o[mi][dt] * inv; u32x2 ov; ov.x = pk2(v.x, v.y); ov.y = pk2(v.z, v.w); *(u32x2*)(dst + 16 * dt + 4 * q) = ov; }
            }
        }
    }
}

__device__ __forceinline__ int tile_tok0(int mt, int l) { return l == 1 ? mt * 128 + NMETA * ((mt >> 4) + 1) : mt * 128; }
__device__ __forceinline__ int n_mtiles(int l) { return l == 1 ? 128 : MT; }
__device__ __forceinline__ void phase_D(const Ctx& c0, int l) {
    Ctx c = reopaque(c0);
    const bf16* u2 = WSP(bf16, WS_U2); const bf16* O = WSP(bf16, WS_O); const bf16* gates = WSP(bf16, WS_GATES); bf16* merged = WSP(bf16, WS_MERGED);
    const bf16* Wco = (const bf16*)(c.ws + WS_WIN + l * SZ_WLAYER + OFF_WCO); const bf16* Wmla = (const bf16*)(c.ws + WS_WIN + l * SZ_WLAYER + OFF_WMLA);
    const int r = c.lane & 15, q = c.lane >> 4;
    for (int it = c.vb; it < n_mtiles(l) * 8; it += c.G) {
        const int mt = it / 8, nt = it % 8, tk0 = tile_tok0(mt, l);
        f32x4 acc[2][8]; acc_zero(acc);
        gemm_core(acc, u2 + (size_t)tk0 * 512, 512, Wco + (size_t)nt * 128 * 512, 512, 512, c.lds, c.tid);
#pragma unroll
        for (int mi = 0; mi < 2; ++mi) { const int tok = tk0 + 32 * c.wave + 16 * mi + r;
            const bf16* gp = gates + (size_t)tok * 2048 + nt * 128 + 4 * q; bf16* mp = merged + (size_t)tok * D + nt * 128 + 4 * q;
#pragma unroll
            for (int ni = 0; ni < 8; ++ni) { const u32x2 g = *(const u32x2*)(gp + 16 * ni); const f32x4 v = acc[mi][ni];
                u32x2 o; o.x = pk2(v.x * bf_lo(g.x), v.y * bf_hi(g.x)); o.y = pk2(v.z * bf_lo(g.y), v.w * bf_hi(g.y)); *(u32x2*)(mp + 16 * ni) = o; } }
        acc_zero(acc);
        gemm_core(acc, O + (size_t)tk0 * 512, 512, Wmla + (size_t)nt * 128 * 512, 512, 512, c.lds, c.tid);
#pragma unroll
        for (int mi = 0; mi < 2; ++mi) { const int tok = tk0 + 32 * c.wave + 16 * mi + r;
            const bf16* gp = gates + (size_t)tok * 2048 + 1024 + nt * 128 + 4 * q; bf16* mp = merged + (size_t)tok * D + nt * 128 + 4 * q;
#pragma unroll
            for (int ni = 0; ni < 8; ++ni) { const u32x2 g = *(const u32x2*)(gp + 16 * ni); const u32x2 s = *(const u32x2*)(mp + 16 * ni); const f32x4 v = acc[mi][ni];
                u32x2 o; o.x = pk2(bf_lo(s.x) + v.x * bf_lo(g.x), bf_hi(s.x) + v.y * bf_hi(g.x)); o.y = pk2(bf_lo(s.y) + v.z * bf_lo(g.y), bf_hi(s.y) + v.w * bf_hi(g.y));
                *(u32x2*)(mp + 16 * ni) = o; } }
    }
}

__device__ __forceinline__ void phase_E(const Ctx& c0, int l) {
    Ctx c = reopaque(c0);
    const bf16* merged = WSP(bf16, WS_MERGED); const bf16* Wout = (const bf16*)(c.ws + WS_WIN + l * SZ_WLAYER + OFF_WOUT);
    float* h = WSP(float, WS_H); bf16* hb = WSP(bf16, WS_HB); float* ssq = WSP(float, WS_SSQ);
    const int r = c.lane & 15, q = c.lane >> 4;
    for (int it = c.vb; it < n_mtiles(l) * 8; it += c.G) {
        const int mt = it / 8, nt = it % 8, tk0 = tile_tok0(mt, l);
        f32x4 acc[2][8];
#pragma unroll
        for (int mi = 0; mi < 2; ++mi) { const int tok = tk0 + 32 * c.wave + 16 * mi + r; const float* hp = h + (size_t)tok * D;
            if (l == 0) { const int b = tok / L, pos = tok - b * L; hp = pos < NMETA ? c.in[1] + (size_t)pos * D : c.in[0] + ((size_t)b * SEQ + (pos - NMETA)) * D; }
            hp += nt * 128 + 4 * q;
#pragma unroll
            for (int ni = 0; ni < 8; ++ni) acc[mi][ni] = *(const f32x4*)(hp + 16 * ni); }
        gemm_core(acc, merged + (size_t)tk0 * D, D, Wout + (size_t)nt * 128 * D, D, D, c.lds, c.tid);
#pragma unroll
        for (int mi = 0; mi < 2; ++mi) { const int tok = tk0 + 32 * c.wave + 16 * mi + r; float ss = 0.f;
#pragma unroll
            for (int ni = 0; ni < 8; ++ni) { float* hp = h + (size_t)tok * D + nt * 128 + 16 * ni + 4 * q; const f32x4 v = acc[mi][ni]; *(f32x4*)hp = v;
                ss += (v.x * v.x + v.y * v.y) + (v.z * v.z + v.w * v.w);
                u32x2 o; o.x = pk2(v.x, v.y); o.y = pk2(v.z, v.w); *(u32x2*)(hb + (size_t)tok * D + nt * 128 + 16 * ni + 4 * q) = o; }
            ss = quad_sum(ss);
            if (q == 0) ssq[(size_t)tok * 8 + nt] = ss; }
    }
}

__device__ __forceinline__ unsigned f2key(float f) { const unsigned u = __float_as_uint(f); return u ^ ((u >> 31) ? 0xFFFFFFFFu : 0x80000000u); }
__device__ __forceinline__ float key2f(unsigned k) { const unsigned u = (k >> 31) ? (k ^ 0x80000000u) : ~k; return __uint_as_float(u); }
__device__ __forceinline__ void top16_insert(unsigned (&lst)[16], unsigned x) {
#pragma unroll
    for (int i = 0; i < 16; ++i) { const unsigned a = lst[i]; lst[i] = a > x ? a : x; x = a > x ? x : a; }
}
__device__ __forceinline__ void ce_desc(unsigned& a, unsigned& b) { const unsigned mx = a > b ? a : b, mn = a > b ? b : a; a = mx; b = mn; }
__device__ __forceinline__ void sort16_desc(unsigned (&v)[16]) {
#pragma unroll
    for (int k = 2; k <= 16; k <<= 1)
#pragma unroll
        for (int j = k >> 1; j > 0; j >>= 1)
#pragma unroll
            for (int i = 0; i < 16; ++i) { const int p = i ^ j; if (p > i) { if ((i & k) == 0) ce_desc(v[i], v[p]); else ce_desc(v[p], v[i]); } }
}
__device__ __forceinline__ void merge_top16(unsigned (&a)[16], const unsigned (&b)[16]) {
#pragma unroll
    for (int i = 0; i < 16; ++i) a[i] = a[i] > b[15 - i] ? a[i] : b[15 - i];
#pragma unroll
    for (int j = 8; j > 0; j >>= 1)
#pragma unroll
        for (int i = 0; i < 16; ++i) { const int p = i ^ j; if (p > i) ce_desc(a[i], a[p]); }
}
__device__ __forceinline__ void phase_F(const Ctx& c0, int l) {
    Ctx c = reopaque(c0);
    const bf16* hb = WSP(bf16, WS_HB); const bf16* Wpq = (const bf16*)(c.ws + WS_WIN + l * SZ_WLAYER + OFF_WPQ); const bf16* keys = (const bf16*)(c.ws + WS_WIN + l * SZ_WLAYER + OFF_KEYS);
    const float* ssq = WSP(float, WS_SSQ); float* sv = WSP(float, WS_SV); unsigned char* si = WSP(unsigned char, WS_SI);
    const int tid = c.tid, wave = c.wave, lane = c.lane, r = lane & 15, q = lane >> 4;
    unsigned char* lds = c.lds;
    const int xcd = c.vb / (c.G / 8), lb = c.vb % (c.G / 8), xm = xcd & 1, xn = xcd >> 1, nmt = n_mtiles(l);
    const int m_lo = xm ? (nmt + 1) / 2 : 0, m_cnt = xm ? nmt / 2 : (nmt + 1) / 2;
    for (int j = lb; j < m_cnt * 4; j += c.G / 8) {
        const int mt = m_lo + j / 4, hp = xn * 4 + j % 4, tk0 = tile_tok0(mt, l);
        f32x4 acc[2][8]; acc_zero(acc);
        u32x4 kreg[2][4]; float rsv[2];
        { const int chunk = tid & 7, row0 = tid >> 3; const bf16* pb = keys + ((size_t)hp * 128 + row0) * 128 + chunk * 8;
#pragma unroll
          for (int s = 0; s < 2; ++s)
#pragma unroll
              for (int i = 0; i < 4; ++i) kreg[s][i] = *(const u32x4*)(pb + (size_t)(32 * i) * 128 + s * 64); }
#pragma unroll
        for (int mi = 0; mi < 2; ++mi) rsv[mi] = rstd_from_ssq8(ssq, tk0 + 32 * wave + 16 * mi + r);
        gemm_core(acc, hb + (size_t)tk0 * D, D, Wpq + (size_t)hp * 128 * D, D, D, lds, tid);
#pragma unroll
        for (int mi = 0; mi < 2; ++mi) { const int row = 32 * wave + 16 * mi + r; const float rs = rsv[mi];
#pragma unroll
            for (int ni = 0; ni < 8; ++ni) { const f32x4 v = acc[mi][ni] * rs; u32x2 o; o.x = pk2(v.x, v.y); o.y = pk2(v.z, v.w);
                *(u32x2*)(lds + (ni >> 2) * 32768 + lds_off(row, 2 * (ni & 3) + (q >> 1)) + 8 * (q & 1)) = o; } }
        { const int chunk = tid & 7, row0 = tid >> 3;
#pragma unroll
          for (int s = 0; s < 2; ++s)
#pragma unroll
              for (int i = 0; i < 4; ++i) *(u32x4*)(lds + s * 32768 + 16384 + lds_off(row0 + 32 * i, chunk)) = kreg[s][i]; }
        __syncthreads();
        acc_zero(acc);
        gemm_compute_stage(acc, lds, lds + 16384, wave, lane);
        gemm_compute_stage(acc, lds + 32768, lds + 32768 + 16384, wave, lane);
        __syncthreads();
        float* S = (float*)lds;
#pragma unroll
        for (int mi = 0; mi < 2; ++mi) { const int row = 32 * wave + 16 * mi + r;
#pragma unroll
            for (int ni = 0; ni < 8; ++ni) *(f32x4*)(S + row * 132 + 16 * ni + 4 * q) = acc[mi][ni]; }
        __syncthreads();
        {
            const int tl = 32 * wave + (lane & 31), half = lane >> 5;
            const float* row = S + tl * 132;
            unsigned lst[16];
#pragma unroll
            for (int g = 0; g < 4; ++g) {
                unsigned cur[16];
#pragma unroll
                for (int j = 0; j < 4; ++j) { const int col = 64 * half + 16 * g + 4 * j; const f32x4 v = *(const f32x4*)(row + col);
                    cur[4 * j] = (f2key(v.x) & ~127u) | (unsigned)(127 - col); cur[4 * j + 1] = (f2key(v.y) & ~127u) | (unsigned)(127 - (col + 1));
                    cur[4 * j + 2] = (f2key(v.z) & ~127u) | (unsigned)(127 - (col + 2)); cur[4 * j + 3] = (f2key(v.w) & ~127u) | (unsigned)(127 - (col + 3)); }
                sort16_desc(cur);
                if (g == 0) {
#pragma unroll
                    for (int i = 0; i < 16; ++i) lst[i] = cur[i];
                } else merge_top16(lst, cur);
            }
            unsigned oth[16];
#pragma unroll
            for (int i = 0; i < 16; ++i) { auto rr = __builtin_amdgcn_permlane32_swap(lst[i], lst[i], false, false); oth[i] = half == 0 ? rr[1] : rr[0]; }
            merge_top16(lst, oth);
            if (half == 0) {
                const int tok = tk0 + tl;
                unsigned idx[16]; float val[16];
#pragma unroll
                for (int i = 0; i < 16; ++i) { idx[i] = 127u - (lst[i] & 127u); val[i] = row[idx[i]]; }
                float* svp = sv + ((size_t)tok * 16 + hp) * 16;
#pragma unroll
                for (int i = 0; i < 4; ++i) *(f32x4*)(svp + 4 * i) = (f32x4){val[4 * i], val[4 * i + 1], val[4 * i + 2], val[4 * i + 3]};
                u32x4 pi;
                pi.x = idx[0] | (idx[1] << 8) | (idx[2] << 16) | (idx[3] << 24); pi.y = idx[4] | (idx[5] << 8) | (idx[6] << 16) | (idx[7] << 24);
                pi.z = idx[8] | (idx[9] << 8) | (idx[10] << 16) | (idx[11] << 24); pi.w = idx[12] | (idx[13] << 8) | (idx[14] << 16) | (idx[15] << 24);
                *(u32x4*)(si + ((size_t)tok * 16 + hp) * 16) = pi;
            }
        }
        __syncthreads();
    }
}

__device__ __forceinline__ void phase_F3(const Ctx& c0, int l) {
    Ctx c = reopaque(c0);
    const float* sv = WSP(float, WS_SV); const unsigned char* si = WSP(unsigned char, WS_SI); int* eidx = WSP(int, WS_EIDX); float* gw = WSP(float, WS_GW); unsigned char* stb = WSP(unsigned char, WS_STB);
    float* lsv = (float*)c.lds;
    unsigned char* lsi = c.lds + 256 * 33 * 4;
    const int tid = c.tid;
    const int ntok = l == 1 ? NB * SEQ : T;
    for (int base = c.vb * NTHREADS; base < ntok * 8; base += c.G * NTHREADS) {
        const int thc = base + tid, tkc = thc >> 3;
        const int th = (l == 1 ? tkc + NMETA * ((tkc >> 11) + 1) : tkc) * 8 + (thc & 7);
        float a[16], b[16];
#pragma unroll
        for (int i = 0; i < 4; ++i) { const f32x4 x = *(const f32x4*)(sv + (size_t)th * 32 + 4 * i), y = *(const f32x4*)(sv + (size_t)th * 32 + 16 + 4 * i);
            a[4 * i] = x.x; a[4 * i + 1] = x.y; a[4 * i + 2] = x.z; a[4 * i + 3] = x.w; b[4 * i] = y.x; b[4 * i + 1] = y.y; b[4 * i + 2] = y.z; b[4 * i + 3] = y.w; }
        const u32x4 ia = *(const u32x4*)(si + (size_t)th * 32), ib = *(const u32x4*)(si + (size_t)th * 32 + 16);
#pragma unroll
        for (int i = 0; i < 16; ++i) { lsv[tid * 33 + i] = a[i]; lsv[tid * 33 + 16 + i] = b[i]; }
        *(u32x4*)(lsi + tid * 32) = ia; *(u32x4*)(lsi + tid * 32 + 16) = ib;
        unsigned lst[16], g2[16], g3[16], g4[16];
#pragma unroll
        for (int j = 0; j < 16; ++j) lst[j] = (f2key(a[0] + b[j]) & ~255u) | (unsigned)(255 - j);
#pragma unroll
        for (int i = 1; i < 16; ++i) g2[i - 1] = (f2key(a[i] + b[0]) & ~255u) | (unsigned)(255 - i * 16);
        g2[15] = 0u;
        { int n = 0;
#pragma unroll
          for (int i = 1; i < 16; ++i)
#pragma unroll
              for (int j = 1; j < 16; ++j)
                  if ((i + 1) * (j + 1) <= 16) { const unsigned key = (f2key(a[i] + b[j]) & ~255u) | (unsigned)(255 - (i * 16 + j)); if (n < 16) g3[n] = key; else g4[n - 16] = key; ++n; }
#pragma unroll
          for (int k = 3; k < 16; ++k) g4[k] = 0u; }
        sort16_desc(g3); sort16_desc(g4);
        merge_top16(lst, g2); merge_top16(g3, g4); merge_top16(lst, g3);
        __builtin_amdgcn_s_waitcnt(0xC07F); asm volatile("" ::: "memory");
        float s[16]; int e[16];
#pragma unroll
        for (int k = 0; k < 16; ++k) { const unsigned code = 255u - (lst[k] & 255u); const int i = code >> 4, j = code & 15;
            s[k] = lsv[tid * 33 + i] + lsv[tid * 33 + 16 + j]; e[k] = (int)lsi[tid * 32 + i] * 128 + (int)lsi[tid * 32 + 16 + j]; }
        float mx = s[0];
#pragma unroll
        for (int k = 1; k < 16; ++k) mx = fmaxf(mx, s[k]);
        float sum = 0.f;
#pragma unroll
        for (int k = 0; k < 16; ++k) { s[k] = fast_exp2((s[k] - mx) * 1.4426950409f); sum += s[k]; }
        const float inv = 1.0f / sum;
        typedef unsigned long long u64;
        u64 hlo = 0ull, hhi = 0ull;
#pragma unroll
        for (int k = 0; k < 16; ++k) { const int sl = e[k] >> 10; if (sl < 8) hlo += 1ull << (8 * sl); else hhi += 1ull << (8 * (sl - 8)); }
        u64 ilo = hlo, ihi = hhi;
#pragma unroll
        for (int d = 1; d < 8; d <<= 1) { const u64 a_ = __shfl_up(ilo, d, 8), b_ = __shfl_up(ihi, d, 8); if ((tid & 7) >= d) { ilo += a_; ihi += b_; } }
        const u64 tlo = __shfl(ilo, 7, 8), thi = __shfl(ihi, 7, 8);
        const u64 ones = 0x0101010101010101ull;
        const u64 inlo = tlo * ones, inhi = thi * ones + (inlo >> 56) * ones;
        const u64 stlo = inlo - tlo, sthi = inhi - thi;
        u64 rlo = stlo + (ilo - hlo), rhi = sthi + (ihi - hhi);
        const int tokn = th >> 3;
#pragma unroll
        for (int k = 0; k < 16; ++k) { const int sl = e[k] >> 10; int pos;
            if (sl < 8) { pos = (int)((rlo >> (8 * sl)) & 255ull); rlo += 1ull << (8 * sl); } else { pos = (int)((rhi >> (8 * (sl - 8))) & 255ull); rhi += 1ull << (8 * (sl - 8)); }
            eidx[(size_t)tokn * 128 + pos] = e[k]; gw[(size_t)tokn * 128 + pos] = s[k] * inv; }
        if ((tid & 7) == 0) { u64* sp = (u64*)(stb + (size_t)tokn * 16); sp[0] = stlo; sp[1] = sthi; }
        __builtin_amdgcn_s_waitcnt(0xC07F); asm volatile("" ::: "memory");
    }
}

typedef float f32x2 __attribute__((ext_vector_type(2)));
constexpr int G2_WSTRIDE = 14336, G2_MAXTOK = 9;
__device__ __forceinline__ float fp8dot4(unsigned w, unsigned x01, unsigned x23, float acc) {
    const bf16x2 lo = __builtin_amdgcn_cvt_scalef32_pk_bf16_fp8(w, 1.0f, false), hi = __builtin_amdgcn_cvt_scalef32_pk_bf16_fp8(w, 1.0f, true);
    acc = __builtin_amdgcn_fdot2_f32_bf16(lo, __builtin_bit_cast(bf16x2, x01), acc, false);
    return __builtin_amdgcn_fdot2_f32_bf16(hi, __builtin_bit_cast(bf16x2, x23), acc, false);
}
__device__ __forceinline__ float reduce8_transposed(const float (&p)[8], int lane) {
    float s[4];
#pragma unroll
    for (int k = 0; k < 4; ++k) { auto r = __builtin_amdgcn_permlane32_swap(__float_as_uint(p[k]), __float_as_uint(p[k + 4]), false, false); s[k] = __uint_as_float(r[0]) + __uint_as_float(r[1]); }
    float t[2];
#pragma unroll
    for (int k = 0; k < 2; ++k) { auto r = __builtin_amdgcn_permlane16_swap(__float_as_uint(s[k]), __float_as_uint(s[k + 2]), false, false); t[k] = __uint_as_float(r[0]) + __uint_as_float(r[1]); }
    const float u0 = t[0] + dpp<0x128>(t[0]), u1 = t[1] + dpp<0x128>(t[1]);
    float r = (lane & 8) ? u1 : u0;
    r += dpp<0xB1>(r); r += dpp<0x4E>(r); r += dpp<0x141>(r);
    return r;
}
typedef int i32x4 __attribute__((ext_vector_type(4)));
typedef _Float16 h2 __attribute__((ext_vector_type(2)));
__device__ __forceinline__ void fp4fma8(h2 (&acc)[8], int o, unsigned w, h2 a2) {
    acc[o] = __builtin_elementwise_fma(a2, __builtin_bit_cast(h2, __builtin_amdgcn_cvt_scalef32_pk_f16_fp4(w, 1.0f, 0)), acc[o]);
    acc[o + 1] = __builtin_elementwise_fma(a2, __builtin_bit_cast(h2, __builtin_amdgcn_cvt_scalef32_pk_f16_fp4(w, 1.0f, 1)), acc[o + 1]);
    acc[o + 2] = __builtin_elementwise_fma(a2, __builtin_bit_cast(h2, __builtin_amdgcn_cvt_scalef32_pk_f16_fp4(w, 1.0f, 2)), acc[o + 2]);
    acc[o + 3] = __builtin_elementwise_fma(a2, __builtin_bit_cast(h2, __builtin_amdgcn_cvt_scalef32_pk_f16_fp4(w, 1.0f, 3)), acc[o + 3]);
}
__device__ __forceinline__ void g2_u_chunk(u32x2 (&u)[8], const unsigned char* U, const int* pe_next, const float* pw_c, float* act_c, const u32x2 xq, float rs, int lane) {
    const i32x4 e0 = *(const i32x4*)pe_next, e1 = *(const i32x4*)(pe_next + 4);
    const int en[8] = {e0.x, e0.y, e0.z, e0.w, e1.x, e1.y, e1.z, e1.w};
    float p[8];
#pragma unroll
    for (int k = 0; k < 8; k += 2) {
        int d0 = __builtin_amdgcn_sdot8((int)u[k].x, (int)xq.x, 0, false), d1 = __builtin_amdgcn_sdot8((int)u[k + 1].x, (int)xq.x, 0, false);
        d0 = __builtin_amdgcn_sdot8((int)u[k].y, (int)xq.y, d0, false); d1 = __builtin_amdgcn_sdot8((int)u[k + 1].y, (int)xq.y, d1, false);
        p[k] = (float)d0; p[k + 1] = (float)d1;
        asm volatile("" : "+v"(p[k]), "+v"(p[k + 1]));
        u[k] = *(const u32x2*)(U + (size_t)__builtin_amdgcn_readfirstlane(en[k]) * 512 + lane * 8);
        u[k + 1] = *(const u32x2*)(U + (size_t)__builtin_amdgcn_readfirstlane(en[k + 1]) * 512 + lane * 8);
    }
    const float a = reduce8_transposed(p, lane);
    const int row = (lane >> 3) & 7;
    if ((lane & 7) == 0) { const _Float16 hv = (_Float16)(gelu_tanh(a * rs) * pw_c[row]); act_c[row] = __builtin_bit_cast(float, (h2){hv, hv}); }
}
__device__ __forceinline__ void g2_v_chunk(u32x2 (&v)[8], const unsigned char* V, const int* pe_next, const float* act_c, h2 (&acc)[8], int lane) {
    const i32x4 e0 = *(const i32x4*)pe_next, e1 = *(const i32x4*)(pe_next + 4);
    const int en[8] = {e0.x, e0.y, e0.z, e0.w, e1.x, e1.y, e1.z, e1.w};
    const f32x4 a0 = *(const f32x4*)act_c, a1 = *(const f32x4*)(act_c + 4);
    const float av[8] = {a0.x, a0.y, a0.z, a0.w, a1.x, a1.y, a1.z, a1.w};
#pragma unroll
    for (int k = 0; k < 8; k += 2) {
        const h2 a2 = __builtin_bit_cast(h2, av[k]), b2 = __builtin_bit_cast(h2, av[k + 1]);
        fp4fma8(acc, 0, v[k].x, a2); fp4fma8(acc, 4, v[k].y, a2);
        fp4fma8(acc, 0, v[k + 1].x, b2); fp4fma8(acc, 4, v[k + 1].y, b2);
        asm volatile("" : "+v"(acc[0]), "+v"(acc[1]), "+v"(acc[2]), "+v"(acc[3]), "+v"(acc[4]), "+v"(acc[5]), "+v"(acc[6]), "+v"(acc[7]));
        v[k] = *(const u32x2*)(V + (size_t)__builtin_amdgcn_readfirstlane(en[k]) * 512 + lane * 8);
        v[k + 1] = *(const u32x2*)(V + (size_t)__builtin_amdgcn_readfirstlane(en[k + 1]) * 512 + lane * 8);
    }
}
__device__ __forceinline__ void g2_finish_token(Ctx& c, int l, int tok, const f32x2 (&acc)[8], int lane) {
    float* h = WSP(float, WS_H); bf16* hbw = WSP(bf16, WS_HB); float* ssqw = WSP(float, WS_SSQ);
    float* hp = h + (size_t)tok * D + lane * 16;
    f32x4 r0 = *(const f32x4*)hp, r1 = *(const f32x4*)(hp + 4), r2 = *(const f32x4*)(hp + 8), r3 = *(const f32x4*)(hp + 12);
    r0 += (f32x4){acc[0].x, acc[0].y, acc[1].x, acc[1].y}; r1 += (f32x4){acc[2].x, acc[2].y, acc[3].x, acc[3].y};
    r2 += (f32x4){acc[4].x, acc[4].y, acc[5].x, acc[5].y}; r3 += (f32x4){acc[6].x, acc[6].y, acc[7].x, acc[7].y};
    if (l == 0) {
        *(f32x4*)hp = r0; *(f32x4*)(hp + 4) = r1; *(f32x4*)(hp + 8) = r2; *(f32x4*)(hp + 12) = r3;
        u32x4 o0, o1; o0.x = pk2(r0.x, r0.y); o0.y = pk2(r0.z, r0.w); o0.z = pk2(r1.x, r1.y); o0.w = pk2(r1.z, r1.w);
        o1.x = pk2(r2.x, r2.y); o1.y = pk2(r2.z, r2.w); o1.z = pk2(r3.x, r3.y); o1.w = pk2(r3.z, r3.w);
        *(u32x4*)(hbw + (size_t)tok * D + lane * 16) = o0; *(u32x4*)(hbw + (size_t)tok * D + lane * 16 + 8) = o1;
        float ss = (r0.x * r0.x + r0.y * r0.y) + (r0.z * r0.z + r0.w * r0.w) + (r1.x * r1.x + r1.y * r1.y) + (r1.z * r1.z + r1.w * r1.w)
                 + (r2.x * r2.x + r2.y * r2.y) + (r2.z * r2.z + r2.w * r2.w) + (r3.x * r3.x + r3.y * r3.y) + (r3.z * r3.z + r3.w * r3.w);
        ss = wave_sum_dpp(ss);
        if (lane < 8) ssqw[(size_t)tok * 8 + lane] = lane == 0 ? ss : 0.f;
    } else {
        const int b = tok / L, pos = tok - b * L;
        if (pos >= NMETA) { float* op = c.out + ((size_t)b * SEQ + (pos - NMETA)) * D + lane * 16;
            *(f32x4*)op = r0; *(f32x4*)(op + 4) = r1; *(f32x4*)(op + 8) = r2; *(f32x4*)(op + 12) = r3; }
    }
}
__device__ __forceinline__ void phase_G2(const Ctx& c0, int l) {
    Ctx c = reopaque(c0);
    const bf16* hb = WSP(bf16, WS_HB); const float* ssq = WSP(float, WS_SSQ); const int* pe = WSP(int, WS_EIDX); const float* pw = WSP(float, WS_GW);
    const unsigned char* U = c.ws + WS_TAB + (size_t)(l * 2) * SZ_TAB; const unsigned char* V = c.ws + WS_TAB + (size_t)(l * 2 + 1) * SZ_TAB;
    const int lane = c.lane, wave = c.wave;
    const int gw = c.vb * 4 + wave, t0 = l == 1 ? gw * 8 + NMETA * ((gw >> 8) + 1) : gw * 8;
    const bool has_x = l == 0 && (c.vb & 3) == 0; const int tx = T - 128 + (c.vb >> 2);
    unsigned char* wl = c.lds + wave * G2_WSTRIDE;
    int* pe_l = (int*)wl; float* pw_l = (float*)(wl + 4608); float* act_l = (float*)(wl + 9216);
#pragma unroll
    for (int j = 0; j < G2_MAXTOK; ++j) { const int tok = j < 8 ? t0 + j : (has_x ? tx : t0);
        pe_l[j * 128 + lane] = pe[(size_t)tok * 128 + lane]; pe_l[j * 128 + 64 + lane] = pe[(size_t)tok * 128 + 64 + lane];
        pw_l[j * 128 + lane] = pw[(size_t)tok * 128 + lane]; pw_l[j * 128 + 64 + lane] = pw[(size_t)tok * 128 + 64 + lane]; }
    const int xlo = has_x ? 4 * wave : 16, xhi = has_x ? 4 * wave + 4 : 16;
    {
        u32x2 xq[G2_MAXTOK]; float rs[G2_MAXTOK];
#pragma unroll
        for (int j = 0; j < G2_MAXTOK; ++j) { const int tok = j < 8 ? t0 + j : (has_x ? tx : t0);
            const u32x4 lo = *(const u32x4*)(hb + (size_t)tok * D + lane * 16), hi = *(const u32x4*)(hb + (size_t)tok * D + lane * 16 + 8);
            const float sx = rstd_from_ssq8(ssq, tok) * X_SCALE;
            const f32x4 f0 = (f32x4){bf_lo(lo.x), bf_hi(lo.x), bf_lo(lo.y), bf_hi(lo.y)} * sx, f1 = (f32x4){bf_lo(lo.z), bf_hi(lo.z), bf_lo(lo.w), bf_hi(lo.w)} * sx;
            const f32x4 f2 = (f32x4){bf_lo(hi.x), bf_hi(hi.x), bf_lo(hi.y), bf_hi(hi.y)} * sx, f3 = (f32x4){bf_lo(hi.z), bf_hi(hi.z), bf_lo(hi.w), bf_hi(hi.w)} * sx;
            xq[j].x = pack_i4x4(f0) | (pack_i4x4(f1) << 16); xq[j].y = pack_i4x4(f2) | (pack_i4x4(f3) << 16);
            rs[j] = 1.0f / (X_SCALE * U_SCALE); }
        u32x2 u[8];
#pragma unroll
        for (int k = 0; k < 8; ++k) u[k] = *(const u32x2*)(U + (size_t)__builtin_amdgcn_readfirstlane(pe_l[k]) * 512 + lane * 8);
#pragma unroll 1
        for (int ch = 0; ch < 16; ++ch) {
            const int cn = ch < 15 ? ch + 1 : 0;
            const bool x_here = ch >= xlo && ch < xhi;
#pragma unroll
            for (int j = 0; j < 8; ++j) {
                const int* pe_next = j < 7 ? pe_l + (j + 1) * 128 + ch * 8 : (x_here ? pe_l + 8 * 128 + ch * 8 : pe_l + cn * 8);
                g2_u_chunk(u, U, pe_next, pw_l + j * 128 + ch * 8, act_l + j * 128 + ch * 8, xq[j], rs[j], lane); }
            if (x_here) g2_u_chunk(u, U, pe_l + cn * 8, pw_l + 8 * 128 + ch * 8, act_l + 8 * 128 + ch * 8, xq[8], rs[8], lane);
        }
    }
    h2 acc[G2_MAXTOK][8];
#pragma unroll
    for (int j = 0; j < G2_MAXTOK; ++j)
#pragma unroll
        for (int i = 0; i < 8; ++i) acc[j][i] = (h2){(_Float16)0.f, (_Float16)0.f};
    {
        u32x2 v[8];
#pragma unroll
        for (int k = 0; k < 8; ++k) v[k] = *(const u32x2*)(V + (size_t)__builtin_amdgcn_readfirstlane(pe_l[k]) * 512 + lane * 8);
#pragma unroll 1
        for (int ch = 0; ch < 16; ++ch) {
            const int cn = ch < 15 ? ch + 1 : 0;
            const bool x_here = ch >= xlo && ch < xhi;
#pragma unroll
            for (int j = 0; j < 8; ++j) {
                const int* pe_next = j < 7 ? pe_l + (j + 1) * 128 + ch * 8 : (x_here ? pe_l + 8 * 128 + ch * 8 : pe_l + cn * 8);
                g2_v_chunk(v, V, pe_next, act_l + j * 128 + ch * 8, acc[j], lane); }
            if (x_here) g2_v_chunk(v, V, pe_l + cn * 8, act_l + 8 * 128 + ch * 8, acc[8], lane);
        }
    }
#pragma unroll
    for (int j = 0; j < 8; ++j) { f32x2 af[8];
#pragma unroll
        for (int i = 0; i < 8; ++i) af[i] = (f32x2){(float)acc[j][i].x, (float)acc[j][i].y} * TAB_INV;
        g2_finish_token(c, l, t0 + j, af, lane); }
    f32x2 accx[8];
#pragma unroll
    for (int i = 0; i < 8; ++i) accx[i] = (f32x2){(float)acc[8][i].x, (float)acc[8][i].y} * TAB_INV;
    __syncthreads();
    if (has_x) {
        f32x2* part = (f32x2*)(c.lds + wave * G2_WSTRIDE);
#pragma unroll
        for (int i = 0; i < 8; ++i) part[i * 64 + lane] = accx[i];
    }
    __syncthreads();
    if (has_x && wave == 0) {
        f32x2 tot[8];
#pragma unroll
        for (int i = 0; i < 8; ++i) { tot[i] = accx[i];
#pragma unroll
            for (int w = 1; w < 4; ++w) tot[i] += ((const f32x2*)(c.lds + w * G2_WSTRIDE))[i * 64 + lane]; }
        g2_finish_token(c, l, tx, tot, lane);
    }
    __syncthreads();
}

struct Args { const float* in[22]; float* out; unsigned char* ws; int ph_lo, ph_hi; };
constexpr int N_PHASES = 17;

__global__ void __launch_bounds__(NTHREADS, 2) fwd_kernel(Args args) {
    extern __shared__ __attribute__((aligned(16))) unsigned char lds_raw[];
    Ctx c;
#pragma unroll
    for (int i = 0; i < 22; ++i) c.in[i] = args.in[i];
    c.out = args.out; c.ws = args.ws; c.lds = lds_raw;
    c.tid = threadIdx.x; c.lane = c.tid & 63; c.wave = __builtin_amdgcn_readfirstlane(c.tid >> 6);
    c.G = gridDim.x; { const int bx = blockIdx.x; c.vb = (c.G % 8 == 0) ? (bx % 8) * (c.G / 8) + bx / 8 : bx; }
    volatile unsigned* misc = (volatile unsigned*)(c.lds + LDS_MISC);
    if (c.tid < 16) misc[c.tid] = 0u;
    __syncthreads();
    const int lo = args.ph_lo, hi = args.ph_hi;
    const bool multi = (hi - lo) > 1;
    XcdBarrier bar; bar.bar = WSP(unsigned, WS_CTL) + CW_BAR; bar.x = 0; bar.st = misc;
    if (multi) bar = xcd_barrier_post(WSP(unsigned, WS_CTL) + CW_BAR, misc);
#define IN_(k) (lo <= (k) && (k) < hi)
#define SEAM_(k) do { if ((k) + 1 < hi) xcd_barrier(bar); } while (0)
    if (IN_(0)) { phase_prologue(c); SEAM_(0); }
#pragma unroll 1
    for (int l = 0; l < 2; ++l) {
        const int p0 = 1 + 8 * l;
        if (IN_(p0 + 0)) { phase_A(c, l); SEAM_(p0 + 0); }
        if (IN_(p0 + 1)) { phase_B(c, l); SEAM_(p0 + 1); }
        if (IN_(p0 + 2)) { phase_C(c, l); SEAM_(p0 + 2); }
        if (IN_(p0 + 3)) { phase_D(c, l); SEAM_(p0 + 3); }
        if (IN_(p0 + 4)) { phase_E(c, l); SEAM_(p0 + 4); }
        if (IN_(p0 + 5)) { phase_F(c, l); SEAM_(p0 + 5); }
        if (IN_(p0 + 6)) { phase_F3(c, l); SEAM_(p0 + 6); }
        if (IN_(p0 + 7)) { phase_G2(c, l); SEAM_(p0 + 7); }
    }
}

extern "C" void kernel_launch(void* const* d_in, const int* in_sizes, int n_in, void* d_out, int out_size, void* d_ws, size_t ws_size, hipStream_t stream) {
    static int grid = 0;
    if (grid == 0) {
        if (n_in != 22 || out_size != NB * SEQ * D || ws_size < WS_END) { fprintf(stderr, "kernel_launch: unexpected shapes (n_in %d out %d ws %zu need %zu)\n", n_in, out_size, ws_size, (size_t)WS_END); grid = -1; return; }
        int dev = 0, cus = 0, per_cu = 0;
        hipGetDevice(&dev); hipDeviceGetAttribute(&cus, hipDeviceAttributeMultiprocessorCount, dev);
        if (hipFuncSetAttribute((const void*)fwd_kernel, hipFuncAttributeMaxDynamicSharedMemorySize, LDS_BYTES) != hipSuccess) { fprintf(stderr, "kernel_launch: hipFuncSetAttribute failed\n"); grid = -1; return; }
        if (hipOccupancyMaxActiveBlocksPerMultiprocessor(&per_cu, (const void*)fwd_kernel, NTHREADS, LDS_BYTES) != hipSuccess || per_cu < 1) { fprintf(stderr, "kernel_launch: occupancy query failed (%d)\n", per_cu); per_cu = 1; (void)hipGetLastError(); }
        if (per_cu > 2) per_cu = 2;
        grid = cus * per_cu;
        if (grid != 512) { fprintf(stderr, "kernel_launch: grid %d unsupported by phase G2 (needs 512 workgroups)\n", grid); grid = -1; return; }
        fprintf(stderr, "kernel_launch: grid %d (%d per CU), lds %d, ws need %zu have %zu\n", grid, per_cu, LDS_BYTES, (size_t)WS_END, ws_size);
    }
    if (grid < 0) return;
    hipMemsetAsync((char*)d_ws + WS_CTL, 0, CTL_BYTES, stream);
    Args a{};
    for (int i = 0; i < 22; ++i) a.in[i] = (const float*)d_in[i];
    a.out = (float*)d_out; a.ws = (unsigned char*)d_ws;
#if MK_PER_PHASE
    for (int ph = 0; ph < N_PHASES; ++ph) { a.ph_lo = ph; a.ph_hi = ph + 1; hipLaunchKernelGGL(fwd_kernel, dim3(grid), dim3(NTHREADS), LDS_BYTES, stream, a); }
#else
    a.ph_lo = 0; a.ph_hi = N_PHASES;
    void* kargs[] = {&a};
    hipError_t e = hipLaunchCooperativeKernel((const void*)fwd_kernel, dim3(grid), dim3(NTHREADS), kargs, LDS_BYTES, stream);
    if (e != hipSuccess) fprintf(stderr, "kernel_launch: cooperative launch failed: %s (grid %d)\n", hipGetErrorString(e), grid);
#endif
}
```

```cpp
#include <hip/hip_runtime.h>
#include <cstdio>
#include <cstdint>

#ifndef MK_PER_PHASE
#define MK_PER_PHASE 0
#endif

typedef unsigned short bf16;
typedef short bf16x8 __attribute__((ext_vector_type(8)));
typedef float f32x4 __attribute__((ext_vector_type(4)));
typedef unsigned u32x4 __attribute__((ext_vector_type(4)));
typedef unsigned u32x2 __attribute__((ext_vector_type(2)));
typedef __bf16 bf16x2 __attribute__((ext_vector_type(2)));

constexpr int NB = 8, SEQ = 2048, NMETA = 16, L = SEQ + NMETA, T = NB * L, D = 1024;
constexpr int DC = 512, CW = 31, NH = 8, QL = 256, KVL = 128, NOPE = 64, ROPE = 32, QK = 96, VD = 64;
constexpr int NIN = 3488, NINP = 3584;
constexpr int NEXP = 16384;
constexpr float EPS = 1e-6f;
constexpr int MT = T / 128;
static_assert(T % 128 == 0, "T tiles");

constexpr size_t al256(size_t x) { return (x + 255) & ~(size_t)255; }
constexpr size_t WS_CTL = 0;
constexpr size_t CTL_BYTES = 65536;
constexpr size_t WS_ROPE = WS_CTL + CTL_BYTES;
constexpr size_t WS_WIN = al256(WS_ROPE + (size_t)L * 16 * 8);
constexpr size_t SZ_WIN = (size_t)NINP * 1024 * 2, SZ_WCO = (size_t)1024 * 512 * 2, SZ_WUQ = (size_t)1024 * 256 * 2, SZ_WUKV = (size_t)1024 * 128 * 2,
                 SZ_WMLA = (size_t)1024 * 512 * 2, SZ_WOUT = (size_t)1024 * 1024 * 2, SZ_WPQ = (size_t)2048 * 1024 * 2, SZ_KEYS = (size_t)16 * 128 * 128 * 2;
constexpr size_t OFF_WCO = SZ_WIN, OFF_WUQ = OFF_WCO + SZ_WCO, OFF_WUKV = OFF_WUQ + SZ_WUQ, OFF_WMLA = OFF_WUKV + SZ_WUKV, OFF_WOUT = OFF_WMLA + SZ_WMLA,
                 OFF_WPQ = OFF_WOUT + SZ_WOUT, OFF_KEYS = OFF_WPQ + SZ_WPQ, SZ_WLAYER = OFF_KEYS + SZ_KEYS;
constexpr size_t WS_TAB = al256(WS_WIN + 2 * SZ_WLAYER);
constexpr size_t SZ_TAB = (size_t)NEXP * 1024;
constexpr float TAB_SCALE = 64.0f, TAB_INV = 1.0f / 64.0f;
constexpr float U_CLIP = 2.7f / 32.0f, U_SCALE = 7.0f / U_CLIP;
constexpr float X_SCALE = 7.0f / 2.7f;
constexpr size_t WS_H = al256(WS_TAB + 4 * SZ_TAB);
constexpr size_t WS_HB = al256(WS_H + (size_t)T * 1024 * 4);
constexpr size_t WS_SSQ = al256(WS_HB + (size_t)T * 1024 * 2);
constexpr size_t WS_UGLU = al256(WS_SSQ + (size_t)T * 8 * 4);
constexpr size_t WS_CQ = al256(WS_UGLU + (size_t)T * 512 * 2);
constexpr size_t WS_CKV = al256(WS_CQ + (size_t)T * 256 * 2);
constexpr size_t WS_KROPE = al256(WS_CKV + (size_t)T * 128 * 2);
constexpr size_t WS_SSQQ = al256(WS_KROPE + (size_t)T * 32 * 4);
constexpr size_t WS_SSQKV = al256(WS_SSQQ + (size_t)T * 2 * 4);
constexpr size_t WS_U2 = al256(WS_SSQKV + (size_t)T * 4);
constexpr size_t WS_Q = al256(WS_U2 + (size_t)T * 512 * 2);
constexpr size_t WS_K = al256(WS_Q + (size_t)T * NH * QK * 2);
constexpr size_t WS_VT = al256(WS_K + (size_t)T * NH * QK * 2);
constexpr size_t WS_O = al256(WS_VT + (size_t)T * NH * VD * 2 + 4096);
constexpr size_t WS_MERGED = al256(WS_O + (size_t)T * 512 * 2);
constexpr size_t WS_GATES = al256(WS_MERGED + (size_t)T * 1024 * 2);
constexpr size_t WS_SV = WS_GATES;
constexpr size_t WS_SI = al256(WS_SV + (size_t)T * 256 * 4);
constexpr size_t WS_EIDX = al256(WS_SI + (size_t)T * 256);
constexpr size_t WS_GW = al256(WS_EIDX + (size_t)T * 128 * 4);
constexpr size_t WS_STB = al256(WS_GW + (size_t)T * 128 * 4);
constexpr size_t WS_PEER_END = WS_STB + (size_t)T * 16;
constexpr size_t WS_END = al256(WS_GATES + (size_t)T * 2048 * 2);
static_assert(WS_PEER_END <= WS_END, "peer scratch overlay");

constexpr int CW_BAR = 0;
constexpr int CW_QUEUE = 4096;

constexpr int LDS_MAIN = 128 * 132 * 4;
constexpr int LDS_MISC = LDS_MAIN;
constexpr int LDS_BYTES = LDS_MAIN + 64;

constexpr int NTHREADS = 256;

__device__ __forceinline__ unsigned pk2(float lo, float hi) { bf16x2 v; v.x = (__bf16)lo; v.y = (__bf16)hi; return __builtin_bit_cast(unsigned, v); }
__device__ __forceinline__ unsigned pack_i8x4(f32x4 v) {
    const int a = (int)__builtin_rintf(fminf(fmaxf(v.x, -127.f), 127.f)), b = (int)__builtin_rintf(fminf(fmaxf(v.y, -127.f), 127.f));
    const int c_ = (int)__builtin_rintf(fminf(fmaxf(v.z, -127.f), 127.f)), d = (int)__builtin_rintf(fminf(fmaxf(v.w, -127.f), 127.f));
    return (unsigned)(a & 255) | ((unsigned)(b & 255) << 8) | ((unsigned)(c_ & 255) << 16) | ((unsigned)(d & 255) << 24);
}
__device__ __forceinline__ unsigned pack_i4x4(f32x4 v) {
    const int a = (int)__builtin_rintf(fminf(fmaxf(v.x, -7.f), 7.f)), b = (int)__builtin_rintf(fminf(fmaxf(v.y, -7.f), 7.f));
    const int c_ = (int)__builtin_rintf(fminf(fmaxf(v.z, -7.f), 7.f)), d = (int)__builtin_rintf(fminf(fmaxf(v.w, -7.f), 7.f));
    return (unsigned)(a & 15) | ((unsigned)(b & 15) << 4) | ((unsigned)(c_ & 15) << 8) | ((unsigned)(d & 15) << 12);
}
__device__ __forceinline__ unsigned short pack_fp4x4(f32x4 v) {
#pragma unroll
    for (int i = 0; i < 4; ++i) v[i] = fminf(fmaxf(v[i], -6.0f), 6.0f);
    unsigned w = __builtin_amdgcn_cvt_scalef32_pk_fp4_f32(0u, v.x, v.y, 1.0f, 0);
    w = __builtin_amdgcn_cvt_scalef32_pk_fp4_f32(w, v.z, v.w, 1.0f, 1);
    return (unsigned short)w;
}
__device__ __forceinline__ float bf_lo(unsigned p) { return __uint_as_float(p << 16); }
__device__ __forceinline__ float bf_hi(unsigned p) { return __uint_as_float(p & 0xffff0000u); }
__device__ __forceinline__ float fast_rcp(float x) { return __builtin_amdgcn_rcpf(x); }
__device__ __forceinline__ float fast_exp2(float x) { return __builtin_amdgcn_exp2f(x); }
__device__ __forceinline__ float sigmoidf_(float x) { return fast_rcp(1.0f + fast_exp2(-1.4426950409f * x)); }
__device__ __forceinline__ float gelu_tanh(float x) { const float u = 1.5957691216f * (x + 0.044715f * x * x * x); return x * fast_rcp(1.0f + fast_exp2(-1.4426950409f * u)); }
__device__ __forceinline__ float rsqrt_(float x) { return __builtin_amdgcn_rsqf(x); }
template <int CTRL> __device__ __forceinline__ float dpp(float x) { return __builtin_bit_cast(float, __builtin_amdgcn_mov_dpp(__builtin_bit_cast(int, x), CTRL, 0xf, 0xf, true)); }
__device__ __forceinline__ float xrow16_sum(float x) {
    auto s = __builtin_amdgcn_permlane16_swap(__float_as_uint(x), __float_as_uint(x), false, false);
    x = __uint_as_float(s[0]) + __uint_as_float(s[1]);
    auto t = __builtin_amdgcn_permlane32_swap(__float_as_uint(x), __float_as_uint(x), false, false);
    return __uint_as_float(t[0]) + __uint_as_float(t[1]);
}
__device__ __forceinline__ float xrow16_max(float x) {
    auto s = __builtin_amdgcn_permlane16_swap(__float_as_uint(x), __float_as_uint(x), false, false);
    x = fmaxf(__uint_as_float(s[0]), __uint_as_float(s[1]));
    auto t = __builtin_amdgcn_permlane32_swap(__float_as_uint(x), __float_as_uint(x), false, false);
    return fmaxf(__uint_as_float(t[0]), __uint_as_float(t[1]));
}
__device__ __forceinline__ float wave_sum_dpp(float x) {
    x += dpp<0xB1>(x); x += dpp<0x4E>(x); x += dpp<0x141>(x); x += dpp<0x128>(x); return xrow16_sum(x);
}
__device__ __forceinline__ float quad_sum(float v) { return xrow16_sum(v); }
__device__ __forceinline__ float quad_max(float v) { return xrow16_max(v); }
__device__ __forceinline__ float wave_sum(float v) { return wave_sum_dpp(v); }
__device__ __forceinline__ float dot2(unsigned a, unsigned b, float c) { return __builtin_amdgcn_fdot2_f32_bf16(__builtin_bit_cast(bf16x2, a), __builtin_bit_cast(bf16x2, b), c, false); }

#define XB_TMO      128
#define XB_XCNT(j)  (256  + 64 * (j))
#define XB_XSUB(j)  (1280 + 64 * (j))
#define XB_XGEN(j)  (2304 + 64 * (j))
#define XB_TOP      3328
#define XB_TOPGEN   3392
#define XCD_BAR_WORDS 3456
#define XB_SPIN_CAP (1u << 20)
__device__ __forceinline__ unsigned xb_ld(unsigned* p)              { return __hip_atomic_load(p, __ATOMIC_RELAXED, __HIP_MEMORY_SCOPE_AGENT); }
__device__ __forceinline__ unsigned xb_add(unsigned* p, unsigned v) { return __hip_atomic_fetch_add(p, v, __ATOMIC_RELAXED, __HIP_MEMORY_SCOPE_AGENT); }
__device__ __forceinline__ unsigned xb_xcc_id() { return (unsigned)__builtin_amdgcn_s_getreg((3 << 11) | 20) & 0xFu; }
#define XB_SPIN(cond, bar) do { unsigned _sp = 0; while (cond) { __builtin_amdgcn_s_sleep(1); \
    if ((++_sp & 255u) == 0u) { if (xb_ld(&(bar)[XB_TMO])) break; if (_sp > XB_SPIN_CAP) { atomicAdd(&(bar)[XB_TMO], 1u); break; } } } } while (0)
struct XcdBarrier { unsigned* bar; unsigned x; volatile unsigned* st; };
__device__ __forceinline__ XcdBarrier xcd_barrier_post(unsigned* bar, volatile unsigned* st) {
    XcdBarrier b; b.bar = bar; b.x = xb_xcc_id(); b.st = st;
    if (threadIdx.x == 0) (void)xb_add(&bar[XB_XCNT(b.x)], 1u);
    return b;
}
__device__ __forceinline__ void xcd_barrier_complete(unsigned* bar, unsigned x, unsigned& nloc, unsigned& nx) {
    const unsigned G = gridDim.x * gridDim.y * gridDim.z;
    unsigned sum, cnt, mine, sp = 0u;
    for (;;) {
        sum = 0u; cnt = 0u; mine = 0u;
#pragma unroll
        for (unsigned j = 0; j < 16; ++j) { const unsigned c = xb_ld(&bar[XB_XCNT(j)]); sum += c; cnt += (c > 0u) ? 1u : 0u; mine = (j == x) ? c : mine; }
        if (sum == G) break;
        __builtin_amdgcn_s_sleep(1);
        if ((++sp & 255u) == 0u) { if (xb_ld(&bar[XB_TMO])) break; if (sp > XB_SPIN_CAP) { atomicAdd(&bar[XB_TMO], 1u); break; } }
    }
    nloc = mine > 0u ? mine : 1u; nx = cnt > 0u ? cnt : 1u;
}
__device__ __forceinline__ void xcd_barrier(const XcdBarrier& b) {
    asm volatile("s_waitcnt vmcnt(0)" ::: "memory");
    __syncthreads();
    if (threadIdx.x == 0) {
        unsigned* bar = b.bar;
        __builtin_amdgcn_s_waitcnt(0);
        unsigned nloc = b.st[0], nx = b.st[1];
        if (nloc == 0u) { xcd_barrier_complete(bar, b.x, nloc, nx); b.st[0] = nloc; b.st[1] = nx; }
        const unsigned old = xb_add(&bar[XB_XSUB(b.x)], 1u);
        const unsigned gen = old / nloc;
        if (old + 1u == (gen + 1u) * nloc) {
            __builtin_amdgcn_fence(__ATOMIC_RELEASE, "agent");
            asm volatile("s_waitcnt vmcnt(0)" ::: "memory");
            const unsigned og = xb_add(&bar[XB_TOP], 1u);
            const unsigned tg = og / nx;
            if (og + 1u == (tg + 1u) * nx) xb_add(&bar[XB_TOPGEN], 1u);
            else XB_SPIN(xb_ld(&bar[XB_TOPGEN]) == tg, bar);
            __builtin_amdgcn_fence(__ATOMIC_ACQUIRE, "agent");
            xb_add(&bar[XB_XGEN(b.x)], 1u);
            asm volatile("s_waitcnt vmcnt(0)" ::: "memory");
        } else {
            XB_SPIN(xb_ld(&bar[XB_XGEN(b.x)]) == gen, bar);
            __builtin_amdgcn_fence(__ATOMIC_ACQUIRE, "agent");
            asm volatile("s_waitcnt vmcnt(0)" ::: "memory");
        }
    }
    __syncthreads();
}

struct Ctx {
    const float* in[22]; float* out; unsigned char* ws;
    unsigned char* lds; int tid, lane, wave, G, vb;
};
#define WSP(T_, off) ((T_*)(c.ws + (off)))
__device__ __forceinline__ Ctx reopaque(const Ctx& c0) {
    Ctx c = c0; int t = c0.tid; asm volatile("" : "+v"(t)); c.tid = t; c.lane = t & 63; c.wave = __builtin_amdgcn_readfirstlane(t >> 6);
    int vb = c0.vb; asm volatile("" : "+s"(vb)); c.vb = vb; return c;
}

__device__ __forceinline__ int lds_off(int row, int chunk) { return row * 128 + ((chunk ^ (row & 7)) << 4); }

__device__ __forceinline__ void gemm_compute_stage(f32x4 (&acc)[2][8], const unsigned char* sA, const unsigned char* sB, int wave, int lane) {
    const int r = lane & 15, q = lane >> 4;
    bf16x8 af[2][2], bfr[2][8];
#pragma unroll
    for (int ks = 0; ks < 2; ++ks) {
#pragma unroll
        for (int mi = 0; mi < 2; ++mi) af[ks][mi] = *(const bf16x8*)(sA + lds_off(32 * wave + 16 * mi + r, 4 * ks + q));
#pragma unroll
        for (int ni = 0; ni < 8; ++ni) bfr[ks][ni] = *(const bf16x8*)(sB + lds_off(16 * ni + r, 4 * ks + q));
    }
#pragma unroll
    for (int ks = 0; ks < 2; ++ks)
#pragma unroll
        for (int ni = 0; ni < 8; ++ni)
#pragma unroll
            for (int mi = 0; mi < 2; ++mi) acc[mi][ni] = __builtin_amdgcn_mfma_f32_16x16x32_bf16(bfr[ks][ni], af[ks][mi], acc[mi][ni], 0, 0, 0);
    __builtin_amdgcn_sched_group_barrier(0x100, 6, 0);
#pragma unroll
    for (int i = 0; i < 14; ++i) { __builtin_amdgcn_sched_group_barrier(0x8, 2, 0); __builtin_amdgcn_sched_group_barrier(0x100, 1, 0); }
    __builtin_amdgcn_sched_group_barrier(0x8, 4, 0);
}

#define LAS __attribute__((address_space(3)))
__device__ __forceinline__ void gemm_stage_glds(const bf16* A, int lda, const bf16* Bt, int ldb, int kt, unsigned char* stage, int wave, int lane) {
    const int rr = lane >> 3, cch = (lane & 7) ^ rr;
#pragma unroll
    for (int i = 0; i < 4; ++i) { const int pc = 4 * i + wave;
        __builtin_amdgcn_global_load_lds((const unsigned*)(A + (size_t)(8 * pc + rr) * lda + kt * 64 + cch * 8), (LAS unsigned*)(stage + pc * 1024), 16, 0, 0);
        __builtin_amdgcn_global_load_lds((const unsigned*)(Bt + (size_t)(8 * pc + rr) * ldb + kt * 64 + cch * 8), (LAS unsigned*)(stage + 16384 + pc * 1024), 16, 0, 0); }
}
__device__ __forceinline__ void gemm_core(f32x4 (&acc)[2][8], const bf16* A, int lda, const bf16* Bt, int ldb, int K, unsigned char* lds, int tid) {
    const int wave = __builtin_amdgcn_readfirstlane(tid >> 6), lane = tid & 63;
    const int nk = K >> 6;
    gemm_stage_glds(A, lda, Bt, ldb, 0, lds, wave, lane);
    asm volatile("s_waitcnt vmcnt(0)" ::: "memory");
    __syncthreads();
    for (int kt = 0; kt < nk; ++kt) {
        const int cur = kt & 1;
        if (kt + 1 < nk) gemm_stage_glds(A, lda, Bt, ldb, kt + 1, lds + (cur ^ 1) * 32768, wave, lane);
        gemm_compute_stage(acc, lds + cur * 32768, lds + cur * 32768 + 16384, wave, lane);
        asm volatile("s_waitcnt vmcnt(0)" ::: "memory");
        __syncthreads();
    }
}
__device__ __forceinline__ void acc_zero(f32x4 (&acc)[2][8]) {
#pragma unroll
    for (int mi = 0; mi < 2; ++mi)
#pragma unroll
        for (int ni = 0; ni < 8; ++ni) acc[mi][ni] = (f32x4){0.f, 0.f, 0.f, 0.f};
}
__device__ __forceinline__ float rstd_from_ssq8(const float* ssq, int tok) {
    const f32x4 a = *(const f32x4*)(ssq + (size_t)tok * 8), b = *(const f32x4*)(ssq + (size_t)tok * 8 + 4);
    const float s = ((a.x + a.y) + (a.z + a.w)) + ((b.x + b.y) + (b.z + b.w));
    return rsqrt_(s * (1.0f / 1024.0f) + EPS);
}

__device__ __forceinline__ int src_col(int mode, int np) {
    if (mode == 0) return np;
    if (mode == 2) { const int h = np >> 7, j = np & 127; return j < 96 ? h * 96 + j : -1; }
    if (np < 1024) { const int cblk = np >> 7, j = np & 127; return j < 64 ? 64 * cblk + j : 512 + 64 * cblk + (j - 64); }
    if (np < 1408) return np;
    if (np < 1536) { const int j = np - 1408; return j < 32 ? 1408 + j : -1; }
    return 1440 + (np - 1536);
}
__device__ __forceinline__ void p0_transpose_item(const float* W, int K, int N, bf16* Wt, int mode, const float* g, int item, float* scr, int lane) {
    const int nblk_k = K / 64, nb = item / nblk_k, kb = item % nblk_k, k0 = 64 * kb, n0 = 32 * nb;
    const int n = src_col(mode, n0 + (lane & 31));
    float wv[32], gv[32];
#pragma unroll
    for (int i = 0; i < 32; ++i) { const int kk = 2 * i + (lane >> 5); wv[i] = n >= 0 ? W[(size_t)(k0 + kk) * N + n] : 0.f; gv[i] = g ? g[k0 + kk] : 1.f; }
#pragma unroll
    for (int i = 0; i < 32; ++i) { const int kk = 2 * i + (lane >> 5); scr[kk * 33 + (lane & 31)] = wv[i] * gv[i]; }
    __builtin_amdgcn_s_waitcnt(0xC07F); asm volatile("" ::: "memory");
    const int cch = lane & 7;
#pragma unroll
    for (int j = 0; j < 4; ++j) { const int nl = (lane >> 3) + 8 * j; const float* s = scr + (8 * cch) * 33 + nl;
        u32x4 o; o.x = pk2(s[0 * 33], s[1 * 33]); o.y = pk2(s[2 * 33], s[3 * 33]); o.z = pk2(s[4 * 33], s[5 * 33]); o.w = pk2(s[6 * 33], s[7 * 33]);
        *(u32x4*)(Wt + (size_t)(n0 + nl) * K + k0 + 8 * cch) = o; }
    __builtin_amdgcn_s_waitcnt(0xC07F); asm volatile("" ::: "memory");
}
struct WDesc { int in_idx, K, N, Np, mode, g_idx; size_t off; };
__device__ __forceinline__ void phase_prologue(const Ctx& c0) {
    Ctx c = reopaque(c0);
    const int gw = c.vb * 4 + c.wave, NGW = c.G * 4;
    float* scr = (float*)(c.lds + c.wave * 8704);
    const WDesc wd[7] = {
        {3, 1024, NIN, NINP, 1, 2, 0}, {8, 512, 1024, 1024, 0, -1, OFF_WCO}, {10, 256, 768, 1024, 2, 9, OFF_WUQ}, {12, 128, 1024, 1024, 0, 11, OFF_WUKV},
        {15, 512, 1024, 1024, 0, -1, OFF_WMLA}, {16, 1024, 1024, 1024, 0, -1, OFF_WOUT}, {18, 1024, 2048, 2048, 0, 17, OFF_WPQ}};
    constexpr int ITEMS_PER_LAYER = (1024 / 64) * (NINP / 32) + (512 / 64) * 32 + (256 / 64) * 32 + (128 / 64) * 32 + (512 / 64) * 32 + (1024 / 64) * 32 + (1024 / 64) * 64;
    for (int it = gw; it < 2 * ITEMS_PER_LAYER; it += NGW) {
        const int l = it >= ITEMS_PER_LAYER ? 1 : 0; int r = it - l * ITEMS_PER_LAYER;
        const float* W = nullptr; const float* g = nullptr; bf16* Wt = nullptr; int K = 64, N = 32, mode = 0, rr = 0;
#pragma unroll
        for (int m = 0; m < 7; ++m) {
            const int items = (wd[m].K / 64) * (wd[m].Np / 32);
            if (r >= 0 && r < items) { K = wd[m].K; N = wd[m].N; mode = wd[m].mode; rr = r;
                W = c.in[wd[m].in_idx] + (size_t)l * wd[m].K * wd[m].N; g = wd[m].g_idx >= 0 ? c.in[wd[m].g_idx >= 0 ? wd[m].g_idx : 0] + (size_t)l * wd[m].K : nullptr;
                Wt = (bf16*)(c.ws + WS_WIN + l * SZ_WLAYER + wd[m].off); }
            r -= items;
        }
        p0_transpose_item(W, K, N, Wt, mode, g, rr, scr, c.lane);
    }
    const int gt = c.vb * NTHREADS + c.tid, NGT = c.G * NTHREADS;
    for (int l = 0; l < 2; ++l) {
        const float* src = c.in[19] + (size_t)l * 262144; bf16* dst = (bf16*)(c.ws + WS_WIN + l * SZ_WLAYER + OFF_KEYS);
        for (int i = gt; i < 262144 / 8; i += NGT) { const f32x4 a = *(const f32x4*)(src + i * 8), b = *(const f32x4*)(src + i * 8 + 4);
            u32x4 o; o.x = pk2(a.x, a.y); o.y = pk2(a.z, a.w); o.z = pk2(b.x, b.y); o.w = pk2(b.z, b.w); *(u32x4*)(dst + i * 8) = o; }
    }
    for (int l = 0; l < 2; ++l)
        for (int uv = 0; uv < 2; ++uv) {
            const float* src = c.in[20 + uv] + (size_t)l * NEXP * 1024; unsigned char* dst = c.ws + WS_TAB + (size_t)(l * 2 + uv) * SZ_TAB;
            f32x4 g4[4];
#pragma unroll
            for (int j = 0; j < 4; ++j) { const float sc = uv == 0 ? U_SCALE : TAB_SCALE; g4[j] = (f32x4){sc, sc, sc, sc}; if (uv == 0) g4[j] = g4[j] * *(const f32x4*)(c.in[17] + l * 1024 + 256 * j + 4 * c.lane); }
            for (int row = gw; row < NEXP; row += 2 * NGW) {
                const float* sp = src + (size_t)row * 1024 + 4 * c.lane; const int row2 = row + NGW; const bool two = row2 < NEXP;
                const float* sp2 = src + (size_t)(two ? row2 : row) * 1024 + 4 * c.lane;
                f32x4 a[4], b[4];
#pragma unroll
                for (int j = 0; j < 4; ++j) { a[j] = *(const f32x4*)(sp + 256 * j); b[j] = *(const f32x4*)(sp2 + 256 * j); }
#pragma unroll
                for (int j = 0; j < 4; ++j) { const f32x4 v = a[j] * g4[j];
                    if (uv == 0) *(unsigned short*)(dst + (size_t)row * 512 + 128 * j + 2 * c.lane) = (unsigned short)pack_i4x4(v);
                    else *(unsigned short*)(dst + (size_t)row * 512 + 128 * j + 2 * c.lane) = pack_fp4x4(v); }
                if (two) {
#pragma unroll
                    for (int j = 0; j < 4; ++j) { const f32x4 v = b[j] * g4[j];
                        if (uv == 0) *(unsigned short*)(dst + (size_t)row2 * 512 + 128 * j + 2 * c.lane) = (unsigned short)pack_i4x4(v);
                        else *(unsigned short*)(dst + (size_t)row2 * 512 + 128 * j + 2 * c.lane) = pack_fp4x4(v); } }
            }
        }
    { float* rope = WSP(float, WS_ROPE);
      for (int i = gt; i < L * 16; i += NGT) { const int pos = i >> 4, j = i & 15;
          const float inv = 1.0f / __builtin_exp2f((float)j * 0.8304820237218406f);
          const float angf = (float)pos * inv; const double ang = (double)angf;
          const double nq = __builtin_rint(ang * 0.63661977236758134308);
          double rr = __builtin_fma(-nq, 1.57079632679489655800e+00, ang); rr = __builtin_fma(-nq, 6.12323399573676603587e-17, rr);
          const double r2 = rr * rr;
          double sp = -1.0 / 1307674368000.0; sp = sp * r2 + 1.0 / 6227020800.0; sp = sp * r2 - 1.0 / 39916800.0; sp = sp * r2 + 1.0 / 362880.0; sp = sp * r2 - 1.0 / 5040.0; sp = sp * r2 + 1.0 / 120.0; sp = sp * r2 - 1.0 / 6.0; sp = sp * r2 * rr + rr;
          double cp = 1.0 / 87178291200.0; cp = cp * r2 - 1.0 / 479001600.0; cp = cp * r2 + 1.0 / 3628800.0; cp = cp * r2 - 1.0 / 40320.0; cp = cp * r2 + 1.0 / 720.0; cp = cp * r2 - 1.0 / 24.0; cp = cp * r2 + 0.5; cp = 1.0 - cp * r2;
          const int qd = ((int)nq) & 3;
          const double cv = qd == 0 ? cp : qd == 1 ? -sp : qd == 2 ? -cp : sp;
          const double sv_ = qd == 0 ? sp : qd == 1 ? cp : qd == 2 ? -sp : -cp;
          rope[2 * i] = (float)cv; rope[2 * i + 1] = (float)sv_; } }
    { bf16* hb = WSP(bf16, WS_HB); float* ssq = WSP(float, WS_SSQ);
      for (int t0_ = gw; t0_ < T; t0_ += 4 * NGW) {
          f32x4 v[4][4];
#pragma unroll
          for (int i = 0; i < 4; ++i) { const int t = t0_ + i * NGW < T ? t0_ + i * NGW : t0_; const int b = t / L, pos = t % L;
              const float* src = pos < NMETA ? c.in[1] + (size_t)pos * D : c.in[0] + ((size_t)b * SEQ + (pos - NMETA)) * D;
#pragma unroll
              for (int j = 0; j < 4; ++j) v[i][j] = *(const f32x4*)(src + j * 256 + c.lane * 4); }
#pragma unroll
          for (int i = 0; i < 4; ++i) { const int t = t0_ + i * NGW;
              if (t < T) { float s = 0.f;
#pragma unroll
                  for (int j = 0; j < 4; ++j) { const f32x4 x = v[i][j]; u32x2 o; o.x = pk2(x.x, x.y); o.y = pk2(x.z, x.w); *(u32x2*)(hb + (size_t)t * D + j * 256 + c.lane * 4) = o;
                      s += (x.x * x.x + x.y * x.y) + (x.z * x.z + x.w * x.w); }
                  s = wave_sum(s);
                  if (c.lane < 8) ssq[(size_t)t * 8 + c.lane] = c.lane == 0 ? s : 0.f; } }
      } }
}

__device__ __forceinline__ void phase_A(const Ctx& c0, int l) {
    Ctx c = reopaque(c0);
    const bf16* hb = WSP(bf16, WS_HB); const bf16* Wt = (const bf16*)(c.ws + WS_WIN + l * SZ_WLAYER);
    const float* ssq = WSP(float, WS_SSQ);
    bf16* uglu = WSP(bf16, WS_UGLU); bf16* cq = WSP(bf16, WS_CQ); bf16* ckv = WSP(bf16, WS_CKV); float* krope = WSP(float, WS_KROPE);
    float* ssqq = WSP(float, WS_SSQQ); float* ssqkv = WSP(float, WS_SSQKV); bf16* gates = WSP(bf16, WS_GATES);
    constexpr int NT = NINP / 128;
    const int r = c.lane & 15, q = c.lane >> 4;
    const int xcd = c.vb / (c.G / 8), lb = c.vb % (c.G / 8), xm = xcd & 1, xn = xcd >> 1;
    const int m_lo = xm ? (MT + 1) / 2 : 0, m_cnt = xm ? MT / 2 : (MT + 1) / 2;
    for (int j = lb; j < m_cnt * 7; j += c.G / 8) {
        const int mt = m_lo + j / 7, nt = xn * 7 + j % 7;
        f32x4 acc[2][8]; acc_zero(acc);
        gemm_core(acc, hb + (size_t)mt * 128 * D, D, Wt + (size_t)nt * 128 * D, D, D, c.lds, c.tid);
#pragma unroll
        for (int mi = 0; mi < 2; ++mi) {
            const int tok = mt * 128 + 32 * c.wave + 16 * mi + r;
            const float rs = rstd_from_ssq8(ssq, tok);
            if (nt < 8) {
#pragma unroll
                for (int ni = 0; ni < 4; ++ni) { const f32x4 v = acc[mi][ni] * rs, g = acc[mi][ni + 4] * rs;
                    u32x2 o; o.x = pk2(v.x * sigmoidf_(g.x), v.y * sigmoidf_(g.y)); o.y = pk2(v.z * sigmoidf_(g.z), v.w * sigmoidf_(g.w));
                    *(u32x2*)(uglu + (size_t)tok * DC + nt * 64 + 16 * ni + 4 * q) = o; }
            } else if (nt < 11) {
                bf16* dst = nt < 10 ? cq + (size_t)tok * QL + (nt - 8) * 128 : ckv + (size_t)tok * KVL;
                float ss = 0.f;
#pragma unroll
                for (int ni = 0; ni < 8; ++ni) { const f32x4 v = acc[mi][ni] * rs; ss += (v.x * v.x + v.y * v.y) + (v.z * v.z + v.w * v.w);
                    u32x2 o; o.x = pk2(v.x, v.y); o.y = pk2(v.z, v.w); *(u32x2*)(dst + 16 * ni + 4 * q) = o; }
                ss = quad_sum(ss);
                if (q == 0) { if (nt < 10) ssqq[(size_t)tok * 2 + (nt - 8)] = ss; else ssqkv[tok] = ss; }
            } else if (nt == 11) {
#pragma unroll
                for (int ni = 0; ni < 2; ++ni) *(f32x4*)(krope + (size_t)tok * 32 + 16 * ni + 4 * q) = acc[mi][ni] * rs;
            } else {
#pragma unroll
                for (int ni = 0; ni < 8; ++ni) { const f32x4 v = acc[mi][ni] * rs;
                    u32x2 o; o.x = pk2(sigmoidf_(v.x), sigmoidf_(v.y)); o.y = pk2(sigmoidf_(v.z), sigmoidf_(v.w));
                    *(u32x2*)(gates + (size_t)tok * 2048 + (nt - 12) * 128 + 16 * ni + 4 * q) = o; }
            }
        }
    }
}

__device__ __forceinline__ void phaseB_q_item(Ctx& c, int l, int mt, int head) {
    const bf16* cq = WSP(bf16, WS_CQ); const bf16* Wt = (const bf16*)(c.ws + WS_WIN + l * SZ_WLAYER + OFF_WUQ);
    const float* ssqq = WSP(float, WS_SSQQ); const float* rope = WSP(float, WS_ROPE); const float* qg = c.in[13] + l * QK; bf16* Qb = WSP(bf16, WS_Q);
    const int r = c.lane & 15, q = c.lane >> 4;
    f32x4 acc[2][8]; acc_zero(acc);
    gemm_core(acc, cq + (size_t)mt * 128 * QL, QL, Wt + (size_t)head * 128 * QL, QL, QL, c.lds, c.tid);
    constexpr float QSCALE = 0.10206207261596575f * 1.4426950408889634f;
#pragma unroll
    for (int mi = 0; mi < 2; ++mi) {
        const int tok = mt * 128 + 32 * c.wave + 16 * mi + r, b = tok / L, pos = tok - b * L;
        const float rs = rsqrt_((ssqq[(size_t)tok * 2] + ssqq[(size_t)tok * 2 + 1]) * (1.0f / 256.0f) + EPS);
        float ss = 0.f;
#pragma unroll
        for (int ni = 0; ni < 6; ++ni) { acc[mi][ni] = acc[mi][ni] * rs; const f32x4 v = acc[mi][ni]; ss += (v.x * v.x + v.y * v.y) + (v.z * v.z + v.w * v.w); }
        ss = quad_sum(ss);
        const float rn = rsqrt_(ss * (1.0f / 96.0f) + EPS) * QSCALE;
#pragma unroll
        for (int ni = 0; ni < 6; ++ni) { const f32x4 g = *(const f32x4*)(qg + 16 * ni + 4 * q); acc[mi][ni] = acc[mi][ni] * g * rn; }
        const f32x4 cs0 = *(const f32x4*)(rope + ((size_t)pos * 16 + 4 * q) * 2), cs1 = *(const f32x4*)(rope + ((size_t)pos * 16 + 4 * q) * 2 + 4);
        const float co[4] = {cs0.x, cs0.z, cs1.x, cs1.z}, si[4] = {cs0.y, cs0.w, cs1.y, cs1.w};
        f32x4 x1 = acc[mi][4], x2 = acc[mi][5];
#pragma unroll
        for (int e = 0; e < 4; ++e) { const float a = x1[e], bb = x2[e]; x1[e] = a * co[e] - bb * si[e]; x2[e] = bb * co[e] + a * si[e]; }
        acc[mi][4] = x1; acc[mi][5] = x2;
        bf16* dst = Qb + (((size_t)b * NH + head) * L + pos) * QK;
#pragma unroll
        for (int ni = 0; ni < 6; ++ni) { const f32x4 v = acc[mi][ni]; u32x2 o; o.x = pk2(v.x, v.y); o.y = pk2(v.z, v.w); *(u32x2*)(dst + 16 * ni + 4 * q) = o; }
    }
}
__device__ __forceinline__ void phaseB_kv_item(Ctx& c, int l, int mt, int head) {
    const bf16* ckv = WSP(bf16, WS_CKV); const bf16* Wt = (const bf16*)(c.ws + WS_WIN + l * SZ_WLAYER + OFF_WUKV);
    const float* ssqkv = WSP(float, WS_SSQKV); const float* rope = WSP(float, WS_ROPE); const float* kg = c.in[14] + l * QK; const float* krope = WSP(float, WS_KROPE);
    bf16* Kb = WSP(bf16, WS_K); bf16* Vt = WSP(bf16, WS_VT);
    const int tid = c.tid, wave = c.wave, lane = c.lane, r = lane & 15, q = lane >> 4;
    unsigned char* lds = c.lds;
    f32x4 ak[2][4], av[2][4];
#pragma unroll
    for (int mi = 0; mi < 2; ++mi)
#pragma unroll
        for (int ni = 0; ni < 4; ++ni) { ak[mi][ni] = (f32x4){0.f, 0.f, 0.f, 0.f}; av[mi][ni] = (f32x4){0.f, 0.f, 0.f, 0.f}; }
    { const int chunk = tid & 7, row0 = tid >> 3;
      const bf16* pa = ckv + ((size_t)mt * 128 + row0) * KVL + chunk * 8; const bf16* pb = Wt + ((size_t)head * 128 + row0) * KVL + chunk * 8;
#pragma unroll
      for (int s = 0; s < 2; ++s)
#pragma unroll
          for (int i = 0; i < 4; ++i) { *(u32x4*)(lds + s * 32768 + lds_off(row0 + 32 * i, chunk)) = *(const u32x4*)(pa + (size_t)(32 * i) * KVL + s * 64);
              *(u32x4*)(lds + s * 32768 + 16384 + lds_off(row0 + 32 * i, chunk)) = *(const u32x4*)(pb + (size_t)(32 * i) * KVL + s * 64); }
    }
    __syncthreads();
#pragma unroll
    for (int s = 0; s < 2; ++s)
#pragma unroll
        for (int ks = 0; ks < 2; ++ks) {
            const unsigned char* sA = lds + s * 32768; const unsigned char* sB = sA + 16384;
            bf16x8 af[2], bfr[8];
#pragma unroll
            for (int mi = 0; mi < 2; ++mi) af[mi] = *(const bf16x8*)(sA + lds_off(32 * wave + 16 * mi + r, 4 * ks + q));
#pragma unroll
            for (int ni = 0; ni < 8; ++ni) bfr[ni] = *(const bf16x8*)(sB + lds_off(16 * ni + r, 4 * ks + q));
#pragma unroll
            for (int mi = 0; mi < 2; ++mi)
#pragma unroll
                for (int ni = 0; ni < 4; ++ni) { ak[mi][ni] = __builtin_amdgcn_mfma_f32_16x16x32_bf16(bfr[ni], af[mi], ak[mi][ni], 0, 0, 0);
                    av[mi][ni] = __builtin_amdgcn_mfma_f32_16x16x32_bf16(af[mi], bfr[ni + 4], av[mi][ni], 0, 0, 0); }
        }
    __syncthreads();
#pragma unroll
    for (int mi = 0; mi < 2; ++mi) {
        const int tok0 = mt * 128 + 32 * wave + 16 * mi, b = tok0 / L, pos0 = tok0 - b * L;
        { const int tok = tok0 + r, pos = pos0 + r;
          const float rs = rsqrt_(ssqkv[tok] * (1.0f / 128.0f) + EPS);
          const f32x4 kr1 = *(const f32x4*)(krope + (size_t)tok * 32 + 4 * q), kr2 = *(const f32x4*)(krope + (size_t)tok * 32 + 16 + 4 * q);
          float ss = (kr1.x * kr1.x + kr1.y * kr1.y) + (kr1.z * kr1.z + kr1.w * kr1.w) + (kr2.x * kr2.x + kr2.y * kr2.y) + (kr2.z * kr2.z + kr2.w * kr2.w);
#pragma unroll
          for (int ni = 0; ni < 4; ++ni) { ak[mi][ni] = ak[mi][ni] * rs; const f32x4 v = ak[mi][ni]; ss += (v.x * v.x + v.y * v.y) + (v.z * v.z + v.w * v.w); }
          ss = quad_sum(ss);
          const float rn = rsqrt_(ss * (1.0f / 96.0f) + EPS);
          bf16* dst = Kb + (((size_t)b * NH + head) * L + pos) * QK;
#pragma unroll
          for (int ni = 0; ni < 4; ++ni) { const f32x4 g = *(const f32x4*)(kg + 16 * ni + 4 * q); const f32x4 v = ak[mi][ni] * g * rn;
              u32x2 o; o.x = pk2(v.x, v.y); o.y = pk2(v.z, v.w); *(u32x2*)(dst + 16 * ni + 4 * q) = o; }
          const f32x4 g1 = *(const f32x4*)(kg + 64 + 4 * q), g2 = *(const f32x4*)(kg + 80 + 4 * q);
          f32x4 x1 = kr1 * g1 * rn, x2 = kr2 * g2 * rn;
          const f32x4 cs0 = *(const f32x4*)(rope + ((size_t)pos * 16 + 4 * q) * 2), cs1 = *(const f32x4*)(rope + ((size_t)pos * 16 + 4 * q) * 2 + 4);
          const float co[4] = {cs0.x, cs0.z, cs1.x, cs1.z}, si[4] = {cs0.y, cs0.w, cs1.y, cs1.w};
#pragma unroll
          for (int e = 0; e < 4; ++e) { const float a = x1[e], bb = x2[e]; x1[e] = a * co[e] - bb * si[e]; x2[e] = bb * co[e] + a * si[e]; }
          u32x2 o1, o2; o1.x = pk2(x1.x, x1.y); o1.y = pk2(x1.z, x1.w); o2.x = pk2(x2.x, x2.y); o2.y = pk2(x2.z, x2.w);
          *(u32x2*)(dst + 64 + 4 * q) = o1; *(u32x2*)(dst + 80 + 4 * q) = o2; }
        { const f32x4 sq = *(const f32x4*)(ssqkv + tok0 + 4 * q);
          f32x4 rs4; rs4.x = rsqrt_(sq.x * (1.0f / 128.0f) + EPS); rs4.y = rsqrt_(sq.y * (1.0f / 128.0f) + EPS); rs4.z = rsqrt_(sq.z * (1.0f / 128.0f) + EPS); rs4.w = rsqrt_(sq.w * (1.0f / 128.0f) + EPS);
#pragma unroll
          for (int ni = 0; ni < 4; ++ni) { const f32x4 v = av[mi][ni] * rs4; u32x2 o; o.x = pk2(v.x, v.y); o.y = pk2(v.z, v.w);
              *(u32x2*)(Vt + (((size_t)b * NH + head) * VD + 16 * ni + r) * L + pos0 + 4 * q) = o; } }
    }
}
__device__ __forceinline__ u32x4 conv_row(const bf16* uglu, int b, int pos, int ch) {
    u32x4 xv = (u32x4){0u, 0u, 0u, 0u};
    if (pos >= 0) xv = *(const u32x4*)(uglu + ((size_t)b * L + pos) * DC + ch);
    return xv;
}
__device__ __forceinline__ void conv_fma(float (&a)[8], const u32x4 xv, const f32x4 w0, const f32x4 w1) {
    a[0] += bf_lo(xv.x) * w0.x; a[1] += bf_hi(xv.x) * w0.y; a[2] += bf_lo(xv.y) * w0.z; a[3] += bf_hi(xv.y) * w0.w;
    a[4] += bf_lo(xv.z) * w1.x; a[5] += bf_hi(xv.z) * w1.y; a[6] += bf_lo(xv.w) * w1.z; a[7] += bf_hi(xv.w) * w1.w;
}
__device__ __forceinline__ void phaseB_conv_item(Ctx& c, int l, int grp) {
    const bf16* uglu = WSP(bf16, WS_UGLU); bf16* u2 = WSP(bf16, WS_U2);
    const float* cw = c.in[4] + (size_t)l * CW * DC; const float* cb = c.in[5] + l * DC; const float* lg = c.in[6] + l * DC; const float* lb = c.in[7] + l * DC;
    const int tok0 = grp * 4, b = tok0 / L, pos0 = tok0 - b * L, ch = c.lane * 8;
    float acc[4][8];
    { const f32x4 b0 = *(const f32x4*)(cb + ch), b1 = *(const f32x4*)(cb + ch + 4);
#pragma unroll
      for (int d = 0; d < 4; ++d) { acc[d][0] = b0.x; acc[d][1] = b0.y; acc[d][2] = b0.z; acc[d][3] = b0.w; acc[d][4] = b1.x; acc[d][5] = b1.y; acc[d][6] = b1.z; acc[d][7] = b1.w; } }
    const int base = pos0 - 30;
    u32x4 x0 = conv_row(uglu, b, base + 0, ch), x1 = conv_row(uglu, b, base + 1, ch), x2 = conv_row(uglu, b, base + 2, ch),
          x3 = conv_row(uglu, b, base + 3, ch), x4 = conv_row(uglu, b, base + 4, ch), x5;
    const float* wp = cw + ch;
#pragma unroll 1
    for (int w = 0; w < CW; ++w) {
        x5 = conv_row(uglu, b, (w + 5 <= 33) ? base + w + 5 : -1, ch);
        const f32x4 w0 = *(const f32x4*)wp, w1 = *(const f32x4*)(wp + 4); wp += DC;
        conv_fma(acc[0], x0, w0, w1); conv_fma(acc[1], x1, w0, w1); conv_fma(acc[2], x2, w0, w1); conv_fma(acc[3], x3, w0, w1);
        x0 = x1; x1 = x2; x2 = x3; x3 = x4; x4 = x5;
    }
    const f32x4 g0 = *(const f32x4*)(lg + ch), g1 = *(const f32x4*)(lg + ch + 4), e0 = *(const f32x4*)(lb + ch), e1 = *(const f32x4*)(lb + ch + 4);
    const float gg[8] = {g0.x, g0.y, g0.z, g0.w, g1.x, g1.y, g1.z, g1.w}, be[8] = {e0.x, e0.y, e0.z, e0.w, e1.x, e1.y, e1.z, e1.w};
#pragma unroll
    for (int d = 0; d < 4; ++d) {
        float s = 0.f;
#pragma unroll
        for (int j = 0; j < 8; ++j) s += acc[d][j];
        const float mu = wave_sum(s) * (1.0f / 512.0f);
        float vq = 0.f;
#pragma unroll
        for (int j = 0; j < 8; ++j) { acc[d][j] -= mu; vq += acc[d][j] * acc[d][j]; }
        const float rstd = rsqrt_(wave_sum(vq) * (1.0f / 512.0f) + EPS);
        float y[8];
#pragma unroll
        for (int j = 0; j < 8; ++j) { const float v = acc[d][j] * rstd * gg[j] + be[j]; y[j] = v * sigmoidf_(v); }
        u32x4 o; o.x = pk2(y[0], y[1]); o.y = pk2(y[2], y[3]); o.z = pk2(y[4], y[5]); o.w = pk2(y[6], y[7]);
        *(u32x4*)(u2 + (size_t)(tok0 + d) * DC + ch) = o;
    }
}
__device__ __forceinline__ void phase_B(const Ctx& c0, int l) {
    Ctx c = reopaque(c0);
    constexpr int NQ = MT * NH, NKV = MT * NH, NCV = T / 16;
    for (int it = c.vb; it < NQ + NKV + NCV; it += c.G) {
        if (it < NQ) phaseB_q_item(c, l, it / NH, it % NH);
        else if (it < NQ + NKV) phaseB_kv_item(c, l, (it - NQ) / NH, (it - NQ) % NH);
        else phaseB_conv_item(c, l, (it - NQ - NKV) * 4 + c.wave);
    }
}

constexpr int KROW = 208, VROW = 136, ATT_STAGE = 64 * KROW + 64 * VROW;
constexpr int ATT_ITEMS = NB * NH * 17;
__device__ __forceinline__ void phase_C(const Ctx& c0, int l) {
    Ctx c = reopaque(c0);
    const bf16* Qb = WSP(bf16, WS_Q); const bf16* Kb = WSP(bf16, WS_K); const bf16* Vt = WSP(bf16, WS_VT); bf16* O = WSP(bf16, WS_O);
    unsigned* qctr = WSP(unsigned, WS_CTL) + CW_QUEUE + 64 * l;
    volatile unsigned* misc = (volatile unsigned*)(c.lds + LDS_MISC);
    const int tid = c.tid, wave = c.wave, lane = c.lane, r = lane & 15, q = lane >> 4;
    unsigned char* lds = c.lds;
    for (;;) {
        if (tid == 0) misc[4] = atomicAdd(qctr, 1u);
        __syncthreads();
        const int item = __builtin_amdgcn_readfirstlane((int)misc[4]);
        __syncthreads();
        if (item >= ATT_ITEMS) break;
        const int pp = 15 - item / 64, bh = item % 64, b = bh / NH, h = bh % NH;
        const bool meta = pp < 0;
        const int r0 = meta ? 0 : 16 + 128 * pp;
        const int nfull = meta ? 0 : 2 * pp + 1 + (wave >> 1);
        const int ntiles = meta ? 1 : 2 * pp + 3;
        const bf16* Kbase = Kb + (size_t)bh * L * QK; const bf16* Vbase = Vt + (size_t)bh * VD * L;
        bf16x8 qf[2][3];
#pragma unroll
        for (int mi = 0; mi < 2; ++mi)
#pragma unroll
            for (int ks = 0; ks < 3; ++ks) qf[mi][ks] = *(const bf16x8*)(Qb + ((size_t)bh * L + r0 + 32 * wave + 16 * mi + r) * QK + 32 * ks + 8 * q);
        float m[2] = {-1e30f, -1e30f}, lsum[2] = {0.f, 0.f};
        f32x4 o[2][4];
#pragma unroll
        for (int mi = 0; mi < 2; ++mi)
#pragma unroll
            for (int dt = 0; dt < 4; ++dt) o[mi][dt] = (f32x4){0.f, 0.f, 0.f, 0.f};
        u32x4 rk[3], rv[2];
        auto gload = [&](int kt) {
#pragma unroll
            for (int i = 0; i < 3; ++i) { const int id = tid + 256 * i, row = id / 12, cc = id % 12; rk[i] = *(const u32x4*)(Kbase + (size_t)(kt * 64 + row) * QK + cc * 8); }
#pragma unroll
            for (int i = 0; i < 2; ++i) { const int id = tid + 256 * i, row = id >> 3, cc = id & 7; rv[i] = *(const u32x4*)(Vbase + (size_t)row * L + kt * 64 + cc * 8); }
        };
        auto lstore = [&](int s) {
            unsigned char* st = lds + s * ATT_STAGE;
#pragma unroll
            for (int i = 0; i < 3; ++i) { const int id = tid + 256 * i, row = id / 12, cc = id % 12; *(u32x4*)(st + row * KROW + cc * 16) = rk[i]; }
#pragma unroll
            for (int i = 0; i < 2; ++i) { const int id = tid + 256 * i, row = id >> 3, cc = id & 7; u32x2* d = (u32x2*)(st + 64 * KROW + row * VROW + cc * 16); d[0] = (u32x2){rv[i].x, rv[i].y}; d[1] = (u32x2){rv[i].z, rv[i].w}; }
        };
        gload(0); lstore(0);
#pragma unroll
        for (int mi = 0; mi < 2; ++mi)
#pragma unroll
            for (int ks = 0; ks < 3; ++ks) asm volatile("" : "+v"(qf[mi][ks]));
        __syncthreads();
        for (int kt = 0; kt < ntiles; ++kt) {
            const int cur = kt & 1;
            if (kt + 1 < ntiles) gload(kt + 1);
            const unsigned char* sK = lds + cur * ATT_STAGE; const unsigned char* sV = sK + 64 * KROW;
            const bool full = kt < nfull;
            if (kt <= nfull) {
                f32x4 s[2][4];
#pragma unroll
                for (int kh = 0; kh < 2; ++kh) {
                    bf16x8 kf[2][3];
#pragma unroll
                    for (int kk = 0; kk < 2; ++kk) if ((kh == 0 && kk == 0) || full) {
#pragma unroll
                        for (int ks = 0; ks < 3; ++ks) kf[kk][ks] = *(const bf16x8*)(sK + (16 * (2 * kh + kk) + r) * KROW + 64 * ks + 16 * q); }
#pragma unroll
                    for (int kk = 0; kk < 2; ++kk) { const int k4 = 2 * kh + kk;
#pragma unroll
                        for (int mi = 0; mi < 2; ++mi) s[mi][k4] = (f32x4){0.f, 0.f, 0.f, 0.f};
                        if (k4 == 0 || full) {
#pragma unroll
                            for (int ks = 0; ks < 3; ++ks)
#pragma unroll
                                for (int mi = 0; mi < 2; ++mi) s[mi][k4] = __builtin_amdgcn_mfma_f32_16x16x32_bf16(kf[kk][ks], qf[mi][ks], s[mi][k4], 0, 0, 0);
                        }
                    }
                }
                u32x2 vlo[4], vhi[4];
#pragma unroll
                for (int dt = 0; dt < 4; ++dt) { const unsigned char* vp = sV + (16 * dt + r) * VROW + (4 * q) * 2;
                    vlo[dt] = *(const u32x2*)vp; vhi[dt] = (u32x2){0u, 0u}; if (full) vhi[dt] = *(const u32x2*)(vp + 32); }
                bf16x8 pf[2][2];
#pragma unroll
                for (int mi = 0; mi < 2; ++mi) {
                    float mx = fmaxf(fmaxf(s[mi][0].x, s[mi][0].y), fmaxf(s[mi][0].z, s[mi][0].w));
                    if (full) {
#pragma unroll
                        for (int k4 = 1; k4 < 4; ++k4) mx = fmaxf(mx, fmaxf(fmaxf(s[mi][k4].x, s[mi][k4].y), fmaxf(s[mi][k4].z, s[mi][k4].w)));
                    }
                    mx = quad_max(mx);
                    const float mn = fmaxf(m[mi], mx), alpha = fast_exp2(m[mi] - mn); m[mi] = mn;
                    float ps = 0.f;
#pragma unroll
                    for (int k4 = 0; k4 < 4; ++k4) {
                        if (k4 == 0 || full) { f32x4 p; p.x = fast_exp2(s[mi][k4].x - mn); p.y = fast_exp2(s[mi][k4].y - mn); p.z = fast_exp2(s[mi][k4].z - mn); p.w = fast_exp2(s[mi][k4].w - mn);
                            ps += (p.x + p.y) + (p.z + p.w); s[mi][k4] = p; }
                    }
                    lsum[mi] = lsum[mi] * alpha + ps;
#pragma unroll
                    for (int dt = 0; dt < 4; ++dt) o[mi][dt] = o[mi][dt] * alpha;
#pragma unroll
                    for (int st = 0; st < 2; ++st) { u32x4 pw;
                        pw.x = pk2(s[mi][2 * st].x, s[mi][2 * st].y); pw.y = pk2(s[mi][2 * st].z, s[mi][2 * st].w); pw.z = pk2(s[mi][2 * st + 1].x, s[mi][2 * st + 1].y); pw.w = pk2(s[mi][2 * st + 1].z, s[mi][2 * st + 1].w);
                        if (!full) { pw.z = 0u; pw.w = 0u; }
                        pf[mi][st] = __builtin_bit_cast(bf16x8, pw); }
                }
                u32x2 wlo[4], whi[4];
                if (full) {
#pragma unroll
                    for (int dt = 0; dt < 4; ++dt) { const unsigned char* vp = sV + (16 * dt + r) * VROW + (32 + 4 * q) * 2; wlo[dt] = *(const u32x2*)vp; whi[dt] = *(const u32x2*)(vp + 32); } }
#pragma unroll
                for (int dt = 0; dt < 4; ++dt) { const bf16x8 vf = __builtin_bit_cast(bf16x8, (u32x4){vlo[dt].x, vlo[dt].y, vhi[dt].x, vhi[dt].y});
#pragma unroll
                    for (int mi = 0; mi < 2; ++mi) o[mi][dt] = __builtin_amdgcn_mfma_f32_16x16x32_bf16(vf, pf[mi][0], o[mi][dt], 0, 0, 0); }
                if (full) {
#pragma unroll
                    for (int dt = 0; dt < 4; ++dt) { const bf16x8 vf = __builtin_bit_cast(bf16x8, (u32x4){wlo[dt].x, wlo[dt].y, whi[dt].x, whi[dt].y});
#pragma unroll
                        for (int mi = 0; mi < 2; ++mi) o[mi][dt] = __builtin_amdgcn_mfma_f32_16x16x32_bf16(vf, pf[mi][1], o[mi][dt], 0, 0, 0); } }
            }
            if (kt + 1 < ntiles) lstore(cur ^ 1);
            __syncthreads();
        }
#pragma unroll
        for (int mi = 0; mi < 2; ++mi) {
            const float lt = quad_sum(lsum[mi]);
            if (!meta || (wave == 0 && mi == 0)) {
                const float inv = 1.0f / lt;
                bf16* dst = O + ((size_t)b * L + r0 + 32 * wave + 16 * mi + r) * 512 + h * VD;
#pragma unroll
                for (int dt = 0; dt < 4; ++dt) { const f32x4 v = o[mi][dt] * inv; u32x2 ov; ov.x = pk2(v.x, v.y); ov.y = pk2(v.z, v.w); *(u32x2*)(dst + 16 * dt + 4 * q) = ov; }
            }
        }
    }
}

__device__ __forceinline__ int tile_tok0(int mt, int l) { return l == 1 ? mt * 128 + NMETA * ((mt >> 4) + 1) : mt * 128; }
__device__ __forceinline__ int n_mtiles(int l) { return l == 1 ? 128 : MT; }
__device__ __forceinline__ void phase_D(const Ctx& c0, int l) {
    Ctx c = reopaque(c0);
    const bf16* u2 = WSP(bf16, WS_U2); const bf16* O = WSP(bf16, WS_O); const bf16* gates = WSP(bf16, WS_GATES); bf16* merged = WSP(bf16, WS_MERGED);
    const bf16* Wco = (const bf16*)(c.ws + WS_WIN + l * SZ_WLAYER + OFF_WCO); const bf16* Wmla = (const bf16*)(c.ws + WS_WIN + l * SZ_WLAYER + OFF_WMLA);
    const int r = c.lane & 15, q = c.lane >> 4;
    for (int it = c.vb; it < n_mtiles(l) * 8; it += c.G) {
        const int mt = it / 8, nt = it % 8, tk0 = tile_tok0(mt, l);
        f32x4 acc[2][8]; acc_zero(acc);
        gemm_core(acc, u2 + (size_t)tk0 * 512, 512, Wco + (size_t)nt * 128 * 512, 512, 512, c.lds, c.tid);
#pragma unroll
        for (int mi = 0; mi < 2; ++mi) { const int tok = tk0 + 32 * c.wave + 16 * mi + r;
            const bf16* gp = gates + (size_t)tok * 2048 + nt * 128 + 4 * q; bf16* mp = merged + (size_t)tok * D + nt * 128 + 4 * q;
#pragma unroll
            for (int ni = 0; ni < 8; ++ni) { const u32x2 g = *(const u32x2*)(gp + 16 * ni); const f32x4 v = acc[mi][ni];
                u32x2 o; o.x = pk2(v.x * bf_lo(g.x), v.y * bf_hi(g.x)); o.y = pk2(v.z * bf_lo(g.y), v.w * bf_hi(g.y)); *(u32x2*)(mp + 16 * ni) = o; } }
        acc_zero(acc);
        gemm_core(acc, O + (size_t)tk0 * 512, 512, Wmla + (size_t)nt * 128 * 512, 512, 512, c.lds, c.tid);
#pragma unroll
        for (int mi = 0; mi < 2; ++mi) { const int tok = tk0 + 32 * c.wave + 16 * mi + r;
            const bf16* gp = gates + (size_t)tok * 2048 + 1024 + nt * 128 + 4 * q; bf16* mp = merged + (size_t)tok * D + nt * 128 + 4 * q;
#pragma unroll
            for (int ni = 0; ni < 8; ++ni) { const u32x2 g = *(const u32x2*)(gp + 16 * ni); const u32x2 s = *(const u32x2*)(mp + 16 * ni); const f32x4 v = acc[mi][ni];
                u32x2 o; o.x = pk2(bf_lo(s.x) + v.x * bf_lo(g.x), bf_hi(s.x) + v.y * bf_hi(g.x)); o.y = pk2(bf_lo(s.y) + v.z * bf_lo(g.y), bf_hi(s.y) + v.w * bf_hi(g.y));
                *(u32x2*)(mp + 16 * ni) = o; } }
    }
}

__device__ __forceinline__ void phase_E(const Ctx& c0, int l) {
    Ctx c = reopaque(c0);
    const bf16* merged = WSP(bf16, WS_MERGED); const bf16* Wout = (const bf16*)(c.ws + WS_WIN + l * SZ_WLAYER + OFF_WOUT);
    float* h = WSP(float, WS_H); bf16* hb = WSP(bf16, WS_HB); float* ssq = WSP(float, WS_SSQ);
    const int r = c.lane & 15, q = c.lane >> 4;
    for (int it = c.vb; it < n_mtiles(l) * 8; it += c.G) {
        const int mt = it / 8, nt = it % 8, tk0 = tile_tok0(mt, l);
        f32x4 acc[2][8];
#pragma unroll
        for (int mi = 0; mi < 2; ++mi) { const int tok = tk0 + 32 * c.wave + 16 * mi + r; const float* hp = h + (size_t)tok * D;
            if (l == 0) { const int b = tok / L, pos = tok - b * L; hp = pos < NMETA ? c.in[1] + (size_t)pos * D : c.in[0] + ((size_t)b * SEQ + (pos - NMETA)) * D; }
            hp += nt * 128 + 4 * q;
#pragma unroll
            for (int ni = 0; ni < 8; ++ni) acc[mi][ni] = *(const f32x4*)(hp + 16 * ni); }
        gemm_core(acc, merged + (size_t)tk0 * D, D, Wout + (size_t)nt * 128 * D, D, D, c.lds, c.tid);
#pragma unroll
        for (int mi = 0; mi < 2; ++mi) { const int tok = tk0 + 32 * c.wave + 16 * mi + r; float ss = 0.f;
#pragma unroll
            for (int ni = 0; ni < 8; ++ni) { float* hp = h + (size_t)tok * D + nt * 128 + 16 * ni + 4 * q; const f32x4 v = acc[mi][ni]; *(f32x4*)hp = v;
                ss += (v.x * v.x + v.y * v.y) + (v.z * v.z + v.w * v.w);
                u32x2 o; o.x = pk2(v.x, v.y); o.y = pk2(v.z, v.w); *(u32x2*)(hb + (size_t)tok * D + nt * 128 + 16 * ni + 4 * q) = o; }
            ss = quad_sum(ss);
            if (q == 0) ssq[(size_t)tok * 8 + nt] = ss; }
    }
}

__device__ __forceinline__ unsigned f2key(float f) { const unsigned u = __float_as_uint(f); return u ^ ((u >> 31) ? 0xFFFFFFFFu : 0x80000000u); }
__device__ __forceinline__ float key2f(unsigned k) { const unsigned u = (k >> 31) ? (k ^ 0x80000000u) : ~k; return __uint_as_float(u); }
__device__ __forceinline__ void top16_insert(unsigned (&lst)[16], unsigned x) {
#pragma unroll
    for (int i = 0; i < 16; ++i) { const unsigned a = lst[i]; lst[i] = a > x ? a : x; x = a > x ? x : a; }
}
__device__ __forceinline__ void ce_desc(unsigned& a, unsigned& b) { const unsigned mx = a > b ? a : b, mn = a > b ? b : a; a = mx; b = mn; }
__device__ __forceinline__ void sort16_desc(unsigned (&v)[16]) {
#pragma unroll
    for (int k = 2; k <= 16; k <<= 1)
#pragma unroll
        for (int j = k >> 1; j > 0; j >>= 1)
#pragma unroll
            for (int i = 0; i < 16; ++i) { const int p = i ^ j; if (p > i) { if ((i & k) == 0) ce_desc(v[i], v[p]); else ce_desc(v[p], v[i]); } }
}
__device__ __forceinline__ void merge_top16(unsigned (&a)[16], const unsigned (&b)[16]) {
#pragma unroll
    for (int i = 0; i < 16; ++i) a[i] = a[i] > b[15 - i] ? a[i] : b[15 - i];
#pragma unroll
    for (int j = 8; j > 0; j >>= 1)
#pragma unroll
        for (int i = 0; i < 16; ++i) { const int p = i ^ j; if (p > i) ce_desc(a[i], a[p]); }
}
__device__ __forceinline__ void phase_F(const Ctx& c0, int l) {
    Ctx c = reopaque(c0);
    const bf16* hb = WSP(bf16, WS_HB); const bf16* Wpq = (const bf16*)(c.ws + WS_WIN + l * SZ_WLAYER + OFF_WPQ); const bf16* keys = (const bf16*)(c.ws + WS_WIN + l * SZ_WLAYER + OFF_KEYS);
    const float* ssq = WSP(float, WS_SSQ); float* sv = WSP(float, WS_SV); unsigned char* si = WSP(unsigned char, WS_SI);
    const int tid = c.tid, wave = c.wave, lane = c.lane, r = lane & 15, q = lane >> 4;
    unsigned char* lds = c.lds;
    const int xcd = c.vb / (c.G / 8), lb = c.vb % (c.G / 8), xm = xcd & 1, xn = xcd >> 1, nmt = n_mtiles(l);
    const int m_lo = xm ? (nmt + 1) / 2 : 0, m_cnt = xm ? nmt / 2 : (nmt + 1) / 2;
    for (int j = lb; j < m_cnt * 4; j += c.G / 8) {
        const int mt = m_lo + j / 4, hp = xn * 4 + j % 4, tk0 = tile_tok0(mt, l);
        f32x4 acc[2][8]; acc_zero(acc);
        u32x4 kreg[2][4]; float rsv[2];
        { const int chunk = tid & 7, row0 = tid >> 3; const bf16* pb = keys + ((size_t)hp * 128 + row0) * 128 + chunk * 8;
#pragma unroll
          for (int s = 0; s < 2; ++s)
#pragma unroll
              for (int i = 0; i < 4; ++i) kreg[s][i] = *(const u32x4*)(pb + (size_t)(32 * i) * 128 + s * 64); }
#pragma unroll
        for (int mi = 0; mi < 2; ++mi) rsv[mi] = rstd_from_ssq8(ssq, tk0 + 32 * wave + 16 * mi + r);
        gemm_core(acc, hb + (size_t)tk0 * D, D, Wpq + (size_t)hp * 128 * D, D, D, lds, tid);
#pragma unroll
        for (int mi = 0; mi < 2; ++mi) { const int row = 32 * wave + 16 * mi + r; const float rs = rsv[mi];
#pragma unroll
            for (int ni = 0; ni < 8; ++ni) { const f32x4 v = acc[mi][ni] * rs; u32x2 o; o.x = pk2(v.x, v.y); o.y = pk2(v.z, v.w);
                *(u32x2*)(lds + (ni >> 2) * 32768 + lds_off(row, 2 * (ni & 3) + (q >> 1)) + 8 * (q & 1)) = o; } }
        { const int chunk = tid & 7, row0 = tid >> 3;
#pragma unroll
          for (int s = 0; s < 2; ++s)
#pragma unroll
              for (int i = 0; i < 4; ++i) *(u32x4*)(lds + s * 32768 + 16384 + lds_off(row0 + 32 * i, chunk)) = kreg[s][i]; }
        __syncthreads();
        acc_zero(acc);
        gemm_compute_stage(acc, lds, lds + 16384, wave, lane);
        gemm_compute_stage(acc, lds + 32768, lds + 32768 + 16384, wave, lane);
        __syncthreads();
        float* S = (float*)lds;
#pragma unroll
        for (int mi = 0; mi < 2; ++mi) { const int row = 32 * wave + 16 * mi + r;
#pragma unroll
            for (int ni = 0; ni < 8; ++ni) *(f32x4*)(S + row * 132 + 16 * ni + 4 * q) = acc[mi][ni]; }
        __syncthreads();
        {
            const int tl = 32 * wave + (lane & 31), half = lane >> 5;
            const float* row = S + tl * 132;
            unsigned lst[16];
#pragma unroll
            for (int g = 0; g < 4; ++g) {
                unsigned cur[16];
#pragma unroll
                for (int j = 0; j < 4; ++j) { const int col = 64 * half + 16 * g + 4 * j; const f32x4 v = *(const f32x4*)(row + col);
                    cur[4 * j] = (f2key(v.x) & ~127u) | (unsigned)(127 - col); cur[4 * j + 1] = (f2key(v.y) & ~127u) | (unsigned)(127 - (col + 1));
                    cur[4 * j + 2] = (f2key(v.z) & ~127u) | (unsigned)(127 - (col + 2)); cur[4 * j + 3] = (f2key(v.w) & ~127u) | (unsigned)(127 - (col + 3)); }
                sort16_desc(cur);
                if (g == 0) {
#pragma unroll
                    for (int i = 0; i < 16; ++i) lst[i] = cur[i];
                } else merge_top16(lst, cur);
            }
            unsigned oth[16];
#pragma unroll
            for (int i = 0; i < 16; ++i) { auto rr = __builtin_amdgcn_permlane32_swap(lst[i], lst[i], false, false); oth[i] = half == 0 ? rr[1] : rr[0]; }
            merge_top16(lst, oth);
            if (half == 0) {
                const int tok = tk0 + tl;
                unsigned idx[16]; float val[16];
#pragma unroll
                for (int i = 0; i < 16; ++i) { idx[i] = 127u - (lst[i] & 127u); val[i] = row[idx[i]]; }
                float* svp = sv + ((size_t)tok * 16 + hp) * 16;
#pragma unroll
                for (int i = 0; i < 4; ++i) *(f32x4*)(svp + 4 * i) = (f32x4){val[4 * i], val[4 * i + 1], val[4 * i + 2], val[4 * i + 3]};
                u32x4 pi;
                pi.x = idx[0] | (idx[1] << 8) | (idx[2] << 16) | (idx[3] << 24); pi.y = idx[4] | (idx[5] << 8) | (idx[6] << 16) | (idx[7] << 24);
                pi.z = idx[8] | (idx[9] << 8) | (idx[10] << 16) | (idx[11] << 24); pi.w = idx[12] | (idx[13] << 8) | (idx[14] << 16) | (idx[15] << 24);
                *(u32x4*)(si + ((size_t)tok * 16 + hp) * 16) = pi;
            }
        }
        __syncthreads();
    }
}

__device__ __forceinline__ void phase_F3(const Ctx& c0, int l) {
    Ctx c = reopaque(c0);
    const float* sv = WSP(float, WS_SV); const unsigned char* si = WSP(unsigned char, WS_SI); int* eidx = WSP(int, WS_EIDX); float* gw = WSP(float, WS_GW); unsigned char* stb = WSP(unsigned char, WS_STB);
    float* lsv = (float*)c.lds;
    unsigned char* lsi = c.lds + 256 * 33 * 4;
    const int tid = c.tid;
    const bool has_x = l == 0 && (c.vb & 3) == 0; const int tx = T - 128 + (c.vb >> 2);
    for (int pass = 0; pass < (has_x ? 2 : 1); ++pass) {
        const int thc = c.vb * NTHREADS + tid, tkc = thc >> 3;
        const int th = pass == 1 ? tx * 8 + (tid & 7) : (l == 1 ? tkc + NMETA * ((tkc >> 11) + 1) : tkc) * 8 + (thc & 7);
        float a[16], b[16];
#pragma unroll
        for (int i = 0; i < 4; ++i) { const f32x4 x = *(const f32x4*)(sv + (size_t)th * 32 + 4 * i), y = *(const f32x4*)(sv + (size_t)th * 32 + 16 + 4 * i);
            a[4 * i] = x.x; a[4 * i + 1] = x.y; a[4 * i + 2] = x.z; a[4 * i + 3] = x.w; b[4 * i] = y.x; b[4 * i + 1] = y.y; b[4 * i + 2] = y.z; b[4 * i + 3] = y.w; }
        const u32x4 ia = *(const u32x4*)(si + (size_t)th * 32), ib = *(const u32x4*)(si + (size_t)th * 32 + 16);
#pragma unroll
        for (int i = 0; i < 16; ++i) { lsv[tid * 33 + i] = a[i]; lsv[tid * 33 + 16 + i] = b[i]; }
        *(u32x4*)(lsi + tid * 32) = ia; *(u32x4*)(lsi + tid * 32 + 16) = ib;
        unsigned lst[16], g2[16], g3[16], g4[16];
#pragma unroll
        for (int j = 0; j < 16; ++j) lst[j] = (f2key(a[0] + b[j]) & ~255u) | (unsigned)(255 - j);
#pragma unroll
        for (int i = 1; i < 16; ++i) g2[i - 1] = (f2key(a[i] + b[0]) & ~255u) | (unsigned)(255 - i * 16);
        g2[15] = 0u;
        { int n = 0;
#pragma unroll
          for (int i = 1; i < 16; ++i)
#pragma unroll
              for (int j = 1; j < 16; ++j)
                  if ((i + 1) * (j + 1) <= 16) { const unsigned key = (f2key(a[i] + b[j]) & ~255u) | (unsigned)(255 - (i * 16 + j)); if (n < 16) g3[n] = key; else g4[n - 16] = key; ++n; }
#pragma unroll
          for (int k = 3; k < 16; ++k) g4[k] = 0u; }
        sort16_desc(g3); sort16_desc(g4);
        merge_top16(lst, g2); merge_top16(g3, g4); merge_top16(lst, g3);
        __builtin_amdgcn_s_waitcnt(0xC07F); asm volatile("" ::: "memory");
        float s[16]; int e[16];
#pragma unroll
        for (int k = 0; k < 16; ++k) { const unsigned code = 255u - (lst[k] & 255u); const int i = code >> 4, j = code & 15;
            s[k] = lsv[tid * 33 + i] + lsv[tid * 33 + 16 + j]; e[k] = (int)lsi[tid * 32 + i] * 128 + (int)lsi[tid * 32 + 16 + j]; }
        float mx = s[0];
#pragma unroll
        for (int k = 1; k < 16; ++k) mx = fmaxf(mx, s[k]);
        float sum = 0.f;
#pragma unroll
        for (int k = 0; k < 16; ++k) { s[k] = fast_exp2((s[k] - mx) * 1.4426950409f); sum += s[k]; }
        const float inv = 1.0f / sum;
        typedef unsigned long long u64;
        u64 hlo = 0ull, hhi = 0ull;
#pragma unroll
        for (int k = 0; k < 16; ++k) { const int sl = e[k] >> 10; if (sl < 8) hlo += 1ull << (8 * sl); else hhi += 1ull << (8 * (sl - 8)); }
        u64 ilo = hlo, ihi = hhi;
#pragma unroll
        for (int d = 1; d < 8; d <<= 1) { const u64 a_ = __shfl_up(ilo, d, 8), b_ = __shfl_up(ihi, d, 8); if ((tid & 7) >= d) { ilo += a_; ihi += b_; } }
        const u64 tlo = __shfl(ilo, 7, 8), thi = __shfl(ihi, 7, 8);
        const u64 ones = 0x0101010101010101ull;
        const u64 inlo = tlo * ones, inhi = thi * ones + (inlo >> 56) * ones;
        const u64 stlo = inlo - tlo, sthi = inhi - thi;
        u64 rlo = stlo + (ilo - hlo), rhi = sthi + (ihi - hhi);
        const int tokn = th >> 3;
#pragma unroll
        for (int k = 0; k < 16; ++k) { const int sl = e[k] >> 10; int pos;
            if (sl < 8) { pos = (int)((rlo >> (8 * sl)) & 255ull); rlo += 1ull << (8 * sl); } else { pos = (int)((rhi >> (8 * (sl - 8))) & 255ull); rhi += 1ull << (8 * (sl - 8)); }
            eidx[(size_t)tokn * 128 + pos] = e[k]; gw[(size_t)tokn * 128 + pos] = s[k] * inv; }
        if ((tid & 7) == 0) { u64* sp = (u64*)(stb + (size_t)tokn * 16); sp[0] = stlo; sp[1] = sthi; }
        __builtin_amdgcn_s_waitcnt(0xC07F); asm volatile("" ::: "memory");
    }
}

typedef float f32x2 __attribute__((ext_vector_type(2)));
constexpr int G2_WSTRIDE = 14336, G2_MAXTOK = 9;
__device__ __forceinline__ float fp8dot4(unsigned w, unsigned x01, unsigned x23, float acc) {
    const bf16x2 lo = __builtin_amdgcn_cvt_scalef32_pk_bf16_fp8(w, 1.0f, false), hi = __builtin_amdgcn_cvt_scalef32_pk_bf16_fp8(w, 1.0f, true);
    acc = __builtin_amdgcn_fdot2_f32_bf16(lo, __builtin_bit_cast(bf16x2, x01), acc, false);
    return __builtin_amdgcn_fdot2_f32_bf16(hi, __builtin_bit_cast(bf16x2, x23), acc, false);
}
__device__ __forceinline__ float reduce8_transposed(const float (&p)[8], int lane) {
    float s[4];
#pragma unroll
    for (int k = 0; k < 4; ++k) { auto r = __builtin_amdgcn_permlane32_swap(__float_as_uint(p[k]), __float_as_uint(p[k + 4]), false, false); s[k] = __uint_as_float(r[0]) + __uint_as_float(r[1]); }
    float t[2];
#pragma unroll
    for (int k = 0; k < 2; ++k) { auto r = __builtin_amdgcn_permlane16_swap(__float_as_uint(s[k]), __float_as_uint(s[k + 2]), false, false); t[k] = __uint_as_float(r[0]) + __uint_as_float(r[1]); }
    const float u0 = t[0] + dpp<0x128>(t[0]), u1 = t[1] + dpp<0x128>(t[1]);
    float r = (lane & 8) ? u1 : u0;
    r += dpp<0xB1>(r); r += dpp<0x4E>(r); r += dpp<0x141>(r);
    return r;
}
typedef int i32x4 __attribute__((ext_vector_type(4)));
typedef _Float16 h2 __attribute__((ext_vector_type(2)));
__device__ __forceinline__ void fp4fma8(h2 (&acc)[8], int o, unsigned w, h2 a2) {
    acc[o] = __builtin_elementwise_fma(a2, __builtin_bit_cast(h2, __builtin_amdgcn_cvt_scalef32_pk_f16_fp4(w, 1.0f, 0)), acc[o]);
    acc[o + 1] = __builtin_elementwise_fma(a2, __builtin_bit_cast(h2, __builtin_amdgcn_cvt_scalef32_pk_f16_fp4(w, 1.0f, 1)), acc[o + 1]);
    acc[o + 2] = __builtin_elementwise_fma(a2, __builtin_bit_cast(h2, __builtin_amdgcn_cvt_scalef32_pk_f16_fp4(w, 1.0f, 2)), acc[o + 2]);
    acc[o + 3] = __builtin_elementwise_fma(a2, __builtin_bit_cast(h2, __builtin_amdgcn_cvt_scalef32_pk_f16_fp4(w, 1.0f, 3)), acc[o + 3]);
}
__device__ __forceinline__ void g2_u_chunk(u32x2 (&u)[8], const unsigned char* U, const int* pe_next, const float* pw_c, float* act_c, const u32x2 xq, float rs, int lane) {
    const i32x4 e0 = *(const i32x4*)pe_next, e1 = *(const i32x4*)(pe_next + 4);
    const int en[8] = {e0.x, e0.y, e0.z, e0.w, e1.x, e1.y, e1.z, e1.w};
    float p[8];
#pragma unroll
    for (int k = 0; k < 8; k += 2) {
        int d0 = __builtin_amdgcn_sdot8((int)u[k].x, (int)xq.x, 0, false), d1 = __builtin_amdgcn_sdot8((int)u[k + 1].x, (int)xq.x, 0, false);
        d0 = __builtin_amdgcn_sdot8((int)u[k].y, (int)xq.y, d0, false); d1 = __builtin_amdgcn_sdot8((int)u[k + 1].y, (int)xq.y, d1, false);
        p[k] = (float)d0; p[k + 1] = (float)d1;
        asm volatile("" : "+v"(p[k]), "+v"(p[k + 1]));
        u[k] = *(const u32x2*)(U + (size_t)__builtin_amdgcn_readfirstlane(en[k]) * 512 + lane * 8);
        u[k + 1] = *(const u32x2*)(U + (size_t)__builtin_amdgcn_readfirstlane(en[k + 1]) * 512 + lane * 8);
    }
    const float a = reduce8_transposed(p, lane);
    const int row = (lane >> 3) & 7;
    if ((lane & 7) == 0) { const _Float16 hv = (_Float16)(gelu_tanh(a * rs) * pw_c[row]); act_c[row] = __builtin_bit_cast(float, (h2){hv, hv}); }
}
__device__ __forceinline__ void g2_v_chunk(u32x2 (&v)[8], const unsigned char* V, const int* pe_next, const float* act_c, h2 (&acc)[8], int lane) {
    const i32x4 e0 = *(const i32x4*)pe_next, e1 = *(const i32x4*)(pe_next + 4);
    const int en[8] = {e0.x, e0.y, e0.z, e0.w, e1.x, e1.y, e1.z, e1.w};
    const f32x4 a0 = *(const f32x4*)act_c, a1 = *(const f32x4*)(act_c + 4);
    const float av[8] = {a0.x, a0.y, a0.z, a0.w, a1.x, a1.y, a1.z, a1.w};
#pragma unroll
    for (int k = 0; k < 8; k += 2) {
        const h2 a2 = __builtin_bit_cast(h2, av[k]), b2 = __builtin_bit_cast(h2, av[k + 1]);
        fp4fma8(acc, 0, v[k].x, a2); fp4fma8(acc, 4, v[k].y, a2);
        fp4fma8(acc, 0, v[k + 1].x, b2); fp4fma8(acc, 4, v[k + 1].y, b2);
        asm volatile("" : "+v"(acc[0]), "+v"(acc[1]), "+v"(acc[2]), "+v"(acc[3]), "+v"(acc[4]), "+v"(acc[5]), "+v"(acc[6]), "+v"(acc[7]));
        v[k] = *(const u32x2*)(V + (size_t)__builtin_amdgcn_readfirstlane(en[k]) * 512 + lane * 8);
        v[k + 1] = *(const u32x2*)(V + (size_t)__builtin_amdgcn_readfirstlane(en[k + 1]) * 512 + lane * 8);
    }
}
__device__ __forceinline__ void g2_finish_token(Ctx& c, int l, int tok, const f32x2 (&acc)[8], int lane) {
    float* h = WSP(float, WS_H); bf16* hbw = WSP(bf16, WS_HB); float* ssqw = WSP(float, WS_SSQ);
    float* hp = h + (size_t)tok * D + lane * 16;
    f32x4 r0 = *(const f32x4*)hp, r1 = *(const f32x4*)(hp + 4), r2 = *(const f32x4*)(hp + 8), r3 = *(const f32x4*)(hp + 12);
    r0 += (f32x4){acc[0].x, acc[0].y, acc[1].x, acc[1].y}; r1 += (f32x4){acc[2].x, acc[2].y, acc[3].x, acc[3].y};
    r2 += (f32x4){acc[4].x, acc[4].y, acc[5].x, acc[5].y}; r3 += (f32x4){acc[6].x, acc[6].y, acc[7].x, acc[7].y};
    if (l == 0) {
        *(f32x4*)hp = r0; *(f32x4*)(hp + 4) = r1; *(f32x4*)(hp + 8) = r2; *(f32x4*)(hp + 12) = r3;
        u32x4 o0, o1; o0.x = pk2(r0.x, r0.y); o0.y = pk2(r0.z, r0.w); o0.z = pk2(r1.x, r1.y); o0.w = pk2(r1.z, r1.w);
        o1.x = pk2(r2.x, r2.y); o1.y = pk2(r2.z, r2.w); o1.z = pk2(r3.x, r3.y); o1.w = pk2(r3.z, r3.w);
        *(u32x4*)(hbw + (size_t)tok * D + lane * 16) = o0; *(u32x4*)(hbw + (size_t)tok * D + lane * 16 + 8) = o1;
        float ss = (r0.x * r0.x + r0.y * r0.y) + (r0.z * r0.z + r0.w * r0.w) + (r1.x * r1.x + r1.y * r1.y) + (r1.z * r1.z + r1.w * r1.w)
                 + (r2.x * r2.x + r2.y * r2.y) + (r2.z * r2.z + r2.w * r2.w) + (r3.x * r3.x + r3.y * r3.y) + (r3.z * r3.z + r3.w * r3.w);
        ss = wave_sum_dpp(ss);
        if (lane < 8) ssqw[(size_t)tok * 8 + lane] = lane == 0 ? ss : 0.f;
    } else {
        const int b = tok / L, pos = tok - b * L;
        if (pos >= NMETA) { float* op = c.out + ((size_t)b * SEQ + (pos - NMETA)) * D + lane * 16;
            *(f32x4*)op = r0; *(f32x4*)(op + 4) = r1; *(f32x4*)(op + 8) = r2; *(f32x4*)(op + 12) = r3; }
    }
}
__device__ __forceinline__ void phase_G2(const Ctx& c0, int l) {
    Ctx c = reopaque(c0);
    const bf16* hb = WSP(bf16, WS_HB); const float* ssq = WSP(float, WS_SSQ); const int* pe = WSP(int, WS_EIDX); const float* pw = WSP(float, WS_GW);
    const unsigned char* U = c.ws + WS_TAB + (size_t)(l * 2) * SZ_TAB; const unsigned char* V = c.ws + WS_TAB + (size_t)(l * 2 + 1) * SZ_TAB;
    const int lane = c.lane, wave = c.wave;
    const int gw = c.vb * 4 + wave, t0 = l == 1 ? gw * 8 + NMETA * ((gw >> 8) + 1) : gw * 8;
    const bool has_x = l == 0 && (c.vb & 3) == 0; const int tx = T - 128 + (c.vb >> 2);
    unsigned char* wl = c.lds + wave * G2_WSTRIDE;
    int* pe_l = (int*)wl; float* pw_l = (float*)(wl + 4608); float* act_l = (float*)(wl + 9216);
#pragma unroll
    for (int j = 0; j < G2_MAXTOK; ++j) { const int tok = j < 8 ? t0 + j : (has_x ? tx : t0);
        pe_l[j * 128 + lane] = pe[(size_t)tok * 128 + lane]; pe_l[j * 128 + 64 + lane] = pe[(size_t)tok * 128 + 64 + lane];
        pw_l[j * 128 + lane] = pw[(size_t)tok * 128 + lane]; pw_l[j * 128 + 64 + lane] = pw[(size_t)tok * 128 + 64 + lane]; }
    const int xlo = has_x ? 4 * wave : 16, xhi = has_x ? 4 * wave + 4 : 16;
    {
        u32x2 xq[G2_MAXTOK]; float rs[G2_MAXTOK];
#pragma unroll
        for (int j = 0; j < G2_MAXTOK; ++j) { const int tok = j < 8 ? t0 + j : (has_x ? tx : t0);
            const u32x4 lo = *(const u32x4*)(hb + (size_t)tok * D + lane * 16), hi = *(const u32x4*)(hb + (size_t)tok * D + lane * 16 + 8);
            const float sx = rstd_from_ssq8(ssq, tok) * X_SCALE;
            const f32x4 f0 = (f32x4){bf_lo(lo.x), bf_hi(lo.x), bf_lo(lo.y), bf_hi(lo.y)} * sx, f1 = (f32x4){bf_lo(lo.z), bf_hi(lo.z), bf_lo(lo.w), bf_hi(lo.w)} * sx;
            const f32x4 f2 = (f32x4){bf_lo(hi.x), bf_hi(hi.x), bf_lo(hi.y), bf_hi(hi.y)} * sx, f3 = (f32x4){bf_lo(hi.z), bf_hi(hi.z), bf_lo(hi.w), bf_hi(hi.w)} * sx;
            xq[j].x = pack_i4x4(f0) | (pack_i4x4(f1) << 16); xq[j].y = pack_i4x4(f2) | (pack_i4x4(f3) << 16);
            rs[j] = 1.0f / (X_SCALE * U_SCALE); }
        u32x2 u[8];
#pragma unroll
        for (int k = 0; k < 8; ++k) u[k] = *(const u32x2*)(U + (size_t)__builtin_amdgcn_readfirstlane(pe_l[k]) * 512 + lane * 8);
#pragma unroll 1
        for (int ch = 0; ch < 16; ++ch) {
            const int cn = ch < 15 ? ch + 1 : 0;
            const bool x_here = ch >= xlo && ch < xhi;
#pragma unroll
            for (int j = 0; j < 8; ++j) {
                const int* pe_next = j < 7 ? pe_l + (j + 1) * 128 + ch * 8 : (x_here ? pe_l + 8 * 128 + ch * 8 : pe_l + cn * 8);
                g2_u_chunk(u, U, pe_next, pw_l + j * 128 + ch * 8, act_l + j * 128 + ch * 8, xq[j], rs[j], lane); }
            if (x_here) g2_u_chunk(u, U, pe_l + cn * 8, pw_l + 8 * 128 + ch * 8, act_l + 8 * 128 + ch * 8, xq[8], rs[8], lane);
        }
    }
    h2 acc[G2_MAXTOK][8];
#pragma unroll
    for (int j = 0; j < G2_MAXTOK; ++j)
#pragma unroll
        for (int i = 0; i < 8; ++i) acc[j][i] = (h2){(_Float16)0.f, (_Float16)0.f};
    {
        u32x2 v[8];
#pragma unroll
        for (int k = 0; k < 8; ++k) v[k] = *(const u32x2*)(V + (size_t)__builtin_amdgcn_readfirstlane(pe_l[k]) * 512 + lane * 8);
#pragma unroll 1
        for (int ch = 0; ch < 16; ++ch) {
            const int cn = ch < 15 ? ch + 1 : 0;
            const bool x_here = ch >= xlo && ch < xhi;
#pragma unroll
            for (int j = 0; j < 8; ++j) {
                const int* pe_next = j < 7 ? pe_l + (j + 1) * 128 + ch * 8 : (x_here ? pe_l + 8 * 128 + ch * 8 : pe_l + cn * 8);
                g2_v_chunk(v, V, pe_next, act_l + j * 128 + ch * 8, acc[j], lane); }
            if (x_here) g2_v_chunk(v, V, pe_l + cn * 8, act_l + 8 * 128 + ch * 8, acc[8], lane);
        }
    }
#pragma unroll
    for (int j = 0; j < 8; ++j) { f32x2 af[8];
#pragma unroll
        for (int i = 0; i < 8; ++i) af[i] = (f32x2){(float)acc[j][i].x, (float)acc[j][i].y} * TAB_INV;
        g2_finish_token(c, l, t0 + j, af, lane); }
    f32x2 accx[8];
#pragma unroll
    for (int i = 0; i < 8; ++i) accx[i] = (f32x2){(float)acc[8][i].x, (float)acc[8][i].y} * TAB_INV;
    __syncthreads();
    if (has_x) {
        f32x2* part = (f32x2*)(c.lds + wave * G2_WSTRIDE);
#pragma unroll
        for (int i = 0; i < 8; ++i) part[i * 64 + lane] = accx[i];
    }
    __syncthreads();
    if (has_x && wave == 0) {
        f32x2 tot[8];
#pragma unroll
        for (int i = 0; i < 8; ++i) { tot[i] = accx[i];
#pragma unroll
            for (int w = 1; w < 4; ++w) tot[i] += ((const f32x2*)(c.lds + w * G2_WSTRIDE))[i * 64 + lane]; }
        g2_finish_token(c, l, tx, tot, lane);
    }
    __syncthreads();
}

struct Args { const float* in[22]; float* out; unsigned char* ws; int ph_lo, ph_hi; };
constexpr int N_PHASES = 17;

__global__ void __launch_bounds__(NTHREADS, 2) fwd_kernel(Args args) {
    extern __shared__ __attribute__((aligned(16))) unsigned char lds_raw[];
    Ctx c;
#pragma unroll
    for (int i = 0; i < 22; ++i) c.in[i] = args.in[i];
    c.out = args.out; c.ws = args.ws; c.lds = lds_raw;
    c.tid = threadIdx.x; c.lane = c.tid & 63; c.wave = __builtin_amdgcn_readfirstlane(c.tid >> 6);
    c.G = gridDim.x; { const int bx = blockIdx.x; c.vb = (c.G % 8 == 0) ? (bx % 8) * (c.G / 8) + bx / 8 : bx; }
    volatile unsigned* misc = (volatile unsigned*)(c.lds + LDS_MISC);
    if (c.tid < 16) misc[c.tid] = 0u;
    __syncthreads();
    const int lo = args.ph_lo, hi = args.ph_hi;
    const bool multi = (hi - lo) > 1;
    XcdBarrier bar; bar.bar = WSP(unsigned, WS_CTL) + CW_BAR; bar.x = 0; bar.st = misc;
    if (multi) bar = xcd_barrier_post(WSP(unsigned, WS_CTL) + CW_BAR, misc);
#define IN_(k) (lo <= (k) && (k) < hi)
#define SEAM_(k) do { if ((k) + 1 < hi) xcd_barrier(bar); } while (0)
    if (IN_(0)) { phase_prologue(c); SEAM_(0); }
#pragma unroll 1
    for (int l = 0; l < 2; ++l) {
        const int p0 = 1 + 8 * l;
        if (IN_(p0 + 0)) { phase_A(c, l); SEAM_(p0 + 0); }
        if (IN_(p0 + 1)) { phase_B(c, l); SEAM_(p0 + 1); }
        if (IN_(p0 + 2)) { phase_C(c, l); SEAM_(p0 + 2); }
        if (IN_(p0 + 3)) { phase_D(c, l); SEAM_(p0 + 3); }
        if (IN_(p0 + 4)) { phase_E(c, l); SEAM_(p0 + 4); }
        if (IN_(p0 + 5)) { phase_F(c, l); SEAM_(p0 + 5); }
        if (IN_(p0 + 6)) { phase_F3(c, l); if (p0 + 7 < hi) { asm volatile("s_waitcnt vmcnt(0)" ::: "memory"); __syncthreads(); } }
        if (IN_(p0 + 7)) { phase_G2(c, l); SEAM_(p0 + 7); }
    }
}

extern "C" void kernel_launch(void* const* d_in, const int* in_sizes, int n_in, void* d_out, int out_size, void* d_ws, size_t ws_size, hipStream_t stream) {
    static int grid = 0;
    if (grid == 0) {
        if (n_in != 22 || out_size != NB * SEQ * D || ws_size < WS_END) { fprintf(stderr, "kernel_launch: unexpected shapes (n_in %d out %d ws %zu need %zu)\n", n_in, out_size, ws_size, (size_t)WS_END); grid = -1; return; }
        int dev = 0, cus = 0, per_cu = 0;
        hipGetDevice(&dev); hipDeviceGetAttribute(&cus, hipDeviceAttributeMultiprocessorCount, dev);
        if (hipFuncSetAttribute((const void*)fwd_kernel, hipFuncAttributeMaxDynamicSharedMemorySize, LDS_BYTES) != hipSuccess) { fprintf(stderr, "kernel_launch: hipFuncSetAttribute failed\n"); grid = -1; return; }
        if (hipOccupancyMaxActiveBlocksPerMultiprocessor(&per_cu, (const void*)fwd_kernel, NTHREADS, LDS_BYTES) != hipSuccess || per_cu < 1) { fprintf(stderr, "kernel_launch: occupancy query failed (%d)\n", per_cu); per_cu = 1; (void)hipGetLastError(); }
        if (per_cu > 2) per_cu = 2;
        grid = cus * per_cu;
        if (grid != 512) { fprintf(stderr, "kernel_launch: grid %d unsupported by phase G2 (needs 512 workgroups)\n", grid); grid = -1; return; }
        fprintf(stderr, "kernel_launch: grid %d (%d per CU), lds %d, ws need %zu have %zu\n", grid, per_cu, LDS_BYTES, (size_t)WS_END, ws_size);
    }
    if (grid < 0) return;
    hipMemsetAsync((char*)d_ws + WS_CTL, 0, CTL_BYTES, stream);
    Args a{};
    for (int i = 0; i < 22; ++i) a.in[i] = (const float*)d_in[i];
    a.out = (float*)d_out; a.ws = (unsigned char*)d_ws;
#if MK_PER_PHASE
    for (int ph = 0; ph < N_PHASES; ++ph) { a.ph_lo = ph; a.ph_hi = ph + 1; hipLaunchKernelGGL(fwd_kernel, dim3(grid), dim3(NTHREADS), LDS_BYTES, stream, a); }
#else
    a.ph_lo = 0; a.ph_hi = N_PHASES;
    void* kargs[] = {&a};
    hipError_t e = hipLaunchCooperativeKernel((const void*)fwd_kernel, dim3(grid), dim3(NTHREADS), kargs, LDS_BYTES, stream);
    if (e != hipSuccess) fprintf(stderr, "kernel_launch: cooperative launch failed: %s (grid %d)\n", hipGetErrorString(e), grid);
#endif
}
```

```cpp
#include <hip/hip_runtime.h>
#include <cstdio>
#include <cstdint>

#ifndef MK_PER_PHASE
#define MK_PER_PHASE 0
#endif

typedef unsigned short bf16;
typedef short bf16x8 __attribute__((ext_vector_type(8)));
typedef float f32x4 __attribute__((ext_vector_type(4)));
typedef unsigned u32x4 __attribute__((ext_vector_type(4)));
typedef unsigned u32x2 __attribute__((ext_vector_type(2)));
typedef __bf16 bf16x2 __attribute__((ext_vector_type(2)));

constexpr int NB = 8, SEQ = 2048, NMETA = 16, L = SEQ + NMETA, T = NB * L, D = 1024;
constexpr int DC = 512, CW = 31, NH = 8, QL = 256, KVL = 128, NOPE = 64, ROPE = 32, QK = 96, VD = 64;
constexpr int NIN = 3488, NINP = 3584;
constexpr int NEXP = 16384;
constexpr float EPS = 1e-6f;
constexpr int MT = T / 128;
static_assert(T % 128 == 0, "T tiles");

constexpr size_t al256(size_t x) { return (x + 255) & ~(size_t)255; }
constexpr size_t WS_CTL = 0;
constexpr size_t CTL_BYTES = 65536;
constexpr size_t WS_ROPE = WS_CTL + CTL_BYTES;
constexpr size_t WS_WIN = al256(WS_ROPE + (size_t)L * 16 * 8);
constexpr size_t SZ_WIN = (size_t)NINP * 1024 * 2, SZ_WCO = (size_t)1024 * 512 * 2, SZ_WUQ = (size_t)1024 * 256 * 2, SZ_WUKV = (size_t)1024 * 128 * 2,
                 SZ_WMLA = (size_t)1024 * 512 * 2, SZ_WOUT = (size_t)1024 * 1024 * 2, SZ_WPQ = (size_t)2048 * 1024 * 2, SZ_KEYS = (size_t)16 * 128 * 128 * 2;
constexpr size_t OFF_WCO = SZ_WIN, OFF_WUQ = OFF_WCO + SZ_WCO, OFF_WUKV = OFF_WUQ + SZ_WUQ, OFF_WMLA = OFF_WUKV + SZ_WUKV, OFF_WOUT = OFF_WMLA + SZ_WMLA,
                 OFF_WPQ = OFF_WOUT + SZ_WOUT, OFF_KEYS = OFF_WPQ + SZ_WPQ, SZ_WLAYER = OFF_KEYS + SZ_KEYS;
constexpr size_t WS_TAB = al256(WS_WIN + 2 * SZ_WLAYER);
constexpr size_t SZ_TAB = (size_t)NEXP * 1024;
constexpr float TAB_SCALE = 64.0f, TAB_INV = 1.0f / 64.0f;
constexpr float U_CLIP = 2.7f / 32.0f, U_SCALE = 7.0f / U_CLIP;
constexpr float X_SCALE = 7.0f / 2.7f;
constexpr size_t WS_H = al256(WS_TAB + 4 * SZ_TAB);
constexpr size_t WS_HB = al256(WS_H + (size_t)T * 1024 * 4);
constexpr size_t WS_SSQ = al256(WS_HB + (size_t)T * 1024 * 2);
constexpr size_t WS_UGLU = al256(WS_SSQ + (size_t)T * 8 * 4);
constexpr size_t WS_CQ = al256(WS_UGLU + (size_t)T * 512 * 2);
constexpr size_t WS_CKV = al256(WS_CQ + (size_t)T * 256 * 2);
constexpr size_t WS_KROPE = al256(WS_CKV + (size_t)T * 128 * 2);
constexpr size_t WS_SSQQ = al256(WS_KROPE + (size_t)T * 32 * 4);
constexpr size_t WS_SSQKV = al256(WS_SSQQ + (size_t)T * 2 * 4);
constexpr size_t WS_U2 = al256(WS_SSQKV + (size_t)T * 4);
constexpr size_t WS_Q = al256(WS_U2 + (size_t)T * 512 * 2);
constexpr size_t WS_K = al256(WS_Q + (size_t)T * NH * QK * 2);
constexpr size_t WS_VT = al256(WS_K + (size_t)T * NH * QK * 2);
constexpr size_t WS_O = al256(WS_VT + (size_t)T * NH * VD * 2 + 4096);
constexpr size_t WS_MERGED = al256(WS_O + (size_t)T * 512 * 2);
constexpr size_t WS_GATES = al256(WS_MERGED + (size_t)T * 1024 * 2);
constexpr size_t WS_SV = WS_GATES;
constexpr size_t WS_SI = al256(WS_SV + (size_t)T * 256 * 4);
constexpr size_t WS_EIDX = al256(WS_SI + (size_t)T * 256);
constexpr size_t WS_GW = al256(WS_EIDX + (size_t)T * 128 * 4);
constexpr size_t WS_STB = al256(WS_GW + (size_t)T * 128 * 4);
constexpr size_t WS_PEER_END = WS_STB + (size_t)T * 16;
constexpr size_t WS_END = al256(WS_GATES + (size_t)T * 2048 * 2);
static_assert(WS_PEER_END <= WS_END, "peer scratch overlay");

constexpr int CW_BAR = 0;
constexpr int CW_QUEUE = 4096;

constexpr int LDS_MAIN = 128 * 132 * 4;
constexpr int LDS_MISC = LDS_MAIN;
constexpr int LDS_BYTES = LDS_MAIN + 64;

constexpr int NTHREADS = 256;

__device__ __forceinline__ unsigned pk2(float lo, float hi) { bf16x2 v; v.x = (__bf16)lo; v.y = (__bf16)hi; return __builtin_bit_cast(unsigned, v); }
__device__ __forceinline__ unsigned pack_i8x4(f32x4 v) {
    const int a = (int)__builtin_rintf(fminf(fmaxf(v.x, -127.f), 127.f)), b = (int)__builtin_rintf(fminf(fmaxf(v.y, -127.f), 127.f));
    const int c_ = (int)__builtin_rintf(fminf(fmaxf(v.z, -127.f), 127.f)), d = (int)__builtin_rintf(fminf(fmaxf(v.w, -127.f), 127.f));
    return (unsigned)(a & 255) | ((unsigned)(b & 255) << 8) | ((unsigned)(c_ & 255) << 16) | ((unsigned)(d & 255) << 24);
}
__device__ __forceinline__ unsigned pack_i4x4(f32x4 v) {
    const int a = (int)__builtin_rintf(fminf(fmaxf(v.x, -7.f), 7.f)), b = (int)__builtin_rintf(fminf(fmaxf(v.y, -7.f), 7.f));
    const int c_ = (int)__builtin_rintf(fminf(fmaxf(v.z, -7.f), 7.f)), d = (int)__builtin_rintf(fminf(fmaxf(v.w, -7.f), 7.f));
    return (unsigned)(a & 15) | ((unsigned)(b & 15) << 4) | ((unsigned)(c_ & 15) << 8) | ((unsigned)(d & 15) << 12);
}
__device__ __forceinline__ unsigned short pack_fp4x4(f32x4 v) {
#pragma unroll
    for (int i = 0; i < 4; ++i) v[i] = fminf(fmaxf(v[i], -6.0f), 6.0f);
    unsigned w = __builtin_amdgcn_cvt_scalef32_pk_fp4_f32(0u, v.x, v.y, 1.0f, 0);
    w = __builtin_amdgcn_cvt_scalef32_pk_fp4_f32(w, v.z, v.w, 1.0f, 1);
    return (unsigned short)w;
}
__device__ __forceinline__ float bf_lo(unsigned p) { return __uint_as_float(p << 16); }
__device__ __forceinline__ float bf_hi(unsigned p) { return __uint_as_float(p & 0xffff0000u); }
__device__ __forceinline__ float fast_rcp(float x) { return __builtin_amdgcn_rcpf(x); }
__device__ __forceinline__ float fast_exp2(float x) { return __builtin_amdgcn_exp2f(x); }
__device__ __forceinline__ float sigmoidf_(float x) { return fast_rcp(1.0f + fast_exp2(-1.4426950409f * x)); }
__device__ __forceinline__ float gelu_tanh(float x) { const float u = 1.5957691216f * (x + 0.044715f * x * x * x); return x * fast_rcp(1.0f + fast_exp2(-1.4426950409f * u)); }
__device__ __forceinline__ float rsqrt_(float x) { return __builtin_amdgcn_rsqf(x); }
template <int CTRL> __device__ __forceinline__ float dpp(float x) { return __builtin_bit_cast(float, __builtin_amdgcn_mov_dpp(__builtin_bit_cast(int, x), CTRL, 0xf, 0xf, true)); }
__device__ __forceinline__ float xrow16_sum(float x) {
    auto s = __builtin_amdgcn_permlane16_swap(__float_as_uint(x), __float_as_uint(x), false, false);
    x = __uint_as_float(s[0]) + __uint_as_float(s[1]);
    auto t = __builtin_amdgcn_permlane32_swap(__float_as_uint(x), __float_as_uint(x), false, false);
    return __uint_as_float(t[0]) + __uint_as_float(t[1]);
}
__device__ __forceinline__ float xrow16_max(float x) {
    auto s = __builtin_amdgcn_permlane16_swap(__float_as_uint(x), __float_as_uint(x), false, false);
    x = fmaxf(__uint_as_float(s[0]), __uint_as_float(s[1]));
    auto t = __builtin_amdgcn_permlane32_swap(__float_as_uint(x), __float_as_uint(x), false, false);
    return fmaxf(__uint_as_float(t[0]), __uint_as_float(t[1]));
}
__device__ __forceinline__ float wave_sum_dpp(float x) {
    x += dpp<0xB1>(x); x += dpp<0x4E>(x); x += dpp<0x141>(x); x += dpp<0x128>(x); return xrow16_sum(x);
}
__device__ __forceinline__ float quad_sum(float v) { return xrow16_sum(v); }
__device__ __forceinline__ float quad_max(float v) { return xrow16_max(v); }
__device__ __forceinline__ float wave_sum(float v) { return wave_sum_dpp(v); }
__device__ __forceinline__ float dot2(unsigned a, unsigned b, float c) { return __builtin_amdgcn_fdot2_f32_bf16(__builtin_bit_cast(bf16x2, a), __builtin_bit_cast(bf16x2, b), c, false); }

#define XB_TMO      128
#define XB_XCNT(j)  (256  + 64 * (j))
#define XB_XSUB(j)  (1280 + 64 * (j))
#define XB_XGEN(j)  (2304 + 64 * (j))
#define XB_TOP      3328
#define XB_TOPGEN   3392
#define XCD_BAR_WORDS 3456
#define XB_SPIN_CAP (1u << 20)
__device__ __forceinline__ unsigned xb_ld(unsigned* p)              { return __hip_atomic_load(p, __ATOMIC_RELAXED, __HIP_MEMORY_SCOPE_AGENT); }
__device__ __forceinline__ unsigned xb_add(unsigned* p, unsigned v) { return __hip_atomic_fetch_add(p, v, __ATOMIC_RELAXED, __HIP_MEMORY_SCOPE_AGENT); }
__device__ __forceinline__ unsigned xb_xcc_id() { return (unsigned)__builtin_amdgcn_s_getreg((3 << 11) | 20) & 0xFu; }
#define XB_SPIN(cond, bar) do { unsigned _sp = 0; while (cond) { __builtin_amdgcn_s_sleep(1); \
    if ((++_sp & 255u) == 0u) { if (xb_ld(&(bar)[XB_TMO])) break; if (_sp > XB_SPIN_CAP) { atomicAdd(&(bar)[XB_TMO], 1u); break; } } } } while (0)
struct XcdBarrier { unsigned* bar; unsigned x; volatile unsigned* st; };
__device__ __forceinline__ XcdBarrier xcd_barrier_post(unsigned* bar, volatile unsigned* st) {
    XcdBarrier b; b.bar = bar; b.x = xb_xcc_id(); b.st = st;
    if (threadIdx.x == 0) (void)xb_add(&bar[XB_XCNT(b.x)], 1u);
    return b;
}
__device__ __forceinline__ void xcd_barrier_complete(unsigned* bar, unsigned x, unsigned& nloc, unsigned& nx) {
    const unsigned G = gridDim.x * gridDim.y * gridDim.z;
    unsigned sum, cnt, mine, sp = 0u;
    for (;;) {
        sum = 0u; cnt = 0u; mine = 0u;
#pragma unroll
        for (unsigned j = 0; j < 16; ++j) { const unsigned c = xb_ld(&bar[XB_XCNT(j)]); sum += c; cnt += (c > 0u) ? 1u : 0u; mine = (j == x) ? c : mine; }
        if (sum == G) break;
        __builtin_amdgcn_s_sleep(1);
        if ((++sp & 255u) == 0u) { if (xb_ld(&bar[XB_TMO])) break; if (sp > XB_SPIN_CAP) { atomicAdd(&bar[XB_TMO], 1u); break; } }
    }
    nloc = mine > 0u ? mine : 1u; nx = cnt > 0u ? cnt : 1u;
}
__device__ __forceinline__ void xcd_barrier(const XcdBarrier& b) {
    asm volatile("s_waitcnt vmcnt(0)" ::: "memory");
    __syncthreads();
    if (threadIdx.x == 0) {
        unsigned* bar = b.bar;
        __builtin_amdgcn_s_waitcnt(0);
        unsigned nloc = b.st[0], nx = b.st[1];
        if (nloc == 0u) { xcd_barrier_complete(bar, b.x, nloc, nx); b.st[0] = nloc; b.st[1] = nx; }
        const unsigned old = xb_add(&bar[XB_XSUB(b.x)], 1u);
        const unsigned gen = old / nloc;
        if (old + 1u == (gen + 1u) * nloc) {
            __builtin_amdgcn_fence(__ATOMIC_RELEASE, "agent");
            asm volatile("s_waitcnt vmcnt(0)" ::: "memory");
            const unsigned og = xb_add(&bar[XB_TOP], 1u);
            const unsigned tg = og / nx;
            if (og + 1u == (tg + 1u) * nx) xb_add(&bar[XB_TOPGEN], 1u);
            else XB_SPIN(xb_ld(&bar[XB_TOPGEN]) == tg, bar);
            __builtin_amdgcn_fence(__ATOMIC_ACQUIRE, "agent");
            xb_add(&bar[XB_XGEN(b.x)], 1u);
            asm volatile("s_waitcnt vmcnt(0)" ::: "memory");
        } else {
            XB_SPIN(xb_ld(&bar[XB_XGEN(b.x)]) == gen, bar);
            __builtin_amdgcn_fence(__ATOMIC_ACQUIRE, "agent");
            asm volatile("s_waitcnt vmcnt(0)" ::: "memory");
        }
    }
    __syncthreads();
}

struct Ctx {
    const float* in[22]; float* out; unsigned char* ws;
    unsigned char* lds; int tid, lane, wave, G, vb;
};
#define WSP(T_, off) ((T_*)(c.ws + (off)))
__device__ __forceinline__ Ctx reopaque(const Ctx& c0) {
    Ctx c = c0; int t = c0.tid; asm volatile("" : "+v"(t)); c.tid = t; c.lane = t & 63; c.wave = __builtin_amdgcn_readfirstlane(t >> 6);
    int vb = c0.vb; asm volatile("" : "+s"(vb)); c.vb = vb; return c;
}

__device__ __forceinline__ int lds_off(int row, int chunk) { return row * 128 + ((chunk ^ (row & 7)) << 4); }

__device__ __forceinline__ void gemm_compute_stage(f32x4 (&acc)[2][8], const unsigned char* sA, const unsigned char* sB, int wave, int lane) {
    const int r = lane & 15, q = lane >> 4;
    bf16x8 af[2][2], bfr[2][8];
#pragma unroll
    for (int ks = 0; ks < 2; ++ks) {
#pragma unroll
        for (int mi = 0; mi < 2; ++mi) af[ks][mi] = *(const bf16x8*)(sA + lds_off(32 * wave + 16 * mi + r, 4 * ks + q));
#pragma unroll
        for (int ni = 0; ni < 8; ++ni) bfr[ks][ni] = *(const bf16x8*)(sB + lds_off(16 * ni + r, 4 * ks + q));
    }
#pragma unroll
    for (int ks = 0; ks < 2; ++ks)
#pragma unroll
        for (int ni = 0; ni < 8; ++ni)
#pragma unroll
            for (int mi = 0; mi < 2; ++mi) acc[mi][ni] = __builtin_amdgcn_mfma_f32_16x16x32_bf16(bfr[ks][ni], af[ks][mi], acc[mi][ni], 0, 0, 0);
    __builtin_amdgcn_sched_group_barrier(0x100, 6, 0);
#pragma unroll
    for (int i = 0; i < 14; ++i) { __builtin_amdgcn_sched_group_barrier(0x8, 2, 0); __builtin_amdgcn_sched_group_barrier(0x100, 1, 0); }
    __builtin_amdgcn_sched_group_barrier(0x8, 4, 0);
}

#define LAS __attribute__((address_space(3)))
__device__ __forceinline__ void gemm_stage_glds(const bf16* A, int lda, const bf16* Bt, int ldb, int kt, unsigned char* stage, int wave, int lane) {
    const int rr = lane >> 3, cch = (lane & 7) ^ rr;
#pragma unroll
    for (int i = 0; i < 4; ++i) { const int pc = 4 * i + wave;
        __builtin_amdgcn_global_load_lds((const unsigned*)(A + (size_t)(8 * pc + rr) * lda + kt * 64 + cch * 8), (LAS unsigned*)(stage + pc * 1024), 16, 0, 0);
        __builtin_amdgcn_global_load_lds((const unsigned*)(Bt + (size_t)(8 * pc + rr) * ldb + kt * 64 + cch * 8), (LAS unsigned*)(stage + 16384 + pc * 1024), 16, 0, 0); }
}
__device__ __forceinline__ void gemm_core(f32x4 (&acc)[2][8], const bf16* A, int lda, const bf16* Bt, int ldb, int K, unsigned char* lds, int tid) {
    const int wave = __builtin_amdgcn_readfirstlane(tid >> 6), lane = tid & 63;
    const int nk = K >> 6;
    gemm_stage_glds(A, lda, Bt, ldb, 0, lds, wave, lane);
    asm volatile("s_waitcnt vmcnt(0)" ::: "memory");
    __syncthreads();
    for (int kt = 0; kt < nk; ++kt) {
        const int cur = kt & 1;
        if (kt + 1 < nk) gemm_stage_glds(A, lda, Bt, ldb, kt + 1, lds + (cur ^ 1) * 32768, wave, lane);
        gemm_compute_stage(acc, lds + cur * 32768, lds + cur * 32768 + 16384, wave, lane);
        asm volatile("s_waitcnt vmcnt(0)" ::: "memory");
        __syncthreads();
    }
}
__device__ __forceinline__ void acc_zero(f32x4 (&acc)[2][8]) {
#pragma unroll
    for (int mi = 0; mi < 2; ++mi)
#pragma unroll
        for (int ni = 0; ni < 8; ++ni) acc[mi][ni] = (f32x4){0.f, 0.f, 0.f, 0.f};
}
__device__ __forceinline__ float rstd_from_ssq8(const float* ssq, int tok) {
    const f32x4 a = *(const f32x4*)(ssq + (size_t)tok * 8), b = *(const f32x4*)(ssq + (size_t)tok * 8 + 4);
    const float s = ((a.x + a.y) + (a.z + a.w)) + ((b.x + b.y) + (b.z + b.w));
    return rsqrt_(s * (1.0f / 1024.0f) + EPS);
}

__device__ __forceinline__ int src_col(int mode, int np) {
    if (mode == 0) return np;
    if (mode == 2) { const int h = np >> 7, j = np & 127; return j < 96 ? h * 96 + j : -1; }
    if (np < 1024) { const int cblk = np >> 7, j = np & 127; return j < 64 ? 64 * cblk + j : 512 + 64 * cblk + (j - 64); }
    if (np < 1408) return np;
    if (np < 1536) { const int j = np - 1408; return j < 32 ? 1408 + j : -1; }
    return 1440 + (np - 1536);
}
__device__ __forceinline__ void p0_transpose_item(const float* W, int K, int N, bf16* Wt, int mode, const float* g, int item, float* scr, int lane) {
    const int nblk_k = K / 64, nb = item / nblk_k, kb = item % nblk_k, k0 = 64 * kb, n0 = 32 * nb;
    const int n = src_col(mode, n0 + (lane & 31));
    float wv[32], gv[32];
#pragma unroll
    for (int i = 0; i < 32; ++i) { const int kk = 2 * i + (lane >> 5); wv[i] = n >= 0 ? W[(size_t)(k0 + kk) * N + n] : 0.f; gv[i] = g ? g[k0 + kk] : 1.f; }
#pragma unroll
    for (int i = 0; i < 32; ++i) { const int kk = 2 * i + (lane >> 5); scr[kk * 33 + (lane & 31)] = wv[i] * gv[i]; }
    __builtin_amdgcn_s_waitcnt(0xC07F); asm volatile("" ::: "memory");
    const int cch = lane & 7;
#pragma unroll
    for (int j = 0; j < 4; ++j) { const int nl = (lane >> 3) + 8 * j; const float* s = scr + (8 * cch) * 33 + nl;
        u32x4 o; o.x = pk2(s[0 * 33], s[1 * 33]); o.y = pk2(s[2 * 33], s[3 * 33]); o.z = pk2(s[4 * 33], s[5 * 33]); o.w = pk2(s[6 * 33], s[7 * 33]);
        *(u32x4*)(Wt + (size_t)(n0 + nl) * K + k0 + 8 * cch) = o; }
    __builtin_amdgcn_s_waitcnt(0xC07F); asm volatile("" ::: "memory");
}
struct WDesc { int in_idx, K, N, Np, mode, g_idx; size_t off; };
__device__ __forceinline__ void phase_prologue(const Ctx& c0) {
    Ctx c = reopaque(c0);
    const int gw = c.vb * 4 + c.wave, NGW = c.G * 4;
    float* scr = (float*)(c.lds + c.wave * 8704);
    const WDesc wd[7] = {
        {3, 1024, NIN, NINP, 1, 2, 0}, {8, 512, 1024, 1024, 0, -1, OFF_WCO}, {10, 256, 768, 1024, 2, 9, OFF_WUQ}, {12, 128, 1024, 1024, 0, 11, OFF_WUKV},
        {15, 512, 1024, 1024, 0, -1, OFF_WMLA}, {16, 1024, 1024, 1024, 0, -1, OFF_WOUT}, {18, 1024, 2048, 2048, 0, 17, OFF_WPQ}};
    constexpr int ITEMS_PER_LAYER = (1024 / 64) * (NINP / 32) + (512 / 64) * 32 + (256 / 64) * 32 + (128 / 64) * 32 + (512 / 64) * 32 + (1024 / 64) * 32 + (1024 / 64) * 64;
    for (int it = gw; it < 2 * ITEMS_PER_LAYER; it += NGW) {
        const int l = it >= ITEMS_PER_LAYER ? 1 : 0; int r = it - l * ITEMS_PER_LAYER;
        const float* W = nullptr; const float* g = nullptr; bf16* Wt = nullptr; int K = 64, N = 32, mode = 0, rr = 0;
#pragma unroll
        for (int m = 0; m < 7; ++m) {
            const int items = (wd[m].K / 64) * (wd[m].Np / 32);
            if (r >= 0 && r < items) { K = wd[m].K; N = wd[m].N; mode = wd[m].mode; rr = r;
                W = c.in[wd[m].in_idx] + (size_t)l * wd[m].K * wd[m].N; g = wd[m].g_idx >= 0 ? c.in[wd[m].g_idx >= 0 ? wd[m].g_idx : 0] + (size_t)l * wd[m].K : nullptr;
                Wt = (bf16*)(c.ws + WS_WIN + l * SZ_WLAYER + wd[m].off); }
            r -= items;
        }
        p0_transpose_item(W, K, N, Wt, mode, g, rr, scr, c.lane);
    }
    const int gt = c.vb * NTHREADS + c.tid, NGT = c.G * NTHREADS;
    for (int l = 0; l < 2; ++l) {
        const float* src = c.in[19] + (size_t)l * 262144; bf16* dst = (bf16*)(c.ws + WS_WIN + l * SZ_WLAYER + OFF_KEYS);
        for (int i = gt; i < 262144 / 8; i += NGT) { const f32x4 a = *(const f32x4*)(src + i * 8), b = *(const f32x4*)(src + i * 8 + 4);
            u32x4 o; o.x = pk2(a.x, a.y); o.y = pk2(a.z, a.w); o.z = pk2(b.x, b.y); o.w = pk2(b.z, b.w); *(u32x4*)(dst + i * 8) = o; }
    }
    for (int l = 0; l < 2; ++l)
        for (int uv = 0; uv < 2; ++uv) {
            const float* src = c.in[20 + uv] + (size_t)l * NEXP * 1024; unsigned char* dst = c.ws + WS_TAB + (size_t)(l * 2 + uv) * SZ_TAB;
            f32x4 g4[4];
#pragma unroll
            for (int j = 0; j < 4; ++j) { const float sc = uv == 0 ? U_SCALE : TAB_SCALE; g4[j] = (f32x4){sc, sc, sc, sc}; if (uv == 0) g4[j] = g4[j] * *(const f32x4*)(c.in[17] + l * 1024 + 256 * j + 4 * c.lane); }
            for (int row = gw; row < NEXP; row += 2 * NGW) {
                const float* sp = src + (size_t)row * 1024 + 4 * c.lane; const int row2 = row + NGW; const bool two = row2 < NEXP;
                const float* sp2 = src + (size_t)(two ? row2 : row) * 1024 + 4 * c.lane;
                f32x4 a[4], b[4];
#pragma unroll
                for (int j = 0; j < 4; ++j) { a[j] = *(const f32x4*)(sp + 256 * j); b[j] = *(const f32x4*)(sp2 + 256 * j); }
#pragma unroll
                for (int j = 0; j < 4; ++j) { const f32x4 v = a[j] * g4[j];
                    if (uv == 0) *(unsigned short*)(dst + (size_t)row * 512 + 128 * j + 2 * c.lane) = (unsigned short)pack_i4x4(v);
                    else *(unsigned short*)(dst + (size_t)row * 512 + 128 * j + 2 * c.lane) = pack_fp4x4(v); }
                if (two) {
#pragma unroll
                    for (int j = 0; j < 4; ++j) { const f32x4 v = b[j] * g4[j];
                        if (uv == 0) *(unsigned short*)(dst + (size_t)row2 * 512 + 128 * j + 2 * c.lane) = (unsigned short)pack_i4x4(v);
                        else *(unsigned short*)(dst + (size_t)row2 * 512 + 128 * j + 2 * c.lane) = pack_fp4x4(v); } }
            }
        }
    { float* rope = WSP(float, WS_ROPE);
      for (int i = gt; i < L * 16; i += NGT) { const int pos = i >> 4, j = i & 15;
          const float inv = 1.0f / __builtin_exp2f((float)j * 0.8304820237218406f);
          const float angf = (float)pos * inv; const double ang = (double)angf;
          const double nq = __builtin_rint(ang * 0.63661977236758134308);
          double rr = __builtin_fma(-nq, 1.57079632679489655800e+00, ang); rr = __builtin_fma(-nq, 6.12323399573676603587e-17, rr);
          const double r2 = rr * rr;
          double sp = -1.0 / 1307674368000.0; sp = sp * r2 + 1.0 / 6227020800.0; sp = sp * r2 - 1.0 / 39916800.0; sp = sp * r2 + 1.0 / 362880.0; sp = sp * r2 - 1.0 / 5040.0; sp = sp * r2 + 1.0 / 120.0; sp = sp * r2 - 1.0 / 6.0; sp = sp * r2 * rr + rr;
          double cp = 1.0 / 87178291200.0; cp = cp * r2 - 1.0 / 479001600.0; cp = cp * r2 + 1.0 / 3628800.0; cp = cp * r2 - 1.0 / 40320.0; cp = cp * r2 + 1.0 / 720.0; cp = cp * r2 - 1.0 / 24.0; cp = cp * r2 + 0.5; cp = 1.0 - cp * r2;
          const int qd = ((int)nq) & 3;
          const double cv = qd == 0 ? cp : qd == 1 ? -sp : qd == 2 ? -cp : sp;
          const double sv_ = qd == 0 ? sp : qd == 1 ? cp : qd == 2 ? -sp : -cp;
          rope[2 * i] = (float)cv; rope[2 * i + 1] = (float)sv_; } }
    { bf16* hb = WSP(bf16, WS_HB); float* ssq = WSP(float, WS_SSQ);
      for (int t0_ = gw; t0_ < T; t0_ += 4 * NGW) {
          f32x4 v[4][4];
#pragma unroll
          for (int i = 0; i < 4; ++i) { const int t = t0_ + i * NGW < T ? t0_ + i * NGW : t0_; const int b = t / L, pos = t % L;
              const float* src = pos < NMETA ? c.in[1] + (size_t)pos * D : c.in[0] + ((size_t)b * SEQ + (pos - NMETA)) * D;
#pragma unroll
              for (int j = 0; j < 4; ++j) v[i][j] = *(const f32x4*)(src + j * 256 + c.lane * 4); }
#pragma unroll
          for (int i = 0; i < 4; ++i) { const int t = t0_ + i * NGW;
              if (t < T) { float s = 0.f;
#pragma unroll
                  for (int j = 0; j < 4; ++j) { const f32x4 x = v[i][j]; u32x2 o; o.x = pk2(x.x, x.y); o.y = pk2(x.z, x.w); *(u32x2*)(hb + (size_t)t * D + j * 256 + c.lane * 4) = o;
                      s += (x.x * x.x + x.y * x.y) + (x.z * x.z + x.w * x.w); }
                  s = wave_sum(s);
                  if (c.lane < 8) ssq[(size_t)t * 8 + c.lane] = c.lane == 0 ? s : 0.f; } }
      } }
}

__device__ __forceinline__ void phase_A(const Ctx& c0, int l) {
    Ctx c = reopaque(c0);
    const bf16* hb = WSP(bf16, WS_HB); const bf16* Wt = (const bf16*)(c.ws + WS_WIN + l * SZ_WLAYER);
    const float* ssq = WSP(float, WS_SSQ);
    bf16* uglu = WSP(bf16, WS_UGLU); bf16* cq = WSP(bf16, WS_CQ); bf16* ckv = WSP(bf16, WS_CKV); float* krope = WSP(float, WS_KROPE);
    float* ssqq = WSP(float, WS_SSQQ); float* ssqkv = WSP(float, WS_SSQKV); bf16* gates = WSP(bf16, WS_GATES);
    constexpr int NT = NINP / 128;
    const int r = c.lane & 15, q = c.lane >> 4;
    const int xcd = c.vb / (c.G / 8), lb = c.vb % (c.G / 8), xm = xcd & 1, xn = xcd >> 1;
    const int m_lo = xm ? (MT + 1) / 2 : 0, m_cnt = xm ? MT / 2 : (MT + 1) / 2;
    for (int j = lb; j < m_cnt * 7; j += c.G / 8) {
        const int mt = m_lo + j / 7, nt = xn * 7 + j % 7;
        f32x4 acc[2][8]; acc_zero(acc);
        gemm_core(acc, hb + (size_t)mt * 128 * D, D, Wt + (size_t)nt * 128 * D, D, D, c.lds, c.tid);
#pragma unroll
        for (int mi = 0; mi < 2; ++mi) {
            const int tok = mt * 128 + 32 * c.wave + 16 * mi + r;
            const float rs = rstd_from_ssq8(ssq, tok);
            if (nt < 8) {
#pragma unroll
                for (int ni = 0; ni < 4; ++ni) { const f32x4 v = acc[mi][ni] * rs, g = acc[mi][ni + 4] * rs;
                    u32x2 o; o.x = pk2(v.x * sigmoidf_(g.x), v.y * sigmoidf_(g.y)); o.y = pk2(v.z * sigmoidf_(g.z), v.w * sigmoidf_(g.w));
                    *(u32x2*)(uglu + (size_t)tok * DC + nt * 64 + 16 * ni + 4 * q) = o; }
            } else if (nt < 11) {
                bf16* dst = nt < 10 ? cq + (size_t)tok * QL + (nt - 8) * 128 : ckv + (size_t)tok * KVL;
                float ss = 0.f;
#pragma unroll
                for (int ni = 0; ni < 8; ++ni) { const f32x4 v = acc[mi][ni] * rs; ss += (v.x * v.x + v.y * v.y) + (v.z * v.z + v.w * v.w);
                    u32x2 o; o.x = pk2(v.x, v.y); o.y = pk2(v.z, v.w); *(u32x2*)(dst + 16 * ni + 4 * q) = o; }
                ss = quad_sum(ss);
                if (q == 0) { if (nt < 10) ssqq[(size_t)tok * 2 + (nt - 8)] = ss; else ssqkv[tok] = ss; }
            } else if (nt == 11) {
#pragma unroll
                for (int ni = 0; ni < 2; ++ni) *(f32x4*)(krope + (size_t)tok * 32 + 16 * ni + 4 * q) = acc[mi][ni] * rs;
            } else {
#pragma unroll
                for (int ni = 0; ni < 8; ++ni) { const f32x4 v = acc[mi][ni] * rs;
                    u32x2 o; o.x = pk2(sigmoidf_(v.x), sigmoidf_(v.y)); o.y = pk2(sigmoidf_(v.z), sigmoidf_(v.w));
                    *(u32x2*)(gates + (size_t)tok * 2048 + (nt - 12) * 128 + 16 * ni + 4 * q) = o; }
            }
        }
    }
}

__device__ __forceinline__ void phaseB_q_item(Ctx& c, int l, int mt, int head) {
    const bf16* cq = WSP(bf16, WS_CQ); const bf16* Wt = (const bf16*)(c.ws + WS_WIN + l * SZ_WLAYER + OFF_WUQ);
    const float* ssqq = WSP(float, WS_SSQQ); const float* rope = WSP(float, WS_ROPE); const float* qg = c.in[13] + l * QK; bf16* Qb = WSP(bf16, WS_Q);
    const int r = c.lane & 15, q = c.lane >> 4;
    f32x4 acc[2][8]; acc_zero(acc);
    gemm_core(acc, cq + (size_t)mt * 128 * QL, QL, Wt + (size_t)head * 128 * QL, QL, QL, c.lds, c.tid);
    constexpr float QSCALE = 0.10206207261596575f * 1.4426950408889634f;
#pragma unroll
    for (int mi = 0; mi < 2; ++mi) {
        const int tok = mt * 128 + 32 * c.wave + 16 * mi + r, b = tok / L, pos = tok - b * L;
        const float rs = rsqrt_((ssqq[(size_t)tok * 2] + ssqq[(size_t)tok * 2 + 1]) * (1.0f / 256.0f) + EPS);
        float ss = 0.f;
#pragma unroll
        for (int ni = 0; ni < 6; ++ni) { acc[mi][ni] = acc[mi][ni] * rs; const f32x4 v = acc[mi][ni]; ss += (v.x * v.x + v.y * v.y) + (v.z * v.z + v.w * v.w); }
        ss = quad_sum(ss);
        const float rn = rsqrt_(ss * (1.0f / 96.0f) + EPS) * QSCALE;
#pragma unroll
        for (int ni = 0; ni < 6; ++ni) { const f32x4 g = *(const f32x4*)(qg + 16 * ni + 4 * q); acc[mi][ni] = acc[mi][ni] * g * rn; }
        const f32x4 cs0 = *(const f32x4*)(rope + ((size_t)pos * 16 + 4 * q) * 2), cs1 = *(const f32x4*)(rope + ((size_t)pos * 16 + 4 * q) * 2 + 4);
        const float co[4] = {cs0.x, cs0.z, cs1.x, cs1.z}, si[4] = {cs0.y, cs0.w, cs1.y, cs1.w};
        f32x4 x1 = acc[mi][4], x2 = acc[mi][5];
#pragma unroll
        for (int e = 0; e < 4; ++e) { const float a = x1[e], bb = x2[e]; x1[e] = a * co[e] - bb * si[e]; x2[e] = bb * co[e] + a * si[e]; }
        acc[mi][4] = x1; acc[mi][5] = x2;
        bf16* dst = Qb + (((size_t)b * NH + head) * L + pos) * QK;
#pragma unroll
        for (int ni = 0; ni < 6; ++ni) { const f32x4 v = acc[mi][ni]; u32x2 o; o.x = pk2(v.x, v.y); o.y = pk2(v.z, v.w); *(u32x2*)(dst + 16 * ni + 4 * q) = o; }
    }
}
__device__ __forceinline__ void phaseB_kv_item(Ctx& c, int l, int mt, int head) {
    const bf16* ckv = WSP(bf16, WS_CKV); const bf16* Wt = (const bf16*)(c.ws + WS_WIN + l * SZ_WLAYER + OFF_WUKV);
    const float* ssqkv = WSP(float, WS_SSQKV); const float* rope = WSP(float, WS_ROPE); const float* kg = c.in[14] + l * QK; const float* krope = WSP(float, WS_KROPE);
    bf16* Kb = WSP(bf16, WS_K); bf16* Vt = WSP(bf16, WS_VT);
    const int tid = c.tid, wave = c.wave, lane = c.lane, r = lane & 15, q = lane >> 4;
    unsigned char* lds = c.lds;
    f32x4 ak[2][4], av[2][4];
#pragma unroll
    for (int mi = 0; mi < 2; ++mi)
#pragma unroll
        for (int ni = 0; ni < 4; ++ni) { ak[mi][ni] = (f32x4){0.f, 0.f, 0.f, 0.f}; av[mi][ni] = (f32x4){0.f, 0.f, 0.f, 0.f}; }
    { const int chunk = tid & 7, row0 = tid >> 3;
      const bf16* pa = ckv + ((size_t)mt * 128 + row0) * KVL + chunk * 8; const bf16* pb = Wt + ((size_t)head * 128 + row0) * KVL + chunk * 8;
#pragma unroll
      for (int s = 0; s < 2; ++s)
#pragma unroll
          for (int i = 0; i < 4; ++i) { *(u32x4*)(lds + s * 32768 + lds_off(row0 + 32 * i, chunk)) = *(const u32x4*)(pa + (size_t)(32 * i) * KVL + s * 64);
              *(u32x4*)(lds + s * 32768 + 16384 + lds_off(row0 + 32 * i, chunk)) = *(const u32x4*)(pb + (size_t)(32 * i) * KVL + s * 64); }
    }
    __syncthreads();
#pragma unroll
    for (int s = 0; s < 2; ++s)
#pragma unroll
        for (int ks = 0; ks < 2; ++ks) {
            const unsigned char* sA = lds + s * 32768; const unsigned char* sB = sA + 16384;
            bf16x8 af[2], bfr[8];
#pragma unroll
            for (int mi = 0; mi < 2; ++mi) af[mi] = *(const bf16x8*)(sA + lds_off(32 * wave + 16 * mi + r, 4 * ks + q));
#pragma unroll
            for (int ni = 0; ni < 8; ++ni) bfr[ni] = *(const bf16x8*)(sB + lds_off(16 * ni + r, 4 * ks + q));
#pragma unroll
            for (int mi = 0; mi < 2; ++mi)
#pragma unroll
                for (int ni = 0; ni < 4; ++ni) { ak[mi][ni] = __builtin_amdgcn_mfma_f32_16x16x32_bf16(bfr[ni], af[mi], ak[mi][ni], 0, 0, 0);
                    av[mi][ni] = __builtin_amdgcn_mfma_f32_16x16x32_bf16(af[mi], bfr[ni + 4], av[mi][ni], 0, 0, 0); }
        }
    __syncthreads();
#pragma unroll
    for (int mi = 0; mi < 2; ++mi) {
        const int tok0 = mt * 128 + 32 * wave + 16 * mi, b = tok0 / L, pos0 = tok0 - b * L;
        { const int tok = tok0 + r, pos = pos0 + r;
          const float rs = rsqrt_(ssqkv[tok] * (1.0f / 128.0f) + EPS);
          const f32x4 kr1 = *(const f32x4*)(krope + (size_t)tok * 32 + 4 * q), kr2 = *(const f32x4*)(krope + (size_t)tok * 32 + 16 + 4 * q);
          float ss = (kr1.x * kr1.x + kr1.y * kr1.y) + (kr1.z * kr1.z + kr1.w * kr1.w) + (kr2.x * kr2.x + kr2.y * kr2.y) + (kr2.z * kr2.z + kr2.w * kr2.w);
#pragma unroll
          for (int ni = 0; ni < 4; ++ni) { ak[mi][ni] = ak[mi][ni] * rs; const f32x4 v = ak[mi][ni]; ss += (v.x * v.x + v.y * v.y) + (v.z * v.z + v.w * v.w); }
          ss = quad_sum(ss);
          const float rn = rsqrt_(ss * (1.0f / 96.0f) + EPS);
          bf16* dst = Kb + (((size_t)b * NH + head) * L + pos) * QK;
#pragma unroll
          for (int ni = 0; ni < 4; ++ni) { const f32x4 g = *(const f32x4*)(kg + 16 * ni + 4 * q); const f32x4 v = ak[mi][ni] * g * rn;
              u32x2 o; o.x = pk2(v.x, v.y); o.y = pk2(v.z, v.w); *(u32x2*)(dst + 16 * ni + 4 * q) = o; }
          const f32x4 g1 = *(const f32x4*)(kg + 64 + 4 * q), g2 = *(const f32x4*)(kg + 80 + 4 * q);
          f32x4 x1 = kr1 * g1 * rn, x2 = kr2 * g2 * rn;
          const f32x4 cs0 = *(const f32x4*)(rope + ((size_t)pos * 16 + 4 * q) * 2), cs1 = *(const f32x4*)(rope + ((size_t)pos * 16 + 4 * q) * 2 + 4);
          const float co[4] = {cs0.x, cs0.z, cs1.x, cs1.z}, si[4] = {cs0.y, cs0.w, cs1.y, cs1.w};
#pragma unroll
          for (int e = 0; e < 4; ++e) { const float a = x1[e], bb = x2[e]; x1[e] = a * co[e] - bb * si[e]; x2[e] = bb * co[e] + a * si[e]; }
          u32x2 o1, o2; o1.x = pk2(x1.x, x1.y); o1.y = pk2(x1.z, x1.w); o2.x = pk2(x2.x, x2.y); o2.y = pk2(x2.z, x2.w);
          *(u32x2*)(dst + 64 + 4 * q) = o1; *(u32x2*)(dst + 80 + 4 * q) = o2; }
        { const f32x4 sq = *(const f32x4*)(ssqkv + tok0 + 4 * q);
          f32x4 rs4; rs4.x = rsqrt_(sq.x * (1.0f / 128.0f) + EPS); rs4.y = rsqrt_(sq.y * (1.0f / 128.0f) + EPS); rs4.z = rsqrt_(sq.z * (1.0f / 128.0f) + EPS); rs4.w = rsqrt_(sq.w * (1.0f / 128.0f) + EPS);
#pragma unroll
          for (int ni = 0; ni < 4; ++ni) { const f32x4 v = av[mi][ni] * rs4; u32x2 o; o.x = pk2(v.x, v.y); o.y = pk2(v.z, v.w);
              *(u32x2*)(Vt + (((size_t)b * NH + head) * VD + 16 * ni + r) * L + pos0 + 4 * q) = o; } }
    }
}
__device__ __forceinline__ u32x4 conv_row(const bf16* uglu, int b, int pos, int ch) {
    u32x4 xv = (u32x4){0u, 0u, 0u, 0u};
    if (pos >= 0) xv = *(const u32x4*)(uglu + ((size_t)b * L + pos) * DC + ch);
    return xv;
}
__device__ __forceinline__ void conv_fma(float (&a)[8], const u32x4 xv, const f32x4 w0, const f32x4 w1) {
    a[0] += bf_lo(xv.x) * w0.x; a[1] += bf_hi(xv.x) * w0.y; a[2] += bf_lo(xv.y) * w0.z; a[3] += bf_hi(xv.y) * w0.w;
    a[4] += bf_lo(xv.z) * w1.x; a[5] += bf_hi(xv.z) * w1.y; a[6] += bf_lo(xv.w) * w1.z; a[7] += bf_hi(xv.w) * w1.w;
}
__device__ __forceinline__ void phaseB_conv_item(Ctx& c, int l, int grp) {
    const bf16* uglu = WSP(bf16, WS_UGLU); bf16* u2 = WSP(bf16, WS_U2);
    const float* cw = c.in[4] + (size_t)l * CW * DC; const float* cb = c.in[5] + l * DC; const float* lg = c.in[6] + l * DC; const float* lb = c.in[7] + l * DC;
    const int tok0 = grp * 4, b = tok0 / L, pos0 = tok0 - b * L, ch = c.lane * 8;
    float acc[4][8];
    { const f32x4 b0 = *(const f32x4*)(cb + ch), b1 = *(const f32x4*)(cb + ch + 4);
#pragma unroll
      for (int d = 0; d < 4; ++d) { acc[d][0] = b0.x; acc[d][1] = b0.y; acc[d][2] = b0.z; acc[d][3] = b0.w; acc[d][4] = b1.x; acc[d][5] = b1.y; acc[d][6] = b1.z; acc[d][7] = b1.w; } }
    const int base = pos0 - 30;
    u32x4 R[8];
#pragma unroll
    for (int k = 0; k < 5; ++k) R[k] = conv_row(uglu, b, base + k, ch);
    const float* wp = cw + ch;
    f32x4 WT[4][2];
#pragma unroll
    for (int k = 0; k < 4; ++k) { WT[k][0] = *(const f32x4*)(wp + (size_t)k * DC); WT[k][1] = *(const f32x4*)(wp + (size_t)k * DC + 4); }
#pragma unroll 1
    for (int w8 = 0; w8 < 32; w8 += 8) {
#pragma unroll
        for (int k = 0; k < 8; ++k) { const int w = w8 + k;
            R[(k + 5) & 7] = conv_row(uglu, b, (w + 5 <= 33) ? base + w + 5 : -1, ch);
            const f32x4 w0 = WT[k & 3][0], w1 = WT[k & 3][1];
            conv_fma(acc[0], R[k & 7], w0, w1); conv_fma(acc[1], R[(k + 1) & 7], w0, w1); conv_fma(acc[2], R[(k + 2) & 7], w0, w1); conv_fma(acc[3], R[(k + 3) & 7], w0, w1);
            const bool more = w + 4 < CW; const float* wn = wp + (size_t)(more ? w + 4 : 0) * DC;
            f32x4 p0 = *(const f32x4*)wn, p1 = *(const f32x4*)(wn + 4);
            if (!more) { p0 = (f32x4){0.f, 0.f, 0.f, 0.f}; p1 = p0; }
            WT[k & 3][0] = p0; WT[k & 3][1] = p1; }
    }
    const f32x4 g0 = *(const f32x4*)(lg + ch), g1 = *(const f32x4*)(lg + ch + 4), e0 = *(const f32x4*)(lb + ch), e1 = *(const f32x4*)(lb + ch + 4);
    const float gg[8] = {g0.x, g0.y, g0.z, g0.w, g1.x, g1.y, g1.z, g1.w}, be[8] = {e0.x, e0.y, e0.z, e0.w, e1.x, e1.y, e1.z, e1.w};
#pragma unroll
    for (int d = 0; d < 4; ++d) {
        float s = 0.f;
#pragma unroll
        for (int j = 0; j < 8; ++j) s += acc[d][j];
        const float mu = wave_sum(s) * (1.0f / 512.0f);
        float vq = 0.f;
#pragma unroll
        for (int j = 0; j < 8; ++j) { acc[d][j] -= mu; vq += acc[d][j] * acc[d][j]; }
        const float rstd = rsqrt_(wave_sum(vq) * (1.0f / 512.0f) + EPS);
        float y[8];
#pragma unroll
        for (int j = 0; j < 8; ++j) { const float v = acc[d][j] * rstd * gg[j] + be[j]; y[j] = v * sigmoidf_(v); }
        u32x4 o; o.x = pk2(y[0], y[1]); o.y = pk2(y[2], y[3]); o.z = pk2(y[4], y[5]); o.w = pk2(y[6], y[7]);
        *(u32x4*)(u2 + (size_t)(tok0 + d) * DC + ch) = o;
    }
}
__device__ __forceinline__ void phase_B(const Ctx& c0, int l) {
    Ctx c = reopaque(c0);
    constexpr int NQ = MT * NH, NKV = MT * NH, NCV = T / 16;
    for (int it = c.vb; it < NQ + NKV + NCV; it += c.G) {
        if (it < NQ) phaseB_q_item(c, l, it / NH, it % NH);
        else if (it < NQ + NKV) phaseB_kv_item(c, l, (it - NQ) / NH, (it - NQ) % NH);
        else phaseB_conv_item(c, l, (it - NQ - NKV) * 4 + c.wave);
    }
}

constexpr int KROW = 208, VROW = 136, ATT_STAGE = 64 * KROW + 64 * VROW;
constexpr int ATT_ITEMS = NB * NH * 17;
__device__ __forceinline__ void phase_C(const Ctx& c0, int l) {
    Ctx c = reopaque(c0);
    const bf16* Qb = WSP(bf16, WS_Q); const bf16* Kb = WSP(bf16, WS_K); const bf16* Vt = WSP(bf16, WS_VT); bf16* O = WSP(bf16, WS_O);
    unsigned* qctr = WSP(unsigned, WS_CTL) + CW_QUEUE + 64 * l;
    volatile unsigned* misc = (volatile unsigned*)(c.lds + LDS_MISC);
    const int tid = c.tid, wave = c.wave, lane = c.lane, r = lane & 15, q = lane >> 4;
    unsigned char* lds = c.lds;
    for (;;) {
        if (tid == 0) misc[4] = atomicAdd(qctr, 1u);
        __syncthreads();
        const int item = __builtin_amdgcn_readfirstlane((int)misc[4]);
        __syncthreads();
        if (item >= ATT_ITEMS) break;
        const int pp = 15 - item / 64, bh = item % 64, b = bh / NH, h = bh % NH;
        const bool meta = pp < 0;
        const int r0 = meta ? 0 : 16 + 128 * pp;
        const int nfull = meta ? 0 : 2 * pp + 1 + (wave >> 1);
        const int ntiles = meta ? 1 : 2 * pp + 3;
        const bf16* Kbase = Kb + (size_t)bh * L * QK; const bf16* Vbase = Vt + (size_t)bh * VD * L;
        bf16x8 qf[2][3];
#pragma unroll
        for (int mi = 0; mi < 2; ++mi)
#pragma unroll
            for (int ks = 0; ks < 3; ++ks) qf[mi][ks] = *(const bf16x8*)(Qb + ((size_t)bh * L + r0 + 32 * wave + 16 * mi + r) * QK + 32 * ks + 8 * q);
        float m[2] = {-1e30f, -1e30f}, lsum[2] = {0.f, 0.f};
        f32x4 o[2][4];
#pragma unroll
        for (int mi = 0; mi < 2; ++mi)
#pragma unroll
            for (int dt = 0; dt < 4; ++dt) o[mi][dt] = (f32x4){0.f, 0.f, 0.f, 0.f};
        u32x4 rk[3], rv[2];
        auto gload = [&](int kt) {
#pragma unroll
            for (int i = 0; i < 3; ++i) { const int id = tid + 256 * i, row = id / 12, cc = id % 12; rk[i] = *(const u32x4*)(Kbase + (size_t)(kt * 64 + row) * QK + cc * 8); }
#pragma unroll
            for (int i = 0; i < 2; ++i) { const int id = tid + 256 * i, row = id >> 3, cc = id & 7; rv[i] = *(const u32x4*)(Vbase + (size_t)row * L + kt * 64 + cc * 8); }
        };
        auto lstore = [&](int s) {
            unsigned char* st = lds + s * ATT_STAGE;
#pragma unroll
            for (int i = 0; i < 3; ++i) { const int id = tid + 256 * i, row = id / 12, cc = id % 12; *(u32x4*)(st + row * KROW + cc * 16) = rk[i]; }
#pragma unroll
            for (int i = 0; i < 2; ++i) { const int id = tid + 256 * i, row = id >> 3, cc = id & 7; u32x2* d = (u32x2*)(st + 64 * KROW + row * VROW + cc * 16); d[0] = (u32x2){rv[i].x, rv[i].y}; d[1] = (u32x2){rv[i].z, rv[i].w}; }
        };
        gload(0); lstore(0);
#pragma unroll
        for (int mi = 0; mi < 2; ++mi)
#pragma unroll
            for (int ks = 0; ks < 3; ++ks) asm volatile("" : "+v"(qf[mi][ks]));
        __syncthreads();
        for (int kt = 0; kt < ntiles; ++kt) {
            const int cur = kt & 1;
            if (kt + 1 < ntiles) gload(kt + 1);
            const unsigned char* sK = lds + cur * ATT_STAGE; const unsigned char* sV = sK + 64 * KROW;
            const bool full = kt < nfull;
            if (kt <= nfull) {
                f32x4 s[2][4];
#pragma unroll
                for (int kh = 0; kh < 2; ++kh) {
                    bf16x8 kf[2][3];
#pragma unroll
                    for (int kk = 0; kk < 2; ++kk) if ((kh == 0 && kk == 0) || full) {
#pragma unroll
                        for (int ks = 0; ks < 3; ++ks) kf[kk][ks] = *(const bf16x8*)(sK + (16 * (2 * kh + kk) + r) * KROW + 64 * ks + 16 * q); }
#pragma unroll
                    for (int kk = 0; kk < 2; ++kk) { const int k4 = 2 * kh + kk;
#pragma unroll
                        for (int mi = 0; mi < 2; ++mi) s[mi][k4] = (f32x4){0.f, 0.f, 0.f, 0.f};
                        if (k4 == 0 || full) {
#pragma unroll
                            for (int ks = 0; ks < 3; ++ks)
#pragma unroll
                                for (int mi = 0; mi < 2; ++mi) s[mi][k4] = __builtin_amdgcn_mfma_f32_16x16x32_bf16(kf[kk][ks], qf[mi][ks], s[mi][k4], 0, 0, 0);
                        }
                    }
                }
                u32x2 vlo[4], vhi[4];
#pragma unroll
                for (int dt = 0; dt < 4; ++dt) { const unsigned char* vp = sV + (16 * dt + r) * VROW + (4 * q) * 2;
                    vlo[dt] = *(const u32x2*)vp; vhi[dt] = (u32x2){0u, 0u}; if (full) vhi[dt] = *(const u32x2*)(vp + 32); }
                bf16x8 pf[2][2];
#pragma unroll
                for (int mi = 0; mi < 2; ++mi) {
                    float mx = fmaxf(fmaxf(s[mi][0].x, s[mi][0].y), fmaxf(s[mi][0].z, s[mi][0].w));
                    if (full) {
#pragma unroll
                        for (int k4 = 1; k4 < 4; ++k4) mx = fmaxf(mx, fmaxf(fmaxf(s[mi][k4].x, s[mi][k4].y), fmaxf(s[mi][k4].z, s[mi][k4].w)));
                    }
                    mx = quad_max(mx);
                    const float mn = fmaxf(m[mi], mx), alpha = fast_exp2(m[mi] - mn); m[mi] = mn;
                    float ps = 0.f;
#pragma unroll
                    for (int k4 = 0; k4 < 4; ++k4) {
                        if (k4 == 0 || full) { f32x4 p; p.x = fast_exp2(s[mi][k4].x - mn); p.y = fast_exp2(s[mi][k4].y - mn); p.z = fast_exp2(s[mi][k4].z - mn); p.w = fast_exp2(s[mi][k4].w - mn);
                            ps += (p.x + p.y) + (p.z + p.w); s[mi][k4] = p; }
                    }
                    lsum[mi] = lsum[mi] * alpha + ps;
#pragma unroll
                    for (int dt = 0; dt < 4; ++dt) o[mi][dt] = o[mi][dt] * alpha;
#pragma unroll
                    for (int st = 0; st < 2; ++st) { u32x4 pw;
                        pw.x = pk2(s[mi][2 * st].x, s[mi][2 * st].y); pw.y = pk2(s[mi][2 * st].z, s[mi][2 * st].w); pw.z = pk2(s[mi][2 * st + 1].x, s[mi][2 * st + 1].y); pw.w = pk2(s[mi][2 * st + 1].z, s[mi][2 * st + 1].w);
                        if (!full) { pw.z = 0u; pw.w = 0u; }
                        pf[mi][st] = __builtin_bit_cast(bf16x8, pw); }
                }
                u32x2 wlo[4], whi[4];
                if (full) {
#pragma unroll
                    for (int dt = 0; dt < 4; ++dt) { const unsigned char* vp = sV + (16 * dt + r) * VROW + (32 + 4 * q) * 2; wlo[dt] = *(const u32x2*)vp; whi[dt] = *(const u32x2*)(vp + 32); } }
#pragma unroll
                for (int dt = 0; dt < 4; ++dt) { const bf16x8 vf = __builtin_bit_cast(bf16x8, (u32x4){vlo[dt].x, vlo[dt].y, vhi[dt].x, vhi[dt].y});
#pragma unroll
                    for (int mi = 0; mi < 2; ++mi) o[mi][dt] = __builtin_amdgcn_mfma_f32_16x16x32_bf16(vf, pf[mi][0], o[mi][dt], 0, 0, 0); }
                if (full) {
#pragma unroll
                    for (int dt = 0; dt < 4; ++dt) { const bf16x8 vf = __builtin_bit_cast(bf16x8, (u32x4){wlo[dt].x, wlo[dt].y, whi[dt].x, whi[dt].y});
#pragma unroll
                        for (int mi = 0; mi < 2; ++mi) o[mi][dt] = __builtin_amdgcn_mfma_f32_16x16x32_bf16(vf, pf[mi][1], o[mi][dt], 0, 0, 0); } }
            }
            if (kt + 1 < ntiles) lstore(cur ^ 1);
            __syncthreads();
        }
#pragma unroll
        for (int mi = 0; mi < 2; ++mi) {
            const float lt = quad_sum(lsum[mi]);
            if (!meta || (wave == 0 && mi == 0)) {
                const float inv = 1.0f / lt;
                bf16* dst = O + ((size_t)b * L + r0 + 32 * wave + 16 * mi + r) * 512 + h * VD;
#pragma unroll
                for (int dt = 0; dt < 4; ++dt) { const f32x4 v = o[mi][dt] * inv; u32x2 ov; ov.x = pk2(v.x, v.y); ov.y = pk2(v.z, v.w); *(u32x2*)(dst + 16 * dt + 4 * q) = ov; }
            }
        }
    }
}

__device__ __forceinline__ int tile_tok0(int mt, int l) { return l == 1 ? mt * 128 + NMETA * ((mt >> 4) + 1) : mt * 128; }
__device__ __forceinline__ int n_mtiles(int l) { return l == 1 ? 128 : MT; }
__device__ __forceinline__ void phase_D(const Ctx& c0, int l) {
    Ctx c = reopaque(c0);
    const bf16* u2 = WSP(bf16, WS_U2); const bf16* O = WSP(bf16, WS_O); const bf16* gates = WSP(bf16, WS_GATES); bf16* merged = WSP(bf16, WS_MERGED);
    const bf16* Wco = (const bf16*)(c.ws + WS_WIN + l * SZ_WLAYER + OFF_WCO); const bf16* Wmla = (const bf16*)(c.ws + WS_WIN + l * SZ_WLAYER + OFF_WMLA);
    const int r = c.lane & 15, q = c.lane >> 4;
    for (int it = c.vb; it < n_mtiles(l) * 8; it += c.G) {
        const int mt = it / 8, nt = it % 8, tk0 = tile_tok0(mt, l);
        f32x4 acc[2][8]; acc_zero(acc);
        gemm_core(acc, u2 + (size_t)tk0 * 512, 512, Wco + (size_t)nt * 128 * 512, 512, 512, c.lds, c.tid);
#pragma unroll
        for (int mi = 0; mi < 2; ++mi) { const int tok = tk0 + 32 * c.wave + 16 * mi + r;
            const bf16* gp = gates + (size_t)tok * 2048 + nt * 128 + 4 * q; bf16* mp = merged + (size_t)tok * D + nt * 128 + 4 * q;
#pragma unroll
            for (int ni = 0; ni < 8; ++ni) { const u32x2 g = *(const u32x2*)(gp + 16 * ni); const f32x4 v = acc[mi][ni];
                u32x2 o; o.x = pk2(v.x * bf_lo(g.x), v.y * bf_hi(g.x)); o.y = pk2(v.z * bf_lo(g.y), v.w * bf_hi(g.y)); *(u32x2*)(mp + 16 * ni) = o; } }
        acc_zero(acc);
        gemm_core(acc, O + (size_t)tk0 * 512, 512, Wmla + (size_t)nt * 128 * 512, 512, 512, c.lds, c.tid);
#pragma unroll
        for (int mi = 0; mi < 2; ++mi) { const int tok = tk0 + 32 * c.wave + 16 * mi + r;
            const bf16* gp = gates + (size_t)tok * 2048 + 1024 + nt * 128 + 4 * q; bf16* mp = merged + (size_t)tok * D + nt * 128 + 4 * q;
#pragma unroll
            for (int ni = 0; ni < 8; ++ni) { const u32x2 g = *(const u32x2*)(gp + 16 * ni); const u32x2 s = *(const u32x2*)(mp + 16 * ni); const f32x4 v = acc[mi][ni];
                u32x2 o; o.x = pk2(bf_lo(s.x) + v.x * bf_lo(g.x), bf_hi(s.x) + v.y * bf_hi(g.x)); o.y = pk2(bf_lo(s.y) + v.z * bf_lo(g.y), bf_hi(s.y) + v.w * bf_hi(g.y));
                *(u32x2*)(mp + 16 * ni) = o; } }
    }
}

__device__ __forceinline__ void phase_E(const Ctx& c0, int l) {
    Ctx c = reopaque(c0);
    const bf16* merged = WSP(bf16, WS_MERGED); const bf16* Wout = (const bf16*)(c.ws + WS_WIN + l * SZ_WLAYER + OFF_WOUT);
    float* h = WSP(float, WS_H); bf16* hb = WSP(bf16, WS_HB); float* ssq = WSP(float, WS_SSQ);
    const int r = c.lane & 15, q = c.lane >> 4;
    for (int it = c.vb; it < n_mtiles(l) * 8; it += c.G) {
        const int mt = it / 8, nt = it % 8, tk0 = tile_tok0(mt, l);
        f32x4 acc[2][8];
#pragma unroll
        for (int mi = 0; mi < 2; ++mi) { const int tok = tk0 + 32 * c.wave + 16 * mi + r; const float* hp = h + (size_t)tok * D;
            if (l == 0) { const int b = tok / L, pos = tok - b * L; hp = pos < NMETA ? c.in[1] + (size_t)pos * D : c.in[0] + ((size_t)b * SEQ + (pos - NMETA)) * D; }
            hp += nt * 128 + 4 * q;
#pragma unroll
            for (int ni = 0; ni < 8; ++ni) acc[mi][ni] = *(const f32x4*)(hp + 16 * ni); }
        gemm_core(acc, merged + (size_t)tk0 * D, D, Wout + (size_t)nt * 128 * D, D, D, c.lds, c.tid);
#pragma unroll
        for (int mi = 0; mi < 2; ++mi) { const int tok = tk0 + 32 * c.wave + 16 * mi + r; float ss = 0.f;
#pragma unroll
            for (int ni = 0; ni < 8; ++ni) { float* hp = h + (size_t)tok * D + nt * 128 + 16 * ni + 4 * q; const f32x4 v = acc[mi][ni]; *(f32x4*)hp = v;
                ss += (v.x * v.x + v.y * v.y) + (v.z * v.z + v.w * v.w);
                u32x2 o; o.x = pk2(v.x, v.y); o.y = pk2(v.z, v.w); *(u32x2*)(hb + (size_t)tok * D + nt * 128 + 16 * ni + 4 * q) = o; }
            ss = quad_sum(ss);
            if (q == 0) ssq[(size_t)tok * 8 + nt] = ss; }
    }
}

__device__ __forceinline__ unsigned f2key(float f) { const unsigned u = __float_as_uint(f); return u ^ ((u >> 31) ? 0xFFFFFFFFu : 0x80000000u); }
__device__ __forceinline__ float key2f(unsigned k) { const unsigned u = (k >> 31) ? (k ^ 0x80000000u) : ~k; return __uint_as_float(u); }
__device__ __forceinline__ void top16_insert(unsigned (&lst)[16], unsigned x) {
#pragma unroll
    for (int i = 0; i < 16; ++i) { const unsigned a = lst[i]; lst[i] = a > x ? a : x; x = a > x ? x : a; }
}
__device__ __forceinline__ void ce_desc(unsigned& a, unsigned& b) { const unsigned mx = a > b ? a : b, mn = a > b ? b : a; a = mx; b = mn; }
__device__ __forceinline__ void sort16_desc(unsigned (&v)[16]) {
#pragma unroll
    for (int k = 2; k <= 16; k <<= 1)
#pragma unroll
        for (int j = k >> 1; j > 0; j >>= 1)
#pragma unroll
            for (int i = 0; i < 16; ++i) { const int p = i ^ j; if (p > i) { if ((i & k) == 0) ce_desc(v[i], v[p]); else ce_desc(v[p], v[i]); } }
}
__device__ __forceinline__ void merge_top16(unsigned (&a)[16], const unsigned (&b)[16]) {
#pragma unroll
    for (int i = 0; i < 16; ++i) a[i] = a[i] > b[15 - i] ? a[i] : b[15 - i];
#pragma unroll
    for (int j = 8; j > 0; j >>= 1)
#pragma unroll
        for (int i = 0; i < 16; ++i) { const int p = i ^ j; if (p > i) ce_desc(a[i], a[p]); }
}
__device__ __forceinline__ void phase_F(const Ctx& c0, int l) {
    Ctx c = reopaque(c0);
    const bf16* hb = WSP(bf16, WS_HB); const bf16* Wpq = (const bf16*)(c.ws + WS_WIN + l * SZ_WLAYER + OFF_WPQ); const bf16* keys = (const bf16*)(c.ws + WS_WIN + l * SZ_WLAYER + OFF_KEYS);
    const float* ssq = WSP(float, WS_SSQ); float* sv = WSP(float, WS_SV); unsigned char* si = WSP(unsigned char, WS_SI);
    const int tid = c.tid, wave = c.wave, lane = c.lane, r = lane & 15, q = lane >> 4;
    unsigned char* lds = c.lds;
    const int xcd = c.vb / (c.G / 8), lb = c.vb % (c.G / 8), xm = xcd & 1, xn = xcd >> 1, nmt = n_mtiles(l);
    const int m_lo = xm ? (nmt + 1) / 2 : 0, m_cnt = xm ? nmt / 2 : (nmt + 1) / 2;
    for (int j = lb; j < m_cnt * 4; j += c.G / 8) {
        const int mt = m_lo + j / 4, hp = xn * 4 + j % 4, tk0 = tile_tok0(mt, l);
        f32x4 acc[2][8]; acc_zero(acc);
        u32x4 kreg[2][4]; float rsv[2];
        { const int chunk = tid & 7, row0 = tid >> 3; const bf16* pb = keys + ((size_t)hp * 128 + row0) * 128 + chunk * 8;
#pragma unroll
          for (int s = 0; s < 2; ++s)
#pragma unroll
              for (int i = 0; i < 4; ++i) kreg[s][i] = *(const u32x4*)(pb + (size_t)(32 * i) * 128 + s * 64); }
#pragma unroll
        for (int mi = 0; mi < 2; ++mi) rsv[mi] = rstd_from_ssq8(ssq, tk0 + 32 * wave + 16 * mi + r);
        gemm_core(acc, hb + (size_t)tk0 * D, D, Wpq + (size_t)hp * 128 * D, D, D, lds, tid);
#pragma unroll
        for (int mi = 0; mi < 2; ++mi) { const int row = 32 * wave + 16 * mi + r; const float rs = rsv[mi];
#pragma unroll
            for (int ni = 0; ni < 8; ++ni) { const f32x4 v = acc[mi][ni] * rs; u32x2 o; o.x = pk2(v.x, v.y); o.y = pk2(v.z, v.w);
                *(u32x2*)(lds + (ni >> 2) * 32768 + lds_off(row, 2 * (ni & 3) + (q >> 1)) + 8 * (q & 1)) = o; } }
        { const int chunk = tid & 7, row0 = tid >> 3;
#pragma unroll
          for (int s = 0; s < 2; ++s)
#pragma unroll
              for (int i = 0; i < 4; ++i) *(u32x4*)(lds + s * 32768 + 16384 + lds_off(row0 + 32 * i, chunk)) = kreg[s][i]; }
        __syncthreads();
        acc_zero(acc);
        gemm_compute_stage(acc, lds, lds + 16384, wave, lane);
        gemm_compute_stage(acc, lds + 32768, lds + 32768 + 16384, wave, lane);
        __syncthreads();
        float* S = (float*)lds;
#pragma unroll
        for (int mi = 0; mi < 2; ++mi) { const int row = 32 * wave + 16 * mi + r;
#pragma unroll
            for (int ni = 0; ni < 8; ++ni) *(f32x4*)(S + row * 132 + 16 * ni + 4 * q) = acc[mi][ni]; }
        __syncthreads();
        {
            const int tl = 32 * wave + (lane & 31), half = lane >> 5;
            const float* row = S + tl * 132;
            unsigned lst[16];
#pragma unroll
            for (int g = 0; g < 4; ++g) {
                unsigned cur[16];
#pragma unroll
                for (int j = 0; j < 4; ++j) { const int col = 64 * half + 16 * g + 4 * j; const f32x4 v = *(const f32x4*)(row + col);
                    cur[4 * j] = (f2key(v.x) & ~127u) | (unsigned)(127 - col); cur[4 * j + 1] = (f2key(v.y) & ~127u) | (unsigned)(127 - (col + 1));
                    cur[4 * j + 2] = (f2key(v.z) & ~127u) | (unsigned)(127 - (col + 2)); cur[4 * j + 3] = (f2key(v.w) & ~127u) | (unsigned)(127 - (col + 3)); }
                sort16_desc(cur);
                if (g == 0) {
#pragma unroll
                    for (int i = 0; i < 16; ++i) lst[i] = cur[i];
                } else merge_top16(lst, cur);
            }
            unsigned oth[16];
#pragma unroll
            for (int i = 0; i < 16; ++i) { auto rr = __builtin_amdgcn_permlane32_swap(lst[i], lst[i], false, false); oth[i] = half == 0 ? rr[1] : rr[0]; }
            merge_top16(lst, oth);
            if (half == 0) {
                const int tok = tk0 + tl;
                unsigned idx[16]; float val[16];
#pragma unroll
                for (int i = 0; i < 16; ++i) { idx[i] = 127u - (lst[i] & 127u); val[i] = row[idx[i]]; }
                float* svp = sv + ((size_t)tok * 16 + hp) * 16;
#pragma unroll
                for (int i = 0; i < 4; ++i) *(f32x4*)(svp + 4 * i) = (f32x4){val[4 * i], val[4 * i + 1], val[4 * i + 2], val[4 * i + 3]};
                u32x4 pi;
                pi.x = idx[0] | (idx[1] << 8) | (idx[2] << 16) | (idx[3] << 24); pi.y = idx[4] | (idx[5] << 8) | (idx[6] << 16) | (idx[7] << 24);
                pi.z = idx[8] | (idx[9] << 8) | (idx[10] << 16) | (idx[11] << 24); pi.w = idx[12] | (idx[13] << 8) | (idx[14] << 16) | (idx[15] << 24);
                *(u32x4*)(si + ((size_t)tok * 16 + hp) * 16) = pi;
            }
        }
        __syncthreads();
    }
}

__device__ __forceinline__ void phase_F3(const Ctx& c0, int l) {
    Ctx c = reopaque(c0);
    const float* sv = WSP(float, WS_SV); const unsigned char* si = WSP(unsigned char, WS_SI); int* eidx = WSP(int, WS_EIDX); float* gw = WSP(float, WS_GW); unsigned char* stb = WSP(unsigned char, WS_STB);
    float* lsv = (float*)c.lds;
    unsigned char* lsi = c.lds + 256 * 33 * 4;
    const int tid = c.tid;
    const bool has_x = l == 0 && (c.vb & 3) == 0; const int tx = T - 128 + (c.vb >> 2);
    for (int pass = 0; pass < (has_x ? 2 : 1); ++pass) {
        const int thc = c.vb * NTHREADS + tid, tkc = thc >> 3;
        const int th = pass == 1 ? tx * 8 + (tid & 7) : (l == 1 ? tkc + NMETA * ((tkc >> 11) + 1) : tkc) * 8 + (thc & 7);
        float a[16], b[16];
#pragma unroll
        for (int i = 0; i < 4; ++i) { const f32x4 x = *(const f32x4*)(sv + (size_t)th * 32 + 4 * i), y = *(const f32x4*)(sv + (size_t)th * 32 + 16 + 4 * i);
            a[4 * i] = x.x; a[4 * i + 1] = x.y; a[4 * i + 2] = x.z; a[4 * i + 3] = x.w; b[4 * i] = y.x; b[4 * i + 1] = y.y; b[4 * i + 2] = y.z; b[4 * i + 3] = y.w; }
        const u32x4 ia = *(const u32x4*)(si + (size_t)th * 32), ib = *(const u32x4*)(si + (size_t)th * 32 + 16);
#pragma unroll
        for (int i = 0; i < 16; ++i) { lsv[tid * 33 + i] = a[i]; lsv[tid * 33 + 16 + i] = b[i]; }
        *(u32x4*)(lsi + tid * 32) = ia; *(u32x4*)(lsi + tid * 32 + 16) = ib;
        unsigned lst[16], g2[16], g3[16], g4[16];
#pragma unroll
        for (int j = 0; j < 16; ++j) lst[j] = (f2key(a[0] + b[j]) & ~255u) | (unsigned)(255 - j);
#pragma unroll
        for (int i = 1; i < 16; ++i) g2[i - 1] = (f2key(a[i] + b[0]) & ~255u) | (unsigned)(255 - i * 16);
        g2[15] = 0u;
        { int n = 0;
#pragma unroll
          for (int i = 1; i < 16; ++i)
#pragma unroll
              for (int j = 1; j < 16; ++j)
                  if ((i + 1) * (j + 1) <= 16) { const unsigned key = (f2key(a[i] + b[j]) & ~255u) | (unsigned)(255 - (i * 16 + j)); if (n < 16) g3[n] = key; else g4[n - 16] = key; ++n; }
#pragma unroll
          for (int k = 3; k < 16; ++k) g4[k] = 0u; }
        sort16_desc(g3); sort16_desc(g4);
        merge_top16(lst, g2); merge_top16(g3, g4); merge_top16(lst, g3);
        __builtin_amdgcn_s_waitcnt(0xC07F); asm volatile("" ::: "memory");
        float s[16]; int e[16];
#pragma unroll
        for (int k = 0; k < 16; ++k) { const unsigned code = 255u - (lst[k] & 255u); const int i = code >> 4, j = code & 15;
            s[k] = lsv[tid * 33 + i] + lsv[tid * 33 + 16 + j]; e[k] = (int)lsi[tid * 32 + i] * 128 + (int)lsi[tid * 32 + 16 + j]; }
        float mx = s[0];
#pragma unroll
        for (int k = 1; k < 16; ++k) mx = fmaxf(mx, s[k]);
        float sum = 0.f;
#pragma unroll
        for (int k = 0; k < 16; ++k) { s[k] = fast_exp2((s[k] - mx) * 1.4426950409f); sum += s[k]; }
        const float inv = 1.0f / sum;
        typedef unsigned long long u64;
        u64 hlo = 0ull, hhi = 0ull;
#pragma unroll
        for (int k = 0; k < 16; ++k) { const int sl = e[k] >> 10; if (sl < 8) hlo += 1ull << (8 * sl); else hhi += 1ull << (8 * (sl - 8)); }
        u64 ilo = hlo, ihi = hhi;
#pragma unroll
        for (int d = 1; d < 8; d <<= 1) { const u64 a_ = __shfl_up(ilo, d, 8), b_ = __shfl_up(ihi, d, 8); if ((tid & 7) >= d) { ilo += a_; ihi += b_; } }
        const u64 tlo = __shfl(ilo, 7, 8), thi = __shfl(ihi, 7, 8);
        const u64 ones = 0x0101010101010101ull;
        const u64 inlo = tlo * ones, inhi = thi * ones + (inlo >> 56) * ones;
        const u64 stlo = inlo - tlo, sthi = inhi - thi;
        u64 rlo = stlo + (ilo - hlo), rhi = sthi + (ihi - hhi);
        const int tokn = th >> 3;
#pragma unroll
        for (int k = 0; k < 16; ++k) { const int sl = e[k] >> 10; int pos;
            if (sl < 8) { pos = (int)((rlo >> (8 * sl)) & 255ull); rlo += 1ull << (8 * sl); } else { pos = (int)((rhi >> (8 * (sl - 8))) & 255ull); rhi += 1ull << (8 * (sl - 8)); }
            eidx[(size_t)tokn * 128 + pos] = e[k]; gw[(size_t)tokn * 128 + pos] = s[k] * inv; }
        if ((tid & 7) == 0) { u64* sp = (u64*)(stb + (size_t)tokn * 16); sp[0] = stlo; sp[1] = sthi; }
        __builtin_amdgcn_s_waitcnt(0xC07F); asm volatile("" ::: "memory");
    }
}

typedef float f32x2 __attribute__((ext_vector_type(2)));
constexpr int G2_WSTRIDE = 14336, G2_MAXTOK = 9;
__device__ __forceinline__ float fp8dot4(unsigned w, unsigned x01, unsigned x23, float acc) {
    const bf16x2 lo = __builtin_amdgcn_cvt_scalef32_pk_bf16_fp8(w, 1.0f, false), hi = __builtin_amdgcn_cvt_scalef32_pk_bf16_fp8(w, 1.0f, true);
    acc = __builtin_amdgcn_fdot2_f32_bf16(lo, __builtin_bit_cast(bf16x2, x01), acc, false);
    return __builtin_amdgcn_fdot2_f32_bf16(hi, __builtin_bit_cast(bf16x2, x23), acc, false);
}
__device__ __forceinline__ float reduce8_transposed(const float (&p)[8], int lane) {
    float s[4];
#pragma unroll
    for (int k = 0; k < 4; ++k) { auto r = __builtin_amdgcn_permlane32_swap(__float_as_uint(p[k]), __float_as_uint(p[k + 4]), false, false); s[k] = __uint_as_float(r[0]) + __uint_as_float(r[1]); }
    float t[2];
#pragma unroll
    for (int k = 0; k < 2; ++k) { auto r = __builtin_amdgcn_permlane16_swap(__float_as_uint(s[k]), __float_as_uint(s[k + 2]), false, false); t[k] = __uint_as_float(r[0]) + __uint_as_float(r[1]); }
    const float u0 = t[0] + dpp<0x128>(t[0]), u1 = t[1] + dpp<0x128>(t[1]);
    float r = (lane & 8) ? u1 : u0;
    r += dpp<0xB1>(r); r += dpp<0x4E>(r); r += dpp<0x141>(r);
    return r;
}
typedef int i32x4 __attribute__((ext_vector_type(4)));
typedef _Float16 h2 __attribute__((ext_vector_type(2)));
__device__ __forceinline__ void fp4fma8(h2 (&acc)[8], int o, unsigned w, h2 a2) {
    acc[o] = __builtin_elementwise_fma(a2, __builtin_bit_cast(h2, __builtin_amdgcn_cvt_scalef32_pk_f16_fp4(w, 1.0f, 0)), acc[o]);
    acc[o + 1] = __builtin_elementwise_fma(a2, __builtin_bit_cast(h2, __builtin_amdgcn_cvt_scalef32_pk_f16_fp4(w, 1.0f, 1)), acc[o + 1]);
    acc[o + 2] = __builtin_elementwise_fma(a2, __builtin_bit_cast(h2, __builtin_amdgcn_cvt_scalef32_pk_f16_fp4(w, 1.0f, 2)), acc[o + 2]);
    acc[o + 3] = __builtin_elementwise_fma(a2, __builtin_bit_cast(h2, __builtin_amdgcn_cvt_scalef32_pk_f16_fp4(w, 1.0f, 3)), acc[o + 3]);
}
__device__ __forceinline__ void g2_u_chunk(u32x2 (&u)[8], const unsigned char* U, const int* pe_next, const float* pw_c, float* act_c, const u32x2 xq, float rs, int lane) {
    const i32x4 e0 = *(const i32x4*)pe_next, e1 = *(const i32x4*)(pe_next + 4);
    const int en[8] = {e0.x, e0.y, e0.z, e0.w, e1.x, e1.y, e1.z, e1.w};
    float p[8];
#pragma unroll
    for (int k = 0; k < 8; k += 2) {
        int d0 = __builtin_amdgcn_sdot8((int)u[k].x, (int)xq.x, 0, false), d1 = __builtin_amdgcn_sdot8((int)u[k + 1].x, (int)xq.x, 0, false);
        d0 = __builtin_amdgcn_sdot8((int)u[k].y, (int)xq.y, d0, false); d1 = __builtin_amdgcn_sdot8((int)u[k + 1].y, (int)xq.y, d1, false);
        p[k] = (float)d0; p[k + 1] = (float)d1;
        asm volatile("" : "+v"(p[k]), "+v"(p[k + 1]));
        u[k] = *(const u32x2*)(U + (size_t)__builtin_amdgcn_readfirstlane(en[k]) * 512 + lane * 8);
        u[k + 1] = *(const u32x2*)(U + (size_t)__builtin_amdgcn_readfirstlane(en[k + 1]) * 512 + lane * 8);
    }
    const float a = reduce8_transposed(p, lane);
    const int row = (lane >> 3) & 7;
    if ((lane & 7) == 0) { const _Float16 hv = (_Float16)(gelu_tanh(a * rs) * pw_c[row]); act_c[row] = __builtin_bit_cast(float, (h2){hv, hv}); }
}
__device__ __forceinline__ void g2_v_chunk(u32x2 (&v)[8], const unsigned char* V, const int* pe_next, const float* act_c, h2 (&acc)[8], int lane) {
    const i32x4 e0 = *(const i32x4*)pe_next, e1 = *(const i32x4*)(pe_next + 4);
    const int en[8] = {e0.x, e0.y, e0.z, e0.w, e1.x, e1.y, e1.z, e1.w};
    const f32x4 a0 = *(const f32x4*)act_c, a1 = *(const f32x4*)(act_c + 4);
    const float av[8] = {a0.x, a0.y, a0.z, a0.w, a1.x, a1.y, a1.z, a1.w};
#pragma unroll
    for (int k = 0; k < 8; k += 2) {
        const h2 a2 = __builtin_bit_cast(h2, av[k]), b2 = __builtin_bit_cast(h2, av[k + 1]);
        fp4fma8(acc, 0, v[k].x, a2); fp4fma8(acc, 4, v[k].y, a2);
        fp4fma8(acc, 0, v[k + 1].x, b2); fp4fma8(acc, 4, v[k + 1].y, b2);
        asm volatile("" : "+v"(acc[0]), "+v"(acc[1]), "+v"(acc[2]), "+v"(acc[3]), "+v"(acc[4]), "+v"(acc[5]), "+v"(acc[6]), "+v"(acc[7]));
        v[k] = *(const u32x2*)(V + (size_t)__builtin_amdgcn_readfirstlane(en[k]) * 512 + lane * 8);
        v[k + 1] = *(const u32x2*)(V + (size_t)__builtin_amdgcn_readfirstlane(en[k + 1]) * 512 + lane * 8);
    }
}
__device__ __forceinline__ void g2_finish_token(Ctx& c, int l, int tok, const f32x2 (&acc)[8], int lane) {
    float* h = WSP(float, WS_H); bf16* hbw = WSP(bf16, WS_HB); float* ssqw = WSP(float, WS_SSQ);
    float* hp = h + (size_t)tok * D + lane * 16;
    f32x4 r0 = *(const f32x4*)hp, r1 = *(const f32x4*)(hp + 4), r2 = *(const f32x4*)(hp + 8), r3 = *(const f32x4*)(hp + 12);
    r0 += (f32x4){acc[0].x, acc[0].y, acc[1].x, acc[1].y}; r1 += (f32x4){acc[2].x, acc[2].y, acc[3].x, acc[3].y};
    r2 += (f32x4){acc[4].x, acc[4].y, acc[5].x, acc[5].y}; r3 += (f32x4){acc[6].x, acc[6].y, acc[7].x, acc[7].y};
    if (l == 0) {
        *(f32x4*)hp = r0; *(f32x4*)(hp + 4) = r1; *(f32x4*)(hp + 8) = r2; *(f32x4*)(hp + 12) = r3;
        u32x4 o0, o1; o0.x = pk2(r0.x, r0.y); o0.y = pk2(r0.z, r0.w); o0.z = pk2(r1.x, r1.y); o0.w = pk2(r1.z, r1.w);
        o1.x = pk2(r2.x, r2.y); o1.y = pk2(r2.z, r2.w); o1.z = pk2(r3.x, r3.y); o1.w = pk2(r3.z, r3.w);
        *(u32x4*)(hbw + (size_t)tok * D + lane * 16) = o0; *(u32x4*)(hbw + (size_t)tok * D + lane * 16 + 8) = o1;
        float ss = (r0.x * r0.x + r0.y * r0.y) + (r0.z * r0.z + r0.w * r0.w) + (r1.x * r1.x + r1.y * r1.y) + (r1.z * r1.z + r1.w * r1.w)
                 + (r2.x * r2.x + r2.y * r2.y) + (r2.z * r2.z + r2.w * r2.w) + (r3.x * r3.x + r3.y * r3.y) + (r3.z * r3.z + r3.w * r3.w);
        ss = wave_sum_dpp(ss);
        if (lane < 8) ssqw[(size_t)tok * 8 + lane] = lane == 0 ? ss : 0.f;
    } else {
        const int b = tok / L, pos = tok - b * L;
        if (pos >= NMETA) { float* op = c.out + ((size_t)b * SEQ + (pos - NMETA)) * D + lane * 16;
            *(f32x4*)op = r0; *(f32x4*)(op + 4) = r1; *(f32x4*)(op + 8) = r2; *(f32x4*)(op + 12) = r3; }
    }
}
__device__ __forceinline__ void phase_G2(const Ctx& c0, int l) {
    Ctx c = reopaque(c0);
    const bf16* hb = WSP(bf16, WS_HB); const float* ssq = WSP(float, WS_SSQ); const int* pe = WSP(int, WS_EIDX); const float* pw = WSP(float, WS_GW);
    const unsigned char* U = c.ws + WS_TAB + (size_t)(l * 2) * SZ_TAB; const unsigned char* V = c.ws + WS_TAB + (size_t)(l * 2 + 1) * SZ_TAB;
    const int lane = c.lane, wave = c.wave;
    const int gw = c.vb * 4 + wave, t0 = l == 1 ? gw * 8 + NMETA * ((gw >> 8) + 1) : gw * 8;
    const bool has_x = l == 0 && (c.vb & 3) == 0; const int tx = T - 128 + (c.vb >> 2);
    unsigned char* wl = c.lds + wave * G2_WSTRIDE;
    int* pe_l = (int*)wl; float* pw_l = (float*)(wl + 4608); float* act_l = (float*)(wl + 9216);
#pragma unroll
    for (int j = 0; j < G2_MAXTOK; ++j) { const int tok = j < 8 ? t0 + j : (has_x ? tx : t0);
        pe_l[j * 128 + lane] = pe[(size_t)tok * 128 + lane]; pe_l[j * 128 + 64 + lane] = pe[(size_t)tok * 128 + 64 + lane];
        pw_l[j * 128 + lane] = pw[(size_t)tok * 128 + lane]; pw_l[j * 128 + 64 + lane] = pw[(size_t)tok * 128 + 64 + lane]; }
    const int xlo = has_x ? 4 * wave : 16, xhi = has_x ? 4 * wave + 4 : 16;
    {
        u32x2 xq[G2_MAXTOK]; float rs[G2_MAXTOK];
#pragma unroll
        for (int j = 0; j < G2_MAXTOK; ++j) { const int tok = j < 8 ? t0 + j : (has_x ? tx : t0);
            const u32x4 lo = *(const u32x4*)(hb + (size_t)tok * D + lane * 16), hi = *(const u32x4*)(hb + (size_t)tok * D + lane * 16 + 8);
            const float sx = rstd_from_ssq8(ssq, tok) * X_SCALE;
            const f32x4 f0 = (f32x4){bf_lo(lo.x), bf_hi(lo.x), bf_lo(lo.y), bf_hi(lo.y)} * sx, f1 = (f32x4){bf_lo(lo.z), bf_hi(lo.z), bf_lo(lo.w), bf_hi(lo.w)} * sx;
            const f32x4 f2 = (f32x4){bf_lo(hi.x), bf_hi(hi.x), bf_lo(hi.y), bf_hi(hi.y)} * sx, f3 = (f32x4){bf_lo(hi.z), bf_hi(hi.z), bf_lo(hi.w), bf_hi(hi.w)} * sx;
            xq[j].x = pack_i4x4(f0) | (pack_i4x4(f1) << 16); xq[j].y = pack_i4x4(f2) | (pack_i4x4(f3) << 16);
            rs[j] = 1.0f / (X_SCALE * U_SCALE); }
        u32x2 u[8];
#pragma unroll
        for (int k = 0; k < 8; ++k) u[k] = *(const u32x2*)(U + (size_t)__builtin_amdgcn_readfirstlane(pe_l[k]) * 512 + lane * 8);
#pragma unroll 1
        for (int ch = 0; ch < 16; ++ch) {
            const int cn = ch < 15 ? ch + 1 : 0;
            const bool x_here = ch >= xlo && ch < xhi;
#pragma unroll
            for (int j = 0; j < 8; ++j) {
                const int* pe_next = j < 7 ? pe_l + (j + 1) * 128 + ch * 8 : (x_here ? pe_l + 8 * 128 + ch * 8 : pe_l + cn * 8);
                g2_u_chunk(u, U, pe_next, pw_l + j * 128 + ch * 8, act_l + j * 128 + ch * 8, xq[j], rs[j], lane); }
            if (x_here) g2_u_chunk(u, U, pe_l + cn * 8, pw_l + 8 * 128 + ch * 8, act_l + 8 * 128 + ch * 8, xq[8], rs[8], lane);
        }
    }
    h2 acc[G2_MAXTOK][8];
#pragma unroll
    for (int j = 0; j < G2_MAXTOK; ++j)
#pragma unroll
        for (int i = 0; i < 8; ++i) acc[j][i] = (h2){(_Float16)0.f, (_Float16)0.f};
    {
        u32x2 v[8];
#pragma unroll
        for (int k = 0; k < 8; ++k) v[k] = *(const u32x2*)(V + (size_t)__builtin_amdgcn_readfirstlane(pe_l[k]) * 512 + lane * 8);
#pragma unroll 1
        for (int ch = 0; ch < 16; ++ch) {
            const int cn = ch < 15 ? ch + 1 : 0;
            const bool x_here = ch >= xlo && ch < xhi;
#pragma unroll
            for (int j = 0; j < 8; ++j) {
                const int* pe_next = j < 7 ? pe_l + (j + 1) * 128 + ch * 8 : (x_here ? pe_l + 8 * 128 + ch * 8 : pe_l + cn * 8);
                g2_v_chunk(v, V, pe_next, act_l + j * 128 + ch * 8, acc[j], lane); }
            if (x_here) g2_v_chunk(v, V, pe_l + cn * 8, act_l + 8 * 128 + ch * 8, acc[8], lane);
        }
    }
#pragma unroll
    for (int j = 0; j < 8; ++j) { f32x2 af[8];
#pragma unroll
        for (int i = 0; i < 8; ++i) af[i] = (f32x2){(float)acc[j][i].x, (float)acc[j][i].y} * TAB_INV;
        g2_finish_token(c, l, t0 + j, af, lane); }
    f32x2 accx[8];
#pragma unroll
    for (int i = 0; i < 8; ++i) accx[i] = (f32x2){(float)acc[8][i].x, (float)acc[8][i].y} * TAB_INV;
    __syncthreads();
    if (has_x) {
        f32x2* part = (f32x2*)(c.lds + wave * G2_WSTRIDE);
#pragma unroll
        for (int i = 0; i < 8; ++i) part[i * 64 + lane] = accx[i];
    }
    __syncthreads();
    if (has_x && wave == 0) {
        f32x2 tot[8];
#pragma unroll
        for (int i = 0; i < 8; ++i) { tot[i] = accx[i];
#pragma unroll
            for (int w = 1; w < 4; ++w) tot[i] += ((const f32x2*)(c.lds + w * G2_WSTRIDE))[i * 64 + lane]; }
        g2_finish_token(c, l, tx, tot, lane);
    }
    __syncthreads();
}

struct Args { const float* in[22]; float* out; unsigned char* ws; int ph_lo, ph_hi; };
constexpr int N_PHASES = 17;

__global__ void __launch_bounds__(NTHREADS, 2) fwd_kernel(Args args) {
    extern __shared__ __attribute__((aligned(16))) unsigned char lds_raw[];
    Ctx c;
#pragma unroll
    for (int i = 0; i < 22; ++i) c.in[i] = args.in[i];
    c.out = args.out; c.ws = args.ws; c.lds = lds_raw;
    c.tid = threadIdx.x; c.lane = c.tid & 63; c.wave = __builtin_amdgcn_readfirstlane(c.tid >> 6);
    c.G = gridDim.x; { const int bx = blockIdx.x; c.vb = (c.G % 8 == 0) ? (bx % 8) * (c.G / 8) + bx / 8 : bx; }
    volatile unsigned* misc = (volatile unsigned*)(c.lds + LDS_MISC);
    if (c.tid < 16) misc[c.tid] = 0u;
    __syncthreads();
    const int lo = args.ph_lo, hi = args.ph_hi;
    const bool multi = (hi - lo) > 1;
    XcdBarrier bar; bar.bar = WSP(unsigned, WS_CTL) + CW_BAR; bar.x = 0; bar.st = misc;
    if (multi) bar = xcd_barrier_post(WSP(unsigned, WS_CTL) + CW_BAR, misc);
#define IN_(k) (lo <= (k) && (k) < hi)
#define SEAM_(k) do { if ((k) + 1 < hi) xcd_barrier(bar); } while (0)
    if (IN_(0)) { phase_prologue(c); SEAM_(0); }
#pragma unroll 1
    for (int l = 0; l < 2; ++l) {
        const int p0 = 1 + 8 * l;
        if (IN_(p0 + 0)) { phase_A(c, l); SEAM_(p0 + 0); }
        if (IN_(p0 + 1)) { phase_B(c, l); SEAM_(p0 + 1); }
        if (IN_(p0 + 2)) { phase_C(c, l); SEAM_(p0 + 2); }
        if (IN_(p0 + 3)) { phase_D(c, l); SEAM_(p0 + 3); }
        if (IN_(p0 + 4)) { phase_E(c, l); SEAM_(p0 + 4); }
        if (IN_(p0 + 5)) { phase_F(c, l); SEAM_(p0 + 5); }
        if (IN_(p0 + 6)) { phase_F3(c, l); if (p0 + 7 < hi) { asm volatile("s_waitcnt vmcnt(0)" ::: "memory"); __syncthreads(); } }
        if (IN_(p0 + 7)) { phase_G2(c, l); SEAM_(p0 + 7); }
    }
}

extern "C" void kernel_launch(void* const* d_in, const int* in_sizes, int n_in, void* d_out, int out_size, void* d_ws, size_t ws_size, hipStream_t stream) {
    static int grid = 0;
    if (grid == 0) {
        if (n_in != 22 || out_size != NB * SEQ * D || ws_size < WS_END) { fprintf(stderr, "kernel_launch: unexpected shapes (n_in %d out %d ws %zu need %zu)\n", n_in, out_size, ws_size, (size_t)WS_END); grid = -1; return; }
        int dev = 0, cus = 0, per_cu = 0;
        hipGetDevice(&dev); hipDeviceGetAttribute(&cus, hipDeviceAttributeMultiprocessorCount, dev);
        if (hipFuncSetAttribute((const void*)fwd_kernel, hipFuncAttributeMaxDynamicSharedMemorySize, LDS_BYTES) != hipSuccess) { fprintf(stderr, "kernel_launch: hipFuncSetAttribute failed\n"); grid = -1; return; }
        if (hipOccupancyMaxActiveBlocksPerMultiprocessor(&per_cu, (const void*)fwd_kernel, NTHREADS, LDS_BYTES) != hipSuccess || per_cu < 1) { fprintf(stderr, "kernel_launch: occupancy query failed (%d)\n", per_cu); per_cu = 1; (void)hipGetLastError(); }
        if (per_cu > 2) per_cu = 2;
        grid = cus * per_cu;
        if (grid != 512) { fprintf(stderr, "kernel_launch: grid %d unsupported by phase G2 (needs 512 workgroups)\n", grid); grid = -1; return; }
        fprintf(stderr, "kernel_launch: grid %d (%d per CU), lds %d, ws need %zu have %zu\n", grid, per_cu, LDS_BYTES, (size_t)WS_END, ws_size);
    }
    if (grid < 0) return;
    hipMemsetAsync((char*)d_ws + WS_CTL, 0, CTL_BYTES, stream);
    Args a{};
    for (int i = 0; i < 22; ++i) a.in[i] = (const float*)d_in[i];
    a.out = (float*)d_out; a.ws = (unsigned char*)d_ws;
#if MK_PER_PHASE
    for (int ph = 0; ph < N_PHASES; ++ph) { a.ph_lo = ph; a.ph_hi = ph + 1; hipLaunchKernelGGL(fwd_kernel, dim3(grid), dim3(NTHREADS), LDS_BYTES, stream, a); }
#else
    a.ph_lo = 0; a.ph_hi = N_PHASES;
    void* kargs[] = {&a};
    hipError_t e = hipLaunchCooperativeKernel((const void*)fwd_kernel, dim3(grid), dim3(NTHREADS), kargs, LDS_BYTES, stream);
    if (e != hipSuccess) fprintf(stderr, "kernel_launch: cooperative launch failed: %s (grid %d)\n", hipGetErrorString(e), grid);
#endif
}
```

```cpp
#include <hip/hip_runtime.h>
#include <cstdio>
#include <cstdint>

#ifndef MK_PER_PHASE
#define MK_PER_PHASE 0
#endif

typedef unsigned short bf16;
typedef short bf16x8 __attribute__((ext_vector_type(8)));
typedef float f32x4 __attribute__((ext_vector_type(4)));
typedef unsigned u32x4 __attribute__((ext_vector_type(4)));
typedef unsigned u32x2 __attribute__((ext_vector_type(2)));
typedef __bf16 bf16x2 __attribute__((ext_vector_type(2)));

constexpr int NB = 8, SEQ = 2048, NMETA = 16, L = SEQ + NMETA, T = NB * L, D = 1024;
constexpr int DC = 512, CW = 31, NH = 8, QL = 256, KVL = 128, NOPE = 64, ROPE = 32, QK = 96, VD = 64;
constexpr int NIN = 3488, NINP = 3584;
constexpr int NEXP = 16384;
constexpr float EPS = 1e-6f;
constexpr int MT = T / 128;
static_assert(T % 128 == 0, "T tiles");

constexpr size_t al256(size_t x) { return (x + 255) & ~(size_t)255; }
constexpr size_t WS_CTL = 0;
constexpr size_t CTL_BYTES = 65536;
constexpr size_t WS_ROPE = WS_CTL + CTL_BYTES;
constexpr size_t WS_WIN = al256(WS_ROPE + (size_t)L * 16 * 8);
constexpr size_t SZ_WIN = (size_t)NINP * 1024 * 2, SZ_WCO = (size_t)1024 * 512 * 2, SZ_WUQ = (size_t)1024 * 256 * 2, SZ_WUKV = (size_t)1024 * 128 * 2,
                 SZ_WMLA = (size_t)1024 * 512 * 2, SZ_WOUT = (size_t)1024 * 1024 * 2, SZ_WPQ = (size_t)2048 * 1024 * 2, SZ_KEYS = (size_t)16 * 128 * 128 * 2;
constexpr size_t OFF_WCO = SZ_WIN, OFF_WUQ = OFF_WCO + SZ_WCO, OFF_WUKV = OFF_WUQ + SZ_WUQ, OFF_WMLA = OFF_WUKV + SZ_WUKV, OFF_WOUT = OFF_WMLA + SZ_WMLA,
                 OFF_WPQ = OFF_WOUT + SZ_WOUT, OFF_KEYS = OFF_WPQ + SZ_WPQ, SZ_WLAYER = OFF_KEYS + SZ_KEYS;
constexpr size_t WS_TAB = al256(WS_WIN + 2 * SZ_WLAYER);
constexpr size_t SZ_TAB = (size_t)NEXP * 1024;
constexpr float TAB_SCALE = 64.0f, TAB_INV = 1.0f / 64.0f;
constexpr float U_CLIP = 2.7f / 32.0f, U_SCALE = 7.0f / U_CLIP;
constexpr float X_SCALE = 7.0f / 2.7f;
constexpr size_t WS_H = al256(WS_TAB + 4 * SZ_TAB);
constexpr size_t WS_HB = al256(WS_H + (size_t)T * 1024 * 4);
constexpr size_t WS_SSQ = al256(WS_HB + (size_t)T * 1024 * 2);
constexpr size_t WS_UGLU = al256(WS_SSQ + (size_t)T * 8 * 4);
constexpr size_t WS_CQ = al256(WS_UGLU + (size_t)T * 512 * 2);
constexpr size_t WS_CKV = al256(WS_CQ + (size_t)T * 256 * 2);
constexpr size_t WS_KROPE = al256(WS_CKV + (size_t)T * 128 * 2);
constexpr size_t WS_SSQQ = al256(WS_KROPE + (size_t)T * 32 * 4);
constexpr size_t WS_SSQKV = al256(WS_SSQQ + (size_t)T * 2 * 4);
constexpr size_t WS_U2 = al256(WS_SSQKV + (size_t)T * 4);
constexpr size_t WS_Q = al256(WS_U2 + (size_t)T * 512 * 2);
constexpr size_t WS_K = al256(WS_Q + (size_t)T * NH * QK * 2);
constexpr size_t WS_VT = al256(WS_K + (size_t)T * NH * QK * 2);
constexpr size_t WS_O = al256(WS_VT + (size_t)T * NH * VD * 2 + 4096);
constexpr size_t WS_MERGED = al256(WS_O + (size_t)T * 512 * 2);
constexpr size_t WS_GATES = al256(WS_MERGED + (size_t)T * 1024 * 2);
constexpr size_t WS_SV = WS_GATES;
constexpr size_t WS_SI = al256(WS_SV + (size_t)T * 256 * 4);
constexpr size_t WS_EIDX = al256(WS_SI + (size_t)T * 256);
constexpr size_t WS_GW = al256(WS_EIDX + (size_t)T * 128 * 4);
constexpr size_t WS_STB = al256(WS_GW + (size_t)T * 128 * 4);
constexpr size_t WS_PEER_END = WS_STB + (size_t)T * 16;
constexpr size_t WS_END = al256(WS_GATES + (size_t)T * 2048 * 2);
static_assert(WS_PEER_END <= WS_END, "peer scratch overlay");

constexpr int CW_BAR = 0;
constexpr int CW_QUEUE = 4096;

constexpr int LDS_MAIN = 128 * 132 * 4;
constexpr int LDS_MISC = LDS_MAIN;
constexpr int LDS_BYTES = LDS_MAIN + 64;

constexpr int NTHREADS = 256;

__device__ __forceinline__ unsigned pk2(float lo, float hi) { bf16x2 v; v.x = (__bf16)lo; v.y = (__bf16)hi; return __builtin_bit_cast(unsigned, v); }
__device__ __forceinline__ unsigned pack_i8x4(f32x4 v) {
    const int a = (int)__builtin_rintf(fminf(fmaxf(v.x, -127.f), 127.f)), b = (int)__builtin_rintf(fminf(fmaxf(v.y, -127.f), 127.f));
    const int c_ = (int)__builtin_rintf(fminf(fmaxf(v.z, -127.f), 127.f)), d = (int)__builtin_rintf(fminf(fmaxf(v.w, -127.f), 127.f));
    return (unsigned)(a & 255) | ((unsigned)(b & 255) << 8) | ((unsigned)(c_ & 255) << 16) | ((unsigned)(d & 255) << 24);
}
__device__ __forceinline__ unsigned pack_i4x4(f32x4 v) {
    const int a = (int)__builtin_rintf(fminf(fmaxf(v.x, -7.f), 7.f)), b = (int)__builtin_rintf(fminf(fmaxf(v.y, -7.f), 7.f));
    const int c_ = (int)__builtin_rintf(fminf(fmaxf(v.z, -7.f), 7.f)), d = (int)__builtin_rintf(fminf(fmaxf(v.w, -7.f), 7.f));
    return (unsigned)(a & 15) | ((unsigned)(b & 15) << 4) | ((unsigned)(c_ & 15) << 8) | ((unsigned)(d & 15) << 12);
}
__device__ __forceinline__ unsigned short pack_fp4x4(f32x4 v) {
#pragma unroll
    for (int i = 0; i < 4; ++i) v[i] = fminf(fmaxf(v[i], -6.0f), 6.0f);
    unsigned w = __builtin_amdgcn_cvt_scalef32_pk_fp4_f32(0u, v.x, v.y, 1.0f, 0);
    w = __builtin_amdgcn_cvt_scalef32_pk_fp4_f32(w, v.z, v.w, 1.0f, 1);
    return (unsigned short)w;
}
__device__ __forceinline__ float bf_lo(unsigned p) { return __uint_as_float(p << 16); }
__device__ __forceinline__ float bf_hi(unsigned p) { return __uint_as_float(p & 0xffff0000u); }
__device__ __forceinline__ float fast_rcp(float x) { return __builtin_amdgcn_rcpf(x); }
__device__ __forceinline__ float fast_exp2(float x) { return __builtin_amdgcn_exp2f(x); }
__device__ __forceinline__ float sigmoidf_(float x) { return fast_rcp(1.0f + fast_exp2(-1.4426950409f * x)); }
__device__ __forceinline__ float gelu_tanh(float x) { const float u = 1.5957691216f * (x + 0.044715f * x * x * x); return x * fast_rcp(1.0f + fast_exp2(-1.4426950409f * u)); }
__device__ __forceinline__ float rsqrt_(float x) { return __builtin_amdgcn_rsqf(x); }
template <int CTRL> __device__ __forceinline__ float dpp(float x) { return __builtin_bit_cast(float, __builtin_amdgcn_mov_dpp(__builtin_bit_cast(int, x), CTRL, 0xf, 0xf, true)); }
__device__ __forceinline__ float xrow16_sum(float x) {
    auto s = __builtin_amdgcn_permlane16_swap(__float_as_uint(x), __float_as_uint(x), false, false);
    x = __uint_as_float(s[0]) + __uint_as_float(s[1]);
    auto t = __builtin_amdgcn_permlane32_swap(__float_as_uint(x), __float_as_uint(x), false, false);
    return __uint_as_float(t[0]) + __uint_as_float(t[1]);
}
__device__ __forceinline__ float xrow16_max(float x) {
    auto s = __builtin_amdgcn_permlane16_swap(__float_as_uint(x), __float_as_uint(x), false, false);
    x = fmaxf(__uint_as_float(s[0]), __uint_as_float(s[1]));
    auto t = __builtin_amdgcn_permlane32_swap(__float_as_uint(x), __float_as_uint(x), false, false);
    return fmaxf(__uint_as_float(t[0]), __uint_as_float(t[1]));
}
__device__ __forceinline__ float wave_sum_dpp(float x) {
    x += dpp<0xB1>(x); x += dpp<0x4E>(x); x += dpp<0x141>(x); x += dpp<0x128>(x); return xrow16_sum(x);
}
__device__ __forceinline__ float quad_sum(float v) { return xrow16_sum(v); }
__device__ __forceinline__ float quad_max(float v) { return xrow16_max(v); }
__device__ __forceinline__ float wave_sum(float v) { return wave_sum_dpp(v); }
__device__ __forceinline__ float dot2(unsigned a, unsigned b, float c) { return __builtin_amdgcn_fdot2_f32_bf16(__builtin_bit_cast(bf16x2, a), __builtin_bit_cast(bf16x2, b), c, false); }

#define XB_TMO      128
#define XB_XCNT(j)  (256  + 64 * (j))
#define XB_XSUB(j)  (1280 + 64 * (j))
#define XB_XGEN(j)  (2304 + 64 * (j))
#define XB_TOP      3328
#define XB_TOPGEN   3392
#define XCD_BAR_WORDS 3456
#define XB_SPIN_CAP (1u << 20)
__device__ __forceinline__ unsigned xb_ld(unsigned* p)              { return __hip_atomic_load(p, __ATOMIC_RELAXED, __HIP_MEMORY_SCOPE_AGENT); }
__device__ __forceinline__ unsigned xb_add(unsigned* p, unsigned v) { return __hip_atomic_fetch_add(p, v, __ATOMIC_RELAXED, __HIP_MEMORY_SCOPE_AGENT); }
__device__ __forceinline__ unsigned xb_xcc_id() { return (unsigned)__builtin_amdgcn_s_getreg((3 << 11) | 20) & 0xFu; }
#define XB_SPIN(cond, bar) do { unsigned _sp = 0; while (cond) { __builtin_amdgcn_s_sleep(1); \
    if ((++_sp & 255u) == 0u) { if (xb_ld(&(bar)[XB_TMO])) break; if (_sp > XB_SPIN_CAP) { atomicAdd(&(bar)[XB_TMO], 1u); break; } } } } while (0)
struct XcdBarrier { unsigned* bar; unsigned x; volatile unsigned* st; };
__device__ __forceinline__ XcdBarrier xcd_barrier_post(unsigned* bar, volatile unsigned* st) {
    XcdBarrier b; b.bar = bar; b.x = xb_xcc_id(); b.st = st;
    if (threadIdx.x == 0) (void)xb_add(&bar[XB_XCNT(b.x)], 1u);
    return b;
}
__device__ __forceinline__ void xcd_barrier_complete(unsigned* bar, unsigned x, unsigned& nloc, unsigned& nx) {
    const unsigned G = gridDim.x * gridDim.y * gridDim.z;
    unsigned sum, cnt, mine, sp = 0u;
    for (;;) {
        sum = 0u; cnt = 0u; mine = 0u;
#pragma unroll
        for (unsigned j = 0; j < 16; ++j) { const unsigned c = xb_ld(&bar[XB_XCNT(j)]); sum += c; cnt += (c > 0u) ? 1u : 0u; mine = (j == x) ? c : mine; }
        if (sum == G) break;
        __builtin_amdgcn_s_sleep(1);
        if ((++sp & 255u) == 0u) { if (xb_ld(&bar[XB_TMO])) break; if (sp > XB_SPIN_CAP) { atomicAdd(&bar[XB_TMO], 1u); break; } }
    }
    nloc = mine > 0u ? mine : 1u; nx = cnt > 0u ? cnt : 1u;
}
__device__ __forceinline__ void xcd_barrier(const XcdBarrier& b) {
    asm volatile("s_waitcnt vmcnt(0)" ::: "memory");
    __syncthreads();
    if (threadIdx.x == 0) {
        unsigned* bar = b.bar;
        __builtin_amdgcn_s_waitcnt(0);
        unsigned nloc = b.st[0], nx = b.st[1];
        if (nloc == 0u) { xcd_barrier_complete(bar, b.x, nloc, nx); b.st[0] = nloc; b.st[1] = nx; }
        const unsigned old = xb_add(&bar[XB_XSUB(b.x)], 1u);
        const unsigned gen = old / nloc;
        if (old + 1u == (gen + 1u) * nloc) {
            __builtin_amdgcn_fence(__ATOMIC_RELEASE, "agent");
            asm volatile("s_waitcnt vmcnt(0)" ::: "memory");
            const unsigned og = xb_add(&bar[XB_TOP], 1u);
            const unsigned tg = og / nx;
            if (og + 1u == (tg + 1u) * nx) xb_add(&bar[XB_TOPGEN], 1u);
            else XB_SPIN(xb_ld(&bar[XB_TOPGEN]) == tg, bar);
            __builtin_amdgcn_fence(__ATOMIC_ACQUIRE, "agent");
            xb_add(&bar[XB_XGEN(b.x)], 1u);
            asm volatile("s_waitcnt vmcnt(0)" ::: "memory");
        } else {
            XB_SPIN(xb_ld(&bar[XB_XGEN(b.x)]) == gen, bar);
            __builtin_amdgcn_fence(__ATOMIC_ACQUIRE, "agent");
            asm volatile("s_waitcnt vmcnt(0)" ::: "memory");
        }
    }
    __syncthreads();
}

struct Ctx {
    const float* in[22]; float* out; unsigned char* ws;
    unsigned char* lds; int tid, lane, wave, G, vb;
};
#define WSP(T_, off) ((T_*)(c.ws + (off)))
__device__ __forceinline__ Ctx reopaque(const Ctx& c0) {
    Ctx c = c0; int t = c0.tid; asm volatile("" : "+v"(t)); c.tid = t; c.lane = t & 63; c.wave = __builtin_amdgcn_readfirstlane(t >> 6);
    int vb = c0.vb; asm volatile("" : "+s"(vb)); c.vb = vb; return c;
}

__device__ __forceinline__ int lds_off(int row, int chunk) { return row * 128 + ((chunk ^ (row & 7)) << 4); }

__device__ __forceinline__ void gemm_compute_stage(f32x4 (&acc)[2][8], const unsigned char* sA, const unsigned char* sB, int wave, int lane) {
    const int r = lane & 15, q = lane >> 4;
    bf16x8 af[2][2], bfr[2][8];
#pragma unroll
    for (int ks = 0; ks < 2; ++ks) {
#pragma unroll
        for (int mi = 0; mi < 2; ++mi) af[ks][mi] = *(const bf16x8*)(sA + lds_off(32 * wave + 16 * mi + r, 4 * ks + q));
#pragma unroll
        for (int ni = 0; ni < 8; ++ni) bfr[ks][ni] = *(const bf16x8*)(sB + lds_off(16 * ni + r, 4 * ks + q));
    }
#pragma unroll
    for (int ks = 0; ks < 2; ++ks)
#pragma unroll
        for (int ni = 0; ni < 8; ++ni)
#pragma unroll
            for (int mi = 0; mi < 2; ++mi) acc[mi][ni] = __builtin_amdgcn_mfma_f32_16x16x32_bf16(bfr[ks][ni], af[ks][mi], acc[mi][ni], 0, 0, 0);
    __builtin_amdgcn_sched_group_barrier(0x100, 6, 0);
#pragma unroll
    for (int i = 0; i < 14; ++i) { __builtin_amdgcn_sched_group_barrier(0x8, 2, 0); __builtin_amdgcn_sched_group_barrier(0x100, 1, 0); }
    __builtin_amdgcn_sched_group_barrier(0x8, 4, 0);
}

#define LAS __attribute__((address_space(3)))
__device__ __forceinline__ void gemm_stage_glds(const bf16* A, int lda, const bf16* Bt, int ldb, int kt, unsigned char* stage, int wave, int lane) {
    const int rr = lane >> 3, cch = (lane & 7) ^ rr;
#pragma unroll
    for (int i = 0; i < 4; ++i) { const int pc = 4 * i + wave;
        __builtin_amdgcn_global_load_lds((const unsigned*)(A + (size_t)(8 * pc + rr) * lda + kt * 64 + cch * 8), (LAS unsigned*)(stage + pc * 1024), 16, 0, 0);
        __builtin_amdgcn_global_load_lds((const unsigned*)(Bt + (size_t)(8 * pc + rr) * ldb + kt * 64 + cch * 8), (LAS unsigned*)(stage + 16384 + pc * 1024), 16, 0, 0); }
}
__device__ __forceinline__ void gemm_core(f32x4 (&acc)[2][8], const bf16* A, int lda, const bf16* Bt, int ldb, int K, unsigned char* lds, int tid) {
    const int wave = __builtin_amdgcn_readfirstlane(tid >> 6), lane = tid & 63;
    const int nk = K >> 6;
    gemm_stage_glds(A, lda, Bt, ldb, 0, lds, wave, lane);
    asm volatile("s_waitcnt vmcnt(0)" ::: "memory");
    __syncthreads();
    for (int kt = 0; kt < nk; ++kt) {
        const int cur = kt & 1;
        if (kt + 1 < nk) gemm_stage_glds(A, lda, Bt, ldb, kt + 1, lds + (cur ^ 1) * 32768, wave, lane);
        gemm_compute_stage(acc, lds + cur * 32768, lds + cur * 32768 + 16384, wave, lane);
        asm volatile("s_waitcnt vmcnt(0)" ::: "memory");
        __syncthreads();
    }
}
__device__ __forceinline__ void acc_zero(f32x4 (&acc)[2][8]) {
#pragma unroll
    for (int mi = 0; mi < 2; ++mi)
#pragma unroll
        for (int ni = 0; ni < 8; ++ni) acc[mi][ni] = (f32x4){0.f, 0.f, 0.f, 0.f};
}
__device__ __forceinline__ float rstd_from_ssq8(const float* ssq, int tok) {
    const f32x4 a = *(const f32x4*)(ssq + (size_t)tok * 8), b = *(const f32x4*)(ssq + (size_t)tok * 8 + 4);
    const float s = ((a.x + a.y) + (a.z + a.w)) + ((b.x + b.y) + (b.z + b.w));
    return rsqrt_(s * (1.0f / 1024.0f) + EPS);
}

__device__ __forceinline__ int src_col(int mode, int np) {
    if (mode == 0) return np;
    if (mode == 2) { const int h = np >> 7, j = np & 127; return j < 96 ? h * 96 + j : -1; }
    if (np < 1024) { const int cblk = np >> 7, j = np & 127; return j < 64 ? 64 * cblk + j : 512 + 64 * cblk + (j - 64); }
    if (np < 1408) return np;
    if (np < 1536) { const int j = np - 1408; return j < 32 ? 1408 + j : -1; }
    return 1440 + (np - 1536);
}
__device__ __forceinline__ void p0_transpose_item(const float* W, int K, int N, bf16* Wt, int mode, const float* g, int item, float* scr, int lane) {
    const int nblk_k = K / 64, nb = item / nblk_k, kb = item % nblk_k, k0 = 64 * kb, n0 = 32 * nb;
    const int n = src_col(mode, n0 + (lane & 31));
    float wv[32], gv[32];
#pragma unroll
    for (int i = 0; i < 32; ++i) { const int kk = 2 * i + (lane >> 5); wv[i] = n >= 0 ? W[(size_t)(k0 + kk) * N + n] : 0.f; gv[i] = g ? g[k0 + kk] : 1.f; }
#pragma unroll
    for (int i = 0; i < 32; ++i) { const int kk = 2 * i + (lane >> 5); scr[kk * 33 + (lane & 31)] = wv[i] * gv[i]; }
    __builtin_amdgcn_s_waitcnt(0xC07F); asm volatile("" ::: "memory");
    const int cch = lane & 7;
#pragma unroll
    for (int j = 0; j < 4; ++j) { const int nl = (lane >> 3) + 8 * j; const float* s = scr + (8 * cch) * 33 + nl;
        u32x4 o; o.x = pk2(s[0 * 33], s[1 * 33]); o.y = pk2(s[2 * 33], s[3 * 33]); o.z = pk2(s[4 * 33], s[5 * 33]); o.w = pk2(s[6 * 33], s[7 * 33]);
        *(u32x4*)(Wt + (size_t)(n0 + nl) * K + k0 + 8 * cch) = o; }
    __builtin_amdgcn_s_waitcnt(0xC07F); asm volatile("" ::: "memory");
}
struct WDesc { int in_idx, K, N, Np, mode, g_idx; size_t off; };
__device__ __forceinline__ void phase_prologue(const Ctx& c0) {
    Ctx c = reopaque(c0);
    const int gw = c.vb * 4 + c.wave, NGW = c.G * 4;
    float* scr = (float*)(c.lds + c.wave * 8704);
    const WDesc wd[7] = {
        {3, 1024, NIN, NINP, 1, 2, 0}, {8, 512, 1024, 1024, 0, -1, OFF_WCO}, {10, 256, 768, 1024, 2, 9, OFF_WUQ}, {12, 128, 1024, 1024, 0, 11, OFF_WUKV},
        {15, 512, 1024, 1024, 0, -1, OFF_WMLA}, {16, 1024, 1024, 1024, 0, -1, OFF_WOUT}, {18, 1024, 2048, 2048, 0, 17, OFF_WPQ}};
    constexpr int ITEMS_PER_LAYER = (1024 / 64) * (NINP / 32) + (512 / 64) * 32 + (256 / 64) * 32 + (128 / 64) * 32 + (512 / 64) * 32 + (1024 / 64) * 32 + (1024 / 64) * 64;
    for (int it = gw; it < 2 * ITEMS_PER_LAYER; it += NGW) {
        const int l = it >= ITEMS_PER_LAYER ? 1 : 0; int r = it - l * ITEMS_PER_LAYER;
        const float* W = nullptr; const float* g = nullptr; bf16* Wt = nullptr; int K = 64, N = 32, mode = 0, rr = 0;
#pragma unroll
        for (int m = 0; m < 7; ++m) {
            const int items = (wd[m].K / 64) * (wd[m].Np / 32);
            if (r >= 0 && r < items) { K = wd[m].K; N = wd[m].N; mode = wd[m].mode; rr = r;
                W = c.in[wd[m].in_idx] + (size_t)l * wd[m].K * wd[m].N; g = wd[m].g_idx >= 0 ? c.in[wd[m].g_idx >= 0 ? wd[m].g_idx : 0] + (size_t)l * wd[m].K : nullptr;
                Wt = (bf16*)(c.ws + WS_WIN + l * SZ_WLAYER + wd[m].off); }
            r -= items;
        }
        p0_transpose_item(W, K, N, Wt, mode, g, rr, scr, c.lane);
    }
    const int gt = c.vb * NTHREADS + c.tid, NGT = c.G * NTHREADS;
    for (int l = 0; l < 2; ++l) {
        const float* src = c.in[19] + (size_t)l * 262144; bf16* dst = (bf16*)(c.ws + WS_WIN + l * SZ_WLAYER + OFF_KEYS);
        for (int i = gt; i < 262144 / 8; i += NGT) { const f32x4 a = *(const f32x4*)(src + i * 8), b = *(const f32x4*)(src + i * 8 + 4);
            u32x4 o; o.x = pk2(a.x, a.y); o.y = pk2(a.z, a.w); o.z = pk2(b.x, b.y); o.w = pk2(b.z, b.w); *(u32x4*)(dst + i * 8) = o; }
    }
    for (int l = 0; l < 2; ++l)
        for (int uv = 0; uv < 2; ++uv) {
            const float* src = c.in[20 + uv] + (size_t)l * NEXP * 1024; unsigned char* dst = c.ws + WS_TAB + (size_t)(l * 2) * SZ_TAB + 8 * uv;
            f32x4 g4[4];
#pragma unroll
            for (int j = 0; j < 4; ++j) { const float sc = uv == 0 ? U_SCALE : TAB_SCALE; g4[j] = (f32x4){sc, sc, sc, sc}; if (uv == 0) g4[j] = g4[j] * *(const f32x4*)(c.in[17] + l * 1024 + 256 * j + 4 * c.lane); }
            for (int row = gw; row < NEXP; row += 2 * NGW) {
                const float* sp = src + (size_t)row * 1024 + 4 * c.lane; const int row2 = row + NGW; const bool two = row2 < NEXP;
                const float* sp2 = src + (size_t)(two ? row2 : row) * 1024 + 4 * c.lane;
                f32x4 a[4], b[4];
#pragma unroll
                for (int j = 0; j < 4; ++j) { a[j] = *(const f32x4*)(sp + 256 * j); b[j] = *(const f32x4*)(sp2 + 256 * j); }
#pragma unroll
                for (int j = 0; j < 4; ++j) { const f32x4 v = a[j] * g4[j];
                    if (uv == 0) *(unsigned short*)(dst + (size_t)row * 1024 + 256 * j + 16 * (c.lane >> 2) + 2 * (c.lane & 3)) = (unsigned short)pack_i4x4(v);
                    else *(unsigned short*)(dst + (size_t)row * 1024 + 256 * j + 16 * (c.lane >> 2) + 2 * (c.lane & 3)) = pack_fp4x4(v); }
                if (two) {
#pragma unroll
                    for (int j = 0; j < 4; ++j) { const f32x4 v = b[j] * g4[j];
                        if (uv == 0) *(unsigned short*)(dst + (size_t)row2 * 1024 + 256 * j + 16 * (c.lane >> 2) + 2 * (c.lane & 3)) = (unsigned short)pack_i4x4(v);
                        else *(unsigned short*)(dst + (size_t)row2 * 1024 + 256 * j + 16 * (c.lane >> 2) + 2 * (c.lane & 3)) = pack_fp4x4(v); } }
            }
        }
    { float* rope = WSP(float, WS_ROPE);
      for (int i = gt; i < L * 16; i += NGT) { const int pos = i >> 4, j = i & 15;
          const float inv = 1.0f / __builtin_exp2f((float)j * 0.8304820237218406f);
          const float angf = (float)pos * inv; const double ang = (double)angf;
          const double nq = __builtin_rint(ang * 0.63661977236758134308);
          double rr = __builtin_fma(-nq, 1.57079632679489655800e+00, ang); rr = __builtin_fma(-nq, 6.12323399573676603587e-17, rr);
          const double r2 = rr * rr;
          double sp = -1.0 / 1307674368000.0; sp = sp * r2 + 1.0 / 6227020800.0; sp = sp * r2 - 1.0 / 39916800.0; sp = sp * r2 + 1.0 / 362880.0; sp = sp * r2 - 1.0 / 5040.0; sp = sp * r2 + 1.0 / 120.0; sp = sp * r2 - 1.0 / 6.0; sp = sp * r2 * rr + rr;
          double cp = 1.0 / 87178291200.0; cp = cp * r2 - 1.0 / 479001600.0; cp = cp * r2 + 1.0 / 3628800.0; cp = cp * r2 - 1.0 / 40320.0; cp = cp * r2 + 1.0 / 720.0; cp = cp * r2 - 1.0 / 24.0; cp = cp * r2 + 0.5; cp = 1.0 - cp * r2;
          const int qd = ((int)nq) & 3;
          const double cv = qd == 0 ? cp : qd == 1 ? -sp : qd == 2 ? -cp : sp;
          const double sv_ = qd == 0 ? sp : qd == 1 ? cp : qd == 2 ? -sp : -cp;
          rope[2 * i] = (float)cv; rope[2 * i + 1] = (float)sv_; } }
    { bf16* hb = WSP(bf16, WS_HB); float* ssq = WSP(float, WS_SSQ);
      for (int t0_ = gw; t0_ < T; t0_ += 4 * NGW) {
          f32x4 v[4][4];
#pragma unroll
          for (int i = 0; i < 4; ++i) { const int t = t0_ + i * NGW < T ? t0_ + i * NGW : t0_; const int b = t / L, pos = t % L;
              const float* src = pos < NMETA ? c.in[1] + (size_t)pos * D : c.in[0] + ((size_t)b * SEQ + (pos - NMETA)) * D;
#pragma unroll
              for (int j = 0; j < 4; ++j) v[i][j] = *(const f32x4*)(src + j * 256 + c.lane * 4); }
#pragma unroll
          for (int i = 0; i < 4; ++i) { const int t = t0_ + i * NGW;
              if (t < T) { float s = 0.f;
#pragma unroll
                  for (int j = 0; j < 4; ++j) { const f32x4 x = v[i][j]; u32x2 o; o.x = pk2(x.x, x.y); o.y = pk2(x.z, x.w); *(u32x2*)(hb + (size_t)t * D + j * 256 + c.lane * 4) = o;
                      s += (x.x * x.x + x.y * x.y) + (x.z * x.z + x.w * x.w); }
                  s = wave_sum(s);
                  if (c.lane < 8) ssq[(size_t)t * 8 + c.lane] = c.lane == 0 ? s : 0.f; } }
      } }
}

__device__ __forceinline__ void phase_A(const Ctx& c0, int l) {
    Ctx c = reopaque(c0);
    const bf16* hb = WSP(bf16, WS_HB); const bf16* Wt = (const bf16*)(c.ws + WS_WIN + l * SZ_WLAYER);
    const float* ssq = WSP(float, WS_SSQ);
    bf16* uglu = WSP(bf16, WS_UGLU); bf16* cq = WSP(bf16, WS_CQ); bf16* ckv = WSP(bf16, WS_CKV); float* krope = WSP(float, WS_KROPE);
    float* ssqq = WSP(float, WS_SSQQ); float* ssqkv = WSP(float, WS_SSQKV); bf16* gates = WSP(bf16, WS_GATES);
    constexpr int NT = NINP / 128;
    const int r = c.lane & 15, q = c.lane >> 4;
    const int xcd = c.vb / (c.G / 8), lb = c.vb % (c.G / 8), xm = xcd & 1, xn = xcd >> 1;
    const int m_lo = xm ? (MT + 1) / 2 : 0, m_cnt = xm ? MT / 2 : (MT + 1) / 2;
    for (int j = lb; j < m_cnt * 7; j += c.G / 8) {
        const int mt = m_lo + j / 7, nt = xn * 7 + j % 7;
        f32x4 acc[2][8]; acc_zero(acc);
        gemm_core(acc, hb + (size_t)mt * 128 * D, D, Wt + (size_t)nt * 128 * D, D, D, c.lds, c.tid);
#pragma unroll
        for (int mi = 0; mi < 2; ++mi) {
            const int tok = mt * 128 + 32 * c.wave + 16 * mi + r;
            const float rs = rstd_from_ssq8(ssq, tok);
            if (nt < 8) {
#pragma unroll
                for (int ni = 0; ni < 4; ++ni) { const f32x4 v = acc[mi][ni] * rs, g = acc[mi][ni + 4] * rs;
                    u32x2 o; o.x = pk2(v.x * sigmoidf_(g.x), v.y * sigmoidf_(g.y)); o.y = pk2(v.z * sigmoidf_(g.z), v.w * sigmoidf_(g.w));
                    *(u32x2*)(uglu + (size_t)tok * DC + nt * 64 + 16 * ni + 4 * q) = o; }
            } else if (nt < 11) {
                bf16* dst = nt < 10 ? cq + (size_t)tok * QL + (nt - 8) * 128 : ckv + (size_t)tok * KVL;
                float ss = 0.f;
#pragma unroll
                for (int ni = 0; ni < 8; ++ni) { const f32x4 v = acc[mi][ni] * rs; ss += (v.x * v.x + v.y * v.y) + (v.z * v.z + v.w * v.w);
                    u32x2 o; o.x = pk2(v.x, v.y); o.y = pk2(v.z, v.w); *(u32x2*)(dst + 16 * ni + 4 * q) = o; }
                ss = quad_sum(ss);
                if (q == 0) { if (nt < 10) ssqq[(size_t)tok * 2 + (nt - 8)] = ss; else ssqkv[tok] = ss; }
            } else if (nt == 11) {
#pragma unroll
                for (int ni = 0; ni < 2; ++ni) *(f32x4*)(krope + (size_t)tok * 32 + 16 * ni + 4 * q) = acc[mi][ni] * rs;
            } else {
#pragma unroll
                for (int ni = 0; ni < 8; ++ni) { const f32x4 v = acc[mi][ni] * rs;
                    u32x2 o; o.x = pk2(sigmoidf_(v.x), sigmoidf_(v.y)); o.y = pk2(sigmoidf_(v.z), sigmoidf_(v.w));
                    *(u32x2*)(gates + (size_t)tok * 2048 + (nt - 12) * 128 + 16 * ni + 4 * q) = o; }
            }
        }
    }
}

__device__ __forceinline__ void phaseB_q_item(Ctx& c, int l, int mt, int head) {
    const bf16* cq = WSP(bf16, WS_CQ); const bf16* Wt = (const bf16*)(c.ws + WS_WIN + l * SZ_WLAYER + OFF_WUQ);
    const float* ssqq = WSP(float, WS_SSQQ); const float* rope = WSP(float, WS_ROPE); const float* qg = c.in[13] + l * QK; bf16* Qb = WSP(bf16, WS_Q);
    const int r = c.lane & 15, q = c.lane >> 4;
    f32x4 acc[2][8]; acc_zero(acc);
    gemm_core(acc, cq + (size_t)mt * 128 * QL, QL, Wt + (size_t)head * 128 * QL, QL, QL, c.lds, c.tid);
    constexpr float QSCALE = 0.10206207261596575f * 1.4426950408889634f;
#pragma unroll
    for (int mi = 0; mi < 2; ++mi) {
        const int tok = mt * 128 + 32 * c.wave + 16 * mi + r, b = tok / L, pos = tok - b * L;
        const float rs = rsqrt_((ssqq[(size_t)tok * 2] + ssqq[(size_t)tok * 2 + 1]) * (1.0f / 256.0f) + EPS);
        float ss = 0.f;
#pragma unroll
        for (int ni = 0; ni < 6; ++ni) { acc[mi][ni] = acc[mi][ni] * rs; const f32x4 v = acc[mi][ni]; ss += (v.x * v.x + v.y * v.y) + (v.z * v.z + v.w * v.w); }
        ss = quad_sum(ss);
        const float rn = rsqrt_(ss * (1.0f / 96.0f) + EPS) * QSCALE;
#pragma unroll
        for (int ni = 0; ni < 6; ++ni) { const f32x4 g = *(const f32x4*)(qg + 16 * ni + 4 * q); acc[mi][ni] = acc[mi][ni] * g * rn; }
        const f32x4 cs0 = *(const f32x4*)(rope + ((size_t)pos * 16 + 4 * q) * 2), cs1 = *(const f32x4*)(rope + ((size_t)pos * 16 + 4 * q) * 2 + 4);
        const float co[4] = {cs0.x, cs0.z, cs1.x, cs1.z}, si[4] = {cs0.y, cs0.w, cs1.y, cs1.w};
        f32x4 x1 = acc[mi][4], x2 = acc[mi][5];
#pragma unroll
        for (int e = 0; e < 4; ++e) { const float a = x1[e], bb = x2[e]; x1[e] = a * co[e] - bb * si[e]; x2[e] = bb * co[e] + a * si[e]; }
        acc[mi][4] = x1; acc[mi][5] = x2;
        bf16* dst = Qb + (((size_t)b * NH + head) * L + pos) * QK;
#pragma unroll
        for (int ni = 0; ni < 6; ++ni) { const f32x4 v = acc[mi][ni]; u32x2 o; o.x = pk2(v.x, v.y); o.y = pk2(v.z, v.w); *(u32x2*)(dst + 16 * ni + 4 * q) = o; }
    }
}
__device__ __forceinline__ void phaseB_kv_item(Ctx& c, int l, int mt, int head) {
    const bf16* ckv = WSP(bf16, WS_CKV); const bf16* Wt = (const bf16*)(c.ws + WS_WIN + l * SZ_WLAYER + OFF_WUKV);
    const float* ssqkv = WSP(float, WS_SSQKV); const float* rope = WSP(float, WS_ROPE); const float* kg = c.in[14] + l * QK; const float* krope = WSP(float, WS_KROPE);
    bf16* Kb = WSP(bf16, WS_K); bf16* Vt = WSP(bf16, WS_VT);
    const int tid = c.tid, wave = c.wave, lane = c.lane, r = lane & 15, q = lane >> 4;
    unsigned char* lds = c.lds;
    f32x4 ak[2][4], av[2][4];
#pragma unroll
    for (int mi = 0; mi < 2; ++mi)
#pragma unroll
        for (int ni = 0; ni < 4; ++ni) { ak[mi][ni] = (f32x4){0.f, 0.f, 0.f, 0.f}; av[mi][ni] = (f32x4){0.f, 0.f, 0.f, 0.f}; }
    { const int chunk = tid & 7, row0 = tid >> 3;
      const bf16* pa = ckv + ((size_t)mt * 128 + row0) * KVL + chunk * 8; const bf16* pb = Wt + ((size_t)head * 128 + row0) * KVL + chunk * 8;
#pragma unroll
      for (int s = 0; s < 2; ++s)
#pragma unroll
          for (int i = 0; i < 4; ++i) { *(u32x4*)(lds + s * 32768 + lds_off(row0 + 32 * i, chunk)) = *(const u32x4*)(pa + (size_t)(32 * i) * KVL + s * 64);
              *(u32x4*)(lds + s * 32768 + 16384 + lds_off(row0 + 32 * i, chunk)) = *(const u32x4*)(pb + (size_t)(32 * i) * KVL + s * 64); }
    }
    __syncthreads();
#pragma unroll
    for (int s = 0; s < 2; ++s)
#pragma unroll
        for (int ks = 0; ks < 2; ++ks) {
            const unsigned char* sA = lds + s * 32768; const unsigned char* sB = sA + 16384;
            bf16x8 af[2], bfr[8];
#pragma unroll
            for (int mi = 0; mi < 2; ++mi) af[mi] = *(const bf16x8*)(sA + lds_off(32 * wave + 16 * mi + r, 4 * ks + q));
#pragma unroll
            for (int ni = 0; ni < 8; ++ni) bfr[ni] = *(const bf16x8*)(sB + lds_off(16 * ni + r, 4 * ks + q));
#pragma unroll
            for (int mi = 0; mi < 2; ++mi)
#pragma unroll
                for (int ni = 0; ni < 4; ++ni) { ak[mi][ni] = __builtin_amdgcn_mfma_f32_16x16x32_bf16(bfr[ni], af[mi], ak[mi][ni], 0, 0, 0);
                    av[mi][ni] = __builtin_amdgcn_mfma_f32_16x16x32_bf16(af[mi], bfr[ni + 4], av[mi][ni], 0, 0, 0); }
        }
    __syncthreads();
#pragma unroll
    for (int mi = 0; mi < 2; ++mi) {
        const int tok0 = mt * 128 + 32 * wave + 16 * mi, b = tok0 / L, pos0 = tok0 - b * L;
        { const int tok = tok0 + r, pos = pos0 + r;
          const float rs = rsqrt_(ssqkv[tok] * (1.0f / 128.0f) + EPS);
          const f32x4 kr1 = *(const f32x4*)(krope + (size_t)tok * 32 + 4 * q), kr2 = *(const f32x4*)(krope + (size_t)tok * 32 + 16 + 4 * q);
          float ss = (kr1.x * kr1.x + kr1.y * kr1.y) + (kr1.z * kr1.z + kr1.w * kr1.w) + (kr2.x * kr2.x + kr2.y * kr2.y) + (kr2.z * kr2.z + kr2.w * kr2.w);
#pragma unroll
          for (int ni = 0; ni < 4; ++ni) { ak[mi][ni] = ak[mi][ni] * rs; const f32x4 v = ak[mi][ni]; ss += (v.x * v.x + v.y * v.y) + (v.z * v.z + v.w * v.w); }
          ss = quad_sum(ss);
          const float rn = rsqrt_(ss * (1.0f / 96.0f) + EPS);
          bf16* dst = Kb + (((size_t)b * NH + head) * L + pos) * QK;
#pragma unroll
          for (int ni = 0; ni < 4; ++ni) { const f32x4 g = *(const f32x4*)(kg + 16 * ni + 4 * q); const f32x4 v = ak[mi][ni] * g * rn;
              u32x2 o; o.x = pk2(v.x, v.y); o.y = pk2(v.z, v.w); *(u32x2*)(dst + 16 * ni + 4 * q) = o; }
          const f32x4 g1 = *(const f32x4*)(kg + 64 + 4 * q), g2 = *(const f32x4*)(kg + 80 + 4 * q);
          f32x4 x1 = kr1 * g1 * rn, x2 = kr2 * g2 * rn;
          const f32x4 cs0 = *(const f32x4*)(rope + ((size_t)pos * 16 + 4 * q) * 2), cs1 = *(const f32x4*)(rope + ((size_t)pos * 16 + 4 * q) * 2 + 4);
          const float co[4] = {cs0.x, cs0.z, cs1.x, cs1.z}, si[4] = {cs0.y, cs0.w, cs1.y, cs1.w};
#pragma unroll
          for (int e = 0; e < 4; ++e) { const float a = x1[e], bb = x2[e]; x1[e] = a * co[e] - bb * si[e]; x2[e] = bb * co[e] + a * si[e]; }
          u32x2 o1, o2; o1.x = pk2(x1.x, x1.y); o1.y = pk2(x1.z, x1.w); o2.x = pk2(x2.x, x2.y); o2.y = pk2(x2.z, x2.w);
          *(u32x2*)(dst + 64 + 4 * q) = o1; *(u32x2*)(dst + 80 + 4 * q) = o2; }
        { const f32x4 sq = *(const f32x4*)(ssqkv + tok0 + 4 * q);
          f32x4 rs4; rs4.x = rsqrt_(sq.x * (1.0f / 128.0f) + EPS); rs4.y = rsqrt_(sq.y * (1.0f / 128.0f) + EPS); rs4.z = rsqrt_(sq.z * (1.0f / 128.0f) + EPS); rs4.w = rsqrt_(sq.w * (1.0f / 128.0f) + EPS);
#pragma unroll
          for (int ni = 0; ni < 4; ++ni) { const f32x4 v = av[mi][ni] * rs4; u32x2 o; o.x = pk2(v.x, v.y); o.y = pk2(v.z, v.w);
              *(u32x2*)(Vt + (((size_t)b * NH + head) * VD + 16 * ni + r) * L + pos0 + 4 * q) = o; } }
    }
}
__device__ __forceinline__ u32x4 conv_row(const bf16* uglu, int b, int pos, int ch) {
    u32x4 xv = (u32x4){0u, 0u, 0u, 0u};
    if (pos >= 0) xv = *(const u32x4*)(uglu + ((size_t)b * L + pos) * DC + ch);
    return xv;
}
__device__ __forceinline__ void conv_fma(float (&a)[8], const u32x4 xv, const f32x4 w0, const f32x4 w1) {
    a[0] += bf_lo(xv.x) * w0.x; a[1] += bf_hi(xv.x) * w0.y; a[2] += bf_lo(xv.y) * w0.z; a[3] += bf_hi(xv.y) * w0.w;
    a[4] += bf_lo(xv.z) * w1.x; a[5] += bf_hi(xv.z) * w1.y; a[6] += bf_lo(xv.w) * w1.z; a[7] += bf_hi(xv.w) * w1.w;
}
__device__ __forceinline__ void phaseB_conv_item(Ctx& c, int l, int grp) {
    const bf16* uglu = WSP(bf16, WS_UGLU); bf16* u2 = WSP(bf16, WS_U2);
    const float* cw = c.in[4] + (size_t)l * CW * DC; const float* cb = c.in[5] + l * DC; const float* lg = c.in[6] + l * DC; const float* lb = c.in[7] + l * DC;
    const int tok0 = grp * 4, b = tok0 / L, pos0 = tok0 - b * L, ch = c.lane * 8;
    float acc[4][8];
    { const f32x4 b0 = *(const f32x4*)(cb + ch), b1 = *(const f32x4*)(cb + ch + 4);
#pragma unroll
      for (int d = 0; d < 4; ++d) { acc[d][0] = b0.x; acc[d][1] = b0.y; acc[d][2] = b0.z; acc[d][3] = b0.w; acc[d][4] = b1.x; acc[d][5] = b1.y; acc[d][6] = b1.z; acc[d][7] = b1.w; } }
    const int base = pos0 - 30;
    u32x4 R[8];
#pragma unroll
    for (int k = 0; k < 5; ++k) R[k] = conv_row(uglu, b, base + k, ch);
    const float* wp = cw + ch;
    f32x4 WT[4][2];
#pragma unroll
    for (int k = 0; k < 4; ++k) { WT[k][0] = *(const f32x4*)(wp + (size_t)k * DC); WT[k][1] = *(const f32x4*)(wp + (size_t)k * DC + 4); }
#pragma unroll 1
    for (int w8 = 0; w8 < 32; w8 += 8) {
#pragma unroll
        for (int k = 0; k < 8; ++k) { const int w = w8 + k;
            R[(k + 5) & 7] = conv_row(uglu, b, (w + 5 <= 33) ? base + w + 5 : -1, ch);
            const f32x4 w0 = WT[k & 3][0], w1 = WT[k & 3][1];
            conv_fma(acc[0], R[k & 7], w0, w1); conv_fma(acc[1], R[(k + 1) & 7], w0, w1); conv_fma(acc[2], R[(k + 2) & 7], w0, w1); conv_fma(acc[3], R[(k + 3) & 7], w0, w1);
            const bool more = w + 4 < CW; const float* wn = wp + (size_t)(more ? w + 4 : 0) * DC;
            f32x4 p0 = *(const f32x4*)wn, p1 = *(const f32x4*)(wn + 4);
            if (!more) { p0 = (f32x4){0.f, 0.f, 0.f, 0.f}; p1 = p0; }
            WT[k & 3][0] = p0; WT[k & 3][1] = p1; }
    }
    const f32x4 g0 = *(const f32x4*)(lg + ch), g1 = *(const f32x4*)(lg + ch + 4), e0 = *(const f32x4*)(lb + ch), e1 = *(const f32x4*)(lb + ch + 4);
    const float gg[8] = {g0.x, g0.y, g0.z, g0.w, g1.x, g1.y, g1.z, g1.w}, be[8] = {e0.x, e0.y, e0.z, e0.w, e1.x, e1.y, e1.z, e1.w};
#pragma unroll
    for (int d = 0; d < 4; ++d) {
        float s = 0.f;
#pragma unroll
        for (int j = 0; j < 8; ++j) s += acc[d][j];
        const float mu = wave_sum(s) * (1.0f / 512.0f);
        float vq = 0.f;
#pragma unroll
        for (int j = 0; j < 8; ++j) { acc[d][j] -= mu; vq += acc[d][j] * acc[d][j]; }
        const float rstd = rsqrt_(wave_sum(vq) * (1.0f / 512.0f) + EPS);
        float y[8];
#pragma unroll
        for (int j = 0; j < 8; ++j) { const float v = acc[d][j] * rstd * gg[j] + be[j]; y[j] = v * sigmoidf_(v); }
        u32x4 o; o.x = pk2(y[0], y[1]); o.y = pk2(y[2], y[3]); o.z = pk2(y[4], y[5]); o.w = pk2(y[6], y[7]);
        *(u32x4*)(u2 + (size_t)(tok0 + d) * DC + ch) = o;
    }
}
__device__ __forceinline__ void phase_B(const Ctx& c0, int l) {
    Ctx c = reopaque(c0);
    constexpr int NQ = MT * NH, NKV = MT * NH, NCV = T / 16;
    for (int it = c.vb; it < NQ + NKV + NCV; it += c.G) {
        if (it < NQ) phaseB_q_item(c, l, it / NH, it % NH);
        else if (it < NQ + NKV) phaseB_kv_item(c, l, (it - NQ) / NH, (it - NQ) % NH);
        else phaseB_conv_item(c, l, (it - NQ - NKV) * 4 + c.wave);
    }
}

constexpr int KROW = 208, VROW = 136, ATT_STAGE = 64 * KROW + 64 * VROW;
constexpr int ATT_ITEMS = NB * NH * 17;
__device__ __forceinline__ void phase_C(const Ctx& c0, int l) {
    Ctx c = reopaque(c0);
    const bf16* Qb = WSP(bf16, WS_Q); const bf16* Kb = WSP(bf16, WS_K); const bf16* Vt = WSP(bf16, WS_VT); bf16* O = WSP(bf16, WS_O);
    unsigned* qctr = WSP(unsigned, WS_CTL) + CW_QUEUE + 64 * l;
    volatile unsigned* misc = (volatile unsigned*)(c.lds + LDS_MISC);
    const int tid = c.tid, wave = c.wave, lane = c.lane, r = lane & 15, q = lane >> 4;
    unsigned char* lds = c.lds;
    for (;;) {
        if (tid == 0) misc[4] = atomicAdd(qctr, 1u);
        __syncthreads();
        const int item = __builtin_amdgcn_readfirstlane((int)misc[4]);
        __syncthreads();
        if (item >= ATT_ITEMS) break;
        const int pp = 15 - item / 64, bh = item % 64, b = bh / NH, h = bh % NH;
        const bool meta = pp < 0;
        const int r0 = meta ? 0 : 16 + 128 * pp;
        const int nfull = meta ? 0 : 2 * pp + 1 + (wave >> 1);
        const int ntiles = meta ? 1 : 2 * pp + 3;
        const bf16* Kbase = Kb + (size_t)bh * L * QK; const bf16* Vbase = Vt + (size_t)bh * VD * L;
        bf16x8 qf[2][3];
#pragma unroll
        for (int mi = 0; mi < 2; ++mi)
#pragma unroll
            for (int ks = 0; ks < 3; ++ks) qf[mi][ks] = *(const bf16x8*)(Qb + ((size_t)bh * L + r0 + 32 * wave + 16 * mi + r) * QK + 32 * ks + 8 * q);
        float m[2] = {-1e30f, -1e30f}, lsum[2] = {0.f, 0.f};
        f32x4 o[2][4];
#pragma unroll
        for (int mi = 0; mi < 2; ++mi)
#pragma unroll
            for (int dt = 0; dt < 4; ++dt) o[mi][dt] = (f32x4){0.f, 0.f, 0.f, 0.f};
        u32x4 rk[3], rv[2];
        auto gload = [&](int kt) {
#pragma unroll
            for (int i = 0; i < 3; ++i) { const int id = tid + 256 * i, row = id / 12, cc = id % 12; rk[i] = *(const u32x4*)(Kbase + (size_t)(kt * 64 + row) * QK + cc * 8); }
#pragma unroll
            for (int i = 0; i < 2; ++i) { const int id = tid + 256 * i, row = id >> 3, cc = id & 7; rv[i] = *(const u32x4*)(Vbase + (size_t)row * L + kt * 64 + cc * 8); }
        };
        auto lstore = [&](int s) {
            unsigned char* st = lds + s * ATT_STAGE;
#pragma unroll
            for (int i = 0; i < 3; ++i) { const int id = tid + 256 * i, row = id / 12, cc = id % 12; *(u32x4*)(st + row * KROW + cc * 16) = rk[i]; }
#pragma unroll
            for (int i = 0; i < 2; ++i) { const int id = tid + 256 * i, row = id >> 3, cc = id & 7; u32x2* d = (u32x2*)(st + 64 * KROW + row * VROW + cc * 16); d[0] = (u32x2){rv[i].x, rv[i].y}; d[1] = (u32x2){rv[i].z, rv[i].w}; }
        };
        gload(0); lstore(0);
#pragma unroll
        for (int mi = 0; mi < 2; ++mi)
#pragma unroll
            for (int ks = 0; ks < 3; ++ks) asm volatile("" : "+v"(qf[mi][ks]));
        __syncthreads();
        for (int kt = 0; kt < ntiles; ++kt) {
            const int cur = kt & 1;
            if (kt + 1 < ntiles) gload(kt + 1);
            const unsigned char* sK = lds + cur * ATT_STAGE; const unsigned char* sV = sK + 64 * KROW;
            const bool full = kt < nfull;
            if (kt <= nfull) {
                f32x4 s[2][4];
#pragma unroll
                for (int kh = 0; kh < 2; ++kh) {
                    bf16x8 kf[2][3];
#pragma unroll
                    for (int kk = 0; kk < 2; ++kk) if ((kh == 0 && kk == 0) || full) {
#pragma unroll
                        for (int ks = 0; ks < 3; ++ks) kf[kk][ks] = *(const bf16x8*)(sK + (16 * (2 * kh + kk) + r) * KROW + 64 * ks + 16 * q); }
#pragma unroll
                    for (int kk = 0; kk < 2; ++kk) { const int k4 = 2 * kh + kk;
#pragma unroll
                        for (int mi = 0; mi < 2; ++mi) s[mi][k4] = (f32x4){0.f, 0.f, 0.f, 0.f};
                        if (k4 == 0 || full) {
#pragma unroll
                            for (int ks = 0; ks < 3; ++ks)
#pragma unroll
                                for (int mi = 0; mi < 2; ++mi) s[mi][k4] = __builtin_amdgcn_mfma_f32_16x16x32_bf16(kf[kk][ks], qf[mi][ks], s[mi][k4], 0, 0, 0);
                        }
                    }
                }
                u32x2 vlo[4], vhi[4];
#pragma unroll
                for (int dt = 0; dt < 4; ++dt) { const unsigned char* vp = sV + (16 * dt + r) * VROW + (4 * q) * 2;
                    vlo[dt] = *(const u32x2*)vp; vhi[dt] = (u32x2){0u, 0u}; if (full) vhi[dt] = *(const u32x2*)(vp + 32); }
                bf16x8 pf[2][2];
#pragma unroll
                for (int mi = 0; mi < 2; ++mi) {
                    float mx = fmaxf(fmaxf(s[mi][0].x, s[mi][0].y), fmaxf(s[mi][0].z, s[mi][0].w));
                    if (full) {
#pragma unroll
                        for (int k4 = 1; k4 < 4; ++k4) mx = fmaxf(mx, fmaxf(fmaxf(s[mi][k4].x, s[mi][k4].y), fmaxf(s[mi][k4].z, s[mi][k4].w)));
                    }
                    mx = quad_max(mx);
                    const float mn = fmaxf(m[mi], mx), alpha = fast_exp2(m[mi] - mn); m[mi] = mn;
                    float ps = 0.f;
#pragma unroll
                    for (int k4 = 0; k4 < 4; ++k4) {
                        if (k4 == 0 || full) { f32x4 p; p.x = fast_exp2(s[mi][k4].x - mn); p.y = fast_exp2(s[mi][k4].y - mn); p.z = fast_exp2(s[mi][k4].z - mn); p.w = fast_exp2(s[mi][k4].w - mn);
                            ps += (p.x + p.y) + (p.z + p.w); s[mi][k4] = p; }
                    }
                    lsum[mi] = lsum[mi] * alpha + ps;
#pragma unroll
                    for (int dt = 0; dt < 4; ++dt) o[mi][dt] = o[mi][dt] * alpha;
#pragma unroll
                    for (int st = 0; st < 2; ++st) { u32x4 pw;
                        pw.x = pk2(s[mi][2 * st].x, s[mi][2 * st].y); pw.y = pk2(s[mi][2 * st].z, s[mi][2 * st].w); pw.z = pk2(s[mi][2 * st + 1].x, s[mi][2 * st + 1].y); pw.w = pk2(s[mi][2 * st + 1].z, s[mi][2 * st + 1].w);
                        if (!full) { pw.z = 0u; pw.w = 0u; }
                        pf[mi][st] = __builtin_bit_cast(bf16x8, pw); }
                }
                u32x2 wlo[4], whi[4];
                if (full) {
#pragma unroll
                    for (int dt = 0; dt < 4; ++dt) { const unsigned char* vp = sV + (16 * dt + r) * VROW + (32 + 4 * q) * 2; wlo[dt] = *(const u32x2*)vp; whi[dt] = *(const u32x2*)(vp + 32); } }
#pragma unroll
                for (int dt = 0; dt < 4; ++dt) { const bf16x8 vf = __builtin_bit_cast(bf16x8, (u32x4){vlo[dt].x, vlo[dt].y, vhi[dt].x, vhi[dt].y});
#pragma unroll
                    for (int mi = 0; mi < 2; ++mi) o[mi][dt] = __builtin_amdgcn_mfma_f32_16x16x32_bf16(vf, pf[mi][0], o[mi][dt], 0, 0, 0); }
                if (full) {
#pragma unroll
                    for (int dt = 0; dt < 4; ++dt) { const bf16x8 vf = __builtin_bit_cast(bf16x8, (u32x4){wlo[dt].x, wlo[dt].y, whi[dt].x, whi[dt].y});
#pragma unroll
                        for (int mi = 0; mi < 2; ++mi) o[mi][dt] = __builtin_amdgcn_mfma_f32_16x16x32_bf16(vf, pf[mi][1], o[mi][dt], 0, 0, 0); } }
            }
            if (kt + 1 < ntiles) lstore(cur ^ 1);
            __syncthreads();
        }
#pragma unroll
        for (int mi = 0; mi < 2; ++mi) {
            const float lt = quad_sum(lsum[mi]);
            if (!meta || (wave == 0 && mi == 0)) {
                const float inv = 1.0f / lt;
                bf16* dst = O + ((size_t)b * L + r0 + 32 * wave + 16 * mi + r) * 512 + h * VD;
#pragma unroll
                for (int dt = 0; dt < 4; ++dt) { const f32x4 v = o[mi][dt] * inv; u32x2 ov; ov.x = pk2(v.x, v.y); ov.y = pk2(v.z, v.w); *(u32x2*)(dst + 16 * dt + 4 * q) = ov; }
            }
        }
    }
}

__device__ __forceinline__ int tile_tok0(int mt, int l) { return l == 1 ? mt * 128 + NMETA * ((mt >> 4) + 1) : mt * 128; }
__device__ __forceinline__ int n_mtiles(int l) { return l == 1 ? 128 : MT; }
__device__ __forceinline__ void phase_D(const Ctx& c0, int l) {
    Ctx c = reopaque(c0);
    const bf16* u2 = WSP(bf16, WS_U2); const bf16* O = WSP(bf16, WS_O); const bf16* gates = WSP(bf16, WS_GATES); bf16* merged = WSP(bf16, WS_MERGED);
    const bf16* Wco = (const bf16*)(c.ws + WS_WIN + l * SZ_WLAYER + OFF_WCO); const bf16* Wmla = (const bf16*)(c.ws + WS_WIN + l * SZ_WLAYER + OFF_WMLA);
    const int r = c.lane & 15, q = c.lane >> 4;
    for (int it = c.vb; it < n_mtiles(l) * 8; it += c.G) {
        const int mt = it / 8, nt = it % 8, tk0 = tile_tok0(mt, l);
        f32x4 acc[2][8]; acc_zero(acc);
        gemm_core(acc, u2 + (size_t)tk0 * 512, 512, Wco + (size_t)nt * 128 * 512, 512, 512, c.lds, c.tid);
#pragma unroll
        for (int mi = 0; mi < 2; ++mi) { const int tok = tk0 + 32 * c.wave + 16 * mi + r;
            const bf16* gp = gates + (size_t)tok * 2048 + nt * 128 + 4 * q; bf16* mp = merged + (size_t)tok * D + nt * 128 + 4 * q;
#pragma unroll
            for (int ni = 0; ni < 8; ++ni) { const u32x2 g = *(const u32x2*)(gp + 16 * ni); const f32x4 v = acc[mi][ni];
                u32x2 o; o.x = pk2(v.x * bf_lo(g.x), v.y * bf_hi(g.x)); o.y = pk2(v.z * bf_lo(g.y), v.w * bf_hi(g.y)); *(u32x2*)(mp + 16 * ni) = o; } }
        acc_zero(acc);
        gemm_core(acc, O + (size_t)tk0 * 512, 512, Wmla + (size_t)nt * 128 * 512, 512, 512, c.lds, c.tid);
#pragma unroll
        for (int mi = 0; mi < 2; ++mi) { const int tok = tk0 + 32 * c.wave + 16 * mi + r;
            const bf16* gp = gates + (size_t)tok * 2048 + 1024 + nt * 128 + 4 * q; bf16* mp = merged + (size_t)tok * D + nt * 128 + 4 * q;
#pragma unroll
            for (int ni = 0; ni < 8; ++ni) { const u32x2 g = *(const u32x2*)(gp + 16 * ni); const u32x2 s = *(const u32x2*)(mp + 16 * ni); const f32x4 v = acc[mi][ni];
                u32x2 o; o.x = pk2(bf_lo(s.x) + v.x * bf_lo(g.x), bf_hi(s.x) + v.y * bf_hi(g.x)); o.y = pk2(bf_lo(s.y) + v.z * bf_lo(g.y), bf_hi(s.y) + v.w * bf_hi(g.y));
                *(u32x2*)(mp + 16 * ni) = o; } }
    }
}

__device__ __forceinline__ void phase_E(const Ctx& c0, int l) {
    Ctx c = reopaque(c0);
    const bf16* merged = WSP(bf16, WS_MERGED); const bf16* Wout = (const bf16*)(c.ws + WS_WIN + l * SZ_WLAYER + OFF_WOUT);
    float* h = WSP(float, WS_H); bf16* hb = WSP(bf16, WS_HB); float* ssq = WSP(float, WS_SSQ);
    const int r = c.lane & 15, q = c.lane >> 4;
    for (int it = c.vb; it < n_mtiles(l) * 8; it += c.G) {
        const int mt = it / 8, nt = it % 8, tk0 = tile_tok0(mt, l);
        f32x4 acc[2][8];
#pragma unroll
        for (int mi = 0; mi < 2; ++mi) { const int tok = tk0 + 32 * c.wave + 16 * mi + r; const float* hp = h + (size_t)tok * D;
            if (l == 0) { const int b = tok / L, pos = tok - b * L; hp = pos < NMETA ? c.in[1] + (size_t)pos * D : c.in[0] + ((size_t)b * SEQ + (pos - NMETA)) * D; }
            hp += nt * 128 + 4 * q;
#pragma unroll
            for (int ni = 0; ni < 8; ++ni) acc[mi][ni] = *(const f32x4*)(hp + 16 * ni); }
        gemm_core(acc, merged + (size_t)tk0 * D, D, Wout + (size_t)nt * 128 * D, D, D, c.lds, c.tid);
#pragma unroll
        for (int mi = 0; mi < 2; ++mi) { const int tok = tk0 + 32 * c.wave + 16 * mi + r; float ss = 0.f;
#pragma unroll
            for (int ni = 0; ni < 8; ++ni) { float* hp = h + (size_t)tok * D + nt * 128 + 16 * ni + 4 * q; const f32x4 v = acc[mi][ni]; *(f32x4*)hp = v;
                ss += (v.x * v.x + v.y * v.y) + (v.z * v.z + v.w * v.w);
                u32x2 o; o.x = pk2(v.x, v.y); o.y = pk2(v.z, v.w); *(u32x2*)(hb + (size_t)tok * D + nt * 128 + 16 * ni + 4 * q) = o; }
            ss = quad_sum(ss);
            if (q == 0) ssq[(size_t)tok * 8 + nt] = ss; }
    }
}

__device__ __forceinline__ unsigned f2key(float f) { const unsigned u = __float_as_uint(f); return u ^ ((u >> 31) ? 0xFFFFFFFFu : 0x80000000u); }
__device__ __forceinline__ float key2f(unsigned k) { const unsigned u = (k >> 31) ? (k ^ 0x80000000u) : ~k; return __uint_as_float(u); }
__device__ __forceinline__ void top16_insert(unsigned (&lst)[16], unsigned x) {
#pragma unroll
    for (int i = 0; i < 16; ++i) { const unsigned a = lst[i]; lst[i] = a > x ? a : x; x = a > x ? x : a; }
}
__device__ __forceinline__ void ce_desc(unsigned& a, unsigned& b) { const unsigned mx = a > b ? a : b, mn = a > b ? b : a; a = mx; b = mn; }
__device__ __forceinline__ void sort16_desc(unsigned (&v)[16]) {
#pragma unroll
    for (int k = 2; k <= 16; k <<= 1)
#pragma unroll
        for (int j = k >> 1; j > 0; j >>= 1)
#pragma unroll
            for (int i = 0; i < 16; ++i) { const int p = i ^ j; if (p > i) { if ((i & k) == 0) ce_desc(v[i], v[p]); else ce_desc(v[p], v[i]); } }
}
__device__ __forceinline__ void merge_top16(unsigned (&a)[16], const unsigned (&b)[16]) {
#pragma unroll
    for (int i = 0; i < 16; ++i) a[i] = a[i] > b[15 - i] ? a[i] : b[15 - i];
#pragma unroll
    for (int j = 8; j > 0; j >>= 1)
#pragma unroll
        for (int i = 0; i < 16; ++i) { const int p = i ^ j; if (p > i) ce_desc(a[i], a[p]); }
}
__device__ __forceinline__ void phase_F(const Ctx& c0, int l) {
    Ctx c = reopaque(c0);
    const bf16* hb = WSP(bf16, WS_HB); const bf16* Wpq = (const bf16*)(c.ws + WS_WIN + l * SZ_WLAYER + OFF_WPQ); const bf16* keys = (const bf16*)(c.ws + WS_WIN + l * SZ_WLAYER + OFF_KEYS);
    const float* ssq = WSP(float, WS_SSQ); float* sv = WSP(float, WS_SV); unsigned char* si = WSP(unsigned char, WS_SI);
    const int tid = c.tid, wave = c.wave, lane = c.lane, r = lane & 15, q = lane >> 4;
    unsigned char* lds = c.lds;
    const int xcd = c.vb / (c.G / 8), lb = c.vb % (c.G / 8), xm = xcd & 1, xn = xcd >> 1, nmt = n_mtiles(l);
    const int m_lo = xm ? (nmt + 1) / 2 : 0, m_cnt = xm ? nmt / 2 : (nmt + 1) / 2;
    for (int j = lb; j < m_cnt * 4; j += c.G / 8) {
        const int mt = m_lo + j / 4, hp = xn * 4 + j % 4, tk0 = tile_tok0(mt, l);
        f32x4 acc[2][8]; acc_zero(acc);
        u32x4 kreg[2][4]; float rsv[2];
        { const int chunk = tid & 7, row0 = tid >> 3; const bf16* pb = keys + ((size_t)hp * 128 + row0) * 128 + chunk * 8;
#pragma unroll
          for (int s = 0; s < 2; ++s)
#pragma unroll
              for (int i = 0; i < 4; ++i) kreg[s][i] = *(const u32x4*)(pb + (size_t)(32 * i) * 128 + s * 64); }
#pragma unroll
        for (int mi = 0; mi < 2; ++mi) rsv[mi] = rstd_from_ssq8(ssq, tk0 + 32 * wave + 16 * mi + r);
        gemm_core(acc, hb + (size_t)tk0 * D, D, Wpq + (size_t)hp * 128 * D, D, D, lds, tid);
#pragma unroll
        for (int mi = 0; mi < 2; ++mi) { const int row = 32 * wave + 16 * mi + r; const float rs = rsv[mi];
#pragma unroll
            for (int ni = 0; ni < 8; ++ni) { const f32x4 v = acc[mi][ni] * rs; u32x2 o; o.x = pk2(v.x, v.y); o.y = pk2(v.z, v.w);
                *(u32x2*)(lds + (ni >> 2) * 32768 + lds_off(row, 2 * (ni & 3) + (q >> 1)) + 8 * (q & 1)) = o; } }
        { const int chunk = tid & 7, row0 = tid >> 3;
#pragma unroll
          for (int s = 0; s < 2; ++s)
#pragma unroll
              for (int i = 0; i < 4; ++i) *(u32x4*)(lds + s * 32768 + 16384 + lds_off(row0 + 32 * i, chunk)) = kreg[s][i]; }
        __syncthreads();
        acc_zero(acc);
        gemm_compute_stage(acc, lds, lds + 16384, wave, lane);
        gemm_compute_stage(acc, lds + 32768, lds + 32768 + 16384, wave, lane);
        __syncthreads();
        float* S = (float*)lds;
#pragma unroll
        for (int mi = 0; mi < 2; ++mi) { const int row = 32 * wave + 16 * mi + r;
#pragma unroll
            for (int ni = 0; ni < 8; ++ni) *(f32x4*)(S + row * 132 + 16 * ni + 4 * q) = acc[mi][ni]; }
        __syncthreads();
        {
            const int tl = 32 * wave + (lane & 31), half = lane >> 5;
            const float* row = S + tl * 132;
            unsigned lst[16];
#pragma unroll
            for (int g = 0; g < 4; ++g) {
                unsigned cur[16];
#pragma unroll
                for (int j = 0; j < 4; ++j) { const int col = 64 * half + 16 * g + 4 * j; const f32x4 v = *(const f32x4*)(row + col);
                    cur[4 * j] = (f2key(v.x) & ~127u) | (unsigned)(127 - col); cur[4 * j + 1] = (f2key(v.y) & ~127u) | (unsigned)(127 - (col + 1));
                    cur[4 * j + 2] = (f2key(v.z) & ~127u) | (unsigned)(127 - (col + 2)); cur[4 * j + 3] = (f2key(v.w) & ~127u) | (unsigned)(127 - (col + 3)); }
                sort16_desc(cur);
                if (g == 0) {
#pragma unroll
                    for (int i = 0; i < 16; ++i) lst[i] = cur[i];
                } else merge_top16(lst, cur);
            }
            unsigned oth[16];
#pragma unroll
            for (int i = 0; i < 16; ++i) { auto rr = __builtin_amdgcn_permlane32_swap(lst[i], lst[i], false, false); oth[i] = half == 0 ? rr[1] : rr[0]; }
            merge_top16(lst, oth);
            if (half == 0) {
                const int tok = tk0 + tl;
                unsigned idx[16]; float val[16];
#pragma unroll
                for (int i = 0; i < 16; ++i) { idx[i] = 127u - (lst[i] & 127u); val[i] = row[idx[i]]; }
                float* svp = sv + ((size_t)tok * 16 + hp) * 16;
#pragma unroll
                for (int i = 0; i < 4; ++i) *(f32x4*)(svp + 4 * i) = (f32x4){val[4 * i], val[4 * i + 1], val[4 * i + 2], val[4 * i + 3]};
                u32x4 pi;
                pi.x = idx[0] | (idx[1] << 8) | (idx[2] << 16) | (idx[3] << 24); pi.y = idx[4] | (idx[5] << 8) | (idx[6] << 16) | (idx[7] << 24);
                pi.z = idx[8] | (idx[9] << 8) | (idx[10] << 16) | (idx[11] << 24); pi.w = idx[12] | (idx[13] << 8) | (idx[14] << 16) | (idx[15] << 24);
                *(u32x4*)(si + ((size_t)tok * 16 + hp) * 16) = pi;
            }
        }
        __syncthreads();
    }
}

__device__ __forceinline__ void phase_F3(const Ctx& c0, int l) {
    Ctx c = reopaque(c0);
    const float* sv = WSP(float, WS_SV); const unsigned char* si = WSP(unsigned char, WS_SI); int* eidx = WSP(int, WS_EIDX); float* gw = WSP(float, WS_GW); unsigned char* stb = WSP(unsigned char, WS_STB);
    float* lsv = (float*)c.lds;
    unsigned char* lsi = c.lds + 256 * 33 * 4;
    const int tid = c.tid;
    const bool has_x = l == 0 && (c.vb & 3) == 0; const int tx = T - 128 + (c.vb >> 2);
    for (int pass = 0; pass < (has_x ? 2 : 1); ++pass) {
        const int thc = c.vb * NTHREADS + tid, tkc = thc >> 3;
        const int th = pass == 1 ? tx * 8 + (tid & 7) : (l == 1 ? tkc + NMETA * ((tkc >> 11) + 1) : tkc) * 8 + (thc & 7);
        float a[16], b[16];
#pragma unroll
        for (int i = 0; i < 4; ++i) { const f32x4 x = *(const f32x4*)(sv + (size_t)th * 32 + 4 * i), y = *(const f32x4*)(sv + (size_t)th * 32 + 16 + 4 * i);
            a[4 * i] = x.x; a[4 * i + 1] = x.y; a[4 * i + 2] = x.z; a[4 * i + 3] = x.w; b[4 * i] = y.x; b[4 * i + 1] = y.y; b[4 * i + 2] = y.z; b[4 * i + 3] = y.w; }
        const u32x4 ia = *(const u32x4*)(si + (size_t)th * 32), ib = *(const u32x4*)(si + (size_t)th * 32 + 16);
#pragma unroll
        for (int i = 0; i < 16; ++i) { lsv[tid * 33 + i] = a[i]; lsv[tid * 33 + 16 + i] = b[i]; }
        *(u32x4*)(lsi + tid * 32) = ia; *(u32x4*)(lsi + tid * 32 + 16) = ib;
        unsigned lst[16], g2[16], g3[16], g4[16];
#pragma unroll
        for (int j = 0; j < 16; ++j) lst[j] = (f2key(a[0] + b[j]) & ~255u) | (unsigned)(255 - j);
#pragma unroll
        for (int i = 1; i < 16; ++i) g2[i - 1] = (f2key(a[i] + b[0]) & ~255u) | (unsigned)(255 - i * 16);
        g2[15] = 0u;
        { int n = 0;
#pragma unroll
          for (int i = 1; i < 16; ++i)
#pragma unroll
              for (int j = 1; j < 16; ++j)
                  if ((i + 1) * (j + 1) <= 16) { const unsigned key = (f2key(a[i] + b[j]) & ~255u) | (unsigned)(255 - (i * 16 + j)); if (n < 16) g3[n] = key; else g4[n - 16] = key; ++n; }
#pragma unroll
          for (int k = 3; k < 16; ++k) g4[k] = 0u; }
        sort16_desc(g3); sort16_desc(g4);
        merge_top16(lst, g2); merge_top16(g3, g4); merge_top16(lst, g3);
        __builtin_amdgcn_s_waitcnt(0xC07F); asm volatile("" ::: "memory");
        float s[16]; int e[16];
#pragma unroll
        for (int k = 0; k < 16; ++k) { const unsigned code = 255u - (lst[k] & 255u); const int i = code >> 4, j = code & 15;
            s[k] = lsv[tid * 33 + i] + lsv[tid * 33 + 16 + j]; e[k] = (int)lsi[tid * 32 + i] * 128 + (int)lsi[tid * 32 + 16 + j]; }
        float mx = s[0];
#pragma unroll
        for (int k = 1; k < 16; ++k) mx = fmaxf(mx, s[k]);
        float sum = 0.f;
#pragma unroll
        for (int k = 0; k < 16; ++k) { s[k] = fast_exp2((s[k] - mx) * 1.4426950409f); sum += s[k]; }
        const float inv = 1.0f / sum;
        typedef unsigned long long u64;
        u64 hlo = 0ull, hhi = 0ull;
#pragma unroll
        for (int k = 0; k < 16; ++k) { const int sl = e[k] >> 10; if (sl < 8) hlo += 1ull << (8 * sl); else hhi += 1ull << (8 * (sl - 8)); }
        u64 ilo = hlo, ihi = hhi;
#pragma unroll
        for (int d = 1; d < 8; d <<= 1) { const u64 a_ = __shfl_up(ilo, d, 8), b_ = __shfl_up(ihi, d, 8); if ((tid & 7) >= d) { ilo += a_; ihi += b_; } }
        const u64 tlo = __shfl(ilo, 7, 8), thi = __shfl(ihi, 7, 8);
        const u64 ones = 0x0101010101010101ull;
        const u64 inlo = tlo * ones, inhi = thi * ones + (inlo >> 56) * ones;
        const u64 stlo = inlo - tlo, sthi = inhi - thi;
        u64 rlo = stlo + (ilo - hlo), rhi = sthi + (ihi - hhi);
        const int tokn = th >> 3;
#pragma unroll
        for (int k = 0; k < 16; ++k) { const int sl = e[k] >> 10; int pos;
            if (sl < 8) { pos = (int)((rlo >> (8 * sl)) & 255ull); rlo += 1ull << (8 * sl); } else { pos = (int)((rhi >> (8 * (sl - 8))) & 255ull); rhi += 1ull << (8 * (sl - 8)); }
            eidx[(size_t)tokn * 128 + pos] = e[k]; gw[(size_t)tokn * 128 + pos] = s[k] * inv; }
        if ((tid & 7) == 0) { u64* sp = (u64*)(stb + (size_t)tokn * 16); sp[0] = stlo; sp[1] = sthi; }
        __builtin_amdgcn_s_waitcnt(0xC07F); asm volatile("" ::: "memory");
    }
}

typedef float f32x2 __attribute__((ext_vector_type(2)));
constexpr int G2_WSTRIDE = 14336, G2_MAXTOK = 9;
__device__ __forceinline__ float fp8dot4(unsigned w, unsigned x01, unsigned x23, float acc) {
    const bf16x2 lo = __builtin_amdgcn_cvt_scalef32_pk_bf16_fp8(w, 1.0f, false), hi = __builtin_amdgcn_cvt_scalef32_pk_bf16_fp8(w, 1.0f, true);
    acc = __builtin_amdgcn_fdot2_f32_bf16(lo, __builtin_bit_cast(bf16x2, x01), acc, false);
    return __builtin_amdgcn_fdot2_f32_bf16(hi, __builtin_bit_cast(bf16x2, x23), acc, false);
}
__device__ __forceinline__ float reduce8_transposed(const float (&p)[8], int lane) {
    float s[4];
#pragma unroll
    for (int k = 0; k < 4; ++k) { auto r = __builtin_amdgcn_permlane32_swap(__float_as_uint(p[k]), __float_as_uint(p[k + 4]), false, false); s[k] = __uint_as_float(r[0]) + __uint_as_float(r[1]); }
    float t[2];
#pragma unroll
    for (int k = 0; k < 2; ++k) { auto r = __builtin_amdgcn_permlane16_swap(__float_as_uint(s[k]), __float_as_uint(s[k + 2]), false, false); t[k] = __uint_as_float(r[0]) + __uint_as_float(r[1]); }
    const float u0 = t[0] + dpp<0x128>(t[0]), u1 = t[1] + dpp<0x128>(t[1]);
    float r = (lane & 8) ? u1 : u0;
    r += dpp<0xB1>(r); r += dpp<0x4E>(r); r += dpp<0x141>(r);
    return r;
}
typedef int i32x4 __attribute__((ext_vector_type(4)));
typedef _Float16 h2 __attribute__((ext_vector_type(2)));
__device__ __forceinline__ void fp4fma8(h2 (&acc)[8], int o, unsigned w, h2 a2) {
    acc[o] = __builtin_elementwise_fma(a2, __builtin_bit_cast(h2, __builtin_amdgcn_cvt_scalef32_pk_f16_fp4(w, 1.0f, 0)), acc[o]);
    acc[o + 1] = __builtin_elementwise_fma(a2, __builtin_bit_cast(h2, __builtin_amdgcn_cvt_scalef32_pk_f16_fp4(w, 1.0f, 1)), acc[o + 1]);
    acc[o + 2] = __builtin_elementwise_fma(a2, __builtin_bit_cast(h2, __builtin_amdgcn_cvt_scalef32_pk_f16_fp4(w, 1.0f, 2)), acc[o + 2]);
    acc[o + 3] = __builtin_elementwise_fma(a2, __builtin_bit_cast(h2, __builtin_amdgcn_cvt_scalef32_pk_f16_fp4(w, 1.0f, 3)), acc[o + 3]);
}
__device__ __forceinline__ void g2_u_chunk(u32x2 (&u)[8], const unsigned char* U, const int* pe_next, const float* pw_c, float* act_c, const u32x2 xq, float rs, int lane) {
    const i32x4 e0 = *(const i32x4*)pe_next, e1 = *(const i32x4*)(pe_next + 4);
    const int en[8] = {e0.x, e0.y, e0.z, e0.w, e1.x, e1.y, e1.z, e1.w};
    float p[8];
#pragma unroll
    for (int k = 0; k < 8; k += 2) {
        int d0 = __builtin_amdgcn_sdot8((int)u[k].x, (int)xq.x, 0, false), d1 = __builtin_amdgcn_sdot8((int)u[k + 1].x, (int)xq.x, 0, false);
        d0 = __builtin_amdgcn_sdot8((int)u[k].y, (int)xq.y, d0, false); d1 = __builtin_amdgcn_sdot8((int)u[k + 1].y, (int)xq.y, d1, false);
        p[k] = (float)d0; p[k + 1] = (float)d1;
        asm volatile("" : "+v"(p[k]), "+v"(p[k + 1]));
        u[k] = *(const u32x2*)(U + (size_t)__builtin_amdgcn_readfirstlane(en[k]) * 512 + lane * 8);
        u[k + 1] = *(const u32x2*)(U + (size_t)__builtin_amdgcn_readfirstlane(en[k + 1]) * 512 + lane * 8);
    }
    const float a = reduce8_transposed(p, lane);
    const int row = (lane >> 3) & 7;
    if ((lane & 7) == 0) { const _Float16 hv = (_Float16)(gelu_tanh(a * rs) * pw_c[row]); act_c[row] = __builtin_bit_cast(float, (h2){hv, hv}); }
}
__device__ __forceinline__ void g2_v_chunk(u32x2 (&v)[8], const unsigned char* V, const int* pe_next, const float* act_c, h2 (&acc)[8], int lane) {
    const i32x4 e0 = *(const i32x4*)pe_next, e1 = *(const i32x4*)(pe_next + 4);
    const int en[8] = {e0.x, e0.y, e0.z, e0.w, e1.x, e1.y, e1.z, e1.w};
    const f32x4 a0 = *(const f32x4*)act_c, a1 = *(const f32x4*)(act_c + 4);
    const float av[8] = {a0.x, a0.y, a0.z, a0.w, a1.x, a1.y, a1.z, a1.w};
#pragma unroll
    for (int k = 0; k < 8; k += 2) {
        const h2 a2 = __builtin_bit_cast(h2, av[k]), b2 = __builtin_bit_cast(h2, av[k + 1]);
        fp4fma8(acc, 0, v[k].x, a2); fp4fma8(acc, 4, v[k].y, a2);
        fp4fma8(acc, 0, v[k + 1].x, b2); fp4fma8(acc, 4, v[k + 1].y, b2);
        asm volatile("" : "+v"(acc[0]), "+v"(acc[1]), "+v"(acc[2]), "+v"(acc[3]), "+v"(acc[4]), "+v"(acc[5]), "+v"(acc[6]), "+v"(acc[7]));
        v[k] = *(const u32x2*)(V + (size_t)__builtin_amdgcn_readfirstlane(en[k]) * 512 + lane * 8);
        v[k + 1] = *(const u32x2*)(V + (size_t)__builtin_amdgcn_readfirstlane(en[k + 1]) * 512 + lane * 8);
    }
}
template <bool REFILL>
__device__ __forceinline__ void g2_uv_chunk(u32x4 (&w)[8], const unsigned char* TB, const int* pe_next, const float* pw_c, const u32x2 xq, float rs, h2 (&acc)[8], int lane) {
    const i32x4 e0 = *(const i32x4*)pe_next, e1 = *(const i32x4*)(pe_next + 4);
    const int en[8] = {e0.x, e0.y, e0.z, e0.w, e1.x, e1.y, e1.z, e1.w};
    float p[8];
#pragma unroll
    for (int k = 0; k < 8; ++k) { int d = __builtin_amdgcn_sdot8((int)w[k].x, (int)xq.x, 0, false); d = __builtin_amdgcn_sdot8((int)w[k].y, (int)xq.y, d, false); p[k] = (float)d; }
    const float a = reduce8_transposed(p, lane);
    const _Float16 hv = (_Float16)(gelu_tanh(a * rs) * pw_c[(lane >> 3) & 7]);
    const int apk = (int)__builtin_bit_cast(unsigned, (h2){hv, hv});
#pragma unroll
    for (int k = 0; k < 8; k += 2) {
        const h2 a2 = __builtin_bit_cast(h2, __builtin_amdgcn_readlane(apk, 8 * k)), b2 = __builtin_bit_cast(h2, __builtin_amdgcn_readlane(apk, 8 * k + 8));
        fp4fma8(acc, 0, w[k].z, a2); fp4fma8(acc, 4, w[k].w, a2);
        fp4fma8(acc, 0, w[k + 1].z, b2); fp4fma8(acc, 4, w[k + 1].w, b2);
        asm volatile("" : "+v"(acc[0]), "+v"(acc[1]), "+v"(acc[2]), "+v"(acc[3]), "+v"(acc[4]), "+v"(acc[5]), "+v"(acc[6]), "+v"(acc[7]));
        if (REFILL) { w[k] = *(const u32x4*)(TB + (size_t)__builtin_amdgcn_readfirstlane(en[k]) * 1024 + lane * 16);
            w[k + 1] = *(const u32x4*)(TB + (size_t)__builtin_amdgcn_readfirstlane(en[k + 1]) * 1024 + lane * 16); }
    }
}
__device__ __forceinline__ void g2_finish_token(Ctx& c, int l, int tok, const f32x2 (&acc)[8], int lane) {
    float* h = WSP(float, WS_H); bf16* hbw = WSP(bf16, WS_HB); float* ssqw = WSP(float, WS_SSQ);
    float* hp = h + (size_t)tok * D + lane * 16;
    f32x4 r0 = *(const f32x4*)hp, r1 = *(const f32x4*)(hp + 4), r2 = *(const f32x4*)(hp + 8), r3 = *(const f32x4*)(hp + 12);
    r0 += (f32x4){acc[0].x, acc[0].y, acc[1].x, acc[1].y}; r1 += (f32x4){acc[2].x, acc[2].y, acc[3].x, acc[3].y};
    r2 += (f32x4){acc[4].x, acc[4].y, acc[5].x, acc[5].y}; r3 += (f32x4){acc[6].x, acc[6].y, acc[7].x, acc[7].y};
    if (l == 0) {
        *(f32x4*)hp = r0; *(f32x4*)(hp + 4) = r1; *(f32x4*)(hp + 8) = r2; *(f32x4*)(hp + 12) = r3;
        u32x4 o0, o1; o0.x = pk2(r0.x, r0.y); o0.y = pk2(r0.z, r0.w); o0.z = pk2(r1.x, r1.y); o0.w = pk2(r1.z, r1.w);
        o1.x = pk2(r2.x, r2.y); o1.y = pk2(r2.z, r2.w); o1.z = pk2(r3.x, r3.y); o1.w = pk2(r3.z, r3.w);
        *(u32x4*)(hbw + (size_t)tok * D + lane * 16) = o0; *(u32x4*)(hbw + (size_t)tok * D + lane * 16 + 8) = o1;
        float ss = (r0.x * r0.x + r0.y * r0.y) + (r0.z * r0.z + r0.w * r0.w) + (r1.x * r1.x + r1.y * r1.y) + (r1.z * r1.z + r1.w * r1.w)
                 + (r2.x * r2.x + r2.y * r2.y) + (r2.z * r2.z + r2.w * r2.w) + (r3.x * r3.x + r3.y * r3.y) + (r3.z * r3.z + r3.w * r3.w);
        ss = wave_sum_dpp(ss);
        if (lane < 8) ssqw[(size_t)tok * 8 + lane] = lane == 0 ? ss : 0.f;
    } else {
        const int b = tok / L, pos = tok - b * L;
        if (pos >= NMETA) { float* op = c.out + ((size_t)b * SEQ + (pos - NMETA)) * D + lane * 16;
            *(f32x4*)op = r0; *(f32x4*)(op + 4) = r1; *(f32x4*)(op + 8) = r2; *(f32x4*)(op + 12) = r3; }
    }
}
__device__ __forceinline__ void phase_G2(const Ctx& c0, int l) {
    Ctx c = reopaque(c0);
    const bf16* hb = WSP(bf16, WS_HB); const float* ssq = WSP(float, WS_SSQ); const int* pe = WSP(int, WS_EIDX); const float* pw = WSP(float, WS_GW);
    const unsigned char* TB = c.ws + WS_TAB + (size_t)(l * 2) * SZ_TAB;
    const int lane = c.lane, wave = c.wave;
    const int gw = c.vb * 4 + wave, t0 = l == 1 ? gw * 8 + NMETA * ((gw >> 8) + 1) : gw * 8;
    const bool has_x = l == 0 && (c.vb & 3) == 0; const int tx = T - 128 + (c.vb >> 2);
    unsigned char* wl = c.lds + wave * G2_WSTRIDE;
    int* pe_l = (int*)wl; float* pw_l = (float*)(wl + 4608); float* act_l = (float*)(wl + 9216);
#pragma unroll
    for (int j = 0; j < G2_MAXTOK; ++j) { const int tok = j < 8 ? t0 + j : (has_x ? tx : t0);
        pe_l[j * 128 + lane] = pe[(size_t)tok * 128 + lane]; pe_l[j * 128 + 64 + lane] = pe[(size_t)tok * 128 + 64 + lane];
        pw_l[j * 128 + lane] = pw[(size_t)tok * 128 + lane]; pw_l[j * 128 + 64 + lane] = pw[(size_t)tok * 128 + 64 + lane]; }
    const int xlo = has_x ? 4 * wave : 16, xhi = has_x ? 4 * wave + 4 : 16;
    h2 acc[G2_MAXTOK][8];
    {
        u32x2 xq[G2_MAXTOK]; float rs[G2_MAXTOK];
#pragma unroll
        for (int j = 0; j < G2_MAXTOK; ++j) { const int tok = j < 8 ? t0 + j : (has_x ? tx : t0);
            const u32x4 lo = *(const u32x4*)(hb + (size_t)tok * D + lane * 16), hi = *(const u32x4*)(hb + (size_t)tok * D + lane * 16 + 8);
            const float sx = rstd_from_ssq8(ssq, tok) * X_SCALE;
            const f32x4 f0 = (f32x4){bf_lo(lo.x), bf_hi(lo.x), bf_lo(lo.y), bf_hi(lo.y)} * sx, f1 = (f32x4){bf_lo(lo.z), bf_hi(lo.z), bf_lo(lo.w), bf_hi(lo.w)} * sx;
            const f32x4 f2 = (f32x4){bf_lo(hi.x), bf_hi(hi.x), bf_lo(hi.y), bf_hi(hi.y)} * sx, f3 = (f32x4){bf_lo(hi.z), bf_hi(hi.z), bf_lo(hi.w), bf_hi(hi.w)} * sx;
            xq[j].x = pack_i4x4(f0) | (pack_i4x4(f1) << 16); xq[j].y = pack_i4x4(f2) | (pack_i4x4(f3) << 16);
            rs[j] = 1.0f / (X_SCALE * U_SCALE); }
        h2 acc_[G2_MAXTOK][8];
#pragma unroll
        for (int j = 0; j < G2_MAXTOK; ++j)
#pragma unroll
            for (int i = 0; i < 8; ++i) acc_[j][i] = (h2){(_Float16)0.f, (_Float16)0.f};
        u32x4 w[2][8];
#pragma unroll
        for (int k = 0; k < 8; ++k) { w[0][k] = *(const u32x4*)(TB + (size_t)__builtin_amdgcn_readfirstlane(pe_l[k]) * 1024 + lane * 16);
            w[1][k] = *(const u32x4*)(TB + (size_t)__builtin_amdgcn_readfirstlane(pe_l[128 + k]) * 1024 + lane * 16); }
#pragma unroll 1
        for (int ch = 0; ch < 16; ++ch) {
            const int cn = ch < 15 ? ch + 1 : 0;
#pragma unroll
            for (int j = 0; j < 8; ++j) {
                const int* pe_next = j < 6 ? pe_l + (j + 2) * 128 + ch * 8 : pe_l + (j - 6) * 128 + cn * 8;
                g2_uv_chunk<true>(w[j & 1], TB, pe_next, pw_l + j * 128 + ch * 8, xq[j], rs[j], acc_[j], lane); }
            if (ch >= xlo && ch < xhi) {
                u32x4 wx[8];
#pragma unroll
                for (int k = 0; k < 8; ++k) wx[k] = *(const u32x4*)(TB + (size_t)__builtin_amdgcn_readfirstlane(pe_l[8 * 128 + ch * 8 + k]) * 1024 + lane * 16);
                g2_uv_chunk<false>(wx, TB, pe_l, pw_l + 8 * 128 + ch * 8, xq[8], rs[8], acc_[8], lane); }
        }
#pragma unroll
        for (int j = 0; j < G2_MAXTOK; ++j)
#pragma unroll
            for (int i = 0; i < 8; ++i) acc[j][i] = acc_[j][i];
    }
#pragma unroll
    for (int j = 0; j < 8; ++j) { f32x2 af[8];
#pragma unroll
        for (int i = 0; i < 8; ++i) af[i] = (f32x2){(float)acc[j][i].x, (float)acc[j][i].y} * TAB_INV;
        g2_finish_token(c, l, t0 + j, af, lane); }
    f32x2 accx[8];
#pragma unroll
    for (int i = 0; i < 8; ++i) accx[i] = (f32x2){(float)acc[8][i].x, (float)acc[8][i].y} * TAB_INV;
    __syncthreads();
    if (has_x) {
        f32x2* part = (f32x2*)(c.lds + wave * G2_WSTRIDE);
#pragma unroll
        for (int i = 0; i < 8; ++i) part[i * 64 + lane] = accx[i];
    }
    __syncthreads();
    if (has_x && wave == 0) {
        f32x2 tot[8];
#pragma unroll
        for (int i = 0; i < 8; ++i) { tot[i] = accx[i];
#pragma unroll
            for (int w = 1; w < 4; ++w) tot[i] += ((const f32x2*)(c.lds + w * G2_WSTRIDE))[i * 64 + lane]; }
        g2_finish_token(c, l, tx, tot, lane);
    }
    __syncthreads();
}

struct Args { const float* in[22]; float* out; unsigned char* ws; int ph_lo, ph_hi; };
constexpr int N_PHASES = 17;

__global__ void __launch_bounds__(NTHREADS, 2) fwd_kernel(Args args) {
    extern __shared__ __attribute__((aligned(16))) unsigned char lds_raw[];
    Ctx c;
#pragma unroll
    for (int i = 0; i < 22; ++i) c.in[i] = args.in[i];
    c.out = args.out; c.ws = args.ws; c.lds = lds_raw;
    c.tid = threadIdx.x; c.lane = c.tid & 63; c.wave = __builtin_amdgcn_readfirstlane(c.tid >> 6);
    c.G = gridDim.x; { const int bx = blockIdx.x; c.vb = (c.G % 8 == 0) ? (bx % 8) * (c.G / 8) + bx / 8 : bx; }
    volatile unsigned* misc = (volatile unsigned*)(c.lds + LDS_MISC);
    if (c.tid < 16) misc[c.tid] = 0u;
    __syncthreads();
    const int lo = args.ph_lo, hi = args.ph_hi;
    const bool multi = (hi - lo) > 1;
    XcdBarrier bar; bar.bar = WSP(unsigned, WS_CTL) + CW_BAR; bar.x = 0; bar.st = misc;
    if (multi) bar = xcd_barrier_post(WSP(unsigned, WS_CTL) + CW_BAR, misc);
#define IN_(k) (lo <= (k) && (k) < hi)
#define SEAM_(k) do { if ((k) + 1 < hi) xcd_barrier(bar); } while (0)
    if (IN_(0)) { phase_prologue(c); SEAM_(0); }
#pragma unroll 1
    for (int l = 0; l < 2; ++l) {
        const int p0 = 1 + 8 * l;
        if (IN_(p0 + 0)) { phase_A(c, l); SEAM_(p0 + 0); }
        if (IN_(p0 + 1)) { phase_B(c, l); SEAM_(p0 + 1); }
        if (IN_(p0 + 2)) { phase_C(c, l); SEAM_(p0 + 2); }
        if (IN_(p0 + 3)) { phase_D(c, l); SEAM_(p0 + 3); }
        if (IN_(p0 + 4)) { phase_E(c, l); SEAM_(p0 + 4); }
        if (IN_(p0 + 5)) { phase_F(c, l); SEAM_(p0 + 5); }
        if (IN_(p0 + 6)) { phase_F3(c, l); if (p0 + 7 < hi) { asm volatile("s_waitcnt vmcnt(0)" ::: "memory"); __syncthreads(); } }
        if (IN_(p0 + 7)) { phase_G2(c, l); SEAM_(p0 + 7); }
    }
}

extern "C" void kernel_launch(void* const* d_in, const int* in_sizes, int n_in, void* d_out, int out_size, void* d_ws, size_t ws_size, hipStream_t stream) {
    static int grid = 0;
    if (grid == 0) {
        if (n_in != 22 || out_size != NB * SEQ * D || ws_size < WS_END) { fprintf(stderr, "kernel_launch: unexpected shapes (n_in %d out %d ws %zu need %zu)\n", n_in, out_size, ws_size, (size_t)WS_END); grid = -1; return; }
        int dev = 0, cus = 0, per_cu = 0;
        hipGetDevice(&dev); hipDeviceGetAttribute(&cus, hipDeviceAttributeMultiprocessorCount, dev);
        if (hipFuncSetAttribute((const void*)fwd_kernel, hipFuncAttributeMaxDynamicSharedMemorySize, LDS_BYTES) != hipSuccess) { fprintf(stderr, "kernel_launch: hipFuncSetAttribute failed\n"); grid = -1; return; }
        if (hipOccupancyMaxActiveBlocksPerMultiprocessor(&per_cu, (const void*)fwd_kernel, NTHREADS, LDS_BYTES) != hipSuccess || per_cu < 1) { fprintf(stderr, "kernel_launch: occupancy query failed (%d)\n", per_cu); per_cu = 1; (void)hipGetLastError(); }
        if (per_cu > 2) per_cu = 2;
        grid = cus * per_cu;
        if (grid != 512) { fprintf(stderr, "kernel_launch: grid %d unsupported by phase G2 (needs 512 workgroups)\n", grid); grid = -1; return; }
        fprintf(stderr, "kernel_launch: grid %d (%d per CU), lds %d, ws need %zu have %zu\n", grid, per_cu, LDS_BYTES, (size_t)WS_END, ws_size);
    }
    if (grid < 0) return;
    hipMemsetAsync((char*)d_ws + WS_CTL, 0, CTL_BYTES, stream);
    Args a{};
    for (int i = 0; i < 22; ++i) a.in[i] = (const float*)d_in[i];
    a.out = (float*)d_out; a.ws = (unsigned char*)d_ws;
#if MK_PER_PHASE
    for (int ph = 0; ph < N_PHASES; ++ph) { a.ph_lo = ph; a.ph_hi = ph + 1; hipLaunchKernelGGL(fwd_kernel, dim3(grid), dim3(NTHREADS), LDS_BYTES, stream, a); }
#else
    a.ph_lo = 0; a.ph_hi = N_PHASES;
    void* kargs[] = {&a};
    hipError_t e = hipLaunchCooperativeKernel((const void*)fwd_kernel, dim3(grid), dim3(NTHREADS), kargs, LDS_BYTES, stream);
    if (e != hipSuccess) fprintf(stderr, "kernel_launch: cooperative launch failed: %s (grid %d)\n", hipGetErrorString(e), grid);
#endif
}
```
